# Optimizing an MI355X kernel written in HIP

```python
import math
import jax
import jax.numpy as jnp
from jax import lax
import numpy as np

D_MODEL = 2048
BATCH = 2
SEQ = 8192
DEPTH = 2

GRID_W = 64
CTX_LEN = 256
N_BRANCH = 4
BRANCH_WIDTH = D_MODEL // 2

MLA_Q_LORA = D_MODEL // 4
MLA_KV_LORA = D_MODEL // 4
QK_NOPE = 128
QK_ROPE = 64
V_HEAD = 128
MLA_HEADS = BRANCH_WIDTH // V_HEAD
ROPE_BASE = 10000.0
Q_BLOCK = 128

SSM_HEAD_DIM = 64
SSM_HEADS = BRANCH_WIDTH // SSM_HEAD_DIM
SSM_INNER = SSM_HEADS * SSM_HEAD_DIM
SSM_GROUPS = 2
SSM_STATE = 128
SSM_CHUNK = 128
SSM_XBC = SSM_INNER + 2 * SSM_GROUPS * SSM_STATE

HY_WIDTH = BRANCH_WIDTH
HY_EMB = 33
HY_BANDS = (HY_EMB - 1) // 2
HY_FILTER_HIDDEN = 64
HY_TARGET = 1e-2
HY_SLOW_FRAC = 1.5
HY_QUICK_FRAC = 0.3
HY_MIN_DECAY = math.log(HY_TARGET) / HY_SLOW_FRAC
HY_MAX_DECAY = math.log(HY_TARGET) / HY_QUICK_FRAC

RW_HEAD_DIM = 64
RW_WIDTH = BRANCH_WIDTH
RW_HEADS = RW_WIDTH // RW_HEAD_DIM
RW_DECAY_LORA = 64
RW_ICLR_LORA = 64
RW_GATE_LORA = 160
RW_GN_EPS = 64e-5

N_EXPERTS = 16
EXPERT_FF = 1408
EC_CAPACITY = 2

ALPHA = (2 * DEPTH) ** 0.25
BETA = (8 * DEPTH) ** -0.25

MLA_COLS = MLA_Q_LORA + MLA_KV_LORA + QK_ROPE
SSM_COLS = SSM_INNER + SSM_XBC + 2 * SSM_HEADS
HY_COLS = 3 * HY_WIDTH
RW_COLS = 3 * RW_WIDTH + 2 * RW_DECAY_LORA + 2 * RW_ICLR_LORA + RW_GATE_LORA
GATE_COLS = N_BRANCH * D_MODEL
N_IN = MLA_COLS + SSM_COLS + HY_COLS + RW_COLS + GATE_COLS

kernel_name = 'hybrid_mla_ssd_hyena_rwkv7_ecmoe_dit'

F32 = jnp.float32


def layer_norm(x, eps=1e-6):
    xf = x.astype(F32)
    mu = jnp.mean(xf, -1, keepdims=True)
    var = jnp.mean(jnp.square(xf - mu), -1, keepdims=True)
    return (xf - mu) * lax.rsqrt(var + eps)


def rms_norm(x, g, eps=1e-6):
    xf = x.astype(F32)
    return (xf * lax.rsqrt(jnp.mean(xf * xf, -1, keepdims=True) + eps) * g).astype(x.dtype)


def modulate(x, shift, scale):
    return (layer_norm(x) * (1.0 + scale) + shift).astype(x.dtype)


def post_norm(x, y, g, b):
    return (layer_norm(ALPHA * x + y) * g + b).astype(x.dtype)


def dwconv3(u, w, b):
    up = jnp.pad(u, ((0, 0), (1, 1), (0, 0)))
    return up[:, :-2] * w[0] + up[:, 1:-1] * w[1] + up[:, 2:] * w[2] + b


def token_shift(u, mu):
    up = jnp.pad(u, ((0, 0), (1, 1), (0, 0)))
    return u + mu[0] * (up[:, :-2] - u) + mu[1] * (up[:, 2:] - u)


def axial_rope_tables(n_tokens):
    rows = n_tokens // GRID_W
    row = jnp.repeat(jnp.arange(rows), GRID_W).astype(F32)
    col = jnp.tile(jnp.arange(GRID_W), rows).astype(F32)
    half = QK_ROPE // 2
    inv = ROPE_BASE ** (-jnp.arange(0, half, 2, dtype=F32) / half)
    ang = jnp.stack([row[:, None] * inv, col[:, None] * inv], 1)
    return jnp.cos(ang), jnp.sin(ang)


def apply_axial_rope(x, cos, sin):
    xs = x.reshape(x.shape[:-1] + (2, 2, QK_ROPE // 4)).astype(F32)
    x1, x2 = xs[..., 0, :], xs[..., 1, :]
    out = jnp.stack([x1 * cos - x2 * sin, x2 * cos + x1 * sin], -2)
    return out.reshape(x.shape).astype(x.dtype)


def mla_project(u, p, rope):
    b, n, _ = u.shape
    cq, ckv, kpe = jnp.split(u, [MLA_Q_LORA, MLA_Q_LORA + MLA_KV_LORA], -1)
    q = (rms_norm(cq, p['mla_q_norm']) @ p['mla_w_q_up']).reshape(b, n, MLA_HEADS, QK_NOPE + QK_ROPE)
    kv = (rms_norm(ckv, p['mla_kv_norm']) @ p['mla_w_kv_up']).reshape(b, n, MLA_HEADS, QK_NOPE + V_HEAD)
    q_nope, q_pe = jnp.split(q, [QK_NOPE], -1)
    k_nope, v = jnp.split(kv, [QK_NOPE], -1)
    if rope is not None:
        cos, sin = rope
        q_pe = apply_axial_rope(q_pe, cos[:, None], sin[:, None])
        kpe = apply_axial_rope(kpe, cos, sin)
    q = jnp.concatenate([q_nope, q_pe], -1)
    k = jnp.concatenate([k_nope, jnp.broadcast_to(kpe[:, :, None], (b, n, MLA_HEADS, QK_ROPE))], -1)
    return q, k, v


def block_attention(q, k, v):
    b, n, h, dk = q.shape
    scale = dk ** -0.5
    qb = jnp.moveaxis(q.reshape(b, n // Q_BLOCK, Q_BLOCK, h, dk), 1, 0)

    def attend(qi):
        s = jnp.einsum('bqhd,bkhd->bhqk', qi, k).astype(F32) * scale
        pr = jax.nn.softmax(s, -1).astype(v.dtype)
        return jnp.einsum('bhqk,bkhd->bqhd', pr, v)

    o = lax.map(attend, qb)
    return jnp.moveaxis(o, 0, 1).reshape(b, n, h * v.shape[-1])


def mla_branch(uc, ul, rope, p, need_ctx):
    qc, kc, vc = mla_project(uc, p, None)
    ql, kl, vl = mla_project(ul, p, rope)
    yl = block_attention(ql, jnp.concatenate([kc, kl], 1), jnp.concatenate([vc, vl], 1))
    yc = block_attention(qc, kc, vc) if need_ctx else None
    return yc, yl


def segsum(x):
    t = x.shape[-1]
    xr = jnp.broadcast_to(x[..., :, None], x.shape + (t,))
    xr = jnp.where(jnp.tril(jnp.ones((t, t), bool), -1), xr, 0.0)
    cs = jnp.cumsum(xr, axis=-2)
    return jnp.where(jnp.tril(jnp.ones((t, t), bool)), cs, -jnp.inf)


def ssd_chunked(X, dA, Bm, Cm, init):
    b, L, g, j, p_ = X.shape
    c = L // SSM_CHUNK
    X = X.reshape(b, c, SSM_CHUNK, g, j, p_)
    Bm = Bm.reshape(b, c, SSM_CHUNK, g, -1)
    Cm = Cm.reshape(b, c, SSM_CHUNK, g, -1)
    A = jnp.moveaxis(dA.reshape(b, c, SSM_CHUNK, g, j), (1, 2), (3, 4))
    A_cs = jnp.cumsum(A, -1)
    CB = jnp.einsum('bclgn,bcsgn->bgcls', Cm, Bm)
    M = CB[:, :, None] * jnp.exp(segsum(A))
    y_diag = jnp.einsum('bgjcls,bcsgjp->bclgjp', M, X)
    ds = jnp.moveaxis(jnp.exp(A_cs[..., -1:] - A_cs), (3, 4), (1, 2))
    states = jnp.einsum('bclgn,bclgjp->bcgjpn', Bm, X * ds[..., None])
    states = jnp.concatenate([init[:, None], states], 1)
    chunk_A = jnp.pad(A_cs[..., -1], ((0, 0), (0, 0), (0, 0), (1, 0)))
    new_states = jnp.einsum('bgjzc,bcgjpn->bzgjpn', jnp.exp(segsum(chunk_A)), states)
    prev_states, final = new_states[:, :-1], new_states[:, -1]
    sdo = jnp.moveaxis(jnp.exp(A_cs), (3, 4), (1, 2))
    y_off = jnp.einsum('bclgn,bcgjpn->bclgjp', Cm, prev_states) * sdo[..., None]
    return (y_diag + y_off).reshape(b, L, g, j, p_), final


def mamba_prep(u, p):
    b, n, _ = u.shape
    z, xbc, dt = jnp.split(u, [SSM_INNER, SSM_INNER + SSM_XBC], -1)
    xbc = jax.nn.silu(dwconv3(xbc, p['ssm_conv_w'], p['ssm_conv_b']).astype(F32))
    xs, bm, cm = jnp.split(xbc, [SSM_INNER, SSM_INNER + SSM_GROUPS * SSM_STATE], -1)
    xs = xs.reshape(b, n, SSM_HEADS, SSM_HEAD_DIM)
    bm = bm.reshape(b, n, SSM_GROUPS, SSM_STATE)
    cm = cm.reshape(b, n, SSM_GROUPS, SSM_STATE)
    dt = jax.nn.softplus(dt.astype(F32).reshape(b, n, 2, SSM_HEADS) + p['ssm_dt_bias'])
    return z, xs, bm, cm, dt


def ssd_direction(xs, dt, a, bm, cm, init, reverse):
    if reverse:
        xs, dt, bm, cm = (jnp.flip(t, 1) for t in (xs, dt, bm, cm))
    b, n = dt.shape[:2]
    hg = SSM_HEADS // SSM_GROUPS
    X = (xs * dt[..., None]).reshape(b, n, SSM_GROUPS, hg, SSM_HEAD_DIM)
    dA = (dt * a).reshape(b, n, SSM_GROUPS, hg)
    y, final = ssd_chunked(X, dA, bm, cm, init)
    y = y.reshape(b, n, SSM_HEADS, SSM_HEAD_DIM)
    if reverse:
        y = jnp.flip(y, 1)
    return y, final


def mamba_out(y, xs, z, p):
    b, n = y.shape[:2]
    y = (y + xs * p['ssm_d'][:, None]).reshape(b, n, SSM_INNER) * jax.nn.silu(z.astype(F32))
    yg = y.reshape(b, n, SSM_GROUPS, SSM_INNER // SSM_GROUPS)
    yg = yg * lax.rsqrt(jnp.mean(yg * yg, -1, keepdims=True) + 1e-5)
    return (yg.reshape(b, n, SSM_INNER) * p['ssm_norm']).astype(z.dtype)


def mamba_branch(uc, ul, p, need_ctx):
    a = -jnp.exp(p['ssm_a_log'].astype(F32))
    zc, xc, bc, cc, dtc = mamba_prep(uc, p)
    zl, xl, bl, cl, dtl = mamba_prep(ul, p)
    zero = jnp.zeros((ul.shape[0], SSM_GROUPS, SSM_HEADS // SSM_GROUPS, SSM_HEAD_DIM, SSM_STATE), F32)
    yc = yl = 0.0
    for d, rev in enumerate((False, True)):
        yc_d, sc = ssd_direction(xc, dtc[:, :, d], a[d], bc, cc, zero, rev)
        yl_d, _ = ssd_direction(xl, dtl[:, :, d], a[d], bl, cl, sc, rev)
        yc = yc + yc_d
        yl = yl + yl_d
    return (mamba_out(yc, xc, zc, p) if need_ctx else None), mamba_out(yl, xl, zl, p)


def hyena_filters(n, p):
    t = jnp.linspace(0.0, 1.0, n, dtype=F32)[:, None]
    wpos = 2.0 * math.pi * jnp.arange(n, dtype=F32)[:, None] / n
    f = jnp.linspace(1e-4, HY_BANDS - 1, HY_BANDS, dtype=F32)[None]
    z = jnp.concatenate([t, jnp.cos(f * wpos), -jnp.sin(f * wpos)], -1)
    freq = p['hy_freq']
    hdn = jnp.sin(freq * (z @ p['hy_w1'] + p['hy_b1']))
    hdn = jnp.sin(freq * (hdn @ p['hy_w2'] + p['hy_b2']))
    filt = (hdn @ p['hy_w3']).astype(F32).reshape(n, 2, HY_WIDTH)
    deltas = jnp.abs(jnp.linspace(HY_MIN_DECAY, HY_MAX_DECAY, HY_WIDTH, dtype=F32))
    return filt * jnp.exp(-t * deltas)[:, None]


def bidir_long_conv(v, filt):
    n, ch = v.shape[1], v.shape[2]
    k_full = jnp.concatenate([filt[:, 0], jnp.zeros((1, ch), F32), filt[:0:-1, 1]], 0)
    kf = jnp.fft.rfft(k_full, axis=0)
    vf = jnp.fft.rfft(v, n=2 * n, axis=1)
    return jnp.fft.irfft(vf * kf, n=2 * n, axis=1)[:, :n]


def hyena_seq(u, p):
    n = u.shape[1]
    uc = dwconv3(u, p['hy_conv_w'], p['hy_conv_b']).astype(F32)
    x0, x1, v = jnp.split(uc, 3, -1)
    v = v * x1
    y = bidir_long_conv(v, hyena_filters(n, p)) + v * p['hy_d']
    return (y * x0).astype(u.dtype)


def hyena_branch(uc, ul, p, need_ctx):
    return (hyena_seq(uc, p) if need_ctx else None), hyena_seq(ul, p)


def rwkv_prep(u, p):
    b, n, _ = u.shape
    heads = lambda t: t.reshape(b, n, RW_HEADS, RW_HEAD_DIM)
    us = token_shift(u, p['rw_mu']).astype(F32)
    cuts = np.cumsum([RW_WIDTH, RW_WIDTH, RW_WIDTH, 2 * RW_DECAY_LORA, 2 * RW_ICLR_LORA]).tolist()
    r, k, v, wd, ad, gd = jnp.split(us, cuts, -1)
    g = jax.nn.sigmoid(gd) @ p['rw_g_up']
    kk = heads(k * p['rw_kk'])
    kk = kk / jnp.maximum(jnp.sqrt(jnp.sum(kk * kk, -1, keepdims=True)), 1e-12)
    wd = wd.reshape(b, n, 2, RW_DECAY_LORA)
    ad = ad.reshape(b, n, 2, RW_ICLR_LORA)
    dirs = []
    for d in range(2):
        w_log = -jax.nn.softplus(-(p['rw_w0'][d] + jnp.tanh(wd[:, :, d]) @ p['rw_w_up'][d])) - 0.5
        iclr = jax.nn.sigmoid(p['rw_a0'][d] + ad[:, :, d] @ p['rw_a_up'][d])
        k_d = heads(k * (1.0 + (iclr - 1.0) * p['rw_ka']))
        dirs.append((heads(jnp.exp(-jnp.exp(w_log))), k_d, kk * heads(iclr)))
    return heads(r), heads(v), kk, g, dirs


def rwkv_scan(r, decay, k, v, a_vec, b_vec, s0, reverse):
    def step(s, inp):
        r_t, w_t, k_t, v_t, a_t, b_t = inp
        sa = jnp.einsum('bhvk,bhk->bhv', s, a_t)
        s = s * w_t[:, :, None, :] + sa[..., None] * b_t[:, :, None, :] + v_t[..., None] * k_t[:, :, None, :]
        return s, jnp.einsum('bhvk,bhk->bhv', s, r_t)

    xs = tuple(jnp.moveaxis(t, 1, 0) for t in (r, decay, k, v, a_vec, b_vec))
    s, ys = lax.scan(step, s0, xs, reverse=reverse)
    return jnp.moveaxis(ys, 0, 1), s


def rwkv_out(y, r, v, g, dirs, p, dtype):
    b, n = y.shape[:2]
    mu = jnp.mean(y, -1, keepdims=True)
    var = jnp.mean(jnp.square(y - mu), -1, keepdims=True)
    yn = ((y - mu) * lax.rsqrt(var + RW_GN_EPS)).reshape(b, n, RW_WIDTH) * p['rw_ln_g'] + p['rw_ln_b']
    bonus = sum(jnp.sum(r * k_d * p['rw_rk'], -1, keepdims=True) * v for _, k_d, _ in dirs)
    return ((yn + bonus.reshape(b, n, RW_WIDTH)) * g).astype(dtype)


def rwkv_branch(uc, ul, p, need_ctx):
    rc, vc, kkc, gc, dc = rwkv_prep(uc, p)
    rl, vl, kkl, gl, dl = rwkv_prep(ul, p)
    s0 = jnp.zeros((ul.shape[0], RW_HEADS, RW_HEAD_DIM, RW_HEAD_DIM), F32)
    yc = yl = 0.0
    for d, rev in enumerate((False, True)):
        wc_, kc_, bc_ = dc[d]
        yc_d, sc = rwkv_scan(rc, wc_, kc_, vc, -kkc, bc_, s0, rev)
        wl_, kl_, bl_ = dl[d]
        yl_d, _ = rwkv_scan(rl, wl_, kl_, vl, -kkl, bl_, sc, rev)
        yc = yc + yc_d
        yl = yl + yl_d
    out_c = rwkv_out(yc, rc, vc, gc, dc, p, uc.dtype) if need_ctx else None
    return out_c, rwkv_out(yl, rl, vl, gl, dl, p, ul.dtype)


def merge_branches(branches, gate_logits, p):
    b, n, _ = gate_logits.shape
    gates = jax.nn.sigmoid(gate_logits.reshape(b, n, N_BRANCH, D_MODEL))
    merged = sum(gates[:, :, i] * (y @ p['w_branch'][i]) for i, y in enumerate(branches))
    return merged @ p['w_out']


def hybrid_mixer(hc, hl, p, rope, need_ctx):
    cuts = np.cumsum([MLA_COLS, SSM_COLS, HY_COLS, RW_COLS]).tolist()
    pc = jnp.split(hc @ p['w_in'], cuts, -1)
    pl = jnp.split(hl @ p['w_in'], cuts, -1)
    branches = (mla_branch(pc[0], pl[0], rope, p, need_ctx),
                mamba_branch(pc[1], pl[1], p, need_ctx),
                hyena_branch(pc[2], pl[2], p, need_ctx),
                rwkv_branch(pc[3], pl[3], p, need_ctx))
    yl = merge_branches([br[1] for br in branches], pl[4], p)
    yc = merge_branches([br[0] for br in branches], pc[4], p) if need_ctx else None
    return yc, yl


def expert_choice_ffn(h, p):
    b, n, _ = h.shape
    cap = EC_CAPACITY * n // N_EXPERTS
    aff = jax.nn.softmax((h @ p['w_router']).astype(F32), -1)
    gate, idx = lax.top_k(jnp.swapaxes(aff, 1, 2), cap)
    bidx = jnp.arange(b)[:, None, None]
    xs = h[bidx, idx]
    hid = jax.nn.silu(jnp.einsum('becd,edf->becf', xs, p['w_gate_e'])) * jnp.einsum('becd,edf->becf', xs, p['w_up_e'])
    ye = jnp.einsum('becf,efd->becd', hid, p['w_down_e']) * gate[..., None].astype(h.dtype)
    return jnp.zeros_like(h).at[bidx, idx].add(ye.astype(h.dtype))


def trunk_layer(xc, xl, mod_c, mod_l, p, rope, need_ctx):
    sh1c, sc1c, g1c, sh2c, sc2c, g2c = jnp.split(mod_c, 6, -1)
    sh1, sc1, g1, sh2, sc2, g2 = (m[:, None] for m in jnp.split(mod_l, 6, -1))
    yc, yl = hybrid_mixer(modulate(xc, sh1c, sc1c), modulate(xl, sh1, sc1), p, rope, need_ctx)
    xl = post_norm(xl, g1 * yl, p['ln1_g'], p['ln1_b'])
    xl = post_norm(xl, g2 * expert_choice_ffn(modulate(xl, sh2, sc2), p), p['ln2_g'], p['ln2_b'])
    if need_ctx:
        xc = post_norm(xc, g1c * yc, p['ln1_g'], p['ln1_b'])
        xc = post_norm(xc, g2c * expert_choice_ffn(modulate(xc, sh2c, sc2c), p), p['ln2_g'], p['ln2_b'])
    return xc, xl


def setup_inputs(seed: int = 0) -> dict:
    key = jax.random.key(seed)
    keys = iter(jax.random.split(key, 64))
    L = DEPTH

    def normal(shape, scale=1.0):
        return scale * jax.random.normal(next(keys), shape, F32)

    def gain(shape):
        return 1.0 + 0.05 * jax.random.normal(next(keys), shape, F32)

    def uniform(shape, lo, hi):
        return jax.random.uniform(next(keys), shape, F32, lo, hi)

    dt0 = jnp.exp(uniform((L, 2, SSM_HEADS), math.log(1e-3), math.log(1e-1)))
    return {
        'x': normal((BATCH, SEQ, D_MODEL)),
        'c': normal((BATCH, D_MODEL)),
        'ctx': normal((BATCH, CTX_LEN, D_MODEL)),
        'c_ctx': normal((D_MODEL,)),
        'w_ada': normal((L, D_MODEL, 6 * D_MODEL), D_MODEL ** -0.5),
        'b_ada': normal((L, 6 * D_MODEL), 0.01),
        'w_in': normal((L, D_MODEL, N_IN), D_MODEL ** -0.5),
        'mla_q_norm': gain((L, MLA_Q_LORA)),
        'mla_w_q_up': normal((L, MLA_Q_LORA, MLA_HEADS * (QK_NOPE + QK_ROPE)), MLA_Q_LORA ** -0.5),
        'mla_kv_norm': gain((L, MLA_KV_LORA)),
        'mla_w_kv_up': normal((L, MLA_KV_LORA, MLA_HEADS * (QK_NOPE + V_HEAD)), MLA_KV_LORA ** -0.5),
        'ssm_conv_w': normal((L, 3, SSM_XBC), 3 ** -0.5),
        'ssm_conv_b': normal((L, SSM_XBC), 0.01),
        'ssm_dt_bias': dt0 + jnp.log(-jnp.expm1(-dt0)),
        'ssm_a_log': jnp.log(uniform((L, 2, SSM_HEADS), 1.0, 16.0)),
        'ssm_d': gain((L, SSM_HEADS)),
        'ssm_norm': gain((L, SSM_INNER)),
        'hy_conv_w': normal((L, 3, HY_COLS), 3 ** -0.5),
        'hy_conv_b': normal((L, HY_COLS), 0.01),
        'hy_w1': normal((L, HY_EMB, HY_FILTER_HIDDEN), HY_EMB ** -0.5),
        'hy_b1': normal((L, HY_FILTER_HIDDEN), 0.1),
        'hy_w2': normal((L, HY_FILTER_HIDDEN, HY_FILTER_HIDDEN), HY_FILTER_HIDDEN ** -0.5),
        'hy_b2': normal((L, HY_FILTER_HIDDEN), 0.1),
        'hy_w3': normal((L, HY_FILTER_HIDDEN, 2 * HY_WIDTH), 0.02),
        'hy_freq': gain((L, HY_FILTER_HIDDEN)),
        'hy_d': normal((L, HY_WIDTH), 0.1),
        'rw_mu': uniform((L, 2, RW_COLS), 0.0, 0.5),
        'rw_w0': uniform((L, 2, RW_WIDTH), -5.0, -0.5),
        'rw_w_up': normal((L, 2, RW_DECAY_LORA, RW_WIDTH), 0.1),
        'rw_a0': normal((L, 2, RW_WIDTH), 0.1),
        'rw_a_up': normal((L, 2, RW_ICLR_LORA, RW_WIDTH), 0.1),
        'rw_g_up': normal((L, RW_GATE_LORA, RW_WIDTH), RW_GATE_LORA ** -0.5),
        'rw_kk': 0.85 + normal((L, RW_WIDTH), 0.05),
        'rw_ka': gain((L, RW_WIDTH)),
        'rw_rk': normal((L, RW_HEADS, RW_HEAD_DIM), 0.1),
        'rw_ln_g': gain((L, RW_WIDTH)),
        'rw_ln_b': normal((L, RW_WIDTH), 0.01),
        'w_branch': normal((L, N_BRANCH, BRANCH_WIDTH, D_MODEL), BRANCH_WIDTH ** -0.5),
        'w_out': normal((L, D_MODEL, D_MODEL), BETA * D_MODEL ** -0.5),
        'ln1_g': gain((L, D_MODEL)),
        'ln1_b': normal((L, D_MODEL), 0.01),
        'w_router': normal((L, D_MODEL, N_EXPERTS), D_MODEL ** -0.5),
        'w_gate_e': normal((L, N_EXPERTS, D_MODEL, EXPERT_FF), D_MODEL ** -0.5),
        'w_up_e': normal((L, N_EXPERTS, D_MODEL, EXPERT_FF), D_MODEL ** -0.5),
        'w_down_e': normal((L, N_EXPERTS, EXPERT_FF, D_MODEL), BETA * EXPERT_FF ** -0.5),
        'ln2_g': gain((L, D_MODEL)),
        'ln2_b': normal((L, D_MODEL), 0.01),
    }


def reference(x, c, ctx, c_ctx, w_ada, b_ada, w_in, mla_q_norm, mla_w_q_up, mla_kv_norm, mla_w_kv_up,
              ssm_conv_w, ssm_conv_b, ssm_dt_bias, ssm_a_log, ssm_d, ssm_norm,
              hy_conv_w, hy_conv_b, hy_w1, hy_b1, hy_w2, hy_b2, hy_w3, hy_freq, hy_d,
              rw_mu, rw_w0, rw_w_up, rw_a0, rw_a_up, rw_g_up, rw_kk, rw_ka, rw_rk, rw_ln_g, rw_ln_b,
              w_branch, w_out, ln1_g, ln1_b, w_router, w_gate_e, w_up_e, w_down_e, ln2_g, ln2_b):
    stacked = dict(
        w_in=w_in, mla_q_norm=mla_q_norm, mla_w_q_up=mla_w_q_up, mla_kv_norm=mla_kv_norm, mla_w_kv_up=mla_w_kv_up,
        ssm_conv_w=ssm_conv_w, ssm_conv_b=ssm_conv_b, ssm_dt_bias=ssm_dt_bias, ssm_a_log=ssm_a_log,
        ssm_d=ssm_d, ssm_norm=ssm_norm,
        hy_conv_w=hy_conv_w, hy_conv_b=hy_conv_b, hy_w1=hy_w1, hy_b1=hy_b1, hy_w2=hy_w2, hy_b2=hy_b2,
        hy_w3=hy_w3, hy_freq=hy_freq, hy_d=hy_d,
        rw_mu=rw_mu, rw_w0=rw_w0, rw_w_up=rw_w_up, rw_a0=rw_a0, rw_a_up=rw_a_up, rw_g_up=rw_g_up,
        rw_kk=rw_kk, rw_ka=rw_ka, rw_rk=rw_rk, rw_ln_g=rw_ln_g, rw_ln_b=rw_ln_b,
        w_branch=w_branch, w_out=w_out, ln1_g=ln1_g, ln1_b=ln1_b,
        w_router=w_router, w_gate_e=w_gate_e, w_up_e=w_up_e, w_down_e=w_down_e, ln2_g=ln2_g, ln2_b=ln2_b)
    rope = axial_rope_tables(x.shape[1])
    xc, xl = ctx, x
    for i in range(DEPTH):
        p = {name: arr[i] for name, arr in stacked.items()}
        mod_l = jax.nn.silu(c) @ w_ada[i] + b_ada[i]
        mod_c = jax.nn.silu(c_ctx) @ w_ada[i] + b_ada[i]
        xc, xl = trunk_layer(xc, xl, mod_c, mod_l, p, rope, i < DEPTH - 1)
    return xl
```

```cpp
#include <hip/hip_runtime.h>
#include <cstdio>
#include <cstdint>

#ifndef MK_ONE_LAUNCH
#define MK_ONE_LAUNCH 0
#endif

#define LAS __attribute__((address_space(3)))
typedef unsigned short bf16_t;
typedef short bf16x8 __attribute__((ext_vector_type(8)));
typedef float f32x4 __attribute__((ext_vector_type(4)));
typedef float f32x2 __attribute__((ext_vector_type(2)));
typedef unsigned u32x4 __attribute__((ext_vector_type(4)));
typedef unsigned u32x2 __attribute__((ext_vector_type(2)));

constexpr int DM = 2048, NBATCH = 2, SEQ = 8192, CTX = 256, DEPTH = 2;
constexpr int TC = NBATCH * CTX, TL = NBATCH * SEQ, T = TC + TL;
constexpr int NIN = 18432, NNG = 10240, NGATE = 8192;
constexpr int P_CQ = 0, P_CKV = 512, P_KPE = 1024;
constexpr int P_Z = 1088, P_XBC = 2112, P_DT = 3648;
constexpr int P_HY = 3680;
constexpr int P_RW = 6752, P_WD = 9824, P_AD = 9952, P_GD = 10080;
constexpr int NH_MLA = 8, NH_SSM = 16, NH_RW = 16;
constexpr int NEXP = 16, EFF = 1408, CAP_L = 1024, CAP_C = 32;
constexpr int NPAIR = NBATCH * NEXP * CAP_L + NEXP * 256;
constexpr float ALPHA = 1.4142135623730951f;
constexpr int NWAVES = 8, NTHREADS = 512;

__device__ __forceinline__ int seg_of(int row) { return row < 256 ? 0 : row < 512 ? 1 : row < 512 + SEQ ? 2 : 3; }
__device__ __forceinline__ int seg_start(int s) { return s == 0 ? 0 : s == 1 ? 256 : s == 2 ? 512 : 512 + SEQ; }
__device__ __forceinline__ int seg_len(int s) { return s < 2 ? CTX : SEQ; }
__device__ __forceinline__ bool row_first(int row) { return row == 0 || row == 256 || row == 512 || row == 512 + SEQ; }
__device__ __forceinline__ bool row_last(int row) { return row == 255 || row == 511 || row == 511 + SEQ || row == T - 1; }
__device__ __forceinline__ int row_modidx(int row) { return row < 512 ? 2 : (row < 512 + SEQ ? 0 : 1); }

constexpr size_t AL(size_t x) { return (x + 255) / 256 * 256; }
constexpr size_t WS_CTL = 0, CTL_BYTES = 2u << 20;
constexpr int CW_BAR = 1024;
constexpr int CW_MOD = 16384;
constexpr size_t SZ_WIN = (size_t)NIN * DM * 2, SZ_WBR = (size_t)4 * DM * 1024 * 2, SZ_WOUT = (size_t)DM * DM * 2, SZ_WQ = (size_t)1536 * 512 * 2,
                 SZ_WKV = (size_t)2048 * 512 * 2, SZ_WLORA = (size_t)5120 * 512 * 2;
constexpr size_t WS_WIN = CTL_BYTES, WS_WBR = WS_WIN + DEPTH * SZ_WIN, WS_WOUT = WS_WBR + DEPTH * SZ_WBR, WS_WQ = WS_WOUT + DEPTH * SZ_WOUT,
                 WS_WKV = WS_WQ + DEPTH * SZ_WQ, WS_WLORA = WS_WKV + DEPTH * SZ_WKV, WS_XS = WS_WLORA + DEPTH * SZ_WLORA;
constexpr size_t SZ_XS = (size_t)T * DM * 4;
constexpr size_t WS_H = WS_XS + SZ_XS, SZ_H = (size_t)T * DM * 2;
constexpr size_t WS_P = WS_H + SZ_H, SZ_P = (size_t)T * NNG * 2;
constexpr int P2W = 5632, P2_XBC = 0, P2_X0 = 1536, P2_RKV = 2560;
constexpr size_t WS_P2 = WS_P + SZ_P, SZ_P2 = (size_t)T * P2W * 2;
constexpr size_t WS_Q = WS_P2 + SZ_P2, SZ_Q = (size_t)T * 1536 * 2;
constexpr size_t WS_KV = WS_Q + SZ_Q, SZ_KV = (size_t)T * 2048 * 2;
constexpr size_t WS_EW = WS_KV + SZ_KV, SZ_TK2 = (size_t)T * 1024 * 2;
constexpr size_t WS_ICLR = WS_EW + 2 * SZ_TK2;
constexpr size_t WS_KK = WS_ICLR + 2 * SZ_TK2;
constexpr size_t WS_GG = WS_KK + SZ_TK2;
constexpr size_t WS_YRW = WS_GG + SZ_TK2;
constexpr size_t WS_ALORA = WS_YRW + 2 * SZ_TK2, SZ_ALORA = (size_t)T * 512 * 2;
constexpr size_t WS_KPE = WS_ALORA + SZ_ALORA, SZ_KPE = (size_t)T * 64 * 2;
constexpr size_t WS_RS = WS_KPE + SZ_KPE, SZ_RS = AL((size_t)T * 2 * 4);
constexpr size_t WS_DT = WS_RS + SZ_RS, SZ_DT = (size_t)T * 32 * 4;
constexpr size_t WS_VT = WS_DT + SZ_DT, SZ_VT = (size_t)1024 * 2 * SEQ * 4;
constexpr size_t WS_VC = WS_VT + SZ_VT, SZ_VC = (size_t)TC * 1024 * 4;
constexpr size_t WS_FILT = WS_VC + SZ_VC, SZ_FILT = (size_t)1024 * 2 * SEQ * 2;
constexpr size_t WS_FILTC = WS_FILT + SZ_FILT, SZ_FILTC = (size_t)CTX * 2048 * 4;
constexpr size_t WS_HDN = WS_FILTC + SZ_FILTC, SZ_HDN = (size_t)(SEQ + CTX) * 64 * 4;
constexpr int NCHUNK = T / 128;
constexpr size_t WS_MST = WS_HDN + SZ_HDN, SZ_MST = (size_t)2 * NCHUNK * 16 * 8192 * 2;
constexpr size_t WS_MCS = WS_MST + SZ_MST, SZ_MCS = (size_t)2 * NCHUNK * 16 * 4 * 2;
constexpr size_t WS_Y = WS_MCS + AL(SZ_MCS), SZ_Y = (size_t)4 * T * 1024 * 2;
constexpr size_t WS_AFF = WS_Y + SZ_Y, SZ_AFF = (size_t)T * 16 * 4;
constexpr size_t WS_INV = WS_AFF + SZ_AFF, SZ_INV = (size_t)T * 16 * 4;
constexpr size_t WS_PTOK = WS_INV + SZ_INV, SZ_PTOK = (size_t)NPAIR * 4;
constexpr size_t WS_PGATE = WS_PTOK + SZ_PTOK, SZ_PGATE = (size_t)NPAIR * 4;
constexpr size_t WS_END = WS_PGATE + SZ_PGATE;
constexpr size_t WS_GATES = WS_P, SZ_GATES = (size_t)T * NGATE * 2;
constexpr size_t WS_MRGF = WS_P2, SZ_MRGF = (size_t)T * DM * 4;
constexpr size_t WS_MRGB = WS_Q, SZ_MRGB = (size_t)T * DM * 2;
constexpr size_t WS_YMIX = WS_P, SZ_YMIX = (size_t)T * DM * 4;
constexpr size_t WS_H2 = WS_H;
constexpr size_t WS_WE = WS_P2, SZ_WGU = (size_t)NEXP * 2816 * DM * 2, SZ_WD = (size_t)NEXP * DM * EFF * 2;
constexpr size_t WS_XG = WS_P, SZ_XG = (size_t)NPAIR * DM * 2;
constexpr size_t WS_HID = WS_XG + SZ_XG, SZ_HID = (size_t)NPAIR * EFF * 2;
constexpr size_t WS_YE = WS_WE + SZ_WGU + SZ_WD, SZ_YE = (size_t)NPAIR * DM * 2;
static_assert(SZ_GATES <= SZ_P && SZ_MRGF <= SZ_P2 && SZ_MRGB <= SZ_Q + SZ_KV && SZ_YMIX <= SZ_P, "alias map 1");
static_assert(SZ_XG + SZ_HID <= SZ_P, "alias map 2");
static_assert(WS_YE + SZ_YE <= WS_VT, "alias map 3");
static_assert(WS_END < 1800000000ull, "workspace budget");

__device__ __forceinline__ unsigned f2bf(float f) { unsigned u = __builtin_bit_cast(unsigned, f); return (u + 0x7fffu + ((u >> 16) & 1u)) >> 16; }
__device__ __forceinline__ unsigned pk2(float lo, float hi) { return f2bf(lo) | (f2bf(hi) << 16); }
__device__ __forceinline__ float bf2f(unsigned short b) { return __builtin_bit_cast(float, (unsigned)b << 16); }
__device__ __forceinline__ float bflo(unsigned w) { return __builtin_bit_cast(float, w << 16); }
__device__ __forceinline__ float bfhi(unsigned w) { return __builtin_bit_cast(float, w & 0xffff0000u); }
__device__ __forceinline__ unsigned cvt_pk_bf16(float lo, float hi) { unsigned r; asm volatile("v_cvt_pk_bf16_f32 %0, %1, %2" : "=v"(r) : "v"(lo), "v"(hi)); return r; }
__device__ __forceinline__ float dppx(float x, const int sel) {
    const int xi = __builtin_bit_cast(int, x); int r;
    if (sel == 0) r = __builtin_amdgcn_update_dpp(0, xi, 0xB1, 0xF, 0xF, false);
    else if (sel == 1) r = __builtin_amdgcn_update_dpp(0, xi, 0x4E, 0xF, 0xF, false);
    else if (sel == 2) r = __builtin_amdgcn_update_dpp(0, xi, 0x141, 0xF, 0xF, false);
    else r = __builtin_amdgcn_update_dpp(0, xi, 0x140, 0xF, 0xF, false);
    return __builtin_bit_cast(float, r);
}
__device__ __forceinline__ float swz16(float x) { return __builtin_bit_cast(float, __builtin_amdgcn_ds_swizzle(__builtin_bit_cast(int, x), 0x401F)); }
__device__ __forceinline__ float sum4(float v) { v += dppx(v, 0); v += dppx(v, 1); return v; }
__device__ __forceinline__ float sum8(float v) { v = sum4(v); v += dppx(v, 2); return v; }
__device__ __forceinline__ float sum16(float v) { v = sum8(v); v += dppx(v, 3); return v; }
__device__ __forceinline__ float sum32(float v) { v = sum16(v); v += swz16(v); return v; }
__device__ __forceinline__ float wave_sum(float v) {
    v = sum32(v);
    auto rr = __builtin_amdgcn_permlane32_swap(__float_as_uint(v), __float_as_uint(v), false, false);
    return __uint_as_float(rr[0]) + __uint_as_float(rr[1]);
}
__device__ __forceinline__ float sigmoidf_(float x) { return 1.f / (1.f + __expf(-x)); }
__device__ __forceinline__ float siluf_(float x) { return x / (1.f + __expf(-x)); }
__device__ __forceinline__ float softplusf_(float x) { return x > 20.f ? x : __logf(1.f + __expf(x)); }
__device__ __forceinline__ float tanhf_(float x) { const float e = __expf(2.f * fminf(x, 15.f)); return 1.f - 2.f / (e + 1.f); }
#define LDS_WAIT() asm volatile("s_waitcnt lgkmcnt(0)" ::: "memory")
#define VM_WAIT() asm volatile("s_waitcnt vmcnt(0)" ::: "memory")

#define XB_TMO      128
#define XB_XCNT(j)  (256  + 64 * (j))
#define XB_XSUB(j)  (1280 + 64 * (j))
#define XB_XGEN(j)  (2304 + 64 * (j))
#define XB_TOP      3328
#define XB_TOPGEN   3392
#define XCD_BAR_WORDS 3456
#define XB_SPIN_CAP (1u << 18)
__device__ __forceinline__ unsigned xb_ld(unsigned* p)              { return __hip_atomic_load(p, __ATOMIC_RELAXED, __HIP_MEMORY_SCOPE_AGENT); }
__device__ __forceinline__ unsigned xb_add(unsigned* p, unsigned v) { return __hip_atomic_fetch_add(p, v, __ATOMIC_RELAXED, __HIP_MEMORY_SCOPE_AGENT); }
__device__ __forceinline__ unsigned xb_xcc_id() { return (unsigned)__builtin_amdgcn_s_getreg((3 << 11) | 20) & 0xFu; }
#define XB_SPIN(cond, bar) do { unsigned _sp = 0; while (cond) { __builtin_amdgcn_s_sleep(1); \
    if ((++_sp & 255u) == 0u) { if (xb_ld(&(bar)[XB_TMO])) break; if (_sp > XB_SPIN_CAP) { atomicAdd(&(bar)[XB_TMO], 1u); break; } } } } while (0)
struct XcdBarrier { unsigned* bar; unsigned x; volatile LAS unsigned* st; };
__device__ __forceinline__ XcdBarrier xcd_barrier_post(unsigned* bar, volatile LAS unsigned* st) {
    XcdBarrier b; b.bar = bar; b.x = xb_xcc_id(); b.st = st;
    if (threadIdx.x == 0) (void)xb_add(&bar[XB_XCNT(b.x)], 1u);
    return b;
}
__device__ __forceinline__ void xcd_barrier_complete(unsigned* bar, unsigned x, unsigned& nloc, unsigned& nx) {
    const unsigned G = gridDim.x * gridDim.y * gridDim.z;
    unsigned sum, cnt, mine, sp = 0u;
    for (;;) {
        sum = 0u; cnt = 0u; mine = 0u;
#pragma unroll
        for (unsigned j = 0; j < 16; ++j) { const unsigned c = xb_ld(&bar[XB_XCNT(j)]); sum += c; cnt += (c > 0u) ? 1u : 0u; mine = (j == x) ? c : mine; }
        if (sum == G) break;
        __builtin_amdgcn_s_sleep(1);
        if ((++sp & 255u) == 0u) { if (xb_ld(&bar[XB_TMO])) break; if (sp > XB_SPIN_CAP) { atomicAdd(&bar[XB_TMO], 1u); break; } }
    }
    nloc = mine > 0u ? mine : 1u; nx = cnt > 0u ? cnt : 1u;
}
__device__ __forceinline__ void xcd_barrier(const XcdBarrier& b) {
    asm volatile("s_waitcnt vmcnt(0)" ::: "memory");
    __syncthreads();
    if (threadIdx.x == 0) {
        unsigned* bar = b.bar;
        __builtin_amdgcn_s_waitcnt(0);
        unsigned nloc = b.st[0], nx = b.st[1];
        if (nloc == 0u) { xcd_barrier_complete(bar, b.x, nloc, nx); b.st[0] = nloc; b.st[1] = nx; }
        const unsigned old = xb_add(&bar[XB_XSUB(b.x)], 1u);
        const unsigned gen = old / nloc;
        if (old + 1u == (gen + 1u) * nloc) {
            __builtin_amdgcn_fence(__ATOMIC_RELEASE, "agent");
            asm volatile("s_waitcnt vmcnt(0)" ::: "memory");
            const unsigned og = xb_add(&bar[XB_TOP], 1u);
            const unsigned tg = og / nx;
            if (og + 1u == (tg + 1u) * nx) xb_add(&bar[XB_TOPGEN], 1u);
            else XB_SPIN(xb_ld(&bar[XB_TOPGEN]) == tg, bar);
            __builtin_amdgcn_fence(__ATOMIC_ACQUIRE, "agent");
            xb_add(&bar[XB_XGEN(b.x)], 1u);
            asm volatile("s_waitcnt vmcnt(0)" ::: "memory");
        } else {
            XB_SPIN(xb_ld(&bar[XB_XGEN(b.x)]) == gen, bar);
            __builtin_amdgcn_fence(__ATOMIC_ACQUIRE, "agent");
            asm volatile("s_waitcnt vmcnt(0)" ::: "memory");
        }
    }
    __syncthreads();
}

namespace pg8 {
constexpr int BM = 256, BK = 64, HALF = 128, HTB = HALF * BK * 2, STAGE_BYTES = 8 * HTB, NXCD = 8, WGM = 8;
__host__ __device__ __forceinline__ int lds_byte(int r, int c) { const int st = (r >> 4) * 2 + (c >> 5), rr = r & 15, cc = c & 31, ob = rr * 64 + cc * 2; return st * 1024 + (ob ^ (((ob >> 9) & 1) << 5)); }
__host__ __device__ __forceinline__ void stage_rc(int b, int& R, int& C) { const int st = b / 1024, sb = b % 1024, swz = sb ^ (((sb >> 9) & 1) << 5); R = (st >> 1) * 16 + swz / 64; C = (st & 1) * 32 + (swz % 64) / 2; }
__host__ __device__ __forceinline__ int perm32(int rho) { const int n = rho >> 4, i = rho & 15; return 8 * (i >> 2) + 4 * n + (i & 3); }
struct Unit { int pm, pn; };
struct Gemm { const bf16_t* A; const bf16_t* Bt; int lda, ldb, K; };
struct StaticOrder {
    int nM, nN, nwg, G, c;
    __device__ void init(int nM_, int nN_, int G_, int c_) { nM = nM_; nN = nN_; nwg = nM * nN; G = G_; c = c_; }
    __device__ bool next(int i, Unit& u) const {
        const long L = (long)i * G + c; if (L >= nwg) return false;
        int wgid = (int)L; { const int q = nwg / NXCD, r = nwg % NXCD, xcd = wgid % NXCD, off = wgid / NXCD; wgid = (xcd < r ? xcd * (q + 1) : r * (q + 1) + (xcd - r) * q) + off; }
        const int nig = WGM * nN, gid = wgid / nig, fm = gid * WGM, gsz = (nM - fm) < WGM ? (nM - fm) : WGM;
        u.pm = fm + ((wgid % nig) % gsz); u.pn = (wgid % nig) / gsz; return true;
    }
};
template <class Epi, class Sched>
__device__ __forceinline__ void gemm_phase(LAS unsigned char* lds, const Gemm g, const Sched& S, const Epi& E) {
    constexpr bool ALIGN_EPI = true;
    int tid_ = threadIdx.x; asm volatile("" : "+v"(tid_));
    const int tid = tid_, wid = __builtin_amdgcn_readfirstlane(tid >> 6), lane = tid & 63, wr = wid >> 2, wc = wid & 3, fr = lane & 15, fq = lane >> 4;
    const int K = g.K, nt = K / BK;
    unsigned voffA[2], voffB[2];
#pragma unroll
    for (int i = 0; i < 2; ++i) { int R, C; stage_rc(tid * 16 + i * 8192, R, C); const int Rb = Epi::PERM ? ((R & ~31) + perm32(R & 31)) : R;
        voffA[i] = (unsigned)(R * g.lda + C) * 2u; voffB[i] = (unsigned)(Rb * g.ldb + C) * 2u; }
    const size_t kstep = (size_t)(BK * 2);
    const size_t hstepA = (size_t)HALF * g.lda * 2, hstepB = (size_t)HALF * g.ldb * 2;
    const size_t tstepA = 2 * hstepA, tstepB = 2 * hstepB;
    const unsigned ldsw = (unsigned)wid * 1024u;
    const int aoff = lds_byte(wr * 64 + fr, fq * 8), boff = lds_byte(wc * 32 + fr, fq * 8);
#define PG8_SA(b, h) (((b) * 2 + (h)) * HTB)
#define PG8_SB(b, h) ((4 + (b) * 2 + (h)) * HTB)
#define PG8_STAGE(bufoff, gbase, voff) do { _Pragma("unroll") for (int _i = 0; _i < 2; ++_i) \
        __builtin_amdgcn_global_load_lds((const unsigned*)((const char*)(gbase) + (voff)[_i]), (LAS unsigned*)(lds + (bufoff) + ldsw + _i * 8192), 16, 0, 0); } while (0)
#define PG8_LDA(dst, b, h) do { _Pragma("unroll") for (int m = 0; m < 4; ++m) _Pragma("unroll") for (int k = 0; k < 2; ++k) dst[m][k] = *(const LAS bf16x8*)(lds + PG8_SA(b, h) + aoff + m * 2048 + k * 1024); } while (0)
#define PG8_LDB(dst, b, h) do { _Pragma("unroll") for (int n = 0; n < 2; ++n) _Pragma("unroll") for (int k = 0; k < 2; ++k) dst[n][k] = *(const LAS bf16x8*)(lds + PG8_SB(b, h) + boff + n * 2048 + k * 1024); } while (0)
#define PG8_MMA(ai, bj, At, Bt) do { __builtin_amdgcn_s_setprio(1); _Pragma("unroll") for (int m = 0; m < 4; ++m) _Pragma("unroll") for (int n = 0; n < 2; ++n) _Pragma("unroll") for (int k = 0; k < 2; ++k) \
        acc[ai][bj][m][n] = __builtin_amdgcn_mfma_f32_16x16x32_bf16(Bt[n][k], At[m][k], acc[ai][bj][m][n], 0, 0, 0); __builtin_amdgcn_s_setprio(0); } while (0)
#define PG8_WAIT_V(n) asm volatile("s_waitcnt vmcnt(" #n ")" ::: "memory")
#define PG8_WAIT_L(n) asm volatile("s_waitcnt lgkmcnt(" #n ")" ::: "memory")
#define PG8_BAR __builtin_amdgcn_s_barrier()
#define PG8_SCHED __builtin_amdgcn_sched_barrier(0)
    Unit cur, nxt; int ui = 0;
    if (!S.next(0, cur)) return;
    f32x4 acc[2][2][4][2];
#pragma unroll
    for (int a = 0; a < 2; ++a)
#pragma unroll
        for (int b = 0; b < 2; ++b)
#pragma unroll
            for (int m = 0; m < 4; ++m)
#pragma unroll
                for (int n = 0; n < 2; ++n) acc[a][b][m][n] = (f32x4){0.f, 0.f, 0.f, 0.f};
    bf16x8 At[4][2], B0[2][2], B1[2][2];
    const char* cA = (const char*)g.A + (size_t)cur.pm * tstepA; const char* cB = (const char*)g.Bt + (size_t)cur.pn * tstepB;
    PG8_STAGE(PG8_SB(0, 0), cB, voffB); PG8_STAGE(PG8_SB(0, 1), cB + hstepB, voffB); PG8_STAGE(PG8_SA(0, 0), cA, voffA); PG8_STAGE(PG8_SA(0, 1), cA + hstepA, voffA);
    if (wr == 1) PG8_BAR;
    PG8_WAIT_V(2); PG8_BAR;
    PG8_STAGE(PG8_SB(1, 0), cB + kstep, voffB); PG8_STAGE(PG8_SA(1, 0), cA + kstep, voffA); PG8_STAGE(PG8_SB(1, 1), cB + hstepB + kstep, voffB);
    PG8_WAIT_V(6); PG8_BAR;
    for (;;) {
        const bool has_next = S.next(ui + 1, nxt);
        const char* nA = has_next ? (const char*)g.A + (size_t)nxt.pm * tstepA : cA; const char* nB = has_next ? (const char*)g.Bt + (size_t)nxt.pn * tstepB : cB;
        for (int t = 0; t < nt; t += 2) {
            const bool last = (t == nt - 2);
            const char* a1 = cA + (size_t)(t + 1) * kstep;
            const char* a2 = last ? nA : cA + (size_t)(t + 2) * kstep; const char* b2 = last ? nB : cB + (size_t)(t + 2) * kstep;
            const char* a3 = a2 + kstep; const char* b3 = b2 + kstep;
            PG8_LDB(B0, 0, 0); PG8_LDB(B1, 0, 1); PG8_SCHED; PG8_LDA(At, 0, 0); PG8_STAGE(PG8_SA(1, 1), a1 + hstepA, voffA);
            PG8_WAIT_V(8); PG8_WAIT_L(0); PG8_BAR; PG8_MMA(0, 0, At, B0); PG8_MMA(0, 1, At, B1); PG8_BAR; PG8_SCHED;
            PG8_LDA(At, 0, 1); PG8_STAGE(PG8_SB(0, 0), b2, voffB); PG8_STAGE(PG8_SB(0, 1), b2 + hstepB, voffB); PG8_STAGE(PG8_SA(0, 0), a2, voffA);
            PG8_WAIT_V(8); PG8_WAIT_L(0); PG8_BAR; PG8_MMA(1, 0, At, B0); PG8_MMA(1, 1, At, B1); PG8_BAR; PG8_SCHED;
            PG8_LDB(B0, 1, 0); PG8_LDB(B1, 1, 1); PG8_SCHED; PG8_LDA(At, 1, 0); PG8_STAGE(PG8_SA(0, 1), a2 + hstepA, voffA);
            PG8_WAIT_V(8); PG8_WAIT_L(0); PG8_BAR; PG8_MMA(0, 0, At, B0); PG8_MMA(0, 1, At, B1); PG8_BAR; PG8_SCHED;
            PG8_LDA(At, 1, 1); PG8_STAGE(PG8_SB(1, 0), b3, voffB); PG8_STAGE(PG8_SB(1, 1), b3 + hstepB, voffB); PG8_STAGE(PG8_SA(1, 0), a3, voffA);
            PG8_WAIT_V(8); PG8_WAIT_L(0); PG8_BAR; PG8_MMA(1, 0, At, B0); PG8_MMA(1, 1, At, B1); PG8_BAR; PG8_SCHED;
        }
        if constexpr (ALIGN_EPI) { if (wr == 0) PG8_BAR; }
        E(acc, cur, wr, wc, fr, fq);
        if (!has_next) break;
#pragma unroll
        for (int a = 0; a < 2; ++a)
#pragma unroll
            for (int b = 0; b < 2; ++b)
#pragma unroll
                for (int m = 0; m < 4; ++m)
#pragma unroll
                    for (int n = 0; n < 2; ++n) acc[a][b][m][n] = (f32x4){0.f, 0.f, 0.f, 0.f};
        cur = nxt; cA = nA; cB = nB; ++ui;
        if constexpr (ALIGN_EPI) { if (wr == 1) PG8_BAR; }
    }
    PG8_WAIT_V(0);
    if constexpr (!ALIGN_EPI) { if (wr == 0) PG8_BAR; }
    PG8_BAR;
#undef PG8_SA
#undef PG8_SB
#undef PG8_STAGE
#undef PG8_LDA
#undef PG8_LDB
#undef PG8_MMA
#undef PG8_WAIT_V
#undef PG8_WAIT_L
#undef PG8_BAR
#undef PG8_SCHED
}
}

enum { I_X = 0, I_C, I_CTX, I_CCTX, I_WADA, I_BADA, I_WIN, I_QNORM, I_WQUP, I_KVNORM, I_WKVUP, I_SCONVW, I_SCONVB, I_SDTB, I_SALOG, I_SD, I_SNORM,
       I_HCONVW, I_HCONVB, I_HW1, I_HB1, I_HW2, I_HB2, I_HW3, I_HFREQ, I_HD, I_RMU, I_RW0, I_RWUP, I_RA0, I_RAUP, I_RGUP, I_RKK, I_RKA, I_RRK, I_RLNG, I_RLNB,
       I_WBR, I_WOUT, I_LN1G, I_LN1B, I_WROUTER, I_WGATE, I_WUP, I_WDOWN, I_LN2G, I_LN2B, N_INPUTS };
struct Args { const float* in[N_INPUTS]; float* out; unsigned char* ws; int ph_lo, ph_hi; };
static_assert(sizeof(Args) == (N_INPUTS + 2) * 8 + 8, "Args has no padding");

__device__ __forceinline__ const float* arg_in(const Args& a, int i) { asm volatile("" : "+s"(i)); return a.in[i]; }
__device__ __forceinline__ int opqs(int v) { asm volatile("" : "+s"(v)); return v; }
__device__ __forceinline__ int opqv(int v) { asm volatile("" : "+v"(v)); return v; }
__device__ __forceinline__ unsigned char* opq(unsigned char* p) { asm volatile("" : "+s"(p)); return p; }
struct Frame {
    LAS unsigned char* lds;
    int tid, lane, wave, G, bid, gw, NGW;
    unsigned char* ws;
};
#define WSP(T_, off) ((T_*)(F.ws + (off)))

template <class RowMap>
__device__ __forceinline__ void transpose_item(const float* W, int ldw, bf16_t* WT, int ldt, int k0, int n0, const float* kscale, int koff, RowMap rm, LAS float* scr, int lane) {
#pragma unroll 8
    for (int i = 0; i < 32; ++i) { const int kk = 2 * i + (lane >> 5); float v = W[(size_t)(k0 + kk) * ldw + n0 + (lane & 31)]; if (kscale) v *= kscale[k0 + kk]; scr[kk * 33 + (lane & 31)] = v; }
    LDS_WAIT(); asm volatile("" ::: "memory");
    const int c = lane & 7;
#pragma unroll
    for (int j = 0; j < 4; ++j) { const int n = (lane >> 3) + 8 * j; const LAS float* s = scr + (8 * c) * 33 + n;
        u32x4 o; o.x = pk2(s[0 * 33], s[1 * 33]); o.y = pk2(s[2 * 33], s[3 * 33]); o.z = pk2(s[4 * 33], s[5 * 33]); o.w = pk2(s[6 * 33], s[7 * 33]);
        *(u32x4*)(WT + (size_t)rm(n0 + n) * ldt + koff + k0 + 8 * c) = o; }
    LDS_WAIT(); asm volatile("" ::: "memory");
}
struct RmId { __device__ int operator()(int n) const { return n; } };
struct RmGateUp { int up; __device__ int operator()(int n) const { return 256 * (n >> 7) + (n & 127) + (up ? 128 : 0); } };

__device__ __forceinline__ void p0_weights(Frame& F, const Args& a) {
    LAS float* scr = (LAS float*)(F.lds + F.wave * 8704);
    constexpr int IT_IN = 32 * 576, IT_BR = 16 * 64, IT_OUT = 32 * 64, IT_Q = 8 * 48, IT_KV = 8 * 64;
    constexpr int PER_L = IT_IN + 4 * IT_BR + IT_OUT + IT_Q + IT_KV;
    for (int it = F.gw; it < DEPTH * PER_L; it += F.NGW) {
        const int l = it / PER_L; int r = it % PER_L;
        if (r < IT_IN) { const int kb = r / 576, nb = r % 576;
            transpose_item(arg_in(a, I_WIN) + (size_t)l * DM * NIN, NIN, WSP(bf16_t, WS_WIN + l * SZ_WIN), DM, kb * 64, nb * 32, nullptr, 0, RmId(), scr, F.lane); continue; } r -= IT_IN;
        if (r < 4 * IT_BR) { const int br = r / IT_BR, q = r % IT_BR, kb = q / 64, nb = q % 64;
            transpose_item(arg_in(a, I_WBR) + ((size_t)l * 4 + br) * 1024 * DM, DM, WSP(bf16_t, WS_WBR + l * SZ_WBR) + (size_t)br * DM * 1024, 1024, kb * 64, nb * 32, nullptr, 0, RmId(), scr, F.lane); continue; } r -= 4 * IT_BR;
        if (r < IT_OUT) { const int kb = r / 64, nb = r % 64;
            transpose_item(arg_in(a, I_WOUT) + (size_t)l * DM * DM, DM, WSP(bf16_t, WS_WOUT + l * SZ_WOUT), DM, kb * 64, nb * 32, nullptr, 0, RmId(), scr, F.lane); continue; } r -= IT_OUT;
        if (r < IT_Q) { const int kb = r / 48, nb = r % 48;
            transpose_item(arg_in(a, I_WQUP) + (size_t)l * 512 * 1536, 1536, WSP(bf16_t, WS_WQ + l * SZ_WQ), 512, kb * 64, nb * 32, arg_in(a, I_QNORM) + l * 512, 0, RmId(), scr, F.lane); continue; } r -= IT_Q;
        { const int kb = r / 64, nb = r % 64;
            transpose_item(arg_in(a, I_WKVUP) + (size_t)l * 512 * 2048, 2048, WSP(bf16_t, WS_WKV + l * SZ_WKV), 512, kb * 64, nb * 32, arg_in(a, I_KVNORM) + l * 512, 0, RmId(), scr, F.lane); }
    }
    for (size_t e = (size_t)F.bid * NTHREADS + F.tid; e < (size_t)DEPTH * 5120 * 512; e += (size_t)F.G * NTHREADS) {
        const int l = (int)(e / (5120 * 512)); const int rem = (int)(e % (5120 * 512)); const int n = rem / 512, kc = rem % 512; const int blk = n >> 10, c = n & 1023;
        float v = 0.f;
        if (blk < 2) { if (kc >= 64 * blk && kc < 64 * blk + 64) v = arg_in(a, I_RWUP)[(((size_t)l * 2 + blk) * 64 + (kc - 64 * blk)) * 1024 + c]; }
        else if (blk < 4) { const int d = blk - 2; if (kc >= 128 + 64 * d && kc < 192 + 64 * d) v = arg_in(a, I_RAUP)[(((size_t)l * 2 + d) * 64 + (kc - 128 - 64 * d)) * 1024 + c]; }
        else { if (kc >= 256 && kc < 416) v = arg_in(a, I_RGUP)[((size_t)l * 160 + (kc - 256)) * 1024 + c]; }
        WSP(bf16_t, WS_WLORA)[e] = (bf16_t)f2bf(v);
    }
}
__device__ __forceinline__ void conv_experts(Frame& F, const Args& a, int l) {
    LAS float* scr = (LAS float*)(F.lds + F.wave * 8704);
    constexpr int IT_G = 32 * 44, IT_D = 22 * 64, PER_E = 2 * IT_G + IT_D;
    bf16_t* wgu = WSP(bf16_t, WS_WE); bf16_t* wd = WSP(bf16_t, WS_WE + SZ_WGU);
    for (int it = F.gw; it < NEXP * PER_E; it += F.NGW) {
        const int e = it / PER_E; int r = it % PER_E;
        if (r < 2 * IT_G) { const int up = r / IT_G, q = r % IT_G, kb = q / 44, nb = q % 44;
            const float* src = a.in[up ? I_WUP : I_WGATE] + ((size_t)l * NEXP + e) * DM * EFF;
            RmGateUp rm; rm.up = up;
            transpose_item(src, EFF, wgu + (size_t)e * 2816 * DM, DM, kb * 64, nb * 32, nullptr, 0, rm, scr, F.lane); continue; } r -= 2 * IT_G;
        { const int kb = r / 64, nb = r % 64;
            transpose_item(arg_in(a, I_WDOWN) + ((size_t)l * NEXP + e) * EFF * DM, DM, wd + (size_t)e * DM * EFF, EFF, kb * 64, nb * 32, nullptr, 0, RmId(), scr, F.lane); }
    }
}
__device__ __forceinline__ void p0_mod(Frame& F, const Args& a) {
    LAS float* sv = (LAS float*)(F.lds + 69632);
    for (int i = F.tid; i < 3 * DM; i += NTHREADS) { const int v = i / DM, k = i % DM; const float x = v < 2 ? arg_in(a, I_C)[v * DM + k] : arg_in(a, I_CCTX)[k]; sv[i] = siluf_(x); }
    __syncthreads();
    float* mod = (float*)(F.ws + WS_CTL) + CW_MOD;
    LAS float* red = (LAS float*)(F.lds + 69632 + 3 * DM * 4);
    for (int u = F.bid; u < DEPTH * (6 * DM / 128); u += F.G) {
        const int l = u / (6 * DM / 128), nb = u % (6 * DM / 128); const int kg = F.tid >> 7, cl = F.tid & 127, n = nb * 128 + cl;
        const float* w = arg_in(a, I_WADA) + ((size_t)l * DM + kg * 512) * (6 * DM) + n;
        float a0 = 0.f, a1 = 0.f, a2 = 0.f;
#pragma unroll 8
        for (int k = 0; k < 512; ++k) { const float wv = w[(size_t)k * (6 * DM)]; const int kk = kg * 512 + k; a0 += sv[kk] * wv; a1 += sv[DM + kk] * wv; a2 += sv[2 * DM + kk] * wv; }
        __syncthreads();
        red[(kg * 3 + 0) * 128 + cl] = a0; red[(kg * 3 + 1) * 128 + cl] = a1; red[(kg * 3 + 2) * 128 + cl] = a2;
        __syncthreads();
        if (F.tid < 384) { const int v = F.tid >> 7; const float b = arg_in(a, I_BADA)[l * 6 * DM + n];
            mod[(l * 3 + v) * 6 * DM + n] = b + ((red[(0 * 3 + v) * 128 + cl] + red[(1 * 3 + v) * 128 + cl]) + (red[(2 * 3 + v) * 128 + cl] + red[(3 * 3 + v) * 128 + cl])); }
    }
}

__device__ __forceinline__ void row_stats(const f32x4 (&v)[8], float& mean, float& rstd, float eps) {
    float s = 0.f;
#pragma unroll
    for (int j = 0; j < 8; ++j) s += (v[j].x + v[j].y) + (v[j].z + v[j].w);
    mean = wave_sum(s) * (1.f / DM);
    float s2 = 0.f;
#pragma unroll
    for (int j = 0; j < 8; ++j) { const f32x4 d = v[j] - mean; s2 += (d.x * d.x + d.y * d.y) + (d.z * d.z + d.w * d.w); }
    rstd = 1.f / sqrtf(wave_sum(s2) * (1.f / DM) + eps);
}
__device__ __forceinline__ const float* x_src_row(const Args& a, const Frame& F, int layer, int row) {
    if (layer == 0) return row < TC ? arg_in(a, I_CTX) + (size_t)row * DM : arg_in(a, I_X) + (size_t)(row - TC) * DM;
    return (const float*)(F.ws + WS_XS) + (size_t)row * DM;
}
__device__ __forceinline__ void phase_modln(Frame& F, const Args& a, int layer) {
    const float* mod = (const float*)(F.ws + WS_CTL) + CW_MOD + (size_t)layer * 3 * 6 * DM;
    bf16_t* H = WSP(bf16_t, WS_H);
    for (int row = F.gw; row < T; row += F.NGW) {
        const f32x4* xr = (const f32x4*)x_src_row(a, F, layer, row) + F.lane;
        f32x4 v[8];
#pragma unroll
        for (int j = 0; j < 8; ++j) v[j] = xr[64 * j];
        float mean, rstd; row_stats(v, mean, rstd, 1e-6f);
        const float* m = mod + (size_t)row_modidx(row) * 6 * DM;
        u32x2* o = (u32x2*)(H + (size_t)row * DM) + F.lane;
#pragma unroll
        for (int j = 0; j < 8; ++j) { const int c = 4 * (64 * j + F.lane); const f32x4 sh = *(const f32x4*)(m + c), sc = *(const f32x4*)(m + DM + c);
            const f32x4 y = (v[j] - mean) * rstd * (sc + 1.f) + sh; u32x2 w; w.x = pk2(y.x, y.y); w.y = pk2(y.z, y.w); o[64 * j] = w; }
    }
}

__device__ __forceinline__ void phase_hdn(Frame& F, const Args& a, int layer) {
    LAS float* zs = (LAS float*)(F.lds + F.wave * 512);
    const float* w1 = arg_in(a, I_HW1) + (size_t)layer * 33 * 64; const float* b1 = arg_in(a, I_HB1) + layer * 64;
    const float* w2 = arg_in(a, I_HW2) + (size_t)layer * 64 * 64; const float* b2 = arg_in(a, I_HB2) + layer * 64;
    const float fr = arg_in(a, I_HFREQ)[layer * 64 + F.lane];
    float* HDN = WSP(float, WS_HDN);
    for (int r = F.gw; r < SEQ + CTX; r += F.NGW) {
        const int n = r < SEQ ? SEQ : CTX, t = r < SEQ ? r : r - SEQ;
        const float wpos = (6.283185307179586f * (float)t) / (float)n;
        if (F.lane < 33) { float z;
            if (F.lane == 0) z = (float)t / (float)(n - 1);
            else { const int b = (F.lane - 1) & 15; const float f = 1e-4f + (float)b * ((15.f - 1e-4f) / 15.f); const float ang = f * wpos; z = F.lane <= 16 ? __cosf(ang) : -__sinf(ang); }
            zs[F.lane] = z; }
        LDS_WAIT(); asm volatile("" ::: "memory");
        float p = b1[F.lane];
#pragma unroll
        for (int i = 0; i < 33; ++i) p += zs[i] * w1[i * 64 + F.lane];
        const float h1 = __sinf(fr * p);
        zs[64 + F.lane] = h1;
        LDS_WAIT(); asm volatile("" ::: "memory");
        float q = b2[F.lane];
#pragma unroll 16
        for (int i = 0; i < 64; ++i) q += zs[64 + i] * w2[i * 64 + F.lane];
        HDN[(size_t)r * 64 + F.lane] = __sinf(fr * q);
        LDS_WAIT(); asm volatile("" ::: "memory");
    }
}
__device__ __forceinline__ float hy_delta(int c) { const float mn = -3.0701134573253943f, mx = -15.350567286626972f; return fabsf(mn + (float)c * ((mx - mn) / 1023.f)); }
__device__ __forceinline__ void phase_filt(Frame& F, const Args& a, int layer) {
    const float* w3 = arg_in(a, I_HW3) + (size_t)layer * 64 * 2048; const float* HDN = WSP(float, WS_HDN);
    LAS float* ws3 = (LAS float*)F.lds;
    bf16_t* FILT = WSP(bf16_t, WS_FILT);
    for (int u = F.bid; u < 32 * 16; u += F.G) {
        const int cb = u / 16, tb = u % 16, col0 = cb * 64, t = tb * 512 + F.tid;
        __syncthreads();
        for (int i = F.tid; i < 4096; i += NTHREADS) { const int j = i >> 6, cc = i & 63; ws3[cc * 64 + j] = w3[(size_t)j * 2048 + col0 + cc]; }
        __syncthreads();
        f32x4 h[16];
#pragma unroll
        for (int i = 0; i < 16; ++i) h[i] = *(const f32x4*)(HDN + (size_t)t * 64 + 4 * i);
        const float tn = (float)t / (float)(SEQ - 1);
        for (int cc = 0; cc < 64; ++cc) {
            float acc = 0.f;
#pragma unroll
            for (int i = 0; i < 16; ++i) { const f32x4 w = *(const LAS f32x4*)(ws3 + cc * 64 + 4 * i); acc += h[i].x * w.x + h[i].y * w.y + h[i].z * w.z + h[i].w * w.w; }
            const int col = col0 + cc, side = col >> 10, c = col & 1023;
            FILT[((size_t)c * 2 + side) * SEQ + t] = (bf16_t)f2bf(acc * __expf(-tn * hy_delta(c)));
        }
    }
    float* FILTC = WSP(float, WS_FILTC);
    for (int e = F.bid * NTHREADS + F.tid; e < CTX * 2048; e += F.G * NTHREADS) {
        const int lag = e >> 11, col = e & 2047, c = col & 1023; const float* hr = HDN + (size_t)(SEQ + lag) * 64; float acc = 0.f;
#pragma unroll 16
        for (int j = 0; j < 64; ++j) acc += hr[j] * w3[(size_t)j * 2048 + col];
        FILTC[e] = acc * __expf(-((float)lag / (float)(CTX - 1)) * hy_delta(c));
    }
}

__device__ __forceinline__ void ld8bf(const bf16_t* p, float (&o)[8]) { const u32x4 w = *(const u32x4*)p; o[0] = bflo(w.x); o[1] = bfhi(w.x); o[2] = bflo(w.y); o[3] = bfhi(w.y); o[4] = bflo(w.z); o[5] = bfhi(w.z); o[6] = bflo(w.w); o[7] = bfhi(w.w); }
__device__ __forceinline__ void st8bf(bf16_t* p, const float (&v)[8]) { u32x4 w; w.x = pk2(v[0], v[1]); w.y = pk2(v[2], v[3]); w.z = pk2(v[4], v[5]); w.w = pk2(v[6], v[7]); *(u32x4*)p = w; }
__device__ __forceinline__ void ld8f(const float* p, float (&o)[8]) { const f32x4 a = *(const f32x4*)p, b = *(const f32x4*)(p + 4); o[0] = a.x; o[1] = a.y; o[2] = a.z; o[3] = a.w; o[4] = b.x; o[5] = b.y; o[6] = b.z; o[7] = b.w; }

__device__ __forceinline__ void phase_prep(Frame& F, const Args& a, int layer) {
    const bf16_t* P = WSP(bf16_t, WS_P); bf16_t* P2 = WSP(bf16_t, WS_P2);
    float* RS = WSP(float, WS_RS); bf16_t* KPE = WSP(bf16_t, WS_KPE); float* DT = WSP(float, WS_DT);
    bf16_t* KK = WSP(bf16_t, WS_KK); bf16_t* AL_ = WSP(bf16_t, WS_ALORA); float* VC = WSP(float, WS_VC);
    const float* scw = arg_in(a, I_SCONVW) + (size_t)layer * 3 * 1536; const float* scb = arg_in(a, I_SCONVB) + layer * 1536; const float* dtb = arg_in(a, I_SDTB) + layer * 32;
    const float* hcw = arg_in(a, I_HCONVW) + (size_t)layer * 3 * 3072; const float* hcb = arg_in(a, I_HCONVB) + layer * 3072;
    const float* mu = arg_in(a, I_RMU) + (size_t)layer * 2 * 3488; const float* rkk = arg_in(a, I_RKK) + layer * 1024;
    for (int row = F.gw; row < T; row += F.NGW) {
        const bf16_t* pr = P + (size_t)row * NNG; const bool first = row_first(row), last = row_last(row);
        const bf16_t* pp = pr - NNG; const bf16_t* pn = pr + NNG;
        const int lane = F.lane;
        { float x[8]; ld8bf(pr + P_CQ + lane * 8, x); float s = 0.f;
#pragma unroll
          for (int i = 0; i < 8; ++i) s += x[i] * x[i];
          s = wave_sum(s); const float rq = 1.f / sqrtf(s * (1.f / 512.f) + 1e-6f);
          ld8bf(pr + P_CKV + lane * 8, x); s = 0.f;
#pragma unroll
          for (int i = 0; i < 8; ++i) s += x[i] * x[i];
          s = wave_sum(s); const float rk = 1.f / sqrtf(s * (1.f / 512.f) + 1e-6f);
          if (lane == 0) { RS[row * 2] = rq; RS[row * 2 + 1] = rk; }
          float kv = bf2f(pr[P_KPE + lane]);
          const float other = swz16(kv);
          if (row >= TC) { const int t = (row - TC) & (SEQ - 1); const int axis = lane >> 5, half = (lane >> 4) & 1, j = lane & 15;
              const float pos = (float)(axis == 0 ? (t >> 6) : (t & 63)); const float inv = __builtin_amdgcn_exp2f(-(float)j * 0.8304820237218406f);
              const float sn = __sinf(pos * inv), cs = __cosf(pos * inv);
              kv = half == 0 ? kv * cs - other * sn : kv * cs + other * sn; }
          KPE[(size_t)row * 64 + lane] = (bf16_t)f2bf(kv); }
#pragma unroll 1
        for (int ch = 0; ch < 3; ++ch) { const int c = ch * 512 + lane * 8; float x0[8], xm[8], xp[8], w0[8], w1[8], w2[8], bb[8], o[8];
            ld8bf(pr + P_XBC + c, x0);
            if (!first) ld8bf(pp + P_XBC + c, xm); else { for (int i = 0; i < 8; ++i) xm[i] = 0.f; }
            if (!last) ld8bf(pn + P_XBC + c, xp); else { for (int i = 0; i < 8; ++i) xp[i] = 0.f; }
            ld8f(scw + c, w0); ld8f(scw + 1536 + c, w1); ld8f(scw + 3072 + c, w2); ld8f(scb + c, bb);
#pragma unroll
            for (int i = 0; i < 8; ++i) o[i] = siluf_(xm[i] * w0[i] + x0[i] * w1[i] + xp[i] * w2[i] + bb[i]);
            st8bf(P2 + (size_t)row * P2W + P2_XBC + c, o); }
        if (lane < 32) DT[(size_t)row * 32 + lane] = softplusf_(bf2f(pr[P_DT + lane]) + dtb[lane]);
#pragma unroll 1
        for (int ch = 0; ch < 2; ++ch) { const int c = ch * 512 + lane * 8;
            float o0[8];
            { float x0[8], xm[8], xp[8], w0[8], w1[8], w2[8], bb[8];
              ld8bf(pr + P_HY + c, x0);
              if (!first) ld8bf(pp + P_HY + c, xm); else { for (int i = 0; i < 8; ++i) xm[i] = 0.f; }
              if (!last) ld8bf(pn + P_HY + c, xp); else { for (int i = 0; i < 8; ++i) xp[i] = 0.f; }
              ld8f(hcw + c, w0); ld8f(hcw + 3072 + c, w1); ld8f(hcw + 6144 + c, w2); ld8f(hcb + c, bb);
#pragma unroll
              for (int i = 0; i < 8; ++i) o0[i] = xm[i] * w0[i] + x0[i] * w1[i] + xp[i] * w2[i] + bb[i]; }
            st8bf(P2 + (size_t)row * P2W + P2_X0 + c, o0);
            if (row < TC) { float o1[8], o2[8];
#pragma unroll
                for (int part = 1; part < 3; ++part) { float x0[8], xm[8], xp[8], w0[8], w1[8], w2[8], bb[8]; const int cc = part * 1024 + c;
                    ld8bf(pr + P_HY + cc, x0);
                    if (!first) ld8bf(pp + P_HY + cc, xm); else { for (int i = 0; i < 8; ++i) xm[i] = 0.f; }
                    if (!last) ld8bf(pn + P_HY + cc, xp); else { for (int i = 0; i < 8; ++i) xp[i] = 0.f; }
                    ld8f(hcw + cc, w0); ld8f(hcw + 3072 + cc, w1); ld8f(hcw + 6144 + cc, w2); ld8f(hcb + cc, bb);
#pragma unroll
                    for (int i = 0; i < 8; ++i) { const float r = xm[i] * w0[i] + x0[i] * w1[i] + xp[i] * w2[i] + bb[i]; if (part == 1) o1[i] = r; else o2[i] = r; } }
                float* vc = VC + (size_t)row * 1024 + c;
                *(f32x4*)vc = (f32x4){o1[0] * o2[0], o1[1] * o2[1], o1[2] * o2[2], o1[3] * o2[3]};
                *(f32x4*)(vc + 4) = (f32x4){o1[4] * o2[4], o1[5] * o2[5], o1[6] * o2[6], o1[7] * o2[7]}; } }
#pragma unroll 1
        for (int ch = 0; ch < 7; ++ch) { const int c = ch * 512 + lane * 8;
            if (c < 3488) { float u0[8], um[8], up[8], m0[8], m1[8], us[8];
                ld8bf(pr + P_RW + c, u0);
                if (!first) ld8bf(pp + P_RW + c, um); else { for (int i = 0; i < 8; ++i) um[i] = 0.f; }
                if (!last) ld8bf(pn + P_RW + c, up); else { for (int i = 0; i < 8; ++i) up[i] = 0.f; }
                ld8f(mu + c, m0); ld8f(mu + 3488 + c, m1);
#pragma unroll
                for (int i = 0; i < 8; ++i) us[i] = u0[i] + m0[i] * (um[i] - u0[i]) + m1[i] * (up[i] - u0[i]);
                if (ch < 6) st8bf(P2 + (size_t)row * P2W + P2_RKV + c, us);
                if (ch == 2 || ch == 3) {
                    float kx[8], g8[8]; ld8f(rkk + (c - 1024), g8); float s = 0.f;
#pragma unroll
                    for (int i = 0; i < 8; ++i) { kx[i] = us[i] * g8[i]; s += kx[i] * kx[i]; }
                    s = sum8(s);
                    const float inv = 1.f / fmaxf(sqrtf(s), 1e-12f);
#pragma unroll
                    for (int i = 0; i < 8; ++i) kx[i] *= inv;
                    st8bf(KK + (size_t)row * 1024 + (c - 1024), kx); }
                if (ch == 6) { const int cl = c - 3072; float o[8];
#pragma unroll
                    for (int i = 0; i < 8; ++i) o[i] = cl < 128 ? tanhf_(us[i]) : cl < 256 ? us[i] : sigmoidf_(us[i]);
                    st8bf(AL_ + (size_t)row * 512 + cl, o); } }
            else if (ch == 6) { const int cl = c - 3072; float zz = 0.f; asm volatile("" : "+v"(zz)); float o[8] = {zz, zz, zz, zz, zz, zz, zz, zz}; st8bf(AL_ + (size_t)row * 512 + cl, o); } }
    }
    float* VT = WSP(float, WS_VT);
    LAS float* tl = (LAS float*)F.lds;
    for (int u = F.bid; u < (TL / 64) * 4; u += F.G) {
        const int tb = u >> 2, cb = u & 3; const int row0 = TC + tb * 64; const int c = cb * 256 + (F.tid & 255), th = F.tid >> 8;
        const float w10 = hcw[1024 + c], w11 = hcw[3072 + 1024 + c], w12 = hcw[6144 + 1024 + c], b1 = hcb[1024 + c];
        const float w20 = hcw[2048 + c], w21 = hcw[3072 + 2048 + c], w22 = hcw[6144 + 2048 + c], b2 = hcb[2048 + c];
        __syncthreads();
        for (int i = 0; i < 32; ++i) { const int tl_ = th * 32 + i, row = row0 + tl_; const bf16_t* pr = P + (size_t)row * NNG + P_HY;
            const bool first = row_first(row), last = row_last(row);
            const float x1m = first ? 0.f : bf2f(pr[-NNG + 1024 + c]), x10 = bf2f(pr[1024 + c]), x1p = last ? 0.f : bf2f(pr[NNG + 1024 + c]);
            const float vm = first ? 0.f : bf2f(pr[-NNG + 2048 + c]), v0 = bf2f(pr[2048 + c]), vp = last ? 0.f : bf2f(pr[NNG + 2048 + c]);
            tl[(F.tid & 255) * 65 + tl_] = (x1m * w10 + x10 * w11 + x1p * w12 + b1) * (vm * w20 + v0 * w21 + vp * w22 + b2); }
        __syncthreads();
        const int b = (row0 - TC) >> 13, t0 = (row0 - TC) & (SEQ - 1);
        for (int p = 0; p < 8; ++p) { const int cl = p * 32 + (F.tid >> 4), q = F.tid & 15;
            const f32x4 o = {tl[cl * 65 + 4 * q], tl[cl * 65 + 4 * q + 1], tl[cl * 65 + 4 * q + 2], tl[cl * 65 + 4 * q + 3]};
            *(f32x4*)(VT + ((size_t)(cb * 256 + cl) * 2 + b) * SEQ + t0 + 4 * q) = o; }
    }
}

using pg8::Unit;
#define EPI_LOOP_BEGIN const int row0 = u.pm * 256 + wr * 64 + fr; \
    _Pragma("unroll") for (int ai = 0; ai < 2; ++ai) _Pragma("unroll") for (int m = 0; m < 4; ++m) { const int row = row0 + ai * 128 + m * 16; \
    _Pragma("unroll") for (int bj = 0; bj < 2; ++bj) { const int cl = bj * 128 + wc * 32 + 8 * fq; const f32x4 v0 = acc[ai][bj][m][0], v1 = acc[ai][bj][m][1];
#define EPI_LOOP_END } __builtin_amdgcn_sched_barrier(0); }
struct EpiBf16 {
    static constexpr bool PERM = true;
    bf16_t* O; int ldc; const float* rscale; int rs_stride; int act;
    __device__ __forceinline__ void operator()(const f32x4 (&acc)[2][2][4][2], const Unit& u, int wr, int wc, int fr, int fq) const {
        EPI_LOOP_BEGIN
            const float s = rscale ? rscale[(size_t)row * rs_stride] : 1.f;
            float x[8] = {v0.x * s, v0.y * s, v0.z * s, v0.w * s, v1.x * s, v1.y * s, v1.z * s, v1.w * s};
            if (act == 1) {
#pragma unroll
                for (int i = 0; i < 8; ++i) x[i] = sigmoidf_(x[i]); }
            u32x4 w; w.x = cvt_pk_bf16(x[0], x[1]); w.y = cvt_pk_bf16(x[2], x[3]); w.z = cvt_pk_bf16(x[4], x[5]); w.w = cvt_pk_bf16(x[6], x[7]);
            *(u32x4*)(O + (size_t)row * ldc + u.pn * 256 + cl) = w;
        EPI_LOOP_END
    }
};
struct EpiLora {
    static constexpr bool PERM = true;
    bf16_t* EW; bf16_t* ICLR; bf16_t* GG; const float* w0; const float* a0;
    __device__ __forceinline__ void operator()(const f32x4 (&acc)[2][2][4][2], const Unit& u, int wr, int wc, int fr, int fq) const {
        const int blk = u.pn >> 2, cb = (u.pn & 3) * 256;
        const float* bias = blk < 2 ? w0 + blk * 1024 : a0 + (blk & 1) * 1024;
        bf16_t* dbase = blk < 2 ? EW + (size_t)blk * T * 1024 : blk < 4 ? ICLR + (size_t)(blk - 2) * T * 1024 : GG;
        const float scale = blk < 2 ? 0.6065306597126334f : 1.f; const bool sig = blk < 4;
        EPI_LOOP_BEGIN
            const int c = cb + cl; float x[8] = {v0.x, v0.y, v0.z, v0.w, v1.x, v1.y, v1.z, v1.w};
            if (sig) { const f32x4 b0 = *(const f32x4*)(bias + c), b1 = *(const f32x4*)(bias + c + 4); const float bb[8] = {b0.x, b0.y, b0.z, b0.w, b1.x, b1.y, b1.z, b1.w};
#pragma unroll
                for (int i = 0; i < 8; ++i) x[i] = scale * sigmoidf_(bb[i] + x[i]); }
            u32x4 w; w.x = cvt_pk_bf16(x[0], x[1]); w.y = cvt_pk_bf16(x[2], x[3]); w.z = cvt_pk_bf16(x[4], x[5]); w.w = cvt_pk_bf16(x[6], x[7]);
            *(u32x4*)(dbase + (size_t)row * 1024 + c) = w;
        EPI_LOOP_END
    }
};
struct EpiMerge {
    static constexpr bool PERM = true;
    const bf16_t* gates; float* MF; bf16_t* MB;
    __device__ __forceinline__ void operator()(const f32x4 (&acc)[2][2][4][2], const Unit& uu, int wr, int wc, int fr, int fq) const {
        const int br = uu.pn >> 3; Unit u; u.pm = uu.pm - br * 66; u.pn = uu.pn & 7;
        EPI_LOOP_BEGIN
            const int col = u.pn * 256 + cl; float g[8]; ld8bf(gates + (size_t)row * NGATE + br * DM + col, g);
            float x[8] = {v0.x * g[0], v0.y * g[1], v0.z * g[2], v0.w * g[3], v1.x * g[4], v1.y * g[5], v1.z * g[6], v1.w * g[7]};
            float* mf = MF + (size_t)row * DM + col;
            if (br > 0) { const f32x4 p0 = *(const f32x4*)mf, p1 = *(const f32x4*)(mf + 4); x[0] += p0.x; x[1] += p0.y; x[2] += p0.z; x[3] += p0.w; x[4] += p1.x; x[5] += p1.y; x[6] += p1.z; x[7] += p1.w; }
            if (br < 3) { *(f32x4*)mf = (f32x4){x[0], x[1], x[2], x[3]}; *(f32x4*)(mf + 4) = (f32x4){x[4], x[5], x[6], x[7]}; }
            else { u32x4 w; w.x = cvt_pk_bf16(x[0], x[1]); w.y = cvt_pk_bf16(x[2], x[3]); w.z = cvt_pk_bf16(x[4], x[5]); w.w = cvt_pk_bf16(x[6], x[7]); *(u32x4*)(MB + (size_t)row * DM + col) = w; }
        EPI_LOOP_END
    }
};
struct OrderMerge {
    pg8::StaticOrder so;
    __device__ void init(int G, int c) { so.init(66, 8, G, c); }
    __device__ bool next(int i, Unit& u) const { Unit t; if (!so.next(i >> 2, t)) return false; const int br = i & 3; u.pm = br * 66 + t.pm; u.pn = br * 8 + t.pn; return true; }
};
struct EpiF32 {
    static constexpr bool PERM = true;
    float* O; int ldc;
    __device__ __forceinline__ void operator()(const f32x4 (&acc)[2][2][4][2], const Unit& u, int wr, int wc, int fr, int fq) const {
        EPI_LOOP_BEGIN
            float* o = O + (size_t)row * ldc + u.pn * 256 + cl; *(f32x4*)o = v0; *(f32x4*)(o + 4) = v1;
        EPI_LOOP_END
    }
};
__device__ __forceinline__ int moe_panel(int e, int pi) { return pi < 8 ? (((pi >> 2) * NEXP + e) * 4 + (pi & 3)) : 128 + e; }
struct OrderMoe {
    int npn, G, c;
    __device__ void init(int npn_, int G_, int c_) { npn = npn_; G = G_; c = c_; }
    __device__ bool next(int i, Unit& u) const { const int L = i * G + c; const int per = 9 * npn; if (L >= NEXP * per) return false;
        const int e = L / per, r = L % per, j = r / 9, pi = r % 9; u.pm = moe_panel(e, pi); u.pn = e * npn + j; return true; }
};
struct EpiSwiglu {
    static constexpr bool PERM = true;
    bf16_t* HID;
    __device__ __forceinline__ void operator()(const f32x4 (&acc)[2][2][4][2], const Unit& u, int wr, int wc, int fr, int fq) const {
        const int j = u.pn % 11; const int row0 = u.pm * 256 + wr * 64 + fr;
#pragma unroll
        for (int ai = 0; ai < 2; ++ai)
#pragma unroll
            for (int m = 0; m < 4; ++m) { const int row = row0 + ai * 128 + m * 16;
                const f32x4 g0 = acc[ai][0][m][0], g1 = acc[ai][0][m][1], u0 = acc[ai][1][m][0], u1 = acc[ai][1][m][1];
                u32x4 w; w.x = cvt_pk_bf16(siluf_(g0.x) * u0.x, siluf_(g0.y) * u0.y); w.y = cvt_pk_bf16(siluf_(g0.z) * u0.z, siluf_(g0.w) * u0.w);
                w.z = cvt_pk_bf16(siluf_(g1.x) * u1.x, siluf_(g1.y) * u1.y); w.w = cvt_pk_bf16(siluf_(g1.z) * u1.z, siluf_(g1.w) * u1.w);
                *(u32x4*)(HID + (size_t)row * EFF + j * 128 + wc * 32 + 8 * fq) = w; __builtin_amdgcn_sched_barrier(0); }
    }
};
struct EpiDown {
    static constexpr bool PERM = true;
    bf16_t* YE; const float* pgate;
    __device__ __forceinline__ void operator()(const f32x4 (&acc)[2][2][4][2], const Unit& uu, int wr, int wc, int fr, int fq) const {
        Unit u; u.pm = uu.pm; u.pn = uu.pn & 7;
        EPI_LOOP_BEGIN
            const float s = pgate[row];
            u32x4 w; w.x = cvt_pk_bf16(v0.x * s, v0.y * s); w.y = cvt_pk_bf16(v0.z * s, v0.w * s); w.z = cvt_pk_bf16(v1.x * s, v1.y * s); w.w = cvt_pk_bf16(v1.z * s, v1.w * s);
            *(u32x4*)(YE + (size_t)row * DM + u.pn * 256 + cl) = w;
        EPI_LOOP_END
    }
};

namespace att {
using s16x4 = __attribute__((ext_vector_type(4))) short;
using f32x16 = __attribute__((ext_vector_type(16))) float;
constexpr int NW = 8, QBLK = 32, KVBLK = 64, LDQ = 1536, LDKV = 2048, LDO = 1024;
constexpr float SCALE = 0.07216878364870322f;
constexpr float THR = 8.f;
#ifndef ATT_SDEPTH
#define ATT_SDEPTH 1
#endif
constexpr int SDEPTH = ATT_SDEPTH;
constexpr int SHM_V = KVBLK * 128 * 2, SHM_K = KVBLK * 128 * 2, SHM_KP = KVBLK * 64 * 2;
constexpr int OFF_V = 0, OFF_K = 2 * SHM_V, OFF_KP = OFF_K + 2 * SHM_K, OFF_WS = OFF_KP + 2 * SHM_KP, OFF_QP = OFF_WS + NW * 64 * 4, SHM_ATTN = OFF_QP + 256 * 256;
static_assert(SHM_ATTN <= 150 * 1024, "attention LDS");
#define KSWZ(row, colB) ((row) * 256 + ((colB) ^ (((row) & 7) << 4)))
#define KPSWZ(row, colB) ((row) * 128 + ((colB) ^ (((row) & 7) << 4)))
#define SBAR() __builtin_amdgcn_sched_barrier(0)
__device__ __forceinline__ int crow(int r, int hi) { return (r & 3) + 8 * (r >> 2) + 4 * hi; }
__device__ __forceinline__ void partialSM(f32x16& p0, f32x16& p1, float& m_reg, float& mn, float& alpha) {
  constexpr float C = SCALE * 1.4426950408889634f;
  float pmax = p0[0]; for (int r = 1; r < 16; ++r) pmax = fmaxf(pmax, p0[r]); for (int r = 0; r < 16; ++r) pmax = fmaxf(pmax, p1[r]);
  { auto rr = __builtin_amdgcn_permlane32_swap(__float_as_uint(pmax), __float_as_uint(pmax), false, false);
    pmax = fmaxf(__uint_as_float(rr[0]), __uint_as_float(rr[1])); }
  if (__builtin_expect(__all(pmax - m_reg <= THR / SCALE), 1)) { mn = m_reg; alpha = 1.f; }
  else { mn = fmaxf(m_reg, pmax); alpha = __builtin_amdgcn_exp2f((m_reg - mn) * C); m_reg = mn; }
  float mnC = -mn * C;
  for (int r = 0; r < 16; ++r) p0[r] = fmaf(p0[r], C, mnC); for (int r = 0; r < 16; ++r) p1[r] = fmaf(p1[r], C, mnC);
  for (int r = 0; r < 16; ++r) p0[r] = __builtin_amdgcn_exp2f(p0[r]);
}
__device__ __forceinline__ void finishSM(f32x16& p0, f32x16& p1, float alpha, float& l_reg, bf16x8& pa0, bf16x8& pa1, bf16x8& pa2, bf16x8& pa3) {
  for (int r = 0; r < 16; ++r) p1[r] = __builtin_amdgcn_exp2f(p1[r]);
  float ps = 0; for (int r = 0; r < 16; ++r) ps += p0[r]; for (int r = 0; r < 16; ++r) ps += p1[r];
  { auto rr = __builtin_amdgcn_permlane32_swap(__float_as_uint(ps), __float_as_uint(ps), false, false);
    ps = __uint_as_float(rr[0]) + __uint_as_float(rr[1]); }
  l_reg = l_reg * alpha + ps;
#define PK4(P, BASE, OUT) do { unsigned a0 = cvt_pk_bf16(P[BASE + 0], P[BASE + 1]), a1 = cvt_pk_bf16(P[BASE + 2], P[BASE + 3]);   \
    unsigned b0 = cvt_pk_bf16(P[BASE + 4], P[BASE + 5]), b1 = cvt_pk_bf16(P[BASE + 6], P[BASE + 7]);                              \
    auto r0 = __builtin_amdgcn_permlane32_swap(a0, b0, false, false); auto r1 = __builtin_amdgcn_permlane32_swap(a1, b1, false, false); \
    u32x4 w = {r0[0], r1[0], r0[1], r1[1]}; OUT = *reinterpret_cast<bf16x8*>(&w); } while (0)
  PK4(p0, 0, pa0); PK4(p0, 8, pa1); PK4(p1, 0, pa2); PK4(p1, 8, pa3);
#undef PK4
}
__device__ __forceinline__ void qkt(f32x16& p0, f32x16& p1, const char* Ks, const char* Kp, const bf16x8* qr, const char* Qp, int qrow, int r32, int hi) {
  p0 = f32x16{}; p1 = f32x16{};
#pragma unroll
  for (int d0 = 0; d0 < 8; ++d0) { int cb = (d0 * 16 + hi * 8) * 2;
    bf16x8 b0 = *reinterpret_cast<const bf16x8*>(Ks + KSWZ(r32, cb));
    bf16x8 b1 = *reinterpret_cast<const bf16x8*>(Ks + KSWZ(32 + r32, cb));
    bf16x8 q; if (d0 < 4) q = qr[d0]; else q = *reinterpret_cast<const bf16x8*>(Qp + KSWZ(qrow, ((d0 - 4) * 16 + hi * 8) * 2));
    p0 = __builtin_amdgcn_mfma_f32_32x32x16_bf16(b0, q, p0, 0, 0, 0);
    p1 = __builtin_amdgcn_mfma_f32_32x32x16_bf16(b1, q, p1, 0, 0, 0); }
#pragma unroll
  for (int d0 = 0; d0 < 4; ++d0) { int cb = (d0 * 16 + hi * 8) * 2;
    bf16x8 b0 = *reinterpret_cast<const bf16x8*>(Kp + KPSWZ(r32, cb));
    bf16x8 b1 = *reinterpret_cast<const bf16x8*>(Kp + KPSWZ(32 + r32, cb));
    const bf16x8 qp = *reinterpret_cast<const bf16x8*>(Qp + KSWZ(qrow, 128 + cb));
    p0 = __builtin_amdgcn_mfma_f32_32x32x16_bf16(b0, qp, p0, 0, 0, 0);
    p1 = __builtin_amdgcn_mfma_f32_32x32x16_bf16(b1, qp, p1, 0, 0, 0); }
}
__device__ __forceinline__ int v_st(int k, int c) { const int kk = (k & ~0xC) | ((k & 4) << 1) | ((k & 8) >> 1); return ((kk >> 3) * 4 + (c >> 5)) * 512 + ((kk & 7) * 32 + (c & 31)) * 2; }
__device__ __forceinline__ int v_rd_base(int lane) { return ((lane & 3) << 3) | (((lane >> 2) & 3) << 6) | (((lane >> 4) & 1) << 5) | (((lane >> 5) & 1) << 8); }
constexpr int v_rd_off(int d0, int ks, int half) { return d0 * 512 + ks * 4096 + half * 2048; }
template <int OFF> __device__ __forceinline__ s16x4 tr_read(int vb) {
  s16x4 r; asm volatile("ds_read_b64_tr_b16 %0, %1 offset:%2" : "=&v"(r) : "v"(vb), "i"(OFF) : "memory"); return r;
}
template <int D0> __device__ __forceinline__ void pv_one(f32x16& od, int vb, bf16x8 pa0, bf16x8 pa1, bf16x8 pa2, bf16x8 pa3) {
  const s16x4 l0 = tr_read<v_rd_off(D0, 0, 0)>(vb), h0 = tr_read<v_rd_off(D0, 0, 1)>(vb), l1 = tr_read<v_rd_off(D0, 1, 0)>(vb), h1 = tr_read<v_rd_off(D0, 1, 1)>(vb);
  const s16x4 l2 = tr_read<v_rd_off(D0, 2, 0)>(vb), h2 = tr_read<v_rd_off(D0, 2, 1)>(vb), l3 = tr_read<v_rd_off(D0, 3, 0)>(vb), h3 = tr_read<v_rd_off(D0, 3, 1)>(vb);
  asm volatile("s_waitcnt lgkmcnt(0)" ::: "memory"); SBAR();
#define PK(L, H) (bf16x8){L[0], L[1], L[2], L[3], H[0], H[1], H[2], H[3]}
  od = __builtin_amdgcn_mfma_f32_32x32x16_bf16(pa0, PK(l0, h0), od, 0, 0, 0);
  od = __builtin_amdgcn_mfma_f32_32x32x16_bf16(pa1, PK(l1, h1), od, 0, 0, 0);
  od = __builtin_amdgcn_mfma_f32_32x32x16_bf16(pa2, PK(l2, h2), od, 0, 0, 0);
  od = __builtin_amdgcn_mfma_f32_32x32x16_bf16(pa3, PK(l3, h3), od, 0, 0, 0);
#undef PK
}
__device__ __forceinline__ void pv_d0(f32x16* o, int vb, bf16x8 pa0, bf16x8 pa1, bf16x8 pa2, bf16x8 pa3) {
  pv_one<0>(o[0], vb, pa0, pa1, pa2, pa3); pv_one<1>(o[1], vb, pa0, pa1, pa2, pa3); pv_one<2>(o[2], vb, pa0, pa1, pa2, pa3); pv_one<3>(o[3], vb, pa0, pa1, pa2, pa3);
}
__device__ __forceinline__ void attn_unit(const bf16_t* __restrict__ Qb, const bf16_t* __restrict__ KVh, const bf16_t* __restrict__ KPE, bf16_t* __restrict__ Ob,
                                          int ka0, int kb0, int NT, char* lds) {
  int tid_ = threadIdx.x; asm volatile("" : "+v"(tid_));
  const int tid = tid_, wid = tid >> 6, lane = tid & 63, r32 = lane & 31, hi = lane >> 5;
  char* V_lds = lds + OFF_V; char* K_lds = lds + OFF_K; char* P_lds = lds + OFF_KP;
  float* ws = (float*)(lds + OFF_WS) + wid * 64; float* li_l = ws; float* al_l = ws + 32;
  float m_reg = -1e30f, l_reg = 0; f32x16 o[4] = {}; bf16x8 qr[4];
  char* Q_lds = lds + OFF_QP; const int qrow = wid * QBLK + r32;
  const bf16_t* Qw = Qb + (long)(wid * QBLK + r32) * LDQ + hi * 8;
#pragma unroll
  for (int d0 = 0; d0 < 4; ++d0) qr[d0] = *reinterpret_cast<const bf16x8*>(Qw + d0 * 16);
#pragma unroll
  for (int d0 = 0; d0 < 8; ++d0) *reinterpret_cast<bf16x8*>(Q_lds + KSWZ(qrow, (d0 * 16 + hi * 8) * 2)) = *reinterpret_cast<const bf16x8*>(Qw + 64 + d0 * 16);
  const int sr = tid >> 4, sc = (tid & 15) * 8, vst0 = v_st(sr, sc), vst1 = v_st(32 + sr, sc);
  const int pr = tid >> 3, pc = (tid & 7) * 8;
  const int vb0 = (int)(uintptr_t)V_lds + v_rd_base(lane);
  struct { bf16x8 vs0, vs1, ks0, ks1, kp; } sr_[SDEPTH];
#define KROW(j) ((j) < 4 ? ka0 + 64 * (j) : kb0 + 64 * ((j) - 4))
#define SLOAD(i, jt) do { const long k0_ = KROW(jt); \
    sr_[i].vs0 = *reinterpret_cast<const bf16x8*>(&KVh[(k0_ + sr) * LDKV + 128 + sc]); sr_[i].vs1 = *reinterpret_cast<const bf16x8*>(&KVh[(k0_ + 32 + sr) * LDKV + 128 + sc]); \
    sr_[i].ks0 = *reinterpret_cast<const bf16x8*>(&KVh[(k0_ + sr) * LDKV + sc]); sr_[i].ks1 = *reinterpret_cast<const bf16x8*>(&KVh[(k0_ + 32 + sr) * LDKV + sc]); \
    sr_[i].kp = *reinterpret_cast<const bf16x8*>(&KPE[(k0_ + pr) * 64 + pc]); } while (0)
#define SWRITE(b, i) do { *(bf16x8*)(V_lds + (b) * SHM_V + vst0) = sr_[i].vs0;          \
    *(bf16x8*)(V_lds + (b) * SHM_V + vst1) = sr_[i].vs1; int kc = sc * 2;               \
    *(bf16x8*)(K_lds + (b) * SHM_K + KSWZ(sr, kc)) = sr_[i].ks0;                       \
    *(bf16x8*)(K_lds + (b) * SHM_K + KSWZ(32 + sr, kc)) = sr_[i].ks1;                  \
    *(bf16x8*)(P_lds + (b) * SHM_KP + KPSWZ(pr, pc * 2)) = sr_[i].kp; } while (0)
#define SWAIT() do { if constexpr (SDEPTH == 2) asm volatile("s_waitcnt vmcnt(5)" ::: "memory"); else asm volatile("s_waitcnt vmcnt(0)" ::: "memory"); } while (0)
#define RESC(a) do { if (__any((a) < 1.f)) { if (hi == 0) al_l[r32] = (a); asm volatile("s_waitcnt lgkmcnt(0)" ::: "memory"); \
    for (int d = 0; d < 4; ++d) for (int r = 0; r < 16; ++r) o[d][r] *= al_l[crow(r, hi)]; } } while (0)
  f32x16 pA0, pA1, pB0, pB1; float mnA, mnB, alA, alB; bf16x8 pa0, pa1, pa2, pa3;
  constexpr int SE = 0, SO = SDEPTH - 1;
  SLOAD(SE, 0); asm volatile("s_waitcnt vmcnt(0)" ::: "memory"); SWRITE(0, SE); __syncthreads();
  qkt(pA0, pA1, K_lds, P_lds, qr, Q_lds, qrow, r32, hi); partialSM(pA0, pA1, m_reg, mnA, alA);
  SLOAD(SO, 1); if constexpr (SDEPTH == 2) { if (2 < NT) SLOAD(SE, 2); }
  SWAIT(); SWRITE(1, SO); __syncthreads();
  for (int j = 1; j + 1 < NT; j += 2) {
    SBAR(); qkt(pB0, pB1, K_lds + SHM_K, P_lds + SHM_KP, qr, Q_lds, qrow, r32, hi);
    finishSM(pA0, pA1, alA, l_reg, pa0, pa1, pa2, pa3); SBAR();
    SLOAD(SO, j + SDEPTH); SBAR();
    pv_d0(o, vb0, pa0, pa1, pa2, pa3); partialSM(pB0, pB1, m_reg, mnB, alB);
    __syncthreads(); SWAIT(); SWRITE(0, SE);
    RESC(alB); __syncthreads();
    SBAR(); qkt(pA0, pA1, K_lds, P_lds, qr, Q_lds, qrow, r32, hi);
    finishSM(pB0, pB1, alB, l_reg, pa0, pa1, pa2, pa3); SBAR();
    if (SDEPTH == 1 || j + 3 < NT) SLOAD(SE, j + 1 + SDEPTH); SBAR();
    pv_d0(o, vb0 + (int)SHM_V, pa0, pa1, pa2, pa3); partialSM(pA0, pA1, m_reg, mnA, alA);
    __syncthreads(); SWAIT(); SWRITE(1, SO);
    RESC(alA); __syncthreads();
  }
  SBAR(); qkt(pB0, pB1, K_lds + SHM_K, P_lds + SHM_KP, qr, Q_lds, qrow, r32, hi);
  finishSM(pA0, pA1, alA, l_reg, pa0, pa1, pa2, pa3); SBAR();
  pv_d0(o, vb0, pa0, pa1, pa2, pa3); partialSM(pB0, pB1, m_reg, mnB, alB);
  __syncthreads(); RESC(alB);
  finishSM(pB0, pB1, alB, l_reg, pa0, pa1, pa2, pa3); SBAR();
  pv_d0(o, vb0 + (int)SHM_V, pa0, pa1, pa2, pa3);
  if (hi == 0) li_l[r32] = l_reg; asm volatile("s_waitcnt lgkmcnt(0)" ::: "memory");
  float rli[16];
#pragma unroll
  for (int r = 0; r < 16; ++r) rli[r] = __builtin_amdgcn_rcpf(li_l[crow(r, hi)]);
  bf16_t* Ow = Ob + (long)(wid * QBLK) * LDO;
#pragma unroll
  for (int r = 0; r < 16; ++r) { int orow = crow(r, hi);
    for (int d0 = 0; d0 < 4; ++d0) Ow[(long)orow * LDO + d0 * 32 + r32] = (bf16_t)f2bf(o[d0][r] * rli[r]); }
  __syncthreads();
#undef KROW
#undef SLOAD
#undef SWRITE
#undef SWAIT
#undef RESC
}
}

__device__ __forceinline__ void phase_attn(Frame& F) {
    const bf16_t* Q = WSP(bf16_t, WS_Q); const bf16_t* KV = WSP(bf16_t, WS_KV); const bf16_t* KPE = WSP(bf16_t, WS_KPE); bf16_t* YA = WSP(bf16_t, WS_Y);
    constexpr int NU = NBATCH * NH_MLA * 32 + NBATCH * NH_MLA;
    for (int u = F.bid; u < NU; u += F.G) {
        int b, h, row0, NT;
        if (u < NBATCH * NH_MLA * 32) { const int bh = u >> 5, qb = u & 31; b = bh >> 3; h = bh & 7; row0 = TC + b * SEQ + qb * 256; NT = 4 + SEQ / 64; }
        else { const int bh = u - NBATCH * NH_MLA * 32; b = bh >> 3; h = bh & 7; row0 = b * CTX; NT = 4; }
        att::attn_unit(Q + (size_t)row0 * 1536 + h * 192, KV + h * 256, KPE, YA + (size_t)row0 * 1024 + h * 128, b * CTX, TC + b * SEQ, NT, (char*)F.lds);
    }
}
__device__ __forceinline__ void phase_qrope(Frame& F) {
    bf16_t* Q = WSP(bf16_t, WS_Q);
    for (int row = TC + F.gw; row < T; row += F.NGW) {
        const int t = (row - TC) & (SEQ - 1); const int p = F.lane & 31, axis = p >> 4, j = p & 15, hs = F.lane >> 5;
        const float pos = (float)(axis == 0 ? (t >> 6) : (t & 63)); const float inv = __builtin_amdgcn_exp2f(-(float)j * 0.8304820237218406f);
        const float sn = __sinf(pos * inv), cs = __cosf(pos * inv);
#pragma unroll
        for (int hh = 0; hh < 4; ++hh) { const int h = hh * 2 + hs; bf16_t* q = Q + (size_t)row * 1536 + h * 192 + 128 + axis * 32 + j;
            const float x1 = bf2f(q[0]), x2 = bf2f(q[16]);
            q[0] = (bf16_t)f2bf(x1 * cs - x2 * sn); q[16] = (bf16_t)f2bf(x2 * cs + x1 * sn); }
    }
}

#define MFMA16(a, b, c) __builtin_amdgcn_mfma_f32_16x16x32_bf16((a), (b), (c), 0, 0, 0)
constexpr int XS_LD = 264, BC_LD = 136;
__device__ __forceinline__ float wave_incl_scan(float v, int lane) {
#pragma unroll
    for (int o = 1; o < 64; o <<= 1) { const float t = __shfl_up(v, o); if (lane >= o) v += t; }
    return v;
}
__device__ __forceinline__ void stage_tile(LAS bf16_t* dst, int ld, const bf16_t* src, int ncols, int tid) {
    const int cpr = ncols >> 3;
    for (int i = tid; i < 128 * cpr; i += NTHREADS) { const int r = i / cpr, c8 = (i % cpr) * 8; *(LAS u32x4*)(dst + r * ld + c8) = *(const u32x4*)(src + (size_t)r * P2W + c8); }
}
__device__ __forceinline__ void phase_mamba_states(Frame& F, const Args& a, int layer) {
    const bf16_t* P2 = WSP(bf16_t, WS_P2); const float* DT = WSP(float, WS_DT); bf16_t* MST = WSP(bf16_t, WS_MST); float* MCS = WSP(float, WS_MCS);
    LAS bf16_t* XSl = (LAS bf16_t*)F.lds; LAS bf16_t* Bl = (LAS bf16_t*)(F.lds + 67584); LAS float* wt = (LAS float*)(F.lds + 102400) + F.wave * 128;
    const int lane = F.lane, row = lane & 15, quad = lane >> 4;
    for (int u = F.bid; u < NCHUNK * 4; u += F.G) {
        const int chunk = u >> 2, g = (u >> 1) & 1, half = u & 1, row0 = chunk * 128;
        __syncthreads();
        stage_tile(XSl, XS_LD, P2 + (size_t)row0 * P2W + P2_XBC + (g * 8 + half * 4) * 64, 256, F.tid);
        stage_tile(Bl, BC_LD, P2 + (size_t)row0 * P2W + P2_XBC + 1024 + g * 128, 128, F.tid);
        const int hl = F.wave >> 1, d = F.wave & 1, h = g * 8 + half * 4 + hl;
        const float aa = -__expf(arg_in(a, I_SALOG)[(layer * 2 + d) * 16 + h]);
        { const float dt0 = DT[(size_t)(row0 + lane) * 32 + d * 16 + h], dt1 = DT[(size_t)(row0 + 64 + lane) * 32 + d * 16 + h];
          const float da0 = dt0 * aa, da1 = dt1 * aa;
          float c0 = wave_incl_scan(da0, lane); const float tot0 = __shfl(c0, 63); float c1 = wave_incl_scan(da1, lane) + tot0; const float tot = __shfl(c1, 63);
          if (d == 0) { wt[lane] = dt0 * __expf(tot - c0); wt[64 + lane] = dt1 * __expf(tot - c1); }
          else { wt[lane] = dt0 * __expf(c0 - da0); wt[64 + lane] = dt1 * __expf(c1 - da1); }
          if (lane == 0) MCS[(d * NCHUNK + chunk) * 16 + h] = tot; }
        __syncthreads();
        bf16_t* out = MST + ((size_t)(d * NCHUNK + chunk) * 16 + h) * 8192;
#pragma unroll 1
        for (int nh = 0; nh < 2; ++nh) {
            f32x4 acc[4][4];
#pragma unroll
            for (int i = 0; i < 4; ++i)
#pragma unroll
                for (int j = 0; j < 4; ++j) acc[i][j] = (f32x4){0.f, 0.f, 0.f, 0.f};
#pragma unroll 1
            for (int k0 = 0; k0 < 128; k0 += 32) {
                const int sb = k0 + quad * 8;
                float w8[8];
#pragma unroll
                for (int j = 0; j < 8; ++j) w8[j] = wt[sb + j];
                bf16x8 bf[4];
#pragma unroll
                for (int nt = 0; nt < 4; ++nt) {
#pragma unroll
                    for (int j = 0; j < 8; ++j) bf[nt][j] = (short)Bl[(sb + j) * BC_LD + (nh * 4 + nt) * 16 + row]; }
#pragma unroll
                for (int pt = 0; pt < 4; ++pt) { bf16x8 af;
#pragma unroll
                    for (int j = 0; j < 8; ++j) af[j] = (short)f2bf(w8[j] * bf2f(XSl[(sb + j) * XS_LD + hl * 64 + pt * 16 + row]));
#pragma unroll
                    for (int nt = 0; nt < 4; ++nt) acc[pt][nt] = MFMA16(af, bf[nt], acc[pt][nt]); }
            }
#pragma unroll
            for (int pt = 0; pt < 4; ++pt)
#pragma unroll
                for (int nt = 0; nt < 4; ++nt)
#pragma unroll
                    for (int jj = 0; jj < 4; ++jj) out[(pt * 16 + quad * 4 + jj) * 128 + (nh * 4 + nt) * 16 + row] = (bf16_t)f2bf(acc[pt][nt][jj]);
        }
    }
}
__device__ __forceinline__ void phase_mamba_scan(Frame& F) {
    bf16_t* MST = WSP(bf16_t, WS_MST); const float* MCS = WSP(float, WS_MCS);
    for (int idx = F.bid * NTHREADS + F.tid; idx < 2 * 2 * 16 * 8192; idx += F.G * NTHREADS) {
        const int e = idx & 8191, h = (idx >> 13) & 15, b = (idx >> 17) & 1, d = idx >> 18;
        float state = 0.f;
#pragma unroll 6
        for (int i = 0; i < 66; ++i) {
            int chunk; if (i < 2) chunk = 2 * b + (d == 0 ? i : 1 - i); else chunk = 4 + 64 * b + (d == 0 ? i - 2 : 65 - i);
            bf16_t* p = MST + ((size_t)(d * NCHUNK + chunk) * 16 + h) * 8192 + e;
            const float cs = bf2f(*p); const float dec = __expf(MCS[(d * NCHUNK + chunk) * 16 + h]);
            *p = (bf16_t)f2bf(state);
            state = state * dec + cs;
        }
    }
}
__device__ __forceinline__ void phase_mamba_out(Frame& F, const Args& a, int layer) {
    const bf16_t* P = WSP(bf16_t, WS_P); const bf16_t* P2 = WSP(bf16_t, WS_P2); const float* DT = WSP(float, WS_DT); const bf16_t* MST = WSP(bf16_t, WS_MST);
    bf16_t* YB = WSP(bf16_t, WS_Y) + (size_t)1 * T * 1024;
    LAS bf16_t* Cl = (LAS bf16_t*)F.lds; LAS bf16_t* Bl = (LAS bf16_t*)(F.lds + 34816); LAS bf16_t* XSl = (LAS bf16_t*)(F.lds + 69632);
    LAS float* tab = (LAS float*)(F.lds + 137216);
    const int lane = F.lane, row = lane & 15, quad = lane >> 4;
    for (int u = F.bid; u < NCHUNK * 4; u += F.G) {
        const int chunk = u >> 2, g = (u >> 1) & 1, half = u & 1, row0 = chunk * 128;
        __syncthreads();
        stage_tile(XSl, XS_LD, P2 + (size_t)row0 * P2W + P2_XBC + (g * 8 + half * 4) * 64, 256, F.tid);
        stage_tile(Bl, BC_LD, P2 + (size_t)row0 * P2W + P2_XBC + 1024 + g * 128, 128, F.tid);
        stage_tile(Cl, BC_LD, P2 + (size_t)row0 * P2W + P2_XBC + 1280 + g * 128, 128, F.tid);
        float tot1 = 0.f;
        { const int hl = F.wave >> 1, d = F.wave & 1, h = g * 8 + half * 4 + hl;
          const float aa = -__expf(arg_in(a, I_SALOG)[(layer * 2 + d) * 16 + h]);
          const float dt0 = DT[(size_t)(row0 + lane) * 32 + d * 16 + h], dt1 = DT[(size_t)(row0 + 64 + lane) * 32 + d * 16 + h];
          const float da0 = dt0 * aa, da1 = dt1 * aa;
          float c0 = wave_incl_scan(da0, lane); const float t0 = __shfl(c0, 63); float c1 = wave_incl_scan(da1, lane) + t0;
          LAS float* tb = tab + hl * 512;
          if (d == 0) { tb[lane] = c0; tb[64 + lane] = c1; tb[256 + lane] = __logf(dt0) - c0; tb[320 + lane] = __logf(dt1) - c1; }
          else { tb[128 + lane] = c0 - da0; tb[192 + lane] = c1 - da1; tb[384 + lane] = (c0 - da0) + __logf(dt0); tb[448 + lane] = (c1 - da1) + __logf(dt1); if (lane == 63) tab[2048 + hl] = c1; } }
        __syncthreads();
        { f32x4 cb[8];
#pragma unroll
          for (int st = 0; st < 8; ++st) cb[st] = (f32x4){0.f, 0.f, 0.f, 0.f};
#pragma unroll
          for (int k0 = 0; k0 < 128; k0 += 32) { const bf16x8 af = *(const LAS bf16x8*)(Cl + (F.wave * 16 + row) * BC_LD + k0 + quad * 8);
#pragma unroll
              for (int st = 0; st < 8; ++st) { const bf16x8 bfr = *(const LAS bf16x8*)(Bl + (st * 16 + row) * BC_LD + k0 + quad * 8); cb[st] = MFMA16(af, bfr, cb[st]); } }
          __syncthreads();
#pragma unroll
          for (int st = 0; st < 8; ++st)
#pragma unroll
              for (int jj = 0; jj < 4; ++jj) Bl[(F.wave * 16 + quad * 4 + jj) * BC_LD + st * 16 + row] = (bf16_t)f2bf(cb[st][jj]); }
        __syncthreads();
        const int hl = F.wave >> 1, th = F.wave & 1, h = g * 8 + half * 4 + hl;
        const LAS float* tb = tab + hl * 512; tot1 = tab[2048 + hl];
        f32x4 acc[4][4];
#pragma unroll
        for (int i = 0; i < 4; ++i)
#pragma unroll
            for (int j = 0; j < 4; ++j) acc[i][j] = (f32x4){0.f, 0.f, 0.f, 0.f};
#pragma unroll 1
        for (int k0 = 0; k0 < 128; k0 += 32) {
            const int sb = k0 + quad * 8;
            float u0s[8], u1s[8];
#pragma unroll
            for (int j = 0; j < 8; ++j) { u0s[j] = tb[256 + sb + j]; u1s[j] = tb[384 + sb + j]; }
            bf16x8 bx[4];
#pragma unroll
            for (int pt = 0; pt < 4; ++pt) {
#pragma unroll
                for (int j = 0; j < 8; ++j) bx[pt][j] = (short)XSl[(sb + j) * XS_LD + hl * 64 + pt * 16 + row]; }
#pragma unroll
            for (int tt = 0; tt < 4; ++tt) { const int t = th * 64 + tt * 16 + row; const float c0t = tb[t], e1t = tb[128 + t];
                float cbv[8]; { const u32x4 w = *(const LAS u32x4*)(Bl + t * BC_LD + sb); cbv[0] = bflo(w.x); cbv[1] = bfhi(w.x); cbv[2] = bflo(w.y); cbv[3] = bfhi(w.y); cbv[4] = bflo(w.z); cbv[5] = bfhi(w.z); cbv[6] = bflo(w.w); cbv[7] = bfhi(w.w); }
                bf16x8 af;
#pragma unroll
                for (int j = 0; j < 8; ++j) { const int s = sb + j;
                    const float f0 = s <= t ? __expf(c0t + u0s[j]) : 0.f;
                    const float f1 = s >= t ? __expf(u1s[j] - e1t) : 0.f;
                    af[j] = (short)f2bf(cbv[j] * (f0 + f1)); }
#pragma unroll
                for (int pt = 0; pt < 4; ++pt) acc[tt][pt] = MFMA16(af, bx[pt], acc[tt][pt]); }
        }
#pragma unroll 1
        for (int d = 0; d < 2; ++d) {
            const bf16_t* S = MST + ((size_t)(d * NCHUNK + chunk) * 16 + h) * 8192;
#pragma unroll 1
            for (int k0 = 0; k0 < 128; k0 += 32) {
                bf16x8 bs[4];
#pragma unroll
                for (int pt = 0; pt < 4; ++pt) bs[pt] = *(const bf16x8*)(S + (pt * 16 + row) * 128 + k0 + quad * 8);
#pragma unroll
                for (int tt = 0; tt < 4; ++tt) { const int t = th * 64 + tt * 16 + row;
                    const float sc = d == 0 ? __expf(tb[t]) : __expf(tot1 - tb[128 + t]);
                    const u32x4 cw = *(const LAS u32x4*)(Cl + t * BC_LD + k0 + quad * 8);
                    u32x4 aw; aw.x = cvt_pk_bf16(bflo(cw.x) * sc, bfhi(cw.x) * sc); aw.y = cvt_pk_bf16(bflo(cw.y) * sc, bfhi(cw.y) * sc);
                    aw.z = cvt_pk_bf16(bflo(cw.z) * sc, bfhi(cw.z) * sc); aw.w = cvt_pk_bf16(bflo(cw.w) * sc, bfhi(cw.w) * sc);
                    const bf16x8 af = __builtin_bit_cast(bf16x8, aw);
#pragma unroll
                    for (int pt = 0; pt < 4; ++pt) acc[tt][pt] = MFMA16(af, bs[pt], acc[tt][pt]); } }
        }
        const float Dh = arg_in(a, I_SD)[layer * 16 + h];
#pragma unroll
        for (int tt = 0; tt < 4; ++tt)
#pragma unroll
            for (int jj = 0; jj < 4; ++jj) { const int t = th * 64 + tt * 16 + quad * 4 + jj; const size_t r = (size_t)(row0 + t);
#pragma unroll
                for (int pt = 0; pt < 4; ++pt) { const int p = pt * 16 + row;
                    const float xs = bf2f(XSl[t * XS_LD + hl * 64 + p]); const float z = bf2f(P[r * NNG + P_Z + h * 64 + p]);
                    YB[r * 1024 + h * 64 + p] = (bf16_t)f2bf((acc[tt][pt][jj] + xs * Dh) * siluf_(z)); } }
    }
}
__device__ __forceinline__ void phase_mamba_norm(Frame& F, const Args& a, int layer) {
    bf16_t* YB = WSP(bf16_t, WS_Y) + (size_t)1 * T * 1024; const float* nw = arg_in(a, I_SNORM) + layer * 1024;
    for (int row = F.gw; row < T; row += F.NGW) {
        bf16_t* p = YB + (size_t)row * 1024 + F.lane * 16; float x[16]; { float t0[8], t1[8]; ld8bf(p, t0); ld8bf(p + 8, t1);
#pragma unroll
            for (int i = 0; i < 8; ++i) { x[i] = t0[i]; x[8 + i] = t1[i]; } }
        float s = 0.f;
#pragma unroll
        for (int i = 0; i < 16; ++i) s += x[i] * x[i];
        s = sum32(s);
        const float r = 1.f / sqrtf(s * (1.f / 512.f) + 1e-5f);
        float o0[8], o1[8];
#pragma unroll
        for (int i = 0; i < 8; ++i) { o0[i] = x[i] * r * nw[F.lane * 16 + i]; o1[i] = x[8 + i] * r * nw[F.lane * 16 + 8 + i]; }
        st8bf(p, o0); st8bf(p + 8, o1);
    }
}

__device__ __forceinline__ float dpp_f(float x, const int ctrl_sel) {
    const int xi = __builtin_bit_cast(int, x); int r;
    if (ctrl_sel == 0) r = __builtin_amdgcn_update_dpp(0, xi, 0xB1, 0xF, 0xF, false);
    else if (ctrl_sel == 1) r = __builtin_amdgcn_update_dpp(0, xi, 0x4E, 0xF, 0xF, false);
    else r = __builtin_amdgcn_update_dpp(0, xi, 0x141, 0xF, 0xF, false);
    return __builtin_bit_cast(float, r);
}
__device__ __forceinline__ float red8(float x) { x += dpp_f(x, 0); x += dpp_f(x, 1); x += dpp_f(x, 2); return x; }
__device__ __forceinline__ int rw_row(int pos, int b, int d) { return pos < CTX ? b * CTX + (d == 0 ? pos : CTX - 1 - pos) : TC + b * SEQ + (d == 0 ? pos - CTX : SEQ - 1 - (pos - CTX)); }
constexpr int RW_STEP_F = 336, RW_CH = 32, RW_CHF = RW_STEP_F * RW_CH;
__device__ __forceinline__ void phase_rwkv_scan(Frame& F, const Args& a, int layer) {
    const bf16_t* P2 = WSP(bf16_t, WS_P2); const bf16_t* EW = WSP(bf16_t, WS_EW); const bf16_t* ICLR = WSP(bf16_t, WS_ICLR); const bf16_t* KK = WSP(bf16_t, WS_KK);
    bf16_t* YRW = WSP(bf16_t, WS_YRW);
    LAS float* ring = (LAS float*)F.lds; LAS float* ybuf = (LAS float*)(F.lds + 2 * RW_CHF * 4);
    const int lane = F.lane;
    for (int u = F.bid; u < 256; u += F.G) {
        const int chain = u >> 2, rq = u & 3, d = chain >> 5, b = (chain >> 4) & 1, h = chain & 15;
        const float ka = arg_in(a, I_RKA)[layer * 1024 + h * 64 + lane];
        constexpr int NCH = (CTX + SEQ) / RW_CH;
        auto load_chunk = [&](int cidx) {
            LAS float* dst = ring + (cidx & 1) * RW_CHF;
            for (int tok = F.wave - 2; tok < RW_CH; tok += 6) { const int row = rw_row(cidx * RW_CH + tok, b, d); const size_t o = (size_t)row * 1024 + h * 64 + lane;
                const float ew = bf2f(EW[(size_t)d * T * 1024 + o]), ic = bf2f(ICLR[(size_t)d * T * 1024 + o]), kkv = bf2f(KK[o]);
                const bf16_t* p2 = P2 + (size_t)row * P2W + P2_RKV + h * 64; const float rr = bf2f(p2[lane]), kr = bf2f(p2[1024 + lane]);
                LAS float* s = dst + tok * RW_STEP_F;
                s[lane] = __expf(-ew); s[64 + lane] = kr * (1.f + (ic - 1.f) * ka); s[128 + lane] = kkv * ic; s[192 + lane] = -kkv; s[256 + lane] = rr;
                if (lane < 16) s[320 + lane] = bf2f(p2[2048 + rq * 16 + lane]); } };
        auto flush_chunk = [&](int cidx) {
            const LAS float* yb = ybuf + (cidx & 1) * (RW_CH * 16);
            for (int i = F.tid - 128; i < RW_CH * 16; i += 384) { const int tok = i >> 4, rr = i & 15; const int row = rw_row(cidx * RW_CH + tok, b, d);
                YRW[((size_t)d * T + row) * 1024 + h * 64 + rq * 16 + rr] = (bf16_t)f2bf(yb[i]); } };
        __syncthreads();
        if (F.wave >= 2) load_chunk(0);
        __syncthreads();
        float s[8] = {0.f, 0.f, 0.f, 0.f, 0.f, 0.f, 0.f, 0.f};
        const int rloc = lane >> 3, kq = lane & 7;
        for (int c = 0; c < NCH; ++c) {
            if (F.wave >= 2) { if (c + 1 < NCH) load_chunk(c + 1); if (c > 0) flush_chunk(c - 1); }
            else {
                const LAS float* base = ring + (c & 1) * RW_CHF + kq * 8; LAS float* yb = ybuf + (c & 1) * (RW_CH * 16) + F.wave * 8 + rloc;
#pragma unroll 4
                for (int t = 0; t < RW_CH; ++t) { const LAS float* sp = base + t * RW_STEP_F;
                    const f32x4 w0 = *(const LAS f32x4*)(sp), w1 = *(const LAS f32x4*)(sp + 4), k0 = *(const LAS f32x4*)(sp + 64), k1 = *(const LAS f32x4*)(sp + 68);
                    const f32x4 b0 = *(const LAS f32x4*)(sp + 128), b1 = *(const LAS f32x4*)(sp + 132), a0 = *(const LAS f32x4*)(sp + 192), a1 = *(const LAS f32x4*)(sp + 196);
                    const f32x4 r0 = *(const LAS f32x4*)(sp + 256), r1 = *(const LAS f32x4*)(sp + 260);
                    const float v1 = ring[(c & 1) * RW_CHF + t * RW_STEP_F + 320 + F.wave * 8 + rloc];
                    float sa = (s[0] * a0.x + s[1] * a0.y) + (s[2] * a0.z + s[3] * a0.w) + (s[4] * a1.x + s[5] * a1.y) + (s[6] * a1.z + s[7] * a1.w);
                    sa = red8(sa);
                    s[0] = s[0] * w0.x + sa * b0.x + v1 * k0.x; s[1] = s[1] * w0.y + sa * b0.y + v1 * k0.y; s[2] = s[2] * w0.z + sa * b0.z + v1 * k0.z; s[3] = s[3] * w0.w + sa * b0.w + v1 * k0.w;
                    s[4] = s[4] * w1.x + sa * b1.x + v1 * k1.x; s[5] = s[5] * w1.y + sa * b1.y + v1 * k1.y; s[6] = s[6] * w1.z + sa * b1.z + v1 * k1.z; s[7] = s[7] * w1.w + sa * b1.w + v1 * k1.w;
                    float y = (s[0] * r0.x + s[1] * r0.y) + (s[2] * r0.z + s[3] * r0.w) + (s[4] * r1.x + s[5] * r1.y) + (s[6] * r1.z + s[7] * r1.w);
                    y = red8(y);
                    if (kq == 0) yb[t * 16] = y; }
            }
            __syncthreads();
        }
        if (F.wave >= 2) flush_chunk(NCH - 1);
    }
}
__device__ __forceinline__ void phase_rwkv_out(Frame& F, const Args& a, int layer) {
    const bf16_t* P2 = WSP(bf16_t, WS_P2); const bf16_t* ICLR = WSP(bf16_t, WS_ICLR); const bf16_t* YRW = WSP(bf16_t, WS_YRW); const bf16_t* GG = WSP(bf16_t, WS_GG);
    bf16_t* YD = WSP(bf16_t, WS_Y) + (size_t)3 * T * 1024;
    const float* lng = arg_in(a, I_RLNG) + layer * 1024; const float* lnb = arg_in(a, I_RLNB) + layer * 1024; const float* rk = arg_in(a, I_RRK) + layer * 1024; const float* kav = arg_in(a, I_RKA) + layer * 1024;
    for (int row = F.gw; row < T; row += F.NGW) {
        const int c = F.lane * 16; const size_t o = (size_t)row * 1024 + c;
        float y[16], r[16], k[16], v[16], i0[16], i1[16], g[16];
#define LD16(dst, ptr) do { float t0_[8], t1_[8]; ld8bf((ptr), t0_); ld8bf((ptr) + 8, t1_); _Pragma("unroll") for (int i_ = 0; i_ < 8; ++i_) { dst[i_] = t0_[i_]; dst[8 + i_] = t1_[i_]; } } while (0)
        LD16(y, YRW + o); LD16(r, YRW + (size_t)T * 1024 + o);
#pragma unroll
        for (int i = 0; i < 16; ++i) y[i] += r[i];
        const bf16_t* p2 = P2 + (size_t)row * P2W + P2_RKV + c;
        LD16(r, p2); LD16(k, p2 + 1024); LD16(v, p2 + 2048); LD16(i0, ICLR + o); LD16(i1, ICLR + (size_t)T * 1024 + o); LD16(g, GG + o);
#undef LD16
        float s = 0.f, bsum = 0.f;
#pragma unroll
        for (int i = 0; i < 16; ++i) { s += y[i]; const float ka = kav[c + i]; bsum += r[i] * k[i] * rk[c + i] * ((1.f + (i0[i] - 1.f) * ka) + (1.f + (i1[i] - 1.f) * ka)); }
        s = sum4(s); bsum = sum4(bsum);
        const float mu = s * (1.f / 64.f); float q = 0.f;
#pragma unroll
        for (int i = 0; i < 16; ++i) { const float dd = y[i] - mu; q += dd * dd; }
        q = sum4(q);
        const float rstd = 1.f / sqrtf(q * (1.f / 64.f) + 64e-5f);
        float o0[8], o1[8];
#pragma unroll
        for (int i = 0; i < 8; ++i) { o0[i] = ((y[i] - mu) * rstd * lng[c + i] + lnb[c + i] + bsum * v[i]) * g[i];
            o1[i] = ((y[8 + i] - mu) * rstd * lng[c + 8 + i] + lnb[c + 8 + i] + bsum * v[8 + i]) * g[8 + i]; }
        st8bf(YD + o, o0); st8bf(YD + o + 8, o1);
    }
}

constexpr int FFT_N = 16384;
__device__ __forceinline__ int fswz(int i) { return i ^ (((i >> 5) & 3) << 2) ^ (((i >> 6) & 1) << 4); }
__device__ __forceinline__ f32x2 cmul(f32x2 a, f32x2 b) { return (f32x2){a.x * b.x - a.y * b.y, a.x * b.y + a.y * b.x}; }
template <bool INV>
__device__ __forceinline__ void fft_passes(LAS f32x2* X, int tid) {
#pragma unroll 1
    for (int st = 0; st < 7; ++st) {
        const int lq = INV ? 2 * st : 12 - 2 * st;
        const int q = 1 << lq;
        __syncthreads();
#pragma unroll 2
        for (int mm = 0; mm < 8; ++mm) { const int uu = tid + 512 * mm; const int k = uu & (q - 1), blk = uu >> lq; const int i0 = (blk << (lq + 2)) + k;
            const int p0 = fswz(i0), p1 = fswz(i0 + q), p2 = fswz(i0 + 2 * q), p3 = fswz(i0 + 3 * q);
            f32x2 a0 = X[p0], a1 = X[p1], a2 = X[p2], a3 = X[p3];
            const float fr = (float)k / (float)(4 * q);
            const float cs = __builtin_amdgcn_cosf(fr), sn = __builtin_amdgcn_sinf(fr);
            const f32x2 w1 = INV ? (f32x2){cs, sn} : (f32x2){cs, -sn}; const f32x2 w2 = cmul(w1, w1), w3 = cmul(w2, w1);
            if (!INV) {
                const f32x2 t0 = a0 + a2, t1 = a0 - a2, t2 = a1 + a3, t3 = a1 - a3;
                const f32x2 b0 = t0 + t2, b2 = t0 - t2, b1 = (f32x2){t1.x + t3.y, t1.y - t3.x}, b3 = (f32x2){t1.x - t3.y, t1.y + t3.x};
                X[p0] = b0; X[p1] = cmul(b1, w1); X[p2] = cmul(b2, w2); X[p3] = cmul(b3, w3);
            } else {
                a1 = cmul(a1, w1); a2 = cmul(a2, w2); a3 = cmul(a3, w3);
                const f32x2 u0 = a0 + a2, u1 = a0 - a2, u2 = a1 + a3, u3 = a1 - a3;
                X[p0] = u0 + u2; X[p2] = u0 - u2; X[p1] = (f32x2){u1.x - u3.y, u1.y + u3.x}; X[p3] = (f32x2){u1.x + u3.y, u1.y - u3.x};
            } }
    }
    __syncthreads();
}
__device__ __forceinline__ void phase_hyena_fft(Frame& F, const Args& a, int layer) {
    const bf16_t* FILT = WSP(bf16_t, WS_FILT); float* VT = WSP(float, WS_VT); const float* hyd = arg_in(a, I_HD) + layer * 1024;
    LAS f32x2* X = (LAS f32x2*)F.lds;
    for (int c = F.bid; c < 1024; c += F.G) {
        __syncthreads();
        const bf16_t* hf = FILT + (size_t)c * 2 * SEQ; const bf16_t* hb = hf + SEQ;
        for (int i = F.tid; i < FFT_N; i += NTHREADS) { float v; if (i < SEQ) v = bf2f(hf[i]); else if (i == SEQ) v = 0.f; else v = bf2f(hb[FFT_N - i]); X[fswz(i)] = (f32x2){v, 0.f}; }
        fft_passes<false>(X, F.tid);
        f32x2 Kh[32];
#pragma unroll
        for (int j = 0; j < 32; ++j) Kh[j] = X[fswz(F.tid + 512 * j)];
        __syncthreads();
        const float* v0 = VT + (size_t)c * 2 * SEQ; const float* v1 = v0 + SEQ;
        for (int i = F.tid; i < FFT_N; i += NTHREADS) X[fswz(i)] = i < SEQ ? (f32x2){v0[i], v1[i]} : (f32x2){0.f, 0.f};
        fft_passes<false>(X, F.tid);
#pragma unroll
        for (int j = 0; j < 32; ++j) { const int p = fswz(F.tid + 512 * j); X[p] = cmul(X[p], Kh[j]); }
        fft_passes<true>(X, F.tid);
        const float dc = hyd[c]; float* o0 = VT + (size_t)c * 2 * SEQ; float* o1 = o0 + SEQ;
        for (int i = F.tid; i < SEQ; i += NTHREADS) { const f32x2 r = X[fswz(i)]; const float x0 = o0[i], x1 = o1[i];
            o0[i] = r.x * (1.f / FFT_N) + x0 * dc; o1[i] = r.y * (1.f / FFT_N) + x1 * dc; }
    }
}
__device__ __forceinline__ void phase_hyena_out(Frame& F, const Args& a, int layer) {
    const float* VT = WSP(float, WS_VT); const bf16_t* P2 = WSP(bf16_t, WS_P2); bf16_t* YC = WSP(bf16_t, WS_Y) + (size_t)2 * T * 1024;
    LAS float* tl = (LAS float*)F.lds;
    for (int u = F.bid; u < (TL / 64) * 4; u += F.G) {
        const int tb = u >> 2, cb = u & 3; const int row0 = TC + tb * 64; const int b = (row0 - TC) >> 13, t0 = (row0 - TC) & (SEQ - 1);
        __syncthreads();
        for (int p = 0; p < 8; ++p) { const int cl = p * 32 + (F.tid >> 4), q = F.tid & 15;
            const f32x4 v = *(const f32x4*)(VT + ((size_t)(cb * 256 + cl) * 2 + b) * SEQ + t0 + 4 * q);
            tl[cl * 65 + 4 * q] = v.x; tl[cl * 65 + 4 * q + 1] = v.y; tl[cl * 65 + 4 * q + 2] = v.z; tl[cl * 65 + 4 * q + 3] = v.w; }
        __syncthreads();
        const int cl = F.tid & 255, th = F.tid >> 8;
        for (int i = 0; i < 32; ++i) { const int tl_ = th * 32 + i; const size_t row = (size_t)(row0 + tl_);
            const float x0 = bf2f(P2[row * P2W + P2_X0 + cb * 256 + cl]);
            YC[row * 1024 + cb * 256 + cl] = (bf16_t)f2bf(tl[cl * 65 + tl_] * x0); }
    }
    const float* VC = WSP(float, WS_VC); const float* FC = WSP(float, WS_FILTC); const float* hyd = arg_in(a, I_HD) + layer * 1024;
    for (int e = F.bid * NTHREADS + F.tid; e < TC * 1024; e += F.G * NTHREADS) {
        const int row = e >> 10, c = e & 1023, b = row >> 8, t = row & 255; const float* vb = VC + (size_t)b * CTX * 1024 + c; float acc = 0.f;
        for (int s = 0; s <= t; ++s) acc += FC[(size_t)(t - s) * 2048 + c] * vb[(size_t)s * 1024];
        for (int s = t + 1; s < CTX; ++s) acc += FC[(size_t)(s - t) * 2048 + 1024 + c] * vb[(size_t)s * 1024];
        const float x0 = bf2f(P2[(size_t)row * P2W + P2_X0 + c]);
        YC[(size_t)row * 1024 + c] = (bf16_t)f2bf((acc + vb[(size_t)t * 1024] * hyd[c]) * x0);
    }
}

__device__ __forceinline__ void phase_ln1(Frame& F, const Args& a, int layer) {
    const float* mod = (const float*)(F.ws + WS_CTL) + CW_MOD + (size_t)layer * 3 * 6 * DM;
    const float* YM = WSP(float, WS_YMIX); float* XS = WSP(float, WS_XS); bf16_t* H2 = WSP(bf16_t, WS_H2); float* AFF = WSP(float, WS_AFF); int* INV = WSP(int, WS_INV);
    const float* g1w = arg_in(a, I_LN1G) + layer * DM; const float* b1w = arg_in(a, I_LN1B) + layer * DM; const float* wr = arg_in(a, I_WROUTER) + (size_t)layer * DM * NEXP;
    LAS float* wrT = (LAS float*)F.lds;
    __syncthreads();
    for (int i = F.tid; i < DM * NEXP; i += NTHREADS) { const int c = i >> 4, e = i & 15; wrT[e * DM + c] = wr[i]; }
    __syncthreads();
    int* PTOK = WSP(int, WS_PTOK); float* PG = WSP(float, WS_PGATE);
    for (int i = F.bid * NTHREADS + F.tid; i < NPAIR; i += F.G * NTHREADS) { PTOK[i] = -1; PG[i] = 0.f; }
    for (int row = F.gw; row < T; row += F.NGW) {
        const f32x4* xr = (const f32x4*)x_src_row(a, F, layer, row) + F.lane; const f32x4* yr = (const f32x4*)(YM + (size_t)row * DM) + F.lane;
        const float* m = mod + (size_t)row_modidx(row) * 6 * DM;
        f32x4 v[8];
#pragma unroll
        for (int j = 0; j < 8; ++j) { const int c = 4 * (64 * j + F.lane); v[j] = xr[64 * j] * ALPHA + *(const f32x4*)(m + 2 * DM + c) * yr[64 * j]; }
        float mean, rstd; row_stats(v, mean, rstd, 1e-6f);
        f32x4* xo = (f32x4*)(XS + (size_t)row * DM) + F.lane;
#pragma unroll
        for (int j = 0; j < 8; ++j) { const int c = 4 * (64 * j + F.lane); v[j] = (v[j] - mean) * rstd * *(const f32x4*)(g1w + c) + *(const f32x4*)(b1w + c); xo[64 * j] = v[j]; }
        row_stats(v, mean, rstd, 1e-6f);
        u32x2* ho = (u32x2*)(H2 + (size_t)row * DM) + F.lane;
        float lg[16];
#pragma unroll
        for (int e = 0; e < 16; ++e) lg[e] = 0.f;
#pragma unroll
        for (int j = 0; j < 8; ++j) { const int c = 4 * (64 * j + F.lane);
            const f32x4 y = (v[j] - mean) * rstd * (*(const f32x4*)(m + 4 * DM + c) + 1.f) + *(const f32x4*)(m + 3 * DM + c);
            u32x2 w; w.x = pk2(y.x, y.y); w.y = pk2(y.z, y.w); ho[64 * j] = w;
#pragma unroll
            for (int e = 0; e < 16; ++e) { const f32x4 ww = *(const LAS f32x4*)(wrT + e * DM + c); lg[e] += (y.x * ww.x + y.y * ww.y) + (y.z * ww.z + y.w * ww.w); } }
        float mx = -1e30f;
#pragma unroll
        for (int e = 0; e < 16; ++e) { lg[e] = wave_sum(lg[e]); mx = fmaxf(mx, lg[e]); }
        float den = 0.f;
#pragma unroll
        for (int e = 0; e < 16; ++e) { lg[e] = __expf(lg[e] - mx); den += lg[e]; }
        float mine = 0.f;
#pragma unroll
        for (int e = 0; e < 16; ++e) mine = (F.lane == e) ? lg[e] : mine;
        if (F.lane < 16) { AFF[(size_t)row * 16 + F.lane] = mine / den; INV[(size_t)row * 16 + F.lane] = -1; }
    }
}
__device__ __forceinline__ void phase_topk(Frame& F) {
    const float* AFF = WSP(float, WS_AFF); int* INV = WSP(int, WS_INV); int* PTOK = WSP(int, WS_PTOK); float* PG = WSP(float, WS_PGATE);
    LAS unsigned* vals = (LAS unsigned*)F.lds; LAS unsigned* hist = vals + 8192; LAS unsigned* ctl = hist + 256;
    for (int u = F.bid; u < 64; u += F.G) {
        const int s = u >> 4, e = u & 15, rs = seg_start(s), n = seg_len(s), cap = s < 2 ? CAP_C : CAP_L;
        __syncthreads();
        for (int i = F.tid; i < n; i += NTHREADS) vals[i] = __builtin_bit_cast(unsigned, AFF[(size_t)(rs + i) * 16 + e]);
        if (F.tid == 0) { ctl[0] = 0u; ctl[1] = (unsigned)cap; ctl[2] = 0u; ctl[3] = 0u; }
        unsigned mask = 0u;
        for (int shift = 24; shift >= 0; shift -= 8) {
            if (F.tid < 256) hist[F.tid] = 0u;
            __syncthreads();
            const unsigned prefix = ctl[0];
            for (int i = F.tid; i < n; i += NTHREADS) { const unsigned b = vals[i]; if ((b & mask) == prefix) __hip_atomic_fetch_add(&hist[(b >> shift) & 255u], 1u, __ATOMIC_RELAXED, __HIP_MEMORY_SCOPE_WORKGROUP); }
            __syncthreads();
            if (F.tid == 0) { unsigned rem = ctl[1], cum = 0u; int dg = 255; for (; dg > 0; --dg) { const unsigned hc = hist[dg]; if (cum + hc >= rem) break; cum += hc; }
                ctl[1] = rem - cum; ctl[0] = prefix | ((unsigned)dg << shift); }
            mask |= 255u << shift;
            __syncthreads();
        }
        const unsigned thr = ctl[0], rem = ctl[1]; const unsigned ngt = (unsigned)cap - rem;
        const int pbase = s < 2 ? NBATCH * NEXP * CAP_L + e * 256 + s * CAP_C : ((s - 2) * NEXP + e) * CAP_L;
        for (int i = F.tid; i < n; i += NTHREADS) { const unsigned b = vals[i]; int slot = -1;
            if (b > thr) slot = (int)__hip_atomic_fetch_add(&ctl[2], 1u, __ATOMIC_RELAXED, __HIP_MEMORY_SCOPE_WORKGROUP);
            else if (b == thr) { const unsigned q = __hip_atomic_fetch_add(&ctl[3], 1u, __ATOMIC_RELAXED, __HIP_MEMORY_SCOPE_WORKGROUP); if (q < rem) slot = (int)(ngt + q); }
            if (slot >= 0) { const int pair = pbase + slot, row = rs + i; PTOK[pair] = row; PG[pair] = __builtin_bit_cast(float, b); INV[(size_t)row * 16 + e] = pair; } }
    }
}
__device__ __forceinline__ void phase_gather(Frame& F) {
    const bf16_t* H2 = WSP(bf16_t, WS_H2); bf16_t* XG = WSP(bf16_t, WS_XG); const int* PTOK = WSP(int, WS_PTOK);
    for (int p = F.gw; p < NPAIR; p += F.NGW) { const int tok = PTOK[p]; u32x4* dst = (u32x4*)(XG + (size_t)p * DM) + F.lane;
        if (tok >= 0) { const u32x4* src = (const u32x4*)(H2 + (size_t)tok * DM) + F.lane;
#pragma unroll
            for (int j = 0; j < 4; ++j) dst[64 * j] = src[64 * j]; }
        else {
#pragma unroll
            for (int j = 0; j < 4; ++j) { unsigned zz = 0u; asm volatile("" : "+v"(zz)); dst[64 * j] = (u32x4){zz, zz, zz, zz}; } } }
}
__device__ __forceinline__ void phase_ln2(Frame& F, const Args& a, int layer) {
    const float* mod = (const float*)(F.ws + WS_CTL) + CW_MOD + (size_t)layer * 3 * 6 * DM;
    float* XS = WSP(float, WS_XS); const bf16_t* YE = WSP(bf16_t, WS_YE); const int* INV = WSP(int, WS_INV);
    const float* g2w = arg_in(a, I_LN2G) + layer * DM; const float* b2w = arg_in(a, I_LN2B) + layer * DM;
    for (int row = F.gw; row < T; row += F.NGW) {
        f32x4* xr = (f32x4*)(XS + (size_t)row * DM) + F.lane; const float* m = mod + (size_t)row_modidx(row) * 6 * DM;
        f32x4 mo[8];
#pragma unroll
        for (int j = 0; j < 8; ++j) mo[j] = (f32x4){0.f, 0.f, 0.f, 0.f};
        for (int e = 0; e < 16; ++e) { const int pair = INV[(size_t)row * 16 + e];
            if (pair >= 0) { const u32x2* yr = (const u32x2*)(YE + (size_t)pair * DM) + F.lane;
#pragma unroll
                for (int j = 0; j < 8; ++j) { const u32x2 w = yr[64 * j]; mo[j] += (f32x4){bflo(w.x), bfhi(w.x), bflo(w.y), bfhi(w.y)}; } } }
        f32x4 v[8];
#pragma unroll
        for (int j = 0; j < 8; ++j) { const int c = 4 * (64 * j + F.lane); v[j] = xr[64 * j] * ALPHA + *(const f32x4*)(m + 5 * DM + c) * mo[j]; }
        float mean, rstd; row_stats(v, mean, rstd, 1e-6f);
#pragma unroll
        for (int j = 0; j < 8; ++j) { const int c = 4 * (64 * j + F.lane); v[j] = (v[j] - mean) * rstd * *(const f32x4*)(g2w + c) + *(const f32x4*)(b2w + c); xr[64 * j] = v[j]; }
        if (layer == DEPTH - 1 && row >= TC) { f32x4* o = (f32x4*)(a.out + (size_t)(row - TC) * DM) + F.lane;
#pragma unroll
            for (int j = 0; j < 8; ++j) o[64 * j] = v[j]; }
    }
}

constexpr int LDS_BYTES = 153600, MISC_OFF = LDS_BYTES - 64;
constexpr int NPL = 16, NPHASE = 1 + DEPTH * NPL;

__global__ void __launch_bounds__(NTHREADS, 2) fwd_kernel(Args args) {
    extern __shared__ __attribute__((aligned(16))) unsigned char lds_raw[];
    Frame F;
    F.lds = (LAS unsigned char*)lds_raw;
    F.tid = threadIdx.x; F.lane = F.tid & 63; F.wave = __builtin_amdgcn_readfirstlane(F.tid >> 6);
    F.G = gridDim.x; F.bid = blockIdx.x; F.gw = F.bid * NWAVES + F.wave; F.NGW = F.G * NWAVES; F.ws = args.ws;
    volatile LAS unsigned* misc = (volatile LAS unsigned*)(F.lds + MISC_OFF);
    if (F.tid < 16) misc[F.tid] = 0u;
    __syncthreads();
    const int lo = args.ph_lo, hi = args.ph_hi;
    XcdBarrier bar; bar.bar = (unsigned*)(F.ws + WS_CTL) + CW_BAR; bar.x = 0; bar.st = nullptr;
    const bool multi = (hi - lo) > 1;
    if (multi) bar = xcd_barrier_post((unsigned*)(F.ws + WS_CTL) + CW_BAR, misc);
#ifndef ONLY_PHASE
#define ONLY_PHASE -1
#endif
#define PON(r) (ONLY_PHASE < 0 || ONLY_PHASE == (r))
#define IN(k) (lo <= (k) && (k) < hi)
#define SEAM(k) do { if (IN(k) && IN((k) + 1)) { XcdBarrier bb_ = bar; bb_.x = (unsigned)opqs((int)bar.x); xcd_barrier(bb_); } } while (0)
    if (PON(100) && IN(0)) { F.ws = opq(args.ws); F.tid = opqv(threadIdx.x); F.lane = F.tid & 63; F.G = opqs(gridDim.x); F.bid = opqs(blockIdx.x); F.wave = __builtin_amdgcn_readfirstlane(F.tid >> 6); F.gw = F.bid * NWAVES + F.wave; F.NGW = F.G * NWAVES; p0_weights(F, args); p0_mod(F, args); __syncthreads(); }
    SEAM(0);
#pragma unroll 1
    for (int layer = 0; layer < DEPTH; ++layer) {
        const int pb = 1 + layer * NPL;
        if (PON(0) && IN(pb + 0)) { F.ws = opq(args.ws); F.tid = opqv(threadIdx.x); F.lane = F.tid & 63; F.G = opqs(gridDim.x); F.bid = opqs(blockIdx.x); F.wave = __builtin_amdgcn_readfirstlane(F.tid >> 6); F.gw = F.bid * NWAVES + F.wave; F.NGW = F.G * NWAVES; phase_modln(F, args, layer); phase_hdn(F, args, layer); __syncthreads(); }
        SEAM(pb + 0);
        if (PON(1) && IN(pb + 1)) { F.ws = opq(args.ws); F.tid = opqv(threadIdx.x); F.lane = F.tid & 63; F.G = opqs(gridDim.x); F.bid = opqs(blockIdx.x); F.wave = __builtin_amdgcn_readfirstlane(F.tid >> 6); F.gw = F.bid * NWAVES + F.wave; F.NGW = F.G * NWAVES;
            pg8::Gemm g{WSP(bf16_t, WS_H), WSP(bf16_t, WS_WIN + layer * SZ_WIN), DM, DM, DM}; pg8::StaticOrder S; S.init(66, NNG / 256, F.G, F.bid);
            EpiBf16 E{WSP(bf16_t, WS_P), NNG, nullptr, 0, 0};
            pg8::gemm_phase(F.lds, g, S, E);
        }
        SEAM(pb + 1);
        if (PON(2) && IN(pb + 2)) { F.ws = opq(args.ws); F.tid = opqv(threadIdx.x); F.lane = F.tid & 63; F.G = opqs(gridDim.x); F.bid = opqs(blockIdx.x); F.wave = __builtin_amdgcn_readfirstlane(F.tid >> 6); F.gw = F.bid * NWAVES + F.wave; F.NGW = F.G * NWAVES; phase_prep(F, args, layer); phase_filt(F, args, layer); __syncthreads(); }
        SEAM(pb + 2);
        if (PON(3) && IN(pb + 3)) { F.ws = opq(args.ws); F.tid = opqv(threadIdx.x); F.lane = F.tid & 63; F.G = opqs(gridDim.x); F.bid = opqs(blockIdx.x); F.wave = __builtin_amdgcn_readfirstlane(F.tid >> 6); F.gw = F.bid * NWAVES + F.wave; F.NGW = F.G * NWAVES;
#if !defined(T3) || T3 == 0
            { pg8::Gemm g{WSP(bf16_t, WS_P) + P_CQ, WSP(bf16_t, WS_WQ + layer * SZ_WQ), NNG, 512, 512}; pg8::StaticOrder S; S.init(66, 6, F.G, F.bid);
              EpiBf16 E{WSP(bf16_t, WS_Q), 1536, WSP(float, WS_RS), 2, 0}; pg8::gemm_phase(F.lds, g, S, E); }
#endif
#if !defined(T3) || T3 == 1
            { pg8::Gemm g{WSP(bf16_t, WS_P) + P_CKV, WSP(bf16_t, WS_WKV + layer * SZ_WKV), NNG, 512, 512}; pg8::StaticOrder S; S.init(66, 8, F.G, F.bid);
              EpiBf16 E{WSP(bf16_t, WS_KV), 2048, WSP(float, WS_RS) + 1, 2, 0}; pg8::gemm_phase(F.lds, g, S, E); }
#endif
#if !defined(T3) || T3 == 2
            { pg8::Gemm g{WSP(bf16_t, WS_ALORA), WSP(bf16_t, WS_WLORA + layer * SZ_WLORA), 512, 512, 512}; pg8::StaticOrder S; S.init(66, 20, F.G, F.bid);
              EpiLora E{WSP(bf16_t, WS_EW), WSP(bf16_t, WS_ICLR), WSP(bf16_t, WS_GG), arg_in(args, I_RW0) + layer * 2048, arg_in(args, I_RA0) + layer * 2048}; pg8::gemm_phase(F.lds, g, S, E); }
#endif
        }
        SEAM(pb + 3);
        if (PON(4) && IN(pb + 4)) { F.ws = opq(args.ws); F.tid = opqv(threadIdx.x); F.lane = F.tid & 63; F.G = opqs(gridDim.x); F.bid = opqs(blockIdx.x); F.wave = __builtin_amdgcn_readfirstlane(F.tid >> 6); F.gw = F.bid * NWAVES + F.wave; F.NGW = F.G * NWAVES; phase_qrope(F); phase_mamba_states(F, args, layer); __syncthreads(); }
        SEAM(pb + 4);
        if (PON(5) && IN(pb + 5)) { F.ws = opq(args.ws); F.tid = opqv(threadIdx.x); F.lane = F.tid & 63; F.G = opqs(gridDim.x); F.bid = opqs(blockIdx.x); F.wave = __builtin_amdgcn_readfirstlane(F.tid >> 6); F.gw = F.bid * NWAVES + F.wave; F.NGW = F.G * NWAVES;
#if !defined(T5) || T5 == 0
            phase_rwkv_scan(F, args, layer); __syncthreads();
#endif
#if !defined(T5) || T5 == 1
            phase_attn(F);
#endif
#if !defined(T5) || T5 == 2
            phase_hyena_fft(F, args, layer);
#endif
#if !defined(T5) || T5 == 3
            phase_mamba_scan(F); __syncthreads();
#endif
        }
        SEAM(pb + 5);
        if (PON(6) && IN(pb + 6)) { F.ws = opq(args.ws); F.tid = opqv(threadIdx.x); F.lane = F.tid & 63; F.G = opqs(gridDim.x); F.bid = opqs(blockIdx.x); F.wave = __builtin_amdgcn_readfirstlane(F.tid >> 6); F.gw = F.bid * NWAVES + F.wave; F.NGW = F.G * NWAVES;
#if !defined(T6) || T6 == 0
            phase_mamba_out(F, args, layer); __syncthreads();
#endif
#if !defined(T6) || T6 == 1
            phase_hyena_out(F, args, layer);
#endif
#if !defined(T6) || T6 == 2
            phase_rwkv_out(F, args, layer); __syncthreads();
#endif
        }
        SEAM(pb + 6);
        if (PON(7) && IN(pb + 7)) { F.ws = opq(args.ws); F.tid = opqv(threadIdx.x); F.lane = F.tid & 63; F.G = opqs(gridDim.x); F.bid = opqs(blockIdx.x); F.wave = __builtin_amdgcn_readfirstlane(F.tid >> 6); F.gw = F.bid * NWAVES + F.wave; F.NGW = F.G * NWAVES;
            pg8::Gemm g{WSP(bf16_t, WS_H), WSP(bf16_t, WS_WIN + layer * SZ_WIN) + (size_t)NNG * DM, DM, DM, DM}; pg8::StaticOrder S; S.init(66, NGATE / 256, F.G, F.bid);
            EpiBf16 E{WSP(bf16_t, WS_GATES), NGATE, nullptr, 0, 1};
            pg8::gemm_phase(F.lds, g, S, E);
            phase_mamba_norm(F, args, layer);
        }
        SEAM(pb + 7);
        if (PON(8) && IN(pb + 8)) { F.ws = opq(args.ws); F.tid = opqv(threadIdx.x); F.lane = F.tid & 63; F.G = opqs(gridDim.x); F.bid = opqs(blockIdx.x); F.wave = __builtin_amdgcn_readfirstlane(F.tid >> 6); F.gw = F.bid * NWAVES + F.wave; F.NGW = F.G * NWAVES;
            pg8::Gemm g{WSP(bf16_t, WS_Y), WSP(bf16_t, WS_WBR + layer * SZ_WBR), 1024, 1024, 1024}; OrderMerge S; S.init(F.G, F.bid);
            EpiMerge E{WSP(bf16_t, WS_GATES), WSP(float, WS_MRGF), WSP(bf16_t, WS_MRGB)};
            pg8::gemm_phase(F.lds, g, S, E);
        }
        SEAM(pb + 8);
        if (PON(9) && IN(pb + 9)) { F.ws = opq(args.ws); F.tid = opqv(threadIdx.x); F.lane = F.tid & 63; F.G = opqs(gridDim.x); F.bid = opqs(blockIdx.x); F.wave = __builtin_amdgcn_readfirstlane(F.tid >> 6); F.gw = F.bid * NWAVES + F.wave; F.NGW = F.G * NWAVES;
            pg8::Gemm g{WSP(bf16_t, WS_MRGB), WSP(bf16_t, WS_WOUT + layer * SZ_WOUT), DM, DM, DM}; pg8::StaticOrder S; S.init(66, 8, F.G, F.bid);
            EpiF32 E{WSP(float, WS_YMIX), DM};
            pg8::gemm_phase(F.lds, g, S, E);
        }
        SEAM(pb + 9);
        if (PON(10) && IN(pb + 10)) { F.ws = opq(args.ws); F.tid = opqv(threadIdx.x); F.lane = F.tid & 63; F.G = opqs(gridDim.x); F.bid = opqs(blockIdx.x); F.wave = __builtin_amdgcn_readfirstlane(F.tid >> 6); F.gw = F.bid * NWAVES + F.wave; F.NGW = F.G * NWAVES; phase_ln1(F, args, layer); __syncthreads(); conv_experts(F, args, layer); __syncthreads(); }
        SEAM(pb + 10);
        if (PON(11) && IN(pb + 11)) { F.ws = opq(args.ws); F.tid = opqv(threadIdx.x); F.lane = F.tid & 63; F.G = opqs(gridDim.x); F.bid = opqs(blockIdx.x); F.wave = __builtin_amdgcn_readfirstlane(F.tid >> 6); F.gw = F.bid * NWAVES + F.wave; F.NGW = F.G * NWAVES; phase_topk(F); __syncthreads(); }
        SEAM(pb + 11);
        if (PON(12) && IN(pb + 12)) { F.ws = opq(args.ws); F.tid = opqv(threadIdx.x); F.lane = F.tid & 63; F.G = opqs(gridDim.x); F.bid = opqs(blockIdx.x); F.wave = __builtin_amdgcn_readfirstlane(F.tid >> 6); F.gw = F.bid * NWAVES + F.wave; F.NGW = F.G * NWAVES; phase_gather(F); }
        SEAM(pb + 12);
        if (PON(13) && IN(pb + 13)) { F.ws = opq(args.ws); F.tid = opqv(threadIdx.x); F.lane = F.tid & 63; F.G = opqs(gridDim.x); F.bid = opqs(blockIdx.x); F.wave = __builtin_amdgcn_readfirstlane(F.tid >> 6); F.gw = F.bid * NWAVES + F.wave; F.NGW = F.G * NWAVES;
            pg8::Gemm g{WSP(bf16_t, WS_XG), WSP(bf16_t, WS_WE), DM, DM, DM}; OrderMoe S; S.init(11, F.G, F.bid);
            EpiSwiglu E{WSP(bf16_t, WS_HID)};
            pg8::gemm_phase(F.lds, g, S, E);
        }
        SEAM(pb + 13);
        if (PON(14) && IN(pb + 14)) { F.ws = opq(args.ws); F.tid = opqv(threadIdx.x); F.lane = F.tid & 63; F.G = opqs(gridDim.x); F.bid = opqs(blockIdx.x); F.wave = __builtin_amdgcn_readfirstlane(F.tid >> 6); F.gw = F.bid * NWAVES + F.wave; F.NGW = F.G * NWAVES;
            pg8::Gemm g{WSP(bf16_t, WS_HID), WSP(bf16_t, WS_WE + SZ_WGU), EFF, EFF, EFF}; OrderMoe S; S.init(8, F.G, F.bid);
            EpiDown E{WSP(bf16_t, WS_YE), WSP(float, WS_PGATE)};
            pg8::gemm_phase(F.lds, g, S, E);
        }
        SEAM(pb + 14);
        if (PON(15) && IN(pb + 15)) { F.ws = opq(args.ws); F.tid = opqv(threadIdx.x); F.lane = F.tid & 63; F.G = opqs(gridDim.x); F.bid = opqs(blockIdx.x); F.wave = __builtin_amdgcn_readfirstlane(F.tid >> 6); F.gw = F.bid * NWAVES + F.wave; F.NGW = F.G * NWAVES; phase_ln2(F, args, layer); }
        SEAM(pb + 15);
    }
#undef IN
#undef SEAM
}


#ifdef DBG_CUT
__global__ void dbg_dump(const unsigned char* ws, float* out, size_t off, int is_bf16, size_t n_src) {
    const size_t N = (size_t)TL * DM;
    for (size_t i = (size_t)blockIdx.x * blockDim.x + threadIdx.x; i < N; i += (size_t)gridDim.x * blockDim.x) {
        const size_t j = i % n_src;
        out[i] = is_bf16 ? bf2f(((const bf16_t*)(ws + off))[j]) : ((const float*)(ws + off))[j];
    }
}
#endif

#ifdef DBG_PASSES
__global__ void dbg_chk(const unsigned char* base, size_t off, size_t nbytes, unsigned long long* slot) {
    const unsigned* p = (const unsigned*)(base + off); const size_t n = nbytes / 4; unsigned long long s = 0;
    for (size_t i = (size_t)blockIdx.x * blockDim.x + threadIdx.x; i < n; i += (size_t)gridDim.x * blockDim.x) s += p[i];
    for (int o = 32; o > 0; o >>= 1) s += __shfl_xor(s, o);
    if ((threadIdx.x & 63) == 0) atomicAdd(slot, s);
}
__global__ void dbg_report(const unsigned long long* tab, float* out, int npass) {
    int k = 0;
    for (int ph = NPHASE - 1; ph >= 0; --ph) if (tab[ph] != tab[64 + ph]) k = ph + 1;
    if (k == 0 && npass > 2) { for (int ph = NPHASE - 1; ph >= 0; --ph) if (tab[64 + ph] != tab[128 + ph]) k = 50 + ph + 1; }
    if (k == 0) return;
    const float c = sqrtf(10.f * (float)k);
    for (size_t i = (size_t)blockIdx.x * blockDim.x + threadIdx.x; i < (size_t)TL * DM; i += (size_t)gridDim.x * blockDim.x) out[i] = c;
}
struct DbgReg { size_t off, n; };
#endif
extern "C" void kernel_launch(void* const* d_in, const int* in_sizes, int n_in, void* d_out, int out_size, void* d_ws, size_t ws_size, hipStream_t stream) {
    static int grid = 0;
    if (grid == 0) {
        if (n_in != N_INPUTS || in_sizes[0] != TL * DM || out_size != TL * DM || ws_size < WS_END) {
            fprintf(stderr, "kernel_launch: shape/workspace mismatch: n_in %d in0 %d out %d ws %zu (need %zu)\n", n_in, n_in > 0 ? in_sizes[0] : -1, out_size, ws_size, (size_t)WS_END); grid = -1; return; }
        int dev = 0, cus = 0, per_cu = 0;
        if (hipGetDevice(&dev) != hipSuccess || hipDeviceGetAttribute(&cus, hipDeviceAttributeMultiprocessorCount, dev) != hipSuccess) { grid = -1; return; }
        if (hipFuncSetAttribute((const void*)fwd_kernel, hipFuncAttributeMaxDynamicSharedMemorySize, LDS_BYTES) != hipSuccess) { fprintf(stderr, "kernel_launch: hipFuncSetAttribute failed\n"); grid = -1; return; }
        if (hipOccupancyMaxActiveBlocksPerMultiprocessor(&per_cu, (const void*)fwd_kernel, NTHREADS, LDS_BYTES) != hipSuccess || per_cu < 1) { fprintf(stderr, "kernel_launch: occupancy query says %d\n", per_cu); grid = -1; (void)hipGetLastError(); return; }
        grid = cus;
    }
    if (grid < 0) return;
    (void)hipMemsetAsync((char*)d_ws + WS_CTL, 0, CTL_BYTES, stream);
    Args a{};
    for (int i = 0; i < N_INPUTS; ++i) a.in[i] = (const float*)d_in[i];
    a.out = (float*)d_out; a.ws = (unsigned char*)d_ws;
#if MK_ONE_LAUNCH
    a.ph_lo = 0; a.ph_hi = NPHASE;
    hipLaunchKernelGGL(fwd_kernel, dim3(grid), dim3(NTHREADS), LDS_BYTES, stream, a);
#else
#ifdef DBG_PASSES
    {
        unsigned long long* tab = (unsigned long long*)((char*)d_ws + 1600000);
        auto chk = [&](int pass, int ph, size_t off, size_t n) { hipLaunchKernelGGL(dbg_chk, dim3(1024), dim3(256), 0, stream, (const unsigned char*)d_ws, off, n, tab + pass * 64 + ph); };
        for (int pass = 0; pass < DBG_PASSES; ++pass) {
            if (pass > 0) (void)hipMemsetAsync((char*)d_ws + (size_t)CW_MOD * 4, 0, (size_t)DEPTH * 3 * 6 * DM * 4, stream);
            for (int ph = 0; ph < NPHASE; ++ph) {
                a.ph_lo = ph; a.ph_hi = ph + 1; hipLaunchKernelGGL(fwd_kernel, dim3(grid), dim3(NTHREADS), LDS_BYTES, stream, a);
                if (ph == 0) { chk(pass, ph, WS_WIN, WS_XS - WS_WIN); chk(pass, ph, (size_t)CW_MOD * 4, (size_t)DEPTH * 3 * 6 * DM * 4); continue; }
                const int r = (ph - 1) % NPL;
                switch (r) {
                case 0: chk(pass, ph, WS_H, SZ_H); chk(pass, ph, WS_HDN, SZ_HDN); break;
                case 1: chk(pass, ph, WS_P, SZ_P); break;
                case 2: chk(pass, ph, WS_P2, SZ_P2); chk(pass, ph, WS_KK, SZ_TK2); chk(pass, ph, WS_ALORA, WS_VT - WS_ALORA); chk(pass, ph, WS_VT, WS_HDN - WS_VT); break;
                case 3: chk(pass, ph, WS_Q, SZ_Q + SZ_KV); chk(pass, ph, WS_EW, 4 * SZ_TK2); chk(pass, ph, WS_GG, SZ_TK2); break;
                case 4: chk(pass, ph, WS_Q, SZ_Q); chk(pass, ph, WS_MST, SZ_MST + SZ_MCS); break;
                case 5: chk(pass, ph, WS_YRW, 2 * SZ_TK2); chk(pass, ph, WS_Y, SZ_Y / 4); chk(pass, ph, WS_VT, SZ_VT); chk(pass, ph, WS_MST, SZ_MST); break;
                case 6: chk(pass, ph, WS_Y + SZ_Y / 4, 3 * (SZ_Y / 4)); break;
                case 7: chk(pass, ph, WS_GATES, SZ_GATES); chk(pass, ph, WS_Y + SZ_Y / 4, SZ_Y / 4); break;
                case 8: chk(pass, ph, WS_MRGF, SZ_MRGF); chk(pass, ph, WS_MRGB, SZ_MRGB); break;
                case 9: chk(pass, ph, WS_YMIX, SZ_YMIX); break;
                case 10: chk(pass, ph, WS_XS, SZ_XS); chk(pass, ph, WS_H2, SZ_H); chk(pass, ph, WS_AFF, SZ_AFF); chk(pass, ph, WS_WE, SZ_WGU + SZ_WD); break;
                case 11: chk(pass, ph, WS_INV, SZ_INV + SZ_PTOK + SZ_PGATE); break;
                case 12: chk(pass, ph, WS_XG, SZ_XG); break;
                case 13: chk(pass, ph, WS_HID, SZ_HID); break;
                case 14: chk(pass, ph, WS_YE, SZ_YE); break;
                case 15: chk(pass, ph, WS_XS, SZ_XS); break;
                }
            }
        }
        hipLaunchKernelGGL(dbg_report, dim3(2048), dim3(256), 0, stream, (const unsigned long long*)tab, (float*)d_out, (int)DBG_PASSES);
    }
#elif defined(DBG_CUT)
    for (int ph = 0; ph < DBG_CUT; ++ph) { a.ph_lo = ph; a.ph_hi = ph + 1; hipLaunchKernelGGL(fwd_kernel, dim3(grid), dim3(NTHREADS), LDS_BYTES, stream, a); }
    hipLaunchKernelGGL(dbg_dump, dim3(2048), dim3(256), 0, stream, (const unsigned char*)d_ws, (float*)d_out, (size_t)DBG_OFF, DBG_BF16, (size_t)DBG_N);
#else
    for (int ph = 0; ph < NPHASE; ++ph) { a.ph_lo = ph; a.ph_hi = ph + 1; hipLaunchKernelGGL(fwd_kernel, dim3(grid), dim3(NTHREADS), LDS_BYTES, stream, a); }
#endif
#endif
}
```

```cpp
#include <hip/hip_runtime.h>
#include <cstdio>
#include <cstdint>

#ifndef MK_ONE_LAUNCH
#define MK_ONE_LAUNCH 1
#endif

#define LAS __attribute__((address_space(3)))
typedef unsigned short bf16_t;
typedef short bf16x8 __attribute__((ext_vector_type(8)));
typedef float f32x4 __attribute__((ext_vector_type(4)));
typedef float f32x2 __attribute__((ext_vector_type(2)));
typedef unsigned u32x4 __attribute__((ext_vector_type(4)));
typedef unsigned u32x2 __attribute__((ext_vector_type(2)));

constexpr int DM = 2048, NBATCH = 2, SEQ = 8192, CTX = 256, DEPTH = 2;
constexpr int TC = NBATCH * CTX, TL = NBATCH * SEQ, T = TC + TL;
constexpr int NIN = 18432, NNG = 10240, NGATE = 8192;
constexpr int P_CQ = 0, P_CKV = 512, P_KPE = 1024;
constexpr int P_Z = 1088, P_XBC = 2112, P_DT = 3648;
constexpr int P_HY = 3680;
constexpr int P_RW = 6752, P_WD = 9824, P_AD = 9952, P_GD = 10080;
constexpr int NH_MLA = 8, NH_SSM = 16, NH_RW = 16;
constexpr int NEXP = 16, EFF = 1408, CAP_L = 1024, CAP_C = 32;
constexpr int NPAIR = NBATCH * NEXP * CAP_L + NEXP * 256;
constexpr float ALPHA = 1.4142135623730951f;
constexpr int NWAVES = 8, NTHREADS = 512;

__device__ __forceinline__ int seg_of(int row) { return row < 256 ? 0 : row < 512 ? 1 : row < 512 + SEQ ? 2 : 3; }
__device__ __forceinline__ int seg_start(int s) { return s == 0 ? 0 : s == 1 ? 256 : s == 2 ? 512 : 512 + SEQ; }
__device__ __forceinline__ int seg_len(int s) { return s < 2 ? CTX : SEQ; }
__device__ __forceinline__ bool row_first(int row) { return row == 0 || row == 256 || row == 512 || row == 512 + SEQ; }
__device__ __forceinline__ bool row_last(int row) { return row == 255 || row == 511 || row == 511 + SEQ || row == T - 1; }
__device__ __forceinline__ int row_modidx(int row) { return row < 512 ? 2 : (row < 512 + SEQ ? 0 : 1); }

constexpr size_t AL(size_t x) { return (x + 255) / 256 * 256; }
constexpr size_t WS_CTL = 0, CTL_BYTES = 2u << 20;
constexpr int CW_BAR = 1024;
constexpr int CW_MOD = 16384;
constexpr size_t SZ_WIN = (size_t)NIN * DM * 2, SZ_WBR = (size_t)4 * DM * 1024 * 2, SZ_WOUT = (size_t)DM * DM * 2, SZ_WQ = (size_t)1536 * 512 * 2,
                 SZ_WKV = (size_t)2048 * 512 * 2, SZ_WLORA = (size_t)5120 * 512 * 2;
constexpr size_t WS_WIN = CTL_BYTES, WS_WBR = WS_WIN + DEPTH * SZ_WIN, WS_WOUT = WS_WBR + DEPTH * SZ_WBR, WS_WQ = WS_WOUT + DEPTH * SZ_WOUT,
                 WS_WKV = WS_WQ + DEPTH * SZ_WQ, WS_WLORA = WS_WKV + DEPTH * SZ_WKV, WS_XS = WS_WLORA + DEPTH * SZ_WLORA;
constexpr size_t SZ_XS = (size_t)T * DM * 4;
constexpr size_t WS_H = WS_XS + SZ_XS, SZ_H = (size_t)T * DM * 2;
constexpr size_t WS_P = WS_H + SZ_H, SZ_P = (size_t)T * NNG * 2;
constexpr int P2W = 5632, P2_XBC = 0, P2_X0 = 1536, P2_RKV = 2560;
constexpr size_t WS_P2 = WS_P + SZ_P, SZ_P2 = (size_t)T * P2W * 2;
constexpr size_t WS_Q = WS_P2 + SZ_P2, SZ_Q = (size_t)T * 1536 * 2;
constexpr size_t WS_KV = WS_Q + SZ_Q, SZ_KV = (size_t)T * 2048 * 2;
constexpr size_t WS_EW = WS_KV + SZ_KV, SZ_TK2 = (size_t)T * 1024 * 2;
constexpr size_t WS_ICLR = WS_EW + 2 * SZ_TK2;
constexpr size_t WS_KK = WS_ICLR + 2 * SZ_TK2;
constexpr size_t WS_GG = WS_KK + SZ_TK2;
constexpr size_t WS_YRW = WS_GG + SZ_TK2;
constexpr size_t WS_ALORA = WS_YRW + 2 * SZ_TK2, SZ_ALORA = (size_t)T * 512 * 2;
constexpr size_t WS_KPE = WS_ALORA + SZ_ALORA, SZ_KPE = (size_t)T * 64 * 2;
constexpr size_t WS_RS = WS_KPE + SZ_KPE, SZ_RS = AL((size_t)T * 2 * 4);
constexpr size_t WS_DT = WS_RS + SZ_RS, SZ_DT = (size_t)T * 32 * 4;
constexpr size_t WS_VT = WS_DT + SZ_DT, SZ_VT = (size_t)1024 * 2 * SEQ * 4;
constexpr size_t WS_VC = WS_VT + SZ_VT, SZ_VC = (size_t)TC * 1024 * 4;
constexpr size_t WS_FILT = WS_VC + SZ_VC, SZ_FILT = (size_t)1024 * 2 * SEQ * 2;
constexpr size_t WS_FILTC = WS_FILT + SZ_FILT, SZ_FILTC = (size_t)CTX * 2048 * 4;
constexpr size_t WS_HDN = WS_FILTC + SZ_FILTC, SZ_HDN = (size_t)(SEQ + CTX) * 64 * 4;
constexpr int NCHUNK = T / 128;
constexpr size_t WS_MST = WS_HDN + SZ_HDN, SZ_MST = (size_t)2 * NCHUNK * 16 * 8192 * 2;
constexpr size_t WS_MCS = WS_MST + SZ_MST, SZ_MCS = (size_t)2 * NCHUNK * 16 * 4 * 2;
constexpr size_t WS_Y = WS_MCS + AL(SZ_MCS), SZ_Y = (size_t)4 * T * 1024 * 2;
constexpr size_t WS_AFF = WS_Y + SZ_Y, SZ_AFF = (size_t)T * 16 * 4;
constexpr size_t WS_INV = WS_AFF + SZ_AFF, SZ_INV = (size_t)T * 16 * 4;
constexpr size_t WS_PTOK = WS_INV + SZ_INV, SZ_PTOK = (size_t)NPAIR * 4;
constexpr size_t WS_PGATE = WS_PTOK + SZ_PTOK, SZ_PGATE = (size_t)NPAIR * 4;
constexpr size_t WS_END = WS_PGATE + SZ_PGATE;
constexpr size_t WS_GATES = WS_P, SZ_GATES = (size_t)T * NGATE * 2;
constexpr size_t WS_MRGF = WS_P2, SZ_MRGF = (size_t)T * DM * 4;
constexpr size_t WS_MRGB = WS_Q, SZ_MRGB = (size_t)T * DM * 2;
constexpr size_t WS_YMIX = WS_P, SZ_YMIX = (size_t)T * DM * 4;
constexpr size_t WS_H2 = WS_H;
constexpr size_t WS_WE = WS_P2, SZ_WGU = (size_t)NEXP * 2816 * DM * 2, SZ_WD = (size_t)NEXP * DM * EFF * 2;
constexpr size_t WS_XG = WS_P, SZ_XG = (size_t)NPAIR * DM * 2;
constexpr size_t WS_HID = WS_XG + SZ_XG, SZ_HID = (size_t)NPAIR * EFF * 2;
constexpr size_t WS_YE = WS_WE + SZ_WGU + SZ_WD, SZ_YE = (size_t)NPAIR * DM * 2;
static_assert(SZ_GATES <= SZ_P && SZ_MRGF <= SZ_P2 && SZ_MRGB <= SZ_Q + SZ_KV && SZ_YMIX <= SZ_P, "alias map 1");
static_assert(SZ_XG + SZ_HID <= SZ_P, "alias map 2");
static_assert(WS_YE + SZ_YE <= WS_VT, "alias map 3");
static_assert(WS_END < 1800000000ull, "workspace budget");

__device__ __forceinline__ unsigned f2bf(float f) { unsigned u = __builtin_bit_cast(unsigned, f); return (u + 0x7fffu + ((u >> 16) & 1u)) >> 16; }
__device__ __forceinline__ unsigned pk2(float lo, float hi) { return f2bf(lo) | (f2bf(hi) << 16); }
__device__ __forceinline__ float bf2f(unsigned short b) { return __builtin_bit_cast(float, (unsigned)b << 16); }
__device__ __forceinline__ float bflo(unsigned w) { return __builtin_bit_cast(float, w << 16); }
__device__ __forceinline__ float bfhi(unsigned w) { return __builtin_bit_cast(float, w & 0xffff0000u); }
__device__ __forceinline__ unsigned cvt_pk_bf16(float lo, float hi) { unsigned r; asm volatile("v_cvt_pk_bf16_f32 %0, %1, %2" : "=v"(r) : "v"(lo), "v"(hi)); return r; }
__device__ __forceinline__ float dppx(float x, const int sel) {
    const int xi = __builtin_bit_cast(int, x); int r;
    if (sel == 0) r = __builtin_amdgcn_update_dpp(0, xi, 0xB1, 0xF, 0xF, false);
    else if (sel == 1) r = __builtin_amdgcn_update_dpp(0, xi, 0x4E, 0xF, 0xF, false);
    else if (sel == 2) r = __builtin_amdgcn_update_dpp(0, xi, 0x141, 0xF, 0xF, false);
    else r = __builtin_amdgcn_update_dpp(0, xi, 0x140, 0xF, 0xF, false);
    return __builtin_bit_cast(float, r);
}
__device__ __forceinline__ float swz16(float x) { return __builtin_bit_cast(float, __builtin_amdgcn_ds_swizzle(__builtin_bit_cast(int, x), 0x401F)); }
__device__ __forceinline__ float sum4(float v) { v += dppx(v, 0); v += dppx(v, 1); return v; }
__device__ __forceinline__ float sum8(float v) { v = sum4(v); v += dppx(v, 2); return v; }
__device__ __forceinline__ float sum16(float v) { v = sum8(v); v += dppx(v, 3); return v; }
__device__ __forceinline__ float sum32(float v) { v = sum16(v); v += swz16(v); return v; }
__device__ __forceinline__ float wave_sum(float v) {
    v = sum32(v);
    auto rr = __builtin_amdgcn_permlane32_swap(__float_as_uint(v), __float_as_uint(v), false, false);
    return __uint_as_float(rr[0]) + __uint_as_float(rr[1]);
}
__device__ __forceinline__ float sigmoidf_(float x) { return 1.f / (1.f + __expf(-x)); }
__device__ __forceinline__ float siluf_(float x) { return x / (1.f + __expf(-x)); }
__device__ __forceinline__ float softplusf_(float x) { return x > 20.f ? x : __logf(1.f + __expf(x)); }
__device__ __forceinline__ float tanhf_(float x) { const float e = __expf(2.f * fminf(x, 15.f)); return 1.f - 2.f / (e + 1.f); }
#define LDS_WAIT() asm volatile("s_waitcnt lgkmcnt(0)" ::: "memory")
#define VM_WAIT() asm volatile("s_waitcnt vmcnt(0)" ::: "memory")

#define XB_TMO      128
#define XB_XCNT(j)  (256  + 64 * (j))
#define XB_XSUB(j)  (1280 + 64 * (j))
#define XB_XGEN(j)  (2304 + 64 * (j))
#define XB_TOP      3328
#define XB_TOPGEN   3392
#define XCD_BAR_WORDS 3456
#define XB_SPIN_CAP (1u << 18)
__device__ __forceinline__ unsigned xb_ld(unsigned* p)              { return __hip_atomic_load(p, __ATOMIC_RELAXED, __HIP_MEMORY_SCOPE_AGENT); }
__device__ __forceinline__ unsigned xb_add(unsigned* p, unsigned v) { return __hip_atomic_fetch_add(p, v, __ATOMIC_RELAXED, __HIP_MEMORY_SCOPE_AGENT); }
__device__ __forceinline__ unsigned xb_xcc_id() { return (unsigned)__builtin_amdgcn_s_getreg((3 << 11) | 20) & 0xFu; }
#define XB_SPIN(cond, bar) do { unsigned _sp = 0; while (cond) { __builtin_amdgcn_s_sleep(1); \
    if ((++_sp & 255u) == 0u) { if (xb_ld(&(bar)[XB_TMO])) break; if (_sp > XB_SPIN_CAP) { atomicAdd(&(bar)[XB_TMO], 1u); break; } } } } while (0)
struct XcdBarrier { unsigned* bar; unsigned x; volatile LAS unsigned* st; };
__device__ __forceinline__ XcdBarrier xcd_barrier_post(unsigned* bar, volatile LAS unsigned* st) {
    XcdBarrier b; b.bar = bar; b.x = xb_xcc_id(); b.st = st;
    if (threadIdx.x == 0) (void)xb_add(&bar[XB_XCNT(b.x)], 1u);
    return b;
}
__device__ __forceinline__ void xcd_barrier_complete(unsigned* bar, unsigned x, unsigned& nloc, unsigned& nx) {
    const unsigned G = gridDim.x * gridDim.y * gridDim.z;
    unsigned sum, cnt, mine, sp = 0u;
    for (;;) {
        sum = 0u; cnt = 0u; mine = 0u;
#pragma unroll
        for (unsigned j = 0; j < 16; ++j) { const unsigned c = xb_ld(&bar[XB_XCNT(j)]); sum += c; cnt += (c > 0u) ? 1u : 0u; mine = (j == x) ? c : mine; }
        if (sum == G) break;
        __builtin_amdgcn_s_sleep(1);
        if ((++sp & 255u) == 0u) { if (xb_ld(&bar[XB_TMO])) break; if (sp > XB_SPIN_CAP) { atomicAdd(&bar[XB_TMO], 1u); break; } }
    }
    nloc = mine > 0u ? mine : 1u; nx = cnt > 0u ? cnt : 1u;
}
__device__ __forceinline__ void xcd_barrier(const XcdBarrier& b) {
    asm volatile("s_waitcnt vmcnt(0)" ::: "memory");
    __syncthreads();
    if (threadIdx.x == 0) {
        unsigned* bar = b.bar;
        __builtin_amdgcn_s_waitcnt(0);
        unsigned nloc = b.st[0], nx = b.st[1];
        if (nloc == 0u) { xcd_barrier_complete(bar, b.x, nloc, nx); b.st[0] = nloc; b.st[1] = nx; }
        const unsigned old = xb_add(&bar[XB_XSUB(b.x)], 1u);
        const unsigned gen = old / nloc;
        if (old + 1u == (gen + 1u) * nloc) {
            __builtin_amdgcn_fence(__ATOMIC_RELEASE, "agent");
            asm volatile("s_waitcnt vmcnt(0)" ::: "memory");
            const unsigned og = xb_add(&bar[XB_TOP], 1u);
            const unsigned tg = og / nx;
            if (og + 1u == (tg + 1u) * nx) xb_add(&bar[XB_TOPGEN], 1u);
            else XB_SPIN(xb_ld(&bar[XB_TOPGEN]) == tg, bar);
            __builtin_amdgcn_fence(__ATOMIC_ACQUIRE, "agent");
            xb_add(&bar[XB_XGEN(b.x)], 1u);
            asm volatile("s_waitcnt vmcnt(0)" ::: "memory");
        } else {
            XB_SPIN(xb_ld(&bar[XB_XGEN(b.x)]) == gen, bar);
            __builtin_amdgcn_fence(__ATOMIC_ACQUIRE, "agent");
            asm volatile("s_waitcnt vmcnt(0)" ::: "memory");
        }
    }
    __syncthreads();
}

namespace pg8 {
constexpr int BM = 256, BK = 64, HALF = 128, HTB = HALF * BK * 2, STAGE_BYTES = 8 * HTB, NXCD = 8, WGM = 8;
__host__ __device__ __forceinline__ int lds_byte(int r, int c) { const int st = (r >> 4) * 2 + (c >> 5), rr = r & 15, cc = c & 31, ob = rr * 64 + cc * 2; return st * 1024 + (ob ^ (((ob >> 9) & 1) << 5)); }
__host__ __device__ __forceinline__ void stage_rc(int b, int& R, int& C) { const int st = b / 1024, sb = b % 1024, swz = sb ^ (((sb >> 9) & 1) << 5); R = (st >> 1) * 16 + swz / 64; C = (st & 1) * 32 + (swz % 64) / 2; }
__host__ __device__ __forceinline__ int perm32(int rho) { const int n = rho >> 4, i = rho & 15; return 8 * (i >> 2) + 4 * n + (i & 3); }
struct Unit { int pm, pn; };
struct Gemm { const bf16_t* A; const bf16_t* Bt; int lda, ldb, K; };
struct StaticOrder {
    int nM, nN, nwg, G, c;
    __device__ void init(int nM_, int nN_, int G_, int c_) { nM = nM_; nN = nN_; nwg = nM * nN; G = G_; c = c_; }
    __device__ bool next(int i, Unit& u) const {
        const long L = (long)i * G + c; if (L >= nwg) return false;
        int wgid = (int)L; { const int q = nwg / NXCD, r = nwg % NXCD, xcd = wgid % NXCD, off = wgid / NXCD; wgid = (xcd < r ? xcd * (q + 1) : r * (q + 1) + (xcd - r) * q) + off; }
        const int nig = WGM * nN, gid = wgid / nig, fm = gid * WGM, gsz = (nM - fm) < WGM ? (nM - fm) : WGM;
        u.pm = fm + ((wgid % nig) % gsz); u.pn = (wgid % nig) / gsz; return true;
    }
};
template <class Epi, class Sched>
__device__ __forceinline__ void gemm_phase(LAS unsigned char* lds, const Gemm g, const Sched& S, const Epi& E) {
    constexpr bool ALIGN_EPI = true;
    int tid_ = threadIdx.x; asm volatile("" : "+v"(tid_));
    const int tid = tid_, wid = __builtin_amdgcn_readfirstlane(tid >> 6), lane = tid & 63, wr = wid >> 2, wc = wid & 3, fr = lane & 15, fq = lane >> 4;
    const int K = g.K, nt = K / BK;
    unsigned voffA[2], voffB[2];
#pragma unroll
    for (int i = 0; i < 2; ++i) { int R, C; stage_rc(tid * 16 + i * 8192, R, C); const int Rb = Epi::PERM ? ((R & ~31) + perm32(R & 31)) : R;
        voffA[i] = (unsigned)(R * g.lda + C) * 2u; voffB[i] = (unsigned)(Rb * g.ldb + C) * 2u; }
    const size_t kstep = (size_t)(BK * 2);
    const size_t hstepA = (size_t)HALF * g.lda * 2, hstepB = (size_t)HALF * g.ldb * 2;
    const size_t tstepA = 2 * hstepA, tstepB = 2 * hstepB;
    const unsigned ldsw = (unsigned)wid * 1024u;
    const int aoff = lds_byte(wr * 64 + fr, fq * 8), boff = lds_byte(wc * 32 + fr, fq * 8);
#define PG8_SA(b, h) (((b) * 2 + (h)) * HTB)
#define PG8_SB(b, h) ((4 + (b) * 2 + (h)) * HTB)
#define PG8_STAGE(bufoff, gbase, voff) do { _Pragma("unroll") for (int _i = 0; _i < 2; ++_i) \
        __builtin_amdgcn_global_load_lds((const unsigned*)((const char*)(gbase) + (voff)[_i]), (LAS unsigned*)(lds + (bufoff) + ldsw + _i * 8192), 16, 0, 0); } while (0)
#define PG8_LDA(dst, b, h) do { _Pragma("unroll") for (int m = 0; m < 4; ++m) _Pragma("unroll") for (int k = 0; k < 2; ++k) dst[m][k] = *(const LAS bf16x8*)(lds + PG8_SA(b, h) + aoff + m * 2048 + k * 1024); } while (0)
#define PG8_LDB(dst, b, h) do { _Pragma("unroll") for (int n = 0; n < 2; ++n) _Pragma("unroll") for (int k = 0; k < 2; ++k) dst[n][k] = *(const LAS bf16x8*)(lds + PG8_SB(b, h) + boff + n * 2048 + k * 1024); } while (0)
#define PG8_MMA(ai, bj, At, Bt) do { __builtin_amdgcn_s_setprio(1); _Pragma("unroll") for (int m = 0; m < 4; ++m) _Pragma("unroll") for (int n = 0; n < 2; ++n) _Pragma("unroll") for (int k = 0; k < 2; ++k) \
        acc[ai][bj][m][n] = __builtin_amdgcn_mfma_f32_16x16x32_bf16(Bt[n][k], At[m][k], acc[ai][bj][m][n], 0, 0, 0); __builtin_amdgcn_s_setprio(0); } while (0)
#define PG8_WAIT_V(n) asm volatile("s_waitcnt vmcnt(" #n ")" ::: "memory")
#define PG8_WAIT_L(n) asm volatile("s_waitcnt lgkmcnt(" #n ")" ::: "memory")
#define PG8_BAR __builtin_amdgcn_s_barrier()
#define PG8_SCHED __builtin_amdgcn_sched_barrier(0)
    Unit cur, nxt; int ui = 0;
    if (!S.next(0, cur)) return;
    f32x4 acc[2][2][4][2];
#pragma unroll
    for (int a = 0; a < 2; ++a)
#pragma unroll
        for (int b = 0; b < 2; ++b)
#pragma unroll
            for (int m = 0; m < 4; ++m)
#pragma unroll
                for (int n = 0; n < 2; ++n) acc[a][b][m][n] = (f32x4){0.f, 0.f, 0.f, 0.f};
    bf16x8 At[4][2], B0[2][2], B1[2][2];
    const char* cA = (const char*)g.A + (size_t)cur.pm * tstepA; const char* cB = (const char*)g.Bt + (size_t)cur.pn * tstepB;
    PG8_STAGE(PG8_SB(0, 0), cB, voffB); PG8_STAGE(PG8_SB(0, 1), cB + hstepB, voffB); PG8_STAGE(PG8_SA(0, 0), cA, voffA); PG8_STAGE(PG8_SA(0, 1), cA + hstepA, voffA);
    if (wr == 1) PG8_BAR;
    PG8_WAIT_V(2); PG8_BAR;
    PG8_STAGE(PG8_SB(1, 0), cB + kstep, voffB); PG8_STAGE(PG8_SA(1, 0), cA + kstep, voffA); PG8_STAGE(PG8_SB(1, 1), cB + hstepB + kstep, voffB);
    PG8_WAIT_V(6); PG8_BAR;
    for (;;) {
        const bool has_next = S.next(ui + 1, nxt);
        const char* nA = has_next ? (const char*)g.A + (size_t)nxt.pm * tstepA : cA; const char* nB = has_next ? (const char*)g.Bt + (size_t)nxt.pn * tstepB : cB;
        for (int t = 0; t < nt; t += 2) {
            const bool last = (t == nt - 2);
            const char* a1 = cA + (size_t)(t + 1) * kstep;
            const char* a2 = last ? nA : cA + (size_t)(t + 2) * kstep; const char* b2 = last ? nB : cB + (size_t)(t + 2) * kstep;
            const char* a3 = a2 + kstep; const char* b3 = b2 + kstep;
            PG8_LDB(B0, 0, 0); PG8_LDB(B1, 0, 1); PG8_SCHED; PG8_LDA(At, 0, 0); PG8_STAGE(PG8_SA(1, 1), a1 + hstepA, voffA);
            PG8_WAIT_V(8); PG8_WAIT_L(0); PG8_BAR; PG8_MMA(0, 0, At, B0); PG8_MMA(0, 1, At, B1); PG8_BAR; PG8_SCHED;
            PG8_LDA(At, 0, 1); PG8_STAGE(PG8_SB(0, 0), b2, voffB); PG8_STAGE(PG8_SB(0, 1), b2 + hstepB, voffB); PG8_STAGE(PG8_SA(0, 0), a2, voffA);
            PG8_WAIT_V(8); PG8_WAIT_L(0); PG8_BAR; PG8_MMA(1, 0, At, B0); PG8_MMA(1, 1, At, B1); PG8_BAR; PG8_SCHED;
            PG8_LDB(B0, 1, 0); PG8_LDB(B1, 1, 1); PG8_SCHED; PG8_LDA(At, 1, 0); PG8_STAGE(PG8_SA(0, 1), a2 + hstepA, voffA);
            PG8_WAIT_V(8); PG8_WAIT_L(0); PG8_BAR; PG8_MMA(0, 0, At, B0); PG8_MMA(0, 1, At, B1); PG8_BAR; PG8_SCHED;
            PG8_LDA(At, 1, 1); PG8_STAGE(PG8_SB(1, 0), b3, voffB); PG8_STAGE(PG8_SB(1, 1), b3 + hstepB, voffB); PG8_STAGE(PG8_SA(1, 0), a3, voffA);
            PG8_WAIT_V(8); PG8_WAIT_L(0); PG8_BAR; PG8_MMA(1, 0, At, B0); PG8_MMA(1, 1, At, B1); PG8_BAR; PG8_SCHED;
        }
        if constexpr (ALIGN_EPI) { if (wr == 0) PG8_BAR; }
        E(acc, cur, wr, wc, fr, fq);
        if (!has_next) break;
#pragma unroll
        for (int a = 0; a < 2; ++a)
#pragma unroll
            for (int b = 0; b < 2; ++b)
#pragma unroll
                for (int m = 0; m < 4; ++m)
#pragma unroll
                    for (int n = 0; n < 2; ++n) acc[a][b][m][n] = (f32x4){0.f, 0.f, 0.f, 0.f};
        cur = nxt; cA = nA; cB = nB; ++ui;
        if constexpr (ALIGN_EPI) { if (wr == 1) PG8_BAR; }
    }
    PG8_WAIT_V(0);
    if constexpr (!ALIGN_EPI) { if (wr == 0) PG8_BAR; }
    PG8_BAR;
#undef PG8_SA
#undef PG8_SB
#undef PG8_STAGE
#undef PG8_LDA
#undef PG8_LDB
#undef PG8_MMA
#undef PG8_WAIT_V
#undef PG8_WAIT_L
#undef PG8_BAR
#undef PG8_SCHED
}
}

enum { I_X = 0, I_C, I_CTX, I_CCTX, I_WADA, I_BADA, I_WIN, I_QNORM, I_WQUP, I_KVNORM, I_WKVUP, I_SCONVW, I_SCONVB, I_SDTB, I_SALOG, I_SD, I_SNORM,
       I_HCONVW, I_HCONVB, I_HW1, I_HB1, I_HW2, I_HB2, I_HW3, I_HFREQ, I_HD, I_RMU, I_RW0, I_RWUP, I_RA0, I_RAUP, I_RGUP, I_RKK, I_RKA, I_RRK, I_RLNG, I_RLNB,
       I_WBR, I_WOUT, I_LN1G, I_LN1B, I_WROUTER, I_WGATE, I_WUP, I_WDOWN, I_LN2G, I_LN2B, N_INPUTS };
struct Args { const float* in[N_INPUTS]; float* out; unsigned char* ws; int ph_lo, ph_hi; };
static_assert(sizeof(Args) == (N_INPUTS + 2) * 8 + 8, "Args has no padding");

__device__ __forceinline__ const float* arg_in(const Args& a, int i) { asm volatile("" : "+s"(i)); return a.in[i]; }
__device__ __forceinline__ int opqs(int v) { asm volatile("" : "+s"(v)); return v; }
__device__ __forceinline__ int opqv(int v) { asm volatile("" : "+v"(v)); return v; }
__device__ __forceinline__ unsigned char* opq(unsigned char* p) { asm volatile("" : "+s"(p)); return p; }
struct Frame {
    LAS unsigned char* lds;
    int tid, lane, wave, G, bid, gw, NGW;
    unsigned char* ws;
};
#define WSP(T_, off) ((T_*)(F.ws + (off)))

template <class RowMap>
__device__ __forceinline__ void transpose_item(const float* W, int ldw, bf16_t* WT, int ldt, int k0, int n0, const float* kscale, int koff, RowMap rm, LAS float* scr, int lane) {
#pragma unroll 8
    for (int i = 0; i < 32; ++i) { const int kk = 2 * i + (lane >> 5); float v = W[(size_t)(k0 + kk) * ldw + n0 + (lane & 31)]; if (kscale) v *= kscale[k0 + kk]; scr[kk * 33 + (lane & 31)] = v; }
    LDS_WAIT(); asm volatile("" ::: "memory");
    const int c = lane & 7;
#pragma unroll
    for (int j = 0; j < 4; ++j) { const int n = (lane >> 3) + 8 * j; const LAS float* s = scr + (8 * c) * 33 + n;
        u32x4 o; o.x = pk2(s[0 * 33], s[1 * 33]); o.y = pk2(s[2 * 33], s[3 * 33]); o.z = pk2(s[4 * 33], s[5 * 33]); o.w = pk2(s[6 * 33], s[7 * 33]);
        *(u32x4*)(WT + (size_t)rm(n0 + n) * ldt + koff + k0 + 8 * c) = o; }
    LDS_WAIT(); asm volatile("" ::: "memory");
}
struct RmId { __device__ int operator()(int n) const { return n; } };
struct RmGateUp { int up; __device__ int operator()(int n) const { return 256 * (n >> 7) + (n & 127) + (up ? 128 : 0); } };

__device__ __forceinline__ void p0_weights(Frame& F, const Args& a) {
    LAS float* scr = (LAS float*)(F.lds + F.wave * 8704);
    constexpr int IT_IN = 32 * 576, IT_BR = 16 * 64, IT_OUT = 32 * 64, IT_Q = 8 * 48, IT_KV = 8 * 64;
    constexpr int PER_L = IT_IN + 4 * IT_BR + IT_OUT + IT_Q + IT_KV;
    for (int it = F.gw; it < DEPTH * PER_L; it += F.NGW) {
        const int l = it / PER_L; int r = it % PER_L;
        if (r < IT_IN) { const int kb = r / 576, nb = r % 576;
            transpose_item(arg_in(a, I_WIN) + (size_t)l * DM * NIN, NIN, WSP(bf16_t, WS_WIN + l * SZ_WIN), DM, kb * 64, nb * 32, nullptr, 0, RmId(), scr, F.lane); continue; } r -= IT_IN;
        if (r < 4 * IT_BR) { const int br = r / IT_BR, q = r % IT_BR, kb = q / 64, nb = q % 64;
            transpose_item(arg_in(a, I_WBR) + ((size_t)l * 4 + br) * 1024 * DM, DM, WSP(bf16_t, WS_WBR + l * SZ_WBR) + (size_t)br * DM * 1024, 1024, kb * 64, nb * 32, nullptr, 0, RmId(), scr, F.lane); continue; } r -= 4 * IT_BR;
        if (r < IT_OUT) { const int kb = r / 64, nb = r % 64;
            transpose_item(arg_in(a, I_WOUT) + (size_t)l * DM * DM, DM, WSP(bf16_t, WS_WOUT + l * SZ_WOUT), DM, kb * 64, nb * 32, nullptr, 0, RmId(), scr, F.lane); continue; } r -= IT_OUT;
        if (r < IT_Q) { const int kb = r / 48, nb = r % 48;
            transpose_item(arg_in(a, I_WQUP) + (size_t)l * 512 * 1536, 1536, WSP(bf16_t, WS_WQ + l * SZ_WQ), 512, kb * 64, nb * 32, arg_in(a, I_QNORM) + l * 512, 0, RmId(), scr, F.lane); continue; } r -= IT_Q;
        { const int kb = r / 64, nb = r % 64;
            transpose_item(arg_in(a, I_WKVUP) + (size_t)l * 512 * 2048, 2048, WSP(bf16_t, WS_WKV + l * SZ_WKV), 512, kb * 64, nb * 32, arg_in(a, I_KVNORM) + l * 512, 0, RmId(), scr, F.lane); }
    }
    for (size_t e = (size_t)F.bid * NTHREADS + F.tid; e < (size_t)DEPTH * 5120 * 512; e += (size_t)F.G * NTHREADS) {
        const int l = (int)(e / (5120 * 512)); const int rem = (int)(e % (5120 * 512)); const int n = rem / 512, kc = rem % 512; const int blk = n >> 10, c = n & 1023;
        float v = 0.f;
        if (blk < 2) { if (kc >= 64 * blk && kc < 64 * blk + 64) v = arg_in(a, I_RWUP)[(((size_t)l * 2 + blk) * 64 + (kc - 64 * blk)) * 1024 + c]; }
        else if (blk < 4) { const int d = blk - 2; if (kc >= 128 + 64 * d && kc < 192 + 64 * d) v = arg_in(a, I_RAUP)[(((size_t)l * 2 + d) * 64 + (kc - 128 - 64 * d)) * 1024 + c]; }
        else { if (kc >= 256 && kc < 416) v = arg_in(a, I_RGUP)[((size_t)l * 160 + (kc - 256)) * 1024 + c]; }
        WSP(bf16_t, WS_WLORA)[e] = (bf16_t)f2bf(v);
    }
}
__device__ __forceinline__ void conv_experts(Frame& F, const Args& a, int l) {
    LAS float* scr = (LAS float*)(F.lds + F.wave * 8704);
    constexpr int IT_G = 32 * 44, IT_D = 22 * 64, PER_E = 2 * IT_G + IT_D;
    bf16_t* wgu = WSP(bf16_t, WS_WE); bf16_t* wd = WSP(bf16_t, WS_WE + SZ_WGU);
    for (int it = F.gw; it < NEXP * PER_E; it += F.NGW) {
        const int e = it / PER_E; int r = it % PER_E;
        if (r < 2 * IT_G) { const int up = r / IT_G, q = r % IT_G, kb = q / 44, nb = q % 44;
            const float* src = a.in[up ? I_WUP : I_WGATE] + ((size_t)l * NEXP + e) * DM * EFF;
            RmGateUp rm; rm.up = up;
            transpose_item(src, EFF, wgu + (size_t)e * 2816 * DM, DM, kb * 64, nb * 32, nullptr, 0, rm, scr, F.lane); continue; } r -= 2 * IT_G;
        { const int kb = r / 64, nb = r % 64;
            transpose_item(arg_in(a, I_WDOWN) + ((size_t)l * NEXP + e) * EFF * DM, DM, wd + (size_t)e * DM * EFF, EFF, kb * 64, nb * 32, nullptr, 0, RmId(), scr, F.lane); }
    }
}
__device__ __forceinline__ void p0_mod(Frame& F, const Args& a) {
    LAS float* sv = (LAS float*)(F.lds + 69632);
    for (int i = F.tid; i < 3 * DM; i += NTHREADS) { const int v = i / DM, k = i % DM; const float x = v < 2 ? arg_in(a, I_C)[v * DM + k] : arg_in(a, I_CCTX)[k]; sv[i] = siluf_(x); }
    __syncthreads();
    float* mod = (float*)(F.ws + WS_CTL) + CW_MOD;
    LAS float* red = (LAS float*)(F.lds + 69632 + 3 * DM * 4);
    for (int u = F.bid; u < DEPTH * (6 * DM / 128); u += F.G) {
        const int l = u / (6 * DM / 128), nb = u % (6 * DM / 128); const int kg = F.tid >> 7, cl = F.tid & 127, n = nb * 128 + cl;
        const float* w = arg_in(a, I_WADA) + ((size_t)l * DM + kg * 512) * (6 * DM) + n;
        float a0 = 0.f, a1 = 0.f, a2 = 0.f;
#pragma unroll 8
        for (int k = 0; k < 512; ++k) { const float wv = w[(size_t)k * (6 * DM)]; const int kk = kg * 512 + k; a0 += sv[kk] * wv; a1 += sv[DM + kk] * wv; a2 += sv[2 * DM + kk] * wv; }
        __syncthreads();
        red[(kg * 3 + 0) * 128 + cl] = a0; red[(kg * 3 + 1) * 128 + cl] = a1; red[(kg * 3 + 2) * 128 + cl] = a2;
        __syncthreads();
        if (F.tid < 384) { const int v = F.tid >> 7; const float b = arg_in(a, I_BADA)[l * 6 * DM + n];
            mod[(l * 3 + v) * 6 * DM + n] = b + ((red[(0 * 3 + v) * 128 + cl] + red[(1 * 3 + v) * 128 + cl]) + (red[(2 * 3 + v) * 128 + cl] + red[(3 * 3 + v) * 128 + cl])); }
    }
}

__device__ __forceinline__ void row_stats(const f32x4 (&v)[8], float& mean, float& rstd, float eps) {
    float s = 0.f;
#pragma unroll
    for (int j = 0; j < 8; ++j) s += (v[j].x + v[j].y) + (v[j].z + v[j].w);
    mean = wave_sum(s) * (1.f / DM);
    float s2 = 0.f;
#pragma unroll
    for (int j = 0; j < 8; ++j) { const f32x4 d = v[j] - mean; s2 += (d.x * d.x + d.y * d.y) + (d.z * d.z + d.w * d.w); }
    rstd = 1.f / sqrtf(wave_sum(s2) * (1.f / DM) + eps);
}
__device__ __forceinline__ const float* x_src_row(const Args& a, const Frame& F, int layer, int row) {
    if (layer == 0) return row < TC ? arg_in(a, I_CTX) + (size_t)row * DM : arg_in(a, I_X) + (size_t)(row - TC) * DM;
    return (const float*)(F.ws + WS_XS) + (size_t)row * DM;
}
__device__ __forceinline__ void phase_modln(Frame& F, const Args& a, int layer) {
    const float* mod = (const float*)(F.ws + WS_CTL) + CW_MOD + (size_t)layer * 3 * 6 * DM;
    bf16_t* H = WSP(bf16_t, WS_H);
    for (int row = F.gw; row < T; row += F.NGW) {
        const f32x4* xr = (const f32x4*)x_src_row(a, F, layer, row) + F.lane;
        f32x4 v[8];
#pragma unroll
        for (int j = 0; j < 8; ++j) v[j] = xr[64 * j];
        float mean, rstd; row_stats(v, mean, rstd, 1e-6f);
        const float* m = mod + (size_t)row_modidx(row) * 6 * DM;
        u32x2* o = (u32x2*)(H + (size_t)row * DM) + F.lane;
#pragma unroll
        for (int j = 0; j < 8; ++j) { const int c = 4 * (64 * j + F.lane); const f32x4 sh = *(const f32x4*)(m + c), sc = *(const f32x4*)(m + DM + c);
            const f32x4 y = (v[j] - mean) * rstd * (sc + 1.f) + sh; u32x2 w; w.x = pk2(y.x, y.y); w.y = pk2(y.z, y.w); o[64 * j] = w; }
    }
}

__device__ __forceinline__ void phase_hdn(Frame& F, const Args& a, int layer) {
    LAS float* zs = (LAS float*)(F.lds + F.wave * 512);
    const float* w1 = arg_in(a, I_HW1) + (size_t)layer * 33 * 64; const float* b1 = arg_in(a, I_HB1) + layer * 64;
    const float* w2 = arg_in(a, I_HW2) + (size_t)layer * 64 * 64; const float* b2 = arg_in(a, I_HB2) + layer * 64;
    const float fr = arg_in(a, I_HFREQ)[layer * 64 + F.lane];
    float* HDN = WSP(float, WS_HDN);
    for (int r = F.gw; r < SEQ + CTX; r += F.NGW) {
        const int n = r < SEQ ? SEQ : CTX, t = r < SEQ ? r : r - SEQ;
        const float wpos = (6.283185307179586f * (float)t) / (float)n;
        if (F.lane < 33) { float z;
            if (F.lane == 0) z = (float)t / (float)(n - 1);
            else { const int b = (F.lane - 1) & 15; const float f = 1e-4f + (float)b * ((15.f - 1e-4f) / 15.f); const float ang = f * wpos; z = F.lane <= 16 ? __cosf(ang) : -__sinf(ang); }
            zs[F.lane] = z; }
        LDS_WAIT(); asm volatile("" ::: "memory");
        float p = b1[F.lane];
#pragma unroll
        for (int i = 0; i < 33; ++i) p += zs[i] * w1[i * 64 + F.lane];
        const float h1 = __sinf(fr * p);
        zs[64 + F.lane] = h1;
        LDS_WAIT(); asm volatile("" ::: "memory");
        float q = b2[F.lane];
#pragma unroll 16
        for (int i = 0; i < 64; ++i) q += zs[64 + i] * w2[i * 64 + F.lane];
        HDN[(size_t)r * 64 + F.lane] = __sinf(fr * q);
        LDS_WAIT(); asm volatile("" ::: "memory");
    }
}
__device__ __forceinline__ float hy_delta(int c) { const float mn = -3.0701134573253943f, mx = -15.350567286626972f; return fabsf(mn + (float)c * ((mx - mn) / 1023.f)); }
__device__ __forceinline__ void phase_filt(Frame& F, const Args& a, int layer) {
    const float* w3 = arg_in(a, I_HW3) + (size_t)layer * 64 * 2048; const float* HDN = WSP(float, WS_HDN);
    LAS float* ws3 = (LAS float*)F.lds;
    bf16_t* FILT = WSP(bf16_t, WS_FILT);
    for (int u = F.bid; u < 32 * 16; u += F.G) {
        const int cb = u / 16, tb = u % 16, col0 = cb * 64, t = tb * 512 + F.tid;
        __syncthreads();
        for (int i = F.tid; i < 4096; i += NTHREADS) { const int j = i >> 6, cc = i & 63; ws3[cc * 64 + j] = w3[(size_t)j * 2048 + col0 + cc]; }
        __syncthreads();
        f32x4 h[16];
#pragma unroll
        for (int i = 0; i < 16; ++i) h[i] = *(const f32x4*)(HDN + (size_t)t * 64 + 4 * i);
        const float tn = (float)t / (float)(SEQ - 1);
        for (int cc = 0; cc < 64; ++cc) {
            float acc = 0.f;
#pragma unroll
            for (int i = 0; i < 16; ++i) { const f32x4 w = *(const LAS f32x4*)(ws3 + cc * 64 + 4 * i); acc += h[i].x * w.x + h[i].y * w.y + h[i].z * w.z + h[i].w * w.w; }
            const int col = col0 + cc, side = col >> 10, c = col & 1023;
            FILT[((size_t)c * 2 + side) * SEQ + t] = (bf16_t)f2bf(acc * __expf(-tn * hy_delta(c)));
        }
    }
    float* FILTC = WSP(float, WS_FILTC);
    for (int e = F.bid * NTHREADS + F.tid; e < CTX * 2048; e += F.G * NTHREADS) {
        const int lag = e >> 11, col = e & 2047, c = col & 1023; const float* hr = HDN + (size_t)(SEQ + lag) * 64; float acc = 0.f;
#pragma unroll 16
        for (int j = 0; j < 64; ++j) acc += hr[j] * w3[(size_t)j * 2048 + col];
        FILTC[e] = acc * __expf(-((float)lag / (float)(CTX - 1)) * hy_delta(c));
    }
}

__device__ __forceinline__ void ld8bf(const bf16_t* p, float (&o)[8]) { const u32x4 w = *(const u32x4*)p; o[0] = bflo(w.x); o[1] = bfhi(w.x); o[2] = bflo(w.y); o[3] = bfhi(w.y); o[4] = bflo(w.z); o[5] = bfhi(w.z); o[6] = bflo(w.w); o[7] = bfhi(w.w); }
__device__ __forceinline__ void st8bf(bf16_t* p, const float (&v)[8]) { u32x4 w; w.x = pk2(v[0], v[1]); w.y = pk2(v[2], v[3]); w.z = pk2(v[4], v[5]); w.w = pk2(v[6], v[7]); *(u32x4*)p = w; }
__device__ __forceinline__ void ld8f(const float* p, float (&o)[8]) { const f32x4 a = *(const f32x4*)p, b = *(const f32x4*)(p + 4); o[0] = a.x; o[1] = a.y; o[2] = a.z; o[3] = a.w; o[4] = b.x; o[5] = b.y; o[6] = b.z; o[7] = b.w; }

__device__ __forceinline__ void phase_prep(Frame& F, const Args& a, int layer) {
    const bf16_t* P = WSP(bf16_t, WS_P); bf16_t* P2 = WSP(bf16_t, WS_P2);
    float* RS = WSP(float, WS_RS); bf16_t* KPE = WSP(bf16_t, WS_KPE); float* DT = WSP(float, WS_DT);
    bf16_t* KK = WSP(bf16_t, WS_KK); bf16_t* AL_ = WSP(bf16_t, WS_ALORA); float* VC = WSP(float, WS_VC);
    const float* scw = arg_in(a, I_SCONVW) + (size_t)layer * 3 * 1536; const float* scb = arg_in(a, I_SCONVB) + layer * 1536; const float* dtb = arg_in(a, I_SDTB) + layer * 32;
    const float* hcw = arg_in(a, I_HCONVW) + (size_t)layer * 3 * 3072; const float* hcb = arg_in(a, I_HCONVB) + layer * 3072;
    const float* mu = arg_in(a, I_RMU) + (size_t)layer * 2 * 3488; const float* rkk = arg_in(a, I_RKK) + layer * 1024;
    for (int row = F.gw; row < T; row += F.NGW) {
        const bf16_t* pr = P + (size_t)row * NNG; const bool first = row_first(row), last = row_last(row);
        const bf16_t* pp = pr - NNG; const bf16_t* pn = pr + NNG;
        const int lane = F.lane;
        { float x[8]; ld8bf(pr + P_CQ + lane * 8, x); float s = 0.f;
#pragma unroll
          for (int i = 0; i < 8; ++i) s += x[i] * x[i];
          s = wave_sum(s); const float rq = 1.f / sqrtf(s * (1.f / 512.f) + 1e-6f);
          ld8bf(pr + P_CKV + lane * 8, x); s = 0.f;
#pragma unroll
          for (int i = 0; i < 8; ++i) s += x[i] * x[i];
          s = wave_sum(s); const float rk = 1.f / sqrtf(s * (1.f / 512.f) + 1e-6f);
          if (lane == 0) { RS[row * 2] = rq; RS[row * 2 + 1] = rk; }
          float kv = bf2f(pr[P_KPE + lane]);
          const float other = swz16(kv);
          if (row >= TC) { const int t = (row - TC) & (SEQ - 1); const int axis = lane >> 5, half = (lane >> 4) & 1, j = lane & 15;
              const float pos = (float)(axis == 0 ? (t >> 6) : (t & 63)); const float inv = __builtin_amdgcn_exp2f(-(float)j * 0.8304820237218406f);
              const float sn = __sinf(pos * inv), cs = __cosf(pos * inv);
              kv = half == 0 ? kv * cs - other * sn : kv * cs + other * sn; }
          KPE[(size_t)row * 64 + lane] = (bf16_t)f2bf(kv); }
#pragma unroll 1
        for (int ch = 0; ch < 3; ++ch) { const int c = ch * 512 + lane * 8; float x0[8], xm[8], xp[8], w0[8], w1[8], w2[8], bb[8], o[8];
            ld8bf(pr + P_XBC + c, x0);
            if (!first) ld8bf(pp + P_XBC + c, xm); else { for (int i = 0; i < 8; ++i) xm[i] = 0.f; }
            if (!last) ld8bf(pn + P_XBC + c, xp); else { for (int i = 0; i < 8; ++i) xp[i] = 0.f; }
            ld8f(scw + c, w0); ld8f(scw + 1536 + c, w1); ld8f(scw + 3072 + c, w2); ld8f(scb + c, bb);
#pragma unroll
            for (int i = 0; i < 8; ++i) o[i] = siluf_(xm[i] * w0[i] + x0[i] * w1[i] + xp[i] * w2[i] + bb[i]);
            st8bf(P2 + (size_t)row * P2W + P2_XBC + c, o); }
        if (lane < 32) DT[(size_t)row * 32 + lane] = softplusf_(bf2f(pr[P_DT + lane]) + dtb[lane]);
#pragma unroll 1
        for (int ch = 0; ch < 2; ++ch) { const int c = ch * 512 + lane * 8;
            float o0[8];
            { float x0[8], xm[8], xp[8], w0[8], w1[8], w2[8], bb[8];
              ld8bf(pr + P_HY + c, x0);
              if (!first) ld8bf(pp + P_HY + c, xm); else { for (int i = 0; i < 8; ++i) xm[i] = 0.f; }
              if (!last) ld8bf(pn + P_HY + c, xp); else { for (int i = 0; i < 8; ++i) xp[i] = 0.f; }
              ld8f(hcw + c, w0); ld8f(hcw + 3072 + c, w1); ld8f(hcw + 6144 + c, w2); ld8f(hcb + c, bb);
#pragma unroll
              for (int i = 0; i < 8; ++i) o0[i] = xm[i] * w0[i] + x0[i] * w1[i] + xp[i] * w2[i] + bb[i]; }
            st8bf(P2 + (size_t)row * P2W + P2_X0 + c, o0);
            if (row < TC) { float o1[8], o2[8];
#pragma unroll
                for (int part = 1; part < 3; ++part) { float x0[8], xm[8], xp[8], w0[8], w1[8], w2[8], bb[8]; const int cc = part * 1024 + c;
                    ld8bf(pr + P_HY + cc, x0);
                    if (!first) ld8bf(pp + P_HY + cc, xm); else { for (int i = 0; i < 8; ++i) xm[i] = 0.f; }
                    if (!last) ld8bf(pn + P_HY + cc, xp); else { for (int i = 0; i < 8; ++i) xp[i] = 0.f; }
                    ld8f(hcw + cc, w0); ld8f(hcw + 3072 + cc, w1); ld8f(hcw + 6144 + cc, w2); ld8f(hcb + cc, bb);
#pragma unroll
                    for (int i = 0; i < 8; ++i) { const float r = xm[i] * w0[i] + x0[i] * w1[i] + xp[i] * w2[i] + bb[i]; if (part == 1) o1[i] = r; else o2[i] = r; } }
                float* vc = VC + (size_t)row * 1024 + c;
                *(f32x4*)vc = (f32x4){o1[0] * o2[0], o1[1] * o2[1], o1[2] * o2[2], o1[3] * o2[3]};
                *(f32x4*)(vc + 4) = (f32x4){o1[4] * o2[4], o1[5] * o2[5], o1[6] * o2[6], o1[7] * o2[7]}; } }
#pragma unroll 1
        for (int ch = 0; ch < 7; ++ch) { const int c = ch * 512 + lane * 8;
            if (c < 3488) { float u0[8], um[8], up[8], m0[8], m1[8], us[8];
                ld8bf(pr + P_RW + c, u0);
                if (!first) ld8bf(pp + P_RW + c, um); else { for (int i = 0; i < 8; ++i) um[i] = 0.f; }
                if (!last) ld8bf(pn + P_RW + c, up); else { for (int i = 0; i < 8; ++i) up[i] = 0.f; }
                ld8f(mu + c, m0); ld8f(mu + 3488 + c, m1);
#pragma unroll
                for (int i = 0; i < 8; ++i) us[i] = u0[i] + m0[i] * (um[i] - u0[i]) + m1[i] * (up[i] - u0[i]);
                if (ch < 6) st8bf(P2 + (size_t)row * P2W + P2_RKV + c, us);
                if (ch == 2 || ch == 3) {
                    float kx[8], g8[8]; ld8f(rkk + (c - 1024), g8); float s = 0.f;
#pragma unroll
                    for (int i = 0; i < 8; ++i) { kx[i] = us[i] * g8[i]; s += kx[i] * kx[i]; }
                    s = sum8(s);
                    const float inv = 1.f / fmaxf(sqrtf(s), 1e-12f);
#pragma unroll
                    for (int i = 0; i < 8; ++i) kx[i] *= inv;
                    st8bf(KK + (size_t)row * 1024 + (c - 1024), kx); }
                if (ch == 6) { const int cl = c - 3072; float o[8];
#pragma unroll
                    for (int i = 0; i < 8; ++i) o[i] = cl < 128 ? tanhf_(us[i]) : cl < 256 ? us[i] : sigmoidf_(us[i]);
                    st8bf(AL_ + (size_t)row * 512 + cl, o); } }
            else if (ch == 6) { const int cl = c - 3072; float zz = 0.f; asm volatile("" : "+v"(zz)); float o[8] = {zz, zz, zz, zz, zz, zz, zz, zz}; st8bf(AL_ + (size_t)row * 512 + cl, o); } }
    }
    float* VT = WSP(float, WS_VT);
    LAS float* tl = (LAS float*)F.lds;
    for (int u = F.bid; u < (TL / 64) * 4; u += F.G) {
        const int tb = u >> 2, cb = u & 3; const int row0 = TC + tb * 64; const int c = cb * 256 + (F.tid & 255), th = F.tid >> 8;
        const float w10 = hcw[1024 + c], w11 = hcw[3072 + 1024 + c], w12 = hcw[6144 + 1024 + c], b1 = hcb[1024 + c];
        const float w20 = hcw[2048 + c], w21 = hcw[3072 + 2048 + c], w22 = hcw[6144 + 2048 + c], b2 = hcb[2048 + c];
        __syncthreads();
        for (int i = 0; i < 32; ++i) { const int tl_ = th * 32 + i, row = row0 + tl_; const bf16_t* pr = P + (size_t)row * NNG + P_HY;
            const bool first = row_first(row), last = row_last(row);
            const float x1m = first ? 0.f : bf2f(pr[-NNG + 1024 + c]), x10 = bf2f(pr[1024 + c]), x1p = last ? 0.f : bf2f(pr[NNG + 1024 + c]);
            const float vm = first ? 0.f : bf2f(pr[-NNG + 2048 + c]), v0 = bf2f(pr[2048 + c]), vp = last ? 0.f : bf2f(pr[NNG + 2048 + c]);
            tl[(F.tid & 255) * 65 + tl_] = (x1m * w10 + x10 * w11 + x1p * w12 + b1) * (vm * w20 + v0 * w21 + vp * w22 + b2); }
        __syncthreads();
        const int b = (row0 - TC) >> 13, t0 = (row0 - TC) & (SEQ - 1);
        for (int p = 0; p < 8; ++p) { const int cl = p * 32 + (F.tid >> 4), q = F.tid & 15;
            const f32x4 o = {tl[cl * 65 + 4 * q], tl[cl * 65 + 4 * q + 1], tl[cl * 65 + 4 * q + 2], tl[cl * 65 + 4 * q + 3]};
            *(f32x4*)(VT + ((size_t)(cb * 256 + cl) * 2 + b) * SEQ + t0 + 4 * q) = o; }
    }
}

using pg8::Unit;
#define EPI_LOOP_BEGIN const int row0 = u.pm * 256 + wr * 64 + fr; \
    _Pragma("unroll") for (int ai = 0; ai < 2; ++ai) _Pragma("unroll") for (int m = 0; m < 4; ++m) { const int row = row0 + ai * 128 + m * 16; \
    _Pragma("unroll") for (int bj = 0; bj < 2; ++bj) { const int cl = bj * 128 + wc * 32 + 8 * fq; const f32x4 v0 = acc[ai][bj][m][0], v1 = acc[ai][bj][m][1];
#define EPI_LOOP_END } __builtin_amdgcn_sched_barrier(0); }
struct EpiBf16 {
    static constexpr bool PERM = true;
    bf16_t* O; int ldc; const float* rscale; int rs_stride; int act;
    __device__ __forceinline__ void operator()(const f32x4 (&acc)[2][2][4][2], const Unit& u, int wr, int wc, int fr, int fq) const {
        EPI_LOOP_BEGIN
            const float s = rscale ? rscale[(size_t)row * rs_stride] : 1.f;
            float x[8] = {v0.x * s, v0.y * s, v0.z * s, v0.w * s, v1.x * s, v1.y * s, v1.z * s, v1.w * s};
            if (act == 1) {
#pragma unroll
                for (int i = 0; i < 8; ++i) x[i] = sigmoidf_(x[i]); }
            u32x4 w; w.x = cvt_pk_bf16(x[0], x[1]); w.y = cvt_pk_bf16(x[2], x[3]); w.z = cvt_pk_bf16(x[4], x[5]); w.w = cvt_pk_bf16(x[6], x[7]);
            *(u32x4*)(O + (size_t)row * ldc + u.pn * 256 + cl) = w;
        EPI_LOOP_END
    }
};
struct EpiLora {
    static constexpr bool PERM = true;
    bf16_t* EW; bf16_t* ICLR; bf16_t* GG; const float* w0; const float* a0;
    __device__ __forceinline__ void operator()(const f32x4 (&acc)[2][2][4][2], const Unit& u, int wr, int wc, int fr, int fq) const {
        const int blk = u.pn >> 2, cb = (u.pn & 3) * 256;
        const float* bias = blk < 2 ? w0 + blk * 1024 : a0 + (blk & 1) * 1024;
        bf16_t* dbase = blk < 2 ? EW + (size_t)blk * T * 1024 : blk < 4 ? ICLR + (size_t)(blk - 2) * T * 1024 : GG;
        const float scale = blk < 2 ? 0.6065306597126334f : 1.f; const bool sig = blk < 4;
        EPI_LOOP_BEGIN
            const int c = cb + cl; float x[8] = {v0.x, v0.y, v0.z, v0.w, v1.x, v1.y, v1.z, v1.w};
            if (sig) { const f32x4 b0 = *(const f32x4*)(bias + c), b1 = *(const f32x4*)(bias + c + 4); const float bb[8] = {b0.x, b0.y, b0.z, b0.w, b1.x, b1.y, b1.z, b1.w};
#pragma unroll
                for (int i = 0; i < 8; ++i) x[i] = scale * sigmoidf_(bb[i] + x[i]); }
            u32x4 w; w.x = cvt_pk_bf16(x[0], x[1]); w.y = cvt_pk_bf16(x[2], x[3]); w.z = cvt_pk_bf16(x[4], x[5]); w.w = cvt_pk_bf16(x[6], x[7]);
            *(u32x4*)(dbase + (size_t)row * 1024 + c) = w;
        EPI_LOOP_END
    }
};
struct EpiMerge {
    static constexpr bool PERM = true;
    const bf16_t* gates; float* MF; bf16_t* MB;
    __device__ __forceinline__ void operator()(const f32x4 (&acc)[2][2][4][2], const Unit& uu, int wr, int wc, int fr, int fq) const {
        const int br = uu.pn >> 3; Unit u; u.pm = uu.pm - br * 66; u.pn = uu.pn & 7;
        EPI_LOOP_BEGIN
            const int col = u.pn * 256 + cl; float g[8]; ld8bf(gates + (size_t)row * NGATE + br * DM + col, g);
            float x[8] = {v0.x * g[0], v0.y * g[1], v0.z * g[2], v0.w * g[3], v1.x * g[4], v1.y * g[5], v1.z * g[6], v1.w * g[7]};
            float* mf = MF + (size_t)row * DM + col;
            if (br > 0) { const f32x4 p0 = *(const f32x4*)mf, p1 = *(const f32x4*)(mf + 4); x[0] += p0.x; x[1] += p0.y; x[2] += p0.z; x[3] += p0.w; x[4] += p1.x; x[5] += p1.y; x[6] += p1.z; x[7] += p1.w; }
            if (br < 3) { *(f32x4*)mf = (f32x4){x[0], x[1], x[2], x[3]}; *(f32x4*)(mf + 4) = (f32x4){x[4], x[5], x[6], x[7]}; }
            else { u32x4 w; w.x = cvt_pk_bf16(x[0], x[1]); w.y = cvt_pk_bf16(x[2], x[3]); w.z = cvt_pk_bf16(x[4], x[5]); w.w = cvt_pk_bf16(x[6], x[7]); *(u32x4*)(MB + (size_t)row * DM + col) = w; }
        EPI_LOOP_END
    }
};
struct OrderMerge {
    pg8::StaticOrder so;
    __device__ void init(int G, int c) { so.init(66, 8, G, c); }
    __device__ bool next(int i, Unit& u) const { Unit t; if (!so.next(i >> 2, t)) return false; const int br = i & 3; u.pm = br * 66 + t.pm; u.pn = br * 8 + t.pn; return true; }
};
struct EpiF32 {
    static constexpr bool PERM = true;
    float* O; int ldc;
    __device__ __forceinline__ void operator()(const f32x4 (&acc)[2][2][4][2], const Unit& u, int wr, int wc, int fr, int fq) const {
        EPI_LOOP_BEGIN
            float* o = O + (size_t)row * ldc + u.pn * 256 + cl; *(f32x4*)o = v0; *(f32x4*)(o + 4) = v1;
        EPI_LOOP_END
    }
};
__device__ __forceinline__ int moe_panel(int e, int pi) { return pi < 8 ? (((pi >> 2) * NEXP + e) * 4 + (pi & 3)) : 128 + e; }
struct OrderMoe {
    int npn, G, c;
    __device__ void init(int npn_, int G_, int c_) { npn = npn_; G = G_; c = c_; }
    __device__ bool next(int i, Unit& u) const { const int L = i * G + c; const int per = 9 * npn; if (L >= NEXP * per) return false;
        const int e = L / per, r = L % per, j = r / 9, pi = r % 9; u.pm = moe_panel(e, pi); u.pn = e * npn + j; return true; }
};
struct EpiSwiglu {
    static constexpr bool PERM = true;
    bf16_t* HID;
    __device__ __forceinline__ void operator()(const f32x4 (&acc)[2][2][4][2], const Unit& u, int wr, int wc, int fr, int fq) const {
        const int j = u.pn % 11; const int row0 = u.pm * 256 + wr * 64 + fr;
#pragma unroll
        for (int ai = 0; ai < 2; ++ai)
#pragma unroll
            for (int m = 0; m < 4; ++m) { const int row = row0 + ai * 128 + m * 16;
                const f32x4 g0 = acc[ai][0][m][0], g1 = acc[ai][0][m][1], u0 = acc[ai][1][m][0], u1 = acc[ai][1][m][1];
                u32x4 w; w.x = cvt_pk_bf16(siluf_(g0.x) * u0.x, siluf_(g0.y) * u0.y); w.y = cvt_pk_bf16(siluf_(g0.z) * u0.z, siluf_(g0.w) * u0.w);
                w.z = cvt_pk_bf16(siluf_(g1.x) * u1.x, siluf_(g1.y) * u1.y); w.w = cvt_pk_bf16(siluf_(g1.z) * u1.z, siluf_(g1.w) * u1.w);
                *(u32x4*)(HID + (size_t)row * EFF + j * 128 + wc * 32 + 8 * fq) = w; __builtin_amdgcn_sched_barrier(0); }
    }
};
struct EpiDown {
    static constexpr bool PERM = true;
    bf16_t* YE; const float* pgate;
    __device__ __forceinline__ void operator()(const f32x4 (&acc)[2][2][4][2], const Unit& uu, int wr, int wc, int fr, int fq) const {
        Unit u; u.pm = uu.pm; u.pn = uu.pn & 7;
        EPI_LOOP_BEGIN
            const float s = pgate[row];
            u32x4 w; w.x = cvt_pk_bf16(v0.x * s, v0.y * s); w.y = cvt_pk_bf16(v0.z * s, v0.w * s); w.z = cvt_pk_bf16(v1.x * s, v1.y * s); w.w = cvt_pk_bf16(v1.z * s, v1.w * s);
            *(u32x4*)(YE + (size_t)row * DM + u.pn * 256 + cl) = w;
        EPI_LOOP_END
    }
};

namespace att {
using s16x4 = __attribute__((ext_vector_type(4))) short;
using f32x16 = __attribute__((ext_vector_type(16))) float;
constexpr int NW = 8, QBLK = 32, KVBLK = 64, LDQ = 1536, LDKV = 2048, LDO = 1024;
constexpr float SCALE = 0.07216878364870322f;
constexpr float THR = 8.f;
#ifndef ATT_SDEPTH
#define ATT_SDEPTH 1
#endif
constexpr int SDEPTH = ATT_SDEPTH;
constexpr int SHM_V = KVBLK * 128 * 2, SHM_K = KVBLK * 128 * 2, SHM_KP = KVBLK * 64 * 2;
constexpr int OFF_V = 0, OFF_K = 2 * SHM_V, OFF_KP = OFF_K + 2 * SHM_K, OFF_WS = OFF_KP + 2 * SHM_KP, OFF_QP = OFF_WS + NW * 64 * 4, SHM_ATTN = OFF_QP + 256 * 256;
static_assert(SHM_ATTN <= 150 * 1024, "attention LDS");
#define KSWZ(row, colB) ((row) * 256 + ((colB) ^ (((row) & 7) << 4)))
#define KPSWZ(row, colB) ((row) * 128 + ((colB) ^ (((row) & 7) << 4)))
#define SBAR() __builtin_amdgcn_sched_barrier(0)
__device__ __forceinline__ int crow(int r, int hi) { return (r & 3) + 8 * (r >> 2) + 4 * hi; }
__device__ __forceinline__ void partialSM(f32x16& p0, f32x16& p1, float& m_reg, float& mn, float& alpha) {
  constexpr float C = SCALE * 1.4426950408889634f;
  float pmax = p0[0]; for (int r = 1; r < 16; ++r) pmax = fmaxf(pmax, p0[r]); for (int r = 0; r < 16; ++r) pmax = fmaxf(pmax, p1[r]);
  { auto rr = __builtin_amdgcn_permlane32_swap(__float_as_uint(pmax), __float_as_uint(pmax), false, false);
    pmax = fmaxf(__uint_as_float(rr[0]), __uint_as_float(rr[1])); }
  if (__builtin_expect(__all(pmax - m_reg <= THR / SCALE), 1)) { mn = m_reg; alpha = 1.f; }
  else { mn = fmaxf(m_reg, pmax); alpha = __builtin_amdgcn_exp2f((m_reg - mn) * C); m_reg = mn; }
  float mnC = -mn * C;
  for (int r = 0; r < 16; ++r) p0[r] = fmaf(p0[r], C, mnC); for (int r = 0; r < 16; ++r) p1[r] = fmaf(p1[r], C, mnC);
  for (int r = 0; r < 16; ++r) p0[r] = __builtin_amdgcn_exp2f(p0[r]);
}
__device__ __forceinline__ void finishSM(f32x16& p0, f32x16& p1, float alpha, float& l_reg, bf16x8& pa0, bf16x8& pa1, bf16x8& pa2, bf16x8& pa3) {
  for (int r = 0; r < 16; ++r) p1[r] = __builtin_amdgcn_exp2f(p1[r]);
  float ps = 0; for (int r = 0; r < 16; ++r) ps += p0[r]; for (int r = 0; r < 16; ++r) ps += p1[r];
  { auto rr = __builtin_amdgcn_permlane32_swap(__float_as_uint(ps), __float_as_uint(ps), false, false);
    ps = __uint_as_float(rr[0]) + __uint_as_float(rr[1]); }
  l_reg = l_reg * alpha + ps;
#define PK4(P, BASE, OUT) do { unsigned a0 = cvt_pk_bf16(P[BASE + 0], P[BASE + 1]), a1 = cvt_pk_bf16(P[BASE + 2], P[BASE + 3]);   \
    unsigned b0 = cvt_pk_bf16(P[BASE + 4], P[BASE + 5]), b1 = cvt_pk_bf16(P[BASE + 6], P[BASE + 7]);                              \
    auto r0 = __builtin_amdgcn_permlane32_swap(a0, b0, false, false); auto r1 = __builtin_amdgcn_permlane32_swap(a1, b1, false, false); \
    u32x4 w = {r0[0], r1[0], r0[1], r1[1]}; OUT = *reinterpret_cast<bf16x8*>(&w); } while (0)
  PK4(p0, 0, pa0); PK4(p0, 8, pa1); PK4(p1, 0, pa2); PK4(p1, 8, pa3);
#undef PK4
}
__device__ __forceinline__ void qkt(f32x16& p0, f32x16& p1, const char* Ks, const char* Kp, const bf16x8* qr, const char* Qp, int qrow, int r32, int hi) {
  p0 = f32x16{}; p1 = f32x16{};
#pragma unroll
  for (int d0 = 0; d0 < 8; ++d0) { int cb = (d0 * 16 + hi * 8) * 2;
    bf16x8 b0 = *reinterpret_cast<const bf16x8*>(Ks + KSWZ(r32, cb));
    bf16x8 b1 = *reinterpret_cast<const bf16x8*>(Ks + KSWZ(32 + r32, cb));
    bf16x8 q; if (d0 < 4) q = qr[d0]; else q = *reinterpret_cast<const bf16x8*>(Qp + KSWZ(qrow, ((d0 - 4) * 16 + hi * 8) * 2));
    p0 = __builtin_amdgcn_mfma_f32_32x32x16_bf16(b0, q, p0, 0, 0, 0);
    p1 = __builtin_amdgcn_mfma_f32_32x32x16_bf16(b1, q, p1, 0, 0, 0); }
#pragma unroll
  for (int d0 = 0; d0 < 4; ++d0) { int cb = (d0 * 16 + hi * 8) * 2;
    bf16x8 b0 = *reinterpret_cast<const bf16x8*>(Kp + KPSWZ(r32, cb));
    bf16x8 b1 = *reinterpret_cast<const bf16x8*>(Kp + KPSWZ(32 + r32, cb));
    const bf16x8 qp = *reinterpret_cast<const bf16x8*>(Qp + KSWZ(qrow, 128 + cb));
    p0 = __builtin_amdgcn_mfma_f32_32x32x16_bf16(b0, qp, p0, 0, 0, 0);
    p1 = __builtin_amdgcn_mfma_f32_32x32x16_bf16(b1, qp, p1, 0, 0, 0); }
}
__device__ __forceinline__ int v_st(int k, int c) { const int kk = (k & ~0xC) | ((k & 4) << 1) | ((k & 8) >> 1); return ((kk >> 3) * 4 + (c >> 5)) * 512 + ((kk & 7) * 32 + (c & 31)) * 2; }
__device__ __forceinline__ int v_rd_base(int lane) { return ((lane & 3) << 3) | (((lane >> 2) & 3) << 6) | (((lane >> 4) & 1) << 5) | (((lane >> 5) & 1) << 8); }
constexpr int v_rd_off(int d0, int ks, int half) { return d0 * 512 + ks * 4096 + half * 2048; }
template <int OFF> __device__ __forceinline__ s16x4 tr_read(int vb) {
  s16x4 r; asm volatile("ds_read_b64_tr_b16 %0, %1 offset:%2" : "=&v"(r) : "v"(vb), "i"(OFF) : "memory"); return r;
}
template <int D0> __device__ __forceinline__ void pv_one(f32x16& od, int vb, bf16x8 pa0, bf16x8 pa1, bf16x8 pa2, bf16x8 pa3) {
  const s16x4 l0 = tr_read<v_rd_off(D0, 0, 0)>(vb), h0 = tr_read<v_rd_off(D0, 0, 1)>(vb), l1 = tr_read<v_rd_off(D0, 1, 0)>(vb), h1 = tr_read<v_rd_off(D0, 1, 1)>(vb);
  const s16x4 l2 = tr_read<v_rd_off(D0, 2, 0)>(vb), h2 = tr_read<v_rd_off(D0, 2, 1)>(vb), l3 = tr_read<v_rd_off(D0, 3, 0)>(vb), h3 = tr_read<v_rd_off(D0, 3, 1)>(vb);
  asm volatile("s_waitcnt lgkmcnt(0)" ::: "memory"); SBAR();
#define PK(L, H) (bf16x8){L[0], L[1], L[2], L[3], H[0], H[1], H[2], H[3]}
  od = __builtin_amdgcn_mfma_f32_32x32x16_bf16(pa0, PK(l0, h0), od, 0, 0, 0);
  od = __builtin_amdgcn_mfma_f32_32x32x16_bf16(pa1, PK(l1, h1), od, 0, 0, 0);
  od = __builtin_amdgcn_mfma_f32_32x32x16_bf16(pa2, PK(l2, h2), od, 0, 0, 0);
  od = __builtin_amdgcn_mfma_f32_32x32x16_bf16(pa3, PK(l3, h3), od, 0, 0, 0);
#undef PK
}
__device__ __forceinline__ void pv_d0(f32x16* o, int vb, bf16x8 pa0, bf16x8 pa1, bf16x8 pa2, bf16x8 pa3) {
  pv_one<0>(o[0], vb, pa0, pa1, pa2, pa3); pv_one<1>(o[1], vb, pa0, pa1, pa2, pa3); pv_one<2>(o[2], vb, pa0, pa1, pa2, pa3); pv_one<3>(o[3], vb, pa0, pa1, pa2, pa3);
}
__device__ __forceinline__ void attn_unit(const bf16_t* __restrict__ Qb, const bf16_t* __restrict__ KVh, const bf16_t* __restrict__ KPE, bf16_t* __restrict__ Ob,
                                          int ka0, int kb0, int NT, char* lds) {
  int tid_ = threadIdx.x; asm volatile("" : "+v"(tid_));
  const int tid = tid_, wid = tid >> 6, lane = tid & 63, r32 = lane & 31, hi = lane >> 5;
  char* V_lds = lds + OFF_V; char* K_lds = lds + OFF_K; char* P_lds = lds + OFF_KP;
  float* ws = (float*)(lds + OFF_WS) + wid * 64; float* li_l = ws; float* al_l = ws + 32;
  float m_reg = -1e30f, l_reg = 0; f32x16 o[4] = {}; bf16x8 qr[4];
  char* Q_lds = lds + OFF_QP; const int qrow = wid * QBLK + r32;
  const bf16_t* Qw = Qb + (long)(wid * QBLK + r32) * LDQ + hi * 8;
#pragma unroll
  for (int d0 = 0; d0 < 4; ++d0) qr[d0] = *reinterpret_cast<const bf16x8*>(Qw + d0 * 16);
#pragma unroll
  for (int d0 = 0; d0 < 8; ++d0) *reinterpret_cast<bf16x8*>(Q_lds + KSWZ(qrow, (d0 * 16 + hi * 8) * 2)) = *reinterpret_cast<const bf16x8*>(Qw + 64 + d0 * 16);
  const int sr = tid >> 4, sc = (tid & 15) * 8, vst0 = v_st(sr, sc), vst1 = v_st(32 + sr, sc);
  const int pr = tid >> 3, pc = (tid & 7) * 8;
  const int vb0 = (int)(uintptr_t)V_lds + v_rd_base(lane);
  struct { bf16x8 vs0, vs1, ks0, ks1, kp; } sr_[SDEPTH];
#define KROW(j) ((j) < 4 ? ka0 + 64 * (j) : kb0 + 64 * ((j) - 4))
#define SLOAD(i, jt) do { const long k0_ = KROW(jt); \
    sr_[i].vs0 = *reinterpret_cast<const bf16x8*>(&KVh[(k0_ + sr) * LDKV + 128 + sc]); sr_[i].vs1 = *reinterpret_cast<const bf16x8*>(&KVh[(k0_ + 32 + sr) * LDKV + 128 + sc]); \
    sr_[i].ks0 = *reinterpret_cast<const bf16x8*>(&KVh[(k0_ + sr) * LDKV + sc]); sr_[i].ks1 = *reinterpret_cast<const bf16x8*>(&KVh[(k0_ + 32 + sr) * LDKV + sc]); \
    sr_[i].kp = *reinterpret_cast<const bf16x8*>(&KPE[(k0_ + pr) * 64 + pc]); } while (0)
#define SWRITE(b, i) do { *(bf16x8*)(V_lds + (b) * SHM_V + vst0) = sr_[i].vs0;          \
    *(bf16x8*)(V_lds + (b) * SHM_V + vst1) = sr_[i].vs1; int kc = sc * 2;               \
    *(bf16x8*)(K_lds + (b) * SHM_K + KSWZ(sr, kc)) = sr_[i].ks0;                       \
    *(bf16x8*)(K_lds + (b) * SHM_K + KSWZ(32 + sr, kc)) = sr_[i].ks1;                  \
    *(bf16x8*)(P_lds + (b) * SHM_KP + KPSWZ(pr, pc * 2)) = sr_[i].kp; } while (0)
#define SWAIT() do { if constexpr (SDEPTH == 2) asm volatile("s_waitcnt vmcnt(5)" ::: "memory"); else asm volatile("s_waitcnt vmcnt(0)" ::: "memory"); } while (0)
#define RESC(a) do { if (__any((a) < 1.f)) { if (hi == 0) al_l[r32] = (a); asm volatile("s_waitcnt lgkmcnt(0)" ::: "memory"); \
    for (int d = 0; d < 4; ++d) for (int r = 0; r < 16; ++r) o[d][r] *= al_l[crow(r, hi)]; } } while (0)
  f32x16 pA0, pA1, pB0, pB1; float mnA, mnB, alA, alB; bf16x8 pa0, pa1, pa2, pa3;
  constexpr int SE = 0, SO = SDEPTH - 1;
  SLOAD(SE, 0); asm volatile("s_waitcnt vmcnt(0)" ::: "memory"); SWRITE(0, SE); __syncthreads();
  qkt(pA0, pA1, K_lds, P_lds, qr, Q_lds, qrow, r32, hi); partialSM(pA0, pA1, m_reg, mnA, alA);
  SLOAD(SO, 1); if constexpr (SDEPTH == 2) { if (2 < NT) SLOAD(SE, 2); }
  SWAIT(); SWRITE(1, SO); __syncthreads();
  for (int j = 1; j + 1 < NT; j += 2) {
    SBAR(); qkt(pB0, pB1, K_lds + SHM_K, P_lds + SHM_KP, qr, Q_lds, qrow, r32, hi);
    finishSM(pA0, pA1, alA, l_reg, pa0, pa1, pa2, pa3); SBAR();
    SLOAD(SO, j + SDEPTH); SBAR();
    pv_d0(o, vb0, pa0, pa1, pa2, pa3); partialSM(pB0, pB1, m_reg, mnB, alB);
    __syncthreads(); SWAIT(); SWRITE(0, SE);
    RESC(alB); __syncthreads();
    SBAR(); qkt(pA0, pA1, K_lds, P_lds, qr, Q_lds, qrow, r32, hi);
    finishSM(pB0, pB1, alB, l_reg, pa0, pa1, pa2, pa3); SBAR();
    if (SDEPTH == 1 || j + 3 < NT) SLOAD(SE, j + 1 + SDEPTH); SBAR();
    pv_d0(o, vb0 + (int)SHM_V, pa0, pa1, pa2, pa3); partialSM(pA0, pA1, m_reg, mnA, alA);
    __syncthreads(); SWAIT(); SWRITE(1, SO);
    RESC(alA); __syncthreads();
  }
  SBAR(); qkt(pB0, pB1, K_lds + SHM_K, P_lds + SHM_KP, qr, Q_lds, qrow, r32, hi);
  finishSM(pA0, pA1, alA, l_reg, pa0, pa1, pa2, pa3); SBAR();
  pv_d0(o, vb0, pa0, pa1, pa2, pa3); partialSM(pB0, pB1, m_reg, mnB, alB);
  __syncthreads(); RESC(alB);
  finishSM(pB0, pB1, alB, l_reg, pa0, pa1, pa2, pa3); SBAR();
  pv_d0(o, vb0 + (int)SHM_V, pa0, pa1, pa2, pa3);
  if (hi == 0) li_l[r32] = l_reg; asm volatile("s_waitcnt lgkmcnt(0)" ::: "memory");
  float rli[16];
#pragma unroll
  for (int r = 0; r < 16; ++r) rli[r] = __builtin_amdgcn_rcpf(li_l[crow(r, hi)]);
  bf16_t* Ow = Ob + (long)(wid * QBLK) * LDO;
#pragma unroll
  for (int r = 0; r < 16; ++r) { int orow = crow(r, hi);
    for (int d0 = 0; d0 < 4; ++d0) Ow[(long)orow * LDO + d0 * 32 + r32] = (bf16_t)f2bf(o[d0][r] * rli[r]); }
  __syncthreads();
#undef KROW
#undef SLOAD
#undef SWRITE
#undef SWAIT
#undef RESC
}
}

__device__ __forceinline__ void phase_attn(Frame& F) {
    const bf16_t* Q = WSP(bf16_t, WS_Q); const bf16_t* KV = WSP(bf16_t, WS_KV); const bf16_t* KPE = WSP(bf16_t, WS_KPE); bf16_t* YA = WSP(bf16_t, WS_Y);
    constexpr int NU = NBATCH * NH_MLA * 32 + NBATCH * NH_MLA;
    for (int u = F.bid; u < NU; u += F.G) {
        int b, h, row0, NT;
        if (u < NBATCH * NH_MLA * 32) { const int bh = u >> 5, qb = u & 31; b = bh >> 3; h = bh & 7; row0 = TC + b * SEQ + qb * 256; NT = 4 + SEQ / 64; }
        else { const int bh = u - NBATCH * NH_MLA * 32; b = bh >> 3; h = bh & 7; row0 = b * CTX; NT = 4; }
        att::attn_unit(Q + (size_t)row0 * 1536 + h * 192, KV + h * 256, KPE, YA + (size_t)row0 * 1024 + h * 128, b * CTX, TC + b * SEQ, NT, (char*)F.lds);
    }
}
__device__ __forceinline__ void phase_qrope(Frame& F) {
    bf16_t* Q = WSP(bf16_t, WS_Q);
    for (int row = TC + F.gw; row < T; row += F.NGW) {
        const int t = (row - TC) & (SEQ - 1); const int p = F.lane & 31, axis = p >> 4, j = p & 15, hs = F.lane >> 5;
        const float pos = (float)(axis == 0 ? (t >> 6) : (t & 63)); const float inv = __builtin_amdgcn_exp2f(-(float)j * 0.8304820237218406f);
        const float sn = __sinf(pos * inv), cs = __cosf(pos * inv);
#pragma unroll
        for (int hh = 0; hh < 4; ++hh) { const int h = hh * 2 + hs; bf16_t* q = Q + (size_t)row * 1536 + h * 192 + 128 + axis * 32 + j;
            const float x1 = bf2f(q[0]), x2 = bf2f(q[16]);
            q[0] = (bf16_t)f2bf(x1 * cs - x2 * sn); q[16] = (bf16_t)f2bf(x2 * cs + x1 * sn); }
    }
}

#define MFMA16(a, b, c) __builtin_amdgcn_mfma_f32_16x16x32_bf16((a), (b), (c), 0, 0, 0)
constexpr int XS_LD = 264, BC_LD = 136;
__device__ __forceinline__ float wave_incl_scan(float v, int lane) {
#pragma unroll
    for (int o = 1; o < 64; o <<= 1) { const float t = __shfl_up(v, o); if (lane >= o) v += t; }
    return v;
}
__device__ __forceinline__ void stage_tile(LAS bf16_t* dst, int ld, const bf16_t* src, int ncols, int tid) {
    const int cpr = ncols >> 3;
    for (int i = tid; i < 128 * cpr; i += NTHREADS) { const int r = i / cpr, c8 = (i % cpr) * 8; *(LAS u32x4*)(dst + r * ld + c8) = *(const u32x4*)(src + (size_t)r * P2W + c8); }
}
__device__ __forceinline__ void phase_mamba_states(Frame& F, const Args& a, int layer) {
    const bf16_t* P2 = WSP(bf16_t, WS_P2); const float* DT = WSP(float, WS_DT); bf16_t* MST = WSP(bf16_t, WS_MST); float* MCS = WSP(float, WS_MCS);
    LAS bf16_t* XSl = (LAS bf16_t*)F.lds; LAS bf16_t* Bl = (LAS bf16_t*)(F.lds + 67584); LAS float* wt = (LAS float*)(F.lds + 102400) + F.wave * 128;
    const int lane = F.lane, row = lane & 15, quad = lane >> 4;
    for (int u = F.bid; u < NCHUNK * 4; u += F.G) {
        const int chunk = u >> 2, g = (u >> 1) & 1, half = u & 1, row0 = chunk * 128;
        __syncthreads();
        stage_tile(XSl, XS_LD, P2 + (size_t)row0 * P2W + P2_XBC + (g * 8 + half * 4) * 64, 256, F.tid);
        stage_tile(Bl, BC_LD, P2 + (size_t)row0 * P2W + P2_XBC + 1024 + g * 128, 128, F.tid);
        const int hl = F.wave >> 1, d = F.wave & 1, h = g * 8 + half * 4 + hl;
        const float aa = -__expf(arg_in(a, I_SALOG)[(layer * 2 + d) * 16 + h]);
        { const float dt0 = DT[(size_t)(row0 + lane) * 32 + d * 16 + h], dt1 = DT[(size_t)(row0 + 64 + lane) * 32 + d * 16 + h];
          const float da0 = dt0 * aa, da1 = dt1 * aa;
          float c0 = wave_incl_scan(da0, lane); const float tot0 = __shfl(c0, 63); float c1 = wave_incl_scan(da1, lane) + tot0; const float tot = __shfl(c1, 63);
          if (d == 0) { wt[lane] = dt0 * __expf(tot - c0); wt[64 + lane] = dt1 * __expf(tot - c1); }
          else { wt[lane] = dt0 * __expf(c0 - da0); wt[64 + lane] = dt1 * __expf(c1 - da1); }
          if (lane == 0) MCS[(d * NCHUNK + chunk) * 16 + h] = tot; }
        __syncthreads();
        bf16_t* out = MST + ((size_t)(d * NCHUNK + chunk) * 16 + h) * 8192;
#pragma unroll 1
        for (int nh = 0; nh < 2; ++nh) {
            f32x4 acc[4][4];
#pragma unroll
            for (int i = 0; i < 4; ++i)
#pragma unroll
                for (int j = 0; j < 4; ++j) acc[i][j] = (f32x4){0.f, 0.f, 0.f, 0.f};
#pragma unroll 1
            for (int k0 = 0; k0 < 128; k0 += 32) {
                const int sb = k0 + quad * 8;
                float w8[8];
#pragma unroll
                for (int j = 0; j < 8; ++j) w8[j] = wt[sb + j];
                bf16x8 bf[4];
#pragma unroll
                for (int nt = 0; nt < 4; ++nt) {
#pragma unroll
                    for (int j = 0; j < 8; ++j) bf[nt][j] = (short)Bl[(sb + j) * BC_LD + (nh * 4 + nt) * 16 + row]; }
#pragma unroll
                for (int pt = 0; pt < 4; ++pt) { bf16x8 af;
#pragma unroll
                    for (int j = 0; j < 8; ++j) af[j] = (short)f2bf(w8[j] * bf2f(XSl[(sb + j) * XS_LD + hl * 64 + pt * 16 + row]));
#pragma unroll
                    for (int nt = 0; nt < 4; ++nt) acc[pt][nt] = MFMA16(af, bf[nt], acc[pt][nt]); }
            }
#pragma unroll
            for (int pt = 0; pt < 4; ++pt)
#pragma unroll
                for (int nt = 0; nt < 4; ++nt)
#pragma unroll
                    for (int jj = 0; jj < 4; ++jj) out[(pt * 16 + quad * 4 + jj) * 128 + (nh * 4 + nt) * 16 + row] = (bf16_t)f2bf(acc[pt][nt][jj]);
        }
    }
}
__device__ __forceinline__ void phase_mamba_scan(Frame& F) {
    bf16_t* MST = WSP(bf16_t, WS_MST); const float* MCS = WSP(float, WS_MCS);
    for (int idx = F.bid * NTHREADS + F.tid; idx < 2 * 2 * 16 * 8192; idx += F.G * NTHREADS) {
        const int e = idx & 8191, h = (idx >> 13) & 15, b = (idx >> 17) & 1, d = idx >> 18;
        float state = 0.f;
#pragma unroll 6
        for (int i = 0; i < 66; ++i) {
            int chunk; if (i < 2) chunk = 2 * b + (d == 0 ? i : 1 - i); else chunk = 4 + 64 * b + (d == 0 ? i - 2 : 65 - i);
            bf16_t* p = MST + ((size_t)(d * NCHUNK + chunk) * 16 + h) * 8192 + e;
            const float cs = bf2f(*p); const float dec = __expf(MCS[(d * NCHUNK + chunk) * 16 + h]);
            *p = (bf16_t)f2bf(state);
            state = state * dec + cs;
        }
    }
}
__device__ __forceinline__ void phase_mamba_out(Frame& F, const Args& a, int layer) {
    const bf16_t* P = WSP(bf16_t, WS_P); const bf16_t* P2 = WSP(bf16_t, WS_P2); const float* DT = WSP(float, WS_DT); const bf16_t* MST = WSP(bf16_t, WS_MST);
    bf16_t* YB = WSP(bf16_t, WS_Y) + (size_t)1 * T * 1024;
    LAS bf16_t* Cl = (LAS bf16_t*)F.lds; LAS bf16_t* Bl = (LAS bf16_t*)(F.lds + 34816); LAS bf16_t* XSl = (LAS bf16_t*)(F.lds + 69632);
    LAS float* tab = (LAS float*)(F.lds + 137216);
    const int lane = F.lane, row = lane & 15, quad = lane >> 4;
    for (int u = F.bid; u < NCHUNK * 4; u += F.G) {
        const int chunk = u >> 2, g = (u >> 1) & 1, half = u & 1, row0 = chunk * 128;
        __syncthreads();
        stage_tile(XSl, XS_LD, P2 + (size_t)row0 * P2W + P2_XBC + (g * 8 + half * 4) * 64, 256, F.tid);
        stage_tile(Bl, BC_LD, P2 + (size_t)row0 * P2W + P2_XBC + 1024 + g * 128, 128, F.tid);
        stage_tile(Cl, BC_LD, P2 + (size_t)row0 * P2W + P2_XBC + 1280 + g * 128, 128, F.tid);
        float tot1 = 0.f;
        { const int hl = F.wave >> 1, d = F.wave & 1, h = g * 8 + half * 4 + hl;
          const float aa = -__expf(arg_in(a, I_SALOG)[(layer * 2 + d) * 16 + h]);
          const float dt0 = DT[(size_t)(row0 + lane) * 32 + d * 16 + h], dt1 = DT[(size_t)(row0 + 64 + lane) * 32 + d * 16 + h];
          const float da0 = dt0 * aa, da1 = dt1 * aa;
          float c0 = wave_incl_scan(da0, lane); const float t0 = __shfl(c0, 63); float c1 = wave_incl_scan(da1, lane) + t0;
          LAS float* tb = tab + hl * 512;
          if (d == 0) { tb[lane] = c0; tb[64 + lane] = c1; tb[256 + lane] = __logf(dt0) - c0; tb[320 + lane] = __logf(dt1) - c1; }
          else { tb[128 + lane] = c0 - da0; tb[192 + lane] = c1 - da1; tb[384 + lane] = (c0 - da0) + __logf(dt0); tb[448 + lane] = (c1 - da1) + __logf(dt1); if (lane == 63) tab[2048 + hl] = c1; } }
        __syncthreads();
        { f32x4 cb[8];
#pragma unroll
          for (int st = 0; st < 8; ++st) cb[st] = (f32x4){0.f, 0.f, 0.f, 0.f};
#pragma unroll
          for (int k0 = 0; k0 < 128; k0 += 32) { const bf16x8 af = *(const LAS bf16x8*)(Cl + (F.wave * 16 + row) * BC_LD + k0 + quad * 8);
#pragma unroll
              for (int st = 0; st < 8; ++st) { const bf16x8 bfr = *(const LAS bf16x8*)(Bl + (st * 16 + row) * BC_LD + k0 + quad * 8); cb[st] = MFMA16(af, bfr, cb[st]); } }
          __syncthreads();
#pragma unroll
          for (int st = 0; st < 8; ++st)
#pragma unroll
              for (int jj = 0; jj < 4; ++jj) Bl[(F.wave * 16 + quad * 4 + jj) * BC_LD + st * 16 + row] = (bf16_t)f2bf(cb[st][jj]); }
        __syncthreads();
        const int hl = F.wave >> 1, th = F.wave & 1, h = g * 8 + half * 4 + hl;
        const LAS float* tb = tab + hl * 512; tot1 = tab[2048 + hl];
        f32x4 acc[4][4];
#pragma unroll
        for (int i = 0; i < 4; ++i)
#pragma unroll
            for (int j = 0; j < 4; ++j) acc[i][j] = (f32x4){0.f, 0.f, 0.f, 0.f};
#pragma unroll 1
        for (int k0 = 0; k0 < 128; k0 += 32) {
            const int sb = k0 + quad * 8;
            float u0s[8], u1s[8];
#pragma unroll
            for (int j = 0; j < 8; ++j) { u0s[j] = tb[256 + sb + j]; u1s[j] = tb[384 + sb + j]; }
            bf16x8 bx[4];
#pragma unroll
            for (int pt = 0; pt < 4; ++pt) {
#pragma unroll
                for (int j = 0; j < 8; ++j) bx[pt][j] = (short)XSl[(sb + j) * XS_LD + hl * 64 + pt * 16 + row]; }
#pragma unroll
            for (int tt = 0; tt < 4; ++tt) { const int t = th * 64 + tt * 16 + row; const float c0t = tb[t], e1t = tb[128 + t];
                float cbv[8]; { const u32x4 w = *(const LAS u32x4*)(Bl + t * BC_LD + sb); cbv[0] = bflo(w.x); cbv[1] = bfhi(w.x); cbv[2] = bflo(w.y); cbv[3] = bfhi(w.y); cbv[4] = bflo(w.z); cbv[5] = bfhi(w.z); cbv[6] = bflo(w.w); cbv[7] = bfhi(w.w); }
                bf16x8 af;
#pragma unroll
                for (int j = 0; j < 8; ++j) { const int s = sb + j;
                    const float f0 = s <= t ? __expf(c0t + u0s[j]) : 0.f;
                    const float f1 = s >= t ? __expf(u1s[j] - e1t) : 0.f;
                    af[j] = (short)f2bf(cbv[j] * (f0 + f1)); }
#pragma unroll
                for (int pt = 0; pt < 4; ++pt) acc[tt][pt] = MFMA16(af, bx[pt], acc[tt][pt]); }
        }
#pragma unroll 1
        for (int d = 0; d < 2; ++d) {
            const bf16_t* S = MST + ((size_t)(d * NCHUNK + chunk) * 16 + h) * 8192;
#pragma unroll 1
            for (int k0 = 0; k0 < 128; k0 += 32) {
                bf16x8 bs[4];
#pragma unroll
                for (int pt = 0; pt < 4; ++pt) bs[pt] = *(const bf16x8*)(S + (pt * 16 + row) * 128 + k0 + quad * 8);
#pragma unroll
                for (int tt = 0; tt < 4; ++tt) { const int t = th * 64 + tt * 16 + row;
                    const float sc = d == 0 ? __expf(tb[t]) : __expf(tot1 - tb[128 + t]);
                    const u32x4 cw = *(const LAS u32x4*)(Cl + t * BC_LD + k0 + quad * 8);
                    u32x4 aw; aw.x = cvt_pk_bf16(bflo(cw.x) * sc, bfhi(cw.x) * sc); aw.y = cvt_pk_bf16(bflo(cw.y) * sc, bfhi(cw.y) * sc);
                    aw.z = cvt_pk_bf16(bflo(cw.z) * sc, bfhi(cw.z) * sc); aw.w = cvt_pk_bf16(bflo(cw.w) * sc, bfhi(cw.w) * sc);
                    const bf16x8 af = __builtin_bit_cast(bf16x8, aw);
#pragma unroll
                    for (int pt = 0; pt < 4; ++pt) acc[tt][pt] = MFMA16(af, bs[pt], acc[tt][pt]); } }
        }
        const float Dh = arg_in(a, I_SD)[layer * 16 + h];
#pragma unroll
        for (int tt = 0; tt < 4; ++tt)
#pragma unroll
            for (int jj = 0; jj < 4; ++jj) { const int t = th * 64 + tt * 16 + quad * 4 + jj; const size_t r = (size_t)(row0 + t);
#pragma unroll
                for (int pt = 0; pt < 4; ++pt) { const int p = pt * 16 + row;
                    const float xs = bf2f(XSl[t * XS_LD + hl * 64 + p]); const float z = bf2f(P[r * NNG + P_Z + h * 64 + p]);
                    YB[r * 1024 + h * 64 + p] = (bf16_t)f2bf((acc[tt][pt][jj] + xs * Dh) * siluf_(z)); } }
    }
}
__device__ __forceinline__ void phase_mamba_norm(Frame& F, const Args& a, int layer) {
    bf16_t* YB = WSP(bf16_t, WS_Y) + (size_t)1 * T * 1024; const float* nw = arg_in(a, I_SNORM) + layer * 1024;
    for (int row = F.gw; row < T; row += F.NGW) {
        bf16_t* p = YB + (size_t)row * 1024 + F.lane * 16; float x[16]; { float t0[8], t1[8]; ld8bf(p, t0); ld8bf(p + 8, t1);
#pragma unroll
            for (int i = 0; i < 8; ++i) { x[i] = t0[i]; x[8 + i] = t1[i]; } }
        float s = 0.f;
#pragma unroll
        for (int i = 0; i < 16; ++i) s += x[i] * x[i];
        s = sum32(s);
        const float r = 1.f / sqrtf(s * (1.f / 512.f) + 1e-5f);
        float o0[8], o1[8];
#pragma unroll
        for (int i = 0; i < 8; ++i) { o0[i] = x[i] * r * nw[F.lane * 16 + i]; o1[i] = x[8 + i] * r * nw[F.lane * 16 + 8 + i]; }
        st8bf(p, o0); st8bf(p + 8, o1);
    }
}

__device__ __forceinline__ float dpp_f(float x, const int ctrl_sel) {
    const int xi = __builtin_bit_cast(int, x); int r;
    if (ctrl_sel == 0) r = __builtin_amdgcn_update_dpp(0, xi, 0xB1, 0xF, 0xF, false);
    else if (ctrl_sel == 1) r = __builtin_amdgcn_update_dpp(0, xi, 0x4E, 0xF, 0xF, false);
    else r = __builtin_amdgcn_update_dpp(0, xi, 0x141, 0xF, 0xF, false);
    return __builtin_bit_cast(float, r);
}
__device__ __forceinline__ float red8(float x) { x += dpp_f(x, 0); x += dpp_f(x, 1); x += dpp_f(x, 2); return x; }
__device__ __forceinline__ int rw_row(int pos, int b, int d) { return pos < CTX ? b * CTX + (d == 0 ? pos : CTX - 1 - pos) : TC + b * SEQ + (d == 0 ? pos - CTX : SEQ - 1 - (pos - CTX)); }
constexpr int RW_STEP_F = 336, RW_CH = 32, RW_CHF = RW_STEP_F * RW_CH;
__device__ __forceinline__ void phase_rwkv_scan(Frame& F, const Args& a, int layer) {
    const bf16_t* P2 = WSP(bf16_t, WS_P2); const bf16_t* EW = WSP(bf16_t, WS_EW); const bf16_t* ICLR = WSP(bf16_t, WS_ICLR); const bf16_t* KK = WSP(bf16_t, WS_KK);
    bf16_t* YRW = WSP(bf16_t, WS_YRW);
    LAS float* ring = (LAS float*)F.lds; LAS float* ybuf = (LAS float*)(F.lds + 2 * RW_CHF * 4);
    const int lane = F.lane;
    for (int u = F.bid; u < 256; u += F.G) {
        const int chain = u >> 2, rq = u & 3, d = chain >> 5, b = (chain >> 4) & 1, h = chain & 15;
        const float ka = arg_in(a, I_RKA)[layer * 1024 + h * 64 + lane];
        constexpr int NCH = (CTX + SEQ) / RW_CH;
        auto load_chunk = [&](int cidx) {
            LAS float* dst = ring + (cidx & 1) * RW_CHF;
            for (int tok = F.wave - 2; tok < RW_CH; tok += 6) { const int row = rw_row(cidx * RW_CH + tok, b, d); const size_t o = (size_t)row * 1024 + h * 64 + lane;
                const float ew = bf2f(EW[(size_t)d * T * 1024 + o]), ic = bf2f(ICLR[(size_t)d * T * 1024 + o]), kkv = bf2f(KK[o]);
                const bf16_t* p2 = P2 + (size_t)row * P2W + P2_RKV + h * 64; const float rr = bf2f(p2[lane]), kr = bf2f(p2[1024 + lane]);
                LAS float* s = dst + tok * RW_STEP_F;
                s[lane] = __expf(-ew); s[64 + lane] = kr * (1.f + (ic - 1.f) * ka); s[128 + lane] = kkv * ic; s[192 + lane] = -kkv; s[256 + lane] = rr;
                if (lane < 16) s[320 + lane] = bf2f(p2[2048 + rq * 16 + lane]); } };
        auto flush_chunk = [&](int cidx) {
            const LAS float* yb = ybuf + (cidx & 1) * (RW_CH * 16);
            for (int i = F.tid - 128; i < RW_CH * 16; i += 384) { const int tok = i >> 4, rr = i & 15; const int row = rw_row(cidx * RW_CH + tok, b, d);
                YRW[((size_t)d * T + row) * 1024 + h * 64 + rq * 16 + rr] = (bf16_t)f2bf(yb[i]); } };
        __syncthreads();
        if (F.wave >= 2) load_chunk(0);
        __syncthreads();
        float s[8] = {0.f, 0.f, 0.f, 0.f, 0.f, 0.f, 0.f, 0.f};
        const int rloc = lane >> 3, kq = lane & 7;
        for (int c = 0; c < NCH; ++c) {
            if (F.wave >= 2) { if (c + 1 < NCH) load_chunk(c + 1); if (c > 0) flush_chunk(c - 1); }
            else {
                const LAS float* base = ring + (c & 1) * RW_CHF + kq * 8; LAS float* yb = ybuf + (c & 1) * (RW_CH * 16) + F.wave * 8 + rloc;
#pragma unroll 4
                for (int t = 0; t < RW_CH; ++t) { const LAS float* sp = base + t * RW_STEP_F;
                    const f32x4 w0 = *(const LAS f32x4*)(sp), w1 = *(const LAS f32x4*)(sp + 4), k0 = *(const LAS f32x4*)(sp + 64), k1 = *(const LAS f32x4*)(sp + 68);
                    const f32x4 b0 = *(const LAS f32x4*)(sp + 128), b1 = *(const LAS f32x4*)(sp + 132), a0 = *(const LAS f32x4*)(sp + 192), a1 = *(const LAS f32x4*)(sp + 196);
                    const f32x4 r0 = *(const LAS f32x4*)(sp + 256), r1 = *(const LAS f32x4*)(sp + 260);
                    const float v1 = ring[(c & 1) * RW_CHF + t * RW_STEP_F + 320 + F.wave * 8 + rloc];
                    float sa = (s[0] * a0.x + s[1] * a0.y) + (s[2] * a0.z + s[3] * a0.w) + (s[4] * a1.x + s[5] * a1.y) + (s[6] * a1.z + s[7] * a1.w);
                    sa = red8(sa);
                    s[0] = s[0] * w0.x + sa * b0.x + v1 * k0.x; s[1] = s[1] * w0.y + sa * b0.y + v1 * k0.y; s[2] = s[2] * w0.z + sa * b0.z + v1 * k0.z; s[3] = s[3] * w0.w + sa * b0.w + v1 * k0.w;
                    s[4] = s[4] * w1.x + sa * b1.x + v1 * k1.x; s[5] = s[5] * w1.y + sa * b1.y + v1 * k1.y; s[6] = s[6] * w1.z + sa * b1.z + v1 * k1.z; s[7] = s[7] * w1.w + sa * b1.w + v1 * k1.w;
                    float y = (s[0] * r0.x + s[1] * r0.y) + (s[2] * r0.z + s[3] * r0.w) + (s[4] * r1.x + s[5] * r1.y) + (s[6] * r1.z + s[7] * r1.w);
                    y = red8(y);
                    if (kq == 0) yb[t * 16] = y; }
            }
            __syncthreads();
        }
        if (F.wave >= 2) flush_chunk(NCH - 1);
    }
}
__device__ __forceinline__ void phase_rwkv_out(Frame& F, const Args& a, int layer) {
    const bf16_t* P2 = WSP(bf16_t, WS_P2); const bf16_t* ICLR = WSP(bf16_t, WS_ICLR); const bf16_t* YRW = WSP(bf16_t, WS_YRW); const bf16_t* GG = WSP(bf16_t, WS_GG);
    bf16_t* YD = WSP(bf16_t, WS_Y) + (size_t)3 * T * 1024;
    const float* lng = arg_in(a, I_RLNG) + layer * 1024; const float* lnb = arg_in(a, I_RLNB) + layer * 1024; const float* rk = arg_in(a, I_RRK) + layer * 1024; const float* kav = arg_in(a, I_RKA) + layer * 1024;
    for (int row = F.gw; row < T; row += F.NGW) {
        const int c = F.lane * 16; const size_t o = (size_t)row * 1024 + c;
        float y[16], r[16], k[16], v[16], i0[16], i1[16], g[16];
#define LD16(dst, ptr) do { float t0_[8], t1_[8]; ld8bf((ptr), t0_); ld8bf((ptr) + 8, t1_); _Pragma("unroll") for (int i_ = 0; i_ < 8; ++i_) { dst[i_] = t0_[i_]; dst[8 + i_] = t1_[i_]; } } while (0)
        LD16(y, YRW + o); LD16(r, YRW + (size_t)T * 1024 + o);
#pragma unroll
        for (int i = 0; i < 16; ++i) y[i] += r[i];
        const bf16_t* p2 = P2 + (size_t)row * P2W + P2_RKV + c;
        LD16(r, p2); LD16(k, p2 + 1024); LD16(v, p2 + 2048); LD16(i0, ICLR + o); LD16(i1, ICLR + (size_t)T * 1024 + o); LD16(g, GG + o);
#undef LD16
        float s = 0.f, bsum = 0.f;
#pragma unroll
        for (int i = 0; i < 16; ++i) { s += y[i]; const float ka = kav[c + i]; bsum += r[i] * k[i] * rk[c + i] * ((1.f + (i0[i] - 1.f) * ka) + (1.f + (i1[i] - 1.f) * ka)); }
        s = sum4(s); bsum = sum4(bsum);
        const float mu = s * (1.f / 64.f); float q = 0.f;
#pragma unroll
        for (int i = 0; i < 16; ++i) { const float dd = y[i] - mu; q += dd * dd; }
        q = sum4(q);
        const float rstd = 1.f / sqrtf(q * (1.f / 64.f) + 64e-5f);
        float o0[8], o1[8];
#pragma unroll
        for (int i = 0; i < 8; ++i) { o0[i] = ((y[i] - mu) * rstd * lng[c + i] + lnb[c + i] + bsum * v[i]) * g[i];
            o1[i] = ((y[8 + i] - mu) * rstd * lng[c + 8 + i] + lnb[c + 8 + i] + bsum * v[8 + i]) * g[8 + i]; }
        st8bf(YD + o, o0); st8bf(YD + o + 8, o1);
    }
}

constexpr int FFT_N = 16384;
__device__ __forceinline__ int fswz(int i) { return i ^ (((i >> 5) & 3) << 2) ^ (((i >> 6) & 1) << 4); }
__device__ __forceinline__ f32x2 cmul(f32x2 a, f32x2 b) { return (f32x2){a.x * b.x - a.y * b.y, a.x * b.y + a.y * b.x}; }
template <bool INV>
__device__ __forceinline__ void fft_passes(LAS f32x2* X, int tid) {
#pragma unroll 1
    for (int st = 0; st < 7; ++st) {
        const int lq = INV ? 2 * st : 12 - 2 * st;
        const int q = 1 << lq;
        __syncthreads();
#pragma unroll 2
        for (int mm = 0; mm < 8; ++mm) { const int uu = tid + 512 * mm; const int k = uu & (q - 1), blk = uu >> lq; const int i0 = (blk << (lq + 2)) + k;
            const int p0 = fswz(i0), p1 = fswz(i0 + q), p2 = fswz(i0 + 2 * q), p3 = fswz(i0 + 3 * q);
            f32x2 a0 = X[p0], a1 = X[p1], a2 = X[p2], a3 = X[p3];
            const float fr = (float)k / (float)(4 * q);
            const float cs = __builtin_amdgcn_cosf(fr), sn = __builtin_amdgcn_sinf(fr);
            const f32x2 w1 = INV ? (f32x2){cs, sn} : (f32x2){cs, -sn}; const f32x2 w2 = cmul(w1, w1), w3 = cmul(w2, w1);
            if (!INV) {
                const f32x2 t0 = a0 + a2, t1 = a0 - a2, t2 = a1 + a3, t3 = a1 - a3;
                const f32x2 b0 = t0 + t2, b2 = t0 - t2, b1 = (f32x2){t1.x + t3.y, t1.y - t3.x}, b3 = (f32x2){t1.x - t3.y, t1.y + t3.x};
                X[p0] = b0; X[p1] = cmul(b1, w1); X[p2] = cmul(b2, w2); X[p3] = cmul(b3, w3);
            } else {
                a1 = cmul(a1, w1); a2 = cmul(a2, w2); a3 = cmul(a3, w3);
                const f32x2 u0 = a0 + a2, u1 = a0 - a2, u2 = a1 + a3, u3 = a1 - a3;
                X[p0] = u0 + u2; X[p2] = u0 - u2; X[p1] = (f32x2){u1.x - u3.y, u1.y + u3.x}; X[p3] = (f32x2){u1.x + u3.y, u1.y - u3.x};
            } }
    }
    __syncthreads();
}
__device__ __forceinline__ void phase_hyena_fft(Frame& F, const Args& a, int layer) {
    const bf16_t* FILT = WSP(bf16_t, WS_FILT); float* VT = WSP(float, WS_VT); const float* hyd = arg_in(a, I_HD) + layer * 1024;
    LAS f32x2* X = (LAS f32x2*)F.lds;
    for (int c = F.bid; c < 1024; c += F.G) {
        __syncthreads();
        const bf16_t* hf = FILT + (size_t)c * 2 * SEQ; const bf16_t* hb = hf + SEQ;
        for (int i = F.tid; i < FFT_N; i += NTHREADS) { float v; if (i < SEQ) v = bf2f(hf[i]); else if (i == SEQ) v = 0.f; else v = bf2f(hb[FFT_N - i]); X[fswz(i)] = (f32x2){v, 0.f}; }
        fft_passes<false>(X, F.tid);
        f32x2 Kh[32];
#pragma unroll
        for (int j = 0; j < 32; ++j) Kh[j] = X[fswz(F.tid + 512 * j)];
        __syncthreads();
        const float* v0 = VT + (size_t)c * 2 * SEQ; const float* v1 = v0 + SEQ;
        for (int i = F.tid; i < FFT_N; i += NTHREADS) X[fswz(i)] = i < SEQ ? (f32x2){v0[i], v1[i]} : (f32x2){0.f, 0.f};
        fft_passes<false>(X, F.tid);
#pragma unroll
        for (int j = 0; j < 32; ++j) { const int p = fswz(F.tid + 512 * j); X[p] = cmul(X[p], Kh[j]); }
        fft_passes<true>(X, F.tid);
        const float dc = hyd[c]; float* o0 = VT + (size_t)c * 2 * SEQ; float* o1 = o0 + SEQ;
        for (int i = F.tid; i < SEQ; i += NTHREADS) { const f32x2 r = X[fswz(i)]; const float x0 = o0[i], x1 = o1[i];
            o0[i] = r.x * (1.f / FFT_N) + x0 * dc; o1[i] = r.y * (1.f / FFT_N) + x1 * dc; }
    }
}
__device__ __forceinline__ void phase_hyena_out(Frame& F, const Args& a, int layer) {
    const float* VT = WSP(float, WS_VT); const bf16_t* P2 = WSP(bf16_t, WS_P2); bf16_t* YC = WSP(bf16_t, WS_Y) + (size_t)2 * T * 1024;
    LAS float* tl = (LAS float*)F.lds;
    for (int u = F.bid; u < (TL / 64) * 4; u += F.G) {
        const int tb = u >> 2, cb = u & 3; const int row0 = TC + tb * 64; const int b = (row0 - TC) >> 13, t0 = (row0 - TC) & (SEQ - 1);
        __syncthreads();
        for (int p = 0; p < 8; ++p) { const int cl = p * 32 + (F.tid >> 4), q = F.tid & 15;
            const f32x4 v = *(const f32x4*)(VT + ((size_t)(cb * 256 + cl) * 2 + b) * SEQ + t0 + 4 * q);
            tl[cl * 65 + 4 * q] = v.x; tl[cl * 65 + 4 * q + 1] = v.y; tl[cl * 65 + 4 * q + 2] = v.z; tl[cl * 65 + 4 * q + 3] = v.w; }
        __syncthreads();
        const int cl = F.tid & 255, th = F.tid >> 8;
        for (int i = 0; i < 32; ++i) { const int tl_ = th * 32 + i; const size_t row = (size_t)(row0 + tl_);
            const float x0 = bf2f(P2[row * P2W + P2_X0 + cb * 256 + cl]);
            YC[row * 1024 + cb * 256 + cl] = (bf16_t)f2bf(tl[cl * 65 + tl_] * x0); }
    }
    const float* VC = WSP(float, WS_VC); const float* FC = WSP(float, WS_FILTC); const float* hyd = arg_in(a, I_HD) + layer * 1024;
    for (int e = F.bid * NTHREADS + F.tid; e < TC * 1024; e += F.G * NTHREADS) {
        const int row = e >> 10, c = e & 1023, b = row >> 8, t = row & 255; const float* vb = VC + (size_t)b * CTX * 1024 + c; float acc = 0.f;
        for (int s = 0; s <= t; ++s) acc += FC[(size_t)(t - s) * 2048 + c] * vb[(size_t)s * 1024];
        for (int s = t + 1; s < CTX; ++s) acc += FC[(size_t)(s - t) * 2048 + 1024 + c] * vb[(size_t)s * 1024];
        const float x0 = bf2f(P2[(size_t)row * P2W + P2_X0 + c]);
        YC[(size_t)row * 1024 + c] = (bf16_t)f2bf((acc + vb[(size_t)t * 1024] * hyd[c]) * x0);
    }
}

__device__ __forceinline__ void phase_ln1(Frame& F, const Args& a, int layer) {
    const float* mod = (const float*)(F.ws + WS_CTL) + CW_MOD + (size_t)layer * 3 * 6 * DM;
    const float* YM = WSP(float, WS_YMIX); float* XS = WSP(float, WS_XS); bf16_t* H2 = WSP(bf16_t, WS_H2); float* AFF = WSP(float, WS_AFF); int* INV = WSP(int, WS_INV);
    const float* g1w = arg_in(a, I_LN1G) + layer * DM; const float* b1w = arg_in(a, I_LN1B) + layer * DM; const float* wr = arg_in(a, I_WROUTER) + (size_t)layer * DM * NEXP;
    LAS float* wrT = (LAS float*)F.lds;
    __syncthreads();
    for (int i = F.tid; i < DM * NEXP; i += NTHREADS) { const int c = i >> 4, e = i & 15; wrT[e * DM + c] = wr[i]; }
    __syncthreads();
    int* PTOK = WSP(int, WS_PTOK); float* PG = WSP(float, WS_PGATE);
    for (int i = F.bid * NTHREADS + F.tid; i < NPAIR; i += F.G * NTHREADS) { PTOK[i] = -1; PG[i] = 0.f; }
    for (int row = F.gw; row < T; row += F.NGW) {
        const f32x4* xr = (const f32x4*)x_src_row(a, F, layer, row) + F.lane; const f32x4* yr = (const f32x4*)(YM + (size_t)row * DM) + F.lane;
        const float* m = mod + (size_t)row_modidx(row) * 6 * DM;
        f32x4 v[8];
#pragma unroll
        for (int j = 0; j < 8; ++j) { const int c = 4 * (64 * j + F.lane); v[j] = xr[64 * j] * ALPHA + *(const f32x4*)(m + 2 * DM + c) * yr[64 * j]; }
        float mean, rstd; row_stats(v, mean, rstd, 1e-6f);
        f32x4* xo = (f32x4*)(XS + (size_t)row * DM) + F.lane;
#pragma unroll
        for (int j = 0; j < 8; ++j) { const int c = 4 * (64 * j + F.lane); v[j] = (v[j] - mean) * rstd * *(const f32x4*)(g1w + c) + *(const f32x4*)(b1w + c); xo[64 * j] = v[j]; }
        row_stats(v, mean, rstd, 1e-6f);
        u32x2* ho = (u32x2*)(H2 + (size_t)row * DM) + F.lane;
        float lg[16];
#pragma unroll
        for (int e = 0; e < 16; ++e) lg[e] = 0.f;
#pragma unroll
        for (int j = 0; j < 8; ++j) { const int c = 4 * (64 * j + F.lane);
            const f32x4 y = (v[j] - mean) * rstd * (*(const f32x4*)(m + 4 * DM + c) + 1.f) + *(const f32x4*)(m + 3 * DM + c);
            u32x2 w; w.x = pk2(y.x, y.y); w.y = pk2(y.z, y.w); ho[64 * j] = w;
#pragma unroll
            for (int e = 0; e < 16; ++e) { const f32x4 ww = *(const LAS f32x4*)(wrT + e * DM + c); lg[e] += (y.x * ww.x + y.y * ww.y) + (y.z * ww.z + y.w * ww.w); } }
        float mx = -1e30f;
#pragma unroll
        for (int e = 0; e < 16; ++e) { lg[e] = wave_sum(lg[e]); mx = fmaxf(mx, lg[e]); }
        float den = 0.f;
#pragma unroll
        for (int e = 0; e < 16; ++e) { lg[e] = __expf(lg[e] - mx); den += lg[e]; }
        float mine = 0.f;
#pragma unroll
        for (int e = 0; e < 16; ++e) mine = (F.lane == e) ? lg[e] : mine;
        if (F.lane < 16) { AFF[(size_t)row * 16 + F.lane] = mine / den; INV[(size_t)row * 16 + F.lane] = -1; }
    }
}
__device__ __forceinline__ void phase_topk(Frame& F) {
    const float* AFF = WSP(float, WS_AFF); int* INV = WSP(int, WS_INV); int* PTOK = WSP(int, WS_PTOK); float* PG = WSP(float, WS_PGATE);
    LAS unsigned* vals = (LAS unsigned*)F.lds; LAS unsigned* hist = vals + 8192; LAS unsigned* ctl = hist + 256;
    for (int u = F.bid; u < 64; u += F.G) {
        const int s = u >> 4, e = u & 15, rs = seg_start(s), n = seg_len(s), cap = s < 2 ? CAP_C : CAP_L;
        __syncthreads();
        for (int i = F.tid; i < n; i += NTHREADS) vals[i] = __builtin_bit_cast(unsigned, AFF[(size_t)(rs + i) * 16 + e]);
        if (F.tid == 0) { ctl[0] = 0u; ctl[1] = (unsigned)cap; ctl[2] = 0u; ctl[3] = 0u; }
        unsigned mask = 0u;
        for (int shift = 24; shift >= 0; shift -= 8) {
            if (F.tid < 256) hist[F.tid] = 0u;
            __syncthreads();
            const unsigned prefix = ctl[0];
            for (int i = F.tid; i < n; i += NTHREADS) { const unsigned b = vals[i]; if ((b & mask) == prefix) __hip_atomic_fetch_add(&hist[(b >> shift) & 255u], 1u, __ATOMIC_RELAXED, __HIP_MEMORY_SCOPE_WORKGROUP); }
            __syncthreads();
            if (F.tid == 0) { unsigned rem = ctl[1], cum = 0u; int dg = 255; for (; dg > 0; --dg) { const unsigned hc = hist[dg]; if (cum + hc >= rem) break; cum += hc; }
                ctl[1] = rem - cum; ctl[0] = prefix | ((unsigned)dg << shift); }
            mask |= 255u << shift;
            __syncthreads();
        }
        const unsigned thr = ctl[0], rem = ctl[1]; const unsigned ngt = (unsigned)cap - rem;
        const int pbase = s < 2 ? NBATCH * NEXP * CAP_L + e * 256 + s * CAP_C : ((s - 2) * NEXP + e) * CAP_L;
        for (int i = F.tid; i < n; i += NTHREADS) { const unsigned b = vals[i]; int slot = -1;
            if (b > thr) slot = (int)__hip_atomic_fetch_add(&ctl[2], 1u, __ATOMIC_RELAXED, __HIP_MEMORY_SCOPE_WORKGROUP);
            else if (b == thr) { const unsigned q = __hip_atomic_fetch_add(&ctl[3], 1u, __ATOMIC_RELAXED, __HIP_MEMORY_SCOPE_WORKGROUP); if (q < rem) slot = (int)(ngt + q); }
            if (slot >= 0) { const int pair = pbase + slot, row = rs + i; PTOK[pair] = row; PG[pair] = __builtin_bit_cast(float, b); INV[(size_t)row * 16 + e] = pair; } }
    }
}
__device__ __forceinline__ void phase_gather(Frame& F) {
    const bf16_t* H2 = WSP(bf16_t, WS_H2); bf16_t* XG = WSP(bf16_t, WS_XG); const int* PTOK = WSP(int, WS_PTOK);
    for (int p = F.gw; p < NPAIR; p += F.NGW) { const int tok = PTOK[p]; u32x4* dst = (u32x4*)(XG + (size_t)p * DM) + F.lane;
        if (tok >= 0) { const u32x4* src = (const u32x4*)(H2 + (size_t)tok * DM) + F.lane;
#pragma unroll
            for (int j = 0; j < 4; ++j) dst[64 * j] = src[64 * j]; }
        else {
#pragma unroll
            for (int j = 0; j < 4; ++j) { unsigned zz = 0u; asm volatile("" : "+v"(zz)); dst[64 * j] = (u32x4){zz, zz, zz, zz}; } } }
}
__device__ __forceinline__ void phase_ln2(Frame& F, const Args& a, int layer) {
    const float* mod = (const float*)(F.ws + WS_CTL) + CW_MOD + (size_t)layer * 3 * 6 * DM;
    float* XS = WSP(float, WS_XS); const bf16_t* YE = WSP(bf16_t, WS_YE); const int* INV = WSP(int, WS_INV);
    const float* g2w = arg_in(a, I_LN2G) + layer * DM; const float* b2w = arg_in(a, I_LN2B) + layer * DM;
    for (int row = F.gw; row < T; row += F.NGW) {
        f32x4* xr = (f32x4*)(XS + (size_t)row * DM) + F.lane; const float* m = mod + (size_t)row_modidx(row) * 6 * DM;
        f32x4 mo[8];
#pragma unroll
        for (int j = 0; j < 8; ++j) mo[j] = (f32x4){0.f, 0.f, 0.f, 0.f};
        for (int e = 0; e < 16; ++e) { const int pair = INV[(size_t)row * 16 + e];
            if (pair >= 0) { const u32x2* yr = (const u32x2*)(YE + (size_t)pair * DM) + F.lane;
#pragma unroll
                for (int j = 0; j < 8; ++j) { const u32x2 w = yr[64 * j]; mo[j] += (f32x4){bflo(w.x), bfhi(w.x), bflo(w.y), bfhi(w.y)}; } } }
        f32x4 v[8];
#pragma unroll
        for (int j = 0; j < 8; ++j) { const int c = 4 * (64 * j + F.lane); v[j] = xr[64 * j] * ALPHA + *(const f32x4*)(m + 5 * DM + c) * mo[j]; }
        float mean, rstd; row_stats(v, mean, rstd, 1e-6f);
#pragma unroll
        for (int j = 0; j < 8; ++j) { const int c = 4 * (64 * j + F.lane); v[j] = (v[j] - mean) * rstd * *(const f32x4*)(g2w + c) + *(const f32x4*)(b2w + c); xr[64 * j] = v[j]; }
        if (layer == DEPTH - 1 && row >= TC) { f32x4* o = (f32x4*)(a.out + (size_t)(row - TC) * DM) + F.lane;
#pragma unroll
            for (int j = 0; j < 8; ++j) o[64 * j] = v[j]; }
    }
}

constexpr int LDS_BYTES = 153600, MISC_OFF = LDS_BYTES - 64;
constexpr int NPL = 16, NPHASE = 1 + DEPTH * NPL;

__global__ void __launch_bounds__(NTHREADS, 2) fwd_kernel(Args args) {
    extern __shared__ __attribute__((aligned(16))) unsigned char lds_raw[];
    Frame F;
    F.lds = (LAS unsigned char*)lds_raw;
    F.tid = threadIdx.x; F.lane = F.tid & 63; F.wave = __builtin_amdgcn_readfirstlane(F.tid >> 6);
    F.G = gridDim.x; F.bid = blockIdx.x; F.gw = F.bid * NWAVES + F.wave; F.NGW = F.G * NWAVES; F.ws = args.ws;
    volatile LAS unsigned* misc = (volatile LAS unsigned*)(F.lds + MISC_OFF);
    if (F.tid < 16) misc[F.tid] = 0u;
    __syncthreads();
    const int lo = args.ph_lo, hi = args.ph_hi;
    XcdBarrier bar; bar.bar = (unsigned*)(F.ws + WS_CTL) + CW_BAR; bar.x = 0; bar.st = nullptr;
    const bool multi = (hi - lo) > 1;
    if (multi) bar = xcd_barrier_post((unsigned*)(F.ws + WS_CTL) + CW_BAR, misc);
#ifndef ONLY_PHASE
#define ONLY_PHASE -1
#endif
#define PON(r) (ONLY_PHASE < 0 || ONLY_PHASE == (r))
#define IN(k) (lo <= (k) && (k) < hi)
#define SEAM(k) do { if (IN(k) && IN((k) + 1)) { XcdBarrier bb_ = bar; bb_.x = (unsigned)opqs((int)bar.x); xcd_barrier(bb_); } } while (0)
    if (PON(100) && IN(0)) { F.ws = opq(args.ws); F.tid = opqv(threadIdx.x); F.lane = F.tid & 63; F.G = opqs(gridDim.x); F.bid = opqs(blockIdx.x); F.wave = __builtin_amdgcn_readfirstlane(F.tid >> 6); F.gw = F.bid * NWAVES + F.wave; F.NGW = F.G * NWAVES; p0_weights(F, args); p0_mod(F, args); __syncthreads(); }
    SEAM(0);
#pragma unroll 1
    for (int layer = 0; layer < DEPTH; ++layer) {
        const int pb = 1 + layer * NPL;
        if (PON(0) && IN(pb + 0)) { F.ws = opq(args.ws); F.tid = opqv(threadIdx.x); F.lane = F.tid & 63; F.G = opqs(gridDim.x); F.bid = opqs(blockIdx.x); F.wave = __builtin_amdgcn_readfirstlane(F.tid >> 6); F.gw = F.bid * NWAVES + F.wave; F.NGW = F.G * NWAVES; phase_modln(F, args, layer); phase_hdn(F, args, layer); __syncthreads(); }
        SEAM(pb + 0);
        if (PON(1) && IN(pb + 1)) { F.ws = opq(args.ws); F.tid = opqv(threadIdx.x); F.lane = F.tid & 63; F.G = opqs(gridDim.x); F.bid = opqs(blockIdx.x); F.wave = __builtin_amdgcn_readfirstlane(F.tid >> 6); F.gw = F.bid * NWAVES + F.wave; F.NGW = F.G * NWAVES;
            pg8::Gemm g{WSP(bf16_t, WS_H), WSP(bf16_t, WS_WIN + layer * SZ_WIN), DM, DM, DM}; pg8::StaticOrder S; S.init(66, NNG / 256, F.G, F.bid);
            EpiBf16 E{WSP(bf16_t, WS_P), NNG, nullptr, 0, 0};
            pg8::gemm_phase(F.lds, g, S, E);
        }
        SEAM(pb + 1);
        if (PON(2) && IN(pb + 2)) { F.ws = opq(args.ws); F.tid = opqv(threadIdx.x); F.lane = F.tid & 63; F.G = opqs(gridDim.x); F.bid = opqs(blockIdx.x); F.wave = __builtin_amdgcn_readfirstlane(F.tid >> 6); F.gw = F.bid * NWAVES + F.wave; F.NGW = F.G * NWAVES; phase_prep(F, args, layer); phase_filt(F, args, layer); __syncthreads(); }
        SEAM(pb + 2);
        if (PON(3) && IN(pb + 3)) { F.ws = opq(args.ws); F.tid = opqv(threadIdx.x); F.lane = F.tid & 63; F.G = opqs(gridDim.x); F.bid = opqs(blockIdx.x); F.wave = __builtin_amdgcn_readfirstlane(F.tid >> 6); F.gw = F.bid * NWAVES + F.wave; F.NGW = F.G * NWAVES;
#if !defined(T3) || T3 == 0
            { pg8::Gemm g{WSP(bf16_t, WS_P) + P_CQ, WSP(bf16_t, WS_WQ + layer * SZ_WQ), NNG, 512, 512}; pg8::StaticOrder S; S.init(66, 6, F.G, F.bid);
              EpiBf16 E{WSP(bf16_t, WS_Q), 1536, WSP(float, WS_RS), 2, 0}; pg8::gemm_phase(F.lds, g, S, E); }
#endif
#if !defined(T3) || T3 == 1
            { pg8::Gemm g{WSP(bf16_t, WS_P) + P_CKV, WSP(bf16_t, WS_WKV + layer * SZ_WKV), NNG, 512, 512}; pg8::StaticOrder S; S.init(66, 8, F.G, F.bid);
              EpiBf16 E{WSP(bf16_t, WS_KV), 2048, WSP(float, WS_RS) + 1, 2, 0}; pg8::gemm_phase(F.lds, g, S, E); }
#endif
#if !defined(T3) || T3 == 2
            { pg8::Gemm g{WSP(bf16_t, WS_ALORA), WSP(bf16_t, WS_WLORA + layer * SZ_WLORA), 512, 512, 512}; pg8::StaticOrder S; S.init(66, 20, F.G, F.bid);
              EpiLora E{WSP(bf16_t, WS_EW), WSP(bf16_t, WS_ICLR), WSP(bf16_t, WS_GG), arg_in(args, I_RW0) + layer * 2048, arg_in(args, I_RA0) + layer * 2048}; pg8::gemm_phase(F.lds, g, S, E); }
#endif
        }
        SEAM(pb + 3);
        if (PON(4) && IN(pb + 4)) { F.ws = opq(args.ws); F.tid = opqv(threadIdx.x); F.lane = F.tid & 63; F.G = opqs(gridDim.x); F.bid = opqs(blockIdx.x); F.wave = __builtin_amdgcn_readfirstlane(F.tid >> 6); F.gw = F.bid * NWAVES + F.wave; F.NGW = F.G * NWAVES; phase_qrope(F); phase_mamba_states(F, args, layer); __syncthreads(); }
        SEAM(pb + 4);
        if (PON(5) && IN(pb + 5)) { F.ws = opq(args.ws); F.tid = opqv(threadIdx.x); F.lane = F.tid & 63; F.G = opqs(gridDim.x); F.bid = opqs(blockIdx.x); F.wave = __builtin_amdgcn_readfirstlane(F.tid >> 6); F.gw = F.bid * NWAVES + F.wave; F.NGW = F.G * NWAVES;
#if !defined(T5) || T5 == 0
            phase_rwkv_scan(F, args, layer); __syncthreads();
#endif
#if !defined(T5) || T5 == 1
            phase_attn(F);
#endif
#if !defined(T5) || T5 == 2
            phase_hyena_fft(F, args, layer);
#endif
#if !defined(T5) || T5 == 3
            phase_mamba_scan(F); __syncthreads();
#endif
        }
        SEAM(pb + 5);
        if (PON(6) && IN(pb + 6)) { F.ws = opq(args.ws); F.tid = opqv(threadIdx.x); F.lane = F.tid & 63; F.G = opqs(gridDim.x); F.bid = opqs(blockIdx.x); F.wave = __builtin_amdgcn_readfirstlane(F.tid >> 6); F.gw = F.bid * NWAVES + F.wave; F.NGW = F.G * NWAVES;
#if !defined(T6) || T6 == 0
            phase_mamba_out(F, args, layer); __syncthreads();
#endif
#if !defined(T6) || T6 == 1
            phase_hyena_out(F, args, layer);
#endif
#if !defined(T6) || T6 == 2
            phase_rwkv_out(F, args, layer); __syncthreads();
#endif
        }
        SEAM(pb + 6);
        if (PON(7) && IN(pb + 7)) { F.ws = opq(args.ws); F.tid = opqv(threadIdx.x); F.lane = F.tid & 63; F.G = opqs(gridDim.x); F.bid = opqs(blockIdx.x); F.wave = __builtin_amdgcn_readfirstlane(F.tid >> 6); F.gw = F.bid * NWAVES + F.wave; F.NGW = F.G * NWAVES;
            pg8::Gemm g{WSP(bf16_t, WS_H), WSP(bf16_t, WS_WIN + layer * SZ_WIN) + (size_t)NNG * DM, DM, DM, DM}; pg8::StaticOrder S; S.init(66, NGATE / 256, F.G, F.bid);
            EpiBf16 E{WSP(bf16_t, WS_GATES), NGATE, nullptr, 0, 1};
            pg8::gemm_phase(F.lds, g, S, E);
            phase_mamba_norm(F, args, layer);
        }
        SEAM(pb + 7);
        if (PON(8) && IN(pb + 8)) { F.ws = opq(args.ws); F.tid = opqv(threadIdx.x); F.lane = F.tid & 63; F.G = opqs(gridDim.x); F.bid = opqs(blockIdx.x); F.wave = __builtin_amdgcn_readfirstlane(F.tid >> 6); F.gw = F.bid * NWAVES + F.wave; F.NGW = F.G * NWAVES;
            pg8::Gemm g{WSP(bf16_t, WS_Y), WSP(bf16_t, WS_WBR + layer * SZ_WBR), 1024, 1024, 1024}; OrderMerge S; S.init(F.G, F.bid);
            EpiMerge E{WSP(bf16_t, WS_GATES), WSP(float, WS_MRGF), WSP(bf16_t, WS_MRGB)};
            pg8::gemm_phase(F.lds, g, S, E);
        }
        SEAM(pb + 8);
        if (PON(9) && IN(pb + 9)) { F.ws = opq(args.ws); F.tid = opqv(threadIdx.x); F.lane = F.tid & 63; F.G = opqs(gridDim.x); F.bid = opqs(blockIdx.x); F.wave = __builtin_amdgcn_readfirstlane(F.tid >> 6); F.gw = F.bid * NWAVES + F.wave; F.NGW = F.G * NWAVES;
            pg8::Gemm g{WSP(bf16_t, WS_MRGB), WSP(bf16_t, WS_WOUT + layer * SZ_WOUT), DM, DM, DM}; pg8::StaticOrder S; S.init(66, 8, F.G, F.bid);
            EpiF32 E{WSP(float, WS_YMIX), DM};
            pg8::gemm_phase(F.lds, g, S, E);
        }
        SEAM(pb + 9);
        if (PON(10) && IN(pb + 10)) { F.ws = opq(args.ws); F.tid = opqv(threadIdx.x); F.lane = F.tid & 63; F.G = opqs(gridDim.x); F.bid = opqs(blockIdx.x); F.wave = __builtin_amdgcn_readfirstlane(F.tid >> 6); F.gw = F.bid * NWAVES + F.wave; F.NGW = F.G * NWAVES; phase_ln1(F, args, layer); __syncthreads(); conv_experts(F, args, layer); __syncthreads(); }
        SEAM(pb + 10);
        if (PON(11) && IN(pb + 11)) { F.ws = opq(args.ws); F.tid = opqv(threadIdx.x); F.lane = F.tid & 63; F.G = opqs(gridDim.x); F.bid = opqs(blockIdx.x); F.wave = __builtin_amdgcn_readfirstlane(F.tid >> 6); F.gw = F.bid * NWAVES + F.wave; F.NGW = F.G * NWAVES; phase_topk(F); __syncthreads(); }
        SEAM(pb + 11);
        if (PON(12) && IN(pb + 12)) { F.ws = opq(args.ws); F.tid = opqv(threadIdx.x); F.lane = F.tid & 63; F.G = opqs(gridDim.x); F.bid = opqs(blockIdx.x); F.wave = __builtin_amdgcn_readfirstlane(F.tid >> 6); F.gw = F.bid * NWAVES + F.wave; F.NGW = F.G * NWAVES; phase_gather(F); }
        SEAM(pb + 12);
        if (PON(13) && IN(pb + 13)) { F.ws = opq(args.ws); F.tid = opqv(threadIdx.x); F.lane = F.tid & 63; F.G = opqs(gridDim.x); F.bid = opqs(blockIdx.x); F.wave = __builtin_amdgcn_readfirstlane(F.tid >> 6); F.gw = F.bid * NWAVES + F.wave; F.NGW = F.G * NWAVES;
            pg8::Gemm g{WSP(bf16_t, WS_XG), WSP(bf16_t, WS_WE), DM, DM, DM}; OrderMoe S; S.init(11, F.G, F.bid);
            EpiSwiglu E{WSP(bf16_t, WS_HID)};
            pg8::gemm_phase(F.lds, g, S, E);
        }
        SEAM(pb + 13);
        if (PON(14) && IN(pb + 14)) { F.ws = opq(args.ws); F.tid = opqv(threadIdx.x); F.lane = F.tid & 63; F.G = opqs(gridDim.x); F.bid = opqs(blockIdx.x); F.wave = __builtin_amdgcn_readfirstlane(F.tid >> 6); F.gw = F.bid * NWAVES + F.wave; F.NGW = F.G * NWAVES;
            pg8::Gemm g{WSP(bf16_t, WS_HID), WSP(bf16_t, WS_WE + SZ_WGU), EFF, EFF, EFF}; OrderMoe S; S.init(8, F.G, F.bid);
            EpiDown E{WSP(bf16_t, WS_YE), WSP(float, WS_PGATE)};
            pg8::gemm_phase(F.lds, g, S, E);
        }
        SEAM(pb + 14);
        if (PON(15) && IN(pb + 15)) { F.ws = opq(args.ws); F.tid = opqv(threadIdx.x); F.lane = F.tid & 63; F.G = opqs(gridDim.x); F.bid = opqs(blockIdx.x); F.wave = __builtin_amdgcn_readfirstlane(F.tid >> 6); F.gw = F.bid * NWAVES + F.wave; F.NGW = F.G * NWAVES; phase_ln2(F, args, layer); }
        SEAM(pb + 15);
    }
#undef IN
#undef SEAM
}


#ifdef DBG_CUT
__global__ void dbg_dump(const unsigned char* ws, float* out, size_t off, int is_bf16, size_t n_src) {
    const size_t N = (size_t)TL * DM;
    for (size_t i = (size_t)blockIdx.x * blockDim.x + threadIdx.x; i < N; i += (size_t)gridDim.x * blockDim.x) {
        const size_t j = i % n_src;
        out[i] = is_bf16 ? bf2f(((const bf16_t*)(ws + off))[j]) : ((const float*)(ws + off))[j];
    }
}
#endif

#ifdef DBG_PASSES
__global__ void dbg_chk(const unsigned char* base, size_t off, size_t nbytes, unsigned long long* slot) {
    const unsigned* p = (const unsigned*)(base + off); const size_t n = nbytes / 4; unsigned long long s = 0;
    for (size_t i = (size_t)blockIdx.x * blockDim.x + threadIdx.x; i < n; i += (size_t)gridDim.x * blockDim.x) s += p[i];
    for (int o = 32; o > 0; o >>= 1) s += __shfl_xor(s, o);
    if ((threadIdx.x & 63) == 0) atomicAdd(slot, s);
}
__global__ void dbg_report(const unsigned long long* tab, float* out, int npass) {
    int k = 0;
    for (int ph = NPHASE - 1; ph >= 0; --ph) if (tab[ph] != tab[64 + ph]) k = ph + 1;
    if (k == 0 && npass > 2) { for (int ph = NPHASE - 1; ph >= 0; --ph) if (tab[64 + ph] != tab[128 + ph]) k = 50 + ph + 1; }
    if (k == 0) return;
    const float c = sqrtf(10.f * (float)k);
    for (size_t i = (size_t)blockIdx.x * blockDim.x + threadIdx.x; i < (size_t)TL * DM; i += (size_t)gridDim.x * blockDim.x) out[i] = c;
}
struct DbgReg { size_t off, n; };
#endif
extern "C" void kernel_launch(void* const* d_in, const int* in_sizes, int n_in, void* d_out, int out_size, void* d_ws, size_t ws_size, hipStream_t stream) {
    static int grid = 0;
    if (grid == 0) {
        if (n_in != N_INPUTS || in_sizes[0] != TL * DM || out_size != TL * DM || ws_size < WS_END) {
            fprintf(stderr, "kernel_launch: shape/workspace mismatch: n_in %d in0 %d out %d ws %zu (need %zu)\n", n_in, n_in > 0 ? in_sizes[0] : -1, out_size, ws_size, (size_t)WS_END); grid = -1; return; }
        int dev = 0, cus = 0, per_cu = 0;
        if (hipGetDevice(&dev) != hipSuccess || hipDeviceGetAttribute(&cus, hipDeviceAttributeMultiprocessorCount, dev) != hipSuccess) { grid = -1; return; }
        if (hipFuncSetAttribute((const void*)fwd_kernel, hipFuncAttributeMaxDynamicSharedMemorySize, LDS_BYTES) != hipSuccess) { fprintf(stderr, "kernel_launch: hipFuncSetAttribute failed\n"); grid = -1; return; }
        if (hipOccupancyMaxActiveBlocksPerMultiprocessor(&per_cu, (const void*)fwd_kernel, NTHREADS, LDS_BYTES) != hipSuccess || per_cu < 1) { fprintf(stderr, "kernel_launch: occupancy query says %d\n", per_cu); grid = -1; (void)hipGetLastError(); return; }
        grid = cus;
    }
    if (grid < 0) return;
    (void)hipMemsetAsync((char*)d_ws + WS_CTL, 0, CTL_BYTES, stream);
    Args a{};
    for (int i = 0; i < N_INPUTS; ++i) a.in[i] = (const float*)d_in[i];
    a.out = (float*)d_out; a.ws = (unsigned char*)d_ws;
#if MK_ONE_LAUNCH
    a.ph_lo = 0; a.ph_hi = NPHASE;
    hipLaunchKernelGGL(fwd_kernel, dim3(grid), dim3(NTHREADS), LDS_BYTES, stream, a);
#else
#ifdef DBG_PASSES
    {
        unsigned long long* tab = (unsigned long long*)((char*)d_ws + 1600000);
        auto chk = [&](int pass, int ph, size_t off, size_t n) { hipLaunchKernelGGL(dbg_chk, dim3(1024), dim3(256), 0, stream, (const unsigned char*)d_ws, off, n, tab + pass * 64 + ph); };
        for (int pass = 0; pass < DBG_PASSES; ++pass) {
            if (pass > 0) (void)hipMemsetAsync((char*)d_ws + (size_t)CW_MOD * 4, 0, (size_t)DEPTH * 3 * 6 * DM * 4, stream);
            for (int ph = 0; ph < NPHASE; ++ph) {
                a.ph_lo = ph; a.ph_hi = ph + 1; hipLaunchKernelGGL(fwd_kernel, dim3(grid), dim3(NTHREADS), LDS_BYTES, stream, a);
                if (ph == 0) { chk(pass, ph, WS_WIN, WS_XS - WS_WIN); chk(pass, ph, (size_t)CW_MOD * 4, (size_t)DEPTH * 3 * 6 * DM * 4); continue; }
                const int r = (ph - 1) % NPL;
                switch (r) {
                case 0: chk(pass, ph, WS_H, SZ_H); chk(pass, ph, WS_HDN, SZ_HDN); break;
                case 1: chk(pass, ph, WS_P, SZ_P); break;
                case 2: chk(pass, ph, WS_P2, SZ_P2); chk(pass, ph, WS_KK, SZ_TK2); chk(pass, ph, WS_ALORA, WS_VT - WS_ALORA); chk(pass, ph, WS_VT, WS_HDN - WS_VT); break;
                case 3: chk(pass, ph, WS_Q, SZ_Q + SZ_KV); chk(pass, ph, WS_EW, 4 * SZ_TK2); chk(pass, ph, WS_GG, SZ_TK2); break;
                case 4: chk(pass, ph, WS_Q, SZ_Q); chk(pass, ph, WS_MST, SZ_MST + SZ_MCS); break;
                case 5: chk(pass, ph, WS_YRW, 2 * SZ_TK2); chk(pass, ph, WS_Y, SZ_Y / 4); chk(pass, ph, WS_VT, SZ_VT); chk(pass, ph, WS_MST, SZ_MST); break;
                case 6: chk(pass, ph, WS_Y + SZ_Y / 4, 3 * (SZ_Y / 4)); break;
                case 7: chk(pass, ph, WS_GATES, SZ_GATES); chk(pass, ph, WS_Y + SZ_Y / 4, SZ_Y / 4); break;
                case 8: chk(pass, ph, WS_MRGF, SZ_MRGF); chk(pass, ph, WS_MRGB, SZ_MRGB); break;
                case 9: chk(pass, ph, WS_YMIX, SZ_YMIX); break;
                case 10: chk(pass, ph, WS_XS, SZ_XS); chk(pass, ph, WS_H2, SZ_H); chk(pass, ph, WS_AFF, SZ_AFF); chk(pass, ph, WS_WE, SZ_WGU + SZ_WD); break;
                case 11: chk(pass, ph, WS_INV, SZ_INV + SZ_PTOK + SZ_PGATE); break;
                case 12: chk(pass, ph, WS_XG, SZ_XG); break;
                case 13: chk(pass, ph, WS_HID, SZ_HID); break;
                case 14: chk(pass, ph, WS_YE, SZ_YE); break;
                case 15: chk(pass, ph, WS_XS, SZ_XS); break;
                }
            }
        }
        hipLaunchKernelGGL(dbg_report, dim3(2048), dim3(256), 0, stream, (const unsigned long long*)tab, (float*)d_out, (int)DBG_PASSES);
    }
#elif defined(DBG_CUT)
    for (int ph = 0; ph < DBG_CUT; ++ph) { a.ph_lo = ph; a.ph_hi = ph + 1; hipLaunchKernelGGL(fwd_kernel, dim3(grid), dim3(NTHREADS), LDS_BYTES, stream, a); }
    hipLaunchKernelGGL(dbg_dump, dim3(2048), dim3(256), 0, stream, (const unsigned char*)d_ws, (float*)d_out, (size_t)DBG_OFF, DBG_BF16, (size_t)DBG_N);
#else
    for (int ph = 0; ph < NPHASE; ++ph) { a.ph_lo = ph; a.ph_hi = ph + 1; hipLaunchKernelGGL(fwd_kernel, dim3(grid), dim3(NTHREADS), LDS_BYTES, stream, a); }
#endif
#endif
}
```

```cpp
#include <hip/hip_runtime.h>
#include <cstdio>
#include <cstdint>

#define REP_MASK 0x0
#ifndef MK_ONE_LAUNCH
#define MK_ONE_LAUNCH 1
#endif

#define LAS __attribute__((address_space(3)))
typedef unsigned short bf16_t;
typedef short bf16x8 __attribute__((ext_vector_type(8)));
typedef float f32x4 __attribute__((ext_vector_type(4)));
typedef float f32x2 __attribute__((ext_vector_type(2)));
typedef unsigned u32x4 __attribute__((ext_vector_type(4)));
typedef unsigned u32x2 __attribute__((ext_vector_type(2)));

constexpr int DM = 2048, NBATCH = 2, SEQ = 8192, CTX = 256, DEPTH = 2;
constexpr int TC = NBATCH * CTX, TL = NBATCH * SEQ, T = TC + TL;
constexpr int NIN = 18432, NNG = 10240, NGATE = 8192;
constexpr int P_CQ = 0, P_CKV = 512, P_KPE = 1024;
constexpr int P_Z = 1088, P_XBC = 2112, P_DT = 3648;
constexpr int P_HY = 3680;
constexpr int P_RW = 6752, P_WD = 9824, P_AD = 9952, P_GD = 10080;
constexpr int NH_MLA = 8, NH_SSM = 16, NH_RW = 16;
constexpr int NEXP = 16, EFF = 1408, CAP_L = 1024, CAP_C = 32;
constexpr int NPAIR = NBATCH * NEXP * CAP_L + NEXP * 256;
constexpr float ALPHA = 1.4142135623730951f;
constexpr int NWAVES = 8, NTHREADS = 512;

__device__ __forceinline__ int seg_of(int row) { return row < 256 ? 0 : row < 512 ? 1 : row < 512 + SEQ ? 2 : 3; }
__device__ __forceinline__ int seg_start(int s) { return s == 0 ? 0 : s == 1 ? 256 : s == 2 ? 512 : 512 + SEQ; }
__device__ __forceinline__ int seg_len(int s) { return s < 2 ? CTX : SEQ; }
__device__ __forceinline__ bool row_first(int row) { return row == 0 || row == 256 || row == 512 || row == 512 + SEQ; }
__device__ __forceinline__ bool row_last(int row) { return row == 255 || row == 511 || row == 511 + SEQ || row == T - 1; }
__device__ __forceinline__ int row_modidx(int row) { return row < 512 ? 2 : (row < 512 + SEQ ? 0 : 1); }

constexpr size_t AL(size_t x) { return (x + 255) / 256 * 256; }
constexpr size_t WS_CTL = 0, CTL_BYTES = 2u << 20;
constexpr int CW_BAR = 1024;
constexpr int CW_MOD = 16384;
constexpr size_t SZ_WIN = (size_t)NIN * DM * 2, SZ_WBR = (size_t)4 * DM * 1024 * 2, SZ_WOUT = (size_t)DM * DM * 2, SZ_WQ = (size_t)1536 * 512 * 2,
                 SZ_WKV = (size_t)2048 * 512 * 2, SZ_WLORA = (size_t)5120 * 512 * 2;
constexpr size_t WS_WIN = CTL_BYTES, WS_WBR = WS_WIN + DEPTH * SZ_WIN, WS_WOUT = WS_WBR + DEPTH * SZ_WBR, WS_WQ = WS_WOUT + DEPTH * SZ_WOUT,
                 WS_WKV = WS_WQ + DEPTH * SZ_WQ, WS_WLORA = WS_WKV + DEPTH * SZ_WKV, WS_XS = WS_WLORA + DEPTH * SZ_WLORA;
constexpr size_t SZ_XS = (size_t)T * DM * 4;
constexpr size_t WS_H = WS_XS + SZ_XS, SZ_H = (size_t)T * DM * 2;
constexpr size_t WS_P = WS_H + SZ_H, SZ_P = (size_t)T * NNG * 2;
constexpr int P2W = 5632, P2_XBC = 0, P2_X0 = 1536, P2_RKV = 2560;
constexpr size_t WS_P2 = WS_P + SZ_P, SZ_P2 = (size_t)T * P2W * 2;
constexpr size_t WS_Q = WS_P2 + SZ_P2, SZ_Q = (size_t)T * 1536 * 2;
constexpr size_t WS_KV = WS_Q + SZ_Q, SZ_KV = (size_t)T * 2048 * 2;
constexpr size_t WS_EW = WS_KV + SZ_KV, SZ_TK2 = (size_t)T * 1024 * 2;
constexpr size_t WS_ICLR = WS_EW + 2 * SZ_TK2;
constexpr size_t WS_KK = WS_ICLR + 2 * SZ_TK2;
constexpr size_t WS_GG = WS_KK + SZ_TK2;
constexpr size_t WS_YRW = WS_GG + SZ_TK2;
constexpr size_t WS_ALORA = WS_YRW + 2 * SZ_TK2, SZ_ALORA = (size_t)T * 512 * 2;
constexpr size_t WS_KPE = WS_ALORA + SZ_ALORA, SZ_KPE = (size_t)T * 64 * 2;
constexpr size_t WS_RS = WS_KPE + SZ_KPE, SZ_RS = AL((size_t)T * 2 * 4);
constexpr size_t WS_DT = WS_RS + SZ_RS, SZ_DT = (size_t)T * 32 * 4;
constexpr size_t WS_VT = WS_DT + SZ_DT, SZ_VT = (size_t)1024 * 2 * SEQ * 4;
constexpr size_t WS_VC = WS_VT + SZ_VT, SZ_VC = (size_t)TC * 1024 * 4;
constexpr size_t WS_FILT = WS_VC + SZ_VC, SZ_FILT = (size_t)1024 * 2 * SEQ * 2;
constexpr size_t WS_FILTC = WS_FILT + SZ_FILT, SZ_FILTC = (size_t)CTX * 2048 * 4;
constexpr size_t WS_HDN = WS_FILTC + SZ_FILTC, SZ_HDN = (size_t)(SEQ + CTX) * 64 * 4;
constexpr int NCHUNK = T / 128;
constexpr size_t WS_MST = WS_HDN + SZ_HDN, SZ_MST = (size_t)2 * NCHUNK * 16 * 8192 * 2;
constexpr size_t WS_MCS = WS_MST + SZ_MST, SZ_MCS = (size_t)2 * NCHUNK * 16 * 4 * 2;
constexpr size_t WS_Y = WS_MCS + AL(SZ_MCS), SZ_Y = (size_t)4 * T * 1024 * 2;
constexpr size_t WS_AFF = WS_Y + SZ_Y, SZ_AFF = (size_t)T * 16 * 4;
constexpr size_t WS_INV = WS_AFF + SZ_AFF, SZ_INV = (size_t)T * 16 * 4;
constexpr size_t WS_PTOK = WS_INV + SZ_INV, SZ_PTOK = (size_t)NPAIR * 4;
constexpr size_t WS_PGATE = WS_PTOK + SZ_PTOK, SZ_PGATE = (size_t)NPAIR * 4;
constexpr size_t WS_END = WS_PGATE + SZ_PGATE;
constexpr size_t WS_GATES = WS_P, SZ_GATES = (size_t)T * NGATE * 2;
constexpr size_t WS_MRGF = WS_P2, SZ_MRGF = (size_t)T * DM * 4;
constexpr size_t WS_MRGB = WS_Q, SZ_MRGB = (size_t)T * DM * 2;
constexpr size_t WS_YMIX = WS_P, SZ_YMIX = (size_t)T * DM * 4;
constexpr size_t WS_H2 = WS_H;
constexpr size_t WS_WE = WS_P2, SZ_WGU = (size_t)NEXP * 2816 * DM * 2, SZ_WD = (size_t)NEXP * DM * EFF * 2;
constexpr size_t WS_XG = WS_P, SZ_XG = (size_t)NPAIR * DM * 2;
constexpr size_t WS_HID = WS_XG + SZ_XG, SZ_HID = (size_t)NPAIR * EFF * 2;
constexpr size_t WS_YE = WS_WE + SZ_WGU + SZ_WD, SZ_YE = (size_t)NPAIR * DM * 2;
static_assert(SZ_GATES <= SZ_P && SZ_MRGF <= SZ_P2 && SZ_MRGB <= SZ_Q + SZ_KV && SZ_YMIX <= SZ_P, "alias map 1");
static_assert(SZ_XG + SZ_HID <= SZ_P, "alias map 2");
static_assert(WS_YE + SZ_YE <= WS_VT, "alias map 3");
static_assert(WS_END < 1800000000ull, "workspace budget");

__device__ __forceinline__ unsigned f2bf(float f) { unsigned u = __builtin_bit_cast(unsigned, f); return (u + 0x7fffu + ((u >> 16) & 1u)) >> 16; }
__device__ __forceinline__ unsigned pk2(float lo, float hi) { return f2bf(lo) | (f2bf(hi) << 16); }
__device__ __forceinline__ float bf2f(unsigned short b) { return __builtin_bit_cast(float, (unsigned)b << 16); }
__device__ __forceinline__ float bflo(unsigned w) { return __builtin_bit_cast(float, w << 16); }
__device__ __forceinline__ float bfhi(unsigned w) { return __builtin_bit_cast(float, w & 0xffff0000u); }
__device__ __forceinline__ unsigned cvt_pk_bf16(float lo, float hi) { unsigned r; asm volatile("v_cvt_pk_bf16_f32 %0, %1, %2" : "=v"(r) : "v"(lo), "v"(hi)); return r; }
__device__ __forceinline__ float dppx(float x, const int sel) {
    const int xi = __builtin_bit_cast(int, x); int r;
    if (sel == 0) r = __builtin_amdgcn_update_dpp(0, xi, 0xB1, 0xF, 0xF, false);
    else if (sel == 1) r = __builtin_amdgcn_update_dpp(0, xi, 0x4E, 0xF, 0xF, false);
    else if (sel == 2) r = __builtin_amdgcn_update_dpp(0, xi, 0x141, 0xF, 0xF, false);
    else r = __builtin_amdgcn_update_dpp(0, xi, 0x140, 0xF, 0xF, false);
    return __builtin_bit_cast(float, r);
}
__device__ __forceinline__ float swz16(float x) { return __builtin_bit_cast(float, __builtin_amdgcn_ds_swizzle(__builtin_bit_cast(int, x), 0x401F)); }
__device__ __forceinline__ float sum4(float v) { v += dppx(v, 0); v += dppx(v, 1); return v; }
__device__ __forceinline__ float sum8(float v) { v = sum4(v); v += dppx(v, 2); return v; }
__device__ __forceinline__ float sum16(float v) { v = sum8(v); v += dppx(v, 3); return v; }
__device__ __forceinline__ float sum32(float v) { v = sum16(v); v += swz16(v); return v; }
__device__ __forceinline__ float wave_sum(float v) {
    v = sum32(v);
    auto rr = __builtin_amdgcn_permlane32_swap(__float_as_uint(v), __float_as_uint(v), false, false);
    return __uint_as_float(rr[0]) + __uint_as_float(rr[1]);
}
__device__ __forceinline__ float sigmoidf_(float x) { return 1.f / (1.f + __expf(-x)); }
__device__ __forceinline__ float siluf_(float x) { return x / (1.f + __expf(-x)); }
__device__ __forceinline__ float softplusf_(float x) { return x > 20.f ? x : __logf(1.f + __expf(x)); }
__device__ __forceinline__ float tanhf_(float x) { const float e = __expf(2.f * fminf(x, 15.f)); return 1.f - 2.f / (e + 1.f); }
#define LDS_WAIT() asm volatile("s_waitcnt lgkmcnt(0)" ::: "memory")
#define VM_WAIT() asm volatile("s_waitcnt vmcnt(0)" ::: "memory")

#define XB_TMO      128
#define XB_XCNT(j)  (256  + 64 * (j))
#define XB_XSUB(j)  (1280 + 64 * (j))
#define XB_XGEN(j)  (2304 + 64 * (j))
#define XB_TOP      3328
#define XB_TOPGEN   3392
#define XCD_BAR_WORDS 3456
#define XB_SPIN_CAP (1u << 18)
__device__ __forceinline__ unsigned xb_ld(unsigned* p)              { return __hip_atomic_load(p, __ATOMIC_RELAXED, __HIP_MEMORY_SCOPE_AGENT); }
__device__ __forceinline__ unsigned xb_add(unsigned* p, unsigned v) { return __hip_atomic_fetch_add(p, v, __ATOMIC_RELAXED, __HIP_MEMORY_SCOPE_AGENT); }
__device__ __forceinline__ unsigned xb_xcc_id() { return (unsigned)__builtin_amdgcn_s_getreg((3 << 11) | 20) & 0xFu; }
#define XB_SPIN(cond, bar) do { unsigned _sp = 0; while (cond) { __builtin_amdgcn_s_sleep(1); \
    if ((++_sp & 255u) == 0u) { if (xb_ld(&(bar)[XB_TMO])) break; if (_sp > XB_SPIN_CAP) { atomicAdd(&(bar)[XB_TMO], 1u); break; } } } } while (0)
struct XcdBarrier { unsigned* bar; unsigned x; volatile LAS unsigned* st; };
__device__ __forceinline__ XcdBarrier xcd_barrier_post(unsigned* bar, volatile LAS unsigned* st) {
    XcdBarrier b; b.bar = bar; b.x = xb_xcc_id(); b.st = st;
    if (threadIdx.x == 0) (void)xb_add(&bar[XB_XCNT(b.x)], 1u);
    return b;
}
__device__ __forceinline__ void xcd_barrier_complete(unsigned* bar, unsigned x, unsigned& nloc, unsigned& nx) {
    const unsigned G = gridDim.x * gridDim.y * gridDim.z;
    unsigned sum, cnt, mine, sp = 0u;
    for (;;) {
        sum = 0u; cnt = 0u; mine = 0u;
#pragma unroll
        for (unsigned j = 0; j < 16; ++j) { const unsigned c = xb_ld(&bar[XB_XCNT(j)]); sum += c; cnt += (c > 0u) ? 1u : 0u; mine = (j == x) ? c : mine; }
        if (sum == G) break;
        __builtin_amdgcn_s_sleep(1);
        if ((++sp & 255u) == 0u) { if (xb_ld(&bar[XB_TMO])) break; if (sp > XB_SPIN_CAP) { atomicAdd(&bar[XB_TMO], 1u); break; } }
    }
    nloc = mine > 0u ? mine : 1u; nx = cnt > 0u ? cnt : 1u;
}
__device__ __forceinline__ void xcd_barrier(const XcdBarrier& b) {
    asm volatile("s_waitcnt vmcnt(0)" ::: "memory");
    __syncthreads();
    if (threadIdx.x == 0) {
        unsigned* bar = b.bar;
        __builtin_amdgcn_s_waitcnt(0);
        unsigned nloc = b.st[0], nx = b.st[1];
        if (nloc == 0u) { xcd_barrier_complete(bar, b.x, nloc, nx); b.st[0] = nloc; b.st[1] = nx; }
        const unsigned old = xb_add(&bar[XB_XSUB(b.x)], 1u);
        const unsigned gen = old / nloc;
        if (old + 1u == (gen + 1u) * nloc) {
            __builtin_amdgcn_fence(__ATOMIC_RELEASE, "agent");
            asm volatile("s_waitcnt vmcnt(0)" ::: "memory");
            const unsigned og = xb_add(&bar[XB_TOP], 1u);
            const unsigned tg = og / nx;
            if (og + 1u == (tg + 1u) * nx) xb_add(&bar[XB_TOPGEN], 1u);
            else XB_SPIN(xb_ld(&bar[XB_TOPGEN]) == tg, bar);
            __builtin_amdgcn_fence(__ATOMIC_ACQUIRE, "agent");
            xb_add(&bar[XB_XGEN(b.x)], 1u);
            asm volatile("s_waitcnt vmcnt(0)" ::: "memory");
        } else {
            XB_SPIN(xb_ld(&bar[XB_XGEN(b.x)]) == gen, bar);
            __builtin_amdgcn_fence(__ATOMIC_ACQUIRE, "agent");
            asm volatile("s_waitcnt vmcnt(0)" ::: "memory");
        }
    }
    __syncthreads();
}

namespace pg8 {
constexpr int BM = 256, BK = 64, HALF = 128, HTB = HALF * BK * 2, STAGE_BYTES = 8 * HTB, NXCD = 8, WGM = 8;
__host__ __device__ __forceinline__ int lds_byte(int r, int c) { const int st = (r >> 4) * 2 + (c >> 5), rr = r & 15, cc = c & 31, ob = rr * 64 + cc * 2; return st * 1024 + (ob ^ (((ob >> 9) & 1) << 5)); }
__host__ __device__ __forceinline__ void stage_rc(int b, int& R, int& C) { const int st = b / 1024, sb = b % 1024, swz = sb ^ (((sb >> 9) & 1) << 5); R = (st >> 1) * 16 + swz / 64; C = (st & 1) * 32 + (swz % 64) / 2; }
__host__ __device__ __forceinline__ int perm32(int rho) { const int n = rho >> 4, i = rho & 15; return 8 * (i >> 2) + 4 * n + (i & 3); }
struct Unit { int pm, pn; };
struct Gemm { const bf16_t* A; const bf16_t* Bt; int lda, ldb, K; };
struct StaticOrder {
    int nM, nN, nwg, G, c;
    __device__ void init(int nM_, int nN_, int G_, int c_) { nM = nM_; nN = nN_; nwg = nM * nN; G = G_; c = c_; }
    __device__ bool next(int i, Unit& u) const {
        const long L = (long)i * G + c; if (L >= nwg) return false;
        int wgid = (int)L; { const int q = nwg / NXCD, r = nwg % NXCD, xcd = wgid % NXCD, off = wgid / NXCD; wgid = (xcd < r ? xcd * (q + 1) : r * (q + 1) + (xcd - r) * q) + off; }
        const int nig = WGM * nN, gid = wgid / nig, fm = gid * WGM, gsz = (nM - fm) < WGM ? (nM - fm) : WGM;
        u.pm = fm + ((wgid % nig) % gsz); u.pn = (wgid % nig) / gsz; return true;
    }
};
template <class Epi, class Sched>
__device__ __forceinline__ void gemm_phase(LAS unsigned char* lds, const Gemm g, const Sched& S, const Epi& E) {
    constexpr bool ALIGN_EPI = true;
    int tid_ = threadIdx.x; asm volatile("" : "+v"(tid_));
    const int tid = tid_, wid = __builtin_amdgcn_readfirstlane(tid >> 6), lane = tid & 63, wr = wid >> 2, wc = wid & 3, fr = lane & 15, fq = lane >> 4;
    const int K = g.K, nt = K / BK;
    unsigned voffA[2], voffB[2];
#pragma unroll
    for (int i = 0; i < 2; ++i) { int R, C; stage_rc(tid * 16 + i * 8192, R, C); const int Rb = Epi::PERM ? ((R & ~31) + perm32(R & 31)) : R;
        voffA[i] = (unsigned)(R * g.lda + C) * 2u; voffB[i] = (unsigned)(Rb * g.ldb + C) * 2u; }
    const size_t kstep = (size_t)(BK * 2);
    const size_t hstepA = (size_t)HALF * g.lda * 2, hstepB = (size_t)HALF * g.ldb * 2;
    const size_t tstepA = 2 * hstepA, tstepB = 2 * hstepB;
    const unsigned ldsw = (unsigned)wid * 1024u;
    const int aoff = lds_byte(wr * 64 + fr, fq * 8), boff = lds_byte(wc * 32 + fr, fq * 8);
#define PG8_SA(b, h) (((b) * 2 + (h)) * HTB)
#define PG8_SB(b, h) ((4 + (b) * 2 + (h)) * HTB)
#define PG8_STAGE(bufoff, gbase, voff) do { _Pragma("unroll") for (int _i = 0; _i < 2; ++_i) \
        __builtin_amdgcn_global_load_lds((const unsigned*)((const char*)(gbase) + (voff)[_i]), (LAS unsigned*)(lds + (bufoff) + ldsw + _i * 8192), 16, 0, 0); } while (0)
#define PG8_LDA(dst, b, h) do { _Pragma("unroll") for (int m = 0; m < 4; ++m) _Pragma("unroll") for (int k = 0; k < 2; ++k) dst[m][k] = *(const LAS bf16x8*)(lds + PG8_SA(b, h) + aoff + m * 2048 + k * 1024); } while (0)
#define PG8_LDB(dst, b, h) do { _Pragma("unroll") for (int n = 0; n < 2; ++n) _Pragma("unroll") for (int k = 0; k < 2; ++k) dst[n][k] = *(const LAS bf16x8*)(lds + PG8_SB(b, h) + boff + n * 2048 + k * 1024); } while (0)
#define PG8_MMA(ai, bj, At, Bt) do { __builtin_amdgcn_s_setprio(1); _Pragma("unroll") for (int m = 0; m < 4; ++m) _Pragma("unroll") for (int n = 0; n < 2; ++n) _Pragma("unroll") for (int k = 0; k < 2; ++k) \
        acc[ai][bj][m][n] = __builtin_amdgcn_mfma_f32_16x16x32_bf16(Bt[n][k], At[m][k], acc[ai][bj][m][n], 0, 0, 0); __builtin_amdgcn_s_setprio(0); } while (0)
#define PG8_WAIT_V(n) asm volatile("s_waitcnt vmcnt(" #n ")" ::: "memory")
#define PG8_WAIT_L(n) asm volatile("s_waitcnt lgkmcnt(" #n ")" ::: "memory")
#define PG8_BAR __builtin_amdgcn_s_barrier()
#define PG8_SCHED __builtin_amdgcn_sched_barrier(0)
    Unit cur, nxt; int ui = 0;
    if (!S.next(0, cur)) return;
    f32x4 acc[2][2][4][2];
#pragma unroll
    for (int a = 0; a < 2; ++a)
#pragma unroll
        for (int b = 0; b < 2; ++b)
#pragma unroll
            for (int m = 0; m < 4; ++m)
#pragma unroll
                for (int n = 0; n < 2; ++n) acc[a][b][m][n] = (f32x4){0.f, 0.f, 0.f, 0.f};
    bf16x8 At[4][2], B0[2][2], B1[2][2];
    const char* cA = (const char*)g.A + (size_t)cur.pm * tstepA; const char* cB = (const char*)g.Bt + (size_t)cur.pn * tstepB;
    PG8_STAGE(PG8_SB(0, 0), cB, voffB); PG8_STAGE(PG8_SB(0, 1), cB + hstepB, voffB); PG8_STAGE(PG8_SA(0, 0), cA, voffA); PG8_STAGE(PG8_SA(0, 1), cA + hstepA, voffA);
    if (wr == 1) PG8_BAR;
    PG8_WAIT_V(2); PG8_BAR;
    PG8_STAGE(PG8_SB(1, 0), cB + kstep, voffB); PG8_STAGE(PG8_SA(1, 0), cA + kstep, voffA); PG8_STAGE(PG8_SB(1, 1), cB + hstepB + kstep, voffB);
    PG8_WAIT_V(6); PG8_BAR;
    for (;;) {
        const bool has_next = S.next(ui + 1, nxt);
        const char* nA = has_next ? (const char*)g.A + (size_t)nxt.pm * tstepA : cA; const char* nB = has_next ? (const char*)g.Bt + (size_t)nxt.pn * tstepB : cB;
        for (int t = 0; t < nt; t += 2) {
            const bool last = (t == nt - 2);
            const char* a1 = cA + (size_t)(t + 1) * kstep;
            const char* a2 = last ? nA : cA + (size_t)(t + 2) * kstep; const char* b2 = last ? nB : cB + (size_t)(t + 2) * kstep;
            const char* a3 = a2 + kstep; const char* b3 = b2 + kstep;
            PG8_LDB(B0, 0, 0); PG8_LDB(B1, 0, 1); PG8_SCHED; PG8_LDA(At, 0, 0); PG8_STAGE(PG8_SA(1, 1), a1 + hstepA, voffA);
            PG8_WAIT_V(8); PG8_WAIT_L(0); PG8_BAR; PG8_MMA(0, 0, At, B0); PG8_MMA(0, 1, At, B1); PG8_BAR; PG8_SCHED;
            PG8_LDA(At, 0, 1); PG8_STAGE(PG8_SB(0, 0), b2, voffB); PG8_STAGE(PG8_SB(0, 1), b2 + hstepB, voffB); PG8_STAGE(PG8_SA(0, 0), a2, voffA);
            PG8_WAIT_V(8); PG8_WAIT_L(0); PG8_BAR; PG8_MMA(1, 0, At, B0); PG8_MMA(1, 1, At, B1); PG8_BAR; PG8_SCHED;
            PG8_LDB(B0, 1, 0); PG8_LDB(B1, 1, 1); PG8_SCHED; PG8_LDA(At, 1, 0); PG8_STAGE(PG8_SA(0, 1), a2 + hstepA, voffA);
            PG8_WAIT_V(8); PG8_WAIT_L(0); PG8_BAR; PG8_MMA(0, 0, At, B0); PG8_MMA(0, 1, At, B1); PG8_BAR; PG8_SCHED;
            PG8_LDA(At, 1, 1); PG8_STAGE(PG8_SB(1, 0), b3, voffB); PG8_STAGE(PG8_SB(1, 1), b3 + hstepB, voffB); PG8_STAGE(PG8_SA(1, 0), a3, voffA);
            PG8_WAIT_V(8); PG8_WAIT_L(0); PG8_BAR; PG8_MMA(1, 0, At, B0); PG8_MMA(1, 1, At, B1); PG8_BAR; PG8_SCHED;
        }
        if constexpr (ALIGN_EPI) { if (wr == 0) PG8_BAR; }
        E(acc, cur, wr, wc, fr, fq);
        if (!has_next) break;
#pragma unroll
        for (int a = 0; a < 2; ++a)
#pragma unroll
            for (int b = 0; b < 2; ++b)
#pragma unroll
                for (int m = 0; m < 4; ++m)
#pragma unroll
                    for (int n = 0; n < 2; ++n) acc[a][b][m][n] = (f32x4){0.f, 0.f, 0.f, 0.f};
        cur = nxt; cA = nA; cB = nB; ++ui;
        if constexpr (ALIGN_EPI) { if (wr == 1) PG8_BAR; }
    }
    PG8_WAIT_V(0);
    if constexpr (!ALIGN_EPI) { if (wr == 0) PG8_BAR; }
    PG8_BAR;
#undef PG8_SA
#undef PG8_SB
#undef PG8_STAGE
#undef PG8_LDA
#undef PG8_LDB
#undef PG8_MMA
#undef PG8_WAIT_V
#undef PG8_WAIT_L
#undef PG8_BAR
#undef PG8_SCHED
}
}

enum { I_X = 0, I_C, I_CTX, I_CCTX, I_WADA, I_BADA, I_WIN, I_QNORM, I_WQUP, I_KVNORM, I_WKVUP, I_SCONVW, I_SCONVB, I_SDTB, I_SALOG, I_SD, I_SNORM,
       I_HCONVW, I_HCONVB, I_HW1, I_HB1, I_HW2, I_HB2, I_HW3, I_HFREQ, I_HD, I_RMU, I_RW0, I_RWUP, I_RA0, I_RAUP, I_RGUP, I_RKK, I_RKA, I_RRK, I_RLNG, I_RLNB,
       I_WBR, I_WOUT, I_LN1G, I_LN1B, I_WROUTER, I_WGATE, I_WUP, I_WDOWN, I_LN2G, I_LN2B, N_INPUTS };
struct Args { const float* in[N_INPUTS]; float* out; unsigned char* ws; int ph_lo, ph_hi; };
static_assert(sizeof(Args) == (N_INPUTS + 2) * 8 + 8, "Args has no padding");

__device__ __forceinline__ const float* arg_in(const Args& a, int i) { asm volatile("" : "+s"(i)); return a.in[i]; }
__device__ __forceinline__ int opqs(int v) { asm volatile("" : "+s"(v)); return v; }
__device__ __forceinline__ int opqv(int v) { asm volatile("" : "+v"(v)); return v; }
__device__ __forceinline__ unsigned char* opq(unsigned char* p) { asm volatile("" : "+s"(p)); return p; }
struct Frame {
    LAS unsigned char* lds;
    int tid, lane, wave, G, bid, gw, NGW;
    unsigned char* ws;
};
#define WSP(T_, off) ((T_*)(F.ws + (off)))

template <class RowMap>
__device__ __forceinline__ void transpose_item(const float* W, int ldw, bf16_t* WT, int ldt, int k0, int n0, const float* kscale, int koff, RowMap rm, LAS float* scr, int lane) {
#pragma unroll 8
    for (int i = 0; i < 32; ++i) { const int kk = 2 * i + (lane >> 5); float v = W[(size_t)(k0 + kk) * ldw + n0 + (lane & 31)]; if (kscale) v *= kscale[k0 + kk]; scr[kk * 33 + (lane & 31)] = v; }
    LDS_WAIT(); asm volatile("" ::: "memory");
    const int c = lane & 7;
#pragma unroll
    for (int j = 0; j < 4; ++j) { const int n = (lane >> 3) + 8 * j; const LAS float* s = scr + (8 * c) * 33 + n;
        u32x4 o; o.x = pk2(s[0 * 33], s[1 * 33]); o.y = pk2(s[2 * 33], s[3 * 33]); o.z = pk2(s[4 * 33], s[5 * 33]); o.w = pk2(s[6 * 33], s[7 * 33]);
        *(u32x4*)(WT + (size_t)rm(n0 + n) * ldt + koff + k0 + 8 * c) = o; }
    LDS_WAIT(); asm volatile("" ::: "memory");
}
struct RmId { __device__ int operator()(int n) const { return n; } };
struct RmGateUp { int up; __device__ int operator()(int n) const { return 256 * (n >> 7) + (n & 127) + (up ? 128 : 0); } };

__device__ __forceinline__ void p0_weights(Frame& F, const Args& a) {
    LAS float* scr = (LAS float*)(F.lds + F.wave * 8704);
    constexpr int IT_IN = 32 * 576, IT_BR = 16 * 64, IT_OUT = 32 * 64, IT_Q = 8 * 48, IT_KV = 8 * 64;
    constexpr int PER_L = IT_IN + 4 * IT_BR + IT_OUT + IT_Q + IT_KV;
    for (int it = F.gw; it < DEPTH * PER_L; it += F.NGW) {
        const int l = it / PER_L; int r = it % PER_L;
        if (r < IT_IN) { const int kb = r / 576, nb = r % 576;
            transpose_item(arg_in(a, I_WIN) + (size_t)l * DM * NIN, NIN, WSP(bf16_t, WS_WIN + l * SZ_WIN), DM, kb * 64, nb * 32, nullptr, 0, RmId(), scr, F.lane); continue; } r -= IT_IN;
        if (r < 4 * IT_BR) { const int br = r / IT_BR, q = r % IT_BR, kb = q / 64, nb = q % 64;
            transpose_item(arg_in(a, I_WBR) + ((size_t)l * 4 + br) * 1024 * DM, DM, WSP(bf16_t, WS_WBR + l * SZ_WBR) + (size_t)br * DM * 1024, 1024, kb * 64, nb * 32, nullptr, 0, RmId(), scr, F.lane); continue; } r -= 4 * IT_BR;
        if (r < IT_OUT) { const int kb = r / 64, nb = r % 64;
            transpose_item(arg_in(a, I_WOUT) + (size_t)l * DM * DM, DM, WSP(bf16_t, WS_WOUT + l * SZ_WOUT), DM, kb * 64, nb * 32, nullptr, 0, RmId(), scr, F.lane); continue; } r -= IT_OUT;
        if (r < IT_Q) { const int kb = r / 48, nb = r % 48;
            transpose_item(arg_in(a, I_WQUP) + (size_t)l * 512 * 1536, 1536, WSP(bf16_t, WS_WQ + l * SZ_WQ), 512, kb * 64, nb * 32, arg_in(a, I_QNORM) + l * 512, 0, RmId(), scr, F.lane); continue; } r -= IT_Q;
        { const int kb = r / 64, nb = r % 64;
            transpose_item(arg_in(a, I_WKVUP) + (size_t)l * 512 * 2048, 2048, WSP(bf16_t, WS_WKV + l * SZ_WKV), 512, kb * 64, nb * 32, arg_in(a, I_KVNORM) + l * 512, 0, RmId(), scr, F.lane); }
    }
    for (size_t e = (size_t)F.bid * NTHREADS + F.tid; e < (size_t)DEPTH * 5120 * 512; e += (size_t)F.G * NTHREADS) {
        const int l = (int)(e / (5120 * 512)); const int rem = (int)(e % (5120 * 512)); const int n = rem / 512, kc = rem % 512; const int blk = n >> 10, c = n & 1023;
        float v = 0.f;
        if (blk < 2) { if (kc >= 64 * blk && kc < 64 * blk + 64) v = arg_in(a, I_RWUP)[(((size_t)l * 2 + blk) * 64 + (kc - 64 * blk)) * 1024 + c]; }
        else if (blk < 4) { const int d = blk - 2; if (kc >= 128 + 64 * d && kc < 192 + 64 * d) v = arg_in(a, I_RAUP)[(((size_t)l * 2 + d) * 64 + (kc - 128 - 64 * d)) * 1024 + c]; }
        else { if (kc >= 256 && kc < 416) v = arg_in(a, I_RGUP)[((size_t)l * 160 + (kc - 256)) * 1024 + c]; }
        WSP(bf16_t, WS_WLORA)[e] = (bf16_t)f2bf(v);
    }
}
__device__ __forceinline__ void conv_experts(Frame& F, const Args& a, int l) {
    LAS float* scr = (LAS float*)(F.lds + F.wave * 8704);
    constexpr int IT_G = 32 * 44, IT_D = 22 * 64, PER_E = 2 * IT_G + IT_D;
    bf16_t* wgu = WSP(bf16_t, WS_WE); bf16_t* wd = WSP(bf16_t, WS_WE + SZ_WGU);
    for (int it = F.gw; it < NEXP * PER_E; it += F.NGW) {
        const int e = it / PER_E; int r = it % PER_E;
        if (r < 2 * IT_G) { const int up = r / IT_G, q = r % IT_G, kb = q / 44, nb = q % 44;
            const float* src = a.in[up ? I_WUP : I_WGATE] + ((size_t)l * NEXP + e) * DM * EFF;
            RmGateUp rm; rm.up = up;
            transpose_item(src, EFF, wgu + (size_t)e * 2816 * DM, DM, kb * 64, nb * 32, nullptr, 0, rm, scr, F.lane); continue; } r -= 2 * IT_G;
        { const int kb = r / 64, nb = r % 64;
            transpose_item(arg_in(a, I_WDOWN) + ((size_t)l * NEXP + e) * EFF * DM, DM, wd + (size_t)e * DM * EFF, EFF, kb * 64, nb * 32, nullptr, 0, RmId(), scr, F.lane); }
    }
}
__device__ __forceinline__ void p0_mod(Frame& F, const Args& a) {
    LAS float* sv = (LAS float*)(F.lds + 69632);
    for (int i = F.tid; i < 3 * DM; i += NTHREADS) { const int v = i / DM, k = i % DM; const float x = v < 2 ? arg_in(a, I_C)[v * DM + k] : arg_in(a, I_CCTX)[k]; sv[i] = siluf_(x); }
    __syncthreads();
    float* mod = (float*)(F.ws + WS_CTL) + CW_MOD;
    LAS float* red = (LAS float*)(F.lds + 69632 + 3 * DM * 4);
    for (int u = F.bid; u < DEPTH * (6 * DM / 128); u += F.G) {
        const int l = u / (6 * DM / 128), nb = u % (6 * DM / 128); const int kg = F.tid >> 7, cl = F.tid & 127, n = nb * 128 + cl;
        const float* w = arg_in(a, I_WADA) + ((size_t)l * DM + kg * 512) * (6 * DM) + n;
        float a0 = 0.f, a1 = 0.f, a2 = 0.f;
#pragma unroll 8
        for (int k = 0; k < 512; ++k) { const float wv = w[(size_t)k * (6 * DM)]; const int kk = kg * 512 + k; a0 += sv[kk] * wv; a1 += sv[DM + kk] * wv; a2 += sv[2 * DM + kk] * wv; }
        __syncthreads();
        red[(kg * 3 + 0) * 128 + cl] = a0; red[(kg * 3 + 1) * 128 + cl] = a1; red[(kg * 3 + 2) * 128 + cl] = a2;
        __syncthreads();
        if (F.tid < 384) { const int v = F.tid >> 7; const float b = arg_in(a, I_BADA)[l * 6 * DM + n];
            mod[(l * 3 + v) * 6 * DM + n] = b + ((red[(0 * 3 + v) * 128 + cl] + red[(1 * 3 + v) * 128 + cl]) + (red[(2 * 3 + v) * 128 + cl] + red[(3 * 3 + v) * 128 + cl])); }
    }
}

__device__ __forceinline__ void row_stats(const f32x4 (&v)[8], float& mean, float& rstd, float eps) {
    float s = 0.f;
#pragma unroll
    for (int j = 0; j < 8; ++j) s += (v[j].x + v[j].y) + (v[j].z + v[j].w);
    mean = wave_sum(s) * (1.f / DM);
    float s2 = 0.f;
#pragma unroll
    for (int j = 0; j < 8; ++j) { const f32x4 d = v[j] - mean; s2 += (d.x * d.x + d.y * d.y) + (d.z * d.z + d.w * d.w); }
    rstd = 1.f / sqrtf(wave_sum(s2) * (1.f / DM) + eps);
}
__device__ __forceinline__ const float* x_src_row(const Args& a, const Frame& F, int layer, int row) {
    if (layer == 0) return row < TC ? arg_in(a, I_CTX) + (size_t)row * DM : arg_in(a, I_X) + (size_t)(row - TC) * DM;
    return (const float*)(F.ws + WS_XS) + (size_t)row * DM;
}
__device__ __forceinline__ void phase_modln(Frame& F, const Args& a, int layer) {
    const float* mod = (const float*)(F.ws + WS_CTL) + CW_MOD + (size_t)layer * 3 * 6 * DM;
    bf16_t* H = WSP(bf16_t, WS_H);
    for (int row = F.gw; row < T; row += F.NGW) {
        const f32x4* xr = (const f32x4*)x_src_row(a, F, layer, row) + F.lane;
        f32x4 v[8];
#pragma unroll
        for (int j = 0; j < 8; ++j) v[j] = xr[64 * j];
        float mean, rstd; row_stats(v, mean, rstd, 1e-6f);
        const float* m = mod + (size_t)row_modidx(row) * 6 * DM;
        u32x2* o = (u32x2*)(H + (size_t)row * DM) + F.lane;
#pragma unroll
        for (int j = 0; j < 8; ++j) { const int c = 4 * (64 * j + F.lane); const f32x4 sh = *(const f32x4*)(m + c), sc = *(const f32x4*)(m + DM + c);
            const f32x4 y = (v[j] - mean) * rstd * (sc + 1.f) + sh; u32x2 w; w.x = pk2(y.x, y.y); w.y = pk2(y.z, y.w); o[64 * j] = w; }
    }
}

__device__ __forceinline__ void phase_hdn(Frame& F, const Args& a, int layer) {
    LAS float* zs = (LAS float*)(F.lds + F.wave * 512);
    const float* w1 = arg_in(a, I_HW1) + (size_t)layer * 33 * 64; const float* b1 = arg_in(a, I_HB1) + layer * 64;
    const float* w2 = arg_in(a, I_HW2) + (size_t)layer * 64 * 64; const float* b2 = arg_in(a, I_HB2) + layer * 64;
    const float fr = arg_in(a, I_HFREQ)[layer * 64 + F.lane];
    float* HDN = WSP(float, WS_HDN);
    for (int r = F.gw; r < SEQ + CTX; r += F.NGW) {
        const int n = r < SEQ ? SEQ : CTX, t = r < SEQ ? r : r - SEQ;
        const float wpos = (6.283185307179586f * (float)t) / (float)n;
        if (F.lane < 33) { float z;
            if (F.lane == 0) z = (float)t / (float)(n - 1);
            else { const int b = (F.lane - 1) & 15; const float f = 1e-4f + (float)b * ((15.f - 1e-4f) / 15.f); const float ang = f * wpos; z = F.lane <= 16 ? __cosf(ang) : -__sinf(ang); }
            zs[F.lane] = z; }
        LDS_WAIT(); asm volatile("" ::: "memory");
        float p = b1[F.lane];
#pragma unroll
        for (int i = 0; i < 33; ++i) p += zs[i] * w1[i * 64 + F.lane];
        const float h1 = __sinf(fr * p);
        zs[64 + F.lane] = h1;
        LDS_WAIT(); asm volatile("" ::: "memory");
        float q = b2[F.lane];
#pragma unroll 16
        for (int i = 0; i < 64; ++i) q += zs[64 + i] * w2[i * 64 + F.lane];
        HDN[(size_t)r * 64 + F.lane] = __sinf(fr * q);
        LDS_WAIT(); asm volatile("" ::: "memory");
    }
}
__device__ __forceinline__ float hy_delta(int c) { const float mn = -3.0701134573253943f, mx = -15.350567286626972f; return fabsf(mn + (float)c * ((mx - mn) / 1023.f)); }
__device__ __forceinline__ void phase_filt(Frame& F, const Args& a, int layer) {
    const float* w3 = arg_in(a, I_HW3) + (size_t)layer * 64 * 2048; const float* HDN = WSP(float, WS_HDN);
    LAS float* ws3 = (LAS float*)F.lds;
    bf16_t* FILT = WSP(bf16_t, WS_FILT);
    for (int u = F.bid; u < 32 * 16; u += F.G) {
        const int cb = u / 16, tb = u % 16, col0 = cb * 64, t = tb * 512 + F.tid;
        __syncthreads();
        for (int i = F.tid; i < 4096; i += NTHREADS) { const int j = i >> 6, cc = i & 63; ws3[cc * 64 + j] = w3[(size_t)j * 2048 + col0 + cc]; }
        __syncthreads();
        f32x4 h[16];
#pragma unroll
        for (int i = 0; i < 16; ++i) h[i] = *(const f32x4*)(HDN + (size_t)t * 64 + 4 * i);
        const float tn = (float)t / (float)(SEQ - 1);
        for (int cc = 0; cc < 64; ++cc) {
            float acc = 0.f;
#pragma unroll
            for (int i = 0; i < 16; ++i) { const f32x4 w = *(const LAS f32x4*)(ws3 + cc * 64 + 4 * i); acc += h[i].x * w.x + h[i].y * w.y + h[i].z * w.z + h[i].w * w.w; }
            const int col = col0 + cc, side = col >> 10, c = col & 1023;
            FILT[((size_t)c * 2 + side) * SEQ + t] = (bf16_t)f2bf(acc * __expf(-tn * hy_delta(c)));
        }
    }
    float* FILTC = WSP(float, WS_FILTC);
    for (int e = F.bid * NTHREADS + F.tid; e < CTX * 2048; e += F.G * NTHREADS) {
        const int lag = e >> 11, col = e & 2047, c = col & 1023; const float* hr = HDN + (size_t)(SEQ + lag) * 64; float acc = 0.f;
#pragma unroll 16
        for (int j = 0; j < 64; ++j) acc += hr[j] * w3[(size_t)j * 2048 + col];
        FILTC[e] = acc * __expf(-((float)lag / (float)(CTX - 1)) * hy_delta(c));
    }
}

__device__ __forceinline__ void ld8bf(const bf16_t* p, float (&o)[8]) { const u32x4 w = *(const u32x4*)p; o[0] = bflo(w.x); o[1] = bfhi(w.x); o[2] = bflo(w.y); o[3] = bfhi(w.y); o[4] = bflo(w.z); o[5] = bfhi(w.z); o[6] = bflo(w.w); o[7] = bfhi(w.w); }
__device__ __forceinline__ void st8bf(bf16_t* p, const float (&v)[8]) { u32x4 w; w.x = pk2(v[0], v[1]); w.y = pk2(v[2], v[3]); w.z = pk2(v[4], v[5]); w.w = pk2(v[6], v[7]); *(u32x4*)p = w; }
__device__ __forceinline__ void ld8f(const float* p, float (&o)[8]) { const f32x4 a = *(const f32x4*)p, b = *(const f32x4*)(p + 4); o[0] = a.x; o[1] = a.y; o[2] = a.z; o[3] = a.w; o[4] = b.x; o[5] = b.y; o[6] = b.z; o[7] = b.w; }

__device__ __forceinline__ void phase_prep(Frame& F, const Args& a, int layer) {
    const bf16_t* P = WSP(bf16_t, WS_P); bf16_t* P2 = WSP(bf16_t, WS_P2);
    float* RS = WSP(float, WS_RS); bf16_t* KPE = WSP(bf16_t, WS_KPE); float* DT = WSP(float, WS_DT);
    bf16_t* KK = WSP(bf16_t, WS_KK); bf16_t* AL_ = WSP(bf16_t, WS_ALORA); float* VC = WSP(float, WS_VC);
    const float* scw = arg_in(a, I_SCONVW) + (size_t)layer * 3 * 1536; const float* scb = arg_in(a, I_SCONVB) + layer * 1536; const float* dtb = arg_in(a, I_SDTB) + layer * 32;
    const float* hcw = arg_in(a, I_HCONVW) + (size_t)layer * 3 * 3072; const float* hcb = arg_in(a, I_HCONVB) + layer * 3072;
    const float* mu = arg_in(a, I_RMU) + (size_t)layer * 2 * 3488; const float* rkk = arg_in(a, I_RKK) + layer * 1024;
    for (int row = F.gw; row < T; row += F.NGW) {
        const bf16_t* pr = P + (size_t)row * NNG; const bool first = row_first(row), last = row_last(row);
        const bf16_t* pp = pr - NNG; const bf16_t* pn = pr + NNG;
        const int lane = F.lane;
        { float x[8]; ld8bf(pr + P_CQ + lane * 8, x); float s = 0.f;
#pragma unroll
          for (int i = 0; i < 8; ++i) s += x[i] * x[i];
          s = wave_sum(s); const float rq = 1.f / sqrtf(s * (1.f / 512.f) + 1e-6f);
          ld8bf(pr + P_CKV + lane * 8, x); s = 0.f;
#pragma unroll
          for (int i = 0; i < 8; ++i) s += x[i] * x[i];
          s = wave_sum(s); const float rk = 1.f / sqrtf(s * (1.f / 512.f) + 1e-6f);
          if (lane == 0) { RS[row * 2] = rq; RS[row * 2 + 1] = rk; }
          float kv = bf2f(pr[P_KPE + lane]);
          const float other = swz16(kv);
          if (row >= TC) { const int t = (row - TC) & (SEQ - 1); const int axis = lane >> 5, half = (lane >> 4) & 1, j = lane & 15;
              const float pos = (float)(axis == 0 ? (t >> 6) : (t & 63)); const float inv = __builtin_amdgcn_exp2f(-(float)j * 0.8304820237218406f);
              const float sn = __sinf(pos * inv), cs = __cosf(pos * inv);
              kv = half == 0 ? kv * cs - other * sn : kv * cs + other * sn; }
          KPE[(size_t)row * 64 + lane] = (bf16_t)f2bf(kv); }
#pragma unroll 1
        for (int ch = 0; ch < 3; ++ch) { const int c = ch * 512 + lane * 8; float x0[8], xm[8], xp[8], w0[8], w1[8], w2[8], bb[8], o[8];
            ld8bf(pr + P_XBC + c, x0);
            if (!first) ld8bf(pp + P_XBC + c, xm); else { for (int i = 0; i < 8; ++i) xm[i] = 0.f; }
            if (!last) ld8bf(pn + P_XBC + c, xp); else { for (int i = 0; i < 8; ++i) xp[i] = 0.f; }
            ld8f(scw + c, w0); ld8f(scw + 1536 + c, w1); ld8f(scw + 3072 + c, w2); ld8f(scb + c, bb);
#pragma unroll
            for (int i = 0; i < 8; ++i) o[i] = siluf_(xm[i] * w0[i] + x0[i] * w1[i] + xp[i] * w2[i] + bb[i]);
            st8bf(P2 + (size_t)row * P2W + P2_XBC + c, o); }
        if (lane < 32) DT[(size_t)row * 32 + lane] = softplusf_(bf2f(pr[P_DT + lane]) + dtb[lane]);
#pragma unroll 1
        for (int ch = 0; ch < 2; ++ch) { const int c = ch * 512 + lane * 8;
            float o0[8];
            { float x0[8], xm[8], xp[8], w0[8], w1[8], w2[8], bb[8];
              ld8bf(pr + P_HY + c, x0);
              if (!first) ld8bf(pp + P_HY + c, xm); else { for (int i = 0; i < 8; ++i) xm[i] = 0.f; }
              if (!last) ld8bf(pn + P_HY + c, xp); else { for (int i = 0; i < 8; ++i) xp[i] = 0.f; }
              ld8f(hcw + c, w0); ld8f(hcw + 3072 + c, w1); ld8f(hcw + 6144 + c, w2); ld8f(hcb + c, bb);
#pragma unroll
              for (int i = 0; i < 8; ++i) o0[i] = xm[i] * w0[i] + x0[i] * w1[i] + xp[i] * w2[i] + bb[i]; }
            st8bf(P2 + (size_t)row * P2W + P2_X0 + c, o0);
            if (row < TC) { float o1[8], o2[8];
#pragma unroll
                for (int part = 1; part < 3; ++part) { float x0[8], xm[8], xp[8], w0[8], w1[8], w2[8], bb[8]; const int cc = part * 1024 + c;
                    ld8bf(pr + P_HY + cc, x0);
                    if (!first) ld8bf(pp + P_HY + cc, xm); else { for (int i = 0; i < 8; ++i) xm[i] = 0.f; }
                    if (!last) ld8bf(pn + P_HY + cc, xp); else { for (int i = 0; i < 8; ++i) xp[i] = 0.f; }
                    ld8f(hcw + cc, w0); ld8f(hcw + 3072 + cc, w1); ld8f(hcw + 6144 + cc, w2); ld8f(hcb + cc, bb);
#pragma unroll
                    for (int i = 0; i < 8; ++i) { const float r = xm[i] * w0[i] + x0[i] * w1[i] + xp[i] * w2[i] + bb[i]; if (part == 1) o1[i] = r; else o2[i] = r; } }
                float* vc = VC + (size_t)row * 1024 + c;
                *(f32x4*)vc = (f32x4){o1[0] * o2[0], o1[1] * o2[1], o1[2] * o2[2], o1[3] * o2[3]};
                *(f32x4*)(vc + 4) = (f32x4){o1[4] * o2[4], o1[5] * o2[5], o1[6] * o2[6], o1[7] * o2[7]}; } }
#pragma unroll 1
        for (int ch = 0; ch < 7; ++ch) { const int c = ch * 512 + lane * 8;
            if (c < 3488) { float u0[8], um[8], up[8], m0[8], m1[8], us[8];
                ld8bf(pr + P_RW + c, u0);
                if (!first) ld8bf(pp + P_RW + c, um); else { for (int i = 0; i < 8; ++i) um[i] = 0.f; }
                if (!last) ld8bf(pn + P_RW + c, up); else { for (int i = 0; i < 8; ++i) up[i] = 0.f; }
                ld8f(mu + c, m0); ld8f(mu + 3488 + c, m1);
#pragma unroll
                for (int i = 0; i < 8; ++i) us[i] = u0[i] + m0[i] * (um[i] - u0[i]) + m1[i] * (up[i] - u0[i]);
                if (ch < 6) st8bf(P2 + (size_t)row * P2W + P2_RKV + c, us);
                if (ch == 2 || ch == 3) {
                    float kx[8], g8[8]; ld8f(rkk + (c - 1024), g8); float s = 0.f;
#pragma unroll
                    for (int i = 0; i < 8; ++i) { kx[i] = us[i] * g8[i]; s += kx[i] * kx[i]; }
                    s = sum8(s);
                    const float inv = 1.f / fmaxf(sqrtf(s), 1e-12f);
#pragma unroll
                    for (int i = 0; i < 8; ++i) kx[i] *= inv;
                    st8bf(KK + (size_t)row * 1024 + (c - 1024), kx); }
                if (ch == 6) { const int cl = c - 3072; float o[8];
#pragma unroll
                    for (int i = 0; i < 8; ++i) o[i] = cl < 128 ? tanhf_(us[i]) : cl < 256 ? us[i] : sigmoidf_(us[i]);
                    st8bf(AL_ + (size_t)row * 512 + cl, o); } }
            else if (ch == 6) { const int cl = c - 3072; float zz = 0.f; asm volatile("" : "+v"(zz)); float o[8] = {zz, zz, zz, zz, zz, zz, zz, zz}; st8bf(AL_ + (size_t)row * 512 + cl, o); } }
    }
    float* VT = WSP(float, WS_VT);
    LAS float* tl = (LAS float*)F.lds;
    for (int u = F.bid; u < (TL / 64) * 4; u += F.G) {
        const int tb = u >> 2, cb = u & 3; const int row0 = TC + tb * 64; const int c = cb * 256 + (F.tid & 255), th = F.tid >> 8;
        const float w10 = hcw[1024 + c], w11 = hcw[3072 + 1024 + c], w12 = hcw[6144 + 1024 + c], b1 = hcb[1024 + c];
        const float w20 = hcw[2048 + c], w21 = hcw[3072 + 2048 + c], w22 = hcw[6144 + 2048 + c], b2 = hcb[2048 + c];
        __syncthreads();
        for (int i = 0; i < 32; ++i) { const int tl_ = th * 32 + i, row = row0 + tl_; const bf16_t* pr = P + (size_t)row * NNG + P_HY;
            const bool first = row_first(row), last = row_last(row);
            const float x1m = first ? 0.f : bf2f(pr[-NNG + 1024 + c]), x10 = bf2f(pr[1024 + c]), x1p = last ? 0.f : bf2f(pr[NNG + 1024 + c]);
            const float vm = first ? 0.f : bf2f(pr[-NNG + 2048 + c]), v0 = bf2f(pr[2048 + c]), vp = last ? 0.f : bf2f(pr[NNG + 2048 + c]);
            tl[(F.tid & 255) * 65 + tl_] = (x1m * w10 + x10 * w11 + x1p * w12 + b1) * (vm * w20 + v0 * w21 + vp * w22 + b2); }
        __syncthreads();
        const int b = (row0 - TC) >> 13, t0 = (row0 - TC) & (SEQ - 1);
        for (int p = 0; p < 8; ++p) { const int cl = p * 32 + (F.tid >> 4), q = F.tid & 15;
            const f32x4 o = {tl[cl * 65 + 4 * q], tl[cl * 65 + 4 * q + 1], tl[cl * 65 + 4 * q + 2], tl[cl * 65 + 4 * q + 3]};
            *(f32x4*)(VT + ((size_t)(cb * 256 + cl) * 2 + b) * SEQ + t0 + 4 * q) = o; }
    }
}

using pg8::Unit;
#define EPI_LOOP_BEGIN const int row0 = u.pm * 256 + wr * 64 + fr; \
    _Pragma("unroll") for (int ai = 0; ai < 2; ++ai) _Pragma("unroll") for (int m = 0; m < 4; ++m) { const int row = row0 + ai * 128 + m * 16; \
    _Pragma("unroll") for (int bj = 0; bj < 2; ++bj) { const int cl = bj * 128 + wc * 32 + 8 * fq; const f32x4 v0 = acc[ai][bj][m][0], v1 = acc[ai][bj][m][1];
#define EPI_LOOP_END } __builtin_amdgcn_sched_barrier(0); }
struct EpiBf16 {
    static constexpr bool PERM = true;
    bf16_t* O; int ldc; const float* rscale; int rs_stride; int act;
    __device__ __forceinline__ void operator()(const f32x4 (&acc)[2][2][4][2], const Unit& u, int wr, int wc, int fr, int fq) const {
        EPI_LOOP_BEGIN
            const float s = rscale ? rscale[(size_t)row * rs_stride] : 1.f;
            float x[8] = {v0.x * s, v0.y * s, v0.z * s, v0.w * s, v1.x * s, v1.y * s, v1.z * s, v1.w * s};
            if (act == 1) {
#pragma unroll
                for (int i = 0; i < 8; ++i) x[i] = sigmoidf_(x[i]); }
            u32x4 w; w.x = cvt_pk_bf16(x[0], x[1]); w.y = cvt_pk_bf16(x[2], x[3]); w.z = cvt_pk_bf16(x[4], x[5]); w.w = cvt_pk_bf16(x[6], x[7]);
            *(u32x4*)(O + (size_t)row * ldc + u.pn * 256 + cl) = w;
        EPI_LOOP_END
    }
};
struct EpiLora {
    static constexpr bool PERM = true;
    bf16_t* EW; bf16_t* ICLR; bf16_t* GG; const float* w0; const float* a0;
    __device__ __forceinline__ void operator()(const f32x4 (&acc)[2][2][4][2], const Unit& u, int wr, int wc, int fr, int fq) const {
        const int blk = u.pn >> 2, cb = (u.pn & 3) * 256;
        const float* bias = blk < 2 ? w0 + blk * 1024 : a0 + (blk & 1) * 1024;
        bf16_t* dbase = blk < 2 ? EW + (size_t)blk * T * 1024 : blk < 4 ? ICLR + (size_t)(blk - 2) * T * 1024 : GG;
        const float scale = blk < 2 ? 0.6065306597126334f : 1.f; const bool sig = blk < 4;
        EPI_LOOP_BEGIN
            const int c = cb + cl; float x[8] = {v0.x, v0.y, v0.z, v0.w, v1.x, v1.y, v1.z, v1.w};
            if (sig) { const f32x4 b0 = *(const f32x4*)(bias + c), b1 = *(const f32x4*)(bias + c + 4); const float bb[8] = {b0.x, b0.y, b0.z, b0.w, b1.x, b1.y, b1.z, b1.w};
#pragma unroll
                for (int i = 0; i < 8; ++i) x[i] = scale * sigmoidf_(bb[i] + x[i]); }
            u32x4 w; w.x = cvt_pk_bf16(x[0], x[1]); w.y = cvt_pk_bf16(x[2], x[3]); w.z = cvt_pk_bf16(x[4], x[5]); w.w = cvt_pk_bf16(x[6], x[7]);
            *(u32x4*)(dbase + (size_t)row * 1024 + c) = w;
        EPI_LOOP_END
    }
};
struct EpiMerge {
    static constexpr bool PERM = true;
    const bf16_t* gates; float* MF; bf16_t* MB;
    __device__ __forceinline__ void operator()(const f32x4 (&acc)[2][2][4][2], const Unit& uu, int wr, int wc, int fr, int fq) const {
        const int br = uu.pn >> 3; Unit u; u.pm = uu.pm - br * 66; u.pn = uu.pn & 7;
        EPI_LOOP_BEGIN
            const int col = u.pn * 256 + cl; float g[8]; ld8bf(gates + (size_t)row * NGATE + br * DM + col, g);
            float x[8] = {v0.x * g[0], v0.y * g[1], v0.z * g[2], v0.w * g[3], v1.x * g[4], v1.y * g[5], v1.z * g[6], v1.w * g[7]};
            float* mf = MF + (size_t)row * DM + col;
            if (br > 0) { const f32x4 p0 = *(const f32x4*)mf, p1 = *(const f32x4*)(mf + 4); x[0] += p0.x; x[1] += p0.y; x[2] += p0.z; x[3] += p0.w; x[4] += p1.x; x[5] += p1.y; x[6] += p1.z; x[7] += p1.w; }
            if (br < 3) { *(f32x4*)mf = (f32x4){x[0], x[1], x[2], x[3]}; *(f32x4*)(mf + 4) = (f32x4){x[4], x[5], x[6], x[7]}; }
            else { u32x4 w; w.x = cvt_pk_bf16(x[0], x[1]); w.y = cvt_pk_bf16(x[2], x[3]); w.z = cvt_pk_bf16(x[4], x[5]); w.w = cvt_pk_bf16(x[6], x[7]); *(u32x4*)(MB + (size_t)row * DM + col) = w; }
        EPI_LOOP_END
    }
};
struct OrderMerge {
    pg8::StaticOrder so;
    __device__ void init(int G, int c) { so.init(66, 8, G, c); }
    __device__ bool next(int i, Unit& u) const { Unit t; if (!so.next(i >> 2, t)) return false; const int br = i & 3; u.pm = br * 66 + t.pm; u.pn = br * 8 + t.pn; return true; }
};
struct EpiF32 {
    static constexpr bool PERM = true;
    float* O; int ldc;
    __device__ __forceinline__ void operator()(const f32x4 (&acc)[2][2][4][2], const Unit& u, int wr, int wc, int fr, int fq) const {
        EPI_LOOP_BEGIN
            float* o = O + (size_t)row * ldc + u.pn * 256 + cl; *(f32x4*)o = v0; *(f32x4*)(o + 4) = v1;
        EPI_LOOP_END
    }
};
__device__ __forceinline__ int moe_panel(int e, int pi) { return pi < 8 ? (((pi >> 2) * NEXP + e) * 4 + (pi & 3)) : 128 + e; }
struct OrderMoe {
    int npn, G, c;
    __device__ void init(int npn_, int G_, int c_) { npn = npn_; G = G_; c = c_; }
    __device__ bool next(int i, Unit& u) const { const int L = i * G + c; const int per = 9 * npn; if (L >= NEXP * per) return false;
        const int e = L / per, r = L % per, j = r / 9, pi = r % 9; u.pm = moe_panel(e, pi); u.pn = e * npn + j; return true; }
};
struct EpiSwiglu {
    static constexpr bool PERM = true;
    bf16_t* HID;
    __device__ __forceinline__ void operator()(const f32x4 (&acc)[2][2][4][2], const Unit& u, int wr, int wc, int fr, int fq) const {
        const int j = u.pn % 11; const int row0 = u.pm * 256 + wr * 64 + fr;
#pragma unroll
        for (int ai = 0; ai < 2; ++ai)
#pragma unroll
            for (int m = 0; m < 4; ++m) { const int row = row0 + ai * 128 + m * 16;
                const f32x4 g0 = acc[ai][0][m][0], g1 = acc[ai][0][m][1], u0 = acc[ai][1][m][0], u1 = acc[ai][1][m][1];
                u32x4 w; w.x = cvt_pk_bf16(siluf_(g0.x) * u0.x, siluf_(g0.y) * u0.y); w.y = cvt_pk_bf16(siluf_(g0.z) * u0.z, siluf_(g0.w) * u0.w);
                w.z = cvt_pk_bf16(siluf_(g1.x) * u1.x, siluf_(g1.y) * u1.y); w.w = cvt_pk_bf16(siluf_(g1.z) * u1.z, siluf_(g1.w) * u1.w);
                *(u32x4*)(HID + (size_t)row * EFF + j * 128 + wc * 32 + 8 * fq) = w; __builtin_amdgcn_sched_barrier(0); }
    }
};
struct EpiDown {
    static constexpr bool PERM = true;
    bf16_t* YE; const float* pgate;
    __device__ __forceinline__ void operator()(const f32x4 (&acc)[2][2][4][2], const Unit& uu, int wr, int wc, int fr, int fq) const {
        Unit u; u.pm = uu.pm; u.pn = uu.pn & 7;
        EPI_LOOP_BEGIN
            const float s = pgate[row];
            u32x4 w; w.x = cvt_pk_bf16(v0.x * s, v0.y * s); w.y = cvt_pk_bf16(v0.z * s, v0.w * s); w.z = cvt_pk_bf16(v1.x * s, v1.y * s); w.w = cvt_pk_bf16(v1.z * s, v1.w * s);
            *(u32x4*)(YE + (size_t)row * DM + u.pn * 256 + cl) = w;
        EPI_LOOP_END
    }
};

namespace att {
using s16x4 = __attribute__((ext_vector_type(4))) short;
using f32x16 = __attribute__((ext_vector_type(16))) float;
constexpr int NW = 8, QBLK = 32, KVBLK = 64, LDQ = 1536, LDKV = 2048, LDO = 1024;
constexpr float SCALE = 0.07216878364870322f;
constexpr float THR = 8.f;
#ifndef ATT_SDEPTH
#define ATT_SDEPTH 1
#endif
constexpr int SDEPTH = ATT_SDEPTH;
constexpr int SHM_V = KVBLK * 128 * 2, SHM_K = KVBLK * 128 * 2, SHM_KP = KVBLK * 64 * 2;
constexpr int OFF_V = 0, OFF_K = 2 * SHM_V, OFF_KP = OFF_K + 2 * SHM_K, OFF_WS = OFF_KP + 2 * SHM_KP, OFF_QP = OFF_WS + NW * 64 * 4, SHM_ATTN = OFF_QP + 256 * 256;
static_assert(SHM_ATTN <= 150 * 1024, "attention LDS");
#define KSWZ(row, colB) ((row) * 256 + ((colB) ^ (((row) & 7) << 4)))
#define KPSWZ(row, colB) ((row) * 128 + ((colB) ^ (((row) & 7) << 4)))
#define SBAR() __builtin_amdgcn_sched_barrier(0)
__device__ __forceinline__ int crow(int r, int hi) { return (r & 3) + 8 * (r >> 2) + 4 * hi; }
__device__ __forceinline__ void partialSM(f32x16& p0, f32x16& p1, float& m_reg, float& mn, float& alpha) {
  constexpr float C = SCALE * 1.4426950408889634f;
  float pmax = p0[0]; for (int r = 1; r < 16; ++r) pmax = fmaxf(pmax, p0[r]); for (int r = 0; r < 16; ++r) pmax = fmaxf(pmax, p1[r]);
  { auto rr = __builtin_amdgcn_permlane32_swap(__float_as_uint(pmax), __float_as_uint(pmax), false, false);
    pmax = fmaxf(__uint_as_float(rr[0]), __uint_as_float(rr[1])); }
  if (__builtin_expect(__all(pmax - m_reg <= THR / SCALE), 1)) { mn = m_reg; alpha = 1.f; }
  else { mn = fmaxf(m_reg, pmax); alpha = __builtin_amdgcn_exp2f((m_reg - mn) * C); m_reg = mn; }
  float mnC = -mn * C;
  for (int r = 0; r < 16; ++r) p0[r] = fmaf(p0[r], C, mnC); for (int r = 0; r < 16; ++r) p1[r] = fmaf(p1[r], C, mnC);
  for (int r = 0; r < 16; ++r) p0[r] = __builtin_amdgcn_exp2f(p0[r]);
}
__device__ __forceinline__ void finishSM(f32x16& p0, f32x16& p1, float alpha, float& l_reg, bf16x8& pa0, bf16x8& pa1, bf16x8& pa2, bf16x8& pa3) {
  for (int r = 0; r < 16; ++r) p1[r] = __builtin_amdgcn_exp2f(p1[r]);
  float ps = 0; for (int r = 0; r < 16; ++r) ps += p0[r]; for (int r = 0; r < 16; ++r) ps += p1[r];
  { auto rr = __builtin_amdgcn_permlane32_swap(__float_as_uint(ps), __float_as_uint(ps), false, false);
    ps = __uint_as_float(rr[0]) + __uint_as_float(rr[1]); }
  l_reg = l_reg * alpha + ps;
#define PK4(P, BASE, OUT) do { unsigned a0 = cvt_pk_bf16(P[BASE + 0], P[BASE + 1]), a1 = cvt_pk_bf16(P[BASE + 2], P[BASE + 3]);   \
    unsigned b0 = cvt_pk_bf16(P[BASE + 4], P[BASE + 5]), b1 = cvt_pk_bf16(P[BASE + 6], P[BASE + 7]);                              \
    auto r0 = __builtin_amdgcn_permlane32_swap(a0, b0, false, false); auto r1 = __builtin_amdgcn_permlane32_swap(a1, b1, false, false); \
    u32x4 w = {r0[0], r1[0], r0[1], r1[1]}; OUT = *reinterpret_cast<bf16x8*>(&w); } while (0)
  PK4(p0, 0, pa0); PK4(p0, 8, pa1); PK4(p1, 0, pa2); PK4(p1, 8, pa3);
#undef PK4
}
__device__ __forceinline__ void qkt(f32x16& p0, f32x16& p1, const char* Ks, const char* Kp, const bf16x8* qr, const char* Qp, int qrow, int r32, int hi) {
  p0 = f32x16{}; p1 = f32x16{};
#pragma unroll
  for (int d0 = 0; d0 < 8; ++d0) { int cb = (d0 * 16 + hi * 8) * 2;
    bf16x8 b0 = *reinterpret_cast<const bf16x8*>(Ks + KSWZ(r32, cb));
    bf16x8 b1 = *reinterpret_cast<const bf16x8*>(Ks + KSWZ(32 + r32, cb));
    bf16x8 q; if (d0 < 4) q = qr[d0]; else q = *reinterpret_cast<const bf16x8*>(Qp + KSWZ(qrow, ((d0 - 4) * 16 + hi * 8) * 2));
    p0 = __builtin_amdgcn_mfma_f32_32x32x16_bf16(b0, q, p0, 0, 0, 0);
    p1 = __builtin_amdgcn_mfma_f32_32x32x16_bf16(b1, q, p1, 0, 0, 0); }
#pragma unroll
  for (int d0 = 0; d0 < 4; ++d0) { int cb = (d0 * 16 + hi * 8) * 2;
    bf16x8 b0 = *reinterpret_cast<const bf16x8*>(Kp + KPSWZ(r32, cb));
    bf16x8 b1 = *reinterpret_cast<const bf16x8*>(Kp + KPSWZ(32 + r32, cb));
    const bf16x8 qp = *reinterpret_cast<const bf16x8*>(Qp + KSWZ(qrow, 128 + cb));
    p0 = __builtin_amdgcn_mfma_f32_32x32x16_bf16(b0, qp, p0, 0, 0, 0);
    p1 = __builtin_amdgcn_mfma_f32_32x32x16_bf16(b1, qp, p1, 0, 0, 0); }
}
__device__ __forceinline__ int v_st(int k, int c) { const int kk = (k & ~0xC) | ((k & 4) << 1) | ((k & 8) >> 1); return ((kk >> 3) * 4 + (c >> 5)) * 512 + ((kk & 7) * 32 + (c & 31)) * 2; }
__device__ __forceinline__ int v_rd_base(int lane) { return ((lane & 3) << 3) | (((lane >> 2) & 3) << 6) | (((lane >> 4) & 1) << 5) | (((lane >> 5) & 1) << 8); }
constexpr int v_rd_off(int d0, int ks, int half) { return d0 * 512 + ks * 4096 + half * 2048; }
template <int OFF> __device__ __forceinline__ s16x4 tr_read(int vb) {
  s16x4 r; asm volatile("ds_read_b64_tr_b16 %0, %1 offset:%2" : "=&v"(r) : "v"(vb), "i"(OFF) : "memory"); return r;
}
template <int D0> __device__ __forceinline__ void pv_one(f32x16& od, int vb, bf16x8 pa0, bf16x8 pa1, bf16x8 pa2, bf16x8 pa3) {
  const s16x4 l0 = tr_read<v_rd_off(D0, 0, 0)>(vb), h0 = tr_read<v_rd_off(D0, 0, 1)>(vb), l1 = tr_read<v_rd_off(D0, 1, 0)>(vb), h1 = tr_read<v_rd_off(D0, 1, 1)>(vb);
  const s16x4 l2 = tr_read<v_rd_off(D0, 2, 0)>(vb), h2 = tr_read<v_rd_off(D0, 2, 1)>(vb), l3 = tr_read<v_rd_off(D0, 3, 0)>(vb), h3 = tr_read<v_rd_off(D0, 3, 1)>(vb);
  asm volatile("s_waitcnt lgkmcnt(0)" ::: "memory"); SBAR();
#define PK(L, H) (bf16x8){L[0], L[1], L[2], L[3], H[0], H[1], H[2], H[3]}
  od = __builtin_amdgcn_mfma_f32_32x32x16_bf16(pa0, PK(l0, h0), od, 0, 0, 0);
  od = __builtin_amdgcn_mfma_f32_32x32x16_bf16(pa1, PK(l1, h1), od, 0, 0, 0);
  od = __builtin_amdgcn_mfma_f32_32x32x16_bf16(pa2, PK(l2, h2), od, 0, 0, 0);
  od = __builtin_amdgcn_mfma_f32_32x32x16_bf16(pa3, PK(l3, h3), od, 0, 0, 0);
#undef PK
}
__device__ __forceinline__ void pv_d0(f32x16* o, int vb, bf16x8 pa0, bf16x8 pa1, bf16x8 pa2, bf16x8 pa3) {
  pv_one<0>(o[0], vb, pa0, pa1, pa2, pa3); pv_one<1>(o[1], vb, pa0, pa1, pa2, pa3); pv_one<2>(o[2], vb, pa0, pa1, pa2, pa3); pv_one<3>(o[3], vb, pa0, pa1, pa2, pa3);
}
__device__ __forceinline__ void attn_unit(const bf16_t* __restrict__ Qb, const bf16_t* __restrict__ KVh, const bf16_t* __restrict__ KPE, bf16_t* __restrict__ Ob,
                                          int ka0, int kb0, int NT, char* lds) {
  int tid_ = threadIdx.x; asm volatile("" : "+v"(tid_));
  const int tid = tid_, wid = tid >> 6, lane = tid & 63, r32 = lane & 31, hi = lane >> 5;
  char* V_lds = lds + OFF_V; char* K_lds = lds + OFF_K; char* P_lds = lds + OFF_KP;
  float* ws = (float*)(lds + OFF_WS) + wid * 64; float* li_l = ws; float* al_l = ws + 32;
  float m_reg = -1e30f, l_reg = 0; f32x16 o[4] = {}; bf16x8 qr[4];
  char* Q_lds = lds + OFF_QP; const int qrow = wid * QBLK + r32;
  const bf16_t* Qw = Qb + (long)(wid * QBLK + r32) * LDQ + hi * 8;
#pragma unroll
  for (int d0 = 0; d0 < 4; ++d0) qr[d0] = *reinterpret_cast<const bf16x8*>(Qw + d0 * 16);
#pragma unroll
  for (int d0 = 0; d0 < 8; ++d0) *reinterpret_cast<bf16x8*>(Q_lds + KSWZ(qrow, (d0 * 16 + hi * 8) * 2)) = *reinterpret_cast<const bf16x8*>(Qw + 64 + d0 * 16);
  const int sr = tid >> 4, sc = (tid & 15) * 8, vst0 = v_st(sr, sc), vst1 = v_st(32 + sr, sc);
  const int pr = tid >> 3, pc = (tid & 7) * 8;
  const int vb0 = (int)(uintptr_t)V_lds + v_rd_base(lane);
  struct { bf16x8 vs0, vs1, ks0, ks1, kp; } sr_[SDEPTH];
#define KROW(j) ((j) < 4 ? ka0 + 64 * (j) : kb0 + 64 * ((j) - 4))
#define SLOAD(i, jt) do { const long k0_ = KROW(jt); \
    sr_[i].vs0 = *reinterpret_cast<const bf16x8*>(&KVh[(k0_ + sr) * LDKV + 128 + sc]); sr_[i].vs1 = *reinterpret_cast<const bf16x8*>(&KVh[(k0_ + 32 + sr) * LDKV + 128 + sc]); \
    sr_[i].ks0 = *reinterpret_cast<const bf16x8*>(&KVh[(k0_ + sr) * LDKV + sc]); sr_[i].ks1 = *reinterpret_cast<const bf16x8*>(&KVh[(k0_ + 32 + sr) * LDKV + sc]); \
    sr_[i].kp = *reinterpret_cast<const bf16x8*>(&KPE[(k0_ + pr) * 64 + pc]); } while (0)
#define SWRITE(b, i) do { *(bf16x8*)(V_lds + (b) * SHM_V + vst0) = sr_[i].vs0;          \
    *(bf16x8*)(V_lds + (b) * SHM_V + vst1) = sr_[i].vs1; int kc = sc * 2;               \
    *(bf16x8*)(K_lds + (b) * SHM_K + KSWZ(sr, kc)) = sr_[i].ks0;                       \
    *(bf16x8*)(K_lds + (b) * SHM_K + KSWZ(32 + sr, kc)) = sr_[i].ks1;                  \
    *(bf16x8*)(P_lds + (b) * SHM_KP + KPSWZ(pr, pc * 2)) = sr_[i].kp; } while (0)
#define SWAIT() do { if constexpr (SDEPTH == 2) asm volatile("s_waitcnt vmcnt(5)" ::: "memory"); else asm volatile("s_waitcnt vmcnt(0)" ::: "memory"); } while (0)
#define RESC(a) do { if (__any((a) < 1.f)) { if (hi == 0) al_l[r32] = (a); asm volatile("s_waitcnt lgkmcnt(0)" ::: "memory"); \
    for (int d = 0; d < 4; ++d) for (int r = 0; r < 16; ++r) o[d][r] *= al_l[crow(r, hi)]; } } while (0)
  f32x16 pA0, pA1, pB0, pB1; float mnA, mnB, alA, alB; bf16x8 pa0, pa1, pa2, pa3;
  constexpr int SE = 0, SO = SDEPTH - 1;
  SLOAD(SE, 0); asm volatile("s_waitcnt vmcnt(0)" ::: "memory"); SWRITE(0, SE); __syncthreads();
  qkt(pA0, pA1, K_lds, P_lds, qr, Q_lds, qrow, r32, hi); partialSM(pA0, pA1, m_reg, mnA, alA);
  SLOAD(SO, 1); if constexpr (SDEPTH == 2) { if (2 < NT) SLOAD(SE, 2); }
  SWAIT(); SWRITE(1, SO); __syncthreads();
  for (int j = 1; j + 1 < NT; j += 2) {
    SBAR(); qkt(pB0, pB1, K_lds + SHM_K, P_lds + SHM_KP, qr, Q_lds, qrow, r32, hi);
    finishSM(pA0, pA1, alA, l_reg, pa0, pa1, pa2, pa3); SBAR();
    SLOAD(SO, j + SDEPTH); SBAR();
    pv_d0(o, vb0, pa0, pa1, pa2, pa3); partialSM(pB0, pB1, m_reg, mnB, alB);
    __syncthreads(); SWAIT(); SWRITE(0, SE);
    RESC(alB); __syncthreads();
    SBAR(); qkt(pA0, pA1, K_lds, P_lds, qr, Q_lds, qrow, r32, hi);
    finishSM(pB0, pB1, alB, l_reg, pa0, pa1, pa2, pa3); SBAR();
    if (SDEPTH == 1 || j + 3 < NT) SLOAD(SE, j + 1 + SDEPTH); SBAR();
    pv_d0(o, vb0 + (int)SHM_V, pa0, pa1, pa2, pa3); partialSM(pA0, pA1, m_reg, mnA, alA);
    __syncthreads(); SWAIT(); SWRITE(1, SO);
    RESC(alA); __syncthreads();
  }
  SBAR(); qkt(pB0, pB1, K_lds + SHM_K, P_lds + SHM_KP, qr, Q_lds, qrow, r32, hi);
  finishSM(pA0, pA1, alA, l_reg, pa0, pa1, pa2, pa3); SBAR();
  pv_d0(o, vb0, pa0, pa1, pa2, pa3); partialSM(pB0, pB1, m_reg, mnB, alB);
  __syncthreads(); RESC(alB);
  finishSM(pB0, pB1, alB, l_reg, pa0, pa1, pa2, pa3); SBAR();
  pv_d0(o, vb0 + (int)SHM_V, pa0, pa1, pa2, pa3);
  if (hi == 0) li_l[r32] = l_reg; asm volatile("s_waitcnt lgkmcnt(0)" ::: "memory");
  float rli[16];
#pragma unroll
  for (int r = 0; r < 16; ++r) rli[r] = __builtin_amdgcn_rcpf(li_l[crow(r, hi)]);
  bf16_t* Ow = Ob + (long)(wid * QBLK) * LDO;
#pragma unroll
  for (int r = 0; r < 16; ++r) { int orow = crow(r, hi);
    for (int d0 = 0; d0 < 4; ++d0) Ow[(long)orow * LDO + d0 * 32 + r32] = (bf16_t)f2bf(o[d0][r] * rli[r]); }
  __syncthreads();
#undef KROW
#undef SLOAD
#undef SWRITE
#undef SWAIT
#undef RESC
}
}

__device__ __forceinline__ void phase_attn(Frame& F) {
    const bf16_t* Q = WSP(bf16_t, WS_Q); const bf16_t* KV = WSP(bf16_t, WS_KV); const bf16_t* KPE = WSP(bf16_t, WS_KPE); bf16_t* YA = WSP(bf16_t, WS_Y);
    constexpr int NU = NBATCH * NH_MLA * 32 + NBATCH * NH_MLA;
    for (int u = F.bid; u < NU; u += F.G) {
        int b, h, row0, NT;
        if (u < NBATCH * NH_MLA * 32) { const int bh = u >> 5, qb = u & 31; b = bh >> 3; h = bh & 7; row0 = TC + b * SEQ + qb * 256; NT = 4 + SEQ / 64; }
        else { const int bh = u - NBATCH * NH_MLA * 32; b = bh >> 3; h = bh & 7; row0 = b * CTX; NT = 4; }
        att::attn_unit(Q + (size_t)row0 * 1536 + h * 192, KV + h * 256, KPE, YA + (size_t)row0 * 1024 + h * 128, b * CTX, TC + b * SEQ, NT, (char*)F.lds);
    }
}
__device__ __forceinline__ void phase_qrope(Frame& F) {
    bf16_t* Q = WSP(bf16_t, WS_Q);
    for (int row = TC + F.gw; row < T; row += F.NGW) {
        const int t = (row - TC) & (SEQ - 1); const int p = F.lane & 31, axis = p >> 4, j = p & 15, hs = F.lane >> 5;
        const float pos = (float)(axis == 0 ? (t >> 6) : (t & 63)); const float inv = __builtin_amdgcn_exp2f(-(float)j * 0.8304820237218406f);
        const float sn = __sinf(pos * inv), cs = __cosf(pos * inv);
#pragma unroll
        for (int hh = 0; hh < 4; ++hh) { const int h = hh * 2 + hs; bf16_t* q = Q + (size_t)row * 1536 + h * 192 + 128 + axis * 32 + j;
            const float x1 = bf2f(q[0]), x2 = bf2f(q[16]);
            q[0] = (bf16_t)f2bf(x1 * cs - x2 * sn); q[16] = (bf16_t)f2bf(x2 * cs + x1 * sn); }
    }
}

#define MFMA16(a, b, c) __builtin_amdgcn_mfma_f32_16x16x32_bf16((a), (b), (c), 0, 0, 0)
constexpr int XS_LD = 264, BC_LD = 136;
__device__ __forceinline__ float wave_incl_scan(float v, int lane) {
#pragma unroll
    for (int o = 1; o < 64; o <<= 1) { const float t = __shfl_up(v, o); if (lane >= o) v += t; }
    return v;
}
__device__ __forceinline__ void stage_tile(LAS bf16_t* dst, int ld, const bf16_t* src, int ncols, int tid) {
    const int cpr = ncols >> 3;
    for (int i = tid; i < 128 * cpr; i += NTHREADS) { const int r = i / cpr, c8 = (i % cpr) * 8; *(LAS u32x4*)(dst + r * ld + c8) = *(const u32x4*)(src + (size_t)r * P2W + c8); }
}
__device__ __forceinline__ void phase_mamba_states(Frame& F, const Args& a, int layer) {
    const bf16_t* P2 = WSP(bf16_t, WS_P2); const float* DT = WSP(float, WS_DT); bf16_t* MST = WSP(bf16_t, WS_MST); float* MCS = WSP(float, WS_MCS);
    LAS bf16_t* XSl = (LAS bf16_t*)F.lds; LAS bf16_t* Bl = (LAS bf16_t*)(F.lds + 67584); LAS float* wt = (LAS float*)(F.lds + 102400) + F.wave * 128;
    const int lane = F.lane, row = lane & 15, quad = lane >> 4;
    for (int u = F.bid; u < NCHUNK * 4; u += F.G) {
        const int chunk = u >> 2, g = (u >> 1) & 1, half = u & 1, row0 = chunk * 128;
        __syncthreads();
        stage_tile(XSl, XS_LD, P2 + (size_t)row0 * P2W + P2_XBC + (g * 8 + half * 4) * 64, 256, F.tid);
        stage_tile(Bl, BC_LD, P2 + (size_t)row0 * P2W + P2_XBC + 1024 + g * 128, 128, F.tid);
        const int hl = F.wave >> 1, d = F.wave & 1, h = g * 8 + half * 4 + hl;
        const float aa = -__expf(arg_in(a, I_SALOG)[(layer * 2 + d) * 16 + h]);
        { const float dt0 = DT[(size_t)(row0 + lane) * 32 + d * 16 + h], dt1 = DT[(size_t)(row0 + 64 + lane) * 32 + d * 16 + h];
          const float da0 = dt0 * aa, da1 = dt1 * aa;
          float c0 = wave_incl_scan(da0, lane); const float tot0 = __shfl(c0, 63); float c1 = wave_incl_scan(da1, lane) + tot0; const float tot = __shfl(c1, 63);
          if (d == 0) { wt[lane] = dt0 * __expf(tot - c0); wt[64 + lane] = dt1 * __expf(tot - c1); }
          else { wt[lane] = dt0 * __expf(c0 - da0); wt[64 + lane] = dt1 * __expf(c1 - da1); }
          if (lane == 0) MCS[(d * NCHUNK + chunk) * 16 + h] = tot; }
        __syncthreads();
        bf16_t* out = MST + ((size_t)(d * NCHUNK + chunk) * 16 + h) * 8192;
#pragma unroll 1
        for (int nh = 0; nh < 2; ++nh) {
            f32x4 acc[4][4];
#pragma unroll
            for (int i = 0; i < 4; ++i)
#pragma unroll
                for (int j = 0; j < 4; ++j) acc[i][j] = (f32x4){0.f, 0.f, 0.f, 0.f};
#pragma unroll 1
            for (int k0 = 0; k0 < 128; k0 += 32) {
                const int sb = k0 + quad * 8;
                float w8[8];
#pragma unroll
                for (int j = 0; j < 8; ++j) w8[j] = wt[sb + j];
                bf16x8 bf[4];
#pragma unroll
                for (int nt = 0; nt < 4; ++nt) {
#pragma unroll
                    for (int j = 0; j < 8; ++j) bf[nt][j] = (short)Bl[(sb + j) * BC_LD + (nh * 4 + nt) * 16 + row]; }
#pragma unroll
                for (int pt = 0; pt < 4; ++pt) { bf16x8 af;
#pragma unroll
                    for (int j = 0; j < 8; ++j) af[j] = (short)f2bf(w8[j] * bf2f(XSl[(sb + j) * XS_LD + hl * 64 + pt * 16 + row]));
#pragma unroll
                    for (int nt = 0; nt < 4; ++nt) acc[pt][nt] = MFMA16(af, bf[nt], acc[pt][nt]); }
            }
#pragma unroll
            for (int pt = 0; pt < 4; ++pt)
#pragma unroll
                for (int nt = 0; nt < 4; ++nt)
#pragma unroll
                    for (int jj = 0; jj < 4; ++jj) out[(pt * 16 + quad * 4 + jj) * 128 + (nh * 4 + nt) * 16 + row] = (bf16_t)f2bf(acc[pt][nt][jj]);
        }
    }
}
__device__ __forceinline__ void phase_mamba_scan(Frame& F) {
    bf16_t* MST = WSP(bf16_t, WS_MST); const float* MCS = WSP(float, WS_MCS);
    for (int idx = F.bid * NTHREADS + F.tid; idx < 2 * 2 * 16 * 8192; idx += F.G * NTHREADS) {
        const int e = idx & 8191, h = (idx >> 13) & 15, b = (idx >> 17) & 1, d = idx >> 18;
        float state = 0.f;
#pragma unroll 6
        for (int i = 0; i < 66; ++i) {
            int chunk; if (i < 2) chunk = 2 * b + (d == 0 ? i : 1 - i); else chunk = 4 + 64 * b + (d == 0 ? i - 2 : 65 - i);
            bf16_t* p = MST + ((size_t)(d * NCHUNK + chunk) * 16 + h) * 8192 + e;
            const float cs = bf2f(*p); const float dec = __expf(MCS[(d * NCHUNK + chunk) * 16 + h]);
            *p = (bf16_t)f2bf(state);
            state = state * dec + cs;
        }
    }
}
__device__ __forceinline__ void phase_mamba_out(Frame& F, const Args& a, int layer) {
    const bf16_t* P = WSP(bf16_t, WS_P); const bf16_t* P2 = WSP(bf16_t, WS_P2); const float* DT = WSP(float, WS_DT); const bf16_t* MST = WSP(bf16_t, WS_MST);
    bf16_t* YB = WSP(bf16_t, WS_Y) + (size_t)1 * T * 1024;
    LAS bf16_t* Cl = (LAS bf16_t*)F.lds; LAS bf16_t* Bl = (LAS bf16_t*)(F.lds + 34816); LAS bf16_t* XSl = (LAS bf16_t*)(F.lds + 69632);
    LAS float* tab = (LAS float*)(F.lds + 137216);
    const int lane = F.lane, row = lane & 15, quad = lane >> 4;
    for (int u = F.bid; u < NCHUNK * 4; u += F.G) {
        const int chunk = u >> 2, g = (u >> 1) & 1, half = u & 1, row0 = chunk * 128;
        __syncthreads();
        stage_tile(XSl, XS_LD, P2 + (size_t)row0 * P2W + P2_XBC + (g * 8 + half * 4) * 64, 256, F.tid);
        stage_tile(Bl, BC_LD, P2 + (size_t)row0 * P2W + P2_XBC + 1024 + g * 128, 128, F.tid);
        stage_tile(Cl, BC_LD, P2 + (size_t)row0 * P2W + P2_XBC + 1280 + g * 128, 128, F.tid);
        float tot1 = 0.f;
        { const int hl = F.wave >> 1, d = F.wave & 1, h = g * 8 + half * 4 + hl;
          const float aa = -__expf(arg_in(a, I_SALOG)[(layer * 2 + d) * 16 + h]);
          const float dt0 = DT[(size_t)(row0 + lane) * 32 + d * 16 + h], dt1 = DT[(size_t)(row0 + 64 + lane) * 32 + d * 16 + h];
          const float da0 = dt0 * aa, da1 = dt1 * aa;
          float c0 = wave_incl_scan(da0, lane); const float t0 = __shfl(c0, 63); float c1 = wave_incl_scan(da1, lane) + t0;
          LAS float* tb = tab + hl * 512;
          if (d == 0) { tb[lane] = c0; tb[64 + lane] = c1; tb[256 + lane] = __logf(dt0) - c0; tb[320 + lane] = __logf(dt1) - c1; }
          else { tb[128 + lane] = c0 - da0; tb[192 + lane] = c1 - da1; tb[384 + lane] = (c0 - da0) + __logf(dt0); tb[448 + lane] = (c1 - da1) + __logf(dt1); if (lane == 63) tab[2048 + hl] = c1; } }
        __syncthreads();
        { f32x4 cb[8];
#pragma unroll
          for (int st = 0; st < 8; ++st) cb[st] = (f32x4){0.f, 0.f, 0.f, 0.f};
#pragma unroll
          for (int k0 = 0; k0 < 128; k0 += 32) { const bf16x8 af = *(const LAS bf16x8*)(Cl + (F.wave * 16 + row) * BC_LD + k0 + quad * 8);
#pragma unroll
              for (int st = 0; st < 8; ++st) { const bf16x8 bfr = *(const LAS bf16x8*)(Bl + (st * 16 + row) * BC_LD + k0 + quad * 8); cb[st] = MFMA16(af, bfr, cb[st]); } }
          __syncthreads();
#pragma unroll
          for (int st = 0; st < 8; ++st)
#pragma unroll
              for (int jj = 0; jj < 4; ++jj) Bl[(F.wave * 16 + quad * 4 + jj) * BC_LD + st * 16 + row] = (bf16_t)f2bf(cb[st][jj]); }
        __syncthreads();
        const int hl = F.wave >> 1, th = F.wave & 1, h = g * 8 + half * 4 + hl;
        const LAS float* tb = tab + hl * 512; tot1 = tab[2048 + hl];
        f32x4 acc[4][4];
#pragma unroll
        for (int i = 0; i < 4; ++i)
#pragma unroll
            for (int j = 0; j < 4; ++j) acc[i][j] = (f32x4){0.f, 0.f, 0.f, 0.f};
#pragma unroll 1
        for (int k0 = 0; k0 < 128; k0 += 32) {
            const int sb = k0 + quad * 8;
            float u0s[8], u1s[8];
#pragma unroll
            for (int j = 0; j < 8; ++j) { u0s[j] = tb[256 + sb + j]; u1s[j] = tb[384 + sb + j]; }
            bf16x8 bx[4];
#pragma unroll
            for (int pt = 0; pt < 4; ++pt) {
#pragma unroll
                for (int j = 0; j < 8; ++j) bx[pt][j] = (short)XSl[(sb + j) * XS_LD + hl * 64 + pt * 16 + row]; }
#pragma unroll
            for (int tt = 0; tt < 4; ++tt) { const int t = th * 64 + tt * 16 + row; const float c0t = tb[t], e1t = tb[128 + t];
                float cbv[8]; { const u32x4 w = *(const LAS u32x4*)(Bl + t * BC_LD + sb); cbv[0] = bflo(w.x); cbv[1] = bfhi(w.x); cbv[2] = bflo(w.y); cbv[3] = bfhi(w.y); cbv[4] = bflo(w.z); cbv[5] = bfhi(w.z); cbv[6] = bflo(w.w); cbv[7] = bfhi(w.w); }
                bf16x8 af;
#pragma unroll
                for (int j = 0; j < 8; ++j) { const int s = sb + j;
                    const float f0 = s <= t ? __expf(c0t + u0s[j]) : 0.f;
                    const float f1 = s >= t ? __expf(u1s[j] - e1t) : 0.f;
                    af[j] = (short)f2bf(cbv[j] * (f0 + f1)); }
#pragma unroll
                for (int pt = 0; pt < 4; ++pt) acc[tt][pt] = MFMA16(af, bx[pt], acc[tt][pt]); }
        }
#pragma unroll 1
        for (int d = 0; d < 2; ++d) {
            const bf16_t* S = MST + ((size_t)(d * NCHUNK + chunk) * 16 + h) * 8192;
#pragma unroll 1
            for (int k0 = 0; k0 < 128; k0 += 32) {
                bf16x8 bs[4];
#pragma unroll
                for (int pt = 0; pt < 4; ++pt) bs[pt] = *(const bf16x8*)(S + (pt * 16 + row) * 128 + k0 + quad * 8);
#pragma unroll
                for (int tt = 0; tt < 4; ++tt) { const int t = th * 64 + tt * 16 + row;
                    const float sc = d == 0 ? __expf(tb[t]) : __expf(tot1 - tb[128 + t]);
                    const u32x4 cw = *(const LAS u32x4*)(Cl + t * BC_LD + k0 + quad * 8);
                    u32x4 aw; aw.x = cvt_pk_bf16(bflo(cw.x) * sc, bfhi(cw.x) * sc); aw.y = cvt_pk_bf16(bflo(cw.y) * sc, bfhi(cw.y) * sc);
                    aw.z = cvt_pk_bf16(bflo(cw.z) * sc, bfhi(cw.z) * sc); aw.w = cvt_pk_bf16(bflo(cw.w) * sc, bfhi(cw.w) * sc);
                    const bf16x8 af = __builtin_bit_cast(bf16x8, aw);
#pragma unroll
                    for (int pt = 0; pt < 4; ++pt) acc[tt][pt] = MFMA16(af, bs[pt], acc[tt][pt]); } }
        }
        const float Dh = arg_in(a, I_SD)[layer * 16 + h];
#pragma unroll
        for (int tt = 0; tt < 4; ++tt)
#pragma unroll
            for (int jj = 0; jj < 4; ++jj) { const int t = th * 64 + tt * 16 + quad * 4 + jj; const size_t r = (size_t)(row0 + t);
#pragma unroll
                for (int pt = 0; pt < 4; ++pt) { const int p = pt * 16 + row;
                    const float xs = bf2f(XSl[t * XS_LD + hl * 64 + p]); const float z = bf2f(P[r * NNG + P_Z + h * 64 + p]);
                    YB[r * 1024 + h * 64 + p] = (bf16_t)f2bf((acc[tt][pt][jj] + xs * Dh) * siluf_(z)); } }
    }
}
__device__ __forceinline__ void phase_mamba_norm(Frame& F, const Args& a, int layer) {
    bf16_t* YB = WSP(bf16_t, WS_Y) + (size_t)1 * T * 1024; const float* nw = arg_in(a, I_SNORM) + layer * 1024;
    for (int row = F.gw; row < T; row += F.NGW) {
        bf16_t* p = YB + (size_t)row * 1024 + F.lane * 16; float x[16]; { float t0[8], t1[8]; ld8bf(p, t0); ld8bf(p + 8, t1);
#pragma unroll
            for (int i = 0; i < 8; ++i) { x[i] = t0[i]; x[8 + i] = t1[i]; } }
        float s = 0.f;
#pragma unroll
        for (int i = 0; i < 16; ++i) s += x[i] * x[i];
        s = sum32(s);
        const float r = 1.f / sqrtf(s * (1.f / 512.f) + 1e-5f);
        float o0[8], o1[8];
#pragma unroll
        for (int i = 0; i < 8; ++i) { o0[i] = x[i] * r * nw[F.lane * 16 + i]; o1[i] = x[8 + i] * r * nw[F.lane * 16 + 8 + i]; }
        st8bf(p, o0); st8bf(p + 8, o1);
    }
}

__device__ __forceinline__ float dpp_f(float x, const int ctrl_sel) {
    const int xi = __builtin_bit_cast(int, x); int r;
    if (ctrl_sel == 0) r = __builtin_amdgcn_update_dpp(0, xi, 0xB1, 0xF, 0xF, false);
    else if (ctrl_sel == 1) r = __builtin_amdgcn_update_dpp(0, xi, 0x4E, 0xF, 0xF, false);
    else r = __builtin_amdgcn_update_dpp(0, xi, 0x141, 0xF, 0xF, false);
    return __builtin_bit_cast(float, r);
}
__device__ __forceinline__ float red8(float x) { x += dpp_f(x, 0); x += dpp_f(x, 1); x += dpp_f(x, 2); return x; }
__device__ __forceinline__ int rw_row(int pos, int b, int d) { return pos < CTX ? b * CTX + (d == 0 ? pos : CTX - 1 - pos) : TC + b * SEQ + (d == 0 ? pos - CTX : SEQ - 1 - (pos - CTX)); }
constexpr int RW_STEP_F = 336, RW_CH = 32, RW_CHF = RW_STEP_F * RW_CH;
struct RwOps { f32x4 w, k, b, a, r; float v; };
__device__ __forceinline__ void rw_load(RwOps& o, const LAS float* sp, const LAS float* vp) {
    o.w = *(const LAS f32x4*)(sp); o.k = *(const LAS f32x4*)(sp + 64); o.b = *(const LAS f32x4*)(sp + 128); o.a = *(const LAS f32x4*)(sp + 192); o.r = *(const LAS f32x4*)(sp + 256); o.v = *vp;
}
__device__ __forceinline__ void rw_step(f32x4& s, const RwOps& o, LAS float* yp) {
    const f32x4 tt = s * o.w + o.k * o.v;
    const f32x4 pa = s * o.a; float sa = (pa.x + pa.y) + (pa.z + pa.w); sa = sum16(sa);
    s = tt + o.b * sa;
    const f32x4 pr = s * o.r; *yp = (pr.x + pr.y) + (pr.z + pr.w);
}
struct RwRaw { float ew[8], ic[8], kk[8], rr[8], kr[8], vv[8]; };
__device__ __forceinline__ void phase_rwkv_scan(Frame& F, const Args& a, int layer) {
    const bf16_t* P2 = WSP(bf16_t, WS_P2); const bf16_t* EW = WSP(bf16_t, WS_EW); const bf16_t* ICLR = WSP(bf16_t, WS_ICLR); const bf16_t* KK = WSP(bf16_t, WS_KK);
    bf16_t* YRW = WSP(bf16_t, WS_YRW);
    LAS float* ring = (LAS float*)F.lds; LAS float* ybuf = (LAS float*)(F.lds + 2 * RW_CHF * 4);
    const int lane = F.lane;
    for (int u = F.bid; u < 256; u += F.G) {
        const int chain = u >> 2, rq = u & 3, d = chain >> 5, b = (chain >> 4) & 1, h = chain & 15;
        const float ka = arg_in(a, I_RKA)[layer * 1024 + h * 64 + lane];
        constexpr int NCH = (CTX + SEQ) / RW_CH;
        const int lw = F.wave - 4;
        auto issue = [&](RwRaw& x, int cidx) {
            const int row0 = rw_row(cidx * RW_CH, b, d), st = d == 0 ? 1 : -1;
            const int o0 = (row0 + st * lw) * 1024 + h * 64 + lane, ostep = st * 4 * 1024;
            const int q0 = (row0 + st * lw) * P2W + P2_RKV + h * 64 + lane, qstep = st * 4 * P2W;
            const bf16_t* ewp = EW + (size_t)d * T * 1024; const bf16_t* icp = ICLR + (size_t)d * T * 1024; const int vo = 2048 + rq * 16 + (lane & 15) - lane;
#pragma unroll
            for (int j = 0; j < 8; ++j) { const int o = o0 + j * ostep, q = q0 + j * qstep;
                x.ew[j] = bf2f(ewp[o]); x.ic[j] = bf2f(icp[o]); x.kk[j] = bf2f(KK[o]);
                x.rr[j] = bf2f(P2[q]); x.kr[j] = bf2f(P2[q + 1024]); x.vv[j] = bf2f(P2[q + vo]); } };
        auto commit = [&](const RwRaw& x, int cidx) {
            LAS float* dst = ring + (cidx & 1) * RW_CHF;
#pragma unroll
            for (int j = 0; j < 8; ++j) { LAS float* s = dst + (lw + 4 * j) * RW_STEP_F;
                s[lane] = __expf(-x.ew[j]); s[64 + lane] = x.kr[j] * (1.f + (x.ic[j] - 1.f) * ka); s[128 + lane] = x.kk[j] * x.ic[j]; s[192 + lane] = -x.kk[j]; s[256 + lane] = x.rr[j];
                if (lane < 16) s[320 + lane] = x.vv[j]; } };
        auto flush_chunk = [&](int cidx) {
            const LAS float* yb = ybuf + (cidx & 1) * (RW_CH * 256);
            const int row0 = rw_row(cidx * RW_CH, b, d), st = d == 0 ? 1 : -1;
#pragma unroll
            for (int q = 0; q < 2; ++q) { const int i = (F.tid - 256) + 256 * q, tok = i >> 4, rr = i & 15; const LAS f32x4* pp = (const LAS f32x4*)(yb + i * 16);
                const f32x4 p0 = pp[0], p1 = pp[1], p2 = pp[2], p3 = pp[3];
                const float y = ((p0.x + p0.y) + (p0.z + p0.w)) + ((p1.x + p1.y) + (p1.z + p1.w)) + (((p2.x + p2.y) + (p2.z + p2.w)) + ((p3.x + p3.y) + (p3.z + p3.w)));
                YRW[((size_t)d * T + row0 + st * tok) * 1024 + h * 64 + rq * 16 + rr] = (bf16_t)f2bf(y); } };
        auto compute = [&](f32x4& s, int c) {
            const int rloc = lane >> 4, kq = lane & 15, r16 = F.wave * 4 + rloc;
            const LAS float* base = ring + (c & 1) * RW_CHF + kq * 4; const LAS float* vb = ring + (c & 1) * RW_CHF + 320 + r16; LAS float* yb = ybuf + (c & 1) * (RW_CH * 256) + r16 * 16 + kq;
            RwOps oa, ob;
            rw_load(oa, base, vb);
#pragma unroll 2
            for (int t = 0; t < RW_CH; t += 2) {
                rw_load(ob, base + (t + 1) * RW_STEP_F, vb + (t + 1) * RW_STEP_F);
                rw_step(s, oa, yb + t * 256);
                if (t + 2 < RW_CH) rw_load(oa, base + (t + 2) * RW_STEP_F, vb + (t + 2) * RW_STEP_F);
                rw_step(s, ob, yb + (t + 1) * 256);
            } };
        __syncthreads();
        f32x4 s = {0.f, 0.f, 0.f, 0.f};
        if (F.wave >= 4) {
            RwRaw ra, rb;
            issue(ra, 0); commit(ra, 0); issue(ra, 1);
            __syncthreads();
            for (int c = 0; c < NCH; c += 2) {
                if (c + 2 < NCH) issue(rb, c + 2);
                if (c > 0) flush_chunk(c - 1);
                commit(ra, c + 1);
                __syncthreads();
                if (c + 3 < NCH) issue(ra, c + 3);
                flush_chunk(c);
                if (c + 2 < NCH) commit(rb, c + 2);
                __syncthreads();
            }
            flush_chunk(NCH - 1);
        } else {
            __syncthreads();
            for (int c = 0; c < NCH; c += 2) { compute(s, c); __syncthreads(); compute(s, c + 1); __syncthreads(); }
        }
    }
}
__device__ __forceinline__ void phase_rwkv_out(Frame& F, const Args& a, int layer) {
    const bf16_t* P2 = WSP(bf16_t, WS_P2); const bf16_t* ICLR = WSP(bf16_t, WS_ICLR); const bf16_t* YRW = WSP(bf16_t, WS_YRW); const bf16_t* GG = WSP(bf16_t, WS_GG);
    bf16_t* YD = WSP(bf16_t, WS_Y) + (size_t)3 * T * 1024;
    const float* lng = arg_in(a, I_RLNG) + layer * 1024; const float* lnb = arg_in(a, I_RLNB) + layer * 1024; const float* rk = arg_in(a, I_RRK) + layer * 1024; const float* kav = arg_in(a, I_RKA) + layer * 1024;
    for (int row = F.gw; row < T; row += F.NGW) {
        const int c = F.lane * 16; const size_t o = (size_t)row * 1024 + c;
        float y[16], r[16], k[16], v[16], i0[16], i1[16], g[16];
#define LD16(dst, ptr) do { float t0_[8], t1_[8]; ld8bf((ptr), t0_); ld8bf((ptr) + 8, t1_); _Pragma("unroll") for (int i_ = 0; i_ < 8; ++i_) { dst[i_] = t0_[i_]; dst[8 + i_] = t1_[i_]; } } while (0)
        LD16(y, YRW + o); LD16(r, YRW + (size_t)T * 1024 + o);
#pragma unroll
        for (int i = 0; i < 16; ++i) y[i] += r[i];
        const bf16_t* p2 = P2 + (size_t)row * P2W + P2_RKV + c;
        LD16(r, p2); LD16(k, p2 + 1024); LD16(v, p2 + 2048); LD16(i0, ICLR + o); LD16(i1, ICLR + (size_t)T * 1024 + o); LD16(g, GG + o);
#undef LD16
        float s = 0.f, bsum = 0.f;
#pragma unroll
        for (int i = 0; i < 16; ++i) { s += y[i]; const float ka = kav[c + i]; bsum += r[i] * k[i] * rk[c + i] * ((1.f + (i0[i] - 1.f) * ka) + (1.f + (i1[i] - 1.f) * ka)); }
        s = sum4(s); bsum = sum4(bsum);
        const float mu = s * (1.f / 64.f); float q = 0.f;
#pragma unroll
        for (int i = 0; i < 16; ++i) { const float dd = y[i] - mu; q += dd * dd; }
        q = sum4(q);
        const float rstd = 1.f / sqrtf(q * (1.f / 64.f) + 64e-5f);
        float o0[8], o1[8];
#pragma unroll
        for (int i = 0; i < 8; ++i) { o0[i] = ((y[i] - mu) * rstd * lng[c + i] + lnb[c + i] + bsum * v[i]) * g[i];
            o1[i] = ((y[8 + i] - mu) * rstd * lng[c + 8 + i] + lnb[c + 8 + i] + bsum * v[8 + i]) * g[8 + i]; }
        st8bf(YD + o, o0); st8bf(YD + o + 8, o1);
    }
}

constexpr int FFT_N = 16384;
__device__ __forceinline__ int fswz(int i) { return i ^ (((i >> 5) & 3) << 2) ^ (((i >> 6) & 1) << 4); }
__device__ __forceinline__ f32x2 cmul(f32x2 a, f32x2 b) { return (f32x2){a.x * b.x - a.y * b.y, a.x * b.y + a.y * b.x}; }
template <bool INV>
__device__ __forceinline__ void fft_passes(LAS f32x2* X, int tid) {
#pragma unroll 1
    for (int st = 0; st < 7; ++st) {
        const int lq = INV ? 2 * st : 12 - 2 * st;
        const int q = 1 << lq;
        __syncthreads();
#pragma unroll 2
        for (int mm = 0; mm < 8; ++mm) { const int uu = tid + 512 * mm; const int k = uu & (q - 1), blk = uu >> lq; const int i0 = (blk << (lq + 2)) + k;
            const int p0 = fswz(i0), p1 = fswz(i0 + q), p2 = fswz(i0 + 2 * q), p3 = fswz(i0 + 3 * q);
            f32x2 a0 = X[p0], a1 = X[p1], a2 = X[p2], a3 = X[p3];
            const float fr = (float)k / (float)(4 * q);
            const float cs = __builtin_amdgcn_cosf(fr), sn = __builtin_amdgcn_sinf(fr);
            const f32x2 w1 = INV ? (f32x2){cs, sn} : (f32x2){cs, -sn}; const f32x2 w2 = cmul(w1, w1), w3 = cmul(w2, w1);
            if (!INV) {
                const f32x2 t0 = a0 + a2, t1 = a0 - a2, t2 = a1 + a3, t3 = a1 - a3;
                const f32x2 b0 = t0 + t2, b2 = t0 - t2, b1 = (f32x2){t1.x + t3.y, t1.y - t3.x}, b3 = (f32x2){t1.x - t3.y, t1.y + t3.x};
                X[p0] = b0; X[p1] = cmul(b1, w1); X[p2] = cmul(b2, w2); X[p3] = cmul(b3, w3);
            } else {
                a1 = cmul(a1, w1); a2 = cmul(a2, w2); a3 = cmul(a3, w3);
                const f32x2 u0 = a0 + a2, u1 = a0 - a2, u2 = a1 + a3, u3 = a1 - a3;
                X[p0] = u0 + u2; X[p2] = u0 - u2; X[p1] = (f32x2){u1.x - u3.y, u1.y + u3.x}; X[p3] = (f32x2){u1.x + u3.y, u1.y - u3.x};
            } }
    }
    __syncthreads();
}
__device__ __forceinline__ void phase_hyena_fft(Frame& F, const Args& a, int layer) {
    const bf16_t* FILT = WSP(bf16_t, WS_FILT); float* VT = WSP(float, WS_VT); const float* hyd = arg_in(a, I_HD) + layer * 1024;
    LAS f32x2* X = (LAS f32x2*)F.lds;
    for (int c = F.bid; c < 1024; c += F.G) {
        __syncthreads();
        const bf16_t* hf = FILT + (size_t)c * 2 * SEQ; const bf16_t* hb = hf + SEQ;
        for (int i = F.tid; i < FFT_N; i += NTHREADS) { float v; if (i < SEQ) v = bf2f(hf[i]); else if (i == SEQ) v = 0.f; else v = bf2f(hb[FFT_N - i]); X[fswz(i)] = (f32x2){v, 0.f}; }
        fft_passes<false>(X, F.tid);
        f32x2 Kh[32];
#pragma unroll
        for (int j = 0; j < 32; ++j) Kh[j] = X[fswz(F.tid + 512 * j)];
        __syncthreads();
        const float* v0 = VT + (size_t)c * 2 * SEQ; const float* v1 = v0 + SEQ;
        for (int i = F.tid; i < FFT_N; i += NTHREADS) X[fswz(i)] = i < SEQ ? (f32x2){v0[i], v1[i]} : (f32x2){0.f, 0.f};
        fft_passes<false>(X, F.tid);
#pragma unroll
        for (int j = 0; j < 32; ++j) { const int p = fswz(F.tid + 512 * j); X[p] = cmul(X[p], Kh[j]); }
        fft_passes<true>(X, F.tid);
        const float dc = hyd[c]; float* o0 = VT + (size_t)c * 2 * SEQ; float* o1 = o0 + SEQ;
        for (int i = F.tid; i < SEQ; i += NTHREADS) { const f32x2 r = X[fswz(i)]; const float x0 = o0[i], x1 = o1[i];
            o0[i] = r.x * (1.f / FFT_N) + x0 * dc; o1[i] = r.y * (1.f / FFT_N) + x1 * dc; }
    }
}
__device__ __forceinline__ void phase_hyena_out(Frame& F, const Args& a, int layer) {
    const float* VT = WSP(float, WS_VT); const bf16_t* P2 = WSP(bf16_t, WS_P2); bf16_t* YC = WSP(bf16_t, WS_Y) + (size_t)2 * T * 1024;
    LAS float* tl = (LAS float*)F.lds;
    for (int u = F.bid; u < (TL / 64) * 4; u += F.G) {
        const int tb = u >> 2, cb = u & 3; const int row0 = TC + tb * 64; const int b = (row0 - TC) >> 13, t0 = (row0 - TC) & (SEQ - 1);
        __syncthreads();
        for (int p = 0; p < 8; ++p) { const int cl = p * 32 + (F.tid >> 4), q = F.tid & 15;
            const f32x4 v = *(const f32x4*)(VT + ((size_t)(cb * 256 + cl) * 2 + b) * SEQ + t0 + 4 * q);
            tl[cl * 65 + 4 * q] = v.x; tl[cl * 65 + 4 * q + 1] = v.y; tl[cl * 65 + 4 * q + 2] = v.z; tl[cl * 65 + 4 * q + 3] = v.w; }
        __syncthreads();
        const int cl = F.tid & 255, th = F.tid >> 8;
        for (int i = 0; i < 32; ++i) { const int tl_ = th * 32 + i; const size_t row = (size_t)(row0 + tl_);
            const float x0 = bf2f(P2[row * P2W + P2_X0 + cb * 256 + cl]);
            YC[row * 1024 + cb * 256 + cl] = (bf16_t)f2bf(tl[cl * 65 + tl_] * x0); }
    }
    const float* VC = WSP(float, WS_VC); const float* FC = WSP(float, WS_FILTC); const float* hyd = arg_in(a, I_HD) + layer * 1024;
    for (int e = F.bid * NTHREADS + F.tid; e < TC * 1024; e += F.G * NTHREADS) {
        const int row = e >> 10, c = e & 1023, b = row >> 8, t = row & 255; const float* vb = VC + (size_t)b * CTX * 1024 + c; float acc = 0.f;
        for (int s = 0; s <= t; ++s) acc += FC[(size_t)(t - s) * 2048 + c] * vb[(size_t)s * 1024];
        for (int s = t + 1; s < CTX; ++s) acc += FC[(size_t)(s - t) * 2048 + 1024 + c] * vb[(size_t)s * 1024];
        const float x0 = bf2f(P2[(size_t)row * P2W + P2_X0 + c]);
        YC[(size_t)row * 1024 + c] = (bf16_t)f2bf((acc + vb[(size_t)t * 1024] * hyd[c]) * x0);
    }
}

__device__ __forceinline__ void phase_ln1(Frame& F, const Args& a, int layer) {
    const float* mod = (const float*)(F.ws + WS_CTL) + CW_MOD + (size_t)layer * 3 * 6 * DM;
    const float* YM = WSP(float, WS_YMIX); float* XS = WSP(float, WS_XS); bf16_t* H2 = WSP(bf16_t, WS_H2); float* AFF = WSP(float, WS_AFF); int* INV = WSP(int, WS_INV);
    const float* g1w = arg_in(a, I_LN1G) + layer * DM; const float* b1w = arg_in(a, I_LN1B) + layer * DM; const float* wr = arg_in(a, I_WROUTER) + (size_t)layer * DM * NEXP;
    LAS float* wrT = (LAS float*)F.lds;
    __syncthreads();
    for (int i = F.tid; i < DM * NEXP; i += NTHREADS) { const int c = i >> 4, e = i & 15; wrT[e * DM + c] = wr[i]; }
    __syncthreads();
    int* PTOK = WSP(int, WS_PTOK); float* PG = WSP(float, WS_PGATE);
    for (int i = F.bid * NTHREADS + F.tid; i < NPAIR; i += F.G * NTHREADS) { PTOK[i] = -1; PG[i] = 0.f; }
    for (int row = F.gw; row < T; row += F.NGW) {
        const f32x4* xr = (const f32x4*)x_src_row(a, F, layer, row) + F.lane; const f32x4* yr = (const f32x4*)(YM + (size_t)row * DM) + F.lane;
        const float* m = mod + (size_t)row_modidx(row) * 6 * DM;
        f32x4 v[8];
#pragma unroll
        for (int j = 0; j < 8; ++j) { const int c = 4 * (64 * j + F.lane); v[j] = xr[64 * j] * ALPHA + *(const f32x4*)(m + 2 * DM + c) * yr[64 * j]; }
        float mean, rstd; row_stats(v, mean, rstd, 1e-6f);
        f32x4* xo = (f32x4*)(XS + (size_t)row * DM) + F.lane;
#pragma unroll
        for (int j = 0; j < 8; ++j) { const int c = 4 * (64 * j + F.lane); v[j] = (v[j] - mean) * rstd * *(const f32x4*)(g1w + c) + *(const f32x4*)(b1w + c); xo[64 * j] = v[j]; }
        row_stats(v, mean, rstd, 1e-6f);
        u32x2* ho = (u32x2*)(H2 + (size_t)row * DM) + F.lane;
        float lg[16];
#pragma unroll
        for (int e = 0; e < 16; ++e) lg[e] = 0.f;
#pragma unroll
        for (int j = 0; j < 8; ++j) { const int c = 4 * (64 * j + F.lane);
            const f32x4 y = (v[j] - mean) * rstd * (*(const f32x4*)(m + 4 * DM + c) + 1.f) + *(const f32x4*)(m + 3 * DM + c);
            u32x2 w; w.x = pk2(y.x, y.y); w.y = pk2(y.z, y.w); ho[64 * j] = w;
#pragma unroll
            for (int e = 0; e < 16; ++e) { const f32x4 ww = *(const LAS f32x4*)(wrT + e * DM + c); lg[e] += (y.x * ww.x + y.y * ww.y) + (y.z * ww.z + y.w * ww.w); } }
        float mx = -1e30f;
#pragma unroll
        for (int e = 0; e < 16; ++e) { lg[e] = wave_sum(lg[e]); mx = fmaxf(mx, lg[e]); }
        float den = 0.f;
#pragma unroll
        for (int e = 0; e < 16; ++e) { lg[e] = __expf(lg[e] - mx); den += lg[e]; }
        float mine = 0.f;
#pragma unroll
        for (int e = 0; e < 16; ++e) mine = (F.lane == e) ? lg[e] : mine;
        if (F.lane < 16) { AFF[(size_t)row * 16 + F.lane] = mine / den; INV[(size_t)row * 16 + F.lane] = -1; }
    }
}
__device__ __forceinline__ void phase_topk(Frame& F) {
    const float* AFF = WSP(float, WS_AFF); int* INV = WSP(int, WS_INV); int* PTOK = WSP(int, WS_PTOK); float* PG = WSP(float, WS_PGATE);
    LAS unsigned* vals = (LAS unsigned*)F.lds; LAS unsigned* hist = vals + 8192; LAS unsigned* ctl = hist + 256;
    for (int u = F.bid; u < 64; u += F.G) {
        const int s = u >> 4, e = u & 15, rs = seg_start(s), n = seg_len(s), cap = s < 2 ? CAP_C : CAP_L;
        __syncthreads();
        for (int i = F.tid; i < n; i += NTHREADS) vals[i] = __builtin_bit_cast(unsigned, AFF[(size_t)(rs + i) * 16 + e]);
        if (F.tid == 0) { ctl[0] = 0u; ctl[1] = (unsigned)cap; ctl[2] = 0u; ctl[3] = 0u; }
        unsigned mask = 0u;
        for (int shift = 24; shift >= 0; shift -= 8) {
            if (F.tid < 256) hist[F.tid] = 0u;
            __syncthreads();
            const unsigned prefix = ctl[0];
            for (int i = F.tid; i < n; i += NTHREADS) { const unsigned b = vals[i]; if ((b & mask) == prefix) __hip_atomic_fetch_add(&hist[(b >> shift) & 255u], 1u, __ATOMIC_RELAXED, __HIP_MEMORY_SCOPE_WORKGROUP); }
            __syncthreads();
            if (F.tid == 0) { unsigned rem = ctl[1], cum = 0u; int dg = 255; for (; dg > 0; --dg) { const unsigned hc = hist[dg]; if (cum + hc >= rem) break; cum += hc; }
                ctl[1] = rem - cum; ctl[0] = prefix | ((unsigned)dg << shift); }
            mask |= 255u << shift;
            __syncthreads();
        }
        const unsigned thr = ctl[0], rem = ctl[1]; const unsigned ngt = (unsigned)cap - rem;
        const int pbase = s < 2 ? NBATCH * NEXP * CAP_L + e * 256 + s * CAP_C : ((s - 2) * NEXP + e) * CAP_L;
        for (int i = F.tid; i < n; i += NTHREADS) { const unsigned b = vals[i]; int slot = -1;
            if (b > thr) slot = (int)__hip_atomic_fetch_add(&ctl[2], 1u, __ATOMIC_RELAXED, __HIP_MEMORY_SCOPE_WORKGROUP);
            else if (b == thr) { const unsigned q = __hip_atomic_fetch_add(&ctl[3], 1u, __ATOMIC_RELAXED, __HIP_MEMORY_SCOPE_WORKGROUP); if (q < rem) slot = (int)(ngt + q); }
            if (slot >= 0) { const int pair = pbase + slot, row = rs + i; PTOK[pair] = row; PG[pair] = __builtin_bit_cast(float, b); INV[(size_t)row * 16 + e] = pair; } }
    }
}
__device__ __forceinline__ void phase_gather(Frame& F) {
    const bf16_t* H2 = WSP(bf16_t, WS_H2); bf16_t* XG = WSP(bf16_t, WS_XG); const int* PTOK = WSP(int, WS_PTOK);
    for (int p = F.gw; p < NPAIR; p += F.NGW) { const int tok = PTOK[p]; u32x4* dst = (u32x4*)(XG + (size_t)p * DM) + F.lane;
        if (tok >= 0) { const u32x4* src = (const u32x4*)(H2 + (size_t)tok * DM) + F.lane;
#pragma unroll
            for (int j = 0; j < 4; ++j) dst[64 * j] = src[64 * j]; }
        else {
#pragma unroll
            for (int j = 0; j < 4; ++j) { unsigned zz = 0u; asm volatile("" : "+v"(zz)); dst[64 * j] = (u32x4){zz, zz, zz, zz}; } } }
}
__device__ __forceinline__ void phase_ln2(Frame& F, const Args& a, int layer) {
    const float* mod = (const float*)(F.ws + WS_CTL) + CW_MOD + (size_t)layer * 3 * 6 * DM;
    float* XS = WSP(float, WS_XS); const bf16_t* YE = WSP(bf16_t, WS_YE); const int* INV = WSP(int, WS_INV);
    const float* g2w = arg_in(a, I_LN2G) + layer * DM; const float* b2w = arg_in(a, I_LN2B) + layer * DM;
    for (int row = F.gw; row < T; row += F.NGW) {
        f32x4* xr = (f32x4*)(XS + (size_t)row * DM) + F.lane; const float* m = mod + (size_t)row_modidx(row) * 6 * DM;
        f32x4 mo[8];
#pragma unroll
        for (int j = 0; j < 8; ++j) mo[j] = (f32x4){0.f, 0.f, 0.f, 0.f};
        for (int e = 0; e < 16; ++e) { const int pair = INV[(size_t)row * 16 + e];
            if (pair >= 0) { const u32x2* yr = (const u32x2*)(YE + (size_t)pair * DM) + F.lane;
#pragma unroll
                for (int j = 0; j < 8; ++j) { const u32x2 w = yr[64 * j]; mo[j] += (f32x4){bflo(w.x), bfhi(w.x), bflo(w.y), bfhi(w.y)}; } } }
        f32x4 v[8];
#pragma unroll
        for (int j = 0; j < 8; ++j) { const int c = 4 * (64 * j + F.lane); v[j] = xr[64 * j] * ALPHA + *(const f32x4*)(m + 5 * DM + c) * mo[j]; }
        float mean, rstd; row_stats(v, mean, rstd, 1e-6f);
#pragma unroll
        for (int j = 0; j < 8; ++j) { const int c = 4 * (64 * j + F.lane); v[j] = (v[j] - mean) * rstd * *(const f32x4*)(g2w + c) + *(const f32x4*)(b2w + c); xr[64 * j] = v[j]; }
        if (layer == DEPTH - 1 && row >= TC) { f32x4* o = (f32x4*)(a.out + (size_t)(row - TC) * DM) + F.lane;
#pragma unroll
            for (int j = 0; j < 8; ++j) o[64 * j] = v[j]; }
    }
}

constexpr int LDS_BYTES = 153600, MISC_OFF = LDS_BYTES - 64;
constexpr int NPL = 16, NPHASE = 1 + DEPTH * NPL;

__global__ void __launch_bounds__(NTHREADS, 2) fwd_kernel(Args args) {
    extern __shared__ __attribute__((aligned(16))) unsigned char lds_raw[];
    Frame F;
    F.lds = (LAS unsigned char*)lds_raw;
    F.tid = threadIdx.x; F.lane = F.tid & 63; F.wave = __builtin_amdgcn_readfirstlane(F.tid >> 6);
    F.G = gridDim.x; F.bid = blockIdx.x; F.gw = F.bid * NWAVES + F.wave; F.NGW = F.G * NWAVES; F.ws = args.ws;
    volatile LAS unsigned* misc = (volatile LAS unsigned*)(F.lds + MISC_OFF);
    if (F.tid < 16) misc[F.tid] = 0u;
    __syncthreads();
    const int lo = args.ph_lo, hi = args.ph_hi;
    XcdBarrier bar; bar.bar = (unsigned*)(F.ws + WS_CTL) + CW_BAR; bar.x = 0; bar.st = nullptr;
    const bool multi = (hi - lo) > 1;
    if (multi) bar = xcd_barrier_post((unsigned*)(F.ws + WS_CTL) + CW_BAR, misc);
#ifndef ONLY_PHASE
#define ONLY_PHASE -1
#endif
#define PON(r) (ONLY_PHASE < 0 || ONLY_PHASE == (r))
#ifndef REP_MASK
#define REP_MASK 0
#endif
#define REP(b) ((REP_MASK >> (b)) & 1)
#define REOPQ() do { F.ws = opq(args.ws); F.tid = opqv(threadIdx.x); F.lane = F.tid & 63; F.G = opqs(gridDim.x); F.bid = opqs(blockIdx.x); F.wave = __builtin_amdgcn_readfirstlane(F.tid >> 6); F.gw = F.bid * NWAVES + F.wave; F.NGW = F.G * NWAVES; } while (0)
#define IN(k) (lo <= (k) && (k) < hi)
#define SEAM(k) do { if (IN(k) && IN((k) + 1)) { XcdBarrier bb_ = bar; bb_.x = (unsigned)opqs((int)bar.x); xcd_barrier(bb_); } } while (0)
    if (PON(100) && IN(0)) { F.ws = opq(args.ws); F.tid = opqv(threadIdx.x); F.lane = F.tid & 63; F.G = opqs(gridDim.x); F.bid = opqs(blockIdx.x); F.wave = __builtin_amdgcn_readfirstlane(F.tid >> 6); F.gw = F.bid * NWAVES + F.wave; F.NGW = F.G * NWAVES; for (int r_ = 0, n_ = opqs(1 + REP(0)); r_ < n_; ++r_) { p0_weights(F, args); REOPQ(); p0_mod(F, args); __syncthreads(); } }
    SEAM(0);
#pragma unroll 1
    for (int layer = 0; layer < DEPTH; ++layer) {
        const int pb = 1 + layer * NPL;
        if (PON(0) && IN(pb + 0)) { F.ws = opq(args.ws); F.tid = opqv(threadIdx.x); F.lane = F.tid & 63; F.G = opqs(gridDim.x); F.bid = opqs(blockIdx.x); F.wave = __builtin_amdgcn_readfirstlane(F.tid >> 6); F.gw = F.bid * NWAVES + F.wave; F.NGW = F.G * NWAVES; phase_modln(F, args, layer); REOPQ(); phase_hdn(F, args, layer); __syncthreads(); if (REP(1)) { phase_modln(F, args, layer); REOPQ(); phase_hdn(F, args, layer); __syncthreads(); } }
        SEAM(pb + 0);
        if (PON(1) && IN(pb + 1)) { F.ws = opq(args.ws); F.tid = opqv(threadIdx.x); F.lane = F.tid & 63; F.G = opqs(gridDim.x); F.bid = opqs(blockIdx.x); F.wave = __builtin_amdgcn_readfirstlane(F.tid >> 6); F.gw = F.bid * NWAVES + F.wave; F.NGW = F.G * NWAVES;
            pg8::Gemm g{WSP(bf16_t, WS_H), WSP(bf16_t, WS_WIN + layer * SZ_WIN), DM, DM, DM}; pg8::StaticOrder S; S.init(66, NNG / 256, F.G, F.bid);
            EpiBf16 E{WSP(bf16_t, WS_P), NNG, nullptr, 0, 0};
            for (int r_ = 0, n_ = opqs(1 + REP(2)); r_ < n_; ++r_) pg8::gemm_phase(F.lds, g, S, E);
        }
        SEAM(pb + 1);
        if (PON(2) && IN(pb + 2)) { F.ws = opq(args.ws); F.tid = opqv(threadIdx.x); F.lane = F.tid & 63; F.G = opqs(gridDim.x); F.bid = opqs(blockIdx.x); F.wave = __builtin_amdgcn_readfirstlane(F.tid >> 6); F.gw = F.bid * NWAVES + F.wave; F.NGW = F.G * NWAVES; for (int r_ = 0, n_ = opqs(1 + REP(3)); r_ < n_; ++r_) { phase_prep(F, args, layer); REOPQ(); phase_filt(F, args, layer); __syncthreads(); } }
        SEAM(pb + 2);
        if (PON(3) && IN(pb + 3)) { F.ws = opq(args.ws); F.tid = opqv(threadIdx.x); F.lane = F.tid & 63; F.G = opqs(gridDim.x); F.bid = opqs(blockIdx.x); F.wave = __builtin_amdgcn_readfirstlane(F.tid >> 6); F.gw = F.bid * NWAVES + F.wave; F.NGW = F.G * NWAVES;
#if !defined(T3) || T3 == 0
            { pg8::Gemm g{WSP(bf16_t, WS_P) + P_CQ, WSP(bf16_t, WS_WQ + layer * SZ_WQ), NNG, 512, 512}; pg8::StaticOrder S; S.init(66, 6, F.G, F.bid);
              EpiBf16 E{WSP(bf16_t, WS_Q), 1536, WSP(float, WS_RS), 2, 0}; pg8::gemm_phase(F.lds, g, S, E); if (REP(4)) pg8::gemm_phase(F.lds, g, S, E); }
#endif
#if !defined(T3) || T3 == 1
            { pg8::Gemm g{WSP(bf16_t, WS_P) + P_CKV, WSP(bf16_t, WS_WKV + layer * SZ_WKV), NNG, 512, 512}; pg8::StaticOrder S; S.init(66, 8, F.G, F.bid);
              EpiBf16 E{WSP(bf16_t, WS_KV), 2048, WSP(float, WS_RS) + 1, 2, 0}; pg8::gemm_phase(F.lds, g, S, E); if (REP(4)) pg8::gemm_phase(F.lds, g, S, E); }
#endif
#if !defined(T3) || T3 == 2
            { pg8::Gemm g{WSP(bf16_t, WS_ALORA), WSP(bf16_t, WS_WLORA + layer * SZ_WLORA), 512, 512, 512}; pg8::StaticOrder S; S.init(66, 20, F.G, F.bid);
              EpiLora E{WSP(bf16_t, WS_EW), WSP(bf16_t, WS_ICLR), WSP(bf16_t, WS_GG), arg_in(args, I_RW0) + layer * 2048, arg_in(args, I_RA0) + layer * 2048}; pg8::gemm_phase(F.lds, g, S, E); if (REP(4)) pg8::gemm_phase(F.lds, g, S, E); }
#endif
        }
        SEAM(pb + 3);
        if (PON(4) && IN(pb + 4)) { F.ws = opq(args.ws); F.tid = opqv(threadIdx.x); F.lane = F.tid & 63; F.G = opqs(gridDim.x); F.bid = opqs(blockIdx.x); F.wave = __builtin_amdgcn_readfirstlane(F.tid >> 6); F.gw = F.bid * NWAVES + F.wave; F.NGW = F.G * NWAVES; phase_qrope(F); REOPQ(); phase_mamba_states(F, args, layer); __syncthreads(); if (REP(5)) { REOPQ(); phase_mamba_states(F, args, layer); __syncthreads(); } }
        SEAM(pb + 4);
        if (PON(5) && IN(pb + 5)) { F.ws = opq(args.ws); F.tid = opqv(threadIdx.x); F.lane = F.tid & 63; F.G = opqs(gridDim.x); F.bid = opqs(blockIdx.x); F.wave = __builtin_amdgcn_readfirstlane(F.tid >> 6); F.gw = F.bid * NWAVES + F.wave; F.NGW = F.G * NWAVES;
#if !defined(T5) || T5 == 0
            phase_rwkv_scan(F, args, layer); __syncthreads();
            if (REP(6)) { phase_rwkv_scan(F, args, layer); __syncthreads(); }
#endif
#if !defined(T5) || T5 == 1
            for (int r_ = 0, n_ = opqs(1 + REP(7)); r_ < n_; ++r_) REOPQ(); phase_attn(F);
#endif
#if !defined(T5) || T5 == 2
            REOPQ(); phase_hyena_fft(F, args, layer);
#endif
#if !defined(T5) || T5 == 3
            REOPQ(); phase_mamba_scan(F); __syncthreads();
#endif
        }
        SEAM(pb + 5);
        if (PON(6) && IN(pb + 6)) { F.ws = opq(args.ws); F.tid = opqv(threadIdx.x); F.lane = F.tid & 63; F.G = opqs(gridDim.x); F.bid = opqs(blockIdx.x); F.wave = __builtin_amdgcn_readfirstlane(F.tid >> 6); F.gw = F.bid * NWAVES + F.wave; F.NGW = F.G * NWAVES;
#if !defined(T6) || T6 == 0
            phase_mamba_out(F, args, layer); __syncthreads();
            if (REP(8)) { phase_mamba_out(F, args, layer); __syncthreads(); }
#endif
#if !defined(T6) || T6 == 1
            REOPQ(); phase_hyena_out(F, args, layer);
#endif
#if !defined(T6) || T6 == 2
            REOPQ(); phase_rwkv_out(F, args, layer); __syncthreads();
            if (REP(9)) { REOPQ(); phase_hyena_out(F, args, layer); REOPQ(); phase_rwkv_out(F, args, layer); __syncthreads(); }
#endif
        }
        SEAM(pb + 6);
        if (PON(7) && IN(pb + 7)) { F.ws = opq(args.ws); F.tid = opqv(threadIdx.x); F.lane = F.tid & 63; F.G = opqs(gridDim.x); F.bid = opqs(blockIdx.x); F.wave = __builtin_amdgcn_readfirstlane(F.tid >> 6); F.gw = F.bid * NWAVES + F.wave; F.NGW = F.G * NWAVES;
            pg8::Gemm g{WSP(bf16_t, WS_H), WSP(bf16_t, WS_WIN + layer * SZ_WIN) + (size_t)NNG * DM, DM, DM, DM}; pg8::StaticOrder S; S.init(66, NGATE / 256, F.G, F.bid);
            EpiBf16 E{WSP(bf16_t, WS_GATES), NGATE, nullptr, 0, 1};
            for (int r_ = 0, n_ = opqs(1 + REP(10)); r_ < n_; ++r_) pg8::gemm_phase(F.lds, g, S, E);
            REOPQ(); phase_mamba_norm(F, args, layer);
        }
        SEAM(pb + 7);
        if (PON(8) && IN(pb + 8)) { F.ws = opq(args.ws); F.tid = opqv(threadIdx.x); F.lane = F.tid & 63; F.G = opqs(gridDim.x); F.bid = opqs(blockIdx.x); F.wave = __builtin_amdgcn_readfirstlane(F.tid >> 6); F.gw = F.bid * NWAVES + F.wave; F.NGW = F.G * NWAVES;
            pg8::Gemm g{WSP(bf16_t, WS_Y), WSP(bf16_t, WS_WBR + layer * SZ_WBR), 1024, 1024, 1024}; OrderMerge S; S.init(F.G, F.bid);
            EpiMerge E{WSP(bf16_t, WS_GATES), WSP(float, WS_MRGF), WSP(bf16_t, WS_MRGB)};
            pg8::gemm_phase(F.lds, g, S, E);
            if (REP(11)) pg8::gemm_phase(F.lds, g, S, E);
        }
        SEAM(pb + 8);
        if (PON(9) && IN(pb + 9)) { F.ws = opq(args.ws); F.tid = opqv(threadIdx.x); F.lane = F.tid & 63; F.G = opqs(gridDim.x); F.bid = opqs(blockIdx.x); F.wave = __builtin_amdgcn_readfirstlane(F.tid >> 6); F.gw = F.bid * NWAVES + F.wave; F.NGW = F.G * NWAVES;
            pg8::Gemm g{WSP(bf16_t, WS_MRGB), WSP(bf16_t, WS_WOUT + layer * SZ_WOUT), DM, DM, DM}; pg8::StaticOrder S; S.init(66, 8, F.G, F.bid);
            EpiF32 E{WSP(float, WS_YMIX), DM};
            pg8::gemm_phase(F.lds, g, S, E);
            if (REP(12)) pg8::gemm_phase(F.lds, g, S, E);
        }
        SEAM(pb + 9);
        if (PON(10) && IN(pb + 10)) { F.ws = opq(args.ws); F.tid = opqv(threadIdx.x); F.lane = F.tid & 63; F.G = opqs(gridDim.x); F.bid = opqs(blockIdx.x); F.wave = __builtin_amdgcn_readfirstlane(F.tid >> 6); F.gw = F.bid * NWAVES + F.wave; F.NGW = F.G * NWAVES; phase_ln1(F, args, layer); __syncthreads(); for (int r_ = 0, n_ = opqs(1 + REP(13)); r_ < n_; ++r_) { REOPQ(); conv_experts(F, args, layer); __syncthreads(); } }
        SEAM(pb + 10);
        if (PON(11) && IN(pb + 11)) { F.ws = opq(args.ws); F.tid = opqv(threadIdx.x); F.lane = F.tid & 63; F.G = opqs(gridDim.x); F.bid = opqs(blockIdx.x); F.wave = __builtin_amdgcn_readfirstlane(F.tid >> 6); F.gw = F.bid * NWAVES + F.wave; F.NGW = F.G * NWAVES; phase_topk(F); __syncthreads(); if (REP(14)) { phase_topk(F); __syncthreads(); } }
        SEAM(pb + 11);
        if (PON(12) && IN(pb + 12)) { F.ws = opq(args.ws); F.tid = opqv(threadIdx.x); F.lane = F.tid & 63; F.G = opqs(gridDim.x); F.bid = opqs(blockIdx.x); F.wave = __builtin_amdgcn_readfirstlane(F.tid >> 6); F.gw = F.bid * NWAVES + F.wave; F.NGW = F.G * NWAVES; phase_gather(F); if (REP(15)) phase_gather(F); }
        SEAM(pb + 12);
        if (PON(13) && IN(pb + 13)) { F.ws = opq(args.ws); F.tid = opqv(threadIdx.x); F.lane = F.tid & 63; F.G = opqs(gridDim.x); F.bid = opqs(blockIdx.x); F.wave = __builtin_amdgcn_readfirstlane(F.tid >> 6); F.gw = F.bid * NWAVES + F.wave; F.NGW = F.G * NWAVES;
            pg8::Gemm g{WSP(bf16_t, WS_XG), WSP(bf16_t, WS_WE), DM, DM, DM}; OrderMoe S; S.init(11, F.G, F.bid);
            EpiSwiglu E{WSP(bf16_t, WS_HID)};
            pg8::gemm_phase(F.lds, g, S, E);
            if (REP(16)) pg8::gemm_phase(F.lds, g, S, E);
        }
        SEAM(pb + 13);
        if (PON(14) && IN(pb + 14)) { F.ws = opq(args.ws); F.tid = opqv(threadIdx.x); F.lane = F.tid & 63; F.G = opqs(gridDim.x); F.bid = opqs(blockIdx.x); F.wave = __builtin_amdgcn_readfirstlane(F.tid >> 6); F.gw = F.bid * NWAVES + F.wave; F.NGW = F.G * NWAVES;
            pg8::Gemm g{WSP(bf16_t, WS_HID), WSP(bf16_t, WS_WE + SZ_WGU), EFF, EFF, EFF}; OrderMoe S; S.init(8, F.G, F.bid);
            EpiDown E{WSP(bf16_t, WS_YE), WSP(float, WS_PGATE)};
            pg8::gemm_phase(F.lds, g, S, E);
            if (REP(17)) pg8::gemm_phase(F.lds, g, S, E);
        }
        SEAM(pb + 14);
        if (PON(15) && IN(pb + 15)) { F.ws = opq(args.ws); F.tid = opqv(threadIdx.x); F.lane = F.tid & 63; F.G = opqs(gridDim.x); F.bid = opqs(blockIdx.x); F.wave = __builtin_amdgcn_readfirstlane(F.tid >> 6); F.gw = F.bid * NWAVES + F.wave; F.NGW = F.G * NWAVES; phase_ln2(F, args, layer); }
        SEAM(pb + 15);
    }
#undef IN
#undef SEAM
}


#ifdef DBG_CUT
__global__ void dbg_dump(const unsigned char* ws, float* out, size_t off, int is_bf16, size_t n_src) {
    const size_t N = (size_t)TL * DM;
    for (size_t i = (size_t)blockIdx.x * blockDim.x + threadIdx.x; i < N; i += (size_t)gridDim.x * blockDim.x) {
        const size_t j = i % n_src;
        out[i] = is_bf16 ? bf2f(((const bf16_t*)(ws + off))[j]) : ((const float*)(ws + off))[j];
    }
}
#endif

#ifdef DBG_PASSES
__global__ void dbg_chk(const unsigned char* base, size_t off, size_t nbytes, unsigned long long* slot) {
    const unsigned* p = (const unsigned*)(base + off); const size_t n = nbytes / 4; unsigned long long s = 0;
    for (size_t i = (size_t)blockIdx.x * blockDim.x + threadIdx.x; i < n; i += (size_t)gridDim.x * blockDim.x) s += p[i];
    for (int o = 32; o > 0; o >>= 1) s += __shfl_xor(s, o);
    if ((threadIdx.x & 63) == 0) atomicAdd(slot, s);
}
__global__ void dbg_report(const unsigned long long* tab, float* out, int npass) {
    int k = 0;
    for (int ph = NPHASE - 1; ph >= 0; --ph) if (tab[ph] != tab[64 + ph]) k = ph + 1;
    if (k == 0 && npass > 2) { for (int ph = NPHASE - 1; ph >= 0; --ph) if (tab[64 + ph] != tab[128 + ph]) k = 50 + ph + 1; }
    if (k == 0) return;
    const float c = sqrtf(10.f * (float)k);
    for (size_t i = (size_t)blockIdx.x * blockDim.x + threadIdx.x; i < (size_t)TL * DM; i += (size_t)gridDim.x * blockDim.x) out[i] = c;
}
struct DbgReg { size_t off, n; };
#endif
extern "C" void kernel_launch(void* const* d_in, const int* in_sizes, int n_in, void* d_out, int out_size, void* d_ws, size_t ws_size, hipStream_t stream) {
    static int grid = 0;
    if (grid == 0) {
        if (n_in != N_INPUTS || in_sizes[0] != TL * DM || out_size != TL * DM || ws_size < WS_END) {
            fprintf(stderr, "kernel_launch: shape/workspace mismatch: n_in %d in0 %d out %d ws %zu (need %zu)\n", n_in, n_in > 0 ? in_sizes[0] : -1, out_size, ws_size, (size_t)WS_END); grid = -1; return; }
        int dev = 0, cus = 0, per_cu = 0;
        if (hipGetDevice(&dev) != hipSuccess || hipDeviceGetAttribute(&cus, hipDeviceAttributeMultiprocessorCount, dev) != hipSuccess) { grid = -1; return; }
        if (hipFuncSetAttribute((const void*)fwd_kernel, hipFuncAttributeMaxDynamicSharedMemorySize, LDS_BYTES) != hipSuccess) { fprintf(stderr, "kernel_launch: hipFuncSetAttribute failed\n"); grid = -1; return; }
        if (hipOccupancyMaxActiveBlocksPerMultiprocessor(&per_cu, (const void*)fwd_kernel, NTHREADS, LDS_BYTES) != hipSuccess || per_cu < 1) { fprintf(stderr, "kernel_launch: occupancy query says %d\n", per_cu); grid = -1; (void)hipGetLastError(); return; }
        grid = cus;
    }
    if (grid < 0) return;
    (void)hipMemsetAsync((char*)d_ws + WS_CTL, 0, CTL_BYTES, stream);
    Args a{};
    for (int i = 0; i < N_INPUTS; ++i) a.in[i] = (const float*)d_in[i];
    a.out = (float*)d_out; a.ws = (unsigned char*)d_ws;
#if MK_ONE_LAUNCH
    a.ph_lo = 0; a.ph_hi = NPHASE;
    hipLaunchKernelGGL(fwd_kernel, dim3(grid), dim3(NTHREADS), LDS_BYTES, stream, a);
#else
#ifdef DBG_PASSES
    {
        unsigned long long* tab = (unsigned long long*)((char*)d_ws + 1600000);
        auto chk = [&](int pass, int ph, size_t off, size_t n) { hipLaunchKernelGGL(dbg_chk, dim3(1024), dim3(256), 0, stream, (const unsigned char*)d_ws, off, n, tab + pass * 64 + ph); };
        for (int pass = 0; pass < DBG_PASSES; ++pass) {
            if (pass > 0) (void)hipMemsetAsync((char*)d_ws + (size_t)CW_MOD * 4, 0, (size_t)DEPTH * 3 * 6 * DM * 4, stream);
            for (int ph = 0; ph < NPHASE; ++ph) {
                a.ph_lo = ph; a.ph_hi = ph + 1; hipLaunchKernelGGL(fwd_kernel, dim3(grid), dim3(NTHREADS), LDS_BYTES, stream, a);
                if (ph == 0) { chk(pass, ph, WS_WIN, WS_XS - WS_WIN); chk(pass, ph, (size_t)CW_MOD * 4, (size_t)DEPTH * 3 * 6 * DM * 4); continue; }
                const int r = (ph - 1) % NPL;
                switch (r) {
                case 0: chk(pass, ph, WS_H, SZ_H); chk(pass, ph, WS_HDN, SZ_HDN); break;
                case 1: chk(pass, ph, WS_P, SZ_P); break;
                case 2: chk(pass, ph, WS_P2, SZ_P2); chk(pass, ph, WS_KK, SZ_TK2); chk(pass, ph, WS_ALORA, WS_VT - WS_ALORA); chk(pass, ph, WS_VT, WS_HDN - WS_VT); break;
                case 3: chk(pass, ph, WS_Q, SZ_Q + SZ_KV); chk(pass, ph, WS_EW, 4 * SZ_TK2); chk(pass, ph, WS_GG, SZ_TK2); break;
                case 4: chk(pass, ph, WS_Q, SZ_Q); chk(pass, ph, WS_MST, SZ_MST + SZ_MCS); break;
                case 5: chk(pass, ph, WS_YRW, 2 * SZ_TK2); chk(pass, ph, WS_Y, SZ_Y / 4); chk(pass, ph, WS_VT, SZ_VT); chk(pass, ph, WS_MST, SZ_MST); break;
                case 6: chk(pass, ph, WS_Y + SZ_Y / 4, 3 * (SZ_Y / 4)); break;
                case 7: chk(pass, ph, WS_GATES, SZ_GATES); chk(pass, ph, WS_Y + SZ_Y / 4, SZ_Y / 4); break;
                case 8: chk(pass, ph, WS_MRGF, SZ_MRGF); chk(pass, ph, WS_MRGB, SZ_MRGB); break;
                case 9: chk(pass, ph, WS_YMIX, SZ_YMIX); break;
                case 10: chk(pass, ph, WS_XS, SZ_XS); chk(pass, ph, WS_H2, SZ_H); chk(pass, ph, WS_AFF, SZ_AFF); chk(pass, ph, WS_WE, SZ_WGU + SZ_WD); break;
                case 11: chk(pass, ph, WS_INV, SZ_INV + SZ_PTOK + SZ_PGATE); break;
                case 12: chk(pass, ph, WS_XG, SZ_XG); break;
                case 13: chk(pass, ph, WS_HID, SZ_HID); break;
                case 14: chk(pass, ph, WS_YE, SZ_YE); break;
                case 15: chk(pass, ph, WS_XS, SZ_XS); break;
                }
            }
        }
        hipLaunchKernelGGL(dbg_report, dim3(2048), dim3(256), 0, stream, (const unsigned long long*)tab, (float*)d_out, (int)DBG_PASSES);
    }
#elif defined(DBG_CUT)
    for (int ph = 0; ph < DBG_CUT; ++ph) { a.ph_lo = ph; a.ph_hi = ph + 1; hipLaunchKernelGGL(fwd_kernel, dim3(grid), dim3(NTHREADS), LDS_BYTES, stream, a); }
    hipLaunchKernelGGL(dbg_dump, dim3(2048), dim3(256), 0, stream, (const unsigned char*)d_ws, (float*)d_out, (size_t)DBG_OFF, DBG_BF16, (size_t)DBG_N);
#else
    for (int ph = 0; ph < NPHASE; ++ph) { a.ph_lo = ph; a.ph_hi = ph + 1; hipLaunchKernelGGL(fwd_kernel, dim3(grid), dim3(NTHREADS), LDS_BYTES, stream, a); }
#endif
#endif
}
```

```cpp
#include <hip/hip_runtime.h>
#include <cstdio>
#include <cstdint>

#define REP_MASK 0x80000
#ifndef MK_ONE_LAUNCH
#define MK_ONE_LAUNCH 1
#endif

#define LAS __attribute__((address_space(3)))
typedef unsigned short bf16_t;
typedef short bf16x8 __attribute__((ext_vector_type(8)));
typedef float f32x4 __attribute__((ext_vector_type(4)));
typedef float f32x2 __attribute__((ext_vector_type(2)));
typedef unsigned u32x4 __attribute__((ext_vector_type(4)));
typedef unsigned u32x2 __attribute__((ext_vector_type(2)));

constexpr int DM = 2048, NBATCH = 2, SEQ = 8192, CTX = 256, DEPTH = 2;
constexpr int TC = NBATCH * CTX, TL = NBATCH * SEQ, T = TC + TL;
constexpr int NIN = 18432, NNG = 10240, NGATE = 8192;
constexpr int P_CQ = 0, P_CKV = 512, P_KPE = 1024;
constexpr int P_Z = 1088, P_XBC = 2112, P_DT = 3648;
constexpr int P_HY = 3680;
constexpr int P_RW = 6752, P_WD = 9824, P_AD = 9952, P_GD = 10080;
constexpr int NH_MLA = 8, NH_SSM = 16, NH_RW = 16;
constexpr int NEXP = 16, EFF = 1408, CAP_L = 1024, CAP_C = 32;
constexpr int NPAIR = NBATCH * NEXP * CAP_L + NEXP * 256;
constexpr float ALPHA = 1.4142135623730951f;
constexpr int NWAVES = 8, NTHREADS = 512;

__device__ __forceinline__ int seg_of(int row) { return row < 256 ? 0 : row < 512 ? 1 : row < 512 + SEQ ? 2 : 3; }
__device__ __forceinline__ int seg_start(int s) { return s == 0 ? 0 : s == 1 ? 256 : s == 2 ? 512 : 512 + SEQ; }
__device__ __forceinline__ int seg_len(int s) { return s < 2 ? CTX : SEQ; }
__device__ __forceinline__ bool row_first(int row) { return row == 0 || row == 256 || row == 512 || row == 512 + SEQ; }
__device__ __forceinline__ bool row_last(int row) { return row == 255 || row == 511 || row == 511 + SEQ || row == T - 1; }
__device__ __forceinline__ int row_modidx(int row) { return row < 512 ? 2 : (row < 512 + SEQ ? 0 : 1); }

constexpr size_t AL(size_t x) { return (x + 255) / 256 * 256; }
constexpr size_t WS_CTL = 0, CTL_BYTES = 2u << 20;
constexpr int CW_BAR = 1024;
constexpr int CW_MOD = 16384;
constexpr size_t SZ_WIN = (size_t)NIN * DM * 2, SZ_WBR = (size_t)4 * DM * 1024 * 2, SZ_WOUT = (size_t)DM * DM * 2, SZ_WQ = (size_t)1536 * 512 * 2,
                 SZ_WKV = (size_t)2048 * 512 * 2, SZ_WLORA = (size_t)5120 * 512 * 2;
constexpr size_t WS_WIN = CTL_BYTES, WS_WBR = WS_WIN + DEPTH * SZ_WIN, WS_WOUT = WS_WBR + DEPTH * SZ_WBR, WS_WQ = WS_WOUT + DEPTH * SZ_WOUT,
                 WS_WKV = WS_WQ + DEPTH * SZ_WQ, WS_WLORA = WS_WKV + DEPTH * SZ_WKV, WS_XS = WS_WLORA + DEPTH * SZ_WLORA;
constexpr size_t SZ_XS = (size_t)T * DM * 4;
constexpr size_t WS_H = WS_XS + SZ_XS, SZ_H = (size_t)T * DM * 2;
constexpr size_t WS_P = WS_H + SZ_H, SZ_P = (size_t)T * NNG * 2;
constexpr int P2W = 5632, P2_XBC = 0, P2_X0 = 1536, P2_RKV = 2560;
constexpr size_t WS_P2 = WS_P + SZ_P, SZ_P2 = (size_t)T * P2W * 2;
constexpr size_t WS_Q = WS_P2 + SZ_P2, SZ_Q = (size_t)T * 1536 * 2;
constexpr size_t WS_KV = WS_Q + SZ_Q, SZ_KV = (size_t)T * 2048 * 2;
constexpr size_t WS_EW = WS_KV + SZ_KV, SZ_TK2 = (size_t)T * 1024 * 2;
constexpr size_t WS_ICLR = WS_EW + 2 * SZ_TK2;
constexpr size_t WS_KK = WS_ICLR + 2 * SZ_TK2;
constexpr size_t WS_GG = WS_KK + SZ_TK2;
constexpr size_t WS_YRW = WS_GG + SZ_TK2;
constexpr size_t WS_ALORA = WS_YRW + 2 * SZ_TK2, SZ_ALORA = (size_t)T * 512 * 2;
constexpr size_t WS_KPE = WS_ALORA + SZ_ALORA, SZ_KPE = (size_t)T * 64 * 2;
constexpr size_t WS_RS = WS_KPE + SZ_KPE, SZ_RS = AL((size_t)T * 2 * 4);
constexpr size_t WS_DT = WS_RS + SZ_RS, SZ_DT = (size_t)T * 32 * 4;
constexpr size_t WS_VT = WS_DT + SZ_DT, SZ_VT = (size_t)1024 * 2 * SEQ * 4;
constexpr size_t WS_VC = WS_VT + SZ_VT, SZ_VC = (size_t)TC * 1024 * 4;
constexpr size_t WS_FILT = WS_VC + SZ_VC, SZ_FILT = (size_t)1024 * 2 * SEQ * 2;
constexpr size_t WS_FILTC = WS_FILT + SZ_FILT, SZ_FILTC = (size_t)CTX * 2048 * 4;
constexpr size_t WS_HDN = WS_FILTC + SZ_FILTC, SZ_HDN = (size_t)(SEQ + CTX) * 64 * 4;
constexpr int NCHUNK = T / 128;
constexpr size_t WS_MST = WS_HDN + SZ_HDN, SZ_MST = (size_t)2 * NCHUNK * 16 * 8192 * 2;
constexpr size_t WS_MCS = WS_MST + SZ_MST, SZ_MCS = (size_t)2 * NCHUNK * 16 * 4 * 2;
constexpr size_t WS_Y = WS_MCS + AL(SZ_MCS), SZ_Y = (size_t)4 * T * 1024 * 2;
constexpr size_t WS_AFF = WS_Y + SZ_Y, SZ_AFF = (size_t)T * 16 * 4;
constexpr size_t WS_INV = WS_AFF + SZ_AFF, SZ_INV = (size_t)T * 16 * 4;
constexpr size_t WS_PTOK = WS_INV + SZ_INV, SZ_PTOK = (size_t)NPAIR * 4;
constexpr size_t WS_PGATE = WS_PTOK + SZ_PTOK, SZ_PGATE = (size_t)NPAIR * 4;
constexpr size_t WS_H8 = WS_PGATE + SZ_PGATE, SZ_H8 = (size_t)T * DM;
constexpr size_t WS_END = WS_H8 + SZ_H8;
constexpr size_t WS_GATES = WS_P, SZ_GATES = (size_t)T * NGATE * 2;
constexpr size_t WS_MRGF = WS_P2, SZ_MRGF = (size_t)T * DM * 4;
constexpr size_t WS_MRGB = WS_Q, SZ_MRGB = (size_t)T * DM * 2;
constexpr size_t WS_YMIX = WS_P, SZ_YMIX = (size_t)T * DM * 4;
constexpr size_t WS_H2 = WS_H;
constexpr size_t WS_WE = WS_P2, SZ_WGU = (size_t)NEXP * 2816 * DM * 2, SZ_WD = (size_t)NEXP * DM * EFF * 2;
constexpr size_t WS_XG = WS_P, SZ_XG = (size_t)NPAIR * DM * 2;
constexpr size_t WS_HID = WS_XG + SZ_XG, SZ_HID = (size_t)NPAIR * EFF * 2;
constexpr size_t WS_YE = WS_WE + SZ_WGU + SZ_WD, SZ_YE = (size_t)NPAIR * DM * 2;
static_assert(SZ_GATES <= SZ_P && SZ_MRGF <= SZ_P2 && SZ_MRGB <= SZ_Q + SZ_KV && SZ_YMIX <= SZ_P, "alias map 1");
static_assert(SZ_XG + SZ_HID <= SZ_P, "alias map 2");
static_assert(WS_YE + SZ_YE <= WS_VT, "alias map 3");
static_assert(WS_END < 1800000000ull, "workspace budget");

__device__ __forceinline__ unsigned f2bf(float f) { unsigned u = __builtin_bit_cast(unsigned, f); return (u + 0x7fffu + ((u >> 16) & 1u)) >> 16; }
__device__ __forceinline__ unsigned pk2(float lo, float hi) { return f2bf(lo) | (f2bf(hi) << 16); }
__device__ __forceinline__ float bf2f(unsigned short b) { return __builtin_bit_cast(float, (unsigned)b << 16); }
__device__ __forceinline__ float bflo(unsigned w) { return __builtin_bit_cast(float, w << 16); }
__device__ __forceinline__ float bfhi(unsigned w) { return __builtin_bit_cast(float, w & 0xffff0000u); }
__device__ __forceinline__ unsigned cvt_pk_bf16(float lo, float hi) { unsigned r; asm volatile("v_cvt_pk_bf16_f32 %0, %1, %2" : "=v"(r) : "v"(lo), "v"(hi)); return r; }
__device__ __forceinline__ float dppx(float x, const int sel) {
    const int xi = __builtin_bit_cast(int, x); int r;
    if (sel == 0) r = __builtin_amdgcn_update_dpp(0, xi, 0xB1, 0xF, 0xF, false);
    else if (sel == 1) r = __builtin_amdgcn_update_dpp(0, xi, 0x4E, 0xF, 0xF, false);
    else if (sel == 2) r = __builtin_amdgcn_update_dpp(0, xi, 0x141, 0xF, 0xF, false);
    else r = __builtin_amdgcn_update_dpp(0, xi, 0x140, 0xF, 0xF, false);
    return __builtin_bit_cast(float, r);
}
__device__ __forceinline__ float swz16(float x) { return __builtin_bit_cast(float, __builtin_amdgcn_ds_swizzle(__builtin_bit_cast(int, x), 0x401F)); }
__device__ __forceinline__ float sum4(float v) { v += dppx(v, 0); v += dppx(v, 1); return v; }
__device__ __forceinline__ float sum8(float v) { v = sum4(v); v += dppx(v, 2); return v; }
__device__ __forceinline__ float sum16(float v) { v = sum8(v); v += dppx(v, 3); return v; }
__device__ __forceinline__ float sum32(float v) { v = sum16(v); v += swz16(v); return v; }
__device__ __forceinline__ unsigned pk4fp8(float a, float b, float c, float d) { int w = 0; w = __builtin_amdgcn_cvt_pk_fp8_f32(a, b, w, false); w = __builtin_amdgcn_cvt_pk_fp8_f32(c, d, w, true); return (unsigned)w; }
__device__ __forceinline__ float wave_sum(float v) {
    v = sum32(v);
    auto rr = __builtin_amdgcn_permlane32_swap(__float_as_uint(v), __float_as_uint(v), false, false);
    return __uint_as_float(rr[0]) + __uint_as_float(rr[1]);
}
__device__ __forceinline__ float sigmoidf_(float x) { return 1.f / (1.f + __expf(-x)); }
__device__ __forceinline__ float siluf_(float x) { return x / (1.f + __expf(-x)); }
__device__ __forceinline__ float softplusf_(float x) { return x > 20.f ? x : __logf(1.f + __expf(x)); }
__device__ __forceinline__ float tanhf_(float x) { const float e = __expf(2.f * fminf(x, 15.f)); return 1.f - 2.f / (e + 1.f); }
#define LDS_WAIT() asm volatile("s_waitcnt lgkmcnt(0)" ::: "memory")
#define VM_WAIT() asm volatile("s_waitcnt vmcnt(0)" ::: "memory")

#define XB_TMO      128
#define XB_XCNT(j)  (256  + 64 * (j))
#define XB_XSUB(j)  (1280 + 64 * (j))
#define XB_XGEN(j)  (2304 + 64 * (j))
#define XB_TOP      3328
#define XB_TOPGEN   3392
#define XCD_BAR_WORDS 3456
#define XB_SPIN_CAP (1u << 18)
__device__ __forceinline__ unsigned xb_ld(unsigned* p)              { return __hip_atomic_load(p, __ATOMIC_RELAXED, __HIP_MEMORY_SCOPE_AGENT); }
__device__ __forceinline__ unsigned xb_add(unsigned* p, unsigned v) { return __hip_atomic_fetch_add(p, v, __ATOMIC_RELAXED, __HIP_MEMORY_SCOPE_AGENT); }
__device__ __forceinline__ unsigned xb_xcc_id() { return (unsigned)__builtin_amdgcn_s_getreg((3 << 11) | 20) & 0xFu; }
#define XB_SPIN(cond, bar) do { unsigned _sp = 0; while (cond) { __builtin_amdgcn_s_sleep(1); \
    if ((++_sp & 255u) == 0u) { if (xb_ld(&(bar)[XB_TMO])) break; if (_sp > XB_SPIN_CAP) { atomicAdd(&(bar)[XB_TMO], 1u); break; } } } } while (0)
struct XcdBarrier { unsigned* bar; unsigned x; volatile LAS unsigned* st; };
__device__ __forceinline__ XcdBarrier xcd_barrier_post(unsigned* bar, volatile LAS unsigned* st) {
    XcdBarrier b; b.bar = bar; b.x = xb_xcc_id(); b.st = st;
    if (threadIdx.x == 0) (void)xb_add(&bar[XB_XCNT(b.x)], 1u);
    return b;
}
__device__ __forceinline__ void xcd_barrier_complete(unsigned* bar, unsigned x, unsigned& nloc, unsigned& nx) {
    const unsigned G = gridDim.x * gridDim.y * gridDim.z;
    unsigned sum, cnt, mine, sp = 0u;
    for (;;) {
        sum = 0u; cnt = 0u; mine = 0u;
#pragma unroll
        for (unsigned j = 0; j < 16; ++j) { const unsigned c = xb_ld(&bar[XB_XCNT(j)]); sum += c; cnt += (c > 0u) ? 1u : 0u; mine = (j == x) ? c : mine; }
        if (sum == G) break;
        __builtin_amdgcn_s_sleep(1);
        if ((++sp & 255u) == 0u) { if (xb_ld(&bar[XB_TMO])) break; if (sp > XB_SPIN_CAP) { atomicAdd(&bar[XB_TMO], 1u); break; } }
    }
    nloc = mine > 0u ? mine : 1u; nx = cnt > 0u ? cnt : 1u;
}
__device__ __forceinline__ void xcd_barrier(const XcdBarrier& b) {
    asm volatile("s_waitcnt vmcnt(0)" ::: "memory");
    __syncthreads();
    if (threadIdx.x == 0) {
        unsigned* bar = b.bar;
        __builtin_amdgcn_s_waitcnt(0);
        unsigned nloc = b.st[0], nx = b.st[1];
        if (nloc == 0u) { xcd_barrier_complete(bar, b.x, nloc, nx); b.st[0] = nloc; b.st[1] = nx; }
        const unsigned old = xb_add(&bar[XB_XSUB(b.x)], 1u);
        const unsigned gen = old / nloc;
        if (old + 1u == (gen + 1u) * nloc) {
            __builtin_amdgcn_fence(__ATOMIC_RELEASE, "agent");
            asm volatile("s_waitcnt vmcnt(0)" ::: "memory");
            const unsigned og = xb_add(&bar[XB_TOP], 1u);
            const unsigned tg = og / nx;
            if (og + 1u == (tg + 1u) * nx) xb_add(&bar[XB_TOPGEN], 1u);
            else XB_SPIN(xb_ld(&bar[XB_TOPGEN]) == tg, bar);
            __builtin_amdgcn_fence(__ATOMIC_ACQUIRE, "agent");
            xb_add(&bar[XB_XGEN(b.x)], 1u);
            asm volatile("s_waitcnt vmcnt(0)" ::: "memory");
        } else {
            XB_SPIN(xb_ld(&bar[XB_XGEN(b.x)]) == gen, bar);
            __builtin_amdgcn_fence(__ATOMIC_ACQUIRE, "agent");
            asm volatile("s_waitcnt vmcnt(0)" ::: "memory");
        }
    }
    __syncthreads();
}

__device__ __forceinline__ int lane_asm() { int l; asm volatile("v_mbcnt_lo_u32_b32 %0, -1, 0\n\tv_mbcnt_hi_u32_b32 %0, -1, %0" : "=v"(l)); return l; }
namespace pg8 {
constexpr int BM = 256, BK = 64, HALF = 128, HTB = HALF * BK * 2, STAGE_BYTES = 8 * HTB, NXCD = 8, WGM = 8;
__host__ __device__ __forceinline__ int lds_byte(int r, int c) { const int st = (r >> 4) * 2 + (c >> 5), rr = r & 15, cc = c & 31, ob = rr * 64 + cc * 2; return st * 1024 + (ob ^ (((ob >> 9) & 1) << 5)); }
__host__ __device__ __forceinline__ void stage_rc(int b, int& R, int& C) { const int st = b / 1024, sb = b % 1024, swz = sb ^ (((sb >> 9) & 1) << 5); R = (st >> 1) * 16 + swz / 64; C = (st & 1) * 32 + (swz % 64) / 2; }
__host__ __device__ __forceinline__ int perm32(int rho) { const int n = rho >> 4, i = rho & 15; return 8 * (i >> 2) + 4 * n + (i & 3); }
struct Unit { int pm, pn; };
struct Gemm { const bf16_t* A; const bf16_t* Bt; int lda, ldb, K; };
struct StaticOrder {
    int nM, nN, nwg, G, c;
    __device__ void init(int nM_, int nN_, int G_, int c_) { nM = nM_; nN = nN_; nwg = nM * nN; G = G_; c = c_; }
    __device__ bool next(int i, Unit& u) const {
        const long L = (long)i * G + c; if (L >= nwg) return false;
        int wgid = (int)L; { const int q = nwg / NXCD, r = nwg % NXCD, xcd = wgid % NXCD, off = wgid / NXCD; wgid = (xcd < r ? xcd * (q + 1) : r * (q + 1) + (xcd - r) * q) + off; }
        const int nig = WGM * nN, gid = wgid / nig, fm = gid * WGM, gsz = (nM - fm) < WGM ? (nM - fm) : WGM;
        u.pm = fm + ((wgid % nig) % gsz); u.pn = (wgid % nig) / gsz; return true;
    }
};
typedef int i32x4v __attribute__((ext_vector_type(4)));
typedef int i32x8v __attribute__((ext_vector_type(8)));
__device__ __forceinline__ i32x8v cat8(bf16x8 a, bf16x8 b) { return __builtin_shufflevector(__builtin_bit_cast(i32x4v, a), __builtin_bit_cast(i32x4v, b), 0, 1, 2, 3, 4, 5, 6, 7); }
template <class Epi, class Sched, bool FP8 = false>
__device__ __forceinline__ void gemm_phase(LAS unsigned char* lds, const Gemm g, const Sched& S, const Epi& E, int tid_in) {
    constexpr bool ALIGN_EPI = true;
    const unsigned tid_u = (unsigned)tid_in; __builtin_assume(tid_u < 512u);
    const int tid = (int)tid_u, wid = __builtin_amdgcn_readfirstlane(tid >> 6), lane = tid & 63, wr = wid >> 2, wc = wid & 3, fr = lane & 15, fq = lane >> 4;
    const int K = g.K, nt = K / BK;
    unsigned voffA[2], voffB[2];
#pragma unroll
    for (int i = 0; i < 2; ++i) { int R, C; stage_rc(tid * 16 + i * 8192, R, C); const int Rb = Epi::PERM ? ((R & ~31) + perm32(R & 31)) : R;
        voffA[i] = (unsigned)(R * g.lda + C) * 2u; voffB[i] = (unsigned)(Rb * g.ldb + C) * 2u; }
    const unsigned kstep = (unsigned)(BK * 2);
    const unsigned hstepA = (unsigned)HALF * g.lda * 2u, hstepB = (unsigned)HALF * g.ldb * 2u;
    const unsigned tstepA = 2u * hstepA, tstepB = 2u * hstepB;
    const unsigned ldsw = (unsigned)wid * 1024u;
    const int aoff = lds_byte(wr * 64 + fr, fq * 8), boff = lds_byte(wc * 32 + fr, fq * 8);
    const __amdgpu_buffer_rsrc_t rsA = __builtin_amdgcn_make_buffer_rsrc((void*)g.A, 0, 0xFFFFFFFFu, 0x00020000);
    const __amdgpu_buffer_rsrc_t rsB = __builtin_amdgcn_make_buffer_rsrc((void*)g.Bt, 0, 0xFFFFFFFFu, 0x00020000);
#define PG8_SA(b, h) (((b) * 2 + (h)) * HTB)
#define PG8_SB(b, h) ((4 + (b) * 2 + (h)) * HTB)
#define PG8_STAGE(bufoff, rs, soff, voff) do { _Pragma("unroll") for (int _i = 0; _i < 2; ++_i) \
        __builtin_amdgcn_raw_ptr_buffer_load_lds(rs, (LAS unsigned*)(lds + (bufoff) + ldsw + _i * 8192), 16, (int)(voff)[_i], (int)(soff), 0, 0); } while (0)
#define PG8_LDA(dst, b, h) do { if constexpr (FP8) { _Pragma("unroll") for (int m = 0; m < 4; ++m) dst##8[m] = __builtin_shufflevector(*(const LAS i32x4v*)(lds + PG8_SA(b, h) + aoff + m * 2048), *(const LAS i32x4v*)(lds + PG8_SA(b, h) + aoff + m * 2048 + 1024), 0, 1, 2, 3, 4, 5, 6, 7); } \
    else { _Pragma("unroll") for (int m = 0; m < 4; ++m) _Pragma("unroll") for (int k = 0; k < 2; ++k) dst[m][k] = *(const LAS bf16x8*)(lds + PG8_SA(b, h) + aoff + m * 2048 + k * 1024); } } while (0)
#define PG8_LDB(dst, b, h) do { if constexpr (FP8) { _Pragma("unroll") for (int n = 0; n < 2; ++n) dst##8[n] = __builtin_shufflevector(*(const LAS i32x4v*)(lds + PG8_SB(b, h) + boff + n * 2048), *(const LAS i32x4v*)(lds + PG8_SB(b, h) + boff + n * 2048 + 1024), 0, 1, 2, 3, 4, 5, 6, 7); } \
    else { _Pragma("unroll") for (int n = 0; n < 2; ++n) _Pragma("unroll") for (int k = 0; k < 2; ++k) dst[n][k] = *(const LAS bf16x8*)(lds + PG8_SB(b, h) + boff + n * 2048 + k * 1024); } } while (0)
#define PG8_MMA(ai, bj, At, Bt) do { __builtin_amdgcn_s_setprio(1); if constexpr (FP8) { _Pragma("unroll") for (int m = 0; m < 4; ++m) _Pragma("unroll") for (int n = 0; n < 2; ++n) \
        acc[ai][bj][m][n] = __builtin_amdgcn_mfma_scale_f32_16x16x128_f8f6f4(Bt##8[n], At##8[m], acc[ai][bj][m][n], 0, 0, 0, 0x7F7F7F7F, 0, 0x7F7F7F7F); } else { \
        _Pragma("unroll") for (int m = 0; m < 4; ++m) _Pragma("unroll") for (int n = 0; n < 2; ++n) _Pragma("unroll") for (int k = 0; k < 2; ++k) \
        acc[ai][bj][m][n] = __builtin_amdgcn_mfma_f32_16x16x32_bf16(Bt[n][k], At[m][k], acc[ai][bj][m][n], 0, 0, 0); } __builtin_amdgcn_s_setprio(0); } while (0)
#define PG8_WAIT_V(n) asm volatile("s_waitcnt vmcnt(" #n ")" ::: "memory")
#define PG8_WAIT_L(n) asm volatile("s_waitcnt lgkmcnt(" #n ")" ::: "memory")
#define PG8_BAR __builtin_amdgcn_s_barrier()
#define PG8_SCHED __builtin_amdgcn_sched_barrier(0)
    Unit cur, nxt; int ui = 0;
    if (!S.next(0, cur)) return;
    f32x4 acc[2][2][4][2];
#pragma unroll
    for (int a = 0; a < 2; ++a)
#pragma unroll
        for (int b = 0; b < 2; ++b)
#pragma unroll
            for (int m = 0; m < 4; ++m)
#pragma unroll
                for (int n = 0; n < 2; ++n) acc[a][b][m][n] = (f32x4){0.f, 0.f, 0.f, 0.f};
    i32x8v At8[4], B08[2], B18[2]; bf16x8 At[4][2], B0[2][2], B1[2][2];
    unsigned cA = (unsigned)cur.pm * tstepA, cB = (unsigned)cur.pn * tstepB;
    PG8_STAGE(PG8_SB(0, 0), rsB, cB, voffB); PG8_STAGE(PG8_SB(0, 1), rsB, cB + hstepB, voffB); PG8_STAGE(PG8_SA(0, 0), rsA, cA, voffA); PG8_STAGE(PG8_SA(0, 1), rsA, cA + hstepA, voffA);
    if (wr == 1) PG8_BAR;
    PG8_WAIT_V(2); PG8_BAR;
    PG8_STAGE(PG8_SB(1, 0), rsB, cB + kstep, voffB); PG8_STAGE(PG8_SA(1, 0), rsA, cA + kstep, voffA); PG8_STAGE(PG8_SB(1, 1), rsB, cB + hstepB + kstep, voffB);
    PG8_WAIT_V(6); PG8_BAR;
    for (;;) {
        const bool has_next = S.next(ui + 1, nxt);
        const unsigned nA = has_next ? (unsigned)nxt.pm * tstepA : cA; const unsigned nB = has_next ? (unsigned)nxt.pn * tstepB : cB;
        for (int t = 0; t < nt; t += 2) {
            const bool last = (t == nt - 2);
            const unsigned a1 = cA + (unsigned)(t + 1) * kstep;
            const unsigned a2 = last ? nA : cA + (unsigned)(t + 2) * kstep; const unsigned b2 = last ? nB : cB + (unsigned)(t + 2) * kstep;
            const unsigned a3 = a2 + kstep; const unsigned b3 = b2 + kstep;
            PG8_LDB(B0, 0, 0); PG8_LDB(B1, 0, 1); PG8_SCHED; PG8_LDA(At, 0, 0); PG8_STAGE(PG8_SA(1, 1), rsA, a1 + hstepA, voffA);
            PG8_WAIT_V(8); PG8_WAIT_L(0); PG8_BAR; PG8_MMA(0, 0, At, B0); PG8_MMA(0, 1, At, B1); PG8_BAR; PG8_SCHED;
            PG8_LDA(At, 0, 1); PG8_STAGE(PG8_SB(0, 0), rsB, b2, voffB); PG8_STAGE(PG8_SB(0, 1), rsB, b2 + hstepB, voffB); PG8_STAGE(PG8_SA(0, 0), rsA, a2, voffA);
            PG8_WAIT_V(8); PG8_WAIT_L(0); PG8_BAR; PG8_MMA(1, 0, At, B0); PG8_MMA(1, 1, At, B1); PG8_BAR; PG8_SCHED;
            PG8_LDB(B0, 1, 0); PG8_LDB(B1, 1, 1); PG8_SCHED; PG8_LDA(At, 1, 0); PG8_STAGE(PG8_SA(0, 1), rsA, a2 + hstepA, voffA);
            PG8_WAIT_V(8); PG8_WAIT_L(0); PG8_BAR; PG8_MMA(0, 0, At, B0); PG8_MMA(0, 1, At, B1); PG8_BAR; PG8_SCHED;
            PG8_LDA(At, 1, 1); PG8_STAGE(PG8_SB(1, 0), rsB, b3, voffB); PG8_STAGE(PG8_SB(1, 1), rsB, b3 + hstepB, voffB); PG8_STAGE(PG8_SA(1, 0), rsA, a3, voffA);
            PG8_WAIT_V(8); PG8_WAIT_L(0); PG8_BAR; PG8_MMA(1, 0, At, B0); PG8_MMA(1, 1, At, B1); PG8_BAR; PG8_SCHED;
        }
        if constexpr (ALIGN_EPI) { if (wr == 0) PG8_BAR; }
        { const int l2 = lane_asm() & 63; E(acc, cur, wr, wc, l2 & 15, l2 >> 4); }
        if (!has_next) break;
#pragma unroll
        for (int a = 0; a < 2; ++a)
#pragma unroll
            for (int b = 0; b < 2; ++b)
#pragma unroll
                for (int m = 0; m < 4; ++m)
#pragma unroll
                    for (int n = 0; n < 2; ++n) acc[a][b][m][n] = (f32x4){0.f, 0.f, 0.f, 0.f};
        cur = nxt; cA = nA; cB = nB; ++ui;
        if constexpr (ALIGN_EPI) { if (wr == 1) PG8_BAR; }
    }
    PG8_WAIT_V(0);
    if constexpr (!ALIGN_EPI) { if (wr == 0) PG8_BAR; }
    PG8_BAR;
#undef PG8_SA
#undef PG8_SB
#undef PG8_STAGE
#undef PG8_LDA
#undef PG8_LDB
#undef PG8_MMA
#undef PG8_WAIT_V
#undef PG8_WAIT_L
#undef PG8_BAR
#undef PG8_SCHED
}
}

enum { I_X = 0, I_C, I_CTX, I_CCTX, I_WADA, I_BADA, I_WIN, I_QNORM, I_WQUP, I_KVNORM, I_WKVUP, I_SCONVW, I_SCONVB, I_SDTB, I_SALOG, I_SD, I_SNORM,
       I_HCONVW, I_HCONVB, I_HW1, I_HB1, I_HW2, I_HB2, I_HW3, I_HFREQ, I_HD, I_RMU, I_RW0, I_RWUP, I_RA0, I_RAUP, I_RGUP, I_RKK, I_RKA, I_RRK, I_RLNG, I_RLNB,
       I_WBR, I_WOUT, I_LN1G, I_LN1B, I_WROUTER, I_WGATE, I_WUP, I_WDOWN, I_LN2G, I_LN2B, N_INPUTS };
struct Args { const float* in[N_INPUTS]; float* out; unsigned char* ws; int ph_lo, ph_hi; };
static_assert(sizeof(Args) == (N_INPUTS + 2) * 8 + 8, "Args has no padding");

__device__ __forceinline__ const float* arg_in(const Args& a, int i) { asm volatile("" : "+s"(i)); return a.in[i]; }
__device__ __forceinline__ int opqs(int v) { asm volatile("" : "+s"(v)); return v; }
__device__ __forceinline__ int opqv(int v) { asm volatile("" : "+v"(v)); return v; }
__device__ __forceinline__ unsigned char* opq(unsigned char* p) { asm volatile("" : "+s"(p)); return p; }
struct Frame {
    LAS unsigned char* lds;
    int tid, lane, wave, G, bid, gw, NGW;
    unsigned char* ws;
};
#define WSP(T_, off) ((T_*)(F.ws + (off)))

template <class RowMap>
__device__ __forceinline__ void transpose_item(const float* W, int ldw, bf16_t* WT, int ldt, int k0, int n0, const float* kscale, int koff, RowMap rm, LAS float* scr, int lane) {
#pragma unroll 8
    for (int i = 0; i < 32; ++i) { const int kk = 2 * i + (lane >> 5); float v = W[(size_t)(k0 + kk) * ldw + n0 + (lane & 31)]; if (kscale) v *= kscale[k0 + kk]; scr[kk * 33 + (lane & 31)] = v; }
    LDS_WAIT(); asm volatile("" ::: "memory");
    const int c = lane & 7;
#pragma unroll
    for (int j = 0; j < 4; ++j) { const int n = (lane >> 3) + 8 * j; const LAS float* s = scr + (8 * c) * 33 + n;
        u32x4 o; o.x = pk2(s[0 * 33], s[1 * 33]); o.y = pk2(s[2 * 33], s[3 * 33]); o.z = pk2(s[4 * 33], s[5 * 33]); o.w = pk2(s[6 * 33], s[7 * 33]);
        *(u32x4*)(WT + (size_t)rm(n0 + n) * ldt + koff + k0 + 8 * c) = o; }
    LDS_WAIT(); asm volatile("" ::: "memory");
}
__device__ __forceinline__ void transpose_item_fp8(const float* W, int ldw, unsigned char* WT, int ldt, int k0, int n0, float sc, LAS float* scr, int lane) {
#pragma unroll 8
    for (int i = 0; i < 32; ++i) { const int kk = 2 * i + (lane >> 5); scr[kk * 33 + (lane & 31)] = W[(size_t)(k0 + kk) * ldw + n0 + (lane & 31)] * sc; }
    LDS_WAIT(); asm volatile("" ::: "memory");
    const int c = lane & 3;
#pragma unroll
    for (int j = 0; j < 2; ++j) { const int n = (lane >> 2) + 16 * j; const LAS float* s = scr + (16 * c) * 33 + n;
        u32x4 o; o.x = pk4fp8(s[0 * 33], s[1 * 33], s[2 * 33], s[3 * 33]); o.y = pk4fp8(s[4 * 33], s[5 * 33], s[6 * 33], s[7 * 33]);
        o.z = pk4fp8(s[8 * 33], s[9 * 33], s[10 * 33], s[11 * 33]); o.w = pk4fp8(s[12 * 33], s[13 * 33], s[14 * 33], s[15 * 33]);
        *(u32x4*)(WT + (size_t)(n0 + n) * ldt + k0 + 16 * c) = o; }
    LDS_WAIT(); asm volatile("" ::: "memory");
}
struct RmId { __device__ int operator()(int n) const { return n; } };
struct RmGateUp { int up; __device__ int operator()(int n) const { return 256 * (n >> 7) + (n & 127) + (up ? 128 : 0); } };

__device__ __forceinline__ void p0_weights(Frame& F, const Args& a) {
    LAS float* scr = (LAS float*)(F.lds + F.wave * 8704);
    constexpr int IT_IN = 32 * 576, IT_BR = 16 * 64, IT_OUT = 32 * 64, IT_Q = 8 * 48, IT_KV = 8 * 64;
    constexpr int PER_L = IT_IN + 4 * IT_BR + IT_OUT + IT_Q + IT_KV;
    for (int it = F.gw; it < DEPTH * PER_L; it += F.NGW) {
        const int l = it / PER_L; int r = it % PER_L;
        if (r < IT_IN) { const int kb = r / 576, nb = r % 576;
            if (nb * 32 < NNG) transpose_item(arg_in(a, I_WIN) + (size_t)l * DM * NIN, NIN, WSP(bf16_t, WS_WIN + l * SZ_WIN), DM, kb * 64, nb * 32, nullptr, 0, RmId(), scr, F.lane);
            else transpose_item_fp8(arg_in(a, I_WIN) + (size_t)l * DM * NIN + NNG, NIN, WSP(unsigned char, WS_WIN + l * SZ_WIN) + (size_t)NNG * DM * 2, DM, kb * 64, nb * 32 - NNG, 64.f, scr, F.lane);
            continue; } r -= IT_IN;
        if (r < 4 * IT_BR) { const int br = r / IT_BR, q = r % IT_BR, kb = q / 64, nb = q % 64;
            transpose_item(arg_in(a, I_WBR) + ((size_t)l * 4 + br) * 1024 * DM, DM, WSP(bf16_t, WS_WBR + l * SZ_WBR) + (size_t)br * DM * 1024, 1024, kb * 64, nb * 32, nullptr, 0, RmId(), scr, F.lane); continue; } r -= 4 * IT_BR;
        if (r < IT_OUT) { const int kb = r / 64, nb = r % 64;
            transpose_item(arg_in(a, I_WOUT) + (size_t)l * DM * DM, DM, WSP(bf16_t, WS_WOUT + l * SZ_WOUT), DM, kb * 64, nb * 32, nullptr, 0, RmId(), scr, F.lane); continue; } r -= IT_OUT;
        if (r < IT_Q) { const int kb = r / 48, nb = r % 48;
            transpose_item(arg_in(a, I_WQUP) + (size_t)l * 512 * 1536, 1536, WSP(bf16_t, WS_WQ + l * SZ_WQ), 512, kb * 64, nb * 32, arg_in(a, I_QNORM) + l * 512, 0, RmId(), scr, F.lane); continue; } r -= IT_Q;
        { const int kb = r / 64, nb = r % 64;
            transpose_item(arg_in(a, I_WKVUP) + (size_t)l * 512 * 2048, 2048, WSP(bf16_t, WS_WKV + l * SZ_WKV), 512, kb * 64, nb * 32, arg_in(a, I_KVNORM) + l * 512, 0, RmId(), scr, F.lane); }
    }
    for (size_t e = (size_t)F.bid * NTHREADS + F.tid; e < (size_t)DEPTH * 5120 * 512; e += (size_t)F.G * NTHREADS) {
        const int l = (int)(e / (5120 * 512)); const int rem = (int)(e % (5120 * 512)); const int n = rem / 512, kc = rem % 512; const int blk = n >> 10, c = n & 1023;
        float v = 0.f;
        if (blk < 2) { if (kc >= 64 * blk && kc < 64 * blk + 64) v = arg_in(a, I_RWUP)[(((size_t)l * 2 + blk) * 64 + (kc - 64 * blk)) * 1024 + c]; }
        else if (blk < 4) { const int d = blk - 2; if (kc >= 128 + 64 * d && kc < 192 + 64 * d) v = arg_in(a, I_RAUP)[(((size_t)l * 2 + d) * 64 + (kc - 128 - 64 * d)) * 1024 + c]; }
        else { if (kc >= 256 && kc < 416) v = arg_in(a, I_RGUP)[((size_t)l * 160 + (kc - 256)) * 1024 + c]; }
        WSP(bf16_t, WS_WLORA)[e] = (bf16_t)f2bf(v);
    }
}
__device__ __forceinline__ void conv_experts(Frame& F, const Args& a, int l) {
    LAS float* scr = (LAS float*)(F.lds + F.wave * 8704);
    constexpr int IT_G = 32 * 44, IT_D = 22 * 64, PER_E = 2 * IT_G + IT_D;
    bf16_t* wgu = WSP(bf16_t, WS_WE); bf16_t* wd = WSP(bf16_t, WS_WE + SZ_WGU);
    for (int it = F.gw; it < NEXP * PER_E; it += F.NGW) {
        const int e = it / PER_E; int r = it % PER_E;
        if (r < 2 * IT_G) { const int up = r / IT_G, q = r % IT_G, kb = q / 44, nb = q % 44;
            const float* src = a.in[up ? I_WUP : I_WGATE] + ((size_t)l * NEXP + e) * DM * EFF;
            RmGateUp rm; rm.up = up;
            transpose_item(src, EFF, wgu + (size_t)e * 2816 * DM, DM, kb * 64, nb * 32, nullptr, 0, rm, scr, F.lane); continue; } r -= 2 * IT_G;
        { const int kb = r / 64, nb = r % 64;
            transpose_item(arg_in(a, I_WDOWN) + ((size_t)l * NEXP + e) * EFF * DM, DM, wd + (size_t)e * DM * EFF, EFF, kb * 64, nb * 32, nullptr, 0, RmId(), scr, F.lane); }
    }
}
__device__ __forceinline__ void p0_mod(Frame& F, const Args& a) {
    LAS float* sv = (LAS float*)(F.lds + 69632);
    for (int i = F.tid; i < 3 * DM; i += NTHREADS) { const int v = i / DM, k = i % DM; const float x = v < 2 ? arg_in(a, I_C)[v * DM + k] : arg_in(a, I_CCTX)[k]; sv[i] = siluf_(x); }
    __syncthreads();
    float* mod = (float*)(F.ws + WS_CTL) + CW_MOD;
    LAS float* red = (LAS float*)(F.lds + 69632 + 3 * DM * 4);
    for (int u = F.bid; u < DEPTH * (6 * DM / 128); u += F.G) {
        const int l = u / (6 * DM / 128), nb = u % (6 * DM / 128); const int kg = F.tid >> 7, cl = F.tid & 127, n = nb * 128 + cl;
        const float* w = arg_in(a, I_WADA) + ((size_t)l * DM + kg * 512) * (6 * DM) + n;
        float a0 = 0.f, a1 = 0.f, a2 = 0.f;
#pragma unroll 8
        for (int k = 0; k < 512; ++k) { const float wv = w[(size_t)k * (6 * DM)]; const int kk = kg * 512 + k; a0 += sv[kk] * wv; a1 += sv[DM + kk] * wv; a2 += sv[2 * DM + kk] * wv; }
        __syncthreads();
        red[(kg * 3 + 0) * 128 + cl] = a0; red[(kg * 3 + 1) * 128 + cl] = a1; red[(kg * 3 + 2) * 128 + cl] = a2;
        __syncthreads();
        if (F.tid < 384) { const int v = F.tid >> 7; const float b = arg_in(a, I_BADA)[l * 6 * DM + n];
            mod[(l * 3 + v) * 6 * DM + n] = b + ((red[(0 * 3 + v) * 128 + cl] + red[(1 * 3 + v) * 128 + cl]) + (red[(2 * 3 + v) * 128 + cl] + red[(3 * 3 + v) * 128 + cl])); }
    }
}

__device__ __forceinline__ void row_stats(const f32x4 (&v)[8], float& mean, float& rstd, float eps) {
    float s = 0.f;
#pragma unroll
    for (int j = 0; j < 8; ++j) s += (v[j].x + v[j].y) + (v[j].z + v[j].w);
    mean = wave_sum(s) * (1.f / DM);
    float s2 = 0.f;
#pragma unroll
    for (int j = 0; j < 8; ++j) { const f32x4 d = v[j] - mean; s2 += (d.x * d.x + d.y * d.y) + (d.z * d.z + d.w * d.w); }
    rstd = 1.f / sqrtf(wave_sum(s2) * (1.f / DM) + eps);
}
__device__ __forceinline__ const float* x_src_row(const Args& a, const Frame& F, int layer, int row) {
    if (layer == 0) return row < TC ? arg_in(a, I_CTX) + (size_t)row * DM : arg_in(a, I_X) + (size_t)(row - TC) * DM;
    return (const float*)(F.ws + WS_XS) + (size_t)row * DM;
}
__device__ __forceinline__ void phase_modln(Frame& F, const Args& a, int layer) {
    const float* mod = (const float*)(F.ws + WS_CTL) + CW_MOD + (size_t)layer * 3 * 6 * DM;
    bf16_t* H = WSP(bf16_t, WS_H); unsigned* H8 = WSP(unsigned, WS_H8);
    for (int row = F.gw; row < T; row += F.NGW) {
        const f32x4* xr = (const f32x4*)x_src_row(a, F, layer, row) + F.lane;
        f32x4 v[8];
#pragma unroll
        for (int j = 0; j < 8; ++j) v[j] = xr[64 * j];
        float mean, rstd; row_stats(v, mean, rstd, 1e-6f);
        const float* m = mod + (size_t)row_modidx(row) * 6 * DM;
        u32x2* o = (u32x2*)(H + (size_t)row * DM) + F.lane; unsigned* o8 = H8 + (size_t)row * (DM / 4) + F.lane;
#pragma unroll
        for (int j = 0; j < 8; ++j) { const int c = 4 * (64 * j + F.lane); const f32x4 sh = *(const f32x4*)(m + c), sc = *(const f32x4*)(m + DM + c);
            const f32x4 y = (v[j] - mean) * rstd * (sc + 1.f) + sh; u32x2 w; w.x = pk2(y.x, y.y); w.y = pk2(y.z, y.w); o[64 * j] = w; o8[64 * j] = pk4fp8(y.x, y.y, y.z, y.w); }
    }
}

__device__ __forceinline__ void phase_hdn(Frame& F, const Args& a, int layer) {
    LAS float* zs = (LAS float*)(F.lds + F.wave * 512);
    const float* w1 = arg_in(a, I_HW1) + (size_t)layer * 33 * 64; const float* b1 = arg_in(a, I_HB1) + layer * 64;
    const float* w2 = arg_in(a, I_HW2) + (size_t)layer * 64 * 64; const float* b2 = arg_in(a, I_HB2) + layer * 64;
    const float fr = arg_in(a, I_HFREQ)[layer * 64 + F.lane];
    float* HDN = WSP(float, WS_HDN);
    for (int r = F.gw; r < SEQ + CTX; r += F.NGW) {
        const int n = r < SEQ ? SEQ : CTX, t = r < SEQ ? r : r - SEQ;
        const float wpos = (6.283185307179586f * (float)t) / (float)n;
        if (F.lane < 33) { float z;
            if (F.lane == 0) z = (float)t / (float)(n - 1);
            else { const int b = (F.lane - 1) & 15; const float f = 1e-4f + (float)b * ((15.f - 1e-4f) / 15.f); const float ang = f * wpos; z = F.lane <= 16 ? __cosf(ang) : -__sinf(ang); }
            zs[F.lane] = z; }
        LDS_WAIT(); asm volatile("" ::: "memory");
        float p = b1[F.lane];
#pragma unroll
        for (int i = 0; i < 33; ++i) p += zs[i] * w1[i * 64 + F.lane];
        const float h1 = __sinf(fr * p);
        zs[64 + F.lane] = h1;
        LDS_WAIT(); asm volatile("" ::: "memory");
        float q = b2[F.lane];
#pragma unroll 16
        for (int i = 0; i < 64; ++i) q += zs[64 + i] * w2[i * 64 + F.lane];
        HDN[(size_t)r * 64 + F.lane] = __sinf(fr * q);
        LDS_WAIT(); asm volatile("" ::: "memory");
    }
}
__device__ __forceinline__ float hy_delta(int c) { const float mn = -3.0701134573253943f, mx = -15.350567286626972f; return fabsf(mn + (float)c * ((mx - mn) / 1023.f)); }
__device__ __forceinline__ void phase_filt(Frame& F, const Args& a, int layer) {
    const float* w3 = arg_in(a, I_HW3) + (size_t)layer * 64 * 2048; const float* HDN = WSP(float, WS_HDN);
    LAS float* ws3 = (LAS float*)F.lds;
    bf16_t* FILT = WSP(bf16_t, WS_FILT);
    for (int u = F.bid; u < 32 * 16; u += F.G) {
        const int cb = u / 16, tb = u % 16, col0 = cb * 64, t = tb * 512 + F.tid;
        __syncthreads();
        for (int i = F.tid; i < 4096; i += NTHREADS) { const int j = i >> 6, cc = i & 63; ws3[cc * 64 + j] = w3[(size_t)j * 2048 + col0 + cc]; }
        __syncthreads();
        f32x4 h[16];
#pragma unroll
        for (int i = 0; i < 16; ++i) h[i] = *(const f32x4*)(HDN + (size_t)t * 64 + 4 * i);
        const float tn = (float)t / (float)(SEQ - 1);
        for (int cc = 0; cc < 64; ++cc) {
            float acc = 0.f;
#pragma unroll
            for (int i = 0; i < 16; ++i) { const f32x4 w = *(const LAS f32x4*)(ws3 + cc * 64 + 4 * i); acc += h[i].x * w.x + h[i].y * w.y + h[i].z * w.z + h[i].w * w.w; }
            const int col = col0 + cc, side = col >> 10, c = col & 1023;
            FILT[((size_t)c * 2 + side) * SEQ + t] = (bf16_t)f2bf(acc * __expf(-tn * hy_delta(c)));
        }
    }
    float* FILTC = WSP(float, WS_FILTC);
    for (int e = F.bid * NTHREADS + F.tid; e < CTX * 2048; e += F.G * NTHREADS) {
        const int lag = e >> 11, col = e & 2047, c = col & 1023; const float* hr = HDN + (size_t)(SEQ + lag) * 64; float acc = 0.f;
#pragma unroll 16
        for (int j = 0; j < 64; ++j) acc += hr[j] * w3[(size_t)j * 2048 + col];
        FILTC[e] = acc * __expf(-((float)lag / (float)(CTX - 1)) * hy_delta(c));
    }
}

__device__ __forceinline__ void ld8bf(const bf16_t* p, float (&o)[8]) { const u32x4 w = *(const u32x4*)p; o[0] = bflo(w.x); o[1] = bfhi(w.x); o[2] = bflo(w.y); o[3] = bfhi(w.y); o[4] = bflo(w.z); o[5] = bfhi(w.z); o[6] = bflo(w.w); o[7] = bfhi(w.w); }
__device__ __forceinline__ void st8bf(bf16_t* p, const float (&v)[8]) { u32x4 w; w.x = pk2(v[0], v[1]); w.y = pk2(v[2], v[3]); w.z = pk2(v[4], v[5]); w.w = pk2(v[6], v[7]); *(u32x4*)p = w; }
__device__ __forceinline__ void ld8f(const float* p, float (&o)[8]) { const f32x4 a = *(const f32x4*)p, b = *(const f32x4*)(p + 4); o[0] = a.x; o[1] = a.y; o[2] = a.z; o[3] = a.w; o[4] = b.x; o[5] = b.y; o[6] = b.z; o[7] = b.w; }

constexpr int PREP_RUN = 16;
__device__ __forceinline__ void phase_prep(Frame& F, const Args& a, int layer) {
    const bf16_t* P = WSP(bf16_t, WS_P); bf16_t* P2 = WSP(bf16_t, WS_P2);
    float* RS = WSP(float, WS_RS); bf16_t* KPE = WSP(bf16_t, WS_KPE); float* DT = WSP(float, WS_DT);
    bf16_t* KK = WSP(bf16_t, WS_KK); bf16_t* AL_ = WSP(bf16_t, WS_ALORA); float* VC = WSP(float, WS_VC);
    const float* scw = arg_in(a, I_SCONVW) + (size_t)layer * 3 * 1536; const float* scb = arg_in(a, I_SCONVB) + layer * 1536; const float* dtb = arg_in(a, I_SDTB) + layer * 32;
    const float* hcw = arg_in(a, I_HCONVW) + (size_t)layer * 3 * 3072; const float* hcb = arg_in(a, I_HCONVB) + layer * 3072;
    const float* mu = arg_in(a, I_RMU) + (size_t)layer * 2 * 3488; const float* rkk = arg_in(a, I_RKK) + layer * 1024;
    const int lane = F.lane;
    for (int item = F.gw; item < (T / PREP_RUN) * 13; item += F.NGW) {
        const int run = item / 13, ct = item % 13; const int r0 = run * PREP_RUN;
        if (ct == 0) {
#pragma unroll 1
        for (int rr = 0; rr < PREP_RUN; ++rr) { const int row = r0 + rr; const bf16_t* pr = P + (size_t)row * NNG;
            float x[8]; ld8bf(pr + P_CQ + lane * 8, x); float s = 0.f;
#pragma unroll
            for (int i = 0; i < 8; ++i) s += x[i] * x[i];
            s = wave_sum(s); const float rq = 1.f / sqrtf(s * (1.f / 512.f) + 1e-6f);
            ld8bf(pr + P_CKV + lane * 8, x); s = 0.f;
#pragma unroll
            for (int i = 0; i < 8; ++i) s += x[i] * x[i];
            s = wave_sum(s); const float rk = 1.f / sqrtf(s * (1.f / 512.f) + 1e-6f);
            if (lane == 0) { RS[row * 2] = rq; RS[row * 2 + 1] = rk; }
            float kv = bf2f(pr[P_KPE + lane]);
            const float other = swz16(kv);
            if (row >= TC) { const int t = (row - TC) & (SEQ - 1); const int axis = lane >> 5, half = (lane >> 4) & 1, j = lane & 15;
                const float pos = (float)(axis == 0 ? (t >> 6) : (t & 63)); const float inv = __builtin_amdgcn_exp2f(-(float)j * 0.8304820237218406f);
                const float sn = __sinf(pos * inv), cs = __cosf(pos * inv);
                kv = half == 0 ? kv * cs - other * sn : kv * cs + other * sn; }
            KPE[(size_t)row * 64 + lane] = (bf16_t)f2bf(kv);
            if (lane < 32) DT[(size_t)row * 32 + lane] = softplusf_(bf2f(pr[P_DT + lane]) + dtb[lane]); }
        continue; }
        const bool first = row_first(r0), last = row_last(r0 + PREP_RUN - 1);
        if (ct >= 1 && ct <= 3) { const int ch = ct - 1; const int c = ch * 512 + lane * 8; float xm[8], x0[8], xp[8], w0[8], w1[8], w2[8], bb[8];
            ld8f(scw + c, w0); ld8f(scw + 1536 + c, w1); ld8f(scw + 3072 + c, w2); ld8f(scb + c, bb);
            const bf16_t* pc = P + (size_t)r0 * NNG + P_XBC + c;
            if (!first) ld8bf(pc - NNG, xm); else { for (int i = 0; i < 8; ++i) xm[i] = 0.f; }
            ld8bf(pc, x0);
#pragma unroll 2
            for (int rr = 0; rr < PREP_RUN; ++rr) {
                if (rr + 1 < PREP_RUN || !last) ld8bf(pc + (size_t)(rr + 1) * NNG, xp); else { for (int i = 0; i < 8; ++i) xp[i] = 0.f; }
                float o[8];
#pragma unroll
                for (int i = 0; i < 8; ++i) { o[i] = siluf_(xm[i] * w0[i] + x0[i] * w1[i] + xp[i] * w2[i] + bb[i]); xm[i] = x0[i]; x0[i] = xp[i]; }
                st8bf(P2 + (size_t)(r0 + rr) * P2W + P2_XBC + c, o); } continue; }
        if (ct >= 4 && ct <= 5) { const int ch = ct - 4; { const int c = ch * 512 + lane * 8; float xm[8], x0[8], xp[8], w0[8], w1[8], w2[8], bb[8];
            ld8f(hcw + c, w0); ld8f(hcw + 3072 + c, w1); ld8f(hcw + 6144 + c, w2); ld8f(hcb + c, bb);
            const bf16_t* pc = P + (size_t)r0 * NNG + P_HY + c;
            if (!first) ld8bf(pc - NNG, xm); else { for (int i = 0; i < 8; ++i) xm[i] = 0.f; }
            ld8bf(pc, x0);
#pragma unroll 2
            for (int rr = 0; rr < PREP_RUN; ++rr) {
                if (rr + 1 < PREP_RUN || !last) ld8bf(pc + (size_t)(rr + 1) * NNG, xp); else { for (int i = 0; i < 8; ++i) xp[i] = 0.f; }
                float o[8];
#pragma unroll
                for (int i = 0; i < 8; ++i) { o[i] = xm[i] * w0[i] + x0[i] * w1[i] + xp[i] * w2[i] + bb[i]; xm[i] = x0[i]; x0[i] = xp[i]; }
                st8bf(P2 + (size_t)(r0 + rr) * P2W + P2_X0 + c, o); } }
        if (r0 < TC) {
#pragma unroll 1
                for (int rr = 0; rr < PREP_RUN; ++rr) { const int row = r0 + rr; const bool f1 = row_first(row), l1 = row_last(row); const int c = ch * 512 + lane * 8;
                    const bf16_t* pr = P + (size_t)row * NNG; float o1[8], o2[8];
#pragma unroll
                    for (int part = 1; part < 3; ++part) { float x0[8], xm[8], xp[8], w0[8], w1[8], w2[8], bb[8]; const int cc = part * 1024 + c;
                        ld8bf(pr + P_HY + cc, x0);
                        if (!f1) ld8bf(pr - NNG + P_HY + cc, xm); else { for (int i = 0; i < 8; ++i) xm[i] = 0.f; }
                        if (!l1) ld8bf(pr + NNG + P_HY + cc, xp); else { for (int i = 0; i < 8; ++i) xp[i] = 0.f; }
                        ld8f(hcw + cc, w0); ld8f(hcw + 3072 + cc, w1); ld8f(hcw + 6144 + cc, w2); ld8f(hcb + cc, bb);
#pragma unroll
                        for (int i = 0; i < 8; ++i) { const float r = xm[i] * w0[i] + x0[i] * w1[i] + xp[i] * w2[i] + bb[i]; if (part == 1) o1[i] = r; else o2[i] = r; } }
                    float* vc = VC + (size_t)row * 1024 + c;
                    *(f32x4*)vc = (f32x4){o1[0] * o2[0], o1[1] * o2[1], o1[2] * o2[2], o1[3] * o2[3]};
                    *(f32x4*)(vc + 4) = (f32x4){o1[4] * o2[4], o1[5] * o2[5], o1[6] * o2[6], o1[7] * o2[7]}; } }
        continue; }
        { const int ch = ct - 6; const int c = ch * 512 + lane * 8;
            if (c < 3488) { float um[8], u0[8], up[8], m0[8], m1[8], g8[8];
                ld8f(mu + c, m0); ld8f(mu + 3488 + c, m1);
                if (ch == 2 || ch == 3) ld8f(rkk + (c - 1024), g8);
                const bf16_t* pc = P + (size_t)r0 * NNG + P_RW + c;
                if (!first) ld8bf(pc - NNG, um); else { for (int i = 0; i < 8; ++i) um[i] = 0.f; }
                ld8bf(pc, u0);
#pragma unroll 2
                for (int rr = 0; rr < PREP_RUN; ++rr) { const int row = r0 + rr;
                    if (rr + 1 < PREP_RUN || !last) ld8bf(pc + (size_t)(rr + 1) * NNG, up); else { for (int i = 0; i < 8; ++i) up[i] = 0.f; }
                    float us[8];
#pragma unroll
                    for (int i = 0; i < 8; ++i) { us[i] = u0[i] + m0[i] * (um[i] - u0[i]) + m1[i] * (up[i] - u0[i]); um[i] = u0[i]; u0[i] = up[i]; }
                    if (ch < 6) st8bf(P2 + (size_t)row * P2W + P2_RKV + c, us);
                    if (ch == 2 || ch == 3) { float kx[8]; float s = 0.f;
#pragma unroll
                        for (int i = 0; i < 8; ++i) { kx[i] = us[i] * g8[i]; s += kx[i] * kx[i]; }
                        s = sum8(s);
                        const float inv = 1.f / fmaxf(sqrtf(s), 1e-12f);
#pragma unroll
                        for (int i = 0; i < 8; ++i) kx[i] *= inv;
                        st8bf(KK + (size_t)row * 1024 + (c - 1024), kx); }
                    if (ch == 6) { const int cl = c - 3072; float o[8];
#pragma unroll
                        for (int i = 0; i < 8; ++i) o[i] = cl < 128 ? tanhf_(us[i]) : cl < 256 ? us[i] : sigmoidf_(us[i]);
                        st8bf(AL_ + (size_t)row * 512 + cl, o); } } }
            else if (ch == 6) { const int cl = c - 3072;
                for (int rr = 0; rr < PREP_RUN; ++rr) { float zz = 0.f; asm volatile("" : "+v"(zz)); float o[8] = {zz, zz, zz, zz, zz, zz, zz, zz}; st8bf(AL_ + (size_t)(r0 + rr) * 512 + cl, o); } } }
    }
    float* VT = WSP(float, WS_VT);
    LAS float* tl = (LAS float*)F.lds;
    for (int u = F.bid; u < (TL / 64) * 4; u += F.G) {
        const int tb = u >> 2, cb = u & 3; const int row0 = TC + tb * 64; const int c8 = (F.tid & 31) * 8, c = cb * 256 + c8, tq = F.tid >> 5;
        float w1[3][8], w2[3][8], b1[8], b2[8];
#pragma unroll
        for (int k = 0; k < 3; ++k) { ld8f(hcw + k * 3072 + 1024 + c, w1[k]); ld8f(hcw + k * 3072 + 2048 + c, w2[k]); }
        ld8f(hcb + 1024 + c, b1); ld8f(hcb + 2048 + c, b2);
        __syncthreads();
#pragma unroll 1
        for (int i = 0; i < 4; ++i) { const int tl_ = tq * 4 + i, row = row0 + tl_; const bf16_t* pr = P + (size_t)row * NNG + P_HY;
            const bool first = row_first(row), last = row_last(row);
            float a1[8], a2[8], x[8];
            ld8bf(pr + 1024 + c, x);
#pragma unroll
            for (int j = 0; j < 8; ++j) a1[j] = x[j] * w1[1][j] + b1[j];
            ld8bf(pr + 2048 + c, x);
#pragma unroll
            for (int j = 0; j < 8; ++j) a2[j] = x[j] * w2[1][j] + b2[j];
            if (!first) { ld8bf(pr - NNG + 1024 + c, x);
#pragma unroll
                for (int j = 0; j < 8; ++j) a1[j] += x[j] * w1[0][j];
                ld8bf(pr - NNG + 2048 + c, x);
#pragma unroll
                for (int j = 0; j < 8; ++j) a2[j] += x[j] * w2[0][j]; }
            if (!last) { ld8bf(pr + NNG + 1024 + c, x);
#pragma unroll
                for (int j = 0; j < 8; ++j) a1[j] += x[j] * w1[2][j];
                ld8bf(pr + NNG + 2048 + c, x);
#pragma unroll
                for (int j = 0; j < 8; ++j) a2[j] += x[j] * w2[2][j]; }
#pragma unroll
            for (int j = 0; j < 8; ++j) tl[(c8 + j) * 65 + tl_] = a1[j] * a2[j]; }
        __syncthreads();
        const int b = (row0 - TC) >> 13, t0 = (row0 - TC) & (SEQ - 1);
        for (int p_ = 0; p_ < 8; ++p_) { const int cl = p_ * 32 + (F.tid >> 4), q = F.tid & 15;
            const f32x4 o = {tl[cl * 65 + 4 * q], tl[cl * 65 + 4 * q + 1], tl[cl * 65 + 4 * q + 2], tl[cl * 65 + 4 * q + 3]};
            *(f32x4*)(VT + ((size_t)(cb * 256 + cl) * 2 + b) * SEQ + t0 + 4 * q) = o; }
    }
}

using pg8::Unit;
#define EPI_LOOP_BEGIN const int row0 = u.pm * 256 + wr * 64 + fr; \
    _Pragma("unroll") for (int ai = 0; ai < 2; ++ai) _Pragma("unroll") for (int m = 0; m < 4; ++m) { const int row = row0 + ai * 128 + m * 16; \
    _Pragma("unroll") for (int bj = 0; bj < 2; ++bj) { const int cl = bj * 128 + wc * 32 + 8 * fq; const f32x4 v0 = acc[ai][bj][m][0], v1 = acc[ai][bj][m][1];
#define EPI_LOOP_END } __builtin_amdgcn_sched_barrier(0); }
struct EpiBf16 {
    static constexpr bool PERM = true;
    bf16_t* O; int ldc; const float* rscale; int rs_stride; int act; float cscale;
    __device__ __forceinline__ void operator()(const f32x4 (&acc)[2][2][4][2], const Unit& u, int wr, int wc, int fr, int fq) const {
        EPI_LOOP_BEGIN
            const float s = rscale ? rscale[(size_t)row * rs_stride] : cscale;
            float x[8] = {v0.x * s, v0.y * s, v0.z * s, v0.w * s, v1.x * s, v1.y * s, v1.z * s, v1.w * s};
            if (act == 1) {
#pragma unroll
                for (int i = 0; i < 8; ++i) x[i] = sigmoidf_(x[i]); }
            u32x4 w; w.x = cvt_pk_bf16(x[0], x[1]); w.y = cvt_pk_bf16(x[2], x[3]); w.z = cvt_pk_bf16(x[4], x[5]); w.w = cvt_pk_bf16(x[6], x[7]);
            *(u32x4*)(O + (size_t)row * ldc + u.pn * 256 + cl) = w;
        EPI_LOOP_END
    }
};
struct EpiLora {
    static constexpr bool PERM = true;
    bf16_t* EW; bf16_t* ICLR; bf16_t* GG; const float* w0; const float* a0;
    __device__ __forceinline__ void operator()(const f32x4 (&acc)[2][2][4][2], const Unit& u, int wr, int wc, int fr, int fq) const {
        const int blk = u.pn >> 2, cb = (u.pn & 3) * 256;
        const float* bias = blk < 2 ? w0 + blk * 1024 : a0 + (blk & 1) * 1024;
        bf16_t* dbase = blk < 2 ? EW + (size_t)blk * T * 1024 : blk < 4 ? ICLR + (size_t)(blk - 2) * T * 1024 : GG;
        const float scale = blk < 2 ? 0.6065306597126334f : 1.f; const bool sig = blk < 4;
        EPI_LOOP_BEGIN
            const int c = cb + cl; float x[8] = {v0.x, v0.y, v0.z, v0.w, v1.x, v1.y, v1.z, v1.w};
            if (sig) { const f32x4 b0 = *(const f32x4*)(bias + c), b1 = *(const f32x4*)(bias + c + 4); const float bb[8] = {b0.x, b0.y, b0.z, b0.w, b1.x, b1.y, b1.z, b1.w};
#pragma unroll
                for (int i = 0; i < 8; ++i) x[i] = scale * sigmoidf_(bb[i] + x[i]); }
            u32x4 w; w.x = cvt_pk_bf16(x[0], x[1]); w.y = cvt_pk_bf16(x[2], x[3]); w.z = cvt_pk_bf16(x[4], x[5]); w.w = cvt_pk_bf16(x[6], x[7]);
            *(u32x4*)(dbase + (size_t)row * 1024 + c) = w;
        EPI_LOOP_END
    }
};
struct EpiMerge {
    static constexpr bool PERM = true;
    const bf16_t* gates; float* MF; bf16_t* MB;
    __device__ __forceinline__ void operator()(const f32x4 (&acc)[2][2][4][2], const Unit& uu, int wr, int wc, int fr, int fq) const {
        const int br = uu.pn >> 3; Unit u; u.pm = uu.pm - br * 66; u.pn = uu.pn & 7;
        EPI_LOOP_BEGIN
            const int col = u.pn * 256 + cl; float g[8]; ld8bf(gates + (size_t)row * NGATE + br * DM + col, g);
#pragma unroll
            for (int i = 0; i < 8; ++i) g[i] = sigmoidf_(g[i]);
            float x[8] = {v0.x * g[0], v0.y * g[1], v0.z * g[2], v0.w * g[3], v1.x * g[4], v1.y * g[5], v1.z * g[6], v1.w * g[7]};
            float* mf = MF + (size_t)row * DM + col;
            if (br > 0) { const f32x4 p0 = *(const f32x4*)mf, p1 = *(const f32x4*)(mf + 4); x[0] += p0.x; x[1] += p0.y; x[2] += p0.z; x[3] += p0.w; x[4] += p1.x; x[5] += p1.y; x[6] += p1.z; x[7] += p1.w; }
            if (br < 3) { *(f32x4*)mf = (f32x4){x[0], x[1], x[2], x[3]}; *(f32x4*)(mf + 4) = (f32x4){x[4], x[5], x[6], x[7]}; }
            else { u32x4 w; w.x = cvt_pk_bf16(x[0], x[1]); w.y = cvt_pk_bf16(x[2], x[3]); w.z = cvt_pk_bf16(x[4], x[5]); w.w = cvt_pk_bf16(x[6], x[7]); *(u32x4*)(MB + (size_t)row * DM + col) = w; }
        EPI_LOOP_END
    }
};
struct OrderMerge {
    pg8::StaticOrder so;
    __device__ void init(int G, int c) { so.init(66, 8, G, c); }
    __device__ bool next(int i, Unit& u) const { Unit t; if (!so.next(i >> 2, t)) return false; const int br = i & 3; u.pm = br * 66 + t.pm; u.pn = br * 8 + t.pn; return true; }
};
struct EpiF32 {
    static constexpr bool PERM = true;
    float* O; int ldc;
    __device__ __forceinline__ void operator()(const f32x4 (&acc)[2][2][4][2], const Unit& u, int wr, int wc, int fr, int fq) const {
        EPI_LOOP_BEGIN
            float* o = O + (size_t)row * ldc + u.pn * 256 + cl; *(f32x4*)o = v0; *(f32x4*)(o + 4) = v1;
        EPI_LOOP_END
    }
};
__device__ __forceinline__ int moe_panel(int e, int pi) { return pi < 8 ? (((pi >> 2) * NEXP + e) * 4 + (pi & 3)) : 128 + e; }
struct OrderMoe {
    int npn, G, c;
    __device__ void init(int npn_, int G_, int c_) { npn = npn_; G = G_; c = c_; }
    __device__ bool next(int i, Unit& u) const { const int L = i * G + c; const int per = 9 * npn; if (L >= NEXP * per) return false;
        const int e = L / per, r = L % per, j = r / 9, pi = r % 9; u.pm = moe_panel(e, pi); u.pn = e * npn + j; return true; }
};
struct EpiSwiglu {
    static constexpr bool PERM = true;
    bf16_t* HID;
    __device__ __forceinline__ void operator()(const f32x4 (&acc)[2][2][4][2], const Unit& u, int wr, int wc, int fr, int fq) const {
        const int j = u.pn % 11; const int row0 = u.pm * 256 + wr * 64 + fr;
#pragma unroll
        for (int ai = 0; ai < 2; ++ai)
#pragma unroll
            for (int m = 0; m < 4; ++m) { const int row = row0 + ai * 128 + m * 16;
                const f32x4 g0 = acc[ai][0][m][0], g1 = acc[ai][0][m][1], u0 = acc[ai][1][m][0], u1 = acc[ai][1][m][1];
                u32x4 w; w.x = cvt_pk_bf16(siluf_(g0.x) * u0.x, siluf_(g0.y) * u0.y); w.y = cvt_pk_bf16(siluf_(g0.z) * u0.z, siluf_(g0.w) * u0.w);
                w.z = cvt_pk_bf16(siluf_(g1.x) * u1.x, siluf_(g1.y) * u1.y); w.w = cvt_pk_bf16(siluf_(g1.z) * u1.z, siluf_(g1.w) * u1.w);
                *(u32x4*)(HID + (size_t)row * EFF + j * 128 + wc * 32 + 8 * fq) = w; __builtin_amdgcn_sched_barrier(0); }
    }
};
struct EpiDown {
    static constexpr bool PERM = true;
    bf16_t* YE; const float* pgate;
    __device__ __forceinline__ void operator()(const f32x4 (&acc)[2][2][4][2], const Unit& uu, int wr, int wc, int fr, int fq) const {
        Unit u; u.pm = uu.pm; u.pn = uu.pn & 7;
        EPI_LOOP_BEGIN
            const float s = pgate[row];
            u32x4 w; w.x = cvt_pk_bf16(v0.x * s, v0.y * s); w.y = cvt_pk_bf16(v0.z * s, v0.w * s); w.z = cvt_pk_bf16(v1.x * s, v1.y * s); w.w = cvt_pk_bf16(v1.z * s, v1.w * s);
            *(u32x4*)(YE + (size_t)row * DM + u.pn * 256 + cl) = w;
        EPI_LOOP_END
    }
};

namespace att {
using s16x4 = __attribute__((ext_vector_type(4))) short;
using f32x16 = __attribute__((ext_vector_type(16))) float;
constexpr int NW = 8, QBLK = 32, KVBLK = 64, LDQ = 1536, LDKV = 2048, LDO = 1024;
constexpr float SCALE = 0.07216878364870322f;
constexpr float THR = 8.f;
#ifndef ATT_SDEPTH
#define ATT_SDEPTH 1
#endif
constexpr int SDEPTH = ATT_SDEPTH;
constexpr int SHM_V = KVBLK * 128 * 2, SHM_K = KVBLK * 128 * 2, SHM_KP = KVBLK * 64 * 2;
constexpr int OFF_V = 0, OFF_K = 2 * SHM_V, OFF_KP = OFF_K + 2 * SHM_K, OFF_WS = OFF_KP + 2 * SHM_KP, OFF_QP = OFF_WS + NW * 64 * 4, SHM_ATTN = OFF_QP + 256 * 256;
static_assert(SHM_ATTN <= 150 * 1024, "attention LDS");
#define KSWZ(row, colB) ((row) * 256 + ((colB) ^ (((row) & 7) << 4)))
#define KPSWZ(row, colB) ((row) * 128 + ((colB) ^ (((row) & 7) << 4)))
#define SBAR() __builtin_amdgcn_sched_barrier(0)
__device__ __forceinline__ int crow(int r, int hi) { return (r & 3) + 8 * (r >> 2) + 4 * hi; }
__device__ __forceinline__ void partialSM(f32x16& p0, f32x16& p1, float& m_reg, float& mn, float& alpha) {
  constexpr float C = SCALE * 1.4426950408889634f;
  float pmax = p0[0]; for (int r = 1; r < 16; ++r) pmax = fmaxf(pmax, p0[r]); for (int r = 0; r < 16; ++r) pmax = fmaxf(pmax, p1[r]);
  { auto rr = __builtin_amdgcn_permlane32_swap(__float_as_uint(pmax), __float_as_uint(pmax), false, false);
    pmax = fmaxf(__uint_as_float(rr[0]), __uint_as_float(rr[1])); }
  if (__builtin_expect(__all(pmax - m_reg <= THR / SCALE), 1)) { mn = m_reg; alpha = 1.f; }
  else { mn = fmaxf(m_reg, pmax); alpha = __builtin_amdgcn_exp2f((m_reg - mn) * C); m_reg = mn; }
  float mnC = -mn * C;
  for (int r = 0; r < 16; ++r) p0[r] = fmaf(p0[r], C, mnC); for (int r = 0; r < 16; ++r) p1[r] = fmaf(p1[r], C, mnC);
  for (int r = 0; r < 16; ++r) p0[r] = __builtin_amdgcn_exp2f(p0[r]);
}
__device__ __forceinline__ void finishSM(f32x16& p0, f32x16& p1, float alpha, float& l_reg, bf16x8& pa0, bf16x8& pa1, bf16x8& pa2, bf16x8& pa3) {
  for (int r = 0; r < 16; ++r) p1[r] = __builtin_amdgcn_exp2f(p1[r]);
  float ps = 0; for (int r = 0; r < 16; ++r) ps += p0[r]; for (int r = 0; r < 16; ++r) ps += p1[r];
  { auto rr = __builtin_amdgcn_permlane32_swap(__float_as_uint(ps), __float_as_uint(ps), false, false);
    ps = __uint_as_float(rr[0]) + __uint_as_float(rr[1]); }
  l_reg = l_reg * alpha + ps;
#define PK4(P, BASE, OUT) do { unsigned a0 = cvt_pk_bf16(P[BASE + 0], P[BASE + 1]), a1 = cvt_pk_bf16(P[BASE + 2], P[BASE + 3]);   \
    unsigned b0 = cvt_pk_bf16(P[BASE + 4], P[BASE + 5]), b1 = cvt_pk_bf16(P[BASE + 6], P[BASE + 7]);                              \
    auto r0 = __builtin_amdgcn_permlane32_swap(a0, b0, false, false); auto r1 = __builtin_amdgcn_permlane32_swap(a1, b1, false, false); \
    u32x4 w = {r0[0], r1[0], r0[1], r1[1]}; OUT = *reinterpret_cast<bf16x8*>(&w); } while (0)
  PK4(p0, 0, pa0); PK4(p0, 8, pa1); PK4(p1, 0, pa2); PK4(p1, 8, pa3);
#undef PK4
}
__device__ __forceinline__ void qkt(f32x16& p0, f32x16& p1, const char* Ks, const char* Kp, const bf16x8* qr, const char* Qp, int qrow, int r32, int hi) {
  p0 = f32x16{}; p1 = f32x16{};
#pragma unroll
  for (int d0 = 0; d0 < 8; ++d0) { int cb = (d0 * 16 + hi * 8) * 2;
    bf16x8 b0 = *reinterpret_cast<const bf16x8*>(Ks + KSWZ(r32, cb));
    bf16x8 b1 = *reinterpret_cast<const bf16x8*>(Ks + KSWZ(32 + r32, cb));
    bf16x8 q; if (d0 < 4) q = qr[d0]; else q = *reinterpret_cast<const bf16x8*>(Qp + KSWZ(qrow, ((d0 - 4) * 16 + hi * 8) * 2));
    p0 = __builtin_amdgcn_mfma_f32_32x32x16_bf16(b0, q, p0, 0, 0, 0);
    p1 = __builtin_amdgcn_mfma_f32_32x32x16_bf16(b1, q, p1, 0, 0, 0); }
#pragma unroll
  for (int d0 = 0; d0 < 4; ++d0) { int cb = (d0 * 16 + hi * 8) * 2;
    bf16x8 b0 = *reinterpret_cast<const bf16x8*>(Kp + KPSWZ(r32, cb));
    bf16x8 b1 = *reinterpret_cast<const bf16x8*>(Kp + KPSWZ(32 + r32, cb));
    const bf16x8 qp = *reinterpret_cast<const bf16x8*>(Qp + KSWZ(qrow, 128 + cb));
    p0 = __builtin_amdgcn_mfma_f32_32x32x16_bf16(b0, qp, p0, 0, 0, 0);
    p1 = __builtin_amdgcn_mfma_f32_32x32x16_bf16(b1, qp, p1, 0, 0, 0); }
}
__device__ __forceinline__ int v_st(int k, int c) { const int kk = (k & ~0xC) | ((k & 4) << 1) | ((k & 8) >> 1); return ((kk >> 3) * 4 + (c >> 5)) * 512 + ((kk & 7) * 32 + (c & 31)) * 2; }
__device__ __forceinline__ int v_rd_base(int lane) { return ((lane & 3) << 3) | (((lane >> 2) & 3) << 6) | (((lane >> 4) & 1) << 5) | (((lane >> 5) & 1) << 8); }
constexpr int v_rd_off(int d0, int ks, int half) { return d0 * 512 + ks * 4096 + half * 2048; }
template <int OFF> __device__ __forceinline__ s16x4 tr_read(int vb) {
  s16x4 r; asm volatile("ds_read_b64_tr_b16 %0, %1 offset:%2" : "=&v"(r) : "v"(vb), "i"(OFF) : "memory"); return r;
}
template <int D0> __device__ __forceinline__ void pv_one(f32x16& od, int vb, bf16x8 pa0, bf16x8 pa1, bf16x8 pa2, bf16x8 pa3) {
  const s16x4 l0 = tr_read<v_rd_off(D0, 0, 0)>(vb), h0 = tr_read<v_rd_off(D0, 0, 1)>(vb), l1 = tr_read<v_rd_off(D0, 1, 0)>(vb), h1 = tr_read<v_rd_off(D0, 1, 1)>(vb);
  const s16x4 l2 = tr_read<v_rd_off(D0, 2, 0)>(vb), h2 = tr_read<v_rd_off(D0, 2, 1)>(vb), l3 = tr_read<v_rd_off(D0, 3, 0)>(vb), h3 = tr_read<v_rd_off(D0, 3, 1)>(vb);
  asm volatile("s_waitcnt lgkmcnt(0)" ::: "memory"); SBAR();
#define PK(L, H) (bf16x8){L[0], L[1], L[2], L[3], H[0], H[1], H[2], H[3]}
  od = __builtin_amdgcn_mfma_f32_32x32x16_bf16(pa0, PK(l0, h0), od, 0, 0, 0);
  od = __builtin_amdgcn_mfma_f32_32x32x16_bf16(pa1, PK(l1, h1), od, 0, 0, 0);
  od = __builtin_amdgcn_mfma_f32_32x32x16_bf16(pa2, PK(l2, h2), od, 0, 0, 0);
  od = __builtin_amdgcn_mfma_f32_32x32x16_bf16(pa3, PK(l3, h3), od, 0, 0, 0);
#undef PK
}
__device__ __forceinline__ void pv_d0(f32x16* o, int vb, bf16x8 pa0, bf16x8 pa1, bf16x8 pa2, bf16x8 pa3) {
  pv_one<0>(o[0], vb, pa0, pa1, pa2, pa3); pv_one<1>(o[1], vb, pa0, pa1, pa2, pa3); pv_one<2>(o[2], vb, pa0, pa1, pa2, pa3); pv_one<3>(o[3], vb, pa0, pa1, pa2, pa3);
}
__device__ __forceinline__ void attn_unit(const bf16_t* __restrict__ Qb, const bf16_t* __restrict__ KVh, const bf16_t* __restrict__ KPE, bf16_t* __restrict__ Ob,
                                          int ka0, int kb0, int NT, char* lds, int tid_in) {
  const unsigned tid_u = (unsigned)tid_in; __builtin_assume(tid_u < 512u);
  const int tid = (int)tid_u, wid = tid >> 6, lane = tid & 63, r32 = lane & 31, hi = lane >> 5;
  char* V_lds = lds + OFF_V; char* K_lds = lds + OFF_K; char* P_lds = lds + OFF_KP;
  float* ws = (float*)(lds + OFF_WS) + wid * 64; float* li_l = ws; float* al_l = ws + 32;
  float m_reg = -1e30f, l_reg = 0; f32x16 o[4] = {}; bf16x8 qr[4];
  char* Q_lds = lds + OFF_QP; const int qrow = wid * QBLK + r32;
  const bf16_t* Qw = Qb + (long)(wid * QBLK + r32) * LDQ + hi * 8;
#pragma unroll
  for (int d0 = 0; d0 < 4; ++d0) qr[d0] = *reinterpret_cast<const bf16x8*>(Qw + d0 * 16);
#pragma unroll
  for (int d0 = 0; d0 < 8; ++d0) *reinterpret_cast<bf16x8*>(Q_lds + KSWZ(qrow, (d0 * 16 + hi * 8) * 2)) = *reinterpret_cast<const bf16x8*>(Qw + 64 + d0 * 16);
  const int sr = tid >> 4, sc = (tid & 15) * 8, vst0 = v_st(sr, sc), vst1 = v_st(32 + sr, sc);
  const int pr = tid >> 3, pc = (tid & 7) * 8;
  const int vb0 = (int)(uintptr_t)V_lds + v_rd_base(lane);
  struct { bf16x8 vs0, vs1, ks0, ks1, kp; } sr_[SDEPTH];
#define KROW(j) ((j) < 4 ? ka0 + 64 * (j) : kb0 + 64 * ((j) - 4))
#define SLOAD(i, jt) do { const long k0_ = KROW(jt); \
    sr_[i].vs0 = *reinterpret_cast<const bf16x8*>(&KVh[(k0_ + sr) * LDKV + 128 + sc]); sr_[i].vs1 = *reinterpret_cast<const bf16x8*>(&KVh[(k0_ + 32 + sr) * LDKV + 128 + sc]); \
    sr_[i].ks0 = *reinterpret_cast<const bf16x8*>(&KVh[(k0_ + sr) * LDKV + sc]); sr_[i].ks1 = *reinterpret_cast<const bf16x8*>(&KVh[(k0_ + 32 + sr) * LDKV + sc]); \
    sr_[i].kp = *reinterpret_cast<const bf16x8*>(&KPE[(k0_ + pr) * 64 + pc]); } while (0)
#define SWRITE(b, i) do { *(bf16x8*)(V_lds + (b) * SHM_V + vst0) = sr_[i].vs0;          \
    *(bf16x8*)(V_lds + (b) * SHM_V + vst1) = sr_[i].vs1; int kc = sc * 2;               \
    *(bf16x8*)(K_lds + (b) * SHM_K + KSWZ(sr, kc)) = sr_[i].ks0;                       \
    *(bf16x8*)(K_lds + (b) * SHM_K + KSWZ(32 + sr, kc)) = sr_[i].ks1;                  \
    *(bf16x8*)(P_lds + (b) * SHM_KP + KPSWZ(pr, pc * 2)) = sr_[i].kp; } while (0)
#define SWAIT() do { if constexpr (SDEPTH == 2) asm volatile("s_waitcnt vmcnt(5)" ::: "memory"); else asm volatile("s_waitcnt vmcnt(0)" ::: "memory"); } while (0)
#define RESC(a) do { if (__any((a) < 1.f)) { if (hi == 0) al_l[r32] = (a); asm volatile("s_waitcnt lgkmcnt(0)" ::: "memory"); \
    for (int d = 0; d < 4; ++d) for (int r = 0; r < 16; ++r) o[d][r] *= al_l[crow(r, hi)]; } } while (0)
  f32x16 pA0, pA1, pB0, pB1; float mnA, mnB, alA, alB; bf16x8 pa0, pa1, pa2, pa3;
  constexpr int SE = 0, SO = SDEPTH - 1;
  SLOAD(SE, 0); asm volatile("s_waitcnt vmcnt(0)" ::: "memory"); SWRITE(0, SE); __syncthreads();
  qkt(pA0, pA1, K_lds, P_lds, qr, Q_lds, qrow, r32, hi); partialSM(pA0, pA1, m_reg, mnA, alA);
  SLOAD(SO, 1); if constexpr (SDEPTH == 2) { if (2 < NT) SLOAD(SE, 2); }
  SWAIT(); SWRITE(1, SO); __syncthreads();
  for (int j = 1; j + 1 < NT; j += 2) {
    SBAR(); qkt(pB0, pB1, K_lds + SHM_K, P_lds + SHM_KP, qr, Q_lds, qrow, r32, hi);
    finishSM(pA0, pA1, alA, l_reg, pa0, pa1, pa2, pa3); SBAR();
    SLOAD(SO, j + SDEPTH); SBAR();
    pv_d0(o, vb0, pa0, pa1, pa2, pa3); partialSM(pB0, pB1, m_reg, mnB, alB);
    __syncthreads(); SWAIT(); SWRITE(0, SE);
    RESC(alB); __syncthreads();
    SBAR(); qkt(pA0, pA1, K_lds, P_lds, qr, Q_lds, qrow, r32, hi);
    finishSM(pB0, pB1, alB, l_reg, pa0, pa1, pa2, pa3); SBAR();
    if (SDEPTH == 1 || j + 3 < NT) SLOAD(SE, j + 1 + SDEPTH); SBAR();
    pv_d0(o, vb0 + (int)SHM_V, pa0, pa1, pa2, pa3); partialSM(pA0, pA1, m_reg, mnA, alA);
    __syncthreads(); SWAIT(); SWRITE(1, SO);
    RESC(alA); __syncthreads();
  }
  SBAR(); qkt(pB0, pB1, K_lds + SHM_K, P_lds + SHM_KP, qr, Q_lds, qrow, r32, hi);
  finishSM(pA0, pA1, alA, l_reg, pa0, pa1, pa2, pa3); SBAR();
  pv_d0(o, vb0, pa0, pa1, pa2, pa3); partialSM(pB0, pB1, m_reg, mnB, alB);
  __syncthreads(); RESC(alB);
  finishSM(pB0, pB1, alB, l_reg, pa0, pa1, pa2, pa3); SBAR();
  pv_d0(o, vb0 + (int)SHM_V, pa0, pa1, pa2, pa3);
  if (hi == 0) li_l[r32] = l_reg; asm volatile("s_waitcnt lgkmcnt(0)" ::: "memory");
  float rli[16];
#pragma unroll
  for (int r = 0; r < 16; ++r) rli[r] = __builtin_amdgcn_rcpf(li_l[crow(r, hi)]);
  bf16_t* Ow = Ob + (long)(wid * QBLK) * LDO;
#pragma unroll
  for (int r = 0; r < 16; ++r) { int orow = crow(r, hi);
    for (int d0 = 0; d0 < 4; ++d0) Ow[(long)orow * LDO + d0 * 32 + r32] = (bf16_t)f2bf(o[d0][r] * rli[r]); }
  __syncthreads();
#undef KROW
#undef SLOAD
#undef SWRITE
#undef SWAIT
#undef RESC
}
}

__device__ __forceinline__ void phase_attn(Frame& F) {
    const bf16_t* Q = WSP(bf16_t, WS_Q); const bf16_t* KV = WSP(bf16_t, WS_KV); const bf16_t* KPE = WSP(bf16_t, WS_KPE); bf16_t* YA = WSP(bf16_t, WS_Y);
    constexpr int NU = NBATCH * NH_MLA * 32 + NBATCH * NH_MLA;
    for (int u = F.bid; u < NU; u += F.G) {
        int b, h, row0, NT;
        if (u < NBATCH * NH_MLA * 32) { const int bh = u >> 5, qb = u & 31; b = bh >> 3; h = bh & 7; row0 = TC + b * SEQ + qb * 256; NT = 4 + SEQ / 64; }
        else { const int bh = u - NBATCH * NH_MLA * 32; b = bh >> 3; h = bh & 7; row0 = b * CTX; NT = 4; }
        att::attn_unit(Q + (size_t)row0 * 1536 + h * 192, KV + h * 256, KPE, YA + (size_t)row0 * 1024 + h * 128, b * CTX, TC + b * SEQ, NT, (char*)F.lds, F.tid);
    }
}
__device__ __forceinline__ void phase_qrope(Frame& F) {
    bf16_t* Q = WSP(bf16_t, WS_Q);
    for (int row = TC + F.gw; row < T; row += F.NGW) {
        const int t = (row - TC) & (SEQ - 1); const int p = F.lane & 31, axis = p >> 4, j = p & 15, hs = F.lane >> 5;
        const float pos = (float)(axis == 0 ? (t >> 6) : (t & 63)); const float inv = __builtin_amdgcn_exp2f(-(float)j * 0.8304820237218406f);
        const float sn = __sinf(pos * inv), cs = __cosf(pos * inv);
#pragma unroll
        for (int hh = 0; hh < 4; ++hh) { const int h = hh * 2 + hs; bf16_t* q = Q + (size_t)row * 1536 + h * 192 + 128 + axis * 32 + j;
            const float x1 = bf2f(q[0]), x2 = bf2f(q[16]);
            q[0] = (bf16_t)f2bf(x1 * cs - x2 * sn); q[16] = (bf16_t)f2bf(x2 * cs + x1 * sn); }
    }
}

#define MFMA16(a, b, c) __builtin_amdgcn_mfma_f32_16x16x32_bf16((a), (b), (c), 0, 0, 0)
constexpr int XS_LD = 264, BC_LD = 136;
__device__ __forceinline__ float bperm(float v, int srclane) { return __builtin_bit_cast(float, __builtin_amdgcn_ds_bpermute(srclane << 2, __builtin_bit_cast(int, v))); }
__device__ __forceinline__ float wave_incl_scan(float v, int lane) {
#pragma unroll
    for (int o = 1; o < 64; o <<= 1) { const float t = bperm(v, lane - o); if (lane >= o) v += t; }
    return v;
}
__device__ __forceinline__ void stage_tile(LAS bf16_t* dst, int ld, const bf16_t* src, int ncols, int tid) {
    const int cpr = ncols >> 3;
    for (int i = tid; i < 128 * cpr; i += NTHREADS) { const int r = i / cpr, c8 = (i % cpr) * 8; *(LAS u32x4*)(dst + r * ld + c8) = *(const u32x4*)(src + (size_t)r * P2W + c8); }
}
__device__ __forceinline__ void phase_mamba_states(Frame& F, const Args& a, int layer) {
    const bf16_t* P2 = WSP(bf16_t, WS_P2); const float* DT = WSP(float, WS_DT); bf16_t* MST = WSP(bf16_t, WS_MST); float* MCS = WSP(float, WS_MCS);
    LAS bf16_t* XSl = (LAS bf16_t*)F.lds; LAS bf16_t* Bl = (LAS bf16_t*)(F.lds + 67584); LAS float* wt = (LAS float*)(F.lds + 102400) + F.wave * 128;
    const int lane = F.lane, row = lane & 15, quad = lane >> 4;
    for (int u = F.bid; u < NCHUNK * 4; u += F.G) {
        const int chunk = u >> 2, g = (u >> 1) & 1, half = u & 1, row0 = chunk * 128;
        __syncthreads();
        stage_tile(XSl, XS_LD, P2 + (size_t)row0 * P2W + P2_XBC + (g * 8 + half * 4) * 64, 256, F.tid);
        stage_tile(Bl, BC_LD, P2 + (size_t)row0 * P2W + P2_XBC + 1024 + g * 128, 128, F.tid);
        const int hl = F.wave >> 1, d = F.wave & 1, h = g * 8 + half * 4 + hl;
        const float aa = -__expf(arg_in(a, I_SALOG)[(layer * 2 + d) * 16 + h]);
        { const float dt0 = DT[(size_t)(row0 + lane) * 32 + d * 16 + h], dt1 = DT[(size_t)(row0 + 64 + lane) * 32 + d * 16 + h];
          const float da0 = dt0 * aa, da1 = dt1 * aa;
          float c0 = wave_incl_scan(da0, lane); const float tot0 = bperm(c0, 63); float c1 = wave_incl_scan(da1, lane) + tot0; const float tot = bperm(c1, 63);
          if (d == 0) { wt[lane] = dt0 * __expf(tot - c0); wt[64 + lane] = dt1 * __expf(tot - c1); }
          else { wt[lane] = dt0 * __expf(c0 - da0); wt[64 + lane] = dt1 * __expf(c1 - da1); }
          if (lane == 0) MCS[(d * NCHUNK + chunk) * 16 + h] = tot; }
        __syncthreads();
        bf16_t* out = MST + ((size_t)(d * NCHUNK + chunk) * 16 + h) * 8192;
#pragma unroll 1
        for (int nh = 0; nh < 2; ++nh) {
            f32x4 acc[4][4];
#pragma unroll
            for (int i = 0; i < 4; ++i)
#pragma unroll
                for (int j = 0; j < 4; ++j) acc[i][j] = (f32x4){0.f, 0.f, 0.f, 0.f};
#pragma unroll 1
            for (int k0 = 0; k0 < 128; k0 += 32) {
                const int sb = k0 + quad * 8;
                float w8[8];
#pragma unroll
                for (int j = 0; j < 8; ++j) w8[j] = wt[sb + j];
                bf16x8 bf[4];
#pragma unroll
                for (int nt = 0; nt < 4; ++nt) {
#pragma unroll
                    for (int j = 0; j < 8; ++j) bf[nt][j] = (short)Bl[(sb + j) * BC_LD + (nh * 4 + nt) * 16 + row]; }
#pragma unroll
                for (int pt = 0; pt < 4; ++pt) { bf16x8 af;
#pragma unroll
                    for (int j = 0; j < 8; ++j) af[j] = (short)f2bf(w8[j] * bf2f(XSl[(sb + j) * XS_LD + hl * 64 + pt * 16 + row]));
#pragma unroll
                    for (int nt = 0; nt < 4; ++nt) acc[pt][nt] = MFMA16(af, bf[nt], acc[pt][nt]); }
            }
#pragma unroll
            for (int pt = 0; pt < 4; ++pt)
#pragma unroll
                for (int nt = 0; nt < 4; ++nt)
#pragma unroll
                    for (int jj = 0; jj < 4; ++jj) out[(pt * 16 + quad * 4 + jj) * 128 + (nh * 4 + nt) * 16 + row] = (bf16_t)f2bf(acc[pt][nt][jj]);
        }
    }
}
__device__ __forceinline__ void phase_mamba_scan(Frame& F) {
    bf16_t* MST = WSP(bf16_t, WS_MST); const float* MCS = WSP(float, WS_MCS);
    for (int idx = F.bid * NTHREADS + F.tid; idx < 2 * 2 * 16 * 8192; idx += F.G * NTHREADS) {
        const int e = idx & 8191, h = (idx >> 13) & 15, b = (idx >> 17) & 1, d = idx >> 18;
        float state = 0.f;
#pragma unroll 6
        for (int i = 0; i < 66; ++i) {
            int chunk; if (i < 2) chunk = 2 * b + (d == 0 ? i : 1 - i); else chunk = 4 + 64 * b + (d == 0 ? i - 2 : 65 - i);
            bf16_t* p = MST + ((size_t)(d * NCHUNK + chunk) * 16 + h) * 8192 + e;
            const float cs = bf2f(*p); const float dec = __expf(MCS[(d * NCHUNK + chunk) * 16 + h]);
            *p = (bf16_t)f2bf(state);
            state = state * dec + cs;
        }
    }
}
__device__ __forceinline__ void phase_mamba_out(Frame& F, const Args& a, int layer) {
    const bf16_t* P = WSP(bf16_t, WS_P); const bf16_t* P2 = WSP(bf16_t, WS_P2); const float* DT = WSP(float, WS_DT); const bf16_t* MST = WSP(bf16_t, WS_MST);
    bf16_t* YB = WSP(bf16_t, WS_Y) + (size_t)1 * T * 1024;
    LAS bf16_t* Cl = (LAS bf16_t*)F.lds; LAS bf16_t* Bl = (LAS bf16_t*)(F.lds + 34816); LAS bf16_t* XSl = (LAS bf16_t*)(F.lds + 69632);
    LAS float* tab = (LAS float*)(F.lds + 137216);
    const int lane = F.lane, row = lane & 15, quad = lane >> 4;
    for (int u = F.bid; u < NCHUNK * 4; u += F.G) {
        const int chunk = u >> 2, g = (u >> 1) & 1, half = u & 1, row0 = chunk * 128;
        __syncthreads();
        stage_tile(XSl, XS_LD, P2 + (size_t)row0 * P2W + P2_XBC + (g * 8 + half * 4) * 64, 256, F.tid);
        stage_tile(Bl, BC_LD, P2 + (size_t)row0 * P2W + P2_XBC + 1024 + g * 128, 128, F.tid);
        stage_tile(Cl, BC_LD, P2 + (size_t)row0 * P2W + P2_XBC + 1280 + g * 128, 128, F.tid);
        float tot1 = 0.f;
        { const int hl = F.wave >> 1, d = F.wave & 1, h = g * 8 + half * 4 + hl;
          const float aa = -__expf(arg_in(a, I_SALOG)[(layer * 2 + d) * 16 + h]);
          const float dt0 = DT[(size_t)(row0 + lane) * 32 + d * 16 + h], dt1 = DT[(size_t)(row0 + 64 + lane) * 32 + d * 16 + h];
          const float da0 = dt0 * aa, da1 = dt1 * aa;
          float c0 = wave_incl_scan(da0, lane); const float t0 = bperm(c0, 63); float c1 = wave_incl_scan(da1, lane) + t0;
          LAS float* tb = tab + hl * 512;
          if (d == 0) { tb[lane] = c0; tb[64 + lane] = c1; tb[256 + lane] = __logf(dt0) - c0; tb[320 + lane] = __logf(dt1) - c1; }
          else { tb[128 + lane] = c0 - da0; tb[192 + lane] = c1 - da1; tb[384 + lane] = (c0 - da0) + __logf(dt0); tb[448 + lane] = (c1 - da1) + __logf(dt1); if (lane == 63) tab[2048 + hl] = c1; } }
        __syncthreads();
        { f32x4 cb[8];
#pragma unroll
          for (int st = 0; st < 8; ++st) cb[st] = (f32x4){0.f, 0.f, 0.f, 0.f};
#pragma unroll
          for (int k0 = 0; k0 < 128; k0 += 32) { const bf16x8 af = *(const LAS bf16x8*)(Cl + (F.wave * 16 + row) * BC_LD + k0 + quad * 8);
#pragma unroll
              for (int st = 0; st < 8; ++st) { const bf16x8 bfr = *(const LAS bf16x8*)(Bl + (st * 16 + row) * BC_LD + k0 + quad * 8); cb[st] = MFMA16(af, bfr, cb[st]); } }
          __syncthreads();
#pragma unroll
          for (int st = 0; st < 8; ++st)
#pragma unroll
              for (int jj = 0; jj < 4; ++jj) Bl[(F.wave * 16 + quad * 4 + jj) * BC_LD + st * 16 + row] = (bf16_t)f2bf(cb[st][jj]); }
        __syncthreads();
        const int hl = F.wave >> 1, th = F.wave & 1, h = g * 8 + half * 4 + hl;
        const LAS float* tb = tab + hl * 512; tot1 = tab[2048 + hl];
        f32x4 acc[4][4];
#pragma unroll
        for (int i = 0; i < 4; ++i)
#pragma unroll
            for (int j = 0; j < 4; ++j) acc[i][j] = (f32x4){0.f, 0.f, 0.f, 0.f};
#pragma unroll 1
        for (int k0 = 0; k0 < 128; k0 += 32) {
            const int sb = k0 + quad * 8;
            float u0s[8], u1s[8];
#pragma unroll
            for (int j = 0; j < 8; ++j) { u0s[j] = tb[256 + sb + j]; u1s[j] = tb[384 + sb + j]; }
            bf16x8 bx[4];
#pragma unroll
            for (int pt = 0; pt < 4; ++pt) {
#pragma unroll
                for (int j = 0; j < 8; ++j) bx[pt][j] = (short)XSl[(sb + j) * XS_LD + hl * 64 + pt * 16 + row]; }
#pragma unroll
            for (int tt = 0; tt < 4; ++tt) { const int t = th * 64 + tt * 16 + row; const float c0t = tb[t], e1t = tb[128 + t];
                float cbv[8]; { const u32x4 w = *(const LAS u32x4*)(Bl + t * BC_LD + sb); cbv[0] = bflo(w.x); cbv[1] = bfhi(w.x); cbv[2] = bflo(w.y); cbv[3] = bfhi(w.y); cbv[4] = bflo(w.z); cbv[5] = bfhi(w.z); cbv[6] = bflo(w.w); cbv[7] = bfhi(w.w); }
                bf16x8 af;
#pragma unroll
                for (int j = 0; j < 8; ++j) { const int s = sb + j;
                    const float f0 = s <= t ? __expf(c0t + u0s[j]) : 0.f;
                    const float f1 = s >= t ? __expf(u1s[j] - e1t) : 0.f;
                    af[j] = (short)f2bf(cbv[j] * (f0 + f1)); }
#pragma unroll
                for (int pt = 0; pt < 4; ++pt) acc[tt][pt] = MFMA16(af, bx[pt], acc[tt][pt]); }
        }
#pragma unroll 1
        for (int d = 0; d < 2; ++d) {
            const bf16_t* S = MST + ((size_t)(d * NCHUNK + chunk) * 16 + h) * 8192;
#pragma unroll 1
            for (int k0 = 0; k0 < 128; k0 += 32) {
                bf16x8 bs[4];
#pragma unroll
                for (int pt = 0; pt < 4; ++pt) bs[pt] = *(const bf16x8*)(S + (pt * 16 + row) * 128 + k0 + quad * 8);
#pragma unroll
                for (int tt = 0; tt < 4; ++tt) { const int t = th * 64 + tt * 16 + row;
                    const float sc = d == 0 ? __expf(tb[t]) : __expf(tot1 - tb[128 + t]);
                    const u32x4 cw = *(const LAS u32x4*)(Cl + t * BC_LD + k0 + quad * 8);
                    u32x4 aw; aw.x = cvt_pk_bf16(bflo(cw.x) * sc, bfhi(cw.x) * sc); aw.y = cvt_pk_bf16(bflo(cw.y) * sc, bfhi(cw.y) * sc);
                    aw.z = cvt_pk_bf16(bflo(cw.z) * sc, bfhi(cw.z) * sc); aw.w = cvt_pk_bf16(bflo(cw.w) * sc, bfhi(cw.w) * sc);
                    const bf16x8 af = __builtin_bit_cast(bf16x8, aw);
#pragma unroll
                    for (int pt = 0; pt < 4; ++pt) acc[tt][pt] = MFMA16(af, bs[pt], acc[tt][pt]); } }
        }
        const float Dh = arg_in(a, I_SD)[layer * 16 + h];
#pragma unroll
        for (int tt = 0; tt < 4; ++tt)
#pragma unroll
            for (int jj = 0; jj < 4; ++jj) { const int t = th * 64 + tt * 16 + quad * 4 + jj; const size_t r = (size_t)(row0 + t);
#pragma unroll
                for (int pt = 0; pt < 4; ++pt) { const int p = pt * 16 + row;
                    const float xs = bf2f(XSl[t * XS_LD + hl * 64 + p]); const float z = bf2f(P[r * NNG + P_Z + h * 64 + p]);
                    YB[r * 1024 + h * 64 + p] = (bf16_t)f2bf((acc[tt][pt][jj] + xs * Dh) * siluf_(z)); } }
    }
}
__device__ __forceinline__ void phase_mamba_norm(Frame& F, const Args& a, int layer) {
    bf16_t* YB = WSP(bf16_t, WS_Y) + (size_t)1 * T * 1024; const float* nw = arg_in(a, I_SNORM) + layer * 1024;
    for (int row = F.gw; row < T; row += F.NGW) {
        bf16_t* p = YB + (size_t)row * 1024 + F.lane * 16; float x[16]; { float t0[8], t1[8]; ld8bf(p, t0); ld8bf(p + 8, t1);
#pragma unroll
            for (int i = 0; i < 8; ++i) { x[i] = t0[i]; x[8 + i] = t1[i]; } }
        float s = 0.f;
#pragma unroll
        for (int i = 0; i < 16; ++i) s += x[i] * x[i];
        s = sum32(s);
        const float r = 1.f / sqrtf(s * (1.f / 512.f) + 1e-5f);
        float o0[8], o1[8];
#pragma unroll
        for (int i = 0; i < 8; ++i) { o0[i] = x[i] * r * nw[F.lane * 16 + i]; o1[i] = x[8 + i] * r * nw[F.lane * 16 + 8 + i]; }
        st8bf(p, o0); st8bf(p + 8, o1);
    }
}

__device__ __forceinline__ float dpp_f(float x, const int ctrl_sel) {
    const int xi = __builtin_bit_cast(int, x); int r;
    if (ctrl_sel == 0) r = __builtin_amdgcn_update_dpp(0, xi, 0xB1, 0xF, 0xF, false);
    else if (ctrl_sel == 1) r = __builtin_amdgcn_update_dpp(0, xi, 0x4E, 0xF, 0xF, false);
    else r = __builtin_amdgcn_update_dpp(0, xi, 0x141, 0xF, 0xF, false);
    return __builtin_bit_cast(float, r);
}
__device__ __forceinline__ float red8(float x) { x += dpp_f(x, 0); x += dpp_f(x, 1); x += dpp_f(x, 2); return x; }
__device__ __forceinline__ int rw_row(int pos, int b, int d) { return pos < CTX ? b * CTX + (d == 0 ? pos : CTX - 1 - pos) : TC + b * SEQ + (d == 0 ? pos - CTX : SEQ - 1 - (pos - CTX)); }
constexpr int RW_STEP_F = 336, RW_CH = 32, RW_CHF = RW_STEP_F * RW_CH;
struct RwOps { f32x4 w, k, b, a, r; float v; };
__device__ __forceinline__ void rw_load(RwOps& o, const LAS float* sp, const LAS float* vp) {
    o.w = *(const LAS f32x4*)(sp); o.k = *(const LAS f32x4*)(sp + 64); o.b = *(const LAS f32x4*)(sp + 128); o.a = *(const LAS f32x4*)(sp + 192); o.r = *(const LAS f32x4*)(sp + 256); o.v = *vp;
}
__device__ __forceinline__ void rw_step(f32x4& s, const RwOps& o, LAS float* yp) {
    const f32x4 tt = s * o.w + o.k * o.v;
    const f32x4 pa = s * o.a; float sa = (pa.x + pa.y) + (pa.z + pa.w); sa = sum16(sa);
    s = tt + o.b * sa;
    const f32x4 pr = s * o.r; *yp = (pr.x + pr.y) + (pr.z + pr.w);
}
struct RwRaw { float ew[8], ic[8], kk[8], rr[8], kr[8], vv[8]; };
__device__ __forceinline__ void phase_rwkv_scan(Frame& F, const Args& a, int layer) {
    const bf16_t* P2 = WSP(bf16_t, WS_P2); const bf16_t* EW = WSP(bf16_t, WS_EW); const bf16_t* ICLR = WSP(bf16_t, WS_ICLR); const bf16_t* KK = WSP(bf16_t, WS_KK);
    bf16_t* YRW = WSP(bf16_t, WS_YRW);
    LAS float* ring = (LAS float*)F.lds; LAS float* ybuf = (LAS float*)(F.lds + 2 * RW_CHF * 4);
    const int lane = F.lane;
    for (int u = F.bid; u < 256; u += F.G) {
        const int chain = u >> 2, rq = u & 3, d = chain >> 5, b = (chain >> 4) & 1, h = chain & 15;
        const float ka = arg_in(a, I_RKA)[layer * 1024 + h * 64 + lane];
        constexpr int NCH = (CTX + SEQ) / RW_CH;
        const int lw = F.wave - 4;
        auto issue = [&](RwRaw& x, int cidx) {
            const int row0 = rw_row(cidx * RW_CH, b, d), st = d == 0 ? 1 : -1;
            const int o0 = (row0 + st * lw) * 1024 + h * 64 + lane, ostep = st * 4 * 1024;
            const int q0 = (row0 + st * lw) * P2W + P2_RKV + h * 64 + lane, qstep = st * 4 * P2W;
            const bf16_t* ewp = EW + (size_t)d * T * 1024; const bf16_t* icp = ICLR + (size_t)d * T * 1024; const int vo = 2048 + rq * 16 + (lane & 15) - lane;
#pragma unroll
            for (int j = 0; j < 8; ++j) { const int o = o0 + j * ostep, q = q0 + j * qstep;
                x.ew[j] = bf2f(ewp[o]); x.ic[j] = bf2f(icp[o]); x.kk[j] = bf2f(KK[o]);
                x.rr[j] = bf2f(P2[q]); x.kr[j] = bf2f(P2[q + 1024]); x.vv[j] = bf2f(P2[q + vo]); } };
        auto commit = [&](const RwRaw& x, int cidx) {
            LAS float* dst = ring + (cidx & 1) * RW_CHF;
#pragma unroll
            for (int j = 0; j < 8; ++j) { LAS float* s = dst + (lw + 4 * j) * RW_STEP_F;
                s[lane] = __expf(-x.ew[j]); s[64 + lane] = x.kr[j] * (1.f + (x.ic[j] - 1.f) * ka); s[128 + lane] = x.kk[j] * x.ic[j]; s[192 + lane] = -x.kk[j]; s[256 + lane] = x.rr[j];
                if (lane < 16) s[320 + lane] = x.vv[j]; } };
        auto flush_chunk = [&](int cidx) {
            const LAS float* yb = ybuf + (cidx & 1) * (RW_CH * 256);
            const int row0 = rw_row(cidx * RW_CH, b, d), st = d == 0 ? 1 : -1;
#pragma unroll
            for (int q = 0; q < 2; ++q) { const int i = (F.tid - 256) + 256 * q, tok = i >> 4, rr = i & 15; const LAS f32x4* pp = (const LAS f32x4*)(yb + i * 16);
                const f32x4 p0 = pp[0], p1 = pp[1], p2 = pp[2], p3 = pp[3];
                const float y = ((p0.x + p0.y) + (p0.z + p0.w)) + ((p1.x + p1.y) + (p1.z + p1.w)) + (((p2.x + p2.y) + (p2.z + p2.w)) + ((p3.x + p3.y) + (p3.z + p3.w)));
                YRW[((size_t)d * T + row0 + st * tok) * 1024 + h * 64 + rq * 16 + rr] = (bf16_t)f2bf(y); } };
        auto compute = [&](f32x4& s, int c) {
            const int rloc = lane >> 4, kq = lane & 15, r16 = F.wave * 4 + rloc;
            const LAS float* base = ring + (c & 1) * RW_CHF + kq * 4; const LAS float* vb = ring + (c & 1) * RW_CHF + 320 + r16; LAS float* yb = ybuf + (c & 1) * (RW_CH * 256) + r16 * 16 + kq;
            RwOps oa, ob;
            rw_load(oa, base, vb);
#pragma unroll 2
            for (int t = 0; t < RW_CH; t += 2) {
                rw_load(ob, base + (t + 1) * RW_STEP_F, vb + (t + 1) * RW_STEP_F);
                rw_step(s, oa, yb + t * 256);
                if (t + 2 < RW_CH) rw_load(oa, base + (t + 2) * RW_STEP_F, vb + (t + 2) * RW_STEP_F);
                rw_step(s, ob, yb + (t + 1) * 256);
            } };
        __syncthreads();
        f32x4 s = {0.f, 0.f, 0.f, 0.f};
        if (F.wave >= 4) {
            RwRaw ra, rb;
            issue(ra, 0); commit(ra, 0); issue(ra, 1);
            __syncthreads();
            for (int c = 0; c < NCH; c += 2) {
                if (c + 2 < NCH) issue(rb, c + 2);
                if (c > 0) flush_chunk(c - 1);
                commit(ra, c + 1);
                __syncthreads();
                if (c + 3 < NCH) issue(ra, c + 3);
                flush_chunk(c);
                if (c + 2 < NCH) commit(rb, c + 2);
                __syncthreads();
            }
            flush_chunk(NCH - 1);
        } else {
            __syncthreads();
            for (int c = 0; c < NCH; c += 2) { compute(s, c); __syncthreads(); compute(s, c + 1); __syncthreads(); }
        }
    }
}
__device__ __forceinline__ void phase_rwkv_out(Frame& F, const Args& a, int layer) {
    const bf16_t* P2 = WSP(bf16_t, WS_P2); const bf16_t* ICLR = WSP(bf16_t, WS_ICLR); const bf16_t* YRW = WSP(bf16_t, WS_YRW); const bf16_t* GG = WSP(bf16_t, WS_GG);
    bf16_t* YD = WSP(bf16_t, WS_Y) + (size_t)3 * T * 1024;
    const float* lng = arg_in(a, I_RLNG) + layer * 1024; const float* lnb = arg_in(a, I_RLNB) + layer * 1024; const float* rk = arg_in(a, I_RRK) + layer * 1024; const float* kav = arg_in(a, I_RKA) + layer * 1024;
    for (int row = F.gw; row < T; row += F.NGW) {
        const int c = F.lane * 16; const size_t o = (size_t)row * 1024 + c;
        float y[16], r[16], k[16], v[16], i0[16], i1[16], g[16];
#define LD16(dst, ptr) do { float t0_[8], t1_[8]; ld8bf((ptr), t0_); ld8bf((ptr) + 8, t1_); _Pragma("unroll") for (int i_ = 0; i_ < 8; ++i_) { dst[i_] = t0_[i_]; dst[8 + i_] = t1_[i_]; } } while (0)
        LD16(y, YRW + o); LD16(r, YRW + (size_t)T * 1024 + o);
#pragma unroll
        for (int i = 0; i < 16; ++i) y[i] += r[i];
        const bf16_t* p2 = P2 + (size_t)row * P2W + P2_RKV + c;
        LD16(r, p2); LD16(k, p2 + 1024); LD16(v, p2 + 2048); LD16(i0, ICLR + o); LD16(i1, ICLR + (size_t)T * 1024 + o); LD16(g, GG + o);
#undef LD16
        float s = 0.f, bsum = 0.f;
#pragma unroll
        for (int i = 0; i < 16; ++i) { s += y[i]; const float ka = kav[c + i]; bsum += r[i] * k[i] * rk[c + i] * ((1.f + (i0[i] - 1.f) * ka) + (1.f + (i1[i] - 1.f) * ka)); }
        s = sum4(s); bsum = sum4(bsum);
        const float mu = s * (1.f / 64.f); float q = 0.f;
#pragma unroll
        for (int i = 0; i < 16; ++i) { const float dd = y[i] - mu; q += dd * dd; }
        q = sum4(q);
        const float rstd = 1.f / sqrtf(q * (1.f / 64.f) + 64e-5f);
        float o0[8], o1[8];
#pragma unroll
        for (int i = 0; i < 8; ++i) { o0[i] = ((y[i] - mu) * rstd * lng[c + i] + lnb[c + i] + bsum * v[i]) * g[i];
            o1[i] = ((y[8 + i] - mu) * rstd * lng[c + 8 + i] + lnb[c + 8 + i] + bsum * v[8 + i]) * g[8 + i]; }
        st8bf(YD + o, o0); st8bf(YD + o + 8, o1);
    }
}

constexpr int FFT_N = 16384;
__device__ __forceinline__ int fswz(int i) { return i ^ (((i >> 5) & 3) << 2) ^ (((i >> 6) & 1) << 4); }
__device__ __forceinline__ f32x2 cmul(f32x2 a, f32x2 b) { return (f32x2){a.x * b.x - a.y * b.y, a.x * b.y + a.y * b.x}; }
template <bool INV>
__device__ __forceinline__ void fft_passes(LAS f32x2* X, int tid) {
#pragma unroll 1
    for (int st = 0; st < 7; ++st) {
        const int lq = INV ? 2 * st : 12 - 2 * st;
        const int q = 1 << lq;
        __syncthreads();
#pragma unroll 2
        for (int mm = 0; mm < 8; ++mm) { const int uu = tid + 512 * mm; const int k = uu & (q - 1), blk = uu >> lq; const int i0 = (blk << (lq + 2)) + k;
            const int p0 = fswz(i0), p1 = fswz(i0 + q), p2 = fswz(i0 + 2 * q), p3 = fswz(i0 + 3 * q);
            f32x2 a0 = X[p0], a1 = X[p1], a2 = X[p2], a3 = X[p3];
            const float fr = (float)k / (float)(4 * q);
            const float cs = __builtin_amdgcn_cosf(fr), sn = __builtin_amdgcn_sinf(fr);
            const f32x2 w1 = INV ? (f32x2){cs, sn} : (f32x2){cs, -sn}; const f32x2 w2 = cmul(w1, w1), w3 = cmul(w2, w1);
            if (!INV) {
                const f32x2 t0 = a0 + a2, t1 = a0 - a2, t2 = a1 + a3, t3 = a1 - a3;
                const f32x2 b0 = t0 + t2, b2 = t0 - t2, b1 = (f32x2){t1.x + t3.y, t1.y - t3.x}, b3 = (f32x2){t1.x - t3.y, t1.y + t3.x};
                X[p0] = b0; X[p1] = cmul(b1, w1); X[p2] = cmul(b2, w2); X[p3] = cmul(b3, w3);
            } else {
                a1 = cmul(a1, w1); a2 = cmul(a2, w2); a3 = cmul(a3, w3);
                const f32x2 u0 = a0 + a2, u1 = a0 - a2, u2 = a1 + a3, u3 = a1 - a3;
                X[p0] = u0 + u2; X[p2] = u0 - u2; X[p1] = (f32x2){u1.x - u3.y, u1.y + u3.x}; X[p3] = (f32x2){u1.x + u3.y, u1.y - u3.x};
            } }
    }
    __syncthreads();
}
__device__ __forceinline__ void phase_hyena_fft(Frame& F, const Args& a, int layer, bool dry = false) {
    const bf16_t* FILT = WSP(bf16_t, WS_FILT); float* VT = WSP(float, WS_VT); const float* hyd = arg_in(a, I_HD) + layer * 1024;
    LAS f32x2* X = (LAS f32x2*)F.lds;
    for (int c = F.bid; c < 1024; c += F.G) {
        __syncthreads();
        const bf16_t* hf = FILT + (size_t)c * 2 * SEQ; const bf16_t* hb = hf + SEQ;
        for (int i = F.tid; i < FFT_N; i += NTHREADS) { float v; if (i < SEQ) v = bf2f(hf[i]); else if (i == SEQ) v = 0.f; else v = bf2f(hb[FFT_N - i]); X[fswz(i)] = (f32x2){v, 0.f}; }
        fft_passes<false>(X, F.tid);
        f32x2 Kh[32];
#pragma unroll
        for (int j = 0; j < 32; ++j) Kh[j] = X[fswz(F.tid + 512 * j)];
        __syncthreads();
        const float* v0 = VT + (size_t)c * 2 * SEQ; const float* v1 = v0 + SEQ;
        for (int i = F.tid; i < FFT_N; i += NTHREADS) X[fswz(i)] = i < SEQ ? (f32x2){v0[i], v1[i]} : (f32x2){0.f, 0.f};
        fft_passes<false>(X, F.tid);
#pragma unroll
        for (int j = 0; j < 32; ++j) { const int p = fswz(F.tid + 512 * j); X[p] = cmul(X[p], Kh[j]); }
        fft_passes<true>(X, F.tid);
        const float dc = hyd[c]; float* o0 = VT + (size_t)c * 2 * SEQ; float* o1 = o0 + SEQ;
        for (int i = F.tid; i < SEQ; i += NTHREADS) { const f32x2 r = X[fswz(i)]; const float x0 = o0[i], x1 = o1[i];
            if (!dry) { o0[i] = r.x * (1.f / FFT_N) + x0 * dc; o1[i] = r.y * (1.f / FFT_N) + x1 * dc; } }
    }
}
__device__ __forceinline__ void phase_hyena_out(Frame& F, const Args& a, int layer) {
    const float* VT = WSP(float, WS_VT); const bf16_t* P2 = WSP(bf16_t, WS_P2); bf16_t* YC = WSP(bf16_t, WS_Y) + (size_t)2 * T * 1024;
    LAS float* tl = (LAS float*)F.lds;
    for (int u = F.bid; u < (TL / 64) * 4; u += F.G) {
        const int tb = u >> 2, cb = u & 3; const int row0 = TC + tb * 64; const int b = (row0 - TC) >> 13, t0 = (row0 - TC) & (SEQ - 1);
        __syncthreads();
        for (int p = 0; p < 8; ++p) { const int cl = p * 32 + (F.tid >> 4), q = F.tid & 15;
            const f32x4 v = *(const f32x4*)(VT + ((size_t)(cb * 256 + cl) * 2 + b) * SEQ + t0 + 4 * q);
            tl[cl * 65 + 4 * q] = v.x; tl[cl * 65 + 4 * q + 1] = v.y; tl[cl * 65 + 4 * q + 2] = v.z; tl[cl * 65 + 4 * q + 3] = v.w; }
        __syncthreads();
        const int cl = F.tid & 255, th = F.tid >> 8;
        for (int i = 0; i < 32; ++i) { const int tl_ = th * 32 + i; const size_t row = (size_t)(row0 + tl_);
            const float x0 = bf2f(P2[row * P2W + P2_X0 + cb * 256 + cl]);
            YC[row * 1024 + cb * 256 + cl] = (bf16_t)f2bf(tl[cl * 65 + tl_] * x0); }
    }
    const float* VC = WSP(float, WS_VC); const float* FC = WSP(float, WS_FILTC); const float* hyd = arg_in(a, I_HD) + layer * 1024;
    for (int it = F.gw; it < 2 * 16 * 16; it += F.NGW) {
        const int b = it >> 8, cbk = (it >> 4) & 15, tb = it & 15; const int c = cbk * 64 + F.lane, t0 = tb * 16;
        const float* vb = VC + (size_t)b * CTX * 1024 + c; const float* fc = FC + c;
        float acc[16];
#pragma unroll
        for (int i = 0; i < 16; ++i) acc[i] = 0.f;
#pragma unroll 1
        for (int sb = 0; sb < 16; ++sb) { const int s0 = sb * 16, dl = t0 - s0;
            float f[31], v[16];
#pragma unroll
            for (int j = 0; j < 31; ++j) { const int lag = dl + j - 15; f[j] = lag >= 0 ? fc[(size_t)lag * 2048] : fc[(size_t)(-lag) * 2048 + 1024]; }
#pragma unroll
            for (int j = 0; j < 16; ++j) v[j] = vb[(size_t)(s0 + j) * 1024];
#pragma unroll
            for (int i = 0; i < 16; ++i)
#pragma unroll
                for (int j = 0; j < 16; ++j) acc[i] += f[i - j + 15] * v[j]; }
#pragma unroll
        for (int i = 0; i < 16; ++i) { const int t = t0 + i; const size_t row = (size_t)(b * CTX + t);
            const float x0 = bf2f(P2[row * P2W + P2_X0 + c]);
            YC[row * 1024 + c] = (bf16_t)f2bf((acc[i] + vb[(size_t)t * 1024] * hyd[c]) * x0); }
    }
}

__device__ __forceinline__ void phase_ln1(Frame& F, const Args& a, int layer) {
    const float* mod = (const float*)(F.ws + WS_CTL) + CW_MOD + (size_t)layer * 3 * 6 * DM;
    const float* YM = WSP(float, WS_YMIX); float* XS = WSP(float, WS_XS); bf16_t* H2 = WSP(bf16_t, WS_H2); float* AFF = WSP(float, WS_AFF); int* INV = WSP(int, WS_INV);
    const float* g1w = arg_in(a, I_LN1G) + layer * DM; const float* b1w = arg_in(a, I_LN1B) + layer * DM; const float* wr = arg_in(a, I_WROUTER) + (size_t)layer * DM * NEXP;
    LAS float* wrT = (LAS float*)F.lds;
    __syncthreads();
    for (int i = F.tid; i < DM * NEXP; i += NTHREADS) { const int c = i >> 4, e = i & 15; wrT[e * DM + c] = wr[i]; }
    __syncthreads();
    int* PTOK = WSP(int, WS_PTOK); float* PG = WSP(float, WS_PGATE);
    for (int i = F.bid * NTHREADS + F.tid; i < NPAIR; i += F.G * NTHREADS) { PTOK[i] = -1; PG[i] = 0.f; }
    for (int row = F.gw; row < T; row += F.NGW) {
        const f32x4* xr = (const f32x4*)x_src_row(a, F, layer, row) + F.lane; const f32x4* yr = (const f32x4*)(YM + (size_t)row * DM) + F.lane;
        const float* m = mod + (size_t)row_modidx(row) * 6 * DM;
        f32x4 v[8];
#pragma unroll
        for (int j = 0; j < 8; ++j) { const int c = 4 * (64 * j + F.lane); v[j] = xr[64 * j] * ALPHA + *(const f32x4*)(m + 2 * DM + c) * yr[64 * j]; }
        float mean, rstd; row_stats(v, mean, rstd, 1e-6f);
        f32x4* xo = (f32x4*)(XS + (size_t)row * DM) + F.lane;
#pragma unroll
        for (int j = 0; j < 8; ++j) { const int c = 4 * (64 * j + F.lane); v[j] = (v[j] - mean) * rstd * *(const f32x4*)(g1w + c) + *(const f32x4*)(b1w + c); xo[64 * j] = v[j]; }
        row_stats(v, mean, rstd, 1e-6f);
        u32x2* ho = (u32x2*)(H2 + (size_t)row * DM) + F.lane;
        float lg[16];
#pragma unroll
        for (int e = 0; e < 16; ++e) lg[e] = 0.f;
#pragma unroll
        for (int j = 0; j < 8; ++j) { const int c = 4 * (64 * j + F.lane);
            const f32x4 y = (v[j] - mean) * rstd * (*(const f32x4*)(m + 4 * DM + c) + 1.f) + *(const f32x4*)(m + 3 * DM + c);
            u32x2 w; w.x = pk2(y.x, y.y); w.y = pk2(y.z, y.w); ho[64 * j] = w;
#pragma unroll
            for (int e = 0; e < 16; ++e) { const f32x4 ww = *(const LAS f32x4*)(wrT + e * DM + c); lg[e] += (y.x * ww.x + y.y * ww.y) + (y.z * ww.z + y.w * ww.w); } }
        float mx = -1e30f;
#pragma unroll
        for (int e = 0; e < 16; ++e) { lg[e] = wave_sum(lg[e]); mx = fmaxf(mx, lg[e]); }
        float den = 0.f;
#pragma unroll
        for (int e = 0; e < 16; ++e) { lg[e] = __expf(lg[e] - mx); den += lg[e]; }
        float mine = 0.f;
#pragma unroll
        for (int e = 0; e < 16; ++e) mine = (F.lane == e) ? lg[e] : mine;
        if (F.lane < 16) { AFF[(size_t)row * 16 + F.lane] = mine / den; INV[(size_t)row * 16 + F.lane] = -1; }
    }
}
__device__ __forceinline__ void phase_topk(Frame& F) {
    const float* AFF = WSP(float, WS_AFF); int* INV = WSP(int, WS_INV); int* PTOK = WSP(int, WS_PTOK); float* PG = WSP(float, WS_PGATE);
    LAS unsigned* vals = (LAS unsigned*)F.lds; LAS unsigned* hist = vals + 8192; LAS unsigned* ctl = hist + 256;
    for (int u = F.bid; u < 64; u += F.G) {
        const int s = u >> 4, e = u & 15, rs = seg_start(s), n = seg_len(s), cap = s < 2 ? CAP_C : CAP_L;
        __syncthreads();
        for (int i = F.tid; i < n; i += NTHREADS) vals[i] = __builtin_bit_cast(unsigned, AFF[(size_t)(rs + i) * 16 + e]);
        if (F.tid == 0) { ctl[0] = 0u; ctl[1] = (unsigned)cap; ctl[2] = 0u; ctl[3] = 0u; }
        unsigned mask = 0u;
        for (int shift = 24; shift >= 0; shift -= 8) {
            if (F.tid < 256) hist[F.tid] = 0u;
            __syncthreads();
            const unsigned prefix = ctl[0];
            for (int i = F.tid; i < n; i += NTHREADS) { const unsigned b = vals[i]; if ((b & mask) == prefix) __hip_atomic_fetch_add(&hist[(b >> shift) & 255u], 1u, __ATOMIC_RELAXED, __HIP_MEMORY_SCOPE_WORKGROUP); }
            __syncthreads();
            if (F.tid == 0) { unsigned rem = ctl[1], cum = 0u; int dg = 255; for (; dg > 0; --dg) { const unsigned hc = hist[dg]; if (cum + hc >= rem) break; cum += hc; }
                ctl[1] = rem - cum; ctl[0] = prefix | ((unsigned)dg << shift); }
            mask |= 255u << shift;
            __syncthreads();
        }
        const unsigned thr = ctl[0], rem = ctl[1]; const unsigned ngt = (unsigned)cap - rem;
        const int pbase = s < 2 ? NBATCH * NEXP * CAP_L + e * 256 + s * CAP_C : ((s - 2) * NEXP + e) * CAP_L;
        for (int i = F.tid; i < n; i += NTHREADS) { const unsigned b = vals[i]; int slot = -1;
            if (b > thr) slot = (int)__hip_atomic_fetch_add(&ctl[2], 1u, __ATOMIC_RELAXED, __HIP_MEMORY_SCOPE_WORKGROUP);
            else if (b == thr) { const unsigned q = __hip_atomic_fetch_add(&ctl[3], 1u, __ATOMIC_RELAXED, __HIP_MEMORY_SCOPE_WORKGROUP); if (q < rem) slot = (int)(ngt + q); }
            if (slot >= 0) { const int pair = pbase + slot, row = rs + i; PTOK[pair] = row; PG[pair] = __builtin_bit_cast(float, b); INV[(size_t)row * 16 + e] = pair; } }
    }
}
__device__ __forceinline__ void phase_gather(Frame& F) {
    const bf16_t* H2 = WSP(bf16_t, WS_H2); bf16_t* XG = WSP(bf16_t, WS_XG); const int* PTOK = WSP(int, WS_PTOK);
    for (int p = F.gw; p < NPAIR; p += F.NGW) { const int tok = PTOK[p]; u32x4* dst = (u32x4*)(XG + (size_t)p * DM) + F.lane;
        if (tok >= 0) { const u32x4* src = (const u32x4*)(H2 + (size_t)tok * DM) + F.lane;
#pragma unroll
            for (int j = 0; j < 4; ++j) dst[64 * j] = src[64 * j]; }
        else {
#pragma unroll
            for (int j = 0; j < 4; ++j) { unsigned zz = 0u; asm volatile("" : "+v"(zz)); dst[64 * j] = (u32x4){zz, zz, zz, zz}; } } }
}
__device__ __forceinline__ void phase_ln2(Frame& F, const Args& a, int layer) {
    const float* mod = (const float*)(F.ws + WS_CTL) + CW_MOD + (size_t)layer * 3 * 6 * DM;
    float* XS = WSP(float, WS_XS); const bf16_t* YE = WSP(bf16_t, WS_YE); const int* INV = WSP(int, WS_INV);
    const float* g2w = arg_in(a, I_LN2G) + layer * DM; const float* b2w = arg_in(a, I_LN2B) + layer * DM;
    for (int row = F.gw; row < T; row += F.NGW) {
        f32x4* xr = (f32x4*)(XS + (size_t)row * DM) + F.lane; const float* m = mod + (size_t)row_modidx(row) * 6 * DM;
        f32x4 mo[8];
#pragma unroll
        for (int j = 0; j < 8; ++j) mo[j] = (f32x4){0.f, 0.f, 0.f, 0.f};
        for (int e = 0; e < 16; ++e) { const int pair = INV[(size_t)row * 16 + e];
            if (pair >= 0) { const u32x2* yr = (const u32x2*)(YE + (size_t)pair * DM) + F.lane;
#pragma unroll
                for (int j = 0; j < 8; ++j) { const u32x2 w = yr[64 * j]; mo[j] += (f32x4){bflo(w.x), bfhi(w.x), bflo(w.y), bfhi(w.y)}; } } }
        f32x4 v[8];
#pragma unroll
        for (int j = 0; j < 8; ++j) { const int c = 4 * (64 * j + F.lane); v[j] = xr[64 * j] * ALPHA + *(const f32x4*)(m + 5 * DM + c) * mo[j]; }
        float mean, rstd; row_stats(v, mean, rstd, 1e-6f);
#pragma unroll
        for (int j = 0; j < 8; ++j) { const int c = 4 * (64 * j + F.lane); v[j] = (v[j] - mean) * rstd * *(const f32x4*)(g2w + c) + *(const f32x4*)(b2w + c); xr[64 * j] = v[j]; }
        if (layer == DEPTH - 1 && row >= TC) { f32x4* o = (f32x4*)(a.out + (size_t)(row - TC) * DM) + F.lane;
#pragma unroll
            for (int j = 0; j < 8; ++j) o[64 * j] = v[j]; }
    }
}

constexpr int LDS_BYTES = 153600, MISC_OFF = LDS_BYTES - 64;
constexpr int NPL = 16, NPHASE = 1 + DEPTH * NPL;

__global__ void __launch_bounds__(NTHREADS, 2) fwd_kernel(Args args) {
    extern __shared__ __attribute__((aligned(16))) unsigned char lds_raw[];
    Frame F;
    F.lds = (LAS unsigned char*)lds_raw;
    F.tid = threadIdx.x; F.lane = F.tid & 63; F.wave = __builtin_amdgcn_readfirstlane(F.tid >> 6); const int wave0 = F.wave;
    F.G = gridDim.x; F.bid = blockIdx.x; F.gw = F.bid * NWAVES + F.wave; F.NGW = F.G * NWAVES; F.ws = args.ws;
    volatile LAS unsigned* misc = (volatile LAS unsigned*)(F.lds + MISC_OFF);
    if (F.tid < 16) misc[F.tid] = 0u;
    __syncthreads();
    const int lo = args.ph_lo, hi = args.ph_hi;
    XcdBarrier bar; bar.bar = (unsigned*)(F.ws + WS_CTL) + CW_BAR; bar.x = 0; bar.st = nullptr;
    const bool multi = (hi - lo) > 1;
    if (multi) bar = xcd_barrier_post((unsigned*)(F.ws + WS_CTL) + CW_BAR, misc);
#ifndef ONLY_PHASE
#define ONLY_PHASE -1
#endif
#define PON(r) (ONLY_PHASE < 0 || ONLY_PHASE == (r))
#ifndef REP_MASK
#define REP_MASK 0
#endif
#define REP(b) ((REP_MASK >> (b)) & 1)
#define REOPQ() do { F.ws = opq(args.ws); F.lane = lane_asm() & 63; F.wave = opqs(wave0) & 7; F.tid = F.wave * 64 + F.lane; F.G = opqs(gridDim.x); F.bid = opqs(blockIdx.x); F.gw = F.bid * NWAVES + F.wave; F.NGW = F.G * NWAVES; } while (0)
#define IN(k) (lo <= (k) && (k) < hi)
#define SEAM(k) do { if (IN(k) && IN((k) + 1)) { XcdBarrier bb_ = bar; bb_.x = (unsigned)opqs((int)bar.x); xcd_barrier(bb_); } } while (0)
    if (PON(100) && IN(0)) { F.ws = opq(args.ws); F.lane = lane_asm() & 63; F.wave = opqs(wave0) & 7; F.tid = F.wave * 64 + F.lane; F.G = opqs(gridDim.x); F.bid = opqs(blockIdx.x); F.gw = F.bid * NWAVES + F.wave; F.NGW = F.G * NWAVES; { p0_weights(F, args); REOPQ(); p0_mod(F, args); __syncthreads(); } }
    SEAM(0);
#pragma unroll 1
    for (int layer = 0; layer < DEPTH; ++layer) {
        const int pb = 1 + layer * NPL;
        if (PON(0) && IN(pb + 0)) { F.ws = opq(args.ws); F.lane = lane_asm() & 63; F.wave = opqs(wave0) & 7; F.tid = F.wave * 64 + F.lane; F.G = opqs(gridDim.x); F.bid = opqs(blockIdx.x); F.gw = F.bid * NWAVES + F.wave; F.NGW = F.G * NWAVES; phase_modln(F, args, layer); REOPQ(); phase_hdn(F, args, layer); __syncthreads(); if (REP(1)) { phase_modln(F, args, layer); REOPQ(); phase_hdn(F, args, layer); __syncthreads(); } }
        SEAM(pb + 0);
        if (PON(1) && IN(pb + 1)) { F.ws = opq(args.ws); F.lane = lane_asm() & 63; F.wave = opqs(wave0) & 7; F.tid = F.wave * 64 + F.lane; F.G = opqs(gridDim.x); F.bid = opqs(blockIdx.x); F.gw = F.bid * NWAVES + F.wave; F.NGW = F.G * NWAVES;
            pg8::Gemm g{WSP(bf16_t, WS_H), WSP(bf16_t, WS_WIN + layer * SZ_WIN), DM, DM, DM}; pg8::StaticOrder S; S.init(66, NNG / 256, F.G, F.bid);
            EpiBf16 E{WSP(bf16_t, WS_P), NNG, nullptr, 0, 0, 1.f};
            pg8::gemm_phase(F.lds, g, S, E, F.tid);
        }
        SEAM(pb + 1);
        if (PON(2) && IN(pb + 2)) { F.ws = opq(args.ws); F.lane = lane_asm() & 63; F.wave = opqs(wave0) & 7; F.tid = F.wave * 64 + F.lane; F.G = opqs(gridDim.x); F.bid = opqs(blockIdx.x); F.gw = F.bid * NWAVES + F.wave; F.NGW = F.G * NWAVES; { phase_prep(F, args, layer); REOPQ(); phase_filt(F, args, layer); __syncthreads(); } }
        SEAM(pb + 2);
        if (PON(3) && IN(pb + 3)) { F.ws = opq(args.ws); F.lane = lane_asm() & 63; F.wave = opqs(wave0) & 7; F.tid = F.wave * 64 + F.lane; F.G = opqs(gridDim.x); F.bid = opqs(blockIdx.x); F.gw = F.bid * NWAVES + F.wave; F.NGW = F.G * NWAVES;
#if !defined(T3) || T3 == 0
            { pg8::Gemm g{WSP(bf16_t, WS_P) + P_CQ, WSP(bf16_t, WS_WQ + layer * SZ_WQ), NNG, 512, 512}; pg8::StaticOrder S; S.init(66, 6, F.G, F.bid);
              EpiBf16 E{WSP(bf16_t, WS_Q), 1536, WSP(float, WS_RS), 2, 0, 1.f}; pg8::gemm_phase(F.lds, g, S, E, F.tid); }
#endif
#if !defined(T3) || T3 == 1
            { pg8::Gemm g{WSP(bf16_t, WS_P) + P_CKV, WSP(bf16_t, WS_WKV + layer * SZ_WKV), NNG, 512, 512}; pg8::StaticOrder S; S.init(66, 8, F.G, F.bid);
              EpiBf16 E{WSP(bf16_t, WS_KV), 2048, WSP(float, WS_RS) + 1, 2, 0, 1.f}; pg8::gemm_phase(F.lds, g, S, E, F.tid); }
#endif
#if !defined(T3) || T3 == 2
            { pg8::Gemm g{WSP(bf16_t, WS_ALORA), WSP(bf16_t, WS_WLORA + layer * SZ_WLORA), 512, 512, 512}; pg8::StaticOrder S; S.init(66, 20, F.G, F.bid);
              EpiLora E{WSP(bf16_t, WS_EW), WSP(bf16_t, WS_ICLR), WSP(bf16_t, WS_GG), arg_in(args, I_RW0) + layer * 2048, arg_in(args, I_RA0) + layer * 2048}; pg8::gemm_phase(F.lds, g, S, E, F.tid); }
#endif
        }
        SEAM(pb + 3);
        if (PON(4) && IN(pb + 4)) { F.ws = opq(args.ws); F.lane = lane_asm() & 63; F.wave = opqs(wave0) & 7; F.tid = F.wave * 64 + F.lane; F.G = opqs(gridDim.x); F.bid = opqs(blockIdx.x); F.gw = F.bid * NWAVES + F.wave; F.NGW = F.G * NWAVES; phase_qrope(F); REOPQ(); phase_mamba_states(F, args, layer); __syncthreads(); if (REP(5)) { REOPQ(); phase_mamba_states(F, args, layer); __syncthreads(); } }
        SEAM(pb + 4);
        if (PON(5) && IN(pb + 5)) { F.ws = opq(args.ws); F.lane = lane_asm() & 63; F.wave = opqs(wave0) & 7; F.tid = F.wave * 64 + F.lane; F.G = opqs(gridDim.x); F.bid = opqs(blockIdx.x); F.gw = F.bid * NWAVES + F.wave; F.NGW = F.G * NWAVES;
#if !defined(T5) || T5 == 0
            phase_rwkv_scan(F, args, layer); __syncthreads();
            if (REP(6)) { phase_rwkv_scan(F, args, layer); __syncthreads(); }
#endif
#if !defined(T5) || T5 == 1
            REOPQ(); phase_attn(F);
#endif
#if !defined(T5) || T5 == 2
            if (REP(18)) { REOPQ(); phase_hyena_fft(F, args, layer, opqs(1) != 0); }
            REOPQ(); phase_hyena_fft(F, args, layer);
#endif
#if !defined(T5) || T5 == 3
            REOPQ(); phase_mamba_scan(F); __syncthreads();
#endif
        }
        SEAM(pb + 5);
        if (PON(6) && IN(pb + 6)) { F.ws = opq(args.ws); F.lane = lane_asm() & 63; F.wave = opqs(wave0) & 7; F.tid = F.wave * 64 + F.lane; F.G = opqs(gridDim.x); F.bid = opqs(blockIdx.x); F.gw = F.bid * NWAVES + F.wave; F.NGW = F.G * NWAVES;
#if !defined(T6) || T6 == 0
            phase_mamba_out(F, args, layer); __syncthreads();
            if (REP(8)) { phase_mamba_out(F, args, layer); __syncthreads(); }
#endif
#if !defined(T6) || T6 == 1
            REOPQ(); phase_hyena_out(F, args, layer);
#endif
#if !defined(T6) || T6 == 2
            REOPQ(); phase_rwkv_out(F, args, layer); __syncthreads();
            if (REP(9)) { REOPQ(); phase_hyena_out(F, args, layer); __syncthreads(); } if (REP(19)) { REOPQ(); phase_rwkv_out(F, args, layer); __syncthreads(); }
#endif
        }
        SEAM(pb + 6);
        if (PON(7) && IN(pb + 7)) { F.ws = opq(args.ws); F.lane = lane_asm() & 63; F.wave = opqs(wave0) & 7; F.tid = F.wave * 64 + F.lane; F.G = opqs(gridDim.x); F.bid = opqs(blockIdx.x); F.gw = F.bid * NWAVES + F.wave; F.NGW = F.G * NWAVES;
            pg8::Gemm g{WSP(bf16_t, WS_H8), WSP(bf16_t, WS_WIN + layer * SZ_WIN) + (size_t)NNG * DM, DM / 2, DM / 2, DM / 2}; pg8::StaticOrder S; S.init(66, NGATE / 256, F.G, F.bid);
            EpiBf16 E{WSP(bf16_t, WS_GATES), NGATE, nullptr, 0, 0, 1.f / 64.f};
            pg8::gemm_phase<EpiBf16, pg8::StaticOrder, true>(F.lds, g, S, E, F.tid);
            REOPQ(); phase_mamba_norm(F, args, layer);
        }
        SEAM(pb + 7);
        if (PON(8) && IN(pb + 8)) { F.ws = opq(args.ws); F.lane = lane_asm() & 63; F.wave = opqs(wave0) & 7; F.tid = F.wave * 64 + F.lane; F.G = opqs(gridDim.x); F.bid = opqs(blockIdx.x); F.gw = F.bid * NWAVES + F.wave; F.NGW = F.G * NWAVES;
            pg8::Gemm g{WSP(bf16_t, WS_Y), WSP(bf16_t, WS_WBR + layer * SZ_WBR), 1024, 1024, 1024}; OrderMerge S; S.init(F.G, F.bid);
            EpiMerge E{WSP(bf16_t, WS_GATES), WSP(float, WS_MRGF), WSP(bf16_t, WS_MRGB)};
            pg8::gemm_phase(F.lds, g, S, E, F.tid);

        }
        SEAM(pb + 8);
        if (PON(9) && IN(pb + 9)) { F.ws = opq(args.ws); F.lane = lane_asm() & 63; F.wave = opqs(wave0) & 7; F.tid = F.wave * 64 + F.lane; F.G = opqs(gridDim.x); F.bid = opqs(blockIdx.x); F.gw = F.bid * NWAVES + F.wave; F.NGW = F.G * NWAVES;
            pg8::Gemm g{WSP(bf16_t, WS_MRGB), WSP(bf16_t, WS_WOUT + layer * SZ_WOUT), DM, DM, DM}; pg8::StaticOrder S; S.init(66, 8, F.G, F.bid);
            EpiF32 E{WSP(float, WS_YMIX), DM};
            pg8::gemm_phase(F.lds, g, S, E, F.tid);

        }
        SEAM(pb + 9);
        if (PON(10) && IN(pb + 10)) { F.ws = opq(args.ws); F.lane = lane_asm() & 63; F.wave = opqs(wave0) & 7; F.tid = F.wave * 64 + F.lane; F.G = opqs(gridDim.x); F.bid = opqs(blockIdx.x); F.gw = F.bid * NWAVES + F.wave; F.NGW = F.G * NWAVES; phase_ln1(F, args, layer); __syncthreads(); { REOPQ(); conv_experts(F, args, layer); __syncthreads(); } }
        SEAM(pb + 10);
        if (PON(11) && IN(pb + 11)) { F.ws = opq(args.ws); F.lane = lane_asm() & 63; F.wave = opqs(wave0) & 7; F.tid = F.wave * 64 + F.lane; F.G = opqs(gridDim.x); F.bid = opqs(blockIdx.x); F.gw = F.bid * NWAVES + F.wave; F.NGW = F.G * NWAVES; phase_topk(F); __syncthreads(); if (REP(14)) { phase_topk(F); __syncthreads(); } }
        SEAM(pb + 11);
        if (PON(12) && IN(pb + 12)) { F.ws = opq(args.ws); F.lane = lane_asm() & 63; F.wave = opqs(wave0) & 7; F.tid = F.wave * 64 + F.lane; F.G = opqs(gridDim.x); F.bid = opqs(blockIdx.x); F.gw = F.bid * NWAVES + F.wave; F.NGW = F.G * NWAVES; phase_gather(F); if (REP(15)) phase_gather(F); }
        SEAM(pb + 12);
        if (PON(13) && IN(pb + 13)) { F.ws = opq(args.ws); F.lane = lane_asm() & 63; F.wave = opqs(wave0) & 7; F.tid = F.wave * 64 + F.lane; F.G = opqs(gridDim.x); F.bid = opqs(blockIdx.x); F.gw = F.bid * NWAVES + F.wave; F.NGW = F.G * NWAVES;
            pg8::Gemm g{WSP(bf16_t, WS_XG), WSP(bf16_t, WS_WE), DM, DM, DM}; OrderMoe S; S.init(11, F.G, F.bid);
            EpiSwiglu E{WSP(bf16_t, WS_HID)};
            pg8::gemm_phase(F.lds, g, S, E, F.tid);

        }
        SEAM(pb + 13);
        if (PON(14) && IN(pb + 14)) { F.ws = opq(args.ws); F.lane = lane_asm() & 63; F.wave = opqs(wave0) & 7; F.tid = F.wave * 64 + F.lane; F.G = opqs(gridDim.x); F.bid = opqs(blockIdx.x); F.gw = F.bid * NWAVES + F.wave; F.NGW = F.G * NWAVES;
            pg8::Gemm g{WSP(bf16_t, WS_HID), WSP(bf16_t, WS_WE + SZ_WGU), EFF, EFF, EFF}; OrderMoe S; S.init(8, F.G, F.bid);
            EpiDown E{WSP(bf16_t, WS_YE), WSP(float, WS_PGATE)};
            pg8::gemm_phase(F.lds, g, S, E, F.tid);

        }
        SEAM(pb + 14);
        if (PON(15) && IN(pb + 15)) { F.ws = opq(args.ws); F.lane = lane_asm() & 63; F.wave = opqs(wave0) & 7; F.tid = F.wave * 64 + F.lane; F.G = opqs(gridDim.x); F.bid = opqs(blockIdx.x); F.gw = F.bid * NWAVES + F.wave; F.NGW = F.G * NWAVES; phase_ln2(F, args, layer); }
        SEAM(pb + 15);
    }
#undef IN
#undef SEAM
}


#ifdef DBG_CUT
__global__ void dbg_dump(const unsigned char* ws, float* out, size_t off, int is_bf16, size_t n_src) {
    const size_t N = (size_t)TL * DM;
    for (size_t i = (size_t)blockIdx.x * blockDim.x + threadIdx.x; i < N; i += (size_t)gridDim.x * blockDim.x) {
        const size_t j = i % n_src;
        out[i] = is_bf16 ? bf2f(((const bf16_t*)(ws + off))[j]) : ((const float*)(ws + off))[j];
    }
}
#endif

#ifdef DBG_PASSES
__global__ void dbg_chk(const unsigned char* base, size_t off, size_t nbytes, unsigned long long* slot) {
    const unsigned* p = (const unsigned*)(base + off); const size_t n = nbytes / 4; unsigned long long s = 0;
    for (size_t i = (size_t)blockIdx.x * blockDim.x + threadIdx.x; i < n; i += (size_t)gridDim.x * blockDim.x) s += p[i];
    for (int o = 32; o > 0; o >>= 1) s += __shfl_xor(s, o);
    if ((threadIdx.x & 63) == 0) atomicAdd(slot, s);
}
__global__ void dbg_report(const unsigned long long* tab, float* out, int npass) {
    int k = 0;
    for (int ph = NPHASE - 1; ph >= 0; --ph) if (tab[ph] != tab[64 + ph]) k = ph + 1;
    if (k == 0 && npass > 2) { for (int ph = NPHASE - 1; ph >= 0; --ph) if (tab[64 + ph] != tab[128 + ph]) k = 50 + ph + 1; }
    if (k == 0) return;
    const float c = sqrtf(10.f * (float)k);
    for (size_t i = (size_t)blockIdx.x * blockDim.x + threadIdx.x; i < (size_t)TL * DM; i += (size_t)gridDim.x * blockDim.x) out[i] = c;
}
struct DbgReg { size_t off, n; };
#endif
extern "C" void kernel_launch(void* const* d_in, const int* in_sizes, int n_in, void* d_out, int out_size, void* d_ws, size_t ws_size, hipStream_t stream) {
    static int grid = 0;
    if (grid == 0) {
        if (n_in != N_INPUTS || in_sizes[0] != TL * DM || out_size != TL * DM || ws_size < WS_END) {
            fprintf(stderr, "kernel_launch: shape/workspace mismatch: n_in %d in0 %d out %d ws %zu (need %zu)\n", n_in, n_in > 0 ? in_sizes[0] : -1, out_size, ws_size, (size_t)WS_END); grid = -1; return; }
        int dev = 0, cus = 0, per_cu = 0;
        if (hipGetDevice(&dev) != hipSuccess || hipDeviceGetAttribute(&cus, hipDeviceAttributeMultiprocessorCount, dev) != hipSuccess) { grid = -1; return; }
        if (hipFuncSetAttribute((const void*)fwd_kernel, hipFuncAttributeMaxDynamicSharedMemorySize, LDS_BYTES) != hipSuccess) { fprintf(stderr, "kernel_launch: hipFuncSetAttribute failed\n"); grid = -1; return; }
        if (hipOccupancyMaxActiveBlocksPerMultiprocessor(&per_cu, (const void*)fwd_kernel, NTHREADS, LDS_BYTES) != hipSuccess || per_cu < 1) { fprintf(stderr, "kernel_launch: occupancy query says %d\n", per_cu); grid = -1; (void)hipGetLastError(); return; }
        grid = cus;
    }
    if (grid < 0) return;
    (void)hipMemsetAsync((char*)d_ws + WS_CTL, 0, CTL_BYTES, stream);
    Args a{};
    for (int i = 0; i < N_INPUTS; ++i) a.in[i] = (const float*)d_in[i];
    a.out = (float*)d_out; a.ws = (unsigned char*)d_ws;
#if MK_ONE_LAUNCH
    a.ph_lo = 0; a.ph_hi = NPHASE;
    hipLaunchKernelGGL(fwd_kernel, dim3(grid), dim3(NTHREADS), LDS_BYTES, stream, a);
#else
#ifdef DBG_PASSES
    {
        unsigned long long* tab = (unsigned long long*)((char*)d_ws + 1600000);
        auto chk = [&](int pass, int ph, size_t off, size_t n) { hipLaunchKernelGGL(dbg_chk, dim3(1024), dim3(256), 0, stream, (const unsigned char*)d_ws, off, n, tab + pass * 64 + ph); };
        for (int pass = 0; pass < DBG_PASSES; ++pass) {
            if (pass > 0) (void)hipMemsetAsync((char*)d_ws + (size_t)CW_MOD * 4, 0, (size_t)DEPTH * 3 * 6 * DM * 4, stream);
            for (int ph = 0; ph < NPHASE; ++ph) {
                a.ph_lo = ph; a.ph_hi = ph + 1; hipLaunchKernelGGL(fwd_kernel, dim3(grid), dim3(NTHREADS), LDS_BYTES, stream, a);
                if (ph == 0) { chk(pass, ph, WS_WIN, WS_XS - WS_WIN); chk(pass, ph, (size_t)CW_MOD * 4, (size_t)DEPTH * 3 * 6 * DM * 4); continue; }
                const int r = (ph - 1) % NPL;
                switch (r) {
                case 0: chk(pass, ph, WS_H, SZ_H); chk(pass, ph, WS_HDN, SZ_HDN); break;
                case 1: chk(pass, ph, WS_P, SZ_P); break;
                case 2: chk(pass, ph, WS_P2, SZ_P2); chk(pass, ph, WS_KK, SZ_TK2); chk(pass, ph, WS_ALORA, WS_VT - WS_ALORA); chk(pass, ph, WS_VT, WS_HDN - WS_VT); break;
                case 3: chk(pass, ph, WS_Q, SZ_Q + SZ_KV); chk(pass, ph, WS_EW, 4 * SZ_TK2); chk(pass, ph, WS_GG, SZ_TK2); break;
                case 4: chk(pass, ph, WS_Q, SZ_Q); chk(pass, ph, WS_MST, SZ_MST + SZ_MCS); break;
                case 5: chk(pass, ph, WS_YRW, 2 * SZ_TK2); chk(pass, ph, WS_Y, SZ_Y / 4); chk(pass, ph, WS_VT, SZ_VT); chk(pass, ph, WS_MST, SZ_MST); break;
                case 6: chk(pass, ph, WS_Y + SZ_Y / 4, 3 * (SZ_Y / 4)); break;
                case 7: chk(pass, ph, WS_GATES, SZ_GATES); chk(pass, ph, WS_Y + SZ_Y / 4, SZ_Y / 4); break;
                case 8: chk(pass, ph, WS_MRGF, SZ_MRGF); chk(pass, ph, WS_MRGB, SZ_MRGB); break;
                case 9: chk(pass, ph, WS_YMIX, SZ_YMIX); break;
                case 10: chk(pass, ph, WS_XS, SZ_XS); chk(pass, ph, WS_H2, SZ_H); chk(pass, ph, WS_AFF, SZ_AFF); chk(pass, ph, WS_WE, SZ_WGU + SZ_WD); break;
                case 11: chk(pass, ph, WS_INV, SZ_INV + SZ_PTOK + SZ_PGATE); break;
                case 12: chk(pass, ph, WS_XG, SZ_XG); break;
                case 13: chk(pass, ph, WS_HID, SZ_HID); break;
                case 14: chk(pass, ph, WS_YE, SZ_YE); break;
                case 15: chk(pass, ph, WS_XS, SZ_XS); break;
                }
            }
        }
        hipLaunchKernelGGL(dbg_report, dim3(2048), dim3(256), 0, stream, (const unsigned long long*)tab, (float*)d_out, (int)DBG_PASSES);
    }
#elif defined(DBG_CUT)
    for (int ph = 0; ph < DBG_CUT; ++ph) { a.ph_lo = ph; a.ph_hi = ph + 1; hipLaunchKernelGGL(fwd_kernel, dim3(grid), dim3(NTHREADS), LDS_BYTES, stream, a); }
    hipLaunchKernelGGL(dbg_dump, dim3(2048), dim3(256), 0, stream, (const unsigned char*)d_ws, (float*)d_out, (size_t)DBG_OFF, DBG_BF16, (size_t)DBG_N);
#else
    for (int ph = 0; ph < NPHASE; ++ph) { a.ph_lo = ph; a.ph_hi = ph + 1; hipLaunchKernelGGL(fwd_kernel, dim3(grid), dim3(NTHREADS), LDS_BYTES, stream, a); }
#endif
#endif
}
```

```cpp
#include <hip/hip_runtime.h>
#include <cstdio>
#include <cstdint>

#define REP_MASK 0x80000
#ifndef MK_ONE_LAUNCH
#define MK_ONE_LAUNCH 1
#endif

#define LAS __attribute__((address_space(3)))
typedef unsigned short bf16_t;
typedef short bf16x8 __attribute__((ext_vector_type(8)));
typedef float f32x4 __attribute__((ext_vector_type(4)));
typedef float f32x2 __attribute__((ext_vector_type(2)));
typedef unsigned u32x4 __attribute__((ext_vector_type(4)));
typedef unsigned u32x2 __attribute__((ext_vector_type(2)));

constexpr int DM = 2048, NBATCH = 2, SEQ = 8192, CTX = 256, DEPTH = 2;
constexpr int TC = NBATCH * CTX, TL = NBATCH * SEQ, T = TC + TL;
constexpr int NIN = 18432, NNG = 10240, NGATE = 8192;
constexpr int P_CQ = 0, P_CKV = 512, P_KPE = 1024;
constexpr int P_Z = 1088, P_XBC = 2112, P_DT = 3648;
constexpr int P_HY = 3680;
constexpr int P_RW = 6752, P_WD = 9824, P_AD = 9952, P_GD = 10080;
constexpr int NH_MLA = 8, NH_SSM = 16, NH_RW = 16;
constexpr int NEXP = 16, EFF = 1408, CAP_L = 1024, CAP_C = 32;
constexpr int NPAIR = NBATCH * NEXP * CAP_L + NEXP * 256;
constexpr float ALPHA = 1.4142135623730951f;
constexpr int NWAVES = 8, NTHREADS = 512;

__device__ __forceinline__ int seg_of(int row) { return row < 256 ? 0 : row < 512 ? 1 : row < 512 + SEQ ? 2 : 3; }
__device__ __forceinline__ int seg_start(int s) { return s == 0 ? 0 : s == 1 ? 256 : s == 2 ? 512 : 512 + SEQ; }
__device__ __forceinline__ int seg_len(int s) { return s < 2 ? CTX : SEQ; }
__device__ __forceinline__ bool row_first(int row) { return row == 0 || row == 256 || row == 512 || row == 512 + SEQ; }
__device__ __forceinline__ bool row_last(int row) { return row == 255 || row == 511 || row == 511 + SEQ || row == T - 1; }
__device__ __forceinline__ int row_modidx(int row) { return row < 512 ? 2 : (row < 512 + SEQ ? 0 : 1); }

constexpr size_t AL(size_t x) { return (x + 255) / 256 * 256; }
constexpr size_t WS_CTL = 0, CTL_BYTES = 2u << 20;
constexpr int CW_BAR = 1024;
constexpr int CW_MOD = 16384;
constexpr size_t SZ_WIN = (size_t)NIN * DM * 2, SZ_WBR = (size_t)4 * DM * 1024 * 2, SZ_WOUT = (size_t)DM * DM * 2, SZ_WQ = (size_t)1536 * 512 * 2,
                 SZ_WKV = (size_t)2048 * 512 * 2, SZ_WLORA = (size_t)5120 * 512 * 2;
constexpr size_t WS_WIN = CTL_BYTES, WS_WBR = WS_WIN + DEPTH * SZ_WIN, WS_WOUT = WS_WBR + DEPTH * SZ_WBR, WS_WQ = WS_WOUT + DEPTH * SZ_WOUT,
                 WS_WKV = WS_WQ + DEPTH * SZ_WQ, WS_WLORA = WS_WKV + DEPTH * SZ_WKV, WS_XS = WS_WLORA + DEPTH * SZ_WLORA;
constexpr size_t SZ_XS = (size_t)T * DM * 4;
constexpr size_t WS_H = WS_XS + SZ_XS, SZ_H = (size_t)T * DM * 2;
constexpr size_t WS_P = WS_H + SZ_H, SZ_P = (size_t)T * NNG * 2;
constexpr int P2W = 5632, P2_XBC = 0, P2_X0 = 1536, P2_RKV = 2560;
constexpr size_t WS_P2 = WS_P + SZ_P, SZ_P2 = (size_t)T * P2W * 2;
constexpr size_t WS_Q = WS_P2 + SZ_P2, SZ_Q = (size_t)T * 1536 * 2;
constexpr size_t WS_KV = WS_Q + SZ_Q, SZ_KV = (size_t)T * 2048 * 2;
constexpr size_t WS_EW = WS_KV + SZ_KV, SZ_TK2 = (size_t)T * 1024 * 2;
constexpr size_t WS_ICLR = WS_EW + 2 * SZ_TK2;
constexpr size_t WS_KK = WS_ICLR + 2 * SZ_TK2;
constexpr size_t WS_GG = WS_KK + SZ_TK2;
constexpr size_t WS_YRW = WS_GG + SZ_TK2;
constexpr size_t WS_ALORA = WS_YRW + 2 * SZ_TK2, SZ_ALORA = (size_t)T * 512 * 2;
constexpr size_t WS_KPE = WS_ALORA + SZ_ALORA, SZ_KPE = (size_t)T * 64 * 2;
constexpr size_t WS_RS = WS_KPE + SZ_KPE, SZ_RS = AL((size_t)T * 2 * 4);
constexpr size_t WS_DT = WS_RS + SZ_RS, SZ_DT = (size_t)T * 32 * 4;
constexpr size_t WS_VT = WS_DT + SZ_DT, SZ_VT = (size_t)1024 * 2 * SEQ * 4;
constexpr size_t WS_VC = WS_VT + SZ_VT, SZ_VC = (size_t)TC * 1024 * 4;
constexpr size_t WS_FILT = WS_VC + SZ_VC, SZ_FILT = (size_t)1024 * 2 * SEQ * 2;
constexpr size_t WS_FILTC = WS_FILT + SZ_FILT, SZ_FILTC = (size_t)CTX * 2048 * 4;
constexpr size_t WS_HDN = WS_FILTC + SZ_FILTC, SZ_HDN = (size_t)(SEQ + CTX) * 64 * 4;
constexpr int NCHUNK = T / 128;
constexpr size_t WS_MST = WS_HDN + SZ_HDN, SZ_MST = (size_t)2 * NCHUNK * 16 * 8192 * 2;
constexpr size_t WS_MCS = WS_MST + SZ_MST, SZ_MCS = (size_t)2 * NCHUNK * 16 * 4 * 2;
constexpr size_t WS_Y = WS_MCS + AL(SZ_MCS), SZ_Y = (size_t)4 * T * 1024 * 2;
constexpr size_t WS_AFF = WS_Y + SZ_Y, SZ_AFF = (size_t)T * 16 * 4;
constexpr size_t WS_INV = WS_AFF + SZ_AFF, SZ_INV = (size_t)T * 16 * 4;
constexpr size_t WS_PTOK = WS_INV + SZ_INV, SZ_PTOK = (size_t)NPAIR * 4;
constexpr size_t WS_PGATE = WS_PTOK + SZ_PTOK, SZ_PGATE = (size_t)NPAIR * 4;
constexpr size_t WS_H8 = WS_PGATE + SZ_PGATE, SZ_H8 = (size_t)T * DM;
constexpr size_t WS_END = WS_H8 + SZ_H8;
constexpr size_t WS_GATES = WS_P, SZ_GATES = (size_t)T * NGATE * 2;
constexpr size_t WS_MRGF = WS_P2, SZ_MRGF = (size_t)T * DM * 4;
constexpr size_t WS_MRGB = WS_Q, SZ_MRGB = (size_t)T * DM * 2;
constexpr size_t WS_YMIX = WS_P, SZ_YMIX = (size_t)T * DM * 4;
constexpr size_t WS_H2 = WS_H;
constexpr size_t WS_WE = WS_P2, SZ_WGU = (size_t)NEXP * 2816 * DM * 2, SZ_WD = (size_t)NEXP * DM * EFF * 2;
constexpr size_t WS_XG = WS_P, SZ_XG = (size_t)NPAIR * DM * 2;
constexpr size_t WS_HID = WS_XG + SZ_XG, SZ_HID = (size_t)NPAIR * EFF * 2;
constexpr size_t WS_YE = WS_WE + SZ_WGU + SZ_WD, SZ_YE = (size_t)NPAIR * DM * 2;
static_assert(SZ_GATES <= SZ_P && SZ_MRGF <= SZ_P2 && SZ_MRGB <= SZ_Q + SZ_KV && SZ_YMIX <= SZ_P, "alias map 1");
static_assert(SZ_XG + SZ_HID <= SZ_P, "alias map 2");
static_assert(WS_YE + SZ_YE <= WS_VT, "alias map 3");
static_assert(WS_END < 1800000000ull, "workspace budget");

__device__ __forceinline__ unsigned f2bf(float f) { unsigned u = __builtin_bit_cast(unsigned, f); return (u + 0x7fffu + ((u >> 16) & 1u)) >> 16; }
__device__ __forceinline__ unsigned pk2(float lo, float hi) { return f2bf(lo) | (f2bf(hi) << 16); }
__device__ __forceinline__ float bf2f(unsigned short b) { return __builtin_bit_cast(float, (unsigned)b << 16); }
__device__ __forceinline__ float bflo(unsigned w) { return __builtin_bit_cast(float, w << 16); }
__device__ __forceinline__ float bfhi(unsigned w) { return __builtin_bit_cast(float, w & 0xffff0000u); }
__device__ __forceinline__ unsigned cvt_pk_bf16(float lo, float hi) { unsigned r; asm volatile("v_cvt_pk_bf16_f32 %0, %1, %2" : "=v"(r) : "v"(lo), "v"(hi)); return r; }
__device__ __forceinline__ float dppx(float x, const int sel) {
    const int xi = __builtin_bit_cast(int, x); int r;
    if (sel == 0) r = __builtin_amdgcn_update_dpp(0, xi, 0xB1, 0xF, 0xF, false);
    else if (sel == 1) r = __builtin_amdgcn_update_dpp(0, xi, 0x4E, 0xF, 0xF, false);
    else if (sel == 2) r = __builtin_amdgcn_update_dpp(0, xi, 0x141, 0xF, 0xF, false);
    else r = __builtin_amdgcn_update_dpp(0, xi, 0x140, 0xF, 0xF, false);
    return __builtin_bit_cast(float, r);
}
__device__ __forceinline__ float swz16(float x) { return __builtin_bit_cast(float, __builtin_amdgcn_ds_swizzle(__builtin_bit_cast(int, x), 0x401F)); }
__device__ __forceinline__ float sum4(float v) { v += dppx(v, 0); v += dppx(v, 1); return v; }
__device__ __forceinline__ float sum8(float v) { v = sum4(v); v += dppx(v, 2); return v; }
__device__ __forceinline__ float sum16(float v) { v = sum8(v); v += dppx(v, 3); return v; }
__device__ __forceinline__ float sum32(float v) { v = sum16(v); v += swz16(v); return v; }
__device__ __forceinline__ unsigned pk4fp8(float a, float b, float c, float d) { int w = 0; w = __builtin_amdgcn_cvt_pk_fp8_f32(a, b, w, false); w = __builtin_amdgcn_cvt_pk_fp8_f32(c, d, w, true); return (unsigned)w; }
__device__ __forceinline__ float wave_sum(float v) {
    v = sum32(v);
    auto rr = __builtin_amdgcn_permlane32_swap(__float_as_uint(v), __float_as_uint(v), false, false);
    return __uint_as_float(rr[0]) + __uint_as_float(rr[1]);
}
__device__ __forceinline__ float sigmoidf_(float x) { return 1.f / (1.f + __expf(-x)); }
__device__ __forceinline__ float siluf_(float x) { return x / (1.f + __expf(-x)); }
__device__ __forceinline__ float softplusf_(float x) { return x > 20.f ? x : __logf(1.f + __expf(x)); }
__device__ __forceinline__ float tanhf_(float x) { const float e = __expf(2.f * fminf(x, 15.f)); return 1.f - 2.f / (e + 1.f); }
#define LDS_WAIT() asm volatile("s_waitcnt lgkmcnt(0)" ::: "memory")
#define VM_WAIT() asm volatile("s_waitcnt vmcnt(0)" ::: "memory")

#define XB_TMO      128
#define XB_XCNT(j)  (256  + 64 * (j))
#define XB_XSUB(j)  (1280 + 64 * (j))
#define XB_XGEN(j)  (2304 + 64 * (j))
#define XB_TOP      3328
#define XB_TOPGEN   3392
#define XCD_BAR_WORDS 3456
#define XB_SPIN_CAP (1u << 18)
__device__ __forceinline__ unsigned xb_ld(unsigned* p)              { return __hip_atomic_load(p, __ATOMIC_RELAXED, __HIP_MEMORY_SCOPE_AGENT); }
__device__ __forceinline__ unsigned xb_add(unsigned* p, unsigned v) { return __hip_atomic_fetch_add(p, v, __ATOMIC_RELAXED, __HIP_MEMORY_SCOPE_AGENT); }
__device__ __forceinline__ unsigned xb_xcc_id() { return (unsigned)__builtin_amdgcn_s_getreg((3 << 11) | 20) & 0xFu; }
#define XB_SPIN(cond, bar) do { unsigned _sp = 0; while (cond) { __builtin_amdgcn_s_sleep(1); \
    if ((++_sp & 255u) == 0u) { if (xb_ld(&(bar)[XB_TMO])) break; if (_sp > XB_SPIN_CAP) { atomicAdd(&(bar)[XB_TMO], 1u); break; } } } } while (0)
struct XcdBarrier { unsigned* bar; unsigned x; volatile LAS unsigned* st; };
__device__ __forceinline__ XcdBarrier xcd_barrier_post(unsigned* bar, volatile LAS unsigned* st) {
    XcdBarrier b; b.bar = bar; b.x = xb_xcc_id(); b.st = st;
    if (threadIdx.x == 0) (void)xb_add(&bar[XB_XCNT(b.x)], 1u);
    return b;
}
__device__ __forceinline__ void xcd_barrier_complete(unsigned* bar, unsigned x, unsigned& nloc, unsigned& nx) {
    const unsigned G = gridDim.x * gridDim.y * gridDim.z;
    unsigned sum, cnt, mine, sp = 0u;
    for (;;) {
        sum = 0u; cnt = 0u; mine = 0u;
#pragma unroll
        for (unsigned j = 0; j < 16; ++j) { const unsigned c = xb_ld(&bar[XB_XCNT(j)]); sum += c; cnt += (c > 0u) ? 1u : 0u; mine = (j == x) ? c : mine; }
        if (sum == G) break;
        __builtin_amdgcn_s_sleep(1);
        if ((++sp & 255u) == 0u) { if (xb_ld(&bar[XB_TMO])) break; if (sp > XB_SPIN_CAP) { atomicAdd(&bar[XB_TMO], 1u); break; } }
    }
    nloc = mine > 0u ? mine : 1u; nx = cnt > 0u ? cnt : 1u;
}
__device__ __forceinline__ void xcd_barrier(const XcdBarrier& b) {
    asm volatile("s_waitcnt vmcnt(0)" ::: "memory");
    __syncthreads();
    if (threadIdx.x == 0) {
        unsigned* bar = b.bar;
        __builtin_amdgcn_s_waitcnt(0);
        unsigned nloc = b.st[0], nx = b.st[1];
        if (nloc == 0u) { xcd_barrier_complete(bar, b.x, nloc, nx); b.st[0] = nloc; b.st[1] = nx; }
        const unsigned old = xb_add(&bar[XB_XSUB(b.x)], 1u);
        const unsigned gen = old / nloc;
        if (old + 1u == (gen + 1u) * nloc) {
            __builtin_amdgcn_fence(__ATOMIC_RELEASE, "agent");
            asm volatile("s_waitcnt vmcnt(0)" ::: "memory");
            const unsigned og = xb_add(&bar[XB_TOP], 1u);
            const unsigned tg = og / nx;
            if (og + 1u == (tg + 1u) * nx) xb_add(&bar[XB_TOPGEN], 1u);
            else XB_SPIN(xb_ld(&bar[XB_TOPGEN]) == tg, bar);
            __builtin_amdgcn_fence(__ATOMIC_ACQUIRE, "agent");
            xb_add(&bar[XB_XGEN(b.x)], 1u);
            asm volatile("s_waitcnt vmcnt(0)" ::: "memory");
        } else {
            XB_SPIN(xb_ld(&bar[XB_XGEN(b.x)]) == gen, bar);
            __builtin_amdgcn_fence(__ATOMIC_ACQUIRE, "agent");
            asm volatile("s_waitcnt vmcnt(0)" ::: "memory");
        }
    }
    __syncthreads();
}

__device__ __forceinline__ int lane_asm() { int l; asm volatile("v_mbcnt_lo_u32_b32 %0, -1, 0\n\tv_mbcnt_hi_u32_b32 %0, -1, %0" : "=v"(l)); return l; }
namespace pg8 {
constexpr int BM = 256, BK = 64, HALF = 128, HTB = HALF * BK * 2, STAGE_BYTES = 8 * HTB, NXCD = 8, WGM = 8;
__host__ __device__ __forceinline__ int lds_byte(int r, int c) { const int st = (r >> 4) * 2 + (c >> 5), rr = r & 15, cc = c & 31, ob = rr * 64 + cc * 2; return st * 1024 + (ob ^ (((ob >> 9) & 1) << 5)); }
__host__ __device__ __forceinline__ void stage_rc(int b, int& R, int& C) { const int st = b / 1024, sb = b % 1024, swz = sb ^ (((sb >> 9) & 1) << 5); R = (st >> 1) * 16 + swz / 64; C = (st & 1) * 32 + (swz % 64) / 2; }
__host__ __device__ __forceinline__ int perm32(int rho) { const int n = rho >> 4, i = rho & 15; return 8 * (i >> 2) + 4 * n + (i & 3); }
struct Unit { int pm, pn; };
struct Gemm { const bf16_t* A; const bf16_t* Bt; int lda, ldb, K; };
struct StaticOrder {
    int nM, nN, nwg, G, c;
    __device__ void init(int nM_, int nN_, int G_, int c_) { nM = nM_; nN = nN_; nwg = nM * nN; G = G_; c = c_; }
    __device__ bool next(int i, Unit& u) const {
        const long L = (long)i * G + c; if (L >= nwg) return false;
        int wgid = (int)L; { const int q = nwg / NXCD, r = nwg % NXCD, xcd = wgid % NXCD, off = wgid / NXCD; wgid = (xcd < r ? xcd * (q + 1) : r * (q + 1) + (xcd - r) * q) + off; }
        const int nig = WGM * nN, gid = wgid / nig, fm = gid * WGM, gsz = (nM - fm) < WGM ? (nM - fm) : WGM;
        u.pm = fm + ((wgid % nig) % gsz); u.pn = (wgid % nig) / gsz; return true;
    }
};
typedef int i32x4v __attribute__((ext_vector_type(4)));
typedef int i32x8v __attribute__((ext_vector_type(8)));
__device__ __forceinline__ i32x8v cat8(bf16x8 a, bf16x8 b) { return __builtin_shufflevector(__builtin_bit_cast(i32x4v, a), __builtin_bit_cast(i32x4v, b), 0, 1, 2, 3, 4, 5, 6, 7); }
template <class Epi, class Sched, bool FP8 = false>
__device__ __forceinline__ void gemm_phase(LAS unsigned char* lds, const Gemm g, const Sched& S, const Epi& E, int tid_in) {
    constexpr bool ALIGN_EPI = true;
    const unsigned tid_u = (unsigned)tid_in; __builtin_assume(tid_u < 512u);
    const int tid = (int)tid_u, wid = __builtin_amdgcn_readfirstlane(tid >> 6), lane = tid & 63, wr = wid >> 2, wc = wid & 3, fr = lane & 15, fq = lane >> 4;
    const int K = g.K, nt = K / BK;
    unsigned voffA[2], voffB[2];
#pragma unroll
    for (int i = 0; i < 2; ++i) { int R, C; stage_rc(tid * 16 + i * 8192, R, C); const int Rb = Epi::PERM ? ((R & ~31) + perm32(R & 31)) : R;
        voffA[i] = (unsigned)(R * g.lda + C) * 2u; voffB[i] = (unsigned)(Rb * g.ldb + C) * 2u; }
    const unsigned kstep = (unsigned)(BK * 2);
    const unsigned hstepA = (unsigned)HALF * g.lda * 2u, hstepB = (unsigned)HALF * g.ldb * 2u;
    const unsigned tstepA = 2u * hstepA, tstepB = 2u * hstepB;
    const unsigned ldsw = (unsigned)wid * 1024u;
    const int aoff = lds_byte(wr * 64 + fr, fq * 8), boff = lds_byte(wc * 32 + fr, fq * 8);
    const __amdgpu_buffer_rsrc_t rsA = __builtin_amdgcn_make_buffer_rsrc((void*)g.A, 0, 0xFFFFFFFFu, 0x00020000);
    const __amdgpu_buffer_rsrc_t rsB = __builtin_amdgcn_make_buffer_rsrc((void*)g.Bt, 0, 0xFFFFFFFFu, 0x00020000);
#define PG8_SA(b, h) (((b) * 2 + (h)) * HTB)
#define PG8_SB(b, h) ((4 + (b) * 2 + (h)) * HTB)
#define PG8_STAGE(bufoff, rs, soff, voff) do { _Pragma("unroll") for (int _i = 0; _i < 2; ++_i) \
        __builtin_amdgcn_raw_ptr_buffer_load_lds(rs, (LAS unsigned*)(lds + (bufoff) + ldsw + _i * 8192), 16, (int)(voff)[_i], (int)(soff), 0, 0); } while (0)
#define PG8_LDA(dst, b, h) do { if constexpr (FP8) { _Pragma("unroll") for (int m = 0; m < 4; ++m) dst##8[m] = __builtin_shufflevector(*(const LAS i32x4v*)(lds + PG8_SA(b, h) + aoff + m * 2048), *(const LAS i32x4v*)(lds + PG8_SA(b, h) + aoff + m * 2048 + 1024), 0, 1, 2, 3, 4, 5, 6, 7); } \
    else { _Pragma("unroll") for (int m = 0; m < 4; ++m) _Pragma("unroll") for (int k = 0; k < 2; ++k) dst[m][k] = *(const LAS bf16x8*)(lds + PG8_SA(b, h) + aoff + m * 2048 + k * 1024); } } while (0)
#define PG8_LDB(dst, b, h) do { if constexpr (FP8) { _Pragma("unroll") for (int n = 0; n < 2; ++n) dst##8[n] = __builtin_shufflevector(*(const LAS i32x4v*)(lds + PG8_SB(b, h) + boff + n * 2048), *(const LAS i32x4v*)(lds + PG8_SB(b, h) + boff + n * 2048 + 1024), 0, 1, 2, 3, 4, 5, 6, 7); } \
    else { _Pragma("unroll") for (int n = 0; n < 2; ++n) _Pragma("unroll") for (int k = 0; k < 2; ++k) dst[n][k] = *(const LAS bf16x8*)(lds + PG8_SB(b, h) + boff + n * 2048 + k * 1024); } } while (0)
#define PG8_MMA(ai, bj, At, Bt) do { __builtin_amdgcn_s_setprio(1); if constexpr (FP8) { _Pragma("unroll") for (int m = 0; m < 4; ++m) _Pragma("unroll") for (int n = 0; n < 2; ++n) \
        acc[ai][bj][m][n] = __builtin_amdgcn_mfma_scale_f32_16x16x128_f8f6f4(Bt##8[n], At##8[m], acc[ai][bj][m][n], 0, 0, 0, 0x7F7F7F7F, 0, 0x7F7F7F7F); } else { \
        _Pragma("unroll") for (int m = 0; m < 4; ++m) _Pragma("unroll") for (int n = 0; n < 2; ++n) _Pragma("unroll") for (int k = 0; k < 2; ++k) \
        acc[ai][bj][m][n] = __builtin_amdgcn_mfma_f32_16x16x32_bf16(Bt[n][k], At[m][k], acc[ai][bj][m][n], 0, 0, 0); } __builtin_amdgcn_s_setprio(0); } while (0)
#define PG8_WAIT_V(n) asm volatile("s_waitcnt vmcnt(" #n ")" ::: "memory")
#define PG8_WAIT_L(n) asm volatile("s_waitcnt lgkmcnt(" #n ")" ::: "memory")
#define PG8_BAR __builtin_amdgcn_s_barrier()
#define PG8_SCHED __builtin_amdgcn_sched_barrier(0)
    Unit cur, nxt; int ui = 0;
    if (!S.next(0, cur)) return;
    f32x4 acc[2][2][4][2];
#pragma unroll
    for (int a = 0; a < 2; ++a)
#pragma unroll
        for (int b = 0; b < 2; ++b)
#pragma unroll
            for (int m = 0; m < 4; ++m)
#pragma unroll
                for (int n = 0; n < 2; ++n) acc[a][b][m][n] = (f32x4){0.f, 0.f, 0.f, 0.f};
    i32x8v At8[4], B08[2], B18[2]; bf16x8 At[4][2], B0[2][2], B1[2][2];
    unsigned cA = (unsigned)cur.pm * tstepA, cB = (unsigned)cur.pn * tstepB;
    PG8_STAGE(PG8_SB(0, 0), rsB, cB, voffB); PG8_STAGE(PG8_SB(0, 1), rsB, cB + hstepB, voffB); PG8_STAGE(PG8_SA(0, 0), rsA, cA, voffA); PG8_STAGE(PG8_SA(0, 1), rsA, cA + hstepA, voffA);
    if (wr == 1) PG8_BAR;
    PG8_WAIT_V(2); PG8_BAR;
    PG8_STAGE(PG8_SB(1, 0), rsB, cB + kstep, voffB); PG8_STAGE(PG8_SA(1, 0), rsA, cA + kstep, voffA); PG8_STAGE(PG8_SB(1, 1), rsB, cB + hstepB + kstep, voffB);
    PG8_WAIT_V(6); PG8_BAR;
    for (;;) {
        const bool has_next = S.next(ui + 1, nxt);
        const unsigned nA = has_next ? (unsigned)nxt.pm * tstepA : cA; const unsigned nB = has_next ? (unsigned)nxt.pn * tstepB : cB;
        for (int t = 0; t < nt; t += 2) {
            const bool last = (t == nt - 2);
            const unsigned a1 = cA + (unsigned)(t + 1) * kstep;
            const unsigned a2 = last ? nA : cA + (unsigned)(t + 2) * kstep; const unsigned b2 = last ? nB : cB + (unsigned)(t + 2) * kstep;
            const unsigned a3 = a2 + kstep; const unsigned b3 = b2 + kstep;
            PG8_LDB(B0, 0, 0); PG8_LDB(B1, 0, 1); PG8_SCHED; PG8_LDA(At, 0, 0); PG8_STAGE(PG8_SA(1, 1), rsA, a1 + hstepA, voffA);
            PG8_WAIT_V(8); PG8_WAIT_L(0); PG8_BAR; PG8_MMA(0, 0, At, B0); PG8_MMA(0, 1, At, B1); PG8_BAR; PG8_SCHED;
            PG8_LDA(At, 0, 1); PG8_STAGE(PG8_SB(0, 0), rsB, b2, voffB); PG8_STAGE(PG8_SB(0, 1), rsB, b2 + hstepB, voffB); PG8_STAGE(PG8_SA(0, 0), rsA, a2, voffA);
            PG8_WAIT_V(8); PG8_WAIT_L(0); PG8_BAR; PG8_MMA(1, 0, At, B0); PG8_MMA(1, 1, At, B1); PG8_BAR; PG8_SCHED;
            PG8_LDB(B0, 1, 0); PG8_LDB(B1, 1, 1); PG8_SCHED; PG8_LDA(At, 1, 0); PG8_STAGE(PG8_SA(0, 1), rsA, a2 + hstepA, voffA);
            PG8_WAIT_V(8); PG8_WAIT_L(0); PG8_BAR; PG8_MMA(0, 0, At, B0); PG8_MMA(0, 1, At, B1); PG8_BAR; PG8_SCHED;
            PG8_LDA(At, 1, 1); PG8_STAGE(PG8_SB(1, 0), rsB, b3, voffB); PG8_STAGE(PG8_SB(1, 1), rsB, b3 + hstepB, voffB); PG8_STAGE(PG8_SA(1, 0), rsA, a3, voffA);
            PG8_WAIT_V(8); PG8_WAIT_L(0); PG8_BAR; PG8_MMA(1, 0, At, B0); PG8_MMA(1, 1, At, B1); PG8_BAR; PG8_SCHED;
        }
        if constexpr (ALIGN_EPI) { if (wr == 0) PG8_BAR; }
        { const int l2 = lane_asm() & 63; E(acc, cur, wr, wc, l2 & 15, l2 >> 4); }
        if (!has_next) break;
#pragma unroll
        for (int a = 0; a < 2; ++a)
#pragma unroll
            for (int b = 0; b < 2; ++b)
#pragma unroll
                for (int m = 0; m < 4; ++m)
#pragma unroll
                    for (int n = 0; n < 2; ++n) acc[a][b][m][n] = (f32x4){0.f, 0.f, 0.f, 0.f};
        cur = nxt; cA = nA; cB = nB; ++ui;
        if constexpr (ALIGN_EPI) { if (wr == 1) PG8_BAR; }
    }
    PG8_WAIT_V(0);
    if constexpr (!ALIGN_EPI) { if (wr == 0) PG8_BAR; }
    PG8_BAR;
#undef PG8_SA
#undef PG8_SB
#undef PG8_STAGE
#undef PG8_LDA
#undef PG8_LDB
#undef PG8_MMA
#undef PG8_WAIT_V
#undef PG8_WAIT_L
#undef PG8_BAR
#undef PG8_SCHED
}
}

enum { I_X = 0, I_C, I_CTX, I_CCTX, I_WADA, I_BADA, I_WIN, I_QNORM, I_WQUP, I_KVNORM, I_WKVUP, I_SCONVW, I_SCONVB, I_SDTB, I_SALOG, I_SD, I_SNORM,
       I_HCONVW, I_HCONVB, I_HW1, I_HB1, I_HW2, I_HB2, I_HW3, I_HFREQ, I_HD, I_RMU, I_RW0, I_RWUP, I_RA0, I_RAUP, I_RGUP, I_RKK, I_RKA, I_RRK, I_RLNG, I_RLNB,
       I_WBR, I_WOUT, I_LN1G, I_LN1B, I_WROUTER, I_WGATE, I_WUP, I_WDOWN, I_LN2G, I_LN2B, N_INPUTS };
struct Args { const float* in[N_INPUTS]; float* out; unsigned char* ws; int ph_lo, ph_hi; };
static_assert(sizeof(Args) == (N_INPUTS + 2) * 8 + 8, "Args has no padding");

__device__ __forceinline__ const float* arg_in(const Args& a, int i) { asm volatile("" : "+s"(i)); return a.in[i]; }
__device__ __forceinline__ int opqs(int v) { asm volatile("" : "+s"(v)); return v; }
__device__ __forceinline__ int opqv(int v) { asm volatile("" : "+v"(v)); return v; }
__device__ __forceinline__ unsigned char* opq(unsigned char* p) { asm volatile("" : "+s"(p)); return p; }
struct Frame {
    LAS unsigned char* lds;
    int tid, lane, wave, G, bid, gw, NGW;
    unsigned char* ws;
};
#define WSP(T_, off) ((T_*)(F.ws + (off)))

template <class RowMap>
__device__ __forceinline__ void transpose_item(const float* W, int ldw, bf16_t* WT, int ldt, int k0, int n0, const float* kscale, int koff, RowMap rm, LAS float* scr, int lane) {
#pragma unroll 8
    for (int i = 0; i < 32; ++i) { const int kk = 2 * i + (lane >> 5); float v = W[(size_t)(k0 + kk) * ldw + n0 + (lane & 31)]; if (kscale) v *= kscale[k0 + kk]; scr[kk * 33 + (lane & 31)] = v; }
    LDS_WAIT(); asm volatile("" ::: "memory");
    const int c = lane & 7;
#pragma unroll
    for (int j = 0; j < 4; ++j) { const int n = (lane >> 3) + 8 * j; const LAS float* s = scr + (8 * c) * 33 + n;
        u32x4 o; o.x = pk2(s[0 * 33], s[1 * 33]); o.y = pk2(s[2 * 33], s[3 * 33]); o.z = pk2(s[4 * 33], s[5 * 33]); o.w = pk2(s[6 * 33], s[7 * 33]);
        *(u32x4*)(WT + (size_t)rm(n0 + n) * ldt + koff + k0 + 8 * c) = o; }
    LDS_WAIT(); asm volatile("" ::: "memory");
}
struct RmId { __device__ int operator()(int n) const { return n; } };
struct RmGateUp { int up; __device__ int operator()(int n) const { return 256 * (n >> 7) + (n & 127) + (up ? 128 : 0); } };
template <class RowMap>
__device__ __forceinline__ void transpose_item_fp8(const float* W, int ldw, unsigned char* WT, int ldt, int k0, int n0, float sc, RowMap rm, LAS float* scr, int lane) {
#pragma unroll 8
    for (int i = 0; i < 32; ++i) { const int kk = 2 * i + (lane >> 5); scr[kk * 33 + (lane & 31)] = W[(size_t)(k0 + kk) * ldw + n0 + (lane & 31)] * sc; }
    LDS_WAIT(); asm volatile("" ::: "memory");
    const int c = lane & 3;
#pragma unroll
    for (int j = 0; j < 2; ++j) { const int n = (lane >> 2) + 16 * j; const LAS float* s = scr + (16 * c) * 33 + n;
        u32x4 o; o.x = pk4fp8(s[0 * 33], s[1 * 33], s[2 * 33], s[3 * 33]); o.y = pk4fp8(s[4 * 33], s[5 * 33], s[6 * 33], s[7 * 33]);
        o.z = pk4fp8(s[8 * 33], s[9 * 33], s[10 * 33], s[11 * 33]); o.w = pk4fp8(s[12 * 33], s[13 * 33], s[14 * 33], s[15 * 33]);
        *(u32x4*)(WT + (size_t)rm(n0 + n) * ldt + k0 + 16 * c) = o; }
    LDS_WAIT(); asm volatile("" ::: "memory");
}

__device__ __forceinline__ void p0_weights(Frame& F, const Args& a) {
    LAS float* scr = (LAS float*)(F.lds + F.wave * 8704);
    constexpr int IT_IN = 32 * 576, IT_BR = 16 * 64, IT_OUT = 32 * 64, IT_Q = 8 * 48, IT_KV = 8 * 64;
    constexpr int PER_L = IT_IN + 4 * IT_BR + IT_OUT + IT_Q + IT_KV;
    for (int it = F.gw; it < DEPTH * PER_L; it += F.NGW) {
        const int l = it / PER_L; int r = it % PER_L;
        if (r < IT_IN) { const int kb = r / 576, nb = r % 576;
            if (nb * 32 < NNG) transpose_item(arg_in(a, I_WIN) + (size_t)l * DM * NIN, NIN, WSP(bf16_t, WS_WIN + l * SZ_WIN), DM, kb * 64, nb * 32, nullptr, 0, RmId(), scr, F.lane);
            else transpose_item_fp8(arg_in(a, I_WIN) + (size_t)l * DM * NIN + NNG, NIN, WSP(unsigned char, WS_WIN + l * SZ_WIN) + (size_t)NNG * DM * 2, DM, kb * 64, nb * 32 - NNG, 64.f, RmId(), scr, F.lane);
            continue; } r -= IT_IN;
        if (r < 4 * IT_BR) { const int br = r / IT_BR, q = r % IT_BR, kb = q / 64, nb = q % 64;
            transpose_item(arg_in(a, I_WBR) + ((size_t)l * 4 + br) * 1024 * DM, DM, WSP(bf16_t, WS_WBR + l * SZ_WBR) + (size_t)br * DM * 1024, 1024, kb * 64, nb * 32, nullptr, 0, RmId(), scr, F.lane); continue; } r -= 4 * IT_BR;
        if (r < IT_OUT) { const int kb = r / 64, nb = r % 64;
            transpose_item(arg_in(a, I_WOUT) + (size_t)l * DM * DM, DM, WSP(bf16_t, WS_WOUT + l * SZ_WOUT), DM, kb * 64, nb * 32, nullptr, 0, RmId(), scr, F.lane); continue; } r -= IT_OUT;
        if (r < IT_Q) { const int kb = r / 48, nb = r % 48;
            transpose_item(arg_in(a, I_WQUP) + (size_t)l * 512 * 1536, 1536, WSP(bf16_t, WS_WQ + l * SZ_WQ), 512, kb * 64, nb * 32, arg_in(a, I_QNORM) + l * 512, 0, RmId(), scr, F.lane); continue; } r -= IT_Q;
        { const int kb = r / 64, nb = r % 64;
            transpose_item(arg_in(a, I_WKVUP) + (size_t)l * 512 * 2048, 2048, WSP(bf16_t, WS_WKV + l * SZ_WKV), 512, kb * 64, nb * 32, arg_in(a, I_KVNORM) + l * 512, 0, RmId(), scr, F.lane); }
    }
    for (size_t e = (size_t)F.bid * NTHREADS + F.tid; e < (size_t)DEPTH * 5120 * 512; e += (size_t)F.G * NTHREADS) {
        const int l = (int)(e / (5120 * 512)); const int rem = (int)(e % (5120 * 512)); const int n = rem / 512, kc = rem % 512; const int blk = n >> 10, c = n & 1023;
        float v = 0.f;
        if (blk < 2) { if (kc >= 64 * blk && kc < 64 * blk + 64) v = arg_in(a, I_RWUP)[(((size_t)l * 2 + blk) * 64 + (kc - 64 * blk)) * 1024 + c]; }
        else if (blk < 4) { const int d = blk - 2; if (kc >= 128 + 64 * d && kc < 192 + 64 * d) v = arg_in(a, I_RAUP)[(((size_t)l * 2 + d) * 64 + (kc - 128 - 64 * d)) * 1024 + c]; }
        else { if (kc >= 256 && kc < 416) v = arg_in(a, I_RGUP)[((size_t)l * 160 + (kc - 256)) * 1024 + c]; }
        WSP(bf16_t, WS_WLORA)[e] = (bf16_t)f2bf(v);
    }
}
constexpr int EFFP = 1536;
constexpr size_t SZ_WGU8 = (size_t)NEXP * 2816 * DM, SZ_WD8 = (size_t)NEXP * DM * EFFP;
__device__ __forceinline__ void conv_experts(Frame& F, const Args& a, int l) {
    LAS float* scr = (LAS float*)(F.lds + F.wave * 8704);
    constexpr int IT_G = 32 * 44, IT_D = 22 * 64, PER_E = 2 * IT_G + IT_D;
    unsigned char* wgu = WSP(unsigned char, WS_WE); unsigned char* wd = WSP(unsigned char, WS_WE + SZ_WGU8);
    for (int it = F.gw; it < NEXP * PER_E; it += F.NGW) {
        const int e = it / PER_E; int r = it % PER_E;
        if (r < 2 * IT_G) { const int up = r / IT_G, q = r % IT_G, kb = q / 44, nb = q % 44;
            const float* src = arg_in(a, up ? I_WUP : I_WGATE) + ((size_t)l * NEXP + e) * DM * EFF;
            RmGateUp rm; rm.up = up;
            transpose_item_fp8(src, EFF, wgu + (size_t)e * 2816 * DM, DM, kb * 64, nb * 32, 64.f, rm, scr, F.lane); continue; } r -= 2 * IT_G;
        { const int kb = r / 64, nb = r % 64;
            transpose_item_fp8(arg_in(a, I_WDOWN) + ((size_t)l * NEXP + e) * EFF * DM, DM, wd + (size_t)e * DM * EFFP, EFFP, kb * 64, nb * 32, 64.f, RmId(), scr, F.lane); }
    }
    for (int i = F.bid * NTHREADS + F.tid; i < NEXP * DM * 8; i += F.G * NTHREADS) { const int rowi = i >> 3, q = i & 7; unsigned zz = 0u; asm volatile("" : "+v"(zz));
        *(u32x4*)(wd + (size_t)rowi * EFFP + EFF + q * 16) = (u32x4){zz, zz, zz, zz}; }
}
__device__ __forceinline__ void p0_mod(Frame& F, const Args& a) {
    LAS float* sv = (LAS float*)(F.lds + 69632);
    for (int i = F.tid; i < 3 * DM; i += NTHREADS) { const int v = i / DM, k = i % DM; const float x = v < 2 ? arg_in(a, I_C)[v * DM + k] : arg_in(a, I_CCTX)[k]; sv[i] = siluf_(x); }
    __syncthreads();
    float* mod = (float*)(F.ws + WS_CTL) + CW_MOD;
    LAS float* red = (LAS float*)(F.lds + 69632 + 3 * DM * 4);
    for (int u = F.bid; u < DEPTH * (6 * DM / 128); u += F.G) {
        const int l = u / (6 * DM / 128), nb = u % (6 * DM / 128); const int kg = F.tid >> 7, cl = F.tid & 127, n = nb * 128 + cl;
        const float* w = arg_in(a, I_WADA) + ((size_t)l * DM + kg * 512) * (6 * DM) + n;
        float a0 = 0.f, a1 = 0.f, a2 = 0.f;
#pragma unroll 8
        for (int k = 0; k < 512; ++k) { const float wv = w[(size_t)k * (6 * DM)]; const int kk = kg * 512 + k; a0 += sv[kk] * wv; a1 += sv[DM + kk] * wv; a2 += sv[2 * DM + kk] * wv; }
        __syncthreads();
        red[(kg * 3 + 0) * 128 + cl] = a0; red[(kg * 3 + 1) * 128 + cl] = a1; red[(kg * 3 + 2) * 128 + cl] = a2;
        __syncthreads();
        if (F.tid < 384) { const int v = F.tid >> 7; const float b = arg_in(a, I_BADA)[l * 6 * DM + n];
            mod[(l * 3 + v) * 6 * DM + n] = b + ((red[(0 * 3 + v) * 128 + cl] + red[(1 * 3 + v) * 128 + cl]) + (red[(2 * 3 + v) * 128 + cl] + red[(3 * 3 + v) * 128 + cl])); }
    }
}

__device__ __forceinline__ void row_stats(const f32x4 (&v)[8], float& mean, float& rstd, float eps) {
    float s = 0.f;
#pragma unroll
    for (int j = 0; j < 8; ++j) s += (v[j].x + v[j].y) + (v[j].z + v[j].w);
    mean = wave_sum(s) * (1.f / DM);
    float s2 = 0.f;
#pragma unroll
    for (int j = 0; j < 8; ++j) { const f32x4 d = v[j] - mean; s2 += (d.x * d.x + d.y * d.y) + (d.z * d.z + d.w * d.w); }
    rstd = 1.f / sqrtf(wave_sum(s2) * (1.f / DM) + eps);
}
__device__ __forceinline__ const float* x_src_row(const Args& a, const Frame& F, int layer, int row) {
    if (layer == 0) return row < TC ? arg_in(a, I_CTX) + (size_t)row * DM : arg_in(a, I_X) + (size_t)(row - TC) * DM;
    return (const float*)(F.ws + WS_XS) + (size_t)row * DM;
}
__device__ __forceinline__ void phase_modln(Frame& F, const Args& a, int layer) {
    const float* mod = (const float*)(F.ws + WS_CTL) + CW_MOD + (size_t)layer * 3 * 6 * DM;
    bf16_t* H = WSP(bf16_t, WS_H); unsigned* H8 = WSP(unsigned, WS_H8);
    for (int row = F.gw; row < T; row += F.NGW) {
        const f32x4* xr = (const f32x4*)x_src_row(a, F, layer, row) + F.lane;
        f32x4 v[8];
#pragma unroll
        for (int j = 0; j < 8; ++j) v[j] = xr[64 * j];
        float mean, rstd; row_stats(v, mean, rstd, 1e-6f);
        const float* m = mod + (size_t)row_modidx(row) * 6 * DM;
        u32x2* o = (u32x2*)(H + (size_t)row * DM) + F.lane; unsigned* o8 = H8 + (size_t)row * (DM / 4) + F.lane;
#pragma unroll
        for (int j = 0; j < 8; ++j) { const int c = 4 * (64 * j + F.lane); const f32x4 sh = *(const f32x4*)(m + c), sc = *(const f32x4*)(m + DM + c);
            const f32x4 y = (v[j] - mean) * rstd * (sc + 1.f) + sh; u32x2 w; w.x = pk2(y.x, y.y); w.y = pk2(y.z, y.w); o[64 * j] = w; o8[64 * j] = pk4fp8(y.x, y.y, y.z, y.w); }
    }
}

__device__ __forceinline__ void phase_hdn(Frame& F, const Args& a, int layer) {
    LAS float* zs = (LAS float*)(F.lds + F.wave * 512);
    const float* w1 = arg_in(a, I_HW1) + (size_t)layer * 33 * 64; const float* b1 = arg_in(a, I_HB1) + layer * 64;
    const float* w2 = arg_in(a, I_HW2) + (size_t)layer * 64 * 64; const float* b2 = arg_in(a, I_HB2) + layer * 64;
    const float fr = arg_in(a, I_HFREQ)[layer * 64 + F.lane];
    float* HDN = WSP(float, WS_HDN);
    for (int r = F.gw; r < SEQ + CTX; r += F.NGW) {
        const int n = r < SEQ ? SEQ : CTX, t = r < SEQ ? r : r - SEQ;
        const float wpos = (6.283185307179586f * (float)t) / (float)n;
        if (F.lane < 33) { float z;
            if (F.lane == 0) z = (float)t / (float)(n - 1);
            else { const int b = (F.lane - 1) & 15; const float f = 1e-4f + (float)b * ((15.f - 1e-4f) / 15.f); const float ang = f * wpos; z = F.lane <= 16 ? __cosf(ang) : -__sinf(ang); }
            zs[F.lane] = z; }
        LDS_WAIT(); asm volatile("" ::: "memory");
        float p = b1[F.lane];
#pragma unroll
        for (int i = 0; i < 33; ++i) p += zs[i] * w1[i * 64 + F.lane];
        const float h1 = __sinf(fr * p);
        zs[64 + F.lane] = h1;
        LDS_WAIT(); asm volatile("" ::: "memory");
        float q = b2[F.lane];
#pragma unroll 16
        for (int i = 0; i < 64; ++i) q += zs[64 + i] * w2[i * 64 + F.lane];
        HDN[(size_t)r * 64 + F.lane] = __sinf(fr * q);
        LDS_WAIT(); asm volatile("" ::: "memory");
    }
}
__device__ __forceinline__ float hy_delta(int c) { const float mn = -3.0701134573253943f, mx = -15.350567286626972f; return fabsf(mn + (float)c * ((mx - mn) / 1023.f)); }
__device__ __forceinline__ void phase_filt(Frame& F, const Args& a, int layer) {
    const float* w3 = arg_in(a, I_HW3) + (size_t)layer * 64 * 2048; const float* HDN = WSP(float, WS_HDN);
    LAS float* ws3 = (LAS float*)F.lds;
    bf16_t* FILT = WSP(bf16_t, WS_FILT);
    for (int u = F.bid; u < 32 * 16; u += F.G) {
        const int cb = u / 16, tb = u % 16, col0 = cb * 64, t = tb * 512 + F.tid;
        __syncthreads();
        for (int i = F.tid; i < 4096; i += NTHREADS) { const int j = i >> 6, cc = i & 63; ws3[cc * 64 + j] = w3[(size_t)j * 2048 + col0 + cc]; }
        __syncthreads();
        f32x4 h[16];
#pragma unroll
        for (int i = 0; i < 16; ++i) h[i] = *(const f32x4*)(HDN + (size_t)t * 64 + 4 * i);
        const float tn = (float)t / (float)(SEQ - 1);
        for (int cc = 0; cc < 64; ++cc) {
            float acc = 0.f;
#pragma unroll
            for (int i = 0; i < 16; ++i) { const f32x4 w = *(const LAS f32x4*)(ws3 + cc * 64 + 4 * i); acc += h[i].x * w.x + h[i].y * w.y + h[i].z * w.z + h[i].w * w.w; }
            const int col = col0 + cc, side = col >> 10, c = col & 1023;
            FILT[((size_t)c * 2 + side) * SEQ + t] = (bf16_t)f2bf(acc * __expf(-tn * hy_delta(c)));
        }
    }
    float* FILTC = WSP(float, WS_FILTC);
    for (int e = F.bid * NTHREADS + F.tid; e < CTX * 2048; e += F.G * NTHREADS) {
        const int lag = e >> 11, col = e & 2047, c = col & 1023; const float* hr = HDN + (size_t)(SEQ + lag) * 64; float acc = 0.f;
#pragma unroll 16
        for (int j = 0; j < 64; ++j) acc += hr[j] * w3[(size_t)j * 2048 + col];
        FILTC[e] = acc * __expf(-((float)lag / (float)(CTX - 1)) * hy_delta(c));
    }
}

__device__ __forceinline__ void ld8bf(const bf16_t* p, float (&o)[8]) { const u32x4 w = *(const u32x4*)p; o[0] = bflo(w.x); o[1] = bfhi(w.x); o[2] = bflo(w.y); o[3] = bfhi(w.y); o[4] = bflo(w.z); o[5] = bfhi(w.z); o[6] = bflo(w.w); o[7] = bfhi(w.w); }
__device__ __forceinline__ void st8bf(bf16_t* p, const float (&v)[8]) { u32x4 w; w.x = pk2(v[0], v[1]); w.y = pk2(v[2], v[3]); w.z = pk2(v[4], v[5]); w.w = pk2(v[6], v[7]); *(u32x4*)p = w; }
__device__ __forceinline__ void ld8f(const float* p, float (&o)[8]) { const f32x4 a = *(const f32x4*)p, b = *(const f32x4*)(p + 4); o[0] = a.x; o[1] = a.y; o[2] = a.z; o[3] = a.w; o[4] = b.x; o[5] = b.y; o[6] = b.z; o[7] = b.w; }

constexpr int PREP_RUN = 16;
__device__ __forceinline__ void phase_prep(Frame& F, const Args& a, int layer) {
    const bf16_t* P = WSP(bf16_t, WS_P); bf16_t* P2 = WSP(bf16_t, WS_P2);
    float* RS = WSP(float, WS_RS); bf16_t* KPE = WSP(bf16_t, WS_KPE); float* DT = WSP(float, WS_DT);
    bf16_t* KK = WSP(bf16_t, WS_KK); bf16_t* AL_ = WSP(bf16_t, WS_ALORA); float* VC = WSP(float, WS_VC);
    const float* scw = arg_in(a, I_SCONVW) + (size_t)layer * 3 * 1536; const float* scb = arg_in(a, I_SCONVB) + layer * 1536; const float* dtb = arg_in(a, I_SDTB) + layer * 32;
    const float* hcw = arg_in(a, I_HCONVW) + (size_t)layer * 3 * 3072; const float* hcb = arg_in(a, I_HCONVB) + layer * 3072;
    const float* mu = arg_in(a, I_RMU) + (size_t)layer * 2 * 3488; const float* rkk = arg_in(a, I_RKK) + layer * 1024;
    const int lane = F.lane;
    for (int item = F.gw; item < (T / PREP_RUN) * 13; item += F.NGW) {
        const int run = item / 13, ct = item % 13; const int r0 = run * PREP_RUN;
        if (ct == 0) {
#pragma unroll 1
        for (int rr = 0; rr < PREP_RUN; ++rr) { const int row = r0 + rr; const bf16_t* pr = P + (size_t)row * NNG;
            float x[8]; ld8bf(pr + P_CQ + lane * 8, x); float s = 0.f;
#pragma unroll
            for (int i = 0; i < 8; ++i) s += x[i] * x[i];
            s = wave_sum(s); const float rq = 1.f / sqrtf(s * (1.f / 512.f) + 1e-6f);
            ld8bf(pr + P_CKV + lane * 8, x); s = 0.f;
#pragma unroll
            for (int i = 0; i < 8; ++i) s += x[i] * x[i];
            s = wave_sum(s); const float rk = 1.f / sqrtf(s * (1.f / 512.f) + 1e-6f);
            if (lane == 0) { RS[row * 2] = rq; RS[row * 2 + 1] = rk; }
            float kv = bf2f(pr[P_KPE + lane]);
            const float other = swz16(kv);
            if (row >= TC) { const int t = (row - TC) & (SEQ - 1); const int axis = lane >> 5, half = (lane >> 4) & 1, j = lane & 15;
                const float pos = (float)(axis == 0 ? (t >> 6) : (t & 63)); const float inv = __builtin_amdgcn_exp2f(-(float)j * 0.8304820237218406f);
                const float sn = __sinf(pos * inv), cs = __cosf(pos * inv);
                kv = half == 0 ? kv * cs - other * sn : kv * cs + other * sn; }
            KPE[(size_t)row * 64 + lane] = (bf16_t)f2bf(kv);
            if (lane < 32) DT[(size_t)row * 32 + lane] = softplusf_(bf2f(pr[P_DT + lane]) + dtb[lane]); }
        continue; }
        const bool first = row_first(r0), last = row_last(r0 + PREP_RUN - 1);
        if (ct >= 1 && ct <= 3) { const int ch = ct - 1; const int c = ch * 512 + lane * 8; float xm[8], x0[8], xp[8], w0[8], w1[8], w2[8], bb[8];
            ld8f(scw + c, w0); ld8f(scw + 1536 + c, w1); ld8f(scw + 3072 + c, w2); ld8f(scb + c, bb);
            const bf16_t* pc = P + (size_t)r0 * NNG + P_XBC + c;
            if (!first) ld8bf(pc - NNG, xm); else { for (int i = 0; i < 8; ++i) xm[i] = 0.f; }
            ld8bf(pc, x0);
#pragma unroll 2
            for (int rr = 0; rr < PREP_RUN; ++rr) {
                if (rr + 1 < PREP_RUN || !last) ld8bf(pc + (size_t)(rr + 1) * NNG, xp); else { for (int i = 0; i < 8; ++i) xp[i] = 0.f; }
                float o[8];
#pragma unroll
                for (int i = 0; i < 8; ++i) { o[i] = siluf_(xm[i] * w0[i] + x0[i] * w1[i] + xp[i] * w2[i] + bb[i]); xm[i] = x0[i]; x0[i] = xp[i]; }
                st8bf(P2 + (size_t)(r0 + rr) * P2W + P2_XBC + c, o); } continue; }
        if (ct >= 4 && ct <= 5) { const int ch = ct - 4; { const int c = ch * 512 + lane * 8; float xm[8], x0[8], xp[8], w0[8], w1[8], w2[8], bb[8];
            ld8f(hcw + c, w0); ld8f(hcw + 3072 + c, w1); ld8f(hcw + 6144 + c, w2); ld8f(hcb + c, bb);
            const bf16_t* pc = P + (size_t)r0 * NNG + P_HY + c;
            if (!first) ld8bf(pc - NNG, xm); else { for (int i = 0; i < 8; ++i) xm[i] = 0.f; }
            ld8bf(pc, x0);
#pragma unroll 2
            for (int rr = 0; rr < PREP_RUN; ++rr) {
                if (rr + 1 < PREP_RUN || !last) ld8bf(pc + (size_t)(rr + 1) * NNG, xp); else { for (int i = 0; i < 8; ++i) xp[i] = 0.f; }
                float o[8];
#pragma unroll
                for (int i = 0; i < 8; ++i) { o[i] = xm[i] * w0[i] + x0[i] * w1[i] + xp[i] * w2[i] + bb[i]; xm[i] = x0[i]; x0[i] = xp[i]; }
                st8bf(P2 + (size_t)(r0 + rr) * P2W + P2_X0 + c, o); } }
        if (r0 < TC) {
#pragma unroll 1
                for (int rr = 0; rr < PREP_RUN; ++rr) { const int row = r0 + rr; const bool f1 = row_first(row), l1 = row_last(row); const int c = ch * 512 + lane * 8;
                    const bf16_t* pr = P + (size_t)row * NNG; float o1[8], o2[8];
#pragma unroll
                    for (int part = 1; part < 3; ++part) { float x0[8], xm[8], xp[8], w0[8], w1[8], w2[8], bb[8]; const int cc = part * 1024 + c;
                        ld8bf(pr + P_HY + cc, x0);
                        if (!f1) ld8bf(pr - NNG + P_HY + cc, xm); else { for (int i = 0; i < 8; ++i) xm[i] = 0.f; }
                        if (!l1) ld8bf(pr + NNG + P_HY + cc, xp); else { for (int i = 0; i < 8; ++i) xp[i] = 0.f; }
                        ld8f(hcw + cc, w0); ld8f(hcw + 3072 + cc, w1); ld8f(hcw + 6144 + cc, w2); ld8f(hcb + cc, bb);
#pragma unroll
                        for (int i = 0; i < 8; ++i) { const float r = xm[i] * w0[i] + x0[i] * w1[i] + xp[i] * w2[i] + bb[i]; if (part == 1) o1[i] = r; else o2[i] = r; } }
                    float* vc = VC + (size_t)row * 1024 + c;
                    *(f32x4*)vc = (f32x4){o1[0] * o2[0], o1[1] * o2[1], o1[2] * o2[2], o1[3] * o2[3]};
                    *(f32x4*)(vc + 4) = (f32x4){o1[4] * o2[4], o1[5] * o2[5], o1[6] * o2[6], o1[7] * o2[7]}; } }
        continue; }
        { const int ch = ct - 6; const int c = ch * 512 + lane * 8;
            if (c < 3488) { float um[8], u0[8], up[8], m0[8], m1[8], g8[8];
                ld8f(mu + c, m0); ld8f(mu + 3488 + c, m1);
                if (ch == 2 || ch == 3) ld8f(rkk + (c - 1024), g8);
                const bf16_t* pc = P + (size_t)r0 * NNG + P_RW + c;
                if (!first) ld8bf(pc - NNG, um); else { for (int i = 0; i < 8; ++i) um[i] = 0.f; }
                ld8bf(pc, u0);
#pragma unroll 2
                for (int rr = 0; rr < PREP_RUN; ++rr) { const int row = r0 + rr;
                    if (rr + 1 < PREP_RUN || !last) ld8bf(pc + (size_t)(rr + 1) * NNG, up); else { for (int i = 0; i < 8; ++i) up[i] = 0.f; }
                    float us[8];
#pragma unroll
                    for (int i = 0; i < 8; ++i) { us[i] = u0[i] + m0[i] * (um[i] - u0[i]) + m1[i] * (up[i] - u0[i]); um[i] = u0[i]; u0[i] = up[i]; }
                    if (ch < 6) st8bf(P2 + (size_t)row * P2W + P2_RKV + c, us);
                    if (ch == 2 || ch == 3) { float kx[8]; float s = 0.f;
#pragma unroll
                        for (int i = 0; i < 8; ++i) { kx[i] = us[i] * g8[i]; s += kx[i] * kx[i]; }
                        s = sum8(s);
                        const float inv = 1.f / fmaxf(sqrtf(s), 1e-12f);
#pragma unroll
                        for (int i = 0; i < 8; ++i) kx[i] *= inv;
                        st8bf(KK + (size_t)row * 1024 + (c - 1024), kx); }
                    if (ch == 6) { const int cl = c - 3072; float o[8];
#pragma unroll
                        for (int i = 0; i < 8; ++i) o[i] = cl < 128 ? tanhf_(us[i]) : cl < 256 ? us[i] : sigmoidf_(us[i]);
                        st8bf(AL_ + (size_t)row * 512 + cl, o); } } }
            else if (ch == 6) { const int cl = c - 3072;
                for (int rr = 0; rr < PREP_RUN; ++rr) { float zz = 0.f; asm volatile("" : "+v"(zz)); float o[8] = {zz, zz, zz, zz, zz, zz, zz, zz}; st8bf(AL_ + (size_t)(r0 + rr) * 512 + cl, o); } } }
    }
    float* VT = WSP(float, WS_VT);
    LAS float* tl = (LAS float*)F.lds;
    for (int u = F.bid; u < (TL / 64) * 4; u += F.G) {
        const int tb = u >> 2, cb = u & 3; const int row0 = TC + tb * 64; const int c8 = (F.tid & 31) * 8, c = cb * 256 + c8, tq = F.tid >> 5;
        float w1[3][8], w2[3][8], b1[8], b2[8];
#pragma unroll
        for (int k = 0; k < 3; ++k) { ld8f(hcw + k * 3072 + 1024 + c, w1[k]); ld8f(hcw + k * 3072 + 2048 + c, w2[k]); }
        ld8f(hcb + 1024 + c, b1); ld8f(hcb + 2048 + c, b2);
        __syncthreads();
#pragma unroll 1
        for (int i = 0; i < 4; ++i) { const int tl_ = tq * 4 + i, row = row0 + tl_; const bf16_t* pr = P + (size_t)row * NNG + P_HY;
            const bool first = row_first(row), last = row_last(row);
            float a1[8], a2[8], x[8];
            ld8bf(pr + 1024 + c, x);
#pragma unroll
            for (int j = 0; j < 8; ++j) a1[j] = x[j] * w1[1][j] + b1[j];
            ld8bf(pr + 2048 + c, x);
#pragma unroll
            for (int j = 0; j < 8; ++j) a2[j] = x[j] * w2[1][j] + b2[j];
            if (!first) { ld8bf(pr - NNG + 1024 + c, x);
#pragma unroll
                for (int j = 0; j < 8; ++j) a1[j] += x[j] * w1[0][j];
                ld8bf(pr - NNG + 2048 + c, x);
#pragma unroll
                for (int j = 0; j < 8; ++j) a2[j] += x[j] * w2[0][j]; }
            if (!last) { ld8bf(pr + NNG + 1024 + c, x);
#pragma unroll
                for (int j = 0; j < 8; ++j) a1[j] += x[j] * w1[2][j];
                ld8bf(pr + NNG + 2048 + c, x);
#pragma unroll
                for (int j = 0; j < 8; ++j) a2[j] += x[j] * w2[2][j]; }
#pragma unroll
            for (int j = 0; j < 8; ++j) tl[(c8 + j) * 65 + tl_] = a1[j] * a2[j]; }
        __syncthreads();
        const int b = (row0 - TC) >> 13, t0 = (row0 - TC) & (SEQ - 1);
        for (int p_ = 0; p_ < 8; ++p_) { const int cl = p_ * 32 + (F.tid >> 4), q = F.tid & 15;
            const f32x4 o = {tl[cl * 65 + 4 * q], tl[cl * 65 + 4 * q + 1], tl[cl * 65 + 4 * q + 2], tl[cl * 65 + 4 * q + 3]};
            *(f32x4*)(VT + ((size_t)(cb * 256 + cl) * 2 + b) * SEQ + t0 + 4 * q) = o; }
    }
}

using pg8::Unit;
#define EPI_LOOP_BEGIN const int row0 = u.pm * 256 + wr * 64 + fr; \
    _Pragma("unroll") for (int ai = 0; ai < 2; ++ai) _Pragma("unroll") for (int m = 0; m < 4; ++m) { const int row = row0 + ai * 128 + m * 16; \
    _Pragma("unroll") for (int bj = 0; bj < 2; ++bj) { const int cl = bj * 128 + wc * 32 + 8 * fq; const f32x4 v0 = acc[ai][bj][m][0], v1 = acc[ai][bj][m][1];
#define EPI_LOOP_END } __builtin_amdgcn_sched_barrier(0); }
struct EpiBf16 {
    static constexpr bool PERM = true;
    bf16_t* O; int ldc; const float* rscale; int rs_stride; int act; float cscale;
    __device__ __forceinline__ void operator()(const f32x4 (&acc)[2][2][4][2], const Unit& u, int wr, int wc, int fr, int fq) const {
        EPI_LOOP_BEGIN
            const float s = rscale ? rscale[(size_t)row * rs_stride] : cscale;
            float x[8] = {v0.x * s, v0.y * s, v0.z * s, v0.w * s, v1.x * s, v1.y * s, v1.z * s, v1.w * s};
            if (act == 1) {
#pragma unroll
                for (int i = 0; i < 8; ++i) x[i] = sigmoidf_(x[i]); }
            u32x4 w; w.x = cvt_pk_bf16(x[0], x[1]); w.y = cvt_pk_bf16(x[2], x[3]); w.z = cvt_pk_bf16(x[4], x[5]); w.w = cvt_pk_bf16(x[6], x[7]);
            *(u32x4*)(O + (size_t)row * ldc + u.pn * 256 + cl) = w;
        EPI_LOOP_END
    }
};
struct EpiLora {
    static constexpr bool PERM = true;
    bf16_t* EW; bf16_t* ICLR; bf16_t* GG; const float* w0; const float* a0;
    __device__ __forceinline__ void operator()(const f32x4 (&acc)[2][2][4][2], const Unit& u, int wr, int wc, int fr, int fq) const {
        const int blk = u.pn >> 2, cb = (u.pn & 3) * 256;
        const float* bias = blk < 2 ? w0 + blk * 1024 : a0 + (blk & 1) * 1024;
        bf16_t* dbase = blk < 2 ? EW + (size_t)blk * T * 1024 : blk < 4 ? ICLR + (size_t)(blk - 2) * T * 1024 : GG;
        const float scale = blk < 2 ? 0.6065306597126334f : 1.f; const bool sig = blk < 4;
        EPI_LOOP_BEGIN
            const int c = cb + cl; float x[8] = {v0.x, v0.y, v0.z, v0.w, v1.x, v1.y, v1.z, v1.w};
            if (sig) { const f32x4 b0 = *(const f32x4*)(bias + c), b1 = *(const f32x4*)(bias + c + 4); const float bb[8] = {b0.x, b0.y, b0.z, b0.w, b1.x, b1.y, b1.z, b1.w};
#pragma unroll
                for (int i = 0; i < 8; ++i) x[i] = scale * sigmoidf_(bb[i] + x[i]); }
            u32x4 w; w.x = cvt_pk_bf16(x[0], x[1]); w.y = cvt_pk_bf16(x[2], x[3]); w.z = cvt_pk_bf16(x[4], x[5]); w.w = cvt_pk_bf16(x[6], x[7]);
            *(u32x4*)(dbase + (size_t)row * 1024 + c) = w;
        EPI_LOOP_END
    }
};
struct EpiMerge {
    static constexpr bool PERM = true;
    const bf16_t* gates; float* MF; bf16_t* MB;
    __device__ __forceinline__ void operator()(const f32x4 (&acc)[2][2][4][2], const Unit& uu, int wr, int wc, int fr, int fq) const {
        const int br = uu.pn >> 3; Unit u; u.pm = uu.pm - br * 66; u.pn = uu.pn & 7;
        EPI_LOOP_BEGIN
            const int col = u.pn * 256 + cl; float g[8]; ld8bf(gates + (size_t)row * NGATE + br * DM + col, g);
#pragma unroll
            for (int i = 0; i < 8; ++i) g[i] = sigmoidf_(g[i]);
            float x[8] = {v0.x * g[0], v0.y * g[1], v0.z * g[2], v0.w * g[3], v1.x * g[4], v1.y * g[5], v1.z * g[6], v1.w * g[7]};
            float* mf = MF + (size_t)row * DM + col;
            if (br > 0) { const f32x4 p0 = *(const f32x4*)mf, p1 = *(const f32x4*)(mf + 4); x[0] += p0.x; x[1] += p0.y; x[2] += p0.z; x[3] += p0.w; x[4] += p1.x; x[5] += p1.y; x[6] += p1.z; x[7] += p1.w; }
            if (br < 3) { *(f32x4*)mf = (f32x4){x[0], x[1], x[2], x[3]}; *(f32x4*)(mf + 4) = (f32x4){x[4], x[5], x[6], x[7]}; }
            else { u32x4 w; w.x = cvt_pk_bf16(x[0], x[1]); w.y = cvt_pk_bf16(x[2], x[3]); w.z = cvt_pk_bf16(x[4], x[5]); w.w = cvt_pk_bf16(x[6], x[7]); *(u32x4*)(MB + (size_t)row * DM + col) = w; }
        EPI_LOOP_END
    }
};
struct OrderMerge {
    pg8::StaticOrder so;
    __device__ void init(int G, int c) { so.init(66, 8, G, c); }
    __device__ bool next(int i, Unit& u) const { Unit t; if (!so.next(i >> 2, t)) return false; const int br = i & 3; u.pm = br * 66 + t.pm; u.pn = br * 8 + t.pn; return true; }
};
struct EpiF32 {
    static constexpr bool PERM = true;
    float* O; int ldc;
    __device__ __forceinline__ void operator()(const f32x4 (&acc)[2][2][4][2], const Unit& u, int wr, int wc, int fr, int fq) const {
        EPI_LOOP_BEGIN
            float* o = O + (size_t)row * ldc + u.pn * 256 + cl; *(f32x4*)o = v0; *(f32x4*)(o + 4) = v1;
        EPI_LOOP_END
    }
};
__device__ __forceinline__ int moe_panel(int e, int pi) { return pi < 8 ? (((pi >> 2) * NEXP + e) * 4 + (pi & 3)) : 128 + e; }
struct OrderMoe {
    int npn, G, c;
    __device__ void init(int npn_, int G_, int c_) { npn = npn_; G = G_; c = c_; }
    __device__ bool next(int i, Unit& u) const { const int L = i * G + c; const int per = 9 * npn; if (L >= NEXP * per) return false;
        const int e = L / per, r = L % per, j = r / 9, pi = r % 9; u.pm = moe_panel(e, pi); u.pn = e * npn + j; return true; }
};
struct EpiSwiglu {
    static constexpr bool PERM = true;
    unsigned char* HID;
    __device__ __forceinline__ void operator()(const f32x4 (&acc)[2][2][4][2], const Unit& u, int wr, int wc, int fr, int fq) const {
        const int j = u.pn % 11; const int row0 = u.pm * 256 + wr * 64 + fr; const float sc = 1.f / 64.f;
#pragma unroll
        for (int ai = 0; ai < 2; ++ai)
#pragma unroll
            for (int m = 0; m < 4; ++m) { const int row = row0 + ai * 128 + m * 16;
                const f32x4 g0 = acc[ai][0][m][0] * sc, g1 = acc[ai][0][m][1] * sc, u0 = acc[ai][1][m][0] * sc, u1 = acc[ai][1][m][1] * sc;
                u32x2 w; w.x = pk4fp8(siluf_(g0.x) * u0.x, siluf_(g0.y) * u0.y, siluf_(g0.z) * u0.z, siluf_(g0.w) * u0.w);
                w.y = pk4fp8(siluf_(g1.x) * u1.x, siluf_(g1.y) * u1.y, siluf_(g1.z) * u1.z, siluf_(g1.w) * u1.w);
                *(u32x2*)(HID + (size_t)row * EFFP + j * 128 + wc * 32 + 8 * fq) = w; __builtin_amdgcn_sched_barrier(0); }
    }
};
struct EpiDown {
    static constexpr bool PERM = true;
    bf16_t* YE; const float* pgate;
    __device__ __forceinline__ void operator()(const f32x4 (&acc)[2][2][4][2], const Unit& uu, int wr, int wc, int fr, int fq) const {
        Unit u; u.pm = uu.pm; u.pn = uu.pn & 7;
        EPI_LOOP_BEGIN
            const float s = pgate[row] * (1.f / 64.f);
            u32x4 w; w.x = cvt_pk_bf16(v0.x * s, v0.y * s); w.y = cvt_pk_bf16(v0.z * s, v0.w * s); w.z = cvt_pk_bf16(v1.x * s, v1.y * s); w.w = cvt_pk_bf16(v1.z * s, v1.w * s);
            *(u32x4*)(YE + (size_t)row * DM + u.pn * 256 + cl) = w;
        EPI_LOOP_END
    }
};

namespace att {
using s16x4 = __attribute__((ext_vector_type(4))) short;
using f32x16 = __attribute__((ext_vector_type(16))) float;
constexpr int NW = 8, QBLK = 32, KVBLK = 64, LDQ = 1536, LDKV = 2048, LDO = 1024;
constexpr float SCALE = 0.07216878364870322f;
constexpr float THR = 8.f;
#ifndef ATT_SDEPTH
#define ATT_SDEPTH 1
#endif
constexpr int SDEPTH = ATT_SDEPTH;
constexpr int SHM_V = KVBLK * 128 * 2, SHM_K = KVBLK * 128 * 2, SHM_KP = KVBLK * 64 * 2;
constexpr int OFF_V = 0, OFF_K = 2 * SHM_V, OFF_KP = OFF_K + 2 * SHM_K, OFF_WS = OFF_KP + 2 * SHM_KP, OFF_QP = OFF_WS + NW * 64 * 4, SHM_ATTN = OFF_QP + 256 * 256;
static_assert(SHM_ATTN <= 150 * 1024, "attention LDS");
#define KSWZ(row, colB) ((row) * 256 + ((colB) ^ (((row) & 7) << 4)))
#define KPSWZ(row, colB) ((row) * 128 + ((colB) ^ (((row) & 7) << 4)))
#define SBAR() __builtin_amdgcn_sched_barrier(0)
__device__ __forceinline__ int crow(int r, int hi) { return (r & 3) + 8 * (r >> 2) + 4 * hi; }
__device__ __forceinline__ void partialSM(f32x16& p0, f32x16& p1, float& m_reg, float& mn, float& alpha) {
  constexpr float C = SCALE * 1.4426950408889634f;
  float pmax = p0[0]; for (int r = 1; r < 16; ++r) pmax = fmaxf(pmax, p0[r]); for (int r = 0; r < 16; ++r) pmax = fmaxf(pmax, p1[r]);
  { auto rr = __builtin_amdgcn_permlane32_swap(__float_as_uint(pmax), __float_as_uint(pmax), false, false);
    pmax = fmaxf(__uint_as_float(rr[0]), __uint_as_float(rr[1])); }
  if (__builtin_expect(__all(pmax - m_reg <= THR / SCALE), 1)) { mn = m_reg; alpha = 1.f; }
  else { mn = fmaxf(m_reg, pmax); alpha = __builtin_amdgcn_exp2f((m_reg - mn) * C); m_reg = mn; }
  float mnC = -mn * C;
  for (int r = 0; r < 16; ++r) p0[r] = fmaf(p0[r], C, mnC); for (int r = 0; r < 16; ++r) p1[r] = fmaf(p1[r], C, mnC);
  for (int r = 0; r < 16; ++r) p0[r] = __builtin_amdgcn_exp2f(p0[r]);
}
__device__ __forceinline__ void finishSM(f32x16& p0, f32x16& p1, float alpha, float& l_reg, bf16x8& pa0, bf16x8& pa1, bf16x8& pa2, bf16x8& pa3) {
  for (int r = 0; r < 16; ++r) p1[r] = __builtin_amdgcn_exp2f(p1[r]);
  float ps = 0; for (int r = 0; r < 16; ++r) ps += p0[r]; for (int r = 0; r < 16; ++r) ps += p1[r];
  { auto rr = __builtin_amdgcn_permlane32_swap(__float_as_uint(ps), __float_as_uint(ps), false, false);
    ps = __uint_as_float(rr[0]) + __uint_as_float(rr[1]); }
  l_reg = l_reg * alpha + ps;
#define PK4(P, BASE, OUT) do { unsigned a0 = cvt_pk_bf16(P[BASE + 0], P[BASE + 1]), a1 = cvt_pk_bf16(P[BASE + 2], P[BASE + 3]);   \
    unsigned b0 = cvt_pk_bf16(P[BASE + 4], P[BASE + 5]), b1 = cvt_pk_bf16(P[BASE + 6], P[BASE + 7]);                              \
    auto r0 = __builtin_amdgcn_permlane32_swap(a0, b0, false, false); auto r1 = __builtin_amdgcn_permlane32_swap(a1, b1, false, false); \
    u32x4 w = {r0[0], r1[0], r0[1], r1[1]}; OUT = *reinterpret_cast<bf16x8*>(&w); } while (0)
  PK4(p0, 0, pa0); PK4(p0, 8, pa1); PK4(p1, 0, pa2); PK4(p1, 8, pa3);
#undef PK4
}
__device__ __forceinline__ void qkt(f32x16& p0, f32x16& p1, const char* Ks, const char* Kp, const bf16x8* qr, const char* Qp, int qrow, int r32, int hi) {
  p0 = f32x16{}; p1 = f32x16{};
#pragma unroll
  for (int d0 = 0; d0 < 8; ++d0) { int cb = (d0 * 16 + hi * 8) * 2;
    bf16x8 b0 = *reinterpret_cast<const bf16x8*>(Ks + KSWZ(r32, cb));
    bf16x8 b1 = *reinterpret_cast<const bf16x8*>(Ks + KSWZ(32 + r32, cb));
    bf16x8 q; if (d0 < 4) q = qr[d0]; else q = *reinterpret_cast<const bf16x8*>(Qp + KSWZ(qrow, ((d0 - 4) * 16 + hi * 8) * 2));
    p0 = __builtin_amdgcn_mfma_f32_32x32x16_bf16(b0, q, p0, 0, 0, 0);
    p1 = __builtin_amdgcn_mfma_f32_32x32x16_bf16(b1, q, p1, 0, 0, 0); }
#pragma unroll
  for (int d0 = 0; d0 < 4; ++d0) { int cb = (d0 * 16 + hi * 8) * 2;
    bf16x8 b0 = *reinterpret_cast<const bf16x8*>(Kp + KPSWZ(r32, cb));
    bf16x8 b1 = *reinterpret_cast<const bf16x8*>(Kp + KPSWZ(32 + r32, cb));
    const bf16x8 qp = *reinterpret_cast<const bf16x8*>(Qp + KSWZ(qrow, 128 + cb));
    p0 = __builtin_amdgcn_mfma_f32_32x32x16_bf16(b0, qp, p0, 0, 0, 0);
    p1 = __builtin_amdgcn_mfma_f32_32x32x16_bf16(b1, qp, p1, 0, 0, 0); }
}
__device__ __forceinline__ int v_st(int k, int c) { const int kk = (k & ~0xC) | ((k & 4) << 1) | ((k & 8) >> 1); return ((kk >> 3) * 4 + (c >> 5)) * 512 + ((kk & 7) * 32 + (c & 31)) * 2; }
__device__ __forceinline__ int v_rd_base(int lane) { return ((lane & 3) << 3) | (((lane >> 2) & 3) << 6) | (((lane >> 4) & 1) << 5) | (((lane >> 5) & 1) << 8); }
constexpr int v_rd_off(int d0, int ks, int half) { return d0 * 512 + ks * 4096 + half * 2048; }
template <int OFF> __device__ __forceinline__ s16x4 tr_read(int vb) {
  s16x4 r; asm volatile("ds_read_b64_tr_b16 %0, %1 offset:%2" : "=&v"(r) : "v"(vb), "i"(OFF) : "memory"); return r;
}
template <int D0> __device__ __forceinline__ void pv_one(f32x16& od, int vb, bf16x8 pa0, bf16x8 pa1, bf16x8 pa2, bf16x8 pa3) {
  const s16x4 l0 = tr_read<v_rd_off(D0, 0, 0)>(vb), h0 = tr_read<v_rd_off(D0, 0, 1)>(vb), l1 = tr_read<v_rd_off(D0, 1, 0)>(vb), h1 = tr_read<v_rd_off(D0, 1, 1)>(vb);
  const s16x4 l2 = tr_read<v_rd_off(D0, 2, 0)>(vb), h2 = tr_read<v_rd_off(D0, 2, 1)>(vb), l3 = tr_read<v_rd_off(D0, 3, 0)>(vb), h3 = tr_read<v_rd_off(D0, 3, 1)>(vb);
  asm volatile("s_waitcnt lgkmcnt(0)" ::: "memory"); SBAR();
#define PK(L, H) (bf16x8){L[0], L[1], L[2], L[3], H[0], H[1], H[2], H[3]}
  od = __builtin_amdgcn_mfma_f32_32x32x16_bf16(pa0, PK(l0, h0), od, 0, 0, 0);
  od = __builtin_amdgcn_mfma_f32_32x32x16_bf16(pa1, PK(l1, h1), od, 0, 0, 0);
  od = __builtin_amdgcn_mfma_f32_32x32x16_bf16(pa2, PK(l2, h2), od, 0, 0, 0);
  od = __builtin_amdgcn_mfma_f32_32x32x16_bf16(pa3, PK(l3, h3), od, 0, 0, 0);
#undef PK
}
__device__ __forceinline__ void pv_d0(f32x16* o, int vb, bf16x8 pa0, bf16x8 pa1, bf16x8 pa2, bf16x8 pa3) {
  pv_one<0>(o[0], vb, pa0, pa1, pa2, pa3); pv_one<1>(o[1], vb, pa0, pa1, pa2, pa3); pv_one<2>(o[2], vb, pa0, pa1, pa2, pa3); pv_one<3>(o[3], vb, pa0, pa1, pa2, pa3);
}
__device__ __forceinline__ void attn_unit(const bf16_t* __restrict__ Qb, const bf16_t* __restrict__ KVh, const bf16_t* __restrict__ KPE, bf16_t* __restrict__ Ob,
                                          int ka0, int kb0, int NT, char* lds, int tid_in) {
  const unsigned tid_u = (unsigned)tid_in; __builtin_assume(tid_u < 512u);
  const int tid = (int)tid_u, wid = tid >> 6, lane = tid & 63, r32 = lane & 31, hi = lane >> 5;
  char* V_lds = lds + OFF_V; char* K_lds = lds + OFF_K; char* P_lds = lds + OFF_KP;
  float* ws = (float*)(lds + OFF_WS) + wid * 64; float* li_l = ws; float* al_l = ws + 32;
  float m_reg = -1e30f, l_reg = 0; f32x16 o[4] = {}; bf16x8 qr[4];
  char* Q_lds = lds + OFF_QP; const int qrow = wid * QBLK + r32;
  const bf16_t* Qw = Qb + (long)(wid * QBLK + r32) * LDQ + hi * 8;
#pragma unroll
  for (int d0 = 0; d0 < 4; ++d0) qr[d0] = *reinterpret_cast<const bf16x8*>(Qw + d0 * 16);
#pragma unroll
  for (int d0 = 0; d0 < 8; ++d0) *reinterpret_cast<bf16x8*>(Q_lds + KSWZ(qrow, (d0 * 16 + hi * 8) * 2)) = *reinterpret_cast<const bf16x8*>(Qw + 64 + d0 * 16);
  const int sr = tid >> 4, sc = (tid & 15) * 8, vst0 = v_st(sr, sc), vst1 = v_st(32 + sr, sc);
  const int pr = tid >> 3, pc = (tid & 7) * 8;
  const int vb0 = (int)(uintptr_t)V_lds + v_rd_base(lane);
  struct { bf16x8 vs0, vs1, ks0, ks1, kp; } sr_[SDEPTH];
#define KROW(j) ((j) < 4 ? ka0 + 64 * (j) : kb0 + 64 * ((j) - 4))
#define SLOAD(i, jt) do { const long k0_ = KROW(jt); \
    sr_[i].vs0 = *reinterpret_cast<const bf16x8*>(&KVh[(k0_ + sr) * LDKV + 128 + sc]); sr_[i].vs1 = *reinterpret_cast<const bf16x8*>(&KVh[(k0_ + 32 + sr) * LDKV + 128 + sc]); \
    sr_[i].ks0 = *reinterpret_cast<const bf16x8*>(&KVh[(k0_ + sr) * LDKV + sc]); sr_[i].ks1 = *reinterpret_cast<const bf16x8*>(&KVh[(k0_ + 32 + sr) * LDKV + sc]); \
    sr_[i].kp = *reinterpret_cast<const bf16x8*>(&KPE[(k0_ + pr) * 64 + pc]); } while (0)
#define SWRITE(b, i) do { *(bf16x8*)(V_lds + (b) * SHM_V + vst0) = sr_[i].vs0;          \
    *(bf16x8*)(V_lds + (b) * SHM_V + vst1) = sr_[i].vs1; int kc = sc * 2;               \
    *(bf16x8*)(K_lds + (b) * SHM_K + KSWZ(sr, kc)) = sr_[i].ks0;                       \
    *(bf16x8*)(K_lds + (b) * SHM_K + KSWZ(32 + sr, kc)) = sr_[i].ks1;                  \
    *(bf16x8*)(P_lds + (b) * SHM_KP + KPSWZ(pr, pc * 2)) = sr_[i].kp; } while (0)
#define SWAIT() do { if constexpr (SDEPTH == 2) asm volatile("s_waitcnt vmcnt(5)" ::: "memory"); else asm volatile("s_waitcnt vmcnt(0)" ::: "memory"); } while (0)
#define RESC(a) do { if (__any((a) < 1.f)) { if (hi == 0) al_l[r32] = (a); asm volatile("s_waitcnt lgkmcnt(0)" ::: "memory"); \
    for (int d = 0; d < 4; ++d) for (int r = 0; r < 16; ++r) o[d][r] *= al_l[crow(r, hi)]; } } while (0)
  f32x16 pA0, pA1, pB0, pB1; float mnA, mnB, alA, alB; bf16x8 pa0, pa1, pa2, pa3;
  constexpr int SE = 0, SO = SDEPTH - 1;
  SLOAD(SE, 0); asm volatile("s_waitcnt vmcnt(0)" ::: "memory"); SWRITE(0, SE); __syncthreads();
  qkt(pA0, pA1, K_lds, P_lds, qr, Q_lds, qrow, r32, hi); partialSM(pA0, pA1, m_reg, mnA, alA);
  SLOAD(SO, 1); if constexpr (SDEPTH == 2) { if (2 < NT) SLOAD(SE, 2); }
  SWAIT(); SWRITE(1, SO); __syncthreads();
  for (int j = 1; j + 1 < NT; j += 2) {
    SBAR(); qkt(pB0, pB1, K_lds + SHM_K, P_lds + SHM_KP, qr, Q_lds, qrow, r32, hi);
    finishSM(pA0, pA1, alA, l_reg, pa0, pa1, pa2, pa3); SBAR();
    SLOAD(SO, j + SDEPTH); SBAR();
    pv_d0(o, vb0, pa0, pa1, pa2, pa3); partialSM(pB0, pB1, m_reg, mnB, alB);
    __syncthreads(); SWAIT(); SWRITE(0, SE);
    RESC(alB); __syncthreads();
    SBAR(); qkt(pA0, pA1, K_lds, P_lds, qr, Q_lds, qrow, r32, hi);
    finishSM(pB0, pB1, alB, l_reg, pa0, pa1, pa2, pa3); SBAR();
    if (SDEPTH == 1 || j + 3 < NT) SLOAD(SE, j + 1 + SDEPTH); SBAR();
    pv_d0(o, vb0 + (int)SHM_V, pa0, pa1, pa2, pa3); partialSM(pA0, pA1, m_reg, mnA, alA);
    __syncthreads(); SWAIT(); SWRITE(1, SO);
    RESC(alA); __syncthreads();
  }
  SBAR(); qkt(pB0, pB1, K_lds + SHM_K, P_lds + SHM_KP, qr, Q_lds, qrow, r32, hi);
  finishSM(pA0, pA1, alA, l_reg, pa0, pa1, pa2, pa3); SBAR();
  pv_d0(o, vb0, pa0, pa1, pa2, pa3); partialSM(pB0, pB1, m_reg, mnB, alB);
  __syncthreads(); RESC(alB);
  finishSM(pB0, pB1, alB, l_reg, pa0, pa1, pa2, pa3); SBAR();
  pv_d0(o, vb0 + (int)SHM_V, pa0, pa1, pa2, pa3);
  if (hi == 0) li_l[r32] = l_reg; asm volatile("s_waitcnt lgkmcnt(0)" ::: "memory");
  float rli[16];
#pragma unroll
  for (int r = 0; r < 16; ++r) rli[r] = __builtin_amdgcn_rcpf(li_l[crow(r, hi)]);
  bf16_t* Ow = Ob + (long)(wid * QBLK) * LDO;
#pragma unroll
  for (int r = 0; r < 16; ++r) { int orow = crow(r, hi);
    for (int d0 = 0; d0 < 4; ++d0) Ow[(long)orow * LDO + d0 * 32 + r32] = (bf16_t)f2bf(o[d0][r] * rli[r]); }
  __syncthreads();
#undef KROW
#undef SLOAD
#undef SWRITE
#undef SWAIT
#undef RESC
}
}

__device__ __forceinline__ void phase_attn(Frame& F) {
    const bf16_t* Q = WSP(bf16_t, WS_Q); const bf16_t* KV = WSP(bf16_t, WS_KV); const bf16_t* KPE = WSP(bf16_t, WS_KPE); bf16_t* YA = WSP(bf16_t, WS_Y);
    constexpr int NU = NBATCH * NH_MLA * 32 + NBATCH * NH_MLA;
    for (int u = F.bid; u < NU; u += F.G) {
        int b, h, row0, NT;
        if (u < NBATCH * NH_MLA * 32) { const int bh = u >> 5, qb = u & 31; b = bh >> 3; h = bh & 7; row0 = TC + b * SEQ + qb * 256; NT = 4 + SEQ / 64; }
        else { const int bh = u - NBATCH * NH_MLA * 32; b = bh >> 3; h = bh & 7; row0 = b * CTX; NT = 4; }
        att::attn_unit(Q + (size_t)row0 * 1536 + h * 192, KV + h * 256, KPE, YA + (size_t)row0 * 1024 + h * 128, b * CTX, TC + b * SEQ, NT, (char*)F.lds, F.tid);
    }
}
__device__ __forceinline__ void phase_qrope(Frame& F) {
    bf16_t* Q = WSP(bf16_t, WS_Q);
    for (int row = TC + F.gw; row < T; row += F.NGW) {
        const int t = (row - TC) & (SEQ - 1); const int p = F.lane & 31, axis = p >> 4, j = p & 15, hs = F.lane >> 5;
        const float pos = (float)(axis == 0 ? (t >> 6) : (t & 63)); const float inv = __builtin_amdgcn_exp2f(-(float)j * 0.8304820237218406f);
        const float sn = __sinf(pos * inv), cs = __cosf(pos * inv);
#pragma unroll
        for (int hh = 0; hh < 4; ++hh) { const int h = hh * 2 + hs; bf16_t* q = Q + (size_t)row * 1536 + h * 192 + 128 + axis * 32 + j;
            const float x1 = bf2f(q[0]), x2 = bf2f(q[16]);
            q[0] = (bf16_t)f2bf(x1 * cs - x2 * sn); q[16] = (bf16_t)f2bf(x2 * cs + x1 * sn); }
    }
}

#define MFMA16(a, b, c) __builtin_amdgcn_mfma_f32_16x16x32_bf16((a), (b), (c), 0, 0, 0)
constexpr int XS_LD = 264, BC_LD = 136;
__device__ __forceinline__ float bperm(float v, int srclane) { return __builtin_bit_cast(float, __builtin_amdgcn_ds_bpermute(srclane << 2, __builtin_bit_cast(int, v))); }
__device__ __forceinline__ float wave_incl_scan(float v, int lane) {
#pragma unroll
    for (int o = 1; o < 64; o <<= 1) { const float t = bperm(v, lane - o); if (lane >= o) v += t; }
    return v;
}
__device__ __forceinline__ void stage_tile(LAS bf16_t* dst, int ld, const bf16_t* src, int ncols, int tid) {
    const int cpr = ncols >> 3;
    for (int i = tid; i < 128 * cpr; i += NTHREADS) { const int r = i / cpr, c8 = (i % cpr) * 8; *(LAS u32x4*)(dst + r * ld + c8) = *(const u32x4*)(src + (size_t)r * P2W + c8); }
}
__device__ __forceinline__ void phase_mamba_states(Frame& F, const Args& a, int layer) {
    const bf16_t* P2 = WSP(bf16_t, WS_P2); const float* DT = WSP(float, WS_DT); bf16_t* MST = WSP(bf16_t, WS_MST); float* MCS = WSP(float, WS_MCS);
    LAS bf16_t* XSl = (LAS bf16_t*)F.lds; LAS bf16_t* Bl = (LAS bf16_t*)(F.lds + 67584); LAS float* wt = (LAS float*)(F.lds + 102400) + F.wave * 128;
    const int lane = F.lane, row = lane & 15, quad = lane >> 4;
    for (int u = F.bid; u < NCHUNK * 4; u += F.G) {
        const int chunk = u >> 2, g = (u >> 1) & 1, half = u & 1, row0 = chunk * 128;
        __syncthreads();
        stage_tile(XSl, XS_LD, P2 + (size_t)row0 * P2W + P2_XBC + (g * 8 + half * 4) * 64, 256, F.tid);
        stage_tile(Bl, BC_LD, P2 + (size_t)row0 * P2W + P2_XBC + 1024 + g * 128, 128, F.tid);
        const int hl = F.wave >> 1, d = F.wave & 1, h = g * 8 + half * 4 + hl;
        const float aa = -__expf(arg_in(a, I_SALOG)[(layer * 2 + d) * 16 + h]);
        { const float dt0 = DT[(size_t)(row0 + lane) * 32 + d * 16 + h], dt1 = DT[(size_t)(row0 + 64 + lane) * 32 + d * 16 + h];
          const float da0 = dt0 * aa, da1 = dt1 * aa;
          float c0 = wave_incl_scan(da0, lane); const float tot0 = bperm(c0, 63); float c1 = wave_incl_scan(da1, lane) + tot0; const float tot = bperm(c1, 63);
          if (d == 0) { wt[lane] = dt0 * __expf(tot - c0); wt[64 + lane] = dt1 * __expf(tot - c1); }
          else { wt[lane] = dt0 * __expf(c0 - da0); wt[64 + lane] = dt1 * __expf(c1 - da1); }
          if (lane == 0) MCS[(d * NCHUNK + chunk) * 16 + h] = tot; }
        __syncthreads();
        bf16_t* out = MST + ((size_t)(d * NCHUNK + chunk) * 16 + h) * 8192;
#pragma unroll 1
        for (int nh = 0; nh < 2; ++nh) {
            f32x4 acc[4][4];
#pragma unroll
            for (int i = 0; i < 4; ++i)
#pragma unroll
                for (int j = 0; j < 4; ++j) acc[i][j] = (f32x4){0.f, 0.f, 0.f, 0.f};
#pragma unroll 1
            for (int k0 = 0; k0 < 128; k0 += 32) {
                const int sb = k0 + quad * 8;
                float w8[8];
#pragma unroll
                for (int j = 0; j < 8; ++j) w8[j] = wt[sb + j];
                bf16x8 bf[4];
#pragma unroll
                for (int nt = 0; nt < 4; ++nt) {
#pragma unroll
                    for (int j = 0; j < 8; ++j) bf[nt][j] = (short)Bl[(sb + j) * BC_LD + (nh * 4 + nt) * 16 + row]; }
#pragma unroll
                for (int pt = 0; pt < 4; ++pt) { bf16x8 af;
#pragma unroll
                    for (int j = 0; j < 8; ++j) af[j] = (short)f2bf(w8[j] * bf2f(XSl[(sb + j) * XS_LD + hl * 64 + pt * 16 + row]));
#pragma unroll
                    for (int nt = 0; nt < 4; ++nt) acc[pt][nt] = MFMA16(af, bf[nt], acc[pt][nt]); }
            }
#pragma unroll
            for (int pt = 0; pt < 4; ++pt)
#pragma unroll
                for (int nt = 0; nt < 4; ++nt)
#pragma unroll
                    for (int jj = 0; jj < 4; ++jj) out[(pt * 16 + quad * 4 + jj) * 128 + (nh * 4 + nt) * 16 + row] = (bf16_t)f2bf(acc[pt][nt][jj]);
        }
    }
}
__device__ __forceinline__ void phase_mamba_scan(Frame& F) {
    bf16_t* MST = WSP(bf16_t, WS_MST); const float* MCS = WSP(float, WS_MCS);
    for (int idx = F.bid * NTHREADS + F.tid; idx < 2 * 2 * 16 * 8192; idx += F.G * NTHREADS) {
        const int e = idx & 8191, h = (idx >> 13) & 15, b = (idx >> 17) & 1, d = idx >> 18;
        float state = 0.f;
#pragma unroll 6
        for (int i = 0; i < 66; ++i) {
            int chunk; if (i < 2) chunk = 2 * b + (d == 0 ? i : 1 - i); else chunk = 4 + 64 * b + (d == 0 ? i - 2 : 65 - i);
            bf16_t* p = MST + ((size_t)(d * NCHUNK + chunk) * 16 + h) * 8192 + e;
            const float cs = bf2f(*p); const float dec = __expf(MCS[(d * NCHUNK + chunk) * 16 + h]);
            *p = (bf16_t)f2bf(state);
            state = state * dec + cs;
        }
    }
}
__device__ __forceinline__ void phase_mamba_out(Frame& F, const Args& a, int layer) {
    const bf16_t* P = WSP(bf16_t, WS_P); const bf16_t* P2 = WSP(bf16_t, WS_P2); const float* DT = WSP(float, WS_DT); const bf16_t* MST = WSP(bf16_t, WS_MST);
    bf16_t* YB = WSP(bf16_t, WS_Y) + (size_t)1 * T * 1024;
    LAS bf16_t* Cl = (LAS bf16_t*)F.lds; LAS bf16_t* Bl = (LAS bf16_t*)(F.lds + 34816); LAS bf16_t* XSl = (LAS bf16_t*)(F.lds + 69632);
    LAS float* tab = (LAS float*)(F.lds + 137216);
    const int lane = F.lane, row = lane & 15, quad = lane >> 4;
    for (int u = F.bid; u < NCHUNK * 4; u += F.G) {
        const int chunk = u >> 2, g = (u >> 1) & 1, half = u & 1, row0 = chunk * 128;
        __syncthreads();
        stage_tile(XSl, XS_LD, P2 + (size_t)row0 * P2W + P2_XBC + (g * 8 + half * 4) * 64, 256, F.tid);
        stage_tile(Bl, BC_LD, P2 + (size_t)row0 * P2W + P2_XBC + 1024 + g * 128, 128, F.tid);
        stage_tile(Cl, BC_LD, P2 + (size_t)row0 * P2W + P2_XBC + 1280 + g * 128, 128, F.tid);
        float tot1 = 0.f;
        { const int hl = F.wave >> 1, d = F.wave & 1, h = g * 8 + half * 4 + hl;
          const float aa = -__expf(arg_in(a, I_SALOG)[(layer * 2 + d) * 16 + h]);
          const float dt0 = DT[(size_t)(row0 + lane) * 32 + d * 16 + h], dt1 = DT[(size_t)(row0 + 64 + lane) * 32 + d * 16 + h];
          const float da0 = dt0 * aa, da1 = dt1 * aa;
          float c0 = wave_incl_scan(da0, lane); const float t0 = bperm(c0, 63); float c1 = wave_incl_scan(da1, lane) + t0;
          LAS float* tb = tab + hl * 512;
          if (d == 0) { tb[lane] = c0; tb[64 + lane] = c1; tb[256 + lane] = __logf(dt0) - c0; tb[320 + lane] = __logf(dt1) - c1; }
          else { tb[128 + lane] = c0 - da0; tb[192 + lane] = c1 - da1; tb[384 + lane] = (c0 - da0) + __logf(dt0); tb[448 + lane] = (c1 - da1) + __logf(dt1); if (lane == 63) tab[2048 + hl] = c1; } }
        __syncthreads();
        { f32x4 cb[8];
#pragma unroll
          for (int st = 0; st < 8; ++st) cb[st] = (f32x4){0.f, 0.f, 0.f, 0.f};
#pragma unroll
          for (int k0 = 0; k0 < 128; k0 += 32) { const bf16x8 af = *(const LAS bf16x8*)(Cl + (F.wave * 16 + row) * BC_LD + k0 + quad * 8);
#pragma unroll
              for (int st = 0; st < 8; ++st) { const bf16x8 bfr = *(const LAS bf16x8*)(Bl + (st * 16 + row) * BC_LD + k0 + quad * 8); cb[st] = MFMA16(af, bfr, cb[st]); } }
          __syncthreads();
#pragma unroll
          for (int st = 0; st < 8; ++st)
#pragma unroll
              for (int jj = 0; jj < 4; ++jj) Bl[(F.wave * 16 + quad * 4 + jj) * BC_LD + st * 16 + row] = (bf16_t)f2bf(cb[st][jj]); }
        __syncthreads();
        const int hl = F.wave >> 1, th = F.wave & 1, h = g * 8 + half * 4 + hl;
        const LAS float* tb = tab + hl * 512; tot1 = tab[2048 + hl];
        f32x4 acc[4][4];
#pragma unroll
        for (int i = 0; i < 4; ++i)
#pragma unroll
            for (int j = 0; j < 4; ++j) acc[i][j] = (f32x4){0.f, 0.f, 0.f, 0.f};
#pragma unroll 1
        for (int k0 = 0; k0 < 128; k0 += 32) {
            const int sb = k0 + quad * 8;
            float u0s[8], u1s[8];
#pragma unroll
            for (int j = 0; j < 8; ++j) { u0s[j] = tb[256 + sb + j]; u1s[j] = tb[384 + sb + j]; }
            bf16x8 bx[4];
#pragma unroll
            for (int pt = 0; pt < 4; ++pt) {
#pragma unroll
                for (int j = 0; j < 8; ++j) bx[pt][j] = (short)XSl[(sb + j) * XS_LD + hl * 64 + pt * 16 + row]; }
#pragma unroll
            for (int tt = 0; tt < 4; ++tt) { const int t = th * 64 + tt * 16 + row; const float c0t = tb[t], e1t = tb[128 + t];
                float cbv[8]; { const u32x4 w = *(const LAS u32x4*)(Bl + t * BC_LD + sb); cbv[0] = bflo(w.x); cbv[1] = bfhi(w.x); cbv[2] = bflo(w.y); cbv[3] = bfhi(w.y); cbv[4] = bflo(w.z); cbv[5] = bfhi(w.z); cbv[6] = bflo(w.w); cbv[7] = bfhi(w.w); }
                bf16x8 af;
#pragma unroll
                for (int j = 0; j < 8; ++j) { const int s = sb + j;
                    const float f0 = s <= t ? __expf(c0t + u0s[j]) : 0.f;
                    const float f1 = s >= t ? __expf(u1s[j] - e1t) : 0.f;
                    af[j] = (short)f2bf(cbv[j] * (f0 + f1)); }
#pragma unroll
                for (int pt = 0; pt < 4; ++pt) acc[tt][pt] = MFMA16(af, bx[pt], acc[tt][pt]); }
        }
#pragma unroll 1
        for (int d = 0; d < 2; ++d) {
            const bf16_t* S = MST + ((size_t)(d * NCHUNK + chunk) * 16 + h) * 8192;
#pragma unroll 1
            for (int k0 = 0; k0 < 128; k0 += 32) {
                bf16x8 bs[4];
#pragma unroll
                for (int pt = 0; pt < 4; ++pt) bs[pt] = *(const bf16x8*)(S + (pt * 16 + row) * 128 + k0 + quad * 8);
#pragma unroll
                for (int tt = 0; tt < 4; ++tt) { const int t = th * 64 + tt * 16 + row;
                    const float sc = d == 0 ? __expf(tb[t]) : __expf(tot1 - tb[128 + t]);
                    const u32x4 cw = *(const LAS u32x4*)(Cl + t * BC_LD + k0 + quad * 8);
                    u32x4 aw; aw.x = cvt_pk_bf16(bflo(cw.x) * sc, bfhi(cw.x) * sc); aw.y = cvt_pk_bf16(bflo(cw.y) * sc, bfhi(cw.y) * sc);
                    aw.z = cvt_pk_bf16(bflo(cw.z) * sc, bfhi(cw.z) * sc); aw.w = cvt_pk_bf16(bflo(cw.w) * sc, bfhi(cw.w) * sc);
                    const bf16x8 af = __builtin_bit_cast(bf16x8, aw);
#pragma unroll
                    for (int pt = 0; pt < 4; ++pt) acc[tt][pt] = MFMA16(af, bs[pt], acc[tt][pt]); } }
        }
        const float Dh = arg_in(a, I_SD)[layer * 16 + h];
#pragma unroll
        for (int tt = 0; tt < 4; ++tt)
#pragma unroll
            for (int jj = 0; jj < 4; ++jj) { const int t = th * 64 + tt * 16 + quad * 4 + jj; const size_t r = (size_t)(row0 + t);
#pragma unroll
                for (int pt = 0; pt < 4; ++pt) { const int p = pt * 16 + row;
                    const float xs = bf2f(XSl[t * XS_LD + hl * 64 + p]); const float z = bf2f(P[r * NNG + P_Z + h * 64 + p]);
                    YB[r * 1024 + h * 64 + p] = (bf16_t)f2bf((acc[tt][pt][jj] + xs * Dh) * siluf_(z)); } }
    }
}
__device__ __forceinline__ void phase_mamba_norm(Frame& F, const Args& a, int layer) {
    bf16_t* YB = WSP(bf16_t, WS_Y) + (size_t)1 * T * 1024; const float* nw = arg_in(a, I_SNORM) + layer * 1024;
    for (int row = F.gw; row < T; row += F.NGW) {
        bf16_t* p = YB + (size_t)row * 1024 + F.lane * 16; float x[16]; { float t0[8], t1[8]; ld8bf(p, t0); ld8bf(p + 8, t1);
#pragma unroll
            for (int i = 0; i < 8; ++i) { x[i] = t0[i]; x[8 + i] = t1[i]; } }
        float s = 0.f;
#pragma unroll
        for (int i = 0; i < 16; ++i) s += x[i] * x[i];
        s = sum32(s);
        const float r = 1.f / sqrtf(s * (1.f / 512.f) + 1e-5f);
        float o0[8], o1[8];
#pragma unroll
        for (int i = 0; i < 8; ++i) { o0[i] = x[i] * r * nw[F.lane * 16 + i]; o1[i] = x[8 + i] * r * nw[F.lane * 16 + 8 + i]; }
        st8bf(p, o0); st8bf(p + 8, o1);
    }
}

__device__ __forceinline__ float dpp_f(float x, const int ctrl_sel) {
    const int xi = __builtin_bit_cast(int, x); int r;
    if (ctrl_sel == 0) r = __builtin_amdgcn_update_dpp(0, xi, 0xB1, 0xF, 0xF, false);
    else if (ctrl_sel == 1) r = __builtin_amdgcn_update_dpp(0, xi, 0x4E, 0xF, 0xF, false);
    else r = __builtin_amdgcn_update_dpp(0, xi, 0x141, 0xF, 0xF, false);
    return __builtin_bit_cast(float, r);
}
__device__ __forceinline__ float red8(float x) { x += dpp_f(x, 0); x += dpp_f(x, 1); x += dpp_f(x, 2); return x; }
__device__ __forceinline__ int rw_row(int pos, int b, int d) { return pos < CTX ? b * CTX + (d == 0 ? pos : CTX - 1 - pos) : TC + b * SEQ + (d == 0 ? pos - CTX : SEQ - 1 - (pos - CTX)); }
constexpr int RW_STEP_F = 336, RW_CH = 32, RW_CHF = RW_STEP_F * RW_CH;
struct RwOps { f32x4 w, k, b, a, r; float v; };
__device__ __forceinline__ void rw_load(RwOps& o, const LAS float* sp, const LAS float* vp) {
    o.w = *(const LAS f32x4*)(sp); o.k = *(const LAS f32x4*)(sp + 64); o.b = *(const LAS f32x4*)(sp + 128); o.a = *(const LAS f32x4*)(sp + 192); o.r = *(const LAS f32x4*)(sp + 256); o.v = *vp;
}
__device__ __forceinline__ void rw_step(f32x4& s, const RwOps& o, LAS float* yp) {
    const f32x4 tt = s * o.w + o.k * o.v;
    const f32x4 pa = s * o.a; float sa = (pa.x + pa.y) + (pa.z + pa.w); sa = sum16(sa);
    s = tt + o.b * sa;
    const f32x4 pr = s * o.r; *yp = (pr.x + pr.y) + (pr.z + pr.w);
}
struct RwRaw { float ew[8], ic[8], kk[8], rr[8], kr[8], vv[8]; };
__device__ __forceinline__ void phase_rwkv_scan(Frame& F, const Args& a, int layer) {
    const bf16_t* P2 = WSP(bf16_t, WS_P2); const bf16_t* EW = WSP(bf16_t, WS_EW); const bf16_t* ICLR = WSP(bf16_t, WS_ICLR); const bf16_t* KK = WSP(bf16_t, WS_KK);
    bf16_t* YRW = WSP(bf16_t, WS_YRW);
    LAS float* ring = (LAS float*)F.lds; LAS float* ybuf = (LAS float*)(F.lds + 2 * RW_CHF * 4);
    const int lane = F.lane;
    for (int u = F.bid; u < 256; u += F.G) {
        const int chain = u >> 2, rq = u & 3, d = chain >> 5, b = (chain >> 4) & 1, h = chain & 15;
        const float ka = arg_in(a, I_RKA)[layer * 1024 + h * 64 + lane];
        constexpr int NCH = (CTX + SEQ) / RW_CH;
        const int lw = F.wave - 4;
        auto issue = [&](RwRaw& x, int cidx) {
            const int row0 = rw_row(cidx * RW_CH, b, d), st = d == 0 ? 1 : -1;
            const int o0 = (row0 + st * lw) * 1024 + h * 64 + lane, ostep = st * 4 * 1024;
            const int q0 = (row0 + st * lw) * P2W + P2_RKV + h * 64 + lane, qstep = st * 4 * P2W;
            const bf16_t* ewp = EW + (size_t)d * T * 1024; const bf16_t* icp = ICLR + (size_t)d * T * 1024; const int vo = 2048 + rq * 16 + (lane & 15) - lane;
#pragma unroll
            for (int j = 0; j < 8; ++j) { const int o = o0 + j * ostep, q = q0 + j * qstep;
                x.ew[j] = bf2f(ewp[o]); x.ic[j] = bf2f(icp[o]); x.kk[j] = bf2f(KK[o]);
                x.rr[j] = bf2f(P2[q]); x.kr[j] = bf2f(P2[q + 1024]); x.vv[j] = bf2f(P2[q + vo]); } };
        auto commit = [&](const RwRaw& x, int cidx) {
            LAS float* dst = ring + (cidx & 1) * RW_CHF;
#pragma unroll
            for (int j = 0; j < 8; ++j) { LAS float* s = dst + (lw + 4 * j) * RW_STEP_F;
                s[lane] = __expf(-x.ew[j]); s[64 + lane] = x.kr[j] * (1.f + (x.ic[j] - 1.f) * ka); s[128 + lane] = x.kk[j] * x.ic[j]; s[192 + lane] = -x.kk[j]; s[256 + lane] = x.rr[j];
                if (lane < 16) s[320 + lane] = x.vv[j]; } };
        auto flush_chunk = [&](int cidx) {
            const LAS float* yb = ybuf + (cidx & 1) * (RW_CH * 256);
            const int row0 = rw_row(cidx * RW_CH, b, d), st = d == 0 ? 1 : -1;
#pragma unroll
            for (int q = 0; q < 2; ++q) { const int i = (F.tid - 256) + 256 * q, tok = i >> 4, rr = i & 15; const LAS f32x4* pp = (const LAS f32x4*)(yb + i * 16);
                const f32x4 p0 = pp[0], p1 = pp[1], p2 = pp[2], p3 = pp[3];
                const float y = ((p0.x + p0.y) + (p0.z + p0.w)) + ((p1.x + p1.y) + (p1.z + p1.w)) + (((p2.x + p2.y) + (p2.z + p2.w)) + ((p3.x + p3.y) + (p3.z + p3.w)));
                YRW[((size_t)d * T + row0 + st * tok) * 1024 + h * 64 + rq * 16 + rr] = (bf16_t)f2bf(y); } };
        auto compute = [&](f32x4& s, int c) {
            const int rloc = lane >> 4, kq = lane & 15, r16 = F.wave * 4 + rloc;
            const LAS float* base = ring + (c & 1) * RW_CHF + kq * 4; const LAS float* vb = ring + (c & 1) * RW_CHF + 320 + r16; LAS float* yb = ybuf + (c & 1) * (RW_CH * 256) + r16 * 16 + kq;
            RwOps oa, ob;
            rw_load(oa, base, vb);
#pragma unroll 2
            for (int t = 0; t < RW_CH; t += 2) {
                rw_load(ob, base + (t + 1) * RW_STEP_F, vb + (t + 1) * RW_STEP_F);
                rw_step(s, oa, yb + t * 256);
                if (t + 2 < RW_CH) rw_load(oa, base + (t + 2) * RW_STEP_F, vb + (t + 2) * RW_STEP_F);
                rw_step(s, ob, yb + (t + 1) * 256);
            } };
        __syncthreads();
        f32x4 s = {0.f, 0.f, 0.f, 0.f};
        if (F.wave >= 4) {
            RwRaw ra, rb;
            issue(ra, 0); commit(ra, 0); issue(ra, 1);
            __syncthreads();
            for (int c = 0; c < NCH; c += 2) {
                if (c + 2 < NCH) issue(rb, c + 2);
                if (c > 0) flush_chunk(c - 1);
                commit(ra, c + 1);
                __syncthreads();
                if (c + 3 < NCH) issue(ra, c + 3);
                flush_chunk(c);
                if (c + 2 < NCH) commit(rb, c + 2);
                __syncthreads();
            }
            flush_chunk(NCH - 1);
        } else {
            __syncthreads();
            for (int c = 0; c < NCH; c += 2) { compute(s, c); __syncthreads(); compute(s, c + 1); __syncthreads(); }
        }
    }
}
__device__ __forceinline__ void phase_rwkv_out(Frame& F, const Args& a, int layer) {
    const bf16_t* P2 = WSP(bf16_t, WS_P2); const bf16_t* ICLR = WSP(bf16_t, WS_ICLR); const bf16_t* YRW = WSP(bf16_t, WS_YRW); const bf16_t* GG = WSP(bf16_t, WS_GG);
    bf16_t* YD = WSP(bf16_t, WS_Y) + (size_t)3 * T * 1024;
    const float* lng = arg_in(a, I_RLNG) + layer * 1024; const float* lnb = arg_in(a, I_RLNB) + layer * 1024; const float* rk = arg_in(a, I_RRK) + layer * 1024; const float* kav = arg_in(a, I_RKA) + layer * 1024;
    for (int row = F.gw; row < T; row += F.NGW) {
        const int c = F.lane * 16; const size_t o = (size_t)row * 1024 + c;
        float y[16], r[16], k[16], v[16], i0[16], i1[16], g[16];
#define LD16(dst, ptr) do { float t0_[8], t1_[8]; ld8bf((ptr), t0_); ld8bf((ptr) + 8, t1_); _Pragma("unroll") for (int i_ = 0; i_ < 8; ++i_) { dst[i_] = t0_[i_]; dst[8 + i_] = t1_[i_]; } } while (0)
        LD16(y, YRW + o); LD16(r, YRW + (size_t)T * 1024 + o);
#pragma unroll
        for (int i = 0; i < 16; ++i) y[i] += r[i];
        const bf16_t* p2 = P2 + (size_t)row * P2W + P2_RKV + c;
        LD16(r, p2); LD16(k, p2 + 1024); LD16(v, p2 + 2048); LD16(i0, ICLR + o); LD16(i1, ICLR + (size_t)T * 1024 + o); LD16(g, GG + o);
#undef LD16
        float s = 0.f, bsum = 0.f;
#pragma unroll
        for (int i = 0; i < 16; ++i) { s += y[i]; const float ka = kav[c + i]; bsum += r[i] * k[i] * rk[c + i] * ((1.f + (i0[i] - 1.f) * ka) + (1.f + (i1[i] - 1.f) * ka)); }
        s = sum4(s); bsum = sum4(bsum);
        const float mu = s * (1.f / 64.f); float q = 0.f;
#pragma unroll
        for (int i = 0; i < 16; ++i) { const float dd = y[i] - mu; q += dd * dd; }
        q = sum4(q);
        const float rstd = 1.f / sqrtf(q * (1.f / 64.f) + 64e-5f);
        float o0[8], o1[8];
#pragma unroll
        for (int i = 0; i < 8; ++i) { o0[i] = ((y[i] - mu) * rstd * lng[c + i] + lnb[c + i] + bsum * v[i]) * g[i];
            o1[i] = ((y[8 + i] - mu) * rstd * lng[c + 8 + i] + lnb[c + 8 + i] + bsum * v[8 + i]) * g[8 + i]; }
        st8bf(YD + o, o0); st8bf(YD + o + 8, o1);
    }
}

constexpr int FFT_N = 16384;
__device__ __forceinline__ int fswz(int i) { return i ^ (((i >> 5) & 3) << 2) ^ (((i >> 6) & 1) << 4); }
__device__ __forceinline__ f32x2 cmul(f32x2 a, f32x2 b) { return (f32x2){a.x * b.x - a.y * b.y, a.x * b.y + a.y * b.x}; }
template <bool INV>
__device__ __forceinline__ void fft_passes(LAS f32x2* X, int tid) {
#pragma unroll 1
    for (int st = 0; st < 7; ++st) {
        const int lq = INV ? 2 * st : 12 - 2 * st;
        const int q = 1 << lq;
        __syncthreads();
#pragma unroll 2
        for (int mm = 0; mm < 8; ++mm) { const int uu = tid + 512 * mm; const int k = uu & (q - 1), blk = uu >> lq; const int i0 = (blk << (lq + 2)) + k;
            const int p0 = fswz(i0), p1 = fswz(i0 + q), p2 = fswz(i0 + 2 * q), p3 = fswz(i0 + 3 * q);
            f32x2 a0 = X[p0], a1 = X[p1], a2 = X[p2], a3 = X[p3];
            const float fr = (float)k / (float)(4 * q);
            const float cs = __builtin_amdgcn_cosf(fr), sn = __builtin_amdgcn_sinf(fr);
            const f32x2 w1 = INV ? (f32x2){cs, sn} : (f32x2){cs, -sn}; const f32x2 w2 = cmul(w1, w1), w3 = cmul(w2, w1);
            if (!INV) {
                const f32x2 t0 = a0 + a2, t1 = a0 - a2, t2 = a1 + a3, t3 = a1 - a3;
                const f32x2 b0 = t0 + t2, b2 = t0 - t2, b1 = (f32x2){t1.x + t3.y, t1.y - t3.x}, b3 = (f32x2){t1.x - t3.y, t1.y + t3.x};
                X[p0] = b0; X[p1] = cmul(b1, w1); X[p2] = cmul(b2, w2); X[p3] = cmul(b3, w3);
            } else {
                a1 = cmul(a1, w1); a2 = cmul(a2, w2); a3 = cmul(a3, w3);
                const f32x2 u0 = a0 + a2, u1 = a0 - a2, u2 = a1 + a3, u3 = a1 - a3;
                X[p0] = u0 + u2; X[p2] = u0 - u2; X[p1] = (f32x2){u1.x - u3.y, u1.y + u3.x}; X[p3] = (f32x2){u1.x + u3.y, u1.y - u3.x};
            } }
    }
    __syncthreads();
}
__device__ __forceinline__ void phase_hyena_fft(Frame& F, const Args& a, int layer, bool dry = false) {
    const bf16_t* FILT = WSP(bf16_t, WS_FILT); float* VT = WSP(float, WS_VT); const float* hyd = arg_in(a, I_HD) + layer * 1024;
    LAS f32x2* X = (LAS f32x2*)F.lds;
    for (int c = F.bid; c < 1024; c += F.G) {
        __syncthreads();
        const bf16_t* hf = FILT + (size_t)c * 2 * SEQ; const bf16_t* hb = hf + SEQ;
        for (int i = F.tid; i < FFT_N; i += NTHREADS) { float v; if (i < SEQ) v = bf2f(hf[i]); else if (i == SEQ) v = 0.f; else v = bf2f(hb[FFT_N - i]); X[fswz(i)] = (f32x2){v, 0.f}; }
        fft_passes<false>(X, F.tid);
        f32x2 Kh[32];
#pragma unroll
        for (int j = 0; j < 32; ++j) Kh[j] = X[fswz(F.tid + 512 * j)];
        __syncthreads();
        const float* v0 = VT + (size_t)c * 2 * SEQ; const float* v1 = v0 + SEQ;
        for (int i = F.tid; i < FFT_N; i += NTHREADS) X[fswz(i)] = i < SEQ ? (f32x2){v0[i], v1[i]} : (f32x2){0.f, 0.f};
        fft_passes<false>(X, F.tid);
#pragma unroll
        for (int j = 0; j < 32; ++j) { const int p = fswz(F.tid + 512 * j); X[p] = cmul(X[p], Kh[j]); }
        fft_passes<true>(X, F.tid);
        const float dc = hyd[c]; float* o0 = VT + (size_t)c * 2 * SEQ; float* o1 = o0 + SEQ;
        for (int i = F.tid; i < SEQ; i += NTHREADS) { const f32x2 r = X[fswz(i)]; const float x0 = o0[i], x1 = o1[i];
            if (!dry) { o0[i] = r.x * (1.f / FFT_N) + x0 * dc; o1[i] = r.y * (1.f / FFT_N) + x1 * dc; } }
    }
}
__device__ __forceinline__ void phase_hyena_out(Frame& F, const Args& a, int layer) {
    const float* VT = WSP(float, WS_VT); const bf16_t* P2 = WSP(bf16_t, WS_P2); bf16_t* YC = WSP(bf16_t, WS_Y) + (size_t)2 * T * 1024;
    LAS float* tl = (LAS float*)F.lds;
    for (int u = F.bid; u < (TL / 64) * 4; u += F.G) {
        const int tb = u >> 2, cb = u & 3; const int row0 = TC + tb * 64; const int b = (row0 - TC) >> 13, t0 = (row0 - TC) & (SEQ - 1);
        __syncthreads();
        for (int p = 0; p < 8; ++p) { const int cl = p * 32 + (F.tid >> 4), q = F.tid & 15;
            const f32x4 v = *(const f32x4*)(VT + ((size_t)(cb * 256 + cl) * 2 + b) * SEQ + t0 + 4 * q);
            tl[cl * 65 + 4 * q] = v.x; tl[cl * 65 + 4 * q + 1] = v.y; tl[cl * 65 + 4 * q + 2] = v.z; tl[cl * 65 + 4 * q + 3] = v.w; }
        __syncthreads();
        const int cl = F.tid & 255, th = F.tid >> 8;
        for (int i = 0; i < 32; ++i) { const int tl_ = th * 32 + i; const size_t row = (size_t)(row0 + tl_);
            const float x0 = bf2f(P2[row * P2W + P2_X0 + cb * 256 + cl]);
            YC[row * 1024 + cb * 256 + cl] = (bf16_t)f2bf(tl[cl * 65 + tl_] * x0); }
    }
    const float* VC = WSP(float, WS_VC); const float* FC = WSP(float, WS_FILTC); const float* hyd = arg_in(a, I_HD) + layer * 1024;
    for (int it = F.gw; it < 2 * 16 * 16; it += F.NGW) {
        const int b = it >> 8, cbk = (it >> 4) & 15, tb = it & 15; const int c = cbk * 64 + F.lane, t0 = tb * 16;
        const float* vb = VC + (size_t)b * CTX * 1024 + c; const float* fc = FC + c;
        float acc[16];
#pragma unroll
        for (int i = 0; i < 16; ++i) acc[i] = 0.f;
#pragma unroll 1
        for (int sb = 0; sb < 16; ++sb) { const int s0 = sb * 16, dl = t0 - s0;
            float f[31], v[16];
#pragma unroll
            for (int j = 0; j < 31; ++j) { const int lag = dl + j - 15; f[j] = lag >= 0 ? fc[(size_t)lag * 2048] : fc[(size_t)(-lag) * 2048 + 1024]; }
#pragma unroll
            for (int j = 0; j < 16; ++j) v[j] = vb[(size_t)(s0 + j) * 1024];
#pragma unroll
            for (int i = 0; i < 16; ++i)
#pragma unroll
                for (int j = 0; j < 16; ++j) acc[i] += f[i - j + 15] * v[j]; }
#pragma unroll
        for (int i = 0; i < 16; ++i) { const int t = t0 + i; const size_t row = (size_t)(b * CTX + t);
            const float x0 = bf2f(P2[row * P2W + P2_X0 + c]);
            YC[row * 1024 + c] = (bf16_t)f2bf((acc[i] + vb[(size_t)t * 1024] * hyd[c]) * x0); }
    }
}

__device__ __forceinline__ void phase_ln1(Frame& F, const Args& a, int layer) {
    const float* mod = (const float*)(F.ws + WS_CTL) + CW_MOD + (size_t)layer * 3 * 6 * DM;
    const float* YM = WSP(float, WS_YMIX); float* XS = WSP(float, WS_XS); unsigned* H2 = WSP(unsigned, WS_H2); float* AFF = WSP(float, WS_AFF); int* INV = WSP(int, WS_INV);
    const float* g1w = arg_in(a, I_LN1G) + layer * DM; const float* b1w = arg_in(a, I_LN1B) + layer * DM; const float* wr = arg_in(a, I_WROUTER) + (size_t)layer * DM * NEXP;
    LAS float* wrT = (LAS float*)F.lds;
    __syncthreads();
    for (int i = F.tid; i < DM * NEXP; i += NTHREADS) { const int c = i >> 4, e = i & 15; wrT[e * DM + c] = wr[i]; }
    __syncthreads();
    int* PTOK = WSP(int, WS_PTOK); float* PG = WSP(float, WS_PGATE);
    for (int i = F.bid * NTHREADS + F.tid; i < NPAIR; i += F.G * NTHREADS) { PTOK[i] = -1; PG[i] = 0.f; }
    for (int row = F.gw; row < T; row += F.NGW) {
        const f32x4* xr = (const f32x4*)x_src_row(a, F, layer, row) + F.lane; const f32x4* yr = (const f32x4*)(YM + (size_t)row * DM) + F.lane;
        const float* m = mod + (size_t)row_modidx(row) * 6 * DM;
        f32x4 v[8];
#pragma unroll
        for (int j = 0; j < 8; ++j) { const int c = 4 * (64 * j + F.lane); v[j] = xr[64 * j] * ALPHA + *(const f32x4*)(m + 2 * DM + c) * yr[64 * j]; }
        float mean, rstd; row_stats(v, mean, rstd, 1e-6f);
        f32x4* xo = (f32x4*)(XS + (size_t)row * DM) + F.lane;
#pragma unroll
        for (int j = 0; j < 8; ++j) { const int c = 4 * (64 * j + F.lane); v[j] = (v[j] - mean) * rstd * *(const f32x4*)(g1w + c) + *(const f32x4*)(b1w + c); xo[64 * j] = v[j]; }
        row_stats(v, mean, rstd, 1e-6f);
        unsigned* ho = H2 + (size_t)row * (DM / 4) + F.lane;
        float lg[16];
#pragma unroll
        for (int e = 0; e < 16; ++e) lg[e] = 0.f;
#pragma unroll
        for (int j = 0; j < 8; ++j) { const int c = 4 * (64 * j + F.lane);
            const f32x4 y = (v[j] - mean) * rstd * (*(const f32x4*)(m + 4 * DM + c) + 1.f) + *(const f32x4*)(m + 3 * DM + c);
            ho[64 * j] = pk4fp8(y.x, y.y, y.z, y.w);
#pragma unroll
            for (int e = 0; e < 16; ++e) { const f32x4 ww = *(const LAS f32x4*)(wrT + e * DM + c); lg[e] += (y.x * ww.x + y.y * ww.y) + (y.z * ww.z + y.w * ww.w); } }
        float mx = -1e30f;
#pragma unroll
        for (int e = 0; e < 16; ++e) { lg[e] = wave_sum(lg[e]); mx = fmaxf(mx, lg[e]); }
        float den = 0.f;
#pragma unroll
        for (int e = 0; e < 16; ++e) { lg[e] = __expf(lg[e] - mx); den += lg[e]; }
        float mine = 0.f;
#pragma unroll
        for (int e = 0; e < 16; ++e) mine = (F.lane == e) ? lg[e] : mine;
        if (F.lane < 16) { AFF[(size_t)row * 16 + F.lane] = mine / den; INV[(size_t)row * 16 + F.lane] = -1; }
    }
}
__device__ __forceinline__ void phase_topk(Frame& F) {
    const float* AFF = WSP(float, WS_AFF); int* INV = WSP(int, WS_INV); int* PTOK = WSP(int, WS_PTOK); float* PG = WSP(float, WS_PGATE);
    LAS unsigned* vals = (LAS unsigned*)F.lds; LAS unsigned* hist = vals + 8192; LAS unsigned* ctl = hist + 256;
    for (int u = F.bid; u < 64; u += F.G) {
        const int s = u >> 4, e = u & 15, rs = seg_start(s), n = seg_len(s), cap = s < 2 ? CAP_C : CAP_L;
        __syncthreads();
        for (int i = F.tid; i < n; i += NTHREADS) vals[i] = __builtin_bit_cast(unsigned, AFF[(size_t)(rs + i) * 16 + e]);
        if (F.tid == 0) { ctl[0] = 0u; ctl[1] = (unsigned)cap; ctl[2] = 0u; ctl[3] = 0u; }
        unsigned mask = 0u;
        for (int shift = 24; shift >= 0; shift -= 8) {
            if (F.tid < 256) hist[F.tid] = 0u;
            __syncthreads();
            const unsigned prefix = ctl[0];
            for (int i = F.tid; i < n; i += NTHREADS) { const unsigned b = vals[i]; if ((b & mask) == prefix) __hip_atomic_fetch_add(&hist[(b >> shift) & 255u], 1u, __ATOMIC_RELAXED, __HIP_MEMORY_SCOPE_WORKGROUP); }
            __syncthreads();
            if (F.tid == 0) { unsigned rem = ctl[1], cum = 0u; int dg = 255; for (; dg > 0; --dg) { const unsigned hc = hist[dg]; if (cum + hc >= rem) break; cum += hc; }
                ctl[1] = rem - cum; ctl[0] = prefix | ((unsigned)dg << shift); }
            mask |= 255u << shift;
            __syncthreads();
        }
        const unsigned thr = ctl[0], rem = ctl[1]; const unsigned ngt = (unsigned)cap - rem;
        const int pbase = s < 2 ? NBATCH * NEXP * CAP_L + e * 256 + s * CAP_C : ((s - 2) * NEXP + e) * CAP_L;
        for (int i = F.tid; i < n; i += NTHREADS) { const unsigned b = vals[i]; int slot = -1;
            if (b > thr) slot = (int)__hip_atomic_fetch_add(&ctl[2], 1u, __ATOMIC_RELAXED, __HIP_MEMORY_SCOPE_WORKGROUP);
            else if (b == thr) { const unsigned q = __hip_atomic_fetch_add(&ctl[3], 1u, __ATOMIC_RELAXED, __HIP_MEMORY_SCOPE_WORKGROUP); if (q < rem) slot = (int)(ngt + q); }
            if (slot >= 0) { const int pair = pbase + slot, row = rs + i; PTOK[pair] = row; PG[pair] = __builtin_bit_cast(float, b); INV[(size_t)row * 16 + e] = pair; } }
    }
}
__device__ __forceinline__ void phase_gather(Frame& F) {
    const unsigned char* H2 = WSP(unsigned char, WS_H2); unsigned char* XG = WSP(unsigned char, WS_XG); unsigned char* HID = WSP(unsigned char, WS_HID); const int* PTOK = WSP(int, WS_PTOK);
    for (int p = F.gw; p < NPAIR; p += F.NGW) { const int tok = PTOK[p]; u32x4* dst = (u32x4*)(XG + (size_t)p * DM) + F.lane;
        unsigned zz = 0u; asm volatile("" : "+v"(zz));
        if (tok >= 0) { const u32x4* src = (const u32x4*)(H2 + (size_t)tok * DM) + F.lane; dst[0] = src[0]; dst[64] = src[64]; }
        else { dst[0] = (u32x4){zz, zz, zz, zz}; dst[64] = (u32x4){zz, zz, zz, zz}; }
        if (F.lane < 8) *((u32x4*)(HID + (size_t)p * EFFP + EFF) + F.lane) = (u32x4){zz, zz, zz, zz}; }
}
__device__ __forceinline__ void phase_ln2(Frame& F, const Args& a, int layer) {
    const float* mod = (const float*)(F.ws + WS_CTL) + CW_MOD + (size_t)layer * 3 * 6 * DM;
    float* XS = WSP(float, WS_XS); const bf16_t* YE = WSP(bf16_t, WS_YE); const int* INV = WSP(int, WS_INV);
    const float* g2w = arg_in(a, I_LN2G) + layer * DM; const float* b2w = arg_in(a, I_LN2B) + layer * DM;
    for (int row = F.gw; row < T; row += F.NGW) {
        f32x4* xr = (f32x4*)(XS + (size_t)row * DM) + F.lane; const float* m = mod + (size_t)row_modidx(row) * 6 * DM;
        f32x4 mo[8];
#pragma unroll
        for (int j = 0; j < 8; ++j) mo[j] = (f32x4){0.f, 0.f, 0.f, 0.f};
        for (int e = 0; e < 16; ++e) { const int pair = INV[(size_t)row * 16 + e];
            if (pair >= 0) { const u32x2* yr = (const u32x2*)(YE + (size_t)pair * DM) + F.lane;
#pragma unroll
                for (int j = 0; j < 8; ++j) { const u32x2 w = yr[64 * j]; mo[j] += (f32x4){bflo(w.x), bfhi(w.x), bflo(w.y), bfhi(w.y)}; } } }
        f32x4 v[8];
#pragma unroll
        for (int j = 0; j < 8; ++j) { const int c = 4 * (64 * j + F.lane); v[j] = xr[64 * j] * ALPHA + *(const f32x4*)(m + 5 * DM + c) * mo[j]; }
        float mean, rstd; row_stats(v, mean, rstd, 1e-6f);
#pragma unroll
        for (int j = 0; j < 8; ++j) { const int c = 4 * (64 * j + F.lane); v[j] = (v[j] - mean) * rstd * *(const f32x4*)(g2w + c) + *(const f32x4*)(b2w + c); xr[64 * j] = v[j]; }
        if (layer == DEPTH - 1 && row >= TC) { f32x4* o = (f32x4*)(a.out + (size_t)(row - TC) * DM) + F.lane;
#pragma unroll
            for (int j = 0; j < 8; ++j) o[64 * j] = v[j]; }
    }
}

constexpr int LDS_BYTES = 153600, MISC_OFF = LDS_BYTES - 64;
constexpr int NPL = 16, NPHASE = 1 + DEPTH * NPL;

__global__ void __launch_bounds__(NTHREADS, 2) fwd_kernel(Args args) {
    extern __shared__ __attribute__((aligned(16))) unsigned char lds_raw[];
    Frame F;
    F.lds = (LAS unsigned char*)lds_raw;
    F.tid = threadIdx.x; F.lane = F.tid & 63; F.wave = __builtin_amdgcn_readfirstlane(F.tid >> 6); const int wave0 = F.wave;
    F.G = gridDim.x; F.bid = blockIdx.x; F.gw = F.bid * NWAVES + F.wave; F.NGW = F.G * NWAVES; F.ws = args.ws;
    volatile LAS unsigned* misc = (volatile LAS unsigned*)(F.lds + MISC_OFF);
    if (F.tid < 16) misc[F.tid] = 0u;
    __syncthreads();
    const int lo = args.ph_lo, hi = args.ph_hi;
    XcdBarrier bar; bar.bar = (unsigned*)(F.ws + WS_CTL) + CW_BAR; bar.x = 0; bar.st = nullptr;
    const bool multi = (hi - lo) > 1;
    if (multi) bar = xcd_barrier_post((unsigned*)(F.ws + WS_CTL) + CW_BAR, misc);
#ifndef ONLY_PHASE
#define ONLY_PHASE -1
#endif
#define PON(r) (ONLY_PHASE < 0 || ONLY_PHASE == (r))
#ifndef REP_MASK
#define REP_MASK 0
#endif
#define REP(b) ((REP_MASK >> (b)) & 1)
#define REOPQ() do { F.ws = opq(args.ws); F.lane = lane_asm() & 63; F.wave = opqs(wave0) & 7; F.tid = F.wave * 64 + F.lane; F.G = opqs(gridDim.x); F.bid = opqs(blockIdx.x); F.gw = F.bid * NWAVES + F.wave; F.NGW = F.G * NWAVES; } while (0)
#define IN(k) (lo <= (k) && (k) < hi)
#define SEAM(k) do { if (IN(k) && IN((k) + 1)) { XcdBarrier bb_ = bar; bb_.x = (unsigned)opqs((int)bar.x); xcd_barrier(bb_); } } while (0)
    if (PON(100) && IN(0)) { F.ws = opq(args.ws); F.lane = lane_asm() & 63; F.wave = opqs(wave0) & 7; F.tid = F.wave * 64 + F.lane; F.G = opqs(gridDim.x); F.bid = opqs(blockIdx.x); F.gw = F.bid * NWAVES + F.wave; F.NGW = F.G * NWAVES; { p0_weights(F, args); REOPQ(); p0_mod(F, args); __syncthreads(); } }
    SEAM(0);
#pragma unroll 1
    for (int layer = 0; layer < DEPTH; ++layer) {
        const int pb = 1 + layer * NPL;
        if (PON(0) && IN(pb + 0)) { F.ws = opq(args.ws); F.lane = lane_asm() & 63; F.wave = opqs(wave0) & 7; F.tid = F.wave * 64 + F.lane; F.G = opqs(gridDim.x); F.bid = opqs(blockIdx.x); F.gw = F.bid * NWAVES + F.wave; F.NGW = F.G * NWAVES; phase_modln(F, args, layer); REOPQ(); phase_hdn(F, args, layer); __syncthreads(); if (REP(1)) { phase_modln(F, args, layer); REOPQ(); phase_hdn(F, args, layer); __syncthreads(); } }
        SEAM(pb + 0);
        if (PON(1) && IN(pb + 1)) { F.ws = opq(args.ws); F.lane = lane_asm() & 63; F.wave = opqs(wave0) & 7; F.tid = F.wave * 64 + F.lane; F.G = opqs(gridDim.x); F.bid = opqs(blockIdx.x); F.gw = F.bid * NWAVES + F.wave; F.NGW = F.G * NWAVES;
            pg8::Gemm g{WSP(bf16_t, WS_H), WSP(bf16_t, WS_WIN + layer * SZ_WIN), DM, DM, DM}; pg8::StaticOrder S; S.init(66, NNG / 256, F.G, F.bid);
            EpiBf16 E{WSP(bf16_t, WS_P), NNG, nullptr, 0, 0, 1.f};
            pg8::gemm_phase(F.lds, g, S, E, F.tid);
        }
        SEAM(pb + 1);
        if (PON(2) && IN(pb + 2)) { F.ws = opq(args.ws); F.lane = lane_asm() & 63; F.wave = opqs(wave0) & 7; F.tid = F.wave * 64 + F.lane; F.G = opqs(gridDim.x); F.bid = opqs(blockIdx.x); F.gw = F.bid * NWAVES + F.wave; F.NGW = F.G * NWAVES; { phase_prep(F, args, layer); REOPQ(); phase_filt(F, args, layer); __syncthreads(); } }
        SEAM(pb + 2);
        if (PON(3) && IN(pb + 3)) { F.ws = opq(args.ws); F.lane = lane_asm() & 63; F.wave = opqs(wave0) & 7; F.tid = F.wave * 64 + F.lane; F.G = opqs(gridDim.x); F.bid = opqs(blockIdx.x); F.gw = F.bid * NWAVES + F.wave; F.NGW = F.G * NWAVES;
#if !defined(T3) || T3 == 0
            { pg8::Gemm g{WSP(bf16_t, WS_P) + P_CQ, WSP(bf16_t, WS_WQ + layer * SZ_WQ), NNG, 512, 512}; pg8::StaticOrder S; S.init(66, 6, F.G, F.bid);
              EpiBf16 E{WSP(bf16_t, WS_Q), 1536, WSP(float, WS_RS), 2, 0, 1.f}; pg8::gemm_phase(F.lds, g, S, E, F.tid); }
#endif
#if !defined(T3) || T3 == 1
            { pg8::Gemm g{WSP(bf16_t, WS_P) + P_CKV, WSP(bf16_t, WS_WKV + layer * SZ_WKV), NNG, 512, 512}; pg8::StaticOrder S; S.init(66, 8, F.G, F.bid);
              EpiBf16 E{WSP(bf16_t, WS_KV), 2048, WSP(float, WS_RS) + 1, 2, 0, 1.f}; pg8::gemm_phase(F.lds, g, S, E, F.tid); }
#endif
#if !defined(T3) || T3 == 2
            { pg8::Gemm g{WSP(bf16_t, WS_ALORA), WSP(bf16_t, WS_WLORA + layer * SZ_WLORA), 512, 512, 512}; pg8::StaticOrder S; S.init(66, 20, F.G, F.bid);
              EpiLora E{WSP(bf16_t, WS_EW), WSP(bf16_t, WS_ICLR), WSP(bf16_t, WS_GG), arg_in(args, I_RW0) + layer * 2048, arg_in(args, I_RA0) + layer * 2048}; pg8::gemm_phase(F.lds, g, S, E, F.tid); }
#endif
        }
        SEAM(pb + 3);
        if (PON(4) && IN(pb + 4)) { F.ws = opq(args.ws); F.lane = lane_asm() & 63; F.wave = opqs(wave0) & 7; F.tid = F.wave * 64 + F.lane; F.G = opqs(gridDim.x); F.bid = opqs(blockIdx.x); F.gw = F.bid * NWAVES + F.wave; F.NGW = F.G * NWAVES; phase_qrope(F); REOPQ(); phase_mamba_states(F, args, layer); __syncthreads(); if (REP(5)) { REOPQ(); phase_mamba_states(F, args, layer); __syncthreads(); } }
        SEAM(pb + 4);
        if (PON(5) && IN(pb + 5)) { F.ws = opq(args.ws); F.lane = lane_asm() & 63; F.wave = opqs(wave0) & 7; F.tid = F.wave * 64 + F.lane; F.G = opqs(gridDim.x); F.bid = opqs(blockIdx.x); F.gw = F.bid * NWAVES + F.wave; F.NGW = F.G * NWAVES;
#if !defined(T5) || T5 == 0
            phase_rwkv_scan(F, args, layer); __syncthreads();
            if (REP(6)) { phase_rwkv_scan(F, args, layer); __syncthreads(); }
#endif
#if !defined(T5) || T5 == 1
            REOPQ(); phase_attn(F);
#endif
#if !defined(T5) || T5 == 2
            if (REP(18)) { REOPQ(); phase_hyena_fft(F, args, layer, opqs(1) != 0); }
            REOPQ(); phase_hyena_fft(F, args, layer);
#endif
#if !defined(T5) || T5 == 3
            REOPQ(); phase_mamba_scan(F); __syncthreads();
#endif
        }
        SEAM(pb + 5);
        if (PON(6) && IN(pb + 6)) { F.ws = opq(args.ws); F.lane = lane_asm() & 63; F.wave = opqs(wave0) & 7; F.tid = F.wave * 64 + F.lane; F.G = opqs(gridDim.x); F.bid = opqs(blockIdx.x); F.gw = F.bid * NWAVES + F.wave; F.NGW = F.G * NWAVES;
#if !defined(T6) || T6 == 0
            phase_mamba_out(F, args, layer); __syncthreads();
            if (REP(8)) { phase_mamba_out(F, args, layer); __syncthreads(); }
#endif
#if !defined(T6) || T6 == 1
            REOPQ(); phase_hyena_out(F, args, layer);
#endif
#if !defined(T6) || T6 == 2
            REOPQ(); phase_rwkv_out(F, args, layer); __syncthreads();
            if (REP(9)) { REOPQ(); phase_hyena_out(F, args, layer); __syncthreads(); } if (REP(19)) { REOPQ(); phase_rwkv_out(F, args, layer); __syncthreads(); }
#endif
        }
        SEAM(pb + 6);
        if (PON(7) && IN(pb + 7)) { F.ws = opq(args.ws); F.lane = lane_asm() & 63; F.wave = opqs(wave0) & 7; F.tid = F.wave * 64 + F.lane; F.G = opqs(gridDim.x); F.bid = opqs(blockIdx.x); F.gw = F.bid * NWAVES + F.wave; F.NGW = F.G * NWAVES;
            pg8::Gemm g{WSP(bf16_t, WS_H8), WSP(bf16_t, WS_WIN + layer * SZ_WIN) + (size_t)NNG * DM, DM / 2, DM / 2, DM / 2}; pg8::StaticOrder S; S.init(66, NGATE / 256, F.G, F.bid);
            EpiBf16 E{WSP(bf16_t, WS_GATES), NGATE, nullptr, 0, 0, 1.f / 64.f};
            pg8::gemm_phase<EpiBf16, pg8::StaticOrder, true>(F.lds, g, S, E, F.tid);
            REOPQ(); phase_mamba_norm(F, args, layer);
        }
        SEAM(pb + 7);
        if (PON(8) && IN(pb + 8)) { F.ws = opq(args.ws); F.lane = lane_asm() & 63; F.wave = opqs(wave0) & 7; F.tid = F.wave * 64 + F.lane; F.G = opqs(gridDim.x); F.bid = opqs(blockIdx.x); F.gw = F.bid * NWAVES + F.wave; F.NGW = F.G * NWAVES;
            pg8::Gemm g{WSP(bf16_t, WS_Y), WSP(bf16_t, WS_WBR + layer * SZ_WBR), 1024, 1024, 1024}; OrderMerge S; S.init(F.G, F.bid);
            EpiMerge E{WSP(bf16_t, WS_GATES), WSP(float, WS_MRGF), WSP(bf16_t, WS_MRGB)};
            pg8::gemm_phase(F.lds, g, S, E, F.tid);

        }
        SEAM(pb + 8);
        if (PON(9) && IN(pb + 9)) { F.ws = opq(args.ws); F.lane = lane_asm() & 63; F.wave = opqs(wave0) & 7; F.tid = F.wave * 64 + F.lane; F.G = opqs(gridDim.x); F.bid = opqs(blockIdx.x); F.gw = F.bid * NWAVES + F.wave; F.NGW = F.G * NWAVES;
            pg8::Gemm g{WSP(bf16_t, WS_MRGB), WSP(bf16_t, WS_WOUT + layer * SZ_WOUT), DM, DM, DM}; pg8::StaticOrder S; S.init(66, 8, F.G, F.bid);
            EpiF32 E{WSP(float, WS_YMIX), DM};
            pg8::gemm_phase(F.lds, g, S, E, F.tid);

        }
        SEAM(pb + 9);
        if (PON(10) && IN(pb + 10)) { F.ws = opq(args.ws); F.lane = lane_asm() & 63; F.wave = opqs(wave0) & 7; F.tid = F.wave * 64 + F.lane; F.G = opqs(gridDim.x); F.bid = opqs(blockIdx.x); F.gw = F.bid * NWAVES + F.wave; F.NGW = F.G * NWAVES; phase_ln1(F, args, layer); __syncthreads(); { REOPQ(); conv_experts(F, args, layer); __syncthreads(); } }
        SEAM(pb + 10);
        if (PON(11) && IN(pb + 11)) { F.ws = opq(args.ws); F.lane = lane_asm() & 63; F.wave = opqs(wave0) & 7; F.tid = F.wave * 64 + F.lane; F.G = opqs(gridDim.x); F.bid = opqs(blockIdx.x); F.gw = F.bid * NWAVES + F.wave; F.NGW = F.G * NWAVES; phase_topk(F); __syncthreads(); if (REP(14)) { phase_topk(F); __syncthreads(); } }
        SEAM(pb + 11);
        if (PON(12) && IN(pb + 12)) { F.ws = opq(args.ws); F.lane = lane_asm() & 63; F.wave = opqs(wave0) & 7; F.tid = F.wave * 64 + F.lane; F.G = opqs(gridDim.x); F.bid = opqs(blockIdx.x); F.gw = F.bid * NWAVES + F.wave; F.NGW = F.G * NWAVES; phase_gather(F); if (REP(15)) phase_gather(F); }
        SEAM(pb + 12);
        if (PON(13) && IN(pb + 13)) { F.ws = opq(args.ws); F.lane = lane_asm() & 63; F.wave = opqs(wave0) & 7; F.tid = F.wave * 64 + F.lane; F.G = opqs(gridDim.x); F.bid = opqs(blockIdx.x); F.gw = F.bid * NWAVES + F.wave; F.NGW = F.G * NWAVES;
            pg8::Gemm g{WSP(bf16_t, WS_XG), WSP(bf16_t, WS_WE), DM / 2, DM / 2, DM / 2}; OrderMoe S; S.init(11, F.G, F.bid);
            EpiSwiglu E{WSP(unsigned char, WS_HID)};
            pg8::gemm_phase<EpiSwiglu, OrderMoe, true>(F.lds, g, S, E, F.tid);

        }
        SEAM(pb + 13);
        if (PON(14) && IN(pb + 14)) { F.ws = opq(args.ws); F.lane = lane_asm() & 63; F.wave = opqs(wave0) & 7; F.tid = F.wave * 64 + F.lane; F.G = opqs(gridDim.x); F.bid = opqs(blockIdx.x); F.gw = F.bid * NWAVES + F.wave; F.NGW = F.G * NWAVES;
            pg8::Gemm g{WSP(bf16_t, WS_HID), WSP(bf16_t, WS_WE + SZ_WGU8), EFFP / 2, EFFP / 2, EFFP / 2}; OrderMoe S; S.init(8, F.G, F.bid);
            EpiDown E{WSP(bf16_t, WS_YE), WSP(float, WS_PGATE)};
            pg8::gemm_phase<EpiDown, OrderMoe, true>(F.lds, g, S, E, F.tid);

        }
        SEAM(pb + 14);
        if (PON(15) && IN(pb + 15)) { F.ws = opq(args.ws); F.lane = lane_asm() & 63; F.wave = opqs(wave0) & 7; F.tid = F.wave * 64 + F.lane; F.G = opqs(gridDim.x); F.bid = opqs(blockIdx.x); F.gw = F.bid * NWAVES + F.wave; F.NGW = F.G * NWAVES; phase_ln2(F, args, layer); }
        SEAM(pb + 15);
    }
#undef IN
#undef SEAM
}


#ifdef DBG_CUT
__global__ void dbg_dump(const unsigned char* ws, float* out, size_t off, int is_bf16, size_t n_src) {
    const size_t N = (size_t)TL * DM;
    for (size_t i = (size_t)blockIdx.x * blockDim.x + threadIdx.x; i < N; i += (size_t)gridDim.x * blockDim.x) {
        const size_t j = i % n_src;
        out[i] = is_bf16 ? bf2f(((const bf16_t*)(ws + off))[j]) : ((const float*)(ws + off))[j];
    }
}
#endif

#ifdef DBG_PASSES
__global__ void dbg_chk(const unsigned char* base, size_t off, size_t nbytes, unsigned long long* slot) {
    const unsigned* p = (const unsigned*)(base + off); const size_t n = nbytes / 4; unsigned long long s = 0;
    for (size_t i = (size_t)blockIdx.x * blockDim.x + threadIdx.x; i < n; i += (size_t)gridDim.x * blockDim.x) s += p[i];
    for (int o = 32; o > 0; o >>= 1) s += __shfl_xor(s, o);
    if ((threadIdx.x & 63) == 0) atomicAdd(slot, s);
}
__global__ void dbg_report(const unsigned long long* tab, float* out, int npass) {
    int k = 0;
    for (int ph = NPHASE - 1; ph >= 0; --ph) if (tab[ph] != tab[64 + ph]) k = ph + 1;
    if (k == 0 && npass > 2) { for (int ph = NPHASE - 1; ph >= 0; --ph) if (tab[64 + ph] != tab[128 + ph]) k = 50 + ph + 1; }
    if (k == 0) return;
    const float c = sqrtf(10.f * (float)k);
    for (size_t i = (size_t)blockIdx.x * blockDim.x + threadIdx.x; i < (size_t)TL * DM; i += (size_t)gridDim.x * blockDim.x) out[i] = c;
}
struct DbgReg { size_t off, n; };
#endif
extern "C" void kernel_launch(void* const* d_in, const int* in_sizes, int n_in, void* d_out, int out_size, void* d_ws, size_t ws_size, hipStream_t stream) {
    static int grid = 0;
    if (grid == 0) {
        if (n_in != N_INPUTS || in_sizes[0] != TL * DM || out_size != TL * DM || ws_size < WS_END) {
            fprintf(stderr, "kernel_launch: shape/workspace mismatch: n_in %d in0 %d out %d ws %zu (need %zu)\n", n_in, n_in > 0 ? in_sizes[0] : -1, out_size, ws_size, (size_t)WS_END); grid = -1; return; }
        int dev = 0, cus = 0, per_cu = 0;
        if (hipGetDevice(&dev) != hipSuccess || hipDeviceGetAttribute(&cus, hipDeviceAttributeMultiprocessorCount, dev) != hipSuccess) { grid = -1; return; }
        if (hipFuncSetAttribute((const void*)fwd_kernel, hipFuncAttributeMaxDynamicSharedMemorySize, LDS_BYTES) != hipSuccess) { fprintf(stderr, "kernel_launch: hipFuncSetAttribute failed\n"); grid = -1; return; }
        if (hipOccupancyMaxActiveBlocksPerMultiprocessor(&per_cu, (const void*)fwd_kernel, NTHREADS, LDS_BYTES) != hipSuccess || per_cu < 1) { fprintf(stderr, "kernel_launch: occupancy query says %d\n", per_cu); grid = -1; (void)hipGetLastError(); return; }
        grid = cus;
    }
    if (grid < 0) return;
    (void)hipMemsetAsync((char*)d_ws + WS_CTL, 0, CTL_BYTES, stream);
    Args a{};
    for (int i = 0; i < N_INPUTS; ++i) a.in[i] = (const float*)d_in[i];
    a.out = (float*)d_out; a.ws = (unsigned char*)d_ws;
#if MK_ONE_LAUNCH
    a.ph_lo = 0; a.ph_hi = NPHASE;
    hipLaunchKernelGGL(fwd_kernel, dim3(grid), dim3(NTHREADS), LDS_BYTES, stream, a);
#else
#ifdef DBG_PASSES
    {
        unsigned long long* tab = (unsigned long long*)((char*)d_ws + 1600000);
        auto chk = [&](int pass, int ph, size_t off, size_t n) { hipLaunchKernelGGL(dbg_chk, dim3(1024), dim3(256), 0, stream, (const unsigned char*)d_ws, off, n, tab + pass * 64 + ph); };
        for (int pass = 0; pass < DBG_PASSES; ++pass) {
            if (pass > 0) (void)hipMemsetAsync((char*)d_ws + (size_t)CW_MOD * 4, 0, (size_t)DEPTH * 3 * 6 * DM * 4, stream);
            for (int ph = 0; ph < NPHASE; ++ph) {
                a.ph_lo = ph; a.ph_hi = ph + 1; hipLaunchKernelGGL(fwd_kernel, dim3(grid), dim3(NTHREADS), LDS_BYTES, stream, a);
                if (ph == 0) { chk(pass, ph, WS_WIN, WS_XS - WS_WIN); chk(pass, ph, (size_t)CW_MOD * 4, (size_t)DEPTH * 3 * 6 * DM * 4); continue; }
                const int r = (ph - 1) % NPL;
                switch (r) {
                case 0: chk(pass, ph, WS_H, SZ_H); chk(pass, ph, WS_HDN, SZ_HDN); break;
                case 1: chk(pass, ph, WS_P, SZ_P); break;
                case 2: chk(pass, ph, WS_P2, SZ_P2); chk(pass, ph, WS_KK, SZ_TK2); chk(pass, ph, WS_ALORA, WS_VT - WS_ALORA); chk(pass, ph, WS_VT, WS_HDN - WS_VT); break;
                case 3: chk(pass, ph, WS_Q, SZ_Q + SZ_KV); chk(pass, ph, WS_EW, 4 * SZ_TK2); chk(pass, ph, WS_GG, SZ_TK2); break;
                case 4: chk(pass, ph, WS_Q, SZ_Q); chk(pass, ph, WS_MST, SZ_MST + SZ_MCS); break;
                case 5: chk(pass, ph, WS_YRW, 2 * SZ_TK2); chk(pass, ph, WS_Y, SZ_Y / 4); chk(pass, ph, WS_VT, SZ_VT); chk(pass, ph, WS_MST, SZ_MST); break;
                case 6: chk(pass, ph, WS_Y + SZ_Y / 4, 3 * (SZ_Y / 4)); break;
                case 7: chk(pass, ph, WS_GATES, SZ_GATES); chk(pass, ph, WS_Y + SZ_Y / 4, SZ_Y / 4); break;
                case 8: chk(pass, ph, WS_MRGF, SZ_MRGF); chk(pass, ph, WS_MRGB, SZ_MRGB); break;
                case 9: chk(pass, ph, WS_YMIX, SZ_YMIX); break;
                case 10: chk(pass, ph, WS_XS, SZ_XS); chk(pass, ph, WS_H2, SZ_H); chk(pass, ph, WS_AFF, SZ_AFF); chk(pass, ph, WS_WE, SZ_WGU + SZ_WD); break;
                case 11: chk(pass, ph, WS_INV, SZ_INV + SZ_PTOK + SZ_PGATE); break;
                case 12: chk(pass, ph, WS_XG, SZ_XG); break;
                case 13: chk(pass, ph, WS_HID, SZ_HID); break;
                case 14: chk(pass, ph, WS_YE, SZ_YE); break;
                case 15: chk(pass, ph, WS_XS, SZ_XS); break;
                }
            }
        }
        hipLaunchKernelGGL(dbg_report, dim3(2048), dim3(256), 0, stream, (const unsigned long long*)tab, (float*)d_out, (int)DBG_PASSES);
    }
#elif defined(DBG_CUT)
    for (int ph = 0; ph < DBG_CUT; ++ph) { a.ph_lo = ph; a.ph_hi = ph + 1; hipLaunchKernelGGL(fwd_kernel, dim3(grid), dim3(NTHREADS), LDS_BYTES, stream, a); }
    hipLaunchKernelGGL(dbg_dump, dim3(2048), dim3(256), 0, stream, (const unsigned char*)d_ws, (float*)d_out, (size_t)DBG_OFF, DBG_BF16, (size_t)DBG_N);
#else
    for (int ph = 0; ph < NPHASE; ++ph) { a.ph_lo = ph; a.ph_hi = ph + 1; hipLaunchKernelGGL(fwd_kernel, dim3(grid), dim3(NTHREADS), LDS_BYTES, stream, a); }
#endif
#endif
}
```

```cpp
#include <hip/hip_runtime.h>
#include <cstdio>
#include <cstdint>

#define REP_MASK 0x80000
#ifndef MK_ONE_LAUNCH
#define MK_ONE_LAUNCH 1
#endif

#define LAS __attribute__((address_space(3)))
typedef unsigned short bf16_t;
typedef short bf16x8 __attribute__((ext_vector_type(8)));
typedef float f32x4 __attribute__((ext_vector_type(4)));
typedef float f32x2 __attribute__((ext_vector_type(2)));
typedef unsigned u32x4 __attribute__((ext_vector_type(4)));
typedef unsigned u32x2 __attribute__((ext_vector_type(2)));

constexpr int DM = 2048, NBATCH = 2, SEQ = 8192, CTX = 256, DEPTH = 2;
constexpr int TC = NBATCH * CTX, TL = NBATCH * SEQ, T = TC + TL;
constexpr int NIN = 18432, NNG = 10240, NGATE = 8192;
constexpr int P_CQ = 0, P_CKV = 512, P_KPE = 1024;
constexpr int P_Z = 1088, P_XBC = 2112, P_DT = 3648;
constexpr int P_HY = 3680;
constexpr int P_RW = 6752, P_WD = 9824, P_AD = 9952, P_GD = 10080;
constexpr int NH_MLA = 8, NH_SSM = 16, NH_RW = 16;
constexpr int NEXP = 16, EFF = 1408, CAP_L = 1024, CAP_C = 32;
constexpr int NPAIR = NBATCH * NEXP * CAP_L + NEXP * 256;
constexpr float ALPHA = 1.4142135623730951f;
constexpr int NWAVES = 8, NTHREADS = 512;

__device__ __forceinline__ int seg_of(int row) { return row < 256 ? 0 : row < 512 ? 1 : row < 512 + SEQ ? 2 : 3; }
__device__ __forceinline__ int seg_start(int s) { return s == 0 ? 0 : s == 1 ? 256 : s == 2 ? 512 : 512 + SEQ; }
__device__ __forceinline__ int seg_len(int s) { return s < 2 ? CTX : SEQ; }
__device__ __forceinline__ bool row_first(int row) { return row == 0 || row == 256 || row == 512 || row == 512 + SEQ; }
__device__ __forceinline__ bool row_last(int row) { return row == 255 || row == 511 || row == 511 + SEQ || row == T - 1; }
__device__ __forceinline__ int row_modidx(int row) { return row < 512 ? 2 : (row < 512 + SEQ ? 0 : 1); }

constexpr size_t AL(size_t x) { return (x + 255) / 256 * 256; }
constexpr size_t WS_CTL = 0, CTL_BYTES = 2u << 20;
constexpr int CW_BAR = 1024;
constexpr int CW_MOD = 16384;
constexpr size_t SZ_WIN = (size_t)NIN * DM * 2, SZ_WBR = (size_t)4 * DM * 1024 * 2, SZ_WOUT = (size_t)DM * DM * 2, SZ_WQ = (size_t)1536 * 512 * 2,
                 SZ_WKV = (size_t)2048 * 512 * 2, SZ_WLORA = (size_t)5120 * 512 * 2;
constexpr size_t WS_WIN = CTL_BYTES, WS_WBR = WS_WIN + DEPTH * SZ_WIN, WS_WOUT = WS_WBR + DEPTH * SZ_WBR, WS_WQ = WS_WOUT + DEPTH * SZ_WOUT,
                 WS_WKV = WS_WQ + DEPTH * SZ_WQ, WS_WLORA = WS_WKV + DEPTH * SZ_WKV, WS_XS = WS_WLORA + DEPTH * SZ_WLORA;
constexpr size_t SZ_XS = (size_t)T * DM * 4;
constexpr size_t WS_H = WS_XS + SZ_XS, SZ_H = (size_t)T * DM * 2;
constexpr size_t WS_P = WS_H + SZ_H, SZ_P = (size_t)T * NNG * 2;
constexpr int P2W = 5632, P2_XBC = 0, P2_X0 = 1536, P2_RKV = 2560;
constexpr size_t WS_P2 = WS_P + SZ_P, SZ_P2 = (size_t)T * P2W * 2;
constexpr size_t WS_Q = WS_P2 + SZ_P2, SZ_Q = (size_t)T * 1536 * 2;
constexpr size_t WS_KV = WS_Q + SZ_Q, SZ_KV = (size_t)T * 2048 * 2;
constexpr size_t WS_EW = WS_KV + SZ_KV, SZ_TK2 = (size_t)T * 1024 * 2;
constexpr size_t WS_ICLR = WS_EW + 2 * SZ_TK2;
constexpr size_t WS_KK = WS_ICLR + 2 * SZ_TK2;
constexpr size_t WS_GG = WS_KK + SZ_TK2;
constexpr size_t WS_YRW = WS_GG + SZ_TK2;
constexpr size_t WS_ALORA = WS_YRW + 2 * SZ_TK2, SZ_ALORA = (size_t)T * 512 * 2;
constexpr size_t WS_KPE = WS_ALORA + SZ_ALORA, SZ_KPE = (size_t)T * 64 * 2;
constexpr size_t WS_RS = WS_KPE + SZ_KPE, SZ_RS = AL((size_t)T * 2 * 4);
constexpr size_t WS_DT = WS_RS + SZ_RS, SZ_DT = (size_t)T * 32 * 4;
constexpr size_t WS_VT = WS_DT + SZ_DT, SZ_VT = (size_t)1024 * 2 * SEQ * 4;
constexpr size_t WS_VC = WS_VT + SZ_VT, SZ_VC = (size_t)TC * 1024 * 4;
constexpr size_t WS_FILT = WS_VC + SZ_VC, SZ_FILT = (size_t)1024 * 2 * SEQ * 2;
constexpr size_t WS_FILTC = WS_FILT + SZ_FILT, SZ_FILTC = (size_t)CTX * 2048 * 4;
constexpr size_t WS_HDN = WS_FILTC + SZ_FILTC, SZ_HDN1 = (size_t)(SEQ + CTX) * 64 * 4, SZ_HDN = DEPTH * SZ_HDN1;
constexpr int NCHUNK = T / 128;
constexpr size_t WS_MST = WS_HDN + SZ_HDN, SZ_MST = (size_t)2 * NCHUNK * 16 * 8192 * 2;
constexpr size_t WS_MCS = WS_MST + SZ_MST, SZ_MCS = (size_t)2 * NCHUNK * 16 * 4 * 2;
constexpr size_t WS_Y = WS_MCS + AL(SZ_MCS), SZ_Y = (size_t)4 * T * 1024 * 2;
constexpr size_t WS_AFF = WS_Y + SZ_Y, SZ_AFF = (size_t)T * 16 * 4;
constexpr size_t WS_INV = WS_AFF + SZ_AFF, SZ_INV = (size_t)T * 16 * 4;
constexpr size_t WS_PTOK = WS_INV + SZ_INV, SZ_PTOK = (size_t)NPAIR * 4;
constexpr size_t WS_PGATE = WS_PTOK + SZ_PTOK, SZ_PGATE = (size_t)NPAIR * 4;
constexpr size_t WS_H8 = WS_PGATE + SZ_PGATE, SZ_H8 = (size_t)T * DM;
constexpr size_t WS_END = WS_H8 + SZ_H8;
constexpr size_t WS_GATES = WS_P, SZ_GATES = (size_t)T * NGATE * 2;
constexpr size_t WS_MRGF = WS_P2, SZ_MRGF = (size_t)T * DM * 4;
constexpr size_t WS_MRGB = WS_Q, SZ_MRGB = (size_t)T * DM * 2;
constexpr size_t WS_YMIX = WS_P, SZ_YMIX = (size_t)T * DM * 4;
constexpr size_t WS_H2 = WS_H;
constexpr size_t WS_WE = WS_P2, SZ_WGU = (size_t)NEXP * 2816 * DM * 2, SZ_WD = (size_t)NEXP * DM * EFF * 2;
constexpr size_t WS_XG = WS_P, SZ_XG = (size_t)NPAIR * DM * 2;
constexpr size_t WS_HID = WS_XG + SZ_XG, SZ_HID = (size_t)NPAIR * EFF * 2;
constexpr size_t WS_YE = WS_WE + SZ_WGU + SZ_WD, SZ_YE = (size_t)NPAIR * DM * 2;
static_assert(SZ_GATES <= SZ_P && SZ_MRGF <= SZ_P2 && SZ_MRGB <= SZ_Q + SZ_KV && SZ_YMIX <= SZ_P, "alias map 1");
static_assert(SZ_XG + SZ_HID <= SZ_P, "alias map 2");
static_assert(WS_YE + SZ_YE <= WS_VT, "alias map 3");
static_assert(WS_END < 1800000000ull, "workspace budget");

__device__ __forceinline__ unsigned f2bf(float f) { unsigned u = __builtin_bit_cast(unsigned, f); return (u + 0x7fffu + ((u >> 16) & 1u)) >> 16; }
__device__ __forceinline__ unsigned pk2(float lo, float hi) { return f2bf(lo) | (f2bf(hi) << 16); }
__device__ __forceinline__ float bf2f(unsigned short b) { return __builtin_bit_cast(float, (unsigned)b << 16); }
__device__ __forceinline__ float bflo(unsigned w) { return __builtin_bit_cast(float, w << 16); }
__device__ __forceinline__ float bfhi(unsigned w) { return __builtin_bit_cast(float, w & 0xffff0000u); }
__device__ __forceinline__ unsigned cvt_pk_bf16(float lo, float hi) { unsigned r; asm volatile("v_cvt_pk_bf16_f32 %0, %1, %2" : "=v"(r) : "v"(lo), "v"(hi)); return r; }
__device__ __forceinline__ float dppx(float x, const int sel) {
    const int xi = __builtin_bit_cast(int, x); int r;
    if (sel == 0) r = __builtin_amdgcn_update_dpp(0, xi, 0xB1, 0xF, 0xF, false);
    else if (sel == 1) r = __builtin_amdgcn_update_dpp(0, xi, 0x4E, 0xF, 0xF, false);
    else if (sel == 2) r = __builtin_amdgcn_update_dpp(0, xi, 0x141, 0xF, 0xF, false);
    else r = __builtin_amdgcn_update_dpp(0, xi, 0x140, 0xF, 0xF, false);
    return __builtin_bit_cast(float, r);
}
__device__ __forceinline__ float swz16(float x) { return __builtin_bit_cast(float, __builtin_amdgcn_ds_swizzle(__builtin_bit_cast(int, x), 0x401F)); }
__device__ __forceinline__ float sum4(float v) { v += dppx(v, 0); v += dppx(v, 1); return v; }
__device__ __forceinline__ float sum8(float v) { v = sum4(v); v += dppx(v, 2); return v; }
__device__ __forceinline__ float sum16(float v) { v = sum8(v); v += dppx(v, 3); return v; }
__device__ __forceinline__ float sum32(float v) { v = sum16(v); v += swz16(v); return v; }
__device__ __forceinline__ unsigned pk4fp8(float a, float b, float c, float d) { int w = 0; w = __builtin_amdgcn_cvt_pk_fp8_f32(a, b, w, false); w = __builtin_amdgcn_cvt_pk_fp8_f32(c, d, w, true); return (unsigned)w; }
__device__ __forceinline__ float wave_sum(float v) {
    v = sum32(v);
    auto rr = __builtin_amdgcn_permlane32_swap(__float_as_uint(v), __float_as_uint(v), false, false);
    return __uint_as_float(rr[0]) + __uint_as_float(rr[1]);
}
__device__ __forceinline__ float sigmoidf_(float x) { return 1.f / (1.f + __expf(-x)); }
__device__ __forceinline__ float siluf_(float x) { return x / (1.f + __expf(-x)); }
__device__ __forceinline__ float softplusf_(float x) { return x > 20.f ? x : __logf(1.f + __expf(x)); }
__device__ __forceinline__ float tanhf_(float x) { const float e = __expf(2.f * fminf(x, 15.f)); return 1.f - 2.f / (e + 1.f); }
#define LDS_WAIT() asm volatile("s_waitcnt lgkmcnt(0)" ::: "memory")
#define VM_WAIT() asm volatile("s_waitcnt vmcnt(0)" ::: "memory")

#define XB_TMO      128
#define XB_XCNT(j)  (256  + 64 * (j))
#define XB_XSUB(j)  (1280 + 64 * (j))
#define XB_XGEN(j)  (2304 + 64 * (j))
#define XB_TOP      3328
#define XB_TOPGEN   3392
#define XCD_BAR_WORDS 3456
#define XB_SPIN_CAP (1u << 18)
__device__ __forceinline__ unsigned xb_ld(unsigned* p)              { return __hip_atomic_load(p, __ATOMIC_RELAXED, __HIP_MEMORY_SCOPE_AGENT); }
__device__ __forceinline__ unsigned xb_add(unsigned* p, unsigned v) { return __hip_atomic_fetch_add(p, v, __ATOMIC_RELAXED, __HIP_MEMORY_SCOPE_AGENT); }
__device__ __forceinline__ unsigned xb_xcc_id() { return (unsigned)__builtin_amdgcn_s_getreg((3 << 11) | 20) & 0xFu; }
#define XB_SPIN(cond, bar) do { unsigned _sp = 0; while (cond) { __builtin_amdgcn_s_sleep(1); \
    if ((++_sp & 255u) == 0u) { if (xb_ld(&(bar)[XB_TMO])) break; if (_sp > XB_SPIN_CAP) { atomicAdd(&(bar)[XB_TMO], 1u); break; } } } } while (0)
struct XcdBarrier { unsigned* bar; unsigned x; volatile LAS unsigned* st; };
__device__ __forceinline__ XcdBarrier xcd_barrier_post(unsigned* bar, volatile LAS unsigned* st) {
    XcdBarrier b; b.bar = bar; b.x = xb_xcc_id(); b.st = st;
    if (threadIdx.x == 0) (void)xb_add(&bar[XB_XCNT(b.x)], 1u);
    return b;
}
__device__ __forceinline__ void xcd_barrier_complete(unsigned* bar, unsigned x, unsigned& nloc, unsigned& nx) {
    const unsigned G = gridDim.x * gridDim.y * gridDim.z;
    unsigned sum, cnt, mine, sp = 0u;
    for (;;) {
        sum = 0u; cnt = 0u; mine = 0u;
#pragma unroll
        for (unsigned j = 0; j < 16; ++j) { const unsigned c = xb_ld(&bar[XB_XCNT(j)]); sum += c; cnt += (c > 0u) ? 1u : 0u; mine = (j == x) ? c : mine; }
        if (sum == G) break;
        __builtin_amdgcn_s_sleep(1);
        if ((++sp & 255u) == 0u) { if (xb_ld(&bar[XB_TMO])) break; if (sp > XB_SPIN_CAP) { atomicAdd(&bar[XB_TMO], 1u); break; } }
    }
    nloc = mine > 0u ? mine : 1u; nx = cnt > 0u ? cnt : 1u;
}
__device__ __forceinline__ void xcd_barrier(const XcdBarrier& b) {
    asm volatile("s_waitcnt vmcnt(0)" ::: "memory");
    __syncthreads();
    if (threadIdx.x == 0) {
        unsigned* bar = b.bar;
        __builtin_amdgcn_s_waitcnt(0);
        unsigned nloc = b.st[0], nx = b.st[1];
        if (nloc == 0u) { xcd_barrier_complete(bar, b.x, nloc, nx); b.st[0] = nloc; b.st[1] = nx; }
        const unsigned old = xb_add(&bar[XB_XSUB(b.x)], 1u);
        const unsigned gen = old / nloc;
        if (old + 1u == (gen + 1u) * nloc) {
            __builtin_amdgcn_fence(__ATOMIC_RELEASE, "agent");
            asm volatile("s_waitcnt vmcnt(0)" ::: "memory");
            const unsigned og = xb_add(&bar[XB_TOP], 1u);
            const unsigned tg = og / nx;
            if (og + 1u == (tg + 1u) * nx) xb_add(&bar[XB_TOPGEN], 1u);
            else XB_SPIN(xb_ld(&bar[XB_TOPGEN]) == tg, bar);
            __builtin_amdgcn_fence(__ATOMIC_ACQUIRE, "agent");
            xb_add(&bar[XB_XGEN(b.x)], 1u);
            asm volatile("s_waitcnt vmcnt(0)" ::: "memory");
        } else {
            XB_SPIN(xb_ld(&bar[XB_XGEN(b.x)]) == gen, bar);
            __builtin_amdgcn_fence(__ATOMIC_ACQUIRE, "agent");
            asm volatile("s_waitcnt vmcnt(0)" ::: "memory");
        }
    }
    __syncthreads();
}

__device__ __forceinline__ int lane_asm() { int l; asm volatile("v_mbcnt_lo_u32_b32 %0, -1, 0\n\tv_mbcnt_hi_u32_b32 %0, -1, %0" : "=v"(l)); return l; }
namespace pg8 {
constexpr int BM = 256, BK = 64, HALF = 128, HTB = HALF * BK * 2, STAGE_BYTES = 8 * HTB, NXCD = 8, WGM = 8;
__host__ __device__ __forceinline__ int lds_byte(int r, int c) { const int st = (r >> 4) * 2 + (c >> 5), rr = r & 15, cc = c & 31, ob = rr * 64 + cc * 2; return st * 1024 + (ob ^ (((ob >> 9) & 1) << 5)); }
__host__ __device__ __forceinline__ void stage_rc(int b, int& R, int& C) { const int st = b / 1024, sb = b % 1024, swz = sb ^ (((sb >> 9) & 1) << 5); R = (st >> 1) * 16 + swz / 64; C = (st & 1) * 32 + (swz % 64) / 2; }
__host__ __device__ __forceinline__ int perm32(int rho) { const int n = rho >> 4, i = rho & 15; return 8 * (i >> 2) + 4 * n + (i & 3); }
struct Unit { int pm, pn; };
struct Gemm { const bf16_t* A; const bf16_t* Bt; int lda, ldb, K; };
struct StaticOrder {
    int nM, nN, nwg, G, c, pm0;
    __device__ void init(int nM_, int nN_, int G_, int c_, int pm0_ = 0) { nM = nM_; nN = nN_; nwg = nM * nN; G = G_; c = c_; pm0 = pm0_; }
    __device__ bool next(int i, Unit& u) const {
        const long L = (long)i * G + c; if (L >= nwg) return false;
        int wgid = (int)L; { const int q = nwg / NXCD, r = nwg % NXCD, xcd = wgid % NXCD, off = wgid / NXCD; wgid = (xcd < r ? xcd * (q + 1) : r * (q + 1) + (xcd - r) * q) + off; }
        const int nig = WGM * nN, gid = wgid / nig, fm = gid * WGM, gsz = (nM - fm) < WGM ? (nM - fm) : WGM;
        u.pm = pm0 + fm + ((wgid % nig) % gsz); u.pn = (wgid % nig) / gsz; return true;
    }
};
typedef int i32x4v __attribute__((ext_vector_type(4)));
typedef int i32x8v __attribute__((ext_vector_type(8)));
__device__ __forceinline__ i32x8v cat8(bf16x8 a, bf16x8 b) { return __builtin_shufflevector(__builtin_bit_cast(i32x4v, a), __builtin_bit_cast(i32x4v, b), 0, 1, 2, 3, 4, 5, 6, 7); }
template <class Epi, class Sched, bool FP8 = false>
__device__ __forceinline__ void gemm_phase(LAS unsigned char* lds, const Gemm g, const Sched& S, const Epi& E, int tid_in) {
    constexpr bool ALIGN_EPI = true;
    const unsigned tid_u = (unsigned)tid_in; __builtin_assume(tid_u < 512u);
    const int tid = (int)tid_u, wid = __builtin_amdgcn_readfirstlane(tid >> 6), lane = tid & 63, wr = wid >> 2, wc = wid & 3, fr = lane & 15, fq = lane >> 4;
    const int K = g.K, nt = K / BK;
    unsigned voffA[2], voffB[2];
#pragma unroll
    for (int i = 0; i < 2; ++i) { int R, C; stage_rc(tid * 16 + i * 8192, R, C); const int Rb = Epi::PERM ? ((R & ~31) + perm32(R & 31)) : R;
        voffA[i] = (unsigned)(R * g.lda + C) * 2u; voffB[i] = (unsigned)(Rb * g.ldb + C) * 2u; }
    const unsigned kstep = (unsigned)(BK * 2);
    const unsigned hstepA = (unsigned)HALF * g.lda * 2u, hstepB = (unsigned)HALF * g.ldb * 2u;
    const unsigned tstepA = 2u * hstepA, tstepB = 2u * hstepB;
    const unsigned ldsw = (unsigned)wid * 1024u;
    const int aoff = lds_byte(wr * 64 + fr, fq * 8), boff = lds_byte(wc * 32 + fr, fq * 8);
    const __amdgpu_buffer_rsrc_t rsA = __builtin_amdgcn_make_buffer_rsrc((void*)g.A, 0, 0xFFFFFFFFu, 0x00020000);
    const __amdgpu_buffer_rsrc_t rsB = __builtin_amdgcn_make_buffer_rsrc((void*)g.Bt, 0, 0xFFFFFFFFu, 0x00020000);
#define PG8_SA(b, h) (((b) * 2 + (h)) * HTB)
#define PG8_SB(b, h) ((4 + (b) * 2 + (h)) * HTB)
#define PG8_STAGE(bufoff, rs, soff, voff) do { _Pragma("unroll") for (int _i = 0; _i < 2; ++_i) \
        __builtin_amdgcn_raw_ptr_buffer_load_lds(rs, (LAS unsigned*)(lds + (bufoff) + ldsw + _i * 8192), 16, (int)(voff)[_i], (int)(soff), 0, 0); } while (0)
#define PG8_LDA(dst, b, h) do { if constexpr (FP8) { _Pragma("unroll") for (int m = 0; m < 4; ++m) dst##8[m] = __builtin_shufflevector(*(const LAS i32x4v*)(lds + PG8_SA(b, h) + aoff + m * 2048), *(const LAS i32x4v*)(lds + PG8_SA(b, h) + aoff + m * 2048 + 1024), 0, 1, 2, 3, 4, 5, 6, 7); } \
    else { _Pragma("unroll") for (int m = 0; m < 4; ++m) _Pragma("unroll") for (int k = 0; k < 2; ++k) dst[m][k] = *(const LAS bf16x8*)(lds + PG8_SA(b, h) + aoff + m * 2048 + k * 1024); } } while (0)
#define PG8_LDB(dst, b, h) do { if constexpr (FP8) { _Pragma("unroll") for (int n = 0; n < 2; ++n) dst##8[n] = __builtin_shufflevector(*(const LAS i32x4v*)(lds + PG8_SB(b, h) + boff + n * 2048), *(const LAS i32x4v*)(lds + PG8_SB(b, h) + boff + n * 2048 + 1024), 0, 1, 2, 3, 4, 5, 6, 7); } \
    else { _Pragma("unroll") for (int n = 0; n < 2; ++n) _Pragma("unroll") for (int k = 0; k < 2; ++k) dst[n][k] = *(const LAS bf16x8*)(lds + PG8_SB(b, h) + boff + n * 2048 + k * 1024); } } while (0)
#define PG8_MMA(ai, bj, At, Bt) do { __builtin_amdgcn_s_setprio(1); if constexpr (FP8) { _Pragma("unroll") for (int m = 0; m < 4; ++m) _Pragma("unroll") for (int n = 0; n < 2; ++n) \
        acc[ai][bj][m][n] = __builtin_amdgcn_mfma_scale_f32_16x16x128_f8f6f4(Bt##8[n], At##8[m], acc[ai][bj][m][n], 0, 0, 0, 0x7F7F7F7F, 0, 0x7F7F7F7F); } else { \
        _Pragma("unroll") for (int m = 0; m < 4; ++m) _Pragma("unroll") for (int n = 0; n < 2; ++n) _Pragma("unroll") for (int k = 0; k < 2; ++k) \
        acc[ai][bj][m][n] = __builtin_amdgcn_mfma_f32_16x16x32_bf16(Bt[n][k], At[m][k], acc[ai][bj][m][n], 0, 0, 0); } __builtin_amdgcn_s_setprio(0); } while (0)
#define PG8_WAIT_V(n) asm volatile("s_waitcnt vmcnt(" #n ")" ::: "memory")
#define PG8_WAIT_L(n) asm volatile("s_waitcnt lgkmcnt(" #n ")" ::: "memory")
#define PG8_BAR __builtin_amdgcn_s_barrier()
#define PG8_SCHED __builtin_amdgcn_sched_barrier(0)
    Unit cur, nxt; int ui = 0;
    if (!S.next(0, cur)) return;
    f32x4 acc[2][2][4][2];
#pragma unroll
    for (int a = 0; a < 2; ++a)
#pragma unroll
        for (int b = 0; b < 2; ++b)
#pragma unroll
            for (int m = 0; m < 4; ++m)
#pragma unroll
                for (int n = 0; n < 2; ++n) acc[a][b][m][n] = (f32x4){0.f, 0.f, 0.f, 0.f};
    i32x8v At8[4], B08[2], B18[2]; bf16x8 At[4][2], B0[2][2], B1[2][2];
    unsigned cA = (unsigned)cur.pm * tstepA, cB = (unsigned)cur.pn * tstepB;
    PG8_STAGE(PG8_SB(0, 0), rsB, cB, voffB); PG8_STAGE(PG8_SB(0, 1), rsB, cB + hstepB, voffB); PG8_STAGE(PG8_SA(0, 0), rsA, cA, voffA); PG8_STAGE(PG8_SA(0, 1), rsA, cA + hstepA, voffA);
    if (wr == 1) PG8_BAR;
    PG8_WAIT_V(2); PG8_BAR;
    PG8_STAGE(PG8_SB(1, 0), rsB, cB + kstep, voffB); PG8_STAGE(PG8_SA(1, 0), rsA, cA + kstep, voffA); PG8_STAGE(PG8_SB(1, 1), rsB, cB + hstepB + kstep, voffB);
    PG8_WAIT_V(6); PG8_BAR;
    for (;;) {
        const bool has_next = S.next(ui + 1, nxt);
        const unsigned nA = has_next ? (unsigned)nxt.pm * tstepA : cA; const unsigned nB = has_next ? (unsigned)nxt.pn * tstepB : cB;
        for (int t = 0; t < nt; t += 2) {
            const bool last = (t == nt - 2);
            const unsigned a1 = cA + (unsigned)(t + 1) * kstep;
            const unsigned a2 = last ? nA : cA + (unsigned)(t + 2) * kstep; const unsigned b2 = last ? nB : cB + (unsigned)(t + 2) * kstep;
            const unsigned a3 = a2 + kstep; const unsigned b3 = b2 + kstep;
            PG8_LDB(B0, 0, 0); PG8_LDB(B1, 0, 1); PG8_SCHED; PG8_LDA(At, 0, 0); PG8_STAGE(PG8_SA(1, 1), rsA, a1 + hstepA, voffA);
            PG8_WAIT_V(8); PG8_WAIT_L(0); PG8_BAR; PG8_MMA(0, 0, At, B0); PG8_MMA(0, 1, At, B1); PG8_BAR; PG8_SCHED;
            PG8_LDA(At, 0, 1); PG8_STAGE(PG8_SB(0, 0), rsB, b2, voffB); PG8_STAGE(PG8_SB(0, 1), rsB, b2 + hstepB, voffB); PG8_STAGE(PG8_SA(0, 0), rsA, a2, voffA);
            PG8_WAIT_V(8); PG8_WAIT_L(0); PG8_BAR; PG8_MMA(1, 0, At, B0); PG8_MMA(1, 1, At, B1); PG8_BAR; PG8_SCHED;
            PG8_LDB(B0, 1, 0); PG8_LDB(B1, 1, 1); PG8_SCHED; PG8_LDA(At, 1, 0); PG8_STAGE(PG8_SA(0, 1), rsA, a2 + hstepA, voffA);
            PG8_WAIT_V(8); PG8_WAIT_L(0); PG8_BAR; PG8_MMA(0, 0, At, B0); PG8_MMA(0, 1, At, B1); PG8_BAR; PG8_SCHED;
            PG8_LDA(At, 1, 1); PG8_STAGE(PG8_SB(1, 0), rsB, b3, voffB); PG8_STAGE(PG8_SB(1, 1), rsB, b3 + hstepB, voffB); PG8_STAGE(PG8_SA(1, 0), rsA, a3, voffA);
            PG8_WAIT_V(8); PG8_WAIT_L(0); PG8_BAR; PG8_MMA(1, 0, At, B0); PG8_MMA(1, 1, At, B1); PG8_BAR; PG8_SCHED;
        }
        if constexpr (ALIGN_EPI) { if (wr == 0) PG8_BAR; }
        { const int l2 = lane_asm() & 63; E(acc, cur, wr, wc, l2 & 15, l2 >> 4); }
        if (!has_next) break;
#pragma unroll
        for (int a = 0; a < 2; ++a)
#pragma unroll
            for (int b = 0; b < 2; ++b)
#pragma unroll
                for (int m = 0; m < 4; ++m)
#pragma unroll
                    for (int n = 0; n < 2; ++n) acc[a][b][m][n] = (f32x4){0.f, 0.f, 0.f, 0.f};
        cur = nxt; cA = nA; cB = nB; ++ui;
        if constexpr (ALIGN_EPI) { if (wr == 1) PG8_BAR; }
    }
    PG8_WAIT_V(0);
    if constexpr (!ALIGN_EPI) { if (wr == 0) PG8_BAR; }
    PG8_BAR;
#undef PG8_SA
#undef PG8_SB
#undef PG8_STAGE
#undef PG8_LDA
#undef PG8_LDB
#undef PG8_MMA
#undef PG8_WAIT_V
#undef PG8_WAIT_L
#undef PG8_BAR
#undef PG8_SCHED
}
}

enum { I_X = 0, I_C, I_CTX, I_CCTX, I_WADA, I_BADA, I_WIN, I_QNORM, I_WQUP, I_KVNORM, I_WKVUP, I_SCONVW, I_SCONVB, I_SDTB, I_SALOG, I_SD, I_SNORM,
       I_HCONVW, I_HCONVB, I_HW1, I_HB1, I_HW2, I_HB2, I_HW3, I_HFREQ, I_HD, I_RMU, I_RW0, I_RWUP, I_RA0, I_RAUP, I_RGUP, I_RKK, I_RKA, I_RRK, I_RLNG, I_RLNB,
       I_WBR, I_WOUT, I_LN1G, I_LN1B, I_WROUTER, I_WGATE, I_WUP, I_WDOWN, I_LN2G, I_LN2B, N_INPUTS };
struct Args { const float* in[N_INPUTS]; float* out; unsigned char* ws; int ph_lo, ph_hi; };
static_assert(sizeof(Args) == (N_INPUTS + 2) * 8 + 8, "Args has no padding");

__device__ __forceinline__ const float* arg_in(const Args& a, int i) { asm volatile("" : "+s"(i)); return a.in[i]; }
__device__ __forceinline__ int opqs(int v) { asm volatile("" : "+s"(v)); return v; }
__device__ __forceinline__ int opqv(int v) { asm volatile("" : "+v"(v)); return v; }
__device__ __forceinline__ unsigned char* opq(unsigned char* p) { asm volatile("" : "+s"(p)); return p; }
struct Frame {
    LAS unsigned char* lds;
    int tid, lane, wave, G, bid, gw, NGW;
    unsigned char* ws;
};
#define WSP(T_, off) ((T_*)(F.ws + (off)))

template <class RowMap>
__device__ __forceinline__ void transpose_item(const float* W, int ldw, bf16_t* WT, int ldt, int k0, int n0, const float* kscale, int koff, RowMap rm, LAS float* scr, int lane) {
#pragma unroll 8
    for (int i = 0; i < 32; ++i) { const int kk = 2 * i + (lane >> 5); float v = W[(size_t)(k0 + kk) * ldw + n0 + (lane & 31)]; if (kscale) v *= kscale[k0 + kk]; scr[kk * 33 + (lane & 31)] = v; }
    LDS_WAIT(); asm volatile("" ::: "memory");
    const int c = lane & 7;
#pragma unroll
    for (int j = 0; j < 4; ++j) { const int n = (lane >> 3) + 8 * j; const LAS float* s = scr + (8 * c) * 33 + n;
        u32x4 o; o.x = pk2(s[0 * 33], s[1 * 33]); o.y = pk2(s[2 * 33], s[3 * 33]); o.z = pk2(s[4 * 33], s[5 * 33]); o.w = pk2(s[6 * 33], s[7 * 33]);
        *(u32x4*)(WT + (size_t)rm(n0 + n) * ldt + koff + k0 + 8 * c) = o; }
    LDS_WAIT(); asm volatile("" ::: "memory");
}
struct RmId { __device__ int operator()(int n) const { return n; } };
struct RmGateUp { int up; __device__ int operator()(int n) const { return 256 * (n >> 7) + (n & 127) + (up ? 128 : 0); } };
template <class RowMap>
__device__ __forceinline__ void transpose_item_fp8(const float* W, int ldw, unsigned char* WT, int ldt, int k0, int n0, float sc, RowMap rm, LAS float* scr, int lane) {
#pragma unroll 8
    for (int i = 0; i < 32; ++i) { const int kk = 2 * i + (lane >> 5); scr[kk * 33 + (lane & 31)] = W[(size_t)(k0 + kk) * ldw + n0 + (lane & 31)] * sc; }
    LDS_WAIT(); asm volatile("" ::: "memory");
    const int c = lane & 3;
#pragma unroll
    for (int j = 0; j < 2; ++j) { const int n = (lane >> 2) + 16 * j; const LAS float* s = scr + (16 * c) * 33 + n;
        u32x4 o; o.x = pk4fp8(s[0 * 33], s[1 * 33], s[2 * 33], s[3 * 33]); o.y = pk4fp8(s[4 * 33], s[5 * 33], s[6 * 33], s[7 * 33]);
        o.z = pk4fp8(s[8 * 33], s[9 * 33], s[10 * 33], s[11 * 33]); o.w = pk4fp8(s[12 * 33], s[13 * 33], s[14 * 33], s[15 * 33]);
        *(u32x4*)(WT + (size_t)rm(n0 + n) * ldt + k0 + 16 * c) = o; }
    LDS_WAIT(); asm volatile("" ::: "memory");
}

__device__ __forceinline__ void p0_weights(Frame& F, const Args& a) {
    LAS float* scr = (LAS float*)(F.lds + F.wave * 8704);
    constexpr int IT_IN = 32 * 576, IT_BR = 16 * 64, IT_OUT = 32 * 64, IT_Q = 8 * 48, IT_KV = 8 * 64;
    constexpr int PER_L = IT_IN + 4 * IT_BR + IT_OUT + IT_Q + IT_KV;
    for (int it = F.gw; it < DEPTH * PER_L; it += F.NGW) {
        const int l = it / PER_L; int r = it % PER_L;
        if (r < IT_IN) { const int kb = r / 576, nb = r % 576;
            if (nb * 32 < NNG) transpose_item(arg_in(a, I_WIN) + (size_t)l * DM * NIN, NIN, WSP(bf16_t, WS_WIN + l * SZ_WIN), DM, kb * 64, nb * 32, nullptr, 0, RmId(), scr, F.lane);
            else transpose_item_fp8(arg_in(a, I_WIN) + (size_t)l * DM * NIN + NNG, NIN, WSP(unsigned char, WS_WIN + l * SZ_WIN) + (size_t)NNG * DM * 2, DM, kb * 64, nb * 32 - NNG, 64.f, RmId(), scr, F.lane);
            continue; } r -= IT_IN;
        if (r < 4 * IT_BR) { const int br = r / IT_BR, q = r % IT_BR, kb = q / 64, nb = q % 64;
            transpose_item(arg_in(a, I_WBR) + ((size_t)l * 4 + br) * 1024 * DM, DM, WSP(bf16_t, WS_WBR + l * SZ_WBR) + (size_t)br * DM * 1024, 1024, kb * 64, nb * 32, nullptr, 0, RmId(), scr, F.lane); continue; } r -= 4 * IT_BR;
        if (r < IT_OUT) { const int kb = r / 64, nb = r % 64;
            transpose_item(arg_in(a, I_WOUT) + (size_t)l * DM * DM, DM, WSP(bf16_t, WS_WOUT + l * SZ_WOUT), DM, kb * 64, nb * 32, nullptr, 0, RmId(), scr, F.lane); continue; } r -= IT_OUT;
        if (r < IT_Q) { const int kb = r / 48, nb = r % 48;
            transpose_item(arg_in(a, I_WQUP) + (size_t)l * 512 * 1536, 1536, WSP(bf16_t, WS_WQ + l * SZ_WQ), 512, kb * 64, nb * 32, arg_in(a, I_QNORM) + l * 512, 0, RmId(), scr, F.lane); continue; } r -= IT_Q;
        { const int kb = r / 64, nb = r % 64;
            transpose_item(arg_in(a, I_WKVUP) + (size_t)l * 512 * 2048, 2048, WSP(bf16_t, WS_WKV + l * SZ_WKV), 512, kb * 64, nb * 32, arg_in(a, I_KVNORM) + l * 512, 0, RmId(), scr, F.lane); }
    }
    for (size_t e = (size_t)F.bid * NTHREADS + F.tid; e < (size_t)DEPTH * 5120 * 512; e += (size_t)F.G * NTHREADS) {
        const int l = (int)(e / (5120 * 512)); const int rem = (int)(e % (5120 * 512)); const int n = rem / 512, kc = rem % 512; const int blk = n >> 10, c = n & 1023;
        float v = 0.f;
        if (blk < 2) { if (kc >= 64 * blk && kc < 64 * blk + 64) v = arg_in(a, I_RWUP)[(((size_t)l * 2 + blk) * 64 + (kc - 64 * blk)) * 1024 + c]; }
        else if (blk < 4) { const int d = blk - 2; if (kc >= 128 + 64 * d && kc < 192 + 64 * d) v = arg_in(a, I_RAUP)[(((size_t)l * 2 + d) * 64 + (kc - 128 - 64 * d)) * 1024 + c]; }
        else { if (kc >= 256 && kc < 416) v = arg_in(a, I_RGUP)[((size_t)l * 160 + (kc - 256)) * 1024 + c]; }
        WSP(bf16_t, WS_WLORA)[e] = (bf16_t)f2bf(v);
    }
}
constexpr int EFFP = 1536;
constexpr size_t SZ_WGU8 = (size_t)NEXP * 2816 * DM, SZ_WD8 = (size_t)NEXP * DM * EFFP;
__device__ __forceinline__ void conv_experts(Frame& F, const Args& a, int l) {
    LAS float* scr = (LAS float*)(F.lds + F.wave * 8704);
    constexpr int IT_G = 32 * 44, IT_D = 22 * 64, PER_E = 2 * IT_G + IT_D;
    unsigned char* wgu = WSP(unsigned char, WS_WE); unsigned char* wd = WSP(unsigned char, WS_WE + SZ_WGU8);
    for (int it = F.gw; it < NEXP * PER_E; it += F.NGW) {
        const int e = it / PER_E; int r = it % PER_E;
        if (r < 2 * IT_G) { const int up = r / IT_G, q = r % IT_G, kb = q / 44, nb = q % 44;
            const float* src = arg_in(a, up ? I_WUP : I_WGATE) + ((size_t)l * NEXP + e) * DM * EFF;
            RmGateUp rm; rm.up = up;
            transpose_item_fp8(src, EFF, wgu + (size_t)e * 2816 * DM, DM, kb * 64, nb * 32, 64.f, rm, scr, F.lane); continue; } r -= 2 * IT_G;
        { const int kb = r / 64, nb = r % 64;
            transpose_item_fp8(arg_in(a, I_WDOWN) + ((size_t)l * NEXP + e) * EFF * DM, DM, wd + (size_t)e * DM * EFFP, EFFP, kb * 64, nb * 32, 64.f, RmId(), scr, F.lane); }
    }
    for (int i = F.bid * NTHREADS + F.tid; i < NEXP * DM * 8; i += F.G * NTHREADS) { const int rowi = i >> 3, q = i & 7; unsigned zz = 0u; asm volatile("" : "+v"(zz));
        *(u32x4*)(wd + (size_t)rowi * EFFP + EFF + q * 16) = (u32x4){zz, zz, zz, zz}; }
}
__device__ __forceinline__ void p0_mod(Frame& F, const Args& a) {
    LAS float* sv = (LAS float*)(F.lds + 69632);
    for (int i = F.tid; i < 3 * DM; i += NTHREADS) { const int v = i / DM, k = i % DM; const float x = v < 2 ? arg_in(a, I_C)[v * DM + k] : arg_in(a, I_CCTX)[k]; sv[i] = siluf_(x); }
    __syncthreads();
    float* mod = (float*)(F.ws + WS_CTL) + CW_MOD;
    LAS float* red = (LAS float*)(F.lds + 69632 + 3 * DM * 4);
    for (int u = F.bid; u < DEPTH * (6 * DM / 128); u += F.G) {
        const int l = u / (6 * DM / 128), nb = u % (6 * DM / 128); const int kg = F.tid >> 7, cl = F.tid & 127, n = nb * 128 + cl;
        const float* w = arg_in(a, I_WADA) + ((size_t)l * DM + kg * 512) * (6 * DM) + n;
        float a0 = 0.f, a1 = 0.f, a2 = 0.f;
#pragma unroll 8
        for (int k = 0; k < 512; ++k) { const float wv = w[(size_t)k * (6 * DM)]; const int kk = kg * 512 + k; a0 += sv[kk] * wv; a1 += sv[DM + kk] * wv; a2 += sv[2 * DM + kk] * wv; }
        __syncthreads();
        red[(kg * 3 + 0) * 128 + cl] = a0; red[(kg * 3 + 1) * 128 + cl] = a1; red[(kg * 3 + 2) * 128 + cl] = a2;
        __syncthreads();
        if (F.tid < 384) { const int v = F.tid >> 7; const float b = arg_in(a, I_BADA)[l * 6 * DM + n];
            mod[(l * 3 + v) * 6 * DM + n] = b + ((red[(0 * 3 + v) * 128 + cl] + red[(1 * 3 + v) * 128 + cl]) + (red[(2 * 3 + v) * 128 + cl] + red[(3 * 3 + v) * 128 + cl])); }
    }
}

__device__ __forceinline__ void row_stats(const f32x4 (&v)[8], float& mean, float& rstd, float eps) {
    float s = 0.f;
#pragma unroll
    for (int j = 0; j < 8; ++j) s += (v[j].x + v[j].y) + (v[j].z + v[j].w);
    mean = wave_sum(s) * (1.f / DM);
    float s2 = 0.f;
#pragma unroll
    for (int j = 0; j < 8; ++j) { const f32x4 d = v[j] - mean; s2 += (d.x * d.x + d.y * d.y) + (d.z * d.z + d.w * d.w); }
    rstd = 1.f / sqrtf(wave_sum(s2) * (1.f / DM) + eps);
}
__device__ __forceinline__ const float* x_src_row(const Args& a, const Frame& F, int layer, int row) {
    if (layer == 0) return row < TC ? arg_in(a, I_CTX) + (size_t)row * DM : arg_in(a, I_X) + (size_t)(row - TC) * DM;
    return (const float*)(F.ws + WS_XS) + (size_t)row * DM;
}
__device__ __forceinline__ void phase_modln(Frame& F, const Args& a, int layer) {
    const float* mod = (const float*)(F.ws + WS_CTL) + CW_MOD + (size_t)layer * 3 * 6 * DM;
    bf16_t* H = WSP(bf16_t, WS_H); unsigned* H8 = WSP(unsigned, WS_H8);
    for (int row = F.gw; row < T; row += F.NGW) {
        const f32x4* xr = (const f32x4*)x_src_row(a, F, layer, row) + F.lane;
        f32x4 v[8];
#pragma unroll
        for (int j = 0; j < 8; ++j) v[j] = xr[64 * j];
        float mean, rstd; row_stats(v, mean, rstd, 1e-6f);
        const float* m = mod + (size_t)row_modidx(row) * 6 * DM;
        u32x2* o = (u32x2*)(H + (size_t)row * DM) + F.lane; unsigned* o8 = H8 + (size_t)row * (DM / 4) + F.lane;
#pragma unroll
        for (int j = 0; j < 8; ++j) { const int c = 4 * (64 * j + F.lane); const f32x4 sh = *(const f32x4*)(m + c), sc = *(const f32x4*)(m + DM + c);
            const f32x4 y = (v[j] - mean) * rstd * (sc + 1.f) + sh; u32x2 w; w.x = pk2(y.x, y.y); w.y = pk2(y.z, y.w); o[64 * j] = w; o8[64 * j] = pk4fp8(y.x, y.y, y.z, y.w); }
    }
}

__device__ __forceinline__ void phase_hdn(Frame& F, const Args& a, int layer) {
    LAS float* zs = (LAS float*)(F.lds + F.wave * 512);
    const float* w1 = arg_in(a, I_HW1) + (size_t)layer * 33 * 64; const float* b1 = arg_in(a, I_HB1) + layer * 64;
    const float* w2 = arg_in(a, I_HW2) + (size_t)layer * 64 * 64; const float* b2 = arg_in(a, I_HB2) + layer * 64;
    const float fr = arg_in(a, I_HFREQ)[layer * 64 + F.lane];
    float* HDN = WSP(float, WS_HDN + layer * SZ_HDN1);
    for (int r = F.gw; r < SEQ + CTX; r += F.NGW) {
        const int n = r < SEQ ? SEQ : CTX, t = r < SEQ ? r : r - SEQ;
        const float wpos = (6.283185307179586f * (float)t) / (float)n;
        if (F.lane < 33) { float z;
            if (F.lane == 0) z = (float)t / (float)(n - 1);
            else { const int b = (F.lane - 1) & 15; const float f = 1e-4f + (float)b * ((15.f - 1e-4f) / 15.f); const float ang = f * wpos; z = F.lane <= 16 ? __cosf(ang) : -__sinf(ang); }
            zs[F.lane] = z; }
        LDS_WAIT(); asm volatile("" ::: "memory");
        float p = b1[F.lane];
#pragma unroll
        for (int i = 0; i < 33; ++i) p += zs[i] * w1[i * 64 + F.lane];
        const float h1 = __sinf(fr * p);
        zs[64 + F.lane] = h1;
        LDS_WAIT(); asm volatile("" ::: "memory");
        float q = b2[F.lane];
#pragma unroll 16
        for (int i = 0; i < 64; ++i) q += zs[64 + i] * w2[i * 64 + F.lane];
        HDN[(size_t)r * 64 + F.lane] = __sinf(fr * q);
        LDS_WAIT(); asm volatile("" ::: "memory");
    }
}
__device__ __forceinline__ float hy_delta(int c) { const float mn = -3.0701134573253943f, mx = -15.350567286626972f; return fabsf(mn + (float)c * ((mx - mn) / 1023.f)); }
__device__ __forceinline__ void phase_filt(Frame& F, const Args& a, int layer) {
    const float* w3 = arg_in(a, I_HW3) + (size_t)layer * 64 * 2048; const float* HDN = WSP(float, WS_HDN + layer * SZ_HDN1);
    LAS float* ws3 = (LAS float*)F.lds;
    bf16_t* FILT = WSP(bf16_t, WS_FILT);
    for (int u = F.bid; u < 32 * 16; u += F.G) {
        const int cb = u / 16, tb = u % 16, col0 = cb * 64, t = tb * 512 + F.tid;
        __syncthreads();
        for (int i = F.tid; i < 4096; i += NTHREADS) { const int j = i >> 6, cc = i & 63; ws3[cc * 64 + j] = w3[(size_t)j * 2048 + col0 + cc]; }
        __syncthreads();
        f32x4 h[16];
#pragma unroll
        for (int i = 0; i < 16; ++i) h[i] = *(const f32x4*)(HDN + (size_t)t * 64 + 4 * i);
        const float tn = (float)t / (float)(SEQ - 1);
        for (int cc = 0; cc < 64; ++cc) {
            float acc = 0.f;
#pragma unroll
            for (int i = 0; i < 16; ++i) { const f32x4 w = *(const LAS f32x4*)(ws3 + cc * 64 + 4 * i); acc += h[i].x * w.x + h[i].y * w.y + h[i].z * w.z + h[i].w * w.w; }
            const int col = col0 + cc, side = col >> 10, c = col & 1023;
            FILT[((size_t)c * 2 + side) * SEQ + t] = (bf16_t)f2bf(acc * __expf(-tn * hy_delta(c)));
        }
    }
    float* FILTC = WSP(float, WS_FILTC);
    for (int e = F.bid * NTHREADS + F.tid; e < CTX * 2048; e += F.G * NTHREADS) {
        const int lag = e >> 11, col = e & 2047, c = col & 1023; const float* hr = HDN + (size_t)(SEQ + lag) * 64; float acc = 0.f;
#pragma unroll 16
        for (int j = 0; j < 64; ++j) acc += hr[j] * w3[(size_t)j * 2048 + col];
        FILTC[e] = acc * __expf(-((float)lag / (float)(CTX - 1)) * hy_delta(c));
    }
}

__device__ __forceinline__ void ld8bf(const bf16_t* p, float (&o)[8]) { const u32x4 w = *(const u32x4*)p; o[0] = bflo(w.x); o[1] = bfhi(w.x); o[2] = bflo(w.y); o[3] = bfhi(w.y); o[4] = bflo(w.z); o[5] = bfhi(w.z); o[6] = bflo(w.w); o[7] = bfhi(w.w); }
__device__ __forceinline__ void st8bf(bf16_t* p, const float (&v)[8]) { u32x4 w; w.x = pk2(v[0], v[1]); w.y = pk2(v[2], v[3]); w.z = pk2(v[4], v[5]); w.w = pk2(v[6], v[7]); *(u32x4*)p = w; }
__device__ __forceinline__ void ld8f(const float* p, float (&o)[8]) { const f32x4 a = *(const f32x4*)p, b = *(const f32x4*)(p + 4); o[0] = a.x; o[1] = a.y; o[2] = a.z; o[3] = a.w; o[4] = b.x; o[5] = b.y; o[6] = b.z; o[7] = b.w; }

constexpr int PREP_RUN = 16;
__device__ __forceinline__ void phase_prep(Frame& F, const Args& a, int layer) {
    const bf16_t* P = WSP(bf16_t, WS_P); bf16_t* P2 = WSP(bf16_t, WS_P2);
    float* RS = WSP(float, WS_RS); bf16_t* KPE = WSP(bf16_t, WS_KPE); float* DT = WSP(float, WS_DT);
    bf16_t* KK = WSP(bf16_t, WS_KK); bf16_t* AL_ = WSP(bf16_t, WS_ALORA); float* VC = WSP(float, WS_VC);
    const float* scw = arg_in(a, I_SCONVW) + (size_t)layer * 3 * 1536; const float* scb = arg_in(a, I_SCONVB) + layer * 1536; const float* dtb = arg_in(a, I_SDTB) + layer * 32;
    const float* hcw = arg_in(a, I_HCONVW) + (size_t)layer * 3 * 3072; const float* hcb = arg_in(a, I_HCONVB) + layer * 3072;
    const float* mu = arg_in(a, I_RMU) + (size_t)layer * 2 * 3488; const float* rkk = arg_in(a, I_RKK) + layer * 1024;
    const int lane = F.lane;
    for (int item = F.gw; item < (T / PREP_RUN) * 13; item += F.NGW) {
        const int run = item / 13, ct = item % 13; const int r0 = run * PREP_RUN;
        if (ct == 0) {
#pragma unroll 1
        for (int rr = 0; rr < PREP_RUN; ++rr) { const int row = r0 + rr; const bf16_t* pr = P + (size_t)row * NNG;
            float x[8]; ld8bf(pr + P_CQ + lane * 8, x); float s = 0.f;
#pragma unroll
            for (int i = 0; i < 8; ++i) s += x[i] * x[i];
            s = wave_sum(s); const float rq = 1.f / sqrtf(s * (1.f / 512.f) + 1e-6f);
            ld8bf(pr + P_CKV + lane * 8, x); s = 0.f;
#pragma unroll
            for (int i = 0; i < 8; ++i) s += x[i] * x[i];
            s = wave_sum(s); const float rk = 1.f / sqrtf(s * (1.f / 512.f) + 1e-6f);
            if (lane == 0) { RS[row * 2] = rq; RS[row * 2 + 1] = rk; }
            float kv = bf2f(pr[P_KPE + lane]);
            const float other = swz16(kv);
            if (row >= TC) { const int t = (row - TC) & (SEQ - 1); const int axis = lane >> 5, half = (lane >> 4) & 1, j = lane & 15;
                const float pos = (float)(axis == 0 ? (t >> 6) : (t & 63)); const float inv = __builtin_amdgcn_exp2f(-(float)j * 0.8304820237218406f);
                const float sn = __sinf(pos * inv), cs = __cosf(pos * inv);
                kv = half == 0 ? kv * cs - other * sn : kv * cs + other * sn; }
            KPE[(size_t)row * 64 + lane] = (bf16_t)f2bf(kv);
            if (lane < 32) DT[(size_t)row * 32 + lane] = softplusf_(bf2f(pr[P_DT + lane]) + dtb[lane]); }
        continue; }
        const bool first = row_first(r0), last = row_last(r0 + PREP_RUN - 1);
        if (ct >= 1 && ct <= 3) { const int ch = ct - 1; const int c = ch * 512 + lane * 8; float xm[8], x0[8], xp[8], w0[8], w1[8], w2[8], bb[8];
            ld8f(scw + c, w0); ld8f(scw + 1536 + c, w1); ld8f(scw + 3072 + c, w2); ld8f(scb + c, bb);
            const bf16_t* pc = P + (size_t)r0 * NNG + P_XBC + c;
            if (!first) ld8bf(pc - NNG, xm); else { for (int i = 0; i < 8; ++i) xm[i] = 0.f; }
            ld8bf(pc, x0);
#pragma unroll 2
            for (int rr = 0; rr < PREP_RUN; ++rr) {
                if (rr + 1 < PREP_RUN || !last) ld8bf(pc + (size_t)(rr + 1) * NNG, xp); else { for (int i = 0; i < 8; ++i) xp[i] = 0.f; }
                float o[8];
#pragma unroll
                for (int i = 0; i < 8; ++i) { o[i] = siluf_(xm[i] * w0[i] + x0[i] * w1[i] + xp[i] * w2[i] + bb[i]); xm[i] = x0[i]; x0[i] = xp[i]; }
                st8bf(P2 + (size_t)(r0 + rr) * P2W + P2_XBC + c, o); } continue; }
        if (ct >= 4 && ct <= 5) { const int ch = ct - 4; { const int c = ch * 512 + lane * 8; float xm[8], x0[8], xp[8], w0[8], w1[8], w2[8], bb[8];
            ld8f(hcw + c, w0); ld8f(hcw + 3072 + c, w1); ld8f(hcw + 6144 + c, w2); ld8f(hcb + c, bb);
            const bf16_t* pc = P + (size_t)r0 * NNG + P_HY + c;
            if (!first) ld8bf(pc - NNG, xm); else { for (int i = 0; i < 8; ++i) xm[i] = 0.f; }
            ld8bf(pc, x0);
#pragma unroll 2
            for (int rr = 0; rr < PREP_RUN; ++rr) {
                if (rr + 1 < PREP_RUN || !last) ld8bf(pc + (size_t)(rr + 1) * NNG, xp); else { for (int i = 0; i < 8; ++i) xp[i] = 0.f; }
                float o[8];
#pragma unroll
                for (int i = 0; i < 8; ++i) { o[i] = xm[i] * w0[i] + x0[i] * w1[i] + xp[i] * w2[i] + bb[i]; xm[i] = x0[i]; x0[i] = xp[i]; }
                st8bf(P2 + (size_t)(r0 + rr) * P2W + P2_X0 + c, o); } }
        if (r0 < TC) {
#pragma unroll 1
                for (int rr = 0; rr < PREP_RUN; ++rr) { const int row = r0 + rr; const bool f1 = row_first(row), l1 = row_last(row); const int c = ch * 512 + lane * 8;
                    const bf16_t* pr = P + (size_t)row * NNG; float o1[8], o2[8];
#pragma unroll
                    for (int part = 1; part < 3; ++part) { float x0[8], xm[8], xp[8], w0[8], w1[8], w2[8], bb[8]; const int cc = part * 1024 + c;
                        ld8bf(pr + P_HY + cc, x0);
                        if (!f1) ld8bf(pr - NNG + P_HY + cc, xm); else { for (int i = 0; i < 8; ++i) xm[i] = 0.f; }
                        if (!l1) ld8bf(pr + NNG + P_HY + cc, xp); else { for (int i = 0; i < 8; ++i) xp[i] = 0.f; }
                        ld8f(hcw + cc, w0); ld8f(hcw + 3072 + cc, w1); ld8f(hcw + 6144 + cc, w2); ld8f(hcb + cc, bb);
#pragma unroll
                        for (int i = 0; i < 8; ++i) { const float r = xm[i] * w0[i] + x0[i] * w1[i] + xp[i] * w2[i] + bb[i]; if (part == 1) o1[i] = r; else o2[i] = r; } }
                    float* vc = VC + (size_t)row * 1024 + c;
                    *(f32x4*)vc = (f32x4){o1[0] * o2[0], o1[1] * o2[1], o1[2] * o2[2], o1[3] * o2[3]};
                    *(f32x4*)(vc + 4) = (f32x4){o1[4] * o2[4], o1[5] * o2[5], o1[6] * o2[6], o1[7] * o2[7]}; } }
        continue; }
        { const int ch = ct - 6; const int c = ch * 512 + lane * 8;
            if (c < 3488) { float um[8], u0[8], up[8], m0[8], m1[8], g8[8];
                ld8f(mu + c, m0); ld8f(mu + 3488 + c, m1);
                if (ch == 2 || ch == 3) ld8f(rkk + (c - 1024), g8);
                const bf16_t* pc = P + (size_t)r0 * NNG + P_RW + c;
                if (!first) ld8bf(pc - NNG, um); else { for (int i = 0; i < 8; ++i) um[i] = 0.f; }
                ld8bf(pc, u0);
#pragma unroll 2
                for (int rr = 0; rr < PREP_RUN; ++rr) { const int row = r0 + rr;
                    if (rr + 1 < PREP_RUN || !last) ld8bf(pc + (size_t)(rr + 1) * NNG, up); else { for (int i = 0; i < 8; ++i) up[i] = 0.f; }
                    float us[8];
#pragma unroll
                    for (int i = 0; i < 8; ++i) { us[i] = u0[i] + m0[i] * (um[i] - u0[i]) + m1[i] * (up[i] - u0[i]); um[i] = u0[i]; u0[i] = up[i]; }
                    if (ch < 6) st8bf(P2 + (size_t)row * P2W + P2_RKV + c, us);
                    if (ch == 2 || ch == 3) { float kx[8]; float s = 0.f;
#pragma unroll
                        for (int i = 0; i < 8; ++i) { kx[i] = us[i] * g8[i]; s += kx[i] * kx[i]; }
                        s = sum8(s);
                        const float inv = 1.f / fmaxf(sqrtf(s), 1e-12f);
#pragma unroll
                        for (int i = 0; i < 8; ++i) kx[i] *= inv;
                        st8bf(KK + (size_t)row * 1024 + (c - 1024), kx); }
                    if (ch == 6) { const int cl = c - 3072; float o[8];
#pragma unroll
                        for (int i = 0; i < 8; ++i) o[i] = cl < 128 ? tanhf_(us[i]) : cl < 256 ? us[i] : sigmoidf_(us[i]);
                        st8bf(AL_ + (size_t)row * 512 + cl, o); } } }
            else if (ch == 6) { const int cl = c - 3072;
                for (int rr = 0; rr < PREP_RUN; ++rr) { float zz = 0.f; asm volatile("" : "+v"(zz)); float o[8] = {zz, zz, zz, zz, zz, zz, zz, zz}; st8bf(AL_ + (size_t)(r0 + rr) * 512 + cl, o); } } }
    }
    float* VT = WSP(float, WS_VT);
    LAS float* tl = (LAS float*)F.lds;
    for (int u = F.bid; u < (TL / 64) * 4; u += F.G) {
        const int tb = u >> 2, cb = u & 3; const int row0 = TC + tb * 64; const int c8 = (F.tid & 31) * 8, c = cb * 256 + c8, tq = F.tid >> 5;
        float w1[3][8], w2[3][8], b1[8], b2[8];
#pragma unroll
        for (int k = 0; k < 3; ++k) { ld8f(hcw + k * 3072 + 1024 + c, w1[k]); ld8f(hcw + k * 3072 + 2048 + c, w2[k]); }
        ld8f(hcb + 1024 + c, b1); ld8f(hcb + 2048 + c, b2);
        __syncthreads();
#pragma unroll 1
        for (int i = 0; i < 4; ++i) { const int tl_ = tq * 4 + i, row = row0 + tl_; const bf16_t* pr = P + (size_t)row * NNG + P_HY;
            const bool first = row_first(row), last = row_last(row);
            float a1[8], a2[8], x[8];
            ld8bf(pr + 1024 + c, x);
#pragma unroll
            for (int j = 0; j < 8; ++j) a1[j] = x[j] * w1[1][j] + b1[j];
            ld8bf(pr + 2048 + c, x);
#pragma unroll
            for (int j = 0; j < 8; ++j) a2[j] = x[j] * w2[1][j] + b2[j];
            if (!first) { ld8bf(pr - NNG + 1024 + c, x);
#pragma unroll
                for (int j = 0; j < 8; ++j) a1[j] += x[j] * w1[0][j];
                ld8bf(pr - NNG + 2048 + c, x);
#pragma unroll
                for (int j = 0; j < 8; ++j) a2[j] += x[j] * w2[0][j]; }
            if (!last) { ld8bf(pr + NNG + 1024 + c, x);
#pragma unroll
                for (int j = 0; j < 8; ++j) a1[j] += x[j] * w1[2][j];
                ld8bf(pr + NNG + 2048 + c, x);
#pragma unroll
                for (int j = 0; j < 8; ++j) a2[j] += x[j] * w2[2][j]; }
#pragma unroll
            for (int j = 0; j < 8; ++j) tl[(c8 + j) * 65 + tl_] = a1[j] * a2[j]; }
        __syncthreads();
        const int b = (row0 - TC) >> 13, t0 = (row0 - TC) & (SEQ - 1);
        for (int p_ = 0; p_ < 8; ++p_) { const int cl = p_ * 32 + (F.tid >> 4), q = F.tid & 15;
            const f32x4 o = {tl[cl * 65 + 4 * q], tl[cl * 65 + 4 * q + 1], tl[cl * 65 + 4 * q + 2], tl[cl * 65 + 4 * q + 3]};
            *(f32x4*)(VT + ((size_t)(cb * 256 + cl) * 2 + b) * SEQ + t0 + 4 * q) = o; }
    }
}

using pg8::Unit;
#define EPI_LOOP_BEGIN const int row0 = u.pm * 256 + wr * 64 + fr; \
    _Pragma("unroll") for (int ai = 0; ai < 2; ++ai) _Pragma("unroll") for (int m = 0; m < 4; ++m) { const int row = row0 + ai * 128 + m * 16; \
    _Pragma("unroll") for (int bj = 0; bj < 2; ++bj) { const int cl = bj * 128 + wc * 32 + 8 * fq; const f32x4 v0 = acc[ai][bj][m][0], v1 = acc[ai][bj][m][1];
#define EPI_LOOP_END } __builtin_amdgcn_sched_barrier(0); }
struct EpiBf16 {
    static constexpr bool PERM = true;
    bf16_t* O; int ldc; const float* rscale; int rs_stride; int act; float cscale;
    __device__ __forceinline__ void operator()(const f32x4 (&acc)[2][2][4][2], const Unit& u, int wr, int wc, int fr, int fq) const {
        EPI_LOOP_BEGIN
            const float s = rscale ? rscale[(size_t)row * rs_stride] : cscale;
            float x[8] = {v0.x * s, v0.y * s, v0.z * s, v0.w * s, v1.x * s, v1.y * s, v1.z * s, v1.w * s};
            if (act == 1) {
#pragma unroll
                for (int i = 0; i < 8; ++i) x[i] = sigmoidf_(x[i]); }
            u32x4 w; w.x = cvt_pk_bf16(x[0], x[1]); w.y = cvt_pk_bf16(x[2], x[3]); w.z = cvt_pk_bf16(x[4], x[5]); w.w = cvt_pk_bf16(x[6], x[7]);
            *(u32x4*)(O + (size_t)row * ldc + u.pn * 256 + cl) = w;
        EPI_LOOP_END
    }
};
struct EpiLora {
    static constexpr bool PERM = true;
    bf16_t* EW; bf16_t* ICLR; bf16_t* GG; const float* w0; const float* a0;
    __device__ __forceinline__ void operator()(const f32x4 (&acc)[2][2][4][2], const Unit& u, int wr, int wc, int fr, int fq) const {
        const int blk = u.pn >> 2, cb = (u.pn & 3) * 256;
        const float* bias = blk < 2 ? w0 + blk * 1024 : a0 + (blk & 1) * 1024;
        bf16_t* dbase = blk < 2 ? EW + (size_t)blk * T * 1024 : blk < 4 ? ICLR + (size_t)(blk - 2) * T * 1024 : GG;
        const float scale = blk < 2 ? 0.6065306597126334f : 1.f; const bool sig = blk < 4;
        EPI_LOOP_BEGIN
            const int c = cb + cl; float x[8] = {v0.x, v0.y, v0.z, v0.w, v1.x, v1.y, v1.z, v1.w};
            if (sig) { const f32x4 b0 = *(const f32x4*)(bias + c), b1 = *(const f32x4*)(bias + c + 4); const float bb[8] = {b0.x, b0.y, b0.z, b0.w, b1.x, b1.y, b1.z, b1.w};
#pragma unroll
                for (int i = 0; i < 8; ++i) x[i] = scale * sigmoidf_(bb[i] + x[i]); }
            u32x4 w; w.x = cvt_pk_bf16(x[0], x[1]); w.y = cvt_pk_bf16(x[2], x[3]); w.z = cvt_pk_bf16(x[4], x[5]); w.w = cvt_pk_bf16(x[6], x[7]);
            *(u32x4*)(dbase + (size_t)row * 1024 + c) = w;
        EPI_LOOP_END
    }
};
struct EpiMerge {
    static constexpr bool PERM = true;
    const bf16_t* gates; float* MF; bf16_t* MB;
    __device__ __forceinline__ void operator()(const f32x4 (&acc)[2][2][4][2], const Unit& uu, int wr, int wc, int fr, int fq) const {
        const int br = uu.pn >> 3; Unit u; u.pm = uu.pm - br * 66; u.pn = uu.pn & 7;
        EPI_LOOP_BEGIN
            const int col = u.pn * 256 + cl; float g[8]; ld8bf(gates + (size_t)row * NGATE + br * DM + col, g);
#pragma unroll
            for (int i = 0; i < 8; ++i) g[i] = sigmoidf_(g[i]);
            float x[8] = {v0.x * g[0], v0.y * g[1], v0.z * g[2], v0.w * g[3], v1.x * g[4], v1.y * g[5], v1.z * g[6], v1.w * g[7]};
            float* mf = MF + (size_t)row * DM + col;
            if (br > 0) { const f32x4 p0 = *(const f32x4*)mf, p1 = *(const f32x4*)(mf + 4); x[0] += p0.x; x[1] += p0.y; x[2] += p0.z; x[3] += p0.w; x[4] += p1.x; x[5] += p1.y; x[6] += p1.z; x[7] += p1.w; }
            if (br < 3) { *(f32x4*)mf = (f32x4){x[0], x[1], x[2], x[3]}; *(f32x4*)(mf + 4) = (f32x4){x[4], x[5], x[6], x[7]}; }
            else { u32x4 w; w.x = cvt_pk_bf16(x[0], x[1]); w.y = cvt_pk_bf16(x[2], x[3]); w.z = cvt_pk_bf16(x[4], x[5]); w.w = cvt_pk_bf16(x[6], x[7]); *(u32x4*)(MB + (size_t)row * DM + col) = w; }
        EPI_LOOP_END
    }
};
struct OrderMerge {
    pg8::StaticOrder so;
    __device__ void init(int G, int c, int nM, int pm0) { so.init(nM, 8, G, c, pm0); }
    __device__ bool next(int i, Unit& u) const { Unit t; if (!so.next(i >> 2, t)) return false; const int br = i & 3; u.pm = br * 66 + t.pm; u.pn = br * 8 + t.pn; return true; }
};
struct EpiF32 {
    static constexpr bool PERM = true;
    float* O; int ldc;
    __device__ __forceinline__ void operator()(const f32x4 (&acc)[2][2][4][2], const Unit& u, int wr, int wc, int fr, int fq) const {
        EPI_LOOP_BEGIN
            float* o = O + (size_t)row * ldc + u.pn * 256 + cl; *(f32x4*)o = v0; *(f32x4*)(o + 4) = v1;
        EPI_LOOP_END
    }
};
__device__ __forceinline__ int moe_panel(int e, int pi) { return pi < 8 ? (((pi >> 2) * NEXP + e) * 4 + (pi & 3)) : 128 + e; }
struct OrderMoe {
    int npn, G, c, npan;
    __device__ void init(int npn_, int G_, int c_, int npan_) { npn = npn_; G = G_; c = c_; npan = npan_; }
    __device__ bool next(int i, Unit& u) const { const int L = i * G + c; const int per = npan * npn; if (L >= NEXP * per) return false;
        const int e = L / per, r = L % per, j = r / npan, pi = r % npan; u.pm = moe_panel(e, pi); u.pn = e * npn + j; return true; }
};
struct EpiSwiglu {
    static constexpr bool PERM = true;
    unsigned char* HID;
    __device__ __forceinline__ void operator()(const f32x4 (&acc)[2][2][4][2], const Unit& u, int wr, int wc, int fr, int fq) const {
        const int j = u.pn % 11; const int row0 = u.pm * 256 + wr * 64 + fr; const float sc = 1.f / 64.f;
#pragma unroll
        for (int ai = 0; ai < 2; ++ai)
#pragma unroll
            for (int m = 0; m < 4; ++m) { const int row = row0 + ai * 128 + m * 16;
                const f32x4 g0 = acc[ai][0][m][0] * sc, g1 = acc[ai][0][m][1] * sc, u0 = acc[ai][1][m][0] * sc, u1 = acc[ai][1][m][1] * sc;
                u32x2 w; w.x = pk4fp8(siluf_(g0.x) * u0.x, siluf_(g0.y) * u0.y, siluf_(g0.z) * u0.z, siluf_(g0.w) * u0.w);
                w.y = pk4fp8(siluf_(g1.x) * u1.x, siluf_(g1.y) * u1.y, siluf_(g1.z) * u1.z, siluf_(g1.w) * u1.w);
                *(u32x2*)(HID + (size_t)row * EFFP + j * 128 + wc * 32 + 8 * fq) = w; __builtin_amdgcn_sched_barrier(0); }
    }
};
struct EpiDown {
    static constexpr bool PERM = true;
    bf16_t* YE; const float* pgate;
    __device__ __forceinline__ void operator()(const f32x4 (&acc)[2][2][4][2], const Unit& uu, int wr, int wc, int fr, int fq) const {
        Unit u; u.pm = uu.pm; u.pn = uu.pn & 7;
        EPI_LOOP_BEGIN
            const float s = pgate[row] * (1.f / 64.f);
            u32x4 w; w.x = cvt_pk_bf16(v0.x * s, v0.y * s); w.y = cvt_pk_bf16(v0.z * s, v0.w * s); w.z = cvt_pk_bf16(v1.x * s, v1.y * s); w.w = cvt_pk_bf16(v1.z * s, v1.w * s);
            *(u32x4*)(YE + (size_t)row * DM + u.pn * 256 + cl) = w;
        EPI_LOOP_END
    }
};

namespace att {
using s16x4 = __attribute__((ext_vector_type(4))) short;
using f32x16 = __attribute__((ext_vector_type(16))) float;
constexpr int NW = 8, QBLK = 32, KVBLK = 64, LDQ = 1536, LDKV = 2048, LDO = 1024;
constexpr float SCALE = 0.07216878364870322f;
constexpr float THR = 8.f;
#ifndef ATT_SDEPTH
#define ATT_SDEPTH 1
#endif
constexpr int SDEPTH = ATT_SDEPTH;
constexpr int SHM_V = KVBLK * 128 * 2, SHM_K = KVBLK * 128 * 2, SHM_KP = KVBLK * 64 * 2;
constexpr int OFF_V = 0, OFF_K = 2 * SHM_V, OFF_KP = OFF_K + 2 * SHM_K, OFF_WS = OFF_KP + 2 * SHM_KP, OFF_QP = OFF_WS + NW * 64 * 4, SHM_ATTN = OFF_QP + 256 * 256;
static_assert(SHM_ATTN <= 150 * 1024, "attention LDS");
#define KSWZ(row, colB) ((row) * 256 + ((colB) ^ (((row) & 7) << 4)))
#define KPSWZ(row, colB) ((row) * 128 + ((colB) ^ (((row) & 7) << 4)))
#define SBAR() __builtin_amdgcn_sched_barrier(0)
__device__ __forceinline__ int crow(int r, int hi) { return (r & 3) + 8 * (r >> 2) + 4 * hi; }
__device__ __forceinline__ void partialSM(f32x16& p0, f32x16& p1, float& m_reg, float& mn, float& alpha) {
  constexpr float C = SCALE * 1.4426950408889634f;
  float pmax = p0[0]; for (int r = 1; r < 16; ++r) pmax = fmaxf(pmax, p0[r]); for (int r = 0; r < 16; ++r) pmax = fmaxf(pmax, p1[r]);
  { auto rr = __builtin_amdgcn_permlane32_swap(__float_as_uint(pmax), __float_as_uint(pmax), false, false);
    pmax = fmaxf(__uint_as_float(rr[0]), __uint_as_float(rr[1])); }
  if (__builtin_expect(__all(pmax - m_reg <= THR / SCALE), 1)) { mn = m_reg; alpha = 1.f; }
  else { mn = fmaxf(m_reg, pmax); alpha = __builtin_amdgcn_exp2f((m_reg - mn) * C); m_reg = mn; }
  float mnC = -mn * C;
  for (int r = 0; r < 16; ++r) p0[r] = fmaf(p0[r], C, mnC); for (int r = 0; r < 16; ++r) p1[r] = fmaf(p1[r], C, mnC);
  for (int r = 0; r < 16; ++r) p0[r] = __builtin_amdgcn_exp2f(p0[r]);
}
__device__ __forceinline__ void finishSM(f32x16& p0, f32x16& p1, float alpha, float& l_reg, bf16x8& pa0, bf16x8& pa1, bf16x8& pa2, bf16x8& pa3) {
  for (int r = 0; r < 16; ++r) p1[r] = __builtin_amdgcn_exp2f(p1[r]);
  float ps = 0; for (int r = 0; r < 16; ++r) ps += p0[r]; for (int r = 0; r < 16; ++r) ps += p1[r];
  { auto rr = __builtin_amdgcn_permlane32_swap(__float_as_uint(ps), __float_as_uint(ps), false, false);
    ps = __uint_as_float(rr[0]) + __uint_as_float(rr[1]); }
  l_reg = l_reg * alpha + ps;
#define PK4(P, BASE, OUT) do { unsigned a0 = cvt_pk_bf16(P[BASE + 0], P[BASE + 1]), a1 = cvt_pk_bf16(P[BASE + 2], P[BASE + 3]);   \
    unsigned b0 = cvt_pk_bf16(P[BASE + 4], P[BASE + 5]), b1 = cvt_pk_bf16(P[BASE + 6], P[BASE + 7]);                              \
    auto r0 = __builtin_amdgcn_permlane32_swap(a0, b0, false, false); auto r1 = __builtin_amdgcn_permlane32_swap(a1, b1, false, false); \
    u32x4 w = {r0[0], r1[0], r0[1], r1[1]}; OUT = *reinterpret_cast<bf16x8*>(&w); } while (0)
  PK4(p0, 0, pa0); PK4(p0, 8, pa1); PK4(p1, 0, pa2); PK4(p1, 8, pa3);
#undef PK4
}
__device__ __forceinline__ void qkt(f32x16& p0, f32x16& p1, const char* Ks, const char* Kp, const bf16x8* qr, const char* Qp, int qrow, int r32, int hi) {
  p0 = f32x16{}; p1 = f32x16{};
#pragma unroll
  for (int d0 = 0; d0 < 8; ++d0) { int cb = (d0 * 16 + hi * 8) * 2;
    bf16x8 b0 = *reinterpret_cast<const bf16x8*>(Ks + KSWZ(r32, cb));
    bf16x8 b1 = *reinterpret_cast<const bf16x8*>(Ks + KSWZ(32 + r32, cb));
    bf16x8 q; if (d0 < 4) q = qr[d0]; else q = *reinterpret_cast<const bf16x8*>(Qp + KSWZ(qrow, ((d0 - 4) * 16 + hi * 8) * 2));
    p0 = __builtin_amdgcn_mfma_f32_32x32x16_bf16(b0, q, p0, 0, 0, 0);
    p1 = __builtin_amdgcn_mfma_f32_32x32x16_bf16(b1, q, p1, 0, 0, 0); }
#pragma unroll
  for (int d0 = 0; d0 < 4; ++d0) { int cb = (d0 * 16 + hi * 8) * 2;
    bf16x8 b0 = *reinterpret_cast<const bf16x8*>(Kp + KPSWZ(r32, cb));
    bf16x8 b1 = *reinterpret_cast<const bf16x8*>(Kp + KPSWZ(32 + r32, cb));
    const bf16x8 qp = *reinterpret_cast<const bf16x8*>(Qp + KSWZ(qrow, 128 + cb));
    p0 = __builtin_amdgcn_mfma_f32_32x32x16_bf16(b0, qp, p0, 0, 0, 0);
    p1 = __builtin_amdgcn_mfma_f32_32x32x16_bf16(b1, qp, p1, 0, 0, 0); }
}
__device__ __forceinline__ int v_st(int k, int c) { const int kk = (k & ~0xC) | ((k & 4) << 1) | ((k & 8) >> 1); return ((kk >> 3) * 4 + (c >> 5)) * 512 + ((kk & 7) * 32 + (c & 31)) * 2; }
__device__ __forceinline__ int v_rd_base(int lane) { return ((lane & 3) << 3) | (((lane >> 2) & 3) << 6) | (((lane >> 4) & 1) << 5) | (((lane >> 5) & 1) << 8); }
constexpr int v_rd_off(int d0, int ks, int half) { return d0 * 512 + ks * 4096 + half * 2048; }
template <int OFF> __device__ __forceinline__ s16x4 tr_read(int vb) {
  s16x4 r; asm volatile("ds_read_b64_tr_b16 %0, %1 offset:%2" : "=&v"(r) : "v"(vb), "i"(OFF) : "memory"); return r;
}
template <int D0> __device__ __forceinline__ void pv_one(f32x16& od, int vb, bf16x8 pa0, bf16x8 pa1, bf16x8 pa2, bf16x8 pa3) {
  const s16x4 l0 = tr_read<v_rd_off(D0, 0, 0)>(vb), h0 = tr_read<v_rd_off(D0, 0, 1)>(vb), l1 = tr_read<v_rd_off(D0, 1, 0)>(vb), h1 = tr_read<v_rd_off(D0, 1, 1)>(vb);
  const s16x4 l2 = tr_read<v_rd_off(D0, 2, 0)>(vb), h2 = tr_read<v_rd_off(D0, 2, 1)>(vb), l3 = tr_read<v_rd_off(D0, 3, 0)>(vb), h3 = tr_read<v_rd_off(D0, 3, 1)>(vb);
  asm volatile("s_waitcnt lgkmcnt(0)" ::: "memory"); SBAR();
#define PK(L, H) (bf16x8){L[0], L[1], L[2], L[3], H[0], H[1], H[2], H[3]}
  od = __builtin_amdgcn_mfma_f32_32x32x16_bf16(pa0, PK(l0, h0), od, 0, 0, 0);
  od = __builtin_amdgcn_mfma_f32_32x32x16_bf16(pa1, PK(l1, h1), od, 0, 0, 0);
  od = __builtin_amdgcn_mfma_f32_32x32x16_bf16(pa2, PK(l2, h2), od, 0, 0, 0);
  od = __builtin_amdgcn_mfma_f32_32x32x16_bf16(pa3, PK(l3, h3), od, 0, 0, 0);
#undef PK
}
__device__ __forceinline__ void pv_d0(f32x16* o, int vb, bf16x8 pa0, bf16x8 pa1, bf16x8 pa2, bf16x8 pa3) {
  pv_one<0>(o[0], vb, pa0, pa1, pa2, pa3); pv_one<1>(o[1], vb, pa0, pa1, pa2, pa3); pv_one<2>(o[2], vb, pa0, pa1, pa2, pa3); pv_one<3>(o[3], vb, pa0, pa1, pa2, pa3);
}
__device__ __forceinline__ void attn_unit(const bf16_t* __restrict__ Qb, const bf16_t* __restrict__ KVh, const bf16_t* __restrict__ KPE, bf16_t* __restrict__ Ob,
                                          int ka0, int kb0, int NT, char* lds, int tid_in, int tpos0) {
  const unsigned tid_u = (unsigned)tid_in; __builtin_assume(tid_u < 512u);
  const int tid = (int)tid_u, wid = tid >> 6, lane = tid & 63, r32 = lane & 31, hi = lane >> 5;
  char* V_lds = lds + OFF_V; char* K_lds = lds + OFF_K; char* P_lds = lds + OFF_KP;
  float* ws = (float*)(lds + OFF_WS) + wid * 64; float* li_l = ws; float* al_l = ws + 32;
  float m_reg = -1e30f, l_reg = 0; f32x16 o[4] = {}; bf16x8 qr[4];
  char* Q_lds = lds + OFF_QP; const int qrow = wid * QBLK + r32;
  const bf16_t* Qw = Qb + (long)(wid * QBLK + r32) * LDQ + hi * 8;
#pragma unroll
  for (int d0 = 0; d0 < 4; ++d0) qr[d0] = *reinterpret_cast<const bf16x8*>(Qw + d0 * 16);
#pragma unroll
  for (int d0 = 0; d0 < 4; ++d0) *reinterpret_cast<bf16x8*>(Q_lds + KSWZ(qrow, (d0 * 16 + hi * 8) * 2)) = *reinterpret_cast<const bf16x8*>(Qw + 64 + d0 * 16);
#pragma unroll
  for (int ax = 0; ax < 2; ++ax) { u32x4 w1 = *reinterpret_cast<const u32x4*>(Qw + 128 + ax * 32), w2 = *reinterpret_cast<const u32x4*>(Qw + 128 + ax * 32 + 16);
    if (tpos0 >= 0) { const int t = tpos0 + qrow; const float pos = (float)(ax == 0 ? (t >> 6) : (t & 63));
      unsigned* p1 = (unsigned*)&w1; unsigned* p2 = (unsigned*)&w2;
#pragma unroll
      for (int i = 0; i < 4; ++i) { float a0 = bflo(p1[i]), a1 = bfhi(p1[i]), b0 = bflo(p2[i]), b1 = bfhi(p2[i]);
        const float ang0 = pos * __builtin_amdgcn_exp2f(-(float)(hi * 8 + 2 * i) * 0.8304820237218406f), ang1 = pos * __builtin_amdgcn_exp2f(-(float)(hi * 8 + 2 * i + 1) * 0.8304820237218406f);
        const float c0 = __cosf(ang0), s0 = __sinf(ang0), c1 = __cosf(ang1), s1 = __sinf(ang1);
        p1[i] = pk2(a0 * c0 - b0 * s0, a1 * c1 - b1 * s1); p2[i] = pk2(b0 * c0 + a0 * s0, b1 * c1 + a1 * s1); } }
    *reinterpret_cast<u32x4*>(Q_lds + KSWZ(qrow, 128 + (ax * 32 + hi * 8) * 2)) = w1; *reinterpret_cast<u32x4*>(Q_lds + KSWZ(qrow, 128 + (ax * 32 + 16 + hi * 8) * 2)) = w2; }
  const int sr = tid >> 4, sc = (tid & 15) * 8, vst0 = v_st(sr, sc), vst1 = v_st(32 + sr, sc);
  const int pr = tid >> 3, pc = (tid & 7) * 8;
  const int vb0 = (int)(uintptr_t)V_lds + v_rd_base(lane);
  struct { bf16x8 vs0, vs1, ks0, ks1, kp; } sr_[SDEPTH];
#define KROW(j) ((j) < 4 ? ka0 + 64 * (j) : kb0 + 64 * ((j) - 4))
  const __amdgpu_buffer_rsrc_t rsKV = __builtin_amdgcn_make_buffer_rsrc((void*)KVh, 0, 0xFFFFFFFFu, 0x00020000);
  const __amdgpu_buffer_rsrc_t rsKP = __builtin_amdgcn_make_buffer_rsrc((void*)KPE, 0, 0xFFFFFFFFu, 0x00020000);
  const int vo_k = (sr * LDKV + sc) * 2, vo_p = (pr * 64 + pc) * 2;
#define SLOAD(i, jt) do { const int k0_ = KROW(jt); const int so0 = k0_ * (LDKV * 2), so1 = so0 + 32 * LDKV * 2; \
    sr_[i].vs0 = __builtin_bit_cast(bf16x8, __builtin_amdgcn_raw_buffer_load_b128(rsKV, vo_k + 256, so0, 0)); sr_[i].vs1 = __builtin_bit_cast(bf16x8, __builtin_amdgcn_raw_buffer_load_b128(rsKV, vo_k + 256, so1, 0)); \
    sr_[i].ks0 = __builtin_bit_cast(bf16x8, __builtin_amdgcn_raw_buffer_load_b128(rsKV, vo_k, so0, 0)); sr_[i].ks1 = __builtin_bit_cast(bf16x8, __builtin_amdgcn_raw_buffer_load_b128(rsKV, vo_k, so1, 0)); \
    sr_[i].kp = __builtin_bit_cast(bf16x8, __builtin_amdgcn_raw_buffer_load_b128(rsKP, vo_p, k0_ * 128, 0)); } while (0)
#define SWRITE(b, i) do { *(bf16x8*)(V_lds + (b) * SHM_V + vst0) = sr_[i].vs0;          \
    *(bf16x8*)(V_lds + (b) * SHM_V + vst1) = sr_[i].vs1; int kc = sc * 2;               \
    *(bf16x8*)(K_lds + (b) * SHM_K + KSWZ(sr, kc)) = sr_[i].ks0;                       \
    *(bf16x8*)(K_lds + (b) * SHM_K + KSWZ(32 + sr, kc)) = sr_[i].ks1;                  \
    *(bf16x8*)(P_lds + (b) * SHM_KP + KPSWZ(pr, pc * 2)) = sr_[i].kp; } while (0)
#define SWAIT() do { if constexpr (SDEPTH == 2) asm volatile("s_waitcnt vmcnt(5)" ::: "memory"); else asm volatile("s_waitcnt vmcnt(0)" ::: "memory"); } while (0)
#define RESC(a) do { if (__any((a) < 1.f)) { if (hi == 0) al_l[r32] = (a); asm volatile("s_waitcnt lgkmcnt(0)" ::: "memory"); \
    for (int d = 0; d < 4; ++d) for (int r = 0; r < 16; ++r) o[d][r] *= al_l[crow(r, hi)]; } } while (0)
  f32x16 pA0, pA1, pB0, pB1; float mnA, mnB, alA, alB; bf16x8 pa0, pa1, pa2, pa3;
  constexpr int SE = 0, SO = SDEPTH - 1;
  SLOAD(SE, 0); asm volatile("s_waitcnt vmcnt(0)" ::: "memory"); SWRITE(0, SE); __syncthreads();
  qkt(pA0, pA1, K_lds, P_lds, qr, Q_lds, qrow, r32, hi); partialSM(pA0, pA1, m_reg, mnA, alA);
  SLOAD(SO, 1); if constexpr (SDEPTH == 2) { if (2 < NT) SLOAD(SE, 2); }
  SWAIT(); SWRITE(1, SO); __syncthreads();
  for (int j = 1; j + 1 < NT; j += 2) {
    SBAR(); qkt(pB0, pB1, K_lds + SHM_K, P_lds + SHM_KP, qr, Q_lds, qrow, r32, hi);
    finishSM(pA0, pA1, alA, l_reg, pa0, pa1, pa2, pa3); SBAR();
    SLOAD(SO, j + SDEPTH); SBAR();
    pv_d0(o, vb0, pa0, pa1, pa2, pa3); partialSM(pB0, pB1, m_reg, mnB, alB);
    __syncthreads(); SWAIT(); SWRITE(0, SE);
    RESC(alB); __syncthreads();
    SBAR(); qkt(pA0, pA1, K_lds, P_lds, qr, Q_lds, qrow, r32, hi);
    finishSM(pB0, pB1, alB, l_reg, pa0, pa1, pa2, pa3); SBAR();
    if (SDEPTH == 1 || j + 3 < NT) SLOAD(SE, j + 1 + SDEPTH); SBAR();
    pv_d0(o, vb0 + (int)SHM_V, pa0, pa1, pa2, pa3); partialSM(pA0, pA1, m_reg, mnA, alA);
    __syncthreads(); SWAIT(); SWRITE(1, SO);
    RESC(alA); __syncthreads();
  }
  SBAR(); qkt(pB0, pB1, K_lds + SHM_K, P_lds + SHM_KP, qr, Q_lds, qrow, r32, hi);
  finishSM(pA0, pA1, alA, l_reg, pa0, pa1, pa2, pa3); SBAR();
  pv_d0(o, vb0, pa0, pa1, pa2, pa3); partialSM(pB0, pB1, m_reg, mnB, alB);
  __syncthreads(); RESC(alB);
  finishSM(pB0, pB1, alB, l_reg, pa0, pa1, pa2, pa3); SBAR();
  pv_d0(o, vb0 + (int)SHM_V, pa0, pa1, pa2, pa3);
  if (hi == 0) li_l[r32] = l_reg; asm volatile("s_waitcnt lgkmcnt(0)" ::: "memory");
  float rli[16];
#pragma unroll
  for (int r = 0; r < 16; ++r) rli[r] = __builtin_amdgcn_rcpf(li_l[crow(r, hi)]);
  bf16_t* Ow = Ob + (long)(wid * QBLK) * LDO;
#pragma unroll
  for (int r = 0; r < 16; ++r) { int orow = crow(r, hi);
    for (int d0 = 0; d0 < 4; ++d0) Ow[(long)orow * LDO + d0 * 32 + r32] = (bf16_t)f2bf(o[d0][r] * rli[r]); }
  __syncthreads();
#undef KROW
#undef SLOAD
#undef SWRITE
#undef SWAIT
#undef RESC
}
}

__device__ __forceinline__ void phase_attn(Frame& F, bool lat_only) {
    const bf16_t* Q = WSP(bf16_t, WS_Q); const bf16_t* KV = WSP(bf16_t, WS_KV); const bf16_t* KPE = WSP(bf16_t, WS_KPE); bf16_t* YA = WSP(bf16_t, WS_Y);
    const int NU = NBATCH * NH_MLA * 32 + (lat_only ? 0 : NBATCH * NH_MLA);
    for (int u = F.bid; u < NU; u += F.G) {
        int b, h, row0, NT, tpos0;
        if (u < NBATCH * NH_MLA * 32) { const int bh = u >> 5, qb = u & 31; b = bh >> 3; h = bh & 7; row0 = TC + b * SEQ + qb * 256; NT = 4 + SEQ / 64; tpos0 = qb * 256; }
        else { const int bh = u - NBATCH * NH_MLA * 32; b = bh >> 3; h = bh & 7; row0 = b * CTX; NT = 4; tpos0 = -1; }
        att::attn_unit(Q + (size_t)row0 * 1536 + h * 192, KV + h * 256, KPE, YA + (size_t)row0 * 1024 + h * 128, b * CTX, TC + b * SEQ, NT, (char*)F.lds, F.tid, tpos0);
    }
}
__device__ __forceinline__ void phase_qrope(Frame& F) {
    bf16_t* Q = WSP(bf16_t, WS_Q);
    for (int row = TC + F.gw; row < T; row += F.NGW) {
        const int t = (row - TC) & (SEQ - 1); const int p = F.lane & 31, axis = p >> 4, j = p & 15, hs = F.lane >> 5;
        const float pos = (float)(axis == 0 ? (t >> 6) : (t & 63)); const float inv = __builtin_amdgcn_exp2f(-(float)j * 0.8304820237218406f);
        const float sn = __sinf(pos * inv), cs = __cosf(pos * inv);
#pragma unroll
        for (int hh = 0; hh < 4; ++hh) { const int h = hh * 2 + hs; bf16_t* q = Q + (size_t)row * 1536 + h * 192 + 128 + axis * 32 + j;
            const float x1 = bf2f(q[0]), x2 = bf2f(q[16]);
            q[0] = (bf16_t)f2bf(x1 * cs - x2 * sn); q[16] = (bf16_t)f2bf(x2 * cs + x1 * sn); }
    }
}

#define MFMA16(a, b, c) __builtin_amdgcn_mfma_f32_16x16x32_bf16((a), (b), (c), 0, 0, 0)
constexpr int XS_LD = 264, BC_LD = 136;
__device__ __forceinline__ float bperm(float v, int srclane) { return __builtin_bit_cast(float, __builtin_amdgcn_ds_bpermute(srclane << 2, __builtin_bit_cast(int, v))); }
__device__ __forceinline__ float wave_incl_scan(float v, int lane) {
#pragma unroll
    for (int o = 1; o < 64; o <<= 1) { const float t = bperm(v, lane - o); if (lane >= o) v += t; }
    return v;
}
__device__ __forceinline__ void stage_tile(LAS bf16_t* dst, int ld, const bf16_t* src, int ncols, int tid) {
    const int cpr = ncols >> 3;
    for (int i = tid; i < 128 * cpr; i += NTHREADS) { const int r = i / cpr, c8 = (i % cpr) * 8; *(LAS u32x4*)(dst + r * ld + c8) = *(const u32x4*)(src + (size_t)r * P2W + c8); }
}
__device__ __forceinline__ void phase_mamba_states(Frame& F, const Args& a, int layer) {
    const bf16_t* P2 = WSP(bf16_t, WS_P2); const float* DT = WSP(float, WS_DT); bf16_t* MST = WSP(bf16_t, WS_MST); float* MCS = WSP(float, WS_MCS);
    LAS bf16_t* XSl = (LAS bf16_t*)F.lds; LAS bf16_t* Bl = (LAS bf16_t*)(F.lds + 67584); LAS float* wt = (LAS float*)(F.lds + 102400) + F.wave * 128;
    const int lane = F.lane, row = lane & 15, quad = lane >> 4;
    for (int u = F.bid; u < NCHUNK * 4; u += F.G) {
        const int chunk = u >> 2, g = (u >> 1) & 1, half = u & 1, row0 = chunk * 128;
        __syncthreads();
        stage_tile(XSl, XS_LD, P2 + (size_t)row0 * P2W + P2_XBC + (g * 8 + half * 4) * 64, 256, F.tid);
        stage_tile(Bl, BC_LD, P2 + (size_t)row0 * P2W + P2_XBC + 1024 + g * 128, 128, F.tid);
        const int hl = F.wave >> 1, d = F.wave & 1, h = g * 8 + half * 4 + hl;
        const float aa = -__expf(arg_in(a, I_SALOG)[(layer * 2 + d) * 16 + h]);
        { const float dt0 = DT[(size_t)(row0 + lane) * 32 + d * 16 + h], dt1 = DT[(size_t)(row0 + 64 + lane) * 32 + d * 16 + h];
          const float da0 = dt0 * aa, da1 = dt1 * aa;
          float c0 = wave_incl_scan(da0, lane); const float tot0 = bperm(c0, 63); float c1 = wave_incl_scan(da1, lane) + tot0; const float tot = bperm(c1, 63);
          if (d == 0) { wt[lane] = dt0 * __expf(tot - c0); wt[64 + lane] = dt1 * __expf(tot - c1); }
          else { wt[lane] = dt0 * __expf(c0 - da0); wt[64 + lane] = dt1 * __expf(c1 - da1); }
          if (lane == 0) MCS[(d * NCHUNK + chunk) * 16 + h] = tot; }
        __syncthreads();
        bf16_t* out = MST + ((size_t)(d * NCHUNK + chunk) * 16 + h) * 8192;
#pragma unroll 1
        for (int nh = 0; nh < 2; ++nh) {
            f32x4 acc[4][4];
#pragma unroll
            for (int i = 0; i < 4; ++i)
#pragma unroll
                for (int j = 0; j < 4; ++j) acc[i][j] = (f32x4){0.f, 0.f, 0.f, 0.f};
#pragma unroll 1
            for (int k0 = 0; k0 < 128; k0 += 32) {
                const int sb = k0 + quad * 8;
                float w8[8];
#pragma unroll
                for (int j = 0; j < 8; ++j) w8[j] = wt[sb + j];
                bf16x8 bf[4];
#pragma unroll
                for (int nt = 0; nt < 4; ++nt) {
#pragma unroll
                    for (int j = 0; j < 8; ++j) bf[nt][j] = (short)Bl[(sb + j) * BC_LD + (nh * 4 + nt) * 16 + row]; }
#pragma unroll
                for (int pt = 0; pt < 4; ++pt) { bf16x8 af;
#pragma unroll
                    for (int j = 0; j < 8; ++j) af[j] = (short)f2bf(w8[j] * bf2f(XSl[(sb + j) * XS_LD + hl * 64 + pt * 16 + row]));
#pragma unroll
                    for (int nt = 0; nt < 4; ++nt) acc[pt][nt] = MFMA16(af, bf[nt], acc[pt][nt]); }
            }
#pragma unroll
            for (int pt = 0; pt < 4; ++pt)
#pragma unroll
                for (int nt = 0; nt < 4; ++nt)
#pragma unroll
                    for (int jj = 0; jj < 4; ++jj) out[(pt * 16 + quad * 4 + jj) * 128 + (nh * 4 + nt) * 16 + row] = (bf16_t)f2bf(acc[pt][nt][jj]);
        }
    }
}
__device__ __forceinline__ void phase_mamba_scan(Frame& F) {
    bf16_t* MST = WSP(bf16_t, WS_MST); const float* MCS = WSP(float, WS_MCS);
    for (int idx = F.bid * NTHREADS + F.tid; idx < 2 * 2 * 16 * 8192; idx += F.G * NTHREADS) {
        const int e = idx & 8191, h = (idx >> 13) & 15, b = (idx >> 17) & 1, d = idx >> 18;
        float state = 0.f;
#pragma unroll 6
        for (int i = 0; i < 66; ++i) {
            int chunk; if (i < 2) chunk = 2 * b + (d == 0 ? i : 1 - i); else chunk = 4 + 64 * b + (d == 0 ? i - 2 : 65 - i);
            bf16_t* p = MST + ((size_t)(d * NCHUNK + chunk) * 16 + h) * 8192 + e;
            const float cs = bf2f(*p); const float dec = __expf(MCS[(d * NCHUNK + chunk) * 16 + h]);
            *p = (bf16_t)f2bf(state);
            state = state * dec + cs;
        }
    }
}
__device__ __forceinline__ void phase_mamba_out(Frame& F, const Args& a, int layer) {
    const bf16_t* P = WSP(bf16_t, WS_P); const bf16_t* P2 = WSP(bf16_t, WS_P2); const float* DT = WSP(float, WS_DT); const bf16_t* MST = WSP(bf16_t, WS_MST);
    bf16_t* YB = WSP(bf16_t, WS_Y) + (size_t)1 * T * 1024;
    LAS bf16_t* Cl = (LAS bf16_t*)F.lds; LAS bf16_t* Bl = (LAS bf16_t*)(F.lds + 34816); LAS bf16_t* XSl = (LAS bf16_t*)(F.lds + 69632);
    LAS float* tab = (LAS float*)(F.lds + 137216);
    const int lane = F.lane, row = lane & 15, quad = lane >> 4;
    for (int u = F.bid; u < NCHUNK * 4; u += F.G) {
        const int chunk = u >> 2, g = (u >> 1) & 1, half = u & 1, row0 = chunk * 128;
        __syncthreads();
        stage_tile(XSl, XS_LD, P2 + (size_t)row0 * P2W + P2_XBC + (g * 8 + half * 4) * 64, 256, F.tid);
        stage_tile(Bl, BC_LD, P2 + (size_t)row0 * P2W + P2_XBC + 1024 + g * 128, 128, F.tid);
        stage_tile(Cl, BC_LD, P2 + (size_t)row0 * P2W + P2_XBC + 1280 + g * 128, 128, F.tid);
        float tot1 = 0.f;
        { const int hl = F.wave >> 1, d = F.wave & 1, h = g * 8 + half * 4 + hl;
          const float aa = -__expf(arg_in(a, I_SALOG)[(layer * 2 + d) * 16 + h]);
          const float dt0 = DT[(size_t)(row0 + lane) * 32 + d * 16 + h], dt1 = DT[(size_t)(row0 + 64 + lane) * 32 + d * 16 + h];
          const float da0 = dt0 * aa, da1 = dt1 * aa;
          float c0 = wave_incl_scan(da0, lane); const float t0 = bperm(c0, 63); float c1 = wave_incl_scan(da1, lane) + t0;
          LAS float* tb = tab + hl * 512;
          if (d == 0) { tb[lane] = c0; tb[64 + lane] = c1; tb[256 + lane] = __logf(dt0) - c0; tb[320 + lane] = __logf(dt1) - c1; }
          else { tb[128 + lane] = c0 - da0; tb[192 + lane] = c1 - da1; tb[384 + lane] = (c0 - da0) + __logf(dt0); tb[448 + lane] = (c1 - da1) + __logf(dt1); if (lane == 63) tab[2048 + hl] = c1; } }
        __syncthreads();
        { f32x4 cb[8];
#pragma unroll
          for (int st = 0; st < 8; ++st) cb[st] = (f32x4){0.f, 0.f, 0.f, 0.f};
#pragma unroll
          for (int k0 = 0; k0 < 128; k0 += 32) { const bf16x8 af = *(const LAS bf16x8*)(Cl + (F.wave * 16 + row) * BC_LD + k0 + quad * 8);
#pragma unroll
              for (int st = 0; st < 8; ++st) { const bf16x8 bfr = *(const LAS bf16x8*)(Bl + (st * 16 + row) * BC_LD + k0 + quad * 8); cb[st] = MFMA16(af, bfr, cb[st]); } }
          __syncthreads();
#pragma unroll
          for (int st = 0; st < 8; ++st)
#pragma unroll
              for (int jj = 0; jj < 4; ++jj) Bl[(F.wave * 16 + quad * 4 + jj) * BC_LD + st * 16 + row] = (bf16_t)f2bf(cb[st][jj]); }
        __syncthreads();
        const int hl = F.wave >> 1, th = F.wave & 1, h = g * 8 + half * 4 + hl;
        const LAS float* tb = tab + hl * 512; tot1 = tab[2048 + hl];
        f32x4 acc[4][4];
#pragma unroll
        for (int i = 0; i < 4; ++i)
#pragma unroll
            for (int j = 0; j < 4; ++j) acc[i][j] = (f32x4){0.f, 0.f, 0.f, 0.f};
#pragma unroll 1
        for (int k0 = 0; k0 < 128; k0 += 32) {
            const int sb = k0 + quad * 8;
            float u0s[8], u1s[8];
#pragma unroll
            for (int j = 0; j < 8; ++j) { u0s[j] = tb[256 + sb + j]; u1s[j] = tb[384 + sb + j]; }
            bf16x8 bx[4];
#pragma unroll
            for (int pt = 0; pt < 4; ++pt) {
#pragma unroll
                for (int j = 0; j < 8; ++j) bx[pt][j] = (short)XSl[(sb + j) * XS_LD + hl * 64 + pt * 16 + row]; }
#pragma unroll
            for (int tt = 0; tt < 4; ++tt) { const int t = th * 64 + tt * 16 + row; const float c0t = tb[t], e1t = tb[128 + t];
                float cbv[8]; { const u32x4 w = *(const LAS u32x4*)(Bl + t * BC_LD + sb); cbv[0] = bflo(w.x); cbv[1] = bfhi(w.x); cbv[2] = bflo(w.y); cbv[3] = bfhi(w.y); cbv[4] = bflo(w.z); cbv[5] = bfhi(w.z); cbv[6] = bflo(w.w); cbv[7] = bfhi(w.w); }
                bf16x8 af;
#pragma unroll
                for (int j = 0; j < 8; ++j) { const int s = sb + j;
                    const float f0 = s <= t ? __expf(c0t + u0s[j]) : 0.f;
                    const float f1 = s >= t ? __expf(u1s[j] - e1t) : 0.f;
                    af[j] = (short)f2bf(cbv[j] * (f0 + f1)); }
#pragma unroll
                for (int pt = 0; pt < 4; ++pt) acc[tt][pt] = MFMA16(af, bx[pt], acc[tt][pt]); }
        }
#pragma unroll 1
        for (int d = 0; d < 2; ++d) {
            const bf16_t* S = MST + ((size_t)(d * NCHUNK + chunk) * 16 + h) * 8192;
#pragma unroll 1
            for (int k0 = 0; k0 < 128; k0 += 32) {
                bf16x8 bs[4];
#pragma unroll
                for (int pt = 0; pt < 4; ++pt) bs[pt] = *(const bf16x8*)(S + (pt * 16 + row) * 128 + k0 + quad * 8);
#pragma unroll
                for (int tt = 0; tt < 4; ++tt) { const int t = th * 64 + tt * 16 + row;
                    const float sc = d == 0 ? __expf(tb[t]) : __expf(tot1 - tb[128 + t]);
                    const u32x4 cw = *(const LAS u32x4*)(Cl + t * BC_LD + k0 + quad * 8);
                    u32x4 aw; aw.x = cvt_pk_bf16(bflo(cw.x) * sc, bfhi(cw.x) * sc); aw.y = cvt_pk_bf16(bflo(cw.y) * sc, bfhi(cw.y) * sc);
                    aw.z = cvt_pk_bf16(bflo(cw.z) * sc, bfhi(cw.z) * sc); aw.w = cvt_pk_bf16(bflo(cw.w) * sc, bfhi(cw.w) * sc);
                    const bf16x8 af = __builtin_bit_cast(bf16x8, aw);
#pragma unroll
                    for (int pt = 0; pt < 4; ++pt) acc[tt][pt] = MFMA16(af, bs[pt], acc[tt][pt]); } }
        }
        const float Dh = arg_in(a, I_SD)[layer * 16 + h];
#pragma unroll
        for (int tt = 0; tt < 4; ++tt)
#pragma unroll
            for (int jj = 0; jj < 4; ++jj) { const int t = th * 64 + tt * 16 + quad * 4 + jj; const size_t r = (size_t)(row0 + t);
#pragma unroll
                for (int pt = 0; pt < 4; ++pt) { const int p = pt * 16 + row;
                    const float xs = bf2f(XSl[t * XS_LD + hl * 64 + p]); const float z = bf2f(P[r * NNG + P_Z + h * 64 + p]);
                    YB[r * 1024 + h * 64 + p] = (bf16_t)f2bf((acc[tt][pt][jj] + xs * Dh) * siluf_(z)); } }
    }
}
__device__ __forceinline__ void phase_mamba_norm(Frame& F, const Args& a, int layer) {
    bf16_t* YB = WSP(bf16_t, WS_Y) + (size_t)1 * T * 1024; const float* nw = arg_in(a, I_SNORM) + layer * 1024;
    for (int row = F.gw; row < T; row += F.NGW) {
        bf16_t* p = YB + (size_t)row * 1024 + F.lane * 16; float x[16]; { float t0[8], t1[8]; ld8bf(p, t0); ld8bf(p + 8, t1);
#pragma unroll
            for (int i = 0; i < 8; ++i) { x[i] = t0[i]; x[8 + i] = t1[i]; } }
        float s = 0.f;
#pragma unroll
        for (int i = 0; i < 16; ++i) s += x[i] * x[i];
        s = sum32(s);
        const float r = 1.f / sqrtf(s * (1.f / 512.f) + 1e-5f);
        float o0[8], o1[8];
#pragma unroll
        for (int i = 0; i < 8; ++i) { o0[i] = x[i] * r * nw[F.lane * 16 + i]; o1[i] = x[8 + i] * r * nw[F.lane * 16 + 8 + i]; }
        st8bf(p, o0); st8bf(p + 8, o1);
    }
}

__device__ __forceinline__ float dpp_f(float x, const int ctrl_sel) {
    const int xi = __builtin_bit_cast(int, x); int r;
    if (ctrl_sel == 0) r = __builtin_amdgcn_update_dpp(0, xi, 0xB1, 0xF, 0xF, false);
    else if (ctrl_sel == 1) r = __builtin_amdgcn_update_dpp(0, xi, 0x4E, 0xF, 0xF, false);
    else r = __builtin_amdgcn_update_dpp(0, xi, 0x141, 0xF, 0xF, false);
    return __builtin_bit_cast(float, r);
}
__device__ __forceinline__ float red8(float x) { x += dpp_f(x, 0); x += dpp_f(x, 1); x += dpp_f(x, 2); return x; }
__device__ __forceinline__ int rw_row(int pos, int b, int d) { return pos < CTX ? b * CTX + (d == 0 ? pos : CTX - 1 - pos) : TC + b * SEQ + (d == 0 ? pos - CTX : SEQ - 1 - (pos - CTX)); }
constexpr int RW_STEP_F = 336, RW_CH = 32, RW_CHF = RW_STEP_F * RW_CH;
struct RwOps { f32x4 w, k, b, a, r; float v; };
__device__ __forceinline__ void rw_load(RwOps& o, const LAS float* sp, const LAS float* vp) {
    o.w = *(const LAS f32x4*)(sp); o.k = *(const LAS f32x4*)(sp + 64); o.b = *(const LAS f32x4*)(sp + 128); o.a = *(const LAS f32x4*)(sp + 192); o.r = *(const LAS f32x4*)(sp + 256); o.v = *vp;
}
__device__ __forceinline__ void rw_step(f32x4& s, const RwOps& o, LAS float* yp) {
    const f32x4 tt = s * o.w + o.k * o.v;
    const f32x4 pa = s * o.a; float sa = (pa.x + pa.y) + (pa.z + pa.w); sa = sum16(sa);
    s = tt + o.b * sa;
    const f32x4 pr = s * o.r; *yp = (pr.x + pr.y) + (pr.z + pr.w);
}
struct RwRaw { float ew[8], ic[8], kk[8], rr[8], kr[8], vv[8]; };
__device__ __forceinline__ void phase_rwkv_scan(Frame& F, const Args& a, int layer) {
    const bf16_t* P2 = WSP(bf16_t, WS_P2); const bf16_t* EW = WSP(bf16_t, WS_EW); const bf16_t* ICLR = WSP(bf16_t, WS_ICLR); const bf16_t* KK = WSP(bf16_t, WS_KK);
    bf16_t* YRW = WSP(bf16_t, WS_YRW);
    LAS float* ring = (LAS float*)F.lds; LAS float* ybuf = (LAS float*)(F.lds + 2 * RW_CHF * 4);
    const int lane = F.lane;
    for (int u = F.bid; u < 256; u += F.G) {
        const int chain = u >> 2, rq = u & 3, d = chain >> 5, b = (chain >> 4) & 1, h = chain & 15;
        const float ka = arg_in(a, I_RKA)[layer * 1024 + h * 64 + lane];
        constexpr int NCH = (CTX + SEQ) / RW_CH;
        const int lw = F.wave - 4;
        auto issue = [&](RwRaw& x, int cidx) {
            const int row0 = rw_row(cidx * RW_CH, b, d), st = d == 0 ? 1 : -1;
            const int o0 = (row0 + st * lw) * 1024 + h * 64 + lane, ostep = st * 4 * 1024;
            const int q0 = (row0 + st * lw) * P2W + P2_RKV + h * 64 + lane, qstep = st * 4 * P2W;
            const bf16_t* ewp = EW + (size_t)d * T * 1024; const bf16_t* icp = ICLR + (size_t)d * T * 1024; const int vo = 2048 + rq * 16 + (lane & 15) - lane;
#pragma unroll
            for (int j = 0; j < 8; ++j) { const int o = o0 + j * ostep, q = q0 + j * qstep;
                x.ew[j] = bf2f(ewp[o]); x.ic[j] = bf2f(icp[o]); x.kk[j] = bf2f(KK[o]);
                x.rr[j] = bf2f(P2[q]); x.kr[j] = bf2f(P2[q + 1024]); x.vv[j] = bf2f(P2[q + vo]); } };
        auto commit = [&](const RwRaw& x, int cidx) {
            LAS float* dst = ring + (cidx & 1) * RW_CHF;
#pragma unroll
            for (int j = 0; j < 8; ++j) { LAS float* s = dst + (lw + 4 * j) * RW_STEP_F;
                s[lane] = __expf(-x.ew[j]); s[64 + lane] = x.kr[j] * (1.f + (x.ic[j] - 1.f) * ka); s[128 + lane] = x.kk[j] * x.ic[j]; s[192 + lane] = -x.kk[j]; s[256 + lane] = x.rr[j];
                if (lane < 16) s[320 + lane] = x.vv[j]; } };
        auto flush_chunk = [&](int cidx) {
            const LAS float* yb = ybuf + (cidx & 1) * (RW_CH * 256);
            const int row0 = rw_row(cidx * RW_CH, b, d), st = d == 0 ? 1 : -1;
#pragma unroll
            for (int q = 0; q < 2; ++q) { const int i = (F.tid - 256) + 256 * q, tok = i >> 4, rr = i & 15; const LAS f32x4* pp = (const LAS f32x4*)(yb + i * 16);
                const f32x4 p0 = pp[0], p1 = pp[1], p2 = pp[2], p3 = pp[3];
                const float y = ((p0.x + p0.y) + (p0.z + p0.w)) + ((p1.x + p1.y) + (p1.z + p1.w)) + (((p2.x + p2.y) + (p2.z + p2.w)) + ((p3.x + p3.y) + (p3.z + p3.w)));
                YRW[((size_t)d * T + row0 + st * tok) * 1024 + h * 64 + rq * 16 + rr] = (bf16_t)f2bf(y); } };
        auto compute = [&](f32x4& s, int c) {
            const int rloc = lane >> 4, kq = lane & 15, r16 = F.wave * 4 + rloc;
            const LAS float* base = ring + (c & 1) * RW_CHF + kq * 4; const LAS float* vb = ring + (c & 1) * RW_CHF + 320 + r16; LAS float* yb = ybuf + (c & 1) * (RW_CH * 256) + r16 * 16 + kq;
            RwOps oa, ob;
            rw_load(oa, base, vb);
#pragma unroll 2
            for (int t = 0; t < RW_CH; t += 2) {
                rw_load(ob, base + (t + 1) * RW_STEP_F, vb + (t + 1) * RW_STEP_F);
                rw_step(s, oa, yb + t * 256);
                if (t + 2 < RW_CH) rw_load(oa, base + (t + 2) * RW_STEP_F, vb + (t + 2) * RW_STEP_F);
                rw_step(s, ob, yb + (t + 1) * 256);
            } };
        __syncthreads();
        f32x4 s = {0.f, 0.f, 0.f, 0.f};
        if (F.wave >= 4) {
            RwRaw ra, rb;
            issue(ra, 0); commit(ra, 0); issue(ra, 1);
            __syncthreads();
            for (int c = 0; c < NCH; c += 2) {
                if (c + 2 < NCH) issue(rb, c + 2);
                if (c > 0) flush_chunk(c - 1);
                commit(ra, c + 1);
                __syncthreads();
                if (c + 3 < NCH) issue(ra, c + 3);
                flush_chunk(c);
                if (c + 2 < NCH) commit(rb, c + 2);
                __syncthreads();
            }
            flush_chunk(NCH - 1);
        } else {
            __syncthreads();
            for (int c = 0; c < NCH; c += 2) { compute(s, c); __syncthreads(); compute(s, c + 1); __syncthreads(); }
        }
    }
}
__device__ __forceinline__ void phase_rwkv_out(Frame& F, const Args& a, int layer) {
    const bf16_t* P2 = WSP(bf16_t, WS_P2); const bf16_t* ICLR = WSP(bf16_t, WS_ICLR); const bf16_t* YRW = WSP(bf16_t, WS_YRW); const bf16_t* GG = WSP(bf16_t, WS_GG);
    bf16_t* YD = WSP(bf16_t, WS_Y) + (size_t)3 * T * 1024;
    const float* lng = arg_in(a, I_RLNG) + layer * 1024; const float* lnb = arg_in(a, I_RLNB) + layer * 1024; const float* rk = arg_in(a, I_RRK) + layer * 1024; const float* kav = arg_in(a, I_RKA) + layer * 1024;
    for (int row = F.gw; row < T; row += F.NGW) {
        const int c = F.lane * 16; const size_t o = (size_t)row * 1024 + c;
        float y[16], r[16], k[16], v[16], i0[16], i1[16], g[16];
#define LD16(dst, ptr) do { float t0_[8], t1_[8]; ld8bf((ptr), t0_); ld8bf((ptr) + 8, t1_); _Pragma("unroll") for (int i_ = 0; i_ < 8; ++i_) { dst[i_] = t0_[i_]; dst[8 + i_] = t1_[i_]; } } while (0)
        LD16(y, YRW + o); LD16(r, YRW + (size_t)T * 1024 + o);
#pragma unroll
        for (int i = 0; i < 16; ++i) y[i] += r[i];
        const bf16_t* p2 = P2 + (size_t)row * P2W + P2_RKV + c;
        LD16(r, p2); LD16(k, p2 + 1024); LD16(v, p2 + 2048); LD16(i0, ICLR + o); LD16(i1, ICLR + (size_t)T * 1024 + o); LD16(g, GG + o);
#undef LD16
        float s = 0.f, bsum = 0.f;
#pragma unroll
        for (int i = 0; i < 16; ++i) { s += y[i]; const float ka = kav[c + i]; bsum += r[i] * k[i] * rk[c + i] * ((1.f + (i0[i] - 1.f) * ka) + (1.f + (i1[i] - 1.f) * ka)); }
        s = sum4(s); bsum = sum4(bsum);
        const float mu = s * (1.f / 64.f); float q = 0.f;
#pragma unroll
        for (int i = 0; i < 16; ++i) { const float dd = y[i] - mu; q += dd * dd; }
        q = sum4(q);
        const float rstd = 1.f / sqrtf(q * (1.f / 64.f) + 64e-5f);
        float o0[8], o1[8];
#pragma unroll
        for (int i = 0; i < 8; ++i) { o0[i] = ((y[i] - mu) * rstd * lng[c + i] + lnb[c + i] + bsum * v[i]) * g[i];
            o1[i] = ((y[8 + i] - mu) * rstd * lng[c + 8 + i] + lnb[c + 8 + i] + bsum * v[8 + i]) * g[8 + i]; }
        st8bf(YD + o, o0); st8bf(YD + o + 8, o1);
    }
}

constexpr int FFT_N = 16384;
__device__ __forceinline__ int fswz(int i) { return i ^ (((i >> 5) & 3) << 2) ^ (((i >> 6) & 1) << 4); }
__device__ __forceinline__ f32x2 cmul(f32x2 a, f32x2 b) { return (f32x2){a.x * b.x - a.y * b.y, a.x * b.y + a.y * b.x}; }
template <bool INV>
__device__ __forceinline__ void fft_passes(LAS f32x2* X, int tid) {
#pragma unroll 1
    for (int st = 0; st < 7; ++st) {
        const int lq = INV ? 2 * st : 12 - 2 * st;
        const int q = 1 << lq;
        __syncthreads();
#pragma unroll 2
        for (int mm = 0; mm < 8; ++mm) { const int uu = tid + 512 * mm; const int k = uu & (q - 1), blk = uu >> lq; const int i0 = (blk << (lq + 2)) + k;
            const int p0 = fswz(i0), p1 = fswz(i0 + q), p2 = fswz(i0 + 2 * q), p3 = fswz(i0 + 3 * q);
            f32x2 a0 = X[p0], a1 = X[p1], a2 = X[p2], a3 = X[p3];
            const float fr = (float)k / (float)(4 * q);
            const float cs = __builtin_amdgcn_cosf(fr), sn = __builtin_amdgcn_sinf(fr);
            const f32x2 w1 = INV ? (f32x2){cs, sn} : (f32x2){cs, -sn}; const f32x2 w2 = cmul(w1, w1), w3 = cmul(w2, w1);
            if (!INV) {
                const f32x2 t0 = a0 + a2, t1 = a0 - a2, t2 = a1 + a3, t3 = a1 - a3;
                const f32x2 b0 = t0 + t2, b2 = t0 - t2, b1 = (f32x2){t1.x + t3.y, t1.y - t3.x}, b3 = (f32x2){t1.x - t3.y, t1.y + t3.x};
                X[p0] = b0; X[p1] = cmul(b1, w1); X[p2] = cmul(b2, w2); X[p3] = cmul(b3, w3);
            } else {
                a1 = cmul(a1, w1); a2 = cmul(a2, w2); a3 = cmul(a3, w3);
                const f32x2 u0 = a0 + a2, u1 = a0 - a2, u2 = a1 + a3, u3 = a1 - a3;
                X[p0] = u0 + u2; X[p2] = u0 - u2; X[p1] = (f32x2){u1.x - u3.y, u1.y + u3.x}; X[p3] = (f32x2){u1.x + u3.y, u1.y - u3.x};
            } }
    }
    __syncthreads();
}
__device__ __forceinline__ void phase_hyena_fft(Frame& F, const Args& a, int layer, bool dry = false) {
    const bf16_t* FILT = WSP(bf16_t, WS_FILT); float* VT = WSP(float, WS_VT); const float* hyd = arg_in(a, I_HD) + layer * 1024;
    LAS f32x2* X = (LAS f32x2*)F.lds;
    for (int c = F.bid; c < 1024; c += F.G) {
        __syncthreads();
        const bf16_t* hf = FILT + (size_t)c * 2 * SEQ; const bf16_t* hb = hf + SEQ;
        for (int i = F.tid; i < FFT_N; i += NTHREADS) { float v; if (i < SEQ) v = bf2f(hf[i]); else if (i == SEQ) v = 0.f; else v = bf2f(hb[FFT_N - i]); X[fswz(i)] = (f32x2){v, 0.f}; }
        fft_passes<false>(X, F.tid);
        f32x2 Kh[32];
#pragma unroll
        for (int j = 0; j < 32; ++j) Kh[j] = X[fswz(F.tid + 512 * j)];
        __syncthreads();
        const float* v0 = VT + (size_t)c * 2 * SEQ; const float* v1 = v0 + SEQ;
        for (int i = F.tid; i < FFT_N; i += NTHREADS) X[fswz(i)] = i < SEQ ? (f32x2){v0[i], v1[i]} : (f32x2){0.f, 0.f};
        fft_passes<false>(X, F.tid);
#pragma unroll
        for (int j = 0; j < 32; ++j) { const int p = fswz(F.tid + 512 * j); X[p] = cmul(X[p], Kh[j]); }
        fft_passes<true>(X, F.tid);
        const float dc = hyd[c]; float* o0 = VT + (size_t)c * 2 * SEQ; float* o1 = o0 + SEQ;
        for (int i = F.tid; i < SEQ; i += NTHREADS) { const f32x2 r = X[fswz(i)]; const float x0 = o0[i], x1 = o1[i];
            if (!dry) { o0[i] = r.x * (1.f / FFT_N) + x0 * dc; o1[i] = r.y * (1.f / FFT_N) + x1 * dc; } }
    }
}
__device__ __forceinline__ void phase_hyena_out(Frame& F, const Args& a, int layer) {
    const float* VT = WSP(float, WS_VT); const bf16_t* P2 = WSP(bf16_t, WS_P2); bf16_t* YC = WSP(bf16_t, WS_Y) + (size_t)2 * T * 1024;
    LAS float* tl = (LAS float*)F.lds;
    for (int u = F.bid; u < (TL / 64) * 4; u += F.G) {
        const int tb = u >> 2, cb = u & 3; const int row0 = TC + tb * 64; const int b = (row0 - TC) >> 13, t0 = (row0 - TC) & (SEQ - 1);
        __syncthreads();
        for (int p = 0; p < 8; ++p) { const int cl = p * 32 + (F.tid >> 4), q = F.tid & 15;
            const f32x4 v = *(const f32x4*)(VT + ((size_t)(cb * 256 + cl) * 2 + b) * SEQ + t0 + 4 * q);
            tl[cl * 65 + 4 * q] = v.x; tl[cl * 65 + 4 * q + 1] = v.y; tl[cl * 65 + 4 * q + 2] = v.z; tl[cl * 65 + 4 * q + 3] = v.w; }
        __syncthreads();
        const int cl = F.tid & 255, th = F.tid >> 8;
        for (int i = 0; i < 32; ++i) { const int tl_ = th * 32 + i; const size_t row = (size_t)(row0 + tl_);
            const float x0 = bf2f(P2[row * P2W + P2_X0 + cb * 256 + cl]);
            YC[row * 1024 + cb * 256 + cl] = (bf16_t)f2bf(tl[cl * 65 + tl_] * x0); }
    }
    const float* VC = WSP(float, WS_VC); const float* FC = WSP(float, WS_FILTC); const float* hyd = arg_in(a, I_HD) + layer * 1024;
    for (int it = F.gw; it < 2 * 16 * 16; it += F.NGW) {
        const int b = it >> 8, cbk = (it >> 4) & 15, tb = it & 15; const int c = cbk * 64 + F.lane, t0 = tb * 16;
        const float* vb = VC + (size_t)b * CTX * 1024 + c; const float* fc = FC + c;
        float acc[16];
#pragma unroll
        for (int i = 0; i < 16; ++i) acc[i] = 0.f;
#pragma unroll 1
        for (int sb = 0; sb < 16; ++sb) { const int s0 = sb * 16, dl = t0 - s0;
            float f[31], v[16];
#pragma unroll
            for (int j = 0; j < 31; ++j) { const int lag = dl + j - 15; f[j] = lag >= 0 ? fc[(size_t)lag * 2048] : fc[(size_t)(-lag) * 2048 + 1024]; }
#pragma unroll
            for (int j = 0; j < 16; ++j) v[j] = vb[(size_t)(s0 + j) * 1024];
#pragma unroll
            for (int i = 0; i < 16; ++i)
#pragma unroll
                for (int j = 0; j < 16; ++j) acc[i] += f[i - j + 15] * v[j]; }
#pragma unroll
        for (int i = 0; i < 16; ++i) { const int t = t0 + i; const size_t row = (size_t)(b * CTX + t);
            const float x0 = bf2f(P2[row * P2W + P2_X0 + c]);
            YC[row * 1024 + c] = (bf16_t)f2bf((acc[i] + vb[(size_t)t * 1024] * hyd[c]) * x0); }
    }
}

__device__ __forceinline__ void phase_ln1(Frame& F, const Args& a, int layer) {
    const float* mod = (const float*)(F.ws + WS_CTL) + CW_MOD + (size_t)layer * 3 * 6 * DM;
    const float* YM = WSP(float, WS_YMIX); float* XS = WSP(float, WS_XS); unsigned* H2 = WSP(unsigned, WS_H2); float* AFF = WSP(float, WS_AFF); int* INV = WSP(int, WS_INV);
    const float* g1w = arg_in(a, I_LN1G) + layer * DM; const float* b1w = arg_in(a, I_LN1B) + layer * DM; const float* wr = arg_in(a, I_WROUTER) + (size_t)layer * DM * NEXP;
    LAS float* wrT = (LAS float*)F.lds;
    __syncthreads();
    for (int i = F.tid; i < DM * NEXP; i += NTHREADS) { const int c = i >> 4, e = i & 15; wrT[e * DM + c] = wr[i]; }
    __syncthreads();
    int* PTOK = WSP(int, WS_PTOK); float* PG = WSP(float, WS_PGATE);
    for (int i = F.bid * NTHREADS + F.tid; i < NPAIR; i += F.G * NTHREADS) { PTOK[i] = -1; PG[i] = 0.f; }
    for (int row = F.gw; row < T; row += F.NGW) {
        const f32x4* xr = (const f32x4*)x_src_row(a, F, layer, row) + F.lane; const f32x4* yr = (const f32x4*)(YM + (size_t)row * DM) + F.lane;
        const float* m = mod + (size_t)row_modidx(row) * 6 * DM;
        f32x4 v[8];
#pragma unroll
        for (int j = 0; j < 8; ++j) { const int c = 4 * (64 * j + F.lane); v[j] = xr[64 * j] * ALPHA + *(const f32x4*)(m + 2 * DM + c) * yr[64 * j]; }
        float mean, rstd; row_stats(v, mean, rstd, 1e-6f);
        f32x4* xo = (f32x4*)(XS + (size_t)row * DM) + F.lane;
#pragma unroll
        for (int j = 0; j < 8; ++j) { const int c = 4 * (64 * j + F.lane); v[j] = (v[j] - mean) * rstd * *(const f32x4*)(g1w + c) + *(const f32x4*)(b1w + c); xo[64 * j] = v[j]; }
        row_stats(v, mean, rstd, 1e-6f);
        unsigned* ho = H2 + (size_t)row * (DM / 4) + F.lane;
        float lg[16];
#pragma unroll
        for (int e = 0; e < 16; ++e) lg[e] = 0.f;
#pragma unroll
        for (int j = 0; j < 8; ++j) { const int c = 4 * (64 * j + F.lane);
            const f32x4 y = (v[j] - mean) * rstd * (*(const f32x4*)(m + 4 * DM + c) + 1.f) + *(const f32x4*)(m + 3 * DM + c);
            ho[64 * j] = pk4fp8(y.x, y.y, y.z, y.w);
#pragma unroll
            for (int e = 0; e < 16; ++e) { const f32x4 ww = *(const LAS f32x4*)(wrT + e * DM + c); lg[e] += (y.x * ww.x + y.y * ww.y) + (y.z * ww.z + y.w * ww.w); } }
        float mx = -1e30f;
#pragma unroll
        for (int e = 0; e < 16; ++e) { lg[e] = wave_sum(lg[e]); mx = fmaxf(mx, lg[e]); }
        float den = 0.f;
#pragma unroll
        for (int e = 0; e < 16; ++e) { lg[e] = __expf(lg[e] - mx); den += lg[e]; }
        float mine = 0.f;
#pragma unroll
        for (int e = 0; e < 16; ++e) mine = (F.lane == e) ? lg[e] : mine;
        if (F.lane < 16) { AFF[(size_t)row * 16 + F.lane] = mine / den; INV[(size_t)row * 16 + F.lane] = -1; }
    }
}
__device__ __forceinline__ void phase_topk(Frame& F, bool lat_only) {
    const float* AFF = WSP(float, WS_AFF); int* INV = WSP(int, WS_INV); int* PTOK = WSP(int, WS_PTOK); float* PG = WSP(float, WS_PGATE);
    LAS unsigned* vals = (LAS unsigned*)F.lds; LAS unsigned* hist = vals + 8192; LAS unsigned* ctl = hist + 256;
    for (int u = F.bid + (lat_only ? 32 : 0); u < 64; u += F.G) {
        const int s = u >> 4, e = u & 15, rs = seg_start(s), n = seg_len(s), cap = s < 2 ? CAP_C : CAP_L;
        __syncthreads();
        for (int i = F.tid; i < n; i += NTHREADS) vals[i] = __builtin_bit_cast(unsigned, AFF[(size_t)(rs + i) * 16 + e]);
        if (F.tid == 0) { ctl[0] = 0u; ctl[1] = (unsigned)cap; ctl[2] = 0u; ctl[3] = 0u; }
        unsigned mask = 0u;
        for (int shift = 24; shift >= 0; shift -= 8) {
            if (F.tid < 256) hist[F.tid] = 0u;
            __syncthreads();
            const unsigned prefix = ctl[0];
            for (int i = F.tid; i < n; i += NTHREADS) { const unsigned b = vals[i]; if ((b & mask) == prefix) __hip_atomic_fetch_add(&hist[(b >> shift) & 255u], 1u, __ATOMIC_RELAXED, __HIP_MEMORY_SCOPE_WORKGROUP); }
            __syncthreads();
            if (F.tid == 0) { unsigned rem = ctl[1], cum = 0u; int dg = 255; for (; dg > 0; --dg) { const unsigned hc = hist[dg]; if (cum + hc >= rem) break; cum += hc; }
                ctl[1] = rem - cum; ctl[0] = prefix | ((unsigned)dg << shift); }
            mask |= 255u << shift;
            __syncthreads();
        }
        const unsigned thr = ctl[0], rem = ctl[1]; const unsigned ngt = (unsigned)cap - rem;
        const int pbase = s < 2 ? NBATCH * NEXP * CAP_L + e * 256 + s * CAP_C : ((s - 2) * NEXP + e) * CAP_L;
        for (int i = F.tid; i < n; i += NTHREADS) { const unsigned b = vals[i]; int slot = -1;
            if (b > thr) slot = (int)__hip_atomic_fetch_add(&ctl[2], 1u, __ATOMIC_RELAXED, __HIP_MEMORY_SCOPE_WORKGROUP);
            else if (b == thr) { const unsigned q = __hip_atomic_fetch_add(&ctl[3], 1u, __ATOMIC_RELAXED, __HIP_MEMORY_SCOPE_WORKGROUP); if (q < rem) slot = (int)(ngt + q); }
            if (slot >= 0) { const int pair = pbase + slot, row = rs + i; PTOK[pair] = row; PG[pair] = __builtin_bit_cast(float, b); INV[(size_t)row * 16 + e] = pair; } }
    }
}
__device__ __forceinline__ void phase_gather(Frame& F) {
    const unsigned char* H2 = WSP(unsigned char, WS_H2); unsigned char* XG = WSP(unsigned char, WS_XG); unsigned char* HID = WSP(unsigned char, WS_HID); const int* PTOK = WSP(int, WS_PTOK);
    for (int p = F.gw; p < NPAIR; p += F.NGW) { const int tok = PTOK[p]; u32x4* dst = (u32x4*)(XG + (size_t)p * DM) + F.lane;
        unsigned zz = 0u; asm volatile("" : "+v"(zz));
        if (tok >= 0) { const u32x4* src = (const u32x4*)(H2 + (size_t)tok * DM) + F.lane; dst[0] = src[0]; dst[64] = src[64]; }
        else { dst[0] = (u32x4){zz, zz, zz, zz}; dst[64] = (u32x4){zz, zz, zz, zz}; }
        if (F.lane < 8) *((u32x4*)(HID + (size_t)p * EFFP + EFF) + F.lane) = (u32x4){zz, zz, zz, zz}; }
}
__device__ __forceinline__ void phase_ln2(Frame& F, const Args& a, int layer) {
    const float* mod = (const float*)(F.ws + WS_CTL) + CW_MOD + (size_t)layer * 3 * 6 * DM;
    float* XS = WSP(float, WS_XS); const bf16_t* YE = WSP(bf16_t, WS_YE); const int* INV = WSP(int, WS_INV);
    const float* g2w = arg_in(a, I_LN2G) + layer * DM; const float* b2w = arg_in(a, I_LN2B) + layer * DM;
    for (int row = F.gw; row < T; row += F.NGW) {
        f32x4* xr = (f32x4*)(XS + (size_t)row * DM) + F.lane; const float* m = mod + (size_t)row_modidx(row) * 6 * DM;
        f32x4 mo[8];
#pragma unroll
        for (int j = 0; j < 8; ++j) mo[j] = (f32x4){0.f, 0.f, 0.f, 0.f};
        for (int e = 0; e < 16; ++e) { const int pair = INV[(size_t)row * 16 + e];
            if (pair >= 0) { const u32x2* yr = (const u32x2*)(YE + (size_t)pair * DM) + F.lane;
#pragma unroll
                for (int j = 0; j < 8; ++j) { const u32x2 w = yr[64 * j]; mo[j] += (f32x4){bflo(w.x), bfhi(w.x), bflo(w.y), bfhi(w.y)}; } } }
        f32x4 v[8];
#pragma unroll
        for (int j = 0; j < 8; ++j) { const int c = 4 * (64 * j + F.lane); v[j] = xr[64 * j] * ALPHA + *(const f32x4*)(m + 5 * DM + c) * mo[j]; }
        float mean, rstd; row_stats(v, mean, rstd, 1e-6f);
#pragma unroll
        for (int j = 0; j < 8; ++j) { const int c = 4 * (64 * j + F.lane); v[j] = (v[j] - mean) * rstd * *(const f32x4*)(g2w + c) + *(const f32x4*)(b2w + c); xr[64 * j] = v[j]; }
        if (layer == DEPTH - 1) { if (row >= TC) { f32x4* o = (f32x4*)(a.out + (size_t)(row - TC) * DM) + F.lane;
#pragma unroll
            for (int j = 0; j < 8; ++j) o[64 * j] = v[j]; } }
        else {
            row_stats(v, mean, rstd, 1e-6f);
            const float* m1 = m + (size_t)3 * 6 * DM;
            bf16_t* H = WSP(bf16_t, WS_H); unsigned* H8 = WSP(unsigned, WS_H8);
            u32x2* o = (u32x2*)(H + (size_t)row * DM) + F.lane; unsigned* o8 = H8 + (size_t)row * (DM / 4) + F.lane;
#pragma unroll
            for (int j = 0; j < 8; ++j) { const int c = 4 * (64 * j + F.lane); const f32x4 sh = *(const f32x4*)(m1 + c), sc = *(const f32x4*)(m1 + DM + c);
                const f32x4 y = (v[j] - mean) * rstd * (sc + 1.f) + sh; u32x2 w; w.x = pk2(y.x, y.y); w.y = pk2(y.z, y.w); o[64 * j] = w; o8[64 * j] = pk4fp8(y.x, y.y, y.z, y.w); } }
    }
}

constexpr int LDS_BYTES = 153600, MISC_OFF = LDS_BYTES - 64;
constexpr int NPL = 16, NPHASE = 1 + DEPTH * NPL;

__global__ void __launch_bounds__(NTHREADS, 2) fwd_kernel(Args args) {
    extern __shared__ __attribute__((aligned(16))) unsigned char lds_raw[];
    Frame F;
    F.lds = (LAS unsigned char*)lds_raw;
    F.tid = threadIdx.x; F.lane = F.tid & 63; F.wave = __builtin_amdgcn_readfirstlane(F.tid >> 6); const int wave0 = F.wave;
    F.G = gridDim.x; F.bid = blockIdx.x; F.gw = F.bid * NWAVES + F.wave; F.NGW = F.G * NWAVES; F.ws = args.ws;
    volatile LAS unsigned* misc = (volatile LAS unsigned*)(F.lds + MISC_OFF);
    if (F.tid < 16) misc[F.tid] = 0u;
    __syncthreads();
    const int lo = args.ph_lo, hi = args.ph_hi;
    XcdBarrier bar; bar.bar = (unsigned*)(F.ws + WS_CTL) + CW_BAR; bar.x = 0; bar.st = nullptr;
    const bool multi = (hi - lo) > 1;
    if (multi) bar = xcd_barrier_post((unsigned*)(F.ws + WS_CTL) + CW_BAR, misc);
#ifndef ONLY_PHASE
#define ONLY_PHASE -1
#endif
#define PON(r) (ONLY_PHASE < 0 || ONLY_PHASE == (r))
#ifndef REP_MASK
#define REP_MASK 0
#endif
#define REP(b) ((REP_MASK >> (b)) & 1)
#define REOPQ() do { F.ws = opq(args.ws); F.lane = lane_asm() & 63; F.wave = opqs(wave0) & 7; F.tid = F.wave * 64 + F.lane; F.G = opqs(gridDim.x); F.bid = opqs(blockIdx.x); F.gw = F.bid * NWAVES + F.wave; F.NGW = F.G * NWAVES; } while (0)
#define IN(k) (lo <= (k) && (k) < hi)
#define SEAM(k) do { if (IN(k) && IN((k) + 1)) { XcdBarrier bb_ = bar; bb_.x = (unsigned)opqs((int)bar.x); xcd_barrier(bb_); } } while (0)
    if (PON(100) && IN(0)) { F.ws = opq(args.ws); F.lane = lane_asm() & 63; F.wave = opqs(wave0) & 7; F.tid = F.wave * 64 + F.lane; F.G = opqs(gridDim.x); F.bid = opqs(blockIdx.x); F.gw = F.bid * NWAVES + F.wave; F.NGW = F.G * NWAVES; { p0_weights(F, args); REOPQ(); p0_mod(F, args); __syncthreads(); REOPQ(); phase_hdn(F, args, 0); REOPQ(); phase_hdn(F, args, 1); __syncthreads(); } }
    SEAM(0);
#pragma unroll 1
    for (int layer = 0; layer < DEPTH; ++layer) {
        const int pb = 1 + layer * NPL; const bool lat_only = (layer == DEPTH - 1);
        if (PON(0) && IN(pb + 0)) { F.ws = opq(args.ws); F.lane = lane_asm() & 63; F.wave = opqs(wave0) & 7; F.tid = F.wave * 64 + F.lane; F.G = opqs(gridDim.x); F.bid = opqs(blockIdx.x); F.gw = F.bid * NWAVES + F.wave; F.NGW = F.G * NWAVES; if (layer == 0) phase_modln(F, args, layer); __syncthreads(); }
        SEAM(pb + 0);
        if (PON(1) && IN(pb + 1)) { F.ws = opq(args.ws); F.lane = lane_asm() & 63; F.wave = opqs(wave0) & 7; F.tid = F.wave * 64 + F.lane; F.G = opqs(gridDim.x); F.bid = opqs(blockIdx.x); F.gw = F.bid * NWAVES + F.wave; F.NGW = F.G * NWAVES;
            pg8::Gemm g{WSP(bf16_t, WS_H), WSP(bf16_t, WS_WIN + layer * SZ_WIN), DM, DM, DM}; pg8::StaticOrder S; S.init(66, NNG / 256, F.G, F.bid);
            EpiBf16 E{WSP(bf16_t, WS_P), NNG, nullptr, 0, 0, 1.f};
            pg8::gemm_phase(F.lds, g, S, E, F.tid);
        }
        SEAM(pb + 1);
        if (PON(2) && IN(pb + 2)) { F.ws = opq(args.ws); F.lane = lane_asm() & 63; F.wave = opqs(wave0) & 7; F.tid = F.wave * 64 + F.lane; F.G = opqs(gridDim.x); F.bid = opqs(blockIdx.x); F.gw = F.bid * NWAVES + F.wave; F.NGW = F.G * NWAVES; { phase_prep(F, args, layer); REOPQ(); phase_filt(F, args, layer); __syncthreads(); } }
        SEAM(pb + 2);
        if (PON(3) && IN(pb + 3)) { F.ws = opq(args.ws); F.lane = lane_asm() & 63; F.wave = opqs(wave0) & 7; F.tid = F.wave * 64 + F.lane; F.G = opqs(gridDim.x); F.bid = opqs(blockIdx.x); F.gw = F.bid * NWAVES + F.wave; F.NGW = F.G * NWAVES;
#if !defined(T3) || T3 == 0
            { pg8::Gemm g{WSP(bf16_t, WS_P) + P_CQ, WSP(bf16_t, WS_WQ + layer * SZ_WQ), NNG, 512, 512}; pg8::StaticOrder S; S.init(lat_only ? 64 : 66, 6, F.G, F.bid, lat_only ? 2 : 0);
              EpiBf16 E{WSP(bf16_t, WS_Q), 1536, WSP(float, WS_RS), 2, 0, 1.f}; pg8::gemm_phase(F.lds, g, S, E, F.tid); }
#endif
#if !defined(T3) || T3 == 1
            { pg8::Gemm g{WSP(bf16_t, WS_P) + P_CKV, WSP(bf16_t, WS_WKV + layer * SZ_WKV), NNG, 512, 512}; pg8::StaticOrder S; S.init(66, 8, F.G, (F.bid + 140) & 255);
              EpiBf16 E{WSP(bf16_t, WS_KV), 2048, WSP(float, WS_RS) + 1, 2, 0, 1.f}; pg8::gemm_phase(F.lds, g, S, E, F.tid); }
#endif
#if !defined(T3) || T3 == 2
            { pg8::Gemm g{WSP(bf16_t, WS_ALORA), WSP(bf16_t, WS_WLORA + layer * SZ_WLORA), 512, 512, 512}; pg8::StaticOrder S; S.init(66, 20, F.G, (F.bid + 156) & 255);
              EpiLora E{WSP(bf16_t, WS_EW), WSP(bf16_t, WS_ICLR), WSP(bf16_t, WS_GG), arg_in(args, I_RW0) + layer * 2048, arg_in(args, I_RA0) + layer * 2048}; pg8::gemm_phase(F.lds, g, S, E, F.tid); }
            REOPQ(); phase_mamba_states(F, args, layer); __syncthreads();
#endif
        }
        SEAM(pb + 3);
        SEAM(pb + 4);
        if (PON(5) && IN(pb + 5)) { F.ws = opq(args.ws); F.lane = lane_asm() & 63; F.wave = opqs(wave0) & 7; F.tid = F.wave * 64 + F.lane; F.G = opqs(gridDim.x); F.bid = opqs(blockIdx.x); F.gw = F.bid * NWAVES + F.wave; F.NGW = F.G * NWAVES;
#if !defined(T5) || T5 == 0
            phase_rwkv_scan(F, args, layer); __syncthreads();
#endif
#if !defined(T5) || T5 == 1
            REOPQ(); phase_attn(F, lat_only);
#endif
#if !defined(T5) || T5 == 2
            REOPQ(); phase_hyena_fft(F, args, layer);
#endif
#if !defined(T5) || T5 == 3
            REOPQ(); phase_mamba_scan(F); __syncthreads();
#endif
        }
        SEAM(pb + 5);
        if (PON(6) && IN(pb + 6)) { F.ws = opq(args.ws); F.lane = lane_asm() & 63; F.wave = opqs(wave0) & 7; F.tid = F.wave * 64 + F.lane; F.G = opqs(gridDim.x); F.bid = opqs(blockIdx.x); F.gw = F.bid * NWAVES + F.wave; F.NGW = F.G * NWAVES;
#if !defined(T6) || T6 == 0
            phase_mamba_out(F, args, layer); __syncthreads();
#endif
#if !defined(T6) || T6 == 1
            REOPQ(); phase_hyena_out(F, args, layer);
#endif
#if !defined(T6) || T6 == 2
            REOPQ(); phase_rwkv_out(F, args, layer); __syncthreads();
#endif
        }
        SEAM(pb + 6);
        if (PON(7) && IN(pb + 7)) { F.ws = opq(args.ws); F.lane = lane_asm() & 63; F.wave = opqs(wave0) & 7; F.tid = F.wave * 64 + F.lane; F.G = opqs(gridDim.x); F.bid = opqs(blockIdx.x); F.gw = F.bid * NWAVES + F.wave; F.NGW = F.G * NWAVES;
            pg8::Gemm g{WSP(bf16_t, WS_H8), WSP(bf16_t, WS_WIN + layer * SZ_WIN) + (size_t)NNG * DM, DM / 2, DM / 2, DM / 2}; pg8::StaticOrder S; S.init(lat_only ? 64 : 66, NGATE / 256, F.G, F.bid, lat_only ? 2 : 0);
            EpiBf16 E{WSP(bf16_t, WS_GATES), NGATE, nullptr, 0, 0, 1.f / 64.f};
            pg8::gemm_phase<EpiBf16, pg8::StaticOrder, true>(F.lds, g, S, E, F.tid);
            REOPQ(); phase_mamba_norm(F, args, layer);
        }
        SEAM(pb + 7);
        if (PON(8) && IN(pb + 8)) { F.ws = opq(args.ws); F.lane = lane_asm() & 63; F.wave = opqs(wave0) & 7; F.tid = F.wave * 64 + F.lane; F.G = opqs(gridDim.x); F.bid = opqs(blockIdx.x); F.gw = F.bid * NWAVES + F.wave; F.NGW = F.G * NWAVES;
            pg8::Gemm g{WSP(bf16_t, WS_Y), WSP(bf16_t, WS_WBR + layer * SZ_WBR), 1024, 1024, 1024}; OrderMerge S; S.init(F.G, F.bid, lat_only ? 64 : 66, lat_only ? 2 : 0);
            EpiMerge E{WSP(bf16_t, WS_GATES), WSP(float, WS_MRGF), WSP(bf16_t, WS_MRGB)};
            pg8::gemm_phase(F.lds, g, S, E, F.tid);

        }
        SEAM(pb + 8);
        if (PON(9) && IN(pb + 9)) { F.ws = opq(args.ws); F.lane = lane_asm() & 63; F.wave = opqs(wave0) & 7; F.tid = F.wave * 64 + F.lane; F.G = opqs(gridDim.x); F.bid = opqs(blockIdx.x); F.gw = F.bid * NWAVES + F.wave; F.NGW = F.G * NWAVES;
            pg8::Gemm g{WSP(bf16_t, WS_MRGB), WSP(bf16_t, WS_WOUT + layer * SZ_WOUT), DM, DM, DM}; pg8::StaticOrder S; S.init(lat_only ? 64 : 66, 8, F.G, F.bid, lat_only ? 2 : 0);
            EpiF32 E{WSP(float, WS_YMIX), DM};
            pg8::gemm_phase(F.lds, g, S, E, F.tid);

        }
        SEAM(pb + 9);
        if (PON(10) && IN(pb + 10)) { F.ws = opq(args.ws); F.lane = lane_asm() & 63; F.wave = opqs(wave0) & 7; F.tid = F.wave * 64 + F.lane; F.G = opqs(gridDim.x); F.bid = opqs(blockIdx.x); F.gw = F.bid * NWAVES + F.wave; F.NGW = F.G * NWAVES; phase_ln1(F, args, layer); __syncthreads(); { REOPQ(); conv_experts(F, args, layer); __syncthreads(); } }
        SEAM(pb + 10);
        if (PON(11) && IN(pb + 11)) { F.ws = opq(args.ws); F.lane = lane_asm() & 63; F.wave = opqs(wave0) & 7; F.tid = F.wave * 64 + F.lane; F.G = opqs(gridDim.x); F.bid = opqs(blockIdx.x); F.gw = F.bid * NWAVES + F.wave; F.NGW = F.G * NWAVES; phase_topk(F, lat_only); __syncthreads(); }
        SEAM(pb + 11);
        if (PON(12) && IN(pb + 12)) { F.ws = opq(args.ws); F.lane = lane_asm() & 63; F.wave = opqs(wave0) & 7; F.tid = F.wave * 64 + F.lane; F.G = opqs(gridDim.x); F.bid = opqs(blockIdx.x); F.gw = F.bid * NWAVES + F.wave; F.NGW = F.G * NWAVES; phase_gather(F); }
        SEAM(pb + 12);
        if (PON(13) && IN(pb + 13)) { F.ws = opq(args.ws); F.lane = lane_asm() & 63; F.wave = opqs(wave0) & 7; F.tid = F.wave * 64 + F.lane; F.G = opqs(gridDim.x); F.bid = opqs(blockIdx.x); F.gw = F.bid * NWAVES + F.wave; F.NGW = F.G * NWAVES;
            pg8::Gemm g{WSP(bf16_t, WS_XG), WSP(bf16_t, WS_WE), DM / 2, DM / 2, DM / 2}; OrderMoe S; S.init(11, F.G, F.bid, lat_only ? 8 : 9);
            EpiSwiglu E{WSP(unsigned char, WS_HID)};
            pg8::gemm_phase<EpiSwiglu, OrderMoe, true>(F.lds, g, S, E, F.tid);

        }
        SEAM(pb + 13);
        if (PON(14) && IN(pb + 14)) { F.ws = opq(args.ws); F.lane = lane_asm() & 63; F.wave = opqs(wave0) & 7; F.tid = F.wave * 64 + F.lane; F.G = opqs(gridDim.x); F.bid = opqs(blockIdx.x); F.gw = F.bid * NWAVES + F.wave; F.NGW = F.G * NWAVES;
            pg8::Gemm g{WSP(bf16_t, WS_HID), WSP(bf16_t, WS_WE + SZ_WGU8), EFFP / 2, EFFP / 2, EFFP / 2}; OrderMoe S; S.init(8, F.G, F.bid, lat_only ? 8 : 9);
            EpiDown E{WSP(bf16_t, WS_YE), WSP(float, WS_PGATE)};
            pg8::gemm_phase<EpiDown, OrderMoe, true>(F.lds, g, S, E, F.tid);

        }
        SEAM(pb + 14);
        if (PON(15) && IN(pb + 15)) { F.ws = opq(args.ws); F.lane = lane_asm() & 63; F.wave = opqs(wave0) & 7; F.tid = F.wave * 64 + F.lane; F.G = opqs(gridDim.x); F.bid = opqs(blockIdx.x); F.gw = F.bid * NWAVES + F.wave; F.NGW = F.G * NWAVES; phase_ln2(F, args, layer); }
        SEAM(pb + 15);
    }
#undef IN
#undef SEAM
}


#ifdef DBG_CUT
__global__ void dbg_dump(const unsigned char* ws, float* out, size_t off, int is_bf16, size_t n_src) {
    const size_t N = (size_t)TL * DM;
    for (size_t i = (size_t)blockIdx.x * blockDim.x + threadIdx.x; i < N; i += (size_t)gridDim.x * blockDim.x) {
        const size_t j = i % n_src;
        out[i] = is_bf16 ? bf2f(((const bf16_t*)(ws + off))[j]) : ((const float*)(ws + off))[j];
    }
}
#endif

#ifdef DBG_PASSES
__global__ void dbg_chk(const unsigned char* base, size_t off, size_t nbytes, unsigned long long* slot) {
    const unsigned* p = (const unsigned*)(base + off); const size_t n = nbytes / 4; unsigned long long s = 0;
    for (size_t i = (size_t)blockIdx.x * blockDim.x + threadIdx.x; i < n; i += (size_t)gridDim.x * blockDim.x) s += p[i];
    for (int o = 32; o > 0; o >>= 1) s += __shfl_xor(s, o);
    if ((threadIdx.x & 63) == 0) atomicAdd(slot, s);
}
__global__ void dbg_report(const unsigned long long* tab, float* out, int npass) {
    int k = 0;
    for (int ph = NPHASE - 1; ph >= 0; --ph) if (tab[ph] != tab[64 + ph]) k = ph + 1;
    if (k == 0 && npass > 2) { for (int ph = NPHASE - 1; ph >= 0; --ph) if (tab[64 + ph] != tab[128 + ph]) k = 50 + ph + 1; }
    if (k == 0) return;
    const float c = sqrtf(10.f * (float)k);
    for (size_t i = (size_t)blockIdx.x * blockDim.x + threadIdx.x; i < (size_t)TL * DM; i += (size_t)gridDim.x * blockDim.x) out[i] = c;
}
struct DbgReg { size_t off, n; };
#endif
extern "C" void kernel_launch(void* const* d_in, const int* in_sizes, int n_in, void* d_out, int out_size, void* d_ws, size_t ws_size, hipStream_t stream) {
    static int grid = 0;
    if (grid == 0) {
        if (n_in != N_INPUTS || in_sizes[0] != TL * DM || out_size != TL * DM || ws_size < WS_END) {
            fprintf(stderr, "kernel_launch: shape/workspace mismatch: n_in %d in0 %d out %d ws %zu (need %zu)\n", n_in, n_in > 0 ? in_sizes[0] : -1, out_size, ws_size, (size_t)WS_END); grid = -1; return; }
        int dev = 0, cus = 0, per_cu = 0;
        if (hipGetDevice(&dev) != hipSuccess || hipDeviceGetAttribute(&cus, hipDeviceAttributeMultiprocessorCount, dev) != hipSuccess) { grid = -1; return; }
        if (hipFuncSetAttribute((const void*)fwd_kernel, hipFuncAttributeMaxDynamicSharedMemorySize, LDS_BYTES) != hipSuccess) { fprintf(stderr, "kernel_launch: hipFuncSetAttribute failed\n"); grid = -1; return; }
        if (hipOccupancyMaxActiveBlocksPerMultiprocessor(&per_cu, (const void*)fwd_kernel, NTHREADS, LDS_BYTES) != hipSuccess || per_cu < 1) { fprintf(stderr, "kernel_launch: occupancy query says %d\n", per_cu); grid = -1; (void)hipGetLastError(); return; }
        grid = cus;
    }
    if (grid < 0) return;
    (void)hipMemsetAsync((char*)d_ws + WS_CTL, 0, CTL_BYTES, stream);
    Args a{};
    for (int i = 0; i < N_INPUTS; ++i) a.in[i] = (const float*)d_in[i];
    a.out = (float*)d_out; a.ws = (unsigned char*)d_ws;
#if MK_ONE_LAUNCH
    a.ph_lo = 0; a.ph_hi = NPHASE;
    hipLaunchKernelGGL(fwd_kernel, dim3(grid), dim3(NTHREADS), LDS_BYTES, stream, a);
#else
#ifdef DBG_PASSES
    {
        unsigned long long* tab = (unsigned long long*)((char*)d_ws + 1600000);
        auto chk = [&](int pass, int ph, size_t off, size_t n) { hipLaunchKernelGGL(dbg_chk, dim3(1024), dim3(256), 0, stream, (const unsigned char*)d_ws, off, n, tab + pass * 64 + ph); };
        for (int pass = 0; pass < DBG_PASSES; ++pass) {
            if (pass > 0) (void)hipMemsetAsync((char*)d_ws + (size_t)CW_MOD * 4, 0, (size_t)DEPTH * 3 * 6 * DM * 4, stream);
            for (int ph = 0; ph < NPHASE; ++ph) {
                a.ph_lo = ph; a.ph_hi = ph + 1; hipLaunchKernelGGL(fwd_kernel, dim3(grid), dim3(NTHREADS), LDS_BYTES, stream, a);
                if (ph == 0) { chk(pass, ph, WS_WIN, WS_XS - WS_WIN); chk(pass, ph, (size_t)CW_MOD * 4, (size_t)DEPTH * 3 * 6 * DM * 4); continue; }
                const int r = (ph - 1) % NPL;
                switch (r) {
                case 0: chk(pass, ph, WS_H, SZ_H); chk(pass, ph, WS_HDN, SZ_HDN); break;
                case 1: chk(pass, ph, WS_P, SZ_P); break;
                case 2: chk(pass, ph, WS_P2, SZ_P2); chk(pass, ph, WS_KK, SZ_TK2); chk(pass, ph, WS_ALORA, WS_VT - WS_ALORA); chk(pass, ph, WS_VT, WS_HDN - WS_VT); break;
                case 3: chk(pass, ph, WS_Q, SZ_Q + SZ_KV); chk(pass, ph, WS_EW, 4 * SZ_TK2); chk(pass, ph, WS_GG, SZ_TK2); break;
                case 4: chk(pass, ph, WS_Q, SZ_Q); chk(pass, ph, WS_MST, SZ_MST + SZ_MCS); break;
                case 5: chk(pass, ph, WS_YRW, 2 * SZ_TK2); chk(pass, ph, WS_Y, SZ_Y / 4); chk(pass, ph, WS_VT, SZ_VT); chk(pass, ph, WS_MST, SZ_MST); break;
                case 6: chk(pass, ph, WS_Y + SZ_Y / 4, 3 * (SZ_Y / 4)); break;
                case 7: chk(pass, ph, WS_GATES, SZ_GATES); chk(pass, ph, WS_Y + SZ_Y / 4, SZ_Y / 4); break;
                case 8: chk(pass, ph, WS_MRGF, SZ_MRGF); chk(pass, ph, WS_MRGB, SZ_MRGB); break;
                case 9: chk(pass, ph, WS_YMIX, SZ_YMIX); break;
                case 10: chk(pass, ph, WS_XS, SZ_XS); chk(pass, ph, WS_H2, SZ_H); chk(pass, ph, WS_AFF, SZ_AFF); chk(pass, ph, WS_WE, SZ_WGU + SZ_WD); break;
                case 11: chk(pass, ph, WS_INV, SZ_INV + SZ_PTOK + SZ_PGATE); break;
                case 12: chk(pass, ph, WS_XG, SZ_XG); break;
                case 13: chk(pass, ph, WS_HID, SZ_HID); break;
                case 14: chk(pass, ph, WS_YE, SZ_YE); break;
                case 15: chk(pass, ph, WS_XS, SZ_XS); break;
                }
            }
        }
        hipLaunchKernelGGL(dbg_report, dim3(2048), dim3(256), 0, stream, (const unsigned long long*)tab, (float*)d_out, (int)DBG_PASSES);
    }
#elif defined(DBG_CUT)
    for (int ph = 0; ph < DBG_CUT; ++ph) { a.ph_lo = ph; a.ph_hi = ph + 1; hipLaunchKernelGGL(fwd_kernel, dim3(grid), dim3(NTHREADS), LDS_BYTES, stream, a); }
    hipLaunchKernelGGL(dbg_dump, dim3(2048), dim3(256), 0, stream, (const unsigned char*)d_ws, (float*)d_out, (size_t)DBG_OFF, DBG_BF16, (size_t)DBG_N);
#else
    for (int ph = 0; ph < NPHASE; ++ph) { a.ph_lo = ph; a.ph_hi = ph + 1; hipLaunchKernelGGL(fwd_kernel, dim3(grid), dim3(NTHREADS), LDS_BYTES, stream, a); }
#endif
#endif
}
```

```cpp
#include <hip/hip_runtime.h>
#include <cstdio>
#include <cstdint>

#define REP_MASK 0x80000
#ifndef MK_ONE_LAUNCH
#define MK_ONE_LAUNCH 1
#endif

#define LAS __attribute__((address_space(3)))
typedef unsigned short bf16_t;
typedef short bf16x8 __attribute__((ext_vector_type(8)));
typedef float f32x4 __attribute__((ext_vector_type(4)));
typedef float f32x2 __attribute__((ext_vector_type(2)));
typedef unsigned u32x4 __attribute__((ext_vector_type(4)));
typedef unsigned u32x2 __attribute__((ext_vector_type(2)));

constexpr int DM = 2048, NBATCH = 2, SEQ = 8192, CTX = 256, DEPTH = 2;
constexpr int TC = NBATCH * CTX, TL = NBATCH * SEQ, T = TC + TL;
constexpr int NIN = 18432, NNG = 10240, NGATE = 8192;
constexpr int P_CQ = 0, P_CKV = 512, P_KPE = 1024;
constexpr int P_Z = 1088, P_XBC = 2112, P_DT = 3648;
constexpr int P_HY = 3680;
constexpr int P_RW = 6752, P_WD = 9824, P_AD = 9952, P_GD = 10080;
constexpr int NH_MLA = 8, NH_SSM = 16, NH_RW = 16;
constexpr int NEXP = 16, EFF = 1408, CAP_L = 1024, CAP_C = 32;
constexpr int NPAIR = NBATCH * NEXP * CAP_L + NEXP * 256;
constexpr float ALPHA = 1.4142135623730951f;
constexpr int NWAVES = 8, NTHREADS = 512;

__device__ __forceinline__ int seg_of(int row) { return row < 256 ? 0 : row < 512 ? 1 : row < 512 + SEQ ? 2 : 3; }
__device__ __forceinline__ int seg_start(int s) { return s == 0 ? 0 : s == 1 ? 256 : s == 2 ? 512 : 512 + SEQ; }
__device__ __forceinline__ int seg_len(int s) { return s < 2 ? CTX : SEQ; }
__device__ __forceinline__ bool row_first(int row) { return row == 0 || row == 256 || row == 512 || row == 512 + SEQ; }
__device__ __forceinline__ bool row_last(int row) { return row == 255 || row == 511 || row == 511 + SEQ || row == T - 1; }
__device__ __forceinline__ int row_modidx(int row) { return row < 512 ? 2 : (row < 512 + SEQ ? 0 : 1); }

constexpr size_t AL(size_t x) { return (x + 255) / 256 * 256; }
constexpr size_t WS_CTL = 0, CTL_BYTES = 2u << 20;
constexpr int CW_BAR = 1024;
constexpr int CW_MOD = 16384;
constexpr size_t SZ_WIN = (size_t)NIN * DM * 2, SZ_WBR = (size_t)4 * DM * 1024 * 2, SZ_WOUT = (size_t)DM * DM * 2, SZ_WQ = (size_t)1536 * 512 * 2,
                 SZ_WKV = (size_t)2048 * 512 * 2, SZ_WLORA = (size_t)5120 * 512 * 2;
constexpr size_t WS_WIN = CTL_BYTES, WS_WBR = WS_WIN + DEPTH * SZ_WIN, WS_WOUT = WS_WBR + DEPTH * SZ_WBR, WS_WQ = WS_WOUT + DEPTH * SZ_WOUT,
                 WS_WKV = WS_WQ + DEPTH * SZ_WQ, WS_WLORA = WS_WKV + DEPTH * SZ_WKV, WS_XS = WS_WLORA + DEPTH * SZ_WLORA;
constexpr size_t SZ_XS = (size_t)T * DM * 4;
constexpr size_t WS_H = WS_XS + SZ_XS, SZ_H = (size_t)T * DM * 2;
constexpr size_t WS_P = WS_H + SZ_H, SZ_P = (size_t)T * NNG * 2;
constexpr int P2W = 5632, P2_XBC = 0, P2_X0 = 1536, P2_RKV = 2560;
constexpr size_t WS_P2 = WS_P + SZ_P, SZ_P2 = (size_t)T * P2W * 2;
constexpr size_t WS_Q = WS_P2 + SZ_P2, SZ_Q = (size_t)T * 1536 * 2;
constexpr size_t WS_KV = WS_Q + SZ_Q, SZ_KV = (size_t)T * 2048 * 2;
constexpr size_t WS_EW = WS_KV + SZ_KV, SZ_TK2 = (size_t)T * 1024 * 2;
constexpr size_t WS_ICLR = WS_EW + 2 * SZ_TK2;
constexpr size_t WS_KK = WS_ICLR + 2 * SZ_TK2;
constexpr size_t WS_GG = WS_KK + SZ_TK2;
constexpr size_t WS_YRW = WS_GG + SZ_TK2;
constexpr size_t WS_ALORA = WS_YRW + 2 * SZ_TK2, SZ_ALORA = (size_t)T * 512 * 2;
constexpr size_t WS_KPE = WS_ALORA + SZ_ALORA, SZ_KPE = (size_t)T * 64 * 2;
constexpr size_t WS_RS = WS_KPE + SZ_KPE, SZ_RS = AL((size_t)T * 2 * 4);
constexpr size_t WS_DT = WS_RS + SZ_RS, SZ_DT = (size_t)T * 32 * 4;
constexpr size_t WS_VT = WS_DT + SZ_DT, SZ_VT = (size_t)1024 * 2 * SEQ * 4;
constexpr size_t WS_VC = WS_VT + SZ_VT, SZ_VC = (size_t)TC * 1024 * 4;
constexpr size_t WS_FILT = WS_VC + SZ_VC, SZ_FILT = (size_t)1024 * 2 * SEQ * 2;
constexpr size_t WS_FILTC = WS_FILT + SZ_FILT, SZ_FILTC = (size_t)CTX * 2048 * 4;
constexpr size_t WS_HDN = WS_FILTC + SZ_FILTC, SZ_HDN1 = (size_t)(SEQ + CTX) * 64 * 4, SZ_HDN = DEPTH * SZ_HDN1;
constexpr int NCHUNK = T / 128;
constexpr size_t WS_MST = WS_HDN + SZ_HDN, SZ_MST = (size_t)2 * NCHUNK * 16 * 8192 * 2;
constexpr size_t WS_MCS = WS_MST + SZ_MST, SZ_MCS = (size_t)2 * NCHUNK * 16 * 4 * 2;
constexpr size_t WS_Y = WS_MCS + AL(SZ_MCS), SZ_Y = (size_t)4 * T * 1024 * 2;
constexpr size_t WS_AFF = WS_Y + SZ_Y, SZ_AFF = (size_t)T * 16 * 4;
constexpr size_t WS_INV = WS_AFF + SZ_AFF, SZ_INV = (size_t)T * 16 * 4;
constexpr size_t WS_PTOK = WS_INV + SZ_INV, SZ_PTOK = (size_t)NPAIR * 4;
constexpr size_t WS_PGATE = WS_PTOK + SZ_PTOK, SZ_PGATE = (size_t)NPAIR * 4;
constexpr size_t WS_H8 = WS_PGATE + SZ_PGATE, SZ_H8 = (size_t)T * DM;
constexpr size_t WS_END = WS_H8 + SZ_H8;
constexpr size_t WS_GATES = WS_P, SZ_GATES = (size_t)T * NGATE * 2;
constexpr size_t WS_MRGF = WS_P2, SZ_MRGF = (size_t)T * DM * 4;
constexpr size_t WS_MRGB = WS_Q, SZ_MRGB = (size_t)T * DM * 2;
constexpr size_t WS_YMIX = WS_P, SZ_YMIX = (size_t)T * DM * 4;
constexpr size_t WS_H2 = WS_H;
constexpr size_t WS_WE = WS_P2, SZ_WGU = (size_t)NEXP * 2816 * DM * 2, SZ_WD = (size_t)NEXP * DM * EFF * 2;
constexpr size_t WS_XG = WS_P, SZ_XG = (size_t)NPAIR * DM * 2;
constexpr size_t WS_HID = WS_XG + SZ_XG, SZ_HID = (size_t)NPAIR * EFF * 2;
constexpr size_t WS_YE = WS_WE + SZ_WGU + SZ_WD, SZ_YE = (size_t)NPAIR * DM * 2;
static_assert(SZ_GATES <= SZ_P && SZ_MRGF <= SZ_P2 && SZ_MRGB <= SZ_Q + SZ_KV && SZ_YMIX <= SZ_P, "alias map 1");
static_assert(SZ_XG + SZ_HID <= SZ_P, "alias map 2");
static_assert(WS_YE + SZ_YE <= WS_VT, "alias map 3");
static_assert(WS_END < 1800000000ull, "workspace budget");

__device__ __forceinline__ unsigned f2bf(float f) { unsigned u = __builtin_bit_cast(unsigned, f); return (u + 0x7fffu + ((u >> 16) & 1u)) >> 16; }
__device__ __forceinline__ unsigned pk2(float lo, float hi) { return f2bf(lo) | (f2bf(hi) << 16); }
__device__ __forceinline__ float bf2f(unsigned short b) { return __builtin_bit_cast(float, (unsigned)b << 16); }
__device__ __forceinline__ float bflo(unsigned w) { return __builtin_bit_cast(float, w << 16); }
__device__ __forceinline__ float bfhi(unsigned w) { return __builtin_bit_cast(float, w & 0xffff0000u); }
__device__ __forceinline__ unsigned cvt_pk_bf16(float lo, float hi) { unsigned r; asm volatile("v_cvt_pk_bf16_f32 %0, %1, %2" : "=v"(r) : "v"(lo), "v"(hi)); return r; }
__device__ __forceinline__ float dppx(float x, const int sel) {
    const int xi = __builtin_bit_cast(int, x); int r;
    if (sel == 0) r = __builtin_amdgcn_update_dpp(0, xi, 0xB1, 0xF, 0xF, false);
    else if (sel == 1) r = __builtin_amdgcn_update_dpp(0, xi, 0x4E, 0xF, 0xF, false);
    else if (sel == 2) r = __builtin_amdgcn_update_dpp(0, xi, 0x141, 0xF, 0xF, false);
    else r = __builtin_amdgcn_update_dpp(0, xi, 0x140, 0xF, 0xF, false);
    return __builtin_bit_cast(float, r);
}
__device__ __forceinline__ float swz16(float x) { return __builtin_bit_cast(float, __builtin_amdgcn_ds_swizzle(__builtin_bit_cast(int, x), 0x401F)); }
__device__ __forceinline__ float sum4(float v) { v += dppx(v, 0); v += dppx(v, 1); return v; }
__device__ __forceinline__ float sum8(float v) { v = sum4(v); v += dppx(v, 2); return v; }
__device__ __forceinline__ float sum16(float v) { v = sum8(v); v += dppx(v, 3); return v; }
__device__ __forceinline__ float sum32(float v) { v = sum16(v); v += swz16(v); return v; }
__device__ __forceinline__ unsigned pk4fp8(float a, float b, float c, float d) { int w = 0; w = __builtin_amdgcn_cvt_pk_fp8_f32(a, b, w, false); w = __builtin_amdgcn_cvt_pk_fp8_f32(c, d, w, true); return (unsigned)w; }
__device__ __forceinline__ float wave_sum(float v) {
    v = sum32(v);
    auto rr = __builtin_amdgcn_permlane32_swap(__float_as_uint(v), __float_as_uint(v), false, false);
    return __uint_as_float(rr[0]) + __uint_as_float(rr[1]);
}
__device__ __forceinline__ float sigmoidf_(float x) { return 1.f / (1.f + __expf(-x)); }
__device__ __forceinline__ float siluf_(float x) { return x / (1.f + __expf(-x)); }
__device__ __forceinline__ float softplusf_(float x) { return x > 20.f ? x : __logf(1.f + __expf(x)); }
__device__ __forceinline__ float tanhf_(float x) { const float e = __expf(2.f * fminf(x, 15.f)); return 1.f - 2.f / (e + 1.f); }
#define LDS_WAIT() asm volatile("s_waitcnt lgkmcnt(0)" ::: "memory")
#define VM_WAIT() asm volatile("s_waitcnt vmcnt(0)" ::: "memory")

#define XB_TMO      128
#define XB_XCNT(j)  (256  + 64 * (j))
#define XB_XSUB(j)  (1280 + 64 * (j))
#define XB_XGEN(j)  (2304 + 64 * (j))
#define XB_TOP      3328
#define XB_TOPGEN   3392
#define XCD_BAR_WORDS 3456
#define XB_SPIN_CAP (1u << 18)
__device__ __forceinline__ unsigned xb_ld(unsigned* p)              { return __hip_atomic_load(p, __ATOMIC_RELAXED, __HIP_MEMORY_SCOPE_AGENT); }
__device__ __forceinline__ unsigned xb_add(unsigned* p, unsigned v) { return __hip_atomic_fetch_add(p, v, __ATOMIC_RELAXED, __HIP_MEMORY_SCOPE_AGENT); }
__device__ __forceinline__ unsigned xb_xcc_id() { return (unsigned)__builtin_amdgcn_s_getreg((3 << 11) | 20) & 0xFu; }
#define XB_SPIN(cond, bar) do { unsigned _sp = 0; while (cond) { __builtin_amdgcn_s_sleep(1); \
    if ((++_sp & 255u) == 0u) { if (xb_ld(&(bar)[XB_TMO])) break; if (_sp > XB_SPIN_CAP) { atomicAdd(&(bar)[XB_TMO], 1u); break; } } } } while (0)
struct XcdBarrier { unsigned* bar; unsigned x; volatile LAS unsigned* st; };
__device__ __forceinline__ XcdBarrier xcd_barrier_post(unsigned* bar, volatile LAS unsigned* st) {
    XcdBarrier b; b.bar = bar; b.x = xb_xcc_id(); b.st = st;
    if (threadIdx.x == 0) (void)xb_add(&bar[XB_XCNT(b.x)], 1u);
    return b;
}
__device__ __forceinline__ void xcd_barrier_complete(unsigned* bar, unsigned x, unsigned& nloc, unsigned& nx) {
    const unsigned G = gridDim.x * gridDim.y * gridDim.z;
    unsigned sum, cnt, mine, sp = 0u;
    for (;;) {
        sum = 0u; cnt = 0u; mine = 0u;
#pragma unroll
        for (unsigned j = 0; j < 16; ++j) { const unsigned c = xb_ld(&bar[XB_XCNT(j)]); sum += c; cnt += (c > 0u) ? 1u : 0u; mine = (j == x) ? c : mine; }
        if (sum == G) break;
        __builtin_amdgcn_s_sleep(1);
        if ((++sp & 255u) == 0u) { if (xb_ld(&bar[XB_TMO])) break; if (sp > XB_SPIN_CAP) { atomicAdd(&bar[XB_TMO], 1u); break; } }
    }
    nloc = mine > 0u ? mine : 1u; nx = cnt > 0u ? cnt : 1u;
}
__device__ __forceinline__ void xcd_barrier(const XcdBarrier& b) {
    asm volatile("s_waitcnt vmcnt(0)" ::: "memory");
    __syncthreads();
    if (threadIdx.x == 0) {
        unsigned* bar = b.bar;
        __builtin_amdgcn_s_waitcnt(0);
        unsigned nloc = b.st[0], nx = b.st[1];
        if (nloc == 0u) { xcd_barrier_complete(bar, b.x, nloc, nx); b.st[0] = nloc; b.st[1] = nx; }
        const unsigned old = xb_add(&bar[XB_XSUB(b.x)], 1u);
        const unsigned gen = old / nloc;
        if (old + 1u == (gen + 1u) * nloc) {
            __builtin_amdgcn_fence(__ATOMIC_RELEASE, "agent");
            asm volatile("s_waitcnt vmcnt(0)" ::: "memory");
            const unsigned og = xb_add(&bar[XB_TOP], 1u);
            const unsigned tg = og / nx;
            if (og + 1u == (tg + 1u) * nx) xb_add(&bar[XB_TOPGEN], 1u);
            else XB_SPIN(xb_ld(&bar[XB_TOPGEN]) == tg, bar);
            __builtin_amdgcn_fence(__ATOMIC_ACQUIRE, "agent");
            xb_add(&bar[XB_XGEN(b.x)], 1u);
            asm volatile("s_waitcnt vmcnt(0)" ::: "memory");
        } else {
            XB_SPIN(xb_ld(&bar[XB_XGEN(b.x)]) == gen, bar);
            __builtin_amdgcn_fence(__ATOMIC_ACQUIRE, "agent");
            asm volatile("s_waitcnt vmcnt(0)" ::: "memory");
        }
    }
    __syncthreads();
}

__device__ __forceinline__ int lane_asm() { int l; asm volatile("v_mbcnt_lo_u32_b32 %0, -1, 0\n\tv_mbcnt_hi_u32_b32 %0, -1, %0" : "=v"(l)); return l; }
namespace pg8 {
constexpr int BM = 256, BK = 64, HALF = 128, HTB = HALF * BK * 2, STAGE_BYTES = 8 * HTB, NXCD = 8, WGM = 8;
__host__ __device__ __forceinline__ int lds_byte(int r, int c) { const int st = (r >> 4) * 2 + (c >> 5), rr = r & 15, cc = c & 31, ob = rr * 64 + cc * 2; return st * 1024 + (ob ^ (((ob >> 9) & 1) << 5)); }
__host__ __device__ __forceinline__ void stage_rc(int b, int& R, int& C) { const int st = b / 1024, sb = b % 1024, swz = sb ^ (((sb >> 9) & 1) << 5); R = (st >> 1) * 16 + swz / 64; C = (st & 1) * 32 + (swz % 64) / 2; }
__host__ __device__ __forceinline__ int perm32(int rho) { const int n = rho >> 4, i = rho & 15; return 8 * (i >> 2) + 4 * n + (i & 3); }
struct Unit { int pm, pn; };
struct Gemm { const bf16_t* A; const bf16_t* Bt; int lda, ldb, K; };
struct StaticOrder {
    int nM, nN, nwg, G, c, pm0;
    __device__ void init(int nM_, int nN_, int G_, int c_, int pm0_ = 0) { nM = nM_; nN = nN_; nwg = nM * nN; G = G_; c = c_; pm0 = pm0_; }
    __device__ bool next(int i, Unit& u) const {
        const long L = (long)i * G + c; if (L >= nwg) return false;
        int wgid = (int)L; { const int q = nwg / NXCD, r = nwg % NXCD, xcd = wgid % NXCD, off = wgid / NXCD; wgid = (xcd < r ? xcd * (q + 1) : r * (q + 1) + (xcd - r) * q) + off; }
        const int nig = WGM * nN, gid = wgid / nig, fm = gid * WGM, gsz = (nM - fm) < WGM ? (nM - fm) : WGM;
        u.pm = pm0 + fm + ((wgid % nig) % gsz); u.pn = (wgid % nig) / gsz; return true;
    }
};
typedef int i32x4v __attribute__((ext_vector_type(4)));
typedef int i32x8v __attribute__((ext_vector_type(8)));
__device__ __forceinline__ i32x8v cat8(bf16x8 a, bf16x8 b) { return __builtin_shufflevector(__builtin_bit_cast(i32x4v, a), __builtin_bit_cast(i32x4v, b), 0, 1, 2, 3, 4, 5, 6, 7); }
template <class Epi, class Sched, bool FP8 = false>
__device__ __forceinline__ void gemm_phase(LAS unsigned char* lds, const Gemm g, const Sched& S, const Epi& E, int tid_in) {
    constexpr bool ALIGN_EPI = true;
    const unsigned tid_u = (unsigned)tid_in; __builtin_assume(tid_u < 512u);
    const int tid = (int)tid_u, wid = __builtin_amdgcn_readfirstlane(tid >> 6), lane = tid & 63, wr = wid >> 2, wc = wid & 3, fr = lane & 15, fq = lane >> 4;
    const int K = g.K, nt = K / BK;
    unsigned voffA[2], voffB[2];
#pragma unroll
    for (int i = 0; i < 2; ++i) { int R, C; stage_rc(tid * 16 + i * 8192, R, C); const int Rb = Epi::PERM ? ((R & ~31) + perm32(R & 31)) : R;
        voffA[i] = (unsigned)(R * g.lda + C) * 2u; voffB[i] = (unsigned)(Rb * g.ldb + C) * 2u; }
    const unsigned kstep = (unsigned)(BK * 2);
    const unsigned hstepA = (unsigned)HALF * g.lda * 2u, hstepB = (unsigned)HALF * g.ldb * 2u;
    const unsigned tstepA = 2u * hstepA, tstepB = 2u * hstepB;
    const unsigned ldsw = (unsigned)wid * 1024u;
    const int aoff = lds_byte(wr * 64 + fr, fq * 8), boff = lds_byte(wc * 32 + fr, fq * 8);
    const __amdgpu_buffer_rsrc_t rsA = __builtin_amdgcn_make_buffer_rsrc((void*)g.A, 0, 0xFFFFFFFFu, 0x00020000);
    const __amdgpu_buffer_rsrc_t rsB = __builtin_amdgcn_make_buffer_rsrc((void*)g.Bt, 0, 0xFFFFFFFFu, 0x00020000);
#define PG8_SA(b, h) (((b) * 2 + (h)) * HTB)
#define PG8_SB(b, h) ((4 + (b) * 2 + (h)) * HTB)
#define PG8_STAGE(bufoff, rs, soff, voff) do { _Pragma("unroll") for (int _i = 0; _i < 2; ++_i) \
        __builtin_amdgcn_raw_ptr_buffer_load_lds(rs, (LAS unsigned*)(lds + (bufoff) + ldsw + _i * 8192), 16, (int)(voff)[_i], (int)(soff), 0, 0); } while (0)
#define PG8_LDA(dst, b, h) do { if constexpr (FP8) { _Pragma("unroll") for (int m = 0; m < 4; ++m) dst##8[m] = __builtin_shufflevector(*(const LAS i32x4v*)(lds + PG8_SA(b, h) + aoff + m * 2048), *(const LAS i32x4v*)(lds + PG8_SA(b, h) + aoff + m * 2048 + 1024), 0, 1, 2, 3, 4, 5, 6, 7); } \
    else { _Pragma("unroll") for (int m = 0; m < 4; ++m) _Pragma("unroll") for (int k = 0; k < 2; ++k) dst[m][k] = *(const LAS bf16x8*)(lds + PG8_SA(b, h) + aoff + m * 2048 + k * 1024); } } while (0)
#define PG8_LDB(dst, b, h) do { if constexpr (FP8) { _Pragma("unroll") for (int n = 0; n < 2; ++n) dst##8[n] = __builtin_shufflevector(*(const LAS i32x4v*)(lds + PG8_SB(b, h) + boff + n * 2048), *(const LAS i32x4v*)(lds + PG8_SB(b, h) + boff + n * 2048 + 1024), 0, 1, 2, 3, 4, 5, 6, 7); } \
    else { _Pragma("unroll") for (int n = 0; n < 2; ++n) _Pragma("unroll") for (int k = 0; k < 2; ++k) dst[n][k] = *(const LAS bf16x8*)(lds + PG8_SB(b, h) + boff + n * 2048 + k * 1024); } } while (0)
#define PG8_MMA(ai, bj, At, Bt) do { __builtin_amdgcn_s_setprio(1); if constexpr (FP8) { _Pragma("unroll") for (int m = 0; m < 4; ++m) _Pragma("unroll") for (int n = 0; n < 2; ++n) \
        acc[ai][bj][m][n] = __builtin_amdgcn_mfma_scale_f32_16x16x128_f8f6f4(Bt##8[n], At##8[m], acc[ai][bj][m][n], 0, 0, 0, 0x7F7F7F7F, 0, 0x7F7F7F7F); } else { \
        _Pragma("unroll") for (int m = 0; m < 4; ++m) _Pragma("unroll") for (int n = 0; n < 2; ++n) _Pragma("unroll") for (int k = 0; k < 2; ++k) \
        acc[ai][bj][m][n] = __builtin_amdgcn_mfma_f32_16x16x32_bf16(Bt[n][k], At[m][k], acc[ai][bj][m][n], 0, 0, 0); } __builtin_amdgcn_s_setprio(0); } while (0)
#define PG8_WAIT_V(n) asm volatile("s_waitcnt vmcnt(" #n ")" ::: "memory")
#define PG8_WAIT_L(n) asm volatile("s_waitcnt lgkmcnt(" #n ")" ::: "memory")
#define PG8_BAR __builtin_amdgcn_s_barrier()
#define PG8_SCHED __builtin_amdgcn_sched_barrier(0)
    Unit cur, nxt; int ui = 0;
    if (!S.next(0, cur)) return;
    f32x4 acc[2][2][4][2];
#pragma unroll
    for (int a = 0; a < 2; ++a)
#pragma unroll
        for (int b = 0; b < 2; ++b)
#pragma unroll
            for (int m = 0; m < 4; ++m)
#pragma unroll
                for (int n = 0; n < 2; ++n) acc[a][b][m][n] = (f32x4){0.f, 0.f, 0.f, 0.f};
    i32x8v At8[4], B08[2], B18[2]; bf16x8 At[4][2], B0[2][2], B1[2][2];
    unsigned cA = (unsigned)cur.pm * tstepA, cB = (unsigned)cur.pn * tstepB;
    PG8_STAGE(PG8_SB(0, 0), rsB, cB, voffB); PG8_STAGE(PG8_SB(0, 1), rsB, cB + hstepB, voffB); PG8_STAGE(PG8_SA(0, 0), rsA, cA, voffA); PG8_STAGE(PG8_SA(0, 1), rsA, cA + hstepA, voffA);
    if (wr == 1) PG8_BAR;
    PG8_WAIT_V(2); PG8_BAR;
    PG8_STAGE(PG8_SB(1, 0), rsB, cB + kstep, voffB); PG8_STAGE(PG8_SA(1, 0), rsA, cA + kstep, voffA); PG8_STAGE(PG8_SB(1, 1), rsB, cB + hstepB + kstep, voffB);
    PG8_WAIT_V(6); PG8_BAR;
    for (;;) {
        const bool has_next = S.next(ui + 1, nxt);
        const unsigned nA = has_next ? (unsigned)nxt.pm * tstepA : cA; const unsigned nB = has_next ? (unsigned)nxt.pn * tstepB : cB;
        for (int t = 0; t < nt; t += 2) {
            const bool last = (t == nt - 2);
            const unsigned a1 = cA + (unsigned)(t + 1) * kstep;
            const unsigned a2 = last ? nA : cA + (unsigned)(t + 2) * kstep; const unsigned b2 = last ? nB : cB + (unsigned)(t + 2) * kstep;
            const unsigned a3 = a2 + kstep; const unsigned b3 = b2 + kstep;
            PG8_LDB(B0, 0, 0); PG8_LDB(B1, 0, 1); PG8_SCHED; PG8_LDA(At, 0, 0); PG8_STAGE(PG8_SA(1, 1), rsA, a1 + hstepA, voffA);
            PG8_WAIT_V(8); PG8_WAIT_L(0); PG8_BAR; PG8_MMA(0, 0, At, B0); PG8_MMA(0, 1, At, B1); PG8_BAR; PG8_SCHED;
            PG8_LDA(At, 0, 1); PG8_STAGE(PG8_SB(0, 0), rsB, b2, voffB); PG8_STAGE(PG8_SB(0, 1), rsB, b2 + hstepB, voffB); PG8_STAGE(PG8_SA(0, 0), rsA, a2, voffA);
            PG8_WAIT_V(8); PG8_WAIT_L(0); PG8_BAR; PG8_MMA(1, 0, At, B0); PG8_MMA(1, 1, At, B1); PG8_BAR; PG8_SCHED;
            PG8_LDB(B0, 1, 0); PG8_LDB(B1, 1, 1); PG8_SCHED; PG8_LDA(At, 1, 0); PG8_STAGE(PG8_SA(0, 1), rsA, a2 + hstepA, voffA);
            PG8_WAIT_V(8); PG8_WAIT_L(0); PG8_BAR; PG8_MMA(0, 0, At, B0); PG8_MMA(0, 1, At, B1); PG8_BAR; PG8_SCHED;
            PG8_LDA(At, 1, 1); PG8_STAGE(PG8_SB(1, 0), rsB, b3, voffB); PG8_STAGE(PG8_SB(1, 1), rsB, b3 + hstepB, voffB); PG8_STAGE(PG8_SA(1, 0), rsA, a3, voffA);
            PG8_WAIT_V(8); PG8_WAIT_L(0); PG8_BAR; PG8_MMA(1, 0, At, B0); PG8_MMA(1, 1, At, B1); PG8_BAR; PG8_SCHED;
        }
        if constexpr (ALIGN_EPI) { if (wr == 0) PG8_BAR; }
        { const int l2 = lane_asm() & 63; E(acc, cur, wr, wc, l2 & 15, l2 >> 4); }
        if (!has_next) break;
#pragma unroll
        for (int a = 0; a < 2; ++a)
#pragma unroll
            for (int b = 0; b < 2; ++b)
#pragma unroll
                for (int m = 0; m < 4; ++m)
#pragma unroll
                    for (int n = 0; n < 2; ++n) acc[a][b][m][n] = (f32x4){0.f, 0.f, 0.f, 0.f};
        cur = nxt; cA = nA; cB = nB; ++ui;
        if constexpr (ALIGN_EPI) { if (wr == 1) PG8_BAR; }
    }
    PG8_WAIT_V(0);
    if constexpr (!ALIGN_EPI) { if (wr == 0) PG8_BAR; }
    PG8_BAR;
#undef PG8_SA
#undef PG8_SB
#undef PG8_STAGE
#undef PG8_LDA
#undef PG8_LDB
#undef PG8_MMA
#undef PG8_WAIT_V
#undef PG8_WAIT_L
#undef PG8_BAR
#undef PG8_SCHED
}
}

enum { I_X = 0, I_C, I_CTX, I_CCTX, I_WADA, I_BADA, I_WIN, I_QNORM, I_WQUP, I_KVNORM, I_WKVUP, I_SCONVW, I_SCONVB, I_SDTB, I_SALOG, I_SD, I_SNORM,
       I_HCONVW, I_HCONVB, I_HW1, I_HB1, I_HW2, I_HB2, I_HW3, I_HFREQ, I_HD, I_RMU, I_RW0, I_RWUP, I_RA0, I_RAUP, I_RGUP, I_RKK, I_RKA, I_RRK, I_RLNG, I_RLNB,
       I_WBR, I_WOUT, I_LN1G, I_LN1B, I_WROUTER, I_WGATE, I_WUP, I_WDOWN, I_LN2G, I_LN2B, N_INPUTS };
struct Args { const float* in[N_INPUTS]; float* out; unsigned char* ws; int ph_lo, ph_hi; };
static_assert(sizeof(Args) == (N_INPUTS + 2) * 8 + 8, "Args has no padding");

__device__ __forceinline__ const float* arg_in(const Args& a, int i) { asm volatile("" : "+s"(i)); return a.in[i]; }
__device__ __forceinline__ int opqs(int v) { asm volatile("" : "+s"(v)); return v; }
__device__ __forceinline__ int opqv(int v) { asm volatile("" : "+v"(v)); return v; }
__device__ __forceinline__ unsigned char* opq(unsigned char* p) { asm volatile("" : "+s"(p)); return p; }
struct Frame {
    LAS unsigned char* lds;
    int tid, lane, wave, G, bid, gw, NGW;
    unsigned char* ws;
};
#define WSP(T_, off) ((T_*)(F.ws + (off)))

struct RmId { __device__ int operator()(int n) const { return n; } };
struct RmGateUp { int up; __device__ int operator()(int n) const { return 256 * (n >> 7) + (n & 127) + (up ? 128 : 0); } };
constexpr int TR_SCR = 64 * 65 * 4;
__device__ __forceinline__ void tr_load(const float* W, int ldw, int k0, int n0, const float* kscale, float sc, LAS float* scr, int lane) {
    float v[64];
    const float* wp = W + (size_t)k0 * ldw + n0 + lane;
#pragma unroll
    for (int i = 0; i < 64; ++i) v[i] = wp[(size_t)i * ldw];
#pragma unroll
    for (int i = 0; i < 64; ++i) { float x = v[i] * sc; if (kscale) x *= kscale[k0 + i]; scr[i * 65 + lane] = x; }
    LDS_WAIT(); asm volatile("" ::: "memory");
}
template <class RowMap>
__device__ __forceinline__ void transpose_item(const float* W, int ldw, bf16_t* WT, int ldt, int k0, int n0, const float* kscale, RowMap rm, LAS float* scr, int lane) {
    tr_load(W, ldw, k0, n0, kscale, 1.f, scr, lane);
    const int c = lane & 7;
#pragma unroll
    for (int j = 0; j < 8; ++j) { const int n = (lane >> 3) + 8 * j; const LAS float* s = scr + (8 * c) * 65 + n;
        u32x4 o; o.x = pk2(s[0 * 65], s[1 * 65]); o.y = pk2(s[2 * 65], s[3 * 65]); o.z = pk2(s[4 * 65], s[5 * 65]); o.w = pk2(s[6 * 65], s[7 * 65]);
        *(u32x4*)(WT + (size_t)rm(n0 + n) * ldt + k0 + 8 * c) = o; }
    LDS_WAIT(); asm volatile("" ::: "memory");
}
template <class RowMap>
__device__ __forceinline__ void transpose_item_fp8(const float* W, int ldw, unsigned char* WT, int ldt, int k0, int n0, float sc, RowMap rm, LAS float* scr, int lane) {
    tr_load(W, ldw, k0, n0, nullptr, sc, scr, lane);
    const int c = lane & 3;
#pragma unroll
    for (int j = 0; j < 4; ++j) { const int n = (lane >> 2) + 16 * j; const LAS float* s = scr + (16 * c) * 65 + n;
        u32x4 o; o.x = pk4fp8(s[0 * 65], s[1 * 65], s[2 * 65], s[3 * 65]); o.y = pk4fp8(s[4 * 65], s[5 * 65], s[6 * 65], s[7 * 65]);
        o.z = pk4fp8(s[8 * 65], s[9 * 65], s[10 * 65], s[11 * 65]); o.w = pk4fp8(s[12 * 65], s[13 * 65], s[14 * 65], s[15 * 65]);
        *(u32x4*)(WT + (size_t)rm(n0 + n) * ldt + k0 + 16 * c) = o; }
    LDS_WAIT(); asm volatile("" ::: "memory");
}

__device__ __forceinline__ void p0_weights(Frame& F, const Args& a) {
    LAS float* scr = (LAS float*)(F.lds + F.wave * TR_SCR);
    constexpr int IT_IN = 32 * 288, IT_BR = 16 * 32, IT_OUT = 32 * 32, IT_Q = 8 * 24, IT_KV = 8 * 32;
    constexpr int PER_L = IT_IN + 4 * IT_BR + IT_OUT + IT_Q + IT_KV;
    for (int it = F.gw; it < DEPTH * PER_L; it += F.NGW) {
        const int l = it / PER_L; int r = it % PER_L;
        if (r < IT_IN) { const int kb = r / 288, nb = r % 288;
            if (nb * 64 < NNG) transpose_item(arg_in(a, I_WIN) + (size_t)l * DM * NIN, NIN, WSP(bf16_t, WS_WIN + l * SZ_WIN), DM, kb * 64, nb * 64, nullptr, RmId(), scr, F.lane);
            else transpose_item_fp8(arg_in(a, I_WIN) + (size_t)l * DM * NIN + NNG, NIN, WSP(unsigned char, WS_WIN + l * SZ_WIN) + (size_t)NNG * DM * 2, DM, kb * 64, nb * 64 - NNG, 64.f, RmId(), scr, F.lane);
            continue; } r -= IT_IN;
        if (r < 4 * IT_BR) { const int br = r / IT_BR, q = r % IT_BR, kb = q / 32, nb = q % 32;
            transpose_item(arg_in(a, I_WBR) + ((size_t)l * 4 + br) * 1024 * DM, DM, WSP(bf16_t, WS_WBR + l * SZ_WBR) + (size_t)br * DM * 1024, 1024, kb * 64, nb * 64, nullptr, RmId(), scr, F.lane); continue; } r -= 4 * IT_BR;
        if (r < IT_OUT) { const int kb = r / 32, nb = r % 32;
            transpose_item(arg_in(a, I_WOUT) + (size_t)l * DM * DM, DM, WSP(bf16_t, WS_WOUT + l * SZ_WOUT), DM, kb * 64, nb * 64, nullptr, RmId(), scr, F.lane); continue; } r -= IT_OUT;
        if (r < IT_Q) { const int kb = r / 24, nb = r % 24;
            transpose_item(arg_in(a, I_WQUP) + (size_t)l * 512 * 1536, 1536, WSP(bf16_t, WS_WQ + l * SZ_WQ), 512, kb * 64, nb * 64, arg_in(a, I_QNORM) + l * 512, RmId(), scr, F.lane); continue; } r -= IT_Q;
        { const int kb = r / 32, nb = r % 32;
            transpose_item(arg_in(a, I_WKVUP) + (size_t)l * 512 * 2048, 2048, WSP(bf16_t, WS_WKV + l * SZ_WKV), 512, kb * 64, nb * 64, arg_in(a, I_KVNORM) + l * 512, RmId(), scr, F.lane); }
    }
    for (size_t e = (size_t)F.bid * NTHREADS + F.tid; e < (size_t)DEPTH * 5120 * 512; e += (size_t)F.G * NTHREADS) {
        const int l = (int)(e / (5120 * 512)); const int rem = (int)(e % (5120 * 512)); const int n = rem / 512, kc = rem % 512; const int blk = n >> 10, c = n & 1023;
        float v = 0.f;
        if (blk < 2) { if (kc >= 64 * blk && kc < 64 * blk + 64) v = arg_in(a, I_RWUP)[(((size_t)l * 2 + blk) * 64 + (kc - 64 * blk)) * 1024 + c]; }
        else if (blk < 4) { const int d = blk - 2; if (kc >= 128 + 64 * d && kc < 192 + 64 * d) v = arg_in(a, I_RAUP)[(((size_t)l * 2 + d) * 64 + (kc - 128 - 64 * d)) * 1024 + c]; }
        else { if (kc >= 256 && kc < 416) v = arg_in(a, I_RGUP)[((size_t)l * 160 + (kc - 256)) * 1024 + c]; }
        WSP(bf16_t, WS_WLORA)[e] = (bf16_t)f2bf(v);
    }
}
constexpr int EFFP = 1536;
constexpr size_t SZ_WGU8 = (size_t)NEXP * 2816 * DM, SZ_WD8 = (size_t)NEXP * DM * EFFP;
__device__ __forceinline__ void conv_experts(Frame& F, const Args& a, int l) {
    LAS float* scr = (LAS float*)(F.lds + F.wave * TR_SCR);
    constexpr int IT_G = 32 * 22, IT_D = 22 * 32, PER_E = 2 * IT_G + IT_D;
    unsigned char* wgu = WSP(unsigned char, WS_WE); unsigned char* wd = WSP(unsigned char, WS_WE + SZ_WGU8);
    for (int it = F.gw; it < NEXP * PER_E; it += F.NGW) {
        const int e = it / PER_E; int r = it % PER_E;
        if (r < 2 * IT_G) { const int up = r / IT_G, q = r % IT_G, kb = q / 22, nb = q % 22;
            const float* src = arg_in(a, up ? I_WUP : I_WGATE) + ((size_t)l * NEXP + e) * DM * EFF;
            RmGateUp rm; rm.up = up;
            transpose_item_fp8(src, EFF, wgu + (size_t)e * 2816 * DM, DM, kb * 64, nb * 64, 64.f, rm, scr, F.lane); continue; } r -= 2 * IT_G;
        { const int kb = r / 32, nb = r % 32;
            transpose_item_fp8(arg_in(a, I_WDOWN) + ((size_t)l * NEXP + e) * EFF * DM, DM, wd + (size_t)e * DM * EFFP, EFFP, kb * 64, nb * 64, 64.f, RmId(), scr, F.lane); }
    }
    for (int i = F.bid * NTHREADS + F.tid; i < NEXP * DM * 8; i += F.G * NTHREADS) { const int rowi = i >> 3, q = i & 7; unsigned zz = 0u; asm volatile("" : "+v"(zz));
        *(u32x4*)(wd + (size_t)rowi * EFFP + EFF + q * 16) = (u32x4){zz, zz, zz, zz}; }
}
__device__ __forceinline__ void p0_mod(Frame& F, const Args& a) {
    LAS float* sv = (LAS float*)(F.lds + 69632);
    for (int i = F.tid; i < 3 * DM; i += NTHREADS) { const int v = i / DM, k = i % DM; const float x = v < 2 ? arg_in(a, I_C)[v * DM + k] : arg_in(a, I_CCTX)[k]; sv[i] = siluf_(x); }
    __syncthreads();
    float* mod = (float*)(F.ws + WS_CTL) + CW_MOD;
    LAS float* red = (LAS float*)(F.lds + 69632 + 3 * DM * 4);
    for (int u = F.bid; u < DEPTH * (6 * DM / 128); u += F.G) {
        const int l = u / (6 * DM / 128), nb = u % (6 * DM / 128); const int kg = F.tid >> 7, cl = F.tid & 127, n = nb * 128 + cl;
        const float* w = arg_in(a, I_WADA) + ((size_t)l * DM + kg * 512) * (6 * DM) + n;
        float a0 = 0.f, a1 = 0.f, a2 = 0.f;
#pragma unroll 32
        for (int k = 0; k < 512; ++k) { const float wv = w[(size_t)k * (6 * DM)]; const int kk = kg * 512 + k; a0 += sv[kk] * wv; a1 += sv[DM + kk] * wv; a2 += sv[2 * DM + kk] * wv; }
        __syncthreads();
        red[(kg * 3 + 0) * 128 + cl] = a0; red[(kg * 3 + 1) * 128 + cl] = a1; red[(kg * 3 + 2) * 128 + cl] = a2;
        __syncthreads();
        if (F.tid < 384) { const int v = F.tid >> 7; const float b = arg_in(a, I_BADA)[l * 6 * DM + n];
            mod[(l * 3 + v) * 6 * DM + n] = b + ((red[(0 * 3 + v) * 128 + cl] + red[(1 * 3 + v) * 128 + cl]) + (red[(2 * 3 + v) * 128 + cl] + red[(3 * 3 + v) * 128 + cl])); }
    }
}

__device__ __forceinline__ void row_stats(const f32x4 (&v)[8], float& mean, float& rstd, float eps) {
    float s = 0.f;
#pragma unroll
    for (int j = 0; j < 8; ++j) s += (v[j].x + v[j].y) + (v[j].z + v[j].w);
    mean = wave_sum(s) * (1.f / DM);
    float s2 = 0.f;
#pragma unroll
    for (int j = 0; j < 8; ++j) { const f32x4 d = v[j] - mean; s2 += (d.x * d.x + d.y * d.y) + (d.z * d.z + d.w * d.w); }
    rstd = 1.f / sqrtf(wave_sum(s2) * (1.f / DM) + eps);
}
__device__ __forceinline__ const float* x_src_row(const Args& a, const Frame& F, int layer, int row) {
    if (layer == 0) return row < TC ? arg_in(a, I_CTX) + (size_t)row * DM : arg_in(a, I_X) + (size_t)(row - TC) * DM;
    return (const float*)(F.ws + WS_XS) + (size_t)row * DM;
}
__device__ __forceinline__ void phase_modln(Frame& F, const Args& a, int layer) {
    const float* mod = (const float*)(F.ws + WS_CTL) + CW_MOD + (size_t)layer * 3 * 6 * DM;
    bf16_t* H = WSP(bf16_t, WS_H); unsigned* H8 = WSP(unsigned, WS_H8);
    for (int row = F.gw; row < T; row += F.NGW) {
        const f32x4* xr = (const f32x4*)x_src_row(a, F, layer, row) + F.lane;
        f32x4 v[8];
#pragma unroll
        for (int j = 0; j < 8; ++j) v[j] = xr[64 * j];
        float mean, rstd; row_stats(v, mean, rstd, 1e-6f);
        const float* m = mod + (size_t)row_modidx(row) * 6 * DM;
        u32x2* o = (u32x2*)(H + (size_t)row * DM) + F.lane; unsigned* o8 = H8 + (size_t)row * (DM / 4) + F.lane;
#pragma unroll
        for (int j = 0; j < 8; ++j) { const int c = 4 * (64 * j + F.lane); const f32x4 sh = *(const f32x4*)(m + c), sc = *(const f32x4*)(m + DM + c);
            const f32x4 y = (v[j] - mean) * rstd * (sc + 1.f) + sh; u32x2 w; w.x = pk2(y.x, y.y); w.y = pk2(y.z, y.w); o[64 * j] = w; o8[64 * j] = pk4fp8(y.x, y.y, y.z, y.w); }
    }
}

__device__ __forceinline__ void phase_hdn(Frame& F, const Args& a, int layer) {
    LAS float* zs = (LAS float*)(F.lds + F.wave * 512);
    const float* w1 = arg_in(a, I_HW1) + (size_t)layer * 33 * 64; const float* b1 = arg_in(a, I_HB1) + layer * 64;
    const float* w2 = arg_in(a, I_HW2) + (size_t)layer * 64 * 64; const float* b2 = arg_in(a, I_HB2) + layer * 64;
    const float fr = arg_in(a, I_HFREQ)[layer * 64 + F.lane];
    float* HDN = WSP(float, WS_HDN + layer * SZ_HDN1);
    for (int r = F.gw; r < SEQ + CTX; r += F.NGW) {
        const int n = r < SEQ ? SEQ : CTX, t = r < SEQ ? r : r - SEQ;
        const float wpos = (6.283185307179586f * (float)t) / (float)n;
        if (F.lane < 33) { float z;
            if (F.lane == 0) z = (float)t / (float)(n - 1);
            else { const int b = (F.lane - 1) & 15; const float f = 1e-4f + (float)b * ((15.f - 1e-4f) / 15.f); const float ang = f * wpos; z = F.lane <= 16 ? __cosf(ang) : -__sinf(ang); }
            zs[F.lane] = z; }
        LDS_WAIT(); asm volatile("" ::: "memory");
        float p = b1[F.lane];
#pragma unroll
        for (int i = 0; i < 33; ++i) p += zs[i] * w1[i * 64 + F.lane];
        const float h1 = __sinf(fr * p);
        zs[64 + F.lane] = h1;
        LDS_WAIT(); asm volatile("" ::: "memory");
        float q = b2[F.lane];
#pragma unroll 16
        for (int i = 0; i < 64; ++i) q += zs[64 + i] * w2[i * 64 + F.lane];
        HDN[(size_t)r * 64 + F.lane] = __sinf(fr * q);
        LDS_WAIT(); asm volatile("" ::: "memory");
    }
}
__device__ __forceinline__ float hy_delta(int c) { const float mn = -3.0701134573253943f, mx = -15.350567286626972f; return fabsf(mn + (float)c * ((mx - mn) / 1023.f)); }
__device__ __forceinline__ void phase_filt(Frame& F, const Args& a, int layer) {
    const float* w3 = arg_in(a, I_HW3) + (size_t)layer * 64 * 2048; const float* HDN = WSP(float, WS_HDN + layer * SZ_HDN1);
    LAS float* ws3 = (LAS float*)F.lds;
    bf16_t* FILT = WSP(bf16_t, WS_FILT);
    for (int u = F.bid; u < 32 * 16; u += F.G) {
        const int cb = u / 16, tb = u % 16, col0 = cb * 64, t = tb * 512 + F.tid;
        __syncthreads();
        for (int i = F.tid; i < 4096; i += NTHREADS) { const int j = i >> 6, cc = i & 63; ws3[cc * 64 + j] = w3[(size_t)j * 2048 + col0 + cc]; }
        __syncthreads();
        f32x4 h[16];
#pragma unroll
        for (int i = 0; i < 16; ++i) h[i] = *(const f32x4*)(HDN + (size_t)t * 64 + 4 * i);
        const float tn = (float)t / (float)(SEQ - 1);
        for (int cc = 0; cc < 64; ++cc) {
            float acc = 0.f;
#pragma unroll
            for (int i = 0; i < 16; ++i) { const f32x4 w = *(const LAS f32x4*)(ws3 + cc * 64 + 4 * i); acc += h[i].x * w.x + h[i].y * w.y + h[i].z * w.z + h[i].w * w.w; }
            const int col = col0 + cc, side = col >> 10, c = col & 1023;
            FILT[((size_t)c * 2 + side) * SEQ + t] = (bf16_t)f2bf(acc * __expf(-tn * hy_delta(c)));
        }
    }
    float* FILTC = WSP(float, WS_FILTC);
    for (int e = F.bid * NTHREADS + F.tid; e < CTX * 2048; e += F.G * NTHREADS) {
        const int lag = e >> 11, col = e & 2047, c = col & 1023; const float* hr = HDN + (size_t)(SEQ + lag) * 64; float acc = 0.f;
#pragma unroll 16
        for (int j = 0; j < 64; ++j) acc += hr[j] * w3[(size_t)j * 2048 + col];
        FILTC[e] = acc * __expf(-((float)lag / (float)(CTX - 1)) * hy_delta(c));
    }
}

__device__ __forceinline__ void ld8bf(const bf16_t* p, float (&o)[8]) { const u32x4 w = *(const u32x4*)p; o[0] = bflo(w.x); o[1] = bfhi(w.x); o[2] = bflo(w.y); o[3] = bfhi(w.y); o[4] = bflo(w.z); o[5] = bfhi(w.z); o[6] = bflo(w.w); o[7] = bfhi(w.w); }
__device__ __forceinline__ void up8(const u32x4 w, float (&o)[8]) { o[0] = bflo(w.x); o[1] = bfhi(w.x); o[2] = bflo(w.y); o[3] = bfhi(w.y); o[4] = bflo(w.z); o[5] = bfhi(w.z); o[6] = bflo(w.w); o[7] = bfhi(w.w); }
__device__ __forceinline__ void st8bf(bf16_t* p, const float (&v)[8]) { u32x4 w; w.x = pk2(v[0], v[1]); w.y = pk2(v[2], v[3]); w.z = pk2(v[4], v[5]); w.w = pk2(v[6], v[7]); *(u32x4*)p = w; }
__device__ __forceinline__ void ld8f(const float* p, float (&o)[8]) { const f32x4 a = *(const f32x4*)p, b = *(const f32x4*)(p + 4); o[0] = a.x; o[1] = a.y; o[2] = a.z; o[3] = a.w; o[4] = b.x; o[5] = b.y; o[6] = b.z; o[7] = b.w; }

constexpr int PREP_RUN = 16;
__device__ __forceinline__ void phase_prep(Frame& F, const Args& a, int layer) {
    const bf16_t* P = WSP(bf16_t, WS_P); bf16_t* P2 = WSP(bf16_t, WS_P2);
    float* RS = WSP(float, WS_RS); bf16_t* KPE = WSP(bf16_t, WS_KPE); float* DT = WSP(float, WS_DT);
    bf16_t* KK = WSP(bf16_t, WS_KK); bf16_t* AL_ = WSP(bf16_t, WS_ALORA); float* VC = WSP(float, WS_VC);
    const float* scw = arg_in(a, I_SCONVW) + (size_t)layer * 3 * 1536; const float* scb = arg_in(a, I_SCONVB) + layer * 1536; const float* dtb = arg_in(a, I_SDTB) + layer * 32;
    const float* hcw = arg_in(a, I_HCONVW) + (size_t)layer * 3 * 3072; const float* hcb = arg_in(a, I_HCONVB) + layer * 3072;
    const float* mu = arg_in(a, I_RMU) + (size_t)layer * 2 * 3488; const float* rkk = arg_in(a, I_RKK) + layer * 1024;
    const int lane = F.lane;
    for (int item = F.gw; item < (T / PREP_RUN) * 13; item += F.NGW) {
        const int run = item / 13, ct = item % 13; const int r0 = run * PREP_RUN;
        if (ct == 0) {
#pragma unroll 1
        for (int rr = 0; rr < PREP_RUN; ++rr) { const int row = r0 + rr; const bf16_t* pr = P + (size_t)row * NNG;
            float x[8]; ld8bf(pr + P_CQ + lane * 8, x); float s = 0.f;
#pragma unroll
            for (int i = 0; i < 8; ++i) s += x[i] * x[i];
            s = wave_sum(s); const float rq = 1.f / sqrtf(s * (1.f / 512.f) + 1e-6f);
            ld8bf(pr + P_CKV + lane * 8, x); s = 0.f;
#pragma unroll
            for (int i = 0; i < 8; ++i) s += x[i] * x[i];
            s = wave_sum(s); const float rk = 1.f / sqrtf(s * (1.f / 512.f) + 1e-6f);
            if (lane == 0) { RS[row * 2] = rq; RS[row * 2 + 1] = rk; }
            float kv = bf2f(pr[P_KPE + lane]);
            const float other = swz16(kv);
            if (row >= TC) { const int t = (row - TC) & (SEQ - 1); const int axis = lane >> 5, half = (lane >> 4) & 1, j = lane & 15;
                const float pos = (float)(axis == 0 ? (t >> 6) : (t & 63)); const float inv = __builtin_amdgcn_exp2f(-(float)j * 0.8304820237218406f);
                const float sn = __sinf(pos * inv), cs = __cosf(pos * inv);
                kv = half == 0 ? kv * cs - other * sn : kv * cs + other * sn; }
            KPE[(size_t)row * 64 + lane] = (bf16_t)f2bf(kv);
            if (lane < 32) DT[(size_t)row * 32 + lane] = softplusf_(bf2f(pr[P_DT + lane]) + dtb[lane]); }
        continue; }
        const bool first = row_first(r0), last = row_last(r0 + PREP_RUN - 1);
        if (ct >= 1 && ct <= 3) { const int ch = ct - 1; const int c = ch * 512 + lane * 8; float xm[8], x0[8], xp[8], w0[8], w1[8], w2[8], bb[8];
            ld8f(scw + c, w0); ld8f(scw + 1536 + c, w1); ld8f(scw + 3072 + c, w2); ld8f(scb + c, bb);
            const bf16_t* pc = P + (size_t)r0 * NNG + P_XBC + c;
            u32x4 raw[PREP_RUN + 2];
#pragma unroll
            for (int rr = 0; rr < PREP_RUN + 2; ++rr) { const bool ok = (rr > 0 || !first) && (rr < PREP_RUN + 1 || !last); raw[rr] = ok ? *(const u32x4*)(pc + (ptrdiff_t)(rr - 1) * NNG) : (u32x4){0u, 0u, 0u, 0u}; }
            up8(raw[0], xm); up8(raw[1], x0);
#pragma unroll
            for (int rr = 0; rr < PREP_RUN; ++rr) {
                up8(raw[rr + 2], xp);
                float o[8];
#pragma unroll
                for (int i = 0; i < 8; ++i) { o[i] = siluf_(xm[i] * w0[i] + x0[i] * w1[i] + xp[i] * w2[i] + bb[i]); xm[i] = x0[i]; x0[i] = xp[i]; }
                st8bf(P2 + (size_t)(r0 + rr) * P2W + P2_XBC + c, o); } continue; }
        if (ct >= 4 && ct <= 5) { const int ch = ct - 4; { const int c = ch * 512 + lane * 8; float xm[8], x0[8], xp[8], w0[8], w1[8], w2[8], bb[8];
            ld8f(hcw + c, w0); ld8f(hcw + 3072 + c, w1); ld8f(hcw + 6144 + c, w2); ld8f(hcb + c, bb);
            const bf16_t* pc = P + (size_t)r0 * NNG + P_HY + c;
            u32x4 raw[PREP_RUN + 2];
#pragma unroll
            for (int rr = 0; rr < PREP_RUN + 2; ++rr) { const bool ok = (rr > 0 || !first) && (rr < PREP_RUN + 1 || !last); raw[rr] = ok ? *(const u32x4*)(pc + (ptrdiff_t)(rr - 1) * NNG) : (u32x4){0u, 0u, 0u, 0u}; }
            up8(raw[0], xm); up8(raw[1], x0);
#pragma unroll
            for (int rr = 0; rr < PREP_RUN; ++rr) {
                up8(raw[rr + 2], xp);
                float o[8];
#pragma unroll
                for (int i = 0; i < 8; ++i) { o[i] = xm[i] * w0[i] + x0[i] * w1[i] + xp[i] * w2[i] + bb[i]; xm[i] = x0[i]; x0[i] = xp[i]; }
                st8bf(P2 + (size_t)(r0 + rr) * P2W + P2_X0 + c, o); } }
        if (r0 < TC) {
#pragma unroll 1
                for (int rr = 0; rr < PREP_RUN; ++rr) { const int row = r0 + rr; const bool f1 = row_first(row), l1 = row_last(row); const int c = ch * 512 + lane * 8;
                    const bf16_t* pr = P + (size_t)row * NNG; float o1[8], o2[8];
#pragma unroll
                    for (int part = 1; part < 3; ++part) { float x0[8], xm[8], xp[8], w0[8], w1[8], w2[8], bb[8]; const int cc = part * 1024 + c;
                        ld8bf(pr + P_HY + cc, x0);
                        if (!f1) ld8bf(pr - NNG + P_HY + cc, xm); else { for (int i = 0; i < 8; ++i) xm[i] = 0.f; }
                        if (!l1) ld8bf(pr + NNG + P_HY + cc, xp); else { for (int i = 0; i < 8; ++i) xp[i] = 0.f; }
                        ld8f(hcw + cc, w0); ld8f(hcw + 3072 + cc, w1); ld8f(hcw + 6144 + cc, w2); ld8f(hcb + cc, bb);
#pragma unroll
                        for (int i = 0; i < 8; ++i) { const float r = xm[i] * w0[i] + x0[i] * w1[i] + xp[i] * w2[i] + bb[i]; if (part == 1) o1[i] = r; else o2[i] = r; } }
                    float* vc = VC + (size_t)row * 1024 + c;
                    *(f32x4*)vc = (f32x4){o1[0] * o2[0], o1[1] * o2[1], o1[2] * o2[2], o1[3] * o2[3]};
                    *(f32x4*)(vc + 4) = (f32x4){o1[4] * o2[4], o1[5] * o2[5], o1[6] * o2[6], o1[7] * o2[7]}; } }
        continue; }
        { const int ch = ct - 6; const int c = ch * 512 + lane * 8;
            if (c < 3488) { float um[8], u0[8], up[8], m0[8], m1[8], g8[8];
                ld8f(mu + c, m0); ld8f(mu + 3488 + c, m1);
                if (ch == 2 || ch == 3) ld8f(rkk + (c - 1024), g8);
                const bf16_t* pc = P + (size_t)r0 * NNG + P_RW + c;
                u32x4 raw[PREP_RUN + 2];
#pragma unroll
                for (int rr = 0; rr < PREP_RUN + 2; ++rr) { const bool ok = (rr > 0 || !first) && (rr < PREP_RUN + 1 || !last); raw[rr] = ok ? *(const u32x4*)(pc + (ptrdiff_t)(rr - 1) * NNG) : (u32x4){0u, 0u, 0u, 0u}; }
                up8(raw[0], um); up8(raw[1], u0);
#pragma unroll
                for (int rr = 0; rr < PREP_RUN; ++rr) { const int row = r0 + rr;
                    up8(raw[rr + 2], up);
                    float us[8];
#pragma unroll
                    for (int i = 0; i < 8; ++i) { us[i] = u0[i] + m0[i] * (um[i] - u0[i]) + m1[i] * (up[i] - u0[i]); um[i] = u0[i]; u0[i] = up[i]; }
                    if (ch < 6) st8bf(P2 + (size_t)row * P2W + P2_RKV + c, us);
                    if (ch == 2 || ch == 3) { float kx[8]; float s = 0.f;
#pragma unroll
                        for (int i = 0; i < 8; ++i) { kx[i] = us[i] * g8[i]; s += kx[i] * kx[i]; }
                        s = sum8(s);
                        const float inv = 1.f / fmaxf(sqrtf(s), 1e-12f);
#pragma unroll
                        for (int i = 0; i < 8; ++i) kx[i] *= inv;
                        st8bf(KK + (size_t)row * 1024 + (c - 1024), kx); }
                    if (ch == 6) { const int cl = c - 3072; float o[8];
#pragma unroll
                        for (int i = 0; i < 8; ++i) o[i] = cl < 128 ? tanhf_(us[i]) : cl < 256 ? us[i] : sigmoidf_(us[i]);
                        st8bf(AL_ + (size_t)row * 512 + cl, o); } } }
            else if (ch == 6) { const int cl = c - 3072;
                for (int rr = 0; rr < PREP_RUN; ++rr) { float zz = 0.f; asm volatile("" : "+v"(zz)); float o[8] = {zz, zz, zz, zz, zz, zz, zz, zz}; st8bf(AL_ + (size_t)(r0 + rr) * 512 + cl, o); } } }
    }
    float* VT = WSP(float, WS_VT);
    LAS float* tl = (LAS float*)F.lds;
    for (int u = F.bid; u < (TL / 64) * 4; u += F.G) {
        const int tb = u >> 2, cb = u & 3; const int row0 = TC + tb * 64; const int c8 = (F.tid & 31) * 8, c = cb * 256 + c8, tq = F.tid >> 5;
        float w1[3][8], w2[3][8], b1[8], b2[8];
#pragma unroll
        for (int k = 0; k < 3; ++k) { ld8f(hcw + k * 3072 + 1024 + c, w1[k]); ld8f(hcw + k * 3072 + 2048 + c, w2[k]); }
        ld8f(hcb + 1024 + c, b1); ld8f(hcb + 2048 + c, b2);
        __syncthreads();
#pragma unroll 1
        for (int i = 0; i < 4; ++i) { const int tl_ = tq * 4 + i, row = row0 + tl_; const bf16_t* pr = P + (size_t)row * NNG + P_HY;
            const bool first = row_first(row), last = row_last(row);
            float a1[8], a2[8], x[8];
            ld8bf(pr + 1024 + c, x);
#pragma unroll
            for (int j = 0; j < 8; ++j) a1[j] = x[j] * w1[1][j] + b1[j];
            ld8bf(pr + 2048 + c, x);
#pragma unroll
            for (int j = 0; j < 8; ++j) a2[j] = x[j] * w2[1][j] + b2[j];
            if (!first) { ld8bf(pr - NNG + 1024 + c, x);
#pragma unroll
                for (int j = 0; j < 8; ++j) a1[j] += x[j] * w1[0][j];
                ld8bf(pr - NNG + 2048 + c, x);
#pragma unroll
                for (int j = 0; j < 8; ++j) a2[j] += x[j] * w2[0][j]; }
            if (!last) { ld8bf(pr + NNG + 1024 + c, x);
#pragma unroll
                for (int j = 0; j < 8; ++j) a1[j] += x[j] * w1[2][j];
                ld8bf(pr + NNG + 2048 + c, x);
#pragma unroll
                for (int j = 0; j < 8; ++j) a2[j] += x[j] * w2[2][j]; }
#pragma unroll
            for (int j = 0; j < 8; ++j) tl[(c8 + j) * 65 + tl_] = a1[j] * a2[j]; }
        __syncthreads();
        const int b = (row0 - TC) >> 13, t0 = (row0 - TC) & (SEQ - 1);
        for (int p_ = 0; p_ < 8; ++p_) { const int cl = p_ * 32 + (F.tid >> 4), q = F.tid & 15;
            const f32x4 o = {tl[cl * 65 + 4 * q], tl[cl * 65 + 4 * q + 1], tl[cl * 65 + 4 * q + 2], tl[cl * 65 + 4 * q + 3]};
            *(f32x4*)(VT + ((size_t)(cb * 256 + cl) * 2 + b) * SEQ + t0 + 4 * q) = o; }
    }
}

using pg8::Unit;
#define EPI_LOOP_BEGIN const int row0 = u.pm * 256 + wr * 64 + fr; \
    _Pragma("unroll") for (int ai = 0; ai < 2; ++ai) _Pragma("unroll") for (int m = 0; m < 4; ++m) { const int row = row0 + ai * 128 + m * 16; \
    _Pragma("unroll") for (int bj = 0; bj < 2; ++bj) { const int cl = bj * 128 + wc * 32 + 8 * fq; const f32x4 v0 = acc[ai][bj][m][0], v1 = acc[ai][bj][m][1];
#define EPI_LOOP_END } __builtin_amdgcn_sched_barrier(0); }
struct EpiBf16 {
    static constexpr bool PERM = true;
    bf16_t* O; int ldc; const float* rscale; int rs_stride; int act; float cscale;
    __device__ __forceinline__ void operator()(const f32x4 (&acc)[2][2][4][2], const Unit& u, int wr, int wc, int fr, int fq) const {
        EPI_LOOP_BEGIN
            const float s = rscale ? rscale[(size_t)row * rs_stride] : cscale;
            float x[8] = {v0.x * s, v0.y * s, v0.z * s, v0.w * s, v1.x * s, v1.y * s, v1.z * s, v1.w * s};
            if (act == 1) {
#pragma unroll
                for (int i = 0; i < 8; ++i) x[i] = sigmoidf_(x[i]); }
            u32x4 w; w.x = cvt_pk_bf16(x[0], x[1]); w.y = cvt_pk_bf16(x[2], x[3]); w.z = cvt_pk_bf16(x[4], x[5]); w.w = cvt_pk_bf16(x[6], x[7]);
            *(u32x4*)(O + (size_t)row * ldc + u.pn * 256 + cl) = w;
        EPI_LOOP_END
    }
};
struct EpiLora {
    static constexpr bool PERM = true;
    bf16_t* EW; bf16_t* ICLR; bf16_t* GG; const float* w0; const float* a0;
    __device__ __forceinline__ void operator()(const f32x4 (&acc)[2][2][4][2], const Unit& u, int wr, int wc, int fr, int fq) const {
        const int blk = u.pn >> 2, cb = (u.pn & 3) * 256;
        const float* bias = blk < 2 ? w0 + blk * 1024 : a0 + (blk & 1) * 1024;
        bf16_t* dbase = blk < 2 ? EW + (size_t)blk * T * 1024 : blk < 4 ? ICLR + (size_t)(blk - 2) * T * 1024 : GG;
        const float scale = blk < 2 ? 0.6065306597126334f : 1.f; const bool sig = blk < 4;
        EPI_LOOP_BEGIN
            const int c = cb + cl; float x[8] = {v0.x, v0.y, v0.z, v0.w, v1.x, v1.y, v1.z, v1.w};
            if (sig) { const f32x4 b0 = *(const f32x4*)(bias + c), b1 = *(const f32x4*)(bias + c + 4); const float bb[8] = {b0.x, b0.y, b0.z, b0.w, b1.x, b1.y, b1.z, b1.w};
#pragma unroll
                for (int i = 0; i < 8; ++i) x[i] = scale * sigmoidf_(bb[i] + x[i]); }
            u32x4 w; w.x = cvt_pk_bf16(x[0], x[1]); w.y = cvt_pk_bf16(x[2], x[3]); w.z = cvt_pk_bf16(x[4], x[5]); w.w = cvt_pk_bf16(x[6], x[7]);
            *(u32x4*)(dbase + (size_t)row * 1024 + c) = w;
        EPI_LOOP_END
    }
};
struct EpiMerge {
    static constexpr bool PERM = true;
    const bf16_t* gates; float* MF; bf16_t* MB;
    __device__ __forceinline__ void operator()(const f32x4 (&acc)[2][2][4][2], const Unit& uu, int wr, int wc, int fr, int fq) const {
        const int br = uu.pn >> 3; Unit u; u.pm = uu.pm - br * 66; u.pn = uu.pn & 7;
        EPI_LOOP_BEGIN
            const int col = u.pn * 256 + cl; float g[8]; ld8bf(gates + (size_t)row * NGATE + br * DM + col, g);
#pragma unroll
            for (int i = 0; i < 8; ++i) g[i] = sigmoidf_(g[i]);
            float x[8] = {v0.x * g[0], v0.y * g[1], v0.z * g[2], v0.w * g[3], v1.x * g[4], v1.y * g[5], v1.z * g[6], v1.w * g[7]};
            bf16_t* mb = MB + (size_t)row * DM + col;
            if (br > 0) { float pp[8]; ld8bf(mb, pp);
#pragma unroll
                for (int i = 0; i < 8; ++i) x[i] += pp[i]; }
            { u32x4 w; w.x = cvt_pk_bf16(x[0], x[1]); w.y = cvt_pk_bf16(x[2], x[3]); w.z = cvt_pk_bf16(x[4], x[5]); w.w = cvt_pk_bf16(x[6], x[7]); *(u32x4*)mb = w; }
        EPI_LOOP_END
    }
};
struct OrderMerge {
    pg8::StaticOrder so;
    __device__ void init(int G, int c, int nM, int pm0) { so.init(nM, 8, G, c, pm0); }
    __device__ bool next(int i, Unit& u) const { Unit t; if (!so.next(i >> 2, t)) return false; const int br = i & 3; u.pm = br * 66 + t.pm; u.pn = br * 8 + t.pn; return true; }
};
struct EpiF32 {
    static constexpr bool PERM = true;
    float* O; int ldc;
    __device__ __forceinline__ void operator()(const f32x4 (&acc)[2][2][4][2], const Unit& u, int wr, int wc, int fr, int fq) const {
        EPI_LOOP_BEGIN
            float* o = O + (size_t)row * ldc + u.pn * 256 + cl; *(f32x4*)o = v0; *(f32x4*)(o + 4) = v1;
        EPI_LOOP_END
    }
};
__device__ __forceinline__ int moe_panel(int e, int pi) { return pi < 8 ? (((pi >> 2) * NEXP + e) * 4 + (pi & 3)) : 128 + e; }
struct OrderMoe {
    int npn, G, c, npan;
    __device__ void init(int npn_, int G_, int c_, int npan_) { npn = npn_; G = G_; c = c_; npan = npan_; }
    __device__ bool next(int i, Unit& u) const { const int L = i * G + c; const int per = npan * npn; if (L >= NEXP * per) return false;
        const int e = L / per, r = L % per, j = r / npan, pi = r % npan; u.pm = moe_panel(e, pi); u.pn = e * npn + j; return true; }
};
struct EpiSwiglu {
    static constexpr bool PERM = true;
    unsigned char* HID;
    __device__ __forceinline__ void operator()(const f32x4 (&acc)[2][2][4][2], const Unit& u, int wr, int wc, int fr, int fq) const {
        const int j = u.pn % 11; const int row0 = u.pm * 256 + wr * 64 + fr; const float sc = 1.f / 64.f;
#pragma unroll
        for (int ai = 0; ai < 2; ++ai)
#pragma unroll
            for (int m = 0; m < 4; ++m) { const int row = row0 + ai * 128 + m * 16;
                const f32x4 g0 = acc[ai][0][m][0] * sc, g1 = acc[ai][0][m][1] * sc, u0 = acc[ai][1][m][0] * sc, u1 = acc[ai][1][m][1] * sc;
                u32x2 w; w.x = pk4fp8(siluf_(g0.x) * u0.x, siluf_(g0.y) * u0.y, siluf_(g0.z) * u0.z, siluf_(g0.w) * u0.w);
                w.y = pk4fp8(siluf_(g1.x) * u1.x, siluf_(g1.y) * u1.y, siluf_(g1.z) * u1.z, siluf_(g1.w) * u1.w);
                *(u32x2*)(HID + (size_t)row * EFFP + j * 128 + wc * 32 + 8 * fq) = w; __builtin_amdgcn_sched_barrier(0); }
    }
};
struct EpiDown {
    static constexpr bool PERM = true;
    bf16_t* YE; const float* pgate;
    __device__ __forceinline__ void operator()(const f32x4 (&acc)[2][2][4][2], const Unit& uu, int wr, int wc, int fr, int fq) const {
        Unit u; u.pm = uu.pm; u.pn = uu.pn & 7;
        EPI_LOOP_BEGIN
            const float s = pgate[row] * (1.f / 64.f);
            u32x4 w; w.x = cvt_pk_bf16(v0.x * s, v0.y * s); w.y = cvt_pk_bf16(v0.z * s, v0.w * s); w.z = cvt_pk_bf16(v1.x * s, v1.y * s); w.w = cvt_pk_bf16(v1.z * s, v1.w * s);
            *(u32x4*)(YE + (size_t)row * DM + u.pn * 256 + cl) = w;
        EPI_LOOP_END
    }
};

namespace att {
using s16x4 = __attribute__((ext_vector_type(4))) short;
using f32x16 = __attribute__((ext_vector_type(16))) float;
constexpr int NW = 8, QBLK = 32, KVBLK = 64, LDQ = 1536, LDKV = 2048, LDO = 1024;
constexpr float SCALE = 0.07216878364870322f;
constexpr float THR = 8.f;
#ifndef ATT_SDEPTH
#define ATT_SDEPTH 1
#endif
constexpr int SDEPTH = ATT_SDEPTH;
constexpr int SHM_V = KVBLK * 128 * 2, SHM_K = KVBLK * 128 * 2, SHM_KP = KVBLK * 64 * 2;
constexpr int OFF_V = 0, OFF_K = 2 * SHM_V, OFF_KP = OFF_K + 2 * SHM_K, OFF_WS = OFF_KP + 2 * SHM_KP, OFF_QP = OFF_WS + NW * 64 * 4, SHM_ATTN = OFF_QP + 256 * 256;
static_assert(SHM_ATTN <= 150 * 1024, "attention LDS");
#define KSWZ(row, colB) ((row) * 256 + ((colB) ^ (((row) & 7) << 4)))
#define KPSWZ(row, colB) ((row) * 128 + ((colB) ^ (((row) & 7) << 4)))
#define SBAR() __builtin_amdgcn_sched_barrier(0)
__device__ __forceinline__ int crow(int r, int hi) { return (r & 3) + 8 * (r >> 2) + 4 * hi; }
__device__ __forceinline__ void partialSM(f32x16& p0, f32x16& p1, float& m_reg, float& mn, float& alpha) {
  constexpr float C = SCALE * 1.4426950408889634f;
  float pmax = p0[0]; for (int r = 1; r < 16; ++r) pmax = fmaxf(pmax, p0[r]); for (int r = 0; r < 16; ++r) pmax = fmaxf(pmax, p1[r]);
  { auto rr = __builtin_amdgcn_permlane32_swap(__float_as_uint(pmax), __float_as_uint(pmax), false, false);
    pmax = fmaxf(__uint_as_float(rr[0]), __uint_as_float(rr[1])); }
  if (__builtin_expect(__all(pmax - m_reg <= THR / SCALE), 1)) { mn = m_reg; alpha = 1.f; }
  else { mn = fmaxf(m_reg, pmax); alpha = __builtin_amdgcn_exp2f((m_reg - mn) * C); m_reg = mn; }
  float mnC = -mn * C;
  for (int r = 0; r < 16; ++r) p0[r] = fmaf(p0[r], C, mnC); for (int r = 0; r < 16; ++r) p1[r] = fmaf(p1[r], C, mnC);
  for (int r = 0; r < 16; ++r) p0[r] = __builtin_amdgcn_exp2f(p0[r]);
}
__device__ __forceinline__ void finishSM(f32x16& p0, f32x16& p1, float alpha, float& l_reg, bf16x8& pa0, bf16x8& pa1, bf16x8& pa2, bf16x8& pa3) {
  for (int r = 0; r < 16; ++r) p1[r] = __builtin_amdgcn_exp2f(p1[r]);
  float ps = 0; for (int r = 0; r < 16; ++r) ps += p0[r]; for (int r = 0; r < 16; ++r) ps += p1[r];
  { auto rr = __builtin_amdgcn_permlane32_swap(__float_as_uint(ps), __float_as_uint(ps), false, false);
    ps = __uint_as_float(rr[0]) + __uint_as_float(rr[1]); }
  l_reg = l_reg * alpha + ps;
#define PK4(P, BASE, OUT) do { unsigned a0 = cvt_pk_bf16(P[BASE + 0], P[BASE + 1]), a1 = cvt_pk_bf16(P[BASE + 2], P[BASE + 3]);   \
    unsigned b0 = cvt_pk_bf16(P[BASE + 4], P[BASE + 5]), b1 = cvt_pk_bf16(P[BASE + 6], P[BASE + 7]);                              \
    auto r0 = __builtin_amdgcn_permlane32_swap(a0, b0, false, false); auto r1 = __builtin_amdgcn_permlane32_swap(a1, b1, false, false); \
    u32x4 w = {r0[0], r1[0], r0[1], r1[1]}; OUT = *reinterpret_cast<bf16x8*>(&w); } while (0)
  PK4(p0, 0, pa0); PK4(p0, 8, pa1); PK4(p1, 0, pa2); PK4(p1, 8, pa3);
#undef PK4
}
__device__ __forceinline__ void qkt(f32x16& p0, f32x16& p1, const char* Ks, const char* Kp, const bf16x8* qr, const char* Qp, int qrow, int r32, int hi) {
  p0 = f32x16{}; p1 = f32x16{};
#pragma unroll
  for (int d0 = 0; d0 < 8; ++d0) { int cb = (d0 * 16 + hi * 8) * 2;
    bf16x8 b0 = *reinterpret_cast<const bf16x8*>(Ks + KSWZ(r32, cb));
    bf16x8 b1 = *reinterpret_cast<const bf16x8*>(Ks + KSWZ(32 + r32, cb));
    bf16x8 q; if (d0 < 4) q = qr[d0]; else q = *reinterpret_cast<const bf16x8*>(Qp + KSWZ(qrow, ((d0 - 4) * 16 + hi * 8) * 2));
    p0 = __builtin_amdgcn_mfma_f32_32x32x16_bf16(b0, q, p0, 0, 0, 0);
    p1 = __builtin_amdgcn_mfma_f32_32x32x16_bf16(b1, q, p1, 0, 0, 0); }
#pragma unroll
  for (int d0 = 0; d0 < 4; ++d0) { int cb = (d0 * 16 + hi * 8) * 2;
    bf16x8 b0 = *reinterpret_cast<const bf16x8*>(Kp + KPSWZ(r32, cb));
    bf16x8 b1 = *reinterpret_cast<const bf16x8*>(Kp + KPSWZ(32 + r32, cb));
    const bf16x8 qp = *reinterpret_cast<const bf16x8*>(Qp + KSWZ(qrow, 128 + cb));
    p0 = __builtin_amdgcn_mfma_f32_32x32x16_bf16(b0, qp, p0, 0, 0, 0);
    p1 = __builtin_amdgcn_mfma_f32_32x32x16_bf16(b1, qp, p1, 0, 0, 0); }
}
__device__ __forceinline__ int v_st(int k, int c) { const int kk = (k & ~0xC) | ((k & 4) << 1) | ((k & 8) >> 1); return ((kk >> 3) * 4 + (c >> 5)) * 512 + ((kk & 7) * 32 + (c & 31)) * 2; }
__device__ __forceinline__ int v_rd_base(int lane) { return ((lane & 3) << 3) | (((lane >> 2) & 3) << 6) | (((lane >> 4) & 1) << 5) | (((lane >> 5) & 1) << 8); }
constexpr int v_rd_off(int d0, int ks, int half) { return d0 * 512 + ks * 4096 + half * 2048; }
template <int OFF> __device__ __forceinline__ s16x4 tr_read(int vb) {
  s16x4 r; asm volatile("ds_read_b64_tr_b16 %0, %1 offset:%2" : "=&v"(r) : "v"(vb), "i"(OFF) : "memory"); return r;
}
template <int D0> __device__ __forceinline__ void pv_one(f32x16& od, int vb, bf16x8 pa0, bf16x8 pa1, bf16x8 pa2, bf16x8 pa3) {
  const s16x4 l0 = tr_read<v_rd_off(D0, 0, 0)>(vb), h0 = tr_read<v_rd_off(D0, 0, 1)>(vb), l1 = tr_read<v_rd_off(D0, 1, 0)>(vb), h1 = tr_read<v_rd_off(D0, 1, 1)>(vb);
  const s16x4 l2 = tr_read<v_rd_off(D0, 2, 0)>(vb), h2 = tr_read<v_rd_off(D0, 2, 1)>(vb), l3 = tr_read<v_rd_off(D0, 3, 0)>(vb), h3 = tr_read<v_rd_off(D0, 3, 1)>(vb);
  asm volatile("s_waitcnt lgkmcnt(0)" ::: "memory"); SBAR();
#define PK(L, H) (bf16x8){L[0], L[1], L[2], L[3], H[0], H[1], H[2], H[3]}
  od = __builtin_amdgcn_mfma_f32_32x32x16_bf16(pa0, PK(l0, h0), od, 0, 0, 0);
  od = __builtin_amdgcn_mfma_f32_32x32x16_bf16(pa1, PK(l1, h1), od, 0, 0, 0);
  od = __builtin_amdgcn_mfma_f32_32x32x16_bf16(pa2, PK(l2, h2), od, 0, 0, 0);
  od = __builtin_amdgcn_mfma_f32_32x32x16_bf16(pa3, PK(l3, h3), od, 0, 0, 0);
#undef PK
}
__device__ __forceinline__ void pv_d0(f32x16* o, int vb, bf16x8 pa0, bf16x8 pa1, bf16x8 pa2, bf16x8 pa3) {
  pv_one<0>(o[0], vb, pa0, pa1, pa2, pa3); pv_one<1>(o[1], vb, pa0, pa1, pa2, pa3); pv_one<2>(o[2], vb, pa0, pa1, pa2, pa3); pv_one<3>(o[3], vb, pa0, pa1, pa2, pa3);
}
__device__ __forceinline__ void attn_unit(const bf16_t* __restrict__ Qb, const bf16_t* __restrict__ KVh, const bf16_t* __restrict__ KPE, bf16_t* __restrict__ Ob,
                                          int ka0, int kb0, int NT, char* lds, int tid_in, int tpos0) {
  const unsigned tid_u = (unsigned)tid_in; __builtin_assume(tid_u < 512u);
  const int tid = (int)tid_u, wid = tid >> 6, lane = tid & 63, r32 = lane & 31, hi = lane >> 5;
  char* V_lds = lds + OFF_V; char* K_lds = lds + OFF_K; char* P_lds = lds + OFF_KP;
  float* ws = (float*)(lds + OFF_WS) + wid * 64; float* li_l = ws; float* al_l = ws + 32;
  float m_reg = -1e30f, l_reg = 0; f32x16 o[4] = {}; bf16x8 qr[4];
  char* Q_lds = lds + OFF_QP; const int qrow = wid * QBLK + r32;
  const bf16_t* Qw = Qb + (long)(wid * QBLK + r32) * LDQ + hi * 8;
#pragma unroll
  for (int d0 = 0; d0 < 4; ++d0) qr[d0] = *reinterpret_cast<const bf16x8*>(Qw + d0 * 16);
#pragma unroll
  for (int d0 = 0; d0 < 4; ++d0) *reinterpret_cast<bf16x8*>(Q_lds + KSWZ(qrow, (d0 * 16 + hi * 8) * 2)) = *reinterpret_cast<const bf16x8*>(Qw + 64 + d0 * 16);
#pragma unroll
  for (int ax = 0; ax < 2; ++ax) { u32x4 w1 = *reinterpret_cast<const u32x4*>(Qw + 128 + ax * 32), w2 = *reinterpret_cast<const u32x4*>(Qw + 128 + ax * 32 + 16);
    if (tpos0 >= 0) { const int t = tpos0 + qrow; const float pos = (float)(ax == 0 ? (t >> 6) : (t & 63));
      unsigned* p1 = (unsigned*)&w1; unsigned* p2 = (unsigned*)&w2;
#pragma unroll
      for (int i = 0; i < 4; ++i) { float a0 = bflo(p1[i]), a1 = bfhi(p1[i]), b0 = bflo(p2[i]), b1 = bfhi(p2[i]);
        const float ang0 = pos * __builtin_amdgcn_exp2f(-(float)(hi * 8 + 2 * i) * 0.8304820237218406f), ang1 = pos * __builtin_amdgcn_exp2f(-(float)(hi * 8 + 2 * i + 1) * 0.8304820237218406f);
        const float c0 = __cosf(ang0), s0 = __sinf(ang0), c1 = __cosf(ang1), s1 = __sinf(ang1);
        p1[i] = pk2(a0 * c0 - b0 * s0, a1 * c1 - b1 * s1); p2[i] = pk2(b0 * c0 + a0 * s0, b1 * c1 + a1 * s1); } }
    *reinterpret_cast<u32x4*>(Q_lds + KSWZ(qrow, 128 + (ax * 32 + hi * 8) * 2)) = w1; *reinterpret_cast<u32x4*>(Q_lds + KSWZ(qrow, 128 + (ax * 32 + 16 + hi * 8) * 2)) = w2; }
  const int sr = tid >> 4, sc = (tid & 15) * 8, vst0 = v_st(sr, sc), vst1 = v_st(32 + sr, sc);
  const int pr = tid >> 3, pc = (tid & 7) * 8;
  const int vb0 = (int)(uintptr_t)V_lds + v_rd_base(lane);
  struct { bf16x8 vs0, vs1, ks0, ks1, kp; } sr_[SDEPTH];
#define KROW(j) ((j) < 4 ? ka0 + 64 * (j) : kb0 + 64 * ((j) - 4))
  const __amdgpu_buffer_rsrc_t rsKV = __builtin_amdgcn_make_buffer_rsrc((void*)KVh, 0, 0xFFFFFFFFu, 0x00020000);
  const __amdgpu_buffer_rsrc_t rsKP = __builtin_amdgcn_make_buffer_rsrc((void*)KPE, 0, 0xFFFFFFFFu, 0x00020000);
  const int vo_k = (sr * LDKV + sc) * 2, vo_p = (pr * 64 + pc) * 2;
#define SLOAD(i, jt) do { const int k0_ = KROW(jt); const int so0 = k0_ * (LDKV * 2), so1 = so0 + 32 * LDKV * 2; \
    sr_[i].vs0 = __builtin_bit_cast(bf16x8, __builtin_amdgcn_raw_buffer_load_b128(rsKV, vo_k + 256, so0, 0)); sr_[i].vs1 = __builtin_bit_cast(bf16x8, __builtin_amdgcn_raw_buffer_load_b128(rsKV, vo_k + 256, so1, 0)); \
    sr_[i].ks0 = __builtin_bit_cast(bf16x8, __builtin_amdgcn_raw_buffer_load_b128(rsKV, vo_k, so0, 0)); sr_[i].ks1 = __builtin_bit_cast(bf16x8, __builtin_amdgcn_raw_buffer_load_b128(rsKV, vo_k, so1, 0)); \
    sr_[i].kp = __builtin_bit_cast(bf16x8, __builtin_amdgcn_raw_buffer_load_b128(rsKP, vo_p, k0_ * 128, 0)); } while (0)
#define SWRITE(b, i) do { *(bf16x8*)(V_lds + (b) * SHM_V + vst0) = sr_[i].vs0;          \
    *(bf16x8*)(V_lds + (b) * SHM_V + vst1) = sr_[i].vs1; int kc = sc * 2;               \
    *(bf16x8*)(K_lds + (b) * SHM_K + KSWZ(sr, kc)) = sr_[i].ks0;                       \
    *(bf16x8*)(K_lds + (b) * SHM_K + KSWZ(32 + sr, kc)) = sr_[i].ks1;                  \
    *(bf16x8*)(P_lds + (b) * SHM_KP + KPSWZ(pr, pc * 2)) = sr_[i].kp; } while (0)
#define SWAIT() do { if constexpr (SDEPTH == 2) asm volatile("s_waitcnt vmcnt(5)" ::: "memory"); else asm volatile("s_waitcnt vmcnt(0)" ::: "memory"); } while (0)
#define RESC(a) do { if (__any((a) < 1.f)) { if (hi == 0) al_l[r32] = (a); asm volatile("s_waitcnt lgkmcnt(0)" ::: "memory"); \
    for (int d = 0; d < 4; ++d) for (int r = 0; r < 16; ++r) o[d][r] *= al_l[crow(r, hi)]; } } while (0)
  f32x16 pA0, pA1, pB0, pB1; float mnA, mnB, alA, alB; bf16x8 pa0, pa1, pa2, pa3;
  constexpr int SE = 0, SO = SDEPTH - 1;
  SLOAD(SE, 0); asm volatile("s_waitcnt vmcnt(0)" ::: "memory"); SWRITE(0, SE); __syncthreads();
  qkt(pA0, pA1, K_lds, P_lds, qr, Q_lds, qrow, r32, hi); partialSM(pA0, pA1, m_reg, mnA, alA);
  SLOAD(SO, 1); if constexpr (SDEPTH == 2) { if (2 < NT) SLOAD(SE, 2); }
  SWAIT(); SWRITE(1, SO); __syncthreads();
  for (int j = 1; j + 1 < NT; j += 2) {
    SBAR(); qkt(pB0, pB1, K_lds + SHM_K, P_lds + SHM_KP, qr, Q_lds, qrow, r32, hi);
    finishSM(pA0, pA1, alA, l_reg, pa0, pa1, pa2, pa3); SBAR();
    SLOAD(SO, j + SDEPTH); SBAR();
    pv_d0(o, vb0, pa0, pa1, pa2, pa3); partialSM(pB0, pB1, m_reg, mnB, alB);
    __syncthreads(); SWAIT(); SWRITE(0, SE);
    RESC(alB); __syncthreads();
    SBAR(); qkt(pA0, pA1, K_lds, P_lds, qr, Q_lds, qrow, r32, hi);
    finishSM(pB0, pB1, alB, l_reg, pa0, pa1, pa2, pa3); SBAR();
    if (SDEPTH == 1 || j + 3 < NT) SLOAD(SE, j + 1 + SDEPTH); SBAR();
    pv_d0(o, vb0 + (int)SHM_V, pa0, pa1, pa2, pa3); partialSM(pA0, pA1, m_reg, mnA, alA);
    __syncthreads(); SWAIT(); SWRITE(1, SO);
    RESC(alA); __syncthreads();
  }
  SBAR(); qkt(pB0, pB1, K_lds + SHM_K, P_lds + SHM_KP, qr, Q_lds, qrow, r32, hi);
  finishSM(pA0, pA1, alA, l_reg, pa0, pa1, pa2, pa3); SBAR();
  pv_d0(o, vb0, pa0, pa1, pa2, pa3); partialSM(pB0, pB1, m_reg, mnB, alB);
  __syncthreads(); RESC(alB);
  finishSM(pB0, pB1, alB, l_reg, pa0, pa1, pa2, pa3); SBAR();
  pv_d0(o, vb0 + (int)SHM_V, pa0, pa1, pa2, pa3);
  if (hi == 0) li_l[r32] = l_reg; asm volatile("s_waitcnt lgkmcnt(0)" ::: "memory");
  float rli[16];
#pragma unroll
  for (int r = 0; r < 16; ++r) rli[r] = __builtin_amdgcn_rcpf(li_l[crow(r, hi)]);
  bf16_t* Ow = Ob + (long)(wid * QBLK) * LDO;
#pragma unroll
  for (int r = 0; r < 16; ++r) { int orow = crow(r, hi);
    for (int d0 = 0; d0 < 4; ++d0) Ow[(long)orow * LDO + d0 * 32 + r32] = (bf16_t)f2bf(o[d0][r] * rli[r]); }
  __syncthreads();
#undef KROW
#undef SLOAD
#undef SWRITE
#undef SWAIT
#undef RESC
}
}

__device__ __forceinline__ void phase_attn(Frame& F, bool lat_only) {
    const bf16_t* Q = WSP(bf16_t, WS_Q); const bf16_t* KV = WSP(bf16_t, WS_KV); const bf16_t* KPE = WSP(bf16_t, WS_KPE); bf16_t* YA = WSP(bf16_t, WS_Y);
    const int NU = NBATCH * NH_MLA * 32 + (lat_only ? 0 : NBATCH * NH_MLA);
    for (int u = F.bid; u < NU; u += F.G) {
        int b, h, row0, NT, tpos0;
        if (u < NBATCH * NH_MLA * 32) { const int bh = u >> 5, qb = u & 31; b = bh >> 3; h = bh & 7; row0 = TC + b * SEQ + qb * 256; NT = 4 + SEQ / 64; tpos0 = qb * 256; }
        else { const int bh = u - NBATCH * NH_MLA * 32; b = bh >> 3; h = bh & 7; row0 = b * CTX; NT = 4; tpos0 = -1; }
        att::attn_unit(Q + (size_t)row0 * 1536 + h * 192, KV + h * 256, KPE, YA + (size_t)row0 * 1024 + h * 128, b * CTX, TC + b * SEQ, NT, (char*)F.lds, F.tid, tpos0);
    }
}
__device__ __forceinline__ void phase_qrope(Frame& F) {
    bf16_t* Q = WSP(bf16_t, WS_Q);
    for (int row = TC + F.gw; row < T; row += F.NGW) {
        const int t = (row - TC) & (SEQ - 1); const int p = F.lane & 31, axis = p >> 4, j = p & 15, hs = F.lane >> 5;
        const float pos = (float)(axis == 0 ? (t >> 6) : (t & 63)); const float inv = __builtin_amdgcn_exp2f(-(float)j * 0.8304820237218406f);
        const float sn = __sinf(pos * inv), cs = __cosf(pos * inv);
#pragma unroll
        for (int hh = 0; hh < 4; ++hh) { const int h = hh * 2 + hs; bf16_t* q = Q + (size_t)row * 1536 + h * 192 + 128 + axis * 32 + j;
            const float x1 = bf2f(q[0]), x2 = bf2f(q[16]);
            q[0] = (bf16_t)f2bf(x1 * cs - x2 * sn); q[16] = (bf16_t)f2bf(x2 * cs + x1 * sn); }
    }
}

#define MFMA16(a, b, c) __builtin_amdgcn_mfma_f32_16x16x32_bf16((a), (b), (c), 0, 0, 0)
constexpr int XS_LD = 264, BC_LD = 136;
__device__ __forceinline__ float bperm(float v, int srclane) { return __builtin_bit_cast(float, __builtin_amdgcn_ds_bpermute(srclane << 2, __builtin_bit_cast(int, v))); }
__device__ __forceinline__ float wave_incl_scan(float v, int lane) {
#pragma unroll
    for (int o = 1; o < 64; o <<= 1) { const float t = bperm(v, lane - o); if (lane >= o) v += t; }
    return v;
}
template <int NCOLS>
__device__ __forceinline__ void stage_tile(LAS bf16_t* dst, int ld, const bf16_t* src, int tid) {
    constexpr int cpr = NCOLS >> 3, NIT = 128 * cpr / NTHREADS;
    u32x4 v[NIT];
#pragma unroll
    for (int k = 0; k < NIT; ++k) { const int i = tid + k * NTHREADS; const int r = i / cpr, c8 = (i % cpr) * 8; v[k] = *(const u32x4*)(src + (size_t)r * P2W + c8); }
#pragma unroll
    for (int k = 0; k < NIT; ++k) { const int i = tid + k * NTHREADS; const int r = i / cpr, c8 = (i % cpr) * 8; *(LAS u32x4*)(dst + r * ld + c8) = v[k]; }
}
__device__ __forceinline__ void phase_mamba_states(Frame& F, const Args& a, int layer) {
    const bf16_t* P2 = WSP(bf16_t, WS_P2); const float* DT = WSP(float, WS_DT); bf16_t* MST = WSP(bf16_t, WS_MST); float* MCS = WSP(float, WS_MCS);
    LAS bf16_t* XSl = (LAS bf16_t*)F.lds; LAS bf16_t* Bl = (LAS bf16_t*)(F.lds + 67584); LAS float* wt = (LAS float*)(F.lds + 102400) + F.wave * 128;
    const int lane = F.lane, row = lane & 15, quad = lane >> 4;
    for (int u = F.bid; u < NCHUNK * 4; u += F.G) {
        const int chunk = u >> 2, g = (u >> 1) & 1, half = u & 1, row0 = chunk * 128;
        __syncthreads();
        stage_tile<256>(XSl, XS_LD, P2 + (size_t)row0 * P2W + P2_XBC + (g * 8 + half * 4) * 64, F.tid);
        stage_tile<128>(Bl, BC_LD, P2 + (size_t)row0 * P2W + P2_XBC + 1024 + g * 128, F.tid);
        const int hl = F.wave >> 1, d = F.wave & 1, h = g * 8 + half * 4 + hl;
        const float aa = -__expf(arg_in(a, I_SALOG)[(layer * 2 + d) * 16 + h]);
        { const float dt0 = DT[(size_t)(row0 + lane) * 32 + d * 16 + h], dt1 = DT[(size_t)(row0 + 64 + lane) * 32 + d * 16 + h];
          const float da0 = dt0 * aa, da1 = dt1 * aa;
          float c0 = wave_incl_scan(da0, lane); const float tot0 = bperm(c0, 63); float c1 = wave_incl_scan(da1, lane) + tot0; const float tot = bperm(c1, 63);
          if (d == 0) { wt[lane] = dt0 * __expf(tot - c0); wt[64 + lane] = dt1 * __expf(tot - c1); }
          else { wt[lane] = dt0 * __expf(c0 - da0); wt[64 + lane] = dt1 * __expf(c1 - da1); }
          if (lane == 0) MCS[(d * NCHUNK + chunk) * 16 + h] = tot; }
        __syncthreads();
        bf16_t* out = MST + ((size_t)(d * NCHUNK + chunk) * 16 + h) * 8192;
#pragma unroll 1
        for (int nh = 0; nh < 2; ++nh) {
            f32x4 acc[4][4];
#pragma unroll
            for (int i = 0; i < 4; ++i)
#pragma unroll
                for (int j = 0; j < 4; ++j) acc[i][j] = (f32x4){0.f, 0.f, 0.f, 0.f};
#pragma unroll 1
            for (int k0 = 0; k0 < 128; k0 += 32) {
                const int sb = k0 + quad * 8;
                float w8[8];
#pragma unroll
                for (int j = 0; j < 8; ++j) w8[j] = wt[sb + j];
                bf16x8 bf[4];
#pragma unroll
                for (int nt = 0; nt < 4; ++nt) {
#pragma unroll
                    for (int j = 0; j < 8; ++j) bf[nt][j] = (short)Bl[(sb + j) * BC_LD + (nh * 4 + nt) * 16 + row]; }
#pragma unroll
                for (int pt = 0; pt < 4; ++pt) { bf16x8 af;
#pragma unroll
                    for (int j = 0; j < 8; ++j) af[j] = (short)f2bf(w8[j] * bf2f(XSl[(sb + j) * XS_LD + hl * 64 + pt * 16 + row]));
#pragma unroll
                    for (int nt = 0; nt < 4; ++nt) acc[pt][nt] = MFMA16(af, bf[nt], acc[pt][nt]); }
            }
#pragma unroll
            for (int pt = 0; pt < 4; ++pt)
#pragma unroll
                for (int nt = 0; nt < 4; ++nt)
#pragma unroll
                    for (int jj = 0; jj < 4; ++jj) out[(pt * 16 + quad * 4 + jj) * 128 + (nh * 4 + nt) * 16 + row] = (bf16_t)f2bf(acc[pt][nt][jj]);
        }
    }
}
__device__ __forceinline__ void phase_mamba_scan(Frame& F) {
    bf16_t* MST = WSP(bf16_t, WS_MST); const float* MCS = WSP(float, WS_MCS);
    for (int idx = F.bid * NTHREADS + F.tid; idx < 2 * 2 * 16 * 8192; idx += F.G * NTHREADS) {
        const int e = idx & 8191, h = (idx >> 13) & 15, b = (idx >> 17) & 1, d = idx >> 18;
        float state = 0.f;
#pragma unroll 6
        for (int i = 0; i < 66; ++i) {
            int chunk; if (i < 2) chunk = 2 * b + (d == 0 ? i : 1 - i); else chunk = 4 + 64 * b + (d == 0 ? i - 2 : 65 - i);
            bf16_t* p = MST + ((size_t)(d * NCHUNK + chunk) * 16 + h) * 8192 + e;
            const float cs = bf2f(*p); const float dec = __expf(MCS[(d * NCHUNK + chunk) * 16 + h]);
            *p = (bf16_t)f2bf(state);
            state = state * dec + cs;
        }
    }
}
__device__ __forceinline__ void phase_mamba_out(Frame& F, const Args& a, int layer) {
    const bf16_t* P = WSP(bf16_t, WS_P); const bf16_t* P2 = WSP(bf16_t, WS_P2); const float* DT = WSP(float, WS_DT); const bf16_t* MST = WSP(bf16_t, WS_MST);
    bf16_t* YB = WSP(bf16_t, WS_Y) + (size_t)1 * T * 1024;
    LAS bf16_t* Cl = (LAS bf16_t*)F.lds; LAS bf16_t* Bl = (LAS bf16_t*)(F.lds + 34816); LAS bf16_t* XSl = (LAS bf16_t*)(F.lds + 69632);
    LAS float* tab = (LAS float*)(F.lds + 137216);
    for (int u = F.bid; u < NCHUNK * 4; u += F.G) {
        const int chunk = u >> 2, g = (u >> 1) & 1, half = u & 1, row0 = chunk * 128;
        __syncthreads();
        { const int tid_ = F.wave * 64 + (lane_asm() & 63);
          stage_tile<256>(XSl, XS_LD, P2 + (size_t)row0 * P2W + P2_XBC + (g * 8 + half * 4) * 64, tid_);
          stage_tile<128>(Bl, BC_LD, P2 + (size_t)row0 * P2W + P2_XBC + 1024 + g * 128, tid_);
          stage_tile<128>(Cl, BC_LD, P2 + (size_t)row0 * P2W + P2_XBC + 1280 + g * 128, tid_); }
        const int lane = lane_asm() & 63, row = lane & 15, quad = lane >> 4;
        float tot1 = 0.f;
        { const int hl = F.wave >> 1, d = F.wave & 1, h = g * 8 + half * 4 + hl;
          const float aa = -__expf(arg_in(a, I_SALOG)[(layer * 2 + d) * 16 + h]);
          const float dt0 = DT[(size_t)(row0 + lane) * 32 + d * 16 + h], dt1 = DT[(size_t)(row0 + 64 + lane) * 32 + d * 16 + h];
          const float da0 = dt0 * aa, da1 = dt1 * aa;
          float c0 = wave_incl_scan(da0, lane); const float t0 = bperm(c0, 63); float c1 = wave_incl_scan(da1, lane) + t0;
          LAS float* tb = tab + hl * 512;
          if (d == 0) { tb[lane] = c0; tb[64 + lane] = c1; tb[256 + lane] = __logf(dt0) - c0; tb[320 + lane] = __logf(dt1) - c1; }
          else { tb[128 + lane] = c0 - da0; tb[192 + lane] = c1 - da1; tb[384 + lane] = (c0 - da0) + __logf(dt0); tb[448 + lane] = (c1 - da1) + __logf(dt1); if (lane == 63) tab[2048 + hl] = c1; } }
        __syncthreads();
        { f32x4 cb[8];
#pragma unroll
          for (int st = 0; st < 8; ++st) cb[st] = (f32x4){0.f, 0.f, 0.f, 0.f};
#pragma unroll
          for (int k0 = 0; k0 < 128; k0 += 32) { const bf16x8 af = *(const LAS bf16x8*)(Cl + (F.wave * 16 + row) * BC_LD + k0 + quad * 8);
#pragma unroll
              for (int st = 0; st < 8; ++st) { const bf16x8 bfr = *(const LAS bf16x8*)(Bl + (st * 16 + row) * BC_LD + k0 + quad * 8); cb[st] = MFMA16(af, bfr, cb[st]); } }
          __syncthreads();
#pragma unroll
          for (int st = 0; st < 8; ++st)
#pragma unroll
              for (int jj = 0; jj < 4; ++jj) Bl[(F.wave * 16 + quad * 4 + jj) * BC_LD + st * 16 + row] = (bf16_t)f2bf(cb[st][jj]); }
        __syncthreads();
        const int hl = F.wave >> 1, th = F.wave & 1, h = g * 8 + half * 4 + hl;
        const LAS float* tb = tab + hl * 512; tot1 = tab[2048 + hl];
        f32x4 acc[4][4];
#pragma unroll
        for (int i = 0; i < 4; ++i)
#pragma unroll
            for (int j = 0; j < 4; ++j) acc[i][j] = (f32x4){0.f, 0.f, 0.f, 0.f};
#pragma unroll 1
        for (int k0 = 0; k0 < 128; k0 += 32) {
            const int sb = k0 + quad * 8;
            float u0s[8], u1s[8];
#pragma unroll
            for (int j = 0; j < 8; ++j) { u0s[j] = tb[256 + sb + j]; u1s[j] = tb[384 + sb + j]; }
            bf16x8 bx[4];
#pragma unroll
            for (int pt = 0; pt < 4; ++pt) {
#pragma unroll
                for (int j = 0; j < 8; ++j) bx[pt][j] = (short)XSl[(sb + j) * XS_LD + hl * 64 + pt * 16 + row]; }
#pragma unroll
            for (int tt = 0; tt < 4; ++tt) { const int t = th * 64 + tt * 16 + row; const float c0t = tb[t], e1t = tb[128 + t];
                float cbv[8]; { const u32x4 w = *(const LAS u32x4*)(Bl + t * BC_LD + sb); cbv[0] = bflo(w.x); cbv[1] = bfhi(w.x); cbv[2] = bflo(w.y); cbv[3] = bfhi(w.y); cbv[4] = bflo(w.z); cbv[5] = bfhi(w.z); cbv[6] = bflo(w.w); cbv[7] = bfhi(w.w); }
                bf16x8 af;
#pragma unroll
                for (int j = 0; j < 8; ++j) { const int s = sb + j;
                    const float f0 = s <= t ? __expf(c0t + u0s[j]) : 0.f;
                    const float f1 = s >= t ? __expf(u1s[j] - e1t) : 0.f;
                    af[j] = (short)f2bf(cbv[j] * (f0 + f1)); }
#pragma unroll
                for (int pt = 0; pt < 4; ++pt) acc[tt][pt] = MFMA16(af, bx[pt], acc[tt][pt]); }
        }
#pragma unroll 1
        for (int d = 0; d < 2; ++d) {
            const bf16_t* S = MST + ((size_t)(d * NCHUNK + chunk) * 16 + h) * 8192;
#pragma unroll 1
            for (int k0 = 0; k0 < 128; k0 += 32) {
                bf16x8 bs[4];
#pragma unroll
                for (int pt = 0; pt < 4; ++pt) bs[pt] = *(const bf16x8*)(S + (pt * 16 + row) * 128 + k0 + quad * 8);
#pragma unroll
                for (int tt = 0; tt < 4; ++tt) { const int t = th * 64 + tt * 16 + row;
                    const float sc = d == 0 ? __expf(tb[t]) : __expf(tot1 - tb[128 + t]);
                    const u32x4 cw = *(const LAS u32x4*)(Cl + t * BC_LD + k0 + quad * 8);
                    u32x4 aw; aw.x = cvt_pk_bf16(bflo(cw.x) * sc, bfhi(cw.x) * sc); aw.y = cvt_pk_bf16(bflo(cw.y) * sc, bfhi(cw.y) * sc);
                    aw.z = cvt_pk_bf16(bflo(cw.z) * sc, bfhi(cw.z) * sc); aw.w = cvt_pk_bf16(bflo(cw.w) * sc, bfhi(cw.w) * sc);
                    const bf16x8 af = __builtin_bit_cast(bf16x8, aw);
#pragma unroll
                    for (int pt = 0; pt < 4; ++pt) acc[tt][pt] = MFMA16(af, bs[pt], acc[tt][pt]); } }
        }
        const float Dh = arg_in(a, I_SD)[layer * 16 + h];
#pragma unroll
        for (int tt = 0; tt < 4; ++tt)
#pragma unroll
            for (int jj = 0; jj < 4; ++jj) { const int t = th * 64 + tt * 16 + quad * 4 + jj; const size_t r = (size_t)(row0 + t);
#pragma unroll
                for (int pt = 0; pt < 4; ++pt) { const int p = pt * 16 + row;
                    const float xs = bf2f(XSl[t * XS_LD + hl * 64 + p]); const float z = bf2f(P[r * NNG + P_Z + h * 64 + p]);
                    YB[r * 1024 + h * 64 + p] = (bf16_t)f2bf((acc[tt][pt][jj] + xs * Dh) * siluf_(z)); } }
    }
}
__device__ __forceinline__ void phase_mamba_norm(Frame& F, const Args& a, int layer) {
    bf16_t* YB = WSP(bf16_t, WS_Y) + (size_t)1 * T * 1024; const float* nw = arg_in(a, I_SNORM) + layer * 1024;
    for (int row = F.gw; row < T; row += F.NGW) {
        bf16_t* p = YB + (size_t)row * 1024 + F.lane * 16; float x[16]; { float t0[8], t1[8]; ld8bf(p, t0); ld8bf(p + 8, t1);
#pragma unroll
            for (int i = 0; i < 8; ++i) { x[i] = t0[i]; x[8 + i] = t1[i]; } }
        float s = 0.f;
#pragma unroll
        for (int i = 0; i < 16; ++i) s += x[i] * x[i];
        s = sum32(s);
        const float r = 1.f / sqrtf(s * (1.f / 512.f) + 1e-5f);
        float o0[8], o1[8];
#pragma unroll
        for (int i = 0; i < 8; ++i) { o0[i] = x[i] * r * nw[F.lane * 16 + i]; o1[i] = x[8 + i] * r * nw[F.lane * 16 + 8 + i]; }
        st8bf(p, o0); st8bf(p + 8, o1);
    }
}

__device__ __forceinline__ float dpp_f(float x, const int ctrl_sel) {
    const int xi = __builtin_bit_cast(int, x); int r;
    if (ctrl_sel == 0) r = __builtin_amdgcn_update_dpp(0, xi, 0xB1, 0xF, 0xF, false);
    else if (ctrl_sel == 1) r = __builtin_amdgcn_update_dpp(0, xi, 0x4E, 0xF, 0xF, false);
    else r = __builtin_amdgcn_update_dpp(0, xi, 0x141, 0xF, 0xF, false);
    return __builtin_bit_cast(float, r);
}
__device__ __forceinline__ float red8(float x) { x += dpp_f(x, 0); x += dpp_f(x, 1); x += dpp_f(x, 2); return x; }
__device__ __forceinline__ int rw_row(int pos, int b, int d) { return pos < CTX ? b * CTX + (d == 0 ? pos : CTX - 1 - pos) : TC + b * SEQ + (d == 0 ? pos - CTX : SEQ - 1 - (pos - CTX)); }
constexpr int RW_STEP_F = 336, RW_CH = 32, RW_CHF = RW_STEP_F * RW_CH;
struct RwOps { f32x4 w, k, b, a, r; float v; };
__device__ __forceinline__ void rw_load(RwOps& o, const LAS float* sp, const LAS float* vp) {
    o.w = *(const LAS f32x4*)(sp); o.k = *(const LAS f32x4*)(sp + 64); o.b = *(const LAS f32x4*)(sp + 128); o.a = *(const LAS f32x4*)(sp + 192); o.r = *(const LAS f32x4*)(sp + 256); o.v = *vp;
}
__device__ __forceinline__ void rw_step(f32x4& s, const RwOps& o, LAS float* yp) {
    const f32x4 tt = s * o.w + o.k * o.v;
    const f32x4 pa = s * o.a; float sa = (pa.x + pa.y) + (pa.z + pa.w); sa = sum16(sa);
    s = tt + o.b * sa;
    const f32x4 pr = s * o.r; *yp = (pr.x + pr.y) + (pr.z + pr.w);
}
struct RwRaw { unsigned ew[4], ic[4], kk[4], rr[4], kr[4], vv[4]; };
__device__ __forceinline__ void phase_rwkv_scan(Frame& F, const Args& a, int layer) {
    const bf16_t* P2 = WSP(bf16_t, WS_P2); const bf16_t* EW = WSP(bf16_t, WS_EW); const bf16_t* ICLR = WSP(bf16_t, WS_ICLR); const bf16_t* KK = WSP(bf16_t, WS_KK);
    bf16_t* YRW = WSP(bf16_t, WS_YRW);
    LAS float* ring = (LAS float*)F.lds; LAS float* ybuf = (LAS float*)(F.lds + 2 * RW_CHF * 4);
    const int lane = F.lane;
    for (int u = F.bid; u < 256; u += F.G) {
        const int chain = u >> 2, rq = u & 3, d = chain >> 5, b = (chain >> 4) & 1, h = chain & 15;
        constexpr int NCH = (CTX + SEQ) / RW_CH;
        const int lw = F.wave - 4;
        const int tsel = lane >> 5, kp = lane & 31;
        const f32x2 ka2 = *(const f32x2*)(arg_in(a, I_RKA) + layer * 1024 + h * 64 + 2 * kp);
        auto issue = [&](RwRaw& x, int cidx) {
            const int row0 = rw_row(cidx * RW_CH, b, d), st = d == 0 ? 1 : -1;
            const int tk0 = 2 * lw + tsel;
            const unsigned* ewp = (const unsigned*)(EW + (size_t)d * T * 1024); const unsigned* icp = (const unsigned*)(ICLR + (size_t)d * T * 1024);
            const unsigned* kkp = (const unsigned*)KK; const unsigned* p2p = (const unsigned*)P2;
#pragma unroll
            for (int j = 0; j < 4; ++j) { const int row = row0 + st * (8 * j + tk0); const int o = (row * 1024 + h * 64) / 2 + kp, q = (row * P2W + P2_RKV + h * 64) / 2 + kp;
                x.ew[j] = ewp[o]; x.ic[j] = icp[o]; x.kk[j] = kkp[o]; x.rr[j] = p2p[q]; x.kr[j] = p2p[q + 512]; x.vv[j] = p2p[q + 1024 + rq * 8 - kp + (kp & 7)]; } };
        auto commit = [&](const RwRaw& x, int cidx) {
            LAS float* dst = ring + (cidx & 1) * RW_CHF;
#pragma unroll
            for (int j = 0; j < 4; ++j) { LAS float* sbase = dst + (8 * j + 2 * lw + tsel) * RW_STEP_F; LAS f32x2* s2 = (LAS f32x2*)sbase + kp;
                const f32x2 ew = {bflo(x.ew[j]), bfhi(x.ew[j])}, ic = {bflo(x.ic[j]), bfhi(x.ic[j])}, kkv = {bflo(x.kk[j]), bfhi(x.kk[j])}, rr = {bflo(x.rr[j]), bfhi(x.rr[j])}, kr = {bflo(x.kr[j]), bfhi(x.kr[j])};
                s2[0] = (f32x2){__expf(-ew.x), __expf(-ew.y)}; s2[32] = kr * ((ic - 1.f) * ka2 + 1.f); s2[64] = kkv * ic; s2[96] = -kkv; s2[128] = rr;
                if (kp < 8) s2[160] = (f32x2){bflo(x.vv[j]), bfhi(x.vv[j])}; } };
        auto flush_chunk = [&](int cidx) {
            const LAS float* yb = ybuf + (cidx & 1) * (RW_CH * 256);
            const int row0 = rw_row(cidx * RW_CH, b, d), st = d == 0 ? 1 : -1;
#pragma unroll
            for (int q = 0; q < 2; ++q) { const int i = (F.tid - 256) + 256 * q, tok = i >> 4, rr = i & 15; const LAS f32x4* pp = (const LAS f32x4*)(yb + i * 16);
                const f32x4 p0 = pp[0], p1 = pp[1], p2 = pp[2], p3 = pp[3];
                const float y = ((p0.x + p0.y) + (p0.z + p0.w)) + ((p1.x + p1.y) + (p1.z + p1.w)) + (((p2.x + p2.y) + (p2.z + p2.w)) + ((p3.x + p3.y) + (p3.z + p3.w)));
                YRW[((size_t)d * T + row0 + st * tok) * 1024 + h * 64 + rq * 16 + rr] = (bf16_t)f2bf(y); } };
        auto compute = [&](f32x4& s, int c) {
            const int rloc = lane >> 4, kq = lane & 15, r16 = F.wave * 4 + rloc;
            const LAS float* base = ring + (c & 1) * RW_CHF + kq * 4; const LAS float* vb = ring + (c & 1) * RW_CHF + 320 + r16; LAS float* yb = ybuf + (c & 1) * (RW_CH * 256) + r16 * 16 + kq;
            RwOps o0, o1, o2, o3;
            rw_load(o0, base, vb); rw_load(o1, base + RW_STEP_F, vb + RW_STEP_F); rw_load(o2, base + 2 * RW_STEP_F, vb + 2 * RW_STEP_F);
#pragma unroll
            for (int t = 0; t < RW_CH; t += 4) {
                if (t + 3 < RW_CH) rw_load(o3, base + (t + 3) * RW_STEP_F, vb + (t + 3) * RW_STEP_F);
                rw_step(s, o0, yb + t * 256);
                if (t + 4 < RW_CH) rw_load(o0, base + (t + 4) * RW_STEP_F, vb + (t + 4) * RW_STEP_F);
                rw_step(s, o1, yb + (t + 1) * 256);
                if (t + 5 < RW_CH) rw_load(o1, base + (t + 5) * RW_STEP_F, vb + (t + 5) * RW_STEP_F);
                rw_step(s, o2, yb + (t + 2) * 256);
                if (t + 6 < RW_CH) rw_load(o2, base + (t + 6) * RW_STEP_F, vb + (t + 6) * RW_STEP_F);
                rw_step(s, o3, yb + (t + 3) * 256);
            } };
        __syncthreads();
        f32x4 s = {0.f, 0.f, 0.f, 0.f};
        if (F.wave >= 4) {
            RwRaw ra, rb;
            issue(ra, 0); commit(ra, 0); issue(ra, 1);
            __syncthreads();
            for (int c = 0; c < NCH; c += 2) {
                if (c + 2 < NCH) issue(rb, c + 2);
                if (c > 0) flush_chunk(c - 1);
                commit(ra, c + 1);
                __syncthreads();
                if (c + 3 < NCH) issue(ra, c + 3);
                flush_chunk(c);
                if (c + 2 < NCH) commit(rb, c + 2);
                __syncthreads();
            }
            flush_chunk(NCH - 1);
        } else {
            __syncthreads();
            for (int c = 0; c < NCH; c += 2) { compute(s, c); __syncthreads(); compute(s, c + 1); __syncthreads(); }
        }
    }
}
__device__ __forceinline__ void phase_rwkv_out(Frame& F, const Args& a, int layer) {
    const bf16_t* P2 = WSP(bf16_t, WS_P2); const bf16_t* ICLR = WSP(bf16_t, WS_ICLR); const bf16_t* YRW = WSP(bf16_t, WS_YRW); const bf16_t* GG = WSP(bf16_t, WS_GG);
    bf16_t* YD = WSP(bf16_t, WS_Y) + (size_t)3 * T * 1024;
    const float* lng = arg_in(a, I_RLNG) + layer * 1024; const float* lnb = arg_in(a, I_RLNB) + layer * 1024; const float* rk = arg_in(a, I_RRK) + layer * 1024; const float* kav = arg_in(a, I_RKA) + layer * 1024;
    for (int row = F.gw; row < T; row += F.NGW) {
        const int c = F.lane * 16; const size_t o = (size_t)row * 1024 + c;
        float y[16], r[16], k[16], v[16], i0[16], i1[16], g[16];
#define LD16(dst, ptr) do { float t0_[8], t1_[8]; ld8bf((ptr), t0_); ld8bf((ptr) + 8, t1_); _Pragma("unroll") for (int i_ = 0; i_ < 8; ++i_) { dst[i_] = t0_[i_]; dst[8 + i_] = t1_[i_]; } } while (0)
        LD16(y, YRW + o); LD16(r, YRW + (size_t)T * 1024 + o);
#pragma unroll
        for (int i = 0; i < 16; ++i) y[i] += r[i];
        const bf16_t* p2 = P2 + (size_t)row * P2W + P2_RKV + c;
        LD16(r, p2); LD16(k, p2 + 1024); LD16(v, p2 + 2048); LD16(i0, ICLR + o); LD16(i1, ICLR + (size_t)T * 1024 + o); LD16(g, GG + o);
#undef LD16
        float s = 0.f, bsum = 0.f;
#pragma unroll
        for (int i = 0; i < 16; ++i) { s += y[i]; const float ka = kav[c + i]; bsum += r[i] * k[i] * rk[c + i] * ((1.f + (i0[i] - 1.f) * ka) + (1.f + (i1[i] - 1.f) * ka)); }
        s = sum4(s); bsum = sum4(bsum);
        const float mu = s * (1.f / 64.f); float q = 0.f;
#pragma unroll
        for (int i = 0; i < 16; ++i) { const float dd = y[i] - mu; q += dd * dd; }
        q = sum4(q);
        const float rstd = 1.f / sqrtf(q * (1.f / 64.f) + 64e-5f);
        float o0[8], o1[8];
#pragma unroll
        for (int i = 0; i < 8; ++i) { o0[i] = ((y[i] - mu) * rstd * lng[c + i] + lnb[c + i] + bsum * v[i]) * g[i];
            o1[i] = ((y[8 + i] - mu) * rstd * lng[c + 8 + i] + lnb[c + 8 + i] + bsum * v[8 + i]) * g[8 + i]; }
        st8bf(YD + o, o0); st8bf(YD + o + 8, o1);
    }
}

constexpr int FFT_N = 16384;
__device__ __forceinline__ int fswz(int i) { return i ^ (((i >> 5) & 3) << 2) ^ (((i >> 6) & 1) << 4); }
__device__ __forceinline__ f32x2 cmul(f32x2 a, f32x2 b) { return (f32x2){a.x * b.x - a.y * b.y, a.x * b.y + a.y * b.x}; }
template <bool INV>
__device__ __forceinline__ void fft_passes(LAS f32x2* X, int tid) {
#pragma unroll 1
    for (int st = 0; st < 7; ++st) {
        const int lq = INV ? 2 * st : 12 - 2 * st;
        const int q = 1 << lq;
        __syncthreads();
#pragma unroll 2
        for (int mm = 0; mm < 8; ++mm) { const int uu = tid + 512 * mm; const int k = uu & (q - 1), blk = uu >> lq; const int i0 = (blk << (lq + 2)) + k;
            const int p0 = fswz(i0), p1 = fswz(i0 + q), p2 = fswz(i0 + 2 * q), p3 = fswz(i0 + 3 * q);
            f32x2 a0 = X[p0], a1 = X[p1], a2 = X[p2], a3 = X[p3];
            const float fr = (float)k / (float)(4 * q);
            const float cs = __builtin_amdgcn_cosf(fr), sn = __builtin_amdgcn_sinf(fr);
            const f32x2 w1 = INV ? (f32x2){cs, sn} : (f32x2){cs, -sn}; const f32x2 w2 = cmul(w1, w1), w3 = cmul(w2, w1);
            if (!INV) {
                const f32x2 t0 = a0 + a2, t1 = a0 - a2, t2 = a1 + a3, t3 = a1 - a3;
                const f32x2 b0 = t0 + t2, b2 = t0 - t2, b1 = (f32x2){t1.x + t3.y, t1.y - t3.x}, b3 = (f32x2){t1.x - t3.y, t1.y + t3.x};
                X[p0] = b0; X[p1] = cmul(b1, w1); X[p2] = cmul(b2, w2); X[p3] = cmul(b3, w3);
            } else {
                a1 = cmul(a1, w1); a2 = cmul(a2, w2); a3 = cmul(a3, w3);
                const f32x2 u0 = a0 + a2, u1 = a0 - a2, u2 = a1 + a3, u3 = a1 - a3;
                X[p0] = u0 + u2; X[p2] = u0 - u2; X[p1] = (f32x2){u1.x - u3.y, u1.y + u3.x}; X[p3] = (f32x2){u1.x + u3.y, u1.y - u3.x};
            } }
    }
    __syncthreads();
}
__device__ __forceinline__ void phase_hyena_fft(Frame& F, const Args& a, int layer, bool dry = false) {
    const bf16_t* FILT = WSP(bf16_t, WS_FILT); float* VT = WSP(float, WS_VT); const float* hyd = arg_in(a, I_HD) + layer * 1024;
    LAS f32x2* X = (LAS f32x2*)F.lds;
    for (int c = F.bid; c < 1024; c += F.G) {
        __syncthreads();
        const int tid = F.wave * 64 + (lane_asm() & 63), i0 = tid * 16;
        { const bf16_t* hf = FILT + (size_t)c * 2 * SEQ; const bf16_t* hb = hf + SEQ;
          float f[16], g[16]; ld8bf(hf + i0, *(float(*)[8])&f[0]); ld8bf(hf + i0 + 8, *(float(*)[8])&f[8]);
          ld8bf(hb + (SEQ - 16 - i0), *(float(*)[8])&g[0]); ld8bf(hb + (SEQ - 8 - i0), *(float(*)[8])&g[8]);
#pragma unroll
          for (int j = 0; j < 16; ++j) X[fswz(i0 + j)] = (f32x2){f[j], 0.f};
#pragma unroll
          for (int j = 0; j < 16; ++j) { const int pos = SEQ + i0 + 1 + j; if (pos < FFT_N) X[fswz(pos)] = (f32x2){g[15 - j], 0.f}; }
          if (tid == 0) { float zz = 0.f; asm volatile("" : "+v"(zz)); X[fswz(SEQ)] = (f32x2){zz, zz}; } }
        fft_passes<false>(X, F.tid);
        f32x2 Kh[32];
#pragma unroll
        for (int j = 0; j < 32; ++j) Kh[j] = X[fswz(F.tid + 512 * j)];
        __syncthreads();
        float* v0 = VT + (size_t)c * 2 * SEQ; float* v1 = v0 + SEQ;
        { f32x4 a0[4], a1[4];
#pragma unroll
          for (int q = 0; q < 4; ++q) { a0[q] = *(const f32x4*)(v0 + i0 + 4 * q); a1[q] = *(const f32x4*)(v1 + i0 + 4 * q); }
#pragma unroll
          for (int q = 0; q < 4; ++q) { X[fswz(i0 + 4 * q)] = (f32x2){a0[q].x, a1[q].x}; X[fswz(i0 + 4 * q + 1)] = (f32x2){a0[q].y, a1[q].y}; X[fswz(i0 + 4 * q + 2)] = (f32x2){a0[q].z, a1[q].z}; X[fswz(i0 + 4 * q + 3)] = (f32x2){a0[q].w, a1[q].w}; }
          { float zz = 0.f; asm volatile("" : "+v"(zz));
#pragma unroll
          for (int j = 0; j < 16; ++j) X[fswz(SEQ + i0 + j)] = (f32x2){zz, zz}; } }
        fft_passes<false>(X, F.tid);
#pragma unroll
        for (int j = 0; j < 32; ++j) { const int p = fswz(F.tid + 512 * j); X[p] = cmul(X[p], Kh[j]); }
        fft_passes<true>(X, F.tid);
        const float dc = hyd[c];
        { f32x4 a0[4], a1[4];
#pragma unroll
          for (int q = 0; q < 4; ++q) { a0[q] = *(const f32x4*)(v0 + i0 + 4 * q); a1[q] = *(const f32x4*)(v1 + i0 + 4 * q); }
#pragma unroll
          for (int q = 0; q < 4; ++q) { const f32x2 r0 = X[fswz(i0 + 4 * q)], r1 = X[fswz(i0 + 4 * q + 1)], r2 = X[fswz(i0 + 4 * q + 2)], r3 = X[fswz(i0 + 4 * q + 3)];
              const f32x4 o0 = (f32x4){r0.x, r1.x, r2.x, r3.x} * (1.f / FFT_N) + a0[q] * dc, o1 = (f32x4){r0.y, r1.y, r2.y, r3.y} * (1.f / FFT_N) + a1[q] * dc;
              if (!dry) { *(f32x4*)(v0 + i0 + 4 * q) = o0; *(f32x4*)(v1 + i0 + 4 * q) = o1; } } }
    }
}
__device__ __forceinline__ void phase_hyena_out(Frame& F, const Args& a, int layer) {
    const float* VT = WSP(float, WS_VT); const bf16_t* P2 = WSP(bf16_t, WS_P2); bf16_t* YC = WSP(bf16_t, WS_Y) + (size_t)2 * T * 1024;
    LAS float* tl = (LAS float*)F.lds;
    for (int u = F.bid; u < (TL / 64) * 4; u += F.G) {
        const int tb = u >> 2, cb = u & 3; const int row0 = TC + tb * 64; const int b = (row0 - TC) >> 13, t0 = (row0 - TC) & (SEQ - 1);
        __syncthreads();
        for (int p = 0; p < 8; ++p) { const int cl = p * 32 + (F.tid >> 4), q = F.tid & 15;
            const f32x4 v = *(const f32x4*)(VT + ((size_t)(cb * 256 + cl) * 2 + b) * SEQ + t0 + 4 * q);
            tl[cl * 65 + 4 * q] = v.x; tl[cl * 65 + 4 * q + 1] = v.y; tl[cl * 65 + 4 * q + 2] = v.z; tl[cl * 65 + 4 * q + 3] = v.w; }
        __syncthreads();
        const int cl = F.tid & 255, th = F.tid >> 8;
        for (int i = 0; i < 32; ++i) { const int tl_ = th * 32 + i; const size_t row = (size_t)(row0 + tl_);
            const float x0 = bf2f(P2[row * P2W + P2_X0 + cb * 256 + cl]);
            YC[row * 1024 + cb * 256 + cl] = (bf16_t)f2bf(tl[cl * 65 + tl_] * x0); }
    }
    const float* VC = WSP(float, WS_VC); const float* FC = WSP(float, WS_FILTC); const float* hyd = arg_in(a, I_HD) + layer * 1024;
    for (int it = F.gw; it < 2 * 16 * 16; it += F.NGW) {
        const int b = it >> 8, cbk = (it >> 4) & 15, tb = it & 15; const int c = cbk * 64 + F.lane, t0 = tb * 16;
        const float* vb = VC + (size_t)b * CTX * 1024 + c; const float* fc = FC + c;
        float acc[16];
#pragma unroll
        for (int i = 0; i < 16; ++i) acc[i] = 0.f;
#pragma unroll 1
        for (int sb = 0; sb < 16; ++sb) { const int s0 = sb * 16, dl = t0 - s0;
            float f[31], v[16];
#pragma unroll
            for (int j = 0; j < 31; ++j) { const int lag = dl + j - 15; f[j] = lag >= 0 ? fc[(size_t)lag * 2048] : fc[(size_t)(-lag) * 2048 + 1024]; }
#pragma unroll
            for (int j = 0; j < 16; ++j) v[j] = vb[(size_t)(s0 + j) * 1024];
#pragma unroll
            for (int i = 0; i < 16; ++i)
#pragma unroll
                for (int j = 0; j < 16; ++j) acc[i] += f[i - j + 15] * v[j]; }
#pragma unroll
        for (int i = 0; i < 16; ++i) { const int t = t0 + i; const size_t row = (size_t)(b * CTX + t);
            const float x0 = bf2f(P2[row * P2W + P2_X0 + c]);
            YC[row * 1024 + c] = (bf16_t)f2bf((acc[i] + vb[(size_t)t * 1024] * hyd[c]) * x0); }
    }
}

__device__ __forceinline__ void phase_ln1(Frame& F, const Args& a, int layer) {
    const float* mod = (const float*)(F.ws + WS_CTL) + CW_MOD + (size_t)layer * 3 * 6 * DM;
    const float* YM = WSP(float, WS_YMIX); float* XS = WSP(float, WS_XS); unsigned* H2 = WSP(unsigned, WS_H2); float* AFF = WSP(float, WS_AFF); int* INV = WSP(int, WS_INV);
    const float* g1w = arg_in(a, I_LN1G) + layer * DM; const float* b1w = arg_in(a, I_LN1B) + layer * DM; const float* wr = arg_in(a, I_WROUTER) + (size_t)layer * DM * NEXP;
    LAS float* wrT = (LAS float*)F.lds;
    __syncthreads();
    for (int i = F.tid; i < DM * NEXP; i += NTHREADS) { const int c = i >> 4, e = i & 15; wrT[e * DM + c] = wr[i]; }
    __syncthreads();
    int* PTOK = WSP(int, WS_PTOK); float* PG = WSP(float, WS_PGATE);
    for (int i = F.bid * NTHREADS + F.tid; i < NPAIR; i += F.G * NTHREADS) { PTOK[i] = -1; PG[i] = 0.f; }
    for (int row = F.gw; row < T; row += F.NGW) {
        const f32x4* xr = (const f32x4*)x_src_row(a, F, layer, row) + F.lane; const f32x4* yr = (const f32x4*)(YM + (size_t)row * DM) + F.lane;
        const float* m = mod + (size_t)row_modidx(row) * 6 * DM;
        f32x4 v[8];
#pragma unroll
        for (int j = 0; j < 8; ++j) { const int c = 4 * (64 * j + F.lane); v[j] = xr[64 * j] * ALPHA + *(const f32x4*)(m + 2 * DM + c) * yr[64 * j]; }
        float mean, rstd; row_stats(v, mean, rstd, 1e-6f);
        f32x4* xo = (f32x4*)(XS + (size_t)row * DM) + F.lane;
#pragma unroll
        for (int j = 0; j < 8; ++j) { const int c = 4 * (64 * j + F.lane); v[j] = (v[j] - mean) * rstd * *(const f32x4*)(g1w + c) + *(const f32x4*)(b1w + c); xo[64 * j] = v[j]; }
        row_stats(v, mean, rstd, 1e-6f);
        unsigned* ho = H2 + (size_t)row * (DM / 4) + F.lane;
        float lg[16];
#pragma unroll
        for (int e = 0; e < 16; ++e) lg[e] = 0.f;
#pragma unroll
        for (int j = 0; j < 8; ++j) { const int c = 4 * (64 * j + F.lane);
            const f32x4 y = (v[j] - mean) * rstd * (*(const f32x4*)(m + 4 * DM + c) + 1.f) + *(const f32x4*)(m + 3 * DM + c);
            ho[64 * j] = pk4fp8(y.x, y.y, y.z, y.w);
#pragma unroll
            for (int e = 0; e < 16; ++e) { const f32x4 ww = *(const LAS f32x4*)(wrT + e * DM + c); lg[e] += (y.x * ww.x + y.y * ww.y) + (y.z * ww.z + y.w * ww.w); } }
        float mx = -1e30f;
#pragma unroll
        for (int e = 0; e < 16; ++e) { lg[e] = wave_sum(lg[e]); mx = fmaxf(mx, lg[e]); }
        float den = 0.f;
#pragma unroll
        for (int e = 0; e < 16; ++e) { lg[e] = __expf(lg[e] - mx); den += lg[e]; }
        float mine = 0.f;
#pragma unroll
        for (int e = 0; e < 16; ++e) mine = (F.lane == e) ? lg[e] : mine;
        if (F.lane < 16) { AFF[(size_t)row * 16 + F.lane] = mine / den; INV[(size_t)row * 16 + F.lane] = -1; }
    }
}
__device__ __forceinline__ void phase_topk(Frame& F, bool lat_only) {
    const float* AFF = WSP(float, WS_AFF); int* INV = WSP(int, WS_INV); int* PTOK = WSP(int, WS_PTOK); float* PG = WSP(float, WS_PGATE);
    LAS unsigned* vals = (LAS unsigned*)F.lds; LAS unsigned* hist = vals + 8192; LAS unsigned* ctl = hist + 256;
    for (int u = F.bid + (lat_only ? 32 : 0); u < 64; u += F.G) {
        const int s = u >> 4, e = u & 15, rs = seg_start(s), n = seg_len(s), cap = s < 2 ? CAP_C : CAP_L;
        __syncthreads();
        for (int i = F.tid; i < n; i += NTHREADS) vals[i] = __builtin_bit_cast(unsigned, AFF[(size_t)(rs + i) * 16 + e]);
        if (F.tid == 0) { ctl[0] = 0u; ctl[1] = (unsigned)cap; ctl[2] = 0u; ctl[3] = 0u; }
        unsigned mask = 0u;
        for (int shift = 24; shift >= 0; shift -= 8) {
            if (F.tid < 256) hist[F.tid] = 0u;
            __syncthreads();
            const unsigned prefix = ctl[0];
            for (int i = F.tid; i < n; i += NTHREADS) { const unsigned b = vals[i]; if ((b & mask) == prefix) __hip_atomic_fetch_add(&hist[(b >> shift) & 255u], 1u, __ATOMIC_RELAXED, __HIP_MEMORY_SCOPE_WORKGROUP); }
            __syncthreads();
            if (F.tid == 0) { unsigned rem = ctl[1], cum = 0u; int dg = 255; for (; dg > 0; --dg) { const unsigned hc = hist[dg]; if (cum + hc >= rem) break; cum += hc; }
                ctl[1] = rem - cum; ctl[0] = prefix | ((unsigned)dg << shift); }
            mask |= 255u << shift;
            __syncthreads();
        }
        const unsigned thr = ctl[0], rem = ctl[1]; const unsigned ngt = (unsigned)cap - rem;
        const int pbase = s < 2 ? NBATCH * NEXP * CAP_L + e * 256 + s * CAP_C : ((s - 2) * NEXP + e) * CAP_L;
        for (int i = F.tid; i < n; i += NTHREADS) { const unsigned b = vals[i]; int slot = -1;
            if (b > thr) slot = (int)__hip_atomic_fetch_add(&ctl[2], 1u, __ATOMIC_RELAXED, __HIP_MEMORY_SCOPE_WORKGROUP);
            else if (b == thr) { const unsigned q = __hip_atomic_fetch_add(&ctl[3], 1u, __ATOMIC_RELAXED, __HIP_MEMORY_SCOPE_WORKGROUP); if (q < rem) slot = (int)(ngt + q); }
            if (slot >= 0) { const int pair = pbase + slot, row = rs + i; PTOK[pair] = row; PG[pair] = __builtin_bit_cast(float, b); INV[(size_t)row * 16 + e] = pair; } }
    }
}
__device__ __forceinline__ void phase_gather(Frame& F) {
    const unsigned char* H2 = WSP(unsigned char, WS_H2); unsigned char* XG = WSP(unsigned char, WS_XG); unsigned char* HID = WSP(unsigned char, WS_HID); const int* PTOK = WSP(int, WS_PTOK);
    for (int p = F.gw; p < NPAIR; p += F.NGW) { const int tok = PTOK[p]; u32x4* dst = (u32x4*)(XG + (size_t)p * DM) + F.lane;
        unsigned zz = 0u; asm volatile("" : "+v"(zz));
        if (tok >= 0) { const u32x4* src = (const u32x4*)(H2 + (size_t)tok * DM) + F.lane; dst[0] = src[0]; dst[64] = src[64]; }
        else { dst[0] = (u32x4){zz, zz, zz, zz}; dst[64] = (u32x4){zz, zz, zz, zz}; }
        if (F.lane < 8) *((u32x4*)(HID + (size_t)p * EFFP + EFF) + F.lane) = (u32x4){zz, zz, zz, zz}; }
}
__device__ __forceinline__ void phase_ln2(Frame& F, const Args& a, int layer) {
    const float* mod = (const float*)(F.ws + WS_CTL) + CW_MOD + (size_t)layer * 3 * 6 * DM;
    float* XS = WSP(float, WS_XS); const bf16_t* YE = WSP(bf16_t, WS_YE); const int* INV = WSP(int, WS_INV);
    const float* g2w = arg_in(a, I_LN2G) + layer * DM; const float* b2w = arg_in(a, I_LN2B) + layer * DM;
    for (int row = F.gw; row < T; row += F.NGW) {
        f32x4* xr = (f32x4*)(XS + (size_t)row * DM) + F.lane; const float* m = mod + (size_t)row_modidx(row) * 6 * DM;
        f32x4 mo[8];
#pragma unroll
        for (int j = 0; j < 8; ++j) mo[j] = (f32x4){0.f, 0.f, 0.f, 0.f};
        for (int e = 0; e < 16; ++e) { const int pair = INV[(size_t)row * 16 + e];
            if (pair >= 0) { const u32x2* yr = (const u32x2*)(YE + (size_t)pair * DM) + F.lane;
#pragma unroll
                for (int j = 0; j < 8; ++j) { const u32x2 w = yr[64 * j]; mo[j] += (f32x4){bflo(w.x), bfhi(w.x), bflo(w.y), bfhi(w.y)}; } } }
        f32x4 v[8];
#pragma unroll
        for (int j = 0; j < 8; ++j) { const int c = 4 * (64 * j + F.lane); v[j] = xr[64 * j] * ALPHA + *(const f32x4*)(m + 5 * DM + c) * mo[j]; }
        float mean, rstd; row_stats(v, mean, rstd, 1e-6f);
#pragma unroll
        for (int j = 0; j < 8; ++j) { const int c = 4 * (64 * j + F.lane); v[j] = (v[j] - mean) * rstd * *(const f32x4*)(g2w + c) + *(const f32x4*)(b2w + c); xr[64 * j] = v[j]; }
        if (layer == DEPTH - 1) { if (row >= TC) { f32x4* o = (f32x4*)(a.out + (size_t)(row - TC) * DM) + F.lane;
#pragma unroll
            for (int j = 0; j < 8; ++j) o[64 * j] = v[j]; } }
        else {
            row_stats(v, mean, rstd, 1e-6f);
            const float* m1 = m + (size_t)3 * 6 * DM;
            bf16_t* H = WSP(bf16_t, WS_H); unsigned* H8 = WSP(unsigned, WS_H8);
            u32x2* o = (u32x2*)(H + (size_t)row * DM) + F.lane; unsigned* o8 = H8 + (size_t)row * (DM / 4) + F.lane;
#pragma unroll
            for (int j = 0; j < 8; ++j) { const int c = 4 * (64 * j + F.lane); const f32x4 sh = *(const f32x4*)(m1 + c), sc = *(const f32x4*)(m1 + DM + c);
                const f32x4 y = (v[j] - mean) * rstd * (sc + 1.f) + sh; u32x2 w; w.x = pk2(y.x, y.y); w.y = pk2(y.z, y.w); o[64 * j] = w; o8[64 * j] = pk4fp8(y.x, y.y, y.z, y.w); } }
    }
}

constexpr int LDS_BYTES = 153600, MISC_OFF = LDS_BYTES - 64;
constexpr int NPL = 16, NPHASE = 1 + DEPTH * NPL;

__global__ void __launch_bounds__(NTHREADS, 2) fwd_kernel(Args args) {
    extern __shared__ __attribute__((aligned(16))) unsigned char lds_raw[];
    Frame F;
    F.lds = (LAS unsigned char*)lds_raw;
    F.tid = threadIdx.x; F.lane = F.tid & 63; F.wave = __builtin_amdgcn_readfirstlane(F.tid >> 6); const int wave0 = F.wave;
    F.G = gridDim.x; F.bid = blockIdx.x; F.gw = F.bid * NWAVES + F.wave; F.NGW = F.G * NWAVES; F.ws = args.ws;
    volatile LAS unsigned* misc = (volatile LAS unsigned*)(F.lds + MISC_OFF);
    if (F.tid < 16) misc[F.tid] = 0u;
    __syncthreads();
    const int lo = args.ph_lo, hi = args.ph_hi;
    XcdBarrier bar; bar.bar = (unsigned*)(F.ws + WS_CTL) + CW_BAR; bar.x = 0; bar.st = nullptr;
    const bool multi = (hi - lo) > 1;
    if (multi) bar = xcd_barrier_post((unsigned*)(F.ws + WS_CTL) + CW_BAR, misc);
#ifndef ONLY_PHASE
#define ONLY_PHASE -1
#endif
#define PON(r) (ONLY_PHASE < 0 || ONLY_PHASE == (r))
#ifndef REP_MASK
#define REP_MASK 0
#endif
#define REP(b) ((REP_MASK >> (b)) & 1)
#define REOPQ() do { F.ws = opq(args.ws); F.lane = lane_asm() & 63; F.wave = opqs(wave0) & 7; F.tid = F.wave * 64 + F.lane; F.G = opqs(gridDim.x); F.bid = opqs(blockIdx.x); F.gw = F.bid * NWAVES + F.wave; F.NGW = F.G * NWAVES; } while (0)
#define IN(k) (lo <= (k) && (k) < hi)
#define SEAM(k) do { if (IN(k) && IN((k) + 1)) { XcdBarrier bb_ = bar; bb_.x = (unsigned)opqs((int)bar.x); xcd_barrier(bb_); } } while (0)
    if (PON(100) && IN(0)) { F.ws = opq(args.ws); F.lane = lane_asm() & 63; F.wave = opqs(wave0) & 7; F.tid = F.wave * 64 + F.lane; F.G = opqs(gridDim.x); F.bid = opqs(blockIdx.x); F.gw = F.bid * NWAVES + F.wave; F.NGW = F.G * NWAVES; { p0_weights(F, args); __syncthreads(); REOPQ(); p0_mod(F, args); __syncthreads(); REOPQ(); phase_hdn(F, args, 0); REOPQ(); phase_hdn(F, args, 1); __syncthreads(); } }
    SEAM(0);
#pragma unroll 1
    for (int layer = 0; layer < DEPTH; ++layer) {
        const int pb = 1 + layer * NPL; const bool lat_only = (layer == DEPTH - 1);
        if (PON(0) && IN(pb + 0)) { F.ws = opq(args.ws); F.lane = lane_asm() & 63; F.wave = opqs(wave0) & 7; F.tid = F.wave * 64 + F.lane; F.G = opqs(gridDim.x); F.bid = opqs(blockIdx.x); F.gw = F.bid * NWAVES + F.wave; F.NGW = F.G * NWAVES; if (layer == 0) phase_modln(F, args, layer); __syncthreads(); }
        SEAM(pb + 0);
        if (PON(1) && IN(pb + 1)) { F.ws = opq(args.ws); F.lane = lane_asm() & 63; F.wave = opqs(wave0) & 7; F.tid = F.wave * 64 + F.lane; F.G = opqs(gridDim.x); F.bid = opqs(blockIdx.x); F.gw = F.bid * NWAVES + F.wave; F.NGW = F.G * NWAVES;
            pg8::Gemm g{WSP(bf16_t, WS_H), WSP(bf16_t, WS_WIN + layer * SZ_WIN), DM, DM, DM}; pg8::StaticOrder S; S.init(66, NNG / 256, F.G, F.bid);
            EpiBf16 E{WSP(bf16_t, WS_P), NNG, nullptr, 0, 0, 1.f};
            pg8::gemm_phase(F.lds, g, S, E, F.tid);
        }
        SEAM(pb + 1);
        if (PON(2) && IN(pb + 2)) { F.ws = opq(args.ws); F.lane = lane_asm() & 63; F.wave = opqs(wave0) & 7; F.tid = F.wave * 64 + F.lane; F.G = opqs(gridDim.x); F.bid = opqs(blockIdx.x); F.gw = F.bid * NWAVES + F.wave; F.NGW = F.G * NWAVES; { phase_prep(F, args, layer); REOPQ(); phase_filt(F, args, layer); __syncthreads(); } }
        SEAM(pb + 2);
        if (PON(3) && IN(pb + 3)) { F.ws = opq(args.ws); F.lane = lane_asm() & 63; F.wave = opqs(wave0) & 7; F.tid = F.wave * 64 + F.lane; F.G = opqs(gridDim.x); F.bid = opqs(blockIdx.x); F.gw = F.bid * NWAVES + F.wave; F.NGW = F.G * NWAVES;
#if !defined(T3) || T3 == 0
            { pg8::Gemm g{WSP(bf16_t, WS_P) + P_CQ, WSP(bf16_t, WS_WQ + layer * SZ_WQ), NNG, 512, 512}; pg8::StaticOrder S; S.init(lat_only ? 64 : 66, 6, F.G, F.bid, lat_only ? 2 : 0);
              EpiBf16 E{WSP(bf16_t, WS_Q), 1536, WSP(float, WS_RS), 2, 0, 1.f}; pg8::gemm_phase(F.lds, g, S, E, F.tid); }
#endif
#if !defined(T3) || T3 == 1
            { pg8::Gemm g{WSP(bf16_t, WS_P) + P_CKV, WSP(bf16_t, WS_WKV + layer * SZ_WKV), NNG, 512, 512}; pg8::StaticOrder S; S.init(66, 8, F.G, (F.bid + 140) & 255);
              EpiBf16 E{WSP(bf16_t, WS_KV), 2048, WSP(float, WS_RS) + 1, 2, 0, 1.f}; pg8::gemm_phase(F.lds, g, S, E, F.tid); }
#endif
#if !defined(T3) || T3 == 2
            { pg8::Gemm g{WSP(bf16_t, WS_ALORA), WSP(bf16_t, WS_WLORA + layer * SZ_WLORA), 512, 512, 512}; pg8::StaticOrder S; S.init(66, 20, F.G, (F.bid + 156) & 255);
              EpiLora E{WSP(bf16_t, WS_EW), WSP(bf16_t, WS_ICLR), WSP(bf16_t, WS_GG), arg_in(args, I_RW0) + layer * 2048, arg_in(args, I_RA0) + layer * 2048}; pg8::gemm_phase(F.lds, g, S, E, F.tid); }
            REOPQ(); phase_mamba_states(F, args, layer); __syncthreads();
#endif
        }
        SEAM(pb + 3);
        SEAM(pb + 4);
        if (PON(5) && IN(pb + 5)) { F.ws = opq(args.ws); F.lane = lane_asm() & 63; F.wave = opqs(wave0) & 7; F.tid = F.wave * 64 + F.lane; F.G = opqs(gridDim.x); F.bid = opqs(blockIdx.x); F.gw = F.bid * NWAVES + F.wave; F.NGW = F.G * NWAVES;
#if !defined(T5) || T5 == 0
            phase_rwkv_scan(F, args, layer); __syncthreads();
#endif
#if !defined(T5) || T5 == 1
            REOPQ(); phase_attn(F, lat_only);
#endif
#if !defined(T5) || T5 == 2
            REOPQ(); phase_hyena_fft(F, args, layer);
#endif
#if !defined(T5) || T5 == 3
            REOPQ(); phase_mamba_scan(F); __syncthreads();
#endif
        }
        SEAM(pb + 5);
        if (PON(6) && IN(pb + 6)) { F.ws = opq(args.ws); F.lane = lane_asm() & 63; F.wave = opqs(wave0) & 7; F.tid = F.wave * 64 + F.lane; F.G = opqs(gridDim.x); F.bid = opqs(blockIdx.x); F.gw = F.bid * NWAVES + F.wave; F.NGW = F.G * NWAVES;
#if !defined(T6) || T6 == 0
            phase_mamba_out(F, args, layer); __syncthreads();
#endif
#if !defined(T6) || T6 == 1
            REOPQ(); phase_hyena_out(F, args, layer);
#endif
#if !defined(T6) || T6 == 2
            REOPQ(); phase_rwkv_out(F, args, layer); __syncthreads();
#endif
        }
        SEAM(pb + 6);
        if (PON(7) && IN(pb + 7)) { F.ws = opq(args.ws); F.lane = lane_asm() & 63; F.wave = opqs(wave0) & 7; F.tid = F.wave * 64 + F.lane; F.G = opqs(gridDim.x); F.bid = opqs(blockIdx.x); F.gw = F.bid * NWAVES + F.wave; F.NGW = F.G * NWAVES;
            pg8::Gemm g{WSP(bf16_t, WS_H8), WSP(bf16_t, WS_WIN + layer * SZ_WIN) + (size_t)NNG * DM, DM / 2, DM / 2, DM / 2}; pg8::StaticOrder S; S.init(lat_only ? 64 : 66, NGATE / 256, F.G, F.bid, lat_only ? 2 : 0);
            EpiBf16 E{WSP(bf16_t, WS_GATES), NGATE, nullptr, 0, 0, 1.f / 64.f};
            pg8::gemm_phase<EpiBf16, pg8::StaticOrder, true>(F.lds, g, S, E, F.tid);
            REOPQ(); phase_mamba_norm(F, args, layer);
        }
        SEAM(pb + 7);
        if (PON(8) && IN(pb + 8)) { F.ws = opq(args.ws); F.lane = lane_asm() & 63; F.wave = opqs(wave0) & 7; F.tid = F.wave * 64 + F.lane; F.G = opqs(gridDim.x); F.bid = opqs(blockIdx.x); F.gw = F.bid * NWAVES + F.wave; F.NGW = F.G * NWAVES;
            pg8::Gemm g{WSP(bf16_t, WS_Y), WSP(bf16_t, WS_WBR + layer * SZ_WBR), 1024, 1024, 1024}; OrderMerge S; S.init(F.G, F.bid, lat_only ? 64 : 66, lat_only ? 2 : 0);
            EpiMerge E{WSP(bf16_t, WS_GATES), WSP(float, WS_MRGF), WSP(bf16_t, WS_MRGB)};
            pg8::gemm_phase(F.lds, g, S, E, F.tid);

        }
        SEAM(pb + 8);
        if (PON(9) && IN(pb + 9)) { F.ws = opq(args.ws); F.lane = lane_asm() & 63; F.wave = opqs(wave0) & 7; F.tid = F.wave * 64 + F.lane; F.G = opqs(gridDim.x); F.bid = opqs(blockIdx.x); F.gw = F.bid * NWAVES + F.wave; F.NGW = F.G * NWAVES;
            pg8::Gemm g{WSP(bf16_t, WS_MRGB), WSP(bf16_t, WS_WOUT + layer * SZ_WOUT), DM, DM, DM}; pg8::StaticOrder S; S.init(lat_only ? 64 : 66, 8, F.G, F.bid, lat_only ? 2 : 0);
            EpiF32 E{WSP(float, WS_YMIX), DM};
            pg8::gemm_phase(F.lds, g, S, E, F.tid);

        }
        SEAM(pb + 9);
        if (PON(10) && IN(pb + 10)) { F.ws = opq(args.ws); F.lane = lane_asm() & 63; F.wave = opqs(wave0) & 7; F.tid = F.wave * 64 + F.lane; F.G = opqs(gridDim.x); F.bid = opqs(blockIdx.x); F.gw = F.bid * NWAVES + F.wave; F.NGW = F.G * NWAVES; phase_ln1(F, args, layer); __syncthreads(); { REOPQ(); conv_experts(F, args, layer); __syncthreads(); } }
        SEAM(pb + 10);
        if (PON(11) && IN(pb + 11)) { F.ws = opq(args.ws); F.lane = lane_asm() & 63; F.wave = opqs(wave0) & 7; F.tid = F.wave * 64 + F.lane; F.G = opqs(gridDim.x); F.bid = opqs(blockIdx.x); F.gw = F.bid * NWAVES + F.wave; F.NGW = F.G * NWAVES; phase_topk(F, lat_only); __syncthreads(); }
        SEAM(pb + 11);
        if (PON(12) && IN(pb + 12)) { F.ws = opq(args.ws); F.lane = lane_asm() & 63; F.wave = opqs(wave0) & 7; F.tid = F.wave * 64 + F.lane; F.G = opqs(gridDim.x); F.bid = opqs(blockIdx.x); F.gw = F.bid * NWAVES + F.wave; F.NGW = F.G * NWAVES; phase_gather(F); }
        SEAM(pb + 12);
        if (PON(13) && IN(pb + 13)) { F.ws = opq(args.ws); F.lane = lane_asm() & 63; F.wave = opqs(wave0) & 7; F.tid = F.wave * 64 + F.lane; F.G = opqs(gridDim.x); F.bid = opqs(blockIdx.x); F.gw = F.bid * NWAVES + F.wave; F.NGW = F.G * NWAVES;
            pg8::Gemm g{WSP(bf16_t, WS_XG), WSP(bf16_t, WS_WE), DM / 2, DM / 2, DM / 2}; OrderMoe S; S.init(11, F.G, F.bid, lat_only ? 8 : 9);
            EpiSwiglu E{WSP(unsigned char, WS_HID)};
            pg8::gemm_phase<EpiSwiglu, OrderMoe, true>(F.lds, g, S, E, F.tid);

        }
        SEAM(pb + 13);
        if (PON(14) && IN(pb + 14)) { F.ws = opq(args.ws); F.lane = lane_asm() & 63; F.wave = opqs(wave0) & 7; F.tid = F.wave * 64 + F.lane; F.G = opqs(gridDim.x); F.bid = opqs(blockIdx.x); F.gw = F.bid * NWAVES + F.wave; F.NGW = F.G * NWAVES;
            pg8::Gemm g{WSP(bf16_t, WS_HID), WSP(bf16_t, WS_WE + SZ_WGU8), EFFP / 2, EFFP / 2, EFFP / 2}; OrderMoe S; S.init(8, F.G, F.bid, lat_only ? 8 : 9);
            EpiDown E{WSP(bf16_t, WS_YE), WSP(float, WS_PGATE)};
            pg8::gemm_phase<EpiDown, OrderMoe, true>(F.lds, g, S, E, F.tid);

        }
        SEAM(pb + 14);
        if (PON(15) && IN(pb + 15)) { F.ws = opq(args.ws); F.lane = lane_asm() & 63; F.wave = opqs(wave0) & 7; F.tid = F.wave * 64 + F.lane; F.G = opqs(gridDim.x); F.bid = opqs(blockIdx.x); F.gw = F.bid * NWAVES + F.wave; F.NGW = F.G * NWAVES; phase_ln2(F, args, layer); }
        SEAM(pb + 15);
    }
#undef IN
#undef SEAM
}


#ifdef DBG_CUT
__global__ void dbg_dump(const unsigned char* ws, float* out, size_t off, int is_bf16, size_t n_src) {
    const size_t N = (size_t)TL * DM;
    for (size_t i = (size_t)blockIdx.x * blockDim.x + threadIdx.x; i < N; i += (size_t)gridDim.x * blockDim.x) {
        const size_t j = i % n_src;
        out[i] = is_bf16 ? bf2f(((const bf16_t*)(ws + off))[j]) : ((const float*)(ws + off))[j];
    }
}
#endif

#ifdef DBG_PASSES
__global__ void dbg_chk(const unsigned char* base, size_t off, size_t nbytes, unsigned long long* slot) {
    const unsigned* p = (const unsigned*)(base + off); const size_t n = nbytes / 4; unsigned long long s = 0;
    for (size_t i = (size_t)blockIdx.x * blockDim.x + threadIdx.x; i < n; i += (size_t)gridDim.x * blockDim.x) s += p[i];
    for (int o = 32; o > 0; o >>= 1) s += __shfl_xor(s, o);
    if ((threadIdx.x & 63) == 0) atomicAdd(slot, s);
}
__global__ void dbg_report(const unsigned long long* tab, float* out, int npass) {
    int k = 0;
    for (int ph = NPHASE - 1; ph >= 0; --ph) if (tab[ph] != tab[64 + ph]) k = ph + 1;
    if (k == 0 && npass > 2) { for (int ph = NPHASE - 1; ph >= 0; --ph) if (tab[64 + ph] != tab[128 + ph]) k = 50 + ph + 1; }
    if (k == 0) return;
    const float c = sqrtf(10.f * (float)k);
    for (size_t i = (size_t)blockIdx.x * blockDim.x + threadIdx.x; i < (size_t)TL * DM; i += (size_t)gridDim.x * blockDim.x) out[i] = c;
}
struct DbgReg { size_t off, n; };
#endif
extern "C" void kernel_launch(void* const* d_in, const int* in_sizes, int n_in, void* d_out, int out_size, void* d_ws, size_t ws_size, hipStream_t stream) {
    static int grid = 0;
    if (grid == 0) {
        if (n_in != N_INPUTS || in_sizes[0] != TL * DM || out_size != TL * DM || ws_size < WS_END) {
            fprintf(stderr, "kernel_launch: shape/workspace mismatch: n_in %d in0 %d out %d ws %zu (need %zu)\n", n_in, n_in > 0 ? in_sizes[0] : -1, out_size, ws_size, (size_t)WS_END); grid = -1; return; }
        int dev = 0, cus = 0, per_cu = 0;
        if (hipGetDevice(&dev) != hipSuccess || hipDeviceGetAttribute(&cus, hipDeviceAttributeMultiprocessorCount, dev) != hipSuccess) { grid = -1; return; }
        if (hipFuncSetAttribute((const void*)fwd_kernel, hipFuncAttributeMaxDynamicSharedMemorySize, LDS_BYTES) != hipSuccess) { fprintf(stderr, "kernel_launch: hipFuncSetAttribute failed\n"); grid = -1; return; }
        if (hipOccupancyMaxActiveBlocksPerMultiprocessor(&per_cu, (const void*)fwd_kernel, NTHREADS, LDS_BYTES) != hipSuccess || per_cu < 1) { fprintf(stderr, "kernel_launch: occupancy query says %d\n", per_cu); grid = -1; (void)hipGetLastError(); return; }
        grid = cus;
    }
    if (grid < 0) return;
    (void)hipMemsetAsync((char*)d_ws + WS_CTL, 0, CTL_BYTES, stream);
    Args a{};
    for (int i = 0; i < N_INPUTS; ++i) a.in[i] = (const float*)d_in[i];
    a.out = (float*)d_out; a.ws = (unsigned char*)d_ws;
#if MK_ONE_LAUNCH
    a.ph_lo = 0; a.ph_hi = NPHASE;
    hipLaunchKernelGGL(fwd_kernel, dim3(grid), dim3(NTHREADS), LDS_BYTES, stream, a);
#else
#ifdef DBG_PASSES
    {
        unsigned long long* tab = (unsigned long long*)((char*)d_ws + 1600000);
        auto chk = [&](int pass, int ph, size_t off, size_t n) { hipLaunchKernelGGL(dbg_chk, dim3(1024), dim3(256), 0, stream, (const unsigned char*)d_ws, off, n, tab + pass * 64 + ph); };
        for (int pass = 0; pass < DBG_PASSES; ++pass) {
            if (pass > 0) (void)hipMemsetAsync((char*)d_ws + (size_t)CW_MOD * 4, 0, (size_t)DEPTH * 3 * 6 * DM * 4, stream);
            for (int ph = 0; ph < NPHASE; ++ph) {
                a.ph_lo = ph; a.ph_hi = ph + 1; hipLaunchKernelGGL(fwd_kernel, dim3(grid), dim3(NTHREADS), LDS_BYTES, stream, a);
                if (ph == 0) { chk(pass, ph, WS_WIN, WS_XS - WS_WIN); chk(pass, ph, (size_t)CW_MOD * 4, (size_t)DEPTH * 3 * 6 * DM * 4); continue; }
                const int r = (ph - 1) % NPL;
                switch (r) {
                case 0: chk(pass, ph, WS_H, SZ_H); chk(pass, ph, WS_HDN, SZ_HDN); break;
                case 1: chk(pass, ph, WS_P, SZ_P); break;
                case 2: chk(pass, ph, WS_P2, SZ_P2); chk(pass, ph, WS_KK, SZ_TK2); chk(pass, ph, WS_ALORA, WS_VT - WS_ALORA); chk(pass, ph, WS_VT, WS_HDN - WS_VT); break;
                case 3: chk(pass, ph, WS_Q, SZ_Q + SZ_KV); chk(pass, ph, WS_EW, 4 * SZ_TK2); chk(pass, ph, WS_GG, SZ_TK2); break;
                case 4: chk(pass, ph, WS_Q, SZ_Q); chk(pass, ph, WS_MST, SZ_MST + SZ_MCS); break;
                case 5: chk(pass, ph, WS_YRW, 2 * SZ_TK2); chk(pass, ph, WS_Y, SZ_Y / 4); chk(pass, ph, WS_VT, SZ_VT); chk(pass, ph, WS_MST, SZ_MST); break;
                case 6: chk(pass, ph, WS_Y + SZ_Y / 4, 3 * (SZ_Y / 4)); break;
                case 7: chk(pass, ph, WS_GATES, SZ_GATES); chk(pass, ph, WS_Y + SZ_Y / 4, SZ_Y / 4); break;
                case 8: chk(pass, ph, WS_MRGF, SZ_MRGF); chk(pass, ph, WS_MRGB, SZ_MRGB); break;
                case 9: chk(pass, ph, WS_YMIX, SZ_YMIX); break;
                case 10: chk(pass, ph, WS_XS, SZ_XS); chk(pass, ph, WS_H2, SZ_H); chk(pass, ph, WS_AFF, SZ_AFF); chk(pass, ph, WS_WE, SZ_WGU + SZ_WD); break;
                case 11: chk(pass, ph, WS_INV, SZ_INV + SZ_PTOK + SZ_PGATE); break;
                case 12: chk(pass, ph, WS_XG, SZ_XG); break;
                case 13: chk(pass, ph, WS_HID, SZ_HID); break;
                case 14: chk(pass, ph, WS_YE, SZ_YE); break;
                case 15: chk(pass, ph, WS_XS, SZ_XS); break;
                }
            }
        }
        hipLaunchKernelGGL(dbg_report, dim3(2048), dim3(256), 0, stream, (const unsigned long long*)tab, (float*)d_out, (int)DBG_PASSES);
    }
#elif defined(DBG_CUT)
    for (int ph = 0; ph < DBG_CUT; ++ph) { a.ph_lo = ph; a.ph_hi = ph + 1; hipLaunchKernelGGL(fwd_kernel, dim3(grid), dim3(NTHREADS), LDS_BYTES, stream, a); }
    hipLaunchKernelGGL(dbg_dump, dim3(2048), dim3(256), 0, stream, (const unsigned char*)d_ws, (float*)d_out, (size_t)DBG_OFF, DBG_BF16, (size_t)DBG_N);
#else
    for (int ph = 0; ph < NPHASE; ++ph) { a.ph_lo = ph; a.ph_hi = ph + 1; hipLaunchKernelGGL(fwd_kernel, dim3(grid), dim3(NTHREADS), LDS_BYTES, stream, a); }
#endif
#endif
}
```

```cpp
#include <hip/hip_runtime.h>
#include <cstdio>
#include <cstdint>

#define REP_MASK 0x80000
#ifndef MK_ONE_LAUNCH
#define MK_ONE_LAUNCH 1
#endif

#define LAS __attribute__((address_space(3)))
typedef unsigned short bf16_t;
typedef short bf16x8 __attribute__((ext_vector_type(8)));
typedef float f32x4 __attribute__((ext_vector_type(4)));
typedef float f32x2 __attribute__((ext_vector_type(2)));
typedef unsigned u32x4 __attribute__((ext_vector_type(4)));
typedef unsigned u32x2 __attribute__((ext_vector_type(2)));

constexpr int DM = 2048, NBATCH = 2, SEQ = 8192, CTX = 256, DEPTH = 2;
constexpr int TC = NBATCH * CTX, TL = NBATCH * SEQ, T = TC + TL;
constexpr int NIN = 18432, NNG = 10240, NGATE = 8192;
constexpr int P_CQ = 0, P_CKV = 512, P_KPE = 1024;
constexpr int P_Z = 1088, P_XBC = 2112, P_DT = 3648;
constexpr int P_HY = 3680;
constexpr int P_RW = 6752, P_WD = 9824, P_AD = 9952, P_GD = 10080;
constexpr int NH_MLA = 8, NH_SSM = 16, NH_RW = 16;
constexpr int NEXP = 16, EFF = 1408, CAP_L = 1024, CAP_C = 32;
constexpr int NPAIR = NBATCH * NEXP * CAP_L + NEXP * 256;
constexpr float ALPHA = 1.4142135623730951f;
constexpr int NWAVES = 8, NTHREADS = 512;

__device__ __forceinline__ int seg_of(int row) { return row < 256 ? 0 : row < 512 ? 1 : row < 512 + SEQ ? 2 : 3; }
__device__ __forceinline__ int seg_start(int s) { return s == 0 ? 0 : s == 1 ? 256 : s == 2 ? 512 : 512 + SEQ; }
__device__ __forceinline__ int seg_len(int s) { return s < 2 ? CTX : SEQ; }
__device__ __forceinline__ bool row_first(int row) { return row == 0 || row == 256 || row == 512 || row == 512 + SEQ; }
__device__ __forceinline__ bool row_last(int row) { return row == 255 || row == 511 || row == 511 + SEQ || row == T - 1; }
__device__ __forceinline__ int row_modidx(int row) { return row < 512 ? 2 : (row < 512 + SEQ ? 0 : 1); }

constexpr size_t AL(size_t x) { return (x + 255) / 256 * 256; }
constexpr size_t WS_CTL = 0, CTL_BYTES = 2u << 20;
constexpr int CW_BAR = 1024;
constexpr int CW_MOD = 16384;
constexpr size_t SZ_WIN = (size_t)NIN * DM * 2, SZ_WBR = (size_t)4 * DM * 1024 * 2, SZ_WOUT = (size_t)DM * DM * 2, SZ_WQ = (size_t)1536 * 512 * 2,
                 SZ_WKV = (size_t)2048 * 512 * 2, SZ_WLORA = (size_t)5120 * 512 * 2;
constexpr size_t WS_WIN = CTL_BYTES, WS_WBR = WS_WIN + DEPTH * SZ_WIN, WS_WOUT = WS_WBR + DEPTH * SZ_WBR, WS_WQ = WS_WOUT + DEPTH * SZ_WOUT,
                 WS_WKV = WS_WQ + DEPTH * SZ_WQ, WS_WLORA = WS_WKV + DEPTH * SZ_WKV, WS_XS = WS_WLORA + DEPTH * SZ_WLORA;
constexpr size_t SZ_XS = (size_t)T * DM * 4;
constexpr size_t WS_H = WS_XS + SZ_XS, SZ_H = (size_t)T * DM * 2;
constexpr size_t WS_P = WS_H + SZ_H, SZ_P = (size_t)T * NNG * 2;
constexpr int P2W = 5632, P2_XBC = 0, P2_X0 = 1536, P2_RKV = 2560;
constexpr size_t WS_P2 = WS_P + SZ_P, SZ_P2 = (size_t)T * P2W * 2;
constexpr size_t WS_Q = WS_P2 + SZ_P2, SZ_Q = (size_t)T * 1536 * 2;
constexpr size_t WS_KV = WS_Q + SZ_Q, SZ_KV = (size_t)T * 2048 * 2;
constexpr size_t WS_EW = WS_KV + SZ_KV, SZ_TK2 = (size_t)T * 1024 * 2;
constexpr size_t WS_ICLR = WS_EW + 2 * SZ_TK2;
constexpr size_t WS_KK = WS_ICLR + 2 * SZ_TK2;
constexpr size_t WS_GG = WS_KK + SZ_TK2;
constexpr size_t WS_YRW = WS_GG + SZ_TK2;
constexpr size_t WS_ALORA = WS_YRW + 2 * SZ_TK2, SZ_ALORA = (size_t)T * 512 * 2;
constexpr size_t WS_KPE = WS_ALORA + SZ_ALORA, SZ_KPE = (size_t)T * 64 * 2;
constexpr size_t WS_RS = WS_KPE + SZ_KPE, SZ_RS = AL((size_t)T * 2 * 4);
constexpr size_t WS_DT = WS_RS + SZ_RS, SZ_DT = (size_t)T * 32 * 4;
constexpr size_t WS_VT = WS_DT + SZ_DT, SZ_VT = (size_t)1024 * 2 * SEQ * 4;
constexpr size_t WS_VC = WS_VT + SZ_VT, SZ_VC = (size_t)TC * 1024 * 4;
constexpr size_t WS_FILT = WS_VC + SZ_VC, SZ_FILT = (size_t)1024 * 2 * SEQ * 2;
constexpr size_t WS_FILTC = WS_FILT + SZ_FILT, SZ_FILTC = (size_t)CTX * 2048 * 4;
constexpr size_t WS_HDN = WS_FILTC + SZ_FILTC, SZ_HDN1 = (size_t)(SEQ + CTX) * 64 * 4, SZ_HDN = DEPTH * SZ_HDN1;
constexpr int NCHUNK = T / 128;
constexpr size_t WS_MST = WS_HDN + SZ_HDN, SZ_MST = (size_t)2 * NCHUNK * 16 * 8192 * 2;
constexpr size_t WS_MCS = WS_MST + SZ_MST, SZ_MCS = (size_t)2 * NCHUNK * 16 * 4 * 2;
constexpr size_t WS_Y = WS_MCS + AL(SZ_MCS), SZ_Y = (size_t)4 * T * 1024 * 2;
constexpr size_t WS_AFF = WS_Y + SZ_Y, SZ_AFF = (size_t)T * 16 * 4;
constexpr size_t WS_INV = WS_AFF + SZ_AFF, SZ_INV = (size_t)T * 16 * 4;
constexpr size_t WS_PTOK = WS_INV + SZ_INV, SZ_PTOK = (size_t)NPAIR * 4;
constexpr size_t WS_PGATE = WS_PTOK + SZ_PTOK, SZ_PGATE = (size_t)NPAIR * 4;
constexpr size_t WS_H8 = WS_PGATE + SZ_PGATE, SZ_H8 = (size_t)T * DM;
constexpr size_t WS_END = WS_H8 + SZ_H8;
constexpr size_t WS_GATES = WS_P, SZ_GATES = (size_t)T * NGATE * 2;
constexpr size_t WS_MRGF = WS_P2, SZ_MRGF = (size_t)T * DM * 4;
constexpr size_t WS_MRGB = WS_Q, SZ_MRGB = (size_t)T * DM * 2;
constexpr size_t WS_YMIX = WS_P, SZ_YMIX = (size_t)T * DM * 4;
constexpr size_t WS_H2 = WS_H;
constexpr size_t WS_WE = WS_P2, SZ_WGU = (size_t)NEXP * 2816 * DM * 2, SZ_WD = (size_t)NEXP * DM * EFF * 2;
constexpr size_t WS_XG = WS_P, SZ_XG = (size_t)NPAIR * DM * 2;
constexpr size_t WS_HID = WS_XG + SZ_XG, SZ_HID = (size_t)NPAIR * EFF * 2;
constexpr size_t WS_YE = WS_WE + SZ_WGU + SZ_WD, SZ_YE = (size_t)NPAIR * DM * 2;
static_assert(SZ_GATES <= SZ_P && SZ_MRGF <= SZ_P2 && SZ_MRGB <= SZ_Q + SZ_KV && SZ_YMIX <= SZ_P, "alias map 1");
static_assert(SZ_XG + SZ_HID <= SZ_P, "alias map 2");
static_assert(WS_YE + SZ_YE <= WS_VT, "alias map 3");
static_assert(WS_END < 1800000000ull, "workspace budget");

__device__ __forceinline__ unsigned f2bf(float f) { unsigned u = __builtin_bit_cast(unsigned, f); return (u + 0x7fffu + ((u >> 16) & 1u)) >> 16; }
__device__ __forceinline__ unsigned pk2(float lo, float hi) { return f2bf(lo) | (f2bf(hi) << 16); }
__device__ __forceinline__ float bf2f(unsigned short b) { return __builtin_bit_cast(float, (unsigned)b << 16); }
__device__ __forceinline__ float bflo(unsigned w) { return __builtin_bit_cast(float, w << 16); }
__device__ __forceinline__ float bfhi(unsigned w) { return __builtin_bit_cast(float, w & 0xffff0000u); }
__device__ __forceinline__ unsigned cvt_pk_bf16(float lo, float hi) { unsigned r; asm volatile("v_cvt_pk_bf16_f32 %0, %1, %2" : "=v"(r) : "v"(lo), "v"(hi)); return r; }
__device__ __forceinline__ float dppx(float x, const int sel) {
    const int xi = __builtin_bit_cast(int, x); int r;
    if (sel == 0) r = __builtin_amdgcn_update_dpp(0, xi, 0xB1, 0xF, 0xF, false);
    else if (sel == 1) r = __builtin_amdgcn_update_dpp(0, xi, 0x4E, 0xF, 0xF, false);
    else if (sel == 2) r = __builtin_amdgcn_update_dpp(0, xi, 0x141, 0xF, 0xF, false);
    else r = __builtin_amdgcn_update_dpp(0, xi, 0x140, 0xF, 0xF, false);
    return __builtin_bit_cast(float, r);
}
__device__ __forceinline__ float swz16(float x) { return __builtin_bit_cast(float, __builtin_amdgcn_ds_swizzle(__builtin_bit_cast(int, x), 0x401F)); }
__device__ __forceinline__ float sum4(float v) { v += dppx(v, 0); v += dppx(v, 1); return v; }
__device__ __forceinline__ float sum8(float v) { v = sum4(v); v += dppx(v, 2); return v; }
__device__ __forceinline__ float sum16(float v) { v = sum8(v); v += dppx(v, 3); return v; }
__device__ __forceinline__ float sum32(float v) { v = sum16(v); v += swz16(v); return v; }
__device__ __forceinline__ unsigned pk4fp8(float a, float b, float c, float d) { int w = 0; w = __builtin_amdgcn_cvt_pk_fp8_f32(a, b, w, false); w = __builtin_amdgcn_cvt_pk_fp8_f32(c, d, w, true); return (unsigned)w; }
__device__ __forceinline__ float wave_sum(float v) {
    v = sum32(v);
    auto rr = __builtin_amdgcn_permlane32_swap(__float_as_uint(v), __float_as_uint(v), false, false);
    return __uint_as_float(rr[0]) + __uint_as_float(rr[1]);
}
__device__ __forceinline__ float sigmoidf_(float x) { return 1.f / (1.f + __expf(-x)); }
__device__ __forceinline__ float siluf_(float x) { return x / (1.f + __expf(-x)); }
__device__ __forceinline__ float softplusf_(float x) { return x > 20.f ? x : __logf(1.f + __expf(x)); }
__device__ __forceinline__ float tanhf_(float x) { const float e = __expf(2.f * fminf(x, 15.f)); return 1.f - 2.f / (e + 1.f); }
#define LDS_WAIT() asm volatile("s_waitcnt lgkmcnt(0)" ::: "memory")
#define VM_WAIT() asm volatile("s_waitcnt vmcnt(0)" ::: "memory")

#define XB_TMO      128
#define XB_XCNT(j)  (256  + 64 * (j))
#define XB_XSUB(j)  (1280 + 64 * (j))
#define XB_XGEN(j)  (2304 + 64 * (j))
#define XB_TOP      3328
#define XB_TOPGEN   3392
#define XCD_BAR_WORDS 3456
#define XB_SPIN_CAP (1u << 18)
__device__ __forceinline__ unsigned xb_ld(unsigned* p)              { return __hip_atomic_load(p, __ATOMIC_RELAXED, __HIP_MEMORY_SCOPE_AGENT); }
__device__ __forceinline__ unsigned xb_add(unsigned* p, unsigned v) { return __hip_atomic_fetch_add(p, v, __ATOMIC_RELAXED, __HIP_MEMORY_SCOPE_AGENT); }
__device__ __forceinline__ unsigned xb_xcc_id() { return (unsigned)__builtin_amdgcn_s_getreg((3 << 11) | 20) & 0xFu; }
#define XB_SPIN(cond, bar) do { unsigned _sp = 0; while (cond) { __builtin_amdgcn_s_sleep(1); \
    if ((++_sp & 255u) == 0u) { if (xb_ld(&(bar)[XB_TMO])) break; if (_sp > XB_SPIN_CAP) { atomicAdd(&(bar)[XB_TMO], 1u); break; } } } } while (0)
struct XcdBarrier { unsigned* bar; unsigned x; volatile LAS unsigned* st; };
__device__ __forceinline__ XcdBarrier xcd_barrier_post(unsigned* bar, volatile LAS unsigned* st) {
    XcdBarrier b; b.bar = bar; b.x = xb_xcc_id(); b.st = st;
    if (threadIdx.x == 0) (void)xb_add(&bar[XB_XCNT(b.x)], 1u);
    return b;
}
__device__ __forceinline__ void xcd_barrier_complete(unsigned* bar, unsigned x, unsigned& nloc, unsigned& nx) {
    const unsigned G = gridDim.x * gridDim.y * gridDim.z;
    unsigned sum, cnt, mine, sp = 0u;
    for (;;) {
        sum = 0u; cnt = 0u; mine = 0u;
#pragma unroll
        for (unsigned j = 0; j < 16; ++j) { const unsigned c = xb_ld(&bar[XB_XCNT(j)]); sum += c; cnt += (c > 0u) ? 1u : 0u; mine = (j == x) ? c : mine; }
        if (sum == G) break;
        __builtin_amdgcn_s_sleep(1);
        if ((++sp & 255u) == 0u) { if (xb_ld(&bar[XB_TMO])) break; if (sp > XB_SPIN_CAP) { atomicAdd(&bar[XB_TMO], 1u); break; } }
    }
    nloc = mine > 0u ? mine : 1u; nx = cnt > 0u ? cnt : 1u;
}
__device__ __forceinline__ void xcd_barrier(const XcdBarrier& b) {
    asm volatile("s_waitcnt vmcnt(0)" ::: "memory");
    __syncthreads();
    if (threadIdx.x == 0) {
        unsigned* bar = b.bar;
        __builtin_amdgcn_s_waitcnt(0);
        unsigned nloc = b.st[0], nx = b.st[1];
        if (nloc == 0u) { xcd_barrier_complete(bar, b.x, nloc, nx); b.st[0] = nloc; b.st[1] = nx; }
        const unsigned old = xb_add(&bar[XB_XSUB(b.x)], 1u);
        const unsigned gen = old / nloc;
        if (old + 1u == (gen + 1u) * nloc) {
            __builtin_amdgcn_fence(__ATOMIC_RELEASE, "agent");
            asm volatile("s_waitcnt vmcnt(0)" ::: "memory");
            const unsigned og = xb_add(&bar[XB_TOP], 1u);
            const unsigned tg = og / nx;
            if (og + 1u == (tg + 1u) * nx) xb_add(&bar[XB_TOPGEN], 1u);
            else XB_SPIN(xb_ld(&bar[XB_TOPGEN]) == tg, bar);
            __builtin_amdgcn_fence(__ATOMIC_ACQUIRE, "agent");
            xb_add(&bar[XB_XGEN(b.x)], 1u);
            asm volatile("s_waitcnt vmcnt(0)" ::: "memory");
        } else {
            XB_SPIN(xb_ld(&bar[XB_XGEN(b.x)]) == gen, bar);
            __builtin_amdgcn_fence(__ATOMIC_ACQUIRE, "agent");
            asm volatile("s_waitcnt vmcnt(0)" ::: "memory");
        }
    }
    __syncthreads();
}

__device__ __forceinline__ int lane_asm() { int l; asm volatile("v_mbcnt_lo_u32_b32 %0, -1, 0\n\tv_mbcnt_hi_u32_b32 %0, -1, %0" : "=v"(l)); return l; }
namespace pg8 {
constexpr int BM = 256, BK = 64, HALF = 128, HTB = HALF * BK * 2, STAGE_BYTES = 8 * HTB, NXCD = 8, WGM = 8;
__host__ __device__ __forceinline__ int lds_byte(int r, int c) { const int st = (r >> 4) * 2 + (c >> 5), rr = r & 15, cc = c & 31, ob = rr * 64 + cc * 2; return st * 1024 + (ob ^ (((ob >> 9) & 1) << 5)); }
__host__ __device__ __forceinline__ void stage_rc(int b, int& R, int& C) { const int st = b / 1024, sb = b % 1024, swz = sb ^ (((sb >> 9) & 1) << 5); R = (st >> 1) * 16 + swz / 64; C = (st & 1) * 32 + (swz % 64) / 2; }
__host__ __device__ __forceinline__ int perm32(int rho) { const int n = rho >> 4, i = rho & 15; return 8 * (i >> 2) + 4 * n + (i & 3); }
struct Unit { int pm, pn; };
struct Gemm { const bf16_t* A; const bf16_t* Bt; int lda, ldb, K; };
struct StaticOrder {
    int nM, nN, nwg, G, c, pm0;
    __device__ void init(int nM_, int nN_, int G_, int c_, int pm0_ = 0) { nM = nM_; nN = nN_; nwg = nM * nN; G = G_; c = c_; pm0 = pm0_; }
    __device__ bool next(int i, Unit& u) const {
        const long L = (long)i * G + c; if (L >= nwg) return false;
        int wgid = (int)L; { const int q = nwg / NXCD, r = nwg % NXCD, xcd = wgid % NXCD, off = wgid / NXCD; wgid = (xcd < r ? xcd * (q + 1) : r * (q + 1) + (xcd - r) * q) + off; }
        const int nig = WGM * nN, gid = wgid / nig, fm = gid * WGM, gsz = (nM - fm) < WGM ? (nM - fm) : WGM;
        u.pm = pm0 + fm + ((wgid % nig) % gsz); u.pn = (wgid % nig) / gsz; return true;
    }
};
typedef int i32x4v __attribute__((ext_vector_type(4)));
typedef int i32x8v __attribute__((ext_vector_type(8)));
__device__ __forceinline__ i32x8v cat8(bf16x8 a, bf16x8 b) { return __builtin_shufflevector(__builtin_bit_cast(i32x4v, a), __builtin_bit_cast(i32x4v, b), 0, 1, 2, 3, 4, 5, 6, 7); }
template <class Epi, class Sched, bool FP8 = false>
__device__ __forceinline__ void gemm_phase(LAS unsigned char* lds, const Gemm g, const Sched& S, const Epi& E, int tid_in) {
    constexpr bool ALIGN_EPI = true;
    const unsigned tid_u = (unsigned)tid_in; __builtin_assume(tid_u < 512u);
    const int tid = (int)tid_u, wid = __builtin_amdgcn_readfirstlane(tid >> 6), lane = tid & 63, wr = wid >> 2, wc = wid & 3, fr = lane & 15, fq = lane >> 4;
    const int K = g.K, nt = K / BK;
    unsigned voffA[2], voffB[2];
#pragma unroll
    for (int i = 0; i < 2; ++i) { int R, C; stage_rc(tid * 16 + i * 8192, R, C); const int Rb = Epi::PERM ? ((R & ~31) + perm32(R & 31)) : R;
        voffA[i] = (unsigned)(R * g.lda + C) * 2u; voffB[i] = (unsigned)(Rb * g.ldb + C) * 2u; }
    const unsigned kstep = (unsigned)(BK * 2);
    const unsigned hstepA = (unsigned)HALF * g.lda * 2u, hstepB = (unsigned)HALF * g.ldb * 2u;
    const unsigned tstepA = 2u * hstepA, tstepB = 2u * hstepB;
    const unsigned ldsw = (unsigned)wid * 1024u;
    const int aoff = lds_byte(wr * 64 + fr, fq * 8), boff = lds_byte(wc * 32 + fr, fq * 8);
    const __amdgpu_buffer_rsrc_t rsA = __builtin_amdgcn_make_buffer_rsrc((void*)g.A, 0, 0xFFFFFFFFu, 0x00020000);
    const __amdgpu_buffer_rsrc_t rsB = __builtin_amdgcn_make_buffer_rsrc((void*)g.Bt, 0, 0xFFFFFFFFu, 0x00020000);
#define PG8_SA(b, h) (((b) * 2 + (h)) * HTB)
#define PG8_SB(b, h) ((4 + (b) * 2 + (h)) * HTB)
#define PG8_STAGE(bufoff, rs, soff, voff) do { _Pragma("unroll") for (int _i = 0; _i < 2; ++_i) \
        __builtin_amdgcn_raw_ptr_buffer_load_lds(rs, (LAS unsigned*)(lds + (bufoff) + ldsw + _i * 8192), 16, (int)(voff)[_i], (int)(soff), 0, 0); } while (0)
#define PG8_LDA(dst, b, h) do { if constexpr (FP8) { _Pragma("unroll") for (int m = 0; m < 4; ++m) dst##8[m] = __builtin_shufflevector(*(const LAS i32x4v*)(lds + PG8_SA(b, h) + aoff + m * 2048), *(const LAS i32x4v*)(lds + PG8_SA(b, h) + aoff + m * 2048 + 1024), 0, 1, 2, 3, 4, 5, 6, 7); } \
    else { _Pragma("unroll") for (int m = 0; m < 4; ++m) _Pragma("unroll") for (int k = 0; k < 2; ++k) dst[m][k] = *(const LAS bf16x8*)(lds + PG8_SA(b, h) + aoff + m * 2048 + k * 1024); } } while (0)
#define PG8_LDB(dst, b, h) do { if constexpr (FP8) { _Pragma("unroll") for (int n = 0; n < 2; ++n) dst##8[n] = __builtin_shufflevector(*(const LAS i32x4v*)(lds + PG8_SB(b, h) + boff + n * 2048), *(const LAS i32x4v*)(lds + PG8_SB(b, h) + boff + n * 2048 + 1024), 0, 1, 2, 3, 4, 5, 6, 7); } \
    else { _Pragma("unroll") for (int n = 0; n < 2; ++n) _Pragma("unroll") for (int k = 0; k < 2; ++k) dst[n][k] = *(const LAS bf16x8*)(lds + PG8_SB(b, h) + boff + n * 2048 + k * 1024); } } while (0)
#define PG8_MMA(ai, bj, At, Bt) do { __builtin_amdgcn_s_setprio(1); if constexpr (FP8) { _Pragma("unroll") for (int m = 0; m < 4; ++m) _Pragma("unroll") for (int n = 0; n < 2; ++n) \
        asm volatile("v_mfma_scale_f32_16x16x128_f8f6f4 %0, %1, %2, %0, %3, %3 op_sel_hi:[0,0,0]" : "+v"(acc[ai][bj][m][n]) : "v"(Bt##8[n]), "v"(At##8[m]), "v"(sc1)); } else { \
        _Pragma("unroll") for (int m = 0; m < 4; ++m) _Pragma("unroll") for (int n = 0; n < 2; ++n) _Pragma("unroll") for (int k = 0; k < 2; ++k) \
        acc[ai][bj][m][n] = __builtin_amdgcn_mfma_f32_16x16x32_bf16(Bt[n][k], At[m][k], acc[ai][bj][m][n], 0, 0, 0); } __builtin_amdgcn_s_setprio(0); } while (0)
#define PG8_WAIT_V(n) asm volatile("s_waitcnt vmcnt(" #n ")" ::: "memory")
#define PG8_WAIT_L(n) asm volatile("s_waitcnt lgkmcnt(" #n ")" ::: "memory")
#define PG8_BAR __builtin_amdgcn_s_barrier()
#define PG8_SCHED __builtin_amdgcn_sched_barrier(0)
    Unit cur, nxt; int ui = 0;
    if (!S.next(0, cur)) return;
    f32x4 acc[2][2][4][2];
#pragma unroll
    for (int a = 0; a < 2; ++a)
#pragma unroll
        for (int b = 0; b < 2; ++b)
#pragma unroll
            for (int m = 0; m < 4; ++m)
#pragma unroll
                for (int n = 0; n < 2; ++n) acc[a][b][m][n] = (f32x4){0.f, 0.f, 0.f, 0.f};
    i32x8v At8[4], B08[2], B18[2]; bf16x8 At[4][2], B0[2][2], B1[2][2];
    const int sc1 = 0x7F7F7F7F;
    unsigned cA = (unsigned)cur.pm * tstepA, cB = (unsigned)cur.pn * tstepB;
    PG8_STAGE(PG8_SB(0, 0), rsB, cB, voffB); PG8_STAGE(PG8_SB(0, 1), rsB, cB + hstepB, voffB); PG8_STAGE(PG8_SA(0, 0), rsA, cA, voffA); PG8_STAGE(PG8_SA(0, 1), rsA, cA + hstepA, voffA);
    if (wr == 1) PG8_BAR;
    PG8_WAIT_V(2); PG8_BAR;
    PG8_STAGE(PG8_SB(1, 0), rsB, cB + kstep, voffB); PG8_STAGE(PG8_SA(1, 0), rsA, cA + kstep, voffA); PG8_STAGE(PG8_SB(1, 1), rsB, cB + hstepB + kstep, voffB);
    PG8_WAIT_V(6); PG8_BAR;
    for (;;) {
        const bool has_next = S.next(ui + 1, nxt);
        const unsigned nA = has_next ? (unsigned)nxt.pm * tstepA : cA; const unsigned nB = has_next ? (unsigned)nxt.pn * tstepB : cB;
        for (int t = 0; t < nt; t += 2) {
            const bool last = (t == nt - 2);
            const unsigned a1 = cA + (unsigned)(t + 1) * kstep;
            const unsigned a2 = last ? nA : cA + (unsigned)(t + 2) * kstep; const unsigned b2 = last ? nB : cB + (unsigned)(t + 2) * kstep;
            const unsigned a3 = a2 + kstep; const unsigned b3 = b2 + kstep;
            PG8_LDB(B0, 0, 0); PG8_LDB(B1, 0, 1); PG8_SCHED; PG8_LDA(At, 0, 0); PG8_STAGE(PG8_SA(1, 1), rsA, a1 + hstepA, voffA);
            PG8_WAIT_V(8); PG8_WAIT_L(0); PG8_BAR; PG8_MMA(0, 0, At, B0); PG8_MMA(0, 1, At, B1); PG8_BAR; PG8_SCHED;
            PG8_LDA(At, 0, 1); PG8_STAGE(PG8_SB(0, 0), rsB, b2, voffB); PG8_STAGE(PG8_SB(0, 1), rsB, b2 + hstepB, voffB); PG8_STAGE(PG8_SA(0, 0), rsA, a2, voffA);
            PG8_WAIT_V(8); PG8_WAIT_L(0); PG8_BAR; PG8_MMA(1, 0, At, B0); PG8_MMA(1, 1, At, B1); PG8_BAR; PG8_SCHED;
            PG8_LDB(B0, 1, 0); PG8_LDB(B1, 1, 1); PG8_SCHED; PG8_LDA(At, 1, 0); PG8_STAGE(PG8_SA(0, 1), rsA, a2 + hstepA, voffA);
            PG8_WAIT_V(8); PG8_WAIT_L(0); PG8_BAR; PG8_MMA(0, 0, At, B0); PG8_MMA(0, 1, At, B1); PG8_BAR; PG8_SCHED;
            PG8_LDA(At, 1, 1); PG8_STAGE(PG8_SB(1, 0), rsB, b3, voffB); PG8_STAGE(PG8_SB(1, 1), rsB, b3 + hstepB, voffB); PG8_STAGE(PG8_SA(1, 0), rsA, a3, voffA);
            PG8_WAIT_V(8); PG8_WAIT_L(0); PG8_BAR; PG8_MMA(1, 0, At, B0); PG8_MMA(1, 1, At, B1); PG8_BAR; PG8_SCHED;
        }
        if constexpr (FP8) asm volatile("s_nop 15\n\ts_nop 7" ::: "memory");
        if constexpr (ALIGN_EPI) { if (wr == 0) PG8_BAR; }
        bool keep_acc = false;
        { const int l2 = lane_asm() & 63; if constexpr (Epi::KEEPS) keep_acc = E(acc, cur, wr, wc, l2 & 15, l2 >> 4); else E(acc, cur, wr, wc, l2 & 15, l2 >> 4); }
        if (!has_next) break;
        if (!keep_acc) {
#pragma unroll
        for (int a = 0; a < 2; ++a)
#pragma unroll
            for (int b = 0; b < 2; ++b)
#pragma unroll
                for (int m = 0; m < 4; ++m)
#pragma unroll
                    for (int n = 0; n < 2; ++n) acc[a][b][m][n] = (f32x4){0.f, 0.f, 0.f, 0.f};
        }
        cur = nxt; cA = nA; cB = nB; ++ui;
        if constexpr (ALIGN_EPI) { if (wr == 1) PG8_BAR; }
    }
    PG8_WAIT_V(0);
    if constexpr (!ALIGN_EPI) { if (wr == 0) PG8_BAR; }
    PG8_BAR;
#undef PG8_SA
#undef PG8_SB
#undef PG8_STAGE
#undef PG8_LDA
#undef PG8_LDB
#undef PG8_MMA
#undef PG8_WAIT_V
#undef PG8_WAIT_L
#undef PG8_BAR
#undef PG8_SCHED
}
}

enum { I_X = 0, I_C, I_CTX, I_CCTX, I_WADA, I_BADA, I_WIN, I_QNORM, I_WQUP, I_KVNORM, I_WKVUP, I_SCONVW, I_SCONVB, I_SDTB, I_SALOG, I_SD, I_SNORM,
       I_HCONVW, I_HCONVB, I_HW1, I_HB1, I_HW2, I_HB2, I_HW3, I_HFREQ, I_HD, I_RMU, I_RW0, I_RWUP, I_RA0, I_RAUP, I_RGUP, I_RKK, I_RKA, I_RRK, I_RLNG, I_RLNB,
       I_WBR, I_WOUT, I_LN1G, I_LN1B, I_WROUTER, I_WGATE, I_WUP, I_WDOWN, I_LN2G, I_LN2B, N_INPUTS };
struct Args { const float* in[N_INPUTS]; float* out; unsigned char* ws; int ph_lo, ph_hi; };
static_assert(sizeof(Args) == (N_INPUTS + 2) * 8 + 8, "Args has no padding");

__device__ __forceinline__ const float* arg_in(const Args& a, int i) { asm volatile("" : "+s"(i)); return a.in[i]; }
__device__ __forceinline__ int opqs(int v) { asm volatile("" : "+s"(v)); return v; }
__device__ __forceinline__ int opqv(int v) { asm volatile("" : "+v"(v)); return v; }
__device__ __forceinline__ unsigned char* opq(unsigned char* p) { asm volatile("" : "+s"(p)); return p; }
struct Frame {
    LAS unsigned char* lds;
    int tid, lane, wave, G, bid, gw, NGW;
    unsigned char* ws;
};
#define WSP(T_, off) ((T_*)(F.ws + (off)))

struct RmId { __device__ int operator()(int n) const { return n; } };
struct RmGateUp { int up; __device__ int operator()(int n) const { return 256 * (n >> 7) + (n & 127) + (up ? 128 : 0); } };
constexpr int TR_SCR = 64 * 65 * 4;
__device__ __forceinline__ void tr_load(const float* W, int ldw, int k0, int n0, const float* kscale, float sc, LAS float* scr, int lane) {
    float v[64];
    const float* wp = W + (size_t)k0 * ldw + n0 + lane;
#pragma unroll
    for (int i = 0; i < 64; ++i) v[i] = wp[(size_t)i * ldw];
#pragma unroll
    for (int i = 0; i < 64; ++i) { float x = v[i] * sc; if (kscale) x *= kscale[k0 + i]; scr[i * 65 + lane] = x; }
    LDS_WAIT(); asm volatile("" ::: "memory");
}
template <class RowMap>
__device__ __forceinline__ void transpose_item(const float* W, int ldw, bf16_t* WT, int ldt, int k0, int n0, const float* kscale, RowMap rm, LAS float* scr, int lane) {
    tr_load(W, ldw, k0, n0, kscale, 1.f, scr, lane);
    const int c = lane & 7;
#pragma unroll
    for (int j = 0; j < 8; ++j) { const int n = (lane >> 3) + 8 * j; const LAS float* s = scr + (8 * c) * 65 + n;
        u32x4 o; o.x = pk2(s[0 * 65], s[1 * 65]); o.y = pk2(s[2 * 65], s[3 * 65]); o.z = pk2(s[4 * 65], s[5 * 65]); o.w = pk2(s[6 * 65], s[7 * 65]);
        *(u32x4*)(WT + (size_t)rm(n0 + n) * ldt + k0 + 8 * c) = o; }
    LDS_WAIT(); asm volatile("" ::: "memory");
}
template <class RowMap>
__device__ __forceinline__ void transpose_item_fp8(const float* W, int ldw, unsigned char* WT, int ldt, int k0, int n0, float sc, RowMap rm, LAS float* scr, int lane) {
    tr_load(W, ldw, k0, n0, nullptr, sc, scr, lane);
    const int c = lane & 3;
#pragma unroll
    for (int j = 0; j < 4; ++j) { const int n = (lane >> 2) + 16 * j; const LAS float* s = scr + (16 * c) * 65 + n;
        u32x4 o; o.x = pk4fp8(s[0 * 65], s[1 * 65], s[2 * 65], s[3 * 65]); o.y = pk4fp8(s[4 * 65], s[5 * 65], s[6 * 65], s[7 * 65]);
        o.z = pk4fp8(s[8 * 65], s[9 * 65], s[10 * 65], s[11 * 65]); o.w = pk4fp8(s[12 * 65], s[13 * 65], s[14 * 65], s[15 * 65]);
        *(u32x4*)(WT + (size_t)rm(n0 + n) * ldt + k0 + 16 * c) = o; }
    LDS_WAIT(); asm volatile("" ::: "memory");
}

__device__ __forceinline__ void p0_weights(Frame& F, const Args& a) {
    LAS float* scr = (LAS float*)(F.lds + F.wave * TR_SCR);
    constexpr int IT_IN = 32 * 288, IT_BR = 16 * 32, IT_OUT = 32 * 32, IT_Q = 8 * 24, IT_KV = 8 * 32;
    constexpr int PER_L = IT_IN + 4 * IT_BR + IT_OUT + IT_Q + IT_KV;
    for (int it = F.gw; it < DEPTH * PER_L; it += F.NGW) {
        const int l = it / PER_L; int r = it % PER_L;
        if (r < IT_IN) { const int kb = r / 288, nb = r % 288;
            if (nb * 64 < NNG) transpose_item(arg_in(a, I_WIN) + (size_t)l * DM * NIN, NIN, WSP(bf16_t, WS_WIN + l * SZ_WIN), DM, kb * 64, nb * 64, nullptr, RmId(), scr, F.lane);
            else transpose_item_fp8(arg_in(a, I_WIN) + (size_t)l * DM * NIN + NNG, NIN, WSP(unsigned char, WS_WIN + l * SZ_WIN) + (size_t)NNG * DM * 2, DM, kb * 64, nb * 64 - NNG, 64.f, RmId(), scr, F.lane);
            continue; } r -= IT_IN;
        if (r < 4 * IT_BR) { const int br = r / IT_BR, q = r % IT_BR, kb = q / 32, nb = q % 32;
            transpose_item(arg_in(a, I_WBR) + ((size_t)l * 4 + br) * 1024 * DM, DM, WSP(bf16_t, WS_WBR + l * SZ_WBR) + (size_t)br * DM * 1024, 1024, kb * 64, nb * 64, nullptr, RmId(), scr, F.lane); continue; } r -= 4 * IT_BR;
        if (r < IT_OUT) { const int kb = r / 32, nb = r % 32;
            transpose_item(arg_in(a, I_WOUT) + (size_t)l * DM * DM, DM, WSP(bf16_t, WS_WOUT + l * SZ_WOUT), DM, kb * 64, nb * 64, nullptr, RmId(), scr, F.lane); continue; } r -= IT_OUT;
        if (r < IT_Q) { const int kb = r / 24, nb = r % 24;
            transpose_item(arg_in(a, I_WQUP) + (size_t)l * 512 * 1536, 1536, WSP(bf16_t, WS_WQ + l * SZ_WQ), 512, kb * 64, nb * 64, arg_in(a, I_QNORM) + l * 512, RmId(), scr, F.lane); continue; } r -= IT_Q;
        { const int kb = r / 32, nb = r % 32;
            transpose_item(arg_in(a, I_WKVUP) + (size_t)l * 512 * 2048, 2048, WSP(bf16_t, WS_WKV + l * SZ_WKV), 512, kb * 64, nb * 64, arg_in(a, I_KVNORM) + l * 512, RmId(), scr, F.lane); }
    }
    for (size_t e = (size_t)F.bid * NTHREADS + F.tid; e < (size_t)DEPTH * 5120 * 512; e += (size_t)F.G * NTHREADS) {
        const int l = (int)(e / (5120 * 512)); const int rem = (int)(e % (5120 * 512)); const int n = rem / 512, kc = rem % 512; const int blk = n >> 10, c = n & 1023;
        float v = 0.f;
        if (blk < 2) { if (kc >= 64 * blk && kc < 64 * blk + 64) v = arg_in(a, I_RWUP)[(((size_t)l * 2 + blk) * 64 + (kc - 64 * blk)) * 1024 + c]; }
        else if (blk < 4) { const int d = blk - 2; if (kc >= 128 + 64 * d && kc < 192 + 64 * d) v = arg_in(a, I_RAUP)[(((size_t)l * 2 + d) * 64 + (kc - 128 - 64 * d)) * 1024 + c]; }
        else { if (kc >= 256 && kc < 416) v = arg_in(a, I_RGUP)[((size_t)l * 160 + (kc - 256)) * 1024 + c]; }
        WSP(bf16_t, WS_WLORA)[e] = (bf16_t)f2bf(v);
    }
}
constexpr int EFFP = 1536;
constexpr size_t SZ_WGU8 = (size_t)NEXP * 2816 * DM, SZ_WD8 = (size_t)NEXP * DM * EFFP;
__device__ __forceinline__ void conv_experts(Frame& F, const Args& a, int l) {
    LAS float* scr = (LAS float*)(F.lds + F.wave * TR_SCR);
    constexpr int IT_G = 32 * 22, IT_D = 22 * 32, PER_E = 2 * IT_G + IT_D;
    unsigned char* wgu = WSP(unsigned char, WS_WE); unsigned char* wd = WSP(unsigned char, WS_WE + SZ_WGU8);
    for (int it = F.gw; it < NEXP * PER_E; it += F.NGW) {
        const int e = it / PER_E; int r = it % PER_E;
        if (r < 2 * IT_G) { const int up = r / IT_G, q = r % IT_G, kb = q / 22, nb = q % 22;
            const float* src = arg_in(a, up ? I_WUP : I_WGATE) + ((size_t)l * NEXP + e) * DM * EFF;
            RmGateUp rm; rm.up = up;
            transpose_item_fp8(src, EFF, wgu + (size_t)e * 2816 * DM, DM, kb * 64, nb * 64, 64.f, rm, scr, F.lane); continue; } r -= 2 * IT_G;
        { const int kb = r / 32, nb = r % 32;
            transpose_item_fp8(arg_in(a, I_WDOWN) + ((size_t)l * NEXP + e) * EFF * DM, DM, wd + (size_t)e * DM * EFFP, EFFP, kb * 64, nb * 64, 64.f, RmId(), scr, F.lane); }
    }
    for (int i = F.bid * NTHREADS + F.tid; i < NEXP * DM * 8; i += F.G * NTHREADS) { const int rowi = i >> 3, q = i & 7; unsigned zz = 0u; asm volatile("" : "+v"(zz));
        *(u32x4*)(wd + (size_t)rowi * EFFP + EFF + q * 16) = (u32x4){zz, zz, zz, zz}; }
}
__device__ __forceinline__ void p0_mod(Frame& F, const Args& a) {
    LAS float* sv = (LAS float*)(F.lds + 69632);
    for (int i = F.tid; i < 3 * DM; i += NTHREADS) { const int v = i / DM, k = i % DM; const float x = v < 2 ? arg_in(a, I_C)[v * DM + k] : arg_in(a, I_CCTX)[k]; sv[i] = siluf_(x); }
    __syncthreads();
    float* mod = (float*)(F.ws + WS_CTL) + CW_MOD;
    LAS float* red = (LAS float*)(F.lds + 69632 + 3 * DM * 4);
    for (int u = F.bid; u < DEPTH * (6 * DM / 128); u += F.G) {
        const int l = u / (6 * DM / 128), nb = u % (6 * DM / 128); const int kg = F.tid >> 7, cl = F.tid & 127, n = nb * 128 + cl;
        const float* w = arg_in(a, I_WADA) + ((size_t)l * DM + kg * 512) * (6 * DM) + n;
        float a0 = 0.f, a1 = 0.f, a2 = 0.f;
#pragma unroll 32
        for (int k = 0; k < 512; ++k) { const float wv = w[(size_t)k * (6 * DM)]; const int kk = kg * 512 + k; a0 += sv[kk] * wv; a1 += sv[DM + kk] * wv; a2 += sv[2 * DM + kk] * wv; }
        __syncthreads();
        red[(kg * 3 + 0) * 128 + cl] = a0; red[(kg * 3 + 1) * 128 + cl] = a1; red[(kg * 3 + 2) * 128 + cl] = a2;
        __syncthreads();
        if (F.tid < 384) { const int v = F.tid >> 7; const float b = arg_in(a, I_BADA)[l * 6 * DM + n];
            mod[(l * 3 + v) * 6 * DM + n] = b + ((red[(0 * 3 + v) * 128 + cl] + red[(1 * 3 + v) * 128 + cl]) + (red[(2 * 3 + v) * 128 + cl] + red[(3 * 3 + v) * 128 + cl])); }
    }
}

__device__ __forceinline__ void row_stats(const f32x4 (&v)[8], float& mean, float& rstd, float eps) {
    float s = 0.f;
#pragma unroll
    for (int j = 0; j < 8; ++j) s += (v[j].x + v[j].y) + (v[j].z + v[j].w);
    mean = wave_sum(s) * (1.f / DM);
    float s2 = 0.f;
#pragma unroll
    for (int j = 0; j < 8; ++j) { const f32x4 d = v[j] - mean; s2 += (d.x * d.x + d.y * d.y) + (d.z * d.z + d.w * d.w); }
    rstd = 1.f / sqrtf(wave_sum(s2) * (1.f / DM) + eps);
}
__device__ __forceinline__ const float* x_src_row(const Args& a, const Frame& F, int layer, int row) {
    if (layer == 0) return row < TC ? arg_in(a, I_CTX) + (size_t)row * DM : arg_in(a, I_X) + (size_t)(row - TC) * DM;
    return (const float*)(F.ws + WS_XS) + (size_t)row * DM;
}
__device__ __forceinline__ void phase_modln(Frame& F, const Args& a, int layer) {
    const float* mod = (const float*)(F.ws + WS_CTL) + CW_MOD + (size_t)layer * 3 * 6 * DM;
    bf16_t* H = WSP(bf16_t, WS_H); unsigned* H8 = WSP(unsigned, WS_H8);
    for (int row = F.gw; row < T; row += F.NGW) {
        const f32x4* xr = (const f32x4*)x_src_row(a, F, layer, row) + F.lane;
        f32x4 v[8];
#pragma unroll
        for (int j = 0; j < 8; ++j) v[j] = xr[64 * j];
        float mean, rstd; row_stats(v, mean, rstd, 1e-6f);
        const float* m = mod + (size_t)row_modidx(row) * 6 * DM;
        u32x2* o = (u32x2*)(H + (size_t)row * DM) + F.lane; unsigned* o8 = H8 + (size_t)row * (DM / 4) + F.lane;
#pragma unroll
        for (int j = 0; j < 8; ++j) { const int c = 4 * (64 * j + F.lane); const f32x4 sh = *(const f32x4*)(m + c), sc = *(const f32x4*)(m + DM + c);
            const f32x4 y = (v[j] - mean) * rstd * (sc + 1.f) + sh; u32x2 w; w.x = pk2(y.x, y.y); w.y = pk2(y.z, y.w); o[64 * j] = w; o8[64 * j] = pk4fp8(y.x, y.y, y.z, y.w); }
    }
}

__device__ __forceinline__ void phase_hdn(Frame& F, const Args& a, int layer) {
    LAS float* zs = (LAS float*)(F.lds + F.wave * 512);
    const float* w1 = arg_in(a, I_HW1) + (size_t)layer * 33 * 64; const float* b1 = arg_in(a, I_HB1) + layer * 64;
    const float* w2 = arg_in(a, I_HW2) + (size_t)layer * 64 * 64; const float* b2 = arg_in(a, I_HB2) + layer * 64;
    const float fr = arg_in(a, I_HFREQ)[layer * 64 + F.lane];
    float* HDN = WSP(float, WS_HDN + layer * SZ_HDN1);
    for (int r = F.gw; r < SEQ + CTX; r += F.NGW) {
        const int n = r < SEQ ? SEQ : CTX, t = r < SEQ ? r : r - SEQ;
        const float wpos = (6.283185307179586f * (float)t) / (float)n;
        if (F.lane < 33) { float z;
            if (F.lane == 0) z = (float)t / (float)(n - 1);
            else { const int b = (F.lane - 1) & 15; const float f = 1e-4f + (float)b * ((15.f - 1e-4f) / 15.f); const float ang = f * wpos; z = F.lane <= 16 ? __cosf(ang) : -__sinf(ang); }
            zs[F.lane] = z; }
        LDS_WAIT(); asm volatile("" ::: "memory");
        float p = b1[F.lane];
#pragma unroll
        for (int i = 0; i < 33; ++i) p += zs[i] * w1[i * 64 + F.lane];
        const float h1 = __sinf(fr * p);
        zs[64 + F.lane] = h1;
        LDS_WAIT(); asm volatile("" ::: "memory");
        float q = b2[F.lane];
#pragma unroll 16
        for (int i = 0; i < 64; ++i) q += zs[64 + i] * w2[i * 64 + F.lane];
        HDN[(size_t)r * 64 + F.lane] = __sinf(fr * q);
        LDS_WAIT(); asm volatile("" ::: "memory");
    }
}
__device__ __forceinline__ float hy_delta(int c) { const float mn = -3.0701134573253943f, mx = -15.350567286626972f; return fabsf(mn + (float)c * ((mx - mn) / 1023.f)); }
__device__ __forceinline__ void phase_filt(Frame& F, const Args& a, int layer) {
    const float* w3 = arg_in(a, I_HW3) + (size_t)layer * 64 * 2048; const float* HDN = WSP(float, WS_HDN + layer * SZ_HDN1);
    LAS float* ws3 = (LAS float*)F.lds;
    bf16_t* FILT = WSP(bf16_t, WS_FILT);
    for (int u = F.bid; u < 32 * 16; u += F.G) {
        const int cb = u / 16, tb = u % 16, col0 = cb * 64, t = tb * 512 + F.tid;
        __syncthreads();
        for (int i = F.tid; i < 4096; i += NTHREADS) { const int j = i >> 6, cc = i & 63; ws3[cc * 64 + j] = w3[(size_t)j * 2048 + col0 + cc]; }
        __syncthreads();
        f32x4 h[16];
#pragma unroll
        for (int i = 0; i < 16; ++i) h[i] = *(const f32x4*)(HDN + (size_t)t * 64 + 4 * i);
        const float tn = (float)t / (float)(SEQ - 1);
        for (int cc = 0; cc < 64; ++cc) {
            float acc = 0.f;
#pragma unroll
            for (int i = 0; i < 16; ++i) { const f32x4 w = *(const LAS f32x4*)(ws3 + cc * 64 + 4 * i); acc += h[i].x * w.x + h[i].y * w.y + h[i].z * w.z + h[i].w * w.w; }
            const int col = col0 + cc, side = col >> 10, c = col & 1023;
            FILT[((size_t)c * 2 + side) * SEQ + t] = (bf16_t)f2bf(acc * __expf(-tn * hy_delta(c)));
        }
    }
    float* FILTC = WSP(float, WS_FILTC);
    for (int e = F.bid * NTHREADS + F.tid; e < CTX * 2048; e += F.G * NTHREADS) {
        const int lag = e >> 11, col = e & 2047, c = col & 1023; const float* hr = HDN + (size_t)(SEQ + lag) * 64; float acc = 0.f;
#pragma unroll 16
        for (int j = 0; j < 64; ++j) acc += hr[j] * w3[(size_t)j * 2048 + col];
        FILTC[e] = acc * __expf(-((float)lag / (float)(CTX - 1)) * hy_delta(c));
    }
}

__device__ __forceinline__ void ld8bf(const bf16_t* p, float (&o)[8]) { const u32x4 w = *(const u32x4*)p; o[0] = bflo(w.x); o[1] = bfhi(w.x); o[2] = bflo(w.y); o[3] = bfhi(w.y); o[4] = bflo(w.z); o[5] = bfhi(w.z); o[6] = bflo(w.w); o[7] = bfhi(w.w); }
__device__ __forceinline__ void up8(const u32x4 w, float (&o)[8]) { o[0] = bflo(w.x); o[1] = bfhi(w.x); o[2] = bflo(w.y); o[3] = bfhi(w.y); o[4] = bflo(w.z); o[5] = bfhi(w.z); o[6] = bflo(w.w); o[7] = bfhi(w.w); }
__device__ __forceinline__ void st8bf(bf16_t* p, const float (&v)[8]) { u32x4 w; w.x = pk2(v[0], v[1]); w.y = pk2(v[2], v[3]); w.z = pk2(v[4], v[5]); w.w = pk2(v[6], v[7]); *(u32x4*)p = w; }
__device__ __forceinline__ void ld8f(const float* p, float (&o)[8]) { const f32x4 a = *(const f32x4*)p, b = *(const f32x4*)(p + 4); o[0] = a.x; o[1] = a.y; o[2] = a.z; o[3] = a.w; o[4] = b.x; o[5] = b.y; o[6] = b.z; o[7] = b.w; }

constexpr int PREP_RUN = 16;
__device__ __forceinline__ void phase_prep(Frame& F, const Args& a, int layer) {
    const bf16_t* P = WSP(bf16_t, WS_P); bf16_t* P2 = WSP(bf16_t, WS_P2);
    float* RS = WSP(float, WS_RS); bf16_t* KPE = WSP(bf16_t, WS_KPE); float* DT = WSP(float, WS_DT);
    bf16_t* KK = WSP(bf16_t, WS_KK); bf16_t* AL_ = WSP(bf16_t, WS_ALORA); float* VC = WSP(float, WS_VC);
    const float* scw = arg_in(a, I_SCONVW) + (size_t)layer * 3 * 1536; const float* scb = arg_in(a, I_SCONVB) + layer * 1536; const float* dtb = arg_in(a, I_SDTB) + layer * 32;
    const float* hcw = arg_in(a, I_HCONVW) + (size_t)layer * 3 * 3072; const float* hcb = arg_in(a, I_HCONVB) + layer * 3072;
    const float* mu = arg_in(a, I_RMU) + (size_t)layer * 2 * 3488; const float* rkk = arg_in(a, I_RKK) + layer * 1024;
    const int lane = F.lane;
    for (int item = F.gw; item < (T / PREP_RUN) * 13; item += F.NGW) {
        const int run = item / 13, ct = item % 13; const int r0 = run * PREP_RUN;
        if (ct == 0) {
#pragma unroll 1
        for (int rr = 0; rr < PREP_RUN; ++rr) { const int row = r0 + rr; const bf16_t* pr = P + (size_t)row * NNG;
            float x[8]; ld8bf(pr + P_CQ + lane * 8, x); float s = 0.f;
#pragma unroll
            for (int i = 0; i < 8; ++i) s += x[i] * x[i];
            s = wave_sum(s); const float rq = 1.f / sqrtf(s * (1.f / 512.f) + 1e-6f);
            ld8bf(pr + P_CKV + lane * 8, x); s = 0.f;
#pragma unroll
            for (int i = 0; i < 8; ++i) s += x[i] * x[i];
            s = wave_sum(s); const float rk = 1.f / sqrtf(s * (1.f / 512.f) + 1e-6f);
            if (lane == 0) { RS[row * 2] = rq; RS[row * 2 + 1] = rk; }
            float kv = bf2f(pr[P_KPE + lane]);
            const float other = swz16(kv);
            if (row >= TC) { const int t = (row - TC) & (SEQ - 1); const int axis = lane >> 5, half = (lane >> 4) & 1, j = lane & 15;
                const float pos = (float)(axis == 0 ? (t >> 6) : (t & 63)); const float inv = __builtin_amdgcn_exp2f(-(float)j * 0.8304820237218406f);
                const float sn = __sinf(pos * inv), cs = __cosf(pos * inv);
                kv = half == 0 ? kv * cs - other * sn : kv * cs + other * sn; }
            KPE[(size_t)row * 64 + lane] = (bf16_t)f2bf(kv);
            if (lane < 32) DT[(size_t)row * 32 + lane] = softplusf_(bf2f(pr[P_DT + lane]) + dtb[lane]); }
        continue; }
        const bool first = row_first(r0), last = row_last(r0 + PREP_RUN - 1);
        if (ct >= 1 && ct <= 3) { const int ch = ct - 1; const int c = ch * 512 + lane * 8; float xm[8], x0[8], xp[8], w0[8], w1[8], w2[8], bb[8];
            ld8f(scw + c, w0); ld8f(scw + 1536 + c, w1); ld8f(scw + 3072 + c, w2); ld8f(scb + c, bb);
            const bf16_t* pc = P + (size_t)r0 * NNG + P_XBC + c;
            u32x4 raw[PREP_RUN + 2];
#pragma unroll
            for (int rr = 0; rr < PREP_RUN + 2; ++rr) { const bool ok = (rr > 0 || !first) && (rr < PREP_RUN + 1 || !last); raw[rr] = ok ? *(const u32x4*)(pc + (ptrdiff_t)(rr - 1) * NNG) : (u32x4){0u, 0u, 0u, 0u}; }
            up8(raw[0], xm); up8(raw[1], x0);
#pragma unroll
            for (int rr = 0; rr < PREP_RUN; ++rr) {
                up8(raw[rr + 2], xp);
                float o[8];
#pragma unroll
                for (int i = 0; i < 8; ++i) { o[i] = siluf_(xm[i] * w0[i] + x0[i] * w1[i] + xp[i] * w2[i] + bb[i]); xm[i] = x0[i]; x0[i] = xp[i]; }
                st8bf(P2 + (size_t)(r0 + rr) * P2W + P2_XBC + c, o); } continue; }
        if (ct >= 4 && ct <= 5) { const int ch = ct - 4; { const int c = ch * 512 + lane * 8; float xm[8], x0[8], xp[8], w0[8], w1[8], w2[8], bb[8];
            ld8f(hcw + c, w0); ld8f(hcw + 3072 + c, w1); ld8f(hcw + 6144 + c, w2); ld8f(hcb + c, bb);
            const bf16_t* pc = P + (size_t)r0 * NNG + P_HY + c;
            u32x4 raw[PREP_RUN + 2];
#pragma unroll
            for (int rr = 0; rr < PREP_RUN + 2; ++rr) { const bool ok = (rr > 0 || !first) && (rr < PREP_RUN + 1 || !last); raw[rr] = ok ? *(const u32x4*)(pc + (ptrdiff_t)(rr - 1) * NNG) : (u32x4){0u, 0u, 0u, 0u}; }
            up8(raw[0], xm); up8(raw[1], x0);
#pragma unroll
            for (int rr = 0; rr < PREP_RUN; ++rr) {
                up8(raw[rr + 2], xp);
                float o[8];
#pragma unroll
                for (int i = 0; i < 8; ++i) { o[i] = xm[i] * w0[i] + x0[i] * w1[i] + xp[i] * w2[i] + bb[i]; xm[i] = x0[i]; x0[i] = xp[i]; }
                st8bf(P2 + (size_t)(r0 + rr) * P2W + P2_X0 + c, o); } }
        if (r0 < TC) {
#pragma unroll 1
                for (int rr = 0; rr < PREP_RUN; ++rr) { const int row = r0 + rr; const bool f1 = row_first(row), l1 = row_last(row); const int c = ch * 512 + lane * 8;
                    const bf16_t* pr = P + (size_t)row * NNG; float o1[8], o2[8];
#pragma unroll
                    for (int part = 1; part < 3; ++part) { float x0[8], xm[8], xp[8], w0[8], w1[8], w2[8], bb[8]; const int cc = part * 1024 + c;
                        ld8bf(pr + P_HY + cc, x0);
                        if (!f1) ld8bf(pr - NNG + P_HY + cc, xm); else { for (int i = 0; i < 8; ++i) xm[i] = 0.f; }
                        if (!l1) ld8bf(pr + NNG + P_HY + cc, xp); else { for (int i = 0; i < 8; ++i) xp[i] = 0.f; }
                        ld8f(hcw + cc, w0); ld8f(hcw + 3072 + cc, w1); ld8f(hcw + 6144 + cc, w2); ld8f(hcb + cc, bb);
#pragma unroll
                        for (int i = 0; i < 8; ++i) { const float r = xm[i] * w0[i] + x0[i] * w1[i] + xp[i] * w2[i] + bb[i]; if (part == 1) o1[i] = r; else o2[i] = r; } }
                    float* vc = VC + (size_t)row * 1024 + c;
                    *(f32x4*)vc = (f32x4){o1[0] * o2[0], o1[1] * o2[1], o1[2] * o2[2], o1[3] * o2[3]};
                    *(f32x4*)(vc + 4) = (f32x4){o1[4] * o2[4], o1[5] * o2[5], o1[6] * o2[6], o1[7] * o2[7]}; } }
        continue; }
        { const int ch = ct - 6; const int c = ch * 512 + lane * 8;
            if (c < 3488) { float um[8], u0[8], up[8], m0[8], m1[8], g8[8];
                ld8f(mu + c, m0); ld8f(mu + 3488 + c, m1);
                if (ch == 2 || ch == 3) ld8f(rkk + (c - 1024), g8);
                const bf16_t* pc = P + (size_t)r0 * NNG + P_RW + c;
                u32x4 raw[PREP_RUN + 2];
#pragma unroll
                for (int rr = 0; rr < PREP_RUN + 2; ++rr) { const bool ok = (rr > 0 || !first) && (rr < PREP_RUN + 1 || !last); raw[rr] = ok ? *(const u32x4*)(pc + (ptrdiff_t)(rr - 1) * NNG) : (u32x4){0u, 0u, 0u, 0u}; }
                up8(raw[0], um); up8(raw[1], u0);
#pragma unroll
                for (int rr = 0; rr < PREP_RUN; ++rr) { const int row = r0 + rr;
                    up8(raw[rr + 2], up);
                    float us[8];
#pragma unroll
                    for (int i = 0; i < 8; ++i) { us[i] = u0[i] + m0[i] * (um[i] - u0[i]) + m1[i] * (up[i] - u0[i]); um[i] = u0[i]; u0[i] = up[i]; }
                    if (ch < 6) st8bf(P2 + (size_t)row * P2W + P2_RKV + c, us);
                    if (ch == 2 || ch == 3) { float kx[8]; float s = 0.f;
#pragma unroll
                        for (int i = 0; i < 8; ++i) { kx[i] = us[i] * g8[i]; s += kx[i] * kx[i]; }
                        s = sum8(s);
                        const float inv = 1.f / fmaxf(sqrtf(s), 1e-12f);
#pragma unroll
                        for (int i = 0; i < 8; ++i) kx[i] *= inv;
                        st8bf(KK + (size_t)row * 1024 + (c - 1024), kx); }
                    if (ch == 6) { const int cl = c - 3072; float o[8];
#pragma unroll
                        for (int i = 0; i < 8; ++i) o[i] = cl < 128 ? tanhf_(us[i]) : cl < 256 ? us[i] : sigmoidf_(us[i]);
                        st8bf(AL_ + (size_t)row * 512 + cl, o); } } }
            else if (ch == 6) { const int cl = c - 3072;
                for (int rr = 0; rr < PREP_RUN; ++rr) { float zz = 0.f; asm volatile("" : "+v"(zz)); float o[8] = {zz, zz, zz, zz, zz, zz, zz, zz}; st8bf(AL_ + (size_t)(r0 + rr) * 512 + cl, o); } } }
    }
    float* VT = WSP(float, WS_VT);
    LAS float* tl = (LAS float*)F.lds;
    for (int u = F.bid; u < (TL / 64) * 4; u += F.G) {
        const int tb = u >> 2, cb = u & 3; const int row0 = TC + tb * 64; const int c8 = (F.tid & 31) * 8, c = cb * 256 + c8, tq = F.tid >> 5;
        float w1[3][8], w2[3][8], b1[8], b2[8];
#pragma unroll
        for (int k = 0; k < 3; ++k) { ld8f(hcw + k * 3072 + 1024 + c, w1[k]); ld8f(hcw + k * 3072 + 2048 + c, w2[k]); }
        ld8f(hcb + 1024 + c, b1); ld8f(hcb + 2048 + c, b2);
        __syncthreads();
#pragma unroll 1
        for (int i = 0; i < 4; ++i) { const int tl_ = tq * 4 + i, row = row0 + tl_; const bf16_t* pr = P + (size_t)row * NNG + P_HY;
            const bool first = row_first(row), last = row_last(row);
            float a1[8], a2[8], x[8];
            ld8bf(pr + 1024 + c, x);
#pragma unroll
            for (int j = 0; j < 8; ++j) a1[j] = x[j] * w1[1][j] + b1[j];
            ld8bf(pr + 2048 + c, x);
#pragma unroll
            for (int j = 0; j < 8; ++j) a2[j] = x[j] * w2[1][j] + b2[j];
            if (!first) { ld8bf(pr - NNG + 1024 + c, x);
#pragma unroll
                for (int j = 0; j < 8; ++j) a1[j] += x[j] * w1[0][j];
                ld8bf(pr - NNG + 2048 + c, x);
#pragma unroll
                for (int j = 0; j < 8; ++j) a2[j] += x[j] * w2[0][j]; }
            if (!last) { ld8bf(pr + NNG + 1024 + c, x);
#pragma unroll
                for (int j = 0; j < 8; ++j) a1[j] += x[j] * w1[2][j];
                ld8bf(pr + NNG + 2048 + c, x);
#pragma unroll
                for (int j = 0; j < 8; ++j) a2[j] += x[j] * w2[2][j]; }
#pragma unroll
            for (int j = 0; j < 8; ++j) tl[(c8 + j) * 65 + tl_] = a1[j] * a2[j]; }
        __syncthreads();
        const int b = (row0 - TC) >> 13, t0 = (row0 - TC) & (SEQ - 1);
        for (int p_ = 0; p_ < 8; ++p_) { const int cl = p_ * 32 + (F.tid >> 4), q = F.tid & 15;
            const f32x4 o = {tl[cl * 65 + 4 * q], tl[cl * 65 + 4 * q + 1], tl[cl * 65 + 4 * q + 2], tl[cl * 65 + 4 * q + 3]};
            *(f32x4*)(VT + ((size_t)(cb * 256 + cl) * 2 + b) * SEQ + t0 + 4 * q) = o; }
    }
}

using pg8::Unit;
#define EPI_LOOP_BEGIN const int row0 = u.pm * 256 + wr * 64 + fr; \
    _Pragma("unroll") for (int ai = 0; ai < 2; ++ai) _Pragma("unroll") for (int m = 0; m < 4; ++m) { const int row = row0 + ai * 128 + m * 16; \
    _Pragma("unroll") for (int bj = 0; bj < 2; ++bj) { const int cl = bj * 128 + wc * 32 + 8 * fq; const f32x4 v0 = acc[ai][bj][m][0], v1 = acc[ai][bj][m][1];
#define EPI_LOOP_END } __builtin_amdgcn_sched_barrier(0); }
struct EpiBf16 {
    static constexpr bool PERM = true, KEEPS = false;
    bf16_t* O; int ldc; const float* rscale; int rs_stride; int act; float cscale;
    __device__ __forceinline__ void operator()(const f32x4 (&acc)[2][2][4][2], const Unit& u, int wr, int wc, int fr, int fq) const {
        EPI_LOOP_BEGIN
            const float s = rscale ? rscale[(size_t)row * rs_stride] : cscale;
            float x[8] = {v0.x * s, v0.y * s, v0.z * s, v0.w * s, v1.x * s, v1.y * s, v1.z * s, v1.w * s};
            if (act == 1) {
#pragma unroll
                for (int i = 0; i < 8; ++i) x[i] = sigmoidf_(x[i]); }
            u32x4 w; w.x = cvt_pk_bf16(x[0], x[1]); w.y = cvt_pk_bf16(x[2], x[3]); w.z = cvt_pk_bf16(x[4], x[5]); w.w = cvt_pk_bf16(x[6], x[7]);
            *(u32x4*)(O + (size_t)row * ldc + u.pn * 256 + cl) = w;
        EPI_LOOP_END
    }
};
struct EpiLora {
    static constexpr bool PERM = true, KEEPS = false;
    bf16_t* EW; bf16_t* ICLR; bf16_t* GG; const float* w0; const float* a0;
    __device__ __forceinline__ void operator()(const f32x4 (&acc)[2][2][4][2], const Unit& u, int wr, int wc, int fr, int fq) const {
        const int blk = u.pn >> 2, cb = (u.pn & 3) * 256;
        const float* bias = blk < 2 ? w0 + blk * 1024 : a0 + (blk & 1) * 1024;
        bf16_t* dbase = blk < 2 ? EW + (size_t)blk * T * 1024 : blk < 4 ? ICLR + (size_t)(blk - 2) * T * 1024 : GG;
        const float scale = blk < 2 ? 0.6065306597126334f : 1.f; const bool sig = blk < 4;
        f32x4 bia[2][2];
#pragma unroll
        for (int bj = 0; bj < 2; ++bj) { const int c = cb + bj * 128 + wc * 32 + 8 * fq; bia[bj][0] = *(const f32x4*)(bias + c); bia[bj][1] = *(const f32x4*)(bias + c + 4); }
        EPI_LOOP_BEGIN
            const int c = cb + cl; float x[8] = {v0.x, v0.y, v0.z, v0.w, v1.x, v1.y, v1.z, v1.w};
            if (sig) { const f32x4 b0 = bia[bj][0], b1 = bia[bj][1]; const float bb[8] = {b0.x, b0.y, b0.z, b0.w, b1.x, b1.y, b1.z, b1.w};
#pragma unroll
                for (int i = 0; i < 8; ++i) x[i] = scale * sigmoidf_(bb[i] + x[i]); }
            u32x4 w; w.x = cvt_pk_bf16(x[0], x[1]); w.y = cvt_pk_bf16(x[2], x[3]); w.z = cvt_pk_bf16(x[4], x[5]); w.w = cvt_pk_bf16(x[6], x[7]);
            *(u32x4*)(dbase + (size_t)row * 1024 + c) = w;
        EPI_LOOP_END
    }
};
struct EpiMerge {
    static constexpr bool PERM = true, KEEPS = true;
    const bf16_t* gates; bf16_t* MB;
    __device__ __forceinline__ bool operator()(f32x4 (&acc)[2][2][4][2], const Unit& uu, int wr, int wc, int fr, int fq) const {
        const int br = uu.pn >> 3; Unit u; u.pm = uu.pm - br * 66; u.pn = uu.pn & 7;
        const int row0 = u.pm * 256 + wr * 64 + fr, col0 = u.pn * 256 + wc * 32 + 8 * fq; const bool last = br == 3;
        const bf16_t* gcur = gates + br * DM + col0; const bf16_t* gnxt = gates + (last ? br : br + 1) * DM + col0;
        u32x4 gq[2], hq[2], gn[2], hn[2];
#define EM_ROW(it_) ((size_t)(row0 + ((it_) >> 2) * 128 + ((it_) & 3) * 16))
#pragma unroll
        for (int bj = 0; bj < 2; ++bj) { gq[bj] = *(const u32x4*)(gcur + EM_ROW(0) * NGATE + bj * 128); hq[bj] = *(const u32x4*)(gnxt + EM_ROW(0) * NGATE + bj * 128); }
#pragma unroll
        for (int it = 0; it < 8; ++it) { const int ai = it >> 2, m = it & 3;
            if (it < 7) {
#pragma unroll
                for (int bj = 0; bj < 2; ++bj) { gn[bj] = *(const u32x4*)(gcur + EM_ROW(it + 1) * NGATE + bj * 128); hn[bj] = *(const u32x4*)(gnxt + EM_ROW(it + 1) * NGATE + bj * 128); } }
#pragma unroll
            for (int bj = 0; bj < 2; ++bj) { float g[8], hh[8]; up8(gq[bj], g); up8(hq[bj], hh); float f[8];
#pragma unroll
                for (int i = 0; i < 8; ++i) { const float ea = __expf(-g[i]), eb = __expf(-hh[i]); f[i] = last ? 1.f / (1.f + ea) : (1.f + eb) / (1.f + ea); }
                f32x4& v0 = acc[ai][bj][m][0]; f32x4& v1 = acc[ai][bj][m][1];
                v0 = v0 * (f32x4){f[0], f[1], f[2], f[3]}; v1 = v1 * (f32x4){f[4], f[5], f[6], f[7]};
                if (last) { u32x4 w; w.x = cvt_pk_bf16(v0.x, v0.y); w.y = cvt_pk_bf16(v0.z, v0.w); w.z = cvt_pk_bf16(v1.x, v1.y); w.w = cvt_pk_bf16(v1.z, v1.w);
                    *(u32x4*)(MB + EM_ROW(it) * DM + col0 + bj * 128) = w; } }
            gq[0] = gn[0]; gq[1] = gn[1]; hq[0] = hn[0]; hq[1] = hn[1];
            __builtin_amdgcn_sched_barrier(0); }
#undef EM_ROW
        return !last;
    }
};
struct OrderMerge {
    pg8::StaticOrder so;
    __device__ void init(int G, int c, int nM, int pm0) { so.init(nM, 8, G, c, pm0); }
    __device__ bool next(int i, Unit& u) const { Unit t; if (!so.next(i >> 2, t)) return false; const int br = i & 3; u.pm = br * 66 + t.pm; u.pn = br * 8 + t.pn; return true; }
};
struct EpiF32 {
    static constexpr bool PERM = true, KEEPS = false;
    float* O; int ldc;
    __device__ __forceinline__ void operator()(const f32x4 (&acc)[2][2][4][2], const Unit& u, int wr, int wc, int fr, int fq) const {
        EPI_LOOP_BEGIN
            float* o = O + (size_t)row * ldc + u.pn * 256 + cl; *(f32x4*)o = v0; *(f32x4*)(o + 4) = v1;
        EPI_LOOP_END
    }
};
__device__ __forceinline__ int moe_panel(int e, int pi) { return pi < 8 ? (((pi >> 2) * NEXP + e) * 4 + (pi & 3)) : 128 + e; }
struct OrderMoe {
    int npn, G, c, npan;
    __device__ void init(int npn_, int G_, int c_, int npan_) { npn = npn_; G = G_; c = c_; npan = npan_; }
    __device__ bool next(int i, Unit& u) const { const int L = i * G + c; const int per = npan * npn; if (L >= NEXP * per) return false;
        const int e = L / per, r = L % per, j = r / npan, pi = r % npan; u.pm = moe_panel(e, pi); u.pn = e * npn + j; return true; }
};
struct EpiSwiglu {
    static constexpr bool PERM = true, KEEPS = false;
    unsigned char* HID;
    __device__ __forceinline__ void operator()(const f32x4 (&acc)[2][2][4][2], const Unit& u, int wr, int wc, int fr, int fq) const {
        const int j = u.pn % 11; const int row0 = u.pm * 256 + wr * 64 + fr; const float sc = 1.f / 64.f;
#pragma unroll
        for (int ai = 0; ai < 2; ++ai)
#pragma unroll
            for (int m = 0; m < 4; ++m) { const int row = row0 + ai * 128 + m * 16;
                const f32x4 g0 = acc[ai][0][m][0] * sc, g1 = acc[ai][0][m][1] * sc, u0 = acc[ai][1][m][0] * sc, u1 = acc[ai][1][m][1] * sc;
                u32x2 w; w.x = pk4fp8(siluf_(g0.x) * u0.x, siluf_(g0.y) * u0.y, siluf_(g0.z) * u0.z, siluf_(g0.w) * u0.w);
                w.y = pk4fp8(siluf_(g1.x) * u1.x, siluf_(g1.y) * u1.y, siluf_(g1.z) * u1.z, siluf_(g1.w) * u1.w);
                *(u32x2*)(HID + (size_t)row * EFFP + j * 128 + wc * 32 + 8 * fq) = w; __builtin_amdgcn_sched_barrier(0); }
    }
};
struct EpiDown {
    static constexpr bool PERM = true, KEEPS = false;
    bf16_t* YE;
    __device__ __forceinline__ void operator()(const f32x4 (&acc)[2][2][4][2], const Unit& uu, int wr, int wc, int fr, int fq) const {
        Unit u; u.pm = uu.pm; u.pn = uu.pn & 7; const float s = 1.f / 64.f;
        EPI_LOOP_BEGIN
            u32x4 w; w.x = cvt_pk_bf16(v0.x * s, v0.y * s); w.y = cvt_pk_bf16(v0.z * s, v0.w * s); w.z = cvt_pk_bf16(v1.x * s, v1.y * s); w.w = cvt_pk_bf16(v1.z * s, v1.w * s);
            *(u32x4*)(YE + (size_t)row * DM + u.pn * 256 + cl) = w;
        EPI_LOOP_END
    }
};

namespace att {
using s16x4 = __attribute__((ext_vector_type(4))) short;
using f32x16 = __attribute__((ext_vector_type(16))) float;
constexpr int NW = 8, QBLK = 32, KVBLK = 64, LDQ = 1536, LDKV = 2048, LDO = 1024;
constexpr float SCALE = 0.07216878364870322f;
constexpr float THR = 8.f;
#ifndef ATT_SDEPTH
#define ATT_SDEPTH 1
#endif
constexpr int SDEPTH = ATT_SDEPTH;
constexpr int SHM_V = KVBLK * 128 * 2, SHM_K = KVBLK * 128 * 2, SHM_KP = KVBLK * 64 * 2;
constexpr int OFF_V = 0, OFF_K = 2 * SHM_V, OFF_KP = OFF_K + 2 * SHM_K, OFF_WS = OFF_KP + 2 * SHM_KP, OFF_QP = OFF_WS + NW * 64 * 4, SHM_ATTN = OFF_QP + 256 * 256;
static_assert(SHM_ATTN <= 150 * 1024, "attention LDS");
#define KSWZ(row, colB) ((row) * 256 + ((colB) ^ (((row) & 7) << 4)))
#define KPSWZ(row, colB) ((row) * 128 + ((colB) ^ (((row) & 7) << 4)))
#define SBAR() __builtin_amdgcn_sched_barrier(0)
__device__ __forceinline__ int crow(int r, int hi) { return (r & 3) + 8 * (r >> 2) + 4 * hi; }
__device__ __forceinline__ void partialSM(f32x16& p0, f32x16& p1, float& m_reg, float& mn, float& alpha) {
  constexpr float C = SCALE * 1.4426950408889634f;
  float pmax = p0[0]; for (int r = 1; r < 16; ++r) pmax = fmaxf(pmax, p0[r]); for (int r = 0; r < 16; ++r) pmax = fmaxf(pmax, p1[r]);
  { auto rr = __builtin_amdgcn_permlane32_swap(__float_as_uint(pmax), __float_as_uint(pmax), false, false);
    pmax = fmaxf(__uint_as_float(rr[0]), __uint_as_float(rr[1])); }
  if (__builtin_expect(__all(pmax - m_reg <= THR / SCALE), 1)) { mn = m_reg; alpha = 1.f; }
  else { mn = fmaxf(m_reg, pmax); alpha = __builtin_amdgcn_exp2f((m_reg - mn) * C); m_reg = mn; }
  float mnC = -mn * C;
  for (int r = 0; r < 16; ++r) p0[r] = fmaf(p0[r], C, mnC); for (int r = 0; r < 16; ++r) p1[r] = fmaf(p1[r], C, mnC);
  for (int r = 0; r < 16; ++r) p0[r] = __builtin_amdgcn_exp2f(p0[r]);
}
__device__ __forceinline__ void finishSM(f32x16& p0, f32x16& p1, float alpha, float& l_reg, bf16x8& pa0, bf16x8& pa1, bf16x8& pa2, bf16x8& pa3) {
  for (int r = 0; r < 16; ++r) p1[r] = __builtin_amdgcn_exp2f(p1[r]);
  float ps = 0; for (int r = 0; r < 16; ++r) ps += p0[r]; for (int r = 0; r < 16; ++r) ps += p1[r];
  { auto rr = __builtin_amdgcn_permlane32_swap(__float_as_uint(ps), __float_as_uint(ps), false, false);
    ps = __uint_as_float(rr[0]) + __uint_as_float(rr[1]); }
  l_reg = l_reg * alpha + ps;
#define PK4(P, BASE, OUT) do { unsigned a0 = cvt_pk_bf16(P[BASE + 0], P[BASE + 1]), a1 = cvt_pk_bf16(P[BASE + 2], P[BASE + 3]);   \
    unsigned b0 = cvt_pk_bf16(P[BASE + 4], P[BASE + 5]), b1 = cvt_pk_bf16(P[BASE + 6], P[BASE + 7]);                              \
    auto r0 = __builtin_amdgcn_permlane32_swap(a0, b0, false, false); auto r1 = __builtin_amdgcn_permlane32_swap(a1, b1, false, false); \
    u32x4 w = {r0[0], r1[0], r0[1], r1[1]}; OUT = *reinterpret_cast<bf16x8*>(&w); } while (0)
  PK4(p0, 0, pa0); PK4(p0, 8, pa1); PK4(p1, 0, pa2); PK4(p1, 8, pa3);
#undef PK4
}
__device__ __forceinline__ void qkt(f32x16& p0, f32x16& p1, const char* Ks, const char* Kp, const bf16x8* qr, const char* Qp, int qrow, int r32, int hi) {
  p0 = f32x16{}; p1 = f32x16{};
#pragma unroll
  for (int d0 = 0; d0 < 8; ++d0) { int cb = (d0 * 16 + hi * 8) * 2;
    bf16x8 b0 = *reinterpret_cast<const bf16x8*>(Ks + KSWZ(r32, cb));
    bf16x8 b1 = *reinterpret_cast<const bf16x8*>(Ks + KSWZ(32 + r32, cb));
    bf16x8 q; if (d0 < 4) q = qr[d0]; else q = *reinterpret_cast<const bf16x8*>(Qp + KSWZ(qrow, ((d0 - 4) * 16 + hi * 8) * 2));
    p0 = __builtin_amdgcn_mfma_f32_32x32x16_bf16(b0, q, p0, 0, 0, 0);
    p1 = __builtin_amdgcn_mfma_f32_32x32x16_bf16(b1, q, p1, 0, 0, 0); }
#pragma unroll
  for (int d0 = 0; d0 < 4; ++d0) { int cb = (d0 * 16 + hi * 8) * 2;
    bf16x8 b0 = *reinterpret_cast<const bf16x8*>(Kp + KPSWZ(r32, cb));
    bf16x8 b1 = *reinterpret_cast<const bf16x8*>(Kp + KPSWZ(32 + r32, cb));
    const bf16x8 qp = *reinterpret_cast<const bf16x8*>(Qp + KSWZ(qrow, 128 + cb));
    p0 = __builtin_amdgcn_mfma_f32_32x32x16_bf16(b0, qp, p0, 0, 0, 0);
    p1 = __builtin_amdgcn_mfma_f32_32x32x16_bf16(b1, qp, p1, 0, 0, 0); }
}
__device__ __forceinline__ int v_st(int k, int c) { const int kk = (k & ~0xC) | ((k & 4) << 1) | ((k & 8) >> 1); return ((kk >> 3) * 4 + (c >> 5)) * 512 + ((kk & 7) * 32 + (c & 31)) * 2; }
__device__ __forceinline__ int v_rd_base(int lane) { return ((lane & 3) << 3) | (((lane >> 2) & 3) << 6) | (((lane >> 4) & 1) << 5) | (((lane >> 5) & 1) << 8); }
constexpr int v_rd_off(int d0, int ks, int half) { return d0 * 512 + ks * 4096 + half * 2048; }
template <int OFF> __device__ __forceinline__ s16x4 tr_read(int vb) {
  s16x4 r; asm volatile("ds_read_b64_tr_b16 %0, %1 offset:%2" : "=&v"(r) : "v"(vb), "i"(OFF) : "memory"); return r;
}
template <int D0> __device__ __forceinline__ void pv_one(f32x16& od, int vb, bf16x8 pa0, bf16x8 pa1, bf16x8 pa2, bf16x8 pa3) {
  const s16x4 l0 = tr_read<v_rd_off(D0, 0, 0)>(vb), h0 = tr_read<v_rd_off(D0, 0, 1)>(vb), l1 = tr_read<v_rd_off(D0, 1, 0)>(vb), h1 = tr_read<v_rd_off(D0, 1, 1)>(vb);
  const s16x4 l2 = tr_read<v_rd_off(D0, 2, 0)>(vb), h2 = tr_read<v_rd_off(D0, 2, 1)>(vb), l3 = tr_read<v_rd_off(D0, 3, 0)>(vb), h3 = tr_read<v_rd_off(D0, 3, 1)>(vb);
  asm volatile("s_waitcnt lgkmcnt(0)" ::: "memory"); SBAR();
#define PK(L, H) (bf16x8){L[0], L[1], L[2], L[3], H[0], H[1], H[2], H[3]}
  od = __builtin_amdgcn_mfma_f32_32x32x16_bf16(pa0, PK(l0, h0), od, 0, 0, 0);
  od = __builtin_amdgcn_mfma_f32_32x32x16_bf16(pa1, PK(l1, h1), od, 0, 0, 0);
  od = __builtin_amdgcn_mfma_f32_32x32x16_bf16(pa2, PK(l2, h2), od, 0, 0, 0);
  od = __builtin_amdgcn_mfma_f32_32x32x16_bf16(pa3, PK(l3, h3), od, 0, 0, 0);
#undef PK
}
__device__ __forceinline__ void pv_d0(f32x16* o, int vb, bf16x8 pa0, bf16x8 pa1, bf16x8 pa2, bf16x8 pa3) {
  pv_one<0>(o[0], vb, pa0, pa1, pa2, pa3); pv_one<1>(o[1], vb, pa0, pa1, pa2, pa3); pv_one<2>(o[2], vb, pa0, pa1, pa2, pa3); pv_one<3>(o[3], vb, pa0, pa1, pa2, pa3);
}
__device__ __forceinline__ void attn_unit(const bf16_t* __restrict__ Qb, const bf16_t* __restrict__ KVh, const bf16_t* __restrict__ KPE, bf16_t* __restrict__ Ob,
                                          int ka0, int kb0, int NT, char* lds, int tid_in, int tpos0) {
  const unsigned tid_u = (unsigned)tid_in; __builtin_assume(tid_u < 512u);
  const int tid = (int)tid_u, wid = tid >> 6, lane = tid & 63, r32 = lane & 31, hi = lane >> 5;
  char* V_lds = lds + OFF_V; char* K_lds = lds + OFF_K; char* P_lds = lds + OFF_KP;
  float* ws = (float*)(lds + OFF_WS) + wid * 64; float* li_l = ws; float* al_l = ws + 32;
  float m_reg = -1e30f, l_reg = 0; f32x16 o[4] = {}; bf16x8 qr[4];
  char* Q_lds = lds + OFF_QP; const int qrow = wid * QBLK + r32;
  const bf16_t* Qw = Qb + (long)(wid * QBLK + r32) * LDQ + hi * 8;
#pragma unroll
  for (int d0 = 0; d0 < 4; ++d0) qr[d0] = *reinterpret_cast<const bf16x8*>(Qw + d0 * 16);
#pragma unroll
  for (int d0 = 0; d0 < 4; ++d0) *reinterpret_cast<bf16x8*>(Q_lds + KSWZ(qrow, (d0 * 16 + hi * 8) * 2)) = *reinterpret_cast<const bf16x8*>(Qw + 64 + d0 * 16);
#pragma unroll
  for (int ax = 0; ax < 2; ++ax) { u32x4 w1 = *reinterpret_cast<const u32x4*>(Qw + 128 + ax * 32), w2 = *reinterpret_cast<const u32x4*>(Qw + 128 + ax * 32 + 16);
    if (tpos0 >= 0) { const int t = tpos0 + qrow; const float pos = (float)(ax == 0 ? (t >> 6) : (t & 63));
      unsigned* p1 = (unsigned*)&w1; unsigned* p2 = (unsigned*)&w2;
#pragma unroll
      for (int i = 0; i < 4; ++i) { float a0 = bflo(p1[i]), a1 = bfhi(p1[i]), b0 = bflo(p2[i]), b1 = bfhi(p2[i]);
        const float ang0 = pos * __builtin_amdgcn_exp2f(-(float)(hi * 8 + 2 * i) * 0.8304820237218406f), ang1 = pos * __builtin_amdgcn_exp2f(-(float)(hi * 8 + 2 * i + 1) * 0.8304820237218406f);
        const float c0 = __cosf(ang0), s0 = __sinf(ang0), c1 = __cosf(ang1), s1 = __sinf(ang1);
        p1[i] = pk2(a0 * c0 - b0 * s0, a1 * c1 - b1 * s1); p2[i] = pk2(b0 * c0 + a0 * s0, b1 * c1 + a1 * s1); } }
    *reinterpret_cast<u32x4*>(Q_lds + KSWZ(qrow, 128 + (ax * 32 + hi * 8) * 2)) = w1; *reinterpret_cast<u32x4*>(Q_lds + KSWZ(qrow, 128 + (ax * 32 + 16 + hi * 8) * 2)) = w2; }
  const int sr = tid >> 4, sc = (tid & 15) * 8, vst0 = v_st(sr, sc), vst1 = v_st(32 + sr, sc);
  const int pr = tid >> 3, pc = (tid & 7) * 8;
  const int vb0 = (int)(uintptr_t)V_lds + v_rd_base(lane);
  struct { bf16x8 vs0, vs1, ks0, ks1, kp; } sr_[SDEPTH];
#define KROW(j) ((j) < 4 ? ka0 + 64 * (j) : kb0 + 64 * ((j) - 4))
  const __amdgpu_buffer_rsrc_t rsKV = __builtin_amdgcn_make_buffer_rsrc((void*)KVh, 0, 0xFFFFFFFFu, 0x00020000);
  const __amdgpu_buffer_rsrc_t rsKP = __builtin_amdgcn_make_buffer_rsrc((void*)KPE, 0, 0xFFFFFFFFu, 0x00020000);
  const int vo_k = (sr * LDKV + sc) * 2, vo_p = (pr * 64 + pc) * 2;
#define SLOAD(i, jt) do { const int k0_ = KROW(jt); const int so0 = k0_ * (LDKV * 2), so1 = so0 + 32 * LDKV * 2; \
    sr_[i].vs0 = __builtin_bit_cast(bf16x8, __builtin_amdgcn_raw_buffer_load_b128(rsKV, vo_k + 256, so0, 0)); sr_[i].vs1 = __builtin_bit_cast(bf16x8, __builtin_amdgcn_raw_buffer_load_b128(rsKV, vo_k + 256, so1, 0)); \
    sr_[i].ks0 = __builtin_bit_cast(bf16x8, __builtin_amdgcn_raw_buffer_load_b128(rsKV, vo_k, so0, 0)); sr_[i].ks1 = __builtin_bit_cast(bf16x8, __builtin_amdgcn_raw_buffer_load_b128(rsKV, vo_k, so1, 0)); \
    sr_[i].kp = __builtin_bit_cast(bf16x8, __builtin_amdgcn_raw_buffer_load_b128(rsKP, vo_p, k0_ * 128, 0)); } while (0)
#define SWRITE(b, i) do { *(bf16x8*)(V_lds + (b) * SHM_V + vst0) = sr_[i].vs0;          \
    *(bf16x8*)(V_lds + (b) * SHM_V + vst1) = sr_[i].vs1; int kc = sc * 2;               \
    *(bf16x8*)(K_lds + (b) * SHM_K + KSWZ(sr, kc)) = sr_[i].ks0;                       \
    *(bf16x8*)(K_lds + (b) * SHM_K + KSWZ(32 + sr, kc)) = sr_[i].ks1;                  \
    *(bf16x8*)(P_lds + (b) * SHM_KP + KPSWZ(pr, pc * 2)) = sr_[i].kp; } while (0)
#define SWAIT() do { if constexpr (SDEPTH == 2) asm volatile("s_waitcnt vmcnt(5)" ::: "memory"); else asm volatile("s_waitcnt vmcnt(0)" ::: "memory"); } while (0)
#define RESC(a) do { if (__any((a) < 1.f)) { if (hi == 0) al_l[r32] = (a); asm volatile("s_waitcnt lgkmcnt(0)" ::: "memory"); \
    for (int d = 0; d < 4; ++d) for (int r = 0; r < 16; ++r) o[d][r] *= al_l[crow(r, hi)]; } } while (0)
  f32x16 pA0, pA1, pB0, pB1; float mnA, mnB, alA, alB; bf16x8 pa0, pa1, pa2, pa3;
  constexpr int SE = 0, SO = SDEPTH - 1;
  SLOAD(SE, 0); asm volatile("s_waitcnt vmcnt(0)" ::: "memory"); SWRITE(0, SE); __syncthreads();
  qkt(pA0, pA1, K_lds, P_lds, qr, Q_lds, qrow, r32, hi); partialSM(pA0, pA1, m_reg, mnA, alA);
  SLOAD(SO, 1); if constexpr (SDEPTH == 2) { if (2 < NT) SLOAD(SE, 2); }
  SWAIT(); SWRITE(1, SO); __syncthreads();
  for (int j = 1; j + 1 < NT; j += 2) {
    SBAR(); qkt(pB0, pB1, K_lds + SHM_K, P_lds + SHM_KP, qr, Q_lds, qrow, r32, hi);
    finishSM(pA0, pA1, alA, l_reg, pa0, pa1, pa2, pa3); SBAR();
    SLOAD(SO, j + SDEPTH); SBAR();
    pv_d0(o, vb0, pa0, pa1, pa2, pa3); partialSM(pB0, pB1, m_reg, mnB, alB);
    __syncthreads(); SWAIT(); SWRITE(0, SE);
    RESC(alB); __syncthreads();
    SBAR(); qkt(pA0, pA1, K_lds, P_lds, qr, Q_lds, qrow, r32, hi);
    finishSM(pB0, pB1, alB, l_reg, pa0, pa1, pa2, pa3); SBAR();
    if (SDEPTH == 1 || j + 3 < NT) SLOAD(SE, j + 1 + SDEPTH); SBAR();
    pv_d0(o, vb0 + (int)SHM_V, pa0, pa1, pa2, pa3); partialSM(pA0, pA1, m_reg, mnA, alA);
    __syncthreads(); SWAIT(); SWRITE(1, SO);
    RESC(alA); __syncthreads();
  }
  SBAR(); qkt(pB0, pB1, K_lds + SHM_K, P_lds + SHM_KP, qr, Q_lds, qrow, r32, hi);
  finishSM(pA0, pA1, alA, l_reg, pa0, pa1, pa2, pa3); SBAR();
  pv_d0(o, vb0, pa0, pa1, pa2, pa3); partialSM(pB0, pB1, m_reg, mnB, alB);
  __syncthreads(); RESC(alB);
  finishSM(pB0, pB1, alB, l_reg, pa0, pa1, pa2, pa3); SBAR();
  pv_d0(o, vb0 + (int)SHM_V, pa0, pa1, pa2, pa3);
  if (hi == 0) li_l[r32] = l_reg; asm volatile("s_waitcnt lgkmcnt(0)" ::: "memory");
  float rli[16];
#pragma unroll
  for (int r = 0; r < 16; ++r) rli[r] = __builtin_amdgcn_rcpf(li_l[crow(r, hi)]);
  bf16_t* Ow = Ob + (long)(wid * QBLK) * LDO;
#pragma unroll
  for (int r = 0; r < 16; ++r) { int orow = crow(r, hi);
    for (int d0 = 0; d0 < 4; ++d0) Ow[(long)orow * LDO + d0 * 32 + r32] = (bf16_t)f2bf(o[d0][r] * rli[r]); }
  __syncthreads();
#undef KROW
#undef SLOAD
#undef SWRITE
#undef SWAIT
#undef RESC
}
}

__device__ __forceinline__ void phase_attn(Frame& F, bool lat_only) {
    const bf16_t* Q = WSP(bf16_t, WS_Q); const bf16_t* KV = WSP(bf16_t, WS_KV); const bf16_t* KPE = WSP(bf16_t, WS_KPE); bf16_t* YA = WSP(bf16_t, WS_Y);
    const int NU = NBATCH * NH_MLA * 32 + (lat_only ? 0 : NBATCH * NH_MLA);
    for (int u = F.bid; u < NU; u += F.G) {
        int b, h, row0, NT, tpos0;
        if (u < NBATCH * NH_MLA * 32) { const int bh = u >> 5, qb = u & 31; b = bh >> 3; h = bh & 7; row0 = TC + b * SEQ + qb * 256; NT = 4 + SEQ / 64; tpos0 = qb * 256; }
        else { const int bh = u - NBATCH * NH_MLA * 32; b = bh >> 3; h = bh & 7; row0 = b * CTX; NT = 4; tpos0 = -1; }
        att::attn_unit(Q + (size_t)row0 * 1536 + h * 192, KV + h * 256, KPE, YA + (size_t)row0 * 1024 + h * 128, b * CTX, TC + b * SEQ, NT, (char*)F.lds, F.tid, tpos0);
    }
}
__device__ __forceinline__ void phase_qrope(Frame& F) {
    bf16_t* Q = WSP(bf16_t, WS_Q);
    for (int row = TC + F.gw; row < T; row += F.NGW) {
        const int t = (row - TC) & (SEQ - 1); const int p = F.lane & 31, axis = p >> 4, j = p & 15, hs = F.lane >> 5;
        const float pos = (float)(axis == 0 ? (t >> 6) : (t & 63)); const float inv = __builtin_amdgcn_exp2f(-(float)j * 0.8304820237218406f);
        const float sn = __sinf(pos * inv), cs = __cosf(pos * inv);
#pragma unroll
        for (int hh = 0; hh < 4; ++hh) { const int h = hh * 2 + hs; bf16_t* q = Q + (size_t)row * 1536 + h * 192 + 128 + axis * 32 + j;
            const float x1 = bf2f(q[0]), x2 = bf2f(q[16]);
            q[0] = (bf16_t)f2bf(x1 * cs - x2 * sn); q[16] = (bf16_t)f2bf(x2 * cs + x1 * sn); }
    }
}

#define MFMA16(a, b, c) __builtin_amdgcn_mfma_f32_16x16x32_bf16((a), (b), (c), 0, 0, 0)
constexpr int XS_LD = 264, BC_LD = 136;
__device__ __forceinline__ float bperm(float v, int srclane) { return __builtin_bit_cast(float, __builtin_amdgcn_ds_bpermute(srclane << 2, __builtin_bit_cast(int, v))); }
__device__ __forceinline__ float wave_incl_scan(float v, int lane) {
#pragma unroll
    for (int o = 1; o < 64; o <<= 1) { const float t = bperm(v, lane - o); if (lane >= o) v += t; }
    return v;
}
template <int NCOLS>
__device__ __forceinline__ void stage_tile(LAS bf16_t* dst, int ld, const bf16_t* src, int tid) {
    constexpr int cpr = NCOLS >> 3, NIT = 128 * cpr / NTHREADS;
    u32x4 v[NIT];
#pragma unroll
    for (int k = 0; k < NIT; ++k) { const int i = tid + k * NTHREADS; const int r = i / cpr, c8 = (i % cpr) * 8; v[k] = *(const u32x4*)(src + (size_t)r * P2W + c8); }
#pragma unroll
    for (int k = 0; k < NIT; ++k) { const int i = tid + k * NTHREADS; const int r = i / cpr, c8 = (i % cpr) * 8; *(LAS u32x4*)(dst + r * ld + c8) = v[k]; }
}
__device__ __forceinline__ void phase_mamba_states(Frame& F, const Args& a, int layer) {
    const bf16_t* P2 = WSP(bf16_t, WS_P2); const float* DT = WSP(float, WS_DT); bf16_t* MST = WSP(bf16_t, WS_MST); float* MCS = WSP(float, WS_MCS);
    LAS bf16_t* XSl = (LAS bf16_t*)F.lds; LAS bf16_t* Bl = (LAS bf16_t*)(F.lds + 67584); LAS float* wt = (LAS float*)(F.lds + 102400) + F.wave * 128;
    const int lane = F.lane, row = lane & 15, quad = lane >> 4;
    for (int u = F.bid; u < NCHUNK * 4; u += F.G) {
        const int chunk = u >> 2, g = (u >> 1) & 1, half = u & 1, row0 = chunk * 128;
        __syncthreads();
        stage_tile<256>(XSl, XS_LD, P2 + (size_t)row0 * P2W + P2_XBC + (g * 8 + half * 4) * 64, F.tid);
        stage_tile<128>(Bl, BC_LD, P2 + (size_t)row0 * P2W + P2_XBC + 1024 + g * 128, F.tid);
        const int hl = F.wave >> 1, d = F.wave & 1, h = g * 8 + half * 4 + hl;
        const float aa = -__expf(arg_in(a, I_SALOG)[(layer * 2 + d) * 16 + h]);
        { const float dt0 = DT[(size_t)(row0 + lane) * 32 + d * 16 + h], dt1 = DT[(size_t)(row0 + 64 + lane) * 32 + d * 16 + h];
          const float da0 = dt0 * aa, da1 = dt1 * aa;
          float c0 = wave_incl_scan(da0, lane); const float tot0 = bperm(c0, 63); float c1 = wave_incl_scan(da1, lane) + tot0; const float tot = bperm(c1, 63);
          if (d == 0) { wt[lane] = dt0 * __expf(tot - c0); wt[64 + lane] = dt1 * __expf(tot - c1); }
          else { wt[lane] = dt0 * __expf(c0 - da0); wt[64 + lane] = dt1 * __expf(c1 - da1); }
          if (lane == 0) MCS[(d * NCHUNK + chunk) * 16 + h] = tot; }
        __syncthreads();
        bf16_t* out = MST + ((size_t)(d * NCHUNK + chunk) * 16 + h) * 8192;
#pragma unroll 1
        for (int nh = 0; nh < 2; ++nh) {
            f32x4 acc[4][4];
#pragma unroll
            for (int i = 0; i < 4; ++i)
#pragma unroll
                for (int j = 0; j < 4; ++j) acc[i][j] = (f32x4){0.f, 0.f, 0.f, 0.f};
#pragma unroll 1
            for (int k0 = 0; k0 < 128; k0 += 32) {
                const int sb = k0 + quad * 8;
                float w8[8];
#pragma unroll
                for (int j = 0; j < 8; ++j) w8[j] = wt[sb + j];
                bf16x8 bf[4];
#pragma unroll
                for (int nt = 0; nt < 4; ++nt) {
#pragma unroll
                    for (int j = 0; j < 8; ++j) bf[nt][j] = (short)Bl[(sb + j) * BC_LD + (nh * 4 + nt) * 16 + row]; }
#pragma unroll
                for (int pt = 0; pt < 4; ++pt) { bf16x8 af;
#pragma unroll
                    for (int j = 0; j < 8; ++j) af[j] = (short)f2bf(w8[j] * bf2f(XSl[(sb + j) * XS_LD + hl * 64 + pt * 16 + row]));
#pragma unroll
                    for (int nt = 0; nt < 4; ++nt) acc[pt][nt] = MFMA16(af, bf[nt], acc[pt][nt]); }
            }
#pragma unroll
            for (int pt = 0; pt < 4; ++pt)
#pragma unroll
                for (int nt = 0; nt < 4; ++nt)
#pragma unroll
                    for (int jj = 0; jj < 4; ++jj) out[(pt * 16 + quad * 4 + jj) * 128 + (nh * 4 + nt) * 16 + row] = (bf16_t)f2bf(acc[pt][nt][jj]);
        }
    }
}
__device__ __forceinline__ void phase_mamba_scan(Frame& F) {
    bf16_t* MST = WSP(bf16_t, WS_MST); const float* MCS = WSP(float, WS_MCS);
    for (int idx = F.bid * NTHREADS + F.tid; idx < 2 * 2 * 16 * 8192; idx += F.G * NTHREADS) {
        const int e = idx & 8191, h = (idx >> 13) & 15, b = (idx >> 17) & 1, d = idx >> 18;
        float state = 0.f;
#pragma unroll 6
        for (int i = 0; i < 66; ++i) {
            int chunk; if (i < 2) chunk = 2 * b + (d == 0 ? i : 1 - i); else chunk = 4 + 64 * b + (d == 0 ? i - 2 : 65 - i);
            bf16_t* p = MST + ((size_t)(d * NCHUNK + chunk) * 16 + h) * 8192 + e;
            const float cs = bf2f(*p); const float dec = __expf(MCS[(d * NCHUNK + chunk) * 16 + h]);
            *p = (bf16_t)f2bf(state);
            state = state * dec + cs;
        }
    }
}
__device__ __forceinline__ void phase_mamba_out(Frame& F, const Args& a, int layer) {
    const bf16_t* P = WSP(bf16_t, WS_P); const bf16_t* P2 = WSP(bf16_t, WS_P2); const float* DT = WSP(float, WS_DT); const bf16_t* MST = WSP(bf16_t, WS_MST);
    bf16_t* YB = WSP(bf16_t, WS_Y) + (size_t)1 * T * 1024;
    LAS bf16_t* Cl = (LAS bf16_t*)F.lds; LAS bf16_t* Bl = (LAS bf16_t*)(F.lds + 34816); LAS bf16_t* XSl = (LAS bf16_t*)(F.lds + 69632);
    LAS float* tab = (LAS float*)(F.lds + 137216);
    for (int u = F.bid; u < NCHUNK * 4; u += F.G) {
        const int chunk = u >> 2, g = (u >> 1) & 1, half = u & 1, row0 = chunk * 128;
        __syncthreads();
        { const int tid_ = F.wave * 64 + (lane_asm() & 63);
          stage_tile<256>(XSl, XS_LD, P2 + (size_t)row0 * P2W + P2_XBC + (g * 8 + half * 4) * 64, tid_);
          stage_tile<128>(Bl, BC_LD, P2 + (size_t)row0 * P2W + P2_XBC + 1024 + g * 128, tid_);
          stage_tile<128>(Cl, BC_LD, P2 + (size_t)row0 * P2W + P2_XBC + 1280 + g * 128, tid_); }
        const int lane = lane_asm() & 63, row = lane & 15, quad = lane >> 4;
        float tot1 = 0.f;
        { const int hl = F.wave >> 1, d = F.wave & 1, h = g * 8 + half * 4 + hl;
          const float aa = -__expf(arg_in(a, I_SALOG)[(layer * 2 + d) * 16 + h]);
          const float dt0 = DT[(size_t)(row0 + lane) * 32 + d * 16 + h], dt1 = DT[(size_t)(row0 + 64 + lane) * 32 + d * 16 + h];
          const float da0 = dt0 * aa, da1 = dt1 * aa;
          float c0 = wave_incl_scan(da0, lane); const float t0 = bperm(c0, 63); float c1 = wave_incl_scan(da1, lane) + t0;
          LAS float* tb = tab + hl * 512;
          if (d == 0) { tb[lane] = c0; tb[64 + lane] = c1; tb[256 + lane] = __logf(dt0) - c0; tb[320 + lane] = __logf(dt1) - c1; }
          else { tb[128 + lane] = c0 - da0; tb[192 + lane] = c1 - da1; tb[384 + lane] = (c0 - da0) + __logf(dt0); tb[448 + lane] = (c1 - da1) + __logf(dt1); if (lane == 63) tab[2048 + hl] = c1; } }
        __syncthreads();
        { f32x4 cb[8];
#pragma unroll
          for (int st = 0; st < 8; ++st) cb[st] = (f32x4){0.f, 0.f, 0.f, 0.f};
#pragma unroll
          for (int k0 = 0; k0 < 128; k0 += 32) { const bf16x8 af = *(const LAS bf16x8*)(Cl + (F.wave * 16 + row) * BC_LD + k0 + quad * 8);
#pragma unroll
              for (int st = 0; st < 8; ++st) { const bf16x8 bfr = *(const LAS bf16x8*)(Bl + (st * 16 + row) * BC_LD + k0 + quad * 8); cb[st] = MFMA16(af, bfr, cb[st]); } }
          __syncthreads();
#pragma unroll
          for (int st = 0; st < 8; ++st)
#pragma unroll
              for (int jj = 0; jj < 4; ++jj) Bl[(F.wave * 16 + quad * 4 + jj) * BC_LD + st * 16 + row] = (bf16_t)f2bf(cb[st][jj]); }
        __syncthreads();
        const int hl = F.wave >> 1, th = F.wave & 1, h = g * 8 + half * 4 + hl;
        const LAS float* tb = tab + hl * 512; tot1 = tab[2048 + hl];
        f32x4 acc[4][4];
#pragma unroll
        for (int i = 0; i < 4; ++i)
#pragma unroll
            for (int j = 0; j < 4; ++j) acc[i][j] = (f32x4){0.f, 0.f, 0.f, 0.f};
#pragma unroll 1
        for (int k0 = 0; k0 < 128; k0 += 32) {
            const int sb = k0 + quad * 8;
            float u0s[8], u1s[8];
#pragma unroll
            for (int j = 0; j < 8; ++j) { u0s[j] = tb[256 + sb + j]; u1s[j] = tb[384 + sb + j]; }
            bf16x8 bx[4];
#pragma unroll
            for (int pt = 0; pt < 4; ++pt) {
#pragma unroll
                for (int j = 0; j < 8; ++j) bx[pt][j] = (short)XSl[(sb + j) * XS_LD + hl * 64 + pt * 16 + row]; }
#pragma unroll
            for (int tt = 0; tt < 4; ++tt) { const int t = th * 64 + tt * 16 + row; const float c0t = tb[t], e1t = tb[128 + t];
                float cbv[8]; { const u32x4 w = *(const LAS u32x4*)(Bl + t * BC_LD + sb); cbv[0] = bflo(w.x); cbv[1] = bfhi(w.x); cbv[2] = bflo(w.y); cbv[3] = bfhi(w.y); cbv[4] = bflo(w.z); cbv[5] = bfhi(w.z); cbv[6] = bflo(w.w); cbv[7] = bfhi(w.w); }
                bf16x8 af;
#pragma unroll
                for (int j = 0; j < 8; ++j) { const int s = sb + j;
                    const float f0 = s <= t ? __expf(c0t + u0s[j]) : 0.f;
                    const float f1 = s >= t ? __expf(u1s[j] - e1t) : 0.f;
                    af[j] = (short)f2bf(cbv[j] * (f0 + f1)); }
#pragma unroll
                for (int pt = 0; pt < 4; ++pt) acc[tt][pt] = MFMA16(af, bx[pt], acc[tt][pt]); }
        }
#pragma unroll 1
        for (int d = 0; d < 2; ++d) {
            const bf16_t* S = MST + ((size_t)(d * NCHUNK + chunk) * 16 + h) * 8192;
#pragma unroll 1
            for (int k0 = 0; k0 < 128; k0 += 32) {
                bf16x8 bs[4];
#pragma unroll
                for (int pt = 0; pt < 4; ++pt) bs[pt] = *(const bf16x8*)(S + (pt * 16 + row) * 128 + k0 + quad * 8);
#pragma unroll
                for (int tt = 0; tt < 4; ++tt) { const int t = th * 64 + tt * 16 + row;
                    const float sc = d == 0 ? __expf(tb[t]) : __expf(tot1 - tb[128 + t]);
                    const u32x4 cw = *(const LAS u32x4*)(Cl + t * BC_LD + k0 + quad * 8);
                    u32x4 aw; aw.x = cvt_pk_bf16(bflo(cw.x) * sc, bfhi(cw.x) * sc); aw.y = cvt_pk_bf16(bflo(cw.y) * sc, bfhi(cw.y) * sc);
                    aw.z = cvt_pk_bf16(bflo(cw.z) * sc, bfhi(cw.z) * sc); aw.w = cvt_pk_bf16(bflo(cw.w) * sc, bfhi(cw.w) * sc);
                    const bf16x8 af = __builtin_bit_cast(bf16x8, aw);
#pragma unroll
                    for (int pt = 0; pt < 4; ++pt) acc[tt][pt] = MFMA16(af, bs[pt], acc[tt][pt]); } }
        }
        const float Dh = arg_in(a, I_SD)[layer * 16 + h];
#pragma unroll
        for (int tt = 0; tt < 4; ++tt)
#pragma unroll
            for (int jj = 0; jj < 4; ++jj) { const int t = th * 64 + tt * 16 + quad * 4 + jj; const size_t r = (size_t)(row0 + t);
#pragma unroll
                for (int pt = 0; pt < 4; ++pt) { const int p = pt * 16 + row;
                    const float xs = bf2f(XSl[t * XS_LD + hl * 64 + p]); const float z = bf2f(P[r * NNG + P_Z + h * 64 + p]);
                    YB[r * 1024 + h * 64 + p] = (bf16_t)f2bf((acc[tt][pt][jj] + xs * Dh) * siluf_(z)); } }
    }
}
__device__ __forceinline__ void phase_mamba_norm(Frame& F, const Args& a, int layer) {
    bf16_t* YB = WSP(bf16_t, WS_Y) + (size_t)1 * T * 1024; const float* nw = arg_in(a, I_SNORM) + layer * 1024;
    for (int row = F.gw; row < T; row += F.NGW) {
        bf16_t* p = YB + (size_t)row * 1024 + F.lane * 16; float x[16]; { float t0[8], t1[8]; ld8bf(p, t0); ld8bf(p + 8, t1);
#pragma unroll
            for (int i = 0; i < 8; ++i) { x[i] = t0[i]; x[8 + i] = t1[i]; } }
        float s = 0.f;
#pragma unroll
        for (int i = 0; i < 16; ++i) s += x[i] * x[i];
        s = sum32(s);
        const float r = 1.f / sqrtf(s * (1.f / 512.f) + 1e-5f);
        float o0[8], o1[8];
#pragma unroll
        for (int i = 0; i < 8; ++i) { o0[i] = x[i] * r * nw[F.lane * 16 + i]; o1[i] = x[8 + i] * r * nw[F.lane * 16 + 8 + i]; }
        st8bf(p, o0); st8bf(p + 8, o1);
    }
}

__device__ __forceinline__ float dpp_f(float x, const int ctrl_sel) {
    const int xi = __builtin_bit_cast(int, x); int r;
    if (ctrl_sel == 0) r = __builtin_amdgcn_update_dpp(0, xi, 0xB1, 0xF, 0xF, false);
    else if (ctrl_sel == 1) r = __builtin_amdgcn_update_dpp(0, xi, 0x4E, 0xF, 0xF, false);
    else r = __builtin_amdgcn_update_dpp(0, xi, 0x141, 0xF, 0xF, false);
    return __builtin_bit_cast(float, r);
}
__device__ __forceinline__ float red8(float x) { x += dpp_f(x, 0); x += dpp_f(x, 1); x += dpp_f(x, 2); return x; }
__device__ __forceinline__ int rw_row(int pos, int b, int d) { return pos < CTX ? b * CTX + (d == 0 ? pos : CTX - 1 - pos) : TC + b * SEQ + (d == 0 ? pos - CTX : SEQ - 1 - (pos - CTX)); }
constexpr int RW_STEP_F = 336, RW_CH = 32, RW_CHF = RW_STEP_F * RW_CH;
struct RwOps { f32x4 w, k, b, a, r; float v; };
__device__ __forceinline__ void rw_load(RwOps& o, const LAS float* sp, const LAS float* vp) {
    o.w = *(const LAS f32x4*)(sp); o.k = *(const LAS f32x4*)(sp + 64); o.b = *(const LAS f32x4*)(sp + 128); o.a = *(const LAS f32x4*)(sp + 192); o.r = *(const LAS f32x4*)(sp + 256); o.v = *vp;
}
__device__ __forceinline__ void rw_step(f32x4& s, const RwOps& o, LAS float* yp) {
    const f32x4 tt = s * o.w + o.k * o.v;
    const f32x4 pa = s * o.a; float sa = (pa.x + pa.y) + (pa.z + pa.w); sa = sum16(sa);
    s = tt + o.b * sa;
    const f32x4 pr = s * o.r; *yp = (pr.x + pr.y) + (pr.z + pr.w);
}
struct RwRaw { unsigned ew[4], ic[4], kk[4], rr[4], kr[4], vv[4]; };
__device__ __forceinline__ void phase_rwkv_scan(Frame& F, const Args& a, int layer) {
    const bf16_t* P2 = WSP(bf16_t, WS_P2); const bf16_t* EW = WSP(bf16_t, WS_EW); const bf16_t* ICLR = WSP(bf16_t, WS_ICLR); const bf16_t* KK = WSP(bf16_t, WS_KK);
    bf16_t* YRW = WSP(bf16_t, WS_YRW);
    LAS float* ring = (LAS float*)F.lds; LAS float* ybuf = (LAS float*)(F.lds + 2 * RW_CHF * 4);
    const int lane = F.lane;
    for (int u = F.bid; u < 256; u += F.G) {
        const int chain = u >> 2, rq = u & 3, d = chain >> 5, b = (chain >> 4) & 1, h = chain & 15;
        constexpr int NCH = (CTX + SEQ) / RW_CH;
        const int lw = F.wave - 4;
        const int tsel = lane >> 5, kp = lane & 31;
        const f32x2 ka2 = *(const f32x2*)(arg_in(a, I_RKA) + layer * 1024 + h * 64 + 2 * kp);
        auto issue = [&](RwRaw& x, int cidx) {
            const int row0 = rw_row(cidx * RW_CH, b, d), st = d == 0 ? 1 : -1;
            const int tk0 = 2 * lw + tsel;
            const unsigned* ewp = (const unsigned*)(EW + (size_t)d * T * 1024); const unsigned* icp = (const unsigned*)(ICLR + (size_t)d * T * 1024);
            const unsigned* kkp = (const unsigned*)KK; const unsigned* p2p = (const unsigned*)P2;
#pragma unroll
            for (int j = 0; j < 4; ++j) { const int row = row0 + st * (8 * j + tk0); const int o = (row * 1024 + h * 64) / 2 + kp, q = (row * P2W + P2_RKV + h * 64) / 2 + kp;
                x.ew[j] = ewp[o]; x.ic[j] = icp[o]; x.kk[j] = kkp[o]; x.rr[j] = p2p[q]; x.kr[j] = p2p[q + 512]; x.vv[j] = p2p[q + 1024 + rq * 8 - kp + (kp & 7)]; } };
        auto commit = [&](const RwRaw& x, int cidx) {
            LAS float* dst = ring + (cidx & 1) * RW_CHF;
#pragma unroll
            for (int j = 0; j < 4; ++j) { LAS float* sbase = dst + (8 * j + 2 * lw + tsel) * RW_STEP_F; LAS f32x2* s2 = (LAS f32x2*)sbase + kp;
                const f32x2 ew = {bflo(x.ew[j]), bfhi(x.ew[j])}, ic = {bflo(x.ic[j]), bfhi(x.ic[j])}, kkv = {bflo(x.kk[j]), bfhi(x.kk[j])}, rr = {bflo(x.rr[j]), bfhi(x.rr[j])}, kr = {bflo(x.kr[j]), bfhi(x.kr[j])};
                s2[0] = (f32x2){__expf(-ew.x), __expf(-ew.y)}; s2[32] = kr * ((ic - 1.f) * ka2 + 1.f); s2[64] = kkv * ic; s2[96] = -kkv; s2[128] = rr;
                if (kp < 8) s2[160] = (f32x2){bflo(x.vv[j]), bfhi(x.vv[j])}; } };
        auto flush_chunk = [&](int cidx) {
            const LAS float* yb = ybuf + (cidx & 1) * (RW_CH * 256);
            const int row0 = rw_row(cidx * RW_CH, b, d), st = d == 0 ? 1 : -1;
#pragma unroll
            for (int q = 0; q < 2; ++q) { const int i = (F.tid - 256) + 256 * q, tok = i >> 4, rr = i & 15; const LAS f32x4* pp = (const LAS f32x4*)(yb + i * 16);
                const f32x4 p0 = pp[0], p1 = pp[1], p2 = pp[2], p3 = pp[3];
                const float y = ((p0.x + p0.y) + (p0.z + p0.w)) + ((p1.x + p1.y) + (p1.z + p1.w)) + (((p2.x + p2.y) + (p2.z + p2.w)) + ((p3.x + p3.y) + (p3.z + p3.w)));
                YRW[((size_t)d * T + row0 + st * tok) * 1024 + h * 64 + rq * 16 + rr] = (bf16_t)f2bf(y); } };
        auto compute = [&](f32x4& s, int c) {
            const int rloc = lane >> 4, kq = lane & 15, r16 = F.wave * 4 + rloc;
            const LAS float* base = ring + (c & 1) * RW_CHF + kq * 4; const LAS float* vb = ring + (c & 1) * RW_CHF + 320 + r16; LAS float* yb = ybuf + (c & 1) * (RW_CH * 256) + r16 * 16 + kq;
            RwOps o0, o1, o2, o3;
            rw_load(o0, base, vb); rw_load(o1, base + RW_STEP_F, vb + RW_STEP_F); rw_load(o2, base + 2 * RW_STEP_F, vb + 2 * RW_STEP_F);
#pragma unroll
            for (int t = 0; t < RW_CH; t += 4) {
                if (t + 3 < RW_CH) rw_load(o3, base + (t + 3) * RW_STEP_F, vb + (t + 3) * RW_STEP_F);
                rw_step(s, o0, yb + t * 256);
                if (t + 4 < RW_CH) rw_load(o0, base + (t + 4) * RW_STEP_F, vb + (t + 4) * RW_STEP_F);
                rw_step(s, o1, yb + (t + 1) * 256);
                if (t + 5 < RW_CH) rw_load(o1, base + (t + 5) * RW_STEP_F, vb + (t + 5) * RW_STEP_F);
                rw_step(s, o2, yb + (t + 2) * 256);
                if (t + 6 < RW_CH) rw_load(o2, base + (t + 6) * RW_STEP_F, vb + (t + 6) * RW_STEP_F);
                rw_step(s, o3, yb + (t + 3) * 256);
            } };
        __syncthreads();
        f32x4 s = {0.f, 0.f, 0.f, 0.f};
        if (F.wave >= 4) {
            RwRaw ra, rb;
            issue(ra, 0); commit(ra, 0); issue(ra, 1);
            __syncthreads();
            for (int c = 0; c < NCH; c += 2) {
                if (c + 2 < NCH) issue(rb, c + 2);
                if (c > 0) flush_chunk(c - 1);
                commit(ra, c + 1);
                __syncthreads();
                if (c + 3 < NCH) issue(ra, c + 3);
                flush_chunk(c);
                if (c + 2 < NCH) commit(rb, c + 2);
                __syncthreads();
            }
            flush_chunk(NCH - 1);
        } else {
            __syncthreads();
            for (int c = 0; c < NCH; c += 2) { compute(s, c); __syncthreads(); compute(s, c + 1); __syncthreads(); }
        }
    }
}
__device__ __forceinline__ void phase_rwkv_out(Frame& F, const Args& a, int layer) {
    const bf16_t* P2 = WSP(bf16_t, WS_P2); const bf16_t* ICLR = WSP(bf16_t, WS_ICLR); const bf16_t* YRW = WSP(bf16_t, WS_YRW); const bf16_t* GG = WSP(bf16_t, WS_GG);
    bf16_t* YD = WSP(bf16_t, WS_Y) + (size_t)3 * T * 1024;
    const float* lng = arg_in(a, I_RLNG) + layer * 1024; const float* lnb = arg_in(a, I_RLNB) + layer * 1024; const float* rk = arg_in(a, I_RRK) + layer * 1024; const float* kav = arg_in(a, I_RKA) + layer * 1024;
    for (int row = F.gw; row < T; row += F.NGW) {
        const int c = F.lane * 16; const size_t o = (size_t)row * 1024 + c;
        float y[16], r[16], k[16], v[16], i0[16], i1[16], g[16];
#define LD16(dst, ptr) do { float t0_[8], t1_[8]; ld8bf((ptr), t0_); ld8bf((ptr) + 8, t1_); _Pragma("unroll") for (int i_ = 0; i_ < 8; ++i_) { dst[i_] = t0_[i_]; dst[8 + i_] = t1_[i_]; } } while (0)
        LD16(y, YRW + o); LD16(r, YRW + (size_t)T * 1024 + o);
#pragma unroll
        for (int i = 0; i < 16; ++i) y[i] += r[i];
        const bf16_t* p2 = P2 + (size_t)row * P2W + P2_RKV + c;
        LD16(r, p2); LD16(k, p2 + 1024); LD16(v, p2 + 2048); LD16(i0, ICLR + o); LD16(i1, ICLR + (size_t)T * 1024 + o); LD16(g, GG + o);
#undef LD16
        float s = 0.f, bsum = 0.f;
#pragma unroll
        for (int i = 0; i < 16; ++i) { s += y[i]; const float ka = kav[c + i]; bsum += r[i] * k[i] * rk[c + i] * ((1.f + (i0[i] - 1.f) * ka) + (1.f + (i1[i] - 1.f) * ka)); }
        s = sum4(s); bsum = sum4(bsum);
        const float mu = s * (1.f / 64.f); float q = 0.f;
#pragma unroll
        for (int i = 0; i < 16; ++i) { const float dd = y[i] - mu; q += dd * dd; }
        q = sum4(q);
        const float rstd = 1.f / sqrtf(q * (1.f / 64.f) + 64e-5f);
        float o0[8], o1[8];
#pragma unroll
        for (int i = 0; i < 8; ++i) { o0[i] = ((y[i] - mu) * rstd * lng[c + i] + lnb[c + i] + bsum * v[i]) * g[i];
            o1[i] = ((y[8 + i] - mu) * rstd * lng[c + 8 + i] + lnb[c + 8 + i] + bsum * v[8 + i]) * g[8 + i]; }
        st8bf(YD + o, o0); st8bf(YD + o + 8, o1);
    }
}

constexpr int FFT_N = 16384;
__device__ __forceinline__ int fswz(int i) { return i ^ (((i >> 5) & 3) << 2) ^ (((i >> 6) & 1) << 4); }
__device__ __forceinline__ f32x2 cmul(f32x2 a, f32x2 b) { return (f32x2){a.x * b.x - a.y * b.y, a.x * b.y + a.y * b.x}; }
template <bool INV>
__device__ __forceinline__ void fft_passes(LAS f32x2* X, int tid) {
#pragma unroll 1
    for (int st = 0; st < 7; ++st) {
        const int lq = INV ? 2 * st : 12 - 2 * st;
        const int q = 1 << lq;
        __syncthreads();
#pragma unroll 2
        for (int mm = 0; mm < 8; ++mm) { const int uu = tid + 512 * mm; const int k = uu & (q - 1), blk = uu >> lq; const int i0 = (blk << (lq + 2)) + k;
            const int p0 = fswz(i0), p1 = fswz(i0 + q), p2 = fswz(i0 + 2 * q), p3 = fswz(i0 + 3 * q);
            f32x2 a0 = X[p0], a1 = X[p1], a2 = X[p2], a3 = X[p3];
            const float fr = (float)k / (float)(4 * q);
            const float cs = __builtin_amdgcn_cosf(fr), sn = __builtin_amdgcn_sinf(fr);
            const f32x2 w1 = INV ? (f32x2){cs, sn} : (f32x2){cs, -sn}; const f32x2 w2 = cmul(w1, w1), w3 = cmul(w2, w1);
            if (!INV) {
                const f32x2 t0 = a0 + a2, t1 = a0 - a2, t2 = a1 + a3, t3 = a1 - a3;
                const f32x2 b0 = t0 + t2, b2 = t0 - t2, b1 = (f32x2){t1.x + t3.y, t1.y - t3.x}, b3 = (f32x2){t1.x - t3.y, t1.y + t3.x};
                X[p0] = b0; X[p1] = cmul(b1, w1); X[p2] = cmul(b2, w2); X[p3] = cmul(b3, w3);
            } else {
                a1 = cmul(a1, w1); a2 = cmul(a2, w2); a3 = cmul(a3, w3);
                const f32x2 u0 = a0 + a2, u1 = a0 - a2, u2 = a1 + a3, u3 = a1 - a3;
                X[p0] = u0 + u2; X[p2] = u0 - u2; X[p1] = (f32x2){u1.x - u3.y, u1.y + u3.x}; X[p3] = (f32x2){u1.x + u3.y, u1.y - u3.x};
            } }
    }
    __syncthreads();
}
__device__ __forceinline__ void phase_hyena_fft(Frame& F, const Args& a, int layer, bool dry = false) {
    const bf16_t* FILT = WSP(bf16_t, WS_FILT); float* VT = WSP(float, WS_VT); const float* hyd = arg_in(a, I_HD) + layer * 1024;
    LAS f32x2* X = (LAS f32x2*)F.lds;
    for (int c = F.bid; c < 1024; c += F.G) {
        __syncthreads();
        const int tid = F.wave * 64 + (lane_asm() & 63), i0 = tid * 16;
        { const bf16_t* hf = FILT + (size_t)c * 2 * SEQ; const bf16_t* hb = hf + SEQ;
          float f[16], g[16]; ld8bf(hf + i0, *(float(*)[8])&f[0]); ld8bf(hf + i0 + 8, *(float(*)[8])&f[8]);
          ld8bf(hb + (SEQ - 16 - i0), *(float(*)[8])&g[0]); ld8bf(hb + (SEQ - 8 - i0), *(float(*)[8])&g[8]);
#pragma unroll
          for (int j = 0; j < 16; ++j) X[fswz(i0 + j)] = (f32x2){f[j], 0.f};
#pragma unroll
          for (int j = 0; j < 16; ++j) { const int pos = SEQ + i0 + 1 + j; if (pos < FFT_N) X[fswz(pos)] = (f32x2){g[15 - j], 0.f}; }
          if (tid == 0) { float zz = 0.f; asm volatile("" : "+v"(zz)); X[fswz(SEQ)] = (f32x2){zz, zz}; } }
        fft_passes<false>(X, F.tid);
        f32x2 Kh[32];
#pragma unroll
        for (int j = 0; j < 32; ++j) Kh[j] = X[fswz(F.tid + 512 * j)];
        __syncthreads();
        float* v0 = VT + (size_t)c * 2 * SEQ; float* v1 = v0 + SEQ;
        { f32x4 a0[4], a1[4];
#pragma unroll
          for (int q = 0; q < 4; ++q) { a0[q] = *(const f32x4*)(v0 + i0 + 4 * q); a1[q] = *(const f32x4*)(v1 + i0 + 4 * q); }
#pragma unroll
          for (int q = 0; q < 4; ++q) { X[fswz(i0 + 4 * q)] = (f32x2){a0[q].x, a1[q].x}; X[fswz(i0 + 4 * q + 1)] = (f32x2){a0[q].y, a1[q].y}; X[fswz(i0 + 4 * q + 2)] = (f32x2){a0[q].z, a1[q].z}; X[fswz(i0 + 4 * q + 3)] = (f32x2){a0[q].w, a1[q].w}; }
          { float zz = 0.f; asm volatile("" : "+v"(zz));
#pragma unroll
          for (int j = 0; j < 16; ++j) X[fswz(SEQ + i0 + j)] = (f32x2){zz, zz}; } }
        fft_passes<false>(X, F.tid);
#pragma unroll
        for (int j = 0; j < 32; ++j) { const int p = fswz(F.tid + 512 * j); X[p] = cmul(X[p], Kh[j]); }
        fft_passes<true>(X, F.tid);
        const float dc = hyd[c];
        { f32x4 a0[4], a1[4];
#pragma unroll
          for (int q = 0; q < 4; ++q) { a0[q] = *(const f32x4*)(v0 + i0 + 4 * q); a1[q] = *(const f32x4*)(v1 + i0 + 4 * q); }
#pragma unroll
          for (int q = 0; q < 4; ++q) { const f32x2 r0 = X[fswz(i0 + 4 * q)], r1 = X[fswz(i0 + 4 * q + 1)], r2 = X[fswz(i0 + 4 * q + 2)], r3 = X[fswz(i0 + 4 * q + 3)];
              const f32x4 o0 = (f32x4){r0.x, r1.x, r2.x, r3.x} * (1.f / FFT_N) + a0[q] * dc, o1 = (f32x4){r0.y, r1.y, r2.y, r3.y} * (1.f / FFT_N) + a1[q] * dc;
              if (!dry) { *(f32x4*)(v0 + i0 + 4 * q) = o0; *(f32x4*)(v1 + i0 + 4 * q) = o1; } } }
    }
}
__device__ __forceinline__ void phase_hyena_out(Frame& F, const Args& a, int layer) {
    const float* VT = WSP(float, WS_VT); const bf16_t* P2 = WSP(bf16_t, WS_P2); bf16_t* YC = WSP(bf16_t, WS_Y) + (size_t)2 * T * 1024;
    LAS float* tl = (LAS float*)F.lds;
    for (int u = F.bid; u < (TL / 64) * 4; u += F.G) {
        const int tb = u >> 2, cb = u & 3; const int row0 = TC + tb * 64; const int b = (row0 - TC) >> 13, t0 = (row0 - TC) & (SEQ - 1);
        __syncthreads();
        for (int p = 0; p < 8; ++p) { const int cl = p * 32 + (F.tid >> 4), q = F.tid & 15;
            const f32x4 v = *(const f32x4*)(VT + ((size_t)(cb * 256 + cl) * 2 + b) * SEQ + t0 + 4 * q);
            tl[cl * 65 + 4 * q] = v.x; tl[cl * 65 + 4 * q + 1] = v.y; tl[cl * 65 + 4 * q + 2] = v.z; tl[cl * 65 + 4 * q + 3] = v.w; }
        __syncthreads();
        const int cl = F.tid & 255, th = F.tid >> 8;
        for (int i = 0; i < 32; ++i) { const int tl_ = th * 32 + i; const size_t row = (size_t)(row0 + tl_);
            const float x0 = bf2f(P2[row * P2W + P2_X0 + cb * 256 + cl]);
            YC[row * 1024 + cb * 256 + cl] = (bf16_t)f2bf(tl[cl * 65 + tl_] * x0); }
    }
    const float* VC = WSP(float, WS_VC); const float* FC = WSP(float, WS_FILTC); const float* hyd = arg_in(a, I_HD) + layer * 1024;
    for (int it = F.gw; it < 2 * 16 * 16; it += F.NGW) {
        const int b = it >> 8, cbk = (it >> 4) & 15, tb = it & 15; const int c = cbk * 64 + F.lane, t0 = tb * 16;
        const float* vb = VC + (size_t)b * CTX * 1024 + c; const float* fc = FC + c;
        float acc[16];
#pragma unroll
        for (int i = 0; i < 16; ++i) acc[i] = 0.f;
#pragma unroll 1
        for (int sb = 0; sb < 16; ++sb) { const int s0 = sb * 16, dl = t0 - s0;
            float f[31], v[16];
#pragma unroll
            for (int j = 0; j < 31; ++j) { const int lag = dl + j - 15; f[j] = lag >= 0 ? fc[(size_t)lag * 2048] : fc[(size_t)(-lag) * 2048 + 1024]; }
#pragma unroll
            for (int j = 0; j < 16; ++j) v[j] = vb[(size_t)(s0 + j) * 1024];
#pragma unroll
            for (int i = 0; i < 16; ++i)
#pragma unroll
                for (int j = 0; j < 16; ++j) acc[i] += f[i - j + 15] * v[j]; }
#pragma unroll
        for (int i = 0; i < 16; ++i) { const int t = t0 + i; const size_t row = (size_t)(b * CTX + t);
            const float x0 = bf2f(P2[row * P2W + P2_X0 + c]);
            YC[row * 1024 + c] = (bf16_t)f2bf((acc[i] + vb[(size_t)t * 1024] * hyd[c]) * x0); }
    }
}

__device__ __forceinline__ void phase_ln1(Frame& F, const Args& a, int layer) {
    const float* mod = (const float*)(F.ws + WS_CTL) + CW_MOD + (size_t)layer * 3 * 6 * DM;
    const float* YM = WSP(float, WS_YMIX); float* XS = WSP(float, WS_XS); unsigned* H2 = WSP(unsigned, WS_H2); float* AFF = WSP(float, WS_AFF); int* INV = WSP(int, WS_INV);
    const float* g1w = arg_in(a, I_LN1G) + layer * DM; const float* b1w = arg_in(a, I_LN1B) + layer * DM; const float* wr = arg_in(a, I_WROUTER) + (size_t)layer * DM * NEXP;
    LAS float* wrT = (LAS float*)F.lds;
    __syncthreads();
    for (int i = F.tid; i < DM * NEXP; i += NTHREADS) { const int c = i >> 4, e = i & 15; wrT[e * DM + c] = wr[i]; }
    __syncthreads();
    int* PTOK = WSP(int, WS_PTOK); float* PG = WSP(float, WS_PGATE);
    for (int i = F.bid * NTHREADS + F.tid; i < NPAIR; i += F.G * NTHREADS) { PTOK[i] = -1; PG[i] = 0.f; }
    for (int row = F.gw; row < T; row += F.NGW) {
        const f32x4* xr = (const f32x4*)x_src_row(a, F, layer, row) + F.lane; const f32x4* yr = (const f32x4*)(YM + (size_t)row * DM) + F.lane;
        const float* m = mod + (size_t)row_modidx(row) * 6 * DM;
        f32x4 v[8];
#pragma unroll
        for (int j = 0; j < 8; ++j) { const int c = 4 * (64 * j + F.lane); v[j] = xr[64 * j] * ALPHA + *(const f32x4*)(m + 2 * DM + c) * yr[64 * j]; }
        float mean, rstd; row_stats(v, mean, rstd, 1e-6f);
        f32x4* xo = (f32x4*)(XS + (size_t)row * DM) + F.lane;
#pragma unroll
        for (int j = 0; j < 8; ++j) { const int c = 4 * (64 * j + F.lane); v[j] = (v[j] - mean) * rstd * *(const f32x4*)(g1w + c) + *(const f32x4*)(b1w + c); xo[64 * j] = v[j]; }
        row_stats(v, mean, rstd, 1e-6f);
        unsigned* ho = H2 + (size_t)row * (DM / 4) + F.lane;
        float lg[16];
#pragma unroll
        for (int e = 0; e < 16; ++e) lg[e] = 0.f;
#pragma unroll
        for (int j = 0; j < 8; ++j) { const int c = 4 * (64 * j + F.lane);
            const f32x4 y = (v[j] - mean) * rstd * (*(const f32x4*)(m + 4 * DM + c) + 1.f) + *(const f32x4*)(m + 3 * DM + c);
            ho[64 * j] = pk4fp8(y.x, y.y, y.z, y.w);
#pragma unroll
            for (int e = 0; e < 16; ++e) { const f32x4 ww = *(const LAS f32x4*)(wrT + e * DM + c); lg[e] += (y.x * ww.x + y.y * ww.y) + (y.z * ww.z + y.w * ww.w); } }
        float mx = -1e30f;
#pragma unroll
        for (int e = 0; e < 16; ++e) { lg[e] = wave_sum(lg[e]); mx = fmaxf(mx, lg[e]); }
        float den = 0.f;
#pragma unroll
        for (int e = 0; e < 16; ++e) { lg[e] = __expf(lg[e] - mx); den += lg[e]; }
        float mine = 0.f;
#pragma unroll
        for (int e = 0; e < 16; ++e) mine = (F.lane == e) ? lg[e] : mine;
        if (F.lane < 16) { AFF[(size_t)row * 16 + F.lane] = mine / den; INV[(size_t)row * 16 + F.lane] = -1; }
    }
}
__device__ __forceinline__ void phase_topk(Frame& F, bool lat_only) {
    const float* AFF = WSP(float, WS_AFF); int* INV = WSP(int, WS_INV); int* PTOK = WSP(int, WS_PTOK); float* PG = WSP(float, WS_PGATE);
    LAS unsigned* vals = (LAS unsigned*)F.lds; LAS unsigned* hist = vals + 8192; LAS unsigned* ctl = hist + 256;
    for (int u = F.bid + (lat_only ? 32 : 0); u < 64; u += F.G) {
        const int s = u >> 4, e = u & 15, rs = seg_start(s), n = seg_len(s), cap = s < 2 ? CAP_C : CAP_L;
        __syncthreads();
        for (int i = F.tid; i < n; i += NTHREADS) vals[i] = __builtin_bit_cast(unsigned, AFF[(size_t)(rs + i) * 16 + e]);
        if (F.tid == 0) { ctl[0] = 0u; ctl[1] = (unsigned)cap; ctl[2] = 0u; ctl[3] = 0u; }
        unsigned mask = 0u;
        for (int shift = 24; shift >= 0; shift -= 8) {
            if (F.tid < 256) hist[F.tid] = 0u;
            __syncthreads();
            const unsigned prefix = ctl[0];
            for (int i = F.tid; i < n; i += NTHREADS) { const unsigned b = vals[i]; if ((b & mask) == prefix) __hip_atomic_fetch_add(&hist[(b >> shift) & 255u], 1u, __ATOMIC_RELAXED, __HIP_MEMORY_SCOPE_WORKGROUP); }
            __syncthreads();
            if (F.tid == 0) { unsigned rem = ctl[1], cum = 0u; int dg = 255; for (; dg > 0; --dg) { const unsigned hc = hist[dg]; if (cum + hc >= rem) break; cum += hc; }
                ctl[1] = rem - cum; ctl[0] = prefix | ((unsigned)dg << shift); }
            mask |= 255u << shift;
            __syncthreads();
        }
        const unsigned thr = ctl[0], rem = ctl[1]; const unsigned ngt = (unsigned)cap - rem;
        const int pbase = s < 2 ? NBATCH * NEXP * CAP_L + e * 256 + s * CAP_C : ((s - 2) * NEXP + e) * CAP_L;
        for (int i = F.tid; i < n; i += NTHREADS) { const unsigned b = vals[i]; int slot = -1;
            if (b > thr) slot = (int)__hip_atomic_fetch_add(&ctl[2], 1u, __ATOMIC_RELAXED, __HIP_MEMORY_SCOPE_WORKGROUP);
            else if (b == thr) { const unsigned q = __hip_atomic_fetch_add(&ctl[3], 1u, __ATOMIC_RELAXED, __HIP_MEMORY_SCOPE_WORKGROUP); if (q < rem) slot = (int)(ngt + q); }
            if (slot >= 0) { const int pair = pbase + slot, row = rs + i; PTOK[pair] = row; PG[pair] = __builtin_bit_cast(float, b); INV[(size_t)row * 16 + e] = pair; } }
    }
}
__device__ __forceinline__ void phase_gather(Frame& F) {
    const unsigned char* H2 = WSP(unsigned char, WS_H2); unsigned char* XG = WSP(unsigned char, WS_XG); unsigned char* HID = WSP(unsigned char, WS_HID); const int* PTOK = WSP(int, WS_PTOK);
    for (int p = F.gw; p < NPAIR; p += F.NGW) { const int tok = PTOK[p]; u32x4* dst = (u32x4*)(XG + (size_t)p * DM) + F.lane;
        unsigned zz = 0u; asm volatile("" : "+v"(zz));
        if (tok >= 0) { const u32x4* src = (const u32x4*)(H2 + (size_t)tok * DM) + F.lane; dst[0] = src[0]; dst[64] = src[64]; }
        else { dst[0] = (u32x4){zz, zz, zz, zz}; dst[64] = (u32x4){zz, zz, zz, zz}; }
        if (F.lane < 8) *((u32x4*)(HID + (size_t)p * EFFP + EFF) + F.lane) = (u32x4){zz, zz, zz, zz}; }
}
__device__ __forceinline__ void phase_ln2(Frame& F, const Args& a, int layer) {
    const float* mod = (const float*)(F.ws + WS_CTL) + CW_MOD + (size_t)layer * 3 * 6 * DM;
    float* XS = WSP(float, WS_XS); const bf16_t* YE = WSP(bf16_t, WS_YE); const int* INV = WSP(int, WS_INV); const float* PG = WSP(float, WS_PGATE);
    const float* g2w = arg_in(a, I_LN2G) + layer * DM; const float* b2w = arg_in(a, I_LN2B) + layer * DM;
    for (int row = F.gw; row < T; row += F.NGW) {
        f32x4* xr = (f32x4*)(XS + (size_t)row * DM) + F.lane; const float* m = mod + (size_t)row_modidx(row) * 6 * DM;
        f32x4 mo[8];
#pragma unroll
        for (int j = 0; j < 8; ++j) mo[j] = (f32x4){0.f, 0.f, 0.f, 0.f};
        for (int e = 0; e < 16; ++e) { const int pair = INV[(size_t)row * 16 + e];
            if (pair >= 0) { const u32x2* yr = (const u32x2*)(YE + (size_t)pair * DM) + F.lane; const float pg = PG[pair];
#pragma unroll
                for (int j = 0; j < 8; ++j) { const u32x2 w = yr[64 * j]; mo[j] += (f32x4){bflo(w.x), bfhi(w.x), bflo(w.y), bfhi(w.y)} * pg; } } }
        f32x4 v[8];
#pragma unroll
        for (int j = 0; j < 8; ++j) { const int c = 4 * (64 * j + F.lane); v[j] = xr[64 * j] * ALPHA + *(const f32x4*)(m + 5 * DM + c) * mo[j]; }
        float mean, rstd; row_stats(v, mean, rstd, 1e-6f);
#pragma unroll
        for (int j = 0; j < 8; ++j) { const int c = 4 * (64 * j + F.lane); v[j] = (v[j] - mean) * rstd * *(const f32x4*)(g2w + c) + *(const f32x4*)(b2w + c); xr[64 * j] = v[j]; }
        if (layer == DEPTH - 1) { if (row >= TC) { f32x4* o = (f32x4*)(a.out + (size_t)(row - TC) * DM) + F.lane;
#pragma unroll
            for (int j = 0; j < 8; ++j) o[64 * j] = v[j]; } }
        else {
            row_stats(v, mean, rstd, 1e-6f);
            const float* m1 = m + (size_t)3 * 6 * DM;
            bf16_t* H = WSP(bf16_t, WS_H); unsigned* H8 = WSP(unsigned, WS_H8);
            u32x2* o = (u32x2*)(H + (size_t)row * DM) + F.lane; unsigned* o8 = H8 + (size_t)row * (DM / 4) + F.lane;
#pragma unroll
            for (int j = 0; j < 8; ++j) { const int c = 4 * (64 * j + F.lane); const f32x4 sh = *(const f32x4*)(m1 + c), sc = *(const f32x4*)(m1 + DM + c);
                const f32x4 y = (v[j] - mean) * rstd * (sc + 1.f) + sh; u32x2 w; w.x = pk2(y.x, y.y); w.y = pk2(y.z, y.w); o[64 * j] = w; o8[64 * j] = pk4fp8(y.x, y.y, y.z, y.w); } }
    }
}

constexpr int LDS_BYTES = 153600, MISC_OFF = LDS_BYTES - 64;
constexpr int NPL = 16, NPHASE = 1 + DEPTH * NPL;

__global__ void __launch_bounds__(NTHREADS, 2) fwd_kernel(Args args) {
    extern __shared__ __attribute__((aligned(16))) unsigned char lds_raw[];
    Frame F;
    F.lds = (LAS unsigned char*)lds_raw;
    F.tid = threadIdx.x; F.lane = F.tid & 63; F.wave = __builtin_amdgcn_readfirstlane(F.tid >> 6); const int wave0 = F.wave;
    F.G = gridDim.x; F.bid = blockIdx.x; F.gw = F.bid * NWAVES + F.wave; F.NGW = F.G * NWAVES; F.ws = args.ws;
    volatile LAS unsigned* misc = (volatile LAS unsigned*)(F.lds + MISC_OFF);
    if (F.tid < 16) misc[F.tid] = 0u;
    __syncthreads();
    const int lo = args.ph_lo, hi = args.ph_hi;
    XcdBarrier bar; bar.bar = (unsigned*)(F.ws + WS_CTL) + CW_BAR; bar.x = 0; bar.st = nullptr;
    const bool multi = (hi - lo) > 1;
    if (multi) bar = xcd_barrier_post((unsigned*)(F.ws + WS_CTL) + CW_BAR, misc);
#ifndef ONLY_PHASE
#define ONLY_PHASE -1
#endif
#define PON(r) (ONLY_PHASE < 0 || ONLY_PHASE == (r))
#ifndef REP_MASK
#define REP_MASK 0
#endif
#define REP(b) ((REP_MASK >> (b)) & 1)
#define REOPQ() do { F.ws = opq(args.ws); F.lane = lane_asm() & 63; F.wave = opqs(wave0) & 7; F.tid = F.wave * 64 + F.lane; F.G = opqs(gridDim.x); F.bid = opqs(blockIdx.x); F.gw = F.bid * NWAVES + F.wave; F.NGW = F.G * NWAVES; } while (0)
#define IN(k) (lo <= (k) && (k) < hi)
#define SEAM(k) do { if (IN(k) && IN((k) + 1)) { XcdBarrier bb_ = bar; bb_.x = (unsigned)opqs((int)bar.x); xcd_barrier(bb_); } } while (0)
    if (PON(100) && IN(0)) { F.ws = opq(args.ws); F.lane = lane_asm() & 63; F.wave = opqs(wave0) & 7; F.tid = F.wave * 64 + F.lane; F.G = opqs(gridDim.x); F.bid = opqs(blockIdx.x); F.gw = F.bid * NWAVES + F.wave; F.NGW = F.G * NWAVES; { p0_weights(F, args); __syncthreads(); REOPQ(); p0_mod(F, args); __syncthreads(); REOPQ(); phase_hdn(F, args, 0); REOPQ(); phase_hdn(F, args, 1); __syncthreads(); } }
    SEAM(0);
#pragma unroll 1
    for (int layer = 0; layer < DEPTH; ++layer) {
        const int pb = 1 + layer * NPL; const bool lat_only = (layer == DEPTH - 1);
        if (PON(0) && IN(pb + 0)) { F.ws = opq(args.ws); F.lane = lane_asm() & 63; F.wave = opqs(wave0) & 7; F.tid = F.wave * 64 + F.lane; F.G = opqs(gridDim.x); F.bid = opqs(blockIdx.x); F.gw = F.bid * NWAVES + F.wave; F.NGW = F.G * NWAVES; if (layer == 0) phase_modln(F, args, layer); __syncthreads(); }
        SEAM(pb + 0);
        if (PON(1) && IN(pb + 1)) { F.ws = opq(args.ws); F.lane = lane_asm() & 63; F.wave = opqs(wave0) & 7; F.tid = F.wave * 64 + F.lane; F.G = opqs(gridDim.x); F.bid = opqs(blockIdx.x); F.gw = F.bid * NWAVES + F.wave; F.NGW = F.G * NWAVES;
            pg8::Gemm g{WSP(bf16_t, WS_H), WSP(bf16_t, WS_WIN + layer * SZ_WIN), DM, DM, DM}; pg8::StaticOrder S; S.init(66, NNG / 256, F.G, F.bid);
            EpiBf16 E{WSP(bf16_t, WS_P), NNG, nullptr, 0, 0, 1.f};
            pg8::gemm_phase(F.lds, g, S, E, F.tid);
        }
        SEAM(pb + 1);
        if (PON(2) && IN(pb + 2)) { F.ws = opq(args.ws); F.lane = lane_asm() & 63; F.wave = opqs(wave0) & 7; F.tid = F.wave * 64 + F.lane; F.G = opqs(gridDim.x); F.bid = opqs(blockIdx.x); F.gw = F.bid * NWAVES + F.wave; F.NGW = F.G * NWAVES; { phase_prep(F, args, layer); REOPQ(); phase_filt(F, args, layer); __syncthreads(); } }
        SEAM(pb + 2);
        if (PON(3) && IN(pb + 3)) { F.ws = opq(args.ws); F.lane = lane_asm() & 63; F.wave = opqs(wave0) & 7; F.tid = F.wave * 64 + F.lane; F.G = opqs(gridDim.x); F.bid = opqs(blockIdx.x); F.gw = F.bid * NWAVES + F.wave; F.NGW = F.G * NWAVES;
#if !defined(T3) || T3 == 0
            { pg8::Gemm g{WSP(bf16_t, WS_P) + P_CQ, WSP(bf16_t, WS_WQ + layer * SZ_WQ), NNG, 512, 512}; pg8::StaticOrder S; S.init(lat_only ? 64 : 66, 6, F.G, F.bid, lat_only ? 2 : 0);
              EpiBf16 E{WSP(bf16_t, WS_Q), 1536, WSP(float, WS_RS), 2, 0, 1.f}; pg8::gemm_phase(F.lds, g, S, E, F.tid); }
#endif
#if !defined(T3) || T3 == 1
            { pg8::Gemm g{WSP(bf16_t, WS_P) + P_CKV, WSP(bf16_t, WS_WKV + layer * SZ_WKV), NNG, 512, 512}; pg8::StaticOrder S; S.init(66, 8, F.G, (F.bid + 140) & 255);
              EpiBf16 E{WSP(bf16_t, WS_KV), 2048, WSP(float, WS_RS) + 1, 2, 0, 1.f}; pg8::gemm_phase(F.lds, g, S, E, F.tid); }
#endif
#if !defined(T3) || T3 == 2
            { pg8::Gemm g{WSP(bf16_t, WS_ALORA), WSP(bf16_t, WS_WLORA + layer * SZ_WLORA), 512, 512, 512}; pg8::StaticOrder S; S.init(66, 20, F.G, (F.bid + 156) & 255);
              EpiLora E{WSP(bf16_t, WS_EW), WSP(bf16_t, WS_ICLR), WSP(bf16_t, WS_GG), arg_in(args, I_RW0) + layer * 2048, arg_in(args, I_RA0) + layer * 2048}; pg8::gemm_phase(F.lds, g, S, E, F.tid); }
            REOPQ(); phase_mamba_states(F, args, layer); __syncthreads();
#endif
        }
        SEAM(pb + 3);
        SEAM(pb + 4);
        if (PON(5) && IN(pb + 5)) { F.ws = opq(args.ws); F.lane = lane_asm() & 63; F.wave = opqs(wave0) & 7; F.tid = F.wave * 64 + F.lane; F.G = opqs(gridDim.x); F.bid = opqs(blockIdx.x); F.gw = F.bid * NWAVES + F.wave; F.NGW = F.G * NWAVES;
#if !defined(T5) || T5 == 0
            phase_rwkv_scan(F, args, layer); __syncthreads();
#endif
#if !defined(T5) || T5 == 1
            REOPQ(); phase_attn(F, lat_only);
#endif
#if !defined(T5) || T5 == 2
            REOPQ(); phase_hyena_fft(F, args, layer);
#endif
#if !defined(T5) || T5 == 3
            REOPQ(); phase_mamba_scan(F); __syncthreads();
#endif
        }
        SEAM(pb + 5);
        if (PON(6) && IN(pb + 6)) { F.ws = opq(args.ws); F.lane = lane_asm() & 63; F.wave = opqs(wave0) & 7; F.tid = F.wave * 64 + F.lane; F.G = opqs(gridDim.x); F.bid = opqs(blockIdx.x); F.gw = F.bid * NWAVES + F.wave; F.NGW = F.G * NWAVES;
#if !defined(T6) || T6 == 0
            phase_mamba_out(F, args, layer); __syncthreads();
#endif
#if !defined(T6) || T6 == 1
            REOPQ(); phase_hyena_out(F, args, layer);
#endif
#if !defined(T6) || T6 == 2
            REOPQ(); phase_rwkv_out(F, args, layer); __syncthreads();
#endif
        }
        SEAM(pb + 6);
        if (PON(7) && IN(pb + 7)) { F.ws = opq(args.ws); F.lane = lane_asm() & 63; F.wave = opqs(wave0) & 7; F.tid = F.wave * 64 + F.lane; F.G = opqs(gridDim.x); F.bid = opqs(blockIdx.x); F.gw = F.bid * NWAVES + F.wave; F.NGW = F.G * NWAVES;
            pg8::Gemm g{WSP(bf16_t, WS_H8), WSP(bf16_t, WS_WIN + layer * SZ_WIN) + (size_t)NNG * DM, DM / 2, DM / 2, DM / 2}; pg8::StaticOrder S; S.init(lat_only ? 64 : 66, NGATE / 256, F.G, F.bid, lat_only ? 2 : 0);
            EpiBf16 E{WSP(bf16_t, WS_GATES), NGATE, nullptr, 0, 0, 1.f / 64.f};
            pg8::gemm_phase<EpiBf16, pg8::StaticOrder, true>(F.lds, g, S, E, F.tid);
            REOPQ(); phase_mamba_norm(F, args, layer);
        }
        SEAM(pb + 7);
        if (PON(8) && IN(pb + 8)) { F.ws = opq(args.ws); F.lane = lane_asm() & 63; F.wave = opqs(wave0) & 7; F.tid = F.wave * 64 + F.lane; F.G = opqs(gridDim.x); F.bid = opqs(blockIdx.x); F.gw = F.bid * NWAVES + F.wave; F.NGW = F.G * NWAVES;
            pg8::Gemm g{WSP(bf16_t, WS_Y), WSP(bf16_t, WS_WBR + layer * SZ_WBR), 1024, 1024, 1024}; OrderMerge S; S.init(F.G, F.bid, lat_only ? 64 : 66, lat_only ? 2 : 0);
            EpiMerge E{WSP(bf16_t, WS_GATES), WSP(bf16_t, WS_MRGB)};
            pg8::gemm_phase(F.lds, g, S, E, F.tid);

        }
        SEAM(pb + 8);
        if (PON(9) && IN(pb + 9)) { F.ws = opq(args.ws); F.lane = lane_asm() & 63; F.wave = opqs(wave0) & 7; F.tid = F.wave * 64 + F.lane; F.G = opqs(gridDim.x); F.bid = opqs(blockIdx.x); F.gw = F.bid * NWAVES + F.wave; F.NGW = F.G * NWAVES;
            pg8::Gemm g{WSP(bf16_t, WS_MRGB), WSP(bf16_t, WS_WOUT + layer * SZ_WOUT), DM, DM, DM}; pg8::StaticOrder S; S.init(lat_only ? 64 : 66, 8, F.G, F.bid, lat_only ? 2 : 0);
            EpiF32 E{WSP(float, WS_YMIX), DM};
            pg8::gemm_phase(F.lds, g, S, E, F.tid);

        }
        SEAM(pb + 9);
        if (PON(10) && IN(pb + 10)) { F.ws = opq(args.ws); F.lane = lane_asm() & 63; F.wave = opqs(wave0) & 7; F.tid = F.wave * 64 + F.lane; F.G = opqs(gridDim.x); F.bid = opqs(blockIdx.x); F.gw = F.bid * NWAVES + F.wave; F.NGW = F.G * NWAVES; phase_ln1(F, args, layer); __syncthreads(); { REOPQ(); conv_experts(F, args, layer); __syncthreads(); } }
        SEAM(pb + 10);
        if (PON(11) && IN(pb + 11)) { F.ws = opq(args.ws); F.lane = lane_asm() & 63; F.wave = opqs(wave0) & 7; F.tid = F.wave * 64 + F.lane; F.G = opqs(gridDim.x); F.bid = opqs(blockIdx.x); F.gw = F.bid * NWAVES + F.wave; F.NGW = F.G * NWAVES; phase_topk(F, lat_only); __syncthreads(); }
        SEAM(pb + 11);
        if (PON(12) && IN(pb + 12)) { F.ws = opq(args.ws); F.lane = lane_asm() & 63; F.wave = opqs(wave0) & 7; F.tid = F.wave * 64 + F.lane; F.G = opqs(gridDim.x); F.bid = opqs(blockIdx.x); F.gw = F.bid * NWAVES + F.wave; F.NGW = F.G * NWAVES; phase_gather(F); }
        SEAM(pb + 12);
        if (PON(13) && IN(pb + 13)) { F.ws = opq(args.ws); F.lane = lane_asm() & 63; F.wave = opqs(wave0) & 7; F.tid = F.wave * 64 + F.lane; F.G = opqs(gridDim.x); F.bid = opqs(blockIdx.x); F.gw = F.bid * NWAVES + F.wave; F.NGW = F.G * NWAVES;
            pg8::Gemm g{WSP(bf16_t, WS_XG), WSP(bf16_t, WS_WE), DM / 2, DM / 2, DM / 2}; OrderMoe S; S.init(11, F.G, F.bid, lat_only ? 8 : 9);
            EpiSwiglu E{WSP(unsigned char, WS_HID)};
            pg8::gemm_phase<EpiSwiglu, OrderMoe, true>(F.lds, g, S, E, F.tid);

        }
        SEAM(pb + 13);
        if (PON(14) && IN(pb + 14)) { F.ws = opq(args.ws); F.lane = lane_asm() & 63; F.wave = opqs(wave0) & 7; F.tid = F.wave * 64 + F.lane; F.G = opqs(gridDim.x); F.bid = opqs(blockIdx.x); F.gw = F.bid * NWAVES + F.wave; F.NGW = F.G * NWAVES;
            pg8::Gemm g{WSP(bf16_t, WS_HID), WSP(bf16_t, WS_WE + SZ_WGU8), EFFP / 2, EFFP / 2, EFFP / 2}; OrderMoe S; S.init(8, F.G, F.bid, lat_only ? 8 : 9);
            EpiDown E{WSP(bf16_t, WS_YE)};
            pg8::gemm_phase<EpiDown, OrderMoe, true>(F.lds, g, S, E, F.tid);

        }
        SEAM(pb + 14);
        if (PON(15) && IN(pb + 15)) { F.ws = opq(args.ws); F.lane = lane_asm() & 63; F.wave = opqs(wave0) & 7; F.tid = F.wave * 64 + F.lane; F.G = opqs(gridDim.x); F.bid = opqs(blockIdx.x); F.gw = F.bid * NWAVES + F.wave; F.NGW = F.G * NWAVES; phase_ln2(F, args, layer); }
        SEAM(pb + 15);
    }
#undef IN
#undef SEAM
}


#ifdef DBG_CUT
__global__ void dbg_dump(const unsigned char* ws, float* out, size_t off, int is_bf16, size_t n_src) {
    const size_t N = (size_t)TL * DM;
    for (size_t i = (size_t)blockIdx.x * blockDim.x + threadIdx.x; i < N; i += (size_t)gridDim.x * blockDim.x) {
        const size_t j = i % n_src;
        out[i] = is_bf16 ? bf2f(((const bf16_t*)(ws + off))[j]) : ((const float*)(ws + off))[j];
    }
}
#endif

#ifdef DBG_PASSES
__global__ void dbg_chk(const unsigned char* base, size_t off, size_t nbytes, unsigned long long* slot) {
    const unsigned* p = (const unsigned*)(base + off); const size_t n = nbytes / 4; unsigned long long s = 0;
    for (size_t i = (size_t)blockIdx.x * blockDim.x + threadIdx.x; i < n; i += (size_t)gridDim.x * blockDim.x) s += p[i];
    for (int o = 32; o > 0; o >>= 1) s += __shfl_xor(s, o);
    if ((threadIdx.x & 63) == 0) atomicAdd(slot, s);
}
__global__ void dbg_report(const unsigned long long* tab, float* out, int npass) {
    int k = 0;
    for (int ph = NPHASE - 1; ph >= 0; --ph) if (tab[ph] != tab[64 + ph]) k = ph + 1;
    if (k == 0 && npass > 2) { for (int ph = NPHASE - 1; ph >= 0; --ph) if (tab[64 + ph] != tab[128 + ph]) k = 50 + ph + 1; }
    if (k == 0) return;
    const float c = sqrtf(10.f * (float)k);
    for (size_t i = (size_t)blockIdx.x * blockDim.x + threadIdx.x; i < (size_t)TL * DM; i += (size_t)gridDim.x * blockDim.x) out[i] = c;
}
struct DbgReg { size_t off, n; };
#endif
extern "C" void kernel_launch(void* const* d_in, const int* in_sizes, int n_in, void* d_out, int out_size, void* d_ws, size_t ws_size, hipStream_t stream) {
    static int grid = 0;
    if (grid == 0) {
        if (n_in != N_INPUTS || in_sizes[0] != TL * DM || out_size != TL * DM || ws_size < WS_END) {
            fprintf(stderr, "kernel_launch: shape/workspace mismatch: n_in %d in0 %d out %d ws %zu (need %zu)\n", n_in, n_in > 0 ? in_sizes[0] : -1, out_size, ws_size, (size_t)WS_END); grid = -1; return; }
        int dev = 0, cus = 0, per_cu = 0;
        if (hipGetDevice(&dev) != hipSuccess || hipDeviceGetAttribute(&cus, hipDeviceAttributeMultiprocessorCount, dev) != hipSuccess) { grid = -1; return; }
        if (hipFuncSetAttribute((const void*)fwd_kernel, hipFuncAttributeMaxDynamicSharedMemorySize, LDS_BYTES) != hipSuccess) { fprintf(stderr, "kernel_launch: hipFuncSetAttribute failed\n"); grid = -1; return; }
        if (hipOccupancyMaxActiveBlocksPerMultiprocessor(&per_cu, (const void*)fwd_kernel, NTHREADS, LDS_BYTES) != hipSuccess || per_cu < 1) { fprintf(stderr, "kernel_launch: occupancy query says %d\n", per_cu); grid = -1; (void)hipGetLastError(); return; }
        grid = cus;
    }
    if (grid < 0) return;
    (void)hipMemsetAsync((char*)d_ws + WS_CTL, 0, CTL_BYTES, stream);
    Args a{};
    for (int i = 0; i < N_INPUTS; ++i) a.in[i] = (const float*)d_in[i];
    a.out = (float*)d_out; a.ws = (unsigned char*)d_ws;
#if MK_ONE_LAUNCH
    a.ph_lo = 0; a.ph_hi = NPHASE;
    hipLaunchKernelGGL(fwd_kernel, dim3(grid), dim3(NTHREADS), LDS_BYTES, stream, a);
#else
#ifdef DBG_PASSES
    {
        unsigned long long* tab = (unsigned long long*)((char*)d_ws + 1600000);
        auto chk = [&](int pass, int ph, size_t off, size_t n) { hipLaunchKernelGGL(dbg_chk, dim3(1024), dim3(256), 0, stream, (const unsigned char*)d_ws, off, n, tab + pass * 64 + ph); };
        for (int pass = 0; pass < DBG_PASSES; ++pass) {
            if (pass > 0) (void)hipMemsetAsync((char*)d_ws + (size_t)CW_MOD * 4, 0, (size_t)DEPTH * 3 * 6 * DM * 4, stream);
            for (int ph = 0; ph < NPHASE; ++ph) {
                a.ph_lo = ph; a.ph_hi = ph + 1; hipLaunchKernelGGL(fwd_kernel, dim3(grid), dim3(NTHREADS), LDS_BYTES, stream, a);
                if (ph == 0) { chk(pass, ph, WS_WIN, WS_XS - WS_WIN); chk(pass, ph, (size_t)CW_MOD * 4, (size_t)DEPTH * 3 * 6 * DM * 4); continue; }
                const int r = (ph - 1) % NPL;
                switch (r) {
                case 0: chk(pass, ph, WS_H, SZ_H); chk(pass, ph, WS_HDN, SZ_HDN); break;
                case 1: chk(pass, ph, WS_P, SZ_P); break;
                case 2: chk(pass, ph, WS_P2, SZ_P2); chk(pass, ph, WS_KK, SZ_TK2); chk(pass, ph, WS_ALORA, WS_VT - WS_ALORA); chk(pass, ph, WS_VT, WS_HDN - WS_VT); break;
                case 3: chk(pass, ph, WS_Q, SZ_Q + SZ_KV); chk(pass, ph, WS_EW, 4 * SZ_TK2); chk(pass, ph, WS_GG, SZ_TK2); break;
                case 4: chk(pass, ph, WS_Q, SZ_Q); chk(pass, ph, WS_MST, SZ_MST + SZ_MCS); break;
                case 5: chk(pass, ph, WS_YRW, 2 * SZ_TK2); chk(pass, ph, WS_Y, SZ_Y / 4); chk(pass, ph, WS_VT, SZ_VT); chk(pass, ph, WS_MST, SZ_MST); break;
                case 6: chk(pass, ph, WS_Y + SZ_Y / 4, 3 * (SZ_Y / 4)); break;
                case 7: chk(pass, ph, WS_GATES, SZ_GATES); chk(pass, ph, WS_Y + SZ_Y / 4, SZ_Y / 4); break;
                case 8: chk(pass, ph, WS_MRGF, SZ_MRGF); chk(pass, ph, WS_MRGB, SZ_MRGB); break;
                case 9: chk(pass, ph, WS_YMIX, SZ_YMIX); break;
                case 10: chk(pass, ph, WS_XS, SZ_XS); chk(pass, ph, WS_H2, SZ_H); chk(pass, ph, WS_AFF, SZ_AFF); chk(pass, ph, WS_WE, SZ_WGU + SZ_WD); break;
                case 11: chk(pass, ph, WS_INV, SZ_INV + SZ_PTOK + SZ_PGATE); break;
                case 12: chk(pass, ph, WS_XG, SZ_XG); break;
                case 13: chk(pass, ph, WS_HID, SZ_HID); break;
                case 14: chk(pass, ph, WS_YE, SZ_YE); break;
                case 15: chk(pass, ph, WS_XS, SZ_XS); break;
                }
            }
        }
        hipLaunchKernelGGL(dbg_report, dim3(2048), dim3(256), 0, stream, (const unsigned long long*)tab, (float*)d_out, (int)DBG_PASSES);
    }
#elif defined(DBG_CUT)
    for (int ph = 0; ph < DBG_CUT; ++ph) { a.ph_lo = ph; a.ph_hi = ph + 1; hipLaunchKernelGGL(fwd_kernel, dim3(grid), dim3(NTHREADS), LDS_BYTES, stream, a); }
    hipLaunchKernelGGL(dbg_dump, dim3(2048), dim3(256), 0, stream, (const unsigned char*)d_ws, (float*)d_out, (size_t)DBG_OFF, DBG_BF16, (size_t)DBG_N);
#else
    for (int ph = 0; ph < NPHASE; ++ph) { a.ph_lo = ph; a.ph_hi = ph + 1; hipLaunchKernelGGL(fwd_kernel, dim3(grid), dim3(NTHREADS), LDS_BYTES, stream, a); }
#endif
#endif
}
```

```cpp
#include <hip/hip_runtime.h>
#include <cstdio>
#include <cstdint>

#define REP_MASK 0x80000
#ifndef MK_ONE_LAUNCH
#define MK_ONE_LAUNCH 1
#endif

#define LAS __attribute__((address_space(3)))
typedef unsigned short bf16_t;
typedef short bf16x8 __attribute__((ext_vector_type(8)));
typedef float f32x4 __attribute__((ext_vector_type(4)));
typedef float f32x2 __attribute__((ext_vector_type(2)));
typedef unsigned u32x4 __attribute__((ext_vector_type(4)));
typedef unsigned u32x2 __attribute__((ext_vector_type(2)));

constexpr int DM = 2048, NBATCH = 2, SEQ = 8192, CTX = 256, DEPTH = 2;
constexpr int TC = NBATCH * CTX, TL = NBATCH * SEQ, T = TC + TL;
constexpr int NIN = 18432, NNG = 10240, NGATE = 8192;
constexpr int P_CQ = 0, P_CKV = 512, P_KPE = 1024;
constexpr int P_Z = 1088, P_XBC = 2112, P_DT = 3648;
constexpr int P_HY = 3680;
constexpr int P_RW = 6752, P_WD = 9824, P_AD = 9952, P_GD = 10080;
constexpr int NH_MLA = 8, NH_SSM = 16, NH_RW = 16;
constexpr int NEXP = 16, EFF = 1408, CAP_L = 1024, CAP_C = 32;
constexpr int NPAIR = NBATCH * NEXP * CAP_L + NEXP * 256;
constexpr float ALPHA = 1.4142135623730951f;
constexpr int NWAVES = 8, NTHREADS = 512;

__device__ __forceinline__ int seg_of(int row) { return row < 256 ? 0 : row < 512 ? 1 : row < 512 + SEQ ? 2 : 3; }
__device__ __forceinline__ int seg_start(int s) { return s == 0 ? 0 : s == 1 ? 256 : s == 2 ? 512 : 512 + SEQ; }
__device__ __forceinline__ int seg_len(int s) { return s < 2 ? CTX : SEQ; }
__device__ __forceinline__ bool row_first(int row) { return row == 0 || row == 256 || row == 512 || row == 512 + SEQ; }
__device__ __forceinline__ bool row_last(int row) { return row == 255 || row == 511 || row == 511 + SEQ || row == T - 1; }
__device__ __forceinline__ int row_modidx(int row) { return row < 512 ? 2 : (row < 512 + SEQ ? 0 : 1); }

constexpr size_t AL(size_t x) { return (x + 255) / 256 * 256; }
constexpr size_t WS_CTL = 0, CTL_BYTES = 2u << 20;
constexpr int CW_BAR = 1024;
constexpr int CW_MOD = 16384;
constexpr size_t SZ_WIN = (size_t)NIN * DM * 2, SZ_WBR = (size_t)4 * DM * 1024 * 2, SZ_WOUT = (size_t)DM * DM * 2, SZ_WQ = (size_t)1536 * 512 * 2,
                 SZ_WKV = (size_t)2048 * 512 * 2, SZ_WLORA = (size_t)5120 * 512 * 2;
constexpr size_t WS_WIN = CTL_BYTES, WS_WBR = WS_WIN + DEPTH * SZ_WIN, WS_WOUT = WS_WBR + DEPTH * SZ_WBR, WS_WQ = WS_WOUT + DEPTH * SZ_WOUT,
                 WS_WKV = WS_WQ + DEPTH * SZ_WQ, WS_WLORA = WS_WKV + DEPTH * SZ_WKV, WS_XS = WS_WLORA + DEPTH * SZ_WLORA;
constexpr size_t SZ_XS = (size_t)T * DM * 4;
constexpr size_t WS_H = WS_XS + SZ_XS, SZ_H = (size_t)T * DM * 2;
constexpr size_t WS_P = WS_H + SZ_H, SZ_P = (size_t)T * NNG * 2;
constexpr int P2W = 5632, P2_XBC = 0, P2_X0 = 1536, P2_RKV = 2560;
constexpr size_t WS_P2 = WS_P + SZ_P, SZ_P2 = (size_t)T * P2W * 2;
constexpr size_t WS_Q = WS_P2 + SZ_P2, SZ_Q = (size_t)T * 1536 * 2;
constexpr size_t WS_KV = WS_Q + SZ_Q, SZ_KV = (size_t)T * 2048 * 2;
constexpr size_t WS_EW = WS_KV + SZ_KV, SZ_TK2 = (size_t)T * 1024 * 2;
constexpr size_t WS_ICLR = WS_EW + 2 * SZ_TK2;
constexpr size_t WS_KK = WS_ICLR + 2 * SZ_TK2;
constexpr size_t WS_GG = WS_KK + SZ_TK2;
constexpr size_t WS_YRW = WS_GG + SZ_TK2;
constexpr size_t WS_ALORA = WS_YRW + 2 * SZ_TK2, SZ_ALORA = (size_t)T * 512 * 2;
constexpr size_t WS_KPE = WS_ALORA + SZ_ALORA, SZ_KPE = (size_t)T * 64 * 2;
constexpr size_t WS_RS = WS_KPE + SZ_KPE, SZ_RS = AL((size_t)T * 2 * 4);
constexpr size_t WS_DT = WS_RS + SZ_RS, SZ_DT = (size_t)T * 32 * 4;
constexpr size_t WS_VT = WS_DT + SZ_DT, SZ_VT = (size_t)1024 * 2 * SEQ * 4;
constexpr size_t WS_VC = WS_VT + SZ_VT, SZ_VC = (size_t)TC * 1024 * 4;
constexpr size_t WS_FILT = WS_VC + SZ_VC, SZ_FILT = (size_t)1024 * 2 * SEQ * 2;
constexpr size_t WS_FILTC = WS_FILT + SZ_FILT, SZ_FILTC = (size_t)CTX * 2048 * 4;
constexpr size_t WS_HDN = WS_FILTC + SZ_FILTC, SZ_HDN1 = (size_t)(SEQ + CTX) * 64 * 4, SZ_HDN = DEPTH * SZ_HDN1;
constexpr int NCHUNK = T / 128;
constexpr size_t WS_MST = WS_HDN + SZ_HDN, SZ_MST = (size_t)2 * NCHUNK * 16 * 8192 * 2;
constexpr size_t WS_MCS = WS_MST + SZ_MST, SZ_MCS = (size_t)2 * NCHUNK * 16 * 4 * 2;
constexpr size_t WS_Y = WS_MCS + AL(SZ_MCS), SZ_Y = (size_t)4 * T * 1024 * 2;
constexpr size_t WS_AFF = WS_Y + SZ_Y, SZ_AFF = (size_t)T * 16 * 4;
constexpr size_t WS_INV = WS_AFF + SZ_AFF, SZ_INV = (size_t)T * 16 * 4;
constexpr size_t WS_PTOK = WS_INV + SZ_INV, SZ_PTOK = (size_t)NPAIR * 4;
constexpr size_t WS_PGATE = WS_PTOK + SZ_PTOK, SZ_PGATE = (size_t)NPAIR * 4;
constexpr size_t WS_H8 = WS_PGATE + SZ_PGATE, SZ_H8 = (size_t)T * DM;
constexpr size_t WS_END = WS_H8 + SZ_H8;
constexpr size_t WS_GATES = WS_P, SZ_GATES = (size_t)T * NGATE * 2;
constexpr size_t WS_MRGF = WS_P2, SZ_MRGF = (size_t)T * DM * 4;
constexpr size_t WS_MRGB = WS_Q, SZ_MRGB = (size_t)T * DM * 2;
constexpr size_t WS_YMIX = WS_P, SZ_YMIX = (size_t)T * DM * 4;
constexpr size_t WS_H2 = WS_H;
constexpr size_t WS_WE = WS_P2, SZ_WGU = (size_t)NEXP * 2816 * DM * 2, SZ_WD = (size_t)NEXP * DM * EFF * 2;
constexpr size_t WS_XG = WS_P, SZ_XG = (size_t)NPAIR * DM * 2;
constexpr size_t WS_HID = WS_XG + SZ_XG, SZ_HID = (size_t)NPAIR * EFF * 2;
constexpr size_t WS_YE = WS_WE + SZ_WGU + SZ_WD, SZ_YE = (size_t)NPAIR * DM * 2;
static_assert(SZ_GATES <= SZ_P && SZ_MRGF <= SZ_P2 && SZ_MRGB <= SZ_Q + SZ_KV && SZ_YMIX <= SZ_P, "alias map 1");
static_assert(SZ_XG + SZ_HID <= SZ_P, "alias map 2");
static_assert(WS_YE + SZ_YE <= WS_VT, "alias map 3");
static_assert(WS_END < 1800000000ull, "workspace budget");

__device__ __forceinline__ unsigned f2bf(float f) { unsigned u = __builtin_bit_cast(unsigned, f); return (u + 0x7fffu + ((u >> 16) & 1u)) >> 16; }
__device__ __forceinline__ unsigned pk2(float lo, float hi) { return f2bf(lo) | (f2bf(hi) << 16); }
__device__ __forceinline__ float bf2f(unsigned short b) { return __builtin_bit_cast(float, (unsigned)b << 16); }
__device__ __forceinline__ float bflo(unsigned w) { return __builtin_bit_cast(float, w << 16); }
__device__ __forceinline__ float bfhi(unsigned w) { return __builtin_bit_cast(float, w & 0xffff0000u); }
__device__ __forceinline__ unsigned cvt_pk_bf16(float lo, float hi) { unsigned r; asm volatile("v_cvt_pk_bf16_f32 %0, %1, %2" : "=v"(r) : "v"(lo), "v"(hi)); return r; }
__device__ __forceinline__ float dppx(float x, const int sel) {
    const int xi = __builtin_bit_cast(int, x); int r;
    if (sel == 0) r = __builtin_amdgcn_update_dpp(0, xi, 0xB1, 0xF, 0xF, false);
    else if (sel == 1) r = __builtin_amdgcn_update_dpp(0, xi, 0x4E, 0xF, 0xF, false);
    else if (sel == 2) r = __builtin_amdgcn_update_dpp(0, xi, 0x141, 0xF, 0xF, false);
    else r = __builtin_amdgcn_update_dpp(0, xi, 0x140, 0xF, 0xF, false);
    return __builtin_bit_cast(float, r);
}
__device__ __forceinline__ float swz16(float x) { return __builtin_bit_cast(float, __builtin_amdgcn_ds_swizzle(__builtin_bit_cast(int, x), 0x401F)); }
__device__ __forceinline__ float sum4(float v) { v += dppx(v, 0); v += dppx(v, 1); return v; }
__device__ __forceinline__ float sum8(float v) { v = sum4(v); v += dppx(v, 2); return v; }
__device__ __forceinline__ float sum16(float v) { v = sum8(v); v += dppx(v, 3); return v; }
__device__ __forceinline__ float sum32(float v) { v = sum16(v); v += swz16(v); return v; }
__device__ __forceinline__ unsigned pk4fp8(float a, float b, float c, float d) { int w = 0; w = __builtin_amdgcn_cvt_pk_fp8_f32(a, b, w, false); w = __builtin_amdgcn_cvt_pk_fp8_f32(c, d, w, true); return (unsigned)w; }
__device__ __forceinline__ float wave_sum(float v) {
    v = sum32(v);
    auto rr = __builtin_amdgcn_permlane32_swap(__float_as_uint(v), __float_as_uint(v), false, false);
    return __uint_as_float(rr[0]) + __uint_as_float(rr[1]);
}
__device__ __forceinline__ float sigmoidf_(float x) { return 1.f / (1.f + __expf(-x)); }
__device__ __forceinline__ float siluf_(float x) { return x / (1.f + __expf(-x)); }
__device__ __forceinline__ float softplusf_(float x) { return x > 20.f ? x : __logf(1.f + __expf(x)); }
__device__ __forceinline__ float tanhf_(float x) { const float e = __expf(2.f * fminf(x, 15.f)); return 1.f - 2.f / (e + 1.f); }
#define LDS_WAIT() asm volatile("s_waitcnt lgkmcnt(0)" ::: "memory")
#define VM_WAIT() asm volatile("s_waitcnt vmcnt(0)" ::: "memory")

#define XB_TMO      128
#define XB_XCNT(j)  (256  + 64 * (j))
#define XB_XSUB(j)  (1280 + 64 * (j))
#define XB_XGEN(j)  (2304 + 64 * (j))
#define XB_TOP      3328
#define XB_TOPGEN   3392
#define XCD_BAR_WORDS 3456
#define XB_SPIN_CAP (1u << 18)
__device__ __forceinline__ unsigned xb_ld(unsigned* p)              { return __hip_atomic_load(p, __ATOMIC_RELAXED, __HIP_MEMORY_SCOPE_AGENT); }
__device__ __forceinline__ unsigned xb_add(unsigned* p, unsigned v) { return __hip_atomic_fetch_add(p, v, __ATOMIC_RELAXED, __HIP_MEMORY_SCOPE_AGENT); }
__device__ __forceinline__ unsigned xb_xcc_id() { return (unsigned)__builtin_amdgcn_s_getreg((3 << 11) | 20) & 0xFu; }
#define XB_SPIN(cond, bar) do { unsigned _sp = 0; while (cond) { __builtin_amdgcn_s_sleep(1); \
    if ((++_sp & 255u) == 0u) { if (xb_ld(&(bar)[XB_TMO])) break; if (_sp > XB_SPIN_CAP) { atomicAdd(&(bar)[XB_TMO], 1u); break; } } } } while (0)
struct XcdBarrier { unsigned* bar; unsigned x; volatile LAS unsigned* st; };
__device__ __forceinline__ XcdBarrier xcd_barrier_post(unsigned* bar, volatile LAS unsigned* st) {
    XcdBarrier b; b.bar = bar; b.x = xb_xcc_id(); b.st = st;
    if (threadIdx.x == 0) (void)xb_add(&bar[XB_XCNT(b.x)], 1u);
    return b;
}
__device__ __forceinline__ void xcd_barrier_complete(unsigned* bar, unsigned x, unsigned& nloc, unsigned& nx) {
    const unsigned G = gridDim.x * gridDim.y * gridDim.z;
    unsigned sum, cnt, mine, sp = 0u;
    for (;;) {
        sum = 0u; cnt = 0u; mine = 0u;
#pragma unroll
        for (unsigned j = 0; j < 16; ++j) { const unsigned c = xb_ld(&bar[XB_XCNT(j)]); sum += c; cnt += (c > 0u) ? 1u : 0u; mine = (j == x) ? c : mine; }
        if (sum == G) break;
        __builtin_amdgcn_s_sleep(1);
        if ((++sp & 255u) == 0u) { if (xb_ld(&bar[XB_TMO])) break; if (sp > XB_SPIN_CAP) { atomicAdd(&bar[XB_TMO], 1u); break; } }
    }
    nloc = mine > 0u ? mine : 1u; nx = cnt > 0u ? cnt : 1u;
}
__device__ __forceinline__ void xcd_barrier(const XcdBarrier& b) {
    asm volatile("s_waitcnt vmcnt(0)" ::: "memory");
    __syncthreads();
    if (threadIdx.x == 0) {
        unsigned* bar = b.bar;
        __builtin_amdgcn_s_waitcnt(0);
        unsigned nloc = b.st[0], nx = b.st[1];
        if (nloc == 0u) { xcd_barrier_complete(bar, b.x, nloc, nx); b.st[0] = nloc; b.st[1] = nx; }
        const unsigned old = xb_add(&bar[XB_XSUB(b.x)], 1u);
        const unsigned gen = old / nloc;
        if (old + 1u == (gen + 1u) * nloc) {
            __builtin_amdgcn_fence(__ATOMIC_RELEASE, "agent");
            asm volatile("s_waitcnt vmcnt(0)" ::: "memory");
            const unsigned og = xb_add(&bar[XB_TOP], 1u);
            const unsigned tg = og / nx;
            if (og + 1u == (tg + 1u) * nx) xb_add(&bar[XB_TOPGEN], 1u);
            else XB_SPIN(xb_ld(&bar[XB_TOPGEN]) == tg, bar);
            __builtin_amdgcn_fence(__ATOMIC_ACQUIRE, "agent");
            xb_add(&bar[XB_XGEN(b.x)], 1u);
            asm volatile("s_waitcnt vmcnt(0)" ::: "memory");
        } else {
            XB_SPIN(xb_ld(&bar[XB_XGEN(b.x)]) == gen, bar);
            __builtin_amdgcn_fence(__ATOMIC_ACQUIRE, "agent");
            asm volatile("s_waitcnt vmcnt(0)" ::: "memory");
        }
    }
    __syncthreads();
}

__device__ __forceinline__ int lane_asm() { int l; asm volatile("v_mbcnt_lo_u32_b32 %0, -1, 0\n\tv_mbcnt_hi_u32_b32 %0, -1, %0" : "=v"(l)); return l; }
namespace pg8 {
constexpr int BM = 256, BK = 64, HALF = 128, HTB = HALF * BK * 2, STAGE_BYTES = 8 * HTB, NXCD = 8, WGM = 8;
__host__ __device__ __forceinline__ int lds_byte(int r, int c) { const int st = (r >> 4) * 2 + (c >> 5), rr = r & 15, cc = c & 31, ob = rr * 64 + cc * 2; return st * 1024 + (ob ^ (((ob >> 9) & 1) << 5)); }
__host__ __device__ __forceinline__ void stage_rc(int b, int& R, int& C) { const int st = b / 1024, sb = b % 1024, swz = sb ^ (((sb >> 9) & 1) << 5); R = (st >> 1) * 16 + swz / 64; C = (st & 1) * 32 + (swz % 64) / 2; }
__host__ __device__ __forceinline__ int perm32(int rho) { const int n = rho >> 4, i = rho & 15; return 8 * (i >> 2) + 4 * n + (i & 3); }
struct Unit { int pm, pn; };
struct Gemm { const bf16_t* A; const bf16_t* Bt; int lda, ldb, K; };
struct StaticOrder {
    int nM, nN, nwg, G, c, pm0;
    __device__ void init(int nM_, int nN_, int G_, int c_, int pm0_ = 0) { nM = nM_; nN = nN_; nwg = nM * nN; G = G_; c = c_; pm0 = pm0_; }
    __device__ bool next(int i, Unit& u) const {
        const long L = (long)i * G + c; if (L >= nwg) return false;
        int wgid = (int)L; { const int q = nwg / NXCD, r = nwg % NXCD, xcd = wgid % NXCD, off = wgid / NXCD; wgid = (xcd < r ? xcd * (q + 1) : r * (q + 1) + (xcd - r) * q) + off; }
        const int nig = WGM * nN, gid = wgid / nig, fm = gid * WGM, gsz = (nM - fm) < WGM ? (nM - fm) : WGM;
        u.pm = pm0 + fm + ((wgid % nig) % gsz); u.pn = (wgid % nig) / gsz; return true;
    }
};
typedef int i32x4v __attribute__((ext_vector_type(4)));
typedef int i32x8v __attribute__((ext_vector_type(8)));
__device__ __forceinline__ i32x8v cat8(bf16x8 a, bf16x8 b) { return __builtin_shufflevector(__builtin_bit_cast(i32x4v, a), __builtin_bit_cast(i32x4v, b), 0, 1, 2, 3, 4, 5, 6, 7); }
template <class Epi, class Sched, bool FP8 = false>
__device__ __forceinline__ void gemm_phase(LAS unsigned char* lds, const Gemm g, const Sched& S, const Epi& E, int tid_in) {
    constexpr bool ALIGN_EPI = true;
    const unsigned tid_u = (unsigned)tid_in; __builtin_assume(tid_u < 512u);
    const int tid = (int)tid_u, wid = __builtin_amdgcn_readfirstlane(tid >> 6), lane = tid & 63, wr = wid >> 2, wc = wid & 3, fr = lane & 15, fq = lane >> 4;
    const int K = g.K, nt = K / BK;
    unsigned voffA[2], voffB[2];
#pragma unroll
    for (int i = 0; i < 2; ++i) { int R, C; stage_rc(tid * 16 + i * 8192, R, C); const int Rb = Epi::PERM ? ((R & ~31) + perm32(R & 31)) : R;
        voffA[i] = (unsigned)(R * g.lda + C) * 2u; voffB[i] = (unsigned)(Rb * g.ldb + C) * 2u; }
    const unsigned kstep = (unsigned)(BK * 2);
    const unsigned hstepA = (unsigned)HALF * g.lda * 2u, hstepB = (unsigned)HALF * g.ldb * 2u;
    const unsigned tstepA = 2u * hstepA, tstepB = 2u * hstepB;
    const unsigned ldsw = (unsigned)wid * 1024u;
    const int aoff = lds_byte(wr * 64 + fr, fq * 8), boff = lds_byte(wc * 32 + fr, fq * 8);
    const __amdgpu_buffer_rsrc_t rsA = __builtin_amdgcn_make_buffer_rsrc((void*)g.A, 0, 0xFFFFFFFFu, 0x00020000);
    const __amdgpu_buffer_rsrc_t rsB = __builtin_amdgcn_make_buffer_rsrc((void*)g.Bt, 0, 0xFFFFFFFFu, 0x00020000);
#define PG8_SA(b, h) (((b) * 2 + (h)) * HTB)
#define PG8_SB(b, h) ((4 + (b) * 2 + (h)) * HTB)
#define PG8_STAGE(bufoff, rs, soff, voff) do { _Pragma("unroll") for (int _i = 0; _i < 2; ++_i) \
        __builtin_amdgcn_raw_ptr_buffer_load_lds(rs, (LAS unsigned*)(lds + (bufoff) + ldsw + _i * 8192), 16, (int)(voff)[_i], (int)(soff), 0, 0); } while (0)
#define PG8_LDA(dst, b, h) do { if constexpr (FP8) { _Pragma("unroll") for (int m = 0; m < 4; ++m) dst##8[m] = __builtin_shufflevector(*(const LAS i32x4v*)(lds + PG8_SA(b, h) + aoff + m * 2048), *(const LAS i32x4v*)(lds + PG8_SA(b, h) + aoff + m * 2048 + 1024), 0, 1, 2, 3, 4, 5, 6, 7); } \
    else { _Pragma("unroll") for (int m = 0; m < 4; ++m) _Pragma("unroll") for (int k = 0; k < 2; ++k) dst[m][k] = *(const LAS bf16x8*)(lds + PG8_SA(b, h) + aoff + m * 2048 + k * 1024); } } while (0)
#define PG8_LDB(dst, b, h) do { if constexpr (FP8) { _Pragma("unroll") for (int n = 0; n < 2; ++n) dst##8[n] = __builtin_shufflevector(*(const LAS i32x4v*)(lds + PG8_SB(b, h) + boff + n * 2048), *(const LAS i32x4v*)(lds + PG8_SB(b, h) + boff + n * 2048 + 1024), 0, 1, 2, 3, 4, 5, 6, 7); } \
    else { _Pragma("unroll") for (int n = 0; n < 2; ++n) _Pragma("unroll") for (int k = 0; k < 2; ++k) dst[n][k] = *(const LAS bf16x8*)(lds + PG8_SB(b, h) + boff + n * 2048 + k * 1024); } } while (0)
#define PG8_MMA(ai, bj, At, Bt) do { __builtin_amdgcn_s_setprio(1); if constexpr (FP8) { _Pragma("unroll") for (int m = 0; m < 4; ++m) _Pragma("unroll") for (int n = 0; n < 2; ++n) \
        asm volatile("v_mfma_scale_f32_16x16x128_f8f6f4 %0, %1, %2, %0, %3, %3 op_sel_hi:[0,0,0]" : "+v"(acc[ai][bj][m][n]) : "v"(Bt##8[n]), "v"(At##8[m]), "v"(sc1)); } else { \
        _Pragma("unroll") for (int m = 0; m < 4; ++m) _Pragma("unroll") for (int n = 0; n < 2; ++n) _Pragma("unroll") for (int k = 0; k < 2; ++k) \
        acc[ai][bj][m][n] = __builtin_amdgcn_mfma_f32_16x16x32_bf16(Bt[n][k], At[m][k], acc[ai][bj][m][n], 0, 0, 0); } __builtin_amdgcn_s_setprio(0); } while (0)
#define PG8_WAIT_V(n) asm volatile("s_waitcnt vmcnt(" #n ")" ::: "memory")
#define PG8_WAIT_L(n) asm volatile("s_waitcnt lgkmcnt(" #n ")" ::: "memory")
#define PG8_BAR __builtin_amdgcn_s_barrier()
#define PG8_SCHED __builtin_amdgcn_sched_barrier(0)
    Unit cur, nxt; int ui = 0;
    if (!S.next(0, cur)) return;
    f32x4 acc[2][2][4][2];
#pragma unroll
    for (int a = 0; a < 2; ++a)
#pragma unroll
        for (int b = 0; b < 2; ++b)
#pragma unroll
            for (int m = 0; m < 4; ++m)
#pragma unroll
                for (int n = 0; n < 2; ++n) acc[a][b][m][n] = (f32x4){0.f, 0.f, 0.f, 0.f};
    i32x8v At8[4], B08[2], B18[2]; bf16x8 At[4][2], B0[2][2], B1[2][2];
    const int sc1 = 0x7F7F7F7F;
    unsigned cA = (unsigned)cur.pm * tstepA, cB = (unsigned)cur.pn * tstepB;
    PG8_STAGE(PG8_SB(0, 0), rsB, cB, voffB); PG8_STAGE(PG8_SB(0, 1), rsB, cB + hstepB, voffB); PG8_STAGE(PG8_SA(0, 0), rsA, cA, voffA); PG8_STAGE(PG8_SA(0, 1), rsA, cA + hstepA, voffA);
    if (wr == 1) PG8_BAR;
    PG8_WAIT_V(2); PG8_BAR;
    PG8_STAGE(PG8_SB(1, 0), rsB, cB + kstep, voffB); PG8_STAGE(PG8_SA(1, 0), rsA, cA + kstep, voffA); PG8_STAGE(PG8_SB(1, 1), rsB, cB + hstepB + kstep, voffB);
    PG8_WAIT_V(6); PG8_BAR;
    for (;;) {
        const bool has_next = S.next(ui + 1, nxt);
        const unsigned nA = has_next ? (unsigned)nxt.pm * tstepA : cA; const unsigned nB = has_next ? (unsigned)nxt.pn * tstepB : cB;
        for (int t = 0; t < nt; t += 2) {
            const bool last = (t == nt - 2);
            const unsigned a1 = cA + (unsigned)(t + 1) * kstep;
            const unsigned a2 = last ? nA : cA + (unsigned)(t + 2) * kstep; const unsigned b2 = last ? nB : cB + (unsigned)(t + 2) * kstep;
            const unsigned a3 = a2 + kstep; const unsigned b3 = b2 + kstep;
            PG8_LDB(B0, 0, 0); PG8_LDB(B1, 0, 1); PG8_SCHED; PG8_LDA(At, 0, 0); PG8_STAGE(PG8_SA(1, 1), rsA, a1 + hstepA, voffA);
            PG8_WAIT_V(8); PG8_WAIT_L(0); PG8_BAR; PG8_MMA(0, 0, At, B0); PG8_MMA(0, 1, At, B1); PG8_BAR; PG8_SCHED;
            PG8_LDA(At, 0, 1); PG8_STAGE(PG8_SB(0, 0), rsB, b2, voffB); PG8_STAGE(PG8_SB(0, 1), rsB, b2 + hstepB, voffB); PG8_STAGE(PG8_SA(0, 0), rsA, a2, voffA);
            PG8_WAIT_V(8); PG8_WAIT_L(0); PG8_BAR; PG8_MMA(1, 0, At, B0); PG8_MMA(1, 1, At, B1); PG8_BAR; PG8_SCHED;
            PG8_LDB(B0, 1, 0); PG8_LDB(B1, 1, 1); PG8_SCHED; PG8_LDA(At, 1, 0); PG8_STAGE(PG8_SA(0, 1), rsA, a2 + hstepA, voffA);
            PG8_WAIT_V(8); PG8_WAIT_L(0); PG8_BAR; PG8_MMA(0, 0, At, B0); PG8_MMA(0, 1, At, B1); PG8_BAR; PG8_SCHED;
            PG8_LDA(At, 1, 1); PG8_STAGE(PG8_SB(1, 0), rsB, b3, voffB); PG8_STAGE(PG8_SB(1, 1), rsB, b3 + hstepB, voffB); PG8_STAGE(PG8_SA(1, 0), rsA, a3, voffA);
            PG8_WAIT_V(8); PG8_WAIT_L(0); PG8_BAR; PG8_MMA(1, 0, At, B0); PG8_MMA(1, 1, At, B1); PG8_BAR; PG8_SCHED;
        }
        if constexpr (FP8) asm volatile("s_nop 15\n\ts_nop 7" ::: "memory");
        if constexpr (ALIGN_EPI) { if (wr == 0) PG8_BAR; }
        bool keep_acc = false;
        { const int l2 = lane_asm() & 63; if constexpr (Epi::KEEPS) keep_acc = E(acc, cur, wr, wc, l2 & 15, l2 >> 4); else E(acc, cur, wr, wc, l2 & 15, l2 >> 4); }
        if (!has_next) break;
        if (!keep_acc) {
#pragma unroll
        for (int a = 0; a < 2; ++a)
#pragma unroll
            for (int b = 0; b < 2; ++b)
#pragma unroll
                for (int m = 0; m < 4; ++m)
#pragma unroll
                    for (int n = 0; n < 2; ++n) acc[a][b][m][n] = (f32x4){0.f, 0.f, 0.f, 0.f};
        }
        cur = nxt; cA = nA; cB = nB; ++ui;
        if constexpr (ALIGN_EPI) { if (wr == 1) PG8_BAR; }
    }
    PG8_WAIT_V(0);
    if constexpr (!ALIGN_EPI) { if (wr == 0) PG8_BAR; }
    PG8_BAR;
#undef PG8_SA
#undef PG8_SB
#undef PG8_STAGE
#undef PG8_LDA
#undef PG8_LDB
#undef PG8_MMA
#undef PG8_WAIT_V
#undef PG8_WAIT_L
#undef PG8_BAR
#undef PG8_SCHED
}
}

enum { I_X = 0, I_C, I_CTX, I_CCTX, I_WADA, I_BADA, I_WIN, I_QNORM, I_WQUP, I_KVNORM, I_WKVUP, I_SCONVW, I_SCONVB, I_SDTB, I_SALOG, I_SD, I_SNORM,
       I_HCONVW, I_HCONVB, I_HW1, I_HB1, I_HW2, I_HB2, I_HW3, I_HFREQ, I_HD, I_RMU, I_RW0, I_RWUP, I_RA0, I_RAUP, I_RGUP, I_RKK, I_RKA, I_RRK, I_RLNG, I_RLNB,
       I_WBR, I_WOUT, I_LN1G, I_LN1B, I_WROUTER, I_WGATE, I_WUP, I_WDOWN, I_LN2G, I_LN2B, N_INPUTS };
struct Args { const float* in[N_INPUTS]; float* out; unsigned char* ws; int ph_lo, ph_hi; };
static_assert(sizeof(Args) == (N_INPUTS + 2) * 8 + 8, "Args has no padding");

__device__ __forceinline__ const float* arg_in(const Args& a, int i) { asm volatile("" : "+s"(i)); return a.in[i]; }
__device__ __forceinline__ int opqs(int v) { asm volatile("" : "+s"(v)); return v; }
__device__ __forceinline__ int opqv(int v) { asm volatile("" : "+v"(v)); return v; }
__device__ __forceinline__ unsigned char* opq(unsigned char* p) { asm volatile("" : "+s"(p)); return p; }
struct Frame {
    LAS unsigned char* lds;
    int tid, lane, wave, G, bid, gw, NGW;
    unsigned char* ws;
};
#define WSP(T_, off) ((T_*)(F.ws + (off)))

struct RmId { __device__ int operator()(int n) const { return n; } };
struct RmGateUp { int up; __device__ int operator()(int n) const { return 256 * (n >> 7) + (n & 127) + (up ? 128 : 0); } };
constexpr int TR_SCR = 64 * 65 * 4;
__device__ __forceinline__ void tr_load(const float* W, int ldw, int k0, int n0, const float* kscale, float sc, LAS float* scr, int lane) {
    float v[64];
    const float* wp = W + (size_t)k0 * ldw + n0 + lane;
#pragma unroll
    for (int i = 0; i < 64; ++i) v[i] = wp[(size_t)i * ldw];
#pragma unroll
    for (int i = 0; i < 64; ++i) { float x = v[i] * sc; if (kscale) x *= kscale[k0 + i]; scr[i * 65 + lane] = x; }
    LDS_WAIT(); asm volatile("" ::: "memory");
}
template <class RowMap>
__device__ __forceinline__ void transpose_item(const float* W, int ldw, bf16_t* WT, int ldt, int k0, int n0, const float* kscale, RowMap rm, LAS float* scr, int lane) {
    tr_load(W, ldw, k0, n0, kscale, 1.f, scr, lane);
    const int c = lane & 7;
#pragma unroll
    for (int j = 0; j < 8; ++j) { const int n = (lane >> 3) + 8 * j; const LAS float* s = scr + (8 * c) * 65 + n;
        u32x4 o; o.x = pk2(s[0 * 65], s[1 * 65]); o.y = pk2(s[2 * 65], s[3 * 65]); o.z = pk2(s[4 * 65], s[5 * 65]); o.w = pk2(s[6 * 65], s[7 * 65]);
        *(u32x4*)(WT + (size_t)rm(n0 + n) * ldt + k0 + 8 * c) = o; }
    LDS_WAIT(); asm volatile("" ::: "memory");
}
template <class RowMap>
__device__ __forceinline__ void transpose_item_fp8(const float* W, int ldw, unsigned char* WT, int ldt, int k0, int n0, float sc, RowMap rm, LAS float* scr, int lane) {
    tr_load(W, ldw, k0, n0, nullptr, sc, scr, lane);
    const int c = lane & 3;
#pragma unroll
    for (int j = 0; j < 4; ++j) { const int n = (lane >> 2) + 16 * j; const LAS float* s = scr + (16 * c) * 65 + n;
        u32x4 o; o.x = pk4fp8(s[0 * 65], s[1 * 65], s[2 * 65], s[3 * 65]); o.y = pk4fp8(s[4 * 65], s[5 * 65], s[6 * 65], s[7 * 65]);
        o.z = pk4fp8(s[8 * 65], s[9 * 65], s[10 * 65], s[11 * 65]); o.w = pk4fp8(s[12 * 65], s[13 * 65], s[14 * 65], s[15 * 65]);
        *(u32x4*)(WT + (size_t)rm(n0 + n) * ldt + k0 + 16 * c) = o; }
    LDS_WAIT(); asm volatile("" ::: "memory");
}

__device__ __forceinline__ void p0_weights(Frame& F, const Args& a) {
    LAS float* scr = (LAS float*)(F.lds + F.wave * TR_SCR);
    constexpr int IT_IN = 32 * 288, IT_BR = 16 * 32, IT_OUT = 32 * 32, IT_Q = 8 * 24, IT_KV = 8 * 32;
    constexpr int PER_L = IT_IN + 4 * IT_BR + IT_OUT + IT_Q + IT_KV;
    for (int it = F.gw; it < DEPTH * PER_L; it += F.NGW) {
        const int l = it / PER_L; int r = it % PER_L;
        if (r < IT_IN) { const int kb = r / 288, nb = r % 288;
            if (nb * 64 < NNG) transpose_item(arg_in(a, I_WIN) + (size_t)l * DM * NIN, NIN, WSP(bf16_t, WS_WIN + l * SZ_WIN), DM, kb * 64, nb * 64, nullptr, RmId(), scr, F.lane);
            else transpose_item_fp8(arg_in(a, I_WIN) + (size_t)l * DM * NIN + NNG, NIN, WSP(unsigned char, WS_WIN + l * SZ_WIN) + (size_t)NNG * DM * 2, DM, kb * 64, nb * 64 - NNG, 64.f, RmId(), scr, F.lane);
            continue; } r -= IT_IN;
        if (r < 4 * IT_BR) { const int br = r / IT_BR, q = r % IT_BR, kb = q / 32, nb = q % 32;
            transpose_item(arg_in(a, I_WBR) + ((size_t)l * 4 + br) * 1024 * DM, DM, WSP(bf16_t, WS_WBR + l * SZ_WBR) + (size_t)br * DM * 1024, 1024, kb * 64, nb * 64, nullptr, RmId(), scr, F.lane); continue; } r -= 4 * IT_BR;
        if (r < IT_OUT) { const int kb = r / 32, nb = r % 32;
            transpose_item(arg_in(a, I_WOUT) + (size_t)l * DM * DM, DM, WSP(bf16_t, WS_WOUT + l * SZ_WOUT), DM, kb * 64, nb * 64, nullptr, RmId(), scr, F.lane); continue; } r -= IT_OUT;
        if (r < IT_Q) { const int kb = r / 24, nb = r % 24;
            transpose_item(arg_in(a, I_WQUP) + (size_t)l * 512 * 1536, 1536, WSP(bf16_t, WS_WQ + l * SZ_WQ), 512, kb * 64, nb * 64, arg_in(a, I_QNORM) + l * 512, RmId(), scr, F.lane); continue; } r -= IT_Q;
        { const int kb = r / 32, nb = r % 32;
            transpose_item(arg_in(a, I_WKVUP) + (size_t)l * 512 * 2048, 2048, WSP(bf16_t, WS_WKV + l * SZ_WKV), 512, kb * 64, nb * 64, arg_in(a, I_KVNORM) + l * 512, RmId(), scr, F.lane); }
    }
    for (size_t e = (size_t)F.bid * NTHREADS + F.tid; e < (size_t)DEPTH * 5120 * 512; e += (size_t)F.G * NTHREADS) {
        const int l = (int)(e / (5120 * 512)); const int rem = (int)(e % (5120 * 512)); const int n = rem / 512, kc = rem % 512; const int blk = n >> 10, c = n & 1023;
        float v = 0.f;
        if (blk < 2) { if (kc >= 64 * blk && kc < 64 * blk + 64) v = arg_in(a, I_RWUP)[(((size_t)l * 2 + blk) * 64 + (kc - 64 * blk)) * 1024 + c]; }
        else if (blk < 4) { const int d = blk - 2; if (kc >= 128 + 64 * d && kc < 192 + 64 * d) v = arg_in(a, I_RAUP)[(((size_t)l * 2 + d) * 64 + (kc - 128 - 64 * d)) * 1024 + c]; }
        else { if (kc >= 256 && kc < 416) v = arg_in(a, I_RGUP)[((size_t)l * 160 + (kc - 256)) * 1024 + c]; }
        WSP(bf16_t, WS_WLORA)[e] = (bf16_t)f2bf(v);
    }
}
constexpr int EFFP = 1536;
constexpr size_t SZ_WGU8 = (size_t)NEXP * 2816 * DM, SZ_WD8 = (size_t)NEXP * DM * EFFP;
__device__ __forceinline__ void conv_experts(Frame& F, const Args& a, int l) {
    LAS float* scr = (LAS float*)(F.lds + F.wave * TR_SCR);
    constexpr int IT_G = 32 * 22, IT_D = 22 * 32, PER_E = 2 * IT_G + IT_D;
    unsigned char* wgu = WSP(unsigned char, WS_WE); unsigned char* wd = WSP(unsigned char, WS_WE + SZ_WGU8);
    for (int it = F.gw; it < NEXP * PER_E; it += F.NGW) {
        const int e = it / PER_E; int r = it % PER_E;
        if (r < 2 * IT_G) { const int up = r / IT_G, q = r % IT_G, kb = q / 22, nb = q % 22;
            const float* src = arg_in(a, up ? I_WUP : I_WGATE) + ((size_t)l * NEXP + e) * DM * EFF;
            RmGateUp rm; rm.up = up;
            transpose_item_fp8(src, EFF, wgu + (size_t)e * 2816 * DM, DM, kb * 64, nb * 64, 64.f, rm, scr, F.lane); continue; } r -= 2 * IT_G;
        { const int kb = r / 32, nb = r % 32;
            transpose_item_fp8(arg_in(a, I_WDOWN) + ((size_t)l * NEXP + e) * EFF * DM, DM, wd + (size_t)e * DM * EFFP, EFFP, kb * 64, nb * 64, 64.f, RmId(), scr, F.lane); }
    }
    for (int i = F.bid * NTHREADS + F.tid; i < NEXP * DM * 8; i += F.G * NTHREADS) { const int rowi = i >> 3, q = i & 7; unsigned zz = 0u; asm volatile("" : "+v"(zz));
        *(u32x4*)(wd + (size_t)rowi * EFFP + EFF + q * 16) = (u32x4){zz, zz, zz, zz}; }
}
__device__ __forceinline__ void p0_mod(Frame& F, const Args& a) {
    LAS float* sv = (LAS float*)(F.lds + 69632);
    for (int i = F.tid; i < 3 * DM; i += NTHREADS) { const int v = i / DM, k = i % DM; const float x = v < 2 ? arg_in(a, I_C)[v * DM + k] : arg_in(a, I_CCTX)[k]; sv[i] = siluf_(x); }
    __syncthreads();
    float* mod = (float*)(F.ws + WS_CTL) + CW_MOD;
    LAS float* red = (LAS float*)(F.lds + 69632 + 3 * DM * 4);
    for (int u = F.bid; u < DEPTH * (6 * DM / 128); u += F.G) {
        const int l = u / (6 * DM / 128), nb = u % (6 * DM / 128); const int kg = F.tid >> 7, cl = F.tid & 127, n = nb * 128 + cl;
        const float* w = arg_in(a, I_WADA) + ((size_t)l * DM + kg * 512) * (6 * DM) + n;
        float a0 = 0.f, a1 = 0.f, a2 = 0.f;
#pragma unroll 32
        for (int k = 0; k < 512; ++k) { const float wv = w[(size_t)k * (6 * DM)]; const int kk = kg * 512 + k; a0 += sv[kk] * wv; a1 += sv[DM + kk] * wv; a2 += sv[2 * DM + kk] * wv; }
        __syncthreads();
        red[(kg * 3 + 0) * 128 + cl] = a0; red[(kg * 3 + 1) * 128 + cl] = a1; red[(kg * 3 + 2) * 128 + cl] = a2;
        __syncthreads();
        if (F.tid < 384) { const int v = F.tid >> 7; const float b = arg_in(a, I_BADA)[l * 6 * DM + n];
            mod[(l * 3 + v) * 6 * DM + n] = b + ((red[(0 * 3 + v) * 128 + cl] + red[(1 * 3 + v) * 128 + cl]) + (red[(2 * 3 + v) * 128 + cl] + red[(3 * 3 + v) * 128 + cl])); }
    }
}

__device__ __forceinline__ void row_stats(const f32x4 (&v)[8], float& mean, float& rstd, float eps) {
    float s = 0.f;
#pragma unroll
    for (int j = 0; j < 8; ++j) s += (v[j].x + v[j].y) + (v[j].z + v[j].w);
    mean = wave_sum(s) * (1.f / DM);
    float s2 = 0.f;
#pragma unroll
    for (int j = 0; j < 8; ++j) { const f32x4 d = v[j] - mean; s2 += (d.x * d.x + d.y * d.y) + (d.z * d.z + d.w * d.w); }
    rstd = 1.f / sqrtf(wave_sum(s2) * (1.f / DM) + eps);
}
__device__ __forceinline__ const float* x_src_row(const Args& a, const Frame& F, int layer, int row) {
    if (layer == 0) return row < TC ? arg_in(a, I_CTX) + (size_t)row * DM : arg_in(a, I_X) + (size_t)(row - TC) * DM;
    return (const float*)(F.ws + WS_XS) + (size_t)row * DM;
}
__device__ __forceinline__ void phase_modln(Frame& F, const Args& a, int layer) {
    const float* mod = (const float*)(F.ws + WS_CTL) + CW_MOD + (size_t)layer * 3 * 6 * DM;
    bf16_t* H = WSP(bf16_t, WS_H); unsigned* H8 = WSP(unsigned, WS_H8);
    for (int row = F.gw; row < T; row += F.NGW) {
        const f32x4* xr = (const f32x4*)x_src_row(a, F, layer, row) + F.lane;
        f32x4 v[8];
#pragma unroll
        for (int j = 0; j < 8; ++j) v[j] = xr[64 * j];
        float mean, rstd; row_stats(v, mean, rstd, 1e-6f);
        const float* m = mod + (size_t)row_modidx(row) * 6 * DM;
        u32x2* o = (u32x2*)(H + (size_t)row * DM) + F.lane; unsigned* o8 = H8 + (size_t)row * (DM / 4) + F.lane;
#pragma unroll
        for (int j = 0; j < 8; ++j) { const int c = 4 * (64 * j + F.lane); const f32x4 sh = *(const f32x4*)(m + c), sc = *(const f32x4*)(m + DM + c);
            const f32x4 y = (v[j] - mean) * rstd * (sc + 1.f) + sh; u32x2 w; w.x = pk2(y.x, y.y); w.y = pk2(y.z, y.w); o[64 * j] = w; o8[64 * j] = pk4fp8(y.x, y.y, y.z, y.w); }
    }
}

__device__ __forceinline__ void phase_hdn(Frame& F, const Args& a, int layer) {
    LAS float* zs = (LAS float*)(F.lds + F.wave * 512);
    const float* w1 = arg_in(a, I_HW1) + (size_t)layer * 33 * 64; const float* b1 = arg_in(a, I_HB1) + layer * 64;
    const float* w2 = arg_in(a, I_HW2) + (size_t)layer * 64 * 64; const float* b2 = arg_in(a, I_HB2) + layer * 64;
    const float fr = arg_in(a, I_HFREQ)[layer * 64 + F.lane];
    float* HDN = WSP(float, WS_HDN + layer * SZ_HDN1);
    for (int r = F.gw; r < SEQ + CTX; r += F.NGW) {
        const int n = r < SEQ ? SEQ : CTX, t = r < SEQ ? r : r - SEQ;
        const float wpos = (6.283185307179586f * (float)t) / (float)n;
        if (F.lane < 33) { float z;
            if (F.lane == 0) z = (float)t / (float)(n - 1);
            else { const int b = (F.lane - 1) & 15; const float f = 1e-4f + (float)b * ((15.f - 1e-4f) / 15.f); const float ang = f * wpos; z = F.lane <= 16 ? __cosf(ang) : -__sinf(ang); }
            zs[F.lane] = z; }
        LDS_WAIT(); asm volatile("" ::: "memory");
        float p = b1[F.lane];
#pragma unroll
        for (int i = 0; i < 33; ++i) p += zs[i] * w1[i * 64 + F.lane];
        const float h1 = __sinf(fr * p);
        zs[64 + F.lane] = h1;
        LDS_WAIT(); asm volatile("" ::: "memory");
        float q = b2[F.lane];
#pragma unroll 16
        for (int i = 0; i < 64; ++i) q += zs[64 + i] * w2[i * 64 + F.lane];
        HDN[(size_t)r * 64 + F.lane] = __sinf(fr * q);
        LDS_WAIT(); asm volatile("" ::: "memory");
    }
}
__device__ __forceinline__ float hy_delta(int c) { const float mn = -3.0701134573253943f, mx = -15.350567286626972f; return fabsf(mn + (float)c * ((mx - mn) / 1023.f)); }
__device__ __forceinline__ void phase_filt(Frame& F, const Args& a, int layer) {
    const float* w3 = arg_in(a, I_HW3) + (size_t)layer * 64 * 2048; const float* HDN = WSP(float, WS_HDN + layer * SZ_HDN1);
    LAS float* ws3 = (LAS float*)F.lds;
    bf16_t* FILT = WSP(bf16_t, WS_FILT);
    for (int u = F.bid; u < 32 * 16; u += F.G) {
        const int cb = u / 16, tb = u % 16, col0 = cb * 64, t = tb * 512 + F.tid;
        __syncthreads();
        for (int i = F.tid; i < 4096; i += NTHREADS) { const int j = i >> 6, cc = i & 63; ws3[cc * 64 + j] = w3[(size_t)j * 2048 + col0 + cc]; }
        __syncthreads();
        f32x4 h[16];
#pragma unroll
        for (int i = 0; i < 16; ++i) h[i] = *(const f32x4*)(HDN + (size_t)t * 64 + 4 * i);
        const float tn = (float)t / (float)(SEQ - 1);
        for (int cc = 0; cc < 64; ++cc) {
            float acc = 0.f;
#pragma unroll
            for (int i = 0; i < 16; ++i) { const f32x4 w = *(const LAS f32x4*)(ws3 + cc * 64 + 4 * i); acc += h[i].x * w.x + h[i].y * w.y + h[i].z * w.z + h[i].w * w.w; }
            const int col = col0 + cc, side = col >> 10, c = col & 1023;
            FILT[((size_t)c * 2 + side) * SEQ + t] = (bf16_t)f2bf(acc * __expf(-tn * hy_delta(c)));
        }
    }
    float* FILTC = WSP(float, WS_FILTC);
    for (int e = F.bid * NTHREADS + F.tid; e < CTX * 2048; e += F.G * NTHREADS) {
        const int lag = e >> 11, col = e & 2047, c = col & 1023; const float* hr = HDN + (size_t)(SEQ + lag) * 64; float acc = 0.f;
#pragma unroll 16
        for (int j = 0; j < 64; ++j) acc += hr[j] * w3[(size_t)j * 2048 + col];
        FILTC[e] = acc * __expf(-((float)lag / (float)(CTX - 1)) * hy_delta(c));
    }
}

__device__ __forceinline__ void ld8bf(const bf16_t* p, float (&o)[8]) { const u32x4 w = *(const u32x4*)p; o[0] = bflo(w.x); o[1] = bfhi(w.x); o[2] = bflo(w.y); o[3] = bfhi(w.y); o[4] = bflo(w.z); o[5] = bfhi(w.z); o[6] = bflo(w.w); o[7] = bfhi(w.w); }
__device__ __forceinline__ void up8(const u32x4 w, float (&o)[8]) { o[0] = bflo(w.x); o[1] = bfhi(w.x); o[2] = bflo(w.y); o[3] = bfhi(w.y); o[4] = bflo(w.z); o[5] = bfhi(w.z); o[6] = bflo(w.w); o[7] = bfhi(w.w); }
__device__ __forceinline__ void st8bf(bf16_t* p, const float (&v)[8]) { u32x4 w; w.x = pk2(v[0], v[1]); w.y = pk2(v[2], v[3]); w.z = pk2(v[4], v[5]); w.w = pk2(v[6], v[7]); *(u32x4*)p = w; }
__device__ __forceinline__ void ld8f(const float* p, float (&o)[8]) { const f32x4 a = *(const f32x4*)p, b = *(const f32x4*)(p + 4); o[0] = a.x; o[1] = a.y; o[2] = a.z; o[3] = a.w; o[4] = b.x; o[5] = b.y; o[6] = b.z; o[7] = b.w; }

constexpr int PREP_RUN = 16;
__device__ __forceinline__ void phase_prep(Frame& F, const Args& a, int layer) {
    const bf16_t* P = WSP(bf16_t, WS_P); bf16_t* P2 = WSP(bf16_t, WS_P2);
    float* RS = WSP(float, WS_RS); bf16_t* KPE = WSP(bf16_t, WS_KPE); float* DT = WSP(float, WS_DT);
    bf16_t* KK = WSP(bf16_t, WS_KK); bf16_t* AL_ = WSP(bf16_t, WS_ALORA); float* VC = WSP(float, WS_VC);
    const float* scw = arg_in(a, I_SCONVW) + (size_t)layer * 3 * 1536; const float* scb = arg_in(a, I_SCONVB) + layer * 1536; const float* dtb = arg_in(a, I_SDTB) + layer * 32;
    const float* hcw = arg_in(a, I_HCONVW) + (size_t)layer * 3 * 3072; const float* hcb = arg_in(a, I_HCONVB) + layer * 3072;
    const float* mu = arg_in(a, I_RMU) + (size_t)layer * 2 * 3488; const float* rkk = arg_in(a, I_RKK) + layer * 1024;
    const int lane = F.lane;
    for (int item = F.gw; item < (T / PREP_RUN) * 13; item += F.NGW) {
        const int run = item / 13, ct = item % 13; const int r0 = run * PREP_RUN;
        if (ct == 0) {
#pragma unroll 1
        for (int rr = 0; rr < PREP_RUN; ++rr) { const int row = r0 + rr; const bf16_t* pr = P + (size_t)row * NNG;
            float x[8]; ld8bf(pr + P_CQ + lane * 8, x); float s = 0.f;
#pragma unroll
            for (int i = 0; i < 8; ++i) s += x[i] * x[i];
            s = wave_sum(s); const float rq = 1.f / sqrtf(s * (1.f / 512.f) + 1e-6f);
            ld8bf(pr + P_CKV + lane * 8, x); s = 0.f;
#pragma unroll
            for (int i = 0; i < 8; ++i) s += x[i] * x[i];
            s = wave_sum(s); const float rk = 1.f / sqrtf(s * (1.f / 512.f) + 1e-6f);
            if (lane == 0) { RS[row * 2] = rq; RS[row * 2 + 1] = rk; }
            float kv = bf2f(pr[P_KPE + lane]);
            const float other = swz16(kv);
            if (row >= TC) { const int t = (row - TC) & (SEQ - 1); const int axis = lane >> 5, half = (lane >> 4) & 1, j = lane & 15;
                const float pos = (float)(axis == 0 ? (t >> 6) : (t & 63)); const float inv = __builtin_amdgcn_exp2f(-(float)j * 0.8304820237218406f);
                const float sn = __sinf(pos * inv), cs = __cosf(pos * inv);
                kv = half == 0 ? kv * cs - other * sn : kv * cs + other * sn; }
            KPE[(size_t)row * 64 + lane] = (bf16_t)f2bf(kv);
            if (lane < 32) DT[(size_t)row * 32 + lane] = softplusf_(bf2f(pr[P_DT + lane]) + dtb[lane]); }
        continue; }
        const bool first = row_first(r0), last = row_last(r0 + PREP_RUN - 1);
        if (ct >= 1 && ct <= 3) { const int ch = ct - 1; const int c = ch * 512 + lane * 8; float xm[8], x0[8], xp[8], w0[8], w1[8], w2[8], bb[8];
            ld8f(scw + c, w0); ld8f(scw + 1536 + c, w1); ld8f(scw + 3072 + c, w2); ld8f(scb + c, bb);
            const bf16_t* pc = P + (size_t)r0 * NNG + P_XBC + c;
            u32x4 raw[PREP_RUN + 2];
#pragma unroll
            for (int rr = 0; rr < PREP_RUN + 2; ++rr) { const bool ok = (rr > 0 || !first) && (rr < PREP_RUN + 1 || !last); raw[rr] = ok ? *(const u32x4*)(pc + (ptrdiff_t)(rr - 1) * NNG) : (u32x4){0u, 0u, 0u, 0u}; }
            up8(raw[0], xm); up8(raw[1], x0);
#pragma unroll
            for (int rr = 0; rr < PREP_RUN; ++rr) {
                up8(raw[rr + 2], xp);
                float o[8];
#pragma unroll
                for (int i = 0; i < 8; ++i) { o[i] = siluf_(xm[i] * w0[i] + x0[i] * w1[i] + xp[i] * w2[i] + bb[i]); xm[i] = x0[i]; x0[i] = xp[i]; }
                st8bf(P2 + (size_t)(r0 + rr) * P2W + P2_XBC + c, o); } continue; }
        if (ct >= 4 && ct <= 5) { const int ch = ct - 4; { const int c = ch * 512 + lane * 8; float xm[8], x0[8], xp[8], w0[8], w1[8], w2[8], bb[8];
            ld8f(hcw + c, w0); ld8f(hcw + 3072 + c, w1); ld8f(hcw + 6144 + c, w2); ld8f(hcb + c, bb);
            const bf16_t* pc = P + (size_t)r0 * NNG + P_HY + c;
            u32x4 raw[PREP_RUN + 2];
#pragma unroll
            for (int rr = 0; rr < PREP_RUN + 2; ++rr) { const bool ok = (rr > 0 || !first) && (rr < PREP_RUN + 1 || !last); raw[rr] = ok ? *(const u32x4*)(pc + (ptrdiff_t)(rr - 1) * NNG) : (u32x4){0u, 0u, 0u, 0u}; }
            up8(raw[0], xm); up8(raw[1], x0);
#pragma unroll
            for (int rr = 0; rr < PREP_RUN; ++rr) {
                up8(raw[rr + 2], xp);
                float o[8];
#pragma unroll
                for (int i = 0; i < 8; ++i) { o[i] = xm[i] * w0[i] + x0[i] * w1[i] + xp[i] * w2[i] + bb[i]; xm[i] = x0[i]; x0[i] = xp[i]; }
                st8bf(P2 + (size_t)(r0 + rr) * P2W + P2_X0 + c, o); } }
        if (r0 < TC) {
#pragma unroll 1
                for (int rr = 0; rr < PREP_RUN; ++rr) { const int row = r0 + rr; const bool f1 = row_first(row), l1 = row_last(row); const int c = ch * 512 + lane * 8;
                    const bf16_t* pr = P + (size_t)row * NNG; float o1[8], o2[8];
#pragma unroll
                    for (int part = 1; part < 3; ++part) { float x0[8], xm[8], xp[8], w0[8], w1[8], w2[8], bb[8]; const int cc = part * 1024 + c;
                        ld8bf(pr + P_HY + cc, x0);
                        if (!f1) ld8bf(pr - NNG + P_HY + cc, xm); else { for (int i = 0; i < 8; ++i) xm[i] = 0.f; }
                        if (!l1) ld8bf(pr + NNG + P_HY + cc, xp); else { for (int i = 0; i < 8; ++i) xp[i] = 0.f; }
                        ld8f(hcw + cc, w0); ld8f(hcw + 3072 + cc, w1); ld8f(hcw + 6144 + cc, w2); ld8f(hcb + cc, bb);
#pragma unroll
                        for (int i = 0; i < 8; ++i) { const float r = xm[i] * w0[i] + x0[i] * w1[i] + xp[i] * w2[i] + bb[i]; if (part == 1) o1[i] = r; else o2[i] = r; } }
                    float* vc = VC + (size_t)row * 1024 + c;
                    *(f32x4*)vc = (f32x4){o1[0] * o2[0], o1[1] * o2[1], o1[2] * o2[2], o1[3] * o2[3]};
                    *(f32x4*)(vc + 4) = (f32x4){o1[4] * o2[4], o1[5] * o2[5], o1[6] * o2[6], o1[7] * o2[7]}; } }
        continue; }
        { const int ch = ct - 6; const int c = ch * 512 + lane * 8;
            if (c < 3488) { float um[8], u0[8], up[8], m0[8], m1[8], g8[8];
                ld8f(mu + c, m0); ld8f(mu + 3488 + c, m1);
                if (ch == 2 || ch == 3) ld8f(rkk + (c - 1024), g8);
                const bf16_t* pc = P + (size_t)r0 * NNG + P_RW + c;
                u32x4 raw[PREP_RUN + 2];
#pragma unroll
                for (int rr = 0; rr < PREP_RUN + 2; ++rr) { const bool ok = (rr > 0 || !first) && (rr < PREP_RUN + 1 || !last); raw[rr] = ok ? *(const u32x4*)(pc + (ptrdiff_t)(rr - 1) * NNG) : (u32x4){0u, 0u, 0u, 0u}; }
                up8(raw[0], um); up8(raw[1], u0);
#pragma unroll
                for (int rr = 0; rr < PREP_RUN; ++rr) { const int row = r0 + rr;
                    up8(raw[rr + 2], up);
                    float us[8];
#pragma unroll
                    for (int i = 0; i < 8; ++i) { us[i] = u0[i] + m0[i] * (um[i] - u0[i]) + m1[i] * (up[i] - u0[i]); um[i] = u0[i]; u0[i] = up[i]; }
                    if (ch < 6) st8bf(P2 + (size_t)row * P2W + P2_RKV + c, us);
                    if (ch == 2 || ch == 3) { float kx[8]; float s = 0.f;
#pragma unroll
                        for (int i = 0; i < 8; ++i) { kx[i] = us[i] * g8[i]; s += kx[i] * kx[i]; }
                        s = sum8(s);
                        const float inv = 1.f / fmaxf(sqrtf(s), 1e-12f);
#pragma unroll
                        for (int i = 0; i < 8; ++i) kx[i] *= inv;
                        st8bf(KK + (size_t)row * 1024 + (c - 1024), kx); }
                    if (ch == 6) { const int cl = c - 3072; float o[8];
#pragma unroll
                        for (int i = 0; i < 8; ++i) o[i] = cl < 128 ? tanhf_(us[i]) : cl < 256 ? us[i] : sigmoidf_(us[i]);
                        st8bf(AL_ + (size_t)row * 512 + cl, o); } } }
            else if (ch == 6) { const int cl = c - 3072;
                for (int rr = 0; rr < PREP_RUN; ++rr) { float zz = 0.f; asm volatile("" : "+v"(zz)); float o[8] = {zz, zz, zz, zz, zz, zz, zz, zz}; st8bf(AL_ + (size_t)(r0 + rr) * 512 + cl, o); } } }
    }
    float* VT = WSP(float, WS_VT);
    LAS float* tl = (LAS float*)F.lds;
    for (int u = F.bid; u < (TL / 64) * 4; u += F.G) {
        const int tb = u >> 2, cb = u & 3; const int row0 = TC + tb * 64; const int c8 = (F.tid & 31) * 8, c = cb * 256 + c8, tq = F.tid >> 5;
        float w1[3][8], w2[3][8], b1[8], b2[8];
#pragma unroll
        for (int k = 0; k < 3; ++k) { ld8f(hcw + k * 3072 + 1024 + c, w1[k]); ld8f(hcw + k * 3072 + 2048 + c, w2[k]); }
        ld8f(hcb + 1024 + c, b1); ld8f(hcb + 2048 + c, b2);
        __syncthreads();
#pragma unroll 1
        for (int i = 0; i < 4; ++i) { const int tl_ = tq * 4 + i, row = row0 + tl_; const bf16_t* pr = P + (size_t)row * NNG + P_HY;
            const bool first = row_first(row), last = row_last(row);
            float a1[8], a2[8], x[8];
            ld8bf(pr + 1024 + c, x);
#pragma unroll
            for (int j = 0; j < 8; ++j) a1[j] = x[j] * w1[1][j] + b1[j];
            ld8bf(pr + 2048 + c, x);
#pragma unroll
            for (int j = 0; j < 8; ++j) a2[j] = x[j] * w2[1][j] + b2[j];
            if (!first) { ld8bf(pr - NNG + 1024 + c, x);
#pragma unroll
                for (int j = 0; j < 8; ++j) a1[j] += x[j] * w1[0][j];
                ld8bf(pr - NNG + 2048 + c, x);
#pragma unroll
                for (int j = 0; j < 8; ++j) a2[j] += x[j] * w2[0][j]; }
            if (!last) { ld8bf(pr + NNG + 1024 + c, x);
#pragma unroll
                for (int j = 0; j < 8; ++j) a1[j] += x[j] * w1[2][j];
                ld8bf(pr + NNG + 2048 + c, x);
#pragma unroll
                for (int j = 0; j < 8; ++j) a2[j] += x[j] * w2[2][j]; }
#pragma unroll
            for (int j = 0; j < 8; ++j) tl[(c8 + j) * 65 + tl_] = a1[j] * a2[j]; }
        __syncthreads();
        const int b = (row0 - TC) >> 13, t0 = (row0 - TC) & (SEQ - 1);
        for (int p_ = 0; p_ < 8; ++p_) { const int cl = p_ * 32 + (F.tid >> 4), q = F.tid & 15;
            const f32x4 o = {tl[cl * 65 + 4 * q], tl[cl * 65 + 4 * q + 1], tl[cl * 65 + 4 * q + 2], tl[cl * 65 + 4 * q + 3]};
            *(f32x4*)(VT + ((size_t)(cb * 256 + cl) * 2 + b) * SEQ + t0 + 4 * q) = o; }
    }
}

using pg8::Unit;
#define EPI_LOOP_BEGIN const int row0 = u.pm * 256 + wr * 64 + fr; \
    _Pragma("unroll") for (int ai = 0; ai < 2; ++ai) _Pragma("unroll") for (int m = 0; m < 4; ++m) { const int row = row0 + ai * 128 + m * 16; \
    _Pragma("unroll") for (int bj = 0; bj < 2; ++bj) { const int cl = bj * 128 + wc * 32 + 8 * fq; const f32x4 v0 = acc[ai][bj][m][0], v1 = acc[ai][bj][m][1];
#define EPI_LOOP_END } __builtin_amdgcn_sched_barrier(0); }
struct EpiBf16 {
    static constexpr bool PERM = true, KEEPS = false;
    bf16_t* O; int ldc; const float* rscale; int rs_stride; int act; float cscale;
    __device__ __forceinline__ void operator()(const f32x4 (&acc)[2][2][4][2], const Unit& u, int wr, int wc, int fr, int fq) const {
        EPI_LOOP_BEGIN
            const float s = rscale ? rscale[(size_t)row * rs_stride] : cscale;
            float x[8] = {v0.x * s, v0.y * s, v0.z * s, v0.w * s, v1.x * s, v1.y * s, v1.z * s, v1.w * s};
            if (act == 1) {
#pragma unroll
                for (int i = 0; i < 8; ++i) x[i] = sigmoidf_(x[i]); }
            u32x4 w; w.x = cvt_pk_bf16(x[0], x[1]); w.y = cvt_pk_bf16(x[2], x[3]); w.z = cvt_pk_bf16(x[4], x[5]); w.w = cvt_pk_bf16(x[6], x[7]);
            *(u32x4*)(O + (size_t)row * ldc + u.pn * 256 + cl) = w;
        EPI_LOOP_END
    }
};
struct EpiLora {
    static constexpr bool PERM = true, KEEPS = false;
    bf16_t* EW; bf16_t* ICLR; bf16_t* GG; const float* w0; const float* a0;
    __device__ __forceinline__ void operator()(const f32x4 (&acc)[2][2][4][2], const Unit& u, int wr, int wc, int fr, int fq) const {
        const int blk = u.pn >> 2, cb = (u.pn & 3) * 256;
        const float* bias = blk < 2 ? w0 + blk * 1024 : a0 + (blk & 1) * 1024;
        bf16_t* dbase = blk < 2 ? EW + (size_t)blk * T * 1024 : blk < 4 ? ICLR + (size_t)(blk - 2) * T * 1024 : GG;
        const float scale = blk < 2 ? 0.6065306597126334f : 1.f; const bool sig = blk < 4;
        f32x4 bia[2][2];
#pragma unroll
        for (int bj = 0; bj < 2; ++bj) { const int c = cb + bj * 128 + wc * 32 + 8 * fq; bia[bj][0] = *(const f32x4*)(bias + c); bia[bj][1] = *(const f32x4*)(bias + c + 4); }
        EPI_LOOP_BEGIN
            const int c = cb + cl; float x[8] = {v0.x, v0.y, v0.z, v0.w, v1.x, v1.y, v1.z, v1.w};
            if (sig) { const f32x4 b0 = bia[bj][0], b1 = bia[bj][1]; const float bb[8] = {b0.x, b0.y, b0.z, b0.w, b1.x, b1.y, b1.z, b1.w};
#pragma unroll
                for (int i = 0; i < 8; ++i) x[i] = scale * sigmoidf_(bb[i] + x[i]); }
            u32x4 w; w.x = cvt_pk_bf16(x[0], x[1]); w.y = cvt_pk_bf16(x[2], x[3]); w.z = cvt_pk_bf16(x[4], x[5]); w.w = cvt_pk_bf16(x[6], x[7]);
            *(u32x4*)(dbase + (size_t)row * 1024 + c) = w;
        EPI_LOOP_END
    }
};
struct EpiMerge {
    static constexpr bool PERM = true, KEEPS = true;
    const bf16_t* gates; bf16_t* MB;
    __device__ __forceinline__ bool operator()(f32x4 (&acc)[2][2][4][2], const Unit& uu, int wr, int wc, int fr, int fq) const {
        const int br = uu.pn >> 3; Unit u; u.pm = uu.pm - br * 66; u.pn = uu.pn & 7;
        const int row0 = u.pm * 256 + wr * 64 + fr, col0 = u.pn * 256 + wc * 32 + 8 * fq; const bool last = br == 3;
        const bf16_t* gcur = gates + br * DM + col0; const bf16_t* gnxt = gates + (last ? br : br + 1) * DM + col0;
        u32x4 gq[2], hq[2], gn[2], hn[2];
#define EM_ROW(it_) ((size_t)(row0 + ((it_) >> 2) * 128 + ((it_) & 3) * 16))
#pragma unroll
        for (int bj = 0; bj < 2; ++bj) { gq[bj] = *(const u32x4*)(gcur + EM_ROW(0) * NGATE + bj * 128); hq[bj] = *(const u32x4*)(gnxt + EM_ROW(0) * NGATE + bj * 128); }
#pragma unroll
        for (int it = 0; it < 8; ++it) { const int ai = it >> 2, m = it & 3;
            if (it < 7) {
#pragma unroll
                for (int bj = 0; bj < 2; ++bj) { gn[bj] = *(const u32x4*)(gcur + EM_ROW(it + 1) * NGATE + bj * 128); hn[bj] = *(const u32x4*)(gnxt + EM_ROW(it + 1) * NGATE + bj * 128); } }
#pragma unroll
            for (int bj = 0; bj < 2; ++bj) { float g[8], hh[8]; up8(gq[bj], g); up8(hq[bj], hh); float f[8];
#pragma unroll
                for (int i = 0; i < 8; ++i) { const float ea = __expf(-g[i]), eb = __expf(-hh[i]); f[i] = last ? 1.f / (1.f + ea) : (1.f + eb) / (1.f + ea); }
                f32x4& v0 = acc[ai][bj][m][0]; f32x4& v1 = acc[ai][bj][m][1];
                v0 = v0 * (f32x4){f[0], f[1], f[2], f[3]}; v1 = v1 * (f32x4){f[4], f[5], f[6], f[7]};
                if (last) { u32x4 w; w.x = cvt_pk_bf16(v0.x, v0.y); w.y = cvt_pk_bf16(v0.z, v0.w); w.z = cvt_pk_bf16(v1.x, v1.y); w.w = cvt_pk_bf16(v1.z, v1.w);
                    *(u32x4*)(MB + EM_ROW(it) * DM + col0 + bj * 128) = w; } }
            gq[0] = gn[0]; gq[1] = gn[1]; hq[0] = hn[0]; hq[1] = hn[1];
            __builtin_amdgcn_sched_barrier(0); }
#undef EM_ROW
        return !last;
    }
};
struct OrderMerge {
    pg8::StaticOrder so;
    __device__ void init(int G, int c, int nM, int pm0) { so.init(nM, 8, G, c, pm0); }
    __device__ bool next(int i, Unit& u) const { Unit t; if (!so.next(i >> 2, t)) return false; const int br = i & 3; u.pm = br * 66 + t.pm; u.pn = br * 8 + t.pn; return true; }
};
struct EpiF32 {
    static constexpr bool PERM = true, KEEPS = false;
    float* O; int ldc;
    __device__ __forceinline__ void operator()(const f32x4 (&acc)[2][2][4][2], const Unit& u, int wr, int wc, int fr, int fq) const {
        EPI_LOOP_BEGIN
            float* o = O + (size_t)row * ldc + u.pn * 256 + cl; *(f32x4*)o = v0; *(f32x4*)(o + 4) = v1;
        EPI_LOOP_END
    }
};
__device__ __forceinline__ int moe_panel(int e, int pi) { return pi < 8 ? (((pi >> 2) * NEXP + e) * 4 + (pi & 3)) : 128 + e; }
struct OrderMoe {
    int npn, G, c, npan;
    __device__ void init(int npn_, int G_, int c_, int npan_) { npn = npn_; G = G_; c = c_; npan = npan_; }
    __device__ bool next(int i, Unit& u) const { const int L = i * G + c; const int per = npan * npn; if (L >= NEXP * per) return false;
        const int e = L / per, r = L % per, j = r / npan, pi = r % npan; u.pm = moe_panel(e, pi); u.pn = e * npn + j; return true; }
};
struct EpiSwiglu {
    static constexpr bool PERM = true, KEEPS = false;
    unsigned char* HID;
    __device__ __forceinline__ void operator()(const f32x4 (&acc)[2][2][4][2], const Unit& u, int wr, int wc, int fr, int fq) const {
        const int j = u.pn % 11; const int row0 = u.pm * 256 + wr * 64 + fr; const float sc = 1.f / 64.f;
#pragma unroll
        for (int ai = 0; ai < 2; ++ai)
#pragma unroll
            for (int m = 0; m < 4; ++m) { const int row = row0 + ai * 128 + m * 16;
                const f32x4 g0 = acc[ai][0][m][0] * sc, g1 = acc[ai][0][m][1] * sc, u0 = acc[ai][1][m][0] * sc, u1 = acc[ai][1][m][1] * sc;
                u32x2 w; w.x = pk4fp8(siluf_(g0.x) * u0.x, siluf_(g0.y) * u0.y, siluf_(g0.z) * u0.z, siluf_(g0.w) * u0.w);
                w.y = pk4fp8(siluf_(g1.x) * u1.x, siluf_(g1.y) * u1.y, siluf_(g1.z) * u1.z, siluf_(g1.w) * u1.w);
                *(u32x2*)(HID + (size_t)row * EFFP + j * 128 + wc * 32 + 8 * fq) = w; __builtin_amdgcn_sched_barrier(0); }
    }
};
struct EpiDown {
    static constexpr bool PERM = true, KEEPS = false;
    bf16_t* YE;
    __device__ __forceinline__ void operator()(const f32x4 (&acc)[2][2][4][2], const Unit& uu, int wr, int wc, int fr, int fq) const {
        Unit u; u.pm = uu.pm; u.pn = uu.pn & 7; const float s = 1.f / 64.f;
        EPI_LOOP_BEGIN
            u32x4 w; w.x = cvt_pk_bf16(v0.x * s, v0.y * s); w.y = cvt_pk_bf16(v0.z * s, v0.w * s); w.z = cvt_pk_bf16(v1.x * s, v1.y * s); w.w = cvt_pk_bf16(v1.z * s, v1.w * s);
            *(u32x4*)(YE + (size_t)row * DM + u.pn * 256 + cl) = w;
        EPI_LOOP_END
    }
};

namespace att {
using s16x4 = __attribute__((ext_vector_type(4))) short;
using f32x16 = __attribute__((ext_vector_type(16))) float;
constexpr int NW = 8, QBLK = 32, KVBLK = 64, LDQ = 1536, LDKV = 2048, LDO = 1024;
constexpr float SCALE = 0.07216878364870322f;
constexpr float THR = 8.f;
#ifndef ATT_SDEPTH
#define ATT_SDEPTH 1
#endif
constexpr int SDEPTH = ATT_SDEPTH;
constexpr int SHM_V = KVBLK * 128 * 2, SHM_K = KVBLK * 128 * 2, SHM_KP = KVBLK * 64 * 2;
constexpr int OFF_V = 0, OFF_K = 2 * SHM_V, OFF_KP = OFF_K + 2 * SHM_K, OFF_WS = OFF_KP + 2 * SHM_KP, OFF_QP = OFF_WS + NW * 64 * 4, SHM_ATTN = OFF_QP + 256 * 256;
static_assert(SHM_ATTN <= 150 * 1024, "attention LDS");
#define KSWZ(row, colB) ((row) * 256 + ((colB) ^ (((row) & 7) << 4)))
#define KPSWZ(row, colB) ((row) * 128 + ((colB) ^ (((row) & 7) << 4)))
#define SBAR() __builtin_amdgcn_sched_barrier(0)
__device__ __forceinline__ int crow(int r, int hi) { return (r & 3) + 8 * (r >> 2) + 4 * hi; }
__device__ __forceinline__ void partialSM(f32x16& p0, f32x16& p1, float& m_reg, float& mn, float& alpha) {
  constexpr float C = SCALE * 1.4426950408889634f;
  float pmax = p0[0]; for (int r = 1; r < 16; ++r) pmax = fmaxf(pmax, p0[r]); for (int r = 0; r < 16; ++r) pmax = fmaxf(pmax, p1[r]);
  { auto rr = __builtin_amdgcn_permlane32_swap(__float_as_uint(pmax), __float_as_uint(pmax), false, false);
    pmax = fmaxf(__uint_as_float(rr[0]), __uint_as_float(rr[1])); }
  if (__builtin_expect(__all(pmax - m_reg <= THR / SCALE), 1)) { mn = m_reg; alpha = 1.f; }
  else { mn = fmaxf(m_reg, pmax); alpha = __builtin_amdgcn_exp2f((m_reg - mn) * C); m_reg = mn; }
  float mnC = -mn * C;
  for (int r = 0; r < 16; ++r) p0[r] = fmaf(p0[r], C, mnC); for (int r = 0; r < 16; ++r) p1[r] = fmaf(p1[r], C, mnC);
  for (int r = 0; r < 16; ++r) p0[r] = __builtin_amdgcn_exp2f(p0[r]);
}
__device__ __forceinline__ void finishSM(f32x16& p0, f32x16& p1, float alpha, float& l_reg, bf16x8& pa0, bf16x8& pa1, bf16x8& pa2, bf16x8& pa3) {
  for (int r = 0; r < 16; ++r) p1[r] = __builtin_amdgcn_exp2f(p1[r]);
  float ps = 0; for (int r = 0; r < 16; ++r) ps += p0[r]; for (int r = 0; r < 16; ++r) ps += p1[r];
  { auto rr = __builtin_amdgcn_permlane32_swap(__float_as_uint(ps), __float_as_uint(ps), false, false);
    ps = __uint_as_float(rr[0]) + __uint_as_float(rr[1]); }
  l_reg = l_reg * alpha + ps;
#define PK4(P, BASE, OUT) do { unsigned a0 = cvt_pk_bf16(P[BASE + 0], P[BASE + 1]), a1 = cvt_pk_bf16(P[BASE + 2], P[BASE + 3]);   \
    unsigned b0 = cvt_pk_bf16(P[BASE + 4], P[BASE + 5]), b1 = cvt_pk_bf16(P[BASE + 6], P[BASE + 7]);                              \
    auto r0 = __builtin_amdgcn_permlane32_swap(a0, b0, false, false); auto r1 = __builtin_amdgcn_permlane32_swap(a1, b1, false, false); \
    u32x4 w = {r0[0], r1[0], r0[1], r1[1]}; OUT = *reinterpret_cast<bf16x8*>(&w); } while (0)
  PK4(p0, 0, pa0); PK4(p0, 8, pa1); PK4(p1, 0, pa2); PK4(p1, 8, pa3);
#undef PK4
}
__device__ __forceinline__ void qkt(f32x16& p0, f32x16& p1, const char* Ks, const char* Kp, const bf16x8* qr, const char* Qp, int qrow, int r32, int hi) {
  p0 = f32x16{}; p1 = f32x16{};
#pragma unroll
  for (int d0 = 0; d0 < 8; ++d0) { int cb = (d0 * 16 + hi * 8) * 2;
    bf16x8 b0 = *reinterpret_cast<const bf16x8*>(Ks + KSWZ(r32, cb));
    bf16x8 b1 = *reinterpret_cast<const bf16x8*>(Ks + KSWZ(32 + r32, cb));
    bf16x8 q; if (d0 < 4) q = qr[d0]; else q = *reinterpret_cast<const bf16x8*>(Qp + KSWZ(qrow, ((d0 - 4) * 16 + hi * 8) * 2));
    p0 = __builtin_amdgcn_mfma_f32_32x32x16_bf16(b0, q, p0, 0, 0, 0);
    p1 = __builtin_amdgcn_mfma_f32_32x32x16_bf16(b1, q, p1, 0, 0, 0); }
#pragma unroll
  for (int d0 = 0; d0 < 4; ++d0) { int cb = (d0 * 16 + hi * 8) * 2;
    bf16x8 b0 = *reinterpret_cast<const bf16x8*>(Kp + KPSWZ(r32, cb));
    bf16x8 b1 = *reinterpret_cast<const bf16x8*>(Kp + KPSWZ(32 + r32, cb));
    const bf16x8 qp = *reinterpret_cast<const bf16x8*>(Qp + KSWZ(qrow, 128 + cb));
    p0 = __builtin_amdgcn_mfma_f32_32x32x16_bf16(b0, qp, p0, 0, 0, 0);
    p1 = __builtin_amdgcn_mfma_f32_32x32x16_bf16(b1, qp, p1, 0, 0, 0); }
}
__device__ __forceinline__ int v_st(int k, int c) { const int kk = (k & ~0xC) | ((k & 4) << 1) | ((k & 8) >> 1); return ((kk >> 3) * 4 + (c >> 5)) * 512 + ((kk & 7) * 32 + (c & 31)) * 2; }
__device__ __forceinline__ int v_rd_base(int lane) { return ((lane & 3) << 3) | (((lane >> 2) & 3) << 6) | (((lane >> 4) & 1) << 5) | (((lane >> 5) & 1) << 8); }
constexpr int v_rd_off(int d0, int ks, int half) { return d0 * 512 + ks * 4096 + half * 2048; }
template <int OFF> __device__ __forceinline__ s16x4 tr_read(int vb) {
  s16x4 r; asm volatile("ds_read_b64_tr_b16 %0, %1 offset:%2" : "=&v"(r) : "v"(vb), "i"(OFF) : "memory"); return r;
}
template <int D0> __device__ __forceinline__ void pv_one(f32x16& od, int vb, bf16x8 pa0, bf16x8 pa1, bf16x8 pa2, bf16x8 pa3) {
  const s16x4 l0 = tr_read<v_rd_off(D0, 0, 0)>(vb), h0 = tr_read<v_rd_off(D0, 0, 1)>(vb), l1 = tr_read<v_rd_off(D0, 1, 0)>(vb), h1 = tr_read<v_rd_off(D0, 1, 1)>(vb);
  const s16x4 l2 = tr_read<v_rd_off(D0, 2, 0)>(vb), h2 = tr_read<v_rd_off(D0, 2, 1)>(vb), l3 = tr_read<v_rd_off(D0, 3, 0)>(vb), h3 = tr_read<v_rd_off(D0, 3, 1)>(vb);
  asm volatile("s_waitcnt lgkmcnt(0)" ::: "memory"); SBAR();
#define PK(L, H) (bf16x8){L[0], L[1], L[2], L[3], H[0], H[1], H[2], H[3]}
  od = __builtin_amdgcn_mfma_f32_32x32x16_bf16(pa0, PK(l0, h0), od, 0, 0, 0);
  od = __builtin_amdgcn_mfma_f32_32x32x16_bf16(pa1, PK(l1, h1), od, 0, 0, 0);
  od = __builtin_amdgcn_mfma_f32_32x32x16_bf16(pa2, PK(l2, h2), od, 0, 0, 0);
  od = __builtin_amdgcn_mfma_f32_32x32x16_bf16(pa3, PK(l3, h3), od, 0, 0, 0);
#undef PK
}
__device__ __forceinline__ void pv_d0(f32x16* o, int vb, bf16x8 pa0, bf16x8 pa1, bf16x8 pa2, bf16x8 pa3) {
  pv_one<0>(o[0], vb, pa0, pa1, pa2, pa3); pv_one<1>(o[1], vb, pa0, pa1, pa2, pa3); pv_one<2>(o[2], vb, pa0, pa1, pa2, pa3); pv_one<3>(o[3], vb, pa0, pa1, pa2, pa3);
}
__device__ __forceinline__ void attn_unit(const bf16_t* __restrict__ Qb, const bf16_t* __restrict__ KVh, const bf16_t* __restrict__ KPE, bf16_t* __restrict__ Ob,
                                          int ka0, int kb0, int NT, char* lds, int tid_in, int tpos0) {
  const unsigned tid_u = (unsigned)tid_in; __builtin_assume(tid_u < 512u);
  const int tid = (int)tid_u, wid = tid >> 6, lane = tid & 63, r32 = lane & 31, hi = lane >> 5;
  char* V_lds = lds + OFF_V; char* K_lds = lds + OFF_K; char* P_lds = lds + OFF_KP;
  float* ws = (float*)(lds + OFF_WS) + wid * 64; float* li_l = ws; float* al_l = ws + 32;
  float m_reg = -1e30f, l_reg = 0; f32x16 o[4] = {}; bf16x8 qr[4];
  char* Q_lds = lds + OFF_QP; const int qrow = wid * QBLK + r32;
  const bf16_t* Qw = Qb + (long)(wid * QBLK + r32) * LDQ + hi * 8;
#pragma unroll
  for (int d0 = 0; d0 < 4; ++d0) qr[d0] = *reinterpret_cast<const bf16x8*>(Qw + d0 * 16);
#pragma unroll
  for (int d0 = 0; d0 < 4; ++d0) *reinterpret_cast<bf16x8*>(Q_lds + KSWZ(qrow, (d0 * 16 + hi * 8) * 2)) = *reinterpret_cast<const bf16x8*>(Qw + 64 + d0 * 16);
#pragma unroll
  for (int ax = 0; ax < 2; ++ax) { u32x4 w1 = *reinterpret_cast<const u32x4*>(Qw + 128 + ax * 32), w2 = *reinterpret_cast<const u32x4*>(Qw + 128 + ax * 32 + 16);
    if (tpos0 >= 0) { const int t = tpos0 + qrow; const float pos = (float)(ax == 0 ? (t >> 6) : (t & 63));
      unsigned* p1 = (unsigned*)&w1; unsigned* p2 = (unsigned*)&w2;
#pragma unroll
      for (int i = 0; i < 4; ++i) { float a0 = bflo(p1[i]), a1 = bfhi(p1[i]), b0 = bflo(p2[i]), b1 = bfhi(p2[i]);
        const float ang0 = pos * __builtin_amdgcn_exp2f(-(float)(hi * 8 + 2 * i) * 0.8304820237218406f), ang1 = pos * __builtin_amdgcn_exp2f(-(float)(hi * 8 + 2 * i + 1) * 0.8304820237218406f);
        const float c0 = __cosf(ang0), s0 = __sinf(ang0), c1 = __cosf(ang1), s1 = __sinf(ang1);
        p1[i] = pk2(a0 * c0 - b0 * s0, a1 * c1 - b1 * s1); p2[i] = pk2(b0 * c0 + a0 * s0, b1 * c1 + a1 * s1); } }
    *reinterpret_cast<u32x4*>(Q_lds + KSWZ(qrow, 128 + (ax * 32 + hi * 8) * 2)) = w1; *reinterpret_cast<u32x4*>(Q_lds + KSWZ(qrow, 128 + (ax * 32 + 16 + hi * 8) * 2)) = w2; }
  const int sr = tid >> 4, sc = (tid & 15) * 8, vst0 = v_st(sr, sc), vst1 = v_st(32 + sr, sc);
  const int pr = tid >> 3, pc = (tid & 7) * 8;
  const int vb0 = (int)(uintptr_t)V_lds + v_rd_base(lane);
  struct { bf16x8 vs0, vs1, ks0, ks1, kp; } sr_[SDEPTH];
#define KROW(j) ((j) < 4 ? ka0 + 64 * (j) : kb0 + 64 * ((j) - 4))
  const __amdgpu_buffer_rsrc_t rsKV = __builtin_amdgcn_make_buffer_rsrc((void*)KVh, 0, 0xFFFFFFFFu, 0x00020000);
  const __amdgpu_buffer_rsrc_t rsKP = __builtin_amdgcn_make_buffer_rsrc((void*)KPE, 0, 0xFFFFFFFFu, 0x00020000);
  const int vo_k = (sr * LDKV + sc) * 2, vo_p = (pr * 64 + pc) * 2;
#define SLOAD(i, jt) do { const int k0_ = KROW(jt); const int so0 = k0_ * (LDKV * 2), so1 = so0 + 32 * LDKV * 2; \
    sr_[i].vs0 = __builtin_bit_cast(bf16x8, __builtin_amdgcn_raw_buffer_load_b128(rsKV, vo_k + 256, so0, 0)); sr_[i].vs1 = __builtin_bit_cast(bf16x8, __builtin_amdgcn_raw_buffer_load_b128(rsKV, vo_k + 256, so1, 0)); \
    sr_[i].ks0 = __builtin_bit_cast(bf16x8, __builtin_amdgcn_raw_buffer_load_b128(rsKV, vo_k, so0, 0)); sr_[i].ks1 = __builtin_bit_cast(bf16x8, __builtin_amdgcn_raw_buffer_load_b128(rsKV, vo_k, so1, 0)); \
    sr_[i].kp = __builtin_bit_cast(bf16x8, __builtin_amdgcn_raw_buffer_load_b128(rsKP, vo_p, k0_ * 128, 0)); } while (0)
#define SWRITE(b, i) do { *(bf16x8*)(V_lds + (b) * SHM_V + vst0) = sr_[i].vs0;          \
    *(bf16x8*)(V_lds + (b) * SHM_V + vst1) = sr_[i].vs1; int kc = sc * 2;               \
    *(bf16x8*)(K_lds + (b) * SHM_K + KSWZ(sr, kc)) = sr_[i].ks0;                       \
    *(bf16x8*)(K_lds + (b) * SHM_K + KSWZ(32 + sr, kc)) = sr_[i].ks1;                  \
    *(bf16x8*)(P_lds + (b) * SHM_KP + KPSWZ(pr, pc * 2)) = sr_[i].kp; } while (0)
#define SWAIT() do { if constexpr (SDEPTH == 2) asm volatile("s_waitcnt vmcnt(5)" ::: "memory"); else asm volatile("s_waitcnt vmcnt(0)" ::: "memory"); } while (0)
#define RESC(a) do { if (__any((a) < 1.f)) { if (hi == 0) al_l[r32] = (a); asm volatile("s_waitcnt lgkmcnt(0)" ::: "memory"); \
    for (int d = 0; d < 4; ++d) for (int r = 0; r < 16; ++r) o[d][r] *= al_l[crow(r, hi)]; } } while (0)
  f32x16 pA0, pA1, pB0, pB1; float mnA, mnB, alA, alB; bf16x8 pa0, pa1, pa2, pa3;
  constexpr int SE = 0, SO = SDEPTH - 1;
  SLOAD(SE, 0); asm volatile("s_waitcnt vmcnt(0)" ::: "memory"); SWRITE(0, SE); __syncthreads();
  qkt(pA0, pA1, K_lds, P_lds, qr, Q_lds, qrow, r32, hi); partialSM(pA0, pA1, m_reg, mnA, alA);
  SLOAD(SO, 1); if constexpr (SDEPTH == 2) { if (2 < NT) SLOAD(SE, 2); }
  SWAIT(); SWRITE(1, SO); __syncthreads();
  for (int j = 1; j + 1 < NT; j += 2) {
    SBAR(); qkt(pB0, pB1, K_lds + SHM_K, P_lds + SHM_KP, qr, Q_lds, qrow, r32, hi);
    finishSM(pA0, pA1, alA, l_reg, pa0, pa1, pa2, pa3); SBAR();
    SLOAD(SO, j + SDEPTH); SBAR();
    pv_d0(o, vb0, pa0, pa1, pa2, pa3); partialSM(pB0, pB1, m_reg, mnB, alB);
    __syncthreads(); SWAIT(); SWRITE(0, SE);
    RESC(alB); __syncthreads();
    SBAR(); qkt(pA0, pA1, K_lds, P_lds, qr, Q_lds, qrow, r32, hi);
    finishSM(pB0, pB1, alB, l_reg, pa0, pa1, pa2, pa3); SBAR();
    if (SDEPTH == 1 || j + 3 < NT) SLOAD(SE, j + 1 + SDEPTH); SBAR();
    pv_d0(o, vb0 + (int)SHM_V, pa0, pa1, pa2, pa3); partialSM(pA0, pA1, m_reg, mnA, alA);
    __syncthreads(); SWAIT(); SWRITE(1, SO);
    RESC(alA); __syncthreads();
  }
  SBAR(); qkt(pB0, pB1, K_lds + SHM_K, P_lds + SHM_KP, qr, Q_lds, qrow, r32, hi);
  finishSM(pA0, pA1, alA, l_reg, pa0, pa1, pa2, pa3); SBAR();
  pv_d0(o, vb0, pa0, pa1, pa2, pa3); partialSM(pB0, pB1, m_reg, mnB, alB);
  __syncthreads(); RESC(alB);
  finishSM(pB0, pB1, alB, l_reg, pa0, pa1, pa2, pa3); SBAR();
  pv_d0(o, vb0 + (int)SHM_V, pa0, pa1, pa2, pa3);
  if (hi == 0) li_l[r32] = l_reg; asm volatile("s_waitcnt lgkmcnt(0)" ::: "memory");
  float rli[16];
#pragma unroll
  for (int r = 0; r < 16; ++r) rli[r] = __builtin_amdgcn_rcpf(li_l[crow(r, hi)]);
  bf16_t* Ow = Ob + (long)(wid * QBLK) * LDO;
#pragma unroll
  for (int r = 0; r < 16; ++r) { int orow = crow(r, hi);
    for (int d0 = 0; d0 < 4; ++d0) Ow[(long)orow * LDO + d0 * 32 + r32] = (bf16_t)f2bf(o[d0][r] * rli[r]); }
  __syncthreads();
#undef KROW
#undef SLOAD
#undef SWRITE
#undef SWAIT
#undef RESC
}
}

__device__ __forceinline__ void phase_attn(Frame& F, bool lat_only) {
    const bf16_t* Q = WSP(bf16_t, WS_Q); const bf16_t* KV = WSP(bf16_t, WS_KV); const bf16_t* KPE = WSP(bf16_t, WS_KPE); bf16_t* YA = WSP(bf16_t, WS_Y);
    const int NU = NBATCH * NH_MLA * 32 + (lat_only ? 0 : NBATCH * NH_MLA);
    for (int u = F.bid; u < NU; u += F.G) {
        int b, h, row0, NT, tpos0;
        if (u < NBATCH * NH_MLA * 32) { const int bh = u >> 5, qb = u & 31; b = bh >> 3; h = bh & 7; row0 = TC + b * SEQ + qb * 256; NT = 4 + SEQ / 64; tpos0 = qb * 256; }
        else { const int bh = u - NBATCH * NH_MLA * 32; b = bh >> 3; h = bh & 7; row0 = b * CTX; NT = 4; tpos0 = -1; }
        att::attn_unit(Q + (size_t)row0 * 1536 + h * 192, KV + h * 256, KPE, YA + (size_t)row0 * 1024 + h * 128, b * CTX, TC + b * SEQ, NT, (char*)F.lds, F.tid, tpos0);
    }
}
__device__ __forceinline__ void phase_qrope(Frame& F) {
    bf16_t* Q = WSP(bf16_t, WS_Q);
    for (int row = TC + F.gw; row < T; row += F.NGW) {
        const int t = (row - TC) & (SEQ - 1); const int p = F.lane & 31, axis = p >> 4, j = p & 15, hs = F.lane >> 5;
        const float pos = (float)(axis == 0 ? (t >> 6) : (t & 63)); const float inv = __builtin_amdgcn_exp2f(-(float)j * 0.8304820237218406f);
        const float sn = __sinf(pos * inv), cs = __cosf(pos * inv);
#pragma unroll
        for (int hh = 0; hh < 4; ++hh) { const int h = hh * 2 + hs; bf16_t* q = Q + (size_t)row * 1536 + h * 192 + 128 + axis * 32 + j;
            const float x1 = bf2f(q[0]), x2 = bf2f(q[16]);
            q[0] = (bf16_t)f2bf(x1 * cs - x2 * sn); q[16] = (bf16_t)f2bf(x2 * cs + x1 * sn); }
    }
}

#define MFMA16(a, b, c) __builtin_amdgcn_mfma_f32_16x16x32_bf16((a), (b), (c), 0, 0, 0)
constexpr int XS_LD = 264, BC_LD = 136;
__device__ __forceinline__ float bperm(float v, int srclane) { return __builtin_bit_cast(float, __builtin_amdgcn_ds_bpermute(srclane << 2, __builtin_bit_cast(int, v))); }
__device__ __forceinline__ float wave_incl_scan(float v, int lane) {
#pragma unroll
    for (int o = 1; o < 64; o <<= 1) { const float t = bperm(v, lane - o); if (lane >= o) v += t; }
    return v;
}
template <int NCOLS>
__device__ __forceinline__ void stage_tile(LAS bf16_t* dst, int ld, const bf16_t* src, int tid) {
    constexpr int cpr = NCOLS >> 3, NIT = 128 * cpr / NTHREADS;
    u32x4 v[NIT];
#pragma unroll
    for (int k = 0; k < NIT; ++k) { const int i = tid + k * NTHREADS; const int r = i / cpr, c8 = (i % cpr) * 8; v[k] = *(const u32x4*)(src + (size_t)r * P2W + c8); }
#pragma unroll
    for (int k = 0; k < NIT; ++k) { const int i = tid + k * NTHREADS; const int r = i / cpr, c8 = (i % cpr) * 8; *(LAS u32x4*)(dst + r * ld + c8) = v[k]; }
}
__device__ __forceinline__ void phase_mamba_states(Frame& F, const Args& a, int layer) {
    const bf16_t* P2 = WSP(bf16_t, WS_P2); const float* DT = WSP(float, WS_DT); bf16_t* MST = WSP(bf16_t, WS_MST); float* MCS = WSP(float, WS_MCS);
    LAS bf16_t* XSl = (LAS bf16_t*)F.lds; LAS bf16_t* Bl = (LAS bf16_t*)(F.lds + 67584); LAS float* wt = (LAS float*)(F.lds + 102400) + F.wave * 128;
    const int lane = F.lane, row = lane & 15, quad = lane >> 4;
    for (int u = F.bid; u < NCHUNK * 4; u += F.G) {
        const int chunk = u >> 2, g = (u >> 1) & 1, half = u & 1, row0 = chunk * 128;
        __syncthreads();
        stage_tile<256>(XSl, XS_LD, P2 + (size_t)row0 * P2W + P2_XBC + (g * 8 + half * 4) * 64, F.tid);
        stage_tile<128>(Bl, BC_LD, P2 + (size_t)row0 * P2W + P2_XBC + 1024 + g * 128, F.tid);
        const int hl = F.wave >> 1, d = F.wave & 1, h = g * 8 + half * 4 + hl;
        const float aa = -__expf(arg_in(a, I_SALOG)[(layer * 2 + d) * 16 + h]);
        { const float dt0 = DT[(size_t)(row0 + lane) * 32 + d * 16 + h], dt1 = DT[(size_t)(row0 + 64 + lane) * 32 + d * 16 + h];
          const float da0 = dt0 * aa, da1 = dt1 * aa;
          float c0 = wave_incl_scan(da0, lane); const float tot0 = bperm(c0, 63); float c1 = wave_incl_scan(da1, lane) + tot0; const float tot = bperm(c1, 63);
          if (d == 0) { wt[lane] = dt0 * __expf(tot - c0); wt[64 + lane] = dt1 * __expf(tot - c1); }
          else { wt[lane] = dt0 * __expf(c0 - da0); wt[64 + lane] = dt1 * __expf(c1 - da1); }
          if (lane == 0) MCS[(d * NCHUNK + chunk) * 16 + h] = tot; }
        __syncthreads();
        bf16_t* out = MST + ((size_t)(d * NCHUNK + chunk) * 16 + h) * 8192;
#pragma unroll 1
        for (int nh = 0; nh < 2; ++nh) {
            f32x4 acc[4][4];
#pragma unroll
            for (int i = 0; i < 4; ++i)
#pragma unroll
                for (int j = 0; j < 4; ++j) acc[i][j] = (f32x4){0.f, 0.f, 0.f, 0.f};
#pragma unroll 1
            for (int k0 = 0; k0 < 128; k0 += 32) {
                const int sb = k0 + quad * 8;
                float w8[8];
#pragma unroll
                for (int j = 0; j < 8; ++j) w8[j] = wt[sb + j];
                bf16x8 bf[4];
#pragma unroll
                for (int nt = 0; nt < 4; ++nt) {
#pragma unroll
                    for (int j = 0; j < 8; ++j) bf[nt][j] = (short)Bl[(sb + j) * BC_LD + (nh * 4 + nt) * 16 + row]; }
#pragma unroll
                for (int pt = 0; pt < 4; ++pt) { bf16x8 af;
#pragma unroll
                    for (int j = 0; j < 8; ++j) af[j] = (short)f2bf(w8[j] * bf2f(XSl[(sb + j) * XS_LD + hl * 64 + pt * 16 + row]));
#pragma unroll
                    for (int nt = 0; nt < 4; ++nt) acc[pt][nt] = MFMA16(af, bf[nt], acc[pt][nt]); }
            }
#pragma unroll
            for (int pt = 0; pt < 4; ++pt)
#pragma unroll
                for (int nt = 0; nt < 4; ++nt)
#pragma unroll
                    for (int jj = 0; jj < 4; ++jj) out[(pt * 16 + quad * 4 + jj) * 128 + (nh * 4 + nt) * 16 + row] = (bf16_t)f2bf(acc[pt][nt][jj]);
        }
    }
}
__device__ __forceinline__ void phase_mamba_scan(Frame& F) {
    bf16_t* MST = WSP(bf16_t, WS_MST); const float* MCS = WSP(float, WS_MCS);
    for (int idx = F.bid * NTHREADS + F.tid; idx < 2 * 2 * 16 * 8192; idx += F.G * NTHREADS) {
        const int e = idx & 8191, h = (idx >> 13) & 15, b = (idx >> 17) & 1, d = idx >> 18;
        float state = 0.f;
#pragma unroll 6
        for (int i = 0; i < 66; ++i) {
            int chunk; if (i < 2) chunk = 2 * b + (d == 0 ? i : 1 - i); else chunk = 4 + 64 * b + (d == 0 ? i - 2 : 65 - i);
            bf16_t* p = MST + ((size_t)(d * NCHUNK + chunk) * 16 + h) * 8192 + e;
            const float cs = bf2f(*p); const float dec = __expf(MCS[(d * NCHUNK + chunk) * 16 + h]);
            *p = (bf16_t)f2bf(state);
            state = state * dec + cs;
        }
    }
}
__device__ __forceinline__ void phase_mamba_out(Frame& F, const Args& a, int layer) {
    const bf16_t* P = WSP(bf16_t, WS_P); const bf16_t* P2 = WSP(bf16_t, WS_P2); const float* DT = WSP(float, WS_DT); const bf16_t* MST = WSP(bf16_t, WS_MST);
    bf16_t* YB = WSP(bf16_t, WS_Y) + (size_t)1 * T * 1024;
    LAS bf16_t* Cl = (LAS bf16_t*)F.lds; LAS bf16_t* Bl = (LAS bf16_t*)(F.lds + 34816); LAS bf16_t* XSl = (LAS bf16_t*)(F.lds + 69632);
    LAS float* tab = (LAS float*)(F.lds + 137216);
    for (int u = F.bid; u < NCHUNK * 4; u += F.G) {
        const int chunk = u >> 2, g = (u >> 1) & 1, half = u & 1, row0 = chunk * 128;
        __syncthreads();
        { const int tid_ = F.wave * 64 + (lane_asm() & 63);
          stage_tile<256>(XSl, XS_LD, P2 + (size_t)row0 * P2W + P2_XBC + (g * 8 + half * 4) * 64, tid_);
          stage_tile<128>(Bl, BC_LD, P2 + (size_t)row0 * P2W + P2_XBC + 1024 + g * 128, tid_);
          stage_tile<128>(Cl, BC_LD, P2 + (size_t)row0 * P2W + P2_XBC + 1280 + g * 128, tid_); }
        const int lane = lane_asm() & 63, row = lane & 15, quad = lane >> 4;
        float tot1 = 0.f;
        { const int hl = F.wave >> 1, d = F.wave & 1, h = g * 8 + half * 4 + hl;
          const float aa = -__expf(arg_in(a, I_SALOG)[(layer * 2 + d) * 16 + h]);
          const float dt0 = DT[(size_t)(row0 + lane) * 32 + d * 16 + h], dt1 = DT[(size_t)(row0 + 64 + lane) * 32 + d * 16 + h];
          const float da0 = dt0 * aa, da1 = dt1 * aa;
          float c0 = wave_incl_scan(da0, lane); const float t0 = bperm(c0, 63); float c1 = wave_incl_scan(da1, lane) + t0;
          LAS float* tb = tab + hl * 512;
          if (d == 0) { tb[lane] = c0; tb[64 + lane] = c1; tb[256 + lane] = __logf(dt0) - c0; tb[320 + lane] = __logf(dt1) - c1; }
          else { tb[128 + lane] = c0 - da0; tb[192 + lane] = c1 - da1; tb[384 + lane] = (c0 - da0) + __logf(dt0); tb[448 + lane] = (c1 - da1) + __logf(dt1); if (lane == 63) tab[2048 + hl] = c1; } }
        __syncthreads();
        { f32x4 cb[8];
#pragma unroll
          for (int st = 0; st < 8; ++st) cb[st] = (f32x4){0.f, 0.f, 0.f, 0.f};
#pragma unroll
          for (int k0 = 0; k0 < 128; k0 += 32) { const bf16x8 af = *(const LAS bf16x8*)(Cl + (F.wave * 16 + row) * BC_LD + k0 + quad * 8);
#pragma unroll
              for (int st = 0; st < 8; ++st) { const bf16x8 bfr = *(const LAS bf16x8*)(Bl + (st * 16 + row) * BC_LD + k0 + quad * 8); cb[st] = MFMA16(af, bfr, cb[st]); } }
          __syncthreads();
#pragma unroll
          for (int st = 0; st < 8; ++st)
#pragma unroll
              for (int jj = 0; jj < 4; ++jj) Bl[(F.wave * 16 + quad * 4 + jj) * BC_LD + st * 16 + row] = (bf16_t)f2bf(cb[st][jj]); }
        __syncthreads();
        const int hl = F.wave >> 1, th = F.wave & 1, h = g * 8 + half * 4 + hl;
        const LAS float* tb = tab + hl * 512; tot1 = tab[2048 + hl];
        f32x4 acc[4][4];
#pragma unroll
        for (int i = 0; i < 4; ++i)
#pragma unroll
            for (int j = 0; j < 4; ++j) acc[i][j] = (f32x4){0.f, 0.f, 0.f, 0.f};
#pragma unroll 1
        for (int k0 = 0; k0 < 128; k0 += 32) {
            const int sb = k0 + quad * 8;
            float u0s[8], u1s[8];
#pragma unroll
            for (int j = 0; j < 8; ++j) { u0s[j] = tb[256 + sb + j]; u1s[j] = tb[384 + sb + j]; }
            bf16x8 bx[4];
#pragma unroll
            for (int pt = 0; pt < 4; ++pt) {
#pragma unroll
                for (int j = 0; j < 8; ++j) bx[pt][j] = (short)XSl[(sb + j) * XS_LD + hl * 64 + pt * 16 + row]; }
#pragma unroll
            for (int tt = 0; tt < 4; ++tt) { const int t = th * 64 + tt * 16 + row; const float c0t = tb[t], e1t = tb[128 + t];
                float cbv[8]; { const u32x4 w = *(const LAS u32x4*)(Bl + t * BC_LD + sb); cbv[0] = bflo(w.x); cbv[1] = bfhi(w.x); cbv[2] = bflo(w.y); cbv[3] = bfhi(w.y); cbv[4] = bflo(w.z); cbv[5] = bfhi(w.z); cbv[6] = bflo(w.w); cbv[7] = bfhi(w.w); }
                bf16x8 af;
#pragma unroll
                for (int j = 0; j < 8; ++j) { const int s = sb + j;
                    const float f0 = s <= t ? __expf(c0t + u0s[j]) : 0.f;
                    const float f1 = s >= t ? __expf(u1s[j] - e1t) : 0.f;
                    af[j] = (short)f2bf(cbv[j] * (f0 + f1)); }
#pragma unroll
                for (int pt = 0; pt < 4; ++pt) acc[tt][pt] = MFMA16(af, bx[pt], acc[tt][pt]); }
        }
#pragma unroll 1
        for (int d = 0; d < 2; ++d) {
            const bf16_t* S = MST + ((size_t)(d * NCHUNK + chunk) * 16 + h) * 8192;
#pragma unroll 1
            for (int k0 = 0; k0 < 128; k0 += 32) {
                bf16x8 bs[4];
#pragma unroll
                for (int pt = 0; pt < 4; ++pt) bs[pt] = *(const bf16x8*)(S + (pt * 16 + row) * 128 + k0 + quad * 8);
#pragma unroll
                for (int tt = 0; tt < 4; ++tt) { const int t = th * 64 + tt * 16 + row;
                    const float sc = d == 0 ? __expf(tb[t]) : __expf(tot1 - tb[128 + t]);
                    const u32x4 cw = *(const LAS u32x4*)(Cl + t * BC_LD + k0 + quad * 8);
                    u32x4 aw; aw.x = cvt_pk_bf16(bflo(cw.x) * sc, bfhi(cw.x) * sc); aw.y = cvt_pk_bf16(bflo(cw.y) * sc, bfhi(cw.y) * sc);
                    aw.z = cvt_pk_bf16(bflo(cw.z) * sc, bfhi(cw.z) * sc); aw.w = cvt_pk_bf16(bflo(cw.w) * sc, bfhi(cw.w) * sc);
                    const bf16x8 af = __builtin_bit_cast(bf16x8, aw);
#pragma unroll
                    for (int pt = 0; pt < 4; ++pt) acc[tt][pt] = MFMA16(af, bs[pt], acc[tt][pt]); } }
        }
        const float Dh = arg_in(a, I_SD)[layer * 16 + h];
#pragma unroll
        for (int tt = 0; tt < 4; ++tt)
#pragma unroll
            for (int jj = 0; jj < 4; ++jj) { const int t = th * 64 + tt * 16 + quad * 4 + jj; const size_t r = (size_t)(row0 + t);
#pragma unroll
                for (int pt = 0; pt < 4; ++pt) { const int p = pt * 16 + row;
                    const float xs = bf2f(XSl[t * XS_LD + hl * 64 + p]); const float z = bf2f(P[r * NNG + P_Z + h * 64 + p]);
                    YB[r * 1024 + h * 64 + p] = (bf16_t)f2bf((acc[tt][pt][jj] + xs * Dh) * siluf_(z)); } }
    }
}
__device__ __forceinline__ void phase_mamba_norm(Frame& F, const Args& a, int layer) {
    bf16_t* YB = WSP(bf16_t, WS_Y) + (size_t)1 * T * 1024; const float* nw = arg_in(a, I_SNORM) + layer * 1024;
    for (int row = F.gw; row < T; row += F.NGW) {
        bf16_t* p = YB + (size_t)row * 1024 + F.lane * 16; float x[16]; { float t0[8], t1[8]; ld8bf(p, t0); ld8bf(p + 8, t1);
#pragma unroll
            for (int i = 0; i < 8; ++i) { x[i] = t0[i]; x[8 + i] = t1[i]; } }
        float s = 0.f;
#pragma unroll
        for (int i = 0; i < 16; ++i) s += x[i] * x[i];
        s = sum32(s);
        const float r = 1.f / sqrtf(s * (1.f / 512.f) + 1e-5f);
        float o0[8], o1[8];
#pragma unroll
        for (int i = 0; i < 8; ++i) { o0[i] = x[i] * r * nw[F.lane * 16 + i]; o1[i] = x[8 + i] * r * nw[F.lane * 16 + 8 + i]; }
        st8bf(p, o0); st8bf(p + 8, o1);
    }
}

__device__ __forceinline__ float dpp_f(float x, const int ctrl_sel) {
    const int xi = __builtin_bit_cast(int, x); int r;
    if (ctrl_sel == 0) r = __builtin_amdgcn_update_dpp(0, xi, 0xB1, 0xF, 0xF, false);
    else if (ctrl_sel == 1) r = __builtin_amdgcn_update_dpp(0, xi, 0x4E, 0xF, 0xF, false);
    else r = __builtin_amdgcn_update_dpp(0, xi, 0x141, 0xF, 0xF, false);
    return __builtin_bit_cast(float, r);
}
__device__ __forceinline__ float red8(float x) { x += dpp_f(x, 0); x += dpp_f(x, 1); x += dpp_f(x, 2); return x; }
__device__ __forceinline__ int rw_row(int pos, int b, int d) { return pos < CTX ? b * CTX + (d == 0 ? pos : CTX - 1 - pos) : TC + b * SEQ + (d == 0 ? pos - CTX : SEQ - 1 - (pos - CTX)); }
constexpr int RW_STEP_F = 336, RW_CH = 32, RW_CHF = RW_STEP_F * RW_CH;
struct RwOps { f32x4 w, k, b, a, r; float v; };
__device__ __forceinline__ void rw_load(RwOps& o, const LAS float* sp, const LAS float* vp) {
    o.w = *(const LAS f32x4*)(sp); o.k = *(const LAS f32x4*)(sp + 64); o.b = *(const LAS f32x4*)(sp + 128); o.a = *(const LAS f32x4*)(sp + 192); o.r = *(const LAS f32x4*)(sp + 256); o.v = *vp;
}
__device__ __forceinline__ void rw_step(f32x4& s, const RwOps& o, LAS float* yp) {
    const f32x4 tt = s * o.w + o.k * o.v;
    const f32x4 pa = s * o.a; float sa = (pa.x + pa.y) + (pa.z + pa.w); sa = sum16(sa);
    s = tt + o.b * sa;
    const f32x4 pr = s * o.r; *yp = (pr.x + pr.y) + (pr.z + pr.w);
}
struct RwRaw { unsigned ew[4], ic[4], kk[4], rr[4], kr[4], vv[4]; };
__device__ __forceinline__ void phase_rwkv_scan(Frame& F, const Args& a, int layer) {
    const bf16_t* P2 = WSP(bf16_t, WS_P2); const bf16_t* EW = WSP(bf16_t, WS_EW); const bf16_t* ICLR = WSP(bf16_t, WS_ICLR); const bf16_t* KK = WSP(bf16_t, WS_KK);
    bf16_t* YRW = WSP(bf16_t, WS_YRW);
    LAS float* ring = (LAS float*)F.lds; LAS float* ybuf = (LAS float*)(F.lds + 2 * RW_CHF * 4);
    const int lane = F.lane;
    for (int u = F.bid; u < 256; u += F.G) {
        const int chain = u >> 2, rq = u & 3, d = chain >> 5, b = (chain >> 4) & 1, h = chain & 15;
        constexpr int NCH = (CTX + SEQ) / RW_CH;
        const int lw = F.wave - 4;
        const int tsel = lane >> 5, kp = lane & 31;
        const f32x2 ka2 = *(const f32x2*)(arg_in(a, I_RKA) + layer * 1024 + h * 64 + 2 * kp);
        auto issue = [&](RwRaw& x, int cidx) {
            const int row0 = rw_row(cidx * RW_CH, b, d), st = d == 0 ? 1 : -1;
            const int tk0 = 2 * lw + tsel;
            const unsigned* ewp = (const unsigned*)(EW + (size_t)d * T * 1024); const unsigned* icp = (const unsigned*)(ICLR + (size_t)d * T * 1024);
            const unsigned* kkp = (const unsigned*)KK; const unsigned* p2p = (const unsigned*)P2;
#pragma unroll
            for (int j = 0; j < 4; ++j) { const int row = row0 + st * (8 * j + tk0); const int o = (row * 1024 + h * 64) / 2 + kp, q = (row * P2W + P2_RKV + h * 64) / 2 + kp;
                x.ew[j] = ewp[o]; x.ic[j] = icp[o]; x.kk[j] = kkp[o]; x.rr[j] = p2p[q]; x.kr[j] = p2p[q + 512]; x.vv[j] = p2p[q + 1024 + rq * 8 - kp + (kp & 7)]; } };
        auto commit = [&](const RwRaw& x, int cidx) {
            LAS float* dst = ring + (cidx & 1) * RW_CHF;
#pragma unroll
            for (int j = 0; j < 4; ++j) { LAS float* sbase = dst + (8 * j + 2 * lw + tsel) * RW_STEP_F; LAS f32x2* s2 = (LAS f32x2*)sbase + kp;
                const f32x2 ew = {bflo(x.ew[j]), bfhi(x.ew[j])}, ic = {bflo(x.ic[j]), bfhi(x.ic[j])}, kkv = {bflo(x.kk[j]), bfhi(x.kk[j])}, rr = {bflo(x.rr[j]), bfhi(x.rr[j])}, kr = {bflo(x.kr[j]), bfhi(x.kr[j])};
                s2[0] = (f32x2){__expf(-ew.x), __expf(-ew.y)}; s2[32] = kr * ((ic - 1.f) * ka2 + 1.f); s2[64] = kkv * ic; s2[96] = -kkv; s2[128] = rr;
                if (kp < 8) s2[160] = (f32x2){bflo(x.vv[j]), bfhi(x.vv[j])}; } };
        auto flush_chunk = [&](int cidx) {
            const LAS float* yb = ybuf + (cidx & 1) * (RW_CH * 256);
            const int row0 = rw_row(cidx * RW_CH, b, d), st = d == 0 ? 1 : -1;
#pragma unroll
            for (int q = 0; q < 2; ++q) { const int i = (F.tid - 256) + 256 * q, tok = i >> 4, rr = i & 15; const LAS f32x4* pp = (const LAS f32x4*)(yb + i * 16);
                const f32x4 p0 = pp[0], p1 = pp[1], p2 = pp[2], p3 = pp[3];
                const float y = ((p0.x + p0.y) + (p0.z + p0.w)) + ((p1.x + p1.y) + (p1.z + p1.w)) + (((p2.x + p2.y) + (p2.z + p2.w)) + ((p3.x + p3.y) + (p3.z + p3.w)));
                YRW[((size_t)d * T + row0 + st * tok) * 1024 + h * 64 + rq * 16 + rr] = (bf16_t)f2bf(y); } };
        auto compute = [&](f32x4& s, int c) {
            const int rloc = lane >> 4, kq = lane & 15, r16 = F.wave * 4 + rloc;
            const LAS float* base = ring + (c & 1) * RW_CHF + kq * 4; const LAS float* vb = ring + (c & 1) * RW_CHF + 320 + r16; LAS float* yb = ybuf + (c & 1) * (RW_CH * 256) + r16 * 16 + kq;
            RwOps o0, o1, o2, o3;
            rw_load(o0, base, vb); rw_load(o1, base + RW_STEP_F, vb + RW_STEP_F); rw_load(o2, base + 2 * RW_STEP_F, vb + 2 * RW_STEP_F);
#pragma unroll
            for (int t = 0; t < RW_CH; t += 4) {
                if (t + 3 < RW_CH) rw_load(o3, base + (t + 3) * RW_STEP_F, vb + (t + 3) * RW_STEP_F);
                rw_step(s, o0, yb + t * 256);
                if (t + 4 < RW_CH) rw_load(o0, base + (t + 4) * RW_STEP_F, vb + (t + 4) * RW_STEP_F);
                rw_step(s, o1, yb + (t + 1) * 256);
                if (t + 5 < RW_CH) rw_load(o1, base + (t + 5) * RW_STEP_F, vb + (t + 5) * RW_STEP_F);
                rw_step(s, o2, yb + (t + 2) * 256);
                if (t + 6 < RW_CH) rw_load(o2, base + (t + 6) * RW_STEP_F, vb + (t + 6) * RW_STEP_F);
                rw_step(s, o3, yb + (t + 3) * 256);
            } };
        __syncthreads();
        f32x4 s = {0.f, 0.f, 0.f, 0.f};
        if (F.wave >= 4) {
            RwRaw ra, rb;
            issue(ra, 0); commit(ra, 0); issue(ra, 1);
            __syncthreads();
            for (int c = 0; c < NCH; c += 2) {
                if (c + 2 < NCH) issue(rb, c + 2);
                if (c > 0) flush_chunk(c - 1);
                commit(ra, c + 1);
                __syncthreads();
                if (c + 3 < NCH) issue(ra, c + 3);
                flush_chunk(c);
                if (c + 2 < NCH) commit(rb, c + 2);
                __syncthreads();
            }
            flush_chunk(NCH - 1);
        } else {
            __syncthreads();
            for (int c = 0; c < NCH; c += 2) { compute(s, c); __syncthreads(); compute(s, c + 1); __syncthreads(); }
        }
    }
}
__device__ __forceinline__ void phase_rwkv_out(Frame& F, const Args& a, int layer) {
    const bf16_t* P2 = WSP(bf16_t, WS_P2); const bf16_t* ICLR = WSP(bf16_t, WS_ICLR); const bf16_t* YRW = WSP(bf16_t, WS_YRW); const bf16_t* GG = WSP(bf16_t, WS_GG);
    bf16_t* YD = WSP(bf16_t, WS_Y) + (size_t)3 * T * 1024;
    const float* lng = arg_in(a, I_RLNG) + layer * 1024; const float* lnb = arg_in(a, I_RLNB) + layer * 1024; const float* rk = arg_in(a, I_RRK) + layer * 1024; const float* kav = arg_in(a, I_RKA) + layer * 1024;
    for (int row = F.gw; row < T; row += F.NGW) {
        const int c = F.lane * 16; const size_t o = (size_t)row * 1024 + c;
        float y[16], r[16], k[16], v[16], i0[16], i1[16], g[16];
#define LD16(dst, ptr) do { float t0_[8], t1_[8]; ld8bf((ptr), t0_); ld8bf((ptr) + 8, t1_); _Pragma("unroll") for (int i_ = 0; i_ < 8; ++i_) { dst[i_] = t0_[i_]; dst[8 + i_] = t1_[i_]; } } while (0)
        LD16(y, YRW + o); LD16(r, YRW + (size_t)T * 1024 + o);
#pragma unroll
        for (int i = 0; i < 16; ++i) y[i] += r[i];
        const bf16_t* p2 = P2 + (size_t)row * P2W + P2_RKV + c;
        LD16(r, p2); LD16(k, p2 + 1024); LD16(v, p2 + 2048); LD16(i0, ICLR + o); LD16(i1, ICLR + (size_t)T * 1024 + o); LD16(g, GG + o);
#undef LD16
        float s = 0.f, bsum = 0.f;
#pragma unroll
        for (int i = 0; i < 16; ++i) { s += y[i]; const float ka = kav[c + i]; bsum += r[i] * k[i] * rk[c + i] * ((1.f + (i0[i] - 1.f) * ka) + (1.f + (i1[i] - 1.f) * ka)); }
        s = sum4(s); bsum = sum4(bsum);
        const float mu = s * (1.f / 64.f); float q = 0.f;
#pragma unroll
        for (int i = 0; i < 16; ++i) { const float dd = y[i] - mu; q += dd * dd; }
        q = sum4(q);
        const float rstd = 1.f / sqrtf(q * (1.f / 64.f) + 64e-5f);
        float o0[8], o1[8];
#pragma unroll
        for (int i = 0; i < 8; ++i) { o0[i] = ((y[i] - mu) * rstd * lng[c + i] + lnb[c + i] + bsum * v[i]) * g[i];
            o1[i] = ((y[8 + i] - mu) * rstd * lng[c + 8 + i] + lnb[c + 8 + i] + bsum * v[8 + i]) * g[8 + i]; }
        st8bf(YD + o, o0); st8bf(YD + o + 8, o1);
    }
}

constexpr int FFT_N = 16384;
__device__ __forceinline__ int fswz(int i) { return i ^ (((i >> 5) & 3) << 2) ^ (((i >> 6) & 1) << 4); }
__device__ __forceinline__ f32x2 cmul(f32x2 a, f32x2 b) { return (f32x2){a.x * b.x - a.y * b.y, a.x * b.y + a.y * b.x}; }
template <bool INV>
__device__ __forceinline__ void fft_passes(LAS f32x2* X, int tid) {
#pragma unroll 1
    for (int st = 0; st < 7; ++st) {
        const int lq = INV ? 2 * st : 12 - 2 * st;
        const int q = 1 << lq;
        __syncthreads();
#pragma unroll 2
        for (int mm = 0; mm < 8; ++mm) { const int uu = tid + 512 * mm; const int k = uu & (q - 1), blk = uu >> lq; const int i0 = (blk << (lq + 2)) + k;
            const int p0 = fswz(i0), p1 = fswz(i0 + q), p2 = fswz(i0 + 2 * q), p3 = fswz(i0 + 3 * q);
            f32x2 a0 = X[p0], a1 = X[p1], a2 = X[p2], a3 = X[p3];
            const float fr = (float)k / (float)(4 * q);
            const float cs = __builtin_amdgcn_cosf(fr), sn = __builtin_amdgcn_sinf(fr);
            const f32x2 w1 = INV ? (f32x2){cs, sn} : (f32x2){cs, -sn}; const f32x2 w2 = cmul(w1, w1), w3 = cmul(w2, w1);
            if (!INV) {
                const f32x2 t0 = a0 + a2, t1 = a0 - a2, t2 = a1 + a3, t3 = a1 - a3;
                const f32x2 b0 = t0 + t2, b2 = t0 - t2, b1 = (f32x2){t1.x + t3.y, t1.y - t3.x}, b3 = (f32x2){t1.x - t3.y, t1.y + t3.x};
                X[p0] = b0; X[p1] = cmul(b1, w1); X[p2] = cmul(b2, w2); X[p3] = cmul(b3, w3);
            } else {
                a1 = cmul(a1, w1); a2 = cmul(a2, w2); a3 = cmul(a3, w3);
                const f32x2 u0 = a0 + a2, u1 = a0 - a2, u2 = a1 + a3, u3 = a1 - a3;
                X[p0] = u0 + u2; X[p2] = u0 - u2; X[p1] = (f32x2){u1.x - u3.y, u1.y + u3.x}; X[p3] = (f32x2){u1.x + u3.y, u1.y - u3.x};
            } }
    }
    __syncthreads();
}
__device__ __forceinline__ void phase_hyena_fft(Frame& F, const Args& a, int layer, bool dry = false) {
    const bf16_t* FILT = WSP(bf16_t, WS_FILT); float* VT = WSP(float, WS_VT); const float* hyd = arg_in(a, I_HD) + layer * 1024;
    LAS f32x2* X = (LAS f32x2*)F.lds;
    for (int c = F.bid; c < 1024; c += F.G) {
        __syncthreads();
        const int tid = F.wave * 64 + (lane_asm() & 63), i0 = tid * 16;
        { const bf16_t* hf = FILT + (size_t)c * 2 * SEQ; const bf16_t* hb = hf + SEQ;
          float f[16], g[16]; ld8bf(hf + i0, *(float(*)[8])&f[0]); ld8bf(hf + i0 + 8, *(float(*)[8])&f[8]);
          ld8bf(hb + (SEQ - 16 - i0), *(float(*)[8])&g[0]); ld8bf(hb + (SEQ - 8 - i0), *(float(*)[8])&g[8]);
#pragma unroll
          for (int j = 0; j < 16; ++j) X[fswz(i0 + j)] = (f32x2){f[j], 0.f};
#pragma unroll
          for (int j = 0; j < 16; ++j) { const int pos = SEQ + i0 + 1 + j; if (pos < FFT_N) X[fswz(pos)] = (f32x2){g[15 - j], 0.f}; }
          if (tid == 0) { float zz = 0.f; asm volatile("" : "+v"(zz)); X[fswz(SEQ)] = (f32x2){zz, zz}; } }
        fft_passes<false>(X, F.tid);
        f32x2 Kh[32];
#pragma unroll
        for (int j = 0; j < 32; ++j) Kh[j] = X[fswz(F.tid + 512 * j)];
        __syncthreads();
        float* v0 = VT + (size_t)c * 2 * SEQ; float* v1 = v0 + SEQ;
        { f32x4 a0[4], a1[4];
#pragma unroll
          for (int q = 0; q < 4; ++q) { a0[q] = *(const f32x4*)(v0 + i0 + 4 * q); a1[q] = *(const f32x4*)(v1 + i0 + 4 * q); }
#pragma unroll
          for (int q = 0; q < 4; ++q) { X[fswz(i0 + 4 * q)] = (f32x2){a0[q].x, a1[q].x}; X[fswz(i0 + 4 * q + 1)] = (f32x2){a0[q].y, a1[q].y}; X[fswz(i0 + 4 * q + 2)] = (f32x2){a0[q].z, a1[q].z}; X[fswz(i0 + 4 * q + 3)] = (f32x2){a0[q].w, a1[q].w}; }
          { float zz = 0.f; asm volatile("" : "+v"(zz));
#pragma unroll
          for (int j = 0; j < 16; ++j) X[fswz(SEQ + i0 + j)] = (f32x2){zz, zz}; } }
        fft_passes<false>(X, F.tid);
#pragma unroll
        for (int j = 0; j < 32; ++j) { const int p = fswz(F.tid + 512 * j); X[p] = cmul(X[p], Kh[j]); }
        fft_passes<true>(X, F.tid);
        const float dc = hyd[c];
        { f32x4 a0[4], a1[4];
#pragma unroll
          for (int q = 0; q < 4; ++q) { a0[q] = *(const f32x4*)(v0 + i0 + 4 * q); a1[q] = *(const f32x4*)(v1 + i0 + 4 * q); }
#pragma unroll
          for (int q = 0; q < 4; ++q) { const f32x2 r0 = X[fswz(i0 + 4 * q)], r1 = X[fswz(i0 + 4 * q + 1)], r2 = X[fswz(i0 + 4 * q + 2)], r3 = X[fswz(i0 + 4 * q + 3)];
              const f32x4 o0 = (f32x4){r0.x, r1.x, r2.x, r3.x} * (1.f / FFT_N) + a0[q] * dc, o1 = (f32x4){r0.y, r1.y, r2.y, r3.y} * (1.f / FFT_N) + a1[q] * dc;
              if (!dry) { *(f32x4*)(v0 + i0 + 4 * q) = o0; *(f32x4*)(v1 + i0 + 4 * q) = o1; } } }
    }
}
__device__ __forceinline__ void phase_hyena_out(Frame& F, const Args& a, int layer) {
    const float* VT = WSP(float, WS_VT); const bf16_t* P2 = WSP(bf16_t, WS_P2); bf16_t* YC = WSP(bf16_t, WS_Y) + (size_t)2 * T * 1024;
    LAS float* tl = (LAS float*)F.lds;
    for (int u = F.bid; u < (TL / 64) * 4; u += F.G) {
        const int tb = u >> 2, cb = u & 3; const int row0 = TC + tb * 64; const int b = (row0 - TC) >> 13, t0 = (row0 - TC) & (SEQ - 1);
        __syncthreads();
        for (int p = 0; p < 8; ++p) { const int cl = p * 32 + (F.tid >> 4), q = F.tid & 15;
            const f32x4 v = *(const f32x4*)(VT + ((size_t)(cb * 256 + cl) * 2 + b) * SEQ + t0 + 4 * q);
            tl[cl * 65 + 4 * q] = v.x; tl[cl * 65 + 4 * q + 1] = v.y; tl[cl * 65 + 4 * q + 2] = v.z; tl[cl * 65 + 4 * q + 3] = v.w; }
        __syncthreads();
        const int cl = F.tid & 255, th = F.tid >> 8;
        for (int i = 0; i < 32; ++i) { const int tl_ = th * 32 + i; const size_t row = (size_t)(row0 + tl_);
            const float x0 = bf2f(P2[row * P2W + P2_X0 + cb * 256 + cl]);
            YC[row * 1024 + cb * 256 + cl] = (bf16_t)f2bf(tl[cl * 65 + tl_] * x0); }
    }
    const float* VC = WSP(float, WS_VC); const float* FC = WSP(float, WS_FILTC); const float* hyd = arg_in(a, I_HD) + layer * 1024;
    for (int it = F.gw; it < 2 * 16 * 16; it += F.NGW) {
        const int b = it >> 8, cbk = (it >> 4) & 15, tb = it & 15; const int c = cbk * 64 + F.lane, t0 = tb * 16;
        const float* vb = VC + (size_t)b * CTX * 1024 + c; const float* fc = FC + c;
        float acc[16];
#pragma unroll
        for (int i = 0; i < 16; ++i) acc[i] = 0.f;
#pragma unroll 1
        for (int sb = 0; sb < 16; ++sb) { const int s0 = sb * 16, dl = t0 - s0;
            float f[31], v[16];
#pragma unroll
            for (int j = 0; j < 31; ++j) { const int lag = dl + j - 15; f[j] = lag >= 0 ? fc[(size_t)lag * 2048] : fc[(size_t)(-lag) * 2048 + 1024]; }
#pragma unroll
            for (int j = 0; j < 16; ++j) v[j] = vb[(size_t)(s0 + j) * 1024];
#pragma unroll
            for (int i = 0; i < 16; ++i)
#pragma unroll
                for (int j = 0; j < 16; ++j) acc[i] += f[i - j + 15] * v[j]; }
#pragma unroll
        for (int i = 0; i < 16; ++i) { const int t = t0 + i; const size_t row = (size_t)(b * CTX + t);
            const float x0 = bf2f(P2[row * P2W + P2_X0 + c]);
            YC[row * 1024 + c] = (bf16_t)f2bf((acc[i] + vb[(size_t)t * 1024] * hyd[c]) * x0); }
    }
}

__device__ __forceinline__ void phase_ln1(Frame& F, const Args& a, int layer) {
    const float* mod = (const float*)(F.ws + WS_CTL) + CW_MOD + (size_t)layer * 3 * 6 * DM;
    const float* YM = WSP(float, WS_YMIX); float* XS = WSP(float, WS_XS); unsigned* H2 = WSP(unsigned, WS_H2); float* AFF = WSP(float, WS_AFF); int* INV = WSP(int, WS_INV);
    const float* g1w = arg_in(a, I_LN1G) + layer * DM; const float* b1w = arg_in(a, I_LN1B) + layer * DM; const float* wr = arg_in(a, I_WROUTER) + (size_t)layer * DM * NEXP;
    LAS float* wrT = (LAS float*)F.lds;
    __syncthreads();
    for (int i = F.tid; i < DM * NEXP; i += NTHREADS) { const int c = i >> 4, e = i & 15; wrT[e * DM + c] = wr[i]; }
    __syncthreads();
    int* PTOK = WSP(int, WS_PTOK); float* PG = WSP(float, WS_PGATE);
    for (int i = F.bid * NTHREADS + F.tid; i < NPAIR; i += F.G * NTHREADS) { PTOK[i] = -1; PG[i] = 0.f; }
    for (int row = F.gw; row < T; row += F.NGW) {
        const f32x4* xr = (const f32x4*)x_src_row(a, F, layer, row) + F.lane; const f32x4* yr = (const f32x4*)(YM + (size_t)row * DM) + F.lane;
        const float* m = mod + (size_t)row_modidx(row) * 6 * DM;
        f32x4 v[8];
#pragma unroll
        for (int j = 0; j < 8; ++j) { const int c = 4 * (64 * j + F.lane); v[j] = xr[64 * j] * ALPHA + *(const f32x4*)(m + 2 * DM + c) * yr[64 * j]; }
        float mean, rstd; row_stats(v, mean, rstd, 1e-6f);
        f32x4* xo = (f32x4*)(XS + (size_t)row * DM) + F.lane;
#pragma unroll
        for (int j = 0; j < 8; ++j) { const int c = 4 * (64 * j + F.lane); v[j] = (v[j] - mean) * rstd * *(const f32x4*)(g1w + c) + *(const f32x4*)(b1w + c); xo[64 * j] = v[j]; }
        row_stats(v, mean, rstd, 1e-6f);
        unsigned* ho = H2 + (size_t)row * (DM / 4) + F.lane;
        float lg[16];
#pragma unroll
        for (int e = 0; e < 16; ++e) lg[e] = 0.f;
#pragma unroll
        for (int j = 0; j < 8; ++j) { const int c = 4 * (64 * j + F.lane);
            const f32x4 y = (v[j] - mean) * rstd * (*(const f32x4*)(m + 4 * DM + c) + 1.f) + *(const f32x4*)(m + 3 * DM + c);
            ho[64 * j] = pk4fp8(y.x, y.y, y.z, y.w);
#pragma unroll
            for (int e = 0; e < 16; ++e) { const f32x4 ww = *(const LAS f32x4*)(wrT + e * DM + c); lg[e] += (y.x * ww.x + y.y * ww.y) + (y.z * ww.z + y.w * ww.w); } }
        float mx = -1e30f;
#pragma unroll
        for (int e = 0; e < 16; ++e) { lg[e] = wave_sum(lg[e]); mx = fmaxf(mx, lg[e]); }
        float den = 0.f;
#pragma unroll
        for (int e = 0; e < 16; ++e) { lg[e] = __expf(lg[e] - mx); den += lg[e]; }
        float mine = 0.f;
#pragma unroll
        for (int e = 0; e < 16; ++e) mine = (F.lane == e) ? lg[e] : mine;
        if (F.lane < 16) { AFF[(size_t)row * 16 + F.lane] = mine / den; INV[(size_t)row * 16 + F.lane] = -1; }
    }
}
__device__ __forceinline__ void phase_topk(Frame& F, bool lat_only) {
    const float* AFF = WSP(float, WS_AFF); int* INV = WSP(int, WS_INV); int* PTOK = WSP(int, WS_PTOK); float* PG = WSP(float, WS_PGATE);
    LAS unsigned* vals = (LAS unsigned*)F.lds; LAS unsigned* hist = vals + 8192; LAS unsigned* ctl = hist + 256;
    for (int u = F.bid + (lat_only ? 32 : 0); u < 64; u += F.G) {
        const int s = u >> 4, e = u & 15, rs = seg_start(s), n = seg_len(s), cap = s < 2 ? CAP_C : CAP_L;
        __syncthreads();
        for (int i = F.tid; i < n; i += NTHREADS) vals[i] = __builtin_bit_cast(unsigned, AFF[(size_t)(rs + i) * 16 + e]);
        if (F.tid == 0) { ctl[0] = 0u; ctl[1] = (unsigned)cap; ctl[2] = 0u; ctl[3] = 0u; }
        unsigned mask = 0u;
        for (int shift = 24; shift >= 0; shift -= 8) {
            if (F.tid < 256) hist[F.tid] = 0u;
            __syncthreads();
            const unsigned prefix = ctl[0];
            for (int i = F.tid; i < n; i += NTHREADS) { const unsigned b = vals[i]; if ((b & mask) == prefix) __hip_atomic_fetch_add(&hist[(b >> shift) & 255u], 1u, __ATOMIC_RELAXED, __HIP_MEMORY_SCOPE_WORKGROUP); }
            __syncthreads();
            if (F.tid == 0) { unsigned rem = ctl[1], cum = 0u; int dg = 255; for (; dg > 0; --dg) { const unsigned hc = hist[dg]; if (cum + hc >= rem) break; cum += hc; }
                ctl[1] = rem - cum; ctl[0] = prefix | ((unsigned)dg << shift); }
            mask |= 255u << shift;
            __syncthreads();
        }
        const unsigned thr = ctl[0], rem = ctl[1]; const unsigned ngt = (unsigned)cap - rem;
        const int pbase = s < 2 ? NBATCH * NEXP * CAP_L + e * 256 + s * CAP_C : ((s - 2) * NEXP + e) * CAP_L;
        for (int i = F.tid; i < n; i += NTHREADS) { const unsigned b = vals[i]; int slot = -1;
            if (b > thr) slot = (int)__hip_atomic_fetch_add(&ctl[2], 1u, __ATOMIC_RELAXED, __HIP_MEMORY_SCOPE_WORKGROUP);
            else if (b == thr) { const unsigned q = __hip_atomic_fetch_add(&ctl[3], 1u, __ATOMIC_RELAXED, __HIP_MEMORY_SCOPE_WORKGROUP); if (q < rem) slot = (int)(ngt + q); }
            if (slot >= 0) { const int pair = pbase + slot, row = rs + i; PTOK[pair] = row; PG[pair] = __builtin_bit_cast(float, b); INV[(size_t)row * 16 + e] = pair; } }
    }
}
__device__ __forceinline__ void phase_gather(Frame& F) {
    const unsigned char* H2 = WSP(unsigned char, WS_H2); unsigned char* XG = WSP(unsigned char, WS_XG); unsigned char* HID = WSP(unsigned char, WS_HID); const int* PTOK = WSP(int, WS_PTOK);
    for (int p = F.gw; p < NPAIR; p += F.NGW) { const int tok = PTOK[p]; u32x4* dst = (u32x4*)(XG + (size_t)p * DM) + F.lane;
        unsigned zz = 0u; asm volatile("" : "+v"(zz));
        if (tok >= 0) { const u32x4* src = (const u32x4*)(H2 + (size_t)tok * DM) + F.lane; dst[0] = src[0]; dst[64] = src[64]; }
        else { dst[0] = (u32x4){zz, zz, zz, zz}; dst[64] = (u32x4){zz, zz, zz, zz}; }
        if (F.lane < 8) *((u32x4*)(HID + (size_t)p * EFFP + EFF) + F.lane) = (u32x4){zz, zz, zz, zz}; }
}
__device__ __forceinline__ void phase_ln2(Frame& F, const Args& a, int layer) {
    const float* mod = (const float*)(F.ws + WS_CTL) + CW_MOD + (size_t)layer * 3 * 6 * DM;
    float* XS = WSP(float, WS_XS); const bf16_t* YE = WSP(bf16_t, WS_YE); const int* INV = WSP(int, WS_INV); const float* PG = WSP(float, WS_PGATE);
    const float* g2w = arg_in(a, I_LN2G) + layer * DM; const float* b2w = arg_in(a, I_LN2B) + layer * DM;
    for (int row = F.gw; row < T; row += F.NGW) {
        f32x4* xr = (f32x4*)(XS + (size_t)row * DM) + F.lane; const float* m = mod + (size_t)row_modidx(row) * 6 * DM;
        f32x4 mo[8];
#pragma unroll
        for (int j = 0; j < 8; ++j) mo[j] = (f32x4){0.f, 0.f, 0.f, 0.f};
        const int myinv = F.lane < 16 ? INV[(size_t)row * 16 + F.lane] : -1;
        unsigned long long sel = __ballot(myinv >= 0);
        while (sel) {
            const int e0 = __builtin_ctzll(sel); sel &= sel - 1; const bool two = sel != 0; const int e1 = two ? __builtin_ctzll(sel) : e0; if (two) sel &= sel - 1;
            const int p0 = __builtin_amdgcn_readlane(myinv, e0), p1 = __builtin_amdgcn_readlane(myinv, e1);
            const u32x2* y0 = (const u32x2*)(YE + (size_t)p0 * DM) + F.lane; const u32x2* y1 = (const u32x2*)(YE + (size_t)p1 * DM) + F.lane;
            const float g0 = PG[p0], g1 = two ? PG[p1] : 0.f;
            u32x2 w0[8], w1[8];
#pragma unroll
            for (int j = 0; j < 8; ++j) { w0[j] = y0[64 * j]; w1[j] = y1[64 * j]; }
#pragma unroll
            for (int j = 0; j < 8; ++j) mo[j] += (f32x4){bflo(w0[j].x), bfhi(w0[j].x), bflo(w0[j].y), bfhi(w0[j].y)} * g0 + (f32x4){bflo(w1[j].x), bfhi(w1[j].x), bflo(w1[j].y), bfhi(w1[j].y)} * g1;
        }
        f32x4 v[8];
#pragma unroll
        for (int j = 0; j < 8; ++j) { const int c = 4 * (64 * j + F.lane); v[j] = xr[64 * j] * ALPHA + *(const f32x4*)(m + 5 * DM + c) * mo[j]; }
        float mean, rstd; row_stats(v, mean, rstd, 1e-6f);
#pragma unroll
        for (int j = 0; j < 8; ++j) { const int c = 4 * (64 * j + F.lane); v[j] = (v[j] - mean) * rstd * *(const f32x4*)(g2w + c) + *(const f32x4*)(b2w + c); xr[64 * j] = v[j]; }
        if (layer == DEPTH - 1) { if (row >= TC) { f32x4* o = (f32x4*)(a.out + (size_t)(row - TC) * DM) + F.lane;
#pragma unroll
            for (int j = 0; j < 8; ++j) o[64 * j] = v[j]; } }
        else {
            row_stats(v, mean, rstd, 1e-6f);
            const float* m1 = m + (size_t)3 * 6 * DM;
            bf16_t* H = WSP(bf16_t, WS_H); unsigned* H8 = WSP(unsigned, WS_H8);
            u32x2* o = (u32x2*)(H + (size_t)row * DM) + F.lane; unsigned* o8 = H8 + (size_t)row * (DM / 4) + F.lane;
#pragma unroll
            for (int j = 0; j < 8; ++j) { const int c = 4 * (64 * j + F.lane); const f32x4 sh = *(const f32x4*)(m1 + c), sc = *(const f32x4*)(m1 + DM + c);
                const f32x4 y = (v[j] - mean) * rstd * (sc + 1.f) + sh; u32x2 w; w.x = pk2(y.x, y.y); w.y = pk2(y.z, y.w); o[64 * j] = w; o8[64 * j] = pk4fp8(y.x, y.y, y.z, y.w); } }
    }
}

constexpr int LDS_BYTES = 153600, MISC_OFF = LDS_BYTES - 64;
constexpr int NPL = 16, NPHASE = 1 + DEPTH * NPL;

__global__ void __launch_bounds__(NTHREADS, 2) fwd_kernel(Args args) {
    extern __shared__ __attribute__((aligned(16))) unsigned char lds_raw[];
    Frame F;
    F.lds = (LAS unsigned char*)lds_raw;
    F.tid = threadIdx.x; F.lane = F.tid & 63; F.wave = __builtin_amdgcn_readfirstlane(F.tid >> 6); const int wave0 = F.wave;
    F.G = gridDim.x; F.bid = blockIdx.x; F.gw = F.bid * NWAVES + F.wave; F.NGW = F.G * NWAVES; F.ws = args.ws;
    volatile LAS unsigned* misc = (volatile LAS unsigned*)(F.lds + MISC_OFF);
    if (F.tid < 16) misc[F.tid] = 0u;
    __syncthreads();
    const int lo = args.ph_lo, hi = args.ph_hi;
    XcdBarrier bar; bar.bar = (unsigned*)(F.ws + WS_CTL) + CW_BAR; bar.x = 0; bar.st = nullptr;
    const bool multi = (hi - lo) > 1;
    if (multi) bar = xcd_barrier_post((unsigned*)(F.ws + WS_CTL) + CW_BAR, misc);
#ifndef ONLY_PHASE
#define ONLY_PHASE -1
#endif
#define PON(r) (ONLY_PHASE < 0 || ONLY_PHASE == (r))
#ifndef REP_MASK
#define REP_MASK 0
#endif
#define REP(b) ((REP_MASK >> (b)) & 1)
#define REOPQ() do { F.ws = opq(args.ws); F.lane = lane_asm() & 63; F.wave = opqs(wave0) & 7; F.tid = F.wave * 64 + F.lane; F.G = opqs(gridDim.x); F.bid = opqs(blockIdx.x); F.gw = F.bid * NWAVES + F.wave; F.NGW = F.G * NWAVES; } while (0)
#define IN(k) (lo <= (k) && (k) < hi)
#define SEAM(k) do { if (IN(k) && IN((k) + 1)) { XcdBarrier bb_ = bar; bb_.x = (unsigned)opqs((int)bar.x); xcd_barrier(bb_); } } while (0)
    if (PON(100) && IN(0)) { F.ws = opq(args.ws); F.lane = lane_asm() & 63; F.wave = opqs(wave0) & 7; F.tid = F.wave * 64 + F.lane; F.G = opqs(gridDim.x); F.bid = opqs(blockIdx.x); F.gw = F.bid * NWAVES + F.wave; F.NGW = F.G * NWAVES; { p0_weights(F, args); __syncthreads(); REOPQ(); p0_mod(F, args); __syncthreads(); REOPQ(); phase_hdn(F, args, 0); REOPQ(); phase_hdn(F, args, 1); __syncthreads(); } }
    SEAM(0);
#pragma unroll 1
    for (int layer = 0; layer < DEPTH; ++layer) {
        const int pb = 1 + layer * NPL; const bool lat_only = (layer == DEPTH - 1);
        if (PON(0) && IN(pb + 0)) { F.ws = opq(args.ws); F.lane = lane_asm() & 63; F.wave = opqs(wave0) & 7; F.tid = F.wave * 64 + F.lane; F.G = opqs(gridDim.x); F.bid = opqs(blockIdx.x); F.gw = F.bid * NWAVES + F.wave; F.NGW = F.G * NWAVES; if (layer == 0) phase_modln(F, args, layer); __syncthreads(); }
        SEAM(pb + 0);
        if (PON(1) && IN(pb + 1)) { F.ws = opq(args.ws); F.lane = lane_asm() & 63; F.wave = opqs(wave0) & 7; F.tid = F.wave * 64 + F.lane; F.G = opqs(gridDim.x); F.bid = opqs(blockIdx.x); F.gw = F.bid * NWAVES + F.wave; F.NGW = F.G * NWAVES;
            pg8::Gemm g{WSP(bf16_t, WS_H), WSP(bf16_t, WS_WIN + layer * SZ_WIN), DM, DM, DM}; pg8::StaticOrder S; S.init(66, NNG / 256, F.G, F.bid);
            EpiBf16 E{WSP(bf16_t, WS_P), NNG, nullptr, 0, 0, 1.f};
            pg8::gemm_phase(F.lds, g, S, E, F.tid);
        }
        SEAM(pb + 1);
        if (PON(2) && IN(pb + 2)) { F.ws = opq(args.ws); F.lane = lane_asm() & 63; F.wave = opqs(wave0) & 7; F.tid = F.wave * 64 + F.lane; F.G = opqs(gridDim.x); F.bid = opqs(blockIdx.x); F.gw = F.bid * NWAVES + F.wave; F.NGW = F.G * NWAVES; { phase_prep(F, args, layer); REOPQ(); phase_filt(F, args, layer); __syncthreads(); } }
        SEAM(pb + 2);
        if (PON(3) && IN(pb + 3)) { F.ws = opq(args.ws); F.lane = lane_asm() & 63; F.wave = opqs(wave0) & 7; F.tid = F.wave * 64 + F.lane; F.G = opqs(gridDim.x); F.bid = opqs(blockIdx.x); F.gw = F.bid * NWAVES + F.wave; F.NGW = F.G * NWAVES;
#if !defined(T3) || T3 == 0
            { pg8::Gemm g{WSP(bf16_t, WS_P) + P_CQ, WSP(bf16_t, WS_WQ + layer * SZ_WQ), NNG, 512, 512}; pg8::StaticOrder S; S.init(lat_only ? 64 : 66, 6, F.G, F.bid, lat_only ? 2 : 0);
              EpiBf16 E{WSP(bf16_t, WS_Q), 1536, WSP(float, WS_RS), 2, 0, 1.f}; pg8::gemm_phase(F.lds, g, S, E, F.tid); }
#endif
#if !defined(T3) || T3 == 1
            { pg8::Gemm g{WSP(bf16_t, WS_P) + P_CKV, WSP(bf16_t, WS_WKV + layer * SZ_WKV), NNG, 512, 512}; pg8::StaticOrder S; S.init(66, 8, F.G, (F.bid + 140) & 255);
              EpiBf16 E{WSP(bf16_t, WS_KV), 2048, WSP(float, WS_RS) + 1, 2, 0, 1.f}; pg8::gemm_phase(F.lds, g, S, E, F.tid); }
#endif
#if !defined(T3) || T3 == 2
            { pg8::Gemm g{WSP(bf16_t, WS_ALORA), WSP(bf16_t, WS_WLORA + layer * SZ_WLORA), 512, 512, 512}; pg8::StaticOrder S; S.init(66, 20, F.G, (F.bid + 156) & 255);
              EpiLora E{WSP(bf16_t, WS_EW), WSP(bf16_t, WS_ICLR), WSP(bf16_t, WS_GG), arg_in(args, I_RW0) + layer * 2048, arg_in(args, I_RA0) + layer * 2048}; pg8::gemm_phase(F.lds, g, S, E, F.tid); }
            REOPQ(); phase_mamba_states(F, args, layer); __syncthreads();
#endif
        }
        SEAM(pb + 3);
        SEAM(pb + 4);
        if (PON(5) && IN(pb + 5)) { F.ws = opq(args.ws); F.lane = lane_asm() & 63; F.wave = opqs(wave0) & 7; F.tid = F.wave * 64 + F.lane; F.G = opqs(gridDim.x); F.bid = opqs(blockIdx.x); F.gw = F.bid * NWAVES + F.wave; F.NGW = F.G * NWAVES;
#if !defined(T5) || T5 == 0
            phase_rwkv_scan(F, args, layer); __syncthreads();
#endif
#if !defined(T5) || T5 == 1
            REOPQ(); phase_attn(F, lat_only);
#endif
#if !defined(T5) || T5 == 2
            REOPQ(); phase_hyena_fft(F, args, layer);
#endif
#if !defined(T5) || T5 == 3
            REOPQ(); phase_mamba_scan(F); __syncthreads();
#endif
        }
        SEAM(pb + 5);
        if (PON(6) && IN(pb + 6)) { F.ws = opq(args.ws); F.lane = lane_asm() & 63; F.wave = opqs(wave0) & 7; F.tid = F.wave * 64 + F.lane; F.G = opqs(gridDim.x); F.bid = opqs(blockIdx.x); F.gw = F.bid * NWAVES + F.wave; F.NGW = F.G * NWAVES;
#if !defined(T6) || T6 == 0
            phase_mamba_out(F, args, layer); __syncthreads();
#endif
#if !defined(T6) || T6 == 1
            REOPQ(); phase_hyena_out(F, args, layer);
#endif
#if !defined(T6) || T6 == 2
            REOPQ(); phase_rwkv_out(F, args, layer); __syncthreads();
#endif
        }
        SEAM(pb + 6);
        if (PON(7) && IN(pb + 7)) { F.ws = opq(args.ws); F.lane = lane_asm() & 63; F.wave = opqs(wave0) & 7; F.tid = F.wave * 64 + F.lane; F.G = opqs(gridDim.x); F.bid = opqs(blockIdx.x); F.gw = F.bid * NWAVES + F.wave; F.NGW = F.G * NWAVES;
            pg8::Gemm g{WSP(bf16_t, WS_H8), WSP(bf16_t, WS_WIN + layer * SZ_WIN) + (size_t)NNG * DM, DM / 2, DM / 2, DM / 2}; pg8::StaticOrder S; S.init(lat_only ? 64 : 66, NGATE / 256, F.G, F.bid, lat_only ? 2 : 0);
            EpiBf16 E{WSP(bf16_t, WS_GATES), NGATE, nullptr, 0, 0, 1.f / 64.f};
            pg8::gemm_phase<EpiBf16, pg8::StaticOrder, true>(F.lds, g, S, E, F.tid);
            REOPQ(); phase_mamba_norm(F, args, layer);
        }
        SEAM(pb + 7);
        if (PON(8) && IN(pb + 8)) { F.ws = opq(args.ws); F.lane = lane_asm() & 63; F.wave = opqs(wave0) & 7; F.tid = F.wave * 64 + F.lane; F.G = opqs(gridDim.x); F.bid = opqs(blockIdx.x); F.gw = F.bid * NWAVES + F.wave; F.NGW = F.G * NWAVES;
            pg8::Gemm g{WSP(bf16_t, WS_Y), WSP(bf16_t, WS_WBR + layer * SZ_WBR), 1024, 1024, 1024}; OrderMerge S; S.init(F.G, F.bid, lat_only ? 64 : 66, lat_only ? 2 : 0);
            EpiMerge E{WSP(bf16_t, WS_GATES), WSP(bf16_t, WS_MRGB)};
            pg8::gemm_phase(F.lds, g, S, E, F.tid);

        }
        SEAM(pb + 8);
        if (PON(9) && IN(pb + 9)) { F.ws = opq(args.ws); F.lane = lane_asm() & 63; F.wave = opqs(wave0) & 7; F.tid = F.wave * 64 + F.lane; F.G = opqs(gridDim.x); F.bid = opqs(blockIdx.x); F.gw = F.bid * NWAVES + F.wave; F.NGW = F.G * NWAVES;
            pg8::Gemm g{WSP(bf16_t, WS_MRGB), WSP(bf16_t, WS_WOUT + layer * SZ_WOUT), DM, DM, DM}; pg8::StaticOrder S; S.init(lat_only ? 64 : 66, 8, F.G, F.bid, lat_only ? 2 : 0);
            EpiF32 E{WSP(float, WS_YMIX), DM};
            pg8::gemm_phase(F.lds, g, S, E, F.tid);

        }
        SEAM(pb + 9);
        if (PON(10) && IN(pb + 10)) { F.ws = opq(args.ws); F.lane = lane_asm() & 63; F.wave = opqs(wave0) & 7; F.tid = F.wave * 64 + F.lane; F.G = opqs(gridDim.x); F.bid = opqs(blockIdx.x); F.gw = F.bid * NWAVES + F.wave; F.NGW = F.G * NWAVES; phase_ln1(F, args, layer); __syncthreads(); { REOPQ(); conv_experts(F, args, layer); __syncthreads(); } }
        SEAM(pb + 10);
        if (PON(11) && IN(pb + 11)) { F.ws = opq(args.ws); F.lane = lane_asm() & 63; F.wave = opqs(wave0) & 7; F.tid = F.wave * 64 + F.lane; F.G = opqs(gridDim.x); F.bid = opqs(blockIdx.x); F.gw = F.bid * NWAVES + F.wave; F.NGW = F.G * NWAVES; phase_topk(F, lat_only); __syncthreads(); }
        SEAM(pb + 11);
        if (PON(12) && IN(pb + 12)) { F.ws = opq(args.ws); F.lane = lane_asm() & 63; F.wave = opqs(wave0) & 7; F.tid = F.wave * 64 + F.lane; F.G = opqs(gridDim.x); F.bid = opqs(blockIdx.x); F.gw = F.bid * NWAVES + F.wave; F.NGW = F.G * NWAVES; phase_gather(F); }
        SEAM(pb + 12);
        if (PON(13) && IN(pb + 13)) { F.ws = opq(args.ws); F.lane = lane_asm() & 63; F.wave = opqs(wave0) & 7; F.tid = F.wave * 64 + F.lane; F.G = opqs(gridDim.x); F.bid = opqs(blockIdx.x); F.gw = F.bid * NWAVES + F.wave; F.NGW = F.G * NWAVES;
            pg8::Gemm g{WSP(bf16_t, WS_XG), WSP(bf16_t, WS_WE), DM / 2, DM / 2, DM / 2}; OrderMoe S; S.init(11, F.G, F.bid, lat_only ? 8 : 9);
            EpiSwiglu E{WSP(unsigned char, WS_HID)};
            pg8::gemm_phase<EpiSwiglu, OrderMoe, true>(F.lds, g, S, E, F.tid);

        }
        SEAM(pb + 13);
        if (PON(14) && IN(pb + 14)) { F.ws = opq(args.ws); F.lane = lane_asm() & 63; F.wave = opqs(wave0) & 7; F.tid = F.wave * 64 + F.lane; F.G = opqs(gridDim.x); F.bid = opqs(blockIdx.x); F.gw = F.bid * NWAVES + F.wave; F.NGW = F.G * NWAVES;
            pg8::Gemm g{WSP(bf16_t, WS_HID), WSP(bf16_t, WS_WE + SZ_WGU8), EFFP / 2, EFFP / 2, EFFP / 2}; OrderMoe S; S.init(8, F.G, F.bid, lat_only ? 8 : 9);
            EpiDown E{WSP(bf16_t, WS_YE)};
            pg8::gemm_phase<EpiDown, OrderMoe, true>(F.lds, g, S, E, F.tid);

        }
        SEAM(pb + 14);
        if (PON(15) && IN(pb + 15)) { F.ws = opq(args.ws); F.lane = lane_asm() & 63; F.wave = opqs(wave0) & 7; F.tid = F.wave * 64 + F.lane; F.G = opqs(gridDim.x); F.bid = opqs(blockIdx.x); F.gw = F.bid * NWAVES + F.wave; F.NGW = F.G * NWAVES; phase_ln2(F, args, layer); }
        SEAM(pb + 15);
    }
#undef IN
#undef SEAM
}


#ifdef DBG_CUT
__global__ void dbg_dump(const unsigned char* ws, float* out, size_t off, int is_bf16, size_t n_src) {
    const size_t N = (size_t)TL * DM;
    for (size_t i = (size_t)blockIdx.x * blockDim.x + threadIdx.x; i < N; i += (size_t)gridDim.x * blockDim.x) {
        const size_t j = i % n_src;
        out[i] = is_bf16 ? bf2f(((const bf16_t*)(ws + off))[j]) : ((const float*)(ws + off))[j];
    }
}
#endif

#ifdef DBG_PASSES
__global__ void dbg_chk(const unsigned char* base, size_t off, size_t nbytes, unsigned long long* slot) {
    const unsigned* p = (const unsigned*)(base + off); const size_t n = nbytes / 4; unsigned long long s = 0;
    for (size_t i = (size_t)blockIdx.x * blockDim.x + threadIdx.x; i < n; i += (size_t)gridDim.x * blockDim.x) s += p[i];
    for (int o = 32; o > 0; o >>= 1) s += __shfl_xor(s, o);
    if ((threadIdx.x & 63) == 0) atomicAdd(slot, s);
}
__global__ void dbg_report(const unsigned long long* tab, float* out, int npass) {
    int k = 0;
    for (int ph = NPHASE - 1; ph >= 0; --ph) if (tab[ph] != tab[64 + ph]) k = ph + 1;
    if (k == 0 && npass > 2) { for (int ph = NPHASE - 1; ph >= 0; --ph) if (tab[64 + ph] != tab[128 + ph]) k = 50 + ph + 1; }
    if (k == 0) return;
    const float c = sqrtf(10.f * (float)k);
    for (size_t i = (size_t)blockIdx.x * blockDim.x + threadIdx.x; i < (size_t)TL * DM; i += (size_t)gridDim.x * blockDim.x) out[i] = c;
}
struct DbgReg { size_t off, n; };
#endif
extern "C" void kernel_launch(void* const* d_in, const int* in_sizes, int n_in, void* d_out, int out_size, void* d_ws, size_t ws_size, hipStream_t stream) {
    static int grid = 0;
    if (grid == 0) {
        if (n_in != N_INPUTS || in_sizes[0] != TL * DM || out_size != TL * DM || ws_size < WS_END) {
            fprintf(stderr, "kernel_launch: shape/workspace mismatch: n_in %d in0 %d out %d ws %zu (need %zu)\n", n_in, n_in > 0 ? in_sizes[0] : -1, out_size, ws_size, (size_t)WS_END); grid = -1; return; }
        int dev = 0, cus = 0, per_cu = 0;
        if (hipGetDevice(&dev) != hipSuccess || hipDeviceGetAttribute(&cus, hipDeviceAttributeMultiprocessorCount, dev) != hipSuccess) { grid = -1; return; }
        if (hipFuncSetAttribute((const void*)fwd_kernel, hipFuncAttributeMaxDynamicSharedMemorySize, LDS_BYTES) != hipSuccess) { fprintf(stderr, "kernel_launch: hipFuncSetAttribute failed\n"); grid = -1; return; }
        if (hipOccupancyMaxActiveBlocksPerMultiprocessor(&per_cu, (const void*)fwd_kernel, NTHREADS, LDS_BYTES) != hipSuccess || per_cu < 1) { fprintf(stderr, "kernel_launch: occupancy query says %d\n", per_cu); grid = -1; (void)hipGetLastError(); return; }
        grid = cus;
    }
    if (grid < 0) return;
    (void)hipMemsetAsync((char*)d_ws + WS_CTL, 0, CTL_BYTES, stream);
    Args a{};
    for (int i = 0; i < N_INPUTS; ++i) a.in[i] = (const float*)d_in[i];
    a.out = (float*)d_out; a.ws = (unsigned char*)d_ws;
#if MK_ONE_LAUNCH
    a.ph_lo = 0; a.ph_hi = NPHASE;
    hipLaunchKernelGGL(fwd_kernel, dim3(grid), dim3(NTHREADS), LDS_BYTES, stream, a);
#else
#ifdef DBG_PASSES
    {
        unsigned long long* tab = (unsigned long long*)((char*)d_ws + 1600000);
        auto chk = [&](int pass, int ph, size_t off, size_t n) { hipLaunchKernelGGL(dbg_chk, dim3(1024), dim3(256), 0, stream, (const unsigned char*)d_ws, off, n, tab + pass * 64 + ph); };
        for (int pass = 0; pass < DBG_PASSES; ++pass) {
            if (pass > 0) (void)hipMemsetAsync((char*)d_ws + (size_t)CW_MOD * 4, 0, (size_t)DEPTH * 3 * 6 * DM * 4, stream);
            for (int ph = 0; ph < NPHASE; ++ph) {
                a.ph_lo = ph; a.ph_hi = ph + 1; hipLaunchKernelGGL(fwd_kernel, dim3(grid), dim3(NTHREADS), LDS_BYTES, stream, a);
                if (ph == 0) { chk(pass, ph, WS_WIN, WS_XS - WS_WIN); chk(pass, ph, (size_t)CW_MOD * 4, (size_t)DEPTH * 3 * 6 * DM * 4); continue; }
                const int r = (ph - 1) % NPL;
                switch (r) {
                case 0: chk(pass, ph, WS_H, SZ_H); chk(pass, ph, WS_HDN, SZ_HDN); break;
                case 1: chk(pass, ph, WS_P, SZ_P); break;
                case 2: chk(pass, ph, WS_P2, SZ_P2); chk(pass, ph, WS_KK, SZ_TK2); chk(pass, ph, WS_ALORA, WS_VT - WS_ALORA); chk(pass, ph, WS_VT, WS_HDN - WS_VT); break;
                case 3: chk(pass, ph, WS_Q, SZ_Q + SZ_KV); chk(pass, ph, WS_EW, 4 * SZ_TK2); chk(pass, ph, WS_GG, SZ_TK2); break;
                case 4: chk(pass, ph, WS_Q, SZ_Q); chk(pass, ph, WS_MST, SZ_MST + SZ_MCS); break;
                case 5: chk(pass, ph, WS_YRW, 2 * SZ_TK2); chk(pass, ph, WS_Y, SZ_Y / 4); chk(pass, ph, WS_VT, SZ_VT); chk(pass, ph, WS_MST, SZ_MST); break;
                case 6: chk(pass, ph, WS_Y + SZ_Y / 4, 3 * (SZ_Y / 4)); break;
                case 7: chk(pass, ph, WS_GATES, SZ_GATES); chk(pass, ph, WS_Y + SZ_Y / 4, SZ_Y / 4); break;
                case 8: chk(pass, ph, WS_MRGF, SZ_MRGF); chk(pass, ph, WS_MRGB, SZ_MRGB); break;
                case 9: chk(pass, ph, WS_YMIX, SZ_YMIX); break;
                case 10: chk(pass, ph, WS_XS, SZ_XS); chk(pass, ph, WS_H2, SZ_H); chk(pass, ph, WS_AFF, SZ_AFF); chk(pass, ph, WS_WE, SZ_WGU + SZ_WD); break;
                case 11: chk(pass, ph, WS_INV, SZ_INV + SZ_PTOK + SZ_PGATE); break;
                case 12: chk(pass, ph, WS_XG, SZ_XG); break;
                case 13: chk(pass, ph, WS_HID, SZ_HID); break;
                case 14: chk(pass, ph, WS_YE, SZ_YE); break;
                case 15: chk(pass, ph, WS_XS, SZ_XS); break;
                }
            }
        }
        hipLaunchKernelGGL(dbg_report, dim3(2048), dim3(256), 0, stream, (const unsigned long long*)tab, (float*)d_out, (int)DBG_PASSES);
    }
#elif defined(DBG_CUT)
    for (int ph = 0; ph < DBG_CUT; ++ph) { a.ph_lo = ph; a.ph_hi = ph + 1; hipLaunchKernelGGL(fwd_kernel, dim3(grid), dim3(NTHREADS), LDS_BYTES, stream, a); }
    hipLaunchKernelGGL(dbg_dump, dim3(2048), dim3(256), 0, stream, (const unsigned char*)d_ws, (float*)d_out, (size_t)DBG_OFF, DBG_BF16, (size_t)DBG_N);
#else
    for (int ph = 0; ph < NPHASE; ++ph) { a.ph_lo = ph; a.ph_hi = ph + 1; hipLaunchKernelGGL(fwd_kernel, dim3(grid), dim3(NTHREADS), LDS_BYTES, stream, a); }
#endif
#endif
}
```

```cpp
#include <hip/hip_runtime.h>
#include <cstdio>
#include <cstdint>

#define REP_MASK 0x80000
#ifndef MK_ONE_LAUNCH
#define MK_ONE_LAUNCH 1
#endif

#define LAS __attribute__((address_space(3)))
typedef unsigned short bf16_t;
typedef short bf16x8 __attribute__((ext_vector_type(8)));
typedef float f32x4 __attribute__((ext_vector_type(4)));
typedef float f32x2 __attribute__((ext_vector_type(2)));
typedef unsigned u32x4 __attribute__((ext_vector_type(4)));
typedef unsigned u32x2 __attribute__((ext_vector_type(2)));

constexpr int DM = 2048, NBATCH = 2, SEQ = 8192, CTX = 256, DEPTH = 2;
constexpr int TC = NBATCH * CTX, TL = NBATCH * SEQ, T = TC + TL;
constexpr int NIN = 18432, NNG = 10240, NGATE = 8192;
constexpr int P_CQ = 0, P_CKV = 512, P_KPE = 1024;
constexpr int P_Z = 1088, P_XBC = 2112, P_DT = 3648;
constexpr int P_HY = 3680;
constexpr int P_RW = 6752, P_WD = 9824, P_AD = 9952, P_GD = 10080;
constexpr int NH_MLA = 8, NH_SSM = 16, NH_RW = 16;
constexpr int NEXP = 16, EFF = 1408, CAP_L = 1024, CAP_C = 32;
constexpr int NPAIR = NBATCH * NEXP * CAP_L + NEXP * 256;
constexpr float ALPHA = 1.4142135623730951f;
constexpr int NWAVES = 8, NTHREADS = 512;

__device__ __forceinline__ int seg_of(int row) { return row < 256 ? 0 : row < 512 ? 1 : row < 512 + SEQ ? 2 : 3; }
__device__ __forceinline__ int seg_start(int s) { return s == 0 ? 0 : s == 1 ? 256 : s == 2 ? 512 : 512 + SEQ; }
__device__ __forceinline__ int seg_len(int s) { return s < 2 ? CTX : SEQ; }
__device__ __forceinline__ bool row_first(int row) { return row == 0 || row == 256 || row == 512 || row == 512 + SEQ; }
__device__ __forceinline__ bool row_last(int row) { return row == 255 || row == 511 || row == 511 + SEQ || row == T - 1; }
__device__ __forceinline__ int row_modidx(int row) { return row < 512 ? 2 : (row < 512 + SEQ ? 0 : 1); }

constexpr size_t AL(size_t x) { return (x + 255) / 256 * 256; }
constexpr size_t WS_CTL = 0, CTL_BYTES = 2u << 20;
constexpr int CW_BAR = 1024;
constexpr int CW_MOD = 16384;
constexpr size_t SZ_WIN = (size_t)NIN * DM * 2, SZ_WBR = (size_t)4 * DM * 1024 * 2, SZ_WOUT = (size_t)DM * DM * 2, SZ_WQ = (size_t)1536 * 512 * 2,
                 SZ_WKV = (size_t)2048 * 512 * 2, SZ_WLORA = (size_t)5120 * 512 * 2;
constexpr size_t WS_WIN = CTL_BYTES, WS_WBR = WS_WIN + DEPTH * SZ_WIN, WS_WOUT = WS_WBR + DEPTH * SZ_WBR, WS_WQ = WS_WOUT + DEPTH * SZ_WOUT,
                 WS_WKV = WS_WQ + DEPTH * SZ_WQ, WS_WLORA = WS_WKV + DEPTH * SZ_WKV, WS_XS = WS_WLORA + DEPTH * SZ_WLORA;
constexpr size_t SZ_XS = (size_t)T * DM * 4;
constexpr size_t WIN8P_OFF = (size_t)NNG * DM * 2 + (size_t)NGATE * DM;
static_assert(WIN8P_OFF + (size_t)27 * 256 * DM <= SZ_WIN, "w_in area");
constexpr size_t WS_H = WS_XS + SZ_XS, SZ_H = (size_t)T * DM * 2;
constexpr size_t WS_P = WS_H + SZ_H, SZ_P = (size_t)T * NNG * 2;
constexpr int P2W = 5632, P2_XBC = 0, P2_X0 = 1536, P2_RKV = 2560;
constexpr size_t WS_P2 = WS_P + SZ_P, SZ_P2 = (size_t)T * P2W * 2;
constexpr size_t WS_Q = WS_P2 + SZ_P2, SZ_Q = (size_t)T * 1536 * 2;
constexpr size_t WS_KV = WS_Q + SZ_Q, SZ_KV = (size_t)T * 2048 * 2;
constexpr size_t WS_EW = WS_KV + SZ_KV, SZ_TK2 = (size_t)T * 1024 * 2;
constexpr size_t WS_ICLR = WS_EW + 2 * SZ_TK2;
constexpr size_t WS_KK = WS_ICLR + 2 * SZ_TK2;
constexpr size_t WS_GG = WS_KK + SZ_TK2;
constexpr size_t WS_YRW = WS_GG + SZ_TK2;
constexpr size_t WS_ALORA = WS_YRW + 2 * SZ_TK2, SZ_ALORA = (size_t)T * 512 * 2;
constexpr size_t WS_KPE = WS_ALORA + SZ_ALORA, SZ_KPE = (size_t)T * 64 * 2;
constexpr size_t WS_RS = WS_KPE + SZ_KPE, SZ_RS = AL((size_t)T * 2 * 4);
constexpr size_t WS_DT = WS_RS + SZ_RS, SZ_DT = (size_t)T * 32 * 4;
constexpr size_t WS_VT = WS_DT + SZ_DT, SZ_VT = (size_t)1024 * 2 * SEQ * 4;
constexpr size_t WS_VC = WS_VT + SZ_VT, SZ_VC = (size_t)TC * 1024 * 4;
constexpr size_t WS_FILT = WS_VC + SZ_VC, SZ_FILT = (size_t)1024 * 2 * SEQ * 2;
constexpr size_t WS_FILTC = WS_FILT + SZ_FILT, SZ_FILTC = (size_t)CTX * 2048 * 4;
constexpr size_t WS_HDN = WS_FILTC + SZ_FILTC, SZ_HDN1 = (size_t)(SEQ + CTX) * 64 * 4, SZ_HDN = DEPTH * SZ_HDN1;
constexpr int NCHUNK = T / 128;
constexpr size_t WS_MST = WS_HDN + SZ_HDN, SZ_MST = (size_t)2 * NCHUNK * 16 * 8192 * 2;
constexpr size_t WS_MCS = WS_MST + SZ_MST, SZ_MCS = (size_t)2 * NCHUNK * 16 * 4 * 2;
constexpr size_t WS_Y = WS_MCS + AL(SZ_MCS), SZ_Y = (size_t)4 * T * 1024 * 2;
constexpr size_t WS_AFF = WS_Y + SZ_Y, SZ_AFF = (size_t)T * 16 * 4;
constexpr size_t WS_INV = WS_AFF + SZ_AFF, SZ_INV = (size_t)T * 16 * 4;
constexpr size_t WS_PTOK = WS_INV + SZ_INV, SZ_PTOK = (size_t)NPAIR * 4;
constexpr size_t WS_PGATE = WS_PTOK + SZ_PTOK, SZ_PGATE = (size_t)NPAIR * 4;
constexpr size_t WS_H8 = WS_PGATE + SZ_PGATE, SZ_H8 = (size_t)T * DM;
constexpr size_t WS_END = WS_H8 + SZ_H8;
constexpr size_t WS_GATES = WS_P, SZ_GATES = (size_t)T * NGATE * 2;
constexpr size_t WS_MRGF = WS_P2, SZ_MRGF = (size_t)T * DM * 4;
constexpr size_t WS_MRGB = WS_Q, SZ_MRGB = (size_t)T * DM * 2;
constexpr size_t WS_YMIX = WS_P, SZ_YMIX = (size_t)T * DM * 4;
constexpr size_t WS_H2 = WS_H;
constexpr size_t WS_WE = WS_P2, SZ_WGU = (size_t)NEXP * 2816 * DM * 2, SZ_WD = (size_t)NEXP * DM * EFF * 2;
constexpr size_t WS_XG = WS_P, SZ_XG = (size_t)NPAIR * DM * 2;
constexpr size_t WS_HID = WS_XG + SZ_XG, SZ_HID = (size_t)NPAIR * EFF * 2;
constexpr size_t WS_YE = WS_WE + SZ_WGU + SZ_WD, SZ_YE = (size_t)NPAIR * DM * 2;
static_assert(SZ_GATES <= SZ_P && SZ_MRGF <= SZ_P2 && SZ_MRGB <= SZ_Q + SZ_KV && SZ_YMIX <= SZ_P, "alias map 1");
static_assert(SZ_XG + SZ_HID <= SZ_P, "alias map 2");
static_assert(WS_YE + SZ_YE <= WS_VT, "alias map 3");
static_assert(WS_END < 1800000000ull, "workspace budget");

__device__ __forceinline__ unsigned f2bf(float f) { unsigned u = __builtin_bit_cast(unsigned, f); return (u + 0x7fffu + ((u >> 16) & 1u)) >> 16; }
__device__ __forceinline__ unsigned pk2(float lo, float hi) { return f2bf(lo) | (f2bf(hi) << 16); }
__device__ __forceinline__ float bf2f(unsigned short b) { return __builtin_bit_cast(float, (unsigned)b << 16); }
__device__ __forceinline__ float bflo(unsigned w) { return __builtin_bit_cast(float, w << 16); }
__device__ __forceinline__ float bfhi(unsigned w) { return __builtin_bit_cast(float, w & 0xffff0000u); }
__device__ __forceinline__ unsigned cvt_pk_bf16(float lo, float hi) { unsigned r; asm volatile("v_cvt_pk_bf16_f32 %0, %1, %2" : "=v"(r) : "v"(lo), "v"(hi)); return r; }
__device__ __forceinline__ float dppx(float x, const int sel) {
    const int xi = __builtin_bit_cast(int, x); int r;
    if (sel == 0) r = __builtin_amdgcn_update_dpp(0, xi, 0xB1, 0xF, 0xF, false);
    else if (sel == 1) r = __builtin_amdgcn_update_dpp(0, xi, 0x4E, 0xF, 0xF, false);
    else if (sel == 2) r = __builtin_amdgcn_update_dpp(0, xi, 0x141, 0xF, 0xF, false);
    else r = __builtin_amdgcn_update_dpp(0, xi, 0x140, 0xF, 0xF, false);
    return __builtin_bit_cast(float, r);
}
__device__ __forceinline__ float swz16(float x) { return __builtin_bit_cast(float, __builtin_amdgcn_ds_swizzle(__builtin_bit_cast(int, x), 0x401F)); }
__device__ __forceinline__ float sum4(float v) { v += dppx(v, 0); v += dppx(v, 1); return v; }
__device__ __forceinline__ float sum8(float v) { v = sum4(v); v += dppx(v, 2); return v; }
__device__ __forceinline__ float sum16(float v) { v = sum8(v); v += dppx(v, 3); return v; }
__device__ __forceinline__ float sum32(float v) { v = sum16(v); v += swz16(v); return v; }
__device__ __forceinline__ unsigned pk4fp8(float a, float b, float c, float d) { int w = 0; w = __builtin_amdgcn_cvt_pk_fp8_f32(a, b, w, false); w = __builtin_amdgcn_cvt_pk_fp8_f32(c, d, w, true); return (unsigned)w; }
__device__ __forceinline__ float wave_sum(float v) {
    v = sum32(v);
    auto rr = __builtin_amdgcn_permlane32_swap(__float_as_uint(v), __float_as_uint(v), false, false);
    return __uint_as_float(rr[0]) + __uint_as_float(rr[1]);
}
__device__ __forceinline__ float sigmoidf_(float x) { return 1.f / (1.f + __expf(-x)); }
__device__ __forceinline__ float siluf_(float x) { return x / (1.f + __expf(-x)); }
__device__ __forceinline__ float softplusf_(float x) { return x > 20.f ? x : __logf(1.f + __expf(x)); }
__device__ __forceinline__ float tanhf_(float x) { const float e = __expf(2.f * fminf(x, 15.f)); return 1.f - 2.f / (e + 1.f); }
#define LDS_WAIT() asm volatile("s_waitcnt lgkmcnt(0)" ::: "memory")
#define VM_WAIT() asm volatile("s_waitcnt vmcnt(0)" ::: "memory")

#define XB_TMO      128
#define XB_XCNT(j)  (256  + 64 * (j))
#define XB_XSUB(j)  (1280 + 64 * (j))
#define XB_XGEN(j)  (2304 + 64 * (j))
#define XB_TOP      3328
#define XB_TOPGEN   3392
#define XCD_BAR_WORDS 3456
#define XB_SPIN_CAP (1u << 18)
__device__ __forceinline__ unsigned xb_ld(unsigned* p)              { return __hip_atomic_load(p, __ATOMIC_RELAXED, __HIP_MEMORY_SCOPE_AGENT); }
__device__ __forceinline__ unsigned xb_add(unsigned* p, unsigned v) { return __hip_atomic_fetch_add(p, v, __ATOMIC_RELAXED, __HIP_MEMORY_SCOPE_AGENT); }
__device__ __forceinline__ unsigned xb_xcc_id() { return (unsigned)__builtin_amdgcn_s_getreg((3 << 11) | 20) & 0xFu; }
#define XB_SPIN(cond, bar) do { unsigned _sp = 0; while (cond) { __builtin_amdgcn_s_sleep(1); \
    if ((++_sp & 255u) == 0u) { if (xb_ld(&(bar)[XB_TMO])) break; if (_sp > XB_SPIN_CAP) { atomicAdd(&(bar)[XB_TMO], 1u); break; } } } } while (0)
struct XcdBarrier { unsigned* bar; unsigned x; volatile LAS unsigned* st; };
__device__ __forceinline__ XcdBarrier xcd_barrier_post(unsigned* bar, volatile LAS unsigned* st) {
    XcdBarrier b; b.bar = bar; b.x = xb_xcc_id(); b.st = st;
    if (threadIdx.x == 0) (void)xb_add(&bar[XB_XCNT(b.x)], 1u);
    return b;
}
__device__ __forceinline__ void xcd_barrier_complete(unsigned* bar, unsigned x, unsigned& nloc, unsigned& nx) {
    const unsigned G = gridDim.x * gridDim.y * gridDim.z;
    unsigned sum, cnt, mine, sp = 0u;
    for (;;) {
        sum = 0u; cnt = 0u; mine = 0u;
#pragma unroll
        for (unsigned j = 0; j < 16; ++j) { const unsigned c = xb_ld(&bar[XB_XCNT(j)]); sum += c; cnt += (c > 0u) ? 1u : 0u; mine = (j == x) ? c : mine; }
        if (sum == G) break;
        __builtin_amdgcn_s_sleep(1);
        if ((++sp & 255u) == 0u) { if (xb_ld(&bar[XB_TMO])) break; if (sp > XB_SPIN_CAP) { atomicAdd(&bar[XB_TMO], 1u); break; } }
    }
    nloc = mine > 0u ? mine : 1u; nx = cnt > 0u ? cnt : 1u;
}
__device__ __forceinline__ void xcd_barrier(const XcdBarrier& b) {
    asm volatile("s_waitcnt vmcnt(0)" ::: "memory");
    __syncthreads();
    if (threadIdx.x == 0) {
        unsigned* bar = b.bar;
        __builtin_amdgcn_s_waitcnt(0);
        unsigned nloc = b.st[0], nx = b.st[1];
        if (nloc == 0u) { xcd_barrier_complete(bar, b.x, nloc, nx); b.st[0] = nloc; b.st[1] = nx; }
        const unsigned old = xb_add(&bar[XB_XSUB(b.x)], 1u);
        const unsigned gen = old / nloc;
        if (old + 1u == (gen + 1u) * nloc) {
            __builtin_amdgcn_fence(__ATOMIC_RELEASE, "agent");
            asm volatile("s_waitcnt vmcnt(0)" ::: "memory");
            const unsigned og = xb_add(&bar[XB_TOP], 1u);
            const unsigned tg = og / nx;
            if (og + 1u == (tg + 1u) * nx) xb_add(&bar[XB_TOPGEN], 1u);
            else XB_SPIN(xb_ld(&bar[XB_TOPGEN]) == tg, bar);
            __builtin_amdgcn_fence(__ATOMIC_ACQUIRE, "agent");
            xb_add(&bar[XB_XGEN(b.x)], 1u);
            asm volatile("s_waitcnt vmcnt(0)" ::: "memory");
        } else {
            XB_SPIN(xb_ld(&bar[XB_XGEN(b.x)]) == gen, bar);
            __builtin_amdgcn_fence(__ATOMIC_ACQUIRE, "agent");
            asm volatile("s_waitcnt vmcnt(0)" ::: "memory");
        }
    }
    __syncthreads();
}

__device__ __forceinline__ int lane_asm() { int l; asm volatile("v_mbcnt_lo_u32_b32 %0, -1, 0\n\tv_mbcnt_hi_u32_b32 %0, -1, %0" : "=v"(l)); return l; }
namespace pg8 {
constexpr int BM = 256, BK = 64, HALF = 128, HTB = HALF * BK * 2, STAGE_BYTES = 8 * HTB, NXCD = 8, WGM = 8;
__host__ __device__ __forceinline__ int lds_byte(int r, int c) { const int st = (r >> 4) * 2 + (c >> 5), rr = r & 15, cc = c & 31, ob = rr * 64 + cc * 2; return st * 1024 + (ob ^ (((ob >> 9) & 1) << 5)); }
__host__ __device__ __forceinline__ void stage_rc(int b, int& R, int& C) { const int st = b / 1024, sb = b % 1024, swz = sb ^ (((sb >> 9) & 1) << 5); R = (st >> 1) * 16 + swz / 64; C = (st & 1) * 32 + (swz % 64) / 2; }
__host__ __device__ __forceinline__ int perm32(int rho) { const int n = rho >> 4, i = rho & 15; return 8 * (i >> 2) + 4 * n + (i & 3); }
struct Unit { int pm, pn; };
struct Gemm { const bf16_t* A; const bf16_t* Bt; int lda, ldb, K; };
struct StaticOrder {
    int nM, nN, nwg, G, c, pm0, pn0;
    __device__ void init(int nM_, int nN_, int G_, int c_, int pm0_ = 0, int pn0_ = 0) { nM = nM_; nN = nN_; nwg = nM * nN; G = G_; c = c_; pm0 = pm0_; pn0 = pn0_; }
    __device__ bool next(int i, Unit& u) const {
        const long L = (long)i * G + c; if (L >= nwg) return false;
        int wgid = (int)L; { const int q = nwg / NXCD, r = nwg % NXCD, xcd = wgid % NXCD, off = wgid / NXCD; wgid = (xcd < r ? xcd * (q + 1) : r * (q + 1) + (xcd - r) * q) + off; }
        const int nig = WGM * nN, gid = wgid / nig, fm = gid * WGM, gsz = (nM - fm) < WGM ? (nM - fm) : WGM;
        u.pm = pm0 + fm + ((wgid % nig) % gsz); u.pn = pn0 + (wgid % nig) / gsz; return true;
    }
};
typedef int i32x4v __attribute__((ext_vector_type(4)));
typedef int i32x8v __attribute__((ext_vector_type(8)));
__device__ __forceinline__ i32x8v cat8(bf16x8 a, bf16x8 b) { return __builtin_shufflevector(__builtin_bit_cast(i32x4v, a), __builtin_bit_cast(i32x4v, b), 0, 1, 2, 3, 4, 5, 6, 7); }
template <class Epi, class Sched, bool FP8 = false>
__device__ __forceinline__ void gemm_phase(LAS unsigned char* lds, const Gemm g, const Sched& S, const Epi& E, int tid_in) {
    constexpr bool ALIGN_EPI = true;
    const unsigned tid_u = (unsigned)tid_in; __builtin_assume(tid_u < 512u);
    const int tid = (int)tid_u, wid = __builtin_amdgcn_readfirstlane(tid >> 6), lane = tid & 63, wr = wid >> 2, wc = wid & 3, fr = lane & 15, fq = lane >> 4;
    const int K = g.K, nt = K / BK;
    unsigned voffA[2], voffB[2];
#pragma unroll
    for (int i = 0; i < 2; ++i) { int R, C; stage_rc(tid * 16 + i * 8192, R, C); const int Rb = Epi::PERM ? ((R & ~31) + perm32(R & 31)) : R;
        voffA[i] = (unsigned)(R * g.lda + C) * 2u; voffB[i] = (unsigned)(Rb * g.ldb + C) * 2u; }
    const unsigned kstep = (unsigned)(BK * 2);
    const unsigned hstepA = (unsigned)HALF * g.lda * 2u, hstepB = (unsigned)HALF * g.ldb * 2u;
    const unsigned tstepA = 2u * hstepA, tstepB = 2u * hstepB;
    const unsigned ldsw = (unsigned)wid * 1024u;
    const int aoff = lds_byte(wr * 64 + fr, fq * 8), boff = lds_byte(wc * 32 + fr, fq * 8);
    const __amdgpu_buffer_rsrc_t rsA = __builtin_amdgcn_make_buffer_rsrc((void*)g.A, 0, 0xFFFFFFFFu, 0x00020000);
    const __amdgpu_buffer_rsrc_t rsB = __builtin_amdgcn_make_buffer_rsrc((void*)g.Bt, 0, 0xFFFFFFFFu, 0x00020000);
#define PG8_SA(b, h) (((b) * 2 + (h)) * HTB)
#define PG8_SB(b, h) ((4 + (b) * 2 + (h)) * HTB)
#define PG8_STAGE(bufoff, rs, soff, voff) do { _Pragma("unroll") for (int _i = 0; _i < 2; ++_i) \
        __builtin_amdgcn_raw_ptr_buffer_load_lds(rs, (LAS unsigned*)(lds + (bufoff) + ldsw + _i * 8192), 16, (int)(voff)[_i], (int)(soff), 0, 0); } while (0)
#define PG8_LDA(dst, b, h) do { if constexpr (FP8) { _Pragma("unroll") for (int m = 0; m < 4; ++m) dst##8[m] = __builtin_shufflevector(*(const LAS i32x4v*)(lds + PG8_SA(b, h) + aoff + m * 2048), *(const LAS i32x4v*)(lds + PG8_SA(b, h) + aoff + m * 2048 + 1024), 0, 1, 2, 3, 4, 5, 6, 7); } \
    else { _Pragma("unroll") for (int m = 0; m < 4; ++m) _Pragma("unroll") for (int k = 0; k < 2; ++k) dst[m][k] = *(const LAS bf16x8*)(lds + PG8_SA(b, h) + aoff + m * 2048 + k * 1024); } } while (0)
#define PG8_LDB(dst, b, h) do { if constexpr (FP8) { _Pragma("unroll") for (int n = 0; n < 2; ++n) dst##8[n] = __builtin_shufflevector(*(const LAS i32x4v*)(lds + PG8_SB(b, h) + boff + n * 2048), *(const LAS i32x4v*)(lds + PG8_SB(b, h) + boff + n * 2048 + 1024), 0, 1, 2, 3, 4, 5, 6, 7); } \
    else { _Pragma("unroll") for (int n = 0; n < 2; ++n) _Pragma("unroll") for (int k = 0; k < 2; ++k) dst[n][k] = *(const LAS bf16x8*)(lds + PG8_SB(b, h) + boff + n * 2048 + k * 1024); } } while (0)
#define PG8_MMA(ai, bj, At, Bt) do { __builtin_amdgcn_s_setprio(1); if constexpr (FP8) { _Pragma("unroll") for (int m = 0; m < 4; ++m) _Pragma("unroll") for (int n = 0; n < 2; ++n) \
        asm volatile("v_mfma_scale_f32_16x16x128_f8f6f4 %0, %1, %2, %0, %3, %3 op_sel_hi:[0,0,0]" : "+v"(acc[ai][bj][m][n]) : "v"(Bt##8[n]), "v"(At##8[m]), "v"(sc1)); } else { \
        _Pragma("unroll") for (int m = 0; m < 4; ++m) _Pragma("unroll") for (int n = 0; n < 2; ++n) _Pragma("unroll") for (int k = 0; k < 2; ++k) \
        acc[ai][bj][m][n] = __builtin_amdgcn_mfma_f32_16x16x32_bf16(Bt[n][k], At[m][k], acc[ai][bj][m][n], 0, 0, 0); } __builtin_amdgcn_s_setprio(0); } while (0)
#define PG8_WAIT_V(n) asm volatile("s_waitcnt vmcnt(" #n ")" ::: "memory")
#define PG8_WAIT_L(n) asm volatile("s_waitcnt lgkmcnt(" #n ")" ::: "memory")
#define PG8_BAR __builtin_amdgcn_s_barrier()
#define PG8_SCHED __builtin_amdgcn_sched_barrier(0)
    Unit cur, nxt; int ui = 0;
    if (!S.next(0, cur)) return;
    f32x4 acc[2][2][4][2];
#pragma unroll
    for (int a = 0; a < 2; ++a)
#pragma unroll
        for (int b = 0; b < 2; ++b)
#pragma unroll
            for (int m = 0; m < 4; ++m)
#pragma unroll
                for (int n = 0; n < 2; ++n) acc[a][b][m][n] = (f32x4){0.f, 0.f, 0.f, 0.f};
    i32x8v At8[4], B08[2], B18[2]; bf16x8 At[4][2], B0[2][2], B1[2][2];
    const int sc1 = 0x7F7F7F7F;
    unsigned cA = (unsigned)cur.pm * tstepA, cB = (unsigned)cur.pn * tstepB;
    PG8_STAGE(PG8_SB(0, 0), rsB, cB, voffB); PG8_STAGE(PG8_SB(0, 1), rsB, cB + hstepB, voffB); PG8_STAGE(PG8_SA(0, 0), rsA, cA, voffA); PG8_STAGE(PG8_SA(0, 1), rsA, cA + hstepA, voffA);
    if (wr == 1) PG8_BAR;
    PG8_WAIT_V(2); PG8_BAR;
    PG8_STAGE(PG8_SB(1, 0), rsB, cB + kstep, voffB); PG8_STAGE(PG8_SA(1, 0), rsA, cA + kstep, voffA); PG8_STAGE(PG8_SB(1, 1), rsB, cB + hstepB + kstep, voffB);
    PG8_WAIT_V(6); PG8_BAR;
    for (;;) {
        const bool has_next = S.next(ui + 1, nxt);
        const unsigned nA = has_next ? (unsigned)nxt.pm * tstepA : cA; const unsigned nB = has_next ? (unsigned)nxt.pn * tstepB : cB;
        for (int t = 0; t < nt; t += 2) {
            const bool last = (t == nt - 2);
            const unsigned a1 = cA + (unsigned)(t + 1) * kstep;
            const unsigned a2 = last ? nA : cA + (unsigned)(t + 2) * kstep; const unsigned b2 = last ? nB : cB + (unsigned)(t + 2) * kstep;
            const unsigned a3 = a2 + kstep; const unsigned b3 = b2 + kstep;
            PG8_LDB(B0, 0, 0); PG8_LDB(B1, 0, 1); PG8_SCHED; PG8_LDA(At, 0, 0); PG8_STAGE(PG8_SA(1, 1), rsA, a1 + hstepA, voffA);
            PG8_WAIT_V(8); PG8_WAIT_L(0); PG8_BAR; PG8_MMA(0, 0, At, B0); PG8_MMA(0, 1, At, B1); PG8_BAR; PG8_SCHED;
            PG8_LDA(At, 0, 1); PG8_STAGE(PG8_SB(0, 0), rsB, b2, voffB); PG8_STAGE(PG8_SB(0, 1), rsB, b2 + hstepB, voffB); PG8_STAGE(PG8_SA(0, 0), rsA, a2, voffA);
            PG8_WAIT_V(8); PG8_WAIT_L(0); PG8_BAR; PG8_MMA(1, 0, At, B0); PG8_MMA(1, 1, At, B1); PG8_BAR; PG8_SCHED;
            PG8_LDB(B0, 1, 0); PG8_LDB(B1, 1, 1); PG8_SCHED; PG8_LDA(At, 1, 0); PG8_STAGE(PG8_SA(0, 1), rsA, a2 + hstepA, voffA);
            PG8_WAIT_V(8); PG8_WAIT_L(0); PG8_BAR; PG8_MMA(0, 0, At, B0); PG8_MMA(0, 1, At, B1); PG8_BAR; PG8_SCHED;
            PG8_LDA(At, 1, 1); PG8_STAGE(PG8_SB(1, 0), rsB, b3, voffB); PG8_STAGE(PG8_SB(1, 1), rsB, b3 + hstepB, voffB); PG8_STAGE(PG8_SA(1, 0), rsA, a3, voffA);
            PG8_WAIT_V(8); PG8_WAIT_L(0); PG8_BAR; PG8_MMA(1, 0, At, B0); PG8_MMA(1, 1, At, B1); PG8_BAR; PG8_SCHED;
        }
        if constexpr (FP8) asm volatile("s_nop 15\n\ts_nop 7" ::: "memory");
        if constexpr (ALIGN_EPI) { if (wr == 0) PG8_BAR; }
        bool keep_acc = false;
        { const int l2 = lane_asm() & 63; if constexpr (Epi::KEEPS) keep_acc = E(acc, cur, wr, wc, l2 & 15, l2 >> 4); else E(acc, cur, wr, wc, l2 & 15, l2 >> 4); }
        if (!has_next) break;
        if (!keep_acc) {
#pragma unroll
        for (int a = 0; a < 2; ++a)
#pragma unroll
            for (int b = 0; b < 2; ++b)
#pragma unroll
                for (int m = 0; m < 4; ++m)
#pragma unroll
                    for (int n = 0; n < 2; ++n) acc[a][b][m][n] = (f32x4){0.f, 0.f, 0.f, 0.f};
        }
        cur = nxt; cA = nA; cB = nB; ++ui;
        if constexpr (ALIGN_EPI) { if (wr == 1) PG8_BAR; }
    }
    PG8_WAIT_V(0);
    if constexpr (!ALIGN_EPI) { if (wr == 0) PG8_BAR; }
    PG8_BAR;
#undef PG8_SA
#undef PG8_SB
#undef PG8_STAGE
#undef PG8_LDA
#undef PG8_LDB
#undef PG8_MMA
#undef PG8_WAIT_V
#undef PG8_WAIT_L
#undef PG8_BAR
#undef PG8_SCHED
}
}

enum { I_X = 0, I_C, I_CTX, I_CCTX, I_WADA, I_BADA, I_WIN, I_QNORM, I_WQUP, I_KVNORM, I_WKVUP, I_SCONVW, I_SCONVB, I_SDTB, I_SALOG, I_SD, I_SNORM,
       I_HCONVW, I_HCONVB, I_HW1, I_HB1, I_HW2, I_HB2, I_HW3, I_HFREQ, I_HD, I_RMU, I_RW0, I_RWUP, I_RA0, I_RAUP, I_RGUP, I_RKK, I_RKA, I_RRK, I_RLNG, I_RLNB,
       I_WBR, I_WOUT, I_LN1G, I_LN1B, I_WROUTER, I_WGATE, I_WUP, I_WDOWN, I_LN2G, I_LN2B, N_INPUTS };
struct Args { const float* in[N_INPUTS]; float* out; unsigned char* ws; int ph_lo, ph_hi; };
static_assert(sizeof(Args) == (N_INPUTS + 2) * 8 + 8, "Args has no padding");

__device__ __forceinline__ const float* arg_in(const Args& a, int i) { asm volatile("" : "+s"(i)); return a.in[i]; }
__device__ __forceinline__ int opqs(int v) { asm volatile("" : "+s"(v)); return v; }
__device__ __forceinline__ int opqv(int v) { asm volatile("" : "+v"(v)); return v; }
__device__ __forceinline__ unsigned char* opq(unsigned char* p) { asm volatile("" : "+s"(p)); return p; }
struct Frame {
    LAS unsigned char* lds;
    int tid, lane, wave, G, bid, gw, NGW;
    unsigned char* ws;
};
#define WSP(T_, off) ((T_*)(F.ws + (off)))

struct RmId { __device__ int operator()(int n) const { return n; } };
struct RmShift { int sh; __device__ int operator()(int n) const { return n + sh; } };
struct RmGateUp { int up; __device__ int operator()(int n) const { return 256 * (n >> 7) + (n & 127) + (up ? 128 : 0); } };
constexpr int TR_SCR = 64 * 65 * 4;
__device__ __forceinline__ void tr_load(const float* W, int ldw, int k0, int n0, const float* kscale, float sc, LAS float* scr, int lane) {
    float v[64];
    const float* wp = W + (size_t)k0 * ldw + n0 + lane;
#pragma unroll
    for (int i = 0; i < 64; ++i) v[i] = wp[(size_t)i * ldw];
#pragma unroll
    for (int i = 0; i < 64; ++i) { float x = v[i] * sc; if (kscale) x *= kscale[k0 + i]; scr[i * 65 + lane] = x; }
    LDS_WAIT(); asm volatile("" ::: "memory");
}
template <class RowMap>
__device__ __forceinline__ void transpose_item(const float* W, int ldw, bf16_t* WT, int ldt, int k0, int n0, const float* kscale, RowMap rm, LAS float* scr, int lane) {
    tr_load(W, ldw, k0, n0, kscale, 1.f, scr, lane);
    const int c = lane & 7;
#pragma unroll
    for (int j = 0; j < 8; ++j) { const int n = (lane >> 3) + 8 * j; const LAS float* s = scr + (8 * c) * 65 + n;
        u32x4 o; o.x = pk2(s[0 * 65], s[1 * 65]); o.y = pk2(s[2 * 65], s[3 * 65]); o.z = pk2(s[4 * 65], s[5 * 65]); o.w = pk2(s[6 * 65], s[7 * 65]);
        *(u32x4*)(WT + (size_t)rm(n0 + n) * ldt + k0 + 8 * c) = o; }
    LDS_WAIT(); asm volatile("" ::: "memory");
}
template <class RowMap>
__device__ __forceinline__ void transpose_item_fp8(const float* W, int ldw, unsigned char* WT, int ldt, int k0, int n0, float sc, RowMap rm, LAS float* scr, int lane) {
    tr_load(W, ldw, k0, n0, nullptr, sc, scr, lane);
    const int c = lane & 3;
#pragma unroll
    for (int j = 0; j < 4; ++j) { const int n = (lane >> 2) + 16 * j; const LAS float* s = scr + (16 * c) * 65 + n;
        u32x4 o; o.x = pk4fp8(s[0 * 65], s[1 * 65], s[2 * 65], s[3 * 65]); o.y = pk4fp8(s[4 * 65], s[5 * 65], s[6 * 65], s[7 * 65]);
        o.z = pk4fp8(s[8 * 65], s[9 * 65], s[10 * 65], s[11 * 65]); o.w = pk4fp8(s[12 * 65], s[13 * 65], s[14 * 65], s[15 * 65]);
        *(u32x4*)(WT + (size_t)rm(n0 + n) * ldt + k0 + 16 * c) = o; }
    LDS_WAIT(); asm volatile("" ::: "memory");
}

__device__ __forceinline__ void p0_weights(Frame& F, const Args& a) {
    LAS float* scr = (LAS float*)(F.lds + F.wave * TR_SCR);
    constexpr int IT_IN = 32 * 288, IT_BR = 16 * 32, IT_OUT = 32 * 32, IT_Q = 8 * 24, IT_KV = 8 * 32;
    constexpr int PER_L = IT_IN + 4 * IT_BR + IT_OUT + IT_Q + IT_KV;
    for (int it = F.gw; it < DEPTH * PER_L; it += F.NGW) {
        const int l = it / PER_L; int r = it % PER_L;
        if (r < IT_IN) { const int kb = r / 288, nb = r % 288;
            if (nb * 64 < NNG) { const int tile = nb >> 2;
                if (tile >= 14 && tile < 27) transpose_item(arg_in(a, I_WIN) + (size_t)l * DM * NIN, NIN, WSP(bf16_t, WS_WIN + l * SZ_WIN), DM, kb * 64, nb * 64, nullptr, RmId(), scr, F.lane);
                else { RmShift rs; rs.sh = tile < 14 ? 0 : -13 * 256; transpose_item_fp8(arg_in(a, I_WIN) + (size_t)l * DM * NIN, NIN, WSP(unsigned char, WS_WIN + l * SZ_WIN + WIN8P_OFF), DM, kb * 64, nb * 64, 64.f, rs, scr, F.lane); } }
            else transpose_item_fp8(arg_in(a, I_WIN) + (size_t)l * DM * NIN + NNG, NIN, WSP(unsigned char, WS_WIN + l * SZ_WIN) + (size_t)NNG * DM * 2, DM, kb * 64, nb * 64 - NNG, 64.f, RmId(), scr, F.lane);
            continue; } r -= IT_IN;
        if (r < 4 * IT_BR) { const int br = r / IT_BR, q = r % IT_BR, kb = q / 32, nb = q % 32;
            transpose_item(arg_in(a, I_WBR) + ((size_t)l * 4 + br) * 1024 * DM, DM, WSP(bf16_t, WS_WBR + l * SZ_WBR) + (size_t)br * DM * 1024, 1024, kb * 64, nb * 64, nullptr, RmId(), scr, F.lane); continue; } r -= 4 * IT_BR;
        if (r < IT_OUT) { const int kb = r / 32, nb = r % 32;
            transpose_item(arg_in(a, I_WOUT) + (size_t)l * DM * DM, DM, WSP(bf16_t, WS_WOUT + l * SZ_WOUT), DM, kb * 64, nb * 64, nullptr, RmId(), scr, F.lane); continue; } r -= IT_OUT;
        if (r < IT_Q) { const int kb = r / 24, nb = r % 24;
            transpose_item(arg_in(a, I_WQUP) + (size_t)l * 512 * 1536, 1536, WSP(bf16_t, WS_WQ + l * SZ_WQ), 512, kb * 64, nb * 64, arg_in(a, I_QNORM) + l * 512, RmId(), scr, F.lane); continue; } r -= IT_Q;
        { const int kb = r / 32, nb = r % 32;
            transpose_item(arg_in(a, I_WKVUP) + (size_t)l * 512 * 2048, 2048, WSP(bf16_t, WS_WKV + l * SZ_WKV), 512, kb * 64, nb * 64, arg_in(a, I_KVNORM) + l * 512, RmId(), scr, F.lane); }
    }
    for (size_t e = (size_t)F.bid * NTHREADS + F.tid; e < (size_t)DEPTH * 5120 * 512; e += (size_t)F.G * NTHREADS) {
        const int l = (int)(e / (5120 * 512)); const int rem = (int)(e % (5120 * 512)); const int n = rem / 512, kc = rem % 512; const int blk = n >> 10, c = n & 1023;
        float v = 0.f;
        if (blk < 2) { if (kc >= 64 * blk && kc < 64 * blk + 64) v = arg_in(a, I_RWUP)[(((size_t)l * 2 + blk) * 64 + (kc - 64 * blk)) * 1024 + c]; }
        else if (blk < 4) { const int d = blk - 2; if (kc >= 128 + 64 * d && kc < 192 + 64 * d) v = arg_in(a, I_RAUP)[(((size_t)l * 2 + d) * 64 + (kc - 128 - 64 * d)) * 1024 + c]; }
        else { if (kc >= 256 && kc < 416) v = arg_in(a, I_RGUP)[((size_t)l * 160 + (kc - 256)) * 1024 + c]; }
        WSP(bf16_t, WS_WLORA)[e] = (bf16_t)f2bf(v);
    }
}
constexpr int EFFP = 1536;
constexpr size_t SZ_WGU8 = (size_t)NEXP * 2816 * DM, SZ_WD8 = (size_t)NEXP * DM * EFFP;
__device__ __forceinline__ void conv_experts(Frame& F, const Args& a, int l) {
    LAS float* scr = (LAS float*)(F.lds + F.wave * TR_SCR);
    constexpr int IT_G = 32 * 22, IT_D = 22 * 32, PER_E = 2 * IT_G + IT_D;
    unsigned char* wgu = WSP(unsigned char, WS_WE); unsigned char* wd = WSP(unsigned char, WS_WE + SZ_WGU8);
    for (int it = F.gw; it < NEXP * PER_E; it += F.NGW) {
        const int e = it / PER_E; int r = it % PER_E;
        if (r < 2 * IT_G) { const int up = r / IT_G, q = r % IT_G, kb = q / 22, nb = q % 22;
            const float* src = arg_in(a, up ? I_WUP : I_WGATE) + ((size_t)l * NEXP + e) * DM * EFF;
            RmGateUp rm; rm.up = up;
            transpose_item_fp8(src, EFF, wgu + (size_t)e * 2816 * DM, DM, kb * 64, nb * 64, 64.f, rm, scr, F.lane); continue; } r -= 2 * IT_G;
        { const int kb = r / 32, nb = r % 32;
            transpose_item_fp8(arg_in(a, I_WDOWN) + ((size_t)l * NEXP + e) * EFF * DM, DM, wd + (size_t)e * DM * EFFP, EFFP, kb * 64, nb * 64, 64.f, RmId(), scr, F.lane); }
    }
    for (int i = F.bid * NTHREADS + F.tid; i < NEXP * DM * 8; i += F.G * NTHREADS) { const int rowi = i >> 3, q = i & 7; unsigned zz = 0u; asm volatile("" : "+v"(zz));
        *(u32x4*)(wd + (size_t)rowi * EFFP + EFF + q * 16) = (u32x4){zz, zz, zz, zz}; }
}
__device__ __forceinline__ void p0_mod(Frame& F, const Args& a) {
    LAS float* sv = (LAS float*)(F.lds + 69632);
    for (int i = F.tid; i < 3 * DM; i += NTHREADS) { const int v = i / DM, k = i % DM; const float x = v < 2 ? arg_in(a, I_C)[v * DM + k] : arg_in(a, I_CCTX)[k]; sv[i] = siluf_(x); }
    __syncthreads();
    float* mod = (float*)(F.ws + WS_CTL) + CW_MOD;
    LAS float* red = (LAS float*)(F.lds + 69632 + 3 * DM * 4);
    for (int u = F.bid; u < DEPTH * (6 * DM / 128); u += F.G) {
        const int l = u / (6 * DM / 128), nb = u % (6 * DM / 128); const int kg = F.tid >> 7, cl = F.tid & 127, n = nb * 128 + cl;
        const float* w = arg_in(a, I_WADA) + ((size_t)l * DM + kg * 512) * (6 * DM) + n;
        float a0 = 0.f, a1 = 0.f, a2 = 0.f;
#pragma unroll 32
        for (int k = 0; k < 512; ++k) { const float wv = w[(size_t)k * (6 * DM)]; const int kk = kg * 512 + k; a0 += sv[kk] * wv; a1 += sv[DM + kk] * wv; a2 += sv[2 * DM + kk] * wv; }
        __syncthreads();
        red[(kg * 3 + 0) * 128 + cl] = a0; red[(kg * 3 + 1) * 128 + cl] = a1; red[(kg * 3 + 2) * 128 + cl] = a2;
        __syncthreads();
        if (F.tid < 384) { const int v = F.tid >> 7; const float b = arg_in(a, I_BADA)[l * 6 * DM + n];
            mod[(l * 3 + v) * 6 * DM + n] = b + ((red[(0 * 3 + v) * 128 + cl] + red[(1 * 3 + v) * 128 + cl]) + (red[(2 * 3 + v) * 128 + cl] + red[(3 * 3 + v) * 128 + cl])); }
    }
}

__device__ __forceinline__ void row_stats(const f32x4 (&v)[8], float& mean, float& rstd, float eps) {
    float s = 0.f;
#pragma unroll
    for (int j = 0; j < 8; ++j) s += (v[j].x + v[j].y) + (v[j].z + v[j].w);
    mean = wave_sum(s) * (1.f / DM);
    float s2 = 0.f;
#pragma unroll
    for (int j = 0; j < 8; ++j) { const f32x4 d = v[j] - mean; s2 += (d.x * d.x + d.y * d.y) + (d.z * d.z + d.w * d.w); }
    rstd = 1.f / sqrtf(wave_sum(s2) * (1.f / DM) + eps);
}
__device__ __forceinline__ const float* x_src_row(const Args& a, const Frame& F, int layer, int row) {
    if (layer == 0) return row < TC ? arg_in(a, I_CTX) + (size_t)row * DM : arg_in(a, I_X) + (size_t)(row - TC) * DM;
    return (const float*)(F.ws + WS_XS) + (size_t)row * DM;
}
__device__ __forceinline__ void phase_modln(Frame& F, const Args& a, int layer) {
    const float* mod = (const float*)(F.ws + WS_CTL) + CW_MOD + (size_t)layer * 3 * 6 * DM;
    bf16_t* H = WSP(bf16_t, WS_H); unsigned* H8 = WSP(unsigned, WS_H8);
    for (int row = F.gw; row < T; row += F.NGW) {
        const f32x4* xr = (const f32x4*)x_src_row(a, F, layer, row) + F.lane;
        f32x4 v[8];
#pragma unroll
        for (int j = 0; j < 8; ++j) v[j] = xr[64 * j];
        float mean, rstd; row_stats(v, mean, rstd, 1e-6f);
        const float* m = mod + (size_t)row_modidx(row) * 6 * DM;
        u32x2* o = (u32x2*)(H + (size_t)row * DM) + F.lane; unsigned* o8 = H8 + (size_t)row * (DM / 4) + F.lane;
#pragma unroll
        for (int j = 0; j < 8; ++j) { const int c = 4 * (64 * j + F.lane); const f32x4 sh = *(const f32x4*)(m + c), sc = *(const f32x4*)(m + DM + c);
            const f32x4 y = (v[j] - mean) * rstd * (sc + 1.f) + sh; u32x2 w; w.x = pk2(y.x, y.y); w.y = pk2(y.z, y.w); o[64 * j] = w; o8[64 * j] = pk4fp8(y.x, y.y, y.z, y.w); }
    }
}

__device__ __forceinline__ void phase_hdn(Frame& F, const Args& a, int layer) {
    LAS float* zs = (LAS float*)(F.lds + F.wave * 512);
    const float* w1 = arg_in(a, I_HW1) + (size_t)layer * 33 * 64; const float* b1 = arg_in(a, I_HB1) + layer * 64;
    const float* w2 = arg_in(a, I_HW2) + (size_t)layer * 64 * 64; const float* b2 = arg_in(a, I_HB2) + layer * 64;
    const float fr = arg_in(a, I_HFREQ)[layer * 64 + F.lane];
    float* HDN = WSP(float, WS_HDN + layer * SZ_HDN1);
    for (int r = F.gw; r < SEQ + CTX; r += F.NGW) {
        const int n = r < SEQ ? SEQ : CTX, t = r < SEQ ? r : r - SEQ;
        const float wpos = (6.283185307179586f * (float)t) / (float)n;
        if (F.lane < 33) { float z;
            if (F.lane == 0) z = (float)t / (float)(n - 1);
            else { const int b = (F.lane - 1) & 15; const float f = 1e-4f + (float)b * ((15.f - 1e-4f) / 15.f); const float ang = f * wpos; z = F.lane <= 16 ? __cosf(ang) : -__sinf(ang); }
            zs[F.lane] = z; }
        LDS_WAIT(); asm volatile("" ::: "memory");
        float p = b1[F.lane];
#pragma unroll
        for (int i = 0; i < 33; ++i) p += zs[i] * w1[i * 64 + F.lane];
        const float h1 = __sinf(fr * p);
        zs[64 + F.lane] = h1;
        LDS_WAIT(); asm volatile("" ::: "memory");
        float q = b2[F.lane];
#pragma unroll 16
        for (int i = 0; i < 64; ++i) q += zs[64 + i] * w2[i * 64 + F.lane];
        HDN[(size_t)r * 64 + F.lane] = __sinf(fr * q);
        LDS_WAIT(); asm volatile("" ::: "memory");
    }
}
__device__ __forceinline__ float hy_delta(int c) { const float mn = -3.0701134573253943f, mx = -15.350567286626972f; return fabsf(mn + (float)c * ((mx - mn) / 1023.f)); }
__device__ __forceinline__ void phase_filt(Frame& F, const Args& a, int layer) {
    const float* w3 = arg_in(a, I_HW3) + (size_t)layer * 64 * 2048; const float* HDN = WSP(float, WS_HDN + layer * SZ_HDN1);
    LAS float* ws3 = (LAS float*)F.lds;
    bf16_t* FILT = WSP(bf16_t, WS_FILT);
    for (int u = F.bid; u < 32 * 16; u += F.G) {
        const int cb = u / 16, tb = u % 16, col0 = cb * 64, t = tb * 512 + F.tid;
        __syncthreads();
        for (int i = F.tid; i < 4096; i += NTHREADS) { const int j = i >> 6, cc = i & 63; ws3[cc * 64 + j] = w3[(size_t)j * 2048 + col0 + cc]; }
        __syncthreads();
        f32x4 h[16];
#pragma unroll
        for (int i = 0; i < 16; ++i) h[i] = *(const f32x4*)(HDN + (size_t)t * 64 + 4 * i);
        const float tn = (float)t / (float)(SEQ - 1);
        for (int cc = 0; cc < 64; ++cc) {
            float acc = 0.f;
#pragma unroll
            for (int i = 0; i < 16; ++i) { const f32x4 w = *(const LAS f32x4*)(ws3 + cc * 64 + 4 * i); acc += h[i].x * w.x + h[i].y * w.y + h[i].z * w.z + h[i].w * w.w; }
            const int col = col0 + cc, side = col >> 10, c = col & 1023;
            FILT[((size_t)c * 2 + side) * SEQ + t] = (bf16_t)f2bf(acc * __expf(-tn * hy_delta(c)));
        }
    }
    float* FILTC = WSP(float, WS_FILTC);
    for (int e = F.bid * NTHREADS + F.tid; e < CTX * 2048; e += F.G * NTHREADS) {
        const int lag = e >> 11, col = e & 2047, c = col & 1023; const float* hr = HDN + (size_t)(SEQ + lag) * 64; float acc = 0.f;
#pragma unroll 16
        for (int j = 0; j < 64; ++j) acc += hr[j] * w3[(size_t)j * 2048 + col];
        FILTC[e] = acc * __expf(-((float)lag / (float)(CTX - 1)) * hy_delta(c));
    }
}

__device__ __forceinline__ void ld8bf(const bf16_t* p, float (&o)[8]) { const u32x4 w = *(const u32x4*)p; o[0] = bflo(w.x); o[1] = bfhi(w.x); o[2] = bflo(w.y); o[3] = bfhi(w.y); o[4] = bflo(w.z); o[5] = bfhi(w.z); o[6] = bflo(w.w); o[7] = bfhi(w.w); }
__device__ __forceinline__ void up8(const u32x4 w, float (&o)[8]) { o[0] = bflo(w.x); o[1] = bfhi(w.x); o[2] = bflo(w.y); o[3] = bfhi(w.y); o[4] = bflo(w.z); o[5] = bfhi(w.z); o[6] = bflo(w.w); o[7] = bfhi(w.w); }
__device__ __forceinline__ void st8bf(bf16_t* p, const float (&v)[8]) { u32x4 w; w.x = pk2(v[0], v[1]); w.y = pk2(v[2], v[3]); w.z = pk2(v[4], v[5]); w.w = pk2(v[6], v[7]); *(u32x4*)p = w; }
__device__ __forceinline__ void ld8f(const float* p, float (&o)[8]) { const f32x4 a = *(const f32x4*)p, b = *(const f32x4*)(p + 4); o[0] = a.x; o[1] = a.y; o[2] = a.z; o[3] = a.w; o[4] = b.x; o[5] = b.y; o[6] = b.z; o[7] = b.w; }

constexpr int PREP_RUN = 16;
__device__ __forceinline__ void phase_prep(Frame& F, const Args& a, int layer) {
    const bf16_t* P = WSP(bf16_t, WS_P); bf16_t* P2 = WSP(bf16_t, WS_P2);
    float* RS = WSP(float, WS_RS); bf16_t* KPE = WSP(bf16_t, WS_KPE); float* DT = WSP(float, WS_DT);
    bf16_t* KK = WSP(bf16_t, WS_KK); bf16_t* AL_ = WSP(bf16_t, WS_ALORA); float* VC = WSP(float, WS_VC);
    const float* scw = arg_in(a, I_SCONVW) + (size_t)layer * 3 * 1536; const float* scb = arg_in(a, I_SCONVB) + layer * 1536; const float* dtb = arg_in(a, I_SDTB) + layer * 32;
    const float* hcw = arg_in(a, I_HCONVW) + (size_t)layer * 3 * 3072; const float* hcb = arg_in(a, I_HCONVB) + layer * 3072;
    const float* mu = arg_in(a, I_RMU) + (size_t)layer * 2 * 3488; const float* rkk = arg_in(a, I_RKK) + layer * 1024;
    const int lane = F.lane;
    for (int item = F.gw; item < (T / PREP_RUN) * 13; item += F.NGW) {
        const int run = item / 13, ct = item % 13; const int r0 = run * PREP_RUN;
        if (ct == 0) {
#pragma unroll 1
        for (int rr = 0; rr < PREP_RUN; ++rr) { const int row = r0 + rr; const bf16_t* pr = P + (size_t)row * NNG;
            float x[8]; ld8bf(pr + P_CQ + lane * 8, x); float s = 0.f;
#pragma unroll
            for (int i = 0; i < 8; ++i) s += x[i] * x[i];
            s = wave_sum(s); const float rq = 1.f / sqrtf(s * (1.f / 512.f) + 1e-6f);
            ld8bf(pr + P_CKV + lane * 8, x); s = 0.f;
#pragma unroll
            for (int i = 0; i < 8; ++i) s += x[i] * x[i];
            s = wave_sum(s); const float rk = 1.f / sqrtf(s * (1.f / 512.f) + 1e-6f);
            if (lane == 0) { RS[row * 2] = rq; RS[row * 2 + 1] = rk; }
            float kv = bf2f(pr[P_KPE + lane]);
            const float other = swz16(kv);
            if (row >= TC) { const int t = (row - TC) & (SEQ - 1); const int axis = lane >> 5, half = (lane >> 4) & 1, j = lane & 15;
                const float pos = (float)(axis == 0 ? (t >> 6) : (t & 63)); const float inv = __builtin_amdgcn_exp2f(-(float)j * 0.8304820237218406f);
                const float sn = __sinf(pos * inv), cs = __cosf(pos * inv);
                kv = half == 0 ? kv * cs - other * sn : kv * cs + other * sn; }
            KPE[(size_t)row * 64 + lane] = (bf16_t)f2bf(kv);
            if (lane < 32) DT[(size_t)row * 32 + lane] = softplusf_(bf2f(pr[P_DT + lane]) + dtb[lane]); }
        continue; }
        const bool first = row_first(r0), last = row_last(r0 + PREP_RUN - 1);
        if (ct >= 1 && ct <= 3) { const int ch = ct - 1; const int c = ch * 512 + lane * 8; float xm[8], x0[8], xp[8], w0[8], w1[8], w2[8], bb[8];
            ld8f(scw + c, w0); ld8f(scw + 1536 + c, w1); ld8f(scw + 3072 + c, w2); ld8f(scb + c, bb);
            const bf16_t* pc = P + (size_t)r0 * NNG + P_XBC + c;
            u32x4 raw[PREP_RUN + 2];
#pragma unroll
            for (int rr = 0; rr < PREP_RUN + 2; ++rr) { const bool ok = (rr > 0 || !first) && (rr < PREP_RUN + 1 || !last); raw[rr] = ok ? *(const u32x4*)(pc + (ptrdiff_t)(rr - 1) * NNG) : (u32x4){0u, 0u, 0u, 0u}; }
            up8(raw[0], xm); up8(raw[1], x0);
#pragma unroll
            for (int rr = 0; rr < PREP_RUN; ++rr) {
                up8(raw[rr + 2], xp);
                float o[8];
#pragma unroll
                for (int i = 0; i < 8; ++i) { o[i] = siluf_(xm[i] * w0[i] + x0[i] * w1[i] + xp[i] * w2[i] + bb[i]); xm[i] = x0[i]; x0[i] = xp[i]; }
                st8bf(P2 + (size_t)(r0 + rr) * P2W + P2_XBC + c, o); } continue; }
        if (ct >= 4 && ct <= 5) { const int ch = ct - 4; { const int c = ch * 512 + lane * 8; float xm[8], x0[8], xp[8], w0[8], w1[8], w2[8], bb[8];
            ld8f(hcw + c, w0); ld8f(hcw + 3072 + c, w1); ld8f(hcw + 6144 + c, w2); ld8f(hcb + c, bb);
            const bf16_t* pc = P + (size_t)r0 * NNG + P_HY + c;
            u32x4 raw[PREP_RUN + 2];
#pragma unroll
            for (int rr = 0; rr < PREP_RUN + 2; ++rr) { const bool ok = (rr > 0 || !first) && (rr < PREP_RUN + 1 || !last); raw[rr] = ok ? *(const u32x4*)(pc + (ptrdiff_t)(rr - 1) * NNG) : (u32x4){0u, 0u, 0u, 0u}; }
            up8(raw[0], xm); up8(raw[1], x0);
#pragma unroll
            for (int rr = 0; rr < PREP_RUN; ++rr) {
                up8(raw[rr + 2], xp);
                float o[8];
#pragma unroll
                for (int i = 0; i < 8; ++i) { o[i] = xm[i] * w0[i] + x0[i] * w1[i] + xp[i] * w2[i] + bb[i]; xm[i] = x0[i]; x0[i] = xp[i]; }
                st8bf(P2 + (size_t)(r0 + rr) * P2W + P2_X0 + c, o); } }
        if (r0 < TC) {
#pragma unroll 1
                for (int rr = 0; rr < PREP_RUN; ++rr) { const int row = r0 + rr; const bool f1 = row_first(row), l1 = row_last(row); const int c = ch * 512 + lane * 8;
                    const bf16_t* pr = P + (size_t)row * NNG; float o1[8], o2[8];
#pragma unroll
                    for (int part = 1; part < 3; ++part) { float x0[8], xm[8], xp[8], w0[8], w1[8], w2[8], bb[8]; const int cc = part * 1024 + c;
                        ld8bf(pr + P_HY + cc, x0);
                        if (!f1) ld8bf(pr - NNG + P_HY + cc, xm); else { for (int i = 0; i < 8; ++i) xm[i] = 0.f; }
                        if (!l1) ld8bf(pr + NNG + P_HY + cc, xp); else { for (int i = 0; i < 8; ++i) xp[i] = 0.f; }
                        ld8f(hcw + cc, w0); ld8f(hcw + 3072 + cc, w1); ld8f(hcw + 6144 + cc, w2); ld8f(hcb + cc, bb);
#pragma unroll
                        for (int i = 0; i < 8; ++i) { const float r = xm[i] * w0[i] + x0[i] * w1[i] + xp[i] * w2[i] + bb[i]; if (part == 1) o1[i] = r; else o2[i] = r; } }
                    float* vc = VC + (size_t)row * 1024 + c;
                    *(f32x4*)vc = (f32x4){o1[0] * o2[0], o1[1] * o2[1], o1[2] * o2[2], o1[3] * o2[3]};
                    *(f32x4*)(vc + 4) = (f32x4){o1[4] * o2[4], o1[5] * o2[5], o1[6] * o2[6], o1[7] * o2[7]}; } }
        continue; }
        { const int ch = ct - 6; const int c = ch * 512 + lane * 8;
            if (c < 3488) { float um[8], u0[8], up[8], m0[8], m1[8], g8[8];
                ld8f(mu + c, m0); ld8f(mu + 3488 + c, m1);
                if (ch == 2 || ch == 3) ld8f(rkk + (c - 1024), g8);
                const bf16_t* pc = P + (size_t)r0 * NNG + P_RW + c;
                u32x4 raw[PREP_RUN + 2];
#pragma unroll
                for (int rr = 0; rr < PREP_RUN + 2; ++rr) { const bool ok = (rr > 0 || !first) && (rr < PREP_RUN + 1 || !last); raw[rr] = ok ? *(const u32x4*)(pc + (ptrdiff_t)(rr - 1) * NNG) : (u32x4){0u, 0u, 0u, 0u}; }
                up8(raw[0], um); up8(raw[1], u0);
#pragma unroll
                for (int rr = 0; rr < PREP_RUN; ++rr) { const int row = r0 + rr;
                    up8(raw[rr + 2], up);
                    float us[8];
#pragma unroll
                    for (int i = 0; i < 8; ++i) { us[i] = u0[i] + m0[i] * (um[i] - u0[i]) + m1[i] * (up[i] - u0[i]); um[i] = u0[i]; u0[i] = up[i]; }
                    if (ch < 6) st8bf(P2 + (size_t)row * P2W + P2_RKV + c, us);
                    if (ch == 2 || ch == 3) { float kx[8]; float s = 0.f;
#pragma unroll
                        for (int i = 0; i < 8; ++i) { kx[i] = us[i] * g8[i]; s += kx[i] * kx[i]; }
                        s = sum8(s);
                        const float inv = 1.f / fmaxf(sqrtf(s), 1e-12f);
#pragma unroll
                        for (int i = 0; i < 8; ++i) kx[i] *= inv;
                        st8bf(KK + (size_t)row * 1024 + (c - 1024), kx); }
                    if (ch == 6) { const int cl = c - 3072; float o[8];
#pragma unroll
                        for (int i = 0; i < 8; ++i) o[i] = cl < 128 ? tanhf_(us[i]) : cl < 256 ? us[i] : sigmoidf_(us[i]);
                        st8bf(AL_ + (size_t)row * 512 + cl, o); } } }
            else if (ch == 6) { const int cl = c - 3072;
                for (int rr = 0; rr < PREP_RUN; ++rr) { float zz = 0.f; asm volatile("" : "+v"(zz)); float o[8] = {zz, zz, zz, zz, zz, zz, zz, zz}; st8bf(AL_ + (size_t)(r0 + rr) * 512 + cl, o); } } }
    }
    float* VT = WSP(float, WS_VT);
    LAS float* tl = (LAS float*)F.lds;
    for (int u = F.bid; u < (TL / 64) * 4; u += F.G) {
        const int tb = u >> 2, cb = u & 3; const int row0 = TC + tb * 64; const int c8 = (F.tid & 31) * 8, c = cb * 256 + c8, tq = F.tid >> 5;
        float w1[3][8], w2[3][8], b1[8], b2[8];
#pragma unroll
        for (int k = 0; k < 3; ++k) { ld8f(hcw + k * 3072 + 1024 + c, w1[k]); ld8f(hcw + k * 3072 + 2048 + c, w2[k]); }
        ld8f(hcb + 1024 + c, b1); ld8f(hcb + 2048 + c, b2);
        __syncthreads();
#pragma unroll 1
        for (int i = 0; i < 4; ++i) { const int tl_ = tq * 4 + i, row = row0 + tl_; const bf16_t* pr = P + (size_t)row * NNG + P_HY;
            const bool first = row_first(row), last = row_last(row);
            float a1[8], a2[8], x[8];
            ld8bf(pr + 1024 + c, x);
#pragma unroll
            for (int j = 0; j < 8; ++j) a1[j] = x[j] * w1[1][j] + b1[j];
            ld8bf(pr + 2048 + c, x);
#pragma unroll
            for (int j = 0; j < 8; ++j) a2[j] = x[j] * w2[1][j] + b2[j];
            if (!first) { ld8bf(pr - NNG + 1024 + c, x);
#pragma unroll
                for (int j = 0; j < 8; ++j) a1[j] += x[j] * w1[0][j];
                ld8bf(pr - NNG + 2048 + c, x);
#pragma unroll
                for (int j = 0; j < 8; ++j) a2[j] += x[j] * w2[0][j]; }
            if (!last) { ld8bf(pr + NNG + 1024 + c, x);
#pragma unroll
                for (int j = 0; j < 8; ++j) a1[j] += x[j] * w1[2][j];
                ld8bf(pr + NNG + 2048 + c, x);
#pragma unroll
                for (int j = 0; j < 8; ++j) a2[j] += x[j] * w2[2][j]; }
#pragma unroll
            for (int j = 0; j < 8; ++j) tl[(c8 + j) * 65 + tl_] = a1[j] * a2[j]; }
        __syncthreads();
        const int b = (row0 - TC) >> 13, t0 = (row0 - TC) & (SEQ - 1);
        for (int p_ = 0; p_ < 8; ++p_) { const int cl = p_ * 32 + (F.tid >> 4), q = F.tid & 15;
            const f32x4 o = {tl[cl * 65 + 4 * q], tl[cl * 65 + 4 * q + 1], tl[cl * 65 + 4 * q + 2], tl[cl * 65 + 4 * q + 3]};
            *(f32x4*)(VT + ((size_t)(cb * 256 + cl) * 2 + b) * SEQ + t0 + 4 * q) = o; }
    }
}

using pg8::Unit;
#define EPI_LOOP_BEGIN const int row0 = u.pm * 256 + wr * 64 + fr; \
    _Pragma("unroll") for (int ai = 0; ai < 2; ++ai) _Pragma("unroll") for (int m = 0; m < 4; ++m) { const int row = row0 + ai * 128 + m * 16; \
    _Pragma("unroll") for (int bj = 0; bj < 2; ++bj) { const int cl = bj * 128 + wc * 32 + 8 * fq; const f32x4 v0 = acc[ai][bj][m][0], v1 = acc[ai][bj][m][1];
#define EPI_LOOP_END } __builtin_amdgcn_sched_barrier(0); }
struct EpiBf16 {
    static constexpr bool PERM = true, KEEPS = false;
    bf16_t* O; int ldc; const float* rscale; int rs_stride; int act; float cscale; int pn_from, pn_add;
    __device__ __forceinline__ void operator()(const f32x4 (&acc)[2][2][4][2], const Unit& u, int wr, int wc, int fr, int fq) const {
        EPI_LOOP_BEGIN
            const float s = rscale ? rscale[(size_t)row * rs_stride] : cscale;
            float x[8] = {v0.x * s, v0.y * s, v0.z * s, v0.w * s, v1.x * s, v1.y * s, v1.z * s, v1.w * s};
            if (act == 1) {
#pragma unroll
                for (int i = 0; i < 8; ++i) x[i] = sigmoidf_(x[i]); }
            u32x4 w; w.x = cvt_pk_bf16(x[0], x[1]); w.y = cvt_pk_bf16(x[2], x[3]); w.z = cvt_pk_bf16(x[4], x[5]); w.w = cvt_pk_bf16(x[6], x[7]);
            *(u32x4*)(O + (size_t)row * ldc + (u.pn + (u.pn >= pn_from ? pn_add : 0)) * 256 + cl) = w;
        EPI_LOOP_END
    }
};
struct EpiLora {
    static constexpr bool PERM = true, KEEPS = false;
    bf16_t* EW; bf16_t* ICLR; bf16_t* GG; const float* w0; const float* a0;
    __device__ __forceinline__ void operator()(const f32x4 (&acc)[2][2][4][2], const Unit& u, int wr, int wc, int fr, int fq) const {
        const int blk = u.pn >> 2, cb = (u.pn & 3) * 256;
        const float* bias = blk < 2 ? w0 + blk * 1024 : a0 + (blk & 1) * 1024;
        bf16_t* dbase = blk < 2 ? EW + (size_t)blk * T * 1024 : blk < 4 ? ICLR + (size_t)(blk - 2) * T * 1024 : GG;
        const float scale = blk < 2 ? 0.6065306597126334f : 1.f; const bool sig = blk < 4;
        f32x4 bia[2][2];
#pragma unroll
        for (int bj = 0; bj < 2; ++bj) { const int c = cb + bj * 128 + wc * 32 + 8 * fq; bia[bj][0] = *(const f32x4*)(bias + c); bia[bj][1] = *(const f32x4*)(bias + c + 4); }
        EPI_LOOP_BEGIN
            const int c = cb + cl; float x[8] = {v0.x, v0.y, v0.z, v0.w, v1.x, v1.y, v1.z, v1.w};
            if (sig) { const f32x4 b0 = bia[bj][0], b1 = bia[bj][1]; const float bb[8] = {b0.x, b0.y, b0.z, b0.w, b1.x, b1.y, b1.z, b1.w};
#pragma unroll
                for (int i = 0; i < 8; ++i) x[i] = scale * sigmoidf_(bb[i] + x[i]); }
            u32x4 w; w.x = cvt_pk_bf16(x[0], x[1]); w.y = cvt_pk_bf16(x[2], x[3]); w.z = cvt_pk_bf16(x[4], x[5]); w.w = cvt_pk_bf16(x[6], x[7]);
            *(u32x4*)(dbase + (size_t)row * 1024 + c) = w;
        EPI_LOOP_END
    }
};
struct EpiMerge {
    static constexpr bool PERM = true, KEEPS = true;
    const bf16_t* gates; bf16_t* MB;
    __device__ __forceinline__ bool operator()(f32x4 (&acc)[2][2][4][2], const Unit& uu, int wr, int wc, int fr, int fq) const {
        const int br = uu.pn >> 3; Unit u; u.pm = uu.pm - br * 66; u.pn = uu.pn & 7;
        const int row0 = u.pm * 256 + wr * 64 + fr, col0 = u.pn * 256 + wc * 32 + 8 * fq; const bool last = br == 3;
        const bf16_t* gcur = gates + br * DM + col0; const bf16_t* gnxt = gates + (last ? br : br + 1) * DM + col0;
        u32x4 gq[2], hq[2], gn[2], hn[2];
#define EM_ROW(it_) ((size_t)(row0 + ((it_) >> 2) * 128 + ((it_) & 3) * 16))
#pragma unroll
        for (int bj = 0; bj < 2; ++bj) { gq[bj] = *(const u32x4*)(gcur + EM_ROW(0) * NGATE + bj * 128); hq[bj] = *(const u32x4*)(gnxt + EM_ROW(0) * NGATE + bj * 128); }
#pragma unroll
        for (int it = 0; it < 8; ++it) { const int ai = it >> 2, m = it & 3;
            if (it < 7) {
#pragma unroll
                for (int bj = 0; bj < 2; ++bj) { gn[bj] = *(const u32x4*)(gcur + EM_ROW(it + 1) * NGATE + bj * 128); hn[bj] = *(const u32x4*)(gnxt + EM_ROW(it + 1) * NGATE + bj * 128); } }
#pragma unroll
            for (int bj = 0; bj < 2; ++bj) { float g[8], hh[8]; up8(gq[bj], g); up8(hq[bj], hh); float f[8];
#pragma unroll
                for (int i = 0; i < 8; ++i) { const float ea = __expf(-g[i]), eb = __expf(-hh[i]); f[i] = last ? 1.f / (1.f + ea) : (1.f + eb) / (1.f + ea); }
                f32x4& v0 = acc[ai][bj][m][0]; f32x4& v1 = acc[ai][bj][m][1];
                v0 = v0 * (f32x4){f[0], f[1], f[2], f[3]}; v1 = v1 * (f32x4){f[4], f[5], f[6], f[7]};
                if (last) { u32x4 w; w.x = cvt_pk_bf16(v0.x, v0.y); w.y = cvt_pk_bf16(v0.z, v0.w); w.z = cvt_pk_bf16(v1.x, v1.y); w.w = cvt_pk_bf16(v1.z, v1.w);
                    *(u32x4*)(MB + EM_ROW(it) * DM + col0 + bj * 128) = w; } }
            gq[0] = gn[0]; gq[1] = gn[1]; hq[0] = hn[0]; hq[1] = hn[1];
            __builtin_amdgcn_sched_barrier(0); }
#undef EM_ROW
        return !last;
    }
};
struct OrderMerge {
    pg8::StaticOrder so;
    __device__ void init(int G, int c, int nM, int pm0) { so.init(nM, 8, G, c, pm0); }
    __device__ bool next(int i, Unit& u) const { Unit t; if (!so.next(i >> 2, t)) return false; const int br = i & 3; u.pm = br * 66 + t.pm; u.pn = br * 8 + t.pn; return true; }
};
struct EpiF32 {
    static constexpr bool PERM = true, KEEPS = false;
    float* O; int ldc;
    __device__ __forceinline__ void operator()(const f32x4 (&acc)[2][2][4][2], const Unit& u, int wr, int wc, int fr, int fq) const {
        EPI_LOOP_BEGIN
            float* o = O + (size_t)row * ldc + u.pn * 256 + cl; *(f32x4*)o = v0; *(f32x4*)(o + 4) = v1;
        EPI_LOOP_END
    }
};
__device__ __forceinline__ int moe_panel(int e, int pi) { return pi < 8 ? (((pi >> 2) * NEXP + e) * 4 + (pi & 3)) : 128 + e; }
struct OrderMoe {
    int npn, G, c, npan;
    __device__ void init(int npn_, int G_, int c_, int npan_) { npn = npn_; G = G_; c = c_; npan = npan_; }
    __device__ bool next(int i, Unit& u) const { const int per = npan * npn;
        if ((G & 7) == 0 && G >= 8) { const int xcd = c & 7, wx = G >> 3, r = c >> 3; const int Lx = i * wx + r; if (Lx >= 2 * per) return false;
            const int e = xcd + 8 * (Lx / per), rem = Lx % per, j = rem / npan, pi = rem % npan; u.pm = moe_panel(e, pi); u.pn = e * npn + j; return true; }
        const int L = i * G + c; if (L >= NEXP * per) return false;
        const int e = L / per, r = L % per, j = r / npan, pi = r % npan; u.pm = moe_panel(e, pi); u.pn = e * npn + j; return true; }
};
struct EpiSwiglu {
    static constexpr bool PERM = true, KEEPS = false;
    unsigned char* HID;
    __device__ __forceinline__ void operator()(const f32x4 (&acc)[2][2][4][2], const Unit& u, int wr, int wc, int fr, int fq) const {
        const int j = u.pn % 11; const int row0 = u.pm * 256 + wr * 64 + fr; const float sc = 1.f / 64.f;
#pragma unroll
        for (int ai = 0; ai < 2; ++ai)
#pragma unroll
            for (int m = 0; m < 4; ++m) { const int row = row0 + ai * 128 + m * 16;
                const f32x4 g0 = acc[ai][0][m][0] * sc, g1 = acc[ai][0][m][1] * sc, u0 = acc[ai][1][m][0] * sc, u1 = acc[ai][1][m][1] * sc;
                u32x2 w; w.x = pk4fp8(siluf_(g0.x) * u0.x, siluf_(g0.y) * u0.y, siluf_(g0.z) * u0.z, siluf_(g0.w) * u0.w);
                w.y = pk4fp8(siluf_(g1.x) * u1.x, siluf_(g1.y) * u1.y, siluf_(g1.z) * u1.z, siluf_(g1.w) * u1.w);
                *(u32x2*)(HID + (size_t)row * EFFP + j * 128 + wc * 32 + 8 * fq) = w; __builtin_amdgcn_sched_barrier(0); }
    }
};
struct EpiDown {
    static constexpr bool PERM = true, KEEPS = false;
    bf16_t* YE;
    __device__ __forceinline__ void operator()(const f32x4 (&acc)[2][2][4][2], const Unit& uu, int wr, int wc, int fr, int fq) const {
        Unit u; u.pm = uu.pm; u.pn = uu.pn & 7; const float s = 1.f / 64.f;
        EPI_LOOP_BEGIN
            u32x4 w; w.x = cvt_pk_bf16(v0.x * s, v0.y * s); w.y = cvt_pk_bf16(v0.z * s, v0.w * s); w.z = cvt_pk_bf16(v1.x * s, v1.y * s); w.w = cvt_pk_bf16(v1.z * s, v1.w * s);
            *(u32x4*)(YE + (size_t)row * DM + u.pn * 256 + cl) = w;
        EPI_LOOP_END
    }
};

namespace att {
using s16x4 = __attribute__((ext_vector_type(4))) short;
using f32x16 = __attribute__((ext_vector_type(16))) float;
constexpr int NW = 8, QBLK = 32, KVBLK = 64, LDQ = 1536, LDKV = 2048, LDO = 1024;
constexpr float SCALE = 0.07216878364870322f;
constexpr float THR = 8.f;
#ifndef ATT_SDEPTH
#define ATT_SDEPTH 1
#endif
constexpr int SDEPTH = ATT_SDEPTH;
constexpr int SHM_V = KVBLK * 128 * 2, SHM_K = KVBLK * 128 * 2, SHM_KP = KVBLK * 64 * 2;
constexpr int OFF_V = 0, OFF_K = 2 * SHM_V, OFF_KP = OFF_K + 2 * SHM_K, OFF_WS = OFF_KP + 2 * SHM_KP, OFF_QP = OFF_WS + NW * 64 * 4, SHM_ATTN = OFF_QP + 256 * 256;
static_assert(SHM_ATTN <= 150 * 1024, "attention LDS");
#define KSWZ(row, colB) ((row) * 256 + ((colB) ^ (((row) & 7) << 4)))
#define KPSWZ(row, colB) ((row) * 128 + ((colB) ^ (((row) & 7) << 4)))
#define SBAR() __builtin_amdgcn_sched_barrier(0)
__device__ __forceinline__ int crow(int r, int hi) { return (r & 3) + 8 * (r >> 2) + 4 * hi; }
__device__ __forceinline__ void partialSM(f32x16& p0, f32x16& p1, float& m_reg, float& mn, float& alpha) {
  constexpr float C = SCALE * 1.4426950408889634f;
  float pmax = p0[0]; for (int r = 1; r < 16; ++r) pmax = fmaxf(pmax, p0[r]); for (int r = 0; r < 16; ++r) pmax = fmaxf(pmax, p1[r]);
  { auto rr = __builtin_amdgcn_permlane32_swap(__float_as_uint(pmax), __float_as_uint(pmax), false, false);
    pmax = fmaxf(__uint_as_float(rr[0]), __uint_as_float(rr[1])); }
  if (__builtin_expect(__all(pmax - m_reg <= THR / SCALE), 1)) { mn = m_reg; alpha = 1.f; }
  else { mn = fmaxf(m_reg, pmax); alpha = __builtin_amdgcn_exp2f((m_reg - mn) * C); m_reg = mn; }
  float mnC = -mn * C;
  for (int r = 0; r < 16; ++r) p0[r] = fmaf(p0[r], C, mnC); for (int r = 0; r < 16; ++r) p1[r] = fmaf(p1[r], C, mnC);
  for (int r = 0; r < 16; ++r) p0[r] = __builtin_amdgcn_exp2f(p0[r]);
}
__device__ __forceinline__ void finishSM(f32x16& p0, f32x16& p1, float alpha, float& l_reg, bf16x8& pa0, bf16x8& pa1, bf16x8& pa2, bf16x8& pa3) {
  for (int r = 0; r < 16; ++r) p1[r] = __builtin_amdgcn_exp2f(p1[r]);
  float ps = 0; for (int r = 0; r < 16; ++r) ps += p0[r]; for (int r = 0; r < 16; ++r) ps += p1[r];
  { auto rr = __builtin_amdgcn_permlane32_swap(__float_as_uint(ps), __float_as_uint(ps), false, false);
    ps = __uint_as_float(rr[0]) + __uint_as_float(rr[1]); }
  l_reg = l_reg * alpha + ps;
#define PK4(P, BASE, OUT) do { unsigned a0 = cvt_pk_bf16(P[BASE + 0], P[BASE + 1]), a1 = cvt_pk_bf16(P[BASE + 2], P[BASE + 3]);   \
    unsigned b0 = cvt_pk_bf16(P[BASE + 4], P[BASE + 5]), b1 = cvt_pk_bf16(P[BASE + 6], P[BASE + 7]);                              \
    auto r0 = __builtin_amdgcn_permlane32_swap(a0, b0, false, false); auto r1 = __builtin_amdgcn_permlane32_swap(a1, b1, false, false); \
    u32x4 w = {r0[0], r1[0], r0[1], r1[1]}; OUT = *reinterpret_cast<bf16x8*>(&w); } while (0)
  PK4(p0, 0, pa0); PK4(p0, 8, pa1); PK4(p1, 0, pa2); PK4(p1, 8, pa3);
#undef PK4
}
__device__ __forceinline__ void qkt(f32x16& p0, f32x16& p1, const char* Ks, const char* Kp, const bf16x8* qr, const char* Qp, int qrow, int r32, int hi) {
  p0 = f32x16{}; p1 = f32x16{};
#pragma unroll
  for (int d0 = 0; d0 < 8; ++d0) { int cb = (d0 * 16 + hi * 8) * 2;
    bf16x8 b0 = *reinterpret_cast<const bf16x8*>(Ks + KSWZ(r32, cb));
    bf16x8 b1 = *reinterpret_cast<const bf16x8*>(Ks + KSWZ(32 + r32, cb));
    bf16x8 q; if (d0 < 4) q = qr[d0]; else q = *reinterpret_cast<const bf16x8*>(Qp + KSWZ(qrow, ((d0 - 4) * 16 + hi * 8) * 2));
    p0 = __builtin_amdgcn_mfma_f32_32x32x16_bf16(b0, q, p0, 0, 0, 0);
    p1 = __builtin_amdgcn_mfma_f32_32x32x16_bf16(b1, q, p1, 0, 0, 0); }
#pragma unroll
  for (int d0 = 0; d0 < 4; ++d0) { int cb = (d0 * 16 + hi * 8) * 2;
    bf16x8 b0 = *reinterpret_cast<const bf16x8*>(Kp + KPSWZ(r32, cb));
    bf16x8 b1 = *reinterpret_cast<const bf16x8*>(Kp + KPSWZ(32 + r32, cb));
    const bf16x8 qp = *reinterpret_cast<const bf16x8*>(Qp + KSWZ(qrow, 128 + cb));
    p0 = __builtin_amdgcn_mfma_f32_32x32x16_bf16(b0, qp, p0, 0, 0, 0);
    p1 = __builtin_amdgcn_mfma_f32_32x32x16_bf16(b1, qp, p1, 0, 0, 0); }
}
__device__ __forceinline__ int v_st(int k, int c) { const int kk = (k & ~0xC) | ((k & 4) << 1) | ((k & 8) >> 1); return ((kk >> 3) * 4 + (c >> 5)) * 512 + ((kk & 7) * 32 + (c & 31)) * 2; }
__device__ __forceinline__ int v_rd_base(int lane) { return ((lane & 3) << 3) | (((lane >> 2) & 3) << 6) | (((lane >> 4) & 1) << 5) | (((lane >> 5) & 1) << 8); }
constexpr int v_rd_off(int d0, int ks, int half) { return d0 * 512 + ks * 4096 + half * 2048; }
template <int OFF> __device__ __forceinline__ s16x4 tr_read(int vb) {
  s16x4 r; asm volatile("ds_read_b64_tr_b16 %0, %1 offset:%2" : "=&v"(r) : "v"(vb), "i"(OFF) : "memory"); return r;
}
template <int D0> __device__ __forceinline__ void pv_one(f32x16& od, int vb, bf16x8 pa0, bf16x8 pa1, bf16x8 pa2, bf16x8 pa3) {
  const s16x4 l0 = tr_read<v_rd_off(D0, 0, 0)>(vb), h0 = tr_read<v_rd_off(D0, 0, 1)>(vb), l1 = tr_read<v_rd_off(D0, 1, 0)>(vb), h1 = tr_read<v_rd_off(D0, 1, 1)>(vb);
  const s16x4 l2 = tr_read<v_rd_off(D0, 2, 0)>(vb), h2 = tr_read<v_rd_off(D0, 2, 1)>(vb), l3 = tr_read<v_rd_off(D0, 3, 0)>(vb), h3 = tr_read<v_rd_off(D0, 3, 1)>(vb);
  asm volatile("s_waitcnt lgkmcnt(0)" ::: "memory"); SBAR();
#define PK(L, H) (bf16x8){L[0], L[1], L[2], L[3], H[0], H[1], H[2], H[3]}
  od = __builtin_amdgcn_mfma_f32_32x32x16_bf16(pa0, PK(l0, h0), od, 0, 0, 0);
  od = __builtin_amdgcn_mfma_f32_32x32x16_bf16(pa1, PK(l1, h1), od, 0, 0, 0);
  od = __builtin_amdgcn_mfma_f32_32x32x16_bf16(pa2, PK(l2, h2), od, 0, 0, 0);
  od = __builtin_amdgcn_mfma_f32_32x32x16_bf16(pa3, PK(l3, h3), od, 0, 0, 0);
#undef PK
}
__device__ __forceinline__ void pv_d0(f32x16* o, int vb, bf16x8 pa0, bf16x8 pa1, bf16x8 pa2, bf16x8 pa3) {
  pv_one<0>(o[0], vb, pa0, pa1, pa2, pa3); pv_one<1>(o[1], vb, pa0, pa1, pa2, pa3); pv_one<2>(o[2], vb, pa0, pa1, pa2, pa3); pv_one<3>(o[3], vb, pa0, pa1, pa2, pa3);
}
__device__ __forceinline__ void attn_unit(const bf16_t* __restrict__ Qb, const bf16_t* __restrict__ KVh, const bf16_t* __restrict__ KPE, bf16_t* __restrict__ Ob,
                                          int ka0, int kb0, int NT, char* lds, int tid_in, int tpos0) {
  const unsigned tid_u = (unsigned)tid_in; __builtin_assume(tid_u < 512u);
  const int tid = (int)tid_u, wid = tid >> 6, lane = tid & 63, r32 = lane & 31, hi = lane >> 5;
  char* V_lds = lds + OFF_V; char* K_lds = lds + OFF_K; char* P_lds = lds + OFF_KP;
  float* ws = (float*)(lds + OFF_WS) + wid * 64; float* li_l = ws; float* al_l = ws + 32;
  float m_reg = -1e30f, l_reg = 0; f32x16 o[4] = {}; bf16x8 qr[4];
  char* Q_lds = lds + OFF_QP; const int qrow = wid * QBLK + r32;
  const bf16_t* Qw = Qb + (long)(wid * QBLK + r32) * LDQ + hi * 8;
#pragma unroll
  for (int d0 = 0; d0 < 4; ++d0) qr[d0] = *reinterpret_cast<const bf16x8*>(Qw + d0 * 16);
#pragma unroll
  for (int d0 = 0; d0 < 4; ++d0) *reinterpret_cast<bf16x8*>(Q_lds + KSWZ(qrow, (d0 * 16 + hi * 8) * 2)) = *reinterpret_cast<const bf16x8*>(Qw + 64 + d0 * 16);
#pragma unroll
  for (int ax = 0; ax < 2; ++ax) { u32x4 w1 = *reinterpret_cast<const u32x4*>(Qw + 128 + ax * 32), w2 = *reinterpret_cast<const u32x4*>(Qw + 128 + ax * 32 + 16);
    if (tpos0 >= 0) { const int t = tpos0 + qrow; const float pos = (float)(ax == 0 ? (t >> 6) : (t & 63));
      unsigned* p1 = (unsigned*)&w1; unsigned* p2 = (unsigned*)&w2;
#pragma unroll
      for (int i = 0; i < 4; ++i) { float a0 = bflo(p1[i]), a1 = bfhi(p1[i]), b0 = bflo(p2[i]), b1 = bfhi(p2[i]);
        const float ang0 = pos * __builtin_amdgcn_exp2f(-(float)(hi * 8 + 2 * i) * 0.8304820237218406f), ang1 = pos * __builtin_amdgcn_exp2f(-(float)(hi * 8 + 2 * i + 1) * 0.8304820237218406f);
        const float c0 = __cosf(ang0), s0 = __sinf(ang0), c1 = __cosf(ang1), s1 = __sinf(ang1);
        p1[i] = pk2(a0 * c0 - b0 * s0, a1 * c1 - b1 * s1); p2[i] = pk2(b0 * c0 + a0 * s0, b1 * c1 + a1 * s1); } }
    *reinterpret_cast<u32x4*>(Q_lds + KSWZ(qrow, 128 + (ax * 32 + hi * 8) * 2)) = w1; *reinterpret_cast<u32x4*>(Q_lds + KSWZ(qrow, 128 + (ax * 32 + 16 + hi * 8) * 2)) = w2; }
  const int sr = tid >> 4, sc = (tid & 15) * 8, vst0 = v_st(sr, sc), vst1 = v_st(32 + sr, sc);
  const int pr = tid >> 3, pc = (tid & 7) * 8;
  const int vb0 = (int)(uintptr_t)V_lds + v_rd_base(lane);
  struct { bf16x8 vs0, vs1, ks0, ks1, kp; } sr_[SDEPTH];
#define KROW(j) ((j) < 4 ? ka0 + 64 * (j) : kb0 + 64 * ((j) - 4))
  const __amdgpu_buffer_rsrc_t rsKV = __builtin_amdgcn_make_buffer_rsrc((void*)KVh, 0, 0xFFFFFFFFu, 0x00020000);
  const __amdgpu_buffer_rsrc_t rsKP = __builtin_amdgcn_make_buffer_rsrc((void*)KPE, 0, 0xFFFFFFFFu, 0x00020000);
  const int vo_k = (sr * LDKV + sc) * 2, vo_p = (pr * 64 + pc) * 2;
#define SLOAD(i, jt) do { const int k0_ = KROW(jt); const int so0 = k0_ * (LDKV * 2), so1 = so0 + 32 * LDKV * 2; \
    sr_[i].vs0 = __builtin_bit_cast(bf16x8, __builtin_amdgcn_raw_buffer_load_b128(rsKV, vo_k + 256, so0, 0)); sr_[i].vs1 = __builtin_bit_cast(bf16x8, __builtin_amdgcn_raw_buffer_load_b128(rsKV, vo_k + 256, so1, 0)); \
    sr_[i].ks0 = __builtin_bit_cast(bf16x8, __builtin_amdgcn_raw_buffer_load_b128(rsKV, vo_k, so0, 0)); sr_[i].ks1 = __builtin_bit_cast(bf16x8, __builtin_amdgcn_raw_buffer_load_b128(rsKV, vo_k, so1, 0)); \
    sr_[i].kp = __builtin_bit_cast(bf16x8, __builtin_amdgcn_raw_buffer_load_b128(rsKP, vo_p, k0_ * 128, 0)); } while (0)
#define SWRITE(b, i) do { *(bf16x8*)(V_lds + (b) * SHM_V + vst0) = sr_[i].vs0;          \
    *(bf16x8*)(V_lds + (b) * SHM_V + vst1) = sr_[i].vs1; int kc = sc * 2;               \
    *(bf16x8*)(K_lds + (b) * SHM_K + KSWZ(sr, kc)) = sr_[i].ks0;                       \
    *(bf16x8*)(K_lds + (b) * SHM_K + KSWZ(32 + sr, kc)) = sr_[i].ks1;                  \
    *(bf16x8*)(P_lds + (b) * SHM_KP + KPSWZ(pr, pc * 2)) = sr_[i].kp; } while (0)
#define SWAIT() do { if constexpr (SDEPTH == 2) asm volatile("s_waitcnt vmcnt(5)" ::: "memory"); else asm volatile("s_waitcnt vmcnt(0)" ::: "memory"); } while (0)
#define RESC(a) do { if (__any((a) < 1.f)) { if (hi == 0) al_l[r32] = (a); asm volatile("s_waitcnt lgkmcnt(0)" ::: "memory"); \
    for (int d = 0; d < 4; ++d) for (int r = 0; r < 16; ++r) o[d][r] *= al_l[crow(r, hi)]; } } while (0)
  f32x16 pA0, pA1, pB0, pB1; float mnA, mnB, alA, alB; bf16x8 pa0, pa1, pa2, pa3;
  constexpr int SE = 0, SO = SDEPTH - 1;
  SLOAD(SE, 0); asm volatile("s_waitcnt vmcnt(0)" ::: "memory"); SWRITE(0, SE); __syncthreads();
  qkt(pA0, pA1, K_lds, P_lds, qr, Q_lds, qrow, r32, hi); partialSM(pA0, pA1, m_reg, mnA, alA);
  SLOAD(SO, 1); if constexpr (SDEPTH == 2) { if (2 < NT) SLOAD(SE, 2); }
  SWAIT(); SWRITE(1, SO); __syncthreads();
  for (int j = 1; j + 1 < NT; j += 2) {
    SBAR(); qkt(pB0, pB1, K_lds + SHM_K, P_lds + SHM_KP, qr, Q_lds, qrow, r32, hi);
    finishSM(pA0, pA1, alA, l_reg, pa0, pa1, pa2, pa3); SBAR();
    SLOAD(SO, j + SDEPTH); SBAR();
    pv_d0(o, vb0, pa0, pa1, pa2, pa3); partialSM(pB0, pB1, m_reg, mnB, alB);
    __syncthreads(); SWAIT(); SWRITE(0, SE);
    RESC(alB); __syncthreads();
    SBAR(); qkt(pA0, pA1, K_lds, P_lds, qr, Q_lds, qrow, r32, hi);
    finishSM(pB0, pB1, alB, l_reg, pa0, pa1, pa2, pa3); SBAR();
    if (SDEPTH == 1 || j + 3 < NT) SLOAD(SE, j + 1 + SDEPTH); SBAR();
    pv_d0(o, vb0 + (int)SHM_V, pa0, pa1, pa2, pa3); partialSM(pA0, pA1, m_reg, mnA, alA);
    __syncthreads(); SWAIT(); SWRITE(1, SO);
    RESC(alA); __syncthreads();
  }
  SBAR(); qkt(pB0, pB1, K_lds + SHM_K, P_lds + SHM_KP, qr, Q_lds, qrow, r32, hi);
  finishSM(pA0, pA1, alA, l_reg, pa0, pa1, pa2, pa3); SBAR();
  pv_d0(o, vb0, pa0, pa1, pa2, pa3); partialSM(pB0, pB1, m_reg, mnB, alB);
  __syncthreads(); RESC(alB);
  finishSM(pB0, pB1, alB, l_reg, pa0, pa1, pa2, pa3); SBAR();
  pv_d0(o, vb0 + (int)SHM_V, pa0, pa1, pa2, pa3);
  if (hi == 0) li_l[r32] = l_reg; asm volatile("s_waitcnt lgkmcnt(0)" ::: "memory");
  float rli[16];
#pragma unroll
  for (int r = 0; r < 16; ++r) rli[r] = __builtin_amdgcn_rcpf(li_l[crow(r, hi)]);
  bf16_t* Ow = Ob + (long)(wid * QBLK) * LDO;
#pragma unroll
  for (int r = 0; r < 16; ++r) { int orow = crow(r, hi);
    for (int d0 = 0; d0 < 4; ++d0) Ow[(long)orow * LDO + d0 * 32 + r32] = (bf16_t)f2bf(o[d0][r] * rli[r]); }
  __syncthreads();
#undef KROW
#undef SLOAD
#undef SWRITE
#undef SWAIT
#undef RESC
}
}

__device__ __forceinline__ void phase_attn(Frame& F, bool lat_only) {
    const bf16_t* Q = WSP(bf16_t, WS_Q); const bf16_t* KV = WSP(bf16_t, WS_KV); const bf16_t* KPE = WSP(bf16_t, WS_KPE); bf16_t* YA = WSP(bf16_t, WS_Y);
    const int NU = NBATCH * NH_MLA * 32 + (lat_only ? 0 : NBATCH * NH_MLA);
    const bool xa = (F.G == 256);
    for (int u0 = F.bid; u0 < NU; u0 += F.G) {
        int u = u0;
        if (xa && u0 < NBATCH * NH_MLA * 32) { const int xcd = u0 & 7, r = (u0 >> 3) & 31, rnd = u0 >> 8; u = ((xcd + 8 * rnd) << 5) + r; }
        int b, h, row0, NT, tpos0;
        if (u < NBATCH * NH_MLA * 32) { const int bh = u >> 5, qb = u & 31; b = bh >> 3; h = bh & 7; row0 = TC + b * SEQ + qb * 256; NT = 4 + SEQ / 64; tpos0 = qb * 256; }
        else { const int bh = u - NBATCH * NH_MLA * 32; b = bh >> 3; h = bh & 7; row0 = b * CTX; NT = 4; tpos0 = -1; }
        att::attn_unit(Q + (size_t)row0 * 1536 + h * 192, KV + h * 256, KPE, YA + (size_t)row0 * 1024 + h * 128, b * CTX, TC + b * SEQ, NT, (char*)F.lds, F.tid, tpos0);
    }
}
__device__ __forceinline__ void phase_qrope(Frame& F) {
    bf16_t* Q = WSP(bf16_t, WS_Q);
    for (int row = TC + F.gw; row < T; row += F.NGW) {
        const int t = (row - TC) & (SEQ - 1); const int p = F.lane & 31, axis = p >> 4, j = p & 15, hs = F.lane >> 5;
        const float pos = (float)(axis == 0 ? (t >> 6) : (t & 63)); const float inv = __builtin_amdgcn_exp2f(-(float)j * 0.8304820237218406f);
        const float sn = __sinf(pos * inv), cs = __cosf(pos * inv);
#pragma unroll
        for (int hh = 0; hh < 4; ++hh) { const int h = hh * 2 + hs; bf16_t* q = Q + (size_t)row * 1536 + h * 192 + 128 + axis * 32 + j;
            const float x1 = bf2f(q[0]), x2 = bf2f(q[16]);
            q[0] = (bf16_t)f2bf(x1 * cs - x2 * sn); q[16] = (bf16_t)f2bf(x2 * cs + x1 * sn); }
    }
}

#define MFMA16(a, b, c) __builtin_amdgcn_mfma_f32_16x16x32_bf16((a), (b), (c), 0, 0, 0)
constexpr int XS_LD = 264, BC_LD = 136;
__device__ __forceinline__ float bperm(float v, int srclane) { return __builtin_bit_cast(float, __builtin_amdgcn_ds_bpermute(srclane << 2, __builtin_bit_cast(int, v))); }
__device__ __forceinline__ float wave_incl_scan(float v, int lane) {
#pragma unroll
    for (int o = 1; o < 64; o <<= 1) { const float t = bperm(v, lane - o); if (lane >= o) v += t; }
    return v;
}
template <int NCOLS>
__device__ __forceinline__ void stage_tile(LAS bf16_t* dst, int ld, const bf16_t* src, int tid) {
    constexpr int cpr = NCOLS >> 3, NIT = 128 * cpr / NTHREADS;
    u32x4 v[NIT];
#pragma unroll
    for (int k = 0; k < NIT; ++k) { const int i = tid + k * NTHREADS; const int r = i / cpr, c8 = (i % cpr) * 8; v[k] = *(const u32x4*)(src + (size_t)r * P2W + c8); }
#pragma unroll
    for (int k = 0; k < NIT; ++k) { const int i = tid + k * NTHREADS; const int r = i / cpr, c8 = (i % cpr) * 8; *(LAS u32x4*)(dst + r * ld + c8) = v[k]; }
}
__device__ __forceinline__ void phase_mamba_states(Frame& F, const Args& a, int layer) {
    const bf16_t* P2 = WSP(bf16_t, WS_P2); const float* DT = WSP(float, WS_DT); bf16_t* MST = WSP(bf16_t, WS_MST); float* MCS = WSP(float, WS_MCS);
    LAS bf16_t* XSl = (LAS bf16_t*)F.lds; LAS bf16_t* Bl = (LAS bf16_t*)(F.lds + 67584); LAS float* wt = (LAS float*)(F.lds + 102400) + F.wave * 128;
    const int lane = F.lane, row = lane & 15, quad = lane >> 4;
    for (int u = F.bid; u < NCHUNK * 4; u += F.G) {
        const int chunk = u >> 2, g = (u >> 1) & 1, half = u & 1, row0 = chunk * 128;
        __syncthreads();
        stage_tile<256>(XSl, XS_LD, P2 + (size_t)row0 * P2W + P2_XBC + (g * 8 + half * 4) * 64, F.tid);
        stage_tile<128>(Bl, BC_LD, P2 + (size_t)row0 * P2W + P2_XBC + 1024 + g * 128, F.tid);
        const int hl = F.wave >> 1, d = F.wave & 1, h = g * 8 + half * 4 + hl;
        const float aa = -__expf(arg_in(a, I_SALOG)[(layer * 2 + d) * 16 + h]);
        { const float dt0 = DT[(size_t)(row0 + lane) * 32 + d * 16 + h], dt1 = DT[(size_t)(row0 + 64 + lane) * 32 + d * 16 + h];
          const float da0 = dt0 * aa, da1 = dt1 * aa;
          float c0 = wave_incl_scan(da0, lane); const float tot0 = bperm(c0, 63); float c1 = wave_incl_scan(da1, lane) + tot0; const float tot = bperm(c1, 63);
          if (d == 0) { wt[lane] = dt0 * __expf(tot - c0); wt[64 + lane] = dt1 * __expf(tot - c1); }
          else { wt[lane] = dt0 * __expf(c0 - da0); wt[64 + lane] = dt1 * __expf(c1 - da1); }
          if (lane == 0) MCS[(d * NCHUNK + chunk) * 16 + h] = tot; }
        __syncthreads();
        bf16_t* out = MST + ((size_t)(d * NCHUNK + chunk) * 16 + h) * 8192;
#pragma unroll 1
        for (int nh = 0; nh < 2; ++nh) {
            f32x4 acc[4][4];
#pragma unroll
            for (int i = 0; i < 4; ++i)
#pragma unroll
                for (int j = 0; j < 4; ++j) acc[i][j] = (f32x4){0.f, 0.f, 0.f, 0.f};
#pragma unroll 1
            for (int k0 = 0; k0 < 128; k0 += 32) {
                const int sb = k0 + quad * 8;
                float w8[8];
#pragma unroll
                for (int j = 0; j < 8; ++j) w8[j] = wt[sb + j];
                bf16x8 bf[4];
#pragma unroll
                for (int nt = 0; nt < 4; ++nt) {
#pragma unroll
                    for (int j = 0; j < 8; ++j) bf[nt][j] = (short)Bl[(sb + j) * BC_LD + (nh * 4 + nt) * 16 + row]; }
#pragma unroll
                for (int pt = 0; pt < 4; ++pt) { bf16x8 af;
#pragma unroll
                    for (int j = 0; j < 8; ++j) af[j] = (short)f2bf(w8[j] * bf2f(XSl[(sb + j) * XS_LD + hl * 64 + pt * 16 + row]));
#pragma unroll
                    for (int nt = 0; nt < 4; ++nt) acc[pt][nt] = MFMA16(af, bf[nt], acc[pt][nt]); }
            }
#pragma unroll
            for (int pt = 0; pt < 4; ++pt)
#pragma unroll
                for (int nt = 0; nt < 4; ++nt)
#pragma unroll
                    for (int jj = 0; jj < 4; ++jj) out[(pt * 16 + quad * 4 + jj) * 128 + (nh * 4 + nt) * 16 + row] = (bf16_t)f2bf(acc[pt][nt][jj]);
        }
    }
}
__device__ __forceinline__ void phase_mamba_scan(Frame& F) {
    bf16_t* MST = WSP(bf16_t, WS_MST); const float* MCS = WSP(float, WS_MCS);
    for (int idx = F.bid * NTHREADS + F.tid; idx < 2 * 2 * 16 * 8192; idx += F.G * NTHREADS) {
        const int e = idx & 8191, h = (idx >> 13) & 15, b = (idx >> 17) & 1, d = idx >> 18;
        float state = 0.f;
#pragma unroll 6
        for (int i = 0; i < 66; ++i) {
            int chunk; if (i < 2) chunk = 2 * b + (d == 0 ? i : 1 - i); else chunk = 4 + 64 * b + (d == 0 ? i - 2 : 65 - i);
            bf16_t* p = MST + ((size_t)(d * NCHUNK + chunk) * 16 + h) * 8192 + e;
            const float cs = bf2f(*p); const float dec = __expf(MCS[(d * NCHUNK + chunk) * 16 + h]);
            *p = (bf16_t)f2bf(state);
            state = state * dec + cs;
        }
    }
}
__device__ __forceinline__ void phase_mamba_out(Frame& F, const Args& a, int layer) {
    const bf16_t* P = WSP(bf16_t, WS_P); const bf16_t* P2 = WSP(bf16_t, WS_P2); const float* DT = WSP(float, WS_DT); const bf16_t* MST = WSP(bf16_t, WS_MST);
    bf16_t* YB = WSP(bf16_t, WS_Y) + (size_t)1 * T * 1024;
    LAS bf16_t* Cl = (LAS bf16_t*)F.lds; LAS bf16_t* Bl = (LAS bf16_t*)(F.lds + 34816); LAS bf16_t* XSl = (LAS bf16_t*)(F.lds + 69632);
    LAS float* tab = (LAS float*)(F.lds + 137216);
    for (int u = F.bid; u < NCHUNK * 4; u += F.G) {
        const int chunk = u >> 2, g = (u >> 1) & 1, half = u & 1, row0 = chunk * 128;
        __syncthreads();
        { const int tid_ = F.wave * 64 + (lane_asm() & 63);
          stage_tile<256>(XSl, XS_LD, P2 + (size_t)row0 * P2W + P2_XBC + (g * 8 + half * 4) * 64, tid_);
          stage_tile<128>(Bl, BC_LD, P2 + (size_t)row0 * P2W + P2_XBC + 1024 + g * 128, tid_);
          stage_tile<128>(Cl, BC_LD, P2 + (size_t)row0 * P2W + P2_XBC + 1280 + g * 128, tid_); }
        const int lane = lane_asm() & 63, row = lane & 15, quad = lane >> 4;
        float tot1 = 0.f;
        { const int hl = F.wave >> 1, d = F.wave & 1, h = g * 8 + half * 4 + hl;
          const float aa = -__expf(arg_in(a, I_SALOG)[(layer * 2 + d) * 16 + h]);
          const float dt0 = DT[(size_t)(row0 + lane) * 32 + d * 16 + h], dt1 = DT[(size_t)(row0 + 64 + lane) * 32 + d * 16 + h];
          const float da0 = dt0 * aa, da1 = dt1 * aa;
          float c0 = wave_incl_scan(da0, lane); const float t0 = bperm(c0, 63); float c1 = wave_incl_scan(da1, lane) + t0;
          LAS float* tb = tab + hl * 512;
          if (d == 0) { tb[lane] = c0; tb[64 + lane] = c1; tb[256 + lane] = __logf(dt0) - c0; tb[320 + lane] = __logf(dt1) - c1; }
          else { tb[128 + lane] = c0 - da0; tb[192 + lane] = c1 - da1; tb[384 + lane] = (c0 - da0) + __logf(dt0); tb[448 + lane] = (c1 - da1) + __logf(dt1); if (lane == 63) tab[2048 + hl] = c1; } }
        __syncthreads();
        { f32x4 cb[8];
#pragma unroll
          for (int st = 0; st < 8; ++st) cb[st] = (f32x4){0.f, 0.f, 0.f, 0.f};
#pragma unroll
          for (int k0 = 0; k0 < 128; k0 += 32) { const bf16x8 af = *(const LAS bf16x8*)(Cl + (F.wave * 16 + row) * BC_LD + k0 + quad * 8);
#pragma unroll
              for (int st = 0; st < 8; ++st) { const bf16x8 bfr = *(const LAS bf16x8*)(Bl + (st * 16 + row) * BC_LD + k0 + quad * 8); cb[st] = MFMA16(af, bfr, cb[st]); } }
          __syncthreads();
#pragma unroll
          for (int st = 0; st < 8; ++st)
#pragma unroll
              for (int jj = 0; jj < 4; ++jj) Bl[(F.wave * 16 + quad * 4 + jj) * BC_LD + st * 16 + row] = (bf16_t)f2bf(cb[st][jj]); }
        __syncthreads();
        const int hl = F.wave >> 1, th = F.wave & 1, h = g * 8 + half * 4 + hl;
        const LAS float* tb = tab + hl * 512; tot1 = tab[2048 + hl];
        f32x4 acc[4][4];
#pragma unroll
        for (int i = 0; i < 4; ++i)
#pragma unroll
            for (int j = 0; j < 4; ++j) acc[i][j] = (f32x4){0.f, 0.f, 0.f, 0.f};
#pragma unroll 1
        for (int k0 = 0; k0 < 128; k0 += 32) {
            const int sb = k0 + quad * 8;
            float u0s[8], u1s[8];
#pragma unroll
            for (int j = 0; j < 8; ++j) { u0s[j] = tb[256 + sb + j]; u1s[j] = tb[384 + sb + j]; }
            bf16x8 bx[4];
#pragma unroll
            for (int pt = 0; pt < 4; ++pt) {
#pragma unroll
                for (int j = 0; j < 8; ++j) bx[pt][j] = (short)XSl[(sb + j) * XS_LD + hl * 64 + pt * 16 + row]; }
#pragma unroll
            for (int tt = 0; tt < 4; ++tt) { const int t = th * 64 + tt * 16 + row; const float c0t = tb[t], e1t = tb[128 + t];
                float cbv[8]; { const u32x4 w = *(const LAS u32x4*)(Bl + t * BC_LD + sb); cbv[0] = bflo(w.x); cbv[1] = bfhi(w.x); cbv[2] = bflo(w.y); cbv[3] = bfhi(w.y); cbv[4] = bflo(w.z); cbv[5] = bfhi(w.z); cbv[6] = bflo(w.w); cbv[7] = bfhi(w.w); }
                bf16x8 af;
#pragma unroll
                for (int j = 0; j < 8; ++j) { const int s = sb + j;
                    const float f0 = s <= t ? __expf(c0t + u0s[j]) : 0.f;
                    const float f1 = s >= t ? __expf(u1s[j] - e1t) : 0.f;
                    af[j] = (short)f2bf(cbv[j] * (f0 + f1)); }
#pragma unroll
                for (int pt = 0; pt < 4; ++pt) acc[tt][pt] = MFMA16(af, bx[pt], acc[tt][pt]); }
        }
#pragma unroll 1
        for (int d = 0; d < 2; ++d) {
            const bf16_t* S = MST + ((size_t)(d * NCHUNK + chunk) * 16 + h) * 8192;
#pragma unroll 1
            for (int k0 = 0; k0 < 128; k0 += 32) {
                bf16x8 bs[4];
#pragma unroll
                for (int pt = 0; pt < 4; ++pt) bs[pt] = *(const bf16x8*)(S + (pt * 16 + row) * 128 + k0 + quad * 8);
#pragma unroll
                for (int tt = 0; tt < 4; ++tt) { const int t = th * 64 + tt * 16 + row;
                    const float sc = d == 0 ? __expf(tb[t]) : __expf(tot1 - tb[128 + t]);
                    const u32x4 cw = *(const LAS u32x4*)(Cl + t * BC_LD + k0 + quad * 8);
                    u32x4 aw; aw.x = cvt_pk_bf16(bflo(cw.x) * sc, bfhi(cw.x) * sc); aw.y = cvt_pk_bf16(bflo(cw.y) * sc, bfhi(cw.y) * sc);
                    aw.z = cvt_pk_bf16(bflo(cw.z) * sc, bfhi(cw.z) * sc); aw.w = cvt_pk_bf16(bflo(cw.w) * sc, bfhi(cw.w) * sc);
                    const bf16x8 af = __builtin_bit_cast(bf16x8, aw);
#pragma unroll
                    for (int pt = 0; pt < 4; ++pt) acc[tt][pt] = MFMA16(af, bs[pt], acc[tt][pt]); } }
        }
        const float Dh = arg_in(a, I_SD)[layer * 16 + h];
#pragma unroll
        for (int tt = 0; tt < 4; ++tt)
#pragma unroll
            for (int jj = 0; jj < 4; ++jj) { const int t = th * 64 + tt * 16 + quad * 4 + jj; const size_t r = (size_t)(row0 + t);
#pragma unroll
                for (int pt = 0; pt < 4; ++pt) { const int p = pt * 16 + row;
                    const float xs = bf2f(XSl[t * XS_LD + hl * 64 + p]); const float z = bf2f(P[r * NNG + P_Z + h * 64 + p]);
                    YB[r * 1024 + h * 64 + p] = (bf16_t)f2bf((acc[tt][pt][jj] + xs * Dh) * siluf_(z)); } }
    }
}
__device__ __forceinline__ void phase_mamba_norm(Frame& F, const Args& a, int layer) {
    bf16_t* YB = WSP(bf16_t, WS_Y) + (size_t)1 * T * 1024; const float* nw = arg_in(a, I_SNORM) + layer * 1024;
    for (int row = F.gw; row < T; row += F.NGW) {
        bf16_t* p = YB + (size_t)row * 1024 + F.lane * 16; float x[16]; { float t0[8], t1[8]; ld8bf(p, t0); ld8bf(p + 8, t1);
#pragma unroll
            for (int i = 0; i < 8; ++i) { x[i] = t0[i]; x[8 + i] = t1[i]; } }
        float s = 0.f;
#pragma unroll
        for (int i = 0; i < 16; ++i) s += x[i] * x[i];
        s = sum32(s);
        const float r = 1.f / sqrtf(s * (1.f / 512.f) + 1e-5f);
        float o0[8], o1[8];
#pragma unroll
        for (int i = 0; i < 8; ++i) { o0[i] = x[i] * r * nw[F.lane * 16 + i]; o1[i] = x[8 + i] * r * nw[F.lane * 16 + 8 + i]; }
        st8bf(p, o0); st8bf(p + 8, o1);
    }
}

__device__ __forceinline__ float dpp_f(float x, const int ctrl_sel) {
    const int xi = __builtin_bit_cast(int, x); int r;
    if (ctrl_sel == 0) r = __builtin_amdgcn_update_dpp(0, xi, 0xB1, 0xF, 0xF, false);
    else if (ctrl_sel == 1) r = __builtin_amdgcn_update_dpp(0, xi, 0x4E, 0xF, 0xF, false);
    else r = __builtin_amdgcn_update_dpp(0, xi, 0x141, 0xF, 0xF, false);
    return __builtin_bit_cast(float, r);
}
__device__ __forceinline__ float red8(float x) { x += dpp_f(x, 0); x += dpp_f(x, 1); x += dpp_f(x, 2); return x; }
__device__ __forceinline__ int rw_row(int pos, int b, int d) { return pos < CTX ? b * CTX + (d == 0 ? pos : CTX - 1 - pos) : TC + b * SEQ + (d == 0 ? pos - CTX : SEQ - 1 - (pos - CTX)); }
constexpr int RW_STEP_F = 336, RW_CH = 32, RW_CHF = RW_STEP_F * RW_CH;
struct RwOps { f32x4 w, k, b, a, r; float v; };
__device__ __forceinline__ void rw_load(RwOps& o, const LAS float* sp, const LAS float* vp) {
    o.w = *(const LAS f32x4*)(sp); o.k = *(const LAS f32x4*)(sp + 64); o.b = *(const LAS f32x4*)(sp + 128); o.a = *(const LAS f32x4*)(sp + 192); o.r = *(const LAS f32x4*)(sp + 256); o.v = *vp;
}
__device__ __forceinline__ void rw_step(f32x4& s, const RwOps& o, LAS float* yp) {
    const f32x4 tt = s * o.w + o.k * o.v;
    const f32x4 pa = s * o.a; float sa = (pa.x + pa.y) + (pa.z + pa.w); sa = sum16(sa);
    s = tt + o.b * sa;
    const f32x4 pr = s * o.r; *yp = (pr.x + pr.y) + (pr.z + pr.w);
}
struct RwRaw { unsigned ew[4], ic[4], kk[4], rr[4], kr[4], vv[4]; };
__device__ __forceinline__ void phase_rwkv_scan(Frame& F, const Args& a, int layer) {
    const bf16_t* P2 = WSP(bf16_t, WS_P2); const bf16_t* EW = WSP(bf16_t, WS_EW); const bf16_t* ICLR = WSP(bf16_t, WS_ICLR); const bf16_t* KK = WSP(bf16_t, WS_KK);
    bf16_t* YRW = WSP(bf16_t, WS_YRW);
    LAS float* ring = (LAS float*)F.lds; LAS float* ybuf = (LAS float*)(F.lds + 2 * RW_CHF * 4);
    const int lane = F.lane;
    for (int u0 = F.bid; u0 < 256; u0 += F.G) {
        const int u = (F.G == 256) ? (((u0 & 7) * 8 + (u0 >> 5)) << 2) + ((u0 >> 3) & 3) : u0;
        const int chain = u >> 2, rq = u & 3, d = chain >> 5, b = (chain >> 4) & 1, h = chain & 15;
        constexpr int NCH = (CTX + SEQ) / RW_CH;
        const int lw = F.wave - 4;
        const int tsel = lane >> 5, kp = lane & 31;
        const f32x2 ka2 = *(const f32x2*)(arg_in(a, I_RKA) + layer * 1024 + h * 64 + 2 * kp);
        auto issue = [&](RwRaw& x, int cidx) {
            const int row0 = rw_row(cidx * RW_CH, b, d), st = d == 0 ? 1 : -1;
            const int tk0 = 2 * lw + tsel;
            const unsigned* ewp = (const unsigned*)(EW + (size_t)d * T * 1024); const unsigned* icp = (const unsigned*)(ICLR + (size_t)d * T * 1024);
            const unsigned* kkp = (const unsigned*)KK; const unsigned* p2p = (const unsigned*)P2;
#pragma unroll
            for (int j = 0; j < 4; ++j) { const int row = row0 + st * (8 * j + tk0); const int o = (row * 1024 + h * 64) / 2 + kp, q = (row * P2W + P2_RKV + h * 64) / 2 + kp;
                x.ew[j] = ewp[o]; x.ic[j] = icp[o]; x.kk[j] = kkp[o]; x.rr[j] = p2p[q]; x.kr[j] = p2p[q + 512]; x.vv[j] = p2p[q + 1024 + rq * 8 - kp + (kp & 7)]; } };
        auto commit = [&](const RwRaw& x, int cidx) {
            LAS float* dst = ring + (cidx & 1) * RW_CHF;
#pragma unroll
            for (int j = 0; j < 4; ++j) { LAS float* sbase = dst + (8 * j + 2 * lw + tsel) * RW_STEP_F; LAS f32x2* s2 = (LAS f32x2*)sbase + kp;
                const f32x2 ew = {bflo(x.ew[j]), bfhi(x.ew[j])}, ic = {bflo(x.ic[j]), bfhi(x.ic[j])}, kkv = {bflo(x.kk[j]), bfhi(x.kk[j])}, rr = {bflo(x.rr[j]), bfhi(x.rr[j])}, kr = {bflo(x.kr[j]), bfhi(x.kr[j])};
                s2[0] = (f32x2){__expf(-ew.x), __expf(-ew.y)}; s2[32] = kr * ((ic - 1.f) * ka2 + 1.f); s2[64] = kkv * ic; s2[96] = -kkv; s2[128] = rr;
                if (kp < 8) s2[160] = (f32x2){bflo(x.vv[j]), bfhi(x.vv[j])}; } };
        auto flush_chunk = [&](int cidx) {
            const LAS float* yb = ybuf + (cidx & 1) * (RW_CH * 256);
            const int row0 = rw_row(cidx * RW_CH, b, d), st = d == 0 ? 1 : -1;
#pragma unroll
            for (int q = 0; q < 2; ++q) { const int i = (F.tid - 256) + 256 * q, tok = i >> 4, rr = i & 15; const LAS f32x4* pp = (const LAS f32x4*)(yb + i * 16);
                const f32x4 p0 = pp[0], p1 = pp[1], p2 = pp[2], p3 = pp[3];
                const float y = ((p0.x + p0.y) + (p0.z + p0.w)) + ((p1.x + p1.y) + (p1.z + p1.w)) + (((p2.x + p2.y) + (p2.z + p2.w)) + ((p3.x + p3.y) + (p3.z + p3.w)));
                YRW[((size_t)d * T + row0 + st * tok) * 1024 + h * 64 + rq * 16 + rr] = (bf16_t)f2bf(y); } };
        auto compute = [&](f32x4& s, int c) {
            const int rloc = lane >> 4, kq = lane & 15, r16 = F.wave * 4 + rloc;
            const LAS float* base = ring + (c & 1) * RW_CHF + kq * 4; const LAS float* vb = ring + (c & 1) * RW_CHF + 320 + r16; LAS float* yb = ybuf + (c & 1) * (RW_CH * 256) + r16 * 16 + kq;
            RwOps o0, o1, o2, o3;
            rw_load(o0, base, vb); rw_load(o1, base + RW_STEP_F, vb + RW_STEP_F); rw_load(o2, base + 2 * RW_STEP_F, vb + 2 * RW_STEP_F);
#pragma unroll
            for (int t = 0; t < RW_CH; t += 4) {
                if (t + 3 < RW_CH) rw_load(o3, base + (t + 3) * RW_STEP_F, vb + (t + 3) * RW_STEP_F);
                rw_step(s, o0, yb + t * 256);
                if (t + 4 < RW_CH) rw_load(o0, base + (t + 4) * RW_STEP_F, vb + (t + 4) * RW_STEP_F);
                rw_step(s, o1, yb + (t + 1) * 256);
                if (t + 5 < RW_CH) rw_load(o1, base + (t + 5) * RW_STEP_F, vb + (t + 5) * RW_STEP_F);
                rw_step(s, o2, yb + (t + 2) * 256);
                if (t + 6 < RW_CH) rw_load(o2, base + (t + 6) * RW_STEP_F, vb + (t + 6) * RW_STEP_F);
                rw_step(s, o3, yb + (t + 3) * 256);
            } };
        __syncthreads();
        f32x4 s = {0.f, 0.f, 0.f, 0.f};
        if (F.wave >= 4) {
            RwRaw ra, rb;
            issue(ra, 0); commit(ra, 0); issue(ra, 1);
            __syncthreads();
            for (int c = 0; c < NCH; c += 2) {
                if (c + 2 < NCH) issue(rb, c + 2);
                if (c > 0) flush_chunk(c - 1);
                commit(ra, c + 1);
                __syncthreads();
                if (c + 3 < NCH) issue(ra, c + 3);
                flush_chunk(c);
                if (c + 2 < NCH) commit(rb, c + 2);
                __syncthreads();
            }
            flush_chunk(NCH - 1);
        } else {
            __syncthreads();
            for (int c = 0; c < NCH; c += 2) { compute(s, c); __syncthreads(); compute(s, c + 1); __syncthreads(); }
        }
    }
}
__device__ __forceinline__ void phase_rwkv_out(Frame& F, const Args& a, int layer) {
    const bf16_t* P2 = WSP(bf16_t, WS_P2); const bf16_t* ICLR = WSP(bf16_t, WS_ICLR); const bf16_t* YRW = WSP(bf16_t, WS_YRW); const bf16_t* GG = WSP(bf16_t, WS_GG);
    bf16_t* YD = WSP(bf16_t, WS_Y) + (size_t)3 * T * 1024;
    const float* lng = arg_in(a, I_RLNG) + layer * 1024; const float* lnb = arg_in(a, I_RLNB) + layer * 1024; const float* rk = arg_in(a, I_RRK) + layer * 1024; const float* kav = arg_in(a, I_RKA) + layer * 1024;
    for (int row = F.gw; row < T; row += F.NGW) {
        const int c = F.lane * 16; const size_t o = (size_t)row * 1024 + c;
        float y[16], r[16], k[16], v[16], i0[16], i1[16], g[16];
#define LD16(dst, ptr) do { float t0_[8], t1_[8]; ld8bf((ptr), t0_); ld8bf((ptr) + 8, t1_); _Pragma("unroll") for (int i_ = 0; i_ < 8; ++i_) { dst[i_] = t0_[i_]; dst[8 + i_] = t1_[i_]; } } while (0)
        LD16(y, YRW + o); LD16(r, YRW + (size_t)T * 1024 + o);
#pragma unroll
        for (int i = 0; i < 16; ++i) y[i] += r[i];
        const bf16_t* p2 = P2 + (size_t)row * P2W + P2_RKV + c;
        LD16(r, p2); LD16(k, p2 + 1024); LD16(v, p2 + 2048); LD16(i0, ICLR + o); LD16(i1, ICLR + (size_t)T * 1024 + o); LD16(g, GG + o);
#undef LD16
        float s = 0.f, bsum = 0.f;
#pragma unroll
        for (int i = 0; i < 16; ++i) { s += y[i]; const float ka = kav[c + i]; bsum += r[i] * k[i] * rk[c + i] * ((1.f + (i0[i] - 1.f) * ka) + (1.f + (i1[i] - 1.f) * ka)); }
        s = sum4(s); bsum = sum4(bsum);
        const float mu = s * (1.f / 64.f); float q = 0.f;
#pragma unroll
        for (int i = 0; i < 16; ++i) { const float dd = y[i] - mu; q += dd * dd; }
        q = sum4(q);
        const float rstd = 1.f / sqrtf(q * (1.f / 64.f) + 64e-5f);
        float o0[8], o1[8];
#pragma unroll
        for (int i = 0; i < 8; ++i) { o0[i] = ((y[i] - mu) * rstd * lng[c + i] + lnb[c + i] + bsum * v[i]) * g[i];
            o1[i] = ((y[8 + i] - mu) * rstd * lng[c + 8 + i] + lnb[c + 8 + i] + bsum * v[8 + i]) * g[8 + i]; }
        st8bf(YD + o, o0); st8bf(YD + o + 8, o1);
    }
}

constexpr int FFT_N = 16384;
__device__ __forceinline__ int fswz(int i) { return i ^ (((i >> 5) & 3) << 2) ^ (((i >> 6) & 1) << 4); }
__device__ __forceinline__ f32x2 cmul(f32x2 a, f32x2 b) { return (f32x2){a.x * b.x - a.y * b.y, a.x * b.y + a.y * b.x}; }
template <bool INV>
__device__ __forceinline__ void fft_passes(LAS f32x2* X, int tid) {
#pragma unroll 1
    for (int st = 0; st < 7; ++st) {
        const int lq = INV ? 2 * st : 12 - 2 * st;
        const int q = 1 << lq;
        __syncthreads();
#pragma unroll 2
        for (int mm = 0; mm < 8; ++mm) { const int uu = tid + 512 * mm; const int k = uu & (q - 1), blk = uu >> lq; const int i0 = (blk << (lq + 2)) + k;
            const int p0 = fswz(i0), p1 = fswz(i0 + q), p2 = fswz(i0 + 2 * q), p3 = fswz(i0 + 3 * q);
            f32x2 a0 = X[p0], a1 = X[p1], a2 = X[p2], a3 = X[p3];
            const float fr = (float)k / (float)(4 * q);
            const float cs = __builtin_amdgcn_cosf(fr), sn = __builtin_amdgcn_sinf(fr);
            const f32x2 w1 = INV ? (f32x2){cs, sn} : (f32x2){cs, -sn}; const f32x2 w2 = cmul(w1, w1), w3 = cmul(w2, w1);
            if (!INV) {
                const f32x2 t0 = a0 + a2, t1 = a0 - a2, t2 = a1 + a3, t3 = a1 - a3;
                const f32x2 b0 = t0 + t2, b2 = t0 - t2, b1 = (f32x2){t1.x + t3.y, t1.y - t3.x}, b3 = (f32x2){t1.x - t3.y, t1.y + t3.x};
                X[p0] = b0; X[p1] = cmul(b1, w1); X[p2] = cmul(b2, w2); X[p3] = cmul(b3, w3);
            } else {
                a1 = cmul(a1, w1); a2 = cmul(a2, w2); a3 = cmul(a3, w3);
                const f32x2 u0 = a0 + a2, u1 = a0 - a2, u2 = a1 + a3, u3 = a1 - a3;
                X[p0] = u0 + u2; X[p2] = u0 - u2; X[p1] = (f32x2){u1.x - u3.y, u1.y + u3.x}; X[p3] = (f32x2){u1.x + u3.y, u1.y - u3.x};
            } }
    }
    __syncthreads();
}
__device__ __forceinline__ void phase_hyena_fft(Frame& F, const Args& a, int layer, bool dry = false) {
    const bf16_t* FILT = WSP(bf16_t, WS_FILT); float* VT = WSP(float, WS_VT); const float* hyd = arg_in(a, I_HD) + layer * 1024;
    LAS f32x2* X = (LAS f32x2*)F.lds;
    for (int c = F.bid; c < 1024; c += F.G) {
        __syncthreads();
        const int tid = F.wave * 64 + (lane_asm() & 63), i0 = tid * 16;
        { const bf16_t* hf = FILT + (size_t)c * 2 * SEQ; const bf16_t* hb = hf + SEQ;
          float f[16], g[16]; ld8bf(hf + i0, *(float(*)[8])&f[0]); ld8bf(hf + i0 + 8, *(float(*)[8])&f[8]);
          ld8bf(hb + (SEQ - 16 - i0), *(float(*)[8])&g[0]); ld8bf(hb + (SEQ - 8 - i0), *(float(*)[8])&g[8]);
#pragma unroll
          for (int j = 0; j < 16; ++j) X[fswz(i0 + j)] = (f32x2){f[j], 0.f};
#pragma unroll
          for (int j = 0; j < 16; ++j) { const int pos = SEQ + i0 + 1 + j; if (pos < FFT_N) X[fswz(pos)] = (f32x2){g[15 - j], 0.f}; }
          if (tid == 0) { float zz = 0.f; asm volatile("" : "+v"(zz)); X[fswz(SEQ)] = (f32x2){zz, zz}; } }
        fft_passes<false>(X, F.tid);
        f32x2 Kh[32];
#pragma unroll
        for (int j = 0; j < 32; ++j) Kh[j] = X[fswz(F.tid + 512 * j)];
        __syncthreads();
        float* v0 = VT + (size_t)c * 2 * SEQ; float* v1 = v0 + SEQ;
        { f32x4 a0[4], a1[4];
#pragma unroll
          for (int q = 0; q < 4; ++q) { a0[q] = *(const f32x4*)(v0 + i0 + 4 * q); a1[q] = *(const f32x4*)(v1 + i0 + 4 * q); }
#pragma unroll
          for (int q = 0; q < 4; ++q) { X[fswz(i0 + 4 * q)] = (f32x2){a0[q].x, a1[q].x}; X[fswz(i0 + 4 * q + 1)] = (f32x2){a0[q].y, a1[q].y}; X[fswz(i0 + 4 * q + 2)] = (f32x2){a0[q].z, a1[q].z}; X[fswz(i0 + 4 * q + 3)] = (f32x2){a0[q].w, a1[q].w}; }
          { float zz = 0.f; asm volatile("" : "+v"(zz));
#pragma unroll
          for (int j = 0; j < 16; ++j) X[fswz(SEQ + i0 + j)] = (f32x2){zz, zz}; } }
        fft_passes<false>(X, F.tid);
#pragma unroll
        for (int j = 0; j < 32; ++j) { const int p = fswz(F.tid + 512 * j); X[p] = cmul(X[p], Kh[j]); }
        fft_passes<true>(X, F.tid);
        const float dc = hyd[c];
        { f32x4 a0[4], a1[4];
#pragma unroll
          for (int q = 0; q < 4; ++q) { a0[q] = *(const f32x4*)(v0 + i0 + 4 * q); a1[q] = *(const f32x4*)(v1 + i0 + 4 * q); }
#pragma unroll
          for (int q = 0; q < 4; ++q) { const f32x2 r0 = X[fswz(i0 + 4 * q)], r1 = X[fswz(i0 + 4 * q + 1)], r2 = X[fswz(i0 + 4 * q + 2)], r3 = X[fswz(i0 + 4 * q + 3)];
              const f32x4 o0 = (f32x4){r0.x, r1.x, r2.x, r3.x} * (1.f / FFT_N) + a0[q] * dc, o1 = (f32x4){r0.y, r1.y, r2.y, r3.y} * (1.f / FFT_N) + a1[q] * dc;
              if (!dry) { *(f32x4*)(v0 + i0 + 4 * q) = o0; *(f32x4*)(v1 + i0 + 4 * q) = o1; } } }
    }
}
__device__ __forceinline__ void phase_hyena_out(Frame& F, const Args& a, int layer) {
    const float* VT = WSP(float, WS_VT); const bf16_t* P2 = WSP(bf16_t, WS_P2); bf16_t* YC = WSP(bf16_t, WS_Y) + (size_t)2 * T * 1024;
    LAS float* tl = (LAS float*)F.lds;
    for (int u = F.bid; u < (TL / 64) * 4; u += F.G) {
        const int tb = u >> 2, cb = u & 3; const int row0 = TC + tb * 64; const int b = (row0 - TC) >> 13, t0 = (row0 - TC) & (SEQ - 1);
        __syncthreads();
        for (int p = 0; p < 8; ++p) { const int cl = p * 32 + (F.tid >> 4), q = F.tid & 15;
            const f32x4 v = *(const f32x4*)(VT + ((size_t)(cb * 256 + cl) * 2 + b) * SEQ + t0 + 4 * q);
            tl[cl * 65 + 4 * q] = v.x; tl[cl * 65 + 4 * q + 1] = v.y; tl[cl * 65 + 4 * q + 2] = v.z; tl[cl * 65 + 4 * q + 3] = v.w; }
        __syncthreads();
        const int cl = F.tid & 255, th = F.tid >> 8;
        for (int i = 0; i < 32; ++i) { const int tl_ = th * 32 + i; const size_t row = (size_t)(row0 + tl_);
            const float x0 = bf2f(P2[row * P2W + P2_X0 + cb * 256 + cl]);
            YC[row * 1024 + cb * 256 + cl] = (bf16_t)f2bf(tl[cl * 65 + tl_] * x0); }
    }
    const float* VC = WSP(float, WS_VC); const float* FC = WSP(float, WS_FILTC); const float* hyd = arg_in(a, I_HD) + layer * 1024;
    for (int it = F.gw; it < 2 * 16 * 16; it += F.NGW) {
        const int b = it >> 8, cbk = (it >> 4) & 15, tb = it & 15; const int c = cbk * 64 + F.lane, t0 = tb * 16;
        const float* vb = VC + (size_t)b * CTX * 1024 + c; const float* fc = FC + c;
        float acc[16];
#pragma unroll
        for (int i = 0; i < 16; ++i) acc[i] = 0.f;
#pragma unroll 1
        for (int sb = 0; sb < 16; ++sb) { const int s0 = sb * 16, dl = t0 - s0;
            float f[31], v[16];
#pragma unroll
            for (int j = 0; j < 31; ++j) { const int lag = dl + j - 15; f[j] = lag >= 0 ? fc[(size_t)lag * 2048] : fc[(size_t)(-lag) * 2048 + 1024]; }
#pragma unroll
            for (int j = 0; j < 16; ++j) v[j] = vb[(size_t)(s0 + j) * 1024];
#pragma unroll
            for (int i = 0; i < 16; ++i)
#pragma unroll
                for (int j = 0; j < 16; ++j) acc[i] += f[i - j + 15] * v[j]; }
#pragma unroll
        for (int i = 0; i < 16; ++i) { const int t = t0 + i; const size_t row = (size_t)(b * CTX + t);
            const float x0 = bf2f(P2[row * P2W + P2_X0 + c]);
            YC[row * 1024 + c] = (bf16_t)f2bf((acc[i] + vb[(size_t)t * 1024] * hyd[c]) * x0); }
    }
}

__device__ __forceinline__ void phase_ln1(Frame& F, const Args& a, int layer) {
    const float* mod = (const float*)(F.ws + WS_CTL) + CW_MOD + (size_t)layer * 3 * 6 * DM;
    const float* YM = WSP(float, WS_YMIX); float* XS = WSP(float, WS_XS); unsigned* H2 = WSP(unsigned, WS_H2); float* AFF = WSP(float, WS_AFF); int* INV = WSP(int, WS_INV);
    const float* g1w = arg_in(a, I_LN1G) + layer * DM; const float* b1w = arg_in(a, I_LN1B) + layer * DM; const float* wr = arg_in(a, I_WROUTER) + (size_t)layer * DM * NEXP;
    LAS float* wrT = (LAS float*)F.lds;
    __syncthreads();
    for (int i = F.tid; i < DM * NEXP; i += NTHREADS) { const int c = i >> 4, e = i & 15; wrT[e * DM + c] = wr[i]; }
    __syncthreads();
    int* PTOK = WSP(int, WS_PTOK); float* PG = WSP(float, WS_PGATE);
    for (int i = F.bid * NTHREADS + F.tid; i < NPAIR; i += F.G * NTHREADS) { PTOK[i] = -1; PG[i] = 0.f; }
    for (int row = F.gw; row < T; row += F.NGW) {
        const f32x4* xr = (const f32x4*)x_src_row(a, F, layer, row) + F.lane; const f32x4* yr = (const f32x4*)(YM + (size_t)row * DM) + F.lane;
        const float* m = mod + (size_t)row_modidx(row) * 6 * DM;
        f32x4 v[8];
#pragma unroll
        for (int j = 0; j < 8; ++j) { const int c = 4 * (64 * j + F.lane); v[j] = xr[64 * j] * ALPHA + *(const f32x4*)(m + 2 * DM + c) * yr[64 * j]; }
        float mean, rstd; row_stats(v, mean, rstd, 1e-6f);
        f32x4* xo = (f32x4*)(XS + (size_t)row * DM) + F.lane;
#pragma unroll
        for (int j = 0; j < 8; ++j) { const int c = 4 * (64 * j + F.lane); v[j] = (v[j] - mean) * rstd * *(const f32x4*)(g1w + c) + *(const f32x4*)(b1w + c); xo[64 * j] = v[j]; }
        row_stats(v, mean, rstd, 1e-6f);
        unsigned* ho = H2 + (size_t)row * (DM / 4) + F.lane;
        float lg[16];
#pragma unroll
        for (int e = 0; e < 16; ++e) lg[e] = 0.f;
#pragma unroll
        for (int j = 0; j < 8; ++j) { const int c = 4 * (64 * j + F.lane);
            const f32x4 y = (v[j] - mean) * rstd * (*(const f32x4*)(m + 4 * DM + c) + 1.f) + *(const f32x4*)(m + 3 * DM + c);
            ho[64 * j] = pk4fp8(y.x, y.y, y.z, y.w);
#pragma unroll
            for (int e = 0; e < 16; ++e) { const f32x4 ww = *(const LAS f32x4*)(wrT + e * DM + c); lg[e] += (y.x * ww.x + y.y * ww.y) + (y.z * ww.z + y.w * ww.w); } }
        float mx = -1e30f;
#pragma unroll
        for (int e = 0; e < 16; ++e) { lg[e] = wave_sum(lg[e]); mx = fmaxf(mx, lg[e]); }
        float den = 0.f;
#pragma unroll
        for (int e = 0; e < 16; ++e) { lg[e] = __expf(lg[e] - mx); den += lg[e]; }
        float mine = 0.f;
#pragma unroll
        for (int e = 0; e < 16; ++e) mine = (F.lane == e) ? lg[e] : mine;
        if (F.lane < 16) { AFF[(size_t)row * 16 + F.lane] = mine / den; INV[(size_t)row * 16 + F.lane] = -1; }
    }
}
__device__ __forceinline__ void phase_topk(Frame& F, bool lat_only) {
    const float* AFF = WSP(float, WS_AFF); int* INV = WSP(int, WS_INV); int* PTOK = WSP(int, WS_PTOK); float* PG = WSP(float, WS_PGATE);
    LAS unsigned* vals = (LAS unsigned*)F.lds; LAS unsigned* hist = vals + 8192; LAS unsigned* ctl = hist + 256;
    for (int u = F.bid + (lat_only ? 32 : 0); u < 64; u += F.G) {
        const int s = u >> 4, e = u & 15, rs = seg_start(s), n = seg_len(s), cap = s < 2 ? CAP_C : CAP_L;
        __syncthreads();
        for (int i = F.tid; i < n; i += NTHREADS) vals[i] = __builtin_bit_cast(unsigned, AFF[(size_t)(rs + i) * 16 + e]);
        if (F.tid == 0) { ctl[0] = 0u; ctl[1] = (unsigned)cap; ctl[2] = 0u; ctl[3] = 0u; }
        unsigned mask = 0u;
        for (int shift = 24; shift >= 0; shift -= 8) {
            if (F.tid < 256) hist[F.tid] = 0u;
            __syncthreads();
            const unsigned prefix = ctl[0];
            for (int i = F.tid; i < n; i += NTHREADS) { const unsigned b = vals[i]; if ((b & mask) == prefix) __hip_atomic_fetch_add(&hist[(b >> shift) & 255u], 1u, __ATOMIC_RELAXED, __HIP_MEMORY_SCOPE_WORKGROUP); }
            __syncthreads();
            if (F.tid == 0) { unsigned rem = ctl[1], cum = 0u; int dg = 255; for (; dg > 0; --dg) { const unsigned hc = hist[dg]; if (cum + hc >= rem) break; cum += hc; }
                ctl[1] = rem - cum; ctl[0] = prefix | ((unsigned)dg << shift); }
            mask |= 255u << shift;
            __syncthreads();
        }
        const unsigned thr = ctl[0], rem = ctl[1]; const unsigned ngt = (unsigned)cap - rem;
        const int pbase = s < 2 ? NBATCH * NEXP * CAP_L + e * 256 + s * CAP_C : ((s - 2) * NEXP + e) * CAP_L;
        for (int i = F.tid; i < n; i += NTHREADS) { const unsigned b = vals[i]; int slot = -1;
            if (b > thr) slot = (int)__hip_atomic_fetch_add(&ctl[2], 1u, __ATOMIC_RELAXED, __HIP_MEMORY_SCOPE_WORKGROUP);
            else if (b == thr) { const unsigned q = __hip_atomic_fetch_add(&ctl[3], 1u, __ATOMIC_RELAXED, __HIP_MEMORY_SCOPE_WORKGROUP); if (q < rem) slot = (int)(ngt + q); }
            if (slot >= 0) { const int pair = pbase + slot, row = rs + i; PTOK[pair] = row; PG[pair] = __builtin_bit_cast(float, b); INV[(size_t)row * 16 + e] = pair; } }
    }
}
__device__ __forceinline__ void phase_gather(Frame& F) {
    const unsigned char* H2 = WSP(unsigned char, WS_H2); unsigned char* XG = WSP(unsigned char, WS_XG); unsigned char* HID = WSP(unsigned char, WS_HID); const int* PTOK = WSP(int, WS_PTOK);
    for (int p = F.gw; p < NPAIR; p += F.NGW) { const int tok = PTOK[p]; u32x4* dst = (u32x4*)(XG + (size_t)p * DM) + F.lane;
        unsigned zz = 0u; asm volatile("" : "+v"(zz));
        if (tok >= 0) { const u32x4* src = (const u32x4*)(H2 + (size_t)tok * DM) + F.lane; dst[0] = src[0]; dst[64] = src[64]; }
        else { dst[0] = (u32x4){zz, zz, zz, zz}; dst[64] = (u32x4){zz, zz, zz, zz}; }
        if (F.lane < 8) *((u32x4*)(HID + (size_t)p * EFFP + EFF) + F.lane) = (u32x4){zz, zz, zz, zz}; }
}
__device__ __forceinline__ void phase_ln2(Frame& F, const Args& a, int layer) {
    const float* mod = (const float*)(F.ws + WS_CTL) + CW_MOD + (size_t)layer * 3 * 6 * DM;
    float* XS = WSP(float, WS_XS); const bf16_t* YE = WSP(bf16_t, WS_YE); const int* INV = WSP(int, WS_INV); const float* PG = WSP(float, WS_PGATE);
    const float* g2w = arg_in(a, I_LN2G) + layer * DM; const float* b2w = arg_in(a, I_LN2B) + layer * DM;
    for (int row = F.gw; row < T; row += F.NGW) {
        f32x4* xr = (f32x4*)(XS + (size_t)row * DM) + F.lane; const float* m = mod + (size_t)row_modidx(row) * 6 * DM;
        f32x4 mo[8];
#pragma unroll
        for (int j = 0; j < 8; ++j) mo[j] = (f32x4){0.f, 0.f, 0.f, 0.f};
        const int myinv = F.lane < 16 ? INV[(size_t)row * 16 + F.lane] : -1;
        unsigned long long sel = __ballot(myinv >= 0);
        while (sel) {
            const int e0 = __builtin_ctzll(sel); sel &= sel - 1; const bool two = sel != 0; const int e1 = two ? __builtin_ctzll(sel) : e0; if (two) sel &= sel - 1;
            const int p0 = __builtin_amdgcn_readlane(myinv, e0), p1 = __builtin_amdgcn_readlane(myinv, e1);
            const u32x2* y0 = (const u32x2*)(YE + (size_t)p0 * DM) + F.lane; const u32x2* y1 = (const u32x2*)(YE + (size_t)p1 * DM) + F.lane;
            const float g0 = PG[p0], g1 = two ? PG[p1] : 0.f;
            u32x2 w0[8], w1[8];
#pragma unroll
            for (int j = 0; j < 8; ++j) { w0[j] = y0[64 * j]; w1[j] = y1[64 * j]; }
#pragma unroll
            for (int j = 0; j < 8; ++j) mo[j] += (f32x4){bflo(w0[j].x), bfhi(w0[j].x), bflo(w0[j].y), bfhi(w0[j].y)} * g0 + (f32x4){bflo(w1[j].x), bfhi(w1[j].x), bflo(w1[j].y), bfhi(w1[j].y)} * g1;
        }
        f32x4 v[8];
#pragma unroll
        for (int j = 0; j < 8; ++j) { const int c = 4 * (64 * j + F.lane); v[j] = xr[64 * j] * ALPHA + *(const f32x4*)(m + 5 * DM + c) * mo[j]; }
        float mean, rstd; row_stats(v, mean, rstd, 1e-6f);
#pragma unroll
        for (int j = 0; j < 8; ++j) { const int c = 4 * (64 * j + F.lane); v[j] = (v[j] - mean) * rstd * *(const f32x4*)(g2w + c) + *(const f32x4*)(b2w + c); xr[64 * j] = v[j]; }
        if (layer == DEPTH - 1) { if (row >= TC) { f32x4* o = (f32x4*)(a.out + (size_t)(row - TC) * DM) + F.lane;
#pragma unroll
            for (int j = 0; j < 8; ++j) o[64 * j] = v[j]; } }
        else {
            row_stats(v, mean, rstd, 1e-6f);
            const float* m1 = m + (size_t)3 * 6 * DM;
            bf16_t* H = WSP(bf16_t, WS_H); unsigned* H8 = WSP(unsigned, WS_H8);
            u32x2* o = (u32x2*)(H + (size_t)row * DM) + F.lane; unsigned* o8 = H8 + (size_t)row * (DM / 4) + F.lane;
#pragma unroll
            for (int j = 0; j < 8; ++j) { const int c = 4 * (64 * j + F.lane); const f32x4 sh = *(const f32x4*)(m1 + c), sc = *(const f32x4*)(m1 + DM + c);
                const f32x4 y = (v[j] - mean) * rstd * (sc + 1.f) + sh; u32x2 w; w.x = pk2(y.x, y.y); w.y = pk2(y.z, y.w); o[64 * j] = w; o8[64 * j] = pk4fp8(y.x, y.y, y.z, y.w); } }
    }
}

constexpr int LDS_BYTES = 153600, MISC_OFF = LDS_BYTES - 64;
constexpr int NPL = 16, NPHASE = 1 + DEPTH * NPL;

__global__ void __launch_bounds__(NTHREADS, 2) fwd_kernel(Args args) {
    extern __shared__ __attribute__((aligned(16))) unsigned char lds_raw[];
    Frame F;
    F.lds = (LAS unsigned char*)lds_raw;
    F.tid = threadIdx.x; F.lane = F.tid & 63; F.wave = __builtin_amdgcn_readfirstlane(F.tid >> 6); const int wave0 = F.wave;
    F.G = gridDim.x; F.bid = blockIdx.x; F.gw = F.bid * NWAVES + F.wave; F.NGW = F.G * NWAVES; F.ws = args.ws;
    volatile LAS unsigned* misc = (volatile LAS unsigned*)(F.lds + MISC_OFF);
    if (F.tid < 16) misc[F.tid] = 0u;
    __syncthreads();
    const int lo = args.ph_lo, hi = args.ph_hi;
    XcdBarrier bar; bar.bar = (unsigned*)(F.ws + WS_CTL) + CW_BAR; bar.x = 0; bar.st = nullptr;
    const bool multi = (hi - lo) > 1;
    if (multi) bar = xcd_barrier_post((unsigned*)(F.ws + WS_CTL) + CW_BAR, misc);
#ifndef ONLY_PHASE
#define ONLY_PHASE -1
#endif
#define PON(r) (ONLY_PHASE < 0 || ONLY_PHASE == (r))
#ifndef REP_MASK
#define REP_MASK 0
#endif
#define REP(b) ((REP_MASK >> (b)) & 1)
#define REOPQ() do { F.ws = opq(args.ws); F.lane = lane_asm() & 63; F.wave = opqs(wave0) & 7; F.tid = F.wave * 64 + F.lane; F.G = opqs(gridDim.x); F.bid = opqs(blockIdx.x); F.gw = F.bid * NWAVES + F.wave; F.NGW = F.G * NWAVES; } while (0)
#define IN(k) (lo <= (k) && (k) < hi)
#define SEAM(k) do { if (IN(k) && IN((k) + 1)) { XcdBarrier bb_ = bar; bb_.x = (unsigned)opqs((int)bar.x); xcd_barrier(bb_); } } while (0)
    if (PON(100) && IN(0)) { F.ws = opq(args.ws); F.lane = lane_asm() & 63; F.wave = opqs(wave0) & 7; F.tid = F.wave * 64 + F.lane; F.G = opqs(gridDim.x); F.bid = opqs(blockIdx.x); F.gw = F.bid * NWAVES + F.wave; F.NGW = F.G * NWAVES; { p0_weights(F, args); __syncthreads(); REOPQ(); p0_mod(F, args); __syncthreads(); REOPQ(); phase_hdn(F, args, 0); REOPQ(); phase_hdn(F, args, 1); __syncthreads(); } }
    SEAM(0);
#pragma unroll 1
    for (int layer = 0; layer < DEPTH; ++layer) {
        const int pb = 1 + layer * NPL; const bool lat_only = (layer == DEPTH - 1);
        if (PON(0) && IN(pb + 0)) { F.ws = opq(args.ws); F.lane = lane_asm() & 63; F.wave = opqs(wave0) & 7; F.tid = F.wave * 64 + F.lane; F.G = opqs(gridDim.x); F.bid = opqs(blockIdx.x); F.gw = F.bid * NWAVES + F.wave; F.NGW = F.G * NWAVES; if (layer == 0) phase_modln(F, args, layer); __syncthreads(); }
        SEAM(pb + 0);
        if (PON(1) && IN(pb + 1)) { F.ws = opq(args.ws); F.lane = lane_asm() & 63; F.wave = opqs(wave0) & 7; F.tid = F.wave * 64 + F.lane; F.G = opqs(gridDim.x); F.bid = opqs(blockIdx.x); F.gw = F.bid * NWAVES + F.wave; F.NGW = F.G * NWAVES;
            { pg8::Gemm g{WSP(bf16_t, WS_H), WSP(bf16_t, WS_WIN + layer * SZ_WIN), DM, DM, DM}; pg8::StaticOrder S; S.init(66, 13, F.G, F.bid, 0, 14);
              EpiBf16 E{WSP(bf16_t, WS_P), NNG, nullptr, 0, 0, 1.f, 1 << 30, 0};
              pg8::gemm_phase(F.lds, g, S, E, F.tid); }
            { pg8::Gemm g{WSP(bf16_t, WS_H8), WSP(bf16_t, WS_WIN + layer * SZ_WIN + WIN8P_OFF), DM / 2, DM / 2, DM / 2}; pg8::StaticOrder S; S.init(66, 27, F.G, (F.bid + 90) & 255);
              EpiBf16 E{WSP(bf16_t, WS_P), NNG, nullptr, 0, 0, 1.f / 64.f, 14, 13};
              pg8::gemm_phase<EpiBf16, pg8::StaticOrder, true>(F.lds, g, S, E, F.tid); }
        }
        SEAM(pb + 1);
        if (PON(2) && IN(pb + 2)) { F.ws = opq(args.ws); F.lane = lane_asm() & 63; F.wave = opqs(wave0) & 7; F.tid = F.wave * 64 + F.lane; F.G = opqs(gridDim.x); F.bid = opqs(blockIdx.x); F.gw = F.bid * NWAVES + F.wave; F.NGW = F.G * NWAVES; { phase_prep(F, args, layer); REOPQ(); phase_filt(F, args, layer); __syncthreads(); } }
        SEAM(pb + 2);
        if (PON(3) && IN(pb + 3)) { F.ws = opq(args.ws); F.lane = lane_asm() & 63; F.wave = opqs(wave0) & 7; F.tid = F.wave * 64 + F.lane; F.G = opqs(gridDim.x); F.bid = opqs(blockIdx.x); F.gw = F.bid * NWAVES + F.wave; F.NGW = F.G * NWAVES;
#if !defined(T3) || T3 == 0
            { pg8::Gemm g{WSP(bf16_t, WS_P) + P_CQ, WSP(bf16_t, WS_WQ + layer * SZ_WQ), NNG, 512, 512}; pg8::StaticOrder S; S.init(lat_only ? 64 : 66, 6, F.G, F.bid, lat_only ? 2 : 0);
              EpiBf16 E{WSP(bf16_t, WS_Q), 1536, WSP(float, WS_RS), 2, 0, 1.f, 1 << 30, 0}; pg8::gemm_phase(F.lds, g, S, E, F.tid); }
#endif
#if !defined(T3) || T3 == 1
            { pg8::Gemm g{WSP(bf16_t, WS_P) + P_CKV, WSP(bf16_t, WS_WKV + layer * SZ_WKV), NNG, 512, 512}; pg8::StaticOrder S; S.init(66, 8, F.G, (F.bid + 140) & 255);
              EpiBf16 E{WSP(bf16_t, WS_KV), 2048, WSP(float, WS_RS) + 1, 2, 0, 1.f, 1 << 30, 0}; pg8::gemm_phase(F.lds, g, S, E, F.tid); }
#endif
#if !defined(T3) || T3 == 2
            { pg8::Gemm g{WSP(bf16_t, WS_ALORA), WSP(bf16_t, WS_WLORA + layer * SZ_WLORA), 512, 512, 512}; pg8::StaticOrder S; S.init(66, 20, F.G, (F.bid + 156) & 255);
              EpiLora E{WSP(bf16_t, WS_EW), WSP(bf16_t, WS_ICLR), WSP(bf16_t, WS_GG), arg_in(args, I_RW0) + layer * 2048, arg_in(args, I_RA0) + layer * 2048}; pg8::gemm_phase(F.lds, g, S, E, F.tid); }
            REOPQ(); phase_mamba_states(F, args, layer); __syncthreads();
#endif
        }
        SEAM(pb + 3);
        SEAM(pb + 4);
        if (PON(5) && IN(pb + 5)) { F.ws = opq(args.ws); F.lane = lane_asm() & 63; F.wave = opqs(wave0) & 7; F.tid = F.wave * 64 + F.lane; F.G = opqs(gridDim.x); F.bid = opqs(blockIdx.x); F.gw = F.bid * NWAVES + F.wave; F.NGW = F.G * NWAVES;
#if !defined(T5) || T5 == 0
            phase_rwkv_scan(F, args, layer); __syncthreads();
#endif
#if !defined(T5) || T5 == 1
            REOPQ(); phase_attn(F, lat_only);
#endif
#if !defined(T5) || T5 == 2
            REOPQ(); phase_hyena_fft(F, args, layer);
#endif
#if !defined(T5) || T5 == 3
            REOPQ(); phase_mamba_scan(F); __syncthreads();
#endif
        }
        SEAM(pb + 5);
        if (PON(6) && IN(pb + 6)) { F.ws = opq(args.ws); F.lane = lane_asm() & 63; F.wave = opqs(wave0) & 7; F.tid = F.wave * 64 + F.lane; F.G = opqs(gridDim.x); F.bid = opqs(blockIdx.x); F.gw = F.bid * NWAVES + F.wave; F.NGW = F.G * NWAVES;
#if !defined(T6) || T6 == 0
            phase_mamba_out(F, args, layer); __syncthreads();
#endif
#if !defined(T6) || T6 == 1
            REOPQ(); phase_hyena_out(F, args, layer);
#endif
#if !defined(T6) || T6 == 2
            REOPQ(); phase_rwkv_out(F, args, layer); __syncthreads();
#endif
        }
        SEAM(pb + 6);
        if (PON(7) && IN(pb + 7)) { F.ws = opq(args.ws); F.lane = lane_asm() & 63; F.wave = opqs(wave0) & 7; F.tid = F.wave * 64 + F.lane; F.G = opqs(gridDim.x); F.bid = opqs(blockIdx.x); F.gw = F.bid * NWAVES + F.wave; F.NGW = F.G * NWAVES;
            pg8::Gemm g{WSP(bf16_t, WS_H8), WSP(bf16_t, WS_WIN + layer * SZ_WIN) + (size_t)NNG * DM, DM / 2, DM / 2, DM / 2}; pg8::StaticOrder S; S.init(lat_only ? 64 : 66, NGATE / 256, F.G, F.bid, lat_only ? 2 : 0);
            EpiBf16 E{WSP(bf16_t, WS_GATES), NGATE, nullptr, 0, 0, 1.f / 64.f, 1 << 30, 0};
            pg8::gemm_phase<EpiBf16, pg8::StaticOrder, true>(F.lds, g, S, E, F.tid);
            REOPQ(); phase_mamba_norm(F, args, layer);
        }
        SEAM(pb + 7);
        if (PON(8) && IN(pb + 8)) { F.ws = opq(args.ws); F.lane = lane_asm() & 63; F.wave = opqs(wave0) & 7; F.tid = F.wave * 64 + F.lane; F.G = opqs(gridDim.x); F.bid = opqs(blockIdx.x); F.gw = F.bid * NWAVES + F.wave; F.NGW = F.G * NWAVES;
            pg8::Gemm g{WSP(bf16_t, WS_Y), WSP(bf16_t, WS_WBR + layer * SZ_WBR), 1024, 1024, 1024}; OrderMerge S; S.init(F.G, F.bid, lat_only ? 64 : 66, lat_only ? 2 : 0);
            EpiMerge E{WSP(bf16_t, WS_GATES), WSP(bf16_t, WS_MRGB)};
            pg8::gemm_phase(F.lds, g, S, E, F.tid);

        }
        SEAM(pb + 8);
        if (PON(9) && IN(pb + 9)) { F.ws = opq(args.ws); F.lane = lane_asm() & 63; F.wave = opqs(wave0) & 7; F.tid = F.wave * 64 + F.lane; F.G = opqs(gridDim.x); F.bid = opqs(blockIdx.x); F.gw = F.bid * NWAVES + F.wave; F.NGW = F.G * NWAVES;
            pg8::Gemm g{WSP(bf16_t, WS_MRGB), WSP(bf16_t, WS_WOUT + layer * SZ_WOUT), DM, DM, DM}; pg8::StaticOrder S; S.init(lat_only ? 64 : 66, 8, F.G, F.bid, lat_only ? 2 : 0);
            EpiF32 E{WSP(float, WS_YMIX), DM};
            pg8::gemm_phase(F.lds, g, S, E, F.tid);

        }
        SEAM(pb + 9);
        if (PON(10) && IN(pb + 10)) { F.ws = opq(args.ws); F.lane = lane_asm() & 63; F.wave = opqs(wave0) & 7; F.tid = F.wave * 64 + F.lane; F.G = opqs(gridDim.x); F.bid = opqs(blockIdx.x); F.gw = F.bid * NWAVES + F.wave; F.NGW = F.G * NWAVES; phase_ln1(F, args, layer); __syncthreads(); { REOPQ(); conv_experts(F, args, layer); __syncthreads(); } }
        SEAM(pb + 10);
        if (PON(11) && IN(pb + 11)) { F.ws = opq(args.ws); F.lane = lane_asm() & 63; F.wave = opqs(wave0) & 7; F.tid = F.wave * 64 + F.lane; F.G = opqs(gridDim.x); F.bid = opqs(blockIdx.x); F.gw = F.bid * NWAVES + F.wave; F.NGW = F.G * NWAVES; phase_topk(F, lat_only); __syncthreads(); }
        SEAM(pb + 11);
        if (PON(12) && IN(pb + 12)) { F.ws = opq(args.ws); F.lane = lane_asm() & 63; F.wave = opqs(wave0) & 7; F.tid = F.wave * 64 + F.lane; F.G = opqs(gridDim.x); F.bid = opqs(blockIdx.x); F.gw = F.bid * NWAVES + F.wave; F.NGW = F.G * NWAVES; phase_gather(F); }
        SEAM(pb + 12);
        if (PON(13) && IN(pb + 13)) { F.ws = opq(args.ws); F.lane = lane_asm() & 63; F.wave = opqs(wave0) & 7; F.tid = F.wave * 64 + F.lane; F.G = opqs(gridDim.x); F.bid = opqs(blockIdx.x); F.gw = F.bid * NWAVES + F.wave; F.NGW = F.G * NWAVES;
            pg8::Gemm g{WSP(bf16_t, WS_XG), WSP(bf16_t, WS_WE), DM / 2, DM / 2, DM / 2}; OrderMoe S; S.init(11, F.G, F.bid, lat_only ? 8 : 9);
            EpiSwiglu E{WSP(unsigned char, WS_HID)};
            pg8::gemm_phase<EpiSwiglu, OrderMoe, true>(F.lds, g, S, E, F.tid);

        }
        SEAM(pb + 13);
        if (PON(14) && IN(pb + 14)) { F.ws = opq(args.ws); F.lane = lane_asm() & 63; F.wave = opqs(wave0) & 7; F.tid = F.wave * 64 + F.lane; F.G = opqs(gridDim.x); F.bid = opqs(blockIdx.x); F.gw = F.bid * NWAVES + F.wave; F.NGW = F.G * NWAVES;
            pg8::Gemm g{WSP(bf16_t, WS_HID), WSP(bf16_t, WS_WE + SZ_WGU8), EFFP / 2, EFFP / 2, EFFP / 2}; OrderMoe S; S.init(8, F.G, F.bid, lat_only ? 8 : 9);
            EpiDown E{WSP(bf16_t, WS_YE)};
            pg8::gemm_phase<EpiDown, OrderMoe, true>(F.lds, g, S, E, F.tid);

        }
        SEAM(pb + 14);
        if (PON(15) && IN(pb + 15)) { F.ws = opq(args.ws); F.lane = lane_asm() & 63; F.wave = opqs(wave0) & 7; F.tid = F.wave * 64 + F.lane; F.G = opqs(gridDim.x); F.bid = opqs(blockIdx.x); F.gw = F.bid * NWAVES + F.wave; F.NGW = F.G * NWAVES; phase_ln2(F, args, layer); }
        SEAM(pb + 15);
    }
#undef IN
#undef SEAM
}


#ifdef DBG_CUT
__global__ void dbg_dump(const unsigned char* ws, float* out, size_t off, int is_bf16, size_t n_src) {
    const size_t N = (size_t)TL * DM;
    for (size_t i = (size_t)blockIdx.x * blockDim.x + threadIdx.x; i < N; i += (size_t)gridDim.x * blockDim.x) {
        const size_t j = i % n_src;
        out[i] = is_bf16 ? bf2f(((const bf16_t*)(ws + off))[j]) : ((const float*)(ws + off))[j];
    }
}
#endif

#ifdef DBG_PASSES
__global__ void dbg_chk(const unsigned char* base, size_t off, size_t nbytes, unsigned long long* slot) {
    const unsigned* p = (const unsigned*)(base + off); const size_t n = nbytes / 4; unsigned long long s = 0;
    for (size_t i = (size_t)blockIdx.x * blockDim.x + threadIdx.x; i < n; i += (size_t)gridDim.x * blockDim.x) s += p[i];
    for (int o = 32; o > 0; o >>= 1) s += __shfl_xor(s, o);
    if ((threadIdx.x & 63) == 0) atomicAdd(slot, s);
}
__global__ void dbg_report(const unsigned long long* tab, float* out, int npass) {
    int k = 0;
    for (int ph = NPHASE - 1; ph >= 0; --ph) if (tab[ph] != tab[64 + ph]) k = ph + 1;
    if (k == 0 && npass > 2) { for (int ph = NPHASE - 1; ph >= 0; --ph) if (tab[64 + ph] != tab[128 + ph]) k = 50 + ph + 1; }
    if (k == 0) return;
    const float c = sqrtf(10.f * (float)k);
    for (size_t i = (size_t)blockIdx.x * blockDim.x + threadIdx.x; i < (size_t)TL * DM; i += (size_t)gridDim.x * blockDim.x) out[i] = c;
}
struct DbgReg { size_t off, n; };
#endif
extern "C" void kernel_launch(void* const* d_in, const int* in_sizes, int n_in, void* d_out, int out_size, void* d_ws, size_t ws_size, hipStream_t stream) {
    static int grid = 0;
    if (grid == 0) {
        if (n_in != N_INPUTS || in_sizes[0] != TL * DM || out_size != TL * DM || ws_size < WS_END) {
            fprintf(stderr, "kernel_launch: shape/workspace mismatch: n_in %d in0 %d out %d ws %zu (need %zu)\n", n_in, n_in > 0 ? in_sizes[0] : -1, out_size, ws_size, (size_t)WS_END); grid = -1; return; }
        int dev = 0, cus = 0, per_cu = 0;
        if (hipGetDevice(&dev) != hipSuccess || hipDeviceGetAttribute(&cus, hipDeviceAttributeMultiprocessorCount, dev) != hipSuccess) { grid = -1; return; }
        if (hipFuncSetAttribute((const void*)fwd_kernel, hipFuncAttributeMaxDynamicSharedMemorySize, LDS_BYTES) != hipSuccess) { fprintf(stderr, "kernel_launch: hipFuncSetAttribute failed\n"); grid = -1; return; }
        if (hipOccupancyMaxActiveBlocksPerMultiprocessor(&per_cu, (const void*)fwd_kernel, NTHREADS, LDS_BYTES) != hipSuccess || per_cu < 1) { fprintf(stderr, "kernel_launch: occupancy query says %d\n", per_cu); grid = -1; (void)hipGetLastError(); return; }
        grid = cus;
    }
    if (grid < 0) return;
    (void)hipMemsetAsync((char*)d_ws + WS_CTL, 0, CTL_BYTES, stream);
    Args a{};
    for (int i = 0; i < N_INPUTS; ++i) a.in[i] = (const float*)d_in[i];
    a.out = (float*)d_out; a.ws = (unsigned char*)d_ws;
#if MK_ONE_LAUNCH
    a.ph_lo = 0; a.ph_hi = NPHASE;
    hipLaunchKernelGGL(fwd_kernel, dim3(grid), dim3(NTHREADS), LDS_BYTES, stream, a);
#else
#ifdef DBG_PASSES
    {
        unsigned long long* tab = (unsigned long long*)((char*)d_ws + 1600000);
        auto chk = [&](int pass, int ph, size_t off, size_t n) { hipLaunchKernelGGL(dbg_chk, dim3(1024), dim3(256), 0, stream, (const unsigned char*)d_ws, off, n, tab + pass * 64 + ph); };
        for (int pass = 0; pass < DBG_PASSES; ++pass) {
            if (pass > 0) (void)hipMemsetAsync((char*)d_ws + (size_t)CW_MOD * 4, 0, (size_t)DEPTH * 3 * 6 * DM * 4, stream);
            for (int ph = 0; ph < NPHASE; ++ph) {
                a.ph_lo = ph; a.ph_hi = ph + 1; hipLaunchKernelGGL(fwd_kernel, dim3(grid), dim3(NTHREADS), LDS_BYTES, stream, a);
                if (ph == 0) { chk(pass, ph, WS_WIN, WS_XS - WS_WIN); chk(pass, ph, (size_t)CW_MOD * 4, (size_t)DEPTH * 3 * 6 * DM * 4); continue; }
                const int r = (ph - 1) % NPL;
                switch (r) {
                case 0: chk(pass, ph, WS_H, SZ_H); chk(pass, ph, WS_HDN, SZ_HDN); break;
                case 1: chk(pass, ph, WS_P, SZ_P); break;
                case 2: chk(pass, ph, WS_P2, SZ_P2); chk(pass, ph, WS_KK, SZ_TK2); chk(pass, ph, WS_ALORA, WS_VT - WS_ALORA); chk(pass, ph, WS_VT, WS_HDN - WS_VT); break;
                case 3: chk(pass, ph, WS_Q, SZ_Q + SZ_KV); chk(pass, ph, WS_EW, 4 * SZ_TK2); chk(pass, ph, WS_GG, SZ_TK2); break;
                case 4: chk(pass, ph, WS_Q, SZ_Q); chk(pass, ph, WS_MST, SZ_MST + SZ_MCS); break;
                case 5: chk(pass, ph, WS_YRW, 2 * SZ_TK2); chk(pass, ph, WS_Y, SZ_Y / 4); chk(pass, ph, WS_VT, SZ_VT); chk(pass, ph, WS_MST, SZ_MST); break;
                case 6: chk(pass, ph, WS_Y + SZ_Y / 4, 3 * (SZ_Y / 4)); break;
                case 7: chk(pass, ph, WS_GATES, SZ_GATES); chk(pass, ph, WS_Y + SZ_Y / 4, SZ_Y / 4); break;
                case 8: chk(pass, ph, WS_MRGF, SZ_MRGF); chk(pass, ph, WS_MRGB, SZ_MRGB); break;
                case 9: chk(pass, ph, WS_YMIX, SZ_YMIX); break;
                case 10: chk(pass, ph, WS_XS, SZ_XS); chk(pass, ph, WS_H2, SZ_H); chk(pass, ph, WS_AFF, SZ_AFF); chk(pass, ph, WS_WE, SZ_WGU + SZ_WD); break;
                case 11: chk(pass, ph, WS_INV, SZ_INV + SZ_PTOK + SZ_PGATE); break;
                case 12: chk(pass, ph, WS_XG, SZ_XG); break;
                case 13: chk(pass, ph, WS_HID, SZ_HID); break;
                case 14: chk(pass, ph, WS_YE, SZ_YE); break;
                case 15: chk(pass, ph, WS_XS, SZ_XS); break;
                }
            }
        }
        hipLaunchKernelGGL(dbg_report, dim3(2048), dim3(256), 0, stream, (const unsigned long long*)tab, (float*)d_out, (int)DBG_PASSES);
    }
#elif defined(DBG_CUT)
    for (int ph = 0; ph < DBG_CUT; ++ph) { a.ph_lo = ph; a.ph_hi = ph + 1; hipLaunchKernelGGL(fwd_kernel, dim3(grid), dim3(NTHREADS), LDS_BYTES, stream, a); }
    hipLaunchKernelGGL(dbg_dump, dim3(2048), dim3(256), 0, stream, (const unsigned char*)d_ws, (float*)d_out, (size_t)DBG_OFF, DBG_BF16, (size_t)DBG_N);
#else
    for (int ph = 0; ph < NPHASE; ++ph) { a.ph_lo = ph; a.ph_hi = ph + 1; hipLaunchKernelGGL(fwd_kernel, dim3(grid), dim3(NTHREADS), LDS_BYTES, stream, a); }
#endif
#endif
}
```

```cpp
#include <hip/hip_runtime.h>
#include <cstdio>
#include <cstdint>

#define REP_MASK 0x80000
#ifndef MK_ONE_LAUNCH
#define MK_ONE_LAUNCH 1
#endif

#define LAS __attribute__((address_space(3)))
typedef unsigned short bf16_t;
typedef short bf16x8 __attribute__((ext_vector_type(8)));
typedef float f32x4 __attribute__((ext_vector_type(4)));
typedef float f32x2 __attribute__((ext_vector_type(2)));
typedef unsigned u32x4 __attribute__((ext_vector_type(4)));
typedef unsigned u32x2 __attribute__((ext_vector_type(2)));

constexpr int DM = 2048, NBATCH = 2, SEQ = 8192, CTX = 256, DEPTH = 2;
constexpr int TC = NBATCH * CTX, TL = NBATCH * SEQ, T = TC + TL;
constexpr int NIN = 18432, NNG = 10240, NGATE = 8192;
constexpr int P_CQ = 0, P_CKV = 512, P_KPE = 1024;
constexpr int P_Z = 1088, P_XBC = 2112, P_DT = 3648;
constexpr int P_HY = 3680;
constexpr int P_RW = 6752, P_WD = 9824, P_AD = 9952, P_GD = 10080;
constexpr int NH_MLA = 8, NH_SSM = 16, NH_RW = 16;
constexpr int NEXP = 16, EFF = 1408, CAP_L = 1024, CAP_C = 32;
constexpr int NPAIR = NBATCH * NEXP * CAP_L + NEXP * 256;
constexpr float ALPHA = 1.4142135623730951f;
constexpr int NWAVES = 8, NTHREADS = 512;

__device__ __forceinline__ int seg_of(int row) { return row < 256 ? 0 : row < 512 ? 1 : row < 512 + SEQ ? 2 : 3; }
__device__ __forceinline__ int seg_start(int s) { return s == 0 ? 0 : s == 1 ? 256 : s == 2 ? 512 : 512 + SEQ; }
__device__ __forceinline__ int seg_len(int s) { return s < 2 ? CTX : SEQ; }
__device__ __forceinline__ bool row_first(int row) { return row == 0 || row == 256 || row == 512 || row == 512 + SEQ; }
__device__ __forceinline__ bool row_last(int row) { return row == 255 || row == 511 || row == 511 + SEQ || row == T - 1; }
__device__ __forceinline__ int row_modidx(int row) { return row < 512 ? 2 : (row < 512 + SEQ ? 0 : 1); }

constexpr size_t AL(size_t x) { return (x + 255) / 256 * 256; }
constexpr size_t WS_CTL = 0, CTL_BYTES = 2u << 20;
constexpr int CW_BAR = 1024;
constexpr int CW_MOD = 16384;
constexpr size_t SZ_WIN = (size_t)NIN * DM * 2, SZ_WBR = (size_t)4 * DM * 1024 * 2, SZ_WOUT = (size_t)DM * DM * 2, SZ_WQ = (size_t)1536 * 512 * 2,
                 SZ_WKV = (size_t)2048 * 512 * 2, SZ_WLORA = (size_t)5120 * 512 * 2;
constexpr size_t WS_WIN = CTL_BYTES, WS_WBR = WS_WIN + DEPTH * SZ_WIN, WS_WOUT = WS_WBR + DEPTH * SZ_WBR, WS_WQ = WS_WOUT + DEPTH * SZ_WOUT,
                 WS_WKV = WS_WQ + DEPTH * SZ_WQ, WS_WLORA = WS_WKV + DEPTH * SZ_WKV, WS_XS = WS_WLORA + DEPTH * SZ_WLORA;
constexpr size_t SZ_XS = (size_t)T * DM * 4;
constexpr size_t WIN8P_OFF = (size_t)NNG * DM * 2 + (size_t)NGATE * DM;
static_assert(WIN8P_OFF + (size_t)27 * 256 * DM <= SZ_WIN, "w_in area");
constexpr size_t WS_H = WS_XS + SZ_XS, SZ_H = (size_t)T * DM * 2;
constexpr size_t WS_P = WS_H + SZ_H, SZ_P = (size_t)T * NNG * 2;
constexpr int P2W = 5632, P2_XBC = 0, P2_X0 = 1536, P2_RKV = 2560;
constexpr size_t WS_P2 = WS_P + SZ_P, SZ_P2 = (size_t)T * P2W * 2;
constexpr size_t WS_Q = WS_P2 + SZ_P2, SZ_Q = (size_t)T * 1536 * 2;
constexpr size_t WS_KV = WS_Q + SZ_Q, SZ_KV = (size_t)T * 2048 * 2;
constexpr size_t WS_EW = WS_KV + SZ_KV, SZ_TK2 = (size_t)T * 1024 * 2;
constexpr size_t WS_ICLR = WS_EW + 2 * SZ_TK2;
constexpr size_t WS_KK = WS_ICLR + 2 * SZ_TK2;
constexpr size_t WS_GG = WS_KK + SZ_TK2;
constexpr size_t WS_YRW = WS_GG + SZ_TK2;
constexpr size_t WS_ALORA = WS_YRW + 2 * SZ_TK2, SZ_ALORA = (size_t)T * 512 * 2;
constexpr size_t WS_KPE = WS_ALORA + SZ_ALORA, SZ_KPE = (size_t)T * 64 * 2;
constexpr size_t WS_RS = WS_KPE + SZ_KPE, SZ_RS = AL((size_t)T * 2 * 4);
constexpr size_t WS_DT = WS_RS + SZ_RS, SZ_DT = (size_t)T * 32 * 4;
constexpr size_t WS_VT = WS_DT + SZ_DT, SZ_VT = (size_t)1024 * 2 * SEQ * 4;
constexpr size_t WS_VC = WS_VT + SZ_VT, SZ_VC = (size_t)TC * 1024 * 4;
constexpr size_t WS_FILT = WS_VC + SZ_VC, SZ_FILT = (size_t)1024 * 2 * SEQ * 2;
constexpr size_t WS_FILTC = WS_FILT + SZ_FILT, SZ_FILTC = (size_t)CTX * 2048 * 4;
constexpr size_t WS_HDN = WS_FILTC + SZ_FILTC, SZ_HDN1 = (size_t)(SEQ + CTX) * 64 * 4, SZ_HDN = DEPTH * SZ_HDN1;
constexpr int NCHUNK = T / 128;
constexpr size_t WS_MST = WS_HDN + SZ_HDN, SZ_MST = (size_t)2 * NCHUNK * 16 * 8192 * 2;
constexpr size_t WS_MCS = WS_MST + SZ_MST, SZ_MCS = (size_t)2 * NCHUNK * 16 * 4 * 2;
constexpr size_t WS_Y = WS_MCS + AL(SZ_MCS), SZ_Y = (size_t)4 * T * 1024 * 2;
constexpr size_t WS_AFF = WS_Y + SZ_Y, SZ_AFF = (size_t)T * 16 * 4;
constexpr size_t WS_INV = WS_AFF + SZ_AFF, SZ_INV = (size_t)T * 16 * 4;
constexpr size_t WS_PTOK = WS_INV + SZ_INV, SZ_PTOK = (size_t)NPAIR * 4;
constexpr size_t WS_PGATE = WS_PTOK + SZ_PTOK, SZ_PGATE = (size_t)NPAIR * 4;
constexpr size_t WS_H8 = WS_PGATE + SZ_PGATE, SZ_H8 = (size_t)T * DM;
constexpr size_t WS_CQ8 = WS_H8 + SZ_H8, SZ_CQ8 = (size_t)T * 1024;
constexpr size_t WS_END = WS_CQ8 + SZ_CQ8;
constexpr size_t WS_GATES = WS_P, SZ_GATES = (size_t)T * NGATE * 2;
constexpr size_t WS_MRGF = WS_P2, SZ_MRGF = (size_t)T * DM * 4;
constexpr size_t WS_MRGB = WS_Q, SZ_MRGB = (size_t)T * DM * 2;
constexpr size_t WS_YMIX = WS_P, SZ_YMIX = (size_t)T * DM * 4;
constexpr size_t WS_H2 = WS_H;
constexpr size_t WS_WE = WS_P2, SZ_WGU = (size_t)NEXP * 2816 * DM * 2, SZ_WD = (size_t)NEXP * DM * EFF * 2;
constexpr size_t WS_XG = WS_P, SZ_XG = (size_t)NPAIR * DM * 2;
constexpr size_t WS_HID = WS_XG + SZ_XG, SZ_HID = (size_t)NPAIR * EFF * 2;
constexpr size_t WS_YE = WS_WE + SZ_WGU + SZ_WD, SZ_YE = (size_t)NPAIR * DM * 2;
static_assert(SZ_GATES <= SZ_P && SZ_MRGF <= SZ_P2 && SZ_MRGB <= SZ_Q + SZ_KV && SZ_YMIX <= SZ_P, "alias map 1");
static_assert(SZ_XG + SZ_HID <= SZ_P, "alias map 2");
static_assert(WS_YE + SZ_YE <= WS_VT, "alias map 3");
static_assert(WS_END < 1800000000ull, "workspace budget");

__device__ __forceinline__ unsigned f2bf(float f) { unsigned u = __builtin_bit_cast(unsigned, f); return (u + 0x7fffu + ((u >> 16) & 1u)) >> 16; }
__device__ __forceinline__ unsigned pk2(float lo, float hi) { return f2bf(lo) | (f2bf(hi) << 16); }
__device__ __forceinline__ float bf2f(unsigned short b) { return __builtin_bit_cast(float, (unsigned)b << 16); }
__device__ __forceinline__ float bflo(unsigned w) { return __builtin_bit_cast(float, w << 16); }
__device__ __forceinline__ float bfhi(unsigned w) { return __builtin_bit_cast(float, w & 0xffff0000u); }
__device__ __forceinline__ unsigned cvt_pk_bf16(float lo, float hi) { unsigned r; asm volatile("v_cvt_pk_bf16_f32 %0, %1, %2" : "=v"(r) : "v"(lo), "v"(hi)); return r; }
__device__ __forceinline__ float dppx(float x, const int sel) {
    const int xi = __builtin_bit_cast(int, x); int r;
    if (sel == 0) r = __builtin_amdgcn_update_dpp(0, xi, 0xB1, 0xF, 0xF, false);
    else if (sel == 1) r = __builtin_amdgcn_update_dpp(0, xi, 0x4E, 0xF, 0xF, false);
    else if (sel == 2) r = __builtin_amdgcn_update_dpp(0, xi, 0x141, 0xF, 0xF, false);
    else r = __builtin_amdgcn_update_dpp(0, xi, 0x140, 0xF, 0xF, false);
    return __builtin_bit_cast(float, r);
}
__device__ __forceinline__ float swz16(float x) { return __builtin_bit_cast(float, __builtin_amdgcn_ds_swizzle(__builtin_bit_cast(int, x), 0x401F)); }
__device__ __forceinline__ float sum4(float v) { v += dppx(v, 0); v += dppx(v, 1); return v; }
__device__ __forceinline__ float sum8(float v) { v = sum4(v); v += dppx(v, 2); return v; }
__device__ __forceinline__ float sum16(float v) { v = sum8(v); v += dppx(v, 3); return v; }
__device__ __forceinline__ float sum32(float v) { v = sum16(v); v += swz16(v); return v; }
__device__ __forceinline__ unsigned pk4fp8(float a, float b, float c, float d) { int w = 0; w = __builtin_amdgcn_cvt_pk_fp8_f32(a, b, w, false); w = __builtin_amdgcn_cvt_pk_fp8_f32(c, d, w, true); return (unsigned)w; }
__device__ __forceinline__ float wave_sum(float v) {
    v = sum32(v);
    auto rr = __builtin_amdgcn_permlane32_swap(__float_as_uint(v), __float_as_uint(v), false, false);
    return __uint_as_float(rr[0]) + __uint_as_float(rr[1]);
}
__device__ __forceinline__ float sigmoidf_(float x) { return 1.f / (1.f + __expf(-x)); }
__device__ __forceinline__ float siluf_(float x) { return x / (1.f + __expf(-x)); }
__device__ __forceinline__ float softplusf_(float x) { return x > 20.f ? x : __logf(1.f + __expf(x)); }
__device__ __forceinline__ float tanhf_(float x) { const float e = __expf(2.f * fminf(x, 15.f)); return 1.f - 2.f / (e + 1.f); }
#define LDS_WAIT() asm volatile("s_waitcnt lgkmcnt(0)" ::: "memory")
#define VM_WAIT() asm volatile("s_waitcnt vmcnt(0)" ::: "memory")

#define XB_TMO      128
#define XB_XCNT(j)  (256  + 64 * (j))
#define XB_XSUB(j)  (1280 + 64 * (j))
#define XB_XGEN(j)  (2304 + 64 * (j))
#define XB_TOP      3328
#define XB_TOPGEN   3392
#define XCD_BAR_WORDS 3456
#define XB_SPIN_CAP (1u << 18)
__device__ __forceinline__ unsigned xb_ld(unsigned* p)              { return __hip_atomic_load(p, __ATOMIC_RELAXED, __HIP_MEMORY_SCOPE_AGENT); }
__device__ __forceinline__ unsigned xb_add(unsigned* p, unsigned v) { return __hip_atomic_fetch_add(p, v, __ATOMIC_RELAXED, __HIP_MEMORY_SCOPE_AGENT); }
__device__ __forceinline__ unsigned xb_xcc_id() { return (unsigned)__builtin_amdgcn_s_getreg((3 << 11) | 20) & 0xFu; }
#define XB_SPIN(cond, bar) do { unsigned _sp = 0; while (cond) { __builtin_amdgcn_s_sleep(1); \
    if ((++_sp & 255u) == 0u) { if (xb_ld(&(bar)[XB_TMO])) break; if (_sp > XB_SPIN_CAP) { atomicAdd(&(bar)[XB_TMO], 1u); break; } } } } while (0)
struct XcdBarrier { unsigned* bar; unsigned x; volatile LAS unsigned* st; };
__device__ __forceinline__ XcdBarrier xcd_barrier_post(unsigned* bar, volatile LAS unsigned* st) {
    XcdBarrier b; b.bar = bar; b.x = xb_xcc_id(); b.st = st;
    if (threadIdx.x == 0) (void)xb_add(&bar[XB_XCNT(b.x)], 1u);
    return b;
}
__device__ __forceinline__ void xcd_barrier_complete(unsigned* bar, unsigned x, unsigned& nloc, unsigned& nx) {
    const unsigned G = gridDim.x * gridDim.y * gridDim.z;
    unsigned sum, cnt, mine, sp = 0u;
    for (;;) {
        sum = 0u; cnt = 0u; mine = 0u;
#pragma unroll
        for (unsigned j = 0; j < 16; ++j) { const unsigned c = xb_ld(&bar[XB_XCNT(j)]); sum += c; cnt += (c > 0u) ? 1u : 0u; mine = (j == x) ? c : mine; }
        if (sum == G) break;
        __builtin_amdgcn_s_sleep(1);
        if ((++sp & 255u) == 0u) { if (xb_ld(&bar[XB_TMO])) break; if (sp > XB_SPIN_CAP) { atomicAdd(&bar[XB_TMO], 1u); break; } }
    }
    nloc = mine > 0u ? mine : 1u; nx = cnt > 0u ? cnt : 1u;
}
__device__ __forceinline__ void xcd_barrier(const XcdBarrier& b) {
    asm volatile("s_waitcnt vmcnt(0)" ::: "memory");
    __syncthreads();
    if (threadIdx.x == 0) {
        unsigned* bar = b.bar;
        __builtin_amdgcn_s_waitcnt(0);
        unsigned nloc = b.st[0], nx = b.st[1];
        if (nloc == 0u) { xcd_barrier_complete(bar, b.x, nloc, nx); b.st[0] = nloc; b.st[1] = nx; }
        const unsigned old = xb_add(&bar[XB_XSUB(b.x)], 1u);
        const unsigned gen = old / nloc;
        if (old + 1u == (gen + 1u) * nloc) {
            __builtin_amdgcn_fence(__ATOMIC_RELEASE, "agent");
            asm volatile("s_waitcnt vmcnt(0)" ::: "memory");
            const unsigned og = xb_add(&bar[XB_TOP], 1u);
            const unsigned tg = og / nx;
            if (og + 1u == (tg + 1u) * nx) xb_add(&bar[XB_TOPGEN], 1u);
            else XB_SPIN(xb_ld(&bar[XB_TOPGEN]) == tg, bar);
            __builtin_amdgcn_fence(__ATOMIC_ACQUIRE, "agent");
            xb_add(&bar[XB_XGEN(b.x)], 1u);
            asm volatile("s_waitcnt vmcnt(0)" ::: "memory");
        } else {
            XB_SPIN(xb_ld(&bar[XB_XGEN(b.x)]) == gen, bar);
            __builtin_amdgcn_fence(__ATOMIC_ACQUIRE, "agent");
            asm volatile("s_waitcnt vmcnt(0)" ::: "memory");
        }
    }
    __syncthreads();
}

__device__ __forceinline__ int lane_asm() { int l; asm volatile("v_mbcnt_lo_u32_b32 %0, -1, 0\n\tv_mbcnt_hi_u32_b32 %0, -1, %0" : "=v"(l)); return l; }
namespace pg8 {
constexpr int BM = 256, BK = 64, HALF = 128, HTB = HALF * BK * 2, STAGE_BYTES = 8 * HTB, NXCD = 8, WGM = 8;
__host__ __device__ __forceinline__ int lds_byte(int r, int c) { const int st = (r >> 4) * 2 + (c >> 5), rr = r & 15, cc = c & 31, ob = rr * 64 + cc * 2; return st * 1024 + (ob ^ (((ob >> 9) & 1) << 5)); }
__host__ __device__ __forceinline__ void stage_rc(int b, int& R, int& C) { const int st = b / 1024, sb = b % 1024, swz = sb ^ (((sb >> 9) & 1) << 5); R = (st >> 1) * 16 + swz / 64; C = (st & 1) * 32 + (swz % 64) / 2; }
__host__ __device__ __forceinline__ int perm32(int rho) { const int n = rho >> 4, i = rho & 15; return 8 * (i >> 2) + 4 * n + (i & 3); }
struct Unit { int pm, pn; };
struct Gemm { const bf16_t* A; const bf16_t* Bt; int lda, ldb, K; };
struct StaticOrder {
    int nM, nN, nwg, G, c, pm0, pn0;
    __device__ void init(int nM_, int nN_, int G_, int c_, int pm0_ = 0, int pn0_ = 0) { nM = nM_; nN = nN_; nwg = nM * nN; G = G_; c = c_; pm0 = pm0_; pn0 = pn0_; }
    __device__ bool next(int i, Unit& u) const {
        const long L = (long)i * G + c; if (L >= nwg) return false;
        int wgid = (int)L; { const int q = nwg / NXCD, r = nwg % NXCD, xcd = wgid % NXCD, off = wgid / NXCD; wgid = (xcd < r ? xcd * (q + 1) : r * (q + 1) + (xcd - r) * q) + off; }
        const int nig = WGM * nN, gid = wgid / nig, fm = gid * WGM, gsz = (nM - fm) < WGM ? (nM - fm) : WGM;
        u.pm = pm0 + fm + ((wgid % nig) % gsz); u.pn = pn0 + (wgid % nig) / gsz; return true;
    }
};
typedef int i32x4v __attribute__((ext_vector_type(4)));
typedef int i32x8v __attribute__((ext_vector_type(8)));
__device__ __forceinline__ i32x8v cat8(bf16x8 a, bf16x8 b) { return __builtin_shufflevector(__builtin_bit_cast(i32x4v, a), __builtin_bit_cast(i32x4v, b), 0, 1, 2, 3, 4, 5, 6, 7); }
template <class Epi, class Sched, bool FP8 = false>
__device__ __forceinline__ void gemm_phase(LAS unsigned char* lds, const Gemm g, const Sched& S, const Epi& E, int tid_in) {
    constexpr bool ALIGN_EPI = true;
    const unsigned tid_u = (unsigned)tid_in; __builtin_assume(tid_u < 512u);
    const int tid = (int)tid_u, wid = __builtin_amdgcn_readfirstlane(tid >> 6), lane = tid & 63, wr = wid >> 2, wc = wid & 3, fr = lane & 15, fq = lane >> 4;
    const int K = g.K, nt = K / BK;
    unsigned voffA[2], voffB[2];
#pragma unroll
    for (int i = 0; i < 2; ++i) { int R, C; stage_rc(tid * 16 + i * 8192, R, C); const int Rb = Epi::PERM ? ((R & ~31) + perm32(R & 31)) : R;
        voffA[i] = (unsigned)(R * g.lda + C) * 2u; voffB[i] = (unsigned)(Rb * g.ldb + C) * 2u; }
    const unsigned kstep = (unsigned)(BK * 2);
    const unsigned hstepA = (unsigned)HALF * g.lda * 2u, hstepB = (unsigned)HALF * g.ldb * 2u;
    const unsigned tstepA = 2u * hstepA, tstepB = 2u * hstepB;
    const unsigned ldsw = (unsigned)wid * 1024u;
    const int aoff = lds_byte(wr * 64 + fr, fq * 8), boff = lds_byte(wc * 32 + fr, fq * 8);
    const __amdgpu_buffer_rsrc_t rsA = __builtin_amdgcn_make_buffer_rsrc((void*)g.A, 0, 0xFFFFFFFFu, 0x00020000);
    const __amdgpu_buffer_rsrc_t rsB = __builtin_amdgcn_make_buffer_rsrc((void*)g.Bt, 0, 0xFFFFFFFFu, 0x00020000);
#define PG8_SA(b, h) (((b) * 2 + (h)) * HTB)
#define PG8_SB(b, h) ((4 + (b) * 2 + (h)) * HTB)
#define PG8_STAGE(bufoff, rs, soff, voff) do { _Pragma("unroll") for (int _i = 0; _i < 2; ++_i) \
        __builtin_amdgcn_raw_ptr_buffer_load_lds(rs, (LAS unsigned*)(lds + (bufoff) + ldsw + _i * 8192), 16, (int)(voff)[_i], (int)(soff), 0, 0); } while (0)
#define PG8_LDA(dst, b, h) do { if constexpr (FP8) { _Pragma("unroll") for (int m = 0; m < 4; ++m) dst##8[m] = __builtin_shufflevector(*(const LAS i32x4v*)(lds + PG8_SA(b, h) + aoff + m * 2048), *(const LAS i32x4v*)(lds + PG8_SA(b, h) + aoff + m * 2048 + 1024), 0, 1, 2, 3, 4, 5, 6, 7); } \
    else { _Pragma("unroll") for (int m = 0; m < 4; ++m) _Pragma("unroll") for (int k = 0; k < 2; ++k) dst[m][k] = *(const LAS bf16x8*)(lds + PG8_SA(b, h) + aoff + m * 2048 + k * 1024); } } while (0)
#define PG8_LDB(dst, b, h) do { if constexpr (FP8) { _Pragma("unroll") for (int n = 0; n < 2; ++n) dst##8[n] = __builtin_shufflevector(*(const LAS i32x4v*)(lds + PG8_SB(b, h) + boff + n * 2048), *(const LAS i32x4v*)(lds + PG8_SB(b, h) + boff + n * 2048 + 1024), 0, 1, 2, 3, 4, 5, 6, 7); } \
    else { _Pragma("unroll") for (int n = 0; n < 2; ++n) _Pragma("unroll") for (int k = 0; k < 2; ++k) dst[n][k] = *(const LAS bf16x8*)(lds + PG8_SB(b, h) + boff + n * 2048 + k * 1024); } } while (0)
#define PG8_MMA(ai, bj, At, Bt) do { __builtin_amdgcn_s_setprio(1); if constexpr (FP8) { _Pragma("unroll") for (int m = 0; m < 4; ++m) _Pragma("unroll") for (int n = 0; n < 2; ++n) \
        asm volatile("v_mfma_scale_f32_16x16x128_f8f6f4 %0, %1, %2, %0, %3, %3 op_sel_hi:[0,0,0]" : "+v"(acc[ai][bj][m][n]) : "v"(Bt##8[n]), "v"(At##8[m]), "v"(sc1)); } else { \
        _Pragma("unroll") for (int m = 0; m < 4; ++m) _Pragma("unroll") for (int n = 0; n < 2; ++n) _Pragma("unroll") for (int k = 0; k < 2; ++k) \
        acc[ai][bj][m][n] = __builtin_amdgcn_mfma_f32_16x16x32_bf16(Bt[n][k], At[m][k], acc[ai][bj][m][n], 0, 0, 0); } __builtin_amdgcn_s_setprio(0); } while (0)
#define PG8_WAIT_V(n) asm volatile("s_waitcnt vmcnt(" #n ")" ::: "memory")
#define PG8_WAIT_L(n) asm volatile("s_waitcnt lgkmcnt(" #n ")" ::: "memory")
#define PG8_BAR __builtin_amdgcn_s_barrier()
#define PG8_SCHED __builtin_amdgcn_sched_barrier(0)
    Unit cur, nxt; int ui = 0;
    if (!S.next(0, cur)) return;
    f32x4 acc[2][2][4][2];
#pragma unroll
    for (int a = 0; a < 2; ++a)
#pragma unroll
        for (int b = 0; b < 2; ++b)
#pragma unroll
            for (int m = 0; m < 4; ++m)
#pragma unroll
                for (int n = 0; n < 2; ++n) acc[a][b][m][n] = (f32x4){0.f, 0.f, 0.f, 0.f};
    i32x8v At8[4], B08[2], B18[2]; bf16x8 At[4][2], B0[2][2], B1[2][2];
    const int sc1 = 0x7F7F7F7F;
    unsigned cA = (unsigned)cur.pm * tstepA, cB = (unsigned)cur.pn * tstepB;
    PG8_STAGE(PG8_SB(0, 0), rsB, cB, voffB); PG8_STAGE(PG8_SB(0, 1), rsB, cB + hstepB, voffB); PG8_STAGE(PG8_SA(0, 0), rsA, cA, voffA); PG8_STAGE(PG8_SA(0, 1), rsA, cA + hstepA, voffA);
    if (wr == 1) PG8_BAR;
    PG8_WAIT_V(2); PG8_BAR;
    PG8_STAGE(PG8_SB(1, 0), rsB, cB + kstep, voffB); PG8_STAGE(PG8_SA(1, 0), rsA, cA + kstep, voffA); PG8_STAGE(PG8_SB(1, 1), rsB, cB + hstepB + kstep, voffB);
    PG8_WAIT_V(6); PG8_BAR;
    for (;;) {
        const bool has_next = S.next(ui + 1, nxt);
        const unsigned nA = has_next ? (unsigned)nxt.pm * tstepA : cA; const unsigned nB = has_next ? (unsigned)nxt.pn * tstepB : cB;
        for (int t = 0; t < nt; t += 2) {
            const bool last = (t == nt - 2);
            const unsigned a1 = cA + (unsigned)(t + 1) * kstep;
            const unsigned a2 = last ? nA : cA + (unsigned)(t + 2) * kstep; const unsigned b2 = last ? nB : cB + (unsigned)(t + 2) * kstep;
            const unsigned a3 = a2 + kstep; const unsigned b3 = b2 + kstep;
            PG8_LDB(B0, 0, 0); PG8_LDB(B1, 0, 1); PG8_SCHED; PG8_LDA(At, 0, 0); PG8_STAGE(PG8_SA(1, 1), rsA, a1 + hstepA, voffA);
            PG8_WAIT_V(8); PG8_WAIT_L(0); PG8_BAR; PG8_MMA(0, 0, At, B0); PG8_MMA(0, 1, At, B1); PG8_BAR; PG8_SCHED;
            PG8_LDA(At, 0, 1); PG8_STAGE(PG8_SB(0, 0), rsB, b2, voffB); PG8_STAGE(PG8_SB(0, 1), rsB, b2 + hstepB, voffB); PG8_STAGE(PG8_SA(0, 0), rsA, a2, voffA);
            PG8_WAIT_V(8); PG8_WAIT_L(0); PG8_BAR; PG8_MMA(1, 0, At, B0); PG8_MMA(1, 1, At, B1); PG8_BAR; PG8_SCHED;
            PG8_LDB(B0, 1, 0); PG8_LDB(B1, 1, 1); PG8_SCHED; PG8_LDA(At, 1, 0); PG8_STAGE(PG8_SA(0, 1), rsA, a2 + hstepA, voffA);
            PG8_WAIT_V(8); PG8_WAIT_L(0); PG8_BAR; PG8_MMA(0, 0, At, B0); PG8_MMA(0, 1, At, B1); PG8_BAR; PG8_SCHED;
            PG8_LDA(At, 1, 1); PG8_STAGE(PG8_SB(1, 0), rsB, b3, voffB); PG8_STAGE(PG8_SB(1, 1), rsB, b3 + hstepB, voffB); PG8_STAGE(PG8_SA(1, 0), rsA, a3, voffA);
            PG8_WAIT_V(8); PG8_WAIT_L(0); PG8_BAR; PG8_MMA(1, 0, At, B0); PG8_MMA(1, 1, At, B1); PG8_BAR; PG8_SCHED;
        }
        if constexpr (FP8) asm volatile("s_nop 15\n\ts_nop 7" ::: "memory");
        if constexpr (ALIGN_EPI) { if (wr == 0) PG8_BAR; }
        bool keep_acc = false;
        { const int l2 = lane_asm() & 63; if constexpr (Epi::KEEPS) keep_acc = E(acc, cur, wr, wc, l2 & 15, l2 >> 4); else E(acc, cur, wr, wc, l2 & 15, l2 >> 4); }
        if (!has_next) break;
        if (!keep_acc) {
#pragma unroll
        for (int a = 0; a < 2; ++a)
#pragma unroll
            for (int b = 0; b < 2; ++b)
#pragma unroll
                for (int m = 0; m < 4; ++m)
#pragma unroll
                    for (int n = 0; n < 2; ++n) acc[a][b][m][n] = (f32x4){0.f, 0.f, 0.f, 0.f};
        }
        cur = nxt; cA = nA; cB = nB; ++ui;
        if constexpr (ALIGN_EPI) { if (wr == 1) PG8_BAR; }
    }
    PG8_WAIT_V(0);
    if constexpr (!ALIGN_EPI) { if (wr == 0) PG8_BAR; }
    PG8_BAR;
#undef PG8_SA
#undef PG8_SB
#undef PG8_STAGE
#undef PG8_LDA
#undef PG8_LDB
#undef PG8_MMA
#undef PG8_WAIT_V
#undef PG8_WAIT_L
#undef PG8_BAR
#undef PG8_SCHED
}
}

enum { I_X = 0, I_C, I_CTX, I_CCTX, I_WADA, I_BADA, I_WIN, I_QNORM, I_WQUP, I_KVNORM, I_WKVUP, I_SCONVW, I_SCONVB, I_SDTB, I_SALOG, I_SD, I_SNORM,
       I_HCONVW, I_HCONVB, I_HW1, I_HB1, I_HW2, I_HB2, I_HW3, I_HFREQ, I_HD, I_RMU, I_RW0, I_RWUP, I_RA0, I_RAUP, I_RGUP, I_RKK, I_RKA, I_RRK, I_RLNG, I_RLNB,
       I_WBR, I_WOUT, I_LN1G, I_LN1B, I_WROUTER, I_WGATE, I_WUP, I_WDOWN, I_LN2G, I_LN2B, N_INPUTS };
struct Args { const float* in[N_INPUTS]; float* out; unsigned char* ws; int ph_lo, ph_hi; };
static_assert(sizeof(Args) == (N_INPUTS + 2) * 8 + 8, "Args has no padding");

__device__ __forceinline__ const float* arg_in(const Args& a, int i) { asm volatile("" : "+s"(i)); return a.in[i]; }
__device__ __forceinline__ int opqs(int v) { asm volatile("" : "+s"(v)); return v; }
__device__ __forceinline__ int opqv(int v) { asm volatile("" : "+v"(v)); return v; }
__device__ __forceinline__ unsigned char* opq(unsigned char* p) { asm volatile("" : "+s"(p)); return p; }
struct Frame {
    LAS unsigned char* lds;
    int tid, lane, wave, G, bid, gw, NGW;
    unsigned char* ws;
};
#define WSP(T_, off) ((T_*)(F.ws + (off)))

struct RmId { __device__ int operator()(int n) const { return n; } };
struct RmShift { int sh; __device__ int operator()(int n) const { return n + sh; } };
struct RmGateUp { int up; __device__ int operator()(int n) const { return 256 * (n >> 7) + (n & 127) + (up ? 128 : 0); } };
constexpr int TR_SCR = 64 * 65 * 4;
__device__ __forceinline__ void tr_load(const float* W, int ldw, int k0, int n0, const float* kscale, float sc, LAS float* scr, int lane) {
    float v[64];
    const float* wp = W + (size_t)k0 * ldw + n0 + lane;
#pragma unroll
    for (int i = 0; i < 64; ++i) v[i] = wp[(size_t)i * ldw];
#pragma unroll
    for (int i = 0; i < 64; ++i) { float x = v[i] * sc; if (kscale) x *= kscale[k0 + i]; scr[i * 65 + lane] = x; }
    LDS_WAIT(); asm volatile("" ::: "memory");
}
template <class RowMap>
__device__ __forceinline__ void transpose_item(const float* W, int ldw, bf16_t* WT, int ldt, int k0, int n0, const float* kscale, RowMap rm, LAS float* scr, int lane) {
    tr_load(W, ldw, k0, n0, kscale, 1.f, scr, lane);
    const int c = lane & 7;
#pragma unroll
    for (int j = 0; j < 8; ++j) { const int n = (lane >> 3) + 8 * j; const LAS float* s = scr + (8 * c) * 65 + n;
        u32x4 o; o.x = pk2(s[0 * 65], s[1 * 65]); o.y = pk2(s[2 * 65], s[3 * 65]); o.z = pk2(s[4 * 65], s[5 * 65]); o.w = pk2(s[6 * 65], s[7 * 65]);
        *(u32x4*)(WT + (size_t)rm(n0 + n) * ldt + k0 + 8 * c) = o; }
    LDS_WAIT(); asm volatile("" ::: "memory");
}
template <class RowMap>
__device__ __forceinline__ void transpose_item_fp8(const float* W, int ldw, unsigned char* WT, int ldt, int k0, int n0, float sc, RowMap rm, LAS float* scr, int lane, const float* kscale = nullptr) {
    tr_load(W, ldw, k0, n0, kscale, sc, scr, lane);
    const int c = lane & 3;
#pragma unroll
    for (int j = 0; j < 4; ++j) { const int n = (lane >> 2) + 16 * j; const LAS float* s = scr + (16 * c) * 65 + n;
        u32x4 o; o.x = pk4fp8(s[0 * 65], s[1 * 65], s[2 * 65], s[3 * 65]); o.y = pk4fp8(s[4 * 65], s[5 * 65], s[6 * 65], s[7 * 65]);
        o.z = pk4fp8(s[8 * 65], s[9 * 65], s[10 * 65], s[11 * 65]); o.w = pk4fp8(s[12 * 65], s[13 * 65], s[14 * 65], s[15 * 65]);
        *(u32x4*)(WT + (size_t)rm(n0 + n) * ldt + k0 + 16 * c) = o; }
    LDS_WAIT(); asm volatile("" ::: "memory");
}

__device__ __forceinline__ void p0_weights(Frame& F, const Args& a) {
    LAS float* scr = (LAS float*)(F.lds + F.wave * TR_SCR);
    constexpr int IT_IN = 32 * 288, IT_BR = 16 * 32, IT_OUT = 32 * 32, IT_Q = 8 * 24, IT_KV = 8 * 32;
    constexpr int PER_L = IT_IN + 4 * IT_BR + IT_OUT + IT_Q + IT_KV;
    for (int it = F.gw; it < DEPTH * PER_L; it += F.NGW) {
        const int l = it / PER_L; int r = it % PER_L;
        if (r < IT_IN) { const int kb = r / 288, nb = r % 288;
            if (nb * 64 < NNG) { const int tile = nb >> 2;
                if (tile >= 14 && tile < 27) transpose_item(arg_in(a, I_WIN) + (size_t)l * DM * NIN, NIN, WSP(bf16_t, WS_WIN + l * SZ_WIN), DM, kb * 64, nb * 64, nullptr, RmId(), scr, F.lane);
                else { RmShift rs; rs.sh = tile < 14 ? 0 : -13 * 256; transpose_item_fp8(arg_in(a, I_WIN) + (size_t)l * DM * NIN, NIN, WSP(unsigned char, WS_WIN + l * SZ_WIN + WIN8P_OFF), DM, kb * 64, nb * 64, 64.f, rs, scr, F.lane); } }
            else transpose_item_fp8(arg_in(a, I_WIN) + (size_t)l * DM * NIN + NNG, NIN, WSP(unsigned char, WS_WIN + l * SZ_WIN) + (size_t)NNG * DM * 2, DM, kb * 64, nb * 64 - NNG, 64.f, RmId(), scr, F.lane);
            continue; } r -= IT_IN;
        if (r < 4 * IT_BR) { const int br = r / IT_BR, q = r % IT_BR, kb = q / 32, nb = q % 32;
            transpose_item(arg_in(a, I_WBR) + ((size_t)l * 4 + br) * 1024 * DM, DM, WSP(bf16_t, WS_WBR + l * SZ_WBR) + (size_t)br * DM * 1024, 1024, kb * 64, nb * 64, nullptr, RmId(), scr, F.lane); continue; } r -= 4 * IT_BR;
        if (r < IT_OUT) { const int kb = r / 32, nb = r % 32;
            transpose_item(arg_in(a, I_WOUT) + (size_t)l * DM * DM, DM, WSP(bf16_t, WS_WOUT + l * SZ_WOUT), DM, kb * 64, nb * 64, nullptr, RmId(), scr, F.lane); continue; } r -= IT_OUT;
        if (r < IT_Q) { const int kb = r / 24, nb = r % 24;
            transpose_item_fp8(arg_in(a, I_WQUP) + (size_t)l * 512 * 1536, 1536, WSP(unsigned char, WS_WQ + l * SZ_WQ), 512, kb * 64, nb * 64, 16.f, RmId(), scr, F.lane, arg_in(a, I_QNORM) + l * 512); continue; } r -= IT_Q;
        { const int kb = r / 32, nb = r % 32;
            transpose_item_fp8(arg_in(a, I_WKVUP) + (size_t)l * 512 * 2048, 2048, WSP(unsigned char, WS_WKV + l * SZ_WKV), 512, kb * 64, nb * 64, 16.f, RmId(), scr, F.lane, arg_in(a, I_KVNORM) + l * 512); }
    }
    for (size_t e4 = (size_t)F.bid * NTHREADS + F.tid; e4 < (size_t)DEPTH * 5120 * 128; e4 += (size_t)F.G * NTHREADS) {
        const int l = (int)(e4 / (5120 * 128)); const int rem = (int)(e4 % (5120 * 128)); const int n = rem / 128, kc0 = (rem % 128) * 4; const int blk = n >> 10, c = n & 1023;
        float v[4];
#pragma unroll
        for (int q = 0; q < 4; ++q) { const int kc = kc0 + q; float x = 0.f;
            if (blk < 2) { if (kc >= 64 * blk && kc < 64 * blk + 64) x = arg_in(a, I_RWUP)[(((size_t)l * 2 + blk) * 64 + (kc - 64 * blk)) * 1024 + c]; }
            else if (blk < 4) { const int d = blk - 2; if (kc >= 128 + 64 * d && kc < 192 + 64 * d) x = arg_in(a, I_RAUP)[(((size_t)l * 2 + d) * 64 + (kc - 128 - 64 * d)) * 1024 + c]; }
            else { if (kc >= 256 && kc < 416) x = arg_in(a, I_RGUP)[((size_t)l * 160 + (kc - 256)) * 1024 + c]; }
            v[q] = x * 8.f; }
        WSP(unsigned, WS_WLORA + l * SZ_WLORA)[(size_t)n * 128 + kc0 / 4] = pk4fp8(v[0], v[1], v[2], v[3]);
    }
}
constexpr int EFFP = 1536;
constexpr size_t SZ_WGU8 = (size_t)NEXP * 2816 * DM, SZ_WD8 = (size_t)NEXP * DM * EFFP;
__device__ __forceinline__ void conv_experts(Frame& F, const Args& a, int l) {
    LAS float* scr = (LAS float*)(F.lds + F.wave * TR_SCR);
    constexpr int IT_G = 32 * 22, IT_D = 22 * 32, PER_E = 2 * IT_G + IT_D;
    unsigned char* wgu = WSP(unsigned char, WS_WE); unsigned char* wd = WSP(unsigned char, WS_WE + SZ_WGU8);
    for (int it = F.gw; it < NEXP * PER_E; it += F.NGW) {
        const int e = it / PER_E; int r = it % PER_E;
        if (r < 2 * IT_G) { const int up = r / IT_G, q = r % IT_G, kb = q / 22, nb = q % 22;
            const float* src = arg_in(a, up ? I_WUP : I_WGATE) + ((size_t)l * NEXP + e) * DM * EFF;
            RmGateUp rm; rm.up = up;
            transpose_item_fp8(src, EFF, wgu + (size_t)e * 2816 * DM, DM, kb * 64, nb * 64, 64.f, rm, scr, F.lane); continue; } r -= 2 * IT_G;
        { const int kb = r / 32, nb = r % 32;
            transpose_item_fp8(arg_in(a, I_WDOWN) + ((size_t)l * NEXP + e) * EFF * DM, DM, wd + (size_t)e * DM * EFFP, EFFP, kb * 64, nb * 64, 64.f, RmId(), scr, F.lane); }
    }
    for (int i = F.bid * NTHREADS + F.tid; i < NEXP * DM * 8; i += F.G * NTHREADS) { const int rowi = i >> 3, q = i & 7; unsigned zz = 0u; asm volatile("" : "+v"(zz));
        *(u32x4*)(wd + (size_t)rowi * EFFP + EFF + q * 16) = (u32x4){zz, zz, zz, zz}; }
}
__device__ __forceinline__ void p0_mod(Frame& F, const Args& a) {
    LAS float* sv = (LAS float*)(F.lds + 69632);
    for (int i = F.tid; i < 3 * DM; i += NTHREADS) { const int v = i / DM, k = i % DM; const float x = v < 2 ? arg_in(a, I_C)[v * DM + k] : arg_in(a, I_CCTX)[k]; sv[i] = siluf_(x); }
    __syncthreads();
    float* mod = (float*)(F.ws + WS_CTL) + CW_MOD;
    LAS float* red = (LAS float*)(F.lds + 69632 + 3 * DM * 4);
    for (int u = F.bid; u < DEPTH * (6 * DM / 128); u += F.G) {
        const int l = u / (6 * DM / 128), nb = u % (6 * DM / 128); const int kg = F.tid >> 7, cl = F.tid & 127, n = nb * 128 + cl;
        const float* w = arg_in(a, I_WADA) + ((size_t)l * DM + kg * 512) * (6 * DM) + n;
        float a0 = 0.f, a1 = 0.f, a2 = 0.f;
#pragma unroll 32
        for (int k = 0; k < 512; ++k) { const float wv = w[(size_t)k * (6 * DM)]; const int kk = kg * 512 + k; a0 += sv[kk] * wv; a1 += sv[DM + kk] * wv; a2 += sv[2 * DM + kk] * wv; }
        __syncthreads();
        red[(kg * 3 + 0) * 128 + cl] = a0; red[(kg * 3 + 1) * 128 + cl] = a1; red[(kg * 3 + 2) * 128 + cl] = a2;
        __syncthreads();
        if (F.tid < 384) { const int v = F.tid >> 7; const float b = arg_in(a, I_BADA)[l * 6 * DM + n];
            mod[(l * 3 + v) * 6 * DM + n] = b + ((red[(0 * 3 + v) * 128 + cl] + red[(1 * 3 + v) * 128 + cl]) + (red[(2 * 3 + v) * 128 + cl] + red[(3 * 3 + v) * 128 + cl])); }
    }
}

__device__ __forceinline__ void row_stats(const f32x4 (&v)[8], float& mean, float& rstd, float eps) {
    float s = 0.f;
#pragma unroll
    for (int j = 0; j < 8; ++j) s += (v[j].x + v[j].y) + (v[j].z + v[j].w);
    mean = wave_sum(s) * (1.f / DM);
    float s2 = 0.f;
#pragma unroll
    for (int j = 0; j < 8; ++j) { const f32x4 d = v[j] - mean; s2 += (d.x * d.x + d.y * d.y) + (d.z * d.z + d.w * d.w); }
    rstd = 1.f / sqrtf(wave_sum(s2) * (1.f / DM) + eps);
}
__device__ __forceinline__ const float* x_src_row(const Args& a, const Frame& F, int layer, int row) {
    if (layer == 0) return row < TC ? arg_in(a, I_CTX) + (size_t)row * DM : arg_in(a, I_X) + (size_t)(row - TC) * DM;
    return (const float*)(F.ws + WS_XS) + (size_t)row * DM;
}
__device__ __forceinline__ void phase_modln(Frame& F, const Args& a, int layer) {
    const float* mod = (const float*)(F.ws + WS_CTL) + CW_MOD + (size_t)layer * 3 * 6 * DM;
    bf16_t* H = WSP(bf16_t, WS_H); unsigned* H8 = WSP(unsigned, WS_H8);
    for (int row = F.gw; row < T; row += F.NGW) {
        const f32x4* xr = (const f32x4*)x_src_row(a, F, layer, row) + F.lane;
        f32x4 v[8];
#pragma unroll
        for (int j = 0; j < 8; ++j) v[j] = xr[64 * j];
        float mean, rstd; row_stats(v, mean, rstd, 1e-6f);
        const float* m = mod + (size_t)row_modidx(row) * 6 * DM;
        u32x2* o = (u32x2*)(H + (size_t)row * DM) + F.lane; unsigned* o8 = H8 + (size_t)row * (DM / 4) + F.lane;
#pragma unroll
        for (int j = 0; j < 8; ++j) { const int c = 4 * (64 * j + F.lane); const f32x4 sh = *(const f32x4*)(m + c), sc = *(const f32x4*)(m + DM + c);
            const f32x4 y = (v[j] - mean) * rstd * (sc + 1.f) + sh; u32x2 w; w.x = pk2(y.x, y.y); w.y = pk2(y.z, y.w); o[64 * j] = w; o8[64 * j] = pk4fp8(y.x, y.y, y.z, y.w); }
    }
}

__device__ __forceinline__ void phase_hdn(Frame& F, const Args& a, int layer) {
    LAS float* zs = (LAS float*)(F.lds + F.wave * 512);
    const float* w1 = arg_in(a, I_HW1) + (size_t)layer * 33 * 64; const float* b1 = arg_in(a, I_HB1) + layer * 64;
    const float* w2 = arg_in(a, I_HW2) + (size_t)layer * 64 * 64; const float* b2 = arg_in(a, I_HB2) + layer * 64;
    const float fr = arg_in(a, I_HFREQ)[layer * 64 + F.lane];
    float* HDN = WSP(float, WS_HDN + layer * SZ_HDN1);
    for (int r = F.gw; r < SEQ + CTX; r += F.NGW) {
        const int n = r < SEQ ? SEQ : CTX, t = r < SEQ ? r : r - SEQ;
        const float wpos = (6.283185307179586f * (float)t) / (float)n;
        if (F.lane < 33) { float z;
            if (F.lane == 0) z = (float)t / (float)(n - 1);
            else { const int b = (F.lane - 1) & 15; const float f = 1e-4f + (float)b * ((15.f - 1e-4f) / 15.f); const float ang = f * wpos; z = F.lane <= 16 ? __cosf(ang) : -__sinf(ang); }
            zs[F.lane] = z; }
        LDS_WAIT(); asm volatile("" ::: "memory");
        float p = b1[F.lane];
#pragma unroll
        for (int i = 0; i < 33; ++i) p += zs[i] * w1[i * 64 + F.lane];
        const float h1 = __sinf(fr * p);
        zs[64 + F.lane] = h1;
        LDS_WAIT(); asm volatile("" ::: "memory");
        float q = b2[F.lane];
#pragma unroll 16
        for (int i = 0; i < 64; ++i) q += zs[64 + i] * w2[i * 64 + F.lane];
        HDN[(size_t)r * 64 + F.lane] = __sinf(fr * q);
        LDS_WAIT(); asm volatile("" ::: "memory");
    }
}
__device__ __forceinline__ float hy_delta(int c) { const float mn = -3.0701134573253943f, mx = -15.350567286626972f; return fabsf(mn + (float)c * ((mx - mn) / 1023.f)); }
__device__ __forceinline__ void phase_filt(Frame& F, const Args& a, int layer) {
    const float* w3 = arg_in(a, I_HW3) + (size_t)layer * 64 * 2048; const float* HDN = WSP(float, WS_HDN + layer * SZ_HDN1);
    LAS float* ws3 = (LAS float*)F.lds;
    bf16_t* FILT = WSP(bf16_t, WS_FILT);
    for (int u = F.bid; u < 32 * 16; u += F.G) {
        const int cb = u / 16, tb = u % 16, col0 = cb * 64, t = tb * 512 + F.tid;
        __syncthreads();
        for (int i = F.tid; i < 4096; i += NTHREADS) { const int j = i >> 6, cc = i & 63; ws3[cc * 64 + j] = w3[(size_t)j * 2048 + col0 + cc]; }
        __syncthreads();
        f32x4 h[16];
#pragma unroll
        for (int i = 0; i < 16; ++i) h[i] = *(const f32x4*)(HDN + (size_t)t * 64 + 4 * i);
        const float tn = (float)t / (float)(SEQ - 1);
        for (int cc = 0; cc < 64; ++cc) {
            float acc = 0.f;
#pragma unroll
            for (int i = 0; i < 16; ++i) { const f32x4 w = *(const LAS f32x4*)(ws3 + cc * 64 + 4 * i); acc += h[i].x * w.x + h[i].y * w.y + h[i].z * w.z + h[i].w * w.w; }
            const int col = col0 + cc, side = col >> 10, c = col & 1023;
            FILT[((size_t)c * 2 + side) * SEQ + t] = (bf16_t)f2bf(acc * __expf(-tn * hy_delta(c)));
        }
    }
    float* FILTC = WSP(float, WS_FILTC);
    for (int e = F.bid * NTHREADS + F.tid; e < CTX * 2048; e += F.G * NTHREADS) {
        const int lag = e >> 11, col = e & 2047, c = col & 1023; const float* hr = HDN + (size_t)(SEQ + lag) * 64; float acc = 0.f;
#pragma unroll 16
        for (int j = 0; j < 64; ++j) acc += hr[j] * w3[(size_t)j * 2048 + col];
        FILTC[e] = acc * __expf(-((float)lag / (float)(CTX - 1)) * hy_delta(c));
    }
}

__device__ __forceinline__ void ld8bf(const bf16_t* p, float (&o)[8]) { const u32x4 w = *(const u32x4*)p; o[0] = bflo(w.x); o[1] = bfhi(w.x); o[2] = bflo(w.y); o[3] = bfhi(w.y); o[4] = bflo(w.z); o[5] = bfhi(w.z); o[6] = bflo(w.w); o[7] = bfhi(w.w); }
__device__ __forceinline__ void up8(const u32x4 w, float (&o)[8]) { o[0] = bflo(w.x); o[1] = bfhi(w.x); o[2] = bflo(w.y); o[3] = bfhi(w.y); o[4] = bflo(w.z); o[5] = bfhi(w.z); o[6] = bflo(w.w); o[7] = bfhi(w.w); }
__device__ __forceinline__ void st8bf(bf16_t* p, const float (&v)[8]) { u32x4 w; w.x = pk2(v[0], v[1]); w.y = pk2(v[2], v[3]); w.z = pk2(v[4], v[5]); w.w = pk2(v[6], v[7]); *(u32x4*)p = w; }
__device__ __forceinline__ void ld8f(const float* p, float (&o)[8]) { const f32x4 a = *(const f32x4*)p, b = *(const f32x4*)(p + 4); o[0] = a.x; o[1] = a.y; o[2] = a.z; o[3] = a.w; o[4] = b.x; o[5] = b.y; o[6] = b.z; o[7] = b.w; }

constexpr int PREP_RUN = 16;
__device__ __forceinline__ void phase_prep(Frame& F, const Args& a, int layer) {
    const bf16_t* P = WSP(bf16_t, WS_P); bf16_t* P2 = WSP(bf16_t, WS_P2);
    float* RS = WSP(float, WS_RS); bf16_t* KPE = WSP(bf16_t, WS_KPE); float* DT = WSP(float, WS_DT);
    bf16_t* KK = WSP(bf16_t, WS_KK); unsigned char* AL_ = WSP(unsigned char, WS_ALORA); float* VC = WSP(float, WS_VC); unsigned char* CQ8 = WSP(unsigned char, WS_CQ8);
    const float* scw = arg_in(a, I_SCONVW) + (size_t)layer * 3 * 1536; const float* scb = arg_in(a, I_SCONVB) + layer * 1536; const float* dtb = arg_in(a, I_SDTB) + layer * 32;
    const float* hcw = arg_in(a, I_HCONVW) + (size_t)layer * 3 * 3072; const float* hcb = arg_in(a, I_HCONVB) + layer * 3072;
    const float* mu = arg_in(a, I_RMU) + (size_t)layer * 2 * 3488; const float* rkk = arg_in(a, I_RKK) + layer * 1024;
    const int lane = F.lane;
    for (int item = F.gw; item < (T / PREP_RUN) * 13; item += F.NGW) {
        const int run = item / 13, ct = item % 13; const int r0 = run * PREP_RUN;
        if (ct == 0) {
#pragma unroll 1
        for (int rr = 0; rr < PREP_RUN; ++rr) { const int row = r0 + rr; const bf16_t* pr = P + (size_t)row * NNG;
            float x[8]; ld8bf(pr + P_CQ + lane * 8, x); float s = 0.f;
            *(u32x2*)(CQ8 + (size_t)row * 1024 + lane * 8) = (u32x2){pk4fp8(x[0], x[1], x[2], x[3]), pk4fp8(x[4], x[5], x[6], x[7])};
#pragma unroll
            for (int i = 0; i < 8; ++i) s += x[i] * x[i];
            s = wave_sum(s); const float rq = 1.f / sqrtf(s * (1.f / 512.f) + 1e-6f);
            ld8bf(pr + P_CKV + lane * 8, x); s = 0.f;
            *(u32x2*)(CQ8 + (size_t)row * 1024 + 512 + lane * 8) = (u32x2){pk4fp8(x[0], x[1], x[2], x[3]), pk4fp8(x[4], x[5], x[6], x[7])};
#pragma unroll
            for (int i = 0; i < 8; ++i) s += x[i] * x[i];
            s = wave_sum(s); const float rk = 1.f / sqrtf(s * (1.f / 512.f) + 1e-6f);
            if (lane == 0) { RS[row * 2] = rq; RS[row * 2 + 1] = rk; }
            float kv = bf2f(pr[P_KPE + lane]);
            const float other = swz16(kv);
            if (row >= TC) { const int t = (row - TC) & (SEQ - 1); const int axis = lane >> 5, half = (lane >> 4) & 1, j = lane & 15;
                const float pos = (float)(axis == 0 ? (t >> 6) : (t & 63)); const float inv = __builtin_amdgcn_exp2f(-(float)j * 0.8304820237218406f);
                const float sn = __sinf(pos * inv), cs = __cosf(pos * inv);
                kv = half == 0 ? kv * cs - other * sn : kv * cs + other * sn; }
            KPE[(size_t)row * 64 + lane] = (bf16_t)f2bf(kv);
            if (lane < 32) DT[(size_t)row * 32 + lane] = softplusf_(bf2f(pr[P_DT + lane]) + dtb[lane]); }
        continue; }
        const bool first = row_first(r0), last = row_last(r0 + PREP_RUN - 1);
        if (ct >= 1 && ct <= 3) { const int ch = ct - 1; const int c = ch * 512 + lane * 8; float xm[8], x0[8], xp[8], w0[8], w1[8], w2[8], bb[8];
            ld8f(scw + c, w0); ld8f(scw + 1536 + c, w1); ld8f(scw + 3072 + c, w2); ld8f(scb + c, bb);
            const bf16_t* pc = P + (size_t)r0 * NNG + P_XBC + c;
            u32x4 raw[PREP_RUN + 2];
#pragma unroll
            for (int rr = 0; rr < PREP_RUN + 2; ++rr) { const bool ok = (rr > 0 || !first) && (rr < PREP_RUN + 1 || !last); raw[rr] = ok ? *(const u32x4*)(pc + (ptrdiff_t)(rr - 1) * NNG) : (u32x4){0u, 0u, 0u, 0u}; }
            up8(raw[0], xm); up8(raw[1], x0);
#pragma unroll
            for (int rr = 0; rr < PREP_RUN; ++rr) {
                up8(raw[rr + 2], xp);
                float o[8];
#pragma unroll
                for (int i = 0; i < 8; ++i) { o[i] = siluf_(xm[i] * w0[i] + x0[i] * w1[i] + xp[i] * w2[i] + bb[i]); xm[i] = x0[i]; x0[i] = xp[i]; }
                st8bf(P2 + (size_t)(r0 + rr) * P2W + P2_XBC + c, o); } continue; }
        if (ct >= 4 && ct <= 5) { const int ch = ct - 4; { const int c = ch * 512 + lane * 8; float xm[8], x0[8], xp[8], w0[8], w1[8], w2[8], bb[8];
            ld8f(hcw + c, w0); ld8f(hcw + 3072 + c, w1); ld8f(hcw + 6144 + c, w2); ld8f(hcb + c, bb);
            const bf16_t* pc = P + (size_t)r0 * NNG + P_HY + c;
            u32x4 raw[PREP_RUN + 2];
#pragma unroll
            for (int rr = 0; rr < PREP_RUN + 2; ++rr) { const bool ok = (rr > 0 || !first) && (rr < PREP_RUN + 1 || !last); raw[rr] = ok ? *(const u32x4*)(pc + (ptrdiff_t)(rr - 1) * NNG) : (u32x4){0u, 0u, 0u, 0u}; }
            up8(raw[0], xm); up8(raw[1], x0);
#pragma unroll
            for (int rr = 0; rr < PREP_RUN; ++rr) {
                up8(raw[rr + 2], xp);
                float o[8];
#pragma unroll
                for (int i = 0; i < 8; ++i) { o[i] = xm[i] * w0[i] + x0[i] * w1[i] + xp[i] * w2[i] + bb[i]; xm[i] = x0[i]; x0[i] = xp[i]; }
                st8bf(P2 + (size_t)(r0 + rr) * P2W + P2_X0 + c, o); } }
        if (r0 < TC) {
#pragma unroll 1
                for (int rr = 0; rr < PREP_RUN; ++rr) { const int row = r0 + rr; const bool f1 = row_first(row), l1 = row_last(row); const int c = ch * 512 + lane * 8;
                    const bf16_t* pr = P + (size_t)row * NNG; float o1[8], o2[8];
#pragma unroll
                    for (int part = 1; part < 3; ++part) { float x0[8], xm[8], xp[8], w0[8], w1[8], w2[8], bb[8]; const int cc = part * 1024 + c;
                        ld8bf(pr + P_HY + cc, x0);
                        if (!f1) ld8bf(pr - NNG + P_HY + cc, xm); else { for (int i = 0; i < 8; ++i) xm[i] = 0.f; }
                        if (!l1) ld8bf(pr + NNG + P_HY + cc, xp); else { for (int i = 0; i < 8; ++i) xp[i] = 0.f; }
                        ld8f(hcw + cc, w0); ld8f(hcw + 3072 + cc, w1); ld8f(hcw + 6144 + cc, w2); ld8f(hcb + cc, bb);
#pragma unroll
                        for (int i = 0; i < 8; ++i) { const float r = xm[i] * w0[i] + x0[i] * w1[i] + xp[i] * w2[i] + bb[i]; if (part == 1) o1[i] = r; else o2[i] = r; } }
                    float* vc = VC + (size_t)row * 1024 + c;
                    *(f32x4*)vc = (f32x4){o1[0] * o2[0], o1[1] * o2[1], o1[2] * o2[2], o1[3] * o2[3]};
                    *(f32x4*)(vc + 4) = (f32x4){o1[4] * o2[4], o1[5] * o2[5], o1[6] * o2[6], o1[7] * o2[7]}; } }
        continue; }
        { const int ch = ct - 6; const int c = ch * 512 + lane * 8;
            if (c < 3488) { float um[8], u0[8], up[8], m0[8], m1[8], g8[8];
                ld8f(mu + c, m0); ld8f(mu + 3488 + c, m1);
                if (ch == 2 || ch == 3) ld8f(rkk + (c - 1024), g8);
                const bf16_t* pc = P + (size_t)r0 * NNG + P_RW + c;
                u32x4 raw[PREP_RUN + 2];
#pragma unroll
                for (int rr = 0; rr < PREP_RUN + 2; ++rr) { const bool ok = (rr > 0 || !first) && (rr < PREP_RUN + 1 || !last); raw[rr] = ok ? *(const u32x4*)(pc + (ptrdiff_t)(rr - 1) * NNG) : (u32x4){0u, 0u, 0u, 0u}; }
                up8(raw[0], um); up8(raw[1], u0);
#pragma unroll
                for (int rr = 0; rr < PREP_RUN; ++rr) { const int row = r0 + rr;
                    up8(raw[rr + 2], up);
                    float us[8];
#pragma unroll
                    for (int i = 0; i < 8; ++i) { us[i] = u0[i] + m0[i] * (um[i] - u0[i]) + m1[i] * (up[i] - u0[i]); um[i] = u0[i]; u0[i] = up[i]; }
                    if (ch < 6) st8bf(P2 + (size_t)row * P2W + P2_RKV + c, us);
                    if (ch == 2 || ch == 3) { float kx[8]; float s = 0.f;
#pragma unroll
                        for (int i = 0; i < 8; ++i) { kx[i] = us[i] * g8[i]; s += kx[i] * kx[i]; }
                        s = sum8(s);
                        const float inv = 1.f / fmaxf(sqrtf(s), 1e-12f);
#pragma unroll
                        for (int i = 0; i < 8; ++i) kx[i] *= inv;
                        st8bf(KK + (size_t)row * 1024 + (c - 1024), kx); }
                    if (ch == 6) { const int cl = c - 3072; float o[8];
#pragma unroll
                        for (int i = 0; i < 8; ++i) o[i] = cl < 128 ? tanhf_(us[i]) : cl < 256 ? us[i] : sigmoidf_(us[i]);
                        *(u32x2*)(AL_ + (size_t)row * 512 + cl) = (u32x2){pk4fp8(o[0], o[1], o[2], o[3]), pk4fp8(o[4], o[5], o[6], o[7])}; } } }
            else if (ch == 6) { const int cl = c - 3072;
                for (int rr = 0; rr < PREP_RUN; ++rr) { float zz = 0.f; asm volatile("" : "+v"(zz)); *(u32x2*)(AL_ + (size_t)(r0 + rr) * 512 + cl) = (u32x2){__builtin_bit_cast(unsigned, zz), __builtin_bit_cast(unsigned, zz)}; } } }
    }
    float* VT = WSP(float, WS_VT);
    LAS float* tl = (LAS float*)F.lds;
    for (int u = F.bid; u < (TL / 64) * 4; u += F.G) {
        const int tb = u >> 2, cb = u & 3; const int row0 = TC + tb * 64; const int c8 = (F.tid & 31) * 8, c = cb * 256 + c8, tq = F.tid >> 5;
        float w1[3][8], w2[3][8], b1[8], b2[8];
#pragma unroll
        for (int k = 0; k < 3; ++k) { ld8f(hcw + k * 3072 + 1024 + c, w1[k]); ld8f(hcw + k * 3072 + 2048 + c, w2[k]); }
        ld8f(hcb + 1024 + c, b1); ld8f(hcb + 2048 + c, b2);
        __syncthreads();
#pragma unroll 1
        for (int i = 0; i < 4; ++i) { const int tl_ = tq * 4 + i, row = row0 + tl_; const bf16_t* pr = P + (size_t)row * NNG + P_HY;
            const bool first = row_first(row), last = row_last(row);
            float a1[8], a2[8], x[8];
            ld8bf(pr + 1024 + c, x);
#pragma unroll
            for (int j = 0; j < 8; ++j) a1[j] = x[j] * w1[1][j] + b1[j];
            ld8bf(pr + 2048 + c, x);
#pragma unroll
            for (int j = 0; j < 8; ++j) a2[j] = x[j] * w2[1][j] + b2[j];
            if (!first) { ld8bf(pr - NNG + 1024 + c, x);
#pragma unroll
                for (int j = 0; j < 8; ++j) a1[j] += x[j] * w1[0][j];
                ld8bf(pr - NNG + 2048 + c, x);
#pragma unroll
                for (int j = 0; j < 8; ++j) a2[j] += x[j] * w2[0][j]; }
            if (!last) { ld8bf(pr + NNG + 1024 + c, x);
#pragma unroll
                for (int j = 0; j < 8; ++j) a1[j] += x[j] * w1[2][j];
                ld8bf(pr + NNG + 2048 + c, x);
#pragma unroll
                for (int j = 0; j < 8; ++j) a2[j] += x[j] * w2[2][j]; }
#pragma unroll
            for (int j = 0; j < 8; ++j) tl[(c8 + j) * 65 + tl_] = a1[j] * a2[j]; }
        __syncthreads();
        const int b = (row0 - TC) >> 13, t0 = (row0 - TC) & (SEQ - 1);
        for (int p_ = 0; p_ < 8; ++p_) { const int cl = p_ * 32 + (F.tid >> 4), q = F.tid & 15;
            const f32x4 o = {tl[cl * 65 + 4 * q], tl[cl * 65 + 4 * q + 1], tl[cl * 65 + 4 * q + 2], tl[cl * 65 + 4 * q + 3]};
            *(f32x4*)(VT + ((size_t)(cb * 256 + cl) * 2 + b) * SEQ + t0 + 4 * q) = o; }
    }
}

using pg8::Unit;
#define EPI_LOOP_BEGIN const int row0 = u.pm * 256 + wr * 64 + fr; \
    _Pragma("unroll") for (int ai = 0; ai < 2; ++ai) _Pragma("unroll") for (int m = 0; m < 4; ++m) { const int row = row0 + ai * 128 + m * 16; \
    _Pragma("unroll") for (int bj = 0; bj < 2; ++bj) { const int cl = bj * 128 + wc * 32 + 8 * fq; const f32x4 v0 = acc[ai][bj][m][0], v1 = acc[ai][bj][m][1];
#define EPI_LOOP_END } __builtin_amdgcn_sched_barrier(0); }
struct EpiBf16 {
    static constexpr bool PERM = true, KEEPS = false;
    bf16_t* O; int ldc; const float* rscale; int rs_stride; int act; float cscale; int pn_from, pn_add;
    __device__ __forceinline__ void operator()(const f32x4 (&acc)[2][2][4][2], const Unit& u, int wr, int wc, int fr, int fq) const {
        EPI_LOOP_BEGIN
            const float s = (rscale ? rscale[(size_t)row * rs_stride] : 1.f) * cscale;
            float x[8] = {v0.x * s, v0.y * s, v0.z * s, v0.w * s, v1.x * s, v1.y * s, v1.z * s, v1.w * s};
            if (act == 1) {
#pragma unroll
                for (int i = 0; i < 8; ++i) x[i] = sigmoidf_(x[i]); }
            u32x4 w; w.x = cvt_pk_bf16(x[0], x[1]); w.y = cvt_pk_bf16(x[2], x[3]); w.z = cvt_pk_bf16(x[4], x[5]); w.w = cvt_pk_bf16(x[6], x[7]);
            *(u32x4*)(O + (size_t)row * ldc + (u.pn + (u.pn >= pn_from ? pn_add : 0)) * 256 + cl) = w;
        EPI_LOOP_END
    }
};
struct EpiLora {
    static constexpr bool PERM = true, KEEPS = false;
    bf16_t* EW; bf16_t* ICLR; bf16_t* GG; const float* w0; const float* a0; float cscale;
    __device__ __forceinline__ void operator()(const f32x4 (&acc)[2][2][4][2], const Unit& u, int wr, int wc, int fr, int fq) const {
        const int blk = u.pn >> 2, cb = (u.pn & 3) * 256;
        const float* bias = blk < 2 ? w0 + blk * 1024 : a0 + (blk & 1) * 1024;
        bf16_t* dbase = blk < 2 ? EW + (size_t)blk * T * 1024 : blk < 4 ? ICLR + (size_t)(blk - 2) * T * 1024 : GG;
        const float scale = blk < 2 ? 0.6065306597126334f : 1.f; const bool sig = blk < 4;
        f32x4 bia[2][2];
#pragma unroll
        for (int bj = 0; bj < 2; ++bj) { const int c = cb + bj * 128 + wc * 32 + 8 * fq; bia[bj][0] = *(const f32x4*)(bias + c); bia[bj][1] = *(const f32x4*)(bias + c + 4); }
        EPI_LOOP_BEGIN
            const int c = cb + cl; float x[8] = {v0.x * cscale, v0.y * cscale, v0.z * cscale, v0.w * cscale, v1.x * cscale, v1.y * cscale, v1.z * cscale, v1.w * cscale};
            if (sig) { const f32x4 b0 = bia[bj][0], b1 = bia[bj][1]; const float bb[8] = {b0.x, b0.y, b0.z, b0.w, b1.x, b1.y, b1.z, b1.w};
#pragma unroll
                for (int i = 0; i < 8; ++i) x[i] = scale * sigmoidf_(bb[i] + x[i]); }
            u32x4 w; w.x = cvt_pk_bf16(x[0], x[1]); w.y = cvt_pk_bf16(x[2], x[3]); w.z = cvt_pk_bf16(x[4], x[5]); w.w = cvt_pk_bf16(x[6], x[7]);
            *(u32x4*)(dbase + (size_t)row * 1024 + c) = w;
        EPI_LOOP_END
    }
};
struct EpiMerge {
    static constexpr bool PERM = true, KEEPS = true;
    const bf16_t* gates; bf16_t* MB;
    __device__ __forceinline__ bool operator()(f32x4 (&acc)[2][2][4][2], const Unit& uu, int wr, int wc, int fr, int fq) const {
        const int br = uu.pn >> 3; Unit u; u.pm = uu.pm - br * 66; u.pn = uu.pn & 7;
        const int row0 = u.pm * 256 + wr * 64 + fr, col0 = u.pn * 256 + wc * 32 + 8 * fq; const bool last = br == 3;
        const bf16_t* gcur = gates + br * DM + col0; const bf16_t* gnxt = gates + (last ? br : br + 1) * DM + col0;
        u32x4 gq[2], hq[2], gn[2], hn[2];
#define EM_ROW(it_) ((size_t)(row0 + ((it_) >> 2) * 128 + ((it_) & 3) * 16))
#pragma unroll
        for (int bj = 0; bj < 2; ++bj) { gq[bj] = *(const u32x4*)(gcur + EM_ROW(0) * NGATE + bj * 128); hq[bj] = *(const u32x4*)(gnxt + EM_ROW(0) * NGATE + bj * 128); }
#pragma unroll
        for (int it = 0; it < 8; ++it) { const int ai = it >> 2, m = it & 3;
            if (it < 7) {
#pragma unroll
                for (int bj = 0; bj < 2; ++bj) { gn[bj] = *(const u32x4*)(gcur + EM_ROW(it + 1) * NGATE + bj * 128); hn[bj] = *(const u32x4*)(gnxt + EM_ROW(it + 1) * NGATE + bj * 128); } }
#pragma unroll
            for (int bj = 0; bj < 2; ++bj) { float g[8], hh[8]; up8(gq[bj], g); up8(hq[bj], hh); float f[8];
#pragma unroll
                for (int i = 0; i < 8; ++i) { const float ea = __expf(-g[i]), eb = __expf(-hh[i]); f[i] = last ? 1.f / (1.f + ea) : (1.f + eb) / (1.f + ea); }
                f32x4& v0 = acc[ai][bj][m][0]; f32x4& v1 = acc[ai][bj][m][1];
                v0 = v0 * (f32x4){f[0], f[1], f[2], f[3]}; v1 = v1 * (f32x4){f[4], f[5], f[6], f[7]};
                if (last) { u32x4 w; w.x = cvt_pk_bf16(v0.x, v0.y); w.y = cvt_pk_bf16(v0.z, v0.w); w.z = cvt_pk_bf16(v1.x, v1.y); w.w = cvt_pk_bf16(v1.z, v1.w);
                    *(u32x4*)(MB + EM_ROW(it) * DM + col0 + bj * 128) = w; } }
            gq[0] = gn[0]; gq[1] = gn[1]; hq[0] = hn[0]; hq[1] = hn[1];
            __builtin_amdgcn_sched_barrier(0); }
#undef EM_ROW
        return !last;
    }
};
struct OrderMerge {
    pg8::StaticOrder so;
    __device__ void init(int G, int c, int nM, int pm0) { so.init(nM, 8, G, c, pm0); }
    __device__ bool next(int i, Unit& u) const { Unit t; if (!so.next(i >> 2, t)) return false; const int br = i & 3; u.pm = br * 66 + t.pm; u.pn = br * 8 + t.pn; return true; }
};
struct EpiF32 {
    static constexpr bool PERM = true, KEEPS = false;
    float* O; int ldc;
    __device__ __forceinline__ void operator()(const f32x4 (&acc)[2][2][4][2], const Unit& u, int wr, int wc, int fr, int fq) const {
        EPI_LOOP_BEGIN
            float* o = O + (size_t)row * ldc + u.pn * 256 + cl; *(f32x4*)o = v0; *(f32x4*)(o + 4) = v1;
        EPI_LOOP_END
    }
};
__device__ __forceinline__ int moe_panel(int e, int pi) { return pi < 8 ? (((pi >> 2) * NEXP + e) * 4 + (pi & 3)) : 128 + e; }
struct OrderMoe {
    int npn, G, c, npan;
    __device__ void init(int npn_, int G_, int c_, int npan_) { npn = npn_; G = G_; c = c_; npan = npan_; }
    __device__ bool next(int i, Unit& u) const { const int per = npan * npn;
        if ((G & 7) == 0 && G >= 8) { const int xcd = c & 7, wx = G >> 3, r = c >> 3; const int Lx = i * wx + r; if (Lx >= 2 * per) return false;
            const int e = xcd + 8 * (Lx / per), rem = Lx % per, j = rem / npan, pi = rem % npan; u.pm = moe_panel(e, pi); u.pn = e * npn + j; return true; }
        const int L = i * G + c; if (L >= NEXP * per) return false;
        const int e = L / per, r = L % per, j = r / npan, pi = r % npan; u.pm = moe_panel(e, pi); u.pn = e * npn + j; return true; }
};
struct EpiSwiglu {
    static constexpr bool PERM = true, KEEPS = false;
    unsigned char* HID;
    __device__ __forceinline__ void operator()(const f32x4 (&acc)[2][2][4][2], const Unit& u, int wr, int wc, int fr, int fq) const {
        const int j = u.pn % 11; const int row0 = u.pm * 256 + wr * 64 + fr; const float sc = 1.f / 64.f;
#pragma unroll
        for (int ai = 0; ai < 2; ++ai)
#pragma unroll
            for (int m = 0; m < 4; ++m) { const int row = row0 + ai * 128 + m * 16;
                const f32x4 g0 = acc[ai][0][m][0] * sc, g1 = acc[ai][0][m][1] * sc, u0 = acc[ai][1][m][0] * sc, u1 = acc[ai][1][m][1] * sc;
                u32x2 w; w.x = pk4fp8(siluf_(g0.x) * u0.x, siluf_(g0.y) * u0.y, siluf_(g0.z) * u0.z, siluf_(g0.w) * u0.w);
                w.y = pk4fp8(siluf_(g1.x) * u1.x, siluf_(g1.y) * u1.y, siluf_(g1.z) * u1.z, siluf_(g1.w) * u1.w);
                *(u32x2*)(HID + (size_t)row * EFFP + j * 128 + wc * 32 + 8 * fq) = w; __builtin_amdgcn_sched_barrier(0); }
    }
};
struct EpiDown {
    static constexpr bool PERM = true, KEEPS = false;
    bf16_t* YE;
    __device__ __forceinline__ void operator()(const f32x4 (&acc)[2][2][4][2], const Unit& uu, int wr, int wc, int fr, int fq) const {
        Unit u; u.pm = uu.pm; u.pn = uu.pn & 7; const float s = 1.f / 64.f;
        EPI_LOOP_BEGIN
            u32x4 w; w.x = cvt_pk_bf16(v0.x * s, v0.y * s); w.y = cvt_pk_bf16(v0.z * s, v0.w * s); w.z = cvt_pk_bf16(v1.x * s, v1.y * s); w.w = cvt_pk_bf16(v1.z * s, v1.w * s);
            *(u32x4*)(YE + (size_t)row * DM + u.pn * 256 + cl) = w;
        EPI_LOOP_END
    }
};

namespace att {
using s16x4 = __attribute__((ext_vector_type(4))) short;
using f32x16 = __attribute__((ext_vector_type(16))) float;
constexpr int NW = 8, QBLK = 32, KVBLK = 64, LDQ = 1536, LDKV = 2048, LDO = 1024;
constexpr float SCALE = 0.07216878364870322f;
constexpr float THR = 8.f;
#ifndef ATT_SDEPTH
#define ATT_SDEPTH 1
#endif
constexpr int SDEPTH = ATT_SDEPTH;
constexpr int SHM_V = KVBLK * 128 * 2, SHM_K = KVBLK * 128 * 2, SHM_KP = KVBLK * 64 * 2;
constexpr int OFF_V = 0, OFF_K = 2 * SHM_V, OFF_KP = OFF_K + 2 * SHM_K, OFF_WS = OFF_KP + 2 * SHM_KP, OFF_QP = OFF_WS + NW * 64 * 4, SHM_ATTN = OFF_QP + 256 * 256;
static_assert(SHM_ATTN <= 150 * 1024, "attention LDS");
#define KSWZ(row, colB) ((row) * 256 + ((colB) ^ (((row) & 7) << 4)))
#define KPSWZ(row, colB) ((row) * 128 + ((colB) ^ (((row) & 7) << 4)))
#define SBAR() __builtin_amdgcn_sched_barrier(0)
__device__ __forceinline__ int crow(int r, int hi) { return (r & 3) + 8 * (r >> 2) + 4 * hi; }
__device__ __forceinline__ void partialSM(f32x16& p0, f32x16& p1, float& m_reg, float& mn, float& alpha) {
  constexpr float C = SCALE * 1.4426950408889634f;
  float pmax = p0[0]; for (int r = 1; r < 16; ++r) pmax = fmaxf(pmax, p0[r]); for (int r = 0; r < 16; ++r) pmax = fmaxf(pmax, p1[r]);
  { auto rr = __builtin_amdgcn_permlane32_swap(__float_as_uint(pmax), __float_as_uint(pmax), false, false);
    pmax = fmaxf(__uint_as_float(rr[0]), __uint_as_float(rr[1])); }
  if (__builtin_expect(__all(pmax - m_reg <= THR / SCALE), 1)) { mn = m_reg; alpha = 1.f; }
  else { mn = fmaxf(m_reg, pmax); alpha = __builtin_amdgcn_exp2f((m_reg - mn) * C); m_reg = mn; }
  float mnC = -mn * C;
  for (int r = 0; r < 16; ++r) p0[r] = fmaf(p0[r], C, mnC); for (int r = 0; r < 16; ++r) p1[r] = fmaf(p1[r], C, mnC);
  for (int r = 0; r < 16; ++r) p0[r] = __builtin_amdgcn_exp2f(p0[r]);
}
__device__ __forceinline__ void finishSM(f32x16& p0, f32x16& p1, float alpha, float& l_reg, bf16x8& pa0, bf16x8& pa1, bf16x8& pa2, bf16x8& pa3) {
  for (int r = 0; r < 16; ++r) p1[r] = __builtin_amdgcn_exp2f(p1[r]);
  float ps = 0; for (int r = 0; r < 16; ++r) ps += p0[r]; for (int r = 0; r < 16; ++r) ps += p1[r];
  { auto rr = __builtin_amdgcn_permlane32_swap(__float_as_uint(ps), __float_as_uint(ps), false, false);
    ps = __uint_as_float(rr[0]) + __uint_as_float(rr[1]); }
  l_reg = l_reg * alpha + ps;
#define PK4(P, BASE, OUT) do { unsigned a0 = cvt_pk_bf16(P[BASE + 0], P[BASE + 1]), a1 = cvt_pk_bf16(P[BASE + 2], P[BASE + 3]);   \
    unsigned b0 = cvt_pk_bf16(P[BASE + 4], P[BASE + 5]), b1 = cvt_pk_bf16(P[BASE + 6], P[BASE + 7]);                              \
    auto r0 = __builtin_amdgcn_permlane32_swap(a0, b0, false, false); auto r1 = __builtin_amdgcn_permlane32_swap(a1, b1, false, false); \
    u32x4 w = {r0[0], r1[0], r0[1], r1[1]}; OUT = *reinterpret_cast<bf16x8*>(&w); } while (0)
  PK4(p0, 0, pa0); PK4(p0, 8, pa1); PK4(p1, 0, pa2); PK4(p1, 8, pa3);
#undef PK4
}
__device__ __forceinline__ void qkt(f32x16& p0, f32x16& p1, const char* Ks, const char* Kp, const bf16x8* qr, const char* Qp, int qrow, int r32, int hi) {
  p0 = f32x16{}; p1 = f32x16{};
#pragma unroll
  for (int d0 = 0; d0 < 8; ++d0) { int cb = (d0 * 16 + hi * 8) * 2;
    bf16x8 b0 = *reinterpret_cast<const bf16x8*>(Ks + KSWZ(r32, cb));
    bf16x8 b1 = *reinterpret_cast<const bf16x8*>(Ks + KSWZ(32 + r32, cb));
    bf16x8 q; if (d0 < 4) q = qr[d0]; else q = *reinterpret_cast<const bf16x8*>(Qp + KSWZ(qrow, ((d0 - 4) * 16 + hi * 8) * 2));
    p0 = __builtin_amdgcn_mfma_f32_32x32x16_bf16(b0, q, p0, 0, 0, 0);
    p1 = __builtin_amdgcn_mfma_f32_32x32x16_bf16(b1, q, p1, 0, 0, 0); }
#pragma unroll
  for (int d0 = 0; d0 < 4; ++d0) { int cb = (d0 * 16 + hi * 8) * 2;
    bf16x8 b0 = *reinterpret_cast<const bf16x8*>(Kp + KPSWZ(r32, cb));
    bf16x8 b1 = *reinterpret_cast<const bf16x8*>(Kp + KPSWZ(32 + r32, cb));
    const bf16x8 qp = *reinterpret_cast<const bf16x8*>(Qp + KSWZ(qrow, 128 + cb));
    p0 = __builtin_amdgcn_mfma_f32_32x32x16_bf16(b0, qp, p0, 0, 0, 0);
    p1 = __builtin_amdgcn_mfma_f32_32x32x16_bf16(b1, qp, p1, 0, 0, 0); }
}
__device__ __forceinline__ int v_st(int k, int c) { const int kk = (k & ~0xC) | ((k & 4) << 1) | ((k & 8) >> 1); return ((kk >> 3) * 4 + (c >> 5)) * 512 + ((kk & 7) * 32 + (c & 31)) * 2; }
__device__ __forceinline__ int v_rd_base(int lane) { return ((lane & 3) << 3) | (((lane >> 2) & 3) << 6) | (((lane >> 4) & 1) << 5) | (((lane >> 5) & 1) << 8); }
constexpr int v_rd_off(int d0, int ks, int half) { return d0 * 512 + ks * 4096 + half * 2048; }
template <int OFF> __device__ __forceinline__ s16x4 tr_read(int vb) {
  s16x4 r; asm volatile("ds_read_b64_tr_b16 %0, %1 offset:%2" : "=&v"(r) : "v"(vb), "i"(OFF) : "memory"); return r;
}
template <int D0> __device__ __forceinline__ void pv_one(f32x16& od, int vb, bf16x8 pa0, bf16x8 pa1, bf16x8 pa2, bf16x8 pa3) {
  const s16x4 l0 = tr_read<v_rd_off(D0, 0, 0)>(vb), h0 = tr_read<v_rd_off(D0, 0, 1)>(vb), l1 = tr_read<v_rd_off(D0, 1, 0)>(vb), h1 = tr_read<v_rd_off(D0, 1, 1)>(vb);
  const s16x4 l2 = tr_read<v_rd_off(D0, 2, 0)>(vb), h2 = tr_read<v_rd_off(D0, 2, 1)>(vb), l3 = tr_read<v_rd_off(D0, 3, 0)>(vb), h3 = tr_read<v_rd_off(D0, 3, 1)>(vb);
  asm volatile("s_waitcnt lgkmcnt(0)" ::: "memory"); SBAR();
#define PK(L, H) (bf16x8){L[0], L[1], L[2], L[3], H[0], H[1], H[2], H[3]}
  od = __builtin_amdgcn_mfma_f32_32x32x16_bf16(pa0, PK(l0, h0), od, 0, 0, 0);
  od = __builtin_amdgcn_mfma_f32_32x32x16_bf16(pa1, PK(l1, h1), od, 0, 0, 0);
  od = __builtin_amdgcn_mfma_f32_32x32x16_bf16(pa2, PK(l2, h2), od, 0, 0, 0);
  od = __builtin_amdgcn_mfma_f32_32x32x16_bf16(pa3, PK(l3, h3), od, 0, 0, 0);
#undef PK
}
__device__ __forceinline__ void pv_d0(f32x16* o, int vb, bf16x8 pa0, bf16x8 pa1, bf16x8 pa2, bf16x8 pa3) {
  pv_one<0>(o[0], vb, pa0, pa1, pa2, pa3); pv_one<1>(o[1], vb, pa0, pa1, pa2, pa3); pv_one<2>(o[2], vb, pa0, pa1, pa2, pa3); pv_one<3>(o[3], vb, pa0, pa1, pa2, pa3);
}
__device__ __forceinline__ void attn_unit(const bf16_t* __restrict__ Qb, const bf16_t* __restrict__ KVh, const bf16_t* __restrict__ KPE, bf16_t* __restrict__ Ob,
                                          int ka0, int kb0, int NT, char* lds, int tid_in, int tpos0) {
  const unsigned tid_u = (unsigned)tid_in; __builtin_assume(tid_u < 512u);
  const int tid = (int)tid_u, wid = tid >> 6, lane = tid & 63, r32 = lane & 31, hi = lane >> 5;
  char* V_lds = lds + OFF_V; char* K_lds = lds + OFF_K; char* P_lds = lds + OFF_KP;
  float* ws = (float*)(lds + OFF_WS) + wid * 64; float* li_l = ws; float* al_l = ws + 32;
  float m_reg = -1e30f, l_reg = 0; f32x16 o[4] = {}; bf16x8 qr[4];
  char* Q_lds = lds + OFF_QP; const int qrow = wid * QBLK + r32;
  const bf16_t* Qw = Qb + (long)(wid * QBLK + r32) * LDQ + hi * 8;
#pragma unroll
  for (int d0 = 0; d0 < 4; ++d0) qr[d0] = *reinterpret_cast<const bf16x8*>(Qw + d0 * 16);
#pragma unroll
  for (int d0 = 0; d0 < 4; ++d0) *reinterpret_cast<bf16x8*>(Q_lds + KSWZ(qrow, (d0 * 16 + hi * 8) * 2)) = *reinterpret_cast<const bf16x8*>(Qw + 64 + d0 * 16);
#pragma unroll
  for (int ax = 0; ax < 2; ++ax) { u32x4 w1 = *reinterpret_cast<const u32x4*>(Qw + 128 + ax * 32), w2 = *reinterpret_cast<const u32x4*>(Qw + 128 + ax * 32 + 16);
    if (tpos0 >= 0) { const int t = tpos0 + qrow; const float pos = (float)(ax == 0 ? (t >> 6) : (t & 63));
      unsigned* p1 = (unsigned*)&w1; unsigned* p2 = (unsigned*)&w2;
#pragma unroll
      for (int i = 0; i < 4; ++i) { float a0 = bflo(p1[i]), a1 = bfhi(p1[i]), b0 = bflo(p2[i]), b1 = bfhi(p2[i]);
        const float ang0 = pos * __builtin_amdgcn_exp2f(-(float)(hi * 8 + 2 * i) * 0.8304820237218406f), ang1 = pos * __builtin_amdgcn_exp2f(-(float)(hi * 8 + 2 * i + 1) * 0.8304820237218406f);
        const float c0 = __cosf(ang0), s0 = __sinf(ang0), c1 = __cosf(ang1), s1 = __sinf(ang1);
        p1[i] = pk2(a0 * c0 - b0 * s0, a1 * c1 - b1 * s1); p2[i] = pk2(b0 * c0 + a0 * s0, b1 * c1 + a1 * s1); } }
    *reinterpret_cast<u32x4*>(Q_lds + KSWZ(qrow, 128 + (ax * 32 + hi * 8) * 2)) = w1; *reinterpret_cast<u32x4*>(Q_lds + KSWZ(qrow, 128 + (ax * 32 + 16 + hi * 8) * 2)) = w2; }
  const int sr = tid >> 4, sc = (tid & 15) * 8, vst0 = v_st(sr, sc), vst1 = v_st(32 + sr, sc);
  const int pr = tid >> 3, pc = (tid & 7) * 8;
  const int vb0 = (int)(uintptr_t)V_lds + v_rd_base(lane);
  struct { bf16x8 vs0, vs1, ks0, ks1, kp; } sr_[SDEPTH];
#define KROW(j) ((j) < 4 ? ka0 + 64 * (j) : kb0 + 64 * ((j) - 4))
  const __amdgpu_buffer_rsrc_t rsKV = __builtin_amdgcn_make_buffer_rsrc((void*)KVh, 0, 0xFFFFFFFFu, 0x00020000);
  const __amdgpu_buffer_rsrc_t rsKP = __builtin_amdgcn_make_buffer_rsrc((void*)KPE, 0, 0xFFFFFFFFu, 0x00020000);
  const int vo_k = (sr * LDKV + sc) * 2, vo_p = (pr * 64 + pc) * 2;
#define SLOAD(i, jt) do { const int k0_ = KROW(jt); const int so0 = k0_ * (LDKV * 2), so1 = so0 + 32 * LDKV * 2; \
    sr_[i].vs0 = __builtin_bit_cast(bf16x8, __builtin_amdgcn_raw_buffer_load_b128(rsKV, vo_k + 256, so0, 0)); sr_[i].vs1 = __builtin_bit_cast(bf16x8, __builtin_amdgcn_raw_buffer_load_b128(rsKV, vo_k + 256, so1, 0)); \
    sr_[i].ks0 = __builtin_bit_cast(bf16x8, __builtin_amdgcn_raw_buffer_load_b128(rsKV, vo_k, so0, 0)); sr_[i].ks1 = __builtin_bit_cast(bf16x8, __builtin_amdgcn_raw_buffer_load_b128(rsKV, vo_k, so1, 0)); \
    sr_[i].kp = __builtin_bit_cast(bf16x8, __builtin_amdgcn_raw_buffer_load_b128(rsKP, vo_p, k0_ * 128, 0)); } while (0)
#define SWRITE(b, i) do { *(bf16x8*)(V_lds + (b) * SHM_V + vst0) = sr_[i].vs0;          \
    *(bf16x8*)(V_lds + (b) * SHM_V + vst1) = sr_[i].vs1; int kc = sc * 2;               \
    *(bf16x8*)(K_lds + (b) * SHM_K + KSWZ(sr, kc)) = sr_[i].ks0;                       \
    *(bf16x8*)(K_lds + (b) * SHM_K + KSWZ(32 + sr, kc)) = sr_[i].ks1;                  \
    *(bf16x8*)(P_lds + (b) * SHM_KP + KPSWZ(pr, pc * 2)) = sr_[i].kp; } while (0)
#define SWAIT() do { if constexpr (SDEPTH == 2) asm volatile("s_waitcnt vmcnt(5)" ::: "memory"); else asm volatile("s_waitcnt vmcnt(0)" ::: "memory"); } while (0)
#define RESC(a) do { if (__any((a) < 1.f)) { if (hi == 0) al_l[r32] = (a); asm volatile("s_waitcnt lgkmcnt(0)" ::: "memory"); \
    for (int d = 0; d < 4; ++d) for (int r = 0; r < 16; ++r) o[d][r] *= al_l[crow(r, hi)]; } } while (0)
  f32x16 pA0, pA1, pB0, pB1; float mnA, mnB, alA, alB; bf16x8 pa0, pa1, pa2, pa3;
  constexpr int SE = 0, SO = SDEPTH - 1;
  SLOAD(SE, 0); asm volatile("s_waitcnt vmcnt(0)" ::: "memory"); SWRITE(0, SE); __syncthreads();
  qkt(pA0, pA1, K_lds, P_lds, qr, Q_lds, qrow, r32, hi); partialSM(pA0, pA1, m_reg, mnA, alA);
  SLOAD(SO, 1); if constexpr (SDEPTH == 2) { if (2 < NT) SLOAD(SE, 2); }
  SWAIT(); SWRITE(1, SO); __syncthreads();
  for (int j = 1; j + 1 < NT; j += 2) {
    SBAR(); qkt(pB0, pB1, K_lds + SHM_K, P_lds + SHM_KP, qr, Q_lds, qrow, r32, hi);
    finishSM(pA0, pA1, alA, l_reg, pa0, pa1, pa2, pa3); SBAR();
    SLOAD(SO, j + SDEPTH); SBAR();
    pv_d0(o, vb0, pa0, pa1, pa2, pa3); partialSM(pB0, pB1, m_reg, mnB, alB);
    __syncthreads(); SWAIT(); SWRITE(0, SE);
    RESC(alB); __syncthreads();
    SBAR(); qkt(pA0, pA1, K_lds, P_lds, qr, Q_lds, qrow, r32, hi);
    finishSM(pB0, pB1, alB, l_reg, pa0, pa1, pa2, pa3); SBAR();
    if (SDEPTH == 1 || j + 3 < NT) SLOAD(SE, j + 1 + SDEPTH); SBAR();
    pv_d0(o, vb0 + (int)SHM_V, pa0, pa1, pa2, pa3); partialSM(pA0, pA1, m_reg, mnA, alA);
    __syncthreads(); SWAIT(); SWRITE(1, SO);
    RESC(alA); __syncthreads();
  }
  SBAR(); qkt(pB0, pB1, K_lds + SHM_K, P_lds + SHM_KP, qr, Q_lds, qrow, r32, hi);
  finishSM(pA0, pA1, alA, l_reg, pa0, pa1, pa2, pa3); SBAR();
  pv_d0(o, vb0, pa0, pa1, pa2, pa3); partialSM(pB0, pB1, m_reg, mnB, alB);
  __syncthreads(); RESC(alB);
  finishSM(pB0, pB1, alB, l_reg, pa0, pa1, pa2, pa3); SBAR();
  pv_d0(o, vb0 + (int)SHM_V, pa0, pa1, pa2, pa3);
  if (hi == 0) li_l[r32] = l_reg; asm volatile("s_waitcnt lgkmcnt(0)" ::: "memory");
  float rli[16];
#pragma unroll
  for (int r = 0; r < 16; ++r) rli[r] = __builtin_amdgcn_rcpf(li_l[crow(r, hi)]);
  bf16_t* Ow = Ob + (long)(wid * QBLK) * LDO;
#pragma unroll
  for (int r = 0; r < 16; ++r) { int orow = crow(r, hi);
    for (int d0 = 0; d0 < 4; ++d0) Ow[(long)orow * LDO + d0 * 32 + r32] = (bf16_t)f2bf(o[d0][r] * rli[r]); }
  __syncthreads();
#undef KROW
#undef SLOAD
#undef SWRITE
#undef SWAIT
#undef RESC
}
}

__device__ __forceinline__ void phase_attn(Frame& F, bool lat_only) {
    const bf16_t* Q = WSP(bf16_t, WS_Q); const bf16_t* KV = WSP(bf16_t, WS_KV); const bf16_t* KPE = WSP(bf16_t, WS_KPE); bf16_t* YA = WSP(bf16_t, WS_Y);
    const int NU = NBATCH * NH_MLA * 32 + (lat_only ? 0 : NBATCH * NH_MLA);
    const bool xa = (F.G == 256);
    for (int u0 = F.bid; u0 < NU; u0 += F.G) {
        int u = u0;
        if (xa && u0 < NBATCH * NH_MLA * 32) { const int xcd = u0 & 7, r = (u0 >> 3) & 31, rnd = u0 >> 8; u = ((xcd + 8 * rnd) << 5) + r; }
        int b, h, row0, NT, tpos0;
        if (u < NBATCH * NH_MLA * 32) { const int bh = u >> 5, qb = u & 31; b = bh >> 3; h = bh & 7; row0 = TC + b * SEQ + qb * 256; NT = 4 + SEQ / 64; tpos0 = qb * 256; }
        else { const int bh = u - NBATCH * NH_MLA * 32; b = bh >> 3; h = bh & 7; row0 = b * CTX; NT = 4; tpos0 = -1; }
        att::attn_unit(Q + (size_t)row0 * 1536 + h * 192, KV + h * 256, KPE, YA + (size_t)row0 * 1024 + h * 128, b * CTX, TC + b * SEQ, NT, (char*)F.lds, F.tid, tpos0);
    }
}
__device__ __forceinline__ void phase_qrope(Frame& F) {
    bf16_t* Q = WSP(bf16_t, WS_Q);
    for (int row = TC + F.gw; row < T; row += F.NGW) {
        const int t = (row - TC) & (SEQ - 1); const int p = F.lane & 31, axis = p >> 4, j = p & 15, hs = F.lane >> 5;
        const float pos = (float)(axis == 0 ? (t >> 6) : (t & 63)); const float inv = __builtin_amdgcn_exp2f(-(float)j * 0.8304820237218406f);
        const float sn = __sinf(pos * inv), cs = __cosf(pos * inv);
#pragma unroll
        for (int hh = 0; hh < 4; ++hh) { const int h = hh * 2 + hs; bf16_t* q = Q + (size_t)row * 1536 + h * 192 + 128 + axis * 32 + j;
            const float x1 = bf2f(q[0]), x2 = bf2f(q[16]);
            q[0] = (bf16_t)f2bf(x1 * cs - x2 * sn); q[16] = (bf16_t)f2bf(x2 * cs + x1 * sn); }
    }
}

#define MFMA16(a, b, c) __builtin_amdgcn_mfma_f32_16x16x32_bf16((a), (b), (c), 0, 0, 0)
constexpr int XS_LD = 264, BC_LD = 136;
__device__ __forceinline__ float bperm(float v, int srclane) { return __builtin_bit_cast(float, __builtin_amdgcn_ds_bpermute(srclane << 2, __builtin_bit_cast(int, v))); }
__device__ __forceinline__ float wave_incl_scan(float v, int lane) {
#pragma unroll
    for (int o = 1; o < 64; o <<= 1) { const float t = bperm(v, lane - o); if (lane >= o) v += t; }
    return v;
}
template <int NCOLS>
__device__ __forceinline__ void stage_tile(LAS bf16_t* dst, int ld, const bf16_t* src, int tid) {
    constexpr int cpr = NCOLS >> 3, NIT = 128 * cpr / NTHREADS;
    u32x4 v[NIT];
#pragma unroll
    for (int k = 0; k < NIT; ++k) { const int i = tid + k * NTHREADS; const int r = i / cpr, c8 = (i % cpr) * 8; v[k] = *(const u32x4*)(src + (size_t)r * P2W + c8); }
#pragma unroll
    for (int k = 0; k < NIT; ++k) { const int i = tid + k * NTHREADS; const int r = i / cpr, c8 = (i % cpr) * 8; *(LAS u32x4*)(dst + r * ld + c8) = v[k]; }
}
__device__ __forceinline__ void phase_mamba_states(Frame& F, const Args& a, int layer) {
    const bf16_t* P2 = WSP(bf16_t, WS_P2); const float* DT = WSP(float, WS_DT); bf16_t* MST = WSP(bf16_t, WS_MST); float* MCS = WSP(float, WS_MCS);
    LAS bf16_t* XSl = (LAS bf16_t*)F.lds; LAS bf16_t* Bl = (LAS bf16_t*)(F.lds + 67584); LAS float* wt = (LAS float*)(F.lds + 102400) + F.wave * 128;
    const int lane = F.lane, row = lane & 15, quad = lane >> 4;
    for (int u = F.bid; u < NCHUNK * 4; u += F.G) {
        const int chunk = u >> 2, g = (u >> 1) & 1, half = u & 1, row0 = chunk * 128;
        __syncthreads();
        stage_tile<256>(XSl, XS_LD, P2 + (size_t)row0 * P2W + P2_XBC + (g * 8 + half * 4) * 64, F.tid);
        stage_tile<128>(Bl, BC_LD, P2 + (size_t)row0 * P2W + P2_XBC + 1024 + g * 128, F.tid);
        const int hl = F.wave >> 1, d = F.wave & 1, h = g * 8 + half * 4 + hl;
        const float aa = -__expf(arg_in(a, I_SALOG)[(layer * 2 + d) * 16 + h]);
        { const float dt0 = DT[(size_t)(row0 + lane) * 32 + d * 16 + h], dt1 = DT[(size_t)(row0 + 64 + lane) * 32 + d * 16 + h];
          const float da0 = dt0 * aa, da1 = dt1 * aa;
          float c0 = wave_incl_scan(da0, lane); const float tot0 = bperm(c0, 63); float c1 = wave_incl_scan(da1, lane) + tot0; const float tot = bperm(c1, 63);
          if (d == 0) { wt[lane] = dt0 * __expf(tot - c0); wt[64 + lane] = dt1 * __expf(tot - c1); }
          else { wt[lane] = dt0 * __expf(c0 - da0); wt[64 + lane] = dt1 * __expf(c1 - da1); }
          if (lane == 0) MCS[(d * NCHUNK + chunk) * 16 + h] = tot; }
        __syncthreads();
        bf16_t* out = MST + ((size_t)(d * NCHUNK + chunk) * 16 + h) * 8192;
#pragma unroll 1
        for (int nh = 0; nh < 2; ++nh) {
            f32x4 acc[4][4];
#pragma unroll
            for (int i = 0; i < 4; ++i)
#pragma unroll
                for (int j = 0; j < 4; ++j) acc[i][j] = (f32x4){0.f, 0.f, 0.f, 0.f};
#pragma unroll 1
            for (int k0 = 0; k0 < 128; k0 += 32) {
                const int sb = k0 + quad * 8;
                float w8[8];
#pragma unroll
                for (int j = 0; j < 8; ++j) w8[j] = wt[sb + j];
                bf16x8 bf[4];
#pragma unroll
                for (int nt = 0; nt < 4; ++nt) {
#pragma unroll
                    for (int j = 0; j < 8; ++j) bf[nt][j] = (short)Bl[(sb + j) * BC_LD + (nh * 4 + nt) * 16 + row]; }
#pragma unroll
                for (int pt = 0; pt < 4; ++pt) { bf16x8 af;
#pragma unroll
                    for (int j = 0; j < 8; ++j) af[j] = (short)f2bf(w8[j] * bf2f(XSl[(sb + j) * XS_LD + hl * 64 + pt * 16 + row]));
#pragma unroll
                    for (int nt = 0; nt < 4; ++nt) acc[pt][nt] = MFMA16(af, bf[nt], acc[pt][nt]); }
            }
#pragma unroll
            for (int pt = 0; pt < 4; ++pt)
#pragma unroll
                for (int nt = 0; nt < 4; ++nt)
#pragma unroll
                    for (int jj = 0; jj < 4; ++jj) out[(pt * 16 + quad * 4 + jj) * 128 + (nh * 4 + nt) * 16 + row] = (bf16_t)f2bf(acc[pt][nt][jj]);
        }
    }
}
__device__ __forceinline__ void phase_mamba_scan(Frame& F) {
    bf16_t* MST = WSP(bf16_t, WS_MST); const float* MCS = WSP(float, WS_MCS);
    for (int idx = F.bid * NTHREADS + F.tid; idx < 2 * 2 * 16 * 8192; idx += F.G * NTHREADS) {
        const int e = idx & 8191, h = (idx >> 13) & 15, b = (idx >> 17) & 1, d = idx >> 18;
        float state = 0.f;
#pragma unroll 6
        for (int i = 0; i < 66; ++i) {
            int chunk; if (i < 2) chunk = 2 * b + (d == 0 ? i : 1 - i); else chunk = 4 + 64 * b + (d == 0 ? i - 2 : 65 - i);
            bf16_t* p = MST + ((size_t)(d * NCHUNK + chunk) * 16 + h) * 8192 + e;
            const float cs = bf2f(*p); const float dec = __expf(MCS[(d * NCHUNK + chunk) * 16 + h]);
            *p = (bf16_t)f2bf(state);
            state = state * dec + cs;
        }
    }
}
__device__ __forceinline__ void phase_mamba_out(Frame& F, const Args& a, int layer) {
    const bf16_t* P = WSP(bf16_t, WS_P); const bf16_t* P2 = WSP(bf16_t, WS_P2); const float* DT = WSP(float, WS_DT); const bf16_t* MST = WSP(bf16_t, WS_MST);
    bf16_t* YB = WSP(bf16_t, WS_Y) + (size_t)1 * T * 1024;
    LAS bf16_t* Cl = (LAS bf16_t*)F.lds; LAS bf16_t* Bl = (LAS bf16_t*)(F.lds + 34816); LAS bf16_t* XSl = (LAS bf16_t*)(F.lds + 69632);
    LAS float* tab = (LAS float*)(F.lds + 137216);
    for (int u = F.bid; u < NCHUNK * 4; u += F.G) {
        const int chunk = u >> 2, g = (u >> 1) & 1, half = u & 1, row0 = chunk * 128;
        __syncthreads();
        { const int tid_ = F.wave * 64 + (lane_asm() & 63);
          stage_tile<256>(XSl, XS_LD, P2 + (size_t)row0 * P2W + P2_XBC + (g * 8 + half * 4) * 64, tid_);
          stage_tile<128>(Bl, BC_LD, P2 + (size_t)row0 * P2W + P2_XBC + 1024 + g * 128, tid_);
          stage_tile<128>(Cl, BC_LD, P2 + (size_t)row0 * P2W + P2_XBC + 1280 + g * 128, tid_); }
        const int lane = lane_asm() & 63, row = lane & 15, quad = lane >> 4;
        float tot1 = 0.f;
        { const int hl = F.wave >> 1, d = F.wave & 1, h = g * 8 + half * 4 + hl;
          const float aa = -__expf(arg_in(a, I_SALOG)[(layer * 2 + d) * 16 + h]);
          const float dt0 = DT[(size_t)(row0 + lane) * 32 + d * 16 + h], dt1 = DT[(size_t)(row0 + 64 + lane) * 32 + d * 16 + h];
          const float da0 = dt0 * aa, da1 = dt1 * aa;
          float c0 = wave_incl_scan(da0, lane); const float t0 = bperm(c0, 63); float c1 = wave_incl_scan(da1, lane) + t0;
          LAS float* tb = tab + hl * 512;
          if (d == 0) { tb[lane] = c0; tb[64 + lane] = c1; tb[256 + lane] = __logf(dt0) - c0; tb[320 + lane] = __logf(dt1) - c1; }
          else { tb[128 + lane] = c0 - da0; tb[192 + lane] = c1 - da1; tb[384 + lane] = (c0 - da0) + __logf(dt0); tb[448 + lane] = (c1 - da1) + __logf(dt1); if (lane == 63) tab[2048 + hl] = c1; } }
        __syncthreads();
        { f32x4 cb[8];
#pragma unroll
          for (int st = 0; st < 8; ++st) cb[st] = (f32x4){0.f, 0.f, 0.f, 0.f};
#pragma unroll
          for (int k0 = 0; k0 < 128; k0 += 32) { const bf16x8 af = *(const LAS bf16x8*)(Cl + (F.wave * 16 + row) * BC_LD + k0 + quad * 8);
#pragma unroll
              for (int st = 0; st < 8; ++st) { const bf16x8 bfr = *(const LAS bf16x8*)(Bl + (st * 16 + row) * BC_LD + k0 + quad * 8); cb[st] = MFMA16(af, bfr, cb[st]); } }
          __syncthreads();
#pragma unroll
          for (int st = 0; st < 8; ++st)
#pragma unroll
              for (int jj = 0; jj < 4; ++jj) Bl[(F.wave * 16 + quad * 4 + jj) * BC_LD + st * 16 + row] = (bf16_t)f2bf(cb[st][jj]); }
        __syncthreads();
        const int hl = F.wave >> 1, th = F.wave & 1, h = g * 8 + half * 4 + hl;
        const LAS float* tb = tab + hl * 512; tot1 = tab[2048 + hl];
        f32x4 acc[4][4];
#pragma unroll
        for (int i = 0; i < 4; ++i)
#pragma unroll
            for (int j = 0; j < 4; ++j) acc[i][j] = (f32x4){0.f, 0.f, 0.f, 0.f};
#pragma unroll 1
        for (int k0 = 0; k0 < 128; k0 += 32) {
            const int sb = k0 + quad * 8;
            float u0s[8], u1s[8];
#pragma unroll
            for (int j = 0; j < 8; ++j) { u0s[j] = tb[256 + sb + j]; u1s[j] = tb[384 + sb + j]; }
            bf16x8 bx[4];
#pragma unroll
            for (int pt = 0; pt < 4; ++pt) {
#pragma unroll
                for (int j = 0; j < 8; ++j) bx[pt][j] = (short)XSl[(sb + j) * XS_LD + hl * 64 + pt * 16 + row]; }
#pragma unroll
            for (int tt = 0; tt < 4; ++tt) { const int t = th * 64 + tt * 16 + row; const float c0t = tb[t], e1t = tb[128 + t];
                float cbv[8]; { const u32x4 w = *(const LAS u32x4*)(Bl + t * BC_LD + sb); cbv[0] = bflo(w.x); cbv[1] = bfhi(w.x); cbv[2] = bflo(w.y); cbv[3] = bfhi(w.y); cbv[4] = bflo(w.z); cbv[5] = bfhi(w.z); cbv[6] = bflo(w.w); cbv[7] = bfhi(w.w); }
                bf16x8 af;
#pragma unroll
                for (int j = 0; j < 8; ++j) { const int s = sb + j;
                    const float f0 = s <= t ? __expf(c0t + u0s[j]) : 0.f;
                    const float f1 = s >= t ? __expf(u1s[j] - e1t) : 0.f;
                    af[j] = (short)f2bf(cbv[j] * (f0 + f1)); }
#pragma unroll
                for (int pt = 0; pt < 4; ++pt) acc[tt][pt] = MFMA16(af, bx[pt], acc[tt][pt]); }
        }
#pragma unroll 1
        for (int d = 0; d < 2; ++d) {
            const bf16_t* S = MST + ((size_t)(d * NCHUNK + chunk) * 16 + h) * 8192;
#pragma unroll 1
            for (int k0 = 0; k0 < 128; k0 += 32) {
                bf16x8 bs[4];
#pragma unroll
                for (int pt = 0; pt < 4; ++pt) bs[pt] = *(const bf16x8*)(S + (pt * 16 + row) * 128 + k0 + quad * 8);
#pragma unroll
                for (int tt = 0; tt < 4; ++tt) { const int t = th * 64 + tt * 16 + row;
                    const float sc = d == 0 ? __expf(tb[t]) : __expf(tot1 - tb[128 + t]);
                    const u32x4 cw = *(const LAS u32x4*)(Cl + t * BC_LD + k0 + quad * 8);
                    u32x4 aw; aw.x = cvt_pk_bf16(bflo(cw.x) * sc, bfhi(cw.x) * sc); aw.y = cvt_pk_bf16(bflo(cw.y) * sc, bfhi(cw.y) * sc);
                    aw.z = cvt_pk_bf16(bflo(cw.z) * sc, bfhi(cw.z) * sc); aw.w = cvt_pk_bf16(bflo(cw.w) * sc, bfhi(cw.w) * sc);
                    const bf16x8 af = __builtin_bit_cast(bf16x8, aw);
#pragma unroll
                    for (int pt = 0; pt < 4; ++pt) acc[tt][pt] = MFMA16(af, bs[pt], acc[tt][pt]); } }
        }
        const float Dh = arg_in(a, I_SD)[layer * 16 + h];
#pragma unroll
        for (int tt = 0; tt < 4; ++tt)
#pragma unroll
            for (int jj = 0; jj < 4; ++jj) { const int t = th * 64 + tt * 16 + quad * 4 + jj; const size_t r = (size_t)(row0 + t);
#pragma unroll
                for (int pt = 0; pt < 4; ++pt) { const int p = pt * 16 + row;
                    const float xs = bf2f(XSl[t * XS_LD + hl * 64 + p]); const float z = bf2f(P[r * NNG + P_Z + h * 64 + p]);
                    YB[r * 1024 + h * 64 + p] = (bf16_t)f2bf((acc[tt][pt][jj] + xs * Dh) * siluf_(z)); } }
    }
}
__device__ __forceinline__ void phase_mamba_norm(Frame& F, const Args& a, int layer) {
    bf16_t* YB = WSP(bf16_t, WS_Y) + (size_t)1 * T * 1024; const float* nw = arg_in(a, I_SNORM) + layer * 1024;
    for (int row = F.gw; row < T; row += F.NGW) {
        bf16_t* p = YB + (size_t)row * 1024 + F.lane * 16; float x[16]; { float t0[8], t1[8]; ld8bf(p, t0); ld8bf(p + 8, t1);
#pragma unroll
            for (int i = 0; i < 8; ++i) { x[i] = t0[i]; x[8 + i] = t1[i]; } }
        float s = 0.f;
#pragma unroll
        for (int i = 0; i < 16; ++i) s += x[i] * x[i];
        s = sum32(s);
        const float r = 1.f / sqrtf(s * (1.f / 512.f) + 1e-5f);
        float o0[8], o1[8];
#pragma unroll
        for (int i = 0; i < 8; ++i) { o0[i] = x[i] * r * nw[F.lane * 16 + i]; o1[i] = x[8 + i] * r * nw[F.lane * 16 + 8 + i]; }
        st8bf(p, o0); st8bf(p + 8, o1);
    }
}

__device__ __forceinline__ float dpp_f(float x, const int ctrl_sel) {
    const int xi = __builtin_bit_cast(int, x); int r;
    if (ctrl_sel == 0) r = __builtin_amdgcn_update_dpp(0, xi, 0xB1, 0xF, 0xF, false);
    else if (ctrl_sel == 1) r = __builtin_amdgcn_update_dpp(0, xi, 0x4E, 0xF, 0xF, false);
    else r = __builtin_amdgcn_update_dpp(0, xi, 0x141, 0xF, 0xF, false);
    return __builtin_bit_cast(float, r);
}
__device__ __forceinline__ float red8(float x) { x += dpp_f(x, 0); x += dpp_f(x, 1); x += dpp_f(x, 2); return x; }
__device__ __forceinline__ int rw_row(int pos, int b, int d) { return pos < CTX ? b * CTX + (d == 0 ? pos : CTX - 1 - pos) : TC + b * SEQ + (d == 0 ? pos - CTX : SEQ - 1 - (pos - CTX)); }
constexpr int RW_STEP_F = 336, RW_CH = 32, RW_CHF = RW_STEP_F * RW_CH;
struct RwOps { f32x4 w, k, b, a, r; float v; };
__device__ __forceinline__ void rw_load(RwOps& o, const LAS float* sp, const LAS float* vp) {
    o.w = *(const LAS f32x4*)(sp); o.k = *(const LAS f32x4*)(sp + 64); o.b = *(const LAS f32x4*)(sp + 128); o.a = *(const LAS f32x4*)(sp + 192); o.r = *(const LAS f32x4*)(sp + 256); o.v = *vp;
}
__device__ __forceinline__ void rw_step(f32x4& s, const RwOps& o, LAS float* yp) {
    const f32x4 tt = s * o.w + o.k * o.v;
    const f32x4 pa = s * o.a; float sa = (pa.x + pa.y) + (pa.z + pa.w); sa = sum16(sa);
    s = tt + o.b * sa;
    const f32x4 pr = s * o.r; *yp = (pr.x + pr.y) + (pr.z + pr.w);
}
struct RwRaw { unsigned ew[4], ic[4], kk[4], rr[4], kr[4], vv[4]; };
__device__ __forceinline__ void phase_rwkv_scan(Frame& F, const Args& a, int layer) {
    const bf16_t* P2 = WSP(bf16_t, WS_P2); const bf16_t* EW = WSP(bf16_t, WS_EW); const bf16_t* ICLR = WSP(bf16_t, WS_ICLR); const bf16_t* KK = WSP(bf16_t, WS_KK);
    bf16_t* YRW = WSP(bf16_t, WS_YRW);
    LAS float* ring = (LAS float*)F.lds; LAS float* ybuf = (LAS float*)(F.lds + 2 * RW_CHF * 4);
    const int lane = F.lane;
    for (int u0 = F.bid; u0 < 256; u0 += F.G) {
        const int u = (F.G == 256) ? (((u0 & 7) * 8 + (u0 >> 5)) << 2) + ((u0 >> 3) & 3) : u0;
        const int chain = u >> 2, rq = u & 3, d = chain >> 5, b = (chain >> 4) & 1, h = chain & 15;
        constexpr int NCH = (CTX + SEQ) / RW_CH;
        const int lw = F.wave - 4;
        const int tsel = lane >> 5, kp = lane & 31;
        const f32x2 ka2 = *(const f32x2*)(arg_in(a, I_RKA) + layer * 1024 + h * 64 + 2 * kp);
        auto issue = [&](RwRaw& x, int cidx) {
            const int row0 = rw_row(cidx * RW_CH, b, d), st = d == 0 ? 1 : -1;
            const int tk0 = 2 * lw + tsel;
            const unsigned* ewp = (const unsigned*)(EW + (size_t)d * T * 1024); const unsigned* icp = (const unsigned*)(ICLR + (size_t)d * T * 1024);
            const unsigned* kkp = (const unsigned*)KK; const unsigned* p2p = (const unsigned*)P2;
#pragma unroll
            for (int j = 0; j < 4; ++j) { const int row = row0 + st * (8 * j + tk0); const int o = (row * 1024 + h * 64) / 2 + kp, q = (row * P2W + P2_RKV + h * 64) / 2 + kp;
                x.ew[j] = ewp[o]; x.ic[j] = icp[o]; x.kk[j] = kkp[o]; x.rr[j] = p2p[q]; x.kr[j] = p2p[q + 512]; x.vv[j] = p2p[q + 1024 + rq * 8 - kp + (kp & 7)]; } };
        auto commit = [&](const RwRaw& x, int cidx) {
            LAS float* dst = ring + (cidx & 1) * RW_CHF;
#pragma unroll
            for (int j = 0; j < 4; ++j) { LAS float* sbase = dst + (8 * j + 2 * lw + tsel) * RW_STEP_F; LAS f32x2* s2 = (LAS f32x2*)sbase + kp;
                const f32x2 ew = {bflo(x.ew[j]), bfhi(x.ew[j])}, ic = {bflo(x.ic[j]), bfhi(x.ic[j])}, kkv = {bflo(x.kk[j]), bfhi(x.kk[j])}, rr = {bflo(x.rr[j]), bfhi(x.rr[j])}, kr = {bflo(x.kr[j]), bfhi(x.kr[j])};
                s2[0] = (f32x2){__expf(-ew.x), __expf(-ew.y)}; s2[32] = kr * ((ic - 1.f) * ka2 + 1.f); s2[64] = kkv * ic; s2[96] = -kkv; s2[128] = rr;
                if (kp < 8) s2[160] = (f32x2){bflo(x.vv[j]), bfhi(x.vv[j])}; } };
        auto flush_chunk = [&](int cidx) {
            const LAS float* yb = ybuf + (cidx & 1) * (RW_CH * 256);
            const int row0 = rw_row(cidx * RW_CH, b, d), st = d == 0 ? 1 : -1;
#pragma unroll
            for (int q = 0; q < 2; ++q) { const int i = (F.tid - 256) + 256 * q, tok = i >> 4, rr = i & 15; const LAS f32x4* pp = (const LAS f32x4*)(yb + i * 16);
                const f32x4 p0 = pp[0], p1 = pp[1], p2 = pp[2], p3 = pp[3];
                const float y = ((p0.x + p0.y) + (p0.z + p0.w)) + ((p1.x + p1.y) + (p1.z + p1.w)) + (((p2.x + p2.y) + (p2.z + p2.w)) + ((p3.x + p3.y) + (p3.z + p3.w)));
                YRW[((size_t)d * T + row0 + st * tok) * 1024 + h * 64 + rq * 16 + rr] = (bf16_t)f2bf(y); } };
        auto compute = [&](f32x4& s, int c) {
            const int rloc = lane >> 4, kq = lane & 15, r16 = F.wave * 4 + rloc;
            const LAS float* base = ring + (c & 1) * RW_CHF + kq * 4; const LAS float* vb = ring + (c & 1) * RW_CHF + 320 + r16; LAS float* yb = ybuf + (c & 1) * (RW_CH * 256) + r16 * 16 + kq;
            RwOps o0, o1, o2, o3;
            rw_load(o0, base, vb); rw_load(o1, base + RW_STEP_F, vb + RW_STEP_F); rw_load(o2, base + 2 * RW_STEP_F, vb + 2 * RW_STEP_F);
#pragma unroll
            for (int t = 0; t < RW_CH; t += 4) {
                if (t + 3 < RW_CH) rw_load(o3, base + (t + 3) * RW_STEP_F, vb + (t + 3) * RW_STEP_F);
                rw_step(s, o0, yb + t * 256);
                if (t + 4 < RW_CH) rw_load(o0, base + (t + 4) * RW_STEP_F, vb + (t + 4) * RW_STEP_F);
                rw_step(s, o1, yb + (t + 1) * 256);
                if (t + 5 < RW_CH) rw_load(o1, base + (t + 5) * RW_STEP_F, vb + (t + 5) * RW_STEP_F);
                rw_step(s, o2, yb + (t + 2) * 256);
                if (t + 6 < RW_CH) rw_load(o2, base + (t + 6) * RW_STEP_F, vb + (t + 6) * RW_STEP_F);
                rw_step(s, o3, yb + (t + 3) * 256);
            } };
        __syncthreads();
        f32x4 s = {0.f, 0.f, 0.f, 0.f};
        if (F.wave >= 4) {
            RwRaw ra, rb;
            issue(ra, 0); commit(ra, 0); issue(ra, 1);
            __syncthreads();
            for (int c = 0; c < NCH; c += 2) {
                if (c + 2 < NCH) issue(rb, c + 2);
                if (c > 0) flush_chunk(c - 1);
                commit(ra, c + 1);
                __syncthreads();
                if (c + 3 < NCH) issue(ra, c + 3);
                flush_chunk(c);
                if (c + 2 < NCH) commit(rb, c + 2);
                __syncthreads();
            }
            flush_chunk(NCH - 1);
        } else {
            __syncthreads();
            for (int c = 0; c < NCH; c += 2) { compute(s, c); __syncthreads(); compute(s, c + 1); __syncthreads(); }
        }
    }
}
__device__ __forceinline__ void phase_rwkv_out(Frame& F, const Args& a, int layer) {
    const bf16_t* P2 = WSP(bf16_t, WS_P2); const bf16_t* ICLR = WSP(bf16_t, WS_ICLR); const bf16_t* YRW = WSP(bf16_t, WS_YRW); const bf16_t* GG = WSP(bf16_t, WS_GG);
    bf16_t* YD = WSP(bf16_t, WS_Y) + (size_t)3 * T * 1024;
    const float* lng = arg_in(a, I_RLNG) + layer * 1024; const float* lnb = arg_in(a, I_RLNB) + layer * 1024; const float* rk = arg_in(a, I_RRK) + layer * 1024; const float* kav = arg_in(a, I_RKA) + layer * 1024;
    for (int row = F.gw; row < T; row += F.NGW) {
        const int c = F.lane * 16; const size_t o = (size_t)row * 1024 + c;
        float y[16], r[16], k[16], v[16], i0[16], i1[16], g[16];
#define LD16(dst, ptr) do { float t0_[8], t1_[8]; ld8bf((ptr), t0_); ld8bf((ptr) + 8, t1_); _Pragma("unroll") for (int i_ = 0; i_ < 8; ++i_) { dst[i_] = t0_[i_]; dst[8 + i_] = t1_[i_]; } } while (0)
        LD16(y, YRW + o); LD16(r, YRW + (size_t)T * 1024 + o);
#pragma unroll
        for (int i = 0; i < 16; ++i) y[i] += r[i];
        const bf16_t* p2 = P2 + (size_t)row * P2W + P2_RKV + c;
        LD16(r, p2); LD16(k, p2 + 1024); LD16(v, p2 + 2048); LD16(i0, ICLR + o); LD16(i1, ICLR + (size_t)T * 1024 + o); LD16(g, GG + o);
#undef LD16
        float s = 0.f, bsum = 0.f;
#pragma unroll
        for (int i = 0; i < 16; ++i) { s += y[i]; const float ka = kav[c + i]; bsum += r[i] * k[i] * rk[c + i] * ((1.f + (i0[i] - 1.f) * ka) + (1.f + (i1[i] - 1.f) * ka)); }
        s = sum4(s); bsum = sum4(bsum);
        const float mu = s * (1.f / 64.f); float q = 0.f;
#pragma unroll
        for (int i = 0; i < 16; ++i) { const float dd = y[i] - mu; q += dd * dd; }
        q = sum4(q);
        const float rstd = 1.f / sqrtf(q * (1.f / 64.f) + 64e-5f);
        float o0[8], o1[8];
#pragma unroll
        for (int i = 0; i < 8; ++i) { o0[i] = ((y[i] - mu) * rstd * lng[c + i] + lnb[c + i] + bsum * v[i]) * g[i];
            o1[i] = ((y[8 + i] - mu) * rstd * lng[c + 8 + i] + lnb[c + 8 + i] + bsum * v[8 + i]) * g[8 + i]; }
        st8bf(YD + o, o0); st8bf(YD + o + 8, o1);
    }
}

constexpr int FFT_N = 16384;
__device__ __forceinline__ int fswz(int i) { return i ^ (((i >> 5) & 3) << 2) ^ (((i >> 6) & 1) << 4); }
__device__ __forceinline__ f32x2 cmul(f32x2 a, f32x2 b) { return (f32x2){a.x * b.x - a.y * b.y, a.x * b.y + a.y * b.x}; }
template <bool INV>
__device__ __forceinline__ void fft_passes(LAS f32x2* X, int tid) {
#pragma unroll 1
    for (int st = 0; st < 7; ++st) {
        const int lq = INV ? 2 * st : 12 - 2 * st;
        const int q = 1 << lq;
        __syncthreads();
#pragma unroll 2
        for (int mm = 0; mm < 8; ++mm) { const int uu = tid + 512 * mm; const int k = uu & (q - 1), blk = uu >> lq; const int i0 = (blk << (lq + 2)) + k;
            const int p0 = fswz(i0), p1 = fswz(i0 + q), p2 = fswz(i0 + 2 * q), p3 = fswz(i0 + 3 * q);
            f32x2 a0 = X[p0], a1 = X[p1], a2 = X[p2], a3 = X[p3];
            const float fr = (float)k / (float)(4 * q);
            const float cs = __builtin_amdgcn_cosf(fr), sn = __builtin_amdgcn_sinf(fr);
            const f32x2 w1 = INV ? (f32x2){cs, sn} : (f32x2){cs, -sn}; const f32x2 w2 = cmul(w1, w1), w3 = cmul(w2, w1);
            if (!INV) {
                const f32x2 t0 = a0 + a2, t1 = a0 - a2, t2 = a1 + a3, t3 = a1 - a3;
                const f32x2 b0 = t0 + t2, b2 = t0 - t2, b1 = (f32x2){t1.x + t3.y, t1.y - t3.x}, b3 = (f32x2){t1.x - t3.y, t1.y + t3.x};
                X[p0] = b0; X[p1] = cmul(b1, w1); X[p2] = cmul(b2, w2); X[p3] = cmul(b3, w3);
            } else {
                a1 = cmul(a1, w1); a2 = cmul(a2, w2); a3 = cmul(a3, w3);
                const f32x2 u0 = a0 + a2, u1 = a0 - a2, u2 = a1 + a3, u3 = a1 - a3;
                X[p0] = u0 + u2; X[p2] = u0 - u2; X[p1] = (f32x2){u1.x - u3.y, u1.y + u3.x}; X[p3] = (f32x2){u1.x + u3.y, u1.y - u3.x};
            } }
    }
    __syncthreads();
}
__device__ __forceinline__ void phase_hyena_fft(Frame& F, const Args& a, int layer, bool dry = false) {
    const bf16_t* FILT = WSP(bf16_t, WS_FILT); float* VT = WSP(float, WS_VT); const float* hyd = arg_in(a, I_HD) + layer * 1024;
    LAS f32x2* X = (LAS f32x2*)F.lds;
    for (int c = F.bid; c < 1024; c += F.G) {
        __syncthreads();
        const int tid = F.wave * 64 + (lane_asm() & 63), i0 = tid * 16;
        { const bf16_t* hf = FILT + (size_t)c * 2 * SEQ; const bf16_t* hb = hf + SEQ;
          float f[16], g[16]; ld8bf(hf + i0, *(float(*)[8])&f[0]); ld8bf(hf + i0 + 8, *(float(*)[8])&f[8]);
          ld8bf(hb + (SEQ - 16 - i0), *(float(*)[8])&g[0]); ld8bf(hb + (SEQ - 8 - i0), *(float(*)[8])&g[8]);
#pragma unroll
          for (int j = 0; j < 16; ++j) X[fswz(i0 + j)] = (f32x2){f[j], 0.f};
#pragma unroll
          for (int j = 0; j < 16; ++j) { const int pos = SEQ + i0 + 1 + j; if (pos < FFT_N) X[fswz(pos)] = (f32x2){g[15 - j], 0.f}; }
          if (tid == 0) { float zz = 0.f; asm volatile("" : "+v"(zz)); X[fswz(SEQ)] = (f32x2){zz, zz}; } }
        fft_passes<false>(X, F.tid);
        f32x2 Kh[32];
#pragma unroll
        for (int j = 0; j < 32; ++j) Kh[j] = X[fswz(F.tid + 512 * j)];
        __syncthreads();
        float* v0 = VT + (size_t)c * 2 * SEQ; float* v1 = v0 + SEQ;
        { f32x4 a0[4], a1[4];
#pragma unroll
          for (int q = 0; q < 4; ++q) { a0[q] = *(const f32x4*)(v0 + i0 + 4 * q); a1[q] = *(const f32x4*)(v1 + i0 + 4 * q); }
#pragma unroll
          for (int q = 0; q < 4; ++q) { X[fswz(i0 + 4 * q)] = (f32x2){a0[q].x, a1[q].x}; X[fswz(i0 + 4 * q + 1)] = (f32x2){a0[q].y, a1[q].y}; X[fswz(i0 + 4 * q + 2)] = (f32x2){a0[q].z, a1[q].z}; X[fswz(i0 + 4 * q + 3)] = (f32x2){a0[q].w, a1[q].w}; }
          { float zz = 0.f; asm volatile("" : "+v"(zz));
#pragma unroll
          for (int j = 0; j < 16; ++j) X[fswz(SEQ + i0 + j)] = (f32x2){zz, zz}; } }
        fft_passes<false>(X, F.tid);
#pragma unroll
        for (int j = 0; j < 32; ++j) { const int p = fswz(F.tid + 512 * j); X[p] = cmul(X[p], Kh[j]); }
        fft_passes<true>(X, F.tid);
        const float dc = hyd[c];
        { f32x4 a0[4], a1[4];
#pragma unroll
          for (int q = 0; q < 4; ++q) { a0[q] = *(const f32x4*)(v0 + i0 + 4 * q); a1[q] = *(const f32x4*)(v1 + i0 + 4 * q); }
#pragma unroll
          for (int q = 0; q < 4; ++q) { const f32x2 r0 = X[fswz(i0 + 4 * q)], r1 = X[fswz(i0 + 4 * q + 1)], r2 = X[fswz(i0 + 4 * q + 2)], r3 = X[fswz(i0 + 4 * q + 3)];
              const f32x4 o0 = (f32x4){r0.x, r1.x, r2.x, r3.x} * (1.f / FFT_N) + a0[q] * dc, o1 = (f32x4){r0.y, r1.y, r2.y, r3.y} * (1.f / FFT_N) + a1[q] * dc;
              if (!dry) { *(f32x4*)(v0 + i0 + 4 * q) = o0; *(f32x4*)(v1 + i0 + 4 * q) = o1; } } }
    }
}
__device__ __forceinline__ void phase_hyena_out(Frame& F, const Args& a, int layer) {
    const float* VT = WSP(float, WS_VT); const bf16_t* P2 = WSP(bf16_t, WS_P2); bf16_t* YC = WSP(bf16_t, WS_Y) + (size_t)2 * T * 1024;
    LAS float* tl = (LAS float*)F.lds;
    for (int u = F.bid; u < (TL / 64) * 4; u += F.G) {
        const int tb = u >> 2, cb = u & 3; const int row0 = TC + tb * 64; const int b = (row0 - TC) >> 13, t0 = (row0 - TC) & (SEQ - 1);
        __syncthreads();
        for (int p = 0; p < 8; ++p) { const int cl = p * 32 + (F.tid >> 4), q = F.tid & 15;
            const f32x4 v = *(const f32x4*)(VT + ((size_t)(cb * 256 + cl) * 2 + b) * SEQ + t0 + 4 * q);
            tl[cl * 65 + 4 * q] = v.x; tl[cl * 65 + 4 * q + 1] = v.y; tl[cl * 65 + 4 * q + 2] = v.z; tl[cl * 65 + 4 * q + 3] = v.w; }
        __syncthreads();
        const int cl = F.tid & 255, th = F.tid >> 8;
        for (int i = 0; i < 32; ++i) { const int tl_ = th * 32 + i; const size_t row = (size_t)(row0 + tl_);
            const float x0 = bf2f(P2[row * P2W + P2_X0 + cb * 256 + cl]);
            YC[row * 1024 + cb * 256 + cl] = (bf16_t)f2bf(tl[cl * 65 + tl_] * x0); }
    }
    const float* VC = WSP(float, WS_VC); const float* FC = WSP(float, WS_FILTC); const float* hyd = arg_in(a, I_HD) + layer * 1024;
    for (int it = F.gw; it < 2 * 16 * 16; it += F.NGW) {
        const int b = it >> 8, cbk = (it >> 4) & 15, tb = it & 15; const int c = cbk * 64 + F.lane, t0 = tb * 16;
        const float* vb = VC + (size_t)b * CTX * 1024 + c; const float* fc = FC + c;
        float acc[16];
#pragma unroll
        for (int i = 0; i < 16; ++i) acc[i] = 0.f;
#pragma unroll 1
        for (int sb = 0; sb < 16; ++sb) { const int s0 = sb * 16, dl = t0 - s0;
            float f[31], v[16];
#pragma unroll
            for (int j = 0; j < 31; ++j) { const int lag = dl + j - 15; f[j] = lag >= 0 ? fc[(size_t)lag * 2048] : fc[(size_t)(-lag) * 2048 + 1024]; }
#pragma unroll
            for (int j = 0; j < 16; ++j) v[j] = vb[(size_t)(s0 + j) * 1024];
#pragma unroll
            for (int i = 0; i < 16; ++i)
#pragma unroll
                for (int j = 0; j < 16; ++j) acc[i] += f[i - j + 15] * v[j]; }
#pragma unroll
        for (int i = 0; i < 16; ++i) { const int t = t0 + i; const size_t row = (size_t)(b * CTX + t);
            const float x0 = bf2f(P2[row * P2W + P2_X0 + c]);
            YC[row * 1024 + c] = (bf16_t)f2bf((acc[i] + vb[(size_t)t * 1024] * hyd[c]) * x0); }
    }
}

__device__ __forceinline__ void phase_ln1(Frame& F, const Args& a, int layer) {
    const float* mod = (const float*)(F.ws + WS_CTL) + CW_MOD + (size_t)layer * 3 * 6 * DM;
    const float* YM = WSP(float, WS_YMIX); float* XS = WSP(float, WS_XS); unsigned* H2 = WSP(unsigned, WS_H2); float* AFF = WSP(float, WS_AFF); int* INV = WSP(int, WS_INV);
    const float* g1w = arg_in(a, I_LN1G) + layer * DM; const float* b1w = arg_in(a, I_LN1B) + layer * DM; const float* wr = arg_in(a, I_WROUTER) + (size_t)layer * DM * NEXP;
    LAS float* wrT = (LAS float*)F.lds;
    __syncthreads();
    for (int i = F.tid; i < DM * NEXP; i += NTHREADS) { const int c = i >> 4, e = i & 15; wrT[e * DM + c] = wr[i]; }
    __syncthreads();
    int* PTOK = WSP(int, WS_PTOK); float* PG = WSP(float, WS_PGATE);
    for (int i = F.bid * NTHREADS + F.tid; i < NPAIR; i += F.G * NTHREADS) { PTOK[i] = -1; PG[i] = 0.f; }
    for (int row = F.gw; row < T; row += F.NGW) {
        const f32x4* xr = (const f32x4*)x_src_row(a, F, layer, row) + F.lane; const f32x4* yr = (const f32x4*)(YM + (size_t)row * DM) + F.lane;
        const float* m = mod + (size_t)row_modidx(row) * 6 * DM;
        f32x4 v[8];
#pragma unroll
        for (int j = 0; j < 8; ++j) { const int c = 4 * (64 * j + F.lane); v[j] = xr[64 * j] * ALPHA + *(const f32x4*)(m + 2 * DM + c) * yr[64 * j]; }
        float mean, rstd; row_stats(v, mean, rstd, 1e-6f);
        f32x4* xo = (f32x4*)(XS + (size_t)row * DM) + F.lane;
#pragma unroll
        for (int j = 0; j < 8; ++j) { const int c = 4 * (64 * j + F.lane); v[j] = (v[j] - mean) * rstd * *(const f32x4*)(g1w + c) + *(const f32x4*)(b1w + c); xo[64 * j] = v[j]; }
        row_stats(v, mean, rstd, 1e-6f);
        unsigned* ho = H2 + (size_t)row * (DM / 4) + F.lane;
        float lg[16];
#pragma unroll
        for (int e = 0; e < 16; ++e) lg[e] = 0.f;
#pragma unroll
        for (int j = 0; j < 8; ++j) { const int c = 4 * (64 * j + F.lane);
            const f32x4 y = (v[j] - mean) * rstd * (*(const f32x4*)(m + 4 * DM + c) + 1.f) + *(const f32x4*)(m + 3 * DM + c);
            ho[64 * j] = pk4fp8(y.x, y.y, y.z, y.w);
#pragma unroll
            for (int e = 0; e < 16; ++e) { const f32x4 ww = *(const LAS f32x4*)(wrT + e * DM + c); lg[e] += (y.x * ww.x + y.y * ww.y) + (y.z * ww.z + y.w * ww.w); } }
        float mx = -1e30f;
#pragma unroll
        for (int e = 0; e < 16; ++e) { lg[e] = wave_sum(lg[e]); mx = fmaxf(mx, lg[e]); }
        float den = 0.f;
#pragma unroll
        for (int e = 0; e < 16; ++e) { lg[e] = __expf(lg[e] - mx); den += lg[e]; }
        float mine = 0.f;
#pragma unroll
        for (int e = 0; e < 16; ++e) mine = (F.lane == e) ? lg[e] : mine;
        if (F.lane < 16) { AFF[(size_t)row * 16 + F.lane] = mine / den; INV[(size_t)row * 16 + F.lane] = -1; }
    }
}
__device__ __forceinline__ void phase_topk(Frame& F, bool lat_only) {
    const float* AFF = WSP(float, WS_AFF); int* INV = WSP(int, WS_INV); int* PTOK = WSP(int, WS_PTOK); float* PG = WSP(float, WS_PGATE);
    LAS unsigned* vals = (LAS unsigned*)F.lds; LAS unsigned* hist = vals + 8192; LAS unsigned* ctl = hist + 256;
    for (int u = F.bid + (lat_only ? 32 : 0); u < 64; u += F.G) {
        const int s = u >> 4, e = u & 15, rs = seg_start(s), n = seg_len(s), cap = s < 2 ? CAP_C : CAP_L;
        __syncthreads();
        for (int i = F.tid; i < n; i += NTHREADS) vals[i] = __builtin_bit_cast(unsigned, AFF[(size_t)(rs + i) * 16 + e]);
        if (F.tid == 0) { ctl[0] = 0u; ctl[1] = (unsigned)cap; ctl[2] = 0u; ctl[3] = 0u; }
        unsigned mask = 0u;
        for (int shift = 24; shift >= 0; shift -= 8) {
            if (F.tid < 256) hist[F.tid] = 0u;
            __syncthreads();
            const unsigned prefix = ctl[0];
            for (int i = F.tid; i < n; i += NTHREADS) { const unsigned b = vals[i]; if ((b & mask) == prefix) __hip_atomic_fetch_add(&hist[(b >> shift) & 255u], 1u, __ATOMIC_RELAXED, __HIP_MEMORY_SCOPE_WORKGROUP); }
            __syncthreads();
            if (F.wave == 0) {
                const unsigned rem = ctl[1]; unsigned cnt[4]; float tot = 0.f;
#pragma unroll
                for (int j = 0; j < 4; ++j) { cnt[j] = hist[255 - (4 * F.lane + j)]; tot += (float)cnt[j]; }
                const unsigned incl = (unsigned)(wave_incl_scan(tot, F.lane) + 0.5f), excl = incl - (unsigned)(tot + 0.5f);
                if (excl < rem && rem <= incl) { unsigned cum = excl; int j = 0;
#pragma unroll
                    for (int q = 0; q < 3; ++q) { if (j == q && cum + cnt[q] < rem) { cum += cnt[q]; j = q + 1; } }
                    ctl[1] = rem - cum; ctl[0] = prefix | ((unsigned)(255 - (4 * F.lane + j)) << shift); } }
            mask |= 255u << shift;
            __syncthreads();
        }
        const unsigned thr = ctl[0], rem = ctl[1]; const unsigned ngt = (unsigned)cap - rem;
        const int pbase = s < 2 ? NBATCH * NEXP * CAP_L + e * 256 + s * CAP_C : ((s - 2) * NEXP + e) * CAP_L;
        for (int i = F.tid; i < n; i += NTHREADS) { const unsigned b = vals[i]; int slot = -1;
            if (b > thr) slot = (int)__hip_atomic_fetch_add(&ctl[2], 1u, __ATOMIC_RELAXED, __HIP_MEMORY_SCOPE_WORKGROUP);
            else if (b == thr) { const unsigned q = __hip_atomic_fetch_add(&ctl[3], 1u, __ATOMIC_RELAXED, __HIP_MEMORY_SCOPE_WORKGROUP); if (q < rem) slot = (int)(ngt + q); }
            if (slot >= 0) { const int pair = pbase + slot, row = rs + i; PTOK[pair] = row; PG[pair] = __builtin_bit_cast(float, b); INV[(size_t)row * 16 + e] = pair; } }
    }
}
__device__ __forceinline__ void phase_gather(Frame& F) {
    const unsigned char* H2 = WSP(unsigned char, WS_H2); unsigned char* XG = WSP(unsigned char, WS_XG); unsigned char* HID = WSP(unsigned char, WS_HID); const int* PTOK = WSP(int, WS_PTOK);
    for (int p0 = F.gw * 64; p0 < NPAIR; p0 += F.NGW * 64) {
        const int mytok = PTOK[p0 + F.lane];
        unsigned zz = 0u; asm volatile("" : "+v"(zz));
#pragma unroll 1
        for (int q = 0; q < 64; q += 4) {
            u32x4 v[4][2]; int tk[4];
#pragma unroll
            for (int j = 0; j < 4; ++j) { tk[j] = __builtin_amdgcn_readlane(mytok, q + j); const u32x4* src = (const u32x4*)(H2 + (size_t)(tk[j] >= 0 ? tk[j] : 0) * DM) + F.lane; v[j][0] = src[0]; v[j][1] = src[64]; }
#pragma unroll
            for (int j = 0; j < 4; ++j) { const int p = p0 + q + j; u32x4* dst = (u32x4*)(XG + (size_t)p * DM) + F.lane; const bool ok = tk[j] >= 0;
                dst[0] = ok ? v[j][0] : (u32x4){zz, zz, zz, zz}; dst[64] = ok ? v[j][1] : (u32x4){zz, zz, zz, zz};
                if (F.lane < 8) *((u32x4*)(HID + (size_t)p * EFFP + EFF) + F.lane) = (u32x4){zz, zz, zz, zz}; } }
    }
}
__device__ __forceinline__ void phase_ln2(Frame& F, const Args& a, int layer) {
    const float* mod = (const float*)(F.ws + WS_CTL) + CW_MOD + (size_t)layer * 3 * 6 * DM;
    float* XS = WSP(float, WS_XS); const bf16_t* YE = WSP(bf16_t, WS_YE); const int* INV = WSP(int, WS_INV); const float* PG = WSP(float, WS_PGATE);
    const float* g2w = arg_in(a, I_LN2G) + layer * DM; const float* b2w = arg_in(a, I_LN2B) + layer * DM;
    for (int row = F.gw; row < T; row += F.NGW) {
        f32x4* xr = (f32x4*)(XS + (size_t)row * DM) + F.lane; const float* m = mod + (size_t)row_modidx(row) * 6 * DM;
        f32x4 mo[8];
#pragma unroll
        for (int j = 0; j < 8; ++j) mo[j] = (f32x4){0.f, 0.f, 0.f, 0.f};
        const int myinv = F.lane < 16 ? INV[(size_t)row * 16 + F.lane] : -1;
        unsigned long long sel = __ballot(myinv >= 0);
        while (sel) {
            const int e0 = __builtin_ctzll(sel); sel &= sel - 1; const bool two = sel != 0; const int e1 = two ? __builtin_ctzll(sel) : e0; if (two) sel &= sel - 1;
            const int p0 = __builtin_amdgcn_readlane(myinv, e0), p1 = __builtin_amdgcn_readlane(myinv, e1);
            const u32x2* y0 = (const u32x2*)(YE + (size_t)p0 * DM) + F.lane; const u32x2* y1 = (const u32x2*)(YE + (size_t)p1 * DM) + F.lane;
            const float g0 = PG[p0], g1 = two ? PG[p1] : 0.f;
            u32x2 w0[8], w1[8];
#pragma unroll
            for (int j = 0; j < 8; ++j) { w0[j] = y0[64 * j]; w1[j] = y1[64 * j]; }
#pragma unroll
            for (int j = 0; j < 8; ++j) mo[j] += (f32x4){bflo(w0[j].x), bfhi(w0[j].x), bflo(w0[j].y), bfhi(w0[j].y)} * g0 + (f32x4){bflo(w1[j].x), bfhi(w1[j].x), bflo(w1[j].y), bfhi(w1[j].y)} * g1;
        }
        f32x4 v[8];
#pragma unroll
        for (int j = 0; j < 8; ++j) { const int c = 4 * (64 * j + F.lane); v[j] = xr[64 * j] * ALPHA + *(const f32x4*)(m + 5 * DM + c) * mo[j]; }
        float mean, rstd; row_stats(v, mean, rstd, 1e-6f);
#pragma unroll
        for (int j = 0; j < 8; ++j) { const int c = 4 * (64 * j + F.lane); v[j] = (v[j] - mean) * rstd * *(const f32x4*)(g2w + c) + *(const f32x4*)(b2w + c); xr[64 * j] = v[j]; }
        if (layer == DEPTH - 1) { if (row >= TC) { f32x4* o = (f32x4*)(a.out + (size_t)(row - TC) * DM) + F.lane;
#pragma unroll
            for (int j = 0; j < 8; ++j) o[64 * j] = v[j]; } }
        else {
            row_stats(v, mean, rstd, 1e-6f);
            const float* m1 = m + (size_t)3 * 6 * DM;
            bf16_t* H = WSP(bf16_t, WS_H); unsigned* H8 = WSP(unsigned, WS_H8);
            u32x2* o = (u32x2*)(H + (size_t)row * DM) + F.lane; unsigned* o8 = H8 + (size_t)row * (DM / 4) + F.lane;
#pragma unroll
            for (int j = 0; j < 8; ++j) { const int c = 4 * (64 * j + F.lane); const f32x4 sh = *(const f32x4*)(m1 + c), sc = *(const f32x4*)(m1 + DM + c);
                const f32x4 y = (v[j] - mean) * rstd * (sc + 1.f) + sh; u32x2 w; w.x = pk2(y.x, y.y); w.y = pk2(y.z, y.w); o[64 * j] = w; o8[64 * j] = pk4fp8(y.x, y.y, y.z, y.w); } }
    }
}

constexpr int LDS_BYTES = 153600, MISC_OFF = LDS_BYTES - 64;
constexpr int NPL = 16, NPHASE = 1 + DEPTH * NPL;

__global__ void __launch_bounds__(NTHREADS, 2) fwd_kernel(Args args) {
    extern __shared__ __attribute__((aligned(16))) unsigned char lds_raw[];
    Frame F;
    F.lds = (LAS unsigned char*)lds_raw;
    F.tid = threadIdx.x; F.lane = F.tid & 63; F.wave = __builtin_amdgcn_readfirstlane(F.tid >> 6); const int wave0 = F.wave;
    F.G = gridDim.x; F.bid = blockIdx.x; F.gw = F.bid * NWAVES + F.wave; F.NGW = F.G * NWAVES; F.ws = args.ws;
    volatile LAS unsigned* misc = (volatile LAS unsigned*)(F.lds + MISC_OFF);
    if (F.tid < 16) misc[F.tid] = 0u;
    __syncthreads();
    const int lo = args.ph_lo, hi = args.ph_hi;
    XcdBarrier bar; bar.bar = (unsigned*)(F.ws + WS_CTL) + CW_BAR; bar.x = 0; bar.st = nullptr;
    const bool multi = (hi - lo) > 1;
    if (multi) bar = xcd_barrier_post((unsigned*)(F.ws + WS_CTL) + CW_BAR, misc);
#ifndef ONLY_PHASE
#define ONLY_PHASE -1
#endif
#define PON(r) (ONLY_PHASE < 0 || ONLY_PHASE == (r))
#ifndef REP_MASK
#define REP_MASK 0
#endif
#define REP(b) ((REP_MASK >> (b)) & 1)
#define REOPQ() do { F.ws = opq(args.ws); F.lane = lane_asm() & 63; F.wave = opqs(wave0) & 7; F.tid = F.wave * 64 + F.lane; F.G = opqs(gridDim.x); F.bid = opqs(blockIdx.x); F.gw = F.bid * NWAVES + F.wave; F.NGW = F.G * NWAVES; } while (0)
#define IN(k) (lo <= (k) && (k) < hi)
#define SEAM(k) do { if (IN(k) && IN((k) + 1)) { XcdBarrier bb_ = bar; bb_.x = (unsigned)opqs((int)bar.x); xcd_barrier(bb_); } } while (0)
    if (PON(100) && IN(0)) { F.ws = opq(args.ws); F.lane = lane_asm() & 63; F.wave = opqs(wave0) & 7; F.tid = F.wave * 64 + F.lane; F.G = opqs(gridDim.x); F.bid = opqs(blockIdx.x); F.gw = F.bid * NWAVES + F.wave; F.NGW = F.G * NWAVES; { p0_weights(F, args); __syncthreads(); REOPQ(); p0_mod(F, args); __syncthreads(); REOPQ(); phase_hdn(F, args, 0); REOPQ(); phase_hdn(F, args, 1); __syncthreads(); } }
    SEAM(0);
#pragma unroll 1
    for (int layer = 0; layer < DEPTH; ++layer) {
        const int pb = 1 + layer * NPL; const bool lat_only = (layer == DEPTH - 1);
        if (PON(0) && IN(pb + 0)) { F.ws = opq(args.ws); F.lane = lane_asm() & 63; F.wave = opqs(wave0) & 7; F.tid = F.wave * 64 + F.lane; F.G = opqs(gridDim.x); F.bid = opqs(blockIdx.x); F.gw = F.bid * NWAVES + F.wave; F.NGW = F.G * NWAVES; if (layer == 0) phase_modln(F, args, layer); __syncthreads(); }
        SEAM(pb + 0);
        if (PON(1) && IN(pb + 1)) { F.ws = opq(args.ws); F.lane = lane_asm() & 63; F.wave = opqs(wave0) & 7; F.tid = F.wave * 64 + F.lane; F.G = opqs(gridDim.x); F.bid = opqs(blockIdx.x); F.gw = F.bid * NWAVES + F.wave; F.NGW = F.G * NWAVES;
            { pg8::Gemm g{WSP(bf16_t, WS_H), WSP(bf16_t, WS_WIN + layer * SZ_WIN), DM, DM, DM}; pg8::StaticOrder S; S.init(66, 13, F.G, F.bid, 0, 14);
              EpiBf16 E{WSP(bf16_t, WS_P), NNG, nullptr, 0, 0, 1.f, 1 << 30, 0};
              pg8::gemm_phase(F.lds, g, S, E, F.tid); }
            { pg8::Gemm g{WSP(bf16_t, WS_H8), WSP(bf16_t, WS_WIN + layer * SZ_WIN + WIN8P_OFF), DM / 2, DM / 2, DM / 2}; pg8::StaticOrder S; S.init(66, 27, F.G, (F.bid + 90) & 255);
              EpiBf16 E{WSP(bf16_t, WS_P), NNG, nullptr, 0, 0, 1.f / 64.f, 14, 13};
              pg8::gemm_phase<EpiBf16, pg8::StaticOrder, true>(F.lds, g, S, E, F.tid); }
        }
        SEAM(pb + 1);
        if (PON(2) && IN(pb + 2)) { F.ws = opq(args.ws); F.lane = lane_asm() & 63; F.wave = opqs(wave0) & 7; F.tid = F.wave * 64 + F.lane; F.G = opqs(gridDim.x); F.bid = opqs(blockIdx.x); F.gw = F.bid * NWAVES + F.wave; F.NGW = F.G * NWAVES; { phase_prep(F, args, layer); REOPQ(); phase_filt(F, args, layer); __syncthreads(); } }
        SEAM(pb + 2);
        if (PON(3) && IN(pb + 3)) { F.ws = opq(args.ws); F.lane = lane_asm() & 63; F.wave = opqs(wave0) & 7; F.tid = F.wave * 64 + F.lane; F.G = opqs(gridDim.x); F.bid = opqs(blockIdx.x); F.gw = F.bid * NWAVES + F.wave; F.NGW = F.G * NWAVES;
#if !defined(T3) || T3 == 0
            { pg8::Gemm g{WSP(bf16_t, WS_CQ8), WSP(bf16_t, WS_WQ + layer * SZ_WQ), 512, 256, 256}; pg8::StaticOrder S; S.init(lat_only ? 64 : 66, 6, F.G, F.bid, lat_only ? 2 : 0);
              EpiBf16 E{WSP(bf16_t, WS_Q), 1536, WSP(float, WS_RS), 2, 0, 1.f / 16.f, 1 << 30, 0}; pg8::gemm_phase<EpiBf16, pg8::StaticOrder, true>(F.lds, g, S, E, F.tid); }
#endif
#if !defined(T3) || T3 == 1
            { pg8::Gemm g{WSP(bf16_t, WS_CQ8) + 256, WSP(bf16_t, WS_WKV + layer * SZ_WKV), 512, 256, 256}; pg8::StaticOrder S; S.init(66, 8, F.G, (F.bid + 140) & 255);
              EpiBf16 E{WSP(bf16_t, WS_KV), 2048, WSP(float, WS_RS) + 1, 2, 0, 1.f / 16.f, 1 << 30, 0}; pg8::gemm_phase<EpiBf16, pg8::StaticOrder, true>(F.lds, g, S, E, F.tid); }
#endif
#if !defined(T3) || T3 == 2
            { pg8::Gemm g{WSP(bf16_t, WS_ALORA), WSP(bf16_t, WS_WLORA + layer * SZ_WLORA), 256, 256, 256}; pg8::StaticOrder S; S.init(66, 20, F.G, (F.bid + 156) & 255);
              EpiLora E{WSP(bf16_t, WS_EW), WSP(bf16_t, WS_ICLR), WSP(bf16_t, WS_GG), arg_in(args, I_RW0) + layer * 2048, arg_in(args, I_RA0) + layer * 2048, 1.f / 8.f}; pg8::gemm_phase<EpiLora, pg8::StaticOrder, true>(F.lds, g, S, E, F.tid); }
            REOPQ(); phase_mamba_states(F, args, layer); __syncthreads();
#endif
        }
        SEAM(pb + 3);
        SEAM(pb + 4);
        if (PON(5) && IN(pb + 5)) { F.ws = opq(args.ws); F.lane = lane_asm() & 63; F.wave = opqs(wave0) & 7; F.tid = F.wave * 64 + F.lane; F.G = opqs(gridDim.x); F.bid = opqs(blockIdx.x); F.gw = F.bid * NWAVES + F.wave; F.NGW = F.G * NWAVES;
#if !defined(T5) || T5 == 0
            phase_rwkv_scan(F, args, layer); __syncthreads();
#endif
#if !defined(T5) || T5 == 1
            REOPQ(); phase_attn(F, lat_only);
#endif
#if !defined(T5) || T5 == 2
            REOPQ(); phase_hyena_fft(F, args, layer);
#endif
#if !defined(T5) || T5 == 3
            REOPQ(); phase_mamba_scan(F); __syncthreads();
#endif
        }
        SEAM(pb + 5);
        if (PON(6) && IN(pb + 6)) { F.ws = opq(args.ws); F.lane = lane_asm() & 63; F.wave = opqs(wave0) & 7; F.tid = F.wave * 64 + F.lane; F.G = opqs(gridDim.x); F.bid = opqs(blockIdx.x); F.gw = F.bid * NWAVES + F.wave; F.NGW = F.G * NWAVES;
#if !defined(T6) || T6 == 0
            phase_mamba_out(F, args, layer); __syncthreads();
#endif
#if !defined(T6) || T6 == 1
            REOPQ(); phase_hyena_out(F, args, layer);
#endif
#if !defined(T6) || T6 == 2
            REOPQ(); phase_rwkv_out(F, args, layer); __syncthreads();
#endif
        }
        SEAM(pb + 6);
        if (PON(7) && IN(pb + 7)) { F.ws = opq(args.ws); F.lane = lane_asm() & 63; F.wave = opqs(wave0) & 7; F.tid = F.wave * 64 + F.lane; F.G = opqs(gridDim.x); F.bid = opqs(blockIdx.x); F.gw = F.bid * NWAVES + F.wave; F.NGW = F.G * NWAVES;
            pg8::Gemm g{WSP(bf16_t, WS_H8), WSP(bf16_t, WS_WIN + layer * SZ_WIN) + (size_t)NNG * DM, DM / 2, DM / 2, DM / 2}; pg8::StaticOrder S; S.init(lat_only ? 64 : 66, NGATE / 256, F.G, F.bid, lat_only ? 2 : 0);
            EpiBf16 E{WSP(bf16_t, WS_GATES), NGATE, nullptr, 0, 0, 1.f / 64.f, 1 << 30, 0};
            pg8::gemm_phase<EpiBf16, pg8::StaticOrder, true>(F.lds, g, S, E, F.tid);
            REOPQ(); phase_mamba_norm(F, args, layer);
        }
        SEAM(pb + 7);
        if (PON(8) && IN(pb + 8)) { F.ws = opq(args.ws); F.lane = lane_asm() & 63; F.wave = opqs(wave0) & 7; F.tid = F.wave * 64 + F.lane; F.G = opqs(gridDim.x); F.bid = opqs(blockIdx.x); F.gw = F.bid * NWAVES + F.wave; F.NGW = F.G * NWAVES;
            pg8::Gemm g{WSP(bf16_t, WS_Y), WSP(bf16_t, WS_WBR + layer * SZ_WBR), 1024, 1024, 1024}; OrderMerge S; S.init(F.G, F.bid, lat_only ? 64 : 66, lat_only ? 2 : 0);
            EpiMerge E{WSP(bf16_t, WS_GATES), WSP(bf16_t, WS_MRGB)};
            pg8::gemm_phase(F.lds, g, S, E, F.tid);

        }
        SEAM(pb + 8);
        if (PON(9) && IN(pb + 9)) { F.ws = opq(args.ws); F.lane = lane_asm() & 63; F.wave = opqs(wave0) & 7; F.tid = F.wave * 64 + F.lane; F.G = opqs(gridDim.x); F.bid = opqs(blockIdx.x); F.gw = F.bid * NWAVES + F.wave; F.NGW = F.G * NWAVES;
            pg8::Gemm g{WSP(bf16_t, WS_MRGB), WSP(bf16_t, WS_WOUT + layer * SZ_WOUT), DM, DM, DM}; pg8::StaticOrder S; S.init(lat_only ? 64 : 66, 8, F.G, F.bid, lat_only ? 2 : 0);
            EpiF32 E{WSP(float, WS_YMIX), DM};
            pg8::gemm_phase(F.lds, g, S, E, F.tid);

        }
        SEAM(pb + 9);
        if (PON(10) && IN(pb + 10)) { F.ws = opq(args.ws); F.lane = lane_asm() & 63; F.wave = opqs(wave0) & 7; F.tid = F.wave * 64 + F.lane; F.G = opqs(gridDim.x); F.bid = opqs(blockIdx.x); F.gw = F.bid * NWAVES + F.wave; F.NGW = F.G * NWAVES; phase_ln1(F, args, layer); __syncthreads(); { REOPQ(); conv_experts(F, args, layer); __syncthreads(); } }
        SEAM(pb + 10);
        if (PON(11) && IN(pb + 11)) { F.ws = opq(args.ws); F.lane = lane_asm() & 63; F.wave = opqs(wave0) & 7; F.tid = F.wave * 64 + F.lane; F.G = opqs(gridDim.x); F.bid = opqs(blockIdx.x); F.gw = F.bid * NWAVES + F.wave; F.NGW = F.G * NWAVES; phase_topk(F, lat_only); __syncthreads(); }
        SEAM(pb + 11);
        if (PON(12) && IN(pb + 12)) { F.ws = opq(args.ws); F.lane = lane_asm() & 63; F.wave = opqs(wave0) & 7; F.tid = F.wave * 64 + F.lane; F.G = opqs(gridDim.x); F.bid = opqs(blockIdx.x); F.gw = F.bid * NWAVES + F.wave; F.NGW = F.G * NWAVES; phase_gather(F); }
        SEAM(pb + 12);
        if (PON(13) && IN(pb + 13)) { F.ws = opq(args.ws); F.lane = lane_asm() & 63; F.wave = opqs(wave0) & 7; F.tid = F.wave * 64 + F.lane; F.G = opqs(gridDim.x); F.bid = opqs(blockIdx.x); F.gw = F.bid * NWAVES + F.wave; F.NGW = F.G * NWAVES;
            pg8::Gemm g{WSP(bf16_t, WS_XG), WSP(bf16_t, WS_WE), DM / 2, DM / 2, DM / 2}; OrderMoe S; S.init(11, F.G, F.bid, lat_only ? 8 : 9);
            EpiSwiglu E{WSP(unsigned char, WS_HID)};
            pg8::gemm_phase<EpiSwiglu, OrderMoe, true>(F.lds, g, S, E, F.tid);

        }
        SEAM(pb + 13);
        if (PON(14) && IN(pb + 14)) { F.ws = opq(args.ws); F.lane = lane_asm() & 63; F.wave = opqs(wave0) & 7; F.tid = F.wave * 64 + F.lane; F.G = opqs(gridDim.x); F.bid = opqs(blockIdx.x); F.gw = F.bid * NWAVES + F.wave; F.NGW = F.G * NWAVES;
            pg8::Gemm g{WSP(bf16_t, WS_HID), WSP(bf16_t, WS_WE + SZ_WGU8), EFFP / 2, EFFP / 2, EFFP / 2}; OrderMoe S; S.init(8, F.G, F.bid, lat_only ? 8 : 9);
            EpiDown E{WSP(bf16_t, WS_YE)};
            pg8::gemm_phase<EpiDown, OrderMoe, true>(F.lds, g, S, E, F.tid);

        }
        SEAM(pb + 14);
        if (PON(15) && IN(pb + 15)) { F.ws = opq(args.ws); F.lane = lane_asm() & 63; F.wave = opqs(wave0) & 7; F.tid = F.wave * 64 + F.lane; F.G = opqs(gridDim.x); F.bid = opqs(blockIdx.x); F.gw = F.bid * NWAVES + F.wave; F.NGW = F.G * NWAVES; phase_ln2(F, args, layer); }
        SEAM(pb + 15);
    }
#undef IN
#undef SEAM
}


#ifdef DBG_CUT
__global__ void dbg_dump(const unsigned char* ws, float* out, size_t off, int is_bf16, size_t n_src) {
    const size_t N = (size_t)TL * DM;
    for (size_t i = (size_t)blockIdx.x * blockDim.x + threadIdx.x; i < N; i += (size_t)gridDim.x * blockDim.x) {
        const size_t j = i % n_src;
        out[i] = is_bf16 ? bf2f(((const bf16_t*)(ws + off))[j]) : ((const float*)(ws + off))[j];
    }
}
#endif

#ifdef DBG_PASSES
__global__ void dbg_chk(const unsigned char* base, size_t off, size_t nbytes, unsigned long long* slot) {
    const unsigned* p = (const unsigned*)(base + off); const size_t n = nbytes / 4; unsigned long long s = 0;
    for (size_t i = (size_t)blockIdx.x * blockDim.x + threadIdx.x; i < n; i += (size_t)gridDim.x * blockDim.x) s += p[i];
    for (int o = 32; o > 0; o >>= 1) s += __shfl_xor(s, o);
    if ((threadIdx.x & 63) == 0) atomicAdd(slot, s);
}
__global__ void dbg_report(const unsigned long long* tab, float* out, int npass) {
    int k = 0;
    for (int ph = NPHASE - 1; ph >= 0; --ph) if (tab[ph] != tab[64 + ph]) k = ph + 1;
    if (k == 0 && npass > 2) { for (int ph = NPHASE - 1; ph >= 0; --ph) if (tab[64 + ph] != tab[128 + ph]) k = 50 + ph + 1; }
    if (k == 0) return;
    const float c = sqrtf(10.f * (float)k);
    for (size_t i = (size_t)blockIdx.x * blockDim.x + threadIdx.x; i < (size_t)TL * DM; i += (size_t)gridDim.x * blockDim.x) out[i] = c;
}
struct DbgReg { size_t off, n; };
#endif
extern "C" void kernel_launch(void* const* d_in, const int* in_sizes, int n_in, void* d_out, int out_size, void* d_ws, size_t ws_size, hipStream_t stream) {
    static int grid = 0;
    if (grid == 0) {
        if (n_in != N_INPUTS || in_sizes[0] != TL * DM || out_size != TL * DM || ws_size < WS_END) {
            fprintf(stderr, "kernel_launch: shape/workspace mismatch: n_in %d in0 %d out %d ws %zu (need %zu)\n", n_in, n_in > 0 ? in_sizes[0] : -1, out_size, ws_size, (size_t)WS_END); grid = -1; return; }
        int dev = 0, cus = 0, per_cu = 0;
        if (hipGetDevice(&dev) != hipSuccess || hipDeviceGetAttribute(&cus, hipDeviceAttributeMultiprocessorCount, dev) != hipSuccess) { grid = -1; return; }
        if (hipFuncSetAttribute((const void*)fwd_kernel, hipFuncAttributeMaxDynamicSharedMemorySize, LDS_BYTES) != hipSuccess) { fprintf(stderr, "kernel_launch: hipFuncSetAttribute failed\n"); grid = -1; return; }
        if (hipOccupancyMaxActiveBlocksPerMultiprocessor(&per_cu, (const void*)fwd_kernel, NTHREADS, LDS_BYTES) != hipSuccess || per_cu < 1) { fprintf(stderr, "kernel_launch: occupancy query says %d\n", per_cu); grid = -1; (void)hipGetLastError(); return; }
        grid = cus;
    }
    if (grid < 0) return;
    (void)hipMemsetAsync((char*)d_ws + WS_CTL, 0, CTL_BYTES, stream);
    Args a{};
    for (int i = 0; i < N_INPUTS; ++i) a.in[i] = (const float*)d_in[i];
    a.out = (float*)d_out; a.ws = (unsigned char*)d_ws;
#if MK_ONE_LAUNCH
    a.ph_lo = 0; a.ph_hi = NPHASE;
    hipLaunchKernelGGL(fwd_kernel, dim3(grid), dim3(NTHREADS), LDS_BYTES, stream, a);
#else
#ifdef DBG_PASSES
    {
        unsigned long long* tab = (unsigned long long*)((char*)d_ws + 1600000);
        auto chk = [&](int pass, int ph, size_t off, size_t n) { hipLaunchKernelGGL(dbg_chk, dim3(1024), dim3(256), 0, stream, (const unsigned char*)d_ws, off, n, tab + pass * 64 + ph); };
        for (int pass = 0; pass < DBG_PASSES; ++pass) {
            if (pass > 0) (void)hipMemsetAsync((char*)d_ws + (size_t)CW_MOD * 4, 0, (size_t)DEPTH * 3 * 6 * DM * 4, stream);
            for (int ph = 0; ph < NPHASE; ++ph) {
                a.ph_lo = ph; a.ph_hi = ph + 1; hipLaunchKernelGGL(fwd_kernel, dim3(grid), dim3(NTHREADS), LDS_BYTES, stream, a);
                if (ph == 0) { chk(pass, ph, WS_WIN, WS_XS - WS_WIN); chk(pass, ph, (size_t)CW_MOD * 4, (size_t)DEPTH * 3 * 6 * DM * 4); continue; }
                const int r = (ph - 1) % NPL;
                switch (r) {
                case 0: chk(pass, ph, WS_H, SZ_H); chk(pass, ph, WS_HDN, SZ_HDN); break;
                case 1: chk(pass, ph, WS_P, SZ_P); break;
                case 2: chk(pass, ph, WS_P2, SZ_P2); chk(pass, ph, WS_KK, SZ_TK2); chk(pass, ph, WS_ALORA, WS_VT - WS_ALORA); chk(pass, ph, WS_VT, WS_HDN - WS_VT); break;
                case 3: chk(pass, ph, WS_Q, SZ_Q + SZ_KV); chk(pass, ph, WS_EW, 4 * SZ_TK2); chk(pass, ph, WS_GG, SZ_TK2); break;
                case 4: chk(pass, ph, WS_Q, SZ_Q); chk(pass, ph, WS_MST, SZ_MST + SZ_MCS); break;
                case 5: chk(pass, ph, WS_YRW, 2 * SZ_TK2); chk(pass, ph, WS_Y, SZ_Y / 4); chk(pass, ph, WS_VT, SZ_VT); chk(pass, ph, WS_MST, SZ_MST); break;
                case 6: chk(pass, ph, WS_Y + SZ_Y / 4, 3 * (SZ_Y / 4)); break;
                case 7: chk(pass, ph, WS_GATES, SZ_GATES); chk(pass, ph, WS_Y + SZ_Y / 4, SZ_Y / 4); break;
                case 8: chk(pass, ph, WS_MRGF, SZ_MRGF); chk(pass, ph, WS_MRGB, SZ_MRGB); break;
                case 9: chk(pass, ph, WS_YMIX, SZ_YMIX); break;
                case 10: chk(pass, ph, WS_XS, SZ_XS); chk(pass, ph, WS_H2, SZ_H); chk(pass, ph, WS_AFF, SZ_AFF); chk(pass, ph, WS_WE, SZ_WGU + SZ_WD); break;
                case 11: chk(pass, ph, WS_INV, SZ_INV + SZ_PTOK + SZ_PGATE); break;
                case 12: chk(pass, ph, WS_XG, SZ_XG); break;
                case 13: chk(pass, ph, WS_HID, SZ_HID); break;
                case 14: chk(pass, ph, WS_YE, SZ_YE); break;
                case 15: chk(pass, ph, WS_XS, SZ_XS); break;
                }
            }
        }
        hipLaunchKernelGGL(dbg_report, dim3(2048), dim3(256), 0, stream, (const unsigned long long*)tab, (float*)d_out, (int)DBG_PASSES);
    }
#elif defined(DBG_CUT)
    for (int ph = 0; ph < DBG_CUT; ++ph) { a.ph_lo = ph; a.ph_hi = ph + 1; hipLaunchKernelGGL(fwd_kernel, dim3(grid), dim3(NTHREADS), LDS_BYTES, stream, a); }
    hipLaunchKernelGGL(dbg_dump, dim3(2048), dim3(256), 0, stream, (const unsigned char*)d_ws, (float*)d_out, (size_t)DBG_OFF, DBG_BF16, (size_t)DBG_N);
#else
    for (int ph = 0; ph < NPHASE; ++ph) { a.ph_lo = ph; a.ph_hi = ph + 1; hipLaunchKernelGGL(fwd_kernel, dim3(grid), dim3(NTHREADS), LDS_BYTES, stream, a); }
#endif
#endif
}
```

```cpp
#include <hip/hip_runtime.h>
#include <cstdio>
#include <cstdint>

#define REP_MASK 0x80000
#ifndef MK_ONE_LAUNCH
#define MK_ONE_LAUNCH 1
#endif

#define LAS __attribute__((address_space(3)))
typedef unsigned short bf16_t;
typedef short bf16x8 __attribute__((ext_vector_type(8)));
typedef float f32x4 __attribute__((ext_vector_type(4)));
typedef float f32x2 __attribute__((ext_vector_type(2)));
typedef unsigned u32x4 __attribute__((ext_vector_type(4)));
typedef unsigned u32x2 __attribute__((ext_vector_type(2)));

constexpr int DM = 2048, NBATCH = 2, SEQ = 8192, CTX = 256, DEPTH = 2;
constexpr int TC = NBATCH * CTX, TL = NBATCH * SEQ, T = TC + TL;
constexpr int NIN = 18432, NNG = 10240, NGATE = 8192;
constexpr int P_CQ = 0, P_CKV = 512, P_KPE = 1024;
constexpr int P_Z = 1088, P_XBC = 2112, P_DT = 3648;
constexpr int P_HY = 3680;
constexpr int P_RW = 6752, P_WD = 9824, P_AD = 9952, P_GD = 10080;
constexpr int NH_MLA = 8, NH_SSM = 16, NH_RW = 16;
constexpr int NEXP = 16, EFF = 1408, CAP_L = 1024, CAP_C = 32;
constexpr int NPAIR = NBATCH * NEXP * CAP_L + NEXP * 256;
constexpr float ALPHA = 1.4142135623730951f;
constexpr int NWAVES = 8, NTHREADS = 512;

__device__ __forceinline__ int seg_of(int row) { return row < 256 ? 0 : row < 512 ? 1 : row < 512 + SEQ ? 2 : 3; }
__device__ __forceinline__ int seg_start(int s) { return s == 0 ? 0 : s == 1 ? 256 : s == 2 ? 512 : 512 + SEQ; }
__device__ __forceinline__ int seg_len(int s) { return s < 2 ? CTX : SEQ; }
__device__ __forceinline__ bool row_first(int row) { return row == 0 || row == 256 || row == 512 || row == 512 + SEQ; }
__device__ __forceinline__ bool row_last(int row) { return row == 255 || row == 511 || row == 511 + SEQ || row == T - 1; }
__device__ __forceinline__ int row_modidx(int row) { return row < 512 ? 2 : (row < 512 + SEQ ? 0 : 1); }

constexpr size_t AL(size_t x) { return (x + 255) / 256 * 256; }
constexpr size_t WS_CTL = 0, CTL_BYTES = 2u << 20;
constexpr int CW_BAR = 1024;
constexpr int CW_MOD = 16384;
constexpr size_t SZ_WIN = (size_t)NIN * DM * 2, SZ_WBR = (size_t)4 * DM * 1024 * 2, SZ_WOUT = (size_t)DM * DM * 2, SZ_WQ = (size_t)1536 * 512 * 2,
                 SZ_WKV = (size_t)2048 * 512 * 2, SZ_WLORA = (size_t)5120 * 512 * 2;
constexpr size_t WS_WIN = CTL_BYTES, WS_WBR = WS_WIN + DEPTH * SZ_WIN, WS_WOUT = WS_WBR + DEPTH * SZ_WBR, WS_WQ = WS_WOUT + DEPTH * SZ_WOUT,
                 WS_WKV = WS_WQ + DEPTH * SZ_WQ, WS_WLORA = WS_WKV + DEPTH * SZ_WKV, WS_XS = WS_WLORA + DEPTH * SZ_WLORA;
constexpr size_t SZ_XS = (size_t)T * DM * 4;
constexpr size_t WIN8P_OFF = (size_t)NNG * DM * 2 + (size_t)NGATE * DM;
static_assert(WIN8P_OFF + (size_t)27 * 256 * DM <= SZ_WIN, "w_in area");
constexpr size_t WS_H = WS_XS + SZ_XS, SZ_H = (size_t)T * DM * 2;
constexpr size_t WS_P = WS_H + SZ_H, SZ_P = (size_t)T * NNG * 2;
constexpr int P2W = 5632, P2_XBC = 0, P2_X0 = 1536, P2_RKV = 2560;
constexpr size_t WS_P2 = WS_P + SZ_P, SZ_P2 = (size_t)T * P2W * 2;
constexpr size_t WS_Q = WS_P2 + SZ_P2, SZ_Q = (size_t)T * 1536 * 2;
constexpr size_t WS_KV = WS_Q + SZ_Q, SZ_KV = (size_t)T * 2048 * 2;
constexpr size_t WS_EW = WS_KV + SZ_KV, SZ_TK2 = (size_t)T * 1024 * 2;
constexpr size_t WS_ICLR = WS_EW + 2 * SZ_TK2;
constexpr size_t WS_KK = WS_ICLR + 2 * SZ_TK2;
constexpr size_t WS_GG = WS_KK + SZ_TK2;
constexpr size_t WS_YRW = WS_GG + SZ_TK2;
constexpr size_t WS_ALORA = WS_YRW + 2 * SZ_TK2, SZ_ALORA = (size_t)T * 512 * 2;
constexpr size_t WS_KPE = WS_ALORA + SZ_ALORA, SZ_KPE = (size_t)T * 64 * 2;
constexpr size_t WS_RS = WS_KPE + SZ_KPE, SZ_RS = AL((size_t)T * 2 * 4);
constexpr size_t WS_DT = WS_RS + SZ_RS, SZ_DT = (size_t)T * 32 * 4;
constexpr size_t WS_VT = WS_DT + SZ_DT, SZ_VT = (size_t)1024 * 2 * SEQ * 4;
constexpr size_t WS_VC = WS_VT + SZ_VT, SZ_VC = (size_t)TC * 1024 * 4;
constexpr size_t WS_FILT = WS_VC + SZ_VC, SZ_FILT = (size_t)1024 * 2 * SEQ * 2;
constexpr size_t WS_FILTC = WS_FILT + SZ_FILT, SZ_FILTC = (size_t)CTX * 2048 * 4;
constexpr size_t WS_HDN = WS_FILTC + SZ_FILTC, SZ_HDN1 = (size_t)(SEQ + CTX) * 64 * 4, SZ_HDN = DEPTH * SZ_HDN1;
constexpr int NCHUNK = T / 128;
constexpr size_t WS_MST = WS_HDN + SZ_HDN, SZ_MST = (size_t)2 * NCHUNK * 16 * 8192 * 2;
constexpr size_t WS_MCS = WS_MST + SZ_MST, SZ_MCS = (size_t)2 * NCHUNK * 16 * 4 * 2;
constexpr size_t WS_Y = WS_MCS + AL(SZ_MCS), SZ_Y = (size_t)4 * T * 1024 * 2;
constexpr float Y8A_SCALE = 64.f;
constexpr size_t SZ_Y8 = (size_t)T * 1024, WS_Y8A = WS_Y, WS_Y8B = WS_Y + SZ_Y8, WS_Y8D = WS_Y + 3 * (SZ_Y / 4);
constexpr size_t WS_AFF = WS_Y + SZ_Y, SZ_AFF = (size_t)T * 16 * 4;
constexpr size_t WS_INV = WS_AFF + SZ_AFF, SZ_INV = (size_t)T * 16 * 4;
constexpr size_t WS_PTOK = WS_INV + SZ_INV, SZ_PTOK = (size_t)NPAIR * 4;
constexpr size_t WS_PGATE = WS_PTOK + SZ_PTOK, SZ_PGATE = (size_t)NPAIR * 4;
constexpr size_t WS_H8 = WS_PGATE + SZ_PGATE, SZ_H8 = (size_t)T * DM;
constexpr size_t WS_CQ8 = WS_H8 + SZ_H8, SZ_CQ8 = (size_t)T * 1024;
constexpr size_t WS_END = WS_CQ8 + SZ_CQ8;
constexpr size_t WS_GATES = WS_P, SZ_GATES = (size_t)T * NGATE * 2;
constexpr size_t WS_MRGF = WS_P2, SZ_MRGF = (size_t)T * DM * 4;
constexpr size_t WS_MRGB = WS_Q, SZ_MRGB = (size_t)T * DM * 2;
constexpr size_t WS_YMIX = WS_P, SZ_YMIX = (size_t)T * DM * 4;
constexpr size_t WS_H2 = WS_H;
constexpr size_t WS_WE = WS_P2, SZ_WGU = (size_t)NEXP * 2816 * DM * 2, SZ_WD = (size_t)NEXP * DM * EFF * 2;
constexpr size_t WS_XG = WS_P, SZ_XG = (size_t)NPAIR * DM * 2;
constexpr size_t WS_HID = WS_XG + SZ_XG, SZ_HID = (size_t)NPAIR * EFF * 2;
constexpr size_t WS_YE = WS_WE + SZ_WGU + SZ_WD, SZ_YE = (size_t)NPAIR * DM * 2;
static_assert(SZ_GATES <= SZ_P && SZ_MRGF <= SZ_P2 && SZ_MRGB <= SZ_Q + SZ_KV && SZ_YMIX <= SZ_P, "alias map 1");
static_assert(SZ_XG + SZ_HID <= SZ_P, "alias map 2");
static_assert(WS_YE + SZ_YE <= WS_VT, "alias map 3");
static_assert(WS_END < 1800000000ull, "workspace budget");

__device__ __forceinline__ unsigned f2bf(float f) { unsigned u = __builtin_bit_cast(unsigned, f); return (u + 0x7fffu + ((u >> 16) & 1u)) >> 16; }
__device__ __forceinline__ unsigned pk2(float lo, float hi) { return f2bf(lo) | (f2bf(hi) << 16); }
__device__ __forceinline__ float bf2f(unsigned short b) { return __builtin_bit_cast(float, (unsigned)b << 16); }
__device__ __forceinline__ float bflo(unsigned w) { return __builtin_bit_cast(float, w << 16); }
__device__ __forceinline__ float bfhi(unsigned w) { return __builtin_bit_cast(float, w & 0xffff0000u); }
__device__ __forceinline__ unsigned cvt_pk_bf16(float lo, float hi) { unsigned r; asm volatile("v_cvt_pk_bf16_f32 %0, %1, %2" : "=v"(r) : "v"(lo), "v"(hi)); return r; }
__device__ __forceinline__ float dppx(float x, const int sel) {
    const int xi = __builtin_bit_cast(int, x); int r;
    if (sel == 0) r = __builtin_amdgcn_update_dpp(0, xi, 0xB1, 0xF, 0xF, false);
    else if (sel == 1) r = __builtin_amdgcn_update_dpp(0, xi, 0x4E, 0xF, 0xF, false);
    else if (sel == 2) r = __builtin_amdgcn_update_dpp(0, xi, 0x141, 0xF, 0xF, false);
    else r = __builtin_amdgcn_update_dpp(0, xi, 0x140, 0xF, 0xF, false);
    return __builtin_bit_cast(float, r);
}
__device__ __forceinline__ float swz16(float x) { return __builtin_bit_cast(float, __builtin_amdgcn_ds_swizzle(__builtin_bit_cast(int, x), 0x401F)); }
__device__ __forceinline__ float sum4(float v) { v += dppx(v, 0); v += dppx(v, 1); return v; }
__device__ __forceinline__ float sum8(float v) { v = sum4(v); v += dppx(v, 2); return v; }
__device__ __forceinline__ float sum16(float v) { v = sum8(v); v += dppx(v, 3); return v; }
__device__ __forceinline__ float sum32(float v) { v = sum16(v); v += swz16(v); return v; }
__device__ __forceinline__ unsigned pk4fp8(float a, float b, float c, float d) { int w = 0; w = __builtin_amdgcn_cvt_pk_fp8_f32(a, b, w, false); w = __builtin_amdgcn_cvt_pk_fp8_f32(c, d, w, true); return (unsigned)w; }
__device__ __forceinline__ float wave_sum(float v) {
    v = sum32(v);
    auto rr = __builtin_amdgcn_permlane32_swap(__float_as_uint(v), __float_as_uint(v), false, false);
    return __uint_as_float(rr[0]) + __uint_as_float(rr[1]);
}
__device__ __forceinline__ float sigmoidf_(float x) { return 1.f / (1.f + __expf(-x)); }
__device__ __forceinline__ float siluf_(float x) { return x / (1.f + __expf(-x)); }
__device__ __forceinline__ float softplusf_(float x) { return x > 20.f ? x : __logf(1.f + __expf(x)); }
__device__ __forceinline__ float tanhf_(float x) { const float e = __expf(2.f * fminf(x, 15.f)); return 1.f - 2.f / (e + 1.f); }
#define LDS_WAIT() asm volatile("s_waitcnt lgkmcnt(0)" ::: "memory")
#define VM_WAIT() asm volatile("s_waitcnt vmcnt(0)" ::: "memory")

#define XB_TMO      128
#define XB_XCNT(j)  (256  + 64 * (j))
#define XB_XSUB(j)  (1280 + 64 * (j))
#define XB_XGEN(j)  (2304 + 64 * (j))
#define XB_TOP      3328
#define XB_TOPGEN   3392
#define XCD_BAR_WORDS 3456
#define XB_SPIN_CAP (1u << 18)
__device__ __forceinline__ unsigned xb_ld(unsigned* p)              { return __hip_atomic_load(p, __ATOMIC_RELAXED, __HIP_MEMORY_SCOPE_AGENT); }
__device__ __forceinline__ unsigned xb_add(unsigned* p, unsigned v) { return __hip_atomic_fetch_add(p, v, __ATOMIC_RELAXED, __HIP_MEMORY_SCOPE_AGENT); }
__device__ __forceinline__ unsigned xb_xcc_id() { return (unsigned)__builtin_amdgcn_s_getreg((3 << 11) | 20) & 0xFu; }
#define XB_SPIN(cond, bar) do { unsigned _sp = 0; while (cond) { __builtin_amdgcn_s_sleep(1); \
    if ((++_sp & 255u) == 0u) { if (xb_ld(&(bar)[XB_TMO])) break; if (_sp > XB_SPIN_CAP) { atomicAdd(&(bar)[XB_TMO], 1u); break; } } } } while (0)
struct XcdBarrier { unsigned* bar; unsigned x; volatile LAS unsigned* st; };
__device__ __forceinline__ XcdBarrier xcd_barrier_post(unsigned* bar, volatile LAS unsigned* st) {
    XcdBarrier b; b.bar = bar; b.x = xb_xcc_id(); b.st = st;
    if (threadIdx.x == 0) (void)xb_add(&bar[XB_XCNT(b.x)], 1u);
    return b;
}
__device__ __forceinline__ void xcd_barrier_complete(unsigned* bar, unsigned x, unsigned& nloc, unsigned& nx) {
    const unsigned G = gridDim.x * gridDim.y * gridDim.z;
    unsigned sum, cnt, mine, sp = 0u;
    for (;;) {
        sum = 0u; cnt = 0u; mine = 0u;
#pragma unroll
        for (unsigned j = 0; j < 16; ++j) { const unsigned c = xb_ld(&bar[XB_XCNT(j)]); sum += c; cnt += (c > 0u) ? 1u : 0u; mine = (j == x) ? c : mine; }
        if (sum == G) break;
        __builtin_amdgcn_s_sleep(1);
        if ((++sp & 255u) == 0u) { if (xb_ld(&bar[XB_TMO])) break; if (sp > XB_SPIN_CAP) { atomicAdd(&bar[XB_TMO], 1u); break; } }
    }
    nloc = mine > 0u ? mine : 1u; nx = cnt > 0u ? cnt : 1u;
}
__device__ __forceinline__ void xcd_barrier(const XcdBarrier& b) {
    asm volatile("s_waitcnt vmcnt(0)" ::: "memory");
    __syncthreads();
    if (threadIdx.x == 0) {
        unsigned* bar = b.bar;
        __builtin_amdgcn_s_waitcnt(0);
        unsigned nloc = b.st[0], nx = b.st[1];
        if (nloc == 0u) { xcd_barrier_complete(bar, b.x, nloc, nx); b.st[0] = nloc; b.st[1] = nx; }
        const unsigned old = xb_add(&bar[XB_XSUB(b.x)], 1u);
        const unsigned gen = old / nloc;
        if (old + 1u == (gen + 1u) * nloc) {
            __builtin_amdgcn_fence(__ATOMIC_RELEASE, "agent");
            asm volatile("s_waitcnt vmcnt(0)" ::: "memory");
            const unsigned og = xb_add(&bar[XB_TOP], 1u);
            const unsigned tg = og / nx;
            if (og + 1u == (tg + 1u) * nx) xb_add(&bar[XB_TOPGEN], 1u);
            else XB_SPIN(xb_ld(&bar[XB_TOPGEN]) == tg, bar);
            __builtin_amdgcn_fence(__ATOMIC_ACQUIRE, "agent");
            xb_add(&bar[XB_XGEN(b.x)], 1u);
            asm volatile("s_waitcnt vmcnt(0)" ::: "memory");
        } else {
            XB_SPIN(xb_ld(&bar[XB_XGEN(b.x)]) == gen, bar);
            __builtin_amdgcn_fence(__ATOMIC_ACQUIRE, "agent");
            asm volatile("s_waitcnt vmcnt(0)" ::: "memory");
        }
    }
    __syncthreads();
}

__device__ __forceinline__ int lane_asm() { int l; asm volatile("v_mbcnt_lo_u32_b32 %0, -1, 0\n\tv_mbcnt_hi_u32_b32 %0, -1, %0" : "=v"(l)); return l; }
namespace pg8 {
constexpr int BM = 256, BK = 64, HALF = 128, HTB = HALF * BK * 2, STAGE_BYTES = 8 * HTB, NXCD = 8, WGM = 8;
__host__ __device__ __forceinline__ int lds_byte(int r, int c) { const int st = (r >> 4) * 2 + (c >> 5), rr = r & 15, cc = c & 31, ob = rr * 64 + cc * 2; return st * 1024 + (ob ^ (((ob >> 9) & 1) << 5)); }
__host__ __device__ __forceinline__ void stage_rc(int b, int& R, int& C) { const int st = b / 1024, sb = b % 1024, swz = sb ^ (((sb >> 9) & 1) << 5); R = (st >> 1) * 16 + swz / 64; C = (st & 1) * 32 + (swz % 64) / 2; }
__host__ __device__ __forceinline__ int perm32(int rho) { const int n = rho >> 4, i = rho & 15; return 8 * (i >> 2) + 4 * n + (i & 3); }
struct Unit { int pm, pn; };
struct Gemm { const bf16_t* A; const bf16_t* Bt; int lda, ldb, K; };
struct StaticOrder {
    int nM, nN, nwg, G, c, pm0, pn0;
    __device__ void init(int nM_, int nN_, int G_, int c_, int pm0_ = 0, int pn0_ = 0) { nM = nM_; nN = nN_; nwg = nM * nN; G = G_; c = c_; pm0 = pm0_; pn0 = pn0_; }
    __device__ bool next(int i, Unit& u) const {
        const long L = (long)i * G + c; if (L >= nwg) return false;
        int wgid = (int)L; { const int q = nwg / NXCD, r = nwg % NXCD, xcd = wgid % NXCD, off = wgid / NXCD; wgid = (xcd < r ? xcd * (q + 1) : r * (q + 1) + (xcd - r) * q) + off; }
        const int nig = WGM * nN, gid = wgid / nig, fm = gid * WGM, gsz = (nM - fm) < WGM ? (nM - fm) : WGM;
        u.pm = pm0 + fm + ((wgid % nig) % gsz); u.pn = pn0 + (wgid % nig) / gsz; return true;
    }
};
typedef int i32x4v __attribute__((ext_vector_type(4)));
typedef int i32x8v __attribute__((ext_vector_type(8)));
__device__ __forceinline__ i32x8v cat8(bf16x8 a, bf16x8 b) { return __builtin_shufflevector(__builtin_bit_cast(i32x4v, a), __builtin_bit_cast(i32x4v, b), 0, 1, 2, 3, 4, 5, 6, 7); }
template <class Epi, class Sched, bool FP8 = false>
__device__ __forceinline__ void gemm_phase(LAS unsigned char* lds, const Gemm g, const Sched& S, const Epi& E, int tid_in) {
    constexpr bool ALIGN_EPI = true;
    const unsigned tid_u = (unsigned)tid_in; __builtin_assume(tid_u < 512u);
    const int tid = (int)tid_u, wid = __builtin_amdgcn_readfirstlane(tid >> 6), lane = tid & 63, wr = wid >> 2, wc = wid & 3, fr = lane & 15, fq = lane >> 4;
    const int K = g.K, nt = K / BK;
    unsigned voffA[2], voffB[2];
#pragma unroll
    for (int i = 0; i < 2; ++i) { int R, C; stage_rc(tid * 16 + i * 8192, R, C); const int Rb = Epi::PERM ? ((R & ~31) + perm32(R & 31)) : R;
        voffA[i] = (unsigned)(R * g.lda + C) * 2u; voffB[i] = (unsigned)(Rb * g.ldb + C) * 2u; }
    const unsigned kstep = (unsigned)(BK * 2);
    const unsigned hstepA = (unsigned)HALF * g.lda * 2u, hstepB = (unsigned)HALF * g.ldb * 2u;
    const unsigned tstepA = 2u * hstepA, tstepB = 2u * hstepB;
    const unsigned ldsw = (unsigned)wid * 1024u;
    const int aoff = lds_byte(wr * 64 + fr, fq * 8), boff = lds_byte(wc * 32 + fr, fq * 8);
    const __amdgpu_buffer_rsrc_t rsA = __builtin_amdgcn_make_buffer_rsrc((void*)g.A, 0, 0xFFFFFFFFu, 0x00020000);
    const __amdgpu_buffer_rsrc_t rsB = __builtin_amdgcn_make_buffer_rsrc((void*)g.Bt, 0, 0xFFFFFFFFu, 0x00020000);
#define PG8_SA(b, h) (((b) * 2 + (h)) * HTB)
#define PG8_SB(b, h) ((4 + (b) * 2 + (h)) * HTB)
#define PG8_STAGE(bufoff, rs, soff, voff) do { _Pragma("unroll") for (int _i = 0; _i < 2; ++_i) \
        __builtin_amdgcn_raw_ptr_buffer_load_lds(rs, (LAS unsigned*)(lds + (bufoff) + ldsw + _i * 8192), 16, (int)(voff)[_i], (int)(soff), 0, 0); } while (0)
#define PG8_LDA(dst, b, h) do { if constexpr (FP8) { _Pragma("unroll") for (int m = 0; m < 4; ++m) dst##8[m] = __builtin_shufflevector(*(const LAS i32x4v*)(lds + PG8_SA(b, h) + aoff + m * 2048), *(const LAS i32x4v*)(lds + PG8_SA(b, h) + aoff + m * 2048 + 1024), 0, 1, 2, 3, 4, 5, 6, 7); } \
    else { _Pragma("unroll") for (int m = 0; m < 4; ++m) _Pragma("unroll") for (int k = 0; k < 2; ++k) dst[m][k] = *(const LAS bf16x8*)(lds + PG8_SA(b, h) + aoff + m * 2048 + k * 1024); } } while (0)
#define PG8_LDB(dst, b, h) do { if constexpr (FP8) { _Pragma("unroll") for (int n = 0; n < 2; ++n) dst##8[n] = __builtin_shufflevector(*(const LAS i32x4v*)(lds + PG8_SB(b, h) + boff + n * 2048), *(const LAS i32x4v*)(lds + PG8_SB(b, h) + boff + n * 2048 + 1024), 0, 1, 2, 3, 4, 5, 6, 7); } \
    else { _Pragma("unroll") for (int n = 0; n < 2; ++n) _Pragma("unroll") for (int k = 0; k < 2; ++k) dst[n][k] = *(const LAS bf16x8*)(lds + PG8_SB(b, h) + boff + n * 2048 + k * 1024); } } while (0)
#define PG8_MMA(ai, bj, At, Bt) do { __builtin_amdgcn_s_setprio(1); if constexpr (FP8) { _Pragma("unroll") for (int m = 0; m < 4; ++m) _Pragma("unroll") for (int n = 0; n < 2; ++n) \
        asm volatile("v_mfma_scale_f32_16x16x128_f8f6f4 %0, %1, %2, %0, %3, %3 op_sel_hi:[0,0,0]" : "+v"(acc[ai][bj][m][n]) : "v"(Bt##8[n]), "v"(At##8[m]), "v"(sc1)); } else { \
        _Pragma("unroll") for (int m = 0; m < 4; ++m) _Pragma("unroll") for (int n = 0; n < 2; ++n) _Pragma("unroll") for (int k = 0; k < 2; ++k) \
        acc[ai][bj][m][n] = __builtin_amdgcn_mfma_f32_16x16x32_bf16(Bt[n][k], At[m][k], acc[ai][bj][m][n], 0, 0, 0); } __builtin_amdgcn_s_setprio(0); } while (0)
#define PG8_WAIT_V(n) asm volatile("s_waitcnt vmcnt(" #n ")" ::: "memory")
#define PG8_WAIT_L(n) asm volatile("s_waitcnt lgkmcnt(" #n ")" ::: "memory")
#define PG8_BAR __builtin_amdgcn_s_barrier()
#define PG8_SCHED __builtin_amdgcn_sched_barrier(0)
    Unit cur, nxt; int ui = 0;
    if (!S.next(0, cur)) return;
    f32x4 acc[2][2][4][2];
#pragma unroll
    for (int a = 0; a < 2; ++a)
#pragma unroll
        for (int b = 0; b < 2; ++b)
#pragma unroll
            for (int m = 0; m < 4; ++m)
#pragma unroll
                for (int n = 0; n < 2; ++n) acc[a][b][m][n] = (f32x4){0.f, 0.f, 0.f, 0.f};
    i32x8v At8[4], B08[2], B18[2]; bf16x8 At[4][2], B0[2][2], B1[2][2];
    const int sc1 = 0x7F7F7F7F;
    unsigned cA = (unsigned)cur.pm * tstepA, cB = (unsigned)cur.pn * tstepB;
    PG8_STAGE(PG8_SB(0, 0), rsB, cB, voffB); PG8_STAGE(PG8_SB(0, 1), rsB, cB + hstepB, voffB); PG8_STAGE(PG8_SA(0, 0), rsA, cA, voffA); PG8_STAGE(PG8_SA(0, 1), rsA, cA + hstepA, voffA);
    if (wr == 1) PG8_BAR;
    PG8_WAIT_V(2); PG8_BAR;
    PG8_STAGE(PG8_SB(1, 0), rsB, cB + kstep, voffB); PG8_STAGE(PG8_SA(1, 0), rsA, cA + kstep, voffA); PG8_STAGE(PG8_SB(1, 1), rsB, cB + hstepB + kstep, voffB);
    PG8_WAIT_V(6); PG8_BAR;
    for (;;) {
        const bool has_next = S.next(ui + 1, nxt);
        const unsigned nA = has_next ? (unsigned)nxt.pm * tstepA : cA; const unsigned nB = has_next ? (unsigned)nxt.pn * tstepB : cB;
        for (int t = 0; t < nt; t += 2) {
            const bool last = (t == nt - 2);
            const unsigned a1 = cA + (unsigned)(t + 1) * kstep;
            const unsigned a2 = last ? nA : cA + (unsigned)(t + 2) * kstep; const unsigned b2 = last ? nB : cB + (unsigned)(t + 2) * kstep;
            const unsigned a3 = a2 + kstep; const unsigned b3 = b2 + kstep;
            PG8_LDB(B0, 0, 0); PG8_LDB(B1, 0, 1); PG8_SCHED; PG8_LDA(At, 0, 0); PG8_STAGE(PG8_SA(1, 1), rsA, a1 + hstepA, voffA);
            PG8_WAIT_V(8); PG8_WAIT_L(0); PG8_BAR; PG8_MMA(0, 0, At, B0); PG8_MMA(0, 1, At, B1); PG8_BAR; PG8_SCHED;
            PG8_LDA(At, 0, 1); PG8_STAGE(PG8_SB(0, 0), rsB, b2, voffB); PG8_STAGE(PG8_SB(0, 1), rsB, b2 + hstepB, voffB); PG8_STAGE(PG8_SA(0, 0), rsA, a2, voffA);
            PG8_WAIT_V(8); PG8_WAIT_L(0); PG8_BAR; PG8_MMA(1, 0, At, B0); PG8_MMA(1, 1, At, B1); PG8_BAR; PG8_SCHED;
            PG8_LDB(B0, 1, 0); PG8_LDB(B1, 1, 1); PG8_SCHED; PG8_LDA(At, 1, 0); PG8_STAGE(PG8_SA(0, 1), rsA, a2 + hstepA, voffA);
            PG8_WAIT_V(8); PG8_WAIT_L(0); PG8_BAR; PG8_MMA(0, 0, At, B0); PG8_MMA(0, 1, At, B1); PG8_BAR; PG8_SCHED;
            PG8_LDA(At, 1, 1); PG8_STAGE(PG8_SB(1, 0), rsB, b3, voffB); PG8_STAGE(PG8_SB(1, 1), rsB, b3 + hstepB, voffB); PG8_STAGE(PG8_SA(1, 0), rsA, a3, voffA);
            PG8_WAIT_V(8); PG8_WAIT_L(0); PG8_BAR; PG8_MMA(1, 0, At, B0); PG8_MMA(1, 1, At, B1); PG8_BAR; PG8_SCHED;
        }
        if constexpr (FP8) asm volatile("s_nop 15\n\ts_nop 7" ::: "memory");
        if constexpr (ALIGN_EPI) { if (wr == 0) PG8_BAR; }
        bool keep_acc = false;
        { const int l2 = lane_asm() & 63; if constexpr (Epi::KEEPS) keep_acc = E(acc, cur, wr, wc, l2 & 15, l2 >> 4); else E(acc, cur, wr, wc, l2 & 15, l2 >> 4); }
        if (!has_next) break;
        if (!keep_acc) {
#pragma unroll
        for (int a = 0; a < 2; ++a)
#pragma unroll
            for (int b = 0; b < 2; ++b)
#pragma unroll
                for (int m = 0; m < 4; ++m)
#pragma unroll
                    for (int n = 0; n < 2; ++n) acc[a][b][m][n] = (f32x4){0.f, 0.f, 0.f, 0.f};
        }
        cur = nxt; cA = nA; cB = nB; ++ui;
        if constexpr (ALIGN_EPI) { if (wr == 1) PG8_BAR; }
    }
    PG8_WAIT_V(0);
    if constexpr (!ALIGN_EPI) { if (wr == 0) PG8_BAR; }
    PG8_BAR;
#undef PG8_SA
#undef PG8_SB
#undef PG8_STAGE
#undef PG8_LDA
#undef PG8_LDB
#undef PG8_MMA
#undef PG8_WAIT_V
#undef PG8_WAIT_L
#undef PG8_BAR
#undef PG8_SCHED
}
}

enum { I_X = 0, I_C, I_CTX, I_CCTX, I_WADA, I_BADA, I_WIN, I_QNORM, I_WQUP, I_KVNORM, I_WKVUP, I_SCONVW, I_SCONVB, I_SDTB, I_SALOG, I_SD, I_SNORM,
       I_HCONVW, I_HCONVB, I_HW1, I_HB1, I_HW2, I_HB2, I_HW3, I_HFREQ, I_HD, I_RMU, I_RW0, I_RWUP, I_RA0, I_RAUP, I_RGUP, I_RKK, I_RKA, I_RRK, I_RLNG, I_RLNB,
       I_WBR, I_WOUT, I_LN1G, I_LN1B, I_WROUTER, I_WGATE, I_WUP, I_WDOWN, I_LN2G, I_LN2B, N_INPUTS };
struct Args { const float* in[N_INPUTS]; float* out; unsigned char* ws; int ph_lo, ph_hi; };
static_assert(sizeof(Args) == (N_INPUTS + 2) * 8 + 8, "Args has no padding");

__device__ __forceinline__ const float* arg_in(const Args& a, int i) { asm volatile("" : "+s"(i)); return a.in[i]; }
__device__ __forceinline__ int opqs(int v) { asm volatile("" : "+s"(v)); return v; }
__device__ __forceinline__ int opqv(int v) { asm volatile("" : "+v"(v)); return v; }
__device__ __forceinline__ unsigned char* opq(unsigned char* p) { asm volatile("" : "+s"(p)); return p; }
struct Frame {
    LAS unsigned char* lds;
    int tid, lane, wave, G, bid, gw, NGW;
    unsigned char* ws;
};
#define WSP(T_, off) ((T_*)(F.ws + (off)))

struct RmId { __device__ int operator()(int n) const { return n; } };
struct RmShift { int sh; __device__ int operator()(int n) const { return n + sh; } };
struct RmGateUp { int up; __device__ int operator()(int n) const { return 256 * (n >> 7) + (n & 127) + (up ? 128 : 0); } };
constexpr int TR_SCR = 64 * 65 * 4;
__device__ __forceinline__ void tr_load(const float* W, int ldw, int k0, int n0, const float* kscale, float sc, LAS float* scr, int lane) {
    float v[64];
    const float* wp = W + (size_t)k0 * ldw + n0 + lane;
#pragma unroll
    for (int i = 0; i < 64; ++i) v[i] = wp[(size_t)i * ldw];
#pragma unroll
    for (int i = 0; i < 64; ++i) { float x = v[i] * sc; if (kscale) x *= kscale[k0 + i]; scr[i * 65 + lane] = x; }
    LDS_WAIT(); asm volatile("" ::: "memory");
}
template <class RowMap>
__device__ __forceinline__ void transpose_item(const float* W, int ldw, bf16_t* WT, int ldt, int k0, int n0, const float* kscale, RowMap rm, LAS float* scr, int lane) {
    tr_load(W, ldw, k0, n0, kscale, 1.f, scr, lane);
    const int c = lane & 7;
#pragma unroll
    for (int j = 0; j < 8; ++j) { const int n = (lane >> 3) + 8 * j; const LAS float* s = scr + (8 * c) * 65 + n;
        u32x4 o; o.x = pk2(s[0 * 65], s[1 * 65]); o.y = pk2(s[2 * 65], s[3 * 65]); o.z = pk2(s[4 * 65], s[5 * 65]); o.w = pk2(s[6 * 65], s[7 * 65]);
        *(u32x4*)(WT + (size_t)rm(n0 + n) * ldt + k0 + 8 * c) = o; }
    LDS_WAIT(); asm volatile("" ::: "memory");
}
template <class RowMap>
__device__ __forceinline__ void transpose_item_fp8(const float* W, int ldw, unsigned char* WT, int ldt, int k0, int n0, float sc, RowMap rm, LAS float* scr, int lane, const float* kscale = nullptr) {
    tr_load(W, ldw, k0, n0, kscale, sc, scr, lane);
    const int c = lane & 3;
#pragma unroll
    for (int j = 0; j < 4; ++j) { const int n = (lane >> 2) + 16 * j; const LAS float* s = scr + (16 * c) * 65 + n;
        u32x4 o; o.x = pk4fp8(s[0 * 65], s[1 * 65], s[2 * 65], s[3 * 65]); o.y = pk4fp8(s[4 * 65], s[5 * 65], s[6 * 65], s[7 * 65]);
        o.z = pk4fp8(s[8 * 65], s[9 * 65], s[10 * 65], s[11 * 65]); o.w = pk4fp8(s[12 * 65], s[13 * 65], s[14 * 65], s[15 * 65]);
        *(u32x4*)(WT + (size_t)rm(n0 + n) * ldt + k0 + 16 * c) = o; }
    LDS_WAIT(); asm volatile("" ::: "memory");
}

__device__ __forceinline__ void p0_weights(Frame& F, const Args& a) {
    LAS float* scr = (LAS float*)(F.lds + F.wave * TR_SCR);
    constexpr int IT_IN = 32 * 288, IT_BR = 16 * 32, IT_OUT = 32 * 32, IT_Q = 8 * 24, IT_KV = 8 * 32;
    constexpr int PER_L = IT_IN + 4 * IT_BR + IT_OUT + IT_Q + IT_KV;
    for (int it = F.gw; it < DEPTH * PER_L; it += F.NGW) {
        const int l = it / PER_L; int r = it % PER_L;
        if (r < IT_IN) { const int kb = r / 288, nb = r % 288;
            if (nb * 64 < NNG) { const int tile = nb >> 2;
                if (tile >= 14 && tile < 27) transpose_item(arg_in(a, I_WIN) + (size_t)l * DM * NIN, NIN, WSP(bf16_t, WS_WIN + l * SZ_WIN), DM, kb * 64, nb * 64, nullptr, RmId(), scr, F.lane);
                else { RmShift rs; rs.sh = tile < 14 ? 0 : -13 * 256; transpose_item_fp8(arg_in(a, I_WIN) + (size_t)l * DM * NIN, NIN, WSP(unsigned char, WS_WIN + l * SZ_WIN + WIN8P_OFF), DM, kb * 64, nb * 64, 64.f, rs, scr, F.lane); } }
            else transpose_item_fp8(arg_in(a, I_WIN) + (size_t)l * DM * NIN + NNG, NIN, WSP(unsigned char, WS_WIN + l * SZ_WIN) + (size_t)NNG * DM * 2, DM, kb * 64, nb * 64 - NNG, 64.f, RmId(), scr, F.lane);
            continue; } r -= IT_IN;
        if (r < 4 * IT_BR) { const int br = r / IT_BR, q = r % IT_BR, kb = q / 32, nb = q % 32;
            if (br == 2) transpose_item(arg_in(a, I_WBR) + ((size_t)l * 4 + br) * 1024 * DM, DM, WSP(bf16_t, WS_WBR + l * SZ_WBR) + (size_t)br * DM * 1024, 1024, kb * 64, nb * 64, nullptr, RmId(), scr, F.lane);
            else { const int sub = br == 3 ? 2 : br; transpose_item_fp8(arg_in(a, I_WBR) + ((size_t)l * 4 + br) * 1024 * DM, DM, WSP(unsigned char, WS_WBR + l * SZ_WBR) + (size_t)sub * DM * 1024, 1024, kb * 64, nb * 64, 32.f, RmId(), scr, F.lane); }
            continue; } r -= 4 * IT_BR;
        if (r < IT_OUT) { const int kb = r / 32, nb = r % 32;
            transpose_item(arg_in(a, I_WOUT) + (size_t)l * DM * DM, DM, WSP(bf16_t, WS_WOUT + l * SZ_WOUT), DM, kb * 64, nb * 64, nullptr, RmId(), scr, F.lane); continue; } r -= IT_OUT;
        if (r < IT_Q) { const int kb = r / 24, nb = r % 24;
            transpose_item_fp8(arg_in(a, I_WQUP) + (size_t)l * 512 * 1536, 1536, WSP(unsigned char, WS_WQ + l * SZ_WQ), 512, kb * 64, nb * 64, 16.f, RmId(), scr, F.lane, arg_in(a, I_QNORM) + l * 512); continue; } r -= IT_Q;
        { const int kb = r / 32, nb = r % 32;
            transpose_item_fp8(arg_in(a, I_WKVUP) + (size_t)l * 512 * 2048, 2048, WSP(unsigned char, WS_WKV + l * SZ_WKV), 512, kb * 64, nb * 64, 16.f, RmId(), scr, F.lane, arg_in(a, I_KVNORM) + l * 512); }
    }
    for (size_t e4 = (size_t)F.bid * NTHREADS + F.tid; e4 < (size_t)DEPTH * 5120 * 128; e4 += (size_t)F.G * NTHREADS) {
        const int l = (int)(e4 / (5120 * 128)); const int rem = (int)(e4 % (5120 * 128)); const int n = rem / 128, kc0 = (rem % 128) * 4; const int blk = n >> 10, c = n & 1023;
        float v[4];
#pragma unroll
        for (int q = 0; q < 4; ++q) { const int kc = kc0 + q; float x = 0.f;
            if (blk < 2) { if (kc >= 64 * blk && kc < 64 * blk + 64) x = arg_in(a, I_RWUP)[(((size_t)l * 2 + blk) * 64 + (kc - 64 * blk)) * 1024 + c]; }
            else if (blk < 4) { const int d = blk - 2; if (kc >= 128 + 64 * d && kc < 192 + 64 * d) x = arg_in(a, I_RAUP)[(((size_t)l * 2 + d) * 64 + (kc - 128 - 64 * d)) * 1024 + c]; }
            else { if (kc >= 256 && kc < 416) x = arg_in(a, I_RGUP)[((size_t)l * 160 + (kc - 256)) * 1024 + c]; }
            v[q] = x * 8.f; }
        WSP(unsigned, WS_WLORA + l * SZ_WLORA)[(size_t)n * 128 + kc0 / 4] = pk4fp8(v[0], v[1], v[2], v[3]);
    }
}
constexpr int EFFP = 1536;
constexpr size_t SZ_WGU8 = (size_t)NEXP * 2816 * DM, SZ_WD8 = (size_t)NEXP * DM * EFFP;
__device__ __forceinline__ void conv_experts(Frame& F, const Args& a, int l) {
    LAS float* scr = (LAS float*)(F.lds + F.wave * TR_SCR);
    constexpr int IT_G = 32 * 22, IT_D = 22 * 32, PER_E = 2 * IT_G + IT_D;
    unsigned char* wgu = WSP(unsigned char, WS_WE); unsigned char* wd = WSP(unsigned char, WS_WE + SZ_WGU8);
    for (int it = F.gw; it < NEXP * PER_E; it += F.NGW) {
        const int e = it / PER_E; int r = it % PER_E;
        if (r < 2 * IT_G) { const int up = r / IT_G, q = r % IT_G, kb = q / 22, nb = q % 22;
            const float* src = arg_in(a, up ? I_WUP : I_WGATE) + ((size_t)l * NEXP + e) * DM * EFF;
            RmGateUp rm; rm.up = up;
            transpose_item_fp8(src, EFF, wgu + (size_t)e * 2816 * DM, DM, kb * 64, nb * 64, 64.f, rm, scr, F.lane); continue; } r -= 2 * IT_G;
        { const int kb = r / 32, nb = r % 32;
            transpose_item_fp8(arg_in(a, I_WDOWN) + ((size_t)l * NEXP + e) * EFF * DM, DM, wd + (size_t)e * DM * EFFP, EFFP, kb * 64, nb * 64, 64.f, RmId(), scr, F.lane); }
    }
    for (int i = F.bid * NTHREADS + F.tid; i < NEXP * DM * 8; i += F.G * NTHREADS) { const int rowi = i >> 3, q = i & 7; unsigned zz = 0u; asm volatile("" : "+v"(zz));
        *(u32x4*)(wd + (size_t)rowi * EFFP + EFF + q * 16) = (u32x4){zz, zz, zz, zz}; }
}
__device__ __forceinline__ void p0_mod(Frame& F, const Args& a) {
    LAS float* sv = (LAS float*)(F.lds + 69632);
    for (int i = F.tid; i < 3 * DM; i += NTHREADS) { const int v = i / DM, k = i % DM; const float x = v < 2 ? arg_in(a, I_C)[v * DM + k] : arg_in(a, I_CCTX)[k]; sv[i] = siluf_(x); }
    __syncthreads();
    float* mod = (float*)(F.ws + WS_CTL) + CW_MOD;
    LAS float* red = (LAS float*)(F.lds + 69632 + 3 * DM * 4);
    for (int u = F.bid; u < DEPTH * (6 * DM / 128); u += F.G) {
        const int l = u / (6 * DM / 128), nb = u % (6 * DM / 128); const int kg = F.tid >> 7, cl = F.tid & 127, n = nb * 128 + cl;
        const float* w = arg_in(a, I_WADA) + ((size_t)l * DM + kg * 512) * (6 * DM) + n;
        float a0 = 0.f, a1 = 0.f, a2 = 0.f;
#pragma unroll 32
        for (int k = 0; k < 512; ++k) { const float wv = w[(size_t)k * (6 * DM)]; const int kk = kg * 512 + k; a0 += sv[kk] * wv; a1 += sv[DM + kk] * wv; a2 += sv[2 * DM + kk] * wv; }
        __syncthreads();
        red[(kg * 3 + 0) * 128 + cl] = a0; red[(kg * 3 + 1) * 128 + cl] = a1; red[(kg * 3 + 2) * 128 + cl] = a2;
        __syncthreads();
        if (F.tid < 384) { const int v = F.tid >> 7; const float b = arg_in(a, I_BADA)[l * 6 * DM + n];
            mod[(l * 3 + v) * 6 * DM + n] = b + ((red[(0 * 3 + v) * 128 + cl] + red[(1 * 3 + v) * 128 + cl]) + (red[(2 * 3 + v) * 128 + cl] + red[(3 * 3 + v) * 128 + cl])); }
    }
}

__device__ __forceinline__ void row_stats(const f32x4 (&v)[8], float& mean, float& rstd, float eps) {
    float s = 0.f;
#pragma unroll
    for (int j = 0; j < 8; ++j) s += (v[j].x + v[j].y) + (v[j].z + v[j].w);
    mean = wave_sum(s) * (1.f / DM);
    float s2 = 0.f;
#pragma unroll
    for (int j = 0; j < 8; ++j) { const f32x4 d = v[j] - mean; s2 += (d.x * d.x + d.y * d.y) + (d.z * d.z + d.w * d.w); }
    rstd = 1.f / sqrtf(wave_sum(s2) * (1.f / DM) + eps);
}
__device__ __forceinline__ const float* x_src_row(const Args& a, const Frame& F, int layer, int row) {
    if (layer == 0) return row < TC ? arg_in(a, I_CTX) + (size_t)row * DM : arg_in(a, I_X) + (size_t)(row - TC) * DM;
    return (const float*)(F.ws + WS_XS) + (size_t)row * DM;
}
__device__ __forceinline__ void phase_modln(Frame& F, const Args& a, int layer) {
    const float* mod = (const float*)(F.ws + WS_CTL) + CW_MOD + (size_t)layer * 3 * 6 * DM;
    bf16_t* H = WSP(bf16_t, WS_H); unsigned* H8 = WSP(unsigned, WS_H8);
    for (int row = F.gw; row < T; row += F.NGW) {
        const f32x4* xr = (const f32x4*)x_src_row(a, F, layer, row) + F.lane;
        f32x4 v[8];
#pragma unroll
        for (int j = 0; j < 8; ++j) v[j] = xr[64 * j];
        float mean, rstd; row_stats(v, mean, rstd, 1e-6f);
        const float* m = mod + (size_t)row_modidx(row) * 6 * DM;
        u32x2* o = (u32x2*)(H + (size_t)row * DM) + F.lane; unsigned* o8 = H8 + (size_t)row * (DM / 4) + F.lane;
#pragma unroll
        for (int j = 0; j < 8; ++j) { const int c = 4 * (64 * j + F.lane); const f32x4 sh = *(const f32x4*)(m + c), sc = *(const f32x4*)(m + DM + c);
            const f32x4 y = (v[j] - mean) * rstd * (sc + 1.f) + sh; u32x2 w; w.x = pk2(y.x, y.y); w.y = pk2(y.z, y.w); o[64 * j] = w; o8[64 * j] = pk4fp8(y.x, y.y, y.z, y.w); }
    }
}

__device__ __forceinline__ void phase_hdn(Frame& F, const Args& a, int layer) {
    LAS float* zs = (LAS float*)(F.lds + F.wave * 512);
    const float* w1 = arg_in(a, I_HW1) + (size_t)layer * 33 * 64; const float* b1 = arg_in(a, I_HB1) + layer * 64;
    const float* w2 = arg_in(a, I_HW2) + (size_t)layer * 64 * 64; const float* b2 = arg_in(a, I_HB2) + layer * 64;
    const float fr = arg_in(a, I_HFREQ)[layer * 64 + F.lane];
    float* HDN = WSP(float, WS_HDN + layer * SZ_HDN1);
    for (int r = F.gw; r < SEQ + CTX; r += F.NGW) {
        const int n = r < SEQ ? SEQ : CTX, t = r < SEQ ? r : r - SEQ;
        const float wpos = (6.283185307179586f * (float)t) / (float)n;
        if (F.lane < 33) { float z;
            if (F.lane == 0) z = (float)t / (float)(n - 1);
            else { const int b = (F.lane - 1) & 15; const float f = 1e-4f + (float)b * ((15.f - 1e-4f) / 15.f); const float ang = f * wpos; z = F.lane <= 16 ? __cosf(ang) : -__sinf(ang); }
            zs[F.lane] = z; }
        LDS_WAIT(); asm volatile("" ::: "memory");
        float p = b1[F.lane];
#pragma unroll
        for (int i = 0; i < 33; ++i) p += zs[i] * w1[i * 64 + F.lane];
        const float h1 = __sinf(fr * p);
        zs[64 + F.lane] = h1;
        LDS_WAIT(); asm volatile("" ::: "memory");
        float q = b2[F.lane];
#pragma unroll 16
        for (int i = 0; i < 64; ++i) q += zs[64 + i] * w2[i * 64 + F.lane];
        HDN[(size_t)r * 64 + F.lane] = __sinf(fr * q);
        LDS_WAIT(); asm volatile("" ::: "memory");
    }
}
__device__ __forceinline__ float hy_delta(int c) { const float mn = -3.0701134573253943f, mx = -15.350567286626972f; return fabsf(mn + (float)c * ((mx - mn) / 1023.f)); }
__device__ __forceinline__ void phase_filt(Frame& F, const Args& a, int layer) {
    const float* w3 = arg_in(a, I_HW3) + (size_t)layer * 64 * 2048; const float* HDN = WSP(float, WS_HDN + layer * SZ_HDN1);
    LAS float* ws3 = (LAS float*)F.lds;
    bf16_t* FILT = WSP(bf16_t, WS_FILT);
    for (int u = F.bid; u < 32 * 16; u += F.G) {
        const int cb = u / 16, tb = u % 16, col0 = cb * 64, t = tb * 512 + F.tid;
        __syncthreads();
        for (int i = F.tid; i < 4096; i += NTHREADS) { const int j = i >> 6, cc = i & 63; ws3[cc * 64 + j] = w3[(size_t)j * 2048 + col0 + cc]; }
        __syncthreads();
        f32x4 h[16];
#pragma unroll
        for (int i = 0; i < 16; ++i) h[i] = *(const f32x4*)(HDN + (size_t)t * 64 + 4 * i);
        const float tn = (float)t / (float)(SEQ - 1);
        for (int cc = 0; cc < 64; ++cc) {
            float acc = 0.f;
#pragma unroll
            for (int i = 0; i < 16; ++i) { const f32x4 w = *(const LAS f32x4*)(ws3 + cc * 64 + 4 * i); acc += h[i].x * w.x + h[i].y * w.y + h[i].z * w.z + h[i].w * w.w; }
            const int col = col0 + cc, side = col >> 10, c = col & 1023;
            FILT[((size_t)c * 2 + side) * SEQ + t] = (bf16_t)f2bf(acc * __expf(-tn * hy_delta(c)));
        }
    }
    float* FILTC = WSP(float, WS_FILTC);
    for (int e = F.bid * NTHREADS + F.tid; e < CTX * 2048; e += F.G * NTHREADS) {
        const int lag = e >> 11, col = e & 2047, c = col & 1023; const float* hr = HDN + (size_t)(SEQ + lag) * 64; float acc = 0.f;
#pragma unroll 16
        for (int j = 0; j < 64; ++j) acc += hr[j] * w3[(size_t)j * 2048 + col];
        FILTC[e] = acc * __expf(-((float)lag / (float)(CTX - 1)) * hy_delta(c));
    }
}

__device__ __forceinline__ void ld8bf(const bf16_t* p, float (&o)[8]) { const u32x4 w = *(const u32x4*)p; o[0] = bflo(w.x); o[1] = bfhi(w.x); o[2] = bflo(w.y); o[3] = bfhi(w.y); o[4] = bflo(w.z); o[5] = bfhi(w.z); o[6] = bflo(w.w); o[7] = bfhi(w.w); }
__device__ __forceinline__ void up8(const u32x4 w, float (&o)[8]) { o[0] = bflo(w.x); o[1] = bfhi(w.x); o[2] = bflo(w.y); o[3] = bfhi(w.y); o[4] = bflo(w.z); o[5] = bfhi(w.z); o[6] = bflo(w.w); o[7] = bfhi(w.w); }
__device__ __forceinline__ void st8bf(bf16_t* p, const float (&v)[8]) { u32x4 w; w.x = pk2(v[0], v[1]); w.y = pk2(v[2], v[3]); w.z = pk2(v[4], v[5]); w.w = pk2(v[6], v[7]); *(u32x4*)p = w; }
__device__ __forceinline__ void ld8f(const float* p, float (&o)[8]) { const f32x4 a = *(const f32x4*)p, b = *(const f32x4*)(p + 4); o[0] = a.x; o[1] = a.y; o[2] = a.z; o[3] = a.w; o[4] = b.x; o[5] = b.y; o[6] = b.z; o[7] = b.w; }

constexpr int PREP_RUN = 16;
__device__ __forceinline__ void phase_prep(Frame& F, const Args& a, int layer) {
    const bf16_t* P = WSP(bf16_t, WS_P); bf16_t* P2 = WSP(bf16_t, WS_P2);
    float* RS = WSP(float, WS_RS); bf16_t* KPE = WSP(bf16_t, WS_KPE); float* DT = WSP(float, WS_DT);
    bf16_t* KK = WSP(bf16_t, WS_KK); unsigned char* AL_ = WSP(unsigned char, WS_ALORA); float* VC = WSP(float, WS_VC); unsigned char* CQ8 = WSP(unsigned char, WS_CQ8);
    const float* scw = arg_in(a, I_SCONVW) + (size_t)layer * 3 * 1536; const float* scb = arg_in(a, I_SCONVB) + layer * 1536; const float* dtb = arg_in(a, I_SDTB) + layer * 32;
    const float* hcw = arg_in(a, I_HCONVW) + (size_t)layer * 3 * 3072; const float* hcb = arg_in(a, I_HCONVB) + layer * 3072;
    const float* mu = arg_in(a, I_RMU) + (size_t)layer * 2 * 3488; const float* rkk = arg_in(a, I_RKK) + layer * 1024;
    const int lane = F.lane;
    for (int item = F.gw; item < (T / PREP_RUN) * 13; item += F.NGW) {
        const int run = item / 13, ct = item % 13; const int r0 = run * PREP_RUN;
        if (ct == 0) {
#pragma unroll 1
        for (int rr = 0; rr < PREP_RUN; ++rr) { const int row = r0 + rr; const bf16_t* pr = P + (size_t)row * NNG;
            float x[8]; ld8bf(pr + P_CQ + lane * 8, x); float s = 0.f;
            *(u32x2*)(CQ8 + (size_t)row * 1024 + lane * 8) = (u32x2){pk4fp8(x[0], x[1], x[2], x[3]), pk4fp8(x[4], x[5], x[6], x[7])};
#pragma unroll
            for (int i = 0; i < 8; ++i) s += x[i] * x[i];
            s = wave_sum(s); const float rq = 1.f / sqrtf(s * (1.f / 512.f) + 1e-6f);
            ld8bf(pr + P_CKV + lane * 8, x); s = 0.f;
            *(u32x2*)(CQ8 + (size_t)row * 1024 + 512 + lane * 8) = (u32x2){pk4fp8(x[0], x[1], x[2], x[3]), pk4fp8(x[4], x[5], x[6], x[7])};
#pragma unroll
            for (int i = 0; i < 8; ++i) s += x[i] * x[i];
            s = wave_sum(s); const float rk = 1.f / sqrtf(s * (1.f / 512.f) + 1e-6f);
            if (lane == 0) { RS[row * 2] = rq; RS[row * 2 + 1] = rk; }
            float kv = bf2f(pr[P_KPE + lane]);
            const float other = swz16(kv);
            if (row >= TC) { const int t = (row - TC) & (SEQ - 1); const int axis = lane >> 5, half = (lane >> 4) & 1, j = lane & 15;
                const float pos = (float)(axis == 0 ? (t >> 6) : (t & 63)); const float inv = __builtin_amdgcn_exp2f(-(float)j * 0.8304820237218406f);
                const float sn = __sinf(pos * inv), cs = __cosf(pos * inv);
                kv = half == 0 ? kv * cs - other * sn : kv * cs + other * sn; }
            KPE[(size_t)row * 64 + lane] = (bf16_t)f2bf(kv);
            if (lane < 32) DT[(size_t)row * 32 + lane] = softplusf_(bf2f(pr[P_DT + lane]) + dtb[lane]); }
        continue; }
        const bool first = row_first(r0), last = row_last(r0 + PREP_RUN - 1);
        if (ct >= 1 && ct <= 3) { const int ch = ct - 1; const int c = ch * 512 + lane * 8; float xm[8], x0[8], xp[8], w0[8], w1[8], w2[8], bb[8];
            ld8f(scw + c, w0); ld8f(scw + 1536 + c, w1); ld8f(scw + 3072 + c, w2); ld8f(scb + c, bb);
            const bf16_t* pc = P + (size_t)r0 * NNG + P_XBC + c;
            u32x4 raw[PREP_RUN + 2];
#pragma unroll
            for (int rr = 0; rr < PREP_RUN + 2; ++rr) { const bool ok = (rr > 0 || !first) && (rr < PREP_RUN + 1 || !last); raw[rr] = ok ? *(const u32x4*)(pc + (ptrdiff_t)(rr - 1) * NNG) : (u32x4){0u, 0u, 0u, 0u}; }
            up8(raw[0], xm); up8(raw[1], x0);
#pragma unroll
            for (int rr = 0; rr < PREP_RUN; ++rr) {
                up8(raw[rr + 2], xp);
                float o[8];
#pragma unroll
                for (int i = 0; i < 8; ++i) { o[i] = siluf_(xm[i] * w0[i] + x0[i] * w1[i] + xp[i] * w2[i] + bb[i]); xm[i] = x0[i]; x0[i] = xp[i]; }
                st8bf(P2 + (size_t)(r0 + rr) * P2W + P2_XBC + c, o); } continue; }
        if (ct >= 4 && ct <= 5) { const int ch = ct - 4; { const int c = ch * 512 + lane * 8; float xm[8], x0[8], xp[8], w0[8], w1[8], w2[8], bb[8];
            ld8f(hcw + c, w0); ld8f(hcw + 3072 + c, w1); ld8f(hcw + 6144 + c, w2); ld8f(hcb + c, bb);
            const bf16_t* pc = P + (size_t)r0 * NNG + P_HY + c;
            u32x4 raw[PREP_RUN + 2];
#pragma unroll
            for (int rr = 0; rr < PREP_RUN + 2; ++rr) { const bool ok = (rr > 0 || !first) && (rr < PREP_RUN + 1 || !last); raw[rr] = ok ? *(const u32x4*)(pc + (ptrdiff_t)(rr - 1) * NNG) : (u32x4){0u, 0u, 0u, 0u}; }
            up8(raw[0], xm); up8(raw[1], x0);
#pragma unroll
            for (int rr = 0; rr < PREP_RUN; ++rr) {
                up8(raw[rr + 2], xp);
                float o[8];
#pragma unroll
                for (int i = 0; i < 8; ++i) { o[i] = xm[i] * w0[i] + x0[i] * w1[i] + xp[i] * w2[i] + bb[i]; xm[i] = x0[i]; x0[i] = xp[i]; }
                st8bf(P2 + (size_t)(r0 + rr) * P2W + P2_X0 + c, o); } }
        if (r0 < TC) {
#pragma unroll 1
                for (int rr = 0; rr < PREP_RUN; ++rr) { const int row = r0 + rr; const bool f1 = row_first(row), l1 = row_last(row); const int c = ch * 512 + lane * 8;
                    const bf16_t* pr = P + (size_t)row * NNG; float o1[8], o2[8];
#pragma unroll
                    for (int part = 1; part < 3; ++part) { float x0[8], xm[8], xp[8], w0[8], w1[8], w2[8], bb[8]; const int cc = part * 1024 + c;
                        ld8bf(pr + P_HY + cc, x0);
                        if (!f1) ld8bf(pr - NNG + P_HY + cc, xm); else { for (int i = 0; i < 8; ++i) xm[i] = 0.f; }
                        if (!l1) ld8bf(pr + NNG + P_HY + cc, xp); else { for (int i = 0; i < 8; ++i) xp[i] = 0.f; }
                        ld8f(hcw + cc, w0); ld8f(hcw + 3072 + cc, w1); ld8f(hcw + 6144 + cc, w2); ld8f(hcb + cc, bb);
#pragma unroll
                        for (int i = 0; i < 8; ++i) { const float r = xm[i] * w0[i] + x0[i] * w1[i] + xp[i] * w2[i] + bb[i]; if (part == 1) o1[i] = r; else o2[i] = r; } }
                    float* vc = VC + (size_t)row * 1024 + c;
                    *(f32x4*)vc = (f32x4){o1[0] * o2[0], o1[1] * o2[1], o1[2] * o2[2], o1[3] * o2[3]};
                    *(f32x4*)(vc + 4) = (f32x4){o1[4] * o2[4], o1[5] * o2[5], o1[6] * o2[6], o1[7] * o2[7]}; } }
        continue; }
        { const int ch = ct - 6; const int c = ch * 512 + lane * 8;
            if (c < 3488) { float um[8], u0[8], up[8], m0[8], m1[8], g8[8];
                ld8f(mu + c, m0); ld8f(mu + 3488 + c, m1);
                if (ch == 2 || ch == 3) ld8f(rkk + (c - 1024), g8);
                const bf16_t* pc = P + (size_t)r0 * NNG + P_RW + c;
                u32x4 raw[PREP_RUN + 2];
#pragma unroll
                for (int rr = 0; rr < PREP_RUN + 2; ++rr) { const bool ok = (rr > 0 || !first) && (rr < PREP_RUN + 1 || !last); raw[rr] = ok ? *(const u32x4*)(pc + (ptrdiff_t)(rr - 1) * NNG) : (u32x4){0u, 0u, 0u, 0u}; }
                up8(raw[0], um); up8(raw[1], u0);
#pragma unroll
                for (int rr = 0; rr < PREP_RUN; ++rr) { const int row = r0 + rr;
                    up8(raw[rr + 2], up);
                    float us[8];
#pragma unroll
                    for (int i = 0; i < 8; ++i) { us[i] = u0[i] + m0[i] * (um[i] - u0[i]) + m1[i] * (up[i] - u0[i]); um[i] = u0[i]; u0[i] = up[i]; }
                    if (ch < 6) st8bf(P2 + (size_t)row * P2W + P2_RKV + c, us);
                    if (ch == 2 || ch == 3) { float kx[8]; float s = 0.f;
#pragma unroll
                        for (int i = 0; i < 8; ++i) { kx[i] = us[i] * g8[i]; s += kx[i] * kx[i]; }
                        s = sum8(s);
                        const float inv = 1.f / fmaxf(sqrtf(s), 1e-12f);
#pragma unroll
                        for (int i = 0; i < 8; ++i) kx[i] *= inv;
                        st8bf(KK + (size_t)row * 1024 + (c - 1024), kx); }
                    if (ch == 6) { const int cl = c - 3072; float o[8];
#pragma unroll
                        for (int i = 0; i < 8; ++i) o[i] = cl < 128 ? tanhf_(us[i]) : cl < 256 ? us[i] : sigmoidf_(us[i]);
                        *(u32x2*)(AL_ + (size_t)row * 512 + cl) = (u32x2){pk4fp8(o[0], o[1], o[2], o[3]), pk4fp8(o[4], o[5], o[6], o[7])}; } } }
            else if (ch == 6) { const int cl = c - 3072;
                for (int rr = 0; rr < PREP_RUN; ++rr) { float zz = 0.f; asm volatile("" : "+v"(zz)); *(u32x2*)(AL_ + (size_t)(r0 + rr) * 512 + cl) = (u32x2){__builtin_bit_cast(unsigned, zz), __builtin_bit_cast(unsigned, zz)}; } } }
    }
    float* VT = WSP(float, WS_VT);
    LAS float* tl = (LAS float*)F.lds;
    for (int u = F.bid; u < (TL / 64) * 4; u += F.G) {
        const int tb = u >> 2, cb = u & 3; const int row0 = TC + tb * 64; const int c8 = (F.tid & 31) * 8, c = cb * 256 + c8, tq = F.tid >> 5;
        float w1[3][8], w2[3][8], b1[8], b2[8];
#pragma unroll
        for (int k = 0; k < 3; ++k) { ld8f(hcw + k * 3072 + 1024 + c, w1[k]); ld8f(hcw + k * 3072 + 2048 + c, w2[k]); }
        ld8f(hcb + 1024 + c, b1); ld8f(hcb + 2048 + c, b2);
        __syncthreads();
#pragma unroll 1
        for (int i = 0; i < 4; ++i) { const int tl_ = tq * 4 + i, row = row0 + tl_; const bf16_t* pr = P + (size_t)row * NNG + P_HY;
            const bool first = row_first(row), last = row_last(row);
            float a1[8], a2[8], x[8];
            ld8bf(pr + 1024 + c, x);
#pragma unroll
            for (int j = 0; j < 8; ++j) a1[j] = x[j] * w1[1][j] + b1[j];
            ld8bf(pr + 2048 + c, x);
#pragma unroll
            for (int j = 0; j < 8; ++j) a2[j] = x[j] * w2[1][j] + b2[j];
            if (!first) { ld8bf(pr - NNG + 1024 + c, x);
#pragma unroll
                for (int j = 0; j < 8; ++j) a1[j] += x[j] * w1[0][j];
                ld8bf(pr - NNG + 2048 + c, x);
#pragma unroll
                for (int j = 0; j < 8; ++j) a2[j] += x[j] * w2[0][j]; }
            if (!last) { ld8bf(pr + NNG + 1024 + c, x);
#pragma unroll
                for (int j = 0; j < 8; ++j) a1[j] += x[j] * w1[2][j];
                ld8bf(pr + NNG + 2048 + c, x);
#pragma unroll
                for (int j = 0; j < 8; ++j) a2[j] += x[j] * w2[2][j]; }
#pragma unroll
            for (int j = 0; j < 8; ++j) tl[(c8 + j) * 65 + tl_] = a1[j] * a2[j]; }
        __syncthreads();
        const int b = (row0 - TC) >> 13, t0 = (row0 - TC) & (SEQ - 1);
        for (int p_ = 0; p_ < 8; ++p_) { const int cl = p_ * 32 + (F.tid >> 4), q = F.tid & 15;
            const f32x4 o = {tl[cl * 65 + 4 * q], tl[cl * 65 + 4 * q + 1], tl[cl * 65 + 4 * q + 2], tl[cl * 65 + 4 * q + 3]};
            *(f32x4*)(VT + ((size_t)(cb * 256 + cl) * 2 + b) * SEQ + t0 + 4 * q) = o; }
    }
}

using pg8::Unit;
#define EPI_LOOP_BEGIN const int row0 = u.pm * 256 + wr * 64 + fr; \
    _Pragma("unroll") for (int ai = 0; ai < 2; ++ai) _Pragma("unroll") for (int m = 0; m < 4; ++m) { const int row = row0 + ai * 128 + m * 16; \
    _Pragma("unroll") for (int bj = 0; bj < 2; ++bj) { const int cl = bj * 128 + wc * 32 + 8 * fq; const f32x4 v0 = acc[ai][bj][m][0], v1 = acc[ai][bj][m][1];
#define EPI_LOOP_END } __builtin_amdgcn_sched_barrier(0); }
struct EpiBf16 {
    static constexpr bool PERM = true, KEEPS = false;
    bf16_t* O; int ldc; const float* rscale; int rs_stride; int act; float cscale; int pn_from, pn_add;
    __device__ __forceinline__ void operator()(const f32x4 (&acc)[2][2][4][2], const Unit& u, int wr, int wc, int fr, int fq) const {
        EPI_LOOP_BEGIN
            const float s = (rscale ? rscale[(size_t)row * rs_stride] : 1.f) * cscale;
            float x[8] = {v0.x * s, v0.y * s, v0.z * s, v0.w * s, v1.x * s, v1.y * s, v1.z * s, v1.w * s};
            if (act == 1) {
#pragma unroll
                for (int i = 0; i < 8; ++i) x[i] = sigmoidf_(x[i]); }
            u32x4 w; w.x = cvt_pk_bf16(x[0], x[1]); w.y = cvt_pk_bf16(x[2], x[3]); w.z = cvt_pk_bf16(x[4], x[5]); w.w = cvt_pk_bf16(x[6], x[7]);
            *(u32x4*)(O + (size_t)row * ldc + (u.pn + (u.pn >= pn_from ? pn_add : 0)) * 256 + cl) = w;
        EPI_LOOP_END
    }
};
struct EpiLora {
    static constexpr bool PERM = true, KEEPS = false;
    bf16_t* EW; bf16_t* ICLR; bf16_t* GG; const float* w0; const float* a0; float cscale;
    __device__ __forceinline__ void operator()(const f32x4 (&acc)[2][2][4][2], const Unit& u, int wr, int wc, int fr, int fq) const {
        const int blk = u.pn >> 2, cb = (u.pn & 3) * 256;
        const float* bias = blk < 2 ? w0 + blk * 1024 : a0 + (blk & 1) * 1024;
        bf16_t* dbase = blk < 2 ? EW + (size_t)blk * T * 1024 : blk < 4 ? ICLR + (size_t)(blk - 2) * T * 1024 : GG;
        const float scale = blk < 2 ? 0.6065306597126334f : 1.f; const bool sig = blk < 4;
        f32x4 bia[2][2];
#pragma unroll
        for (int bj = 0; bj < 2; ++bj) { const int c = cb + bj * 128 + wc * 32 + 8 * fq; bia[bj][0] = *(const f32x4*)(bias + c); bia[bj][1] = *(const f32x4*)(bias + c + 4); }
        EPI_LOOP_BEGIN
            const int c = cb + cl; float x[8] = {v0.x * cscale, v0.y * cscale, v0.z * cscale, v0.w * cscale, v1.x * cscale, v1.y * cscale, v1.z * cscale, v1.w * cscale};
            if (sig) { const f32x4 b0 = bia[bj][0], b1 = bia[bj][1]; const float bb[8] = {b0.x, b0.y, b0.z, b0.w, b1.x, b1.y, b1.z, b1.w};
#pragma unroll
                for (int i = 0; i < 8; ++i) x[i] = scale * sigmoidf_(bb[i] + x[i]); }
            u32x4 w; w.x = cvt_pk_bf16(x[0], x[1]); w.y = cvt_pk_bf16(x[2], x[3]); w.z = cvt_pk_bf16(x[4], x[5]); w.w = cvt_pk_bf16(x[6], x[7]);
            *(u32x4*)(dbase + (size_t)row * 1024 + c) = w;
        EPI_LOOP_END
    }
};
struct EpiHy {
    static constexpr bool PERM = true, KEEPS = false;
    const bf16_t* gates; bf16_t* MB;
    __device__ __forceinline__ void operator()(const f32x4 (&acc)[2][2][4][2], const Unit& uu, int wr, int wc, int fr, int fq) const {
        Unit u; u.pm = uu.pm - 2 * 66; u.pn = uu.pn & 7;
        const int row0 = u.pm * 256 + wr * 64 + fr, col0 = u.pn * 256 + wc * 32 + 8 * fq;
        const bf16_t* gcur = gates + 2 * DM + col0;
        u32x4 gq[2], gn[2];
#define EM_ROW(it_) ((size_t)(row0 + ((it_) >> 2) * 128 + ((it_) & 3) * 16))
#pragma unroll
        for (int bj = 0; bj < 2; ++bj) gq[bj] = *(const u32x4*)(gcur + EM_ROW(0) * NGATE + bj * 128);
#pragma unroll
        for (int it = 0; it < 8; ++it) { const int ai = it >> 2, m = it & 3;
            if (it < 7) {
#pragma unroll
                for (int bj = 0; bj < 2; ++bj) gn[bj] = *(const u32x4*)(gcur + EM_ROW(it + 1) * NGATE + bj * 128); }
#pragma unroll
            for (int bj = 0; bj < 2; ++bj) { float g[8]; up8(gq[bj], g); const f32x4 v0 = acc[ai][bj][m][0], v1 = acc[ai][bj][m][1];
#pragma unroll
                for (int i = 0; i < 8; ++i) g[i] = sigmoidf_(g[i]);
                u32x4 w; w.x = cvt_pk_bf16(v0.x * g[0], v0.y * g[1]); w.y = cvt_pk_bf16(v0.z * g[2], v0.w * g[3]); w.z = cvt_pk_bf16(v1.x * g[4], v1.y * g[5]); w.w = cvt_pk_bf16(v1.z * g[6], v1.w * g[7]);
                *(u32x4*)(MB + EM_ROW(it) * DM + col0 + bj * 128) = w; }
            gq[0] = gn[0]; gq[1] = gn[1];
            __builtin_amdgcn_sched_barrier(0); }
    }
};
struct OrderHy {
    pg8::StaticOrder so;
    __device__ void init(int G, int c, int nM, int pm0) { so.init(nM, 8, G, c, pm0); }
    __device__ bool next(int i, Unit& u) const { Unit t; if (!so.next(i, t)) return false; u.pm = 2 * 66 + t.pm; u.pn = 2 * 8 + t.pn; return true; }
};
struct EpiMerge3 {
    static constexpr bool PERM = true, KEEPS = true;
    const bf16_t* gates; bf16_t* MB;
    __device__ __forceinline__ bool operator()(f32x4 (&acc)[2][2][4][2], const Unit& uu, int wr, int wc, int fr, int fq) const {
        const int sub = uu.pn >> 3; Unit u; u.pm = uu.pm - (sub == 0 ? 0 : sub == 1 ? 66 : 396); u.pn = uu.pn & 7;
        const int br = sub == 2 ? 3 : sub, brn = sub == 0 ? 1 : 3; const bool last = sub == 2; const float fs = sub == 0 ? 1.f / Y8A_SCALE : 1.f;
        const int row0 = u.pm * 256 + wr * 64 + fr, col0 = u.pn * 256 + wc * 32 + 8 * fq;
        const bf16_t* gcur = gates + br * DM + col0; const bf16_t* gnxt = gates + brn * DM + col0;
        u32x4 gq[2], hq[2], gn[2], hn[2];
#pragma unroll
        for (int bj = 0; bj < 2; ++bj) { gq[bj] = *(const u32x4*)(gcur + EM_ROW(0) * NGATE + bj * 128); hq[bj] = last ? *(const u32x4*)(MB + EM_ROW(0) * DM + col0 + bj * 128) : *(const u32x4*)(gnxt + EM_ROW(0) * NGATE + bj * 128); }
#pragma unroll
        for (int it = 0; it < 8; ++it) { const int ai = it >> 2, m = it & 3;
            if (it < 7) {
#pragma unroll
                for (int bj = 0; bj < 2; ++bj) { gn[bj] = *(const u32x4*)(gcur + EM_ROW(it + 1) * NGATE + bj * 128); hn[bj] = last ? *(const u32x4*)(MB + EM_ROW(it + 1) * DM + col0 + bj * 128) : *(const u32x4*)(gnxt + EM_ROW(it + 1) * NGATE + bj * 128); } }
#pragma unroll
            for (int bj = 0; bj < 2; ++bj) { float g[8], hh[8]; up8(gq[bj], g); up8(hq[bj], hh); float f[8];
#pragma unroll
                for (int i = 0; i < 8; ++i) { const float ea = __expf(-g[i]), eb = __expf(-hh[i]); f[i] = last ? (1.f / 32.f) / (1.f + ea) : fs * (1.f + eb) / (1.f + ea); }
                f32x4& v0 = acc[ai][bj][m][0]; f32x4& v1 = acc[ai][bj][m][1];
                v0 = v0 * (f32x4){f[0], f[1], f[2], f[3]}; v1 = v1 * (f32x4){f[4], f[5], f[6], f[7]};
                if (last) { u32x4 w; w.x = cvt_pk_bf16(v0.x + hh[0], v0.y + hh[1]); w.y = cvt_pk_bf16(v0.z + hh[2], v0.w + hh[3]); w.z = cvt_pk_bf16(v1.x + hh[4], v1.y + hh[5]); w.w = cvt_pk_bf16(v1.z + hh[6], v1.w + hh[7]);
                    *(u32x4*)(MB + EM_ROW(it) * DM + col0 + bj * 128) = w; } }
            gq[0] = gn[0]; gq[1] = gn[1]; hq[0] = hn[0]; hq[1] = hn[1];
            __builtin_amdgcn_sched_barrier(0); }
#undef EM_ROW
        return !last;
    }
};
struct OrderMerge3 {
    pg8::StaticOrder so;
    __device__ void init(int G, int c, int nM, int pm0) { so.init(nM, 8, G, c, pm0); }
    __device__ bool next(int i, Unit& u) const { Unit t; if (!so.next(i / 3, t)) return false; const int sub = i % 3; u.pm = (sub == 0 ? 0 : sub == 1 ? 66 : 396) + t.pm; u.pn = sub * 8 + t.pn; return true; }
};
struct EpiF32 {
    static constexpr bool PERM = true, KEEPS = false;
    float* O; int ldc;
    __device__ __forceinline__ void operator()(const f32x4 (&acc)[2][2][4][2], const Unit& u, int wr, int wc, int fr, int fq) const {
        EPI_LOOP_BEGIN
            float* o = O + (size_t)row * ldc + u.pn * 256 + cl; *(f32x4*)o = v0; *(f32x4*)(o + 4) = v1;
        EPI_LOOP_END
    }
};
__device__ __forceinline__ int moe_panel(int e, int pi) { return pi < 8 ? (((pi >> 2) * NEXP + e) * 4 + (pi & 3)) : 128 + e; }
struct OrderMoe {
    int npn, G, c, npan;
    __device__ void init(int npn_, int G_, int c_, int npan_) { npn = npn_; G = G_; c = c_; npan = npan_; }
    __device__ bool next(int i, Unit& u) const { const int per = npan * npn;
        if ((G & 7) == 0 && G >= 8) { const int xcd = c & 7, wx = G >> 3, r = c >> 3; const int Lx = i * wx + r; if (Lx >= 2 * per) return false;
            const int e = xcd + 8 * (Lx / per), rem = Lx % per, j = rem / npan, pi = rem % npan; u.pm = moe_panel(e, pi); u.pn = e * npn + j; return true; }
        const int L = i * G + c; if (L >= NEXP * per) return false;
        const int e = L / per, r = L % per, j = r / npan, pi = r % npan; u.pm = moe_panel(e, pi); u.pn = e * npn + j; return true; }
};
struct EpiSwiglu {
    static constexpr bool PERM = true, KEEPS = false;
    unsigned char* HID;
    __device__ __forceinline__ void operator()(const f32x4 (&acc)[2][2][4][2], const Unit& u, int wr, int wc, int fr, int fq) const {
        const int j = u.pn % 11; const int row0 = u.pm * 256 + wr * 64 + fr; const float sc = 1.f / 64.f;
#pragma unroll
        for (int ai = 0; ai < 2; ++ai)
#pragma unroll
            for (int m = 0; m < 4; ++m) { const int row = row0 + ai * 128 + m * 16;
                const f32x4 g0 = acc[ai][0][m][0] * sc, g1 = acc[ai][0][m][1] * sc, u0 = acc[ai][1][m][0] * sc, u1 = acc[ai][1][m][1] * sc;
                u32x2 w; w.x = pk4fp8(siluf_(g0.x) * u0.x, siluf_(g0.y) * u0.y, siluf_(g0.z) * u0.z, siluf_(g0.w) * u0.w);
                w.y = pk4fp8(siluf_(g1.x) * u1.x, siluf_(g1.y) * u1.y, siluf_(g1.z) * u1.z, siluf_(g1.w) * u1.w);
                *(u32x2*)(HID + (size_t)row * EFFP + j * 128 + wc * 32 + 8 * fq) = w; __builtin_amdgcn_sched_barrier(0); }
    }
};
struct EpiDown {
    static constexpr bool PERM = true, KEEPS = false;
    bf16_t* YE;
    __device__ __forceinline__ void operator()(const f32x4 (&acc)[2][2][4][2], const Unit& uu, int wr, int wc, int fr, int fq) const {
        Unit u; u.pm = uu.pm; u.pn = uu.pn & 7; const float s = 1.f / 64.f;
        EPI_LOOP_BEGIN
            u32x4 w; w.x = cvt_pk_bf16(v0.x * s, v0.y * s); w.y = cvt_pk_bf16(v0.z * s, v0.w * s); w.z = cvt_pk_bf16(v1.x * s, v1.y * s); w.w = cvt_pk_bf16(v1.z * s, v1.w * s);
            *(u32x4*)(YE + (size_t)row * DM + u.pn * 256 + cl) = w;
        EPI_LOOP_END
    }
};

namespace att {
using s16x4 = __attribute__((ext_vector_type(4))) short;
using f32x16 = __attribute__((ext_vector_type(16))) float;
constexpr int NW = 8, QBLK = 32, KVBLK = 64, LDQ = 1536, LDKV = 2048, LDO = 1024;
constexpr float SCALE = 0.07216878364870322f;
constexpr float THR = 8.f;
#ifndef ATT_SDEPTH
#define ATT_SDEPTH 1
#endif
constexpr int SDEPTH = ATT_SDEPTH;
constexpr int SHM_V = KVBLK * 128 * 2, SHM_K = KVBLK * 128 * 2, SHM_KP = KVBLK * 64 * 2;
constexpr int OFF_V = 0, OFF_K = 2 * SHM_V, OFF_KP = OFF_K + 2 * SHM_K, OFF_WS = OFF_KP + 2 * SHM_KP, OFF_QP = OFF_WS + NW * 64 * 4, SHM_ATTN = OFF_QP + 256 * 256;
static_assert(SHM_ATTN <= 150 * 1024, "attention LDS");
#define KSWZ(row, colB) ((row) * 256 + ((colB) ^ (((row) & 7) << 4)))
#define KPSWZ(row, colB) ((row) * 128 + ((colB) ^ (((row) & 7) << 4)))
#define SBAR() __builtin_amdgcn_sched_barrier(0)
__device__ __forceinline__ int crow(int r, int hi) { return (r & 3) + 8 * (r >> 2) + 4 * hi; }
__device__ __forceinline__ void partialSM(f32x16& p0, f32x16& p1, float& m_reg, float& mn, float& alpha) {
  constexpr float C = SCALE * 1.4426950408889634f;
  float pmax = p0[0]; for (int r = 1; r < 16; ++r) pmax = fmaxf(pmax, p0[r]); for (int r = 0; r < 16; ++r) pmax = fmaxf(pmax, p1[r]);
  { auto rr = __builtin_amdgcn_permlane32_swap(__float_as_uint(pmax), __float_as_uint(pmax), false, false);
    pmax = fmaxf(__uint_as_float(rr[0]), __uint_as_float(rr[1])); }
  if (__builtin_expect(__all(pmax - m_reg <= THR / SCALE), 1)) { mn = m_reg; alpha = 1.f; }
  else { mn = fmaxf(m_reg, pmax); alpha = __builtin_amdgcn_exp2f((m_reg - mn) * C); m_reg = mn; }
  float mnC = -mn * C;
  for (int r = 0; r < 16; ++r) p0[r] = fmaf(p0[r], C, mnC); for (int r = 0; r < 16; ++r) p1[r] = fmaf(p1[r], C, mnC);
  for (int r = 0; r < 16; ++r) p0[r] = __builtin_amdgcn_exp2f(p0[r]);
}
__device__ __forceinline__ void finishSM(f32x16& p0, f32x16& p1, float alpha, float& l_reg, bf16x8& pa0, bf16x8& pa1, bf16x8& pa2, bf16x8& pa3) {
  for (int r = 0; r < 16; ++r) p1[r] = __builtin_amdgcn_exp2f(p1[r]);
  float ps = 0; for (int r = 0; r < 16; ++r) ps += p0[r]; for (int r = 0; r < 16; ++r) ps += p1[r];
  { auto rr = __builtin_amdgcn_permlane32_swap(__float_as_uint(ps), __float_as_uint(ps), false, false);
    ps = __uint_as_float(rr[0]) + __uint_as_float(rr[1]); }
  l_reg = l_reg * alpha + ps;
#define PK4(P, BASE, OUT) do { unsigned a0 = cvt_pk_bf16(P[BASE + 0], P[BASE + 1]), a1 = cvt_pk_bf16(P[BASE + 2], P[BASE + 3]);   \
    unsigned b0 = cvt_pk_bf16(P[BASE + 4], P[BASE + 5]), b1 = cvt_pk_bf16(P[BASE + 6], P[BASE + 7]);                              \
    auto r0 = __builtin_amdgcn_permlane32_swap(a0, b0, false, false); auto r1 = __builtin_amdgcn_permlane32_swap(a1, b1, false, false); \
    u32x4 w = {r0[0], r1[0], r0[1], r1[1]}; OUT = *reinterpret_cast<bf16x8*>(&w); } while (0)
  PK4(p0, 0, pa0); PK4(p0, 8, pa1); PK4(p1, 0, pa2); PK4(p1, 8, pa3);
#undef PK4
}
__device__ __forceinline__ void qkt(f32x16& p0, f32x16& p1, const char* Ks, const char* Kp, const bf16x8* qr, const char* Qp, int qrow, int r32, int hi) {
  p0 = f32x16{}; p1 = f32x16{};
#pragma unroll
  for (int d0 = 0; d0 < 8; ++d0) { int cb = (d0 * 16 + hi * 8) * 2;
    bf16x8 b0 = *reinterpret_cast<const bf16x8*>(Ks + KSWZ(r32, cb));
    bf16x8 b1 = *reinterpret_cast<const bf16x8*>(Ks + KSWZ(32 + r32, cb));
    bf16x8 q; if (d0 < 4) q = qr[d0]; else q = *reinterpret_cast<const bf16x8*>(Qp + KSWZ(qrow, ((d0 - 4) * 16 + hi * 8) * 2));
    p0 = __builtin_amdgcn_mfma_f32_32x32x16_bf16(b0, q, p0, 0, 0, 0);
    p1 = __builtin_amdgcn_mfma_f32_32x32x16_bf16(b1, q, p1, 0, 0, 0); }
#pragma unroll
  for (int d0 = 0; d0 < 4; ++d0) { int cb = (d0 * 16 + hi * 8) * 2;
    bf16x8 b0 = *reinterpret_cast<const bf16x8*>(Kp + KPSWZ(r32, cb));
    bf16x8 b1 = *reinterpret_cast<const bf16x8*>(Kp + KPSWZ(32 + r32, cb));
    const bf16x8 qp = *reinterpret_cast<const bf16x8*>(Qp + KSWZ(qrow, 128 + cb));
    p0 = __builtin_amdgcn_mfma_f32_32x32x16_bf16(b0, qp, p0, 0, 0, 0);
    p1 = __builtin_amdgcn_mfma_f32_32x32x16_bf16(b1, qp, p1, 0, 0, 0); }
}
__device__ __forceinline__ int v_st(int k, int c) { const int kk = (k & ~0xC) | ((k & 4) << 1) | ((k & 8) >> 1); return ((kk >> 3) * 4 + (c >> 5)) * 512 + ((kk & 7) * 32 + (c & 31)) * 2; }
__device__ __forceinline__ int v_rd_base(int lane) { return ((lane & 3) << 3) | (((lane >> 2) & 3) << 6) | (((lane >> 4) & 1) << 5) | (((lane >> 5) & 1) << 8); }
constexpr int v_rd_off(int d0, int ks, int half) { return d0 * 512 + ks * 4096 + half * 2048; }
template <int OFF> __device__ __forceinline__ s16x4 tr_read(int vb) {
  s16x4 r; asm volatile("ds_read_b64_tr_b16 %0, %1 offset:%2" : "=&v"(r) : "v"(vb), "i"(OFF) : "memory"); return r;
}
template <int D0> __device__ __forceinline__ void pv_one(f32x16& od, int vb, bf16x8 pa0, bf16x8 pa1, bf16x8 pa2, bf16x8 pa3) {
  const s16x4 l0 = tr_read<v_rd_off(D0, 0, 0)>(vb), h0 = tr_read<v_rd_off(D0, 0, 1)>(vb), l1 = tr_read<v_rd_off(D0, 1, 0)>(vb), h1 = tr_read<v_rd_off(D0, 1, 1)>(vb);
  const s16x4 l2 = tr_read<v_rd_off(D0, 2, 0)>(vb), h2 = tr_read<v_rd_off(D0, 2, 1)>(vb), l3 = tr_read<v_rd_off(D0, 3, 0)>(vb), h3 = tr_read<v_rd_off(D0, 3, 1)>(vb);
  asm volatile("s_waitcnt lgkmcnt(0)" ::: "memory"); SBAR();
#define PK(L, H) (bf16x8){L[0], L[1], L[2], L[3], H[0], H[1], H[2], H[3]}
  od = __builtin_amdgcn_mfma_f32_32x32x16_bf16(pa0, PK(l0, h0), od, 0, 0, 0);
  od = __builtin_amdgcn_mfma_f32_32x32x16_bf16(pa1, PK(l1, h1), od, 0, 0, 0);
  od = __builtin_amdgcn_mfma_f32_32x32x16_bf16(pa2, PK(l2, h2), od, 0, 0, 0);
  od = __builtin_amdgcn_mfma_f32_32x32x16_bf16(pa3, PK(l3, h3), od, 0, 0, 0);
#undef PK
}
__device__ __forceinline__ void pv_d0(f32x16* o, int vb, bf16x8 pa0, bf16x8 pa1, bf16x8 pa2, bf16x8 pa3) {
  pv_one<0>(o[0], vb, pa0, pa1, pa2, pa3); pv_one<1>(o[1], vb, pa0, pa1, pa2, pa3); pv_one<2>(o[2], vb, pa0, pa1, pa2, pa3); pv_one<3>(o[3], vb, pa0, pa1, pa2, pa3);
}
__device__ __forceinline__ void attn_unit(const bf16_t* __restrict__ Qb, const bf16_t* __restrict__ KVh, const bf16_t* __restrict__ KPE, unsigned char* __restrict__ Ob,
                                          int ka0, int kb0, int NT, char* lds, int tid_in, int tpos0) {
  const unsigned tid_u = (unsigned)tid_in; __builtin_assume(tid_u < 512u);
  const int tid = (int)tid_u, wid = tid >> 6, lane = tid & 63, r32 = lane & 31, hi = lane >> 5;
  char* V_lds = lds + OFF_V; char* K_lds = lds + OFF_K; char* P_lds = lds + OFF_KP;
  float* ws = (float*)(lds + OFF_WS) + wid * 64; float* li_l = ws; float* al_l = ws + 32;
  float m_reg = -1e30f, l_reg = 0; f32x16 o[4] = {}; bf16x8 qr[4];
  char* Q_lds = lds + OFF_QP; const int qrow = wid * QBLK + r32;
  const bf16_t* Qw = Qb + (long)(wid * QBLK + r32) * LDQ + hi * 8;
#pragma unroll
  for (int d0 = 0; d0 < 4; ++d0) qr[d0] = *reinterpret_cast<const bf16x8*>(Qw + d0 * 16);
#pragma unroll
  for (int d0 = 0; d0 < 4; ++d0) *reinterpret_cast<bf16x8*>(Q_lds + KSWZ(qrow, (d0 * 16 + hi * 8) * 2)) = *reinterpret_cast<const bf16x8*>(Qw + 64 + d0 * 16);
#pragma unroll
  for (int ax = 0; ax < 2; ++ax) { u32x4 w1 = *reinterpret_cast<const u32x4*>(Qw + 128 + ax * 32), w2 = *reinterpret_cast<const u32x4*>(Qw + 128 + ax * 32 + 16);
    if (tpos0 >= 0) { const int t = tpos0 + qrow; const float pos = (float)(ax == 0 ? (t >> 6) : (t & 63));
      unsigned* p1 = (unsigned*)&w1; unsigned* p2 = (unsigned*)&w2;
#pragma unroll
      for (int i = 0; i < 4; ++i) { float a0 = bflo(p1[i]), a1 = bfhi(p1[i]), b0 = bflo(p2[i]), b1 = bfhi(p2[i]);
        const float ang0 = pos * __builtin_amdgcn_exp2f(-(float)(hi * 8 + 2 * i) * 0.8304820237218406f), ang1 = pos * __builtin_amdgcn_exp2f(-(float)(hi * 8 + 2 * i + 1) * 0.8304820237218406f);
        const float c0 = __cosf(ang0), s0 = __sinf(ang0), c1 = __cosf(ang1), s1 = __sinf(ang1);
        p1[i] = pk2(a0 * c0 - b0 * s0, a1 * c1 - b1 * s1); p2[i] = pk2(b0 * c0 + a0 * s0, b1 * c1 + a1 * s1); } }
    *reinterpret_cast<u32x4*>(Q_lds + KSWZ(qrow, 128 + (ax * 32 + hi * 8) * 2)) = w1; *reinterpret_cast<u32x4*>(Q_lds + KSWZ(qrow, 128 + (ax * 32 + 16 + hi * 8) * 2)) = w2; }
  const int sr = tid >> 4, sc = (tid & 15) * 8, vst0 = v_st(sr, sc), vst1 = v_st(32 + sr, sc);
  const int pr = tid >> 3, pc = (tid & 7) * 8;
  const int vb0 = (int)(uintptr_t)V_lds + v_rd_base(lane);
  struct { bf16x8 vs0, vs1, ks0, ks1, kp; } sr_[SDEPTH];
#define KROW(j) ((j) < 4 ? ka0 + 64 * (j) : kb0 + 64 * ((j) - 4))
  const __amdgpu_buffer_rsrc_t rsKV = __builtin_amdgcn_make_buffer_rsrc((void*)KVh, 0, 0xFFFFFFFFu, 0x00020000);
  const __amdgpu_buffer_rsrc_t rsKP = __builtin_amdgcn_make_buffer_rsrc((void*)KPE, 0, 0xFFFFFFFFu, 0x00020000);
  const int vo_k = (sr * LDKV + sc) * 2, vo_p = (pr * 64 + pc) * 2;
#define SLOAD(i, jt) do { const int k0_ = KROW(jt); const int so0 = k0_ * (LDKV * 2), so1 = so0 + 32 * LDKV * 2; \
    sr_[i].vs0 = __builtin_bit_cast(bf16x8, __builtin_amdgcn_raw_buffer_load_b128(rsKV, vo_k + 256, so0, 0)); sr_[i].vs1 = __builtin_bit_cast(bf16x8, __builtin_amdgcn_raw_buffer_load_b128(rsKV, vo_k + 256, so1, 0)); \
    sr_[i].ks0 = __builtin_bit_cast(bf16x8, __builtin_amdgcn_raw_buffer_load_b128(rsKV, vo_k, so0, 0)); sr_[i].ks1 = __builtin_bit_cast(bf16x8, __builtin_amdgcn_raw_buffer_load_b128(rsKV, vo_k, so1, 0)); \
    sr_[i].kp = __builtin_bit_cast(bf16x8, __builtin_amdgcn_raw_buffer_load_b128(rsKP, vo_p, k0_ * 128, 0)); } while (0)
#define SWRITE(b, i) do { *(bf16x8*)(V_lds + (b) * SHM_V + vst0) = sr_[i].vs0;          \
    *(bf16x8*)(V_lds + (b) * SHM_V + vst1) = sr_[i].vs1; int kc = sc * 2;               \
    *(bf16x8*)(K_lds + (b) * SHM_K + KSWZ(sr, kc)) = sr_[i].ks0;                       \
    *(bf16x8*)(K_lds + (b) * SHM_K + KSWZ(32 + sr, kc)) = sr_[i].ks1;                  \
    *(bf16x8*)(P_lds + (b) * SHM_KP + KPSWZ(pr, pc * 2)) = sr_[i].kp; } while (0)
#define SWAIT() do { if constexpr (SDEPTH == 2) asm volatile("s_waitcnt vmcnt(5)" ::: "memory"); else asm volatile("s_waitcnt vmcnt(0)" ::: "memory"); } while (0)
#define RESC(a) do { if (__any((a) < 1.f)) { if (hi == 0) al_l[r32] = (a); asm volatile("s_waitcnt lgkmcnt(0)" ::: "memory"); \
    for (int d = 0; d < 4; ++d) for (int r = 0; r < 16; ++r) o[d][r] *= al_l[crow(r, hi)]; } } while (0)
  f32x16 pA0, pA1, pB0, pB1; float mnA, mnB, alA, alB; bf16x8 pa0, pa1, pa2, pa3;
  constexpr int SE = 0, SO = SDEPTH - 1;
  SLOAD(SE, 0); asm volatile("s_waitcnt vmcnt(0)" ::: "memory"); SWRITE(0, SE); __syncthreads();
  qkt(pA0, pA1, K_lds, P_lds, qr, Q_lds, qrow, r32, hi); partialSM(pA0, pA1, m_reg, mnA, alA);
  SLOAD(SO, 1); if constexpr (SDEPTH == 2) { if (2 < NT) SLOAD(SE, 2); }
  SWAIT(); SWRITE(1, SO); __syncthreads();
  for (int j = 1; j + 1 < NT; j += 2) {
    SBAR(); qkt(pB0, pB1, K_lds + SHM_K, P_lds + SHM_KP, qr, Q_lds, qrow, r32, hi);
    finishSM(pA0, pA1, alA, l_reg, pa0, pa1, pa2, pa3); SBAR();
    SLOAD(SO, j + SDEPTH); SBAR();
    pv_d0(o, vb0, pa0, pa1, pa2, pa3); partialSM(pB0, pB1, m_reg, mnB, alB);
    __syncthreads(); SWAIT(); SWRITE(0, SE);
    RESC(alB); __syncthreads();
    SBAR(); qkt(pA0, pA1, K_lds, P_lds, qr, Q_lds, qrow, r32, hi);
    finishSM(pB0, pB1, alB, l_reg, pa0, pa1, pa2, pa3); SBAR();
    if (SDEPTH == 1 || j + 3 < NT) SLOAD(SE, j + 1 + SDEPTH); SBAR();
    pv_d0(o, vb0 + (int)SHM_V, pa0, pa1, pa2, pa3); partialSM(pA0, pA1, m_reg, mnA, alA);
    __syncthreads(); SWAIT(); SWRITE(1, SO);
    RESC(alA); __syncthreads();
  }
  SBAR(); qkt(pB0, pB1, K_lds + SHM_K, P_lds + SHM_KP, qr, Q_lds, qrow, r32, hi);
  finishSM(pA0, pA1, alA, l_reg, pa0, pa1, pa2, pa3); SBAR();
  pv_d0(o, vb0, pa0, pa1, pa2, pa3); partialSM(pB0, pB1, m_reg, mnB, alB);
  __syncthreads(); RESC(alB);
  finishSM(pB0, pB1, alB, l_reg, pa0, pa1, pa2, pa3); SBAR();
  pv_d0(o, vb0 + (int)SHM_V, pa0, pa1, pa2, pa3);
  if (hi == 0) li_l[r32] = l_reg; asm volatile("s_waitcnt lgkmcnt(0)" ::: "memory");
  float rli[16];
#pragma unroll
  for (int r = 0; r < 16; ++r) rli[r] = __builtin_amdgcn_rcpf(li_l[crow(r, hi)]);
  unsigned char* Ow = Ob + (long)(wid * QBLK) * LDO;
#pragma unroll
  for (int r = 0; r < 16; ++r) { int orow = crow(r, hi);
    for (int d0 = 0; d0 < 4; ++d0) Ow[(long)orow * LDO + d0 * 32 + r32] = (unsigned char)(pk4fp8(o[d0][r] * rli[r] * Y8A_SCALE, 0.f, 0.f, 0.f) & 0xffu); }
  __syncthreads();
#undef KROW
#undef SLOAD
#undef SWRITE
#undef SWAIT
#undef RESC
}
}

__device__ __forceinline__ void phase_attn(Frame& F, bool lat_only) {
    const bf16_t* Q = WSP(bf16_t, WS_Q); const bf16_t* KV = WSP(bf16_t, WS_KV); const bf16_t* KPE = WSP(bf16_t, WS_KPE); unsigned char* YA = WSP(unsigned char, WS_Y8A);
    const int NU = NBATCH * NH_MLA * 32 + (lat_only ? 0 : NBATCH * NH_MLA);
    const bool xa = (F.G == 256);
    for (int u0 = F.bid; u0 < NU; u0 += F.G) {
        int u = u0;
        if (xa && u0 < NBATCH * NH_MLA * 32) { const int xcd = u0 & 7, r = (u0 >> 3) & 31, rnd = u0 >> 8; u = ((xcd + 8 * rnd) << 5) + r; }
        int b, h, row0, NT, tpos0;
        if (u < NBATCH * NH_MLA * 32) { const int bh = u >> 5, qb = u & 31; b = bh >> 3; h = bh & 7; row0 = TC + b * SEQ + qb * 256; NT = 4 + SEQ / 64; tpos0 = qb * 256; }
        else { const int bh = u - NBATCH * NH_MLA * 32; b = bh >> 3; h = bh & 7; row0 = b * CTX; NT = 4; tpos0 = -1; }
        att::attn_unit(Q + (size_t)row0 * 1536 + h * 192, KV + h * 256, KPE, YA + (size_t)row0 * 1024 + h * 128, b * CTX, TC + b * SEQ, NT, (char*)F.lds, F.tid, tpos0);
    }
}
__device__ __forceinline__ void phase_qrope(Frame& F) {
    bf16_t* Q = WSP(bf16_t, WS_Q);
    for (int row = TC + F.gw; row < T; row += F.NGW) {
        const int t = (row - TC) & (SEQ - 1); const int p = F.lane & 31, axis = p >> 4, j = p & 15, hs = F.lane >> 5;
        const float pos = (float)(axis == 0 ? (t >> 6) : (t & 63)); const float inv = __builtin_amdgcn_exp2f(-(float)j * 0.8304820237218406f);
        const float sn = __sinf(pos * inv), cs = __cosf(pos * inv);
#pragma unroll
        for (int hh = 0; hh < 4; ++hh) { const int h = hh * 2 + hs; bf16_t* q = Q + (size_t)row * 1536 + h * 192 + 128 + axis * 32 + j;
            const float x1 = bf2f(q[0]), x2 = bf2f(q[16]);
            q[0] = (bf16_t)f2bf(x1 * cs - x2 * sn); q[16] = (bf16_t)f2bf(x2 * cs + x1 * sn); }
    }
}

#define MFMA16(a, b, c) __builtin_amdgcn_mfma_f32_16x16x32_bf16((a), (b), (c), 0, 0, 0)
constexpr int XS_LD = 264, BC_LD = 136;
__device__ __forceinline__ float bperm(float v, int srclane) { return __builtin_bit_cast(float, __builtin_amdgcn_ds_bpermute(srclane << 2, __builtin_bit_cast(int, v))); }
__device__ __forceinline__ float wave_incl_scan(float v, int lane) {
#pragma unroll
    for (int o = 1; o < 64; o <<= 1) { const float t = bperm(v, lane - o); if (lane >= o) v += t; }
    return v;
}
template <int NCOLS>
__device__ __forceinline__ void stage_tile(LAS bf16_t* dst, int ld, const bf16_t* src, int tid) {
    constexpr int cpr = NCOLS >> 3, NIT = 128 * cpr / NTHREADS;
    u32x4 v[NIT];
#pragma unroll
    for (int k = 0; k < NIT; ++k) { const int i = tid + k * NTHREADS; const int r = i / cpr, c8 = (i % cpr) * 8; v[k] = *(const u32x4*)(src + (size_t)r * P2W + c8); }
#pragma unroll
    for (int k = 0; k < NIT; ++k) { const int i = tid + k * NTHREADS; const int r = i / cpr, c8 = (i % cpr) * 8; *(LAS u32x4*)(dst + r * ld + c8) = v[k]; }
}
__device__ __forceinline__ void phase_mamba_states(Frame& F, const Args& a, int layer) {
    const bf16_t* P2 = WSP(bf16_t, WS_P2); const float* DT = WSP(float, WS_DT); bf16_t* MST = WSP(bf16_t, WS_MST); float* MCS = WSP(float, WS_MCS);
    LAS bf16_t* XSl = (LAS bf16_t*)F.lds; LAS bf16_t* Bl = (LAS bf16_t*)(F.lds + 67584); LAS float* wt = (LAS float*)(F.lds + 102400) + F.wave * 128;
    const int lane = F.lane, row = lane & 15, quad = lane >> 4;
    for (int u = F.bid; u < NCHUNK * 4; u += F.G) {
        const int chunk = u >> 2, g = (u >> 1) & 1, half = u & 1, row0 = chunk * 128;
        __syncthreads();
        stage_tile<256>(XSl, XS_LD, P2 + (size_t)row0 * P2W + P2_XBC + (g * 8 + half * 4) * 64, F.tid);
        stage_tile<128>(Bl, BC_LD, P2 + (size_t)row0 * P2W + P2_XBC + 1024 + g * 128, F.tid);
        const int hl = F.wave >> 1, d = F.wave & 1, h = g * 8 + half * 4 + hl;
        const float aa = -__expf(arg_in(a, I_SALOG)[(layer * 2 + d) * 16 + h]);
        { const float dt0 = DT[(size_t)(row0 + lane) * 32 + d * 16 + h], dt1 = DT[(size_t)(row0 + 64 + lane) * 32 + d * 16 + h];
          const float da0 = dt0 * aa, da1 = dt1 * aa;
          float c0 = wave_incl_scan(da0, lane); const float tot0 = bperm(c0, 63); float c1 = wave_incl_scan(da1, lane) + tot0; const float tot = bperm(c1, 63);
          if (d == 0) { wt[lane] = dt0 * __expf(tot - c0); wt[64 + lane] = dt1 * __expf(tot - c1); }
          else { wt[lane] = dt0 * __expf(c0 - da0); wt[64 + lane] = dt1 * __expf(c1 - da1); }
          if (lane == 0) MCS[(d * NCHUNK + chunk) * 16 + h] = tot; }
        __syncthreads();
        bf16_t* out = MST + ((size_t)(d * NCHUNK + chunk) * 16 + h) * 8192;
#pragma unroll 1
        for (int nh = 0; nh < 2; ++nh) {
            f32x4 acc[4][4];
#pragma unroll
            for (int i = 0; i < 4; ++i)
#pragma unroll
                for (int j = 0; j < 4; ++j) acc[i][j] = (f32x4){0.f, 0.f, 0.f, 0.f};
#pragma unroll 1
            for (int k0 = 0; k0 < 128; k0 += 32) {
                const int sb = k0 + quad * 8;
                float w8[8];
#pragma unroll
                for (int j = 0; j < 8; ++j) w8[j] = wt[sb + j];
                bf16x8 bf[4];
#pragma unroll
                for (int nt = 0; nt < 4; ++nt) {
#pragma unroll
                    for (int j = 0; j < 8; ++j) bf[nt][j] = (short)Bl[(sb + j) * BC_LD + (nh * 4 + nt) * 16 + row]; }
#pragma unroll
                for (int pt = 0; pt < 4; ++pt) { bf16x8 af;
#pragma unroll
                    for (int j = 0; j < 8; ++j) af[j] = (short)f2bf(w8[j] * bf2f(XSl[(sb + j) * XS_LD + hl * 64 + pt * 16 + row]));
#pragma unroll
                    for (int nt = 0; nt < 4; ++nt) acc[pt][nt] = MFMA16(af, bf[nt], acc[pt][nt]); }
            }
#pragma unroll
            for (int pt = 0; pt < 4; ++pt)
#pragma unroll
                for (int nt = 0; nt < 4; ++nt)
#pragma unroll
                    for (int jj = 0; jj < 4; ++jj) out[(pt * 16 + quad * 4 + jj) * 128 + (nh * 4 + nt) * 16 + row] = (bf16_t)f2bf(acc[pt][nt][jj]);
        }
    }
}
__device__ __forceinline__ void phase_mamba_scan(Frame& F) {
    bf16_t* MST = WSP(bf16_t, WS_MST); const float* MCS = WSP(float, WS_MCS);
    for (int idx = F.bid * NTHREADS + F.tid; idx < 2 * 2 * 16 * 8192; idx += F.G * NTHREADS) {
        const int e = idx & 8191, h = (idx >> 13) & 15, b = (idx >> 17) & 1, d = idx >> 18;
        float state = 0.f;
#pragma unroll 6
        for (int i = 0; i < 66; ++i) {
            int chunk; if (i < 2) chunk = 2 * b + (d == 0 ? i : 1 - i); else chunk = 4 + 64 * b + (d == 0 ? i - 2 : 65 - i);
            bf16_t* p = MST + ((size_t)(d * NCHUNK + chunk) * 16 + h) * 8192 + e;
            const float cs = bf2f(*p); const float dec = __expf(MCS[(d * NCHUNK + chunk) * 16 + h]);
            *p = (bf16_t)f2bf(state);
            state = state * dec + cs;
        }
    }
}
__device__ __forceinline__ void phase_mamba_out(Frame& F, const Args& a, int layer) {
    const bf16_t* P = WSP(bf16_t, WS_P); const bf16_t* P2 = WSP(bf16_t, WS_P2); const float* DT = WSP(float, WS_DT); const bf16_t* MST = WSP(bf16_t, WS_MST);
    bf16_t* YB = WSP(bf16_t, WS_Y) + (size_t)1 * T * 1024;
    LAS bf16_t* Cl = (LAS bf16_t*)F.lds; LAS bf16_t* Bl = (LAS bf16_t*)(F.lds + 34816); LAS bf16_t* XSl = (LAS bf16_t*)(F.lds + 69632);
    LAS float* tab = (LAS float*)(F.lds + 137216);
    for (int u = F.bid; u < NCHUNK * 4; u += F.G) {
        const int chunk = u >> 2, g = (u >> 1) & 1, half = u & 1, row0 = chunk * 128;
        __syncthreads();
        { const int tid_ = F.wave * 64 + (lane_asm() & 63);
          stage_tile<256>(XSl, XS_LD, P2 + (size_t)row0 * P2W + P2_XBC + (g * 8 + half * 4) * 64, tid_);
          stage_tile<128>(Bl, BC_LD, P2 + (size_t)row0 * P2W + P2_XBC + 1024 + g * 128, tid_);
          stage_tile<128>(Cl, BC_LD, P2 + (size_t)row0 * P2W + P2_XBC + 1280 + g * 128, tid_); }
        const int lane = lane_asm() & 63, row = lane & 15, quad = lane >> 4;
        float tot1 = 0.f;
        { const int hl = F.wave >> 1, d = F.wave & 1, h = g * 8 + half * 4 + hl;
          const float aa = -__expf(arg_in(a, I_SALOG)[(layer * 2 + d) * 16 + h]);
          const float dt0 = DT[(size_t)(row0 + lane) * 32 + d * 16 + h], dt1 = DT[(size_t)(row0 + 64 + lane) * 32 + d * 16 + h];
          const float da0 = dt0 * aa, da1 = dt1 * aa;
          float c0 = wave_incl_scan(da0, lane); const float t0 = bperm(c0, 63); float c1 = wave_incl_scan(da1, lane) + t0;
          LAS float* tb = tab + hl * 512;
          if (d == 0) { tb[lane] = c0; tb[64 + lane] = c1; tb[256 + lane] = __logf(dt0) - c0; tb[320 + lane] = __logf(dt1) - c1; }
          else { tb[128 + lane] = c0 - da0; tb[192 + lane] = c1 - da1; tb[384 + lane] = (c0 - da0) + __logf(dt0); tb[448 + lane] = (c1 - da1) + __logf(dt1); if (lane == 63) tab[2048 + hl] = c1; } }
        __syncthreads();
        { f32x4 cb[8];
#pragma unroll
          for (int st = 0; st < 8; ++st) cb[st] = (f32x4){0.f, 0.f, 0.f, 0.f};
#pragma unroll
          for (int k0 = 0; k0 < 128; k0 += 32) { const bf16x8 af = *(const LAS bf16x8*)(Cl + (F.wave * 16 + row) * BC_LD + k0 + quad * 8);
#pragma unroll
              for (int st = 0; st < 8; ++st) { const bf16x8 bfr = *(const LAS bf16x8*)(Bl + (st * 16 + row) * BC_LD + k0 + quad * 8); cb[st] = MFMA16(af, bfr, cb[st]); } }
          __syncthreads();
#pragma unroll
          for (int st = 0; st < 8; ++st)
#pragma unroll
              for (int jj = 0; jj < 4; ++jj) Bl[(F.wave * 16 + quad * 4 + jj) * BC_LD + st * 16 + row] = (bf16_t)f2bf(cb[st][jj]); }
        __syncthreads();
        const int hl = F.wave >> 1, th = F.wave & 1, h = g * 8 + half * 4 + hl;
        const LAS float* tb = tab + hl * 512; tot1 = tab[2048 + hl];
        f32x4 acc[4][4];
#pragma unroll
        for (int i = 0; i < 4; ++i)
#pragma unroll
            for (int j = 0; j < 4; ++j) acc[i][j] = (f32x4){0.f, 0.f, 0.f, 0.f};
#pragma unroll 1
        for (int k0 = 0; k0 < 128; k0 += 32) {
            const int sb = k0 + quad * 8;
            float u0s[8], u1s[8];
#pragma unroll
            for (int j = 0; j < 8; ++j) { u0s[j] = tb[256 + sb + j]; u1s[j] = tb[384 + sb + j]; }
            bf16x8 bx[4];
#pragma unroll
            for (int pt = 0; pt < 4; ++pt) {
#pragma unroll
                for (int j = 0; j < 8; ++j) bx[pt][j] = (short)XSl[(sb + j) * XS_LD + hl * 64 + pt * 16 + row]; }
#pragma unroll
            for (int tt = 0; tt < 4; ++tt) { const int t = th * 64 + tt * 16 + row; const float c0t = tb[t], e1t = tb[128 + t];
                float cbv[8]; { const u32x4 w = *(const LAS u32x4*)(Bl + t * BC_LD + sb); cbv[0] = bflo(w.x); cbv[1] = bfhi(w.x); cbv[2] = bflo(w.y); cbv[3] = bfhi(w.y); cbv[4] = bflo(w.z); cbv[5] = bfhi(w.z); cbv[6] = bflo(w.w); cbv[7] = bfhi(w.w); }
                bf16x8 af;
#pragma unroll
                for (int j = 0; j < 8; ++j) { const int s = sb + j;
                    const float f0 = s <= t ? __expf(c0t + u0s[j]) : 0.f;
                    const float f1 = s >= t ? __expf(u1s[j] - e1t) : 0.f;
                    af[j] = (short)f2bf(cbv[j] * (f0 + f1)); }
#pragma unroll
                for (int pt = 0; pt < 4; ++pt) acc[tt][pt] = MFMA16(af, bx[pt], acc[tt][pt]); }
        }
#pragma unroll 1
        for (int d = 0; d < 2; ++d) {
            const bf16_t* S = MST + ((size_t)(d * NCHUNK + chunk) * 16 + h) * 8192;
#pragma unroll 1
            for (int k0 = 0; k0 < 128; k0 += 32) {
                bf16x8 bs[4];
#pragma unroll
                for (int pt = 0; pt < 4; ++pt) bs[pt] = *(const bf16x8*)(S + (pt * 16 + row) * 128 + k0 + quad * 8);
#pragma unroll
                for (int tt = 0; tt < 4; ++tt) { const int t = th * 64 + tt * 16 + row;
                    const float sc = d == 0 ? __expf(tb[t]) : __expf(tot1 - tb[128 + t]);
                    const u32x4 cw = *(const LAS u32x4*)(Cl + t * BC_LD + k0 + quad * 8);
                    u32x4 aw; aw.x = cvt_pk_bf16(bflo(cw.x) * sc, bfhi(cw.x) * sc); aw.y = cvt_pk_bf16(bflo(cw.y) * sc, bfhi(cw.y) * sc);
                    aw.z = cvt_pk_bf16(bflo(cw.z) * sc, bfhi(cw.z) * sc); aw.w = cvt_pk_bf16(bflo(cw.w) * sc, bfhi(cw.w) * sc);
                    const bf16x8 af = __builtin_bit_cast(bf16x8, aw);
#pragma unroll
                    for (int pt = 0; pt < 4; ++pt) acc[tt][pt] = MFMA16(af, bs[pt], acc[tt][pt]); } }
        }
        const float Dh = arg_in(a, I_SD)[layer * 16 + h];
#pragma unroll
        for (int tt = 0; tt < 4; ++tt)
#pragma unroll
            for (int jj = 0; jj < 4; ++jj) { const int t = th * 64 + tt * 16 + quad * 4 + jj; const size_t r = (size_t)(row0 + t);
#pragma unroll
                for (int pt = 0; pt < 4; ++pt) { const int p = pt * 16 + row;
                    const float xs = bf2f(XSl[t * XS_LD + hl * 64 + p]); const float z = bf2f(P[r * NNG + P_Z + h * 64 + p]);
                    YB[r * 1024 + h * 64 + p] = (bf16_t)f2bf((acc[tt][pt][jj] + xs * Dh) * siluf_(z)); } }
    }
}
__device__ __forceinline__ void phase_mamba_norm(Frame& F, const Args& a, int layer) {
    bf16_t* YB = WSP(bf16_t, WS_Y) + (size_t)1 * T * 1024; const float* nw = arg_in(a, I_SNORM) + layer * 1024;
    for (int row = F.gw; row < T; row += F.NGW) {
        bf16_t* p = YB + (size_t)row * 1024 + F.lane * 16; float x[16]; { float t0[8], t1[8]; ld8bf(p, t0); ld8bf(p + 8, t1);
#pragma unroll
            for (int i = 0; i < 8; ++i) { x[i] = t0[i]; x[8 + i] = t1[i]; } }
        float s = 0.f;
#pragma unroll
        for (int i = 0; i < 16; ++i) s += x[i] * x[i];
        s = sum32(s);
        const float r = 1.f / sqrtf(s * (1.f / 512.f) + 1e-5f);
        float o0[8], o1[8];
#pragma unroll
        for (int i = 0; i < 8; ++i) { o0[i] = x[i] * r * nw[F.lane * 16 + i]; o1[i] = x[8 + i] * r * nw[F.lane * 16 + 8 + i]; }
        *(u32x4*)(WSP(unsigned char, WS_Y8B) + (size_t)row * 1024 + F.lane * 16) = (u32x4){pk4fp8(o0[0], o0[1], o0[2], o0[3]), pk4fp8(o0[4], o0[5], o0[6], o0[7]), pk4fp8(o1[0], o1[1], o1[2], o1[3]), pk4fp8(o1[4], o1[5], o1[6], o1[7])};
    }
}

__device__ __forceinline__ float dpp_f(float x, const int ctrl_sel) {
    const int xi = __builtin_bit_cast(int, x); int r;
    if (ctrl_sel == 0) r = __builtin_amdgcn_update_dpp(0, xi, 0xB1, 0xF, 0xF, false);
    else if (ctrl_sel == 1) r = __builtin_amdgcn_update_dpp(0, xi, 0x4E, 0xF, 0xF, false);
    else r = __builtin_amdgcn_update_dpp(0, xi, 0x141, 0xF, 0xF, false);
    return __builtin_bit_cast(float, r);
}
__device__ __forceinline__ float red8(float x) { x += dpp_f(x, 0); x += dpp_f(x, 1); x += dpp_f(x, 2); return x; }
__device__ __forceinline__ int rw_row(int pos, int b, int d) { return pos < CTX ? b * CTX + (d == 0 ? pos : CTX - 1 - pos) : TC + b * SEQ + (d == 0 ? pos - CTX : SEQ - 1 - (pos - CTX)); }
constexpr int RW_STEP_F = 336, RW_CH = 32, RW_CHF = RW_STEP_F * RW_CH;
struct RwOps { f32x4 w, k, b, a, r; float v; };
__device__ __forceinline__ void rw_load(RwOps& o, const LAS float* sp, const LAS float* vp) {
    o.w = *(const LAS f32x4*)(sp); o.k = *(const LAS f32x4*)(sp + 64); o.b = *(const LAS f32x4*)(sp + 128); o.a = *(const LAS f32x4*)(sp + 192); o.r = *(const LAS f32x4*)(sp + 256); o.v = *vp;
}
__device__ __forceinline__ void rw_step(f32x4& s, const RwOps& o, LAS float* yp) {
    const f32x4 tt = s * o.w + o.k * o.v;
    const f32x4 pa = s * o.a; float sa = (pa.x + pa.y) + (pa.z + pa.w); sa = sum16(sa);
    s = tt + o.b * sa;
    const f32x4 pr = s * o.r; *yp = (pr.x + pr.y) + (pr.z + pr.w);
}
struct RwRaw { unsigned ew[4], ic[4], kk[4], rr[4], kr[4], vv[4]; };
__device__ __forceinline__ void phase_rwkv_scan(Frame& F, const Args& a, int layer) {
    const bf16_t* P2 = WSP(bf16_t, WS_P2); const bf16_t* EW = WSP(bf16_t, WS_EW); const bf16_t* ICLR = WSP(bf16_t, WS_ICLR); const bf16_t* KK = WSP(bf16_t, WS_KK);
    bf16_t* YRW = WSP(bf16_t, WS_YRW);
    LAS float* ring = (LAS float*)F.lds; LAS float* ybuf = (LAS float*)(F.lds + 2 * RW_CHF * 4);
    const int lane = F.lane;
    for (int u0 = F.bid; u0 < 256; u0 += F.G) {
        const int u = (F.G == 256) ? (((u0 & 7) * 8 + (u0 >> 5)) << 2) + ((u0 >> 3) & 3) : u0;
        const int chain = u >> 2, rq = u & 3, d = chain >> 5, b = (chain >> 4) & 1, h = chain & 15;
        constexpr int NCH = (CTX + SEQ) / RW_CH;
        const int lw = F.wave - 4;
        const int tsel = lane >> 5, kp = lane & 31;
        const f32x2 ka2 = *(const f32x2*)(arg_in(a, I_RKA) + layer * 1024 + h * 64 + 2 * kp);
        auto issue = [&](RwRaw& x, int cidx) {
            const int row0 = rw_row(cidx * RW_CH, b, d), st = d == 0 ? 1 : -1;
            const int tk0 = 2 * lw + tsel;
            const unsigned* ewp = (const unsigned*)(EW + (size_t)d * T * 1024); const unsigned* icp = (const unsigned*)(ICLR + (size_t)d * T * 1024);
            const unsigned* kkp = (const unsigned*)KK; const unsigned* p2p = (const unsigned*)P2;
#pragma unroll
            for (int j = 0; j < 4; ++j) { const int row = row0 + st * (8 * j + tk0); const int o = (row * 1024 + h * 64) / 2 + kp, q = (row * P2W + P2_RKV + h * 64) / 2 + kp;
                x.ew[j] = ewp[o]; x.ic[j] = icp[o]; x.kk[j] = kkp[o]; x.rr[j] = p2p[q]; x.kr[j] = p2p[q + 512]; x.vv[j] = p2p[q + 1024 + rq * 8 - kp + (kp & 7)]; } };
        auto commit = [&](const RwRaw& x, int cidx) {
            LAS float* dst = ring + (cidx & 1) * RW_CHF;
#pragma unroll
            for (int j = 0; j < 4; ++j) { LAS float* sbase = dst + (8 * j + 2 * lw + tsel) * RW_STEP_F; LAS f32x2* s2 = (LAS f32x2*)sbase + kp;
                const f32x2 ew = {bflo(x.ew[j]), bfhi(x.ew[j])}, ic = {bflo(x.ic[j]), bfhi(x.ic[j])}, kkv = {bflo(x.kk[j]), bfhi(x.kk[j])}, rr = {bflo(x.rr[j]), bfhi(x.rr[j])}, kr = {bflo(x.kr[j]), bfhi(x.kr[j])};
                s2[0] = (f32x2){__expf(-ew.x), __expf(-ew.y)}; s2[32] = kr * ((ic - 1.f) * ka2 + 1.f); s2[64] = kkv * ic; s2[96] = -kkv; s2[128] = rr;
                if (kp < 8) s2[160] = (f32x2){bflo(x.vv[j]), bfhi(x.vv[j])}; } };
        auto flush_chunk = [&](int cidx) {
            const LAS float* yb = ybuf + (cidx & 1) * (RW_CH * 256);
            const int row0 = rw_row(cidx * RW_CH, b, d), st = d == 0 ? 1 : -1;
#pragma unroll
            for (int q = 0; q < 2; ++q) { const int i = (F.tid - 256) + 256 * q, tok = i >> 4, rr = i & 15; const LAS f32x4* pp = (const LAS f32x4*)(yb + i * 16);
                const f32x4 p0 = pp[0], p1 = pp[1], p2 = pp[2], p3 = pp[3];
                const float y = ((p0.x + p0.y) + (p0.z + p0.w)) + ((p1.x + p1.y) + (p1.z + p1.w)) + (((p2.x + p2.y) + (p2.z + p2.w)) + ((p3.x + p3.y) + (p3.z + p3.w)));
                YRW[((size_t)d * T + row0 + st * tok) * 1024 + h * 64 + rq * 16 + rr] = (bf16_t)f2bf(y); } };
        auto compute = [&](f32x4& s, int c) {
            const int rloc = lane >> 4, kq = lane & 15, r16 = F.wave * 4 + rloc;
            const LAS float* base = ring + (c & 1) * RW_CHF + kq * 4; const LAS float* vb = ring + (c & 1) * RW_CHF + 320 + r16; LAS float* yb = ybuf + (c & 1) * (RW_CH * 256) + r16 * 16 + kq;
            RwOps o0, o1, o2, o3;
            rw_load(o0, base, vb); rw_load(o1, base + RW_STEP_F, vb + RW_STEP_F); rw_load(o2, base + 2 * RW_STEP_F, vb + 2 * RW_STEP_F);
#pragma unroll
            for (int t = 0; t < RW_CH; t += 4) {
                if (t + 3 < RW_CH) rw_load(o3, base + (t + 3) * RW_STEP_F, vb + (t + 3) * RW_STEP_F);
                rw_step(s, o0, yb + t * 256);
                if (t + 4 < RW_CH) rw_load(o0, base + (t + 4) * RW_STEP_F, vb + (t + 4) * RW_STEP_F);
                rw_step(s, o1, yb + (t + 1) * 256);
                if (t + 5 < RW_CH) rw_load(o1, base + (t + 5) * RW_STEP_F, vb + (t + 5) * RW_STEP_F);
                rw_step(s, o2, yb + (t + 2) * 256);
                if (t + 6 < RW_CH) rw_load(o2, base + (t + 6) * RW_STEP_F, vb + (t + 6) * RW_STEP_F);
                rw_step(s, o3, yb + (t + 3) * 256);
            } };
        __syncthreads();
        f32x4 s = {0.f, 0.f, 0.f, 0.f};
        if (F.wave >= 4) {
            RwRaw ra, rb;
            issue(ra, 0); commit(ra, 0); issue(ra, 1);
            __syncthreads();
            for (int c = 0; c < NCH; c += 2) {
                if (c + 2 < NCH) issue(rb, c + 2);
                if (c > 0) flush_chunk(c - 1);
                commit(ra, c + 1);
                __syncthreads();
                if (c + 3 < NCH) issue(ra, c + 3);
                flush_chunk(c);
                if (c + 2 < NCH) commit(rb, c + 2);
                __syncthreads();
            }
            flush_chunk(NCH - 1);
        } else {
            __syncthreads();
            for (int c = 0; c < NCH; c += 2) { compute(s, c); __syncthreads(); compute(s, c + 1); __syncthreads(); }
        }
    }
}
__device__ __forceinline__ void phase_rwkv_out(Frame& F, const Args& a, int layer) {
    const bf16_t* P2 = WSP(bf16_t, WS_P2); const bf16_t* ICLR = WSP(bf16_t, WS_ICLR); const bf16_t* YRW = WSP(bf16_t, WS_YRW); const bf16_t* GG = WSP(bf16_t, WS_GG);
    unsigned char* YD = WSP(unsigned char, WS_Y8D);
    const float* lng = arg_in(a, I_RLNG) + layer * 1024; const float* lnb = arg_in(a, I_RLNB) + layer * 1024; const float* rk = arg_in(a, I_RRK) + layer * 1024; const float* kav = arg_in(a, I_RKA) + layer * 1024;
    for (int row = F.gw; row < T; row += F.NGW) {
        const int c = F.lane * 16; const size_t o = (size_t)row * 1024 + c;
        float y[16], r[16], k[16], v[16], i0[16], i1[16], g[16];
#define LD16(dst, ptr) do { float t0_[8], t1_[8]; ld8bf((ptr), t0_); ld8bf((ptr) + 8, t1_); _Pragma("unroll") for (int i_ = 0; i_ < 8; ++i_) { dst[i_] = t0_[i_]; dst[8 + i_] = t1_[i_]; } } while (0)
        LD16(y, YRW + o); LD16(r, YRW + (size_t)T * 1024 + o);
#pragma unroll
        for (int i = 0; i < 16; ++i) y[i] += r[i];
        const bf16_t* p2 = P2 + (size_t)row * P2W + P2_RKV + c;
        LD16(r, p2); LD16(k, p2 + 1024); LD16(v, p2 + 2048); LD16(i0, ICLR + o); LD16(i1, ICLR + (size_t)T * 1024 + o); LD16(g, GG + o);
#undef LD16
        float s = 0.f, bsum = 0.f;
#pragma unroll
        for (int i = 0; i < 16; ++i) { s += y[i]; const float ka = kav[c + i]; bsum += r[i] * k[i] * rk[c + i] * ((1.f + (i0[i] - 1.f) * ka) + (1.f + (i1[i] - 1.f) * ka)); }
        s = sum4(s); bsum = sum4(bsum);
        const float mu = s * (1.f / 64.f); float q = 0.f;
#pragma unroll
        for (int i = 0; i < 16; ++i) { const float dd = y[i] - mu; q += dd * dd; }
        q = sum4(q);
        const float rstd = 1.f / sqrtf(q * (1.f / 64.f) + 64e-5f);
        float o0[8], o1[8];
#pragma unroll
        for (int i = 0; i < 8; ++i) { o0[i] = ((y[i] - mu) * rstd * lng[c + i] + lnb[c + i] + bsum * v[i]) * g[i];
            o1[i] = ((y[8 + i] - mu) * rstd * lng[c + 8 + i] + lnb[c + 8 + i] + bsum * v[8 + i]) * g[8 + i]; }
        *(u32x4*)(YD + o) = (u32x4){pk4fp8(o0[0], o0[1], o0[2], o0[3]), pk4fp8(o0[4], o0[5], o0[6], o0[7]), pk4fp8(o1[0], o1[1], o1[2], o1[3]), pk4fp8(o1[4], o1[5], o1[6], o1[7])};
    }
}

constexpr int FFT_N = 16384;
__device__ __forceinline__ int fswz(int i) { return i ^ (((i >> 5) & 3) << 2) ^ (((i >> 6) & 1) << 4); }
__device__ __forceinline__ f32x2 cmul(f32x2 a, f32x2 b) { return (f32x2){a.x * b.x - a.y * b.y, a.x * b.y + a.y * b.x}; }
template <bool INV>
__device__ __forceinline__ void fft_passes(LAS f32x2* X, int tid) {
#pragma unroll 1
    for (int st = 0; st < 7; ++st) {
        const int lq = INV ? 2 * st : 12 - 2 * st;
        const int q = 1 << lq;
        __syncthreads();
#pragma unroll 2
        for (int mm = 0; mm < 8; ++mm) { const int uu = tid + 512 * mm; const int k = uu & (q - 1), blk = uu >> lq; const int i0 = (blk << (lq + 2)) + k;
            const int p0 = fswz(i0), p1 = fswz(i0 + q), p2 = fswz(i0 + 2 * q), p3 = fswz(i0 + 3 * q);
            f32x2 a0 = X[p0], a1 = X[p1], a2 = X[p2], a3 = X[p3];
            const float fr = (float)k / (float)(4 * q);
            const float cs = __builtin_amdgcn_cosf(fr), sn = __builtin_amdgcn_sinf(fr);
            const f32x2 w1 = INV ? (f32x2){cs, sn} : (f32x2){cs, -sn}; const f32x2 w2 = cmul(w1, w1), w3 = cmul(w2, w1);
            if (!INV) {
                const f32x2 t0 = a0 + a2, t1 = a0 - a2, t2 = a1 + a3, t3 = a1 - a3;
                const f32x2 b0 = t0 + t2, b2 = t0 - t2, b1 = (f32x2){t1.x + t3.y, t1.y - t3.x}, b3 = (f32x2){t1.x - t3.y, t1.y + t3.x};
                X[p0] = b0; X[p1] = cmul(b1, w1); X[p2] = cmul(b2, w2); X[p3] = cmul(b3, w3);
            } else {
                a1 = cmul(a1, w1); a2 = cmul(a2, w2); a3 = cmul(a3, w3);
                const f32x2 u0 = a0 + a2, u1 = a0 - a2, u2 = a1 + a3, u3 = a1 - a3;
                X[p0] = u0 + u2; X[p2] = u0 - u2; X[p1] = (f32x2){u1.x - u3.y, u1.y + u3.x}; X[p3] = (f32x2){u1.x + u3.y, u1.y - u3.x};
            } }
    }
    __syncthreads();
}
__device__ __forceinline__ void phase_hyena_fft(Frame& F, const Args& a, int layer, bool dry = false) {
    const bf16_t* FILT = WSP(bf16_t, WS_FILT); float* VT = WSP(float, WS_VT); const float* hyd = arg_in(a, I_HD) + layer * 1024;
    LAS f32x2* X = (LAS f32x2*)F.lds;
    for (int c = F.bid; c < 1024; c += F.G) {
        __syncthreads();
        const int tid = F.wave * 64 + (lane_asm() & 63), i0 = tid * 16;
        { const bf16_t* hf = FILT + (size_t)c * 2 * SEQ; const bf16_t* hb = hf + SEQ;
          float f[16], g[16]; ld8bf(hf + i0, *(float(*)[8])&f[0]); ld8bf(hf + i0 + 8, *(float(*)[8])&f[8]);
          ld8bf(hb + (SEQ - 16 - i0), *(float(*)[8])&g[0]); ld8bf(hb + (SEQ - 8 - i0), *(float(*)[8])&g[8]);
#pragma unroll
          for (int j = 0; j < 16; ++j) X[fswz(i0 + j)] = (f32x2){f[j], 0.f};
#pragma unroll
          for (int j = 0; j < 16; ++j) { const int pos = SEQ + i0 + 1 + j; if (pos < FFT_N) X[fswz(pos)] = (f32x2){g[15 - j], 0.f}; }
          if (tid == 0) { float zz = 0.f; asm volatile("" : "+v"(zz)); X[fswz(SEQ)] = (f32x2){zz, zz}; } }
        fft_passes<false>(X, F.tid);
        f32x2 Kh[32];
#pragma unroll
        for (int j = 0; j < 32; ++j) Kh[j] = X[fswz(F.tid + 512 * j)];
        __syncthreads();
        float* v0 = VT + (size_t)c * 2 * SEQ; float* v1 = v0 + SEQ;
        { f32x4 a0[4], a1[4];
#pragma unroll
          for (int q = 0; q < 4; ++q) { a0[q] = *(const f32x4*)(v0 + i0 + 4 * q); a1[q] = *(const f32x4*)(v1 + i0 + 4 * q); }
#pragma unroll
          for (int q = 0; q < 4; ++q) { X[fswz(i0 + 4 * q)] = (f32x2){a0[q].x, a1[q].x}; X[fswz(i0 + 4 * q + 1)] = (f32x2){a0[q].y, a1[q].y}; X[fswz(i0 + 4 * q + 2)] = (f32x2){a0[q].z, a1[q].z}; X[fswz(i0 + 4 * q + 3)] = (f32x2){a0[q].w, a1[q].w}; }
          { float zz = 0.f; asm volatile("" : "+v"(zz));
#pragma unroll
          for (int j = 0; j < 16; ++j) X[fswz(SEQ + i0 + j)] = (f32x2){zz, zz}; } }
        fft_passes<false>(X, F.tid);
#pragma unroll
        for (int j = 0; j < 32; ++j) { const int p = fswz(F.tid + 512 * j); X[p] = cmul(X[p], Kh[j]); }
        fft_passes<true>(X, F.tid);
        const float dc = hyd[c];
        { f32x4 a0[4], a1[4];
#pragma unroll
          for (int q = 0; q < 4; ++q) { a0[q] = *(const f32x4*)(v0 + i0 + 4 * q); a1[q] = *(const f32x4*)(v1 + i0 + 4 * q); }
#pragma unroll
          for (int q = 0; q < 4; ++q) { const f32x2 r0 = X[fswz(i0 + 4 * q)], r1 = X[fswz(i0 + 4 * q + 1)], r2 = X[fswz(i0 + 4 * q + 2)], r3 = X[fswz(i0 + 4 * q + 3)];
              const f32x4 o0 = (f32x4){r0.x, r1.x, r2.x, r3.x} * (1.f / FFT_N) + a0[q] * dc, o1 = (f32x4){r0.y, r1.y, r2.y, r3.y} * (1.f / FFT_N) + a1[q] * dc;
              if (!dry) { *(f32x4*)(v0 + i0 + 4 * q) = o0; *(f32x4*)(v1 + i0 + 4 * q) = o1; } } }
    }
}
__device__ __forceinline__ void phase_hyena_out(Frame& F, const Args& a, int layer) {
    const float* VT = WSP(float, WS_VT); const bf16_t* P2 = WSP(bf16_t, WS_P2); bf16_t* YC = WSP(bf16_t, WS_Y) + (size_t)2 * T * 1024;
    LAS float* tl = (LAS float*)F.lds;
    for (int u = F.bid; u < (TL / 64) * 4; u += F.G) {
        const int tb = u >> 2, cb = u & 3; const int row0 = TC + tb * 64; const int b = (row0 - TC) >> 13, t0 = (row0 - TC) & (SEQ - 1);
        __syncthreads();
        for (int p = 0; p < 8; ++p) { const int cl = p * 32 + (F.tid >> 4), q = F.tid & 15;
            const f32x4 v = *(const f32x4*)(VT + ((size_t)(cb * 256 + cl) * 2 + b) * SEQ + t0 + 4 * q);
            tl[cl * 65 + 4 * q] = v.x; tl[cl * 65 + 4 * q + 1] = v.y; tl[cl * 65 + 4 * q + 2] = v.z; tl[cl * 65 + 4 * q + 3] = v.w; }
        __syncthreads();
        const int cl = F.tid & 255, th = F.tid >> 8;
        for (int i = 0; i < 32; ++i) { const int tl_ = th * 32 + i; const size_t row = (size_t)(row0 + tl_);
            const float x0 = bf2f(P2[row * P2W + P2_X0 + cb * 256 + cl]);
            YC[row * 1024 + cb * 256 + cl] = (bf16_t)f2bf(tl[cl * 65 + tl_] * x0); }
    }
    const float* VC = WSP(float, WS_VC); const float* FC = WSP(float, WS_FILTC); const float* hyd = arg_in(a, I_HD) + layer * 1024;
    for (int it = F.gw; it < 2 * 16 * 16; it += F.NGW) {
        const int b = it >> 8, cbk = (it >> 4) & 15, tb = it & 15; const int c = cbk * 64 + F.lane, t0 = tb * 16;
        const float* vb = VC + (size_t)b * CTX * 1024 + c; const float* fc = FC + c;
        float acc[16];
#pragma unroll
        for (int i = 0; i < 16; ++i) acc[i] = 0.f;
#pragma unroll 1
        for (int sb = 0; sb < 16; ++sb) { const int s0 = sb * 16, dl = t0 - s0;
            float f[31], v[16];
#pragma unroll
            for (int j = 0; j < 31; ++j) { const int lag = dl + j - 15; f[j] = lag >= 0 ? fc[(size_t)lag * 2048] : fc[(size_t)(-lag) * 2048 + 1024]; }
#pragma unroll
            for (int j = 0; j < 16; ++j) v[j] = vb[(size_t)(s0 + j) * 1024];
#pragma unroll
            for (int i = 0; i < 16; ++i)
#pragma unroll
                for (int j = 0; j < 16; ++j) acc[i] += f[i - j + 15] * v[j]; }
#pragma unroll
        for (int i = 0; i < 16; ++i) { const int t = t0 + i; const size_t row = (size_t)(b * CTX + t);
            const float x0 = bf2f(P2[row * P2W + P2_X0 + c]);
            YC[row * 1024 + c] = (bf16_t)f2bf((acc[i] + vb[(size_t)t * 1024] * hyd[c]) * x0); }
    }
}

__device__ __forceinline__ void phase_ln1(Frame& F, const Args& a, int layer) {
    const float* mod = (const float*)(F.ws + WS_CTL) + CW_MOD + (size_t)layer * 3 * 6 * DM;
    const float* YM = WSP(float, WS_YMIX); float* XS = WSP(float, WS_XS); unsigned* H2 = WSP(unsigned, WS_H2); float* AFF = WSP(float, WS_AFF); int* INV = WSP(int, WS_INV);
    const float* g1w = arg_in(a, I_LN1G) + layer * DM; const float* b1w = arg_in(a, I_LN1B) + layer * DM; const float* wr = arg_in(a, I_WROUTER) + (size_t)layer * DM * NEXP;
    LAS float* wrT = (LAS float*)F.lds;
    __syncthreads();
    for (int i = F.tid; i < DM * NEXP; i += NTHREADS) { const int c = i >> 4, e = i & 15; wrT[e * DM + c] = wr[i]; }
    __syncthreads();
    int* PTOK = WSP(int, WS_PTOK); float* PG = WSP(float, WS_PGATE);
    for (int i = F.bid * NTHREADS + F.tid; i < NPAIR; i += F.G * NTHREADS) { PTOK[i] = -1; PG[i] = 0.f; }
    for (int row = F.gw; row < T; row += F.NGW) {
        const f32x4* xr = (const f32x4*)x_src_row(a, F, layer, row) + F.lane; const f32x4* yr = (const f32x4*)(YM + (size_t)row * DM) + F.lane;
        const float* m = mod + (size_t)row_modidx(row) * 6 * DM;
        f32x4 v[8];
#pragma unroll
        for (int j = 0; j < 8; ++j) { const int c = 4 * (64 * j + F.lane); v[j] = xr[64 * j] * ALPHA + *(const f32x4*)(m + 2 * DM + c) * yr[64 * j]; }
        float mean, rstd; row_stats(v, mean, rstd, 1e-6f);
        f32x4* xo = (f32x4*)(XS + (size_t)row * DM) + F.lane;
#pragma unroll
        for (int j = 0; j < 8; ++j) { const int c = 4 * (64 * j + F.lane); v[j] = (v[j] - mean) * rstd * *(const f32x4*)(g1w + c) + *(const f32x4*)(b1w + c); xo[64 * j] = v[j]; }
        row_stats(v, mean, rstd, 1e-6f);
        unsigned* ho = H2 + (size_t)row * (DM / 4) + F.lane;
        float lg[16];
#pragma unroll
        for (int e = 0; e < 16; ++e) lg[e] = 0.f;
#pragma unroll
        for (int j = 0; j < 8; ++j) { const int c = 4 * (64 * j + F.lane);
            const f32x4 y = (v[j] - mean) * rstd * (*(const f32x4*)(m + 4 * DM + c) + 1.f) + *(const f32x4*)(m + 3 * DM + c);
            ho[64 * j] = pk4fp8(y.x, y.y, y.z, y.w);
#pragma unroll
            for (int e = 0; e < 16; ++e) { const f32x4 ww = *(const LAS f32x4*)(wrT + e * DM + c); lg[e] += (y.x * ww.x + y.y * ww.y) + (y.z * ww.z + y.w * ww.w); } }
        float mx = -1e30f;
#pragma unroll
        for (int e = 0; e < 16; ++e) { lg[e] = wave_sum(lg[e]); mx = fmaxf(mx, lg[e]); }
        float den = 0.f;
#pragma unroll
        for (int e = 0; e < 16; ++e) { lg[e] = __expf(lg[e] - mx); den += lg[e]; }
        float mine = 0.f;
#pragma unroll
        for (int e = 0; e < 16; ++e) mine = (F.lane == e) ? lg[e] : mine;
        if (F.lane < 16) { AFF[(size_t)row * 16 + F.lane] = mine / den; INV[(size_t)row * 16 + F.lane] = -1; }
    }
}
__device__ __forceinline__ void phase_topk(Frame& F, bool lat_only) {
    const float* AFF = WSP(float, WS_AFF); int* INV = WSP(int, WS_INV); int* PTOK = WSP(int, WS_PTOK); float* PG = WSP(float, WS_PGATE);
    LAS unsigned* vals = (LAS unsigned*)F.lds; LAS unsigned* hist = vals + 8192; LAS unsigned* ctl = hist + 256;
    for (int u = F.bid + (lat_only ? 32 : 0); u < 64; u += F.G) {
        const int s = u >> 4, e = u & 15, rs = seg_start(s), n = seg_len(s), cap = s < 2 ? CAP_C : CAP_L;
        __syncthreads();
        for (int i = F.tid; i < n; i += NTHREADS) vals[i] = __builtin_bit_cast(unsigned, AFF[(size_t)(rs + i) * 16 + e]);
        if (F.tid == 0) { ctl[0] = 0u; ctl[1] = (unsigned)cap; ctl[2] = 0u; ctl[3] = 0u; }
        unsigned mask = 0u;
        for (int shift = 24; shift >= 0; shift -= 8) {
            if (F.tid < 256) hist[F.tid] = 0u;
            __syncthreads();
            const unsigned prefix = ctl[0];
            for (int i = F.tid; i < n; i += NTHREADS) { const unsigned b = vals[i]; if ((b & mask) == prefix) __hip_atomic_fetch_add(&hist[(b >> shift) & 255u], 1u, __ATOMIC_RELAXED, __HIP_MEMORY_SCOPE_WORKGROUP); }
            __syncthreads();
            if (F.wave == 0) {
                const unsigned rem = ctl[1]; unsigned cnt[4]; float tot = 0.f;
#pragma unroll
                for (int j = 0; j < 4; ++j) { cnt[j] = hist[255 - (4 * F.lane + j)]; tot += (float)cnt[j]; }
                const unsigned incl = (unsigned)(wave_incl_scan(tot, F.lane) + 0.5f), excl = incl - (unsigned)(tot + 0.5f);
                if (excl < rem && rem <= incl) { unsigned cum = excl; int j = 0;
#pragma unroll
                    for (int q = 0; q < 3; ++q) { if (j == q && cum + cnt[q] < rem) { cum += cnt[q]; j = q + 1; } }
                    ctl[1] = rem - cum; ctl[0] = prefix | ((unsigned)(255 - (4 * F.lane + j)) << shift); } }
            mask |= 255u << shift;
            __syncthreads();
        }
        const unsigned thr = ctl[0], rem = ctl[1]; const unsigned ngt = (unsigned)cap - rem;
        const int pbase = s < 2 ? NBATCH * NEXP * CAP_L + e * 256 + s * CAP_C : ((s - 2) * NEXP + e) * CAP_L;
        for (int i = F.tid; i < n; i += NTHREADS) { const unsigned b = vals[i]; int slot = -1;
            if (b > thr) slot = (int)__hip_atomic_fetch_add(&ctl[2], 1u, __ATOMIC_RELAXED, __HIP_MEMORY_SCOPE_WORKGROUP);
            else if (b == thr) { const unsigned q = __hip_atomic_fetch_add(&ctl[3], 1u, __ATOMIC_RELAXED, __HIP_MEMORY_SCOPE_WORKGROUP); if (q < rem) slot = (int)(ngt + q); }
            if (slot >= 0) { const int pair = pbase + slot, row = rs + i; PTOK[pair] = row; PG[pair] = __builtin_bit_cast(float, b); INV[(size_t)row * 16 + e] = pair; } }
    }
}
__device__ __forceinline__ void phase_gather(Frame& F) {
    const unsigned char* H2 = WSP(unsigned char, WS_H2); unsigned char* XG = WSP(unsigned char, WS_XG); unsigned char* HID = WSP(unsigned char, WS_HID); const int* PTOK = WSP(int, WS_PTOK);
    for (int p0 = F.gw * 64; p0 < NPAIR; p0 += F.NGW * 64) {
        const int mytok = PTOK[p0 + F.lane];
        unsigned zz = 0u; asm volatile("" : "+v"(zz));
#pragma unroll 1
        for (int q = 0; q < 64; q += 4) {
            u32x4 v[4][2]; int tk[4];
#pragma unroll
            for (int j = 0; j < 4; ++j) { tk[j] = __builtin_amdgcn_readlane(mytok, q + j); const u32x4* src = (const u32x4*)(H2 + (size_t)(tk[j] >= 0 ? tk[j] : 0) * DM) + F.lane; v[j][0] = src[0]; v[j][1] = src[64]; }
#pragma unroll
            for (int j = 0; j < 4; ++j) { const int p = p0 + q + j; u32x4* dst = (u32x4*)(XG + (size_t)p * DM) + F.lane; const bool ok = tk[j] >= 0;
                dst[0] = ok ? v[j][0] : (u32x4){zz, zz, zz, zz}; dst[64] = ok ? v[j][1] : (u32x4){zz, zz, zz, zz};
                if (F.lane < 8) *((u32x4*)(HID + (size_t)p * EFFP + EFF) + F.lane) = (u32x4){zz, zz, zz, zz}; } }
    }
}
__device__ __forceinline__ void phase_ln2(Frame& F, const Args& a, int layer) {
    const float* mod = (const float*)(F.ws + WS_CTL) + CW_MOD + (size_t)layer * 3 * 6 * DM;
    float* XS = WSP(float, WS_XS); const bf16_t* YE = WSP(bf16_t, WS_YE); const int* INV = WSP(int, WS_INV); const float* PG = WSP(float, WS_PGATE);
    const float* g2w = arg_in(a, I_LN2G) + layer * DM; const float* b2w = arg_in(a, I_LN2B) + layer * DM;
    for (int row = F.gw; row < T; row += F.NGW) {
        f32x4* xr = (f32x4*)(XS + (size_t)row * DM) + F.lane; const float* m = mod + (size_t)row_modidx(row) * 6 * DM;
        f32x4 mo[8];
#pragma unroll
        for (int j = 0; j < 8; ++j) mo[j] = (f32x4){0.f, 0.f, 0.f, 0.f};
        const int myinv = F.lane < 16 ? INV[(size_t)row * 16 + F.lane] : -1;
        unsigned long long sel = __ballot(myinv >= 0);
        while (sel) {
            const int e0 = __builtin_ctzll(sel); sel &= sel - 1; const bool two = sel != 0; const int e1 = two ? __builtin_ctzll(sel) : e0; if (two) sel &= sel - 1;
            const int p0 = __builtin_amdgcn_readlane(myinv, e0), p1 = __builtin_amdgcn_readlane(myinv, e1);
            const u32x2* y0 = (const u32x2*)(YE + (size_t)p0 * DM) + F.lane; const u32x2* y1 = (const u32x2*)(YE + (size_t)p1 * DM) + F.lane;
            const float g0 = PG[p0], g1 = two ? PG[p1] : 0.f;
            u32x2 w0[8], w1[8];
#pragma unroll
            for (int j = 0; j < 8; ++j) { w0[j] = y0[64 * j]; w1[j] = y1[64 * j]; }
#pragma unroll
            for (int j = 0; j < 8; ++j) mo[j] += (f32x4){bflo(w0[j].x), bfhi(w0[j].x), bflo(w0[j].y), bfhi(w0[j].y)} * g0 + (f32x4){bflo(w1[j].x), bfhi(w1[j].x), bflo(w1[j].y), bfhi(w1[j].y)} * g1;
        }
        f32x4 v[8];
#pragma unroll
        for (int j = 0; j < 8; ++j) { const int c = 4 * (64 * j + F.lane); v[j] = xr[64 * j] * ALPHA + *(const f32x4*)(m + 5 * DM + c) * mo[j]; }
        float mean, rstd; row_stats(v, mean, rstd, 1e-6f);
#pragma unroll
        for (int j = 0; j < 8; ++j) { const int c = 4 * (64 * j + F.lane); v[j] = (v[j] - mean) * rstd * *(const f32x4*)(g2w + c) + *(const f32x4*)(b2w + c); xr[64 * j] = v[j]; }
        if (layer == DEPTH - 1) { if (row >= TC) { f32x4* o = (f32x4*)(a.out + (size_t)(row - TC) * DM) + F.lane;
#pragma unroll
            for (int j = 0; j < 8; ++j) o[64 * j] = v[j]; } }
        else {
            row_stats(v, mean, rstd, 1e-6f);
            const float* m1 = m + (size_t)3 * 6 * DM;
            bf16_t* H = WSP(bf16_t, WS_H); unsigned* H8 = WSP(unsigned, WS_H8);
            u32x2* o = (u32x2*)(H + (size_t)row * DM) + F.lane; unsigned* o8 = H8 + (size_t)row * (DM / 4) + F.lane;
#pragma unroll
            for (int j = 0; j < 8; ++j) { const int c = 4 * (64 * j + F.lane); const f32x4 sh = *(const f32x4*)(m1 + c), sc = *(const f32x4*)(m1 + DM + c);
                const f32x4 y = (v[j] - mean) * rstd * (sc + 1.f) + sh; u32x2 w; w.x = pk2(y.x, y.y); w.y = pk2(y.z, y.w); o[64 * j] = w; o8[64 * j] = pk4fp8(y.x, y.y, y.z, y.w); } }
    }
}

constexpr int LDS_BYTES = 153600, MISC_OFF = LDS_BYTES - 64;
constexpr int NPL = 16, NPHASE = 1 + DEPTH * NPL;

__global__ void __launch_bounds__(NTHREADS, 2) fwd_kernel(Args args) {
    extern __shared__ __attribute__((aligned(16))) unsigned char lds_raw[];
    Frame F;
    F.lds = (LAS unsigned char*)lds_raw;
    F.tid = threadIdx.x; F.lane = F.tid & 63; F.wave = __builtin_amdgcn_readfirstlane(F.tid >> 6); const int wave0 = F.wave;
    F.G = gridDim.x; F.bid = blockIdx.x; F.gw = F.bid * NWAVES + F.wave; F.NGW = F.G * NWAVES; F.ws = args.ws;
    volatile LAS unsigned* misc = (volatile LAS unsigned*)(F.lds + MISC_OFF);
    if (F.tid < 16) misc[F.tid] = 0u;
    __syncthreads();
    const int lo = args.ph_lo, hi = args.ph_hi;
    XcdBarrier bar; bar.bar = (unsigned*)(F.ws + WS_CTL) + CW_BAR; bar.x = 0; bar.st = nullptr;
    const bool multi = (hi - lo) > 1;
    if (multi) bar = xcd_barrier_post((unsigned*)(F.ws + WS_CTL) + CW_BAR, misc);
#ifndef ONLY_PHASE
#define ONLY_PHASE -1
#endif
#define PON(r) (ONLY_PHASE < 0 || ONLY_PHASE == (r))
#ifndef REP_MASK
#define REP_MASK 0
#endif
#define REP(b) ((REP_MASK >> (b)) & 1)
#define REOPQ() do { F.ws = opq(args.ws); F.lane = lane_asm() & 63; F.wave = opqs(wave0) & 7; F.tid = F.wave * 64 + F.lane; F.G = opqs(gridDim.x); F.bid = opqs(blockIdx.x); F.gw = F.bid * NWAVES + F.wave; F.NGW = F.G * NWAVES; } while (0)
#define IN(k) (lo <= (k) && (k) < hi)
#define SEAM(k) do { if (IN(k) && IN((k) + 1)) { XcdBarrier bb_ = bar; bb_.x = (unsigned)opqs((int)bar.x); xcd_barrier(bb_); } } while (0)
    if (PON(100) && IN(0)) { F.ws = opq(args.ws); F.lane = lane_asm() & 63; F.wave = opqs(wave0) & 7; F.tid = F.wave * 64 + F.lane; F.G = opqs(gridDim.x); F.bid = opqs(blockIdx.x); F.gw = F.bid * NWAVES + F.wave; F.NGW = F.G * NWAVES; { p0_weights(F, args); __syncthreads(); REOPQ(); p0_mod(F, args); __syncthreads(); REOPQ(); phase_hdn(F, args, 0); REOPQ(); phase_hdn(F, args, 1); __syncthreads(); } }
    SEAM(0);
#pragma unroll 1
    for (int layer = 0; layer < DEPTH; ++layer) {
        const int pb = 1 + layer * NPL; const bool lat_only = (layer == DEPTH - 1);
        if (PON(0) && IN(pb + 0)) { F.ws = opq(args.ws); F.lane = lane_asm() & 63; F.wave = opqs(wave0) & 7; F.tid = F.wave * 64 + F.lane; F.G = opqs(gridDim.x); F.bid = opqs(blockIdx.x); F.gw = F.bid * NWAVES + F.wave; F.NGW = F.G * NWAVES; if (layer == 0) phase_modln(F, args, layer); __syncthreads(); }
        SEAM(pb + 0);
        if (PON(1) && IN(pb + 1)) { F.ws = opq(args.ws); F.lane = lane_asm() & 63; F.wave = opqs(wave0) & 7; F.tid = F.wave * 64 + F.lane; F.G = opqs(gridDim.x); F.bid = opqs(blockIdx.x); F.gw = F.bid * NWAVES + F.wave; F.NGW = F.G * NWAVES;
            { pg8::Gemm g{WSP(bf16_t, WS_H), WSP(bf16_t, WS_WIN + layer * SZ_WIN), DM, DM, DM}; pg8::StaticOrder S; S.init(66, 13, F.G, F.bid, 0, 14);
              EpiBf16 E{WSP(bf16_t, WS_P), NNG, nullptr, 0, 0, 1.f, 1 << 30, 0};
              pg8::gemm_phase(F.lds, g, S, E, F.tid); }
            { pg8::Gemm g{WSP(bf16_t, WS_H8), WSP(bf16_t, WS_WIN + layer * SZ_WIN + WIN8P_OFF), DM / 2, DM / 2, DM / 2}; pg8::StaticOrder S; S.init(66, 27, F.G, (F.bid + 90) & 255);
              EpiBf16 E{WSP(bf16_t, WS_P), NNG, nullptr, 0, 0, 1.f / 64.f, 14, 13};
              pg8::gemm_phase<EpiBf16, pg8::StaticOrder, true>(F.lds, g, S, E, F.tid); }
        }
        SEAM(pb + 1);
        if (PON(2) && IN(pb + 2)) { F.ws = opq(args.ws); F.lane = lane_asm() & 63; F.wave = opqs(wave0) & 7; F.tid = F.wave * 64 + F.lane; F.G = opqs(gridDim.x); F.bid = opqs(blockIdx.x); F.gw = F.bid * NWAVES + F.wave; F.NGW = F.G * NWAVES; { phase_prep(F, args, layer); REOPQ(); phase_filt(F, args, layer); __syncthreads(); } }
        SEAM(pb + 2);
        if (PON(3) && IN(pb + 3)) { F.ws = opq(args.ws); F.lane = lane_asm() & 63; F.wave = opqs(wave0) & 7; F.tid = F.wave * 64 + F.lane; F.G = opqs(gridDim.x); F.bid = opqs(blockIdx.x); F.gw = F.bid * NWAVES + F.wave; F.NGW = F.G * NWAVES;
#if !defined(T3) || T3 == 0
            { pg8::Gemm g{WSP(bf16_t, WS_CQ8), WSP(bf16_t, WS_WQ + layer * SZ_WQ), 512, 256, 256}; pg8::StaticOrder S; S.init(lat_only ? 64 : 66, 6, F.G, F.bid, lat_only ? 2 : 0);
              EpiBf16 E{WSP(bf16_t, WS_Q), 1536, WSP(float, WS_RS), 2, 0, 1.f / 16.f, 1 << 30, 0}; pg8::gemm_phase<EpiBf16, pg8::StaticOrder, true>(F.lds, g, S, E, F.tid); }
#endif
#if !defined(T3) || T3 == 1
            { pg8::Gemm g{WSP(bf16_t, WS_CQ8) + 256, WSP(bf16_t, WS_WKV + layer * SZ_WKV), 512, 256, 256}; pg8::StaticOrder S; S.init(66, 8, F.G, (F.bid + 140) & 255);
              EpiBf16 E{WSP(bf16_t, WS_KV), 2048, WSP(float, WS_RS) + 1, 2, 0, 1.f / 16.f, 1 << 30, 0}; pg8::gemm_phase<EpiBf16, pg8::StaticOrder, true>(F.lds, g, S, E, F.tid); }
#endif
#if !defined(T3) || T3 == 2
            { pg8::Gemm g{WSP(bf16_t, WS_ALORA), WSP(bf16_t, WS_WLORA + layer * SZ_WLORA), 256, 256, 256}; pg8::StaticOrder S; S.init(66, 20, F.G, (F.bid + 156) & 255);
              EpiLora E{WSP(bf16_t, WS_EW), WSP(bf16_t, WS_ICLR), WSP(bf16_t, WS_GG), arg_in(args, I_RW0) + layer * 2048, arg_in(args, I_RA0) + layer * 2048, 1.f / 8.f}; pg8::gemm_phase<EpiLora, pg8::StaticOrder, true>(F.lds, g, S, E, F.tid); }
            REOPQ(); phase_mamba_states(F, args, layer); __syncthreads();
#endif
        }
        SEAM(pb + 3);
        SEAM(pb + 4);
        if (PON(5) && IN(pb + 5)) { F.ws = opq(args.ws); F.lane = lane_asm() & 63; F.wave = opqs(wave0) & 7; F.tid = F.wave * 64 + F.lane; F.G = opqs(gridDim.x); F.bid = opqs(blockIdx.x); F.gw = F.bid * NWAVES + F.wave; F.NGW = F.G * NWAVES;
#if !defined(T5) || T5 == 0
            phase_rwkv_scan(F, args, layer); __syncthreads();
#endif
#if !defined(T5) || T5 == 1
            REOPQ(); phase_attn(F, lat_only);
#endif
#if !defined(T5) || T5 == 2
            REOPQ(); phase_hyena_fft(F, args, layer);
#endif
#if !defined(T5) || T5 == 3
            REOPQ(); phase_mamba_scan(F); __syncthreads();
#endif
        }
        SEAM(pb + 5);
        if (PON(6) && IN(pb + 6)) { F.ws = opq(args.ws); F.lane = lane_asm() & 63; F.wave = opqs(wave0) & 7; F.tid = F.wave * 64 + F.lane; F.G = opqs(gridDim.x); F.bid = opqs(blockIdx.x); F.gw = F.bid * NWAVES + F.wave; F.NGW = F.G * NWAVES;
#if !defined(T6) || T6 == 0
            phase_mamba_out(F, args, layer); __syncthreads();
#endif
#if !defined(T6) || T6 == 1
            REOPQ(); phase_hyena_out(F, args, layer);
#endif
#if !defined(T6) || T6 == 2
            REOPQ(); phase_rwkv_out(F, args, layer); __syncthreads();
#endif
        }
        SEAM(pb + 6);
        if (PON(7) && IN(pb + 7)) { F.ws = opq(args.ws); F.lane = lane_asm() & 63; F.wave = opqs(wave0) & 7; F.tid = F.wave * 64 + F.lane; F.G = opqs(gridDim.x); F.bid = opqs(blockIdx.x); F.gw = F.bid * NWAVES + F.wave; F.NGW = F.G * NWAVES;
            pg8::Gemm g{WSP(bf16_t, WS_H8), WSP(bf16_t, WS_WIN + layer * SZ_WIN) + (size_t)NNG * DM, DM / 2, DM / 2, DM / 2}; pg8::StaticOrder S; S.init(lat_only ? 64 : 66, NGATE / 256, F.G, F.bid, lat_only ? 2 : 0);
            EpiBf16 E{WSP(bf16_t, WS_GATES), NGATE, nullptr, 0, 0, 1.f / 64.f, 1 << 30, 0};
            pg8::gemm_phase<EpiBf16, pg8::StaticOrder, true>(F.lds, g, S, E, F.tid);
            REOPQ(); phase_mamba_norm(F, args, layer);
        }
        SEAM(pb + 7);
        if (PON(8) && IN(pb + 8)) { F.ws = opq(args.ws); F.lane = lane_asm() & 63; F.wave = opqs(wave0) & 7; F.tid = F.wave * 64 + F.lane; F.G = opqs(gridDim.x); F.bid = opqs(blockIdx.x); F.gw = F.bid * NWAVES + F.wave; F.NGW = F.G * NWAVES;
            { pg8::Gemm g{WSP(bf16_t, WS_Y), WSP(bf16_t, WS_WBR + layer * SZ_WBR), 1024, 1024, 1024}; OrderHy S; S.init(F.G, F.bid, lat_only ? 64 : 66, lat_only ? 2 : 0);
              EpiHy E{WSP(bf16_t, WS_GATES), WSP(bf16_t, WS_MRGB)};
              pg8::gemm_phase(F.lds, g, S, E, F.tid); }
            { pg8::Gemm g{WSP(bf16_t, WS_Y), WSP(bf16_t, WS_WBR + layer * SZ_WBR), 512, 512, 512}; OrderMerge3 S; S.init(F.G, F.bid, lat_only ? 64 : 66, lat_only ? 2 : 0);
              EpiMerge3 E{WSP(bf16_t, WS_GATES), WSP(bf16_t, WS_MRGB)};
              pg8::gemm_phase<EpiMerge3, OrderMerge3, true>(F.lds, g, S, E, F.tid); }
        }
        SEAM(pb + 8);
        if (PON(9) && IN(pb + 9)) { F.ws = opq(args.ws); F.lane = lane_asm() & 63; F.wave = opqs(wave0) & 7; F.tid = F.wave * 64 + F.lane; F.G = opqs(gridDim.x); F.bid = opqs(blockIdx.x); F.gw = F.bid * NWAVES + F.wave; F.NGW = F.G * NWAVES;
            pg8::Gemm g{WSP(bf16_t, WS_MRGB), WSP(bf16_t, WS_WOUT + layer * SZ_WOUT), DM, DM, DM}; pg8::StaticOrder S; S.init(lat_only ? 64 : 66, 8, F.G, F.bid, lat_only ? 2 : 0);
            EpiF32 E{WSP(float, WS_YMIX), DM};
            pg8::gemm_phase(F.lds, g, S, E, F.tid);

        }
        SEAM(pb + 9);
        if (PON(10) && IN(pb + 10)) { F.ws = opq(args.ws); F.lane = lane_asm() & 63; F.wave = opqs(wave0) & 7; F.tid = F.wave * 64 + F.lane; F.G = opqs(gridDim.x); F.bid = opqs(blockIdx.x); F.gw = F.bid * NWAVES + F.wave; F.NGW = F.G * NWAVES; phase_ln1(F, args, layer); __syncthreads(); { REOPQ(); conv_experts(F, args, layer); __syncthreads(); } }
        SEAM(pb + 10);
        if (PON(11) && IN(pb + 11)) { F.ws = opq(args.ws); F.lane = lane_asm() & 63; F.wave = opqs(wave0) & 7; F.tid = F.wave * 64 + F.lane; F.G = opqs(gridDim.x); F.bid = opqs(blockIdx.x); F.gw = F.bid * NWAVES + F.wave; F.NGW = F.G * NWAVES; phase_topk(F, lat_only); __syncthreads(); }
        SEAM(pb + 11);
        if (PON(12) && IN(pb + 12)) { F.ws = opq(args.ws); F.lane = lane_asm() & 63; F.wave = opqs(wave0) & 7; F.tid = F.wave * 64 + F.lane; F.G = opqs(gridDim.x); F.bid = opqs(blockIdx.x); F.gw = F.bid * NWAVES + F.wave; F.NGW = F.G * NWAVES; phase_gather(F); }
        SEAM(pb + 12);
        if (PON(13) && IN(pb + 13)) { F.ws = opq(args.ws); F.lane = lane_asm() & 63; F.wave = opqs(wave0) & 7; F.tid = F.wave * 64 + F.lane; F.G = opqs(gridDim.x); F.bid = opqs(blockIdx.x); F.gw = F.bid * NWAVES + F.wave; F.NGW = F.G * NWAVES;
            pg8::Gemm g{WSP(bf16_t, WS_XG), WSP(bf16_t, WS_WE), DM / 2, DM / 2, DM / 2}; OrderMoe S; S.init(11, F.G, F.bid, lat_only ? 8 : 9);
            EpiSwiglu E{WSP(unsigned char, WS_HID)};
            pg8::gemm_phase<EpiSwiglu, OrderMoe, true>(F.lds, g, S, E, F.tid);

        }
        SEAM(pb + 13);
        if (PON(14) && IN(pb + 14)) { F.ws = opq(args.ws); F.lane = lane_asm() & 63; F.wave = opqs(wave0) & 7; F.tid = F.wave * 64 + F.lane; F.G = opqs(gridDim.x); F.bid = opqs(blockIdx.x); F.gw = F.bid * NWAVES + F.wave; F.NGW = F.G * NWAVES;
            pg8::Gemm g{WSP(bf16_t, WS_HID), WSP(bf16_t, WS_WE + SZ_WGU8), EFFP / 2, EFFP / 2, EFFP / 2}; OrderMoe S; S.init(8, F.G, F.bid, lat_only ? 8 : 9);
            EpiDown E{WSP(bf16_t, WS_YE)};
            pg8::gemm_phase<EpiDown, OrderMoe, true>(F.lds, g, S, E, F.tid);

        }
        SEAM(pb + 14);
        if (PON(15) && IN(pb + 15)) { F.ws = opq(args.ws); F.lane = lane_asm() & 63; F.wave = opqs(wave0) & 7; F.tid = F.wave * 64 + F.lane; F.G = opqs(gridDim.x); F.bid = opqs(blockIdx.x); F.gw = F.bid * NWAVES + F.wave; F.NGW = F.G * NWAVES; phase_ln2(F, args, layer); }
        SEAM(pb + 15);
    }
#undef IN
#undef SEAM
}


#ifdef DBG_CUT
__global__ void dbg_dump(const unsigned char* ws, float* out, size_t off, int is_bf16, size_t n_src) {
    const size_t N = (size_t)TL * DM;
    for (size_t i = (size_t)blockIdx.x * blockDim.x + threadIdx.x; i < N; i += (size_t)gridDim.x * blockDim.x) {
        const size_t j = i % n_src;
        out[i] = is_bf16 ? bf2f(((const bf16_t*)(ws + off))[j]) : ((const float*)(ws + off))[j];
    }
}
#endif

#ifdef DBG_PASSES
__global__ void dbg_chk(const unsigned char* base, size_t off, size_t nbytes, unsigned long long* slot) {
    const unsigned* p = (const unsigned*)(base + off); const size_t n = nbytes / 4; unsigned long long s = 0;
    for (size_t i = (size_t)blockIdx.x * blockDim.x + threadIdx.x; i < n; i += (size_t)gridDim.x * blockDim.x) s += p[i];
    for (int o = 32; o > 0; o >>= 1) s += __shfl_xor(s, o);
    if ((threadIdx.x & 63) == 0) atomicAdd(slot, s);
}
__global__ void dbg_report(const unsigned long long* tab, float* out, int npass) {
    int k = 0;
    for (int ph = NPHASE - 1; ph >= 0; --ph) if (tab[ph] != tab[64 + ph]) k = ph + 1;
    if (k == 0 && npass > 2) { for (int ph = NPHASE - 1; ph >= 0; --ph) if (tab[64 + ph] != tab[128 + ph]) k = 50 + ph + 1; }
    if (k == 0) return;
    const float c = sqrtf(10.f * (float)k);
    for (size_t i = (size_t)blockIdx.x * blockDim.x + threadIdx.x; i < (size_t)TL * DM; i += (size_t)gridDim.x * blockDim.x) out[i] = c;
}
struct DbgReg { size_t off, n; };
#endif
extern "C" void kernel_launch(void* const* d_in, const int* in_sizes, int n_in, void* d_out, int out_size, void* d_ws, size_t ws_size, hipStream_t stream) {
    static int grid = 0;
    if (grid == 0) {
        if (n_in != N_INPUTS || in_sizes[0] != TL * DM || out_size != TL * DM || ws_size < WS_END) {
            fprintf(stderr, "kernel_launch: shape/workspace mismatch: n_in %d in0 %d out %d ws %zu (need %zu)\n", n_in, n_in > 0 ? in_sizes[0] : -1, out_size, ws_size, (size_t)WS_END); grid = -1; return; }
        int dev = 0, cus = 0, per_cu = 0;
        if (hipGetDevice(&dev) != hipSuccess || hipDeviceGetAttribute(&cus, hipDeviceAttributeMultiprocessorCount, dev) != hipSuccess) { grid = -1; return; }
        if (hipFuncSetAttribute((const void*)fwd_kernel, hipFuncAttributeMaxDynamicSharedMemorySize, LDS_BYTES) != hipSuccess) { fprintf(stderr, "kernel_launch: hipFuncSetAttribute failed\n"); grid = -1; return; }
        if (hipOccupancyMaxActiveBlocksPerMultiprocessor(&per_cu, (const void*)fwd_kernel, NTHREADS, LDS_BYTES) != hipSuccess || per_cu < 1) { fprintf(stderr, "kernel_launch: occupancy query says %d\n", per_cu); grid = -1; (void)hipGetLastError(); return; }
        grid = cus;
    }
    if (grid < 0) return;
    (void)hipMemsetAsync((char*)d_ws + WS_CTL, 0, CTL_BYTES, stream);
    Args a{};
    for (int i = 0; i < N_INPUTS; ++i) a.in[i] = (const float*)d_in[i];
    a.out = (float*)d_out; a.ws = (unsigned char*)d_ws;
#if MK_ONE_LAUNCH
    a.ph_lo = 0; a.ph_hi = NPHASE;
    hipLaunchKernelGGL(fwd_kernel, dim3(grid), dim3(NTHREADS), LDS_BYTES, stream, a);
#else
#ifdef DBG_PASSES
    {
        unsigned long long* tab = (unsigned long long*)((char*)d_ws + 1600000);
        auto chk = [&](int pass, int ph, size_t off, size_t n) { hipLaunchKernelGGL(dbg_chk, dim3(1024), dim3(256), 0, stream, (const unsigned char*)d_ws, off, n, tab + pass * 64 + ph); };
        for (int pass = 0; pass < DBG_PASSES; ++pass) {
            if (pass > 0) (void)hipMemsetAsync((char*)d_ws + (size_t)CW_MOD * 4, 0, (size_t)DEPTH * 3 * 6 * DM * 4, stream);
            for (int ph = 0; ph < NPHASE; ++ph) {
                a.ph_lo = ph; a.ph_hi = ph + 1; hipLaunchKernelGGL(fwd_kernel, dim3(grid), dim3(NTHREADS), LDS_BYTES, stream, a);
                if (ph == 0) { chk(pass, ph, WS_WIN, WS_XS - WS_WIN); chk(pass, ph, (size_t)CW_MOD * 4, (size_t)DEPTH * 3 * 6 * DM * 4); continue; }
                const int r = (ph - 1) % NPL;
                switch (r) {
                case 0: chk(pass, ph, WS_H, SZ_H); chk(pass, ph, WS_HDN, SZ_HDN); break;
                case 1: chk(pass, ph, WS_P, SZ_P); break;
                case 2: chk(pass, ph, WS_P2, SZ_P2); chk(pass, ph, WS_KK, SZ_TK2); chk(pass, ph, WS_ALORA, WS_VT - WS_ALORA); chk(pass, ph, WS_VT, WS_HDN - WS_VT); break;
                case 3: chk(pass, ph, WS_Q, SZ_Q + SZ_KV); chk(pass, ph, WS_EW, 4 * SZ_TK2); chk(pass, ph, WS_GG, SZ_TK2); break;
                case 4: chk(pass, ph, WS_Q, SZ_Q); chk(pass, ph, WS_MST, SZ_MST + SZ_MCS); break;
                case 5: chk(pass, ph, WS_YRW, 2 * SZ_TK2); chk(pass, ph, WS_Y, SZ_Y / 4); chk(pass, ph, WS_VT, SZ_VT); chk(pass, ph, WS_MST, SZ_MST); break;
                case 6: chk(pass, ph, WS_Y + SZ_Y / 4, 3 * (SZ_Y / 4)); break;
                case 7: chk(pass, ph, WS_GATES, SZ_GATES); chk(pass, ph, WS_Y + SZ_Y / 4, SZ_Y / 4); break;
                case 8: chk(pass, ph, WS_MRGF, SZ_MRGF); chk(pass, ph, WS_MRGB, SZ_MRGB); break;
                case 9: chk(pass, ph, WS_YMIX, SZ_YMIX); break;
                case 10: chk(pass, ph, WS_XS, SZ_XS); chk(pass, ph, WS_H2, SZ_H); chk(pass, ph, WS_AFF, SZ_AFF); chk(pass, ph, WS_WE, SZ_WGU + SZ_WD); break;
                case 11: chk(pass, ph, WS_INV, SZ_INV + SZ_PTOK + SZ_PGATE); break;
                case 12: chk(pass, ph, WS_XG, SZ_XG); break;
                case 13: chk(pass, ph, WS_HID, SZ_HID); break;
                case 14: chk(pass, ph, WS_YE, SZ_YE); break;
                case 15: chk(pass, ph, WS_XS, SZ_XS); break;
                }
            }
        }
        hipLaunchKernelGGL(dbg_report, dim3(2048), dim3(256), 0, stream, (const unsigned long long*)tab, (float*)d_out, (int)DBG_PASSES);
    }
#elif defined(DBG_CUT)
    for (int ph = 0; ph < DBG_CUT; ++ph) { a.ph_lo = ph; a.ph_hi = ph + 1; hipLaunchKernelGGL(fwd_kernel, dim3(grid), dim3(NTHREADS), LDS_BYTES, stream, a); }
    hipLaunchKernelGGL(dbg_dump, dim3(2048), dim3(256), 0, stream, (const unsigned char*)d_ws, (float*)d_out, (size_t)DBG_OFF, DBG_BF16, (size_t)DBG_N);
#else
    for (int ph = 0; ph < NPHASE; ++ph) { a.ph_lo = ph; a.ph_hi = ph + 1; hipLaunchKernelGGL(fwd_kernel, dim3(grid), dim3(NTHREADS), LDS_BYTES, stream, a); }
#endif
#endif
}
```

```cpp
#include <hip/hip_runtime.h>
#include <cstdio>
#include <cstdint>

#define REP_MASK 0x80000
#ifndef MK_ONE_LAUNCH
#define MK_ONE_LAUNCH 1
#endif

#define LAS __attribute__((address_space(3)))
typedef unsigned short bf16_t;
typedef short bf16x8 __attribute__((ext_vector_type(8)));
typedef float f32x4 __attribute__((ext_vector_type(4)));
typedef float f32x2 __attribute__((ext_vector_type(2)));
typedef unsigned u32x4 __attribute__((ext_vector_type(4)));
typedef unsigned u32x2 __attribute__((ext_vector_type(2)));

constexpr int DM = 2048, NBATCH = 2, SEQ = 8192, CTX = 256, DEPTH = 2;
constexpr int TC = NBATCH * CTX, TL = NBATCH * SEQ, T = TC + TL;
constexpr int NIN = 18432, NNG = 10240, NGATE = 8192;
constexpr int P_CQ = 0, P_CKV = 512, P_KPE = 1024;
constexpr int P_Z = 1088, P_XBC = 2112, P_DT = 3648;
constexpr int P_HY = 3680;
constexpr int P_RW = 6752, P_WD = 9824, P_AD = 9952, P_GD = 10080;
constexpr int NH_MLA = 8, NH_SSM = 16, NH_RW = 16;
constexpr int NEXP = 16, EFF = 1408, CAP_L = 1024, CAP_C = 32;
constexpr int NPAIR = NBATCH * NEXP * CAP_L + NEXP * 256;
constexpr float ALPHA = 1.4142135623730951f;
constexpr int NWAVES = 8, NTHREADS = 512;

__device__ __forceinline__ int seg_of(int row) { return row < 256 ? 0 : row < 512 ? 1 : row < 512 + SEQ ? 2 : 3; }
__device__ __forceinline__ int seg_start(int s) { return s == 0 ? 0 : s == 1 ? 256 : s == 2 ? 512 : 512 + SEQ; }
__device__ __forceinline__ int seg_len(int s) { return s < 2 ? CTX : SEQ; }
__device__ __forceinline__ bool row_first(int row) { return row == 0 || row == 256 || row == 512 || row == 512 + SEQ; }
__device__ __forceinline__ bool row_last(int row) { return row == 255 || row == 511 || row == 511 + SEQ || row == T - 1; }
__device__ __forceinline__ int row_modidx(int row) { return row < 512 ? 2 : (row < 512 + SEQ ? 0 : 1); }

constexpr size_t AL(size_t x) { return (x + 255) / 256 * 256; }
constexpr size_t WS_CTL = 0, CTL_BYTES = 2u << 20;
constexpr int CW_BAR = 1024;
constexpr int CW_MOD = 16384;
constexpr size_t SZ_WIN = (size_t)NIN * DM * 2, SZ_WBR = (size_t)4 * DM * 1024 * 2, SZ_WOUT = (size_t)DM * DM * 2, SZ_WQ = (size_t)1536 * 512 * 2,
                 SZ_WKV = (size_t)2048 * 512 * 2, SZ_WLORA = (size_t)5120 * 512 * 2;
constexpr size_t WS_WIN = CTL_BYTES, WS_WBR = WS_WIN + DEPTH * SZ_WIN, WS_WOUT = WS_WBR + DEPTH * SZ_WBR, WS_WQ = WS_WOUT + DEPTH * SZ_WOUT,
                 WS_WKV = WS_WQ + DEPTH * SZ_WQ, WS_WLORA = WS_WKV + DEPTH * SZ_WKV, WS_XS = WS_WLORA + DEPTH * SZ_WLORA;
constexpr size_t SZ_XS = (size_t)T * DM * 4;
constexpr size_t WIN8P_OFF = (size_t)NNG * DM * 2 + (size_t)NGATE * DM;
static_assert(WIN8P_OFF + (size_t)27 * 256 * DM <= SZ_WIN, "w_in area");
constexpr size_t WS_H = WS_XS + SZ_XS, SZ_H = (size_t)T * DM * 2;
constexpr size_t WS_P = WS_H + SZ_H, SZ_P = (size_t)T * NNG * 2;
constexpr int P2W = 5632, P2_XBC = 0, P2_X0 = 1536, P2_RKV = 2560;
constexpr size_t WS_P2 = WS_P + SZ_P, SZ_P2 = (size_t)T * P2W * 2;
constexpr size_t WS_Q = WS_P2 + SZ_P2, SZ_Q = (size_t)T * 1536 * 2;
constexpr size_t WS_KV = WS_Q + SZ_Q, SZ_KV = (size_t)T * 2048 * 2;
constexpr size_t WS_EW = WS_KV + SZ_KV, SZ_TK2 = (size_t)T * 1024 * 2;
constexpr size_t WS_ICLR = WS_EW + 2 * SZ_TK2;
constexpr size_t WS_KK = WS_ICLR + 2 * SZ_TK2;
constexpr size_t WS_GG = WS_KK + SZ_TK2;
constexpr size_t WS_YRW = WS_GG + SZ_TK2;
constexpr size_t WS_ALORA = WS_YRW + 2 * SZ_TK2, SZ_ALORA = (size_t)T * 512 * 2;
constexpr size_t WS_KPE = WS_ALORA + SZ_ALORA, SZ_KPE = (size_t)T * 64 * 2;
constexpr size_t WS_RS = WS_KPE + SZ_KPE, SZ_RS = AL((size_t)T * 2 * 4);
constexpr size_t WS_DT = WS_RS + SZ_RS, SZ_DT = (size_t)T * 32 * 4;
constexpr size_t WS_VT = WS_DT + SZ_DT, SZ_VT = (size_t)1024 * 2 * SEQ * 4;
constexpr size_t WS_VC = WS_VT + SZ_VT, SZ_VC = (size_t)TC * 1024 * 4;
constexpr size_t WS_FILT = WS_VC + SZ_VC, SZ_FILT = (size_t)1024 * 2 * SEQ * 2;
constexpr size_t WS_FILTC = WS_FILT + SZ_FILT, SZ_FILTC = (size_t)CTX * 2048 * 4;
constexpr size_t WS_HDN = WS_FILTC + SZ_FILTC, SZ_HDN1 = (size_t)(SEQ + CTX) * 64 * 4, SZ_HDN = DEPTH * SZ_HDN1;
constexpr int NCHUNK = T / 128;
constexpr size_t WS_MST = WS_HDN + SZ_HDN, SZ_MST = (size_t)2 * NCHUNK * 16 * 8192 * 2;
constexpr size_t WS_MCS = WS_MST + SZ_MST, SZ_MCS = (size_t)2 * NCHUNK * 16 * 4 * 2;
constexpr size_t WS_Y = WS_MCS + AL(SZ_MCS), SZ_Y = (size_t)4 * T * 1024 * 2;
constexpr float Y8A_SCALE = 64.f;
constexpr size_t SZ_Y8 = (size_t)T * 1024, WS_Y8A = WS_Y, WS_Y8B = WS_Y + SZ_Y8, WS_Y8D = WS_Y + 3 * (SZ_Y / 4);
constexpr size_t WS_VT8 = WS_Y + 2 * (SZ_Y / 4), WS_K8 = WS_VT8 + (size_t)8 * 128 * T, WS_KPE8 = WS_Y + 3 * (SZ_Y / 4) + (size_t)T * 1024;
constexpr size_t WS_AFF = WS_Y + SZ_Y, SZ_AFF = (size_t)T * 16 * 4;
constexpr size_t WS_INV = WS_AFF + SZ_AFF, SZ_INV = (size_t)T * 16 * 4;
constexpr size_t WS_PTOK = WS_INV + SZ_INV, SZ_PTOK = (size_t)NPAIR * 4;
constexpr size_t WS_PGATE = WS_PTOK + SZ_PTOK, SZ_PGATE = (size_t)NPAIR * 4;
constexpr size_t WS_H8 = WS_PGATE + SZ_PGATE, SZ_H8 = (size_t)T * DM;
constexpr size_t WS_CQ8 = WS_H8 + SZ_H8, SZ_CQ8 = (size_t)T * 1024;
constexpr size_t WS_END = WS_CQ8 + SZ_CQ8;
constexpr size_t WS_GATES = WS_P, SZ_GATES = (size_t)T * NGATE * 2;
constexpr size_t WS_MRGF = WS_P2, SZ_MRGF = (size_t)T * DM * 4;
constexpr size_t WS_MRGB = WS_Q, SZ_MRGB = (size_t)T * DM * 2;
constexpr size_t WS_YMIX = WS_P, SZ_YMIX = (size_t)T * DM * 4;
constexpr size_t WS_H2 = WS_H;
constexpr size_t WS_WE = WS_P2, SZ_WGU = (size_t)NEXP * 2816 * DM * 2, SZ_WD = (size_t)NEXP * DM * EFF * 2;
constexpr size_t WS_XG = WS_P, SZ_XG = (size_t)NPAIR * DM * 2;
constexpr size_t WS_HID = WS_XG + SZ_XG, SZ_HID = (size_t)NPAIR * EFF * 2;
constexpr size_t WS_YE = WS_WE + SZ_WGU + SZ_WD, SZ_YE = (size_t)NPAIR * DM * 2;
static_assert(SZ_GATES <= SZ_P && SZ_MRGF <= SZ_P2 && SZ_MRGB <= SZ_Q + SZ_KV && SZ_YMIX <= SZ_P, "alias map 1");
static_assert(SZ_XG + SZ_HID <= SZ_P, "alias map 2");
static_assert(WS_YE + SZ_YE <= WS_VT, "alias map 3");
static_assert(WS_END < 1800000000ull, "workspace budget");

__device__ __forceinline__ unsigned f2bf(float f) { unsigned u = __builtin_bit_cast(unsigned, f); return (u + 0x7fffu + ((u >> 16) & 1u)) >> 16; }
__device__ __forceinline__ unsigned pk2(float lo, float hi) { return f2bf(lo) | (f2bf(hi) << 16); }
__device__ __forceinline__ float bf2f(unsigned short b) { return __builtin_bit_cast(float, (unsigned)b << 16); }
__device__ __forceinline__ float bflo(unsigned w) { return __builtin_bit_cast(float, w << 16); }
__device__ __forceinline__ float bfhi(unsigned w) { return __builtin_bit_cast(float, w & 0xffff0000u); }
__device__ __forceinline__ unsigned cvt_pk_bf16(float lo, float hi) { unsigned r; asm volatile("v_cvt_pk_bf16_f32 %0, %1, %2" : "=v"(r) : "v"(lo), "v"(hi)); return r; }
__device__ __forceinline__ float dppx(float x, const int sel) {
    const int xi = __builtin_bit_cast(int, x); int r;
    if (sel == 0) r = __builtin_amdgcn_update_dpp(0, xi, 0xB1, 0xF, 0xF, false);
    else if (sel == 1) r = __builtin_amdgcn_update_dpp(0, xi, 0x4E, 0xF, 0xF, false);
    else if (sel == 2) r = __builtin_amdgcn_update_dpp(0, xi, 0x141, 0xF, 0xF, false);
    else r = __builtin_amdgcn_update_dpp(0, xi, 0x140, 0xF, 0xF, false);
    return __builtin_bit_cast(float, r);
}
__device__ __forceinline__ float swz16(float x) { return __builtin_bit_cast(float, __builtin_amdgcn_ds_swizzle(__builtin_bit_cast(int, x), 0x401F)); }
__device__ __forceinline__ float sum4(float v) { v += dppx(v, 0); v += dppx(v, 1); return v; }
__device__ __forceinline__ float sum8(float v) { v = sum4(v); v += dppx(v, 2); return v; }
__device__ __forceinline__ float sum16(float v) { v = sum8(v); v += dppx(v, 3); return v; }
__device__ __forceinline__ float sum32(float v) { v = sum16(v); v += swz16(v); return v; }
__device__ __forceinline__ unsigned pk4fp8(float a, float b, float c, float d) { int w = 0; w = __builtin_amdgcn_cvt_pk_fp8_f32(a, b, w, false); w = __builtin_amdgcn_cvt_pk_fp8_f32(c, d, w, true); return (unsigned)w; }
__device__ __forceinline__ float wave_sum(float v) {
    v = sum32(v);
    auto rr = __builtin_amdgcn_permlane32_swap(__float_as_uint(v), __float_as_uint(v), false, false);
    return __uint_as_float(rr[0]) + __uint_as_float(rr[1]);
}
__device__ __forceinline__ float sigmoidf_(float x) { return 1.f / (1.f + __expf(-x)); }
__device__ __forceinline__ float siluf_(float x) { return x / (1.f + __expf(-x)); }
__device__ __forceinline__ float softplusf_(float x) { return x > 20.f ? x : __logf(1.f + __expf(x)); }
__device__ __forceinline__ float tanhf_(float x) { const float e = __expf(2.f * fminf(x, 15.f)); return 1.f - 2.f / (e + 1.f); }
#define LDS_WAIT() asm volatile("s_waitcnt lgkmcnt(0)" ::: "memory")
#define VM_WAIT() asm volatile("s_waitcnt vmcnt(0)" ::: "memory")

#define XB_TMO      128
#define XB_XCNT(j)  (256  + 64 * (j))
#define XB_XSUB(j)  (1280 + 64 * (j))
#define XB_XGEN(j)  (2304 + 64 * (j))
#define XB_TOP      3328
#define XB_TOPGEN   3392
#define XCD_BAR_WORDS 3456
#define XB_SPIN_CAP (1u << 18)
__device__ __forceinline__ unsigned xb_ld(unsigned* p)              { return __hip_atomic_load(p, __ATOMIC_RELAXED, __HIP_MEMORY_SCOPE_AGENT); }
__device__ __forceinline__ unsigned xb_add(unsigned* p, unsigned v) { return __hip_atomic_fetch_add(p, v, __ATOMIC_RELAXED, __HIP_MEMORY_SCOPE_AGENT); }
__device__ __forceinline__ unsigned xb_xcc_id() { return (unsigned)__builtin_amdgcn_s_getreg((3 << 11) | 20) & 0xFu; }
#define XB_SPIN(cond, bar) do { unsigned _sp = 0; while (cond) { __builtin_amdgcn_s_sleep(1); \
    if ((++_sp & 255u) == 0u) { if (xb_ld(&(bar)[XB_TMO])) break; if (_sp > XB_SPIN_CAP) { atomicAdd(&(bar)[XB_TMO], 1u); break; } } } } while (0)
struct XcdBarrier { unsigned* bar; unsigned x; volatile LAS unsigned* st; };
__device__ __forceinline__ XcdBarrier xcd_barrier_post(unsigned* bar, volatile LAS unsigned* st) {
    XcdBarrier b; b.bar = bar; b.x = xb_xcc_id(); b.st = st;
    if (threadIdx.x == 0) (void)xb_add(&bar[XB_XCNT(b.x)], 1u);
    return b;
}
__device__ __forceinline__ void xcd_barrier_complete(unsigned* bar, unsigned x, unsigned& nloc, unsigned& nx) {
    const unsigned G = gridDim.x * gridDim.y * gridDim.z;
    unsigned sum, cnt, mine, sp = 0u;
    for (;;) {
        sum = 0u; cnt = 0u; mine = 0u;
#pragma unroll
        for (unsigned j = 0; j < 16; ++j) { const unsigned c = xb_ld(&bar[XB_XCNT(j)]); sum += c; cnt += (c > 0u) ? 1u : 0u; mine = (j == x) ? c : mine; }
        if (sum == G) break;
        __builtin_amdgcn_s_sleep(1);
        if ((++sp & 255u) == 0u) { if (xb_ld(&bar[XB_TMO])) break; if (sp > XB_SPIN_CAP) { atomicAdd(&bar[XB_TMO], 1u); break; } }
    }
    nloc = mine > 0u ? mine : 1u; nx = cnt > 0u ? cnt : 1u;
}
__device__ __forceinline__ void xcd_barrier(const XcdBarrier& b) {
    asm volatile("s_waitcnt vmcnt(0)" ::: "memory");
    __syncthreads();
    if (threadIdx.x == 0) {
        unsigned* bar = b.bar;
        __builtin_amdgcn_s_waitcnt(0);
        unsigned nloc = b.st[0], nx = b.st[1];
        if (nloc == 0u) { xcd_barrier_complete(bar, b.x, nloc, nx); b.st[0] = nloc; b.st[1] = nx; }
        const unsigned old = xb_add(&bar[XB_XSUB(b.x)], 1u);
        const unsigned gen = old / nloc;
        if (old + 1u == (gen + 1u) * nloc) {
            __builtin_amdgcn_fence(__ATOMIC_RELEASE, "agent");
            asm volatile("s_waitcnt vmcnt(0)" ::: "memory");
            const unsigned og = xb_add(&bar[XB_TOP], 1u);
            const unsigned tg = og / nx;
            if (og + 1u == (tg + 1u) * nx) xb_add(&bar[XB_TOPGEN], 1u);
            else XB_SPIN(xb_ld(&bar[XB_TOPGEN]) == tg, bar);
            __builtin_amdgcn_fence(__ATOMIC_ACQUIRE, "agent");
            xb_add(&bar[XB_XGEN(b.x)], 1u);
            asm volatile("s_waitcnt vmcnt(0)" ::: "memory");
        } else {
            XB_SPIN(xb_ld(&bar[XB_XGEN(b.x)]) == gen, bar);
            __builtin_amdgcn_fence(__ATOMIC_ACQUIRE, "agent");
            asm volatile("s_waitcnt vmcnt(0)" ::: "memory");
        }
    }
    __syncthreads();
}

__device__ __forceinline__ int lane_asm() { int l; asm volatile("v_mbcnt_lo_u32_b32 %0, -1, 0\n\tv_mbcnt_hi_u32_b32 %0, -1, %0" : "=v"(l)); return l; }
namespace pg8 {
constexpr int BM = 256, BK = 64, HALF = 128, HTB = HALF * BK * 2, STAGE_BYTES = 8 * HTB, NXCD = 8, WGM = 8;
__host__ __device__ __forceinline__ int lds_byte(int r, int c) { const int st = (r >> 4) * 2 + (c >> 5), rr = r & 15, cc = c & 31, ob = rr * 64 + cc * 2; return st * 1024 + (ob ^ (((ob >> 9) & 1) << 5)); }
__host__ __device__ __forceinline__ void stage_rc(int b, int& R, int& C) { const int st = b / 1024, sb = b % 1024, swz = sb ^ (((sb >> 9) & 1) << 5); R = (st >> 1) * 16 + swz / 64; C = (st & 1) * 32 + (swz % 64) / 2; }
__host__ __device__ __forceinline__ int perm32(int rho) { const int n = rho >> 4, i = rho & 15; return 8 * (i >> 2) + 4 * n + (i & 3); }
struct Unit { int pm, pn; };
struct Gemm { const bf16_t* A; const bf16_t* Bt; int lda, ldb, K; };
struct StaticOrder {
    int nM, nN, nwg, G, c, pm0, pn0;
    __device__ void init(int nM_, int nN_, int G_, int c_, int pm0_ = 0, int pn0_ = 0) { nM = nM_; nN = nN_; nwg = nM * nN; G = G_; c = c_; pm0 = pm0_; pn0 = pn0_; }
    __device__ bool next(int i, Unit& u) const {
        const long L = (long)i * G + c; if (L >= nwg) return false;
        int wgid = (int)L; { const int q = nwg / NXCD, r = nwg % NXCD, xcd = wgid % NXCD, off = wgid / NXCD; wgid = (xcd < r ? xcd * (q + 1) : r * (q + 1) + (xcd - r) * q) + off; }
        const int nig = WGM * nN, gid = wgid / nig, fm = gid * WGM, gsz = (nM - fm) < WGM ? (nM - fm) : WGM;
        u.pm = pm0 + fm + ((wgid % nig) % gsz); u.pn = pn0 + (wgid % nig) / gsz; return true;
    }
};
typedef int i32x4v __attribute__((ext_vector_type(4)));
typedef int i32x8v __attribute__((ext_vector_type(8)));
__device__ __forceinline__ i32x8v cat8(bf16x8 a, bf16x8 b) { return __builtin_shufflevector(__builtin_bit_cast(i32x4v, a), __builtin_bit_cast(i32x4v, b), 0, 1, 2, 3, 4, 5, 6, 7); }
template <class Epi, class Sched, bool FP8 = false>
__device__ __forceinline__ void gemm_phase(LAS unsigned char* lds, const Gemm g, const Sched& S, const Epi& E, int tid_in) {
    constexpr bool ALIGN_EPI = true;
    const unsigned tid_u = (unsigned)tid_in; __builtin_assume(tid_u < 512u);
    const int tid = (int)tid_u, wid = __builtin_amdgcn_readfirstlane(tid >> 6), lane = tid & 63, wr = wid >> 2, wc = wid & 3, fr = lane & 15, fq = lane >> 4;
    const int K = g.K, nt = K / BK;
    unsigned voffA[2], voffB[2];
#pragma unroll
    for (int i = 0; i < 2; ++i) { int R, C; stage_rc(tid * 16 + i * 8192, R, C); const int Rb = Epi::PERM ? ((R & ~31) + perm32(R & 31)) : R;
        voffA[i] = (unsigned)(R * g.lda + C) * 2u; voffB[i] = (unsigned)(Rb * g.ldb + C) * 2u; }
    const unsigned kstep = (unsigned)(BK * 2);
    const unsigned hstepA = (unsigned)HALF * g.lda * 2u, hstepB = (unsigned)HALF * g.ldb * 2u;
    const unsigned tstepA = 2u * hstepA, tstepB = 2u * hstepB;
    const unsigned ldsw = (unsigned)wid * 1024u;
    const int aoff = lds_byte(wr * 64 + fr, fq * 8), boff = lds_byte(wc * 32 + fr, fq * 8);
    const __amdgpu_buffer_rsrc_t rsA = __builtin_amdgcn_make_buffer_rsrc((void*)g.A, 0, 0xFFFFFFFFu, 0x00020000);
    const __amdgpu_buffer_rsrc_t rsB = __builtin_amdgcn_make_buffer_rsrc((void*)g.Bt, 0, 0xFFFFFFFFu, 0x00020000);
#define PG8_SA(b, h) (((b) * 2 + (h)) * HTB)
#define PG8_SB(b, h) ((4 + (b) * 2 + (h)) * HTB)
#define PG8_STAGE(bufoff, rs, soff, voff) do { _Pragma("unroll") for (int _i = 0; _i < 2; ++_i) \
        __builtin_amdgcn_raw_ptr_buffer_load_lds(rs, (LAS unsigned*)(lds + (bufoff) + ldsw + _i * 8192), 16, (int)(voff)[_i], (int)(soff), 0, 0); } while (0)
#define PG8_LDA(dst, b, h) do { if constexpr (FP8) { _Pragma("unroll") for (int m = 0; m < 4; ++m) dst##8[m] = __builtin_shufflevector(*(const LAS i32x4v*)(lds + PG8_SA(b, h) + aoff + m * 2048), *(const LAS i32x4v*)(lds + PG8_SA(b, h) + aoff + m * 2048 + 1024), 0, 1, 2, 3, 4, 5, 6, 7); } \
    else { _Pragma("unroll") for (int m = 0; m < 4; ++m) _Pragma("unroll") for (int k = 0; k < 2; ++k) dst[m][k] = *(const LAS bf16x8*)(lds + PG8_SA(b, h) + aoff + m * 2048 + k * 1024); } } while (0)
#define PG8_LDB(dst, b, h) do { if constexpr (FP8) { _Pragma("unroll") for (int n = 0; n < 2; ++n) dst##8[n] = __builtin_shufflevector(*(const LAS i32x4v*)(lds + PG8_SB(b, h) + boff + n * 2048), *(const LAS i32x4v*)(lds + PG8_SB(b, h) + boff + n * 2048 + 1024), 0, 1, 2, 3, 4, 5, 6, 7); } \
    else { _Pragma("unroll") for (int n = 0; n < 2; ++n) _Pragma("unroll") for (int k = 0; k < 2; ++k) dst[n][k] = *(const LAS bf16x8*)(lds + PG8_SB(b, h) + boff + n * 2048 + k * 1024); } } while (0)
#define PG8_MMA(ai, bj, At, Bt) do { __builtin_amdgcn_s_setprio(1); if constexpr (FP8) { _Pragma("unroll") for (int m = 0; m < 4; ++m) _Pragma("unroll") for (int n = 0; n < 2; ++n) \
        asm volatile("v_mfma_scale_f32_16x16x128_f8f6f4 %0, %1, %2, %0, %3, %3 op_sel_hi:[0,0,0]" : "+v"(acc[ai][bj][m][n]) : "v"(Bt##8[n]), "v"(At##8[m]), "v"(sc1)); } else { \
        _Pragma("unroll") for (int m = 0; m < 4; ++m) _Pragma("unroll") for (int n = 0; n < 2; ++n) _Pragma("unroll") for (int k = 0; k < 2; ++k) \
        acc[ai][bj][m][n] = __builtin_amdgcn_mfma_f32_16x16x32_bf16(Bt[n][k], At[m][k], acc[ai][bj][m][n], 0, 0, 0); } __builtin_amdgcn_s_setprio(0); } while (0)
#define PG8_WAIT_V(n) asm volatile("s_waitcnt vmcnt(" #n ")" ::: "memory")
#define PG8_WAIT_L(n) asm volatile("s_waitcnt lgkmcnt(" #n ")" ::: "memory")
#define PG8_BAR __builtin_amdgcn_s_barrier()
#define PG8_SCHED __builtin_amdgcn_sched_barrier(0)
    Unit cur, nxt; int ui = 0;
    if (!S.next(0, cur)) return;
    f32x4 acc[2][2][4][2];
#pragma unroll
    for (int a = 0; a < 2; ++a)
#pragma unroll
        for (int b = 0; b < 2; ++b)
#pragma unroll
            for (int m = 0; m < 4; ++m)
#pragma unroll
                for (int n = 0; n < 2; ++n) acc[a][b][m][n] = (f32x4){0.f, 0.f, 0.f, 0.f};
    i32x8v At8[4], B08[2], B18[2]; bf16x8 At[4][2], B0[2][2], B1[2][2];
    const int sc1 = 0x7F7F7F7F;
    unsigned cA = (unsigned)cur.pm * tstepA, cB = (unsigned)cur.pn * tstepB;
    PG8_STAGE(PG8_SB(0, 0), rsB, cB, voffB); PG8_STAGE(PG8_SB(0, 1), rsB, cB + hstepB, voffB); PG8_STAGE(PG8_SA(0, 0), rsA, cA, voffA); PG8_STAGE(PG8_SA(0, 1), rsA, cA + hstepA, voffA);
    if (wr == 1) PG8_BAR;
    PG8_WAIT_V(2); PG8_BAR;
    PG8_STAGE(PG8_SB(1, 0), rsB, cB + kstep, voffB); PG8_STAGE(PG8_SA(1, 0), rsA, cA + kstep, voffA); PG8_STAGE(PG8_SB(1, 1), rsB, cB + hstepB + kstep, voffB);
    PG8_WAIT_V(6); PG8_BAR;
    for (;;) {
        const bool has_next = S.next(ui + 1, nxt);
        const unsigned nA = has_next ? (unsigned)nxt.pm * tstepA : cA; const unsigned nB = has_next ? (unsigned)nxt.pn * tstepB : cB;
        for (int t = 0; t < nt; t += 2) {
            const bool last = (t == nt - 2);
            const unsigned a1 = cA + (unsigned)(t + 1) * kstep;
            const unsigned a2 = last ? nA : cA + (unsigned)(t + 2) * kstep; const unsigned b2 = last ? nB : cB + (unsigned)(t + 2) * kstep;
            const unsigned a3 = a2 + kstep; const unsigned b3 = b2 + kstep;
            PG8_LDB(B0, 0, 0); PG8_LDB(B1, 0, 1); PG8_SCHED; PG8_LDA(At, 0, 0); PG8_STAGE(PG8_SA(1, 1), rsA, a1 + hstepA, voffA);
            PG8_WAIT_V(8); PG8_WAIT_L(0); PG8_BAR; PG8_MMA(0, 0, At, B0); PG8_MMA(0, 1, At, B1); PG8_BAR; PG8_SCHED;
            PG8_LDA(At, 0, 1); PG8_STAGE(PG8_SB(0, 0), rsB, b2, voffB); PG8_STAGE(PG8_SB(0, 1), rsB, b2 + hstepB, voffB); PG8_STAGE(PG8_SA(0, 0), rsA, a2, voffA);
            PG8_WAIT_V(8); PG8_WAIT_L(0); PG8_BAR; PG8_MMA(1, 0, At, B0); PG8_MMA(1, 1, At, B1); PG8_BAR; PG8_SCHED;
            PG8_LDB(B0, 1, 0); PG8_LDB(B1, 1, 1); PG8_SCHED; PG8_LDA(At, 1, 0); PG8_STAGE(PG8_SA(0, 1), rsA, a2 + hstepA, voffA);
            PG8_WAIT_V(8); PG8_WAIT_L(0); PG8_BAR; PG8_MMA(0, 0, At, B0); PG8_MMA(0, 1, At, B1); PG8_BAR; PG8_SCHED;
            PG8_LDA(At, 1, 1); PG8_STAGE(PG8_SB(1, 0), rsB, b3, voffB); PG8_STAGE(PG8_SB(1, 1), rsB, b3 + hstepB, voffB); PG8_STAGE(PG8_SA(1, 0), rsA, a3, voffA);
            PG8_WAIT_V(8); PG8_WAIT_L(0); PG8_BAR; PG8_MMA(1, 0, At, B0); PG8_MMA(1, 1, At, B1); PG8_BAR; PG8_SCHED;
        }
        if constexpr (FP8) asm volatile("s_nop 15\n\ts_nop 7" ::: "memory");
        if constexpr (ALIGN_EPI) { if (wr == 0) PG8_BAR; }
        bool keep_acc = false;
        { const int l2 = lane_asm() & 63; if constexpr (Epi::KEEPS) keep_acc = E(acc, cur, wr, wc, l2 & 15, l2 >> 4); else E(acc, cur, wr, wc, l2 & 15, l2 >> 4); }
        if (!has_next) break;
        if (!keep_acc) {
#pragma unroll
        for (int a = 0; a < 2; ++a)
#pragma unroll
            for (int b = 0; b < 2; ++b)
#pragma unroll
                for (int m = 0; m < 4; ++m)
#pragma unroll
                    for (int n = 0; n < 2; ++n) acc[a][b][m][n] = (f32x4){0.f, 0.f, 0.f, 0.f};
        }
        cur = nxt; cA = nA; cB = nB; ++ui;
        if constexpr (ALIGN_EPI) { if (wr == 1) PG8_BAR; }
    }
    PG8_WAIT_V(0);
    if constexpr (!ALIGN_EPI) { if (wr == 0) PG8_BAR; }
    PG8_BAR;
#undef PG8_SA
#undef PG8_SB
#undef PG8_STAGE
#undef PG8_LDA
#undef PG8_LDB
#undef PG8_MMA
#undef PG8_WAIT_V
#undef PG8_WAIT_L
#undef PG8_BAR
#undef PG8_SCHED
}
}

enum { I_X = 0, I_C, I_CTX, I_CCTX, I_WADA, I_BADA, I_WIN, I_QNORM, I_WQUP, I_KVNORM, I_WKVUP, I_SCONVW, I_SCONVB, I_SDTB, I_SALOG, I_SD, I_SNORM,
       I_HCONVW, I_HCONVB, I_HW1, I_HB1, I_HW2, I_HB2, I_HW3, I_HFREQ, I_HD, I_RMU, I_RW0, I_RWUP, I_RA0, I_RAUP, I_RGUP, I_RKK, I_RKA, I_RRK, I_RLNG, I_RLNB,
       I_WBR, I_WOUT, I_LN1G, I_LN1B, I_WROUTER, I_WGATE, I_WUP, I_WDOWN, I_LN2G, I_LN2B, N_INPUTS };
struct Args { const float* in[N_INPUTS]; float* out; unsigned char* ws; int ph_lo, ph_hi; };
static_assert(sizeof(Args) == (N_INPUTS + 2) * 8 + 8, "Args has no padding");

__device__ __forceinline__ const float* arg_in(const Args& a, int i) { asm volatile("" : "+s"(i)); return a.in[i]; }
__device__ __forceinline__ int opqs(int v) { asm volatile("" : "+s"(v)); return v; }
__device__ __forceinline__ int opqv(int v) { asm volatile("" : "+v"(v)); return v; }
__device__ __forceinline__ unsigned char* opq(unsigned char* p) { asm volatile("" : "+s"(p)); return p; }
struct Frame {
    LAS unsigned char* lds;
    int tid, lane, wave, G, bid, gw, NGW;
    unsigned char* ws;
};
#define WSP(T_, off) ((T_*)(F.ws + (off)))

struct RmId { __device__ int operator()(int n) const { return n; } };
struct RmShift { int sh; __device__ int operator()(int n) const { return n + sh; } };
struct RmGateUp { int up; __device__ int operator()(int n) const { return 256 * (n >> 7) + (n & 127) + (up ? 128 : 0); } };
constexpr int TR_SCR = 64 * 65 * 4;
__device__ __forceinline__ void tr_load(const float* W, int ldw, int k0, int n0, const float* kscale, float sc, LAS float* scr, int lane) {
    float v[64];
    const float* wp = W + (size_t)k0 * ldw + n0 + lane;
#pragma unroll
    for (int i = 0; i < 64; ++i) v[i] = wp[(size_t)i * ldw];
#pragma unroll
    for (int i = 0; i < 64; ++i) { float x = v[i] * sc; if (kscale) x *= kscale[k0 + i]; scr[i * 65 + lane] = x; }
    LDS_WAIT(); asm volatile("" ::: "memory");
}
template <class RowMap>
__device__ __forceinline__ void transpose_item(const float* W, int ldw, bf16_t* WT, int ldt, int k0, int n0, const float* kscale, RowMap rm, LAS float* scr, int lane) {
    tr_load(W, ldw, k0, n0, kscale, 1.f, scr, lane);
    const int c = lane & 7;
#pragma unroll
    for (int j = 0; j < 8; ++j) { const int n = (lane >> 3) + 8 * j; const LAS float* s = scr + (8 * c) * 65 + n;
        u32x4 o; o.x = pk2(s[0 * 65], s[1 * 65]); o.y = pk2(s[2 * 65], s[3 * 65]); o.z = pk2(s[4 * 65], s[5 * 65]); o.w = pk2(s[6 * 65], s[7 * 65]);
        *(u32x4*)(WT + (size_t)rm(n0 + n) * ldt + k0 + 8 * c) = o; }
    LDS_WAIT(); asm volatile("" ::: "memory");
}
template <class RowMap>
__device__ __forceinline__ void transpose_item_fp8(const float* W, int ldw, unsigned char* WT, int ldt, int k0, int n0, float sc, RowMap rm, LAS float* scr, int lane, const float* kscale = nullptr) {
    tr_load(W, ldw, k0, n0, kscale, sc, scr, lane);
    const int c = lane & 3;
#pragma unroll
    for (int j = 0; j < 4; ++j) { const int n = (lane >> 2) + 16 * j; const LAS float* s = scr + (16 * c) * 65 + n;
        u32x4 o; o.x = pk4fp8(s[0 * 65], s[1 * 65], s[2 * 65], s[3 * 65]); o.y = pk4fp8(s[4 * 65], s[5 * 65], s[6 * 65], s[7 * 65]);
        o.z = pk4fp8(s[8 * 65], s[9 * 65], s[10 * 65], s[11 * 65]); o.w = pk4fp8(s[12 * 65], s[13 * 65], s[14 * 65], s[15 * 65]);
        *(u32x4*)(WT + (size_t)rm(n0 + n) * ldt + k0 + 16 * c) = o; }
    LDS_WAIT(); asm volatile("" ::: "memory");
}

__device__ __forceinline__ void p0_weights(Frame& F, const Args& a) {
    LAS float* scr = (LAS float*)(F.lds + F.wave * TR_SCR);
    constexpr int IT_IN = 32 * 288, IT_BR = 16 * 32, IT_OUT = 32 * 32, IT_Q = 8 * 24, IT_KV = 8 * 32;
    constexpr int PER_L = IT_IN + 4 * IT_BR + IT_OUT + IT_Q + IT_KV;
    for (int it = F.gw; it < DEPTH * PER_L; it += F.NGW) {
        const int l = it / PER_L; int r = it % PER_L;
        if (r < IT_IN) { const int kb = r / 288, nb = r % 288;
            if (nb * 64 < NNG) { const int tile = nb >> 2;
                if (tile >= 14 && tile < 27) transpose_item(arg_in(a, I_WIN) + (size_t)l * DM * NIN, NIN, WSP(bf16_t, WS_WIN + l * SZ_WIN), DM, kb * 64, nb * 64, nullptr, RmId(), scr, F.lane);
                else { RmShift rs; rs.sh = tile < 14 ? 0 : -13 * 256; transpose_item_fp8(arg_in(a, I_WIN) + (size_t)l * DM * NIN, NIN, WSP(unsigned char, WS_WIN + l * SZ_WIN + WIN8P_OFF), DM, kb * 64, nb * 64, 64.f, rs, scr, F.lane); } }
            else transpose_item_fp8(arg_in(a, I_WIN) + (size_t)l * DM * NIN + NNG, NIN, WSP(unsigned char, WS_WIN + l * SZ_WIN) + (size_t)NNG * DM * 2, DM, kb * 64, nb * 64 - NNG, 64.f, RmId(), scr, F.lane);
            continue; } r -= IT_IN;
        if (r < 4 * IT_BR) { const int br = r / IT_BR, q = r % IT_BR, kb = q / 32, nb = q % 32;
            if (br == 2) transpose_item(arg_in(a, I_WBR) + ((size_t)l * 4 + br) * 1024 * DM, DM, WSP(bf16_t, WS_WBR + l * SZ_WBR) + (size_t)br * DM * 1024, 1024, kb * 64, nb * 64, nullptr, RmId(), scr, F.lane);
            else { const int sub = br == 3 ? 2 : br; transpose_item_fp8(arg_in(a, I_WBR) + ((size_t)l * 4 + br) * 1024 * DM, DM, WSP(unsigned char, WS_WBR + l * SZ_WBR) + (size_t)sub * DM * 1024, 1024, kb * 64, nb * 64, 32.f, RmId(), scr, F.lane); }
            continue; } r -= 4 * IT_BR;
        if (r < IT_OUT) { const int kb = r / 32, nb = r % 32;
            transpose_item(arg_in(a, I_WOUT) + (size_t)l * DM * DM, DM, WSP(bf16_t, WS_WOUT + l * SZ_WOUT), DM, kb * 64, nb * 64, nullptr, RmId(), scr, F.lane); continue; } r -= IT_OUT;
        if (r < IT_Q) { const int kb = r / 24, nb = r % 24;
            transpose_item_fp8(arg_in(a, I_WQUP) + (size_t)l * 512 * 1536, 1536, WSP(unsigned char, WS_WQ + l * SZ_WQ), 512, kb * 64, nb * 64, 16.f, RmId(), scr, F.lane, arg_in(a, I_QNORM) + l * 512); continue; } r -= IT_Q;
        { const int kb = r / 32, nb = r % 32;
            transpose_item_fp8(arg_in(a, I_WKVUP) + (size_t)l * 512 * 2048, 2048, WSP(unsigned char, WS_WKV + l * SZ_WKV), 512, kb * 64, nb * 64, 16.f, RmId(), scr, F.lane, arg_in(a, I_KVNORM) + l * 512); }
    }
    for (size_t e4 = (size_t)F.bid * NTHREADS + F.tid; e4 < (size_t)DEPTH * 5120 * 128; e4 += (size_t)F.G * NTHREADS) {
        const int l = (int)(e4 / (5120 * 128)); const int rem = (int)(e4 % (5120 * 128)); const int n = rem / 128, kc0 = (rem % 128) * 4; const int blk = n >> 10, c = n & 1023;
        float v[4];
#pragma unroll
        for (int q = 0; q < 4; ++q) { const int kc = kc0 + q; float x = 0.f;
            if (blk < 2) { if (kc >= 64 * blk && kc < 64 * blk + 64) x = arg_in(a, I_RWUP)[(((size_t)l * 2 + blk) * 64 + (kc - 64 * blk)) * 1024 + c]; }
            else if (blk < 4) { const int d = blk - 2; if (kc >= 128 + 64 * d && kc < 192 + 64 * d) x = arg_in(a, I_RAUP)[(((size_t)l * 2 + d) * 64 + (kc - 128 - 64 * d)) * 1024 + c]; }
            else { if (kc >= 256 && kc < 416) x = arg_in(a, I_RGUP)[((size_t)l * 160 + (kc - 256)) * 1024 + c]; }
            v[q] = x * 8.f; }
        WSP(unsigned, WS_WLORA + l * SZ_WLORA)[(size_t)n * 128 + kc0 / 4] = pk4fp8(v[0], v[1], v[2], v[3]);
    }
}
constexpr int EFFP = 1536;
constexpr size_t SZ_WGU8 = (size_t)NEXP * 2816 * DM, SZ_WD8 = (size_t)NEXP * DM * EFFP;
__device__ __forceinline__ void conv_experts(Frame& F, const Args& a, int l) {
    LAS float* scr = (LAS float*)(F.lds + F.wave * TR_SCR);
    constexpr int IT_G = 32 * 22, IT_D = 22 * 32, PER_E = 2 * IT_G + IT_D;
    unsigned char* wgu = WSP(unsigned char, WS_WE); unsigned char* wd = WSP(unsigned char, WS_WE + SZ_WGU8);
    for (int it = F.gw; it < NEXP * PER_E; it += F.NGW) {
        const int e = it / PER_E; int r = it % PER_E;
        if (r < 2 * IT_G) { const int up = r / IT_G, q = r % IT_G, kb = q / 22, nb = q % 22;
            const float* src = arg_in(a, up ? I_WUP : I_WGATE) + ((size_t)l * NEXP + e) * DM * EFF;
            RmGateUp rm; rm.up = up;
            transpose_item_fp8(src, EFF, wgu + (size_t)e * 2816 * DM, DM, kb * 64, nb * 64, 64.f, rm, scr, F.lane); continue; } r -= 2 * IT_G;
        { const int kb = r / 32, nb = r % 32;
            transpose_item_fp8(arg_in(a, I_WDOWN) + ((size_t)l * NEXP + e) * EFF * DM, DM, wd + (size_t)e * DM * EFFP, EFFP, kb * 64, nb * 64, 64.f, RmId(), scr, F.lane); }
    }
    for (int i = F.bid * NTHREADS + F.tid; i < NEXP * DM * 8; i += F.G * NTHREADS) { const int rowi = i >> 3, q = i & 7; unsigned zz = 0u; asm volatile("" : "+v"(zz));
        *(u32x4*)(wd + (size_t)rowi * EFFP + EFF + q * 16) = (u32x4){zz, zz, zz, zz}; }
}
__device__ __forceinline__ void p0_mod(Frame& F, const Args& a) {
    LAS float* sv = (LAS float*)(F.lds + 69632);
    for (int i = F.tid; i < 3 * DM; i += NTHREADS) { const int v = i / DM, k = i % DM; const float x = v < 2 ? arg_in(a, I_C)[v * DM + k] : arg_in(a, I_CCTX)[k]; sv[i] = siluf_(x); }
    __syncthreads();
    float* mod = (float*)(F.ws + WS_CTL) + CW_MOD;
    LAS float* red = (LAS float*)(F.lds + 69632 + 3 * DM * 4);
    for (int u = F.bid; u < DEPTH * (6 * DM / 128); u += F.G) {
        const int l = u / (6 * DM / 128), nb = u % (6 * DM / 128); const int kg = F.tid >> 7, cl = F.tid & 127, n = nb * 128 + cl;
        const float* w = arg_in(a, I_WADA) + ((size_t)l * DM + kg * 512) * (6 * DM) + n;
        float a0 = 0.f, a1 = 0.f, a2 = 0.f;
#pragma unroll 32
        for (int k = 0; k < 512; ++k) { const float wv = w[(size_t)k * (6 * DM)]; const int kk = kg * 512 + k; a0 += sv[kk] * wv; a1 += sv[DM + kk] * wv; a2 += sv[2 * DM + kk] * wv; }
        __syncthreads();
        red[(kg * 3 + 0) * 128 + cl] = a0; red[(kg * 3 + 1) * 128 + cl] = a1; red[(kg * 3 + 2) * 128 + cl] = a2;
        __syncthreads();
        if (F.tid < 384) { const int v = F.tid >> 7; const float b = arg_in(a, I_BADA)[l * 6 * DM + n];
            mod[(l * 3 + v) * 6 * DM + n] = b + ((red[(0 * 3 + v) * 128 + cl] + red[(1 * 3 + v) * 128 + cl]) + (red[(2 * 3 + v) * 128 + cl] + red[(3 * 3 + v) * 128 + cl])); }
    }
}

__device__ __forceinline__ void row_stats(const f32x4 (&v)[8], float& mean, float& rstd, float eps) {
    float s = 0.f;
#pragma unroll
    for (int j = 0; j < 8; ++j) s += (v[j].x + v[j].y) + (v[j].z + v[j].w);
    mean = wave_sum(s) * (1.f / DM);
    float s2 = 0.f;
#pragma unroll
    for (int j = 0; j < 8; ++j) { const f32x4 d = v[j] - mean; s2 += (d.x * d.x + d.y * d.y) + (d.z * d.z + d.w * d.w); }
    rstd = 1.f / sqrtf(wave_sum(s2) * (1.f / DM) + eps);
}
__device__ __forceinline__ const float* x_src_row(const Args& a, const Frame& F, int layer, int row) {
    if (layer == 0) return row < TC ? arg_in(a, I_CTX) + (size_t)row * DM : arg_in(a, I_X) + (size_t)(row - TC) * DM;
    return (const float*)(F.ws + WS_XS) + (size_t)row * DM;
}
__device__ __forceinline__ void phase_modln(Frame& F, const Args& a, int layer) {
    const float* mod = (const float*)(F.ws + WS_CTL) + CW_MOD + (size_t)layer * 3 * 6 * DM;
    bf16_t* H = WSP(bf16_t, WS_H); unsigned* H8 = WSP(unsigned, WS_H8);
    for (int row = F.gw; row < T; row += F.NGW) {
        const f32x4* xr = (const f32x4*)x_src_row(a, F, layer, row) + F.lane;
        f32x4 v[8];
#pragma unroll
        for (int j = 0; j < 8; ++j) v[j] = xr[64 * j];
        float mean, rstd; row_stats(v, mean, rstd, 1e-6f);
        const float* m = mod + (size_t)row_modidx(row) * 6 * DM;
        u32x2* o = (u32x2*)(H + (size_t)row * DM) + F.lane; unsigned* o8 = H8 + (size_t)row * (DM / 4) + F.lane;
#pragma unroll
        for (int j = 0; j < 8; ++j) { const int c = 4 * (64 * j + F.lane); const f32x4 sh = *(const f32x4*)(m + c), sc = *(const f32x4*)(m + DM + c);
            const f32x4 y = (v[j] - mean) * rstd * (sc + 1.f) + sh; u32x2 w; w.x = pk2(y.x, y.y); w.y = pk2(y.z, y.w); o[64 * j] = w; o8[64 * j] = pk4fp8(y.x, y.y, y.z, y.w); }
    }
}

__device__ __forceinline__ void phase_hdn(Frame& F, const Args& a, int layer) {
    LAS float* zs = (LAS float*)(F.lds + F.wave * 512);
    const float* w1 = arg_in(a, I_HW1) + (size_t)layer * 33 * 64; const float* b1 = arg_in(a, I_HB1) + layer * 64;
    const float* w2 = arg_in(a, I_HW2) + (size_t)layer * 64 * 64; const float* b2 = arg_in(a, I_HB2) + layer * 64;
    const float fr = arg_in(a, I_HFREQ)[layer * 64 + F.lane];
    float* HDN = WSP(float, WS_HDN + layer * SZ_HDN1);
    for (int r = F.gw; r < SEQ + CTX; r += F.NGW) {
        const int n = r < SEQ ? SEQ : CTX, t = r < SEQ ? r : r - SEQ;
        const float wpos = (6.283185307179586f * (float)t) / (float)n;
        if (F.lane < 33) { float z;
            if (F.lane == 0) z = (float)t / (float)(n - 1);
            else { const int b = (F.lane - 1) & 15; const float f = 1e-4f + (float)b * ((15.f - 1e-4f) / 15.f); const float ang = f * wpos; z = F.lane <= 16 ? __cosf(ang) : -__sinf(ang); }
            zs[F.lane] = z; }
        LDS_WAIT(); asm volatile("" ::: "memory");
        float p = b1[F.lane];
#pragma unroll
        for (int i = 0; i < 33; ++i) p += zs[i] * w1[i * 64 + F.lane];
        const float h1 = __sinf(fr * p);
        zs[64 + F.lane] = h1;
        LDS_WAIT(); asm volatile("" ::: "memory");
        float q = b2[F.lane];
#pragma unroll 16
        for (int i = 0; i < 64; ++i) q += zs[64 + i] * w2[i * 64 + F.lane];
        HDN[(size_t)r * 64 + F.lane] = __sinf(fr * q);
        LDS_WAIT(); asm volatile("" ::: "memory");
    }
}
__device__ __forceinline__ float hy_delta(int c) { const float mn = -3.0701134573253943f, mx = -15.350567286626972f; return fabsf(mn + (float)c * ((mx - mn) / 1023.f)); }
__device__ __forceinline__ void phase_filt(Frame& F, const Args& a, int layer) {
    const float* w3 = arg_in(a, I_HW3) + (size_t)layer * 64 * 2048; const float* HDN = WSP(float, WS_HDN + layer * SZ_HDN1);
    LAS float* ws3 = (LAS float*)F.lds;
    bf16_t* FILT = WSP(bf16_t, WS_FILT);
    for (int u = F.bid; u < 32 * 16; u += F.G) {
        const int cb = u / 16, tb = u % 16, col0 = cb * 64, t = tb * 512 + F.tid;
        __syncthreads();
        for (int i = F.tid; i < 4096; i += NTHREADS) { const int j = i >> 6, cc = i & 63; ws3[cc * 64 + j] = w3[(size_t)j * 2048 + col0 + cc]; }
        __syncthreads();
        f32x4 h[16];
#pragma unroll
        for (int i = 0; i < 16; ++i) h[i] = *(const f32x4*)(HDN + (size_t)t * 64 + 4 * i);
        const float tn = (float)t / (float)(SEQ - 1);
        for (int cc = 0; cc < 64; ++cc) {
            float acc = 0.f;
#pragma unroll
            for (int i = 0; i < 16; ++i) { const f32x4 w = *(const LAS f32x4*)(ws3 + cc * 64 + 4 * i); acc += h[i].x * w.x + h[i].y * w.y + h[i].z * w.z + h[i].w * w.w; }
            const int col = col0 + cc, side = col >> 10, c = col & 1023;
            FILT[((size_t)c * 2 + side) * SEQ + t] = (bf16_t)f2bf(acc * __expf(-tn * hy_delta(c)));
        }
    }
    float* FILTC = WSP(float, WS_FILTC);
    for (int e = F.bid * NTHREADS + F.tid; e < CTX * 2048; e += F.G * NTHREADS) {
        const int lag = e >> 11, col = e & 2047, c = col & 1023; const float* hr = HDN + (size_t)(SEQ + lag) * 64; float acc = 0.f;
#pragma unroll 16
        for (int j = 0; j < 64; ++j) acc += hr[j] * w3[(size_t)j * 2048 + col];
        FILTC[e] = acc * __expf(-((float)lag / (float)(CTX - 1)) * hy_delta(c));
    }
}

__device__ __forceinline__ void ld8bf(const bf16_t* p, float (&o)[8]) { const u32x4 w = *(const u32x4*)p; o[0] = bflo(w.x); o[1] = bfhi(w.x); o[2] = bflo(w.y); o[3] = bfhi(w.y); o[4] = bflo(w.z); o[5] = bfhi(w.z); o[6] = bflo(w.w); o[7] = bfhi(w.w); }
__device__ __forceinline__ void up8(const u32x4 w, float (&o)[8]) { o[0] = bflo(w.x); o[1] = bfhi(w.x); o[2] = bflo(w.y); o[3] = bfhi(w.y); o[4] = bflo(w.z); o[5] = bfhi(w.z); o[6] = bflo(w.w); o[7] = bfhi(w.w); }
__device__ __forceinline__ void st8bf(bf16_t* p, const float (&v)[8]) { u32x4 w; w.x = pk2(v[0], v[1]); w.y = pk2(v[2], v[3]); w.z = pk2(v[4], v[5]); w.w = pk2(v[6], v[7]); *(u32x4*)p = w; }
__device__ __forceinline__ void ld8f(const float* p, float (&o)[8]) { const f32x4 a = *(const f32x4*)p, b = *(const f32x4*)(p + 4); o[0] = a.x; o[1] = a.y; o[2] = a.z; o[3] = a.w; o[4] = b.x; o[5] = b.y; o[6] = b.z; o[7] = b.w; }

constexpr int PREP_RUN = 16;
__device__ __forceinline__ void phase_prep(Frame& F, const Args& a, int layer) {
    const bf16_t* P = WSP(bf16_t, WS_P); bf16_t* P2 = WSP(bf16_t, WS_P2);
    float* RS = WSP(float, WS_RS); bf16_t* KPE = WSP(bf16_t, WS_KPE); float* DT = WSP(float, WS_DT);
    bf16_t* KK = WSP(bf16_t, WS_KK); unsigned char* AL_ = WSP(unsigned char, WS_ALORA); float* VC = WSP(float, WS_VC); unsigned char* CQ8 = WSP(unsigned char, WS_CQ8);
    const float* scw = arg_in(a, I_SCONVW) + (size_t)layer * 3 * 1536; const float* scb = arg_in(a, I_SCONVB) + layer * 1536; const float* dtb = arg_in(a, I_SDTB) + layer * 32;
    const float* hcw = arg_in(a, I_HCONVW) + (size_t)layer * 3 * 3072; const float* hcb = arg_in(a, I_HCONVB) + layer * 3072;
    const float* mu = arg_in(a, I_RMU) + (size_t)layer * 2 * 3488; const float* rkk = arg_in(a, I_RKK) + layer * 1024;
    const int lane = F.lane;
    for (int item = F.gw; item < (T / PREP_RUN) * 13; item += F.NGW) {
        const int run = item / 13, ct = item % 13; const int r0 = run * PREP_RUN;
        if (ct == 0) {
#pragma unroll 1
        for (int rr = 0; rr < PREP_RUN; ++rr) { const int row = r0 + rr; const bf16_t* pr = P + (size_t)row * NNG;
            float x[8]; ld8bf(pr + P_CQ + lane * 8, x); float s = 0.f;
            *(u32x2*)(CQ8 + (size_t)row * 1024 + lane * 8) = (u32x2){pk4fp8(x[0], x[1], x[2], x[3]), pk4fp8(x[4], x[5], x[6], x[7])};
#pragma unroll
            for (int i = 0; i < 8; ++i) s += x[i] * x[i];
            s = wave_sum(s); const float rq = 1.f / sqrtf(s * (1.f / 512.f) + 1e-6f);
            ld8bf(pr + P_CKV + lane * 8, x); s = 0.f;
            *(u32x2*)(CQ8 + (size_t)row * 1024 + 512 + lane * 8) = (u32x2){pk4fp8(x[0], x[1], x[2], x[3]), pk4fp8(x[4], x[5], x[6], x[7])};
#pragma unroll
            for (int i = 0; i < 8; ++i) s += x[i] * x[i];
            s = wave_sum(s); const float rk = 1.f / sqrtf(s * (1.f / 512.f) + 1e-6f);
            if (lane == 0) { RS[row * 2] = rq; RS[row * 2 + 1] = rk; }
            float kv = bf2f(pr[P_KPE + lane]);
            const float other = swz16(kv);
            if (row >= TC) { const int t = (row - TC) & (SEQ - 1); const int axis = lane >> 5, half = (lane >> 4) & 1, j = lane & 15;
                const float pos = (float)(axis == 0 ? (t >> 6) : (t & 63)); const float inv = __builtin_amdgcn_exp2f(-(float)j * 0.8304820237218406f);
                const float sn = __sinf(pos * inv), cs = __cosf(pos * inv);
                kv = half == 0 ? kv * cs - other * sn : kv * cs + other * sn; }
            KPE[(size_t)row * 64 + lane] = (bf16_t)f2bf(kv);
            if (lane < 32) DT[(size_t)row * 32 + lane] = softplusf_(bf2f(pr[P_DT + lane]) + dtb[lane]); }
        continue; }
        const bool first = row_first(r0), last = row_last(r0 + PREP_RUN - 1);
        if (ct >= 1 && ct <= 3) { const int ch = ct - 1; const int c = ch * 512 + lane * 8; float xm[8], x0[8], xp[8], w0[8], w1[8], w2[8], bb[8];
            ld8f(scw + c, w0); ld8f(scw + 1536 + c, w1); ld8f(scw + 3072 + c, w2); ld8f(scb + c, bb);
            const bf16_t* pc = P + (size_t)r0 * NNG + P_XBC + c;
            u32x4 raw[PREP_RUN + 2];
#pragma unroll
            for (int rr = 0; rr < PREP_RUN + 2; ++rr) { const bool ok = (rr > 0 || !first) && (rr < PREP_RUN + 1 || !last); raw[rr] = ok ? *(const u32x4*)(pc + (ptrdiff_t)(rr - 1) * NNG) : (u32x4){0u, 0u, 0u, 0u}; }
            up8(raw[0], xm); up8(raw[1], x0);
#pragma unroll
            for (int rr = 0; rr < PREP_RUN; ++rr) {
                up8(raw[rr + 2], xp);
                float o[8];
#pragma unroll
                for (int i = 0; i < 8; ++i) { o[i] = siluf_(xm[i] * w0[i] + x0[i] * w1[i] + xp[i] * w2[i] + bb[i]); xm[i] = x0[i]; x0[i] = xp[i]; }
                st8bf(P2 + (size_t)(r0 + rr) * P2W + P2_XBC + c, o); } continue; }
        if (ct >= 4 && ct <= 5) { const int ch = ct - 4; { const int c = ch * 512 + lane * 8; float xm[8], x0[8], xp[8], w0[8], w1[8], w2[8], bb[8];
            ld8f(hcw + c, w0); ld8f(hcw + 3072 + c, w1); ld8f(hcw + 6144 + c, w2); ld8f(hcb + c, bb);
            const bf16_t* pc = P + (size_t)r0 * NNG + P_HY + c;
            u32x4 raw[PREP_RUN + 2];
#pragma unroll
            for (int rr = 0; rr < PREP_RUN + 2; ++rr) { const bool ok = (rr > 0 || !first) && (rr < PREP_RUN + 1 || !last); raw[rr] = ok ? *(const u32x4*)(pc + (ptrdiff_t)(rr - 1) * NNG) : (u32x4){0u, 0u, 0u, 0u}; }
            up8(raw[0], xm); up8(raw[1], x0);
#pragma unroll
            for (int rr = 0; rr < PREP_RUN; ++rr) {
                up8(raw[rr + 2], xp);
                float o[8];
#pragma unroll
                for (int i = 0; i < 8; ++i) { o[i] = xm[i] * w0[i] + x0[i] * w1[i] + xp[i] * w2[i] + bb[i]; xm[i] = x0[i]; x0[i] = xp[i]; }
                st8bf(P2 + (size_t)(r0 + rr) * P2W + P2_X0 + c, o); } }
        if (r0 < TC) {
#pragma unroll 1
                for (int rr = 0; rr < PREP_RUN; ++rr) { const int row = r0 + rr; const bool f1 = row_first(row), l1 = row_last(row); const int c = ch * 512 + lane * 8;
                    const bf16_t* pr = P + (size_t)row * NNG; float o1[8], o2[8];
#pragma unroll
                    for (int part = 1; part < 3; ++part) { float x0[8], xm[8], xp[8], w0[8], w1[8], w2[8], bb[8]; const int cc = part * 1024 + c;
                        ld8bf(pr + P_HY + cc, x0);
                        if (!f1) ld8bf(pr - NNG + P_HY + cc, xm); else { for (int i = 0; i < 8; ++i) xm[i] = 0.f; }
                        if (!l1) ld8bf(pr + NNG + P_HY + cc, xp); else { for (int i = 0; i < 8; ++i) xp[i] = 0.f; }
                        ld8f(hcw + cc, w0); ld8f(hcw + 3072 + cc, w1); ld8f(hcw + 6144 + cc, w2); ld8f(hcb + cc, bb);
#pragma unroll
                        for (int i = 0; i < 8; ++i) { const float r = xm[i] * w0[i] + x0[i] * w1[i] + xp[i] * w2[i] + bb[i]; if (part == 1) o1[i] = r; else o2[i] = r; } }
                    float* vc = VC + (size_t)row * 1024 + c;
                    *(f32x4*)vc = (f32x4){o1[0] * o2[0], o1[1] * o2[1], o1[2] * o2[2], o1[3] * o2[3]};
                    *(f32x4*)(vc + 4) = (f32x4){o1[4] * o2[4], o1[5] * o2[5], o1[6] * o2[6], o1[7] * o2[7]}; } }
        continue; }
        { const int ch = ct - 6; const int c = ch * 512 + lane * 8;
            if (c < 3488) { float um[8], u0[8], up[8], m0[8], m1[8], g8[8];
                ld8f(mu + c, m0); ld8f(mu + 3488 + c, m1);
                if (ch == 2 || ch == 3) ld8f(rkk + (c - 1024), g8);
                const bf16_t* pc = P + (size_t)r0 * NNG + P_RW + c;
                u32x4 raw[PREP_RUN + 2];
#pragma unroll
                for (int rr = 0; rr < PREP_RUN + 2; ++rr) { const bool ok = (rr > 0 || !first) && (rr < PREP_RUN + 1 || !last); raw[rr] = ok ? *(const u32x4*)(pc + (ptrdiff_t)(rr - 1) * NNG) : (u32x4){0u, 0u, 0u, 0u}; }
                up8(raw[0], um); up8(raw[1], u0);
#pragma unroll
                for (int rr = 0; rr < PREP_RUN; ++rr) { const int row = r0 + rr;
                    up8(raw[rr + 2], up);
                    float us[8];
#pragma unroll
                    for (int i = 0; i < 8; ++i) { us[i] = u0[i] + m0[i] * (um[i] - u0[i]) + m1[i] * (up[i] - u0[i]); um[i] = u0[i]; u0[i] = up[i]; }
                    if (ch < 6) st8bf(P2 + (size_t)row * P2W + P2_RKV + c, us);
                    if (ch == 2 || ch == 3) { float kx[8]; float s = 0.f;
#pragma unroll
                        for (int i = 0; i < 8; ++i) { kx[i] = us[i] * g8[i]; s += kx[i] * kx[i]; }
                        s = sum8(s);
                        const float inv = 1.f / fmaxf(sqrtf(s), 1e-12f);
#pragma unroll
                        for (int i = 0; i < 8; ++i) kx[i] *= inv;
                        st8bf(KK + (size_t)row * 1024 + (c - 1024), kx); }
                    if (ch == 6) { const int cl = c - 3072; float o[8];
#pragma unroll
                        for (int i = 0; i < 8; ++i) o[i] = cl < 128 ? tanhf_(us[i]) : cl < 256 ? us[i] : sigmoidf_(us[i]);
                        *(u32x2*)(AL_ + (size_t)row * 512 + cl) = (u32x2){pk4fp8(o[0], o[1], o[2], o[3]), pk4fp8(o[4], o[5], o[6], o[7])}; } } }
            else if (ch == 6) { const int cl = c - 3072;
                for (int rr = 0; rr < PREP_RUN; ++rr) { float zz = 0.f; asm volatile("" : "+v"(zz)); *(u32x2*)(AL_ + (size_t)(r0 + rr) * 512 + cl) = (u32x2){__builtin_bit_cast(unsigned, zz), __builtin_bit_cast(unsigned, zz)}; } } }
    }
    float* VT = WSP(float, WS_VT);
    LAS float* tl = (LAS float*)F.lds;
    for (int u = F.bid; u < (TL / 64) * 4; u += F.G) {
        const int tb = u >> 2, cb = u & 3; const int row0 = TC + tb * 64; const int c8 = (F.tid & 31) * 8, c = cb * 256 + c8, tq = F.tid >> 5;
        float w1[3][8], w2[3][8], b1[8], b2[8];
#pragma unroll
        for (int k = 0; k < 3; ++k) { ld8f(hcw + k * 3072 + 1024 + c, w1[k]); ld8f(hcw + k * 3072 + 2048 + c, w2[k]); }
        ld8f(hcb + 1024 + c, b1); ld8f(hcb + 2048 + c, b2);
        __syncthreads();
#pragma unroll 1
        for (int i = 0; i < 4; ++i) { const int tl_ = tq * 4 + i, row = row0 + tl_; const bf16_t* pr = P + (size_t)row * NNG + P_HY;
            const bool first = row_first(row), last = row_last(row);
            float a1[8], a2[8], x[8];
            ld8bf(pr + 1024 + c, x);
#pragma unroll
            for (int j = 0; j < 8; ++j) a1[j] = x[j] * w1[1][j] + b1[j];
            ld8bf(pr + 2048 + c, x);
#pragma unroll
            for (int j = 0; j < 8; ++j) a2[j] = x[j] * w2[1][j] + b2[j];
            if (!first) { ld8bf(pr - NNG + 1024 + c, x);
#pragma unroll
                for (int j = 0; j < 8; ++j) a1[j] += x[j] * w1[0][j];
                ld8bf(pr - NNG + 2048 + c, x);
#pragma unroll
                for (int j = 0; j < 8; ++j) a2[j] += x[j] * w2[0][j]; }
            if (!last) { ld8bf(pr + NNG + 1024 + c, x);
#pragma unroll
                for (int j = 0; j < 8; ++j) a1[j] += x[j] * w1[2][j];
                ld8bf(pr + NNG + 2048 + c, x);
#pragma unroll
                for (int j = 0; j < 8; ++j) a2[j] += x[j] * w2[2][j]; }
#pragma unroll
            for (int j = 0; j < 8; ++j) tl[(c8 + j) * 65 + tl_] = a1[j] * a2[j]; }
        __syncthreads();
        const int b = (row0 - TC) >> 13, t0 = (row0 - TC) & (SEQ - 1);
        for (int p_ = 0; p_ < 8; ++p_) { const int cl = p_ * 32 + (F.tid >> 4), q = F.tid & 15;
            const f32x4 o = {tl[cl * 65 + 4 * q], tl[cl * 65 + 4 * q + 1], tl[cl * 65 + 4 * q + 2], tl[cl * 65 + 4 * q + 3]};
            *(f32x4*)(VT + ((size_t)(cb * 256 + cl) * 2 + b) * SEQ + t0 + 4 * q) = o; }
    }
}

using pg8::Unit;
#define EPI_LOOP_BEGIN const int row0 = u.pm * 256 + wr * 64 + fr; \
    _Pragma("unroll") for (int ai = 0; ai < 2; ++ai) _Pragma("unroll") for (int m = 0; m < 4; ++m) { const int row = row0 + ai * 128 + m * 16; \
    _Pragma("unroll") for (int bj = 0; bj < 2; ++bj) { const int cl = bj * 128 + wc * 32 + 8 * fq; const f32x4 v0 = acc[ai][bj][m][0], v1 = acc[ai][bj][m][1];
#define EPI_LOOP_END } __builtin_amdgcn_sched_barrier(0); }
struct EpiBf16 {
    static constexpr bool PERM = true, KEEPS = false;
    bf16_t* O; int ldc; const float* rscale; int rs_stride; int act; float cscale; int pn_from, pn_add;
    __device__ __forceinline__ void operator()(const f32x4 (&acc)[2][2][4][2], const Unit& u, int wr, int wc, int fr, int fq) const {
        EPI_LOOP_BEGIN
            const float s = (rscale ? rscale[(size_t)row * rs_stride] : 1.f) * cscale;
            float x[8] = {v0.x * s, v0.y * s, v0.z * s, v0.w * s, v1.x * s, v1.y * s, v1.z * s, v1.w * s};
            if (act == 1) {
#pragma unroll
                for (int i = 0; i < 8; ++i) x[i] = sigmoidf_(x[i]); }
            u32x4 w; w.x = cvt_pk_bf16(x[0], x[1]); w.y = cvt_pk_bf16(x[2], x[3]); w.z = cvt_pk_bf16(x[4], x[5]); w.w = cvt_pk_bf16(x[6], x[7]);
            *(u32x4*)(O + (size_t)row * ldc + (u.pn + (u.pn >= pn_from ? pn_add : 0)) * 256 + cl) = w;
        EPI_LOOP_END
    }
};
struct EpiLora {
    static constexpr bool PERM = true, KEEPS = false;
    bf16_t* EW; bf16_t* ICLR; bf16_t* GG; const float* w0; const float* a0; float cscale;
    __device__ __forceinline__ void operator()(const f32x4 (&acc)[2][2][4][2], const Unit& u, int wr, int wc, int fr, int fq) const {
        const int blk = u.pn >> 2, cb = (u.pn & 3) * 256;
        const float* bias = blk < 2 ? w0 + blk * 1024 : a0 + (blk & 1) * 1024;
        bf16_t* dbase = blk < 2 ? EW + (size_t)blk * T * 1024 : blk < 4 ? ICLR + (size_t)(blk - 2) * T * 1024 : GG;
        const float scale = blk < 2 ? 0.6065306597126334f : 1.f; const bool sig = blk < 4;
        f32x4 bia[2][2];
#pragma unroll
        for (int bj = 0; bj < 2; ++bj) { const int c = cb + bj * 128 + wc * 32 + 8 * fq; bia[bj][0] = *(const f32x4*)(bias + c); bia[bj][1] = *(const f32x4*)(bias + c + 4); }
        EPI_LOOP_BEGIN
            const int c = cb + cl; float x[8] = {v0.x * cscale, v0.y * cscale, v0.z * cscale, v0.w * cscale, v1.x * cscale, v1.y * cscale, v1.z * cscale, v1.w * cscale};
            if (sig) { const f32x4 b0 = bia[bj][0], b1 = bia[bj][1]; const float bb[8] = {b0.x, b0.y, b0.z, b0.w, b1.x, b1.y, b1.z, b1.w};
#pragma unroll
                for (int i = 0; i < 8; ++i) x[i] = scale * sigmoidf_(bb[i] + x[i]); }
            u32x4 w; w.x = cvt_pk_bf16(x[0], x[1]); w.y = cvt_pk_bf16(x[2], x[3]); w.z = cvt_pk_bf16(x[4], x[5]); w.w = cvt_pk_bf16(x[6], x[7]);
            *(u32x4*)(dbase + (size_t)row * 1024 + c) = w;
        EPI_LOOP_END
    }
};
struct EpiHy {
    static constexpr bool PERM = true, KEEPS = false;
    const bf16_t* gates; bf16_t* MB;
    __device__ __forceinline__ void operator()(const f32x4 (&acc)[2][2][4][2], const Unit& uu, int wr, int wc, int fr, int fq) const {
        Unit u; u.pm = uu.pm - 2 * 66; u.pn = uu.pn & 7;
        const int row0 = u.pm * 256 + wr * 64 + fr, col0 = u.pn * 256 + wc * 32 + 8 * fq;
        const bf16_t* gcur = gates + 2 * DM + col0;
        u32x4 gq[2], gn[2];
#define EM_ROW(it_) ((size_t)(row0 + ((it_) >> 2) * 128 + ((it_) & 3) * 16))
#pragma unroll
        for (int bj = 0; bj < 2; ++bj) gq[bj] = *(const u32x4*)(gcur + EM_ROW(0) * NGATE + bj * 128);
#pragma unroll
        for (int it = 0; it < 8; ++it) { const int ai = it >> 2, m = it & 3;
            if (it < 7) {
#pragma unroll
                for (int bj = 0; bj < 2; ++bj) gn[bj] = *(const u32x4*)(gcur + EM_ROW(it + 1) * NGATE + bj * 128); }
#pragma unroll
            for (int bj = 0; bj < 2; ++bj) { float g[8]; up8(gq[bj], g); const f32x4 v0 = acc[ai][bj][m][0], v1 = acc[ai][bj][m][1];
#pragma unroll
                for (int i = 0; i < 8; ++i) g[i] = sigmoidf_(g[i]);
                u32x4 w; w.x = cvt_pk_bf16(v0.x * g[0], v0.y * g[1]); w.y = cvt_pk_bf16(v0.z * g[2], v0.w * g[3]); w.z = cvt_pk_bf16(v1.x * g[4], v1.y * g[5]); w.w = cvt_pk_bf16(v1.z * g[6], v1.w * g[7]);
                *(u32x4*)(MB + EM_ROW(it) * DM + col0 + bj * 128) = w; }
            gq[0] = gn[0]; gq[1] = gn[1];
            __builtin_amdgcn_sched_barrier(0); }
    }
};
struct OrderHy {
    pg8::StaticOrder so;
    __device__ void init(int G, int c, int nM, int pm0) { so.init(nM, 8, G, c, pm0); }
    __device__ bool next(int i, Unit& u) const { Unit t; if (!so.next(i, t)) return false; u.pm = 2 * 66 + t.pm; u.pn = 2 * 8 + t.pn; return true; }
};
struct EpiMerge3 {
    static constexpr bool PERM = true, KEEPS = true;
    const bf16_t* gates; bf16_t* MB;
    __device__ __forceinline__ bool operator()(f32x4 (&acc)[2][2][4][2], const Unit& uu, int wr, int wc, int fr, int fq) const {
        const int sub = uu.pn >> 3; Unit u; u.pm = uu.pm - (sub == 0 ? 0 : sub == 1 ? 66 : 396); u.pn = uu.pn & 7;
        const int br = sub == 2 ? 3 : sub, brn = sub == 0 ? 1 : 3; const bool last = sub == 2; const float fs = sub == 0 ? 1.f / Y8A_SCALE : 1.f;
        const int row0 = u.pm * 256 + wr * 64 + fr, col0 = u.pn * 256 + wc * 32 + 8 * fq;
        const bf16_t* gcur = gates + br * DM + col0; const bf16_t* gnxt = gates + brn * DM + col0;
        u32x4 gq[2], hq[2], gn[2], hn[2];
#pragma unroll
        for (int bj = 0; bj < 2; ++bj) { gq[bj] = *(const u32x4*)(gcur + EM_ROW(0) * NGATE + bj * 128); hq[bj] = last ? *(const u32x4*)(MB + EM_ROW(0) * DM + col0 + bj * 128) : *(const u32x4*)(gnxt + EM_ROW(0) * NGATE + bj * 128); }
#pragma unroll
        for (int it = 0; it < 8; ++it) { const int ai = it >> 2, m = it & 3;
            if (it < 7) {
#pragma unroll
                for (int bj = 0; bj < 2; ++bj) { gn[bj] = *(const u32x4*)(gcur + EM_ROW(it + 1) * NGATE + bj * 128); hn[bj] = last ? *(const u32x4*)(MB + EM_ROW(it + 1) * DM + col0 + bj * 128) : *(const u32x4*)(gnxt + EM_ROW(it + 1) * NGATE + bj * 128); } }
#pragma unroll
            for (int bj = 0; bj < 2; ++bj) { float g[8], hh[8]; up8(gq[bj], g); up8(hq[bj], hh); float f[8];
#pragma unroll
                for (int i = 0; i < 8; ++i) { const float ea = __expf(-g[i]), eb = __expf(-hh[i]); f[i] = last ? (1.f / 32.f) / (1.f + ea) : fs * (1.f + eb) / (1.f + ea); }
                f32x4& v0 = acc[ai][bj][m][0]; f32x4& v1 = acc[ai][bj][m][1];
                v0 = v0 * (f32x4){f[0], f[1], f[2], f[3]}; v1 = v1 * (f32x4){f[4], f[5], f[6], f[7]};
                if (last) { u32x4 w; w.x = cvt_pk_bf16(v0.x + hh[0], v0.y + hh[1]); w.y = cvt_pk_bf16(v0.z + hh[2], v0.w + hh[3]); w.z = cvt_pk_bf16(v1.x + hh[4], v1.y + hh[5]); w.w = cvt_pk_bf16(v1.z + hh[6], v1.w + hh[7]);
                    *(u32x4*)(MB + EM_ROW(it) * DM + col0 + bj * 128) = w; } }
            gq[0] = gn[0]; gq[1] = gn[1]; hq[0] = hn[0]; hq[1] = hn[1];
            __builtin_amdgcn_sched_barrier(0); }
#undef EM_ROW
        return !last;
    }
};
struct OrderMerge3 {
    pg8::StaticOrder so;
    __device__ void init(int G, int c, int nM, int pm0) { so.init(nM, 8, G, c, pm0); }
    __device__ bool next(int i, Unit& u) const { Unit t; if (!so.next(i / 3, t)) return false; const int sub = i % 3; u.pm = (sub == 0 ? 0 : sub == 1 ? 66 : 396) + t.pm; u.pn = sub * 8 + t.pn; return true; }
};
struct EpiF32 {
    static constexpr bool PERM = true, KEEPS = false;
    float* O; int ldc;
    __device__ __forceinline__ void operator()(const f32x4 (&acc)[2][2][4][2], const Unit& u, int wr, int wc, int fr, int fq) const {
        EPI_LOOP_BEGIN
            float* o = O + (size_t)row * ldc + u.pn * 256 + cl; *(f32x4*)o = v0; *(f32x4*)(o + 4) = v1;
        EPI_LOOP_END
    }
};
__device__ __forceinline__ int moe_panel(int e, int pi) { return pi < 8 ? (((pi >> 2) * NEXP + e) * 4 + (pi & 3)) : 128 + e; }
struct OrderMoe {
    int npn, G, c, npan;
    __device__ void init(int npn_, int G_, int c_, int npan_) { npn = npn_; G = G_; c = c_; npan = npan_; }
    __device__ bool next(int i, Unit& u) const { const int per = npan * npn;
        if ((G & 7) == 0 && G >= 8) { const int xcd = c & 7, wx = G >> 3, r = c >> 3; const int Lx = i * wx + r; if (Lx >= 2 * per) return false;
            const int e = xcd + 8 * (Lx / per), rem = Lx % per, j = rem / npan, pi = rem % npan; u.pm = moe_panel(e, pi); u.pn = e * npn + j; return true; }
        const int L = i * G + c; if (L >= NEXP * per) return false;
        const int e = L / per, r = L % per, j = r / npan, pi = r % npan; u.pm = moe_panel(e, pi); u.pn = e * npn + j; return true; }
};
struct EpiSwiglu {
    static constexpr bool PERM = true, KEEPS = false;
    unsigned char* HID;
    __device__ __forceinline__ void operator()(const f32x4 (&acc)[2][2][4][2], const Unit& u, int wr, int wc, int fr, int fq) const {
        const int j = u.pn % 11; const int row0 = u.pm * 256 + wr * 64 + fr; const float sc = 1.f / 64.f;
#pragma unroll
        for (int ai = 0; ai < 2; ++ai)
#pragma unroll
            for (int m = 0; m < 4; ++m) { const int row = row0 + ai * 128 + m * 16;
                const f32x4 g0 = acc[ai][0][m][0] * sc, g1 = acc[ai][0][m][1] * sc, u0 = acc[ai][1][m][0] * sc, u1 = acc[ai][1][m][1] * sc;
                u32x2 w; w.x = pk4fp8(siluf_(g0.x) * u0.x, siluf_(g0.y) * u0.y, siluf_(g0.z) * u0.z, siluf_(g0.w) * u0.w);
                w.y = pk4fp8(siluf_(g1.x) * u1.x, siluf_(g1.y) * u1.y, siluf_(g1.z) * u1.z, siluf_(g1.w) * u1.w);
                *(u32x2*)(HID + (size_t)row * EFFP + j * 128 + wc * 32 + 8 * fq) = w; __builtin_amdgcn_sched_barrier(0); }
    }
};
struct EpiDown {
    static constexpr bool PERM = true, KEEPS = false;
    bf16_t* YE;
    __device__ __forceinline__ void operator()(const f32x4 (&acc)[2][2][4][2], const Unit& uu, int wr, int wc, int fr, int fq) const {
        Unit u; u.pm = uu.pm; u.pn = uu.pn & 7; const float s = 1.f / 64.f;
        EPI_LOOP_BEGIN
            u32x4 w; w.x = cvt_pk_bf16(v0.x * s, v0.y * s); w.y = cvt_pk_bf16(v0.z * s, v0.w * s); w.z = cvt_pk_bf16(v1.x * s, v1.y * s); w.w = cvt_pk_bf16(v1.z * s, v1.w * s);
            *(u32x4*)(YE + (size_t)row * DM + u.pn * 256 + cl) = w;
        EPI_LOOP_END
    }
};

namespace att {
using s16x4 = __attribute__((ext_vector_type(4))) short;
using f32x16 = __attribute__((ext_vector_type(16))) float;
constexpr int NW = 8, QBLK = 32, KVBLK = 64, LDQ = 1536, LDKV = 2048, LDO = 1024;
constexpr float SCALE = 0.07216878364870322f;
constexpr float THR = 3.f;
constexpr float P_LOG2_SCALE = 4.f;
#ifndef ATT_SDEPTH
#define ATT_SDEPTH 1
#endif
constexpr int SDEPTH = ATT_SDEPTH;
constexpr int SHM_V = KVBLK * 128 * 2, SHM_K = KVBLK * 128 * 2, SHM_KP = KVBLK * 64 * 2;
constexpr int OFF_V = 0, OFF_K = 2 * SHM_V, OFF_KP = OFF_K + 2 * SHM_K, OFF_WS = OFF_KP + 2 * SHM_KP, OFF_QP = OFF_WS + NW * 64 * 4, SHM_ATTN = OFF_QP + 256 * 256;
static_assert(SHM_ATTN <= 150 * 1024, "attention LDS");
#define KSWZ(row, colB) ((row) * 256 + ((colB) ^ (((row) & 7) << 4)))
#define KPSWZ(row, colB) ((row) * 128 + ((colB) ^ (((row) & 7) << 4)))
#define SBAR() __builtin_amdgcn_sched_barrier(0)
__device__ __forceinline__ int crow(int r, int hi) { return (r & 3) + 8 * (r >> 2) + 4 * hi; }
__device__ __forceinline__ void partialSM(f32x16& p0, f32x16& p1, float& m_reg, float& mn, float& alpha) {
  constexpr float C = SCALE * 1.4426950408889634f;
  float pmax = p0[0]; for (int r = 1; r < 16; ++r) pmax = fmaxf(pmax, p0[r]); for (int r = 0; r < 16; ++r) pmax = fmaxf(pmax, p1[r]);
  { auto rr = __builtin_amdgcn_permlane32_swap(__float_as_uint(pmax), __float_as_uint(pmax), false, false);
    pmax = fmaxf(__uint_as_float(rr[0]), __uint_as_float(rr[1])); }
  if (__builtin_expect(__all(pmax - m_reg <= THR / SCALE), 1)) { mn = m_reg; alpha = 1.f; }
  else { mn = fmaxf(m_reg, pmax); alpha = __builtin_amdgcn_exp2f((m_reg - mn) * C); m_reg = mn; }
  float mnC = -mn * C + P_LOG2_SCALE;
  for (int r = 0; r < 16; ++r) p0[r] = fmaf(p0[r], C, mnC); for (int r = 0; r < 16; ++r) p1[r] = fmaf(p1[r], C, mnC);
  for (int r = 0; r < 16; ++r) p0[r] = __builtin_amdgcn_exp2f(p0[r]);
}
typedef int i32x8a __attribute__((ext_vector_type(8)));
typedef int i32x4a __attribute__((ext_vector_type(4)));
__device__ __forceinline__ void finishSM(f32x16& p0, f32x16& p1, float alpha, float& l_reg, i32x8a& pf) {
  for (int r = 0; r < 16; ++r) p1[r] = __builtin_amdgcn_exp2f(p1[r]);
  f32x2 s2 = {p0[0], p0[1]}, t2 = {p1[0], p1[1]};
#pragma unroll
  for (int r = 2; r < 16; r += 2) { s2 += (f32x2){p0[r], p0[r + 1]}; t2 += (f32x2){p1[r], p1[r + 1]}; }
  s2 += t2; float ps = s2.x + s2.y;
  { auto rr = __builtin_amdgcn_permlane32_swap(__float_as_uint(ps), __float_as_uint(ps), false, false);
    ps = __uint_as_float(rr[0]) + __uint_as_float(rr[1]); }
  l_reg = l_reg * alpha + ps;
#pragma unroll
  for (int i = 0; i < 4; ++i) { pf[i] = (int)pk4fp8(p0[4 * i], p0[4 * i + 1], p0[4 * i + 2], p0[4 * i + 3]); pf[4 + i] = (int)pk4fp8(p1[4 * i], p1[4 * i + 1], p1[4 * i + 2], p1[4 * i + 3]); }
}
__host__ __device__ __forceinline__ int vt_pos(int key) { const int kk = key & 31; return ((kk >> 2) & 1) * 32 + (key >= 32 ? 16 : 0) + (kk & 3) + 4 * (kk >> 3); }
#define K8SWZ(row, bo) ((row) * 128 + (((((bo) >> 4) ^ (((row) >> 1) & 7))) << 4) + ((bo) & 15))
#define P8SWZ(row, bo) ((row) * 64 + (((((bo) >> 4) ^ (((row) >> 2) & 3))) << 4) + ((bo) & 15))
__device__ __forceinline__ i32x8a ld32(const char* p0, const char* p1) { return __builtin_shufflevector(*reinterpret_cast<const i32x4a*>(p0), *reinterpret_cast<const i32x4a*>(p1), 0, 1, 2, 3, 4, 5, 6, 7); }
#define MFMA8(acc, a, b) asm volatile("v_mfma_scale_f32_32x32x64_f8f6f4 %0, %1, %2, %0, %3, %3 op_sel_hi:[0,0,0]" : "+v"(acc) : "v"(a), "v"(b), "v"(sc1))
__device__ __forceinline__ void qkt(f32x16& p0, f32x16& p1, const char* Ks, const char* Kp, const i32x8a (&q8)[3], int r32, int hi) {
  p0 = f32x16{}; p1 = f32x16{}; const int sc1 = 0x7F7F7F7F;
#pragma unroll
  for (int blk = 0; blk < 2; ++blk) { const int bo = blk * 64 + hi * 32;
    const i32x8a a0 = ld32(Ks + K8SWZ(r32, bo), Ks + K8SWZ(r32, bo + 16)), a1 = ld32(Ks + K8SWZ(32 + r32, bo), Ks + K8SWZ(32 + r32, bo + 16));
    MFMA8(p0, a0, q8[blk]); MFMA8(p1, a1, q8[blk]); }
  { const int bo = hi * 32;
    const i32x8a a0 = ld32(Kp + P8SWZ(r32, bo), Kp + P8SWZ(r32, bo + 16)), a1 = ld32(Kp + P8SWZ(32 + r32, bo), Kp + P8SWZ(32 + r32, bo + 16));
    MFMA8(p0, a0, q8[2]); MFMA8(p1, a1, q8[2]); }
  asm volatile("s_nop 15\n\ts_nop 7" ::: "memory");
}
__device__ __forceinline__ u32x2 cvt8(bf16x8 v) { const u32x4 w = __builtin_bit_cast(u32x4, v); return (u32x2){pk4fp8(bflo(w.x), bfhi(w.x), bflo(w.y), bfhi(w.y)), pk4fp8(bflo(w.z), bfhi(w.z), bflo(w.w), bfhi(w.w))}; }
__device__ __forceinline__ void pv_d0(f32x16* o, const char* Vt, const i32x8a pf, int r32, int hi) {
  const int sc1 = 0x7F7F7F7F;
#pragma unroll
  for (int d0 = 0; d0 < 4; ++d0) { const int dim = d0 * 32 + r32; const i32x8a bfr = ld32(Vt + P8SWZ(dim, hi * 32), Vt + P8SWZ(dim, hi * 32 + 16)); MFMA8(o[d0], pf, bfr); }
  asm volatile("s_nop 15\n\ts_nop 7" ::: "memory");
}
__device__ __forceinline__ void attn_unit(const bf16_t* __restrict__ Qb, const unsigned char* __restrict__ KVh, const unsigned char* __restrict__ VTh, const unsigned char* __restrict__ KPE, unsigned char* __restrict__ Ob,
                                          int ka0, int kb0, int NT, char* lds, int tid_in, int tpos0) {
  const unsigned tid_u = (unsigned)tid_in; __builtin_assume(tid_u < 512u);
  const int tid = (int)tid_u, wid = tid >> 6, lane = tid & 63, r32 = lane & 31, hi = lane >> 5;
  char* V_lds = lds + OFF_V; char* K_lds = lds + OFF_K; char* P_lds = lds + OFF_KP;
  float* ws = (float*)(lds + OFF_WS) + wid * 64; float* li_l = ws; float* al_l = ws + 32;
  float m_reg = -1e30f, l_reg = 0; f32x16 o[4] = {}; i32x8a q8[3];
  const int qrow = wid * QBLK + r32;
  const bf16_t* Qrow = Qb + (long)qrow * LDQ;
#pragma unroll
  for (int blk = 0; blk < 2; ++blk) { const bf16_t* src = Qrow + blk * 64 + hi * 32;
#pragma unroll
    for (int i = 0; i < 4; ++i) { const u32x2 c = cvt8(*reinterpret_cast<const bf16x8*>(src + 8 * i)); q8[blk][2 * i] = (int)c.x; q8[blk][2 * i + 1] = (int)c.y; } }
  { const bf16_t* src = Qrow + 128 + hi * 32; float x1[16], x2[16];
    { float t0[8], t1[8]; ld8bf(src, t0); ld8bf(src + 8, t1);
#pragma unroll
      for (int i = 0; i < 8; ++i) { x1[i] = t0[i]; x1[8 + i] = t1[i]; }
      ld8bf(src + 16, t0); ld8bf(src + 24, t1);
#pragma unroll
      for (int i = 0; i < 8; ++i) { x2[i] = t0[i]; x2[8 + i] = t1[i]; } }
    if (tpos0 >= 0) { const int t = tpos0 + qrow; const float pos = (float)(hi == 0 ? (t >> 6) : (t & 63));
#pragma unroll
      for (int i = 0; i < 16; ++i) { const float ang = pos * __builtin_amdgcn_exp2f(-(float)i * 0.8304820237218406f); const float c = __cosf(ang), sn = __sinf(ang);
        const float a0 = x1[i], b0 = x2[i]; x1[i] = a0 * c - b0 * sn; x2[i] = b0 * c + a0 * sn; } }
#pragma unroll
    for (int i = 0; i < 4; ++i) { q8[2][i] = (int)pk4fp8(x1[4 * i], x1[4 * i + 1], x1[4 * i + 2], x1[4 * i + 3]); q8[2][4 + i] = (int)pk4fp8(x2[4 * i], x2[4 * i + 1], x2[4 * i + 2], x2[4 * i + 3]); } }
  const int vdim = tid >> 2, vch = (tid & 3) * 16;
  struct { i32x4a vt, k8, p8; } sr_[SDEPTH];
#define KROW(j) ((j) < 4 ? ka0 + 64 * (j) : kb0 + 64 * ((j) - 4))
  const __amdgpu_buffer_rsrc_t rsKV = __builtin_amdgcn_make_buffer_rsrc((void*)KVh, 0, 0xFFFFFFFFu, 0x00020000);
  const __amdgpu_buffer_rsrc_t rsKP = __builtin_amdgcn_make_buffer_rsrc((void*)KPE, 0, 0xFFFFFFFFu, 0x00020000);
  const __amdgpu_buffer_rsrc_t rsVT = __builtin_amdgcn_make_buffer_rsrc((void*)VTh, 0, 0xFFFFFFFFu, 0x00020000);
  const int vo_v = vdim * T + vch;
  const int krow = tid >> 3, kch = (tid & 7) * 16, vo_k = krow * 128 + kch, vo_p = ((tid & 255) >> 2) * 64 + vch;
#define SLOAD(i, jt) do { const int k0_ = KROW(jt); \
    sr_[i].vt = __builtin_bit_cast(i32x4a, __builtin_amdgcn_raw_buffer_load_b128(rsVT, vo_v, k0_, 0)); \
    sr_[i].k8 = __builtin_bit_cast(i32x4a, __builtin_amdgcn_raw_buffer_load_b128(rsKV, vo_k, k0_ * 128, 0)); \
    sr_[i].p8 = __builtin_bit_cast(i32x4a, __builtin_amdgcn_raw_buffer_load_b128(rsKP, vo_p, k0_ * 64, 0)); } while (0)
#define SWRITE(b, i) do { *(i32x4a*)(V_lds + (b) * SHM_V + P8SWZ(vdim, vch)) = sr_[i].vt;               \
    *(i32x4a*)(K_lds + (b) * SHM_K + K8SWZ(krow, kch)) = sr_[i].k8;                       \
    if (tid < 256) *(i32x4a*)(P_lds + (b) * SHM_KP + P8SWZ(vdim, vch)) = sr_[i].p8; } while (0)
#define SWAIT() do { if constexpr (SDEPTH == 2) asm volatile("s_waitcnt vmcnt(5)" ::: "memory"); else asm volatile("s_waitcnt vmcnt(0)" ::: "memory"); } while (0)
#define RESC(a) do { if (__any((a) < 1.f)) { if (hi == 0) al_l[r32] = (a); asm volatile("s_waitcnt lgkmcnt(0)" ::: "memory"); \
    for (int d = 0; d < 4; ++d) for (int r = 0; r < 16; ++r) o[d][r] *= al_l[crow(r, hi)]; } } while (0)
  f32x16 pA0, pA1, pB0, pB1; float mnA, mnB, alA, alB; i32x8a pf;
  constexpr int SE = 0, SO = SDEPTH - 1;
  SLOAD(SE, 0); asm volatile("s_waitcnt vmcnt(0)" ::: "memory"); SWRITE(0, SE); __syncthreads();
  qkt(pA0, pA1, K_lds, P_lds, q8, r32, hi); partialSM(pA0, pA1, m_reg, mnA, alA);
  SLOAD(SO, 1); if constexpr (SDEPTH == 2) { if (2 < NT) SLOAD(SE, 2); }
  SWAIT(); SWRITE(1, SO); __syncthreads();
  for (int j = 1; j + 1 < NT; j += 2) {
    SBAR(); qkt(pB0, pB1, K_lds + SHM_K, P_lds + SHM_KP, q8, r32, hi);
    finishSM(pA0, pA1, alA, l_reg, pf); SBAR();
    SLOAD(SO, j + SDEPTH); SBAR();
    pv_d0(o, V_lds, pf, r32, hi); partialSM(pB0, pB1, m_reg, mnB, alB);
    __syncthreads(); SWAIT(); SWRITE(0, SE);
    RESC(alB); __syncthreads();
    SBAR(); qkt(pA0, pA1, K_lds, P_lds, q8, r32, hi);
    finishSM(pB0, pB1, alB, l_reg, pf); SBAR();
    if (SDEPTH == 1 || j + 3 < NT) SLOAD(SE, j + 1 + SDEPTH); SBAR();
    pv_d0(o, V_lds + SHM_V, pf, r32, hi); partialSM(pA0, pA1, m_reg, mnA, alA);
    __syncthreads(); SWAIT(); SWRITE(1, SO);
    RESC(alA); __syncthreads();
  }
  SBAR(); qkt(pB0, pB1, K_lds + SHM_K, P_lds + SHM_KP, q8, r32, hi);
  finishSM(pA0, pA1, alA, l_reg, pf); SBAR();
  pv_d0(o, V_lds, pf, r32, hi); partialSM(pB0, pB1, m_reg, mnB, alB);
  __syncthreads(); RESC(alB);
  finishSM(pB0, pB1, alB, l_reg, pf); SBAR();
  pv_d0(o, V_lds + SHM_V, pf, r32, hi);
  if (hi == 0) li_l[r32] = l_reg; asm volatile("s_waitcnt lgkmcnt(0)" ::: "memory");
  float rli[16];
#pragma unroll
  for (int r = 0; r < 16; ++r) rli[r] = __builtin_amdgcn_rcpf(li_l[crow(r, hi)]);
  unsigned char* Ow = Ob + (long)(wid * QBLK) * LDO;
#pragma unroll
  for (int r = 0; r < 16; ++r) { int orow = crow(r, hi);
    for (int d0 = 0; d0 < 4; ++d0) Ow[(long)orow * LDO + d0 * 32 + r32] = (unsigned char)(pk4fp8(o[d0][r] * rli[r] * Y8A_SCALE, 0.f, 0.f, 0.f) & 0xffu); }
  __syncthreads();
#undef KROW
#undef SLOAD
#undef SWRITE
#undef SWAIT
#undef RESC
}
}

__device__ __forceinline__ void phase_vt(Frame& F) {
    const bf16_t* KV = WSP(bf16_t, WS_KV); unsigned char* VT = WSP(unsigned char, WS_VT8);
    LAS unsigned char* scr = (LAS unsigned char*)(F.lds + F.wave * 8192);
    const int lane = F.lane;
    for (int it = F.gw; it < (T / 64) * 8; it += F.NGW) { const int tb = it >> 3, h = it & 7, row0 = tb * 64;
        bf16x8 v[16];
#pragma unroll
        for (int i = 0; i < 16; ++i) v[i] = *(const bf16x8*)(KV + (size_t)(row0 + 4 * i + (lane >> 4)) * 2048 + h * 256 + 128 + (lane & 15) * 8);
#pragma unroll
        for (int i = 0; i < 16; ++i) { const u32x2 c = att::cvt8(v[i]); const int pos = att::vt_pos(4 * i + (lane >> 4)); LAS unsigned char* d = scr + ((lane & 15) * 8) * 64 + pos;
            d[0] = (unsigned char)(c.x & 0xff); d[64] = (unsigned char)((c.x >> 8) & 0xff); d[128] = (unsigned char)((c.x >> 16) & 0xff); d[192] = (unsigned char)(c.x >> 24);
            d[256] = (unsigned char)(c.y & 0xff); d[320] = (unsigned char)((c.y >> 8) & 0xff); d[384] = (unsigned char)((c.y >> 16) & 0xff); d[448] = (unsigned char)(c.y >> 24); }
        LDS_WAIT(); asm volatile("" ::: "memory");
#pragma unroll
        for (int r = 0; r < 2; ++r) { const int d = lane * 2 + r; const LAS u32x4* sp = (const LAS u32x4*)(scr + d * 64); u32x4* gp = (u32x4*)(VT + ((size_t)(h * 128 + d)) * T + row0);
            const u32x4 a0 = sp[0], a1 = sp[1], a2 = sp[2], a3 = sp[3]; gp[0] = a0; gp[1] = a1; gp[2] = a2; gp[3] = a3; }
        LDS_WAIT(); asm volatile("" ::: "memory");
        { unsigned char* K8 = WSP(unsigned char, WS_K8) + ((size_t)h * T + row0) * 128;
#pragma unroll
          for (int i = 0; i < 16; ++i) v[i] = *(const bf16x8*)(KV + (size_t)(row0 + 4 * i + (lane >> 4)) * 2048 + h * 256 + (lane & 15) * 8);
#pragma unroll
          for (int i = 0; i < 16; ++i) *(u32x2*)(K8 + (size_t)(4 * i + (lane >> 4)) * 128 + (lane & 15) * 8) = att::cvt8(v[i]); }
        if (h == 0) { const bf16_t* KPE = WSP(bf16_t, WS_KPE) + (size_t)row0 * 64; unsigned char* P8 = WSP(unsigned char, WS_KPE8) + (size_t)row0 * 64;
#pragma unroll
          for (int i = 0; i < 8; ++i) v[i] = *(const bf16x8*)(KPE + (size_t)(8 * i + (lane >> 3)) * 64 + (lane & 7) * 8);
#pragma unroll
          for (int i = 0; i < 8; ++i) *(u32x2*)(P8 + (size_t)(8 * i + (lane >> 3)) * 64 + (lane & 7) * 8) = att::cvt8(v[i]); }
    }
}
__device__ __forceinline__ void phase_attn(Frame& F, bool lat_only) {
    const bf16_t* Q = WSP(bf16_t, WS_Q); const bf16_t* KV = WSP(bf16_t, WS_KV); const bf16_t* KPE = WSP(bf16_t, WS_KPE); unsigned char* YA = WSP(unsigned char, WS_Y8A);
    const int NU = NBATCH * NH_MLA * 32 + (lat_only ? 0 : NBATCH * NH_MLA);
    const bool xa = (F.G == 256);
    for (int u0 = F.bid; u0 < NU; u0 += F.G) {
        int u = u0;
        if (xa && u0 < NBATCH * NH_MLA * 32) { const int xcd = u0 & 7, r = (u0 >> 3) & 31, rnd = u0 >> 8; u = ((xcd + 8 * rnd) << 5) + r; }
        int b, h, row0, NT, tpos0;
        if (u < NBATCH * NH_MLA * 32) { const int bh = u >> 5, qb = u & 31; b = bh >> 3; h = bh & 7; row0 = TC + b * SEQ + qb * 256; NT = 4 + SEQ / 64; tpos0 = qb * 256; }
        else { const int bh = u - NBATCH * NH_MLA * 32; b = bh >> 3; h = bh & 7; row0 = b * CTX; NT = 4; tpos0 = -1; }
        att::attn_unit(Q + (size_t)row0 * 1536 + h * 192, WSP(unsigned char, WS_K8) + (size_t)h * T * 128, WSP(unsigned char, WS_VT8) + (size_t)h * 128 * T, WSP(unsigned char, WS_KPE8), YA + (size_t)row0 * 1024 + h * 128, b * CTX, TC + b * SEQ, NT, (char*)F.lds, F.tid, tpos0);
    }
}
__device__ __forceinline__ void phase_qrope(Frame& F) {
    bf16_t* Q = WSP(bf16_t, WS_Q);
    for (int row = TC + F.gw; row < T; row += F.NGW) {
        const int t = (row - TC) & (SEQ - 1); const int p = F.lane & 31, axis = p >> 4, j = p & 15, hs = F.lane >> 5;
        const float pos = (float)(axis == 0 ? (t >> 6) : (t & 63)); const float inv = __builtin_amdgcn_exp2f(-(float)j * 0.8304820237218406f);
        const float sn = __sinf(pos * inv), cs = __cosf(pos * inv);
#pragma unroll
        for (int hh = 0; hh < 4; ++hh) { const int h = hh * 2 + hs; bf16_t* q = Q + (size_t)row * 1536 + h * 192 + 128 + axis * 32 + j;
            const float x1 = bf2f(q[0]), x2 = bf2f(q[16]);
            q[0] = (bf16_t)f2bf(x1 * cs - x2 * sn); q[16] = (bf16_t)f2bf(x2 * cs + x1 * sn); }
    }
}

#define MFMA16(a, b, c) __builtin_amdgcn_mfma_f32_16x16x32_bf16((a), (b), (c), 0, 0, 0)
constexpr int XS_LD = 264, BC_LD = 136;
__device__ __forceinline__ float bperm(float v, int srclane) { return __builtin_bit_cast(float, __builtin_amdgcn_ds_bpermute(srclane << 2, __builtin_bit_cast(int, v))); }
__device__ __forceinline__ float wave_incl_scan(float v, int lane) {
#pragma unroll
    for (int o = 1; o < 64; o <<= 1) { const float t = bperm(v, lane - o); if (lane >= o) v += t; }
    return v;
}
template <int NCOLS>
__device__ __forceinline__ void stage_tile(LAS bf16_t* dst, int ld, const bf16_t* src, int tid) {
    constexpr int cpr = NCOLS >> 3, NIT = 128 * cpr / NTHREADS;
    u32x4 v[NIT];
#pragma unroll
    for (int k = 0; k < NIT; ++k) { const int i = tid + k * NTHREADS; const int r = i / cpr, c8 = (i % cpr) * 8; v[k] = *(const u32x4*)(src + (size_t)r * P2W + c8); }
#pragma unroll
    for (int k = 0; k < NIT; ++k) { const int i = tid + k * NTHREADS; const int r = i / cpr, c8 = (i % cpr) * 8; *(LAS u32x4*)(dst + r * ld + c8) = v[k]; }
}
__device__ __forceinline__ void phase_mamba_states(Frame& F, const Args& a, int layer) {
    const bf16_t* P2 = WSP(bf16_t, WS_P2); const float* DT = WSP(float, WS_DT); bf16_t* MST = WSP(bf16_t, WS_MST); float* MCS = WSP(float, WS_MCS);
    LAS bf16_t* XSl = (LAS bf16_t*)F.lds; LAS bf16_t* Bl = (LAS bf16_t*)(F.lds + 67584); LAS float* wt = (LAS float*)(F.lds + 102400) + F.wave * 128;
    const int lane = F.lane, row = lane & 15, quad = lane >> 4;
    for (int u = F.bid; u < NCHUNK * 4; u += F.G) {
        const int chunk = u >> 2, g = (u >> 1) & 1, half = u & 1, row0 = chunk * 128;
        __syncthreads();
        stage_tile<256>(XSl, XS_LD, P2 + (size_t)row0 * P2W + P2_XBC + (g * 8 + half * 4) * 64, F.tid);
        stage_tile<128>(Bl, BC_LD, P2 + (size_t)row0 * P2W + P2_XBC + 1024 + g * 128, F.tid);
        const int hl = F.wave >> 1, d = F.wave & 1, h = g * 8 + half * 4 + hl;
        const float aa = -__expf(arg_in(a, I_SALOG)[(layer * 2 + d) * 16 + h]);
        { const float dt0 = DT[(size_t)(row0 + lane) * 32 + d * 16 + h], dt1 = DT[(size_t)(row0 + 64 + lane) * 32 + d * 16 + h];
          const float da0 = dt0 * aa, da1 = dt1 * aa;
          float c0 = wave_incl_scan(da0, lane); const float tot0 = bperm(c0, 63); float c1 = wave_incl_scan(da1, lane) + tot0; const float tot = bperm(c1, 63);
          if (d == 0) { wt[lane] = dt0 * __expf(tot - c0); wt[64 + lane] = dt1 * __expf(tot - c1); }
          else { wt[lane] = dt0 * __expf(c0 - da0); wt[64 + lane] = dt1 * __expf(c1 - da1); }
          if (lane == 0) MCS[(d * NCHUNK + chunk) * 16 + h] = tot; }
        __syncthreads();
        bf16_t* out = MST + ((size_t)(d * NCHUNK + chunk) * 16 + h) * 8192;
#pragma unroll 1
        for (int nh = 0; nh < 2; ++nh) {
            f32x4 acc[4][4];
#pragma unroll
            for (int i = 0; i < 4; ++i)
#pragma unroll
                for (int j = 0; j < 4; ++j) acc[i][j] = (f32x4){0.f, 0.f, 0.f, 0.f};
#pragma unroll 1
            for (int k0 = 0; k0 < 128; k0 += 32) {
                const int sb = k0 + quad * 8;
                float w8[8];
#pragma unroll
                for (int j = 0; j < 8; ++j) w8[j] = wt[sb + j];
                bf16x8 bf[4];
#pragma unroll
                for (int nt = 0; nt < 4; ++nt) {
#pragma unroll
                    for (int j = 0; j < 8; ++j) bf[nt][j] = (short)Bl[(sb + j) * BC_LD + (nh * 4 + nt) * 16 + row]; }
#pragma unroll
                for (int pt = 0; pt < 4; ++pt) { bf16x8 af;
#pragma unroll
                    for (int j = 0; j < 8; ++j) af[j] = (short)f2bf(w8[j] * bf2f(XSl[(sb + j) * XS_LD + hl * 64 + pt * 16 + row]));
#pragma unroll
                    for (int nt = 0; nt < 4; ++nt) acc[pt][nt] = MFMA16(af, bf[nt], acc[pt][nt]); }
            }
#pragma unroll
            for (int pt = 0; pt < 4; ++pt)
#pragma unroll
                for (int nt = 0; nt < 4; ++nt)
#pragma unroll
                    for (int jj = 0; jj < 4; ++jj) out[(pt * 16 + quad * 4 + jj) * 128 + (nh * 4 + nt) * 16 + row] = (bf16_t)f2bf(acc[pt][nt][jj]);
        }
    }
}
__device__ __forceinline__ void phase_mamba_scan(Frame& F) {
    bf16_t* MST = WSP(bf16_t, WS_MST); const float* MCS = WSP(float, WS_MCS);
    for (int idx = F.bid * NTHREADS + F.tid; idx < 2 * 2 * 16 * 8192; idx += F.G * NTHREADS) {
        const int e = idx & 8191, h = (idx >> 13) & 15, b = (idx >> 17) & 1, d = idx >> 18;
        float state = 0.f;
#pragma unroll 6
        for (int i = 0; i < 66; ++i) {
            int chunk; if (i < 2) chunk = 2 * b + (d == 0 ? i : 1 - i); else chunk = 4 + 64 * b + (d == 0 ? i - 2 : 65 - i);
            bf16_t* p = MST + ((size_t)(d * NCHUNK + chunk) * 16 + h) * 8192 + e;
            const float cs = bf2f(*p); const float dec = __expf(MCS[(d * NCHUNK + chunk) * 16 + h]);
            *p = (bf16_t)f2bf(state);
            state = state * dec + cs;
        }
    }
}
__device__ __forceinline__ void phase_mamba_out(Frame& F, const Args& a, int layer) {
    const bf16_t* P = WSP(bf16_t, WS_P); const bf16_t* P2 = WSP(bf16_t, WS_P2); const float* DT = WSP(float, WS_DT); const bf16_t* MST = WSP(bf16_t, WS_MST);
    bf16_t* YB = WSP(bf16_t, WS_Y) + (size_t)1 * T * 1024;
    LAS bf16_t* Cl = (LAS bf16_t*)F.lds; LAS bf16_t* Bl = (LAS bf16_t*)(F.lds + 34816); LAS bf16_t* XSl = (LAS bf16_t*)(F.lds + 69632);
    LAS float* tab = (LAS float*)(F.lds + 137216);
    for (int u = F.bid; u < NCHUNK * 4; u += F.G) {
        const int chunk = u >> 2, g = (u >> 1) & 1, half = u & 1, row0 = chunk * 128;
        __syncthreads();
        { const int tid_ = F.wave * 64 + (lane_asm() & 63);
          stage_tile<256>(XSl, XS_LD, P2 + (size_t)row0 * P2W + P2_XBC + (g * 8 + half * 4) * 64, tid_);
          stage_tile<128>(Bl, BC_LD, P2 + (size_t)row0 * P2W + P2_XBC + 1024 + g * 128, tid_);
          stage_tile<128>(Cl, BC_LD, P2 + (size_t)row0 * P2W + P2_XBC + 1280 + g * 128, tid_); }
        const int lane = lane_asm() & 63, row = lane & 15, quad = lane >> 4;
        float tot1 = 0.f;
        { const int hl = F.wave >> 1, d = F.wave & 1, h = g * 8 + half * 4 + hl;
          const float aa = -__expf(arg_in(a, I_SALOG)[(layer * 2 + d) * 16 + h]);
          const float dt0 = DT[(size_t)(row0 + lane) * 32 + d * 16 + h], dt1 = DT[(size_t)(row0 + 64 + lane) * 32 + d * 16 + h];
          const float da0 = dt0 * aa, da1 = dt1 * aa;
          float c0 = wave_incl_scan(da0, lane); const float t0 = bperm(c0, 63); float c1 = wave_incl_scan(da1, lane) + t0;
          LAS float* tb = tab + hl * 512;
          if (d == 0) { tb[lane] = c0; tb[64 + lane] = c1; tb[256 + lane] = __logf(dt0) - c0; tb[320 + lane] = __logf(dt1) - c1; }
          else { tb[128 + lane] = c0 - da0; tb[192 + lane] = c1 - da1; tb[384 + lane] = (c0 - da0) + __logf(dt0); tb[448 + lane] = (c1 - da1) + __logf(dt1); if (lane == 63) tab[2048 + hl] = c1; } }
        __syncthreads();
        { f32x4 cb[8];
#pragma unroll
          for (int st = 0; st < 8; ++st) cb[st] = (f32x4){0.f, 0.f, 0.f, 0.f};
#pragma unroll
          for (int k0 = 0; k0 < 128; k0 += 32) { const bf16x8 af = *(const LAS bf16x8*)(Cl + (F.wave * 16 + row) * BC_LD + k0 + quad * 8);
#pragma unroll
              for (int st = 0; st < 8; ++st) { const bf16x8 bfr = *(const LAS bf16x8*)(Bl + (st * 16 + row) * BC_LD + k0 + quad * 8); cb[st] = MFMA16(af, bfr, cb[st]); } }
          __syncthreads();
#pragma unroll
          for (int st = 0; st < 8; ++st)
#pragma unroll
              for (int jj = 0; jj < 4; ++jj) Bl[(F.wave * 16 + quad * 4 + jj) * BC_LD + st * 16 + row] = (bf16_t)f2bf(cb[st][jj]); }
        __syncthreads();
        const int hl = F.wave >> 1, th = F.wave & 1, h = g * 8 + half * 4 + hl;
        const LAS float* tb = tab + hl * 512; tot1 = tab[2048 + hl];
        f32x4 acc[4][4];
#pragma unroll
        for (int i = 0; i < 4; ++i)
#pragma unroll
            for (int j = 0; j < 4; ++j) acc[i][j] = (f32x4){0.f, 0.f, 0.f, 0.f};
#pragma unroll 1
        for (int k0 = 0; k0 < 128; k0 += 32) {
            const int sb = k0 + quad * 8;
            float u0s[8], u1s[8];
#pragma unroll
            for (int j = 0; j < 8; ++j) { u0s[j] = tb[256 + sb + j]; u1s[j] = tb[384 + sb + j]; }
            bf16x8 bx[4];
#pragma unroll
            for (int pt = 0; pt < 4; ++pt) {
#pragma unroll
                for (int j = 0; j < 8; ++j) bx[pt][j] = (short)XSl[(sb + j) * XS_LD + hl * 64 + pt * 16 + row]; }
#pragma unroll
            for (int tt = 0; tt < 4; ++tt) { const int t = th * 64 + tt * 16 + row; const float c0t = tb[t], e1t = tb[128 + t];
                float cbv[8]; { const u32x4 w = *(const LAS u32x4*)(Bl + t * BC_LD + sb); cbv[0] = bflo(w.x); cbv[1] = bfhi(w.x); cbv[2] = bflo(w.y); cbv[3] = bfhi(w.y); cbv[4] = bflo(w.z); cbv[5] = bfhi(w.z); cbv[6] = bflo(w.w); cbv[7] = bfhi(w.w); }
                bf16x8 af;
#pragma unroll
                for (int j = 0; j < 8; ++j) { const int s = sb + j;
                    const float f0 = s <= t ? __expf(c0t + u0s[j]) : 0.f;
                    const float f1 = s >= t ? __expf(u1s[j] - e1t) : 0.f;
                    af[j] = (short)f2bf(cbv[j] * (f0 + f1)); }
#pragma unroll
                for (int pt = 0; pt < 4; ++pt) acc[tt][pt] = MFMA16(af, bx[pt], acc[tt][pt]); }
        }
#pragma unroll 1
        for (int d = 0; d < 2; ++d) {
            const bf16_t* S = MST + ((size_t)(d * NCHUNK + chunk) * 16 + h) * 8192;
#pragma unroll 1
            for (int k0 = 0; k0 < 128; k0 += 32) {
                bf16x8 bs[4];
#pragma unroll
                for (int pt = 0; pt < 4; ++pt) bs[pt] = *(const bf16x8*)(S + (pt * 16 + row) * 128 + k0 + quad * 8);
#pragma unroll
                for (int tt = 0; tt < 4; ++tt) { const int t = th * 64 + tt * 16 + row;
                    const float sc = d == 0 ? __expf(tb[t]) : __expf(tot1 - tb[128 + t]);
                    const u32x4 cw = *(const LAS u32x4*)(Cl + t * BC_LD + k0 + quad * 8);
                    u32x4 aw; aw.x = cvt_pk_bf16(bflo(cw.x) * sc, bfhi(cw.x) * sc); aw.y = cvt_pk_bf16(bflo(cw.y) * sc, bfhi(cw.y) * sc);
                    aw.z = cvt_pk_bf16(bflo(cw.z) * sc, bfhi(cw.z) * sc); aw.w = cvt_pk_bf16(bflo(cw.w) * sc, bfhi(cw.w) * sc);
                    const bf16x8 af = __builtin_bit_cast(bf16x8, aw);
#pragma unroll
                    for (int pt = 0; pt < 4; ++pt) acc[tt][pt] = MFMA16(af, bs[pt], acc[tt][pt]); } }
        }
        const float Dh = arg_in(a, I_SD)[layer * 16 + h];
#pragma unroll
        for (int tt = 0; tt < 4; ++tt)
#pragma unroll
            for (int jj = 0; jj < 4; ++jj) { const int t = th * 64 + tt * 16 + quad * 4 + jj; const size_t r = (size_t)(row0 + t);
#pragma unroll
                for (int pt = 0; pt < 4; ++pt) { const int p = pt * 16 + row;
                    const float xs = bf2f(XSl[t * XS_LD + hl * 64 + p]); const float z = bf2f(P[r * NNG + P_Z + h * 64 + p]);
                    YB[r * 1024 + h * 64 + p] = (bf16_t)f2bf((acc[tt][pt][jj] + xs * Dh) * siluf_(z)); } }
    }
}
__device__ __forceinline__ void phase_mamba_norm(Frame& F, const Args& a, int layer) {
    bf16_t* YB = WSP(bf16_t, WS_Y) + (size_t)1 * T * 1024; const float* nw = arg_in(a, I_SNORM) + layer * 1024;
    for (int row = F.gw; row < T; row += F.NGW) {
        bf16_t* p = YB + (size_t)row * 1024 + F.lane * 16; float x[16]; { float t0[8], t1[8]; ld8bf(p, t0); ld8bf(p + 8, t1);
#pragma unroll
            for (int i = 0; i < 8; ++i) { x[i] = t0[i]; x[8 + i] = t1[i]; } }
        float s = 0.f;
#pragma unroll
        for (int i = 0; i < 16; ++i) s += x[i] * x[i];
        s = sum32(s);
        const float r = 1.f / sqrtf(s * (1.f / 512.f) + 1e-5f);
        float o0[8], o1[8];
#pragma unroll
        for (int i = 0; i < 8; ++i) { o0[i] = x[i] * r * nw[F.lane * 16 + i]; o1[i] = x[8 + i] * r * nw[F.lane * 16 + 8 + i]; }
        *(u32x4*)(WSP(unsigned char, WS_Y8B) + (size_t)row * 1024 + F.lane * 16) = (u32x4){pk4fp8(o0[0], o0[1], o0[2], o0[3]), pk4fp8(o0[4], o0[5], o0[6], o0[7]), pk4fp8(o1[0], o1[1], o1[2], o1[3]), pk4fp8(o1[4], o1[5], o1[6], o1[7])};
    }
}

__device__ __forceinline__ float dpp_f(float x, const int ctrl_sel) {
    const int xi = __builtin_bit_cast(int, x); int r;
    if (ctrl_sel == 0) r = __builtin_amdgcn_update_dpp(0, xi, 0xB1, 0xF, 0xF, false);
    else if (ctrl_sel == 1) r = __builtin_amdgcn_update_dpp(0, xi, 0x4E, 0xF, 0xF, false);
    else r = __builtin_amdgcn_update_dpp(0, xi, 0x141, 0xF, 0xF, false);
    return __builtin_bit_cast(float, r);
}
__device__ __forceinline__ float red8(float x) { x += dpp_f(x, 0); x += dpp_f(x, 1); x += dpp_f(x, 2); return x; }
__device__ __forceinline__ int rw_row(int pos, int b, int d) { return pos < CTX ? b * CTX + (d == 0 ? pos : CTX - 1 - pos) : TC + b * SEQ + (d == 0 ? pos - CTX : SEQ - 1 - (pos - CTX)); }
constexpr int RW_STEP_F = 352, RW_CH = 32, RW_CHF = RW_STEP_F * RW_CH;
#define RW_CHUNK_ASM \
    "ds_read_b128 v[152:155], %[a16] offset:0\n\t" \
    "ds_read_b128 v[156:159], %[a16] offset:512\n\t" \
    "ds_read_b64 v[160:161], %[a8] offset:0\n\t" \
    "ds_read_b64 v[162:163], %[av] offset:0\n\t" \
    "ds_read_b128 v[164:167], %[a16] offset:1408\n\t" \
    "ds_read_b128 v[168:171], %[a16] offset:1920\n\t" \
    "ds_read_b64 v[172:173], %[a8] offset:1408\n\t" \
    "ds_read_b64 v[174:175], %[av] offset:1408\n\t" \
    "ds_read_b128 v[176:179], %[a16] offset:2816\n\t" \
    "ds_read_b128 v[180:183], %[a16] offset:3328\n\t" \
    "ds_read_b64 v[184:185], %[a8] offset:2816\n\t" \
    "ds_read_b64 v[186:187], %[av] offset:2816\n\t" \
    "s_waitcnt lgkmcnt(8)\n\t" \
    "v_pk_mul_f32 v[218:219], v[154:155], v[162:163] op_sel_hi:[1,0]\n\t" \
    "v_pk_mul_f32 v[200:201], %[sm], v[158:159]\n\t" \
    "v_pk_mul_f32 v[202:203], %[so], v[158:159]\n\t" \
    "v_pk_mul_f32 v[220:221], v[154:155], v[162:163] op_sel:[0,1] op_sel_hi:[1,1]\n\t" \
    "v_add_f32 v208, v200, v201\n\t" \
    "v_add_f32 v209, v202, v203\n\t" \
    "v_pk_fma_f32 v[218:219], %[sm], v[152:153], v[218:219]\n\t" \
    "v_pk_fma_f32 v[220:221], %[so], v[152:153], v[220:221]\n\t" \
    "v_add_f32_dpp v226, v209, v208 quad_perm:[1,0,3,2] row_mask:0xf bank_mask:0xf bound_ctrl:1\n\t" \
    "ds_read_b128 v[188:191], %[a16] offset:4224\n\t" \
    "ds_read_b128 v[192:195], %[a16] offset:4736\n\t" \
    "v_add_f32_dpp v226, v226, v226 quad_perm:[2,3,0,1] row_mask:0xf bank_mask:0xf bound_ctrl:1\n\t" \
    "ds_read_b64 v[196:197], %[a8] offset:4224\n\t" \
    "ds_read_b64 v[198:199], %[av] offset:4224\n\t" \
    "v_add_f32_dpp v226, v226, v226 row_ror:4 row_mask:0xf bank_mask:0xf bound_ctrl:1\n\t" \
    "s_nop 1\n\t" \
    "v_add_f32_dpp v226, v226, v226 row_ror:8 row_mask:0xf bank_mask:0xf bound_ctrl:1\n\t" \
    "v_mov_b32 v227, v226\n\t" \
    "s_nop 1\n\t" \
    "v_permlane16_swap_b32 v226, v227\n\t" \
    "s_waitcnt lgkmcnt(8)\n\t" \
    "v_add_f32 v216, v226, v227\n\t" \
    "v_pk_mul_f32 v[222:223], v[166:167], v[174:175] op_sel_hi:[1,0]\n\t" \
    "v_pk_fma_f32 %[sm], v[156:157], v[216:217], v[218:219] op_sel_hi:[1,0,1]\n\t" \
    "v_mov_b32_dpp v214, v216 quad_perm:[1,0,3,2] row_mask:0xf bank_mask:0xf\n\t" \
    "v_pk_mul_f32 v[200:201], %[sm], v[170:171]\n\t" \
    "v_pk_fma_f32 %[so], v[156:157], v[214:215], v[220:221] op_sel_hi:[1,0,1]\n\t" \
    "v_add_f32 v208, v200, v201\n\t" \
    "v_pk_mul_f32 v[202:203], %[so], v[170:171]\n\t" \
    "v_pk_mul_f32 v[204:205], %[sm], v[160:161]\n\t" \
    "v_add_f32 v209, v202, v203\n\t" \
    "v_pk_mul_f32 v[206:207], %[so], v[160:161]\n\t" \
    "v_add_f32 v210, v204, v205\n\t" \
    "v_add_f32_dpp v226, v209, v208 quad_perm:[1,0,3,2] row_mask:0xf bank_mask:0xf bound_ctrl:1\n\t" \
    "ds_read_b128 v[152:155], %[a16] offset:5632\n\t" \
    "v_add_f32 v211, v206, v207\n\t" \
    "v_pk_fma_f32 v[222:223], %[sm], v[164:165], v[222:223]\n\t" \
    "v_add_f32_dpp v226, v226, v226 quad_perm:[2,3,0,1] row_mask:0xf bank_mask:0xf bound_ctrl:1\n\t" \
    "ds_read_b128 v[156:159], %[a16] offset:6144\n\t" \
    "v_pk_mul_f32 v[224:225], v[166:167], v[174:175] op_sel:[0,1] op_sel_hi:[1,1]\n\t" \
    "v_add_f32_dpp v212, v211, v210 quad_perm:[1,0,3,2] row_mask:0xf bank_mask:0xf bound_ctrl:1\n\t" \
    "v_add_f32_dpp v226, v226, v226 row_ror:4 row_mask:0xf bank_mask:0xf bound_ctrl:1\n\t" \
    "v_pk_fma_f32 v[224:225], %[so], v[164:165], v[224:225]\n\t" \
    "ds_read_b64 v[160:161], %[a8] offset:5632\n\t" \
    "v_add_f32_dpp v226, v226, v226 row_ror:8 row_mask:0xf bank_mask:0xf bound_ctrl:1\n\t" \
    "v_mov_b32 v227, v226\n\t" \
    "ds_write_b32 %[ya], v212 offset:0\n\t" \
    "ds_read_b64 v[162:163], %[av] offset:5632\n\t" \
    "v_permlane16_swap_b32 v226, v227\n\t" \
    "s_waitcnt lgkmcnt(9)\n\t" \
    "v_add_f32 v216, v226, v227\n\t" \
    "v_pk_mul_f32 v[218:219], v[178:179], v[186:187] op_sel_hi:[1,0]\n\t" \
    "v_pk_fma_f32 %[sm], v[168:169], v[216:217], v[222:223] op_sel_hi:[1,0,1]\n\t" \
    "v_mov_b32_dpp v214, v216 quad_perm:[1,0,3,2] row_mask:0xf bank_mask:0xf\n\t" \
    "v_pk_mul_f32 v[200:201], %[sm], v[182:183]\n\t" \
    "v_pk_fma_f32 %[so], v[168:169], v[214:215], v[224:225] op_sel_hi:[1,0,1]\n\t" \
    "v_add_f32 v208, v200, v201\n\t" \
    "v_pk_mul_f32 v[202:203], %[so], v[182:183]\n\t" \
    "v_pk_mul_f32 v[204:205], %[sm], v[172:173]\n\t" \
    "v_add_f32 v209, v202, v203\n\t" \
    "v_pk_mul_f32 v[206:207], %[so], v[172:173]\n\t" \
    "v_add_f32 v210, v204, v205\n\t" \
    "v_add_f32_dpp v226, v209, v208 quad_perm:[1,0,3,2] row_mask:0xf bank_mask:0xf bound_ctrl:1\n\t" \
    "ds_read_b128 v[164:167], %[a16] offset:7040\n\t" \
    "v_add_f32 v211, v206, v207\n\t" \
    "v_pk_fma_f32 v[218:219], %[sm], v[176:177], v[218:219]\n\t" \
    "v_add_f32_dpp v226, v226, v226 quad_perm:[2,3,0,1] row_mask:0xf bank_mask:0xf bound_ctrl:1\n\t" \
    "ds_read_b128 v[168:171], %[a16] offset:7552\n\t" \
    "v_pk_mul_f32 v[220:221], v[178:179], v[186:187] op_sel:[0,1] op_sel_hi:[1,1]\n\t" \
    "v_add_f32_dpp v212, v211, v210 quad_perm:[1,0,3,2] row_mask:0xf bank_mask:0xf bound_ctrl:1\n\t" \
    "v_add_f32_dpp v226, v226, v226 row_ror:4 row_mask:0xf bank_mask:0xf bound_ctrl:1\n\t" \
    "v_pk_fma_f32 v[220:221], %[so], v[176:177], v[220:221]\n\t" \
    "ds_read_b64 v[172:173], %[a8] offset:7040\n\t" \
    "v_add_f32_dpp v226, v226, v226 row_ror:8 row_mask:0xf bank_mask:0xf bound_ctrl:1\n\t" \
    "v_mov_b32 v227, v226\n\t" \
    "ds_write_b32 %[ya], v212 offset:1024\n\t" \
    "ds_read_b64 v[174:175], %[av] offset:7040\n\t" \
    "v_permlane16_swap_b32 v226, v227\n\t" \
    "s_waitcnt lgkmcnt(10)\n\t" \
    "v_add_f32 v216, v226, v227\n\t" \
    "v_pk_mul_f32 v[222:223], v[190:191], v[198:199] op_sel_hi:[1,0]\n\t" \
    "v_pk_fma_f32 %[sm], v[180:181], v[216:217], v[218:219] op_sel_hi:[1,0,1]\n\t" \
    "v_mov_b32_dpp v214, v216 quad_perm:[1,0,3,2] row_mask:0xf bank_mask:0xf\n\t" \
    "v_pk_mul_f32 v[200:201], %[sm], v[194:195]\n\t" \
    "v_pk_fma_f32 %[so], v[180:181], v[214:215], v[220:221] op_sel_hi:[1,0,1]\n\t" \
    "v_add_f32 v208, v200, v201\n\t" \
    "v_pk_mul_f32 v[202:203], %[so], v[194:195]\n\t" \
    "v_pk_mul_f32 v[204:205], %[sm], v[184:185]\n\t" \
    "v_add_f32 v209, v202, v203\n\t" \
    "v_pk_mul_f32 v[206:207], %[so], v[184:185]\n\t" \
    "v_add_f32 v210, v204, v205\n\t" \
    "v_add_f32_dpp v226, v209, v208 quad_perm:[1,0,3,2] row_mask:0xf bank_mask:0xf bound_ctrl:1\n\t" \
    "ds_read_b128 v[176:179], %[a16] offset:8448\n\t" \
    "v_add_f32 v211, v206, v207\n\t" \
    "v_pk_fma_f32 v[222:223], %[sm], v[188:189], v[222:223]\n\t" \
    "v_add_f32_dpp v226, v226, v226 quad_perm:[2,3,0,1] row_mask:0xf bank_mask:0xf bound_ctrl:1\n\t" \
    "ds_read_b128 v[180:183], %[a16] offset:8960\n\t" \
    "v_pk_mul_f32 v[224:225], v[190:191], v[198:199] op_sel:[0,1] op_sel_hi:[1,1]\n\t" \
    "v_add_f32_dpp v212, v211, v210 quad_perm:[1,0,3,2] row_mask:0xf bank_mask:0xf bound_ctrl:1\n\t" \
    "v_add_f32_dpp v226, v226, v226 row_ror:4 row_mask:0xf bank_mask:0xf bound_ctrl:1\n\t" \
    "v_pk_fma_f32 v[224:225], %[so], v[188:189], v[224:225]\n\t" \
    "ds_read_b64 v[184:185], %[a8] offset:8448\n\t" \
    "v_add_f32_dpp v226, v226, v226 row_ror:8 row_mask:0xf bank_mask:0xf bound_ctrl:1\n\t" \
    "v_mov_b32 v227, v226\n\t" \
    "ds_write_b32 %[ya], v212 offset:2048\n\t" \
    "ds_read_b64 v[186:187], %[av] offset:8448\n\t" \
    "v_permlane16_swap_b32 v226, v227\n\t" \
    "s_waitcnt lgkmcnt(10)\n\t" \
    "v_add_f32 v216, v226, v227\n\t" \
    "v_pk_mul_f32 v[218:219], v[154:155], v[162:163] op_sel_hi:[1,0]\n\t" \
    "v_pk_fma_f32 %[sm], v[192:193], v[216:217], v[222:223] op_sel_hi:[1,0,1]\n\t" \
    "v_mov_b32_dpp v214, v216 quad_perm:[1,0,3,2] row_mask:0xf bank_mask:0xf\n\t" \
    "v_pk_mul_f32 v[200:201], %[sm], v[158:159]\n\t" \
    "v_pk_fma_f32 %[so], v[192:193], v[214:215], v[224:225] op_sel_hi:[1,0,1]\n\t" \
    "v_add_f32 v208, v200, v201\n\t" \
    "v_pk_mul_f32 v[202:203], %[so], v[158:159]\n\t" \
    "v_pk_mul_f32 v[204:205], %[sm], v[196:197]\n\t" \
    "v_add_f32 v209, v202, v203\n\t" \
    "v_pk_mul_f32 v[206:207], %[so], v[196:197]\n\t" \
    "v_add_f32 v210, v204, v205\n\t" \
    "v_add_f32_dpp v226, v209, v208 quad_perm:[1,0,3,2] row_mask:0xf bank_mask:0xf bound_ctrl:1\n\t" \
    "ds_read_b128 v[188:191], %[a16] offset:9856\n\t" \
    "v_add_f32 v211, v206, v207\n\t" \
    "v_pk_fma_f32 v[218:219], %[sm], v[152:153], v[218:219]\n\t" \
    "v_add_f32_dpp v226, v226, v226 quad_perm:[2,3,0,1] row_mask:0xf bank_mask:0xf bound_ctrl:1\n\t" \
    "ds_read_b128 v[192:195], %[a16] offset:10368\n\t" \
    "v_pk_mul_f32 v[220:221], v[154:155], v[162:163] op_sel:[0,1] op_sel_hi:[1,1]\n\t" \
    "v_add_f32_dpp v212, v211, v210 quad_perm:[1,0,3,2] row_mask:0xf bank_mask:0xf bound_ctrl:1\n\t" \
    "v_add_f32_dpp v226, v226, v226 row_ror:4 row_mask:0xf bank_mask:0xf bound_ctrl:1\n\t" \
    "v_pk_fma_f32 v[220:221], %[so], v[152:153], v[220:221]\n\t" \
    "ds_read_b64 v[196:197], %[a8] offset:9856\n\t" \
    "v_add_f32_dpp v226, v226, v226 row_ror:8 row_mask:0xf bank_mask:0xf bound_ctrl:1\n\t" \
    "v_mov_b32 v227, v226\n\t" \
    "ds_write_b32 %[ya], v212 offset:3072\n\t" \
    "ds_read_b64 v[198:199], %[av] offset:9856\n\t" \
    "v_permlane16_swap_b32 v226, v227\n\t" \
    "s_waitcnt lgkmcnt(10)\n\t" \
    "v_add_f32 v216, v226, v227\n\t" \
    "v_pk_mul_f32 v[222:223], v[166:167], v[174:175] op_sel_hi:[1,0]\n\t" \
    "v_pk_fma_f32 %[sm], v[156:157], v[216:217], v[218:219] op_sel_hi:[1,0,1]\n\t" \
    "v_mov_b32_dpp v214, v216 quad_perm:[1,0,3,2] row_mask:0xf bank_mask:0xf\n\t" \
    "v_pk_mul_f32 v[200:201], %[sm], v[170:171]\n\t" \
    "v_pk_fma_f32 %[so], v[156:157], v[214:215], v[220:221] op_sel_hi:[1,0,1]\n\t" \
    "v_add_f32 v208, v200, v201\n\t" \
    "v_pk_mul_f32 v[202:203], %[so], v[170:171]\n\t" \
    "v_pk_mul_f32 v[204:205], %[sm], v[160:161]\n\t" \
    "v_add_f32 v209, v202, v203\n\t" \
    "v_pk_mul_f32 v[206:207], %[so], v[160:161]\n\t" \
    "v_add_f32 v210, v204, v205\n\t" \
    "v_add_f32_dpp v226, v209, v208 quad_perm:[1,0,3,2] row_mask:0xf bank_mask:0xf bound_ctrl:1\n\t" \
    "ds_read_b128 v[152:155], %[a16] offset:11264\n\t" \
    "v_add_f32 v211, v206, v207\n\t" \
    "v_pk_fma_f32 v[222:223], %[sm], v[164:165], v[222:223]\n\t" \
    "v_add_f32_dpp v226, v226, v226 quad_perm:[2,3,0,1] row_mask:0xf bank_mask:0xf bound_ctrl:1\n\t" \
    "ds_read_b128 v[156:159], %[a16] offset:11776\n\t" \
    "v_pk_mul_f32 v[224:225], v[166:167], v[174:175] op_sel:[0,1] op_sel_hi:[1,1]\n\t" \
    "v_add_f32_dpp v212, v211, v210 quad_perm:[1,0,3,2] row_mask:0xf bank_mask:0xf bound_ctrl:1\n\t" \
    "v_add_f32_dpp v226, v226, v226 row_ror:4 row_mask:0xf bank_mask:0xf bound_ctrl:1\n\t" \
    "v_pk_fma_f32 v[224:225], %[so], v[164:165], v[224:225]\n\t" \
    "ds_read_b64 v[160:161], %[a8] offset:11264\n\t" \
    "v_add_f32_dpp v226, v226, v226 row_ror:8 row_mask:0xf bank_mask:0xf bound_ctrl:1\n\t" \
    "v_mov_b32 v227, v226\n\t" \
    "ds_write_b32 %[ya], v212 offset:4096\n\t" \
    "ds_read_b64 v[162:163], %[av] offset:11264\n\t" \
    "v_permlane16_swap_b32 v226, v227\n\t" \
    "s_waitcnt lgkmcnt(10)\n\t" \
    "v_add_f32 v216, v226, v227\n\t" \
    "v_pk_mul_f32 v[218:219], v[178:179], v[186:187] op_sel_hi:[1,0]\n\t" \
    "v_pk_fma_f32 %[sm], v[168:169], v[216:217], v[222:223] op_sel_hi:[1,0,1]\n\t" \
    "v_mov_b32_dpp v214, v216 quad_perm:[1,0,3,2] row_mask:0xf bank_mask:0xf\n\t" \
    "v_pk_mul_f32 v[200:201], %[sm], v[182:183]\n\t" \
    "v_pk_fma_f32 %[so], v[168:169], v[214:215], v[224:225] op_sel_hi:[1,0,1]\n\t" \
    "v_add_f32 v208, v200, v201\n\t" \
    "v_pk_mul_f32 v[202:203], %[so], v[182:183]\n\t" \
    "v_pk_mul_f32 v[204:205], %[sm], v[172:173]\n\t" \
    "v_add_f32 v209, v202, v203\n\t" \
    "v_pk_mul_f32 v[206:207], %[so], v[172:173]\n\t" \
    "v_add_f32 v210, v204, v205\n\t" \
    "v_add_f32_dpp v226, v209, v208 quad_perm:[1,0,3,2] row_mask:0xf bank_mask:0xf bound_ctrl:1\n\t" \
    "ds_read_b128 v[164:167], %[a16] offset:12672\n\t" \
    "v_add_f32 v211, v206, v207\n\t" \
    "v_pk_fma_f32 v[218:219], %[sm], v[176:177], v[218:219]\n\t" \
    "v_add_f32_dpp v226, v226, v226 quad_perm:[2,3,0,1] row_mask:0xf bank_mask:0xf bound_ctrl:1\n\t" \
    "ds_read_b128 v[168:171], %[a16] offset:13184\n\t" \
    "v_pk_mul_f32 v[220:221], v[178:179], v[186:187] op_sel:[0,1] op_sel_hi:[1,1]\n\t" \
    "v_add_f32_dpp v212, v211, v210 quad_perm:[1,0,3,2] row_mask:0xf bank_mask:0xf bound_ctrl:1\n\t" \
    "v_add_f32_dpp v226, v226, v226 row_ror:4 row_mask:0xf bank_mask:0xf bound_ctrl:1\n\t" \
    "v_pk_fma_f32 v[220:221], %[so], v[176:177], v[220:221]\n\t" \
    "ds_read_b64 v[172:173], %[a8] offset:12672\n\t" \
    "v_add_f32_dpp v226, v226, v226 row_ror:8 row_mask:0xf bank_mask:0xf bound_ctrl:1\n\t" \
    "v_mov_b32 v227, v226\n\t" \
    "ds_write_b32 %[ya], v212 offset:5120\n\t" \
    "ds_read_b64 v[174:175], %[av] offset:12672\n\t" \
    "v_permlane16_swap_b32 v226, v227\n\t" \
    "s_waitcnt lgkmcnt(10)\n\t" \
    "v_add_f32 v216, v226, v227\n\t" \
    "v_pk_mul_f32 v[222:223], v[190:191], v[198:199] op_sel_hi:[1,0]\n\t" \
    "v_pk_fma_f32 %[sm], v[180:181], v[216:217], v[218:219] op_sel_hi:[1,0,1]\n\t" \
    "v_mov_b32_dpp v214, v216 quad_perm:[1,0,3,2] row_mask:0xf bank_mask:0xf\n\t" \
    "v_pk_mul_f32 v[200:201], %[sm], v[194:195]\n\t" \
    "v_pk_fma_f32 %[so], v[180:181], v[214:215], v[220:221] op_sel_hi:[1,0,1]\n\t" \
    "v_add_f32 v208, v200, v201\n\t" \
    "v_pk_mul_f32 v[202:203], %[so], v[194:195]\n\t" \
    "v_pk_mul_f32 v[204:205], %[sm], v[184:185]\n\t" \
    "v_add_f32 v209, v202, v203\n\t" \
    "v_pk_mul_f32 v[206:207], %[so], v[184:185]\n\t" \
    "v_add_f32 v210, v204, v205\n\t" \
    "v_add_f32_dpp v226, v209, v208 quad_perm:[1,0,3,2] row_mask:0xf bank_mask:0xf bound_ctrl:1\n\t" \
    "ds_read_b128 v[176:179], %[a16] offset:14080\n\t" \
    "v_add_f32 v211, v206, v207\n\t" \
    "v_pk_fma_f32 v[222:223], %[sm], v[188:189], v[222:223]\n\t" \
    "v_add_f32_dpp v226, v226, v226 quad_perm:[2,3,0,1] row_mask:0xf bank_mask:0xf bound_ctrl:1\n\t" \
    "ds_read_b128 v[180:183], %[a16] offset:14592\n\t" \
    "v_pk_mul_f32 v[224:225], v[190:191], v[198:199] op_sel:[0,1] op_sel_hi:[1,1]\n\t" \
    "v_add_f32_dpp v212, v211, v210 quad_perm:[1,0,3,2] row_mask:0xf bank_mask:0xf bound_ctrl:1\n\t" \
    "v_add_f32_dpp v226, v226, v226 row_ror:4 row_mask:0xf bank_mask:0xf bound_ctrl:1\n\t" \
    "v_pk_fma_f32 v[224:225], %[so], v[188:189], v[224:225]\n\t" \
    "ds_read_b64 v[184:185], %[a8] offset:14080\n\t" \
    "v_add_f32_dpp v226, v226, v226 row_ror:8 row_mask:0xf bank_mask:0xf bound_ctrl:1\n\t" \
    "v_mov_b32 v227, v226\n\t" \
    "ds_write_b32 %[ya], v212 offset:6144\n\t" \
    "ds_read_b64 v[186:187], %[av] offset:14080\n\t" \
    "v_permlane16_swap_b32 v226, v227\n\t" \
    "s_waitcnt lgkmcnt(10)\n\t" \
    "v_add_f32 v216, v226, v227\n\t" \
    "v_pk_mul_f32 v[218:219], v[154:155], v[162:163] op_sel_hi:[1,0]\n\t" \
    "v_pk_fma_f32 %[sm], v[192:193], v[216:217], v[222:223] op_sel_hi:[1,0,1]\n\t" \
    "v_mov_b32_dpp v214, v216 quad_perm:[1,0,3,2] row_mask:0xf bank_mask:0xf\n\t" \
    "v_pk_mul_f32 v[200:201], %[sm], v[158:159]\n\t" \
    "v_pk_fma_f32 %[so], v[192:193], v[214:215], v[224:225] op_sel_hi:[1,0,1]\n\t" \
    "v_add_f32 v208, v200, v201\n\t" \
    "v_pk_mul_f32 v[202:203], %[so], v[158:159]\n\t" \
    "v_pk_mul_f32 v[204:205], %[sm], v[196:197]\n\t" \
    "v_add_f32 v209, v202, v203\n\t" \
    "v_pk_mul_f32 v[206:207], %[so], v[196:197]\n\t" \
    "v_add_f32 v210, v204, v205\n\t" \
    "v_add_f32_dpp v226, v209, v208 quad_perm:[1,0,3,2] row_mask:0xf bank_mask:0xf bound_ctrl:1\n\t" \
    "ds_read_b128 v[188:191], %[a16] offset:15488\n\t" \
    "v_add_f32 v211, v206, v207\n\t" \
    "v_pk_fma_f32 v[218:219], %[sm], v[152:153], v[218:219]\n\t" \
    "v_add_f32_dpp v226, v226, v226 quad_perm:[2,3,0,1] row_mask:0xf bank_mask:0xf bound_ctrl:1\n\t" \
    "ds_read_b128 v[192:195], %[a16] offset:16000\n\t" \
    "v_pk_mul_f32 v[220:221], v[154:155], v[162:163] op_sel:[0,1] op_sel_hi:[1,1]\n\t" \
    "v_add_f32_dpp v212, v211, v210 quad_perm:[1,0,3,2] row_mask:0xf bank_mask:0xf bound_ctrl:1\n\t" \
    "v_add_f32_dpp v226, v226, v226 row_ror:4 row_mask:0xf bank_mask:0xf bound_ctrl:1\n\t" \
    "v_pk_fma_f32 v[220:221], %[so], v[152:153], v[220:221]\n\t" \
    "ds_read_b64 v[196:197], %[a8] offset:15488\n\t" \
    "v_add_f32_dpp v226, v226, v226 row_ror:8 row_mask:0xf bank_mask:0xf bound_ctrl:1\n\t" \
    "v_mov_b32 v227, v226\n\t" \
    "ds_write_b32 %[ya], v212 offset:7168\n\t" \
    "ds_read_b64 v[198:199], %[av] offset:15488\n\t" \
    "v_permlane16_swap_b32 v226, v227\n\t" \
    "s_waitcnt lgkmcnt(10)\n\t" \
    "v_add_f32 v216, v226, v227\n\t" \
    "v_pk_mul_f32 v[222:223], v[166:167], v[174:175] op_sel_hi:[1,0]\n\t" \
    "v_pk_fma_f32 %[sm], v[156:157], v[216:217], v[218:219] op_sel_hi:[1,0,1]\n\t" \
    "v_mov_b32_dpp v214, v216 quad_perm:[1,0,3,2] row_mask:0xf bank_mask:0xf\n\t" \
    "v_pk_mul_f32 v[200:201], %[sm], v[170:171]\n\t" \
    "v_pk_fma_f32 %[so], v[156:157], v[214:215], v[220:221] op_sel_hi:[1,0,1]\n\t" \
    "v_add_f32 v208, v200, v201\n\t" \
    "v_pk_mul_f32 v[202:203], %[so], v[170:171]\n\t" \
    "v_pk_mul_f32 v[204:205], %[sm], v[160:161]\n\t" \
    "v_add_f32 v209, v202, v203\n\t" \
    "v_pk_mul_f32 v[206:207], %[so], v[160:161]\n\t" \
    "v_add_f32 v210, v204, v205\n\t" \
    "v_add_f32_dpp v226, v209, v208 quad_perm:[1,0,3,2] row_mask:0xf bank_mask:0xf bound_ctrl:1\n\t" \
    "ds_read_b128 v[152:155], %[a16] offset:16896\n\t" \
    "v_add_f32 v211, v206, v207\n\t" \
    "v_pk_fma_f32 v[222:223], %[sm], v[164:165], v[222:223]\n\t" \
    "v_add_f32_dpp v226, v226, v226 quad_perm:[2,3,0,1] row_mask:0xf bank_mask:0xf bound_ctrl:1\n\t" \
    "ds_read_b128 v[156:159], %[a16] offset:17408\n\t" \
    "v_pk_mul_f32 v[224:225], v[166:167], v[174:175] op_sel:[0,1] op_sel_hi:[1,1]\n\t" \
    "v_add_f32_dpp v212, v211, v210 quad_perm:[1,0,3,2] row_mask:0xf bank_mask:0xf bound_ctrl:1\n\t" \
    "v_add_f32_dpp v226, v226, v226 row_ror:4 row_mask:0xf bank_mask:0xf bound_ctrl:1\n\t" \
    "v_pk_fma_f32 v[224:225], %[so], v[164:165], v[224:225]\n\t" \
    "ds_read_b64 v[160:161], %[a8] offset:16896\n\t" \
    "v_add_f32_dpp v226, v226, v226 row_ror:8 row_mask:0xf bank_mask:0xf bound_ctrl:1\n\t" \
    "v_mov_b32 v227, v226\n\t" \
    "ds_write_b32 %[ya], v212 offset:8192\n\t" \
    "ds_read_b64 v[162:163], %[av] offset:16896\n\t" \
    "v_permlane16_swap_b32 v226, v227\n\t" \
    "s_waitcnt lgkmcnt(10)\n\t" \
    "v_add_f32 v216, v226, v227\n\t" \
    "v_pk_mul_f32 v[218:219], v[178:179], v[186:187] op_sel_hi:[1,0]\n\t" \
    "v_pk_fma_f32 %[sm], v[168:169], v[216:217], v[222:223] op_sel_hi:[1,0,1]\n\t" \
    "v_mov_b32_dpp v214, v216 quad_perm:[1,0,3,2] row_mask:0xf bank_mask:0xf\n\t" \
    "v_pk_mul_f32 v[200:201], %[sm], v[182:183]\n\t" \
    "v_pk_fma_f32 %[so], v[168:169], v[214:215], v[224:225] op_sel_hi:[1,0,1]\n\t" \
    "v_add_f32 v208, v200, v201\n\t" \
    "v_pk_mul_f32 v[202:203], %[so], v[182:183]\n\t" \
    "v_pk_mul_f32 v[204:205], %[sm], v[172:173]\n\t" \
    "v_add_f32 v209, v202, v203\n\t" \
    "v_pk_mul_f32 v[206:207], %[so], v[172:173]\n\t" \
    "v_add_f32 v210, v204, v205\n\t" \
    "v_add_f32_dpp v226, v209, v208 quad_perm:[1,0,3,2] row_mask:0xf bank_mask:0xf bound_ctrl:1\n\t" \
    "ds_read_b128 v[164:167], %[a16] offset:18304\n\t" \
    "v_add_f32 v211, v206, v207\n\t" \
    "v_pk_fma_f32 v[218:219], %[sm], v[176:177], v[218:219]\n\t" \
    "v_add_f32_dpp v226, v226, v226 quad_perm:[2,3,0,1] row_mask:0xf bank_mask:0xf bound_ctrl:1\n\t" \
    "ds_read_b128 v[168:171], %[a16] offset:18816\n\t" \
    "v_pk_mul_f32 v[220:221], v[178:179], v[186:187] op_sel:[0,1] op_sel_hi:[1,1]\n\t" \
    "v_add_f32_dpp v212, v211, v210 quad_perm:[1,0,3,2] row_mask:0xf bank_mask:0xf bound_ctrl:1\n\t" \
    "v_add_f32_dpp v226, v226, v226 row_ror:4 row_mask:0xf bank_mask:0xf bound_ctrl:1\n\t" \
    "v_pk_fma_f32 v[220:221], %[so], v[176:177], v[220:221]\n\t" \
    "ds_read_b64 v[172:173], %[a8] offset:18304\n\t" \
    "v_add_f32_dpp v226, v226, v226 row_ror:8 row_mask:0xf bank_mask:0xf bound_ctrl:1\n\t" \
    "v_mov_b32 v227, v226\n\t" \
    "ds_write_b32 %[ya], v212 offset:9216\n\t" \
    "ds_read_b64 v[174:175], %[av] offset:18304\n\t" \
    "v_permlane16_swap_b32 v226, v227\n\t" \
    "s_waitcnt lgkmcnt(10)\n\t" \
    "v_add_f32 v216, v226, v227\n\t" \
    "v_pk_mul_f32 v[222:223], v[190:191], v[198:199] op_sel_hi:[1,0]\n\t" \
    "v_pk_fma_f32 %[sm], v[180:181], v[216:217], v[218:219] op_sel_hi:[1,0,1]\n\t" \
    "v_mov_b32_dpp v214, v216 quad_perm:[1,0,3,2] row_mask:0xf bank_mask:0xf\n\t" \
    "v_pk_mul_f32 v[200:201], %[sm], v[194:195]\n\t" \
    "v_pk_fma_f32 %[so], v[180:181], v[214:215], v[220:221] op_sel_hi:[1,0,1]\n\t" \
    "v_add_f32 v208, v200, v201\n\t" \
    "v_pk_mul_f32 v[202:203], %[so], v[194:195]\n\t" \
    "v_pk_mul_f32 v[204:205], %[sm], v[184:185]\n\t" \
    "v_add_f32 v209, v202, v203\n\t" \
    "v_pk_mul_f32 v[206:207], %[so], v[184:185]\n\t" \
    "v_add_f32 v210, v204, v205\n\t" \
    "v_add_f32_dpp v226, v209, v208 quad_perm:[1,0,3,2] row_mask:0xf bank_mask:0xf bound_ctrl:1\n\t" \
    "ds_read_b128 v[176:179], %[a16] offset:19712\n\t" \
    "v_add_f32 v211, v206, v207\n\t" \
    "v_pk_fma_f32 v[222:223], %[sm], v[188:189], v[222:223]\n\t" \
    "v_add_f32_dpp v226, v226, v226 quad_perm:[2,3,0,1] row_mask:0xf bank_mask:0xf bound_ctrl:1\n\t" \
    "ds_read_b128 v[180:183], %[a16] offset:20224\n\t" \
    "v_pk_mul_f32 v[224:225], v[190:191], v[198:199] op_sel:[0,1] op_sel_hi:[1,1]\n\t" \
    "v_add_f32_dpp v212, v211, v210 quad_perm:[1,0,3,2] row_mask:0xf bank_mask:0xf bound_ctrl:1\n\t" \
    "v_add_f32_dpp v226, v226, v226 row_ror:4 row_mask:0xf bank_mask:0xf bound_ctrl:1\n\t" \
    "v_pk_fma_f32 v[224:225], %[so], v[188:189], v[224:225]\n\t" \
    "ds_read_b64 v[184:185], %[a8] offset:19712\n\t" \
    "v_add_f32_dpp v226, v226, v226 row_ror:8 row_mask:0xf bank_mask:0xf bound_ctrl:1\n\t" \
    "v_mov_b32 v227, v226\n\t" \
    "ds_write_b32 %[ya], v212 offset:10240\n\t" \
    "ds_read_b64 v[186:187], %[av] offset:19712\n\t" \
    "v_permlane16_swap_b32 v226, v227\n\t" \
    "s_waitcnt lgkmcnt(10)\n\t" \
    "v_add_f32 v216, v226, v227\n\t" \
    "v_pk_mul_f32 v[218:219], v[154:155], v[162:163] op_sel_hi:[1,0]\n\t" \
    "v_pk_fma_f32 %[sm], v[192:193], v[216:217], v[222:223] op_sel_hi:[1,0,1]\n\t" \
    "v_mov_b32_dpp v214, v216 quad_perm:[1,0,3,2] row_mask:0xf bank_mask:0xf\n\t" \
    "v_pk_mul_f32 v[200:201], %[sm], v[158:159]\n\t" \
    "v_pk_fma_f32 %[so], v[192:193], v[214:215], v[224:225] op_sel_hi:[1,0,1]\n\t" \
    "v_add_f32 v208, v200, v201\n\t" \
    "v_pk_mul_f32 v[202:203], %[so], v[158:159]\n\t" \
    "v_pk_mul_f32 v[204:205], %[sm], v[196:197]\n\t" \
    "v_add_f32 v209, v202, v203\n\t" \
    "v_pk_mul_f32 v[206:207], %[so], v[196:197]\n\t" \
    "v_add_f32 v210, v204, v205\n\t" \
    "v_add_f32_dpp v226, v209, v208 quad_perm:[1,0,3,2] row_mask:0xf bank_mask:0xf bound_ctrl:1\n\t" \
    "ds_read_b128 v[188:191], %[a16] offset:21120\n\t" \
    "v_add_f32 v211, v206, v207\n\t" \
    "v_pk_fma_f32 v[218:219], %[sm], v[152:153], v[218:219]\n\t" \
    "v_add_f32_dpp v226, v226, v226 quad_perm:[2,3,0,1] row_mask:0xf bank_mask:0xf bound_ctrl:1\n\t" \
    "ds_read_b128 v[192:195], %[a16] offset:21632\n\t" \
    "v_pk_mul_f32 v[220:221], v[154:155], v[162:163] op_sel:[0,1] op_sel_hi:[1,1]\n\t" \
    "v_add_f32_dpp v212, v211, v210 quad_perm:[1,0,3,2] row_mask:0xf bank_mask:0xf bound_ctrl:1\n\t" \
    "v_add_f32_dpp v226, v226, v226 row_ror:4 row_mask:0xf bank_mask:0xf bound_ctrl:1\n\t" \
    "v_pk_fma_f32 v[220:221], %[so], v[152:153], v[220:221]\n\t" \
    "ds_read_b64 v[196:197], %[a8] offset:21120\n\t" \
    "v_add_f32_dpp v226, v226, v226 row_ror:8 row_mask:0xf bank_mask:0xf bound_ctrl:1\n\t" \
    "v_mov_b32 v227, v226\n\t" \
    "ds_write_b32 %[ya], v212 offset:11264\n\t" \
    "ds_read_b64 v[198:199], %[av] offset:21120\n\t" \
    "v_permlane16_swap_b32 v226, v227\n\t" \
    "s_waitcnt lgkmcnt(10)\n\t" \
    "v_add_f32 v216, v226, v227\n\t" \
    "v_pk_mul_f32 v[222:223], v[166:167], v[174:175] op_sel_hi:[1,0]\n\t" \
    "v_pk_fma_f32 %[sm], v[156:157], v[216:217], v[218:219] op_sel_hi:[1,0,1]\n\t" \
    "v_mov_b32_dpp v214, v216 quad_perm:[1,0,3,2] row_mask:0xf bank_mask:0xf\n\t" \
    "v_pk_mul_f32 v[200:201], %[sm], v[170:171]\n\t" \
    "v_pk_fma_f32 %[so], v[156:157], v[214:215], v[220:221] op_sel_hi:[1,0,1]\n\t" \
    "v_add_f32 v208, v200, v201\n\t" \
    "v_pk_mul_f32 v[202:203], %[so], v[170:171]\n\t" \
    "v_pk_mul_f32 v[204:205], %[sm], v[160:161]\n\t" \
    "v_add_f32 v209, v202, v203\n\t" \
    "v_pk_mul_f32 v[206:207], %[so], v[160:161]\n\t" \
    "v_add_f32 v210, v204, v205\n\t" \
    "v_add_f32_dpp v226, v209, v208 quad_perm:[1,0,3,2] row_mask:0xf bank_mask:0xf bound_ctrl:1\n\t" \
    "ds_read_b128 v[152:155], %[a16] offset:22528\n\t" \
    "v_add_f32 v211, v206, v207\n\t" \
    "v_pk_fma_f32 v[222:223], %[sm], v[164:165], v[222:223]\n\t" \
    "v_add_f32_dpp v226, v226, v226 quad_perm:[2,3,0,1] row_mask:0xf bank_mask:0xf bound_ctrl:1\n\t" \
    "ds_read_b128 v[156:159], %[a16] offset:23040\n\t" \
    "v_pk_mul_f32 v[224:225], v[166:167], v[174:175] op_sel:[0,1] op_sel_hi:[1,1]\n\t" \
    "v_add_f32_dpp v212, v211, v210 quad_perm:[1,0,3,2] row_mask:0xf bank_mask:0xf bound_ctrl:1\n\t" \
    "v_add_f32_dpp v226, v226, v226 row_ror:4 row_mask:0xf bank_mask:0xf bound_ctrl:1\n\t" \
    "v_pk_fma_f32 v[224:225], %[so], v[164:165], v[224:225]\n\t" \
    "ds_read_b64 v[160:161], %[a8] offset:22528\n\t" \
    "v_add_f32_dpp v226, v226, v226 row_ror:8 row_mask:0xf bank_mask:0xf bound_ctrl:1\n\t" \
    "v_mov_b32 v227, v226\n\t" \
    "ds_write_b32 %[ya], v212 offset:12288\n\t" \
    "ds_read_b64 v[162:163], %[av] offset:22528\n\t" \
    "v_permlane16_swap_b32 v226, v227\n\t" \
    "s_waitcnt lgkmcnt(10)\n\t" \
    "v_add_f32 v216, v226, v227\n\t" \
    "v_pk_mul_f32 v[218:219], v[178:179], v[186:187] op_sel_hi:[1,0]\n\t" \
    "v_pk_fma_f32 %[sm], v[168:169], v[216:217], v[222:223] op_sel_hi:[1,0,1]\n\t" \
    "v_mov_b32_dpp v214, v216 quad_perm:[1,0,3,2] row_mask:0xf bank_mask:0xf\n\t" \
    "v_pk_mul_f32 v[200:201], %[sm], v[182:183]\n\t" \
    "v_pk_fma_f32 %[so], v[168:169], v[214:215], v[224:225] op_sel_hi:[1,0,1]\n\t" \
    "v_add_f32 v208, v200, v201\n\t" \
    "v_pk_mul_f32 v[202:203], %[so], v[182:183]\n\t" \
    "v_pk_mul_f32 v[204:205], %[sm], v[172:173]\n\t" \
    "v_add_f32 v209, v202, v203\n\t" \
    "v_pk_mul_f32 v[206:207], %[so], v[172:173]\n\t" \
    "v_add_f32 v210, v204, v205\n\t" \
    "v_add_f32_dpp v226, v209, v208 quad_perm:[1,0,3,2] row_mask:0xf bank_mask:0xf bound_ctrl:1\n\t" \
    "ds_read_b128 v[164:167], %[a16] offset:23936\n\t" \
    "v_add_f32 v211, v206, v207\n\t" \
    "v_pk_fma_f32 v[218:219], %[sm], v[176:177], v[218:219]\n\t" \
    "v_add_f32_dpp v226, v226, v226 quad_perm:[2,3,0,1] row_mask:0xf bank_mask:0xf bound_ctrl:1\n\t" \
    "ds_read_b128 v[168:171], %[a16] offset:24448\n\t" \
    "v_pk_mul_f32 v[220:221], v[178:179], v[186:187] op_sel:[0,1] op_sel_hi:[1,1]\n\t" \
    "v_add_f32_dpp v212, v211, v210 quad_perm:[1,0,3,2] row_mask:0xf bank_mask:0xf bound_ctrl:1\n\t" \
    "v_add_f32_dpp v226, v226, v226 row_ror:4 row_mask:0xf bank_mask:0xf bound_ctrl:1\n\t" \
    "v_pk_fma_f32 v[220:221], %[so], v[176:177], v[220:221]\n\t" \
    "ds_read_b64 v[172:173], %[a8] offset:23936\n\t" \
    "v_add_f32_dpp v226, v226, v226 row_ror:8 row_mask:0xf bank_mask:0xf bound_ctrl:1\n\t" \
    "v_mov_b32 v227, v226\n\t" \
    "ds_write_b32 %[ya], v212 offset:13312\n\t" \
    "ds_read_b64 v[174:175], %[av] offset:23936\n\t" \
    "v_permlane16_swap_b32 v226, v227\n\t" \
    "s_waitcnt lgkmcnt(10)\n\t" \
    "v_add_f32 v216, v226, v227\n\t" \
    "v_pk_mul_f32 v[222:223], v[190:191], v[198:199] op_sel_hi:[1,0]\n\t" \
    "v_pk_fma_f32 %[sm], v[180:181], v[216:217], v[218:219] op_sel_hi:[1,0,1]\n\t" \
    "v_mov_b32_dpp v214, v216 quad_perm:[1,0,3,2] row_mask:0xf bank_mask:0xf\n\t" \
    "v_pk_mul_f32 v[200:201], %[sm], v[194:195]\n\t" \
    "v_pk_fma_f32 %[so], v[180:181], v[214:215], v[220:221] op_sel_hi:[1,0,1]\n\t" \
    "v_add_f32 v208, v200, v201\n\t" \
    "v_pk_mul_f32 v[202:203], %[so], v[194:195]\n\t" \
    "v_pk_mul_f32 v[204:205], %[sm], v[184:185]\n\t" \
    "v_add_f32 v209, v202, v203\n\t" \
    "v_pk_mul_f32 v[206:207], %[so], v[184:185]\n\t" \
    "v_add_f32 v210, v204, v205\n\t" \
    "v_add_f32_dpp v226, v209, v208 quad_perm:[1,0,3,2] row_mask:0xf bank_mask:0xf bound_ctrl:1\n\t" \
    "ds_read_b128 v[176:179], %[a16] offset:25344\n\t" \
    "v_add_f32 v211, v206, v207\n\t" \
    "v_pk_fma_f32 v[222:223], %[sm], v[188:189], v[222:223]\n\t" \
    "v_add_f32_dpp v226, v226, v226 quad_perm:[2,3,0,1] row_mask:0xf bank_mask:0xf bound_ctrl:1\n\t" \
    "ds_read_b128 v[180:183], %[a16] offset:25856\n\t" \
    "v_pk_mul_f32 v[224:225], v[190:191], v[198:199] op_sel:[0,1] op_sel_hi:[1,1]\n\t" \
    "v_add_f32_dpp v212, v211, v210 quad_perm:[1,0,3,2] row_mask:0xf bank_mask:0xf bound_ctrl:1\n\t" \
    "v_add_f32_dpp v226, v226, v226 row_ror:4 row_mask:0xf bank_mask:0xf bound_ctrl:1\n\t" \
    "v_pk_fma_f32 v[224:225], %[so], v[188:189], v[224:225]\n\t" \
    "ds_read_b64 v[184:185], %[a8] offset:25344\n\t" \
    "v_add_f32_dpp v226, v226, v226 row_ror:8 row_mask:0xf bank_mask:0xf bound_ctrl:1\n\t" \
    "v_mov_b32 v227, v226\n\t" \
    "ds_write_b32 %[ya], v212 offset:14336\n\t" \
    "ds_read_b64 v[186:187], %[av] offset:25344\n\t" \
    "v_permlane16_swap_b32 v226, v227\n\t" \
    "s_waitcnt lgkmcnt(10)\n\t" \
    "v_add_f32 v216, v226, v227\n\t" \
    "v_pk_mul_f32 v[218:219], v[154:155], v[162:163] op_sel_hi:[1,0]\n\t" \
    "v_pk_fma_f32 %[sm], v[192:193], v[216:217], v[222:223] op_sel_hi:[1,0,1]\n\t" \
    "v_mov_b32_dpp v214, v216 quad_perm:[1,0,3,2] row_mask:0xf bank_mask:0xf\n\t" \
    "v_pk_mul_f32 v[200:201], %[sm], v[158:159]\n\t" \
    "v_pk_fma_f32 %[so], v[192:193], v[214:215], v[224:225] op_sel_hi:[1,0,1]\n\t" \
    "v_add_f32 v208, v200, v201\n\t" \
    "v_pk_mul_f32 v[202:203], %[so], v[158:159]\n\t" \
    "v_pk_mul_f32 v[204:205], %[sm], v[196:197]\n\t" \
    "v_add_f32 v209, v202, v203\n\t" \
    "v_pk_mul_f32 v[206:207], %[so], v[196:197]\n\t" \
    "v_add_f32 v210, v204, v205\n\t" \
    "v_add_f32_dpp v226, v209, v208 quad_perm:[1,0,3,2] row_mask:0xf bank_mask:0xf bound_ctrl:1\n\t" \
    "ds_read_b128 v[188:191], %[a16] offset:26752\n\t" \
    "v_add_f32 v211, v206, v207\n\t" \
    "v_pk_fma_f32 v[218:219], %[sm], v[152:153], v[218:219]\n\t" \
    "v_add_f32_dpp v226, v226, v226 quad_perm:[2,3,0,1] row_mask:0xf bank_mask:0xf bound_ctrl:1\n\t" \
    "ds_read_b128 v[192:195], %[a16] offset:27264\n\t" \
    "v_pk_mul_f32 v[220:221], v[154:155], v[162:163] op_sel:[0,1] op_sel_hi:[1,1]\n\t" \
    "v_add_f32_dpp v212, v211, v210 quad_perm:[1,0,3,2] row_mask:0xf bank_mask:0xf bound_ctrl:1\n\t" \
    "v_add_f32_dpp v226, v226, v226 row_ror:4 row_mask:0xf bank_mask:0xf bound_ctrl:1\n\t" \
    "v_pk_fma_f32 v[220:221], %[so], v[152:153], v[220:221]\n\t" \
    "ds_read_b64 v[196:197], %[a8] offset:26752\n\t" \
    "v_add_f32_dpp v226, v226, v226 row_ror:8 row_mask:0xf bank_mask:0xf bound_ctrl:1\n\t" \
    "v_mov_b32 v227, v226\n\t" \
    "ds_write_b32 %[ya], v212 offset:15360\n\t" \
    "ds_read_b64 v[198:199], %[av] offset:26752\n\t" \
    "v_permlane16_swap_b32 v226, v227\n\t" \
    "s_waitcnt lgkmcnt(10)\n\t" \
    "v_add_f32 v216, v226, v227\n\t" \
    "v_pk_mul_f32 v[222:223], v[166:167], v[174:175] op_sel_hi:[1,0]\n\t" \
    "v_pk_fma_f32 %[sm], v[156:157], v[216:217], v[218:219] op_sel_hi:[1,0,1]\n\t" \
    "v_mov_b32_dpp v214, v216 quad_perm:[1,0,3,2] row_mask:0xf bank_mask:0xf\n\t" \
    "v_pk_mul_f32 v[200:201], %[sm], v[170:171]\n\t" \
    "v_pk_fma_f32 %[so], v[156:157], v[214:215], v[220:221] op_sel_hi:[1,0,1]\n\t" \
    "v_add_f32 v208, v200, v201\n\t" \
    "v_pk_mul_f32 v[202:203], %[so], v[170:171]\n\t" \
    "v_pk_mul_f32 v[204:205], %[sm], v[160:161]\n\t" \
    "v_add_f32 v209, v202, v203\n\t" \
    "v_pk_mul_f32 v[206:207], %[so], v[160:161]\n\t" \
    "v_add_f32 v210, v204, v205\n\t" \
    "v_add_f32_dpp v226, v209, v208 quad_perm:[1,0,3,2] row_mask:0xf bank_mask:0xf bound_ctrl:1\n\t" \
    "ds_read_b128 v[152:155], %[a16] offset:28160\n\t" \
    "v_add_f32 v211, v206, v207\n\t" \
    "v_pk_fma_f32 v[222:223], %[sm], v[164:165], v[222:223]\n\t" \
    "v_add_f32_dpp v226, v226, v226 quad_perm:[2,3,0,1] row_mask:0xf bank_mask:0xf bound_ctrl:1\n\t" \
    "ds_read_b128 v[156:159], %[a16] offset:28672\n\t" \
    "v_pk_mul_f32 v[224:225], v[166:167], v[174:175] op_sel:[0,1] op_sel_hi:[1,1]\n\t" \
    "v_add_f32_dpp v212, v211, v210 quad_perm:[1,0,3,2] row_mask:0xf bank_mask:0xf bound_ctrl:1\n\t" \
    "v_add_f32_dpp v226, v226, v226 row_ror:4 row_mask:0xf bank_mask:0xf bound_ctrl:1\n\t" \
    "v_pk_fma_f32 v[224:225], %[so], v[164:165], v[224:225]\n\t" \
    "ds_read_b64 v[160:161], %[a8] offset:28160\n\t" \
    "v_add_f32_dpp v226, v226, v226 row_ror:8 row_mask:0xf bank_mask:0xf bound_ctrl:1\n\t" \
    "v_mov_b32 v227, v226\n\t" \
    "ds_write_b32 %[ya], v212 offset:16384\n\t" \
    "ds_read_b64 v[162:163], %[av] offset:28160\n\t" \
    "v_permlane16_swap_b32 v226, v227\n\t" \
    "s_waitcnt lgkmcnt(10)\n\t" \
    "v_add_f32 v216, v226, v227\n\t" \
    "v_pk_mul_f32 v[218:219], v[178:179], v[186:187] op_sel_hi:[1,0]\n\t" \
    "v_pk_fma_f32 %[sm], v[168:169], v[216:217], v[222:223] op_sel_hi:[1,0,1]\n\t" \
    "v_mov_b32_dpp v214, v216 quad_perm:[1,0,3,2] row_mask:0xf bank_mask:0xf\n\t" \
    "v_pk_mul_f32 v[200:201], %[sm], v[182:183]\n\t" \
    "v_pk_fma_f32 %[so], v[168:169], v[214:215], v[224:225] op_sel_hi:[1,0,1]\n\t" \
    "v_add_f32 v208, v200, v201\n\t" \
    "v_pk_mul_f32 v[202:203], %[so], v[182:183]\n\t" \
    "v_pk_mul_f32 v[204:205], %[sm], v[172:173]\n\t" \
    "v_add_f32 v209, v202, v203\n\t" \
    "v_pk_mul_f32 v[206:207], %[so], v[172:173]\n\t" \
    "v_add_f32 v210, v204, v205\n\t" \
    "v_add_f32_dpp v226, v209, v208 quad_perm:[1,0,3,2] row_mask:0xf bank_mask:0xf bound_ctrl:1\n\t" \
    "ds_read_b128 v[164:167], %[a16] offset:29568\n\t" \
    "v_add_f32 v211, v206, v207\n\t" \
    "v_pk_fma_f32 v[218:219], %[sm], v[176:177], v[218:219]\n\t" \
    "v_add_f32_dpp v226, v226, v226 quad_perm:[2,3,0,1] row_mask:0xf bank_mask:0xf bound_ctrl:1\n\t" \
    "ds_read_b128 v[168:171], %[a16] offset:30080\n\t" \
    "v_pk_mul_f32 v[220:221], v[178:179], v[186:187] op_sel:[0,1] op_sel_hi:[1,1]\n\t" \
    "v_add_f32_dpp v212, v211, v210 quad_perm:[1,0,3,2] row_mask:0xf bank_mask:0xf bound_ctrl:1\n\t" \
    "v_add_f32_dpp v226, v226, v226 row_ror:4 row_mask:0xf bank_mask:0xf bound_ctrl:1\n\t" \
    "v_pk_fma_f32 v[220:221], %[so], v[176:177], v[220:221]\n\t" \
    "ds_read_b64 v[172:173], %[a8] offset:29568\n\t" \
    "v_add_f32_dpp v226, v226, v226 row_ror:8 row_mask:0xf bank_mask:0xf bound_ctrl:1\n\t" \
    "v_mov_b32 v227, v226\n\t" \
    "ds_write_b32 %[ya], v212 offset:17408\n\t" \
    "ds_read_b64 v[174:175], %[av] offset:29568\n\t" \
    "v_permlane16_swap_b32 v226, v227\n\t" \
    "s_waitcnt lgkmcnt(10)\n\t" \
    "v_add_f32 v216, v226, v227\n\t" \
    "v_pk_mul_f32 v[222:223], v[190:191], v[198:199] op_sel_hi:[1,0]\n\t" \
    "v_pk_fma_f32 %[sm], v[180:181], v[216:217], v[218:219] op_sel_hi:[1,0,1]\n\t" \
    "v_mov_b32_dpp v214, v216 quad_perm:[1,0,3,2] row_mask:0xf bank_mask:0xf\n\t" \
    "v_pk_mul_f32 v[200:201], %[sm], v[194:195]\n\t" \
    "v_pk_fma_f32 %[so], v[180:181], v[214:215], v[220:221] op_sel_hi:[1,0,1]\n\t" \
    "v_add_f32 v208, v200, v201\n\t" \
    "v_pk_mul_f32 v[202:203], %[so], v[194:195]\n\t" \
    "v_pk_mul_f32 v[204:205], %[sm], v[184:185]\n\t" \
    "v_add_f32 v209, v202, v203\n\t" \
    "v_pk_mul_f32 v[206:207], %[so], v[184:185]\n\t" \
    "v_add_f32 v210, v204, v205\n\t" \
    "v_add_f32_dpp v226, v209, v208 quad_perm:[1,0,3,2] row_mask:0xf bank_mask:0xf bound_ctrl:1\n\t" \
    "ds_read_b128 v[176:179], %[a16] offset:30976\n\t" \
    "v_add_f32 v211, v206, v207\n\t" \
    "v_pk_fma_f32 v[222:223], %[sm], v[188:189], v[222:223]\n\t" \
    "v_add_f32_dpp v226, v226, v226 quad_perm:[2,3,0,1] row_mask:0xf bank_mask:0xf bound_ctrl:1\n\t" \
    "ds_read_b128 v[180:183], %[a16] offset:31488\n\t" \
    "v_pk_mul_f32 v[224:225], v[190:191], v[198:199] op_sel:[0,1] op_sel_hi:[1,1]\n\t" \
    "v_add_f32_dpp v212, v211, v210 quad_perm:[1,0,3,2] row_mask:0xf bank_mask:0xf bound_ctrl:1\n\t" \
    "v_add_f32_dpp v226, v226, v226 row_ror:4 row_mask:0xf bank_mask:0xf bound_ctrl:1\n\t" \
    "v_pk_fma_f32 v[224:225], %[so], v[188:189], v[224:225]\n\t" \
    "ds_read_b64 v[184:185], %[a8] offset:30976\n\t" \
    "v_add_f32_dpp v226, v226, v226 row_ror:8 row_mask:0xf bank_mask:0xf bound_ctrl:1\n\t" \
    "v_mov_b32 v227, v226\n\t" \
    "ds_write_b32 %[ya], v212 offset:18432\n\t" \
    "ds_read_b64 v[186:187], %[av] offset:30976\n\t" \
    "v_permlane16_swap_b32 v226, v227\n\t" \
    "s_waitcnt lgkmcnt(10)\n\t" \
    "v_add_f32 v216, v226, v227\n\t" \
    "v_pk_mul_f32 v[218:219], v[154:155], v[162:163] op_sel_hi:[1,0]\n\t" \
    "v_pk_fma_f32 %[sm], v[192:193], v[216:217], v[222:223] op_sel_hi:[1,0,1]\n\t" \
    "v_mov_b32_dpp v214, v216 quad_perm:[1,0,3,2] row_mask:0xf bank_mask:0xf\n\t" \
    "v_pk_mul_f32 v[200:201], %[sm], v[158:159]\n\t" \
    "v_pk_fma_f32 %[so], v[192:193], v[214:215], v[224:225] op_sel_hi:[1,0,1]\n\t" \
    "v_add_f32 v208, v200, v201\n\t" \
    "v_pk_mul_f32 v[202:203], %[so], v[158:159]\n\t" \
    "v_pk_mul_f32 v[204:205], %[sm], v[196:197]\n\t" \
    "v_add_f32 v209, v202, v203\n\t" \
    "v_pk_mul_f32 v[206:207], %[so], v[196:197]\n\t" \
    "v_add_f32 v210, v204, v205\n\t" \
    "v_add_f32_dpp v226, v209, v208 quad_perm:[1,0,3,2] row_mask:0xf bank_mask:0xf bound_ctrl:1\n\t" \
    "ds_read_b128 v[188:191], %[a16] offset:32384\n\t" \
    "v_add_f32 v211, v206, v207\n\t" \
    "v_pk_fma_f32 v[218:219], %[sm], v[152:153], v[218:219]\n\t" \
    "v_add_f32_dpp v226, v226, v226 quad_perm:[2,3,0,1] row_mask:0xf bank_mask:0xf bound_ctrl:1\n\t" \
    "ds_read_b128 v[192:195], %[a16] offset:32896\n\t" \
    "v_pk_mul_f32 v[220:221], v[154:155], v[162:163] op_sel:[0,1] op_sel_hi:[1,1]\n\t" \
    "v_add_f32_dpp v212, v211, v210 quad_perm:[1,0,3,2] row_mask:0xf bank_mask:0xf bound_ctrl:1\n\t" \
    "v_add_f32_dpp v226, v226, v226 row_ror:4 row_mask:0xf bank_mask:0xf bound_ctrl:1\n\t" \
    "v_pk_fma_f32 v[220:221], %[so], v[152:153], v[220:221]\n\t" \
    "ds_read_b64 v[196:197], %[a8] offset:32384\n\t" \
    "v_add_f32_dpp v226, v226, v226 row_ror:8 row_mask:0xf bank_mask:0xf bound_ctrl:1\n\t" \
    "v_mov_b32 v227, v226\n\t" \
    "ds_write_b32 %[ya], v212 offset:19456\n\t" \
    "ds_read_b64 v[198:199], %[av] offset:32384\n\t" \
    "v_permlane16_swap_b32 v226, v227\n\t" \
    "s_waitcnt lgkmcnt(10)\n\t" \
    "v_add_f32 v216, v226, v227\n\t" \
    "v_pk_mul_f32 v[222:223], v[166:167], v[174:175] op_sel_hi:[1,0]\n\t" \
    "v_pk_fma_f32 %[sm], v[156:157], v[216:217], v[218:219] op_sel_hi:[1,0,1]\n\t" \
    "v_mov_b32_dpp v214, v216 quad_perm:[1,0,3,2] row_mask:0xf bank_mask:0xf\n\t" \
    "v_pk_mul_f32 v[200:201], %[sm], v[170:171]\n\t" \
    "v_pk_fma_f32 %[so], v[156:157], v[214:215], v[220:221] op_sel_hi:[1,0,1]\n\t" \
    "v_add_f32 v208, v200, v201\n\t" \
    "v_pk_mul_f32 v[202:203], %[so], v[170:171]\n\t" \
    "v_pk_mul_f32 v[204:205], %[sm], v[160:161]\n\t" \
    "v_add_f32 v209, v202, v203\n\t" \
    "v_pk_mul_f32 v[206:207], %[so], v[160:161]\n\t" \
    "v_add_f32 v210, v204, v205\n\t" \
    "v_add_f32_dpp v226, v209, v208 quad_perm:[1,0,3,2] row_mask:0xf bank_mask:0xf bound_ctrl:1\n\t" \
    "ds_read_b128 v[152:155], %[a16] offset:33792\n\t" \
    "v_add_f32 v211, v206, v207\n\t" \
    "v_pk_fma_f32 v[222:223], %[sm], v[164:165], v[222:223]\n\t" \
    "v_add_f32_dpp v226, v226, v226 quad_perm:[2,3,0,1] row_mask:0xf bank_mask:0xf bound_ctrl:1\n\t" \
    "ds_read_b128 v[156:159], %[a16] offset:34304\n\t" \
    "v_pk_mul_f32 v[224:225], v[166:167], v[174:175] op_sel:[0,1] op_sel_hi:[1,1]\n\t" \
    "v_add_f32_dpp v212, v211, v210 quad_perm:[1,0,3,2] row_mask:0xf bank_mask:0xf bound_ctrl:1\n\t" \
    "v_add_f32_dpp v226, v226, v226 row_ror:4 row_mask:0xf bank_mask:0xf bound_ctrl:1\n\t" \
    "v_pk_fma_f32 v[224:225], %[so], v[164:165], v[224:225]\n\t" \
    "ds_read_b64 v[160:161], %[a8] offset:33792\n\t" \
    "v_add_f32_dpp v226, v226, v226 row_ror:8 row_mask:0xf bank_mask:0xf bound_ctrl:1\n\t" \
    "v_mov_b32 v227, v226\n\t" \
    "ds_write_b32 %[ya], v212 offset:20480\n\t" \
    "ds_read_b64 v[162:163], %[av] offset:33792\n\t" \
    "v_permlane16_swap_b32 v226, v227\n\t" \
    "s_waitcnt lgkmcnt(10)\n\t" \
    "v_add_f32 v216, v226, v227\n\t" \
    "v_pk_mul_f32 v[218:219], v[178:179], v[186:187] op_sel_hi:[1,0]\n\t" \
    "v_pk_fma_f32 %[sm], v[168:169], v[216:217], v[222:223] op_sel_hi:[1,0,1]\n\t" \
    "v_mov_b32_dpp v214, v216 quad_perm:[1,0,3,2] row_mask:0xf bank_mask:0xf\n\t" \
    "v_pk_mul_f32 v[200:201], %[sm], v[182:183]\n\t" \
    "v_pk_fma_f32 %[so], v[168:169], v[214:215], v[224:225] op_sel_hi:[1,0,1]\n\t" \
    "v_add_f32 v208, v200, v201\n\t" \
    "v_pk_mul_f32 v[202:203], %[so], v[182:183]\n\t" \
    "v_pk_mul_f32 v[204:205], %[sm], v[172:173]\n\t" \
    "v_add_f32 v209, v202, v203\n\t" \
    "v_pk_mul_f32 v[206:207], %[so], v[172:173]\n\t" \
    "v_add_f32 v210, v204, v205\n\t" \
    "v_add_f32_dpp v226, v209, v208 quad_perm:[1,0,3,2] row_mask:0xf bank_mask:0xf bound_ctrl:1\n\t" \
    "ds_read_b128 v[164:167], %[a16] offset:35200\n\t" \
    "v_add_f32 v211, v206, v207\n\t" \
    "v_pk_fma_f32 v[218:219], %[sm], v[176:177], v[218:219]\n\t" \
    "v_add_f32_dpp v226, v226, v226 quad_perm:[2,3,0,1] row_mask:0xf bank_mask:0xf bound_ctrl:1\n\t" \
    "ds_read_b128 v[168:171], %[a16] offset:35712\n\t" \
    "v_pk_mul_f32 v[220:221], v[178:179], v[186:187] op_sel:[0,1] op_sel_hi:[1,1]\n\t" \
    "v_add_f32_dpp v212, v211, v210 quad_perm:[1,0,3,2] row_mask:0xf bank_mask:0xf bound_ctrl:1\n\t" \
    "v_add_f32_dpp v226, v226, v226 row_ror:4 row_mask:0xf bank_mask:0xf bound_ctrl:1\n\t" \
    "v_pk_fma_f32 v[220:221], %[so], v[176:177], v[220:221]\n\t" \
    "ds_read_b64 v[172:173], %[a8] offset:35200\n\t" \
    "v_add_f32_dpp v226, v226, v226 row_ror:8 row_mask:0xf bank_mask:0xf bound_ctrl:1\n\t" \
    "v_mov_b32 v227, v226\n\t" \
    "ds_write_b32 %[ya], v212 offset:21504\n\t" \
    "ds_read_b64 v[174:175], %[av] offset:35200\n\t" \
    "v_permlane16_swap_b32 v226, v227\n\t" \
    "s_waitcnt lgkmcnt(10)\n\t" \
    "v_add_f32 v216, v226, v227\n\t" \
    "v_pk_mul_f32 v[222:223], v[190:191], v[198:199] op_sel_hi:[1,0]\n\t" \
    "v_pk_fma_f32 %[sm], v[180:181], v[216:217], v[218:219] op_sel_hi:[1,0,1]\n\t" \
    "v_mov_b32_dpp v214, v216 quad_perm:[1,0,3,2] row_mask:0xf bank_mask:0xf\n\t" \
    "v_pk_mul_f32 v[200:201], %[sm], v[194:195]\n\t" \
    "v_pk_fma_f32 %[so], v[180:181], v[214:215], v[220:221] op_sel_hi:[1,0,1]\n\t" \
    "v_add_f32 v208, v200, v201\n\t" \
    "v_pk_mul_f32 v[202:203], %[so], v[194:195]\n\t" \
    "v_pk_mul_f32 v[204:205], %[sm], v[184:185]\n\t" \
    "v_add_f32 v209, v202, v203\n\t" \
    "v_pk_mul_f32 v[206:207], %[so], v[184:185]\n\t" \
    "v_add_f32 v210, v204, v205\n\t" \
    "v_add_f32_dpp v226, v209, v208 quad_perm:[1,0,3,2] row_mask:0xf bank_mask:0xf bound_ctrl:1\n\t" \
    "ds_read_b128 v[176:179], %[a16] offset:36608\n\t" \
    "v_add_f32 v211, v206, v207\n\t" \
    "v_pk_fma_f32 v[222:223], %[sm], v[188:189], v[222:223]\n\t" \
    "v_add_f32_dpp v226, v226, v226 quad_perm:[2,3,0,1] row_mask:0xf bank_mask:0xf bound_ctrl:1\n\t" \
    "ds_read_b128 v[180:183], %[a16] offset:37120\n\t" \
    "v_pk_mul_f32 v[224:225], v[190:191], v[198:199] op_sel:[0,1] op_sel_hi:[1,1]\n\t" \
    "v_add_f32_dpp v212, v211, v210 quad_perm:[1,0,3,2] row_mask:0xf bank_mask:0xf bound_ctrl:1\n\t" \
    "v_add_f32_dpp v226, v226, v226 row_ror:4 row_mask:0xf bank_mask:0xf bound_ctrl:1\n\t" \
    "v_pk_fma_f32 v[224:225], %[so], v[188:189], v[224:225]\n\t" \
    "ds_read_b64 v[184:185], %[a8] offset:36608\n\t" \
    "v_add_f32_dpp v226, v226, v226 row_ror:8 row_mask:0xf bank_mask:0xf bound_ctrl:1\n\t" \
    "v_mov_b32 v227, v226\n\t" \
    "ds_write_b32 %[ya], v212 offset:22528\n\t" \
    "ds_read_b64 v[186:187], %[av] offset:36608\n\t" \
    "v_permlane16_swap_b32 v226, v227\n\t" \
    "s_waitcnt lgkmcnt(10)\n\t" \
    "v_add_f32 v216, v226, v227\n\t" \
    "v_pk_mul_f32 v[218:219], v[154:155], v[162:163] op_sel_hi:[1,0]\n\t" \
    "v_pk_fma_f32 %[sm], v[192:193], v[216:217], v[222:223] op_sel_hi:[1,0,1]\n\t" \
    "v_mov_b32_dpp v214, v216 quad_perm:[1,0,3,2] row_mask:0xf bank_mask:0xf\n\t" \
    "v_pk_mul_f32 v[200:201], %[sm], v[158:159]\n\t" \
    "v_pk_fma_f32 %[so], v[192:193], v[214:215], v[224:225] op_sel_hi:[1,0,1]\n\t" \
    "v_add_f32 v208, v200, v201\n\t" \
    "v_pk_mul_f32 v[202:203], %[so], v[158:159]\n\t" \
    "v_pk_mul_f32 v[204:205], %[sm], v[196:197]\n\t" \
    "v_add_f32 v209, v202, v203\n\t" \
    "v_pk_mul_f32 v[206:207], %[so], v[196:197]\n\t" \
    "v_add_f32 v210, v204, v205\n\t" \
    "v_add_f32_dpp v226, v209, v208 quad_perm:[1,0,3,2] row_mask:0xf bank_mask:0xf bound_ctrl:1\n\t" \
    "ds_read_b128 v[188:191], %[a16] offset:38016\n\t" \
    "v_add_f32 v211, v206, v207\n\t" \
    "v_pk_fma_f32 v[218:219], %[sm], v[152:153], v[218:219]\n\t" \
    "v_add_f32_dpp v226, v226, v226 quad_perm:[2,3,0,1] row_mask:0xf bank_mask:0xf bound_ctrl:1\n\t" \
    "ds_read_b128 v[192:195], %[a16] offset:38528\n\t" \
    "v_pk_mul_f32 v[220:221], v[154:155], v[162:163] op_sel:[0,1] op_sel_hi:[1,1]\n\t" \
    "v_add_f32_dpp v212, v211, v210 quad_perm:[1,0,3,2] row_mask:0xf bank_mask:0xf bound_ctrl:1\n\t" \
    "v_add_f32_dpp v226, v226, v226 row_ror:4 row_mask:0xf bank_mask:0xf bound_ctrl:1\n\t" \
    "v_pk_fma_f32 v[220:221], %[so], v[152:153], v[220:221]\n\t" \
    "ds_read_b64 v[196:197], %[a8] offset:38016\n\t" \
    "v_add_f32_dpp v226, v226, v226 row_ror:8 row_mask:0xf bank_mask:0xf bound_ctrl:1\n\t" \
    "v_mov_b32 v227, v226\n\t" \
    "ds_write_b32 %[ya], v212 offset:23552\n\t" \
    "ds_read_b64 v[198:199], %[av] offset:38016\n\t" \
    "v_permlane16_swap_b32 v226, v227\n\t" \
    "s_waitcnt lgkmcnt(10)\n\t" \
    "v_add_f32 v216, v226, v227\n\t" \
    "v_pk_mul_f32 v[222:223], v[166:167], v[174:175] op_sel_hi:[1,0]\n\t" \
    "v_pk_fma_f32 %[sm], v[156:157], v[216:217], v[218:219] op_sel_hi:[1,0,1]\n\t" \
    "v_mov_b32_dpp v214, v216 quad_perm:[1,0,3,2] row_mask:0xf bank_mask:0xf\n\t" \
    "v_pk_mul_f32 v[200:201], %[sm], v[170:171]\n\t" \
    "v_pk_fma_f32 %[so], v[156:157], v[214:215], v[220:221] op_sel_hi:[1,0,1]\n\t" \
    "v_add_f32 v208, v200, v201\n\t" \
    "v_pk_mul_f32 v[202:203], %[so], v[170:171]\n\t" \
    "v_pk_mul_f32 v[204:205], %[sm], v[160:161]\n\t" \
    "v_add_f32 v209, v202, v203\n\t" \
    "v_pk_mul_f32 v[206:207], %[so], v[160:161]\n\t" \
    "v_add_f32 v210, v204, v205\n\t" \
    "v_add_f32_dpp v226, v209, v208 quad_perm:[1,0,3,2] row_mask:0xf bank_mask:0xf bound_ctrl:1\n\t" \
    "ds_read_b128 v[152:155], %[a16] offset:39424\n\t" \
    "v_add_f32 v211, v206, v207\n\t" \
    "v_pk_fma_f32 v[222:223], %[sm], v[164:165], v[222:223]\n\t" \
    "v_add_f32_dpp v226, v226, v226 quad_perm:[2,3,0,1] row_mask:0xf bank_mask:0xf bound_ctrl:1\n\t" \
    "ds_read_b128 v[156:159], %[a16] offset:39936\n\t" \
    "v_pk_mul_f32 v[224:225], v[166:167], v[174:175] op_sel:[0,1] op_sel_hi:[1,1]\n\t" \
    "v_add_f32_dpp v212, v211, v210 quad_perm:[1,0,3,2] row_mask:0xf bank_mask:0xf bound_ctrl:1\n\t" \
    "v_add_f32_dpp v226, v226, v226 row_ror:4 row_mask:0xf bank_mask:0xf bound_ctrl:1\n\t" \
    "v_pk_fma_f32 v[224:225], %[so], v[164:165], v[224:225]\n\t" \
    "ds_read_b64 v[160:161], %[a8] offset:39424\n\t" \
    "v_add_f32_dpp v226, v226, v226 row_ror:8 row_mask:0xf bank_mask:0xf bound_ctrl:1\n\t" \
    "v_mov_b32 v227, v226\n\t" \
    "ds_write_b32 %[ya], v212 offset:24576\n\t" \
    "ds_read_b64 v[162:163], %[av] offset:39424\n\t" \
    "v_permlane16_swap_b32 v226, v227\n\t" \
    "s_waitcnt lgkmcnt(10)\n\t" \
    "v_add_f32 v216, v226, v227\n\t" \
    "v_pk_mul_f32 v[218:219], v[178:179], v[186:187] op_sel_hi:[1,0]\n\t" \
    "v_pk_fma_f32 %[sm], v[168:169], v[216:217], v[222:223] op_sel_hi:[1,0,1]\n\t" \
    "v_mov_b32_dpp v214, v216 quad_perm:[1,0,3,2] row_mask:0xf bank_mask:0xf\n\t" \
    "v_pk_mul_f32 v[200:201], %[sm], v[182:183]\n\t" \
    "v_pk_fma_f32 %[so], v[168:169], v[214:215], v[224:225] op_sel_hi:[1,0,1]\n\t" \
    "v_add_f32 v208, v200, v201\n\t" \
    "v_pk_mul_f32 v[202:203], %[so], v[182:183]\n\t" \
    "v_pk_mul_f32 v[204:205], %[sm], v[172:173]\n\t" \
    "v_add_f32 v209, v202, v203\n\t" \
    "v_pk_mul_f32 v[206:207], %[so], v[172:173]\n\t" \
    "v_add_f32 v210, v204, v205\n\t" \
    "v_add_f32_dpp v226, v209, v208 quad_perm:[1,0,3,2] row_mask:0xf bank_mask:0xf bound_ctrl:1\n\t" \
    "ds_read_b128 v[164:167], %[a16] offset:40832\n\t" \
    "v_add_f32 v211, v206, v207\n\t" \
    "v_pk_fma_f32 v[218:219], %[sm], v[176:177], v[218:219]\n\t" \
    "v_add_f32_dpp v226, v226, v226 quad_perm:[2,3,0,1] row_mask:0xf bank_mask:0xf bound_ctrl:1\n\t" \
    "ds_read_b128 v[168:171], %[a16] offset:41344\n\t" \
    "v_pk_mul_f32 v[220:221], v[178:179], v[186:187] op_sel:[0,1] op_sel_hi:[1,1]\n\t" \
    "v_add_f32_dpp v212, v211, v210 quad_perm:[1,0,3,2] row_mask:0xf bank_mask:0xf bound_ctrl:1\n\t" \
    "v_add_f32_dpp v226, v226, v226 row_ror:4 row_mask:0xf bank_mask:0xf bound_ctrl:1\n\t" \
    "v_pk_fma_f32 v[220:221], %[so], v[176:177], v[220:221]\n\t" \
    "ds_read_b64 v[172:173], %[a8] offset:40832\n\t" \
    "v_add_f32_dpp v226, v226, v226 row_ror:8 row_mask:0xf bank_mask:0xf bound_ctrl:1\n\t" \
    "v_mov_b32 v227, v226\n\t" \
    "ds_write_b32 %[ya], v212 offset:25600\n\t" \
    "ds_read_b64 v[174:175], %[av] offset:40832\n\t" \
    "v_permlane16_swap_b32 v226, v227\n\t" \
    "s_waitcnt lgkmcnt(10)\n\t" \
    "v_add_f32 v216, v226, v227\n\t" \
    "v_pk_mul_f32 v[222:223], v[190:191], v[198:199] op_sel_hi:[1,0]\n\t" \
    "v_pk_fma_f32 %[sm], v[180:181], v[216:217], v[218:219] op_sel_hi:[1,0,1]\n\t" \
    "v_mov_b32_dpp v214, v216 quad_perm:[1,0,3,2] row_mask:0xf bank_mask:0xf\n\t" \
    "v_pk_mul_f32 v[200:201], %[sm], v[194:195]\n\t" \
    "v_pk_fma_f32 %[so], v[180:181], v[214:215], v[220:221] op_sel_hi:[1,0,1]\n\t" \
    "v_add_f32 v208, v200, v201\n\t" \
    "v_pk_mul_f32 v[202:203], %[so], v[194:195]\n\t" \
    "v_pk_mul_f32 v[204:205], %[sm], v[184:185]\n\t" \
    "v_add_f32 v209, v202, v203\n\t" \
    "v_pk_mul_f32 v[206:207], %[so], v[184:185]\n\t" \
    "v_add_f32 v210, v204, v205\n\t" \
    "v_add_f32_dpp v226, v209, v208 quad_perm:[1,0,3,2] row_mask:0xf bank_mask:0xf bound_ctrl:1\n\t" \
    "ds_read_b128 v[176:179], %[a16] offset:42240\n\t" \
    "v_add_f32 v211, v206, v207\n\t" \
    "v_pk_fma_f32 v[222:223], %[sm], v[188:189], v[222:223]\n\t" \
    "v_add_f32_dpp v226, v226, v226 quad_perm:[2,3,0,1] row_mask:0xf bank_mask:0xf bound_ctrl:1\n\t" \
    "ds_read_b128 v[180:183], %[a16] offset:42752\n\t" \
    "v_pk_mul_f32 v[224:225], v[190:191], v[198:199] op_sel:[0,1] op_sel_hi:[1,1]\n\t" \
    "v_add_f32_dpp v212, v211, v210 quad_perm:[1,0,3,2] row_mask:0xf bank_mask:0xf bound_ctrl:1\n\t" \
    "v_add_f32_dpp v226, v226, v226 row_ror:4 row_mask:0xf bank_mask:0xf bound_ctrl:1\n\t" \
    "v_pk_fma_f32 v[224:225], %[so], v[188:189], v[224:225]\n\t" \
    "ds_read_b64 v[184:185], %[a8] offset:42240\n\t" \
    "v_add_f32_dpp v226, v226, v226 row_ror:8 row_mask:0xf bank_mask:0xf bound_ctrl:1\n\t" \
    "v_mov_b32 v227, v226\n\t" \
    "ds_write_b32 %[ya], v212 offset:26624\n\t" \
    "ds_read_b64 v[186:187], %[av] offset:42240\n\t" \
    "v_permlane16_swap_b32 v226, v227\n\t" \
    "s_waitcnt lgkmcnt(10)\n\t" \
    "v_add_f32 v216, v226, v227\n\t" \
    "v_pk_mul_f32 v[218:219], v[154:155], v[162:163] op_sel_hi:[1,0]\n\t" \
    "v_pk_fma_f32 %[sm], v[192:193], v[216:217], v[222:223] op_sel_hi:[1,0,1]\n\t" \
    "v_mov_b32_dpp v214, v216 quad_perm:[1,0,3,2] row_mask:0xf bank_mask:0xf\n\t" \
    "v_pk_mul_f32 v[200:201], %[sm], v[158:159]\n\t" \
    "v_pk_fma_f32 %[so], v[192:193], v[214:215], v[224:225] op_sel_hi:[1,0,1]\n\t" \
    "v_add_f32 v208, v200, v201\n\t" \
    "v_pk_mul_f32 v[202:203], %[so], v[158:159]\n\t" \
    "v_pk_mul_f32 v[204:205], %[sm], v[196:197]\n\t" \
    "v_add_f32 v209, v202, v203\n\t" \
    "v_pk_mul_f32 v[206:207], %[so], v[196:197]\n\t" \
    "v_add_f32 v210, v204, v205\n\t" \
    "v_add_f32_dpp v226, v209, v208 quad_perm:[1,0,3,2] row_mask:0xf bank_mask:0xf bound_ctrl:1\n\t" \
    "ds_read_b128 v[188:191], %[a16] offset:43648\n\t" \
    "v_add_f32 v211, v206, v207\n\t" \
    "v_pk_fma_f32 v[218:219], %[sm], v[152:153], v[218:219]\n\t" \
    "v_add_f32_dpp v226, v226, v226 quad_perm:[2,3,0,1] row_mask:0xf bank_mask:0xf bound_ctrl:1\n\t" \
    "ds_read_b128 v[192:195], %[a16] offset:44160\n\t" \
    "v_pk_mul_f32 v[220:221], v[154:155], v[162:163] op_sel:[0,1] op_sel_hi:[1,1]\n\t" \
    "v_add_f32_dpp v212, v211, v210 quad_perm:[1,0,3,2] row_mask:0xf bank_mask:0xf bound_ctrl:1\n\t" \
    "v_add_f32_dpp v226, v226, v226 row_ror:4 row_mask:0xf bank_mask:0xf bound_ctrl:1\n\t" \
    "v_pk_fma_f32 v[220:221], %[so], v[152:153], v[220:221]\n\t" \
    "ds_read_b64 v[196:197], %[a8] offset:43648\n\t" \
    "v_add_f32_dpp v226, v226, v226 row_ror:8 row_mask:0xf bank_mask:0xf bound_ctrl:1\n\t" \
    "v_mov_b32 v227, v226\n\t" \
    "ds_write_b32 %[ya], v212 offset:27648\n\t" \
    "ds_read_b64 v[198:199], %[av] offset:43648\n\t" \
    "v_permlane16_swap_b32 v226, v227\n\t" \
    "s_waitcnt lgkmcnt(10)\n\t" \
    "v_add_f32 v216, v226, v227\n\t" \
    "v_pk_mul_f32 v[222:223], v[166:167], v[174:175] op_sel_hi:[1,0]\n\t" \
    "v_pk_fma_f32 %[sm], v[156:157], v[216:217], v[218:219] op_sel_hi:[1,0,1]\n\t" \
    "v_mov_b32_dpp v214, v216 quad_perm:[1,0,3,2] row_mask:0xf bank_mask:0xf\n\t" \
    "v_pk_mul_f32 v[200:201], %[sm], v[170:171]\n\t" \
    "v_pk_fma_f32 %[so], v[156:157], v[214:215], v[220:221] op_sel_hi:[1,0,1]\n\t" \
    "v_add_f32 v208, v200, v201\n\t" \
    "v_pk_mul_f32 v[202:203], %[so], v[170:171]\n\t" \
    "v_pk_mul_f32 v[204:205], %[sm], v[160:161]\n\t" \
    "v_add_f32 v209, v202, v203\n\t" \
    "v_pk_mul_f32 v[206:207], %[so], v[160:161]\n\t" \
    "v_add_f32 v210, v204, v205\n\t" \
    "v_add_f32_dpp v226, v209, v208 quad_perm:[1,0,3,2] row_mask:0xf bank_mask:0xf bound_ctrl:1\n\t" \
    "v_add_f32 v211, v206, v207\n\t" \
    "v_pk_fma_f32 v[222:223], %[sm], v[164:165], v[222:223]\n\t" \
    "v_add_f32_dpp v226, v226, v226 quad_perm:[2,3,0,1] row_mask:0xf bank_mask:0xf bound_ctrl:1\n\t" \
    "v_pk_mul_f32 v[224:225], v[166:167], v[174:175] op_sel:[0,1] op_sel_hi:[1,1]\n\t" \
    "v_add_f32_dpp v212, v211, v210 quad_perm:[1,0,3,2] row_mask:0xf bank_mask:0xf bound_ctrl:1\n\t" \
    "v_add_f32_dpp v226, v226, v226 row_ror:4 row_mask:0xf bank_mask:0xf bound_ctrl:1\n\t" \
    "v_pk_fma_f32 v[224:225], %[so], v[164:165], v[224:225]\n\t" \
    "s_nop 0\n\t" \
    "v_add_f32_dpp v226, v226, v226 row_ror:8 row_mask:0xf bank_mask:0xf bound_ctrl:1\n\t" \
    "v_mov_b32 v227, v226\n\t" \
    "ds_write_b32 %[ya], v212 offset:28672\n\t" \
    "s_nop 0\n\t" \
    "v_permlane16_swap_b32 v226, v227\n\t" \
    "s_waitcnt lgkmcnt(6)\n\t" \
    "v_add_f32 v216, v226, v227\n\t" \
    "v_pk_mul_f32 v[218:219], v[178:179], v[186:187] op_sel_hi:[1,0]\n\t" \
    "v_pk_fma_f32 %[sm], v[168:169], v[216:217], v[222:223] op_sel_hi:[1,0,1]\n\t" \
    "v_mov_b32_dpp v214, v216 quad_perm:[1,0,3,2] row_mask:0xf bank_mask:0xf\n\t" \
    "v_pk_mul_f32 v[200:201], %[sm], v[182:183]\n\t" \
    "v_pk_fma_f32 %[so], v[168:169], v[214:215], v[224:225] op_sel_hi:[1,0,1]\n\t" \
    "v_add_f32 v208, v200, v201\n\t" \
    "v_pk_mul_f32 v[202:203], %[so], v[182:183]\n\t" \
    "v_pk_mul_f32 v[204:205], %[sm], v[172:173]\n\t" \
    "v_add_f32 v209, v202, v203\n\t" \
    "v_pk_mul_f32 v[206:207], %[so], v[172:173]\n\t" \
    "v_add_f32 v210, v204, v205\n\t" \
    "v_add_f32_dpp v226, v209, v208 quad_perm:[1,0,3,2] row_mask:0xf bank_mask:0xf bound_ctrl:1\n\t" \
    "v_add_f32 v211, v206, v207\n\t" \
    "v_pk_fma_f32 v[218:219], %[sm], v[176:177], v[218:219]\n\t" \
    "v_add_f32_dpp v226, v226, v226 quad_perm:[2,3,0,1] row_mask:0xf bank_mask:0xf bound_ctrl:1\n\t" \
    "v_pk_mul_f32 v[220:221], v[178:179], v[186:187] op_sel:[0,1] op_sel_hi:[1,1]\n\t" \
    "v_add_f32_dpp v212, v211, v210 quad_perm:[1,0,3,2] row_mask:0xf bank_mask:0xf bound_ctrl:1\n\t" \
    "v_add_f32_dpp v226, v226, v226 row_ror:4 row_mask:0xf bank_mask:0xf bound_ctrl:1\n\t" \
    "v_pk_fma_f32 v[220:221], %[so], v[176:177], v[220:221]\n\t" \
    "s_nop 0\n\t" \
    "v_add_f32_dpp v226, v226, v226 row_ror:8 row_mask:0xf bank_mask:0xf bound_ctrl:1\n\t" \
    "v_mov_b32 v227, v226\n\t" \
    "ds_write_b32 %[ya], v212 offset:29696\n\t" \
    "s_nop 0\n\t" \
    "v_permlane16_swap_b32 v226, v227\n\t" \
    "s_waitcnt lgkmcnt(2)\n\t" \
    "v_add_f32 v216, v226, v227\n\t" \
    "v_pk_mul_f32 v[222:223], v[190:191], v[198:199] op_sel_hi:[1,0]\n\t" \
    "v_pk_fma_f32 %[sm], v[180:181], v[216:217], v[218:219] op_sel_hi:[1,0,1]\n\t" \
    "v_mov_b32_dpp v214, v216 quad_perm:[1,0,3,2] row_mask:0xf bank_mask:0xf\n\t" \
    "v_pk_mul_f32 v[200:201], %[sm], v[194:195]\n\t" \
    "v_pk_fma_f32 %[so], v[180:181], v[214:215], v[220:221] op_sel_hi:[1,0,1]\n\t" \
    "v_add_f32 v208, v200, v201\n\t" \
    "v_pk_mul_f32 v[202:203], %[so], v[194:195]\n\t" \
    "v_pk_mul_f32 v[204:205], %[sm], v[184:185]\n\t" \
    "v_add_f32 v209, v202, v203\n\t" \
    "v_pk_mul_f32 v[206:207], %[so], v[184:185]\n\t" \
    "v_add_f32 v210, v204, v205\n\t" \
    "v_add_f32_dpp v226, v209, v208 quad_perm:[1,0,3,2] row_mask:0xf bank_mask:0xf bound_ctrl:1\n\t" \
    "v_add_f32 v211, v206, v207\n\t" \
    "v_pk_fma_f32 v[222:223], %[sm], v[188:189], v[222:223]\n\t" \
    "v_add_f32_dpp v226, v226, v226 quad_perm:[2,3,0,1] row_mask:0xf bank_mask:0xf bound_ctrl:1\n\t" \
    "v_pk_mul_f32 v[224:225], v[190:191], v[198:199] op_sel:[0,1] op_sel_hi:[1,1]\n\t" \
    "v_add_f32_dpp v212, v211, v210 quad_perm:[1,0,3,2] row_mask:0xf bank_mask:0xf bound_ctrl:1\n\t" \
    "v_add_f32_dpp v226, v226, v226 row_ror:4 row_mask:0xf bank_mask:0xf bound_ctrl:1\n\t" \
    "v_pk_fma_f32 v[224:225], %[so], v[188:189], v[224:225]\n\t" \
    "s_nop 0\n\t" \
    "v_add_f32_dpp v226, v226, v226 row_ror:8 row_mask:0xf bank_mask:0xf bound_ctrl:1\n\t" \
    "v_mov_b32 v227, v226\n\t" \
    "ds_write_b32 %[ya], v212 offset:30720\n\t" \
    "s_nop 0\n\t" \
    "v_permlane16_swap_b32 v226, v227\n\t" \
    "v_add_f32 v216, v226, v227\n\t" \
    "v_pk_fma_f32 %[sm], v[192:193], v[216:217], v[222:223] op_sel_hi:[1,0,1]\n\t" \
    "s_nop 0\n\t" \
    "v_mov_b32_dpp v214, v216 quad_perm:[1,0,3,2] row_mask:0xf bank_mask:0xf\n\t" \
    "s_nop 0\n\t" \
    "v_pk_fma_f32 %[so], v[192:193], v[214:215], v[224:225] op_sel_hi:[1,0,1]\n\t" \
    "v_pk_mul_f32 v[204:205], %[sm], v[196:197]\n\t" \
    "v_pk_mul_f32 v[206:207], %[so], v[196:197]\n\t" \
    "v_add_f32 v210, v204, v205\n\t" \
    "v_add_f32 v211, v206, v207\n\t" \
    "s_nop 1\n\t" \
    "v_add_f32_dpp v212, v211, v210 quad_perm:[1,0,3,2] row_mask:0xf bank_mask:0xf bound_ctrl:1\n\t" \
    "ds_write_b32 %[ya], v212 offset:31744\n\t" \
    "s_waitcnt lgkmcnt(0)\n\t"
#define RW_CHUNK_CLOB "memory", "v152", "v153", "v154", "v155", "v156", "v157", "v158", "v159", "v160", "v161", "v162", "v163", "v164", "v165", "v166", "v167", "v168", "v169", "v170", "v171", "v172", "v173", "v174", "v175", "v176", "v177", "v178", "v179", "v180", "v181", "v182", "v183", "v184", "v185", "v186", "v187", "v188", "v189", "v190", "v191", "v192", "v193", "v194", "v195", "v196", "v197", "v198", "v199", "v200", "v201", "v202", "v203", "v204", "v205", "v206", "v207", "v208", "v209", "v210", "v211", "v212", "v213", "v214", "v215", "v216", "v217", "v218", "v219", "v220", "v221", "v222", "v223", "v224", "v225", "v226", "v227"
struct RwRaw { unsigned ew[4], ic[4], kk[4], rr[4], kr[4], vv[4]; };
__device__ __forceinline__ void phase_rwkv_scan(Frame& F, const Args& a, int layer) {
    const bf16_t* P2 = WSP(bf16_t, WS_P2); const bf16_t* EW = WSP(bf16_t, WS_EW); const bf16_t* ICLR = WSP(bf16_t, WS_ICLR); const bf16_t* KK = WSP(bf16_t, WS_KK);
    bf16_t* YRW = WSP(bf16_t, WS_YRW);
    LAS float* ring = (LAS float*)F.lds; LAS float* ybuf = (LAS float*)(F.lds + 2 * RW_CHF * 4);
    const int lane = F.lane;
    for (int u0 = F.bid; u0 < 256; u0 += F.G) {
        const int u = (F.G == 256) ? (((u0 & 7) * 8 + (u0 >> 5)) << 2) + ((u0 >> 3) & 3) : u0;
        const int chain = u >> 2, rq = u & 3, d = chain >> 5, b = (chain >> 4) & 1, h = chain & 15;
        constexpr int NCH = (CTX + SEQ) / RW_CH; static_assert(NCH % 6 == 0, "loader loop is unrolled by 3, compute loop by 2");
        const int lw = F.wave - 4;
        const int tsel = lane >> 5, kp = lane & 31;
        const f32x2 ka2 = *(const f32x2*)(arg_in(a, I_RKA) + layer * 1024 + h * 64 + 2 * kp);
        auto issue = [&](RwRaw& x, int cidx) {
            const int row0 = rw_row(cidx * RW_CH, b, d), st = d == 0 ? 1 : -1;
            const int tk0 = 2 * lw + tsel;
            const unsigned* ewp = (const unsigned*)(EW + (size_t)d * T * 1024); const unsigned* icp = (const unsigned*)(ICLR + (size_t)d * T * 1024);
            const unsigned* kkp = (const unsigned*)KK; const unsigned* p2p = (const unsigned*)P2;
#pragma unroll
            for (int j = 0; j < 4; ++j) { const int row = row0 + st * (8 * j + tk0); const int o = (row * 1024 + h * 64) / 2 + kp, q = (row * P2W + P2_RKV + h * 64) / 2 + kp;
                x.ew[j] = ewp[o]; x.ic[j] = icp[o]; x.kk[j] = kkp[o]; x.rr[j] = p2p[q]; x.kr[j] = p2p[q + 512]; x.vv[j] = p2p[q + 1024 + rq * 8 - kp + (kp & 7)]; } };
        auto commit = [&](const RwRaw& x, int cidx) {
            LAS float* dst = ring + (cidx & 1) * RW_CHF;
#pragma unroll
            for (int j = 0; j < 4; ++j) { LAS float* sbase = dst + (8 * j + 2 * lw + tsel) * RW_STEP_F; LAS f32x2* s2 = (LAS f32x2*)sbase + kp;
                const f32x2 ew = {bflo(x.ew[j]), bfhi(x.ew[j])}, ic = {bflo(x.ic[j]), bfhi(x.ic[j])}, kkv = {bflo(x.kk[j]), bfhi(x.kk[j])}, rr = {bflo(x.rr[j]), bfhi(x.rr[j])}, kr = {bflo(x.kr[j]), bfhi(x.kr[j])};
                const f32x2 kq = kr * ((ic - 1.f) * ka2 + 1.f), bq = kkv * ic; LAS f32x4* s4 = (LAS f32x4*)sbase + kp;
                s4[0] = (f32x4){__expf(-ew.x), __expf(-ew.y), kq.x, kq.y}; s4[32] = (f32x4){bq.x, bq.y, -kkv.x, -kkv.y}; s2[128] = rr;
                if (kp < 8) { const float v0 = bflo(x.vv[j]), v1 = bfhi(x.vv[j]); s4[80] = (f32x4){v0, v1, v1, v0}; } } };
        auto flush_chunk = [&](int cidx) {
            const LAS float* yb = ybuf + (cidx & 1) * (RW_CH * 256);
            const int row0 = rw_row(cidx * RW_CH, b, d), st = d == 0 ? 1 : -1;
#pragma unroll
            for (int q = 0; q < 2; ++q) { const int i = (F.tid - 256) + 256 * q, tok = i >> 4, rr = i & 15; const LAS f32x4* pp = (const LAS f32x4*)(yb + i * 16);
                const f32x4 p0 = pp[0], p1 = pp[1], p2 = pp[2], p3 = pp[3];
                const float y = ((p0.x + p0.y) + (p0.z + p0.w)) + ((p1.x + p1.y) + (p1.z + p1.w)) + (((p2.x + p2.y) + (p2.z + p2.w)) + ((p3.x + p3.y) + (p3.z + p3.w)));
                YRW[((size_t)d * T + row0 + st * tok) * 1024 + h * 64 + rq * 16 + rr] = (bf16_t)f2bf(y); } };
        auto compute = [&](f32x2& sm, f32x2& so, int c) {
            const int kp = lane & 31, par = lane & 1, r16 = F.wave * 4 + (lane >> 5) * 2;
            const unsigned rc = (unsigned)(__UINTPTR_TYPE__)(ring + (c & 1) * RW_CHF);
            const unsigned a16 = rc + kp * 16, a8 = rc + 1024 + kp * 8, av = rc + 1280 + (r16 >> 1) * 16 + par * 8;
            const unsigned ya = (unsigned)(__UINTPTR_TYPE__)(ybuf + (c & 1) * (RW_CH * 256) + (r16 + par) * 16 + (kp >> 1));
            asm volatile(RW_CHUNK_ASM : [sm] "+v"(sm), [so] "+v"(so) : [a16] "v"(a16), [a8] "v"(a8), [av] "v"(av), [ya] "v"(ya) : RW_CHUNK_CLOB);
        };
        __syncthreads();
        f32x2 sm = {0.f, 0.f}, so = {0.f, 0.f};
        if (F.wave >= 4) {
            RwRaw r0, r1, r2;
            issue(r0, 0); commit(r0, 0); issue(r1, 1); issue(r2, 2);
            __syncthreads();
            for (int c = 0; c < NCH; c += 3) {
                if (c + 3 < NCH) issue(r0, c + 3);
                if (c > 0) flush_chunk(c - 1);
                commit(r1, c + 1);
                __syncthreads();
                if (c + 4 < NCH) issue(r1, c + 4);
                flush_chunk(c);
                commit(r2, c + 2);
                __syncthreads();
                if (c + 5 < NCH) issue(r2, c + 5);
                flush_chunk(c + 1);
                if (c + 3 < NCH) commit(r0, c + 3);
                __syncthreads();
            }
            flush_chunk(NCH - 1);
        } else {
            __syncthreads();
            for (int c = 0; c < NCH; c += 2) { compute(sm, so, c); __syncthreads(); compute(sm, so, c + 1); __syncthreads(); }
        }
    }
}
__device__ __forceinline__ void phase_rwkv_out(Frame& F, const Args& a, int layer) {
    const bf16_t* P2 = WSP(bf16_t, WS_P2); const bf16_t* ICLR = WSP(bf16_t, WS_ICLR); const bf16_t* YRW = WSP(bf16_t, WS_YRW); const bf16_t* GG = WSP(bf16_t, WS_GG);
    unsigned char* YD = WSP(unsigned char, WS_Y8D);
    const float* lng = arg_in(a, I_RLNG) + layer * 1024; const float* lnb = arg_in(a, I_RLNB) + layer * 1024; const float* rk = arg_in(a, I_RRK) + layer * 1024; const float* kav = arg_in(a, I_RKA) + layer * 1024;
    for (int row = F.gw; row < T; row += F.NGW) {
        const int c = F.lane * 16; const size_t o = (size_t)row * 1024 + c;
        float y[16], r[16], k[16], v[16], i0[16], i1[16], g[16];
#define LD16(dst, ptr) do { float t0_[8], t1_[8]; ld8bf((ptr), t0_); ld8bf((ptr) + 8, t1_); _Pragma("unroll") for (int i_ = 0; i_ < 8; ++i_) { dst[i_] = t0_[i_]; dst[8 + i_] = t1_[i_]; } } while (0)
        LD16(y, YRW + o); LD16(r, YRW + (size_t)T * 1024 + o);
#pragma unroll
        for (int i = 0; i < 16; ++i) y[i] += r[i];
        const bf16_t* p2 = P2 + (size_t)row * P2W + P2_RKV + c;
        LD16(r, p2); LD16(k, p2 + 1024); LD16(v, p2 + 2048); LD16(i0, ICLR + o); LD16(i1, ICLR + (size_t)T * 1024 + o); LD16(g, GG + o);
#undef LD16
        float s = 0.f, bsum = 0.f;
#pragma unroll
        for (int i = 0; i < 16; ++i) { s += y[i]; const float ka = kav[c + i]; bsum += r[i] * k[i] * rk[c + i] * ((1.f + (i0[i] - 1.f) * ka) + (1.f + (i1[i] - 1.f) * ka)); }
        s = sum4(s); bsum = sum4(bsum);
        const float mu = s * (1.f / 64.f); float q = 0.f;
#pragma unroll
        for (int i = 0; i < 16; ++i) { const float dd = y[i] - mu; q += dd * dd; }
        q = sum4(q);
        const float rstd = 1.f / sqrtf(q * (1.f / 64.f) + 64e-5f);
        float o0[8], o1[8];
#pragma unroll
        for (int i = 0; i < 8; ++i) { o0[i] = ((y[i] - mu) * rstd * lng[c + i] + lnb[c + i] + bsum * v[i]) * g[i];
            o1[i] = ((y[8 + i] - mu) * rstd * lng[c + 8 + i] + lnb[c + 8 + i] + bsum * v[8 + i]) * g[8 + i]; }
        *(u32x4*)(YD + o) = (u32x4){pk4fp8(o0[0], o0[1], o0[2], o0[3]), pk4fp8(o0[4], o0[5], o0[6], o0[7]), pk4fp8(o1[0], o1[1], o1[2], o1[3]), pk4fp8(o1[4], o1[5], o1[6], o1[7])};
    }
}

constexpr int FFT_N = 16384;
__device__ __forceinline__ int fswz(int i) { return i ^ (((i >> 5) & 3) << 2) ^ (((i >> 6) & 1) << 4); }
__device__ __forceinline__ f32x2 cmul(f32x2 a, f32x2 b) { return (f32x2){a.x * b.x - a.y * b.y, a.x * b.y + a.y * b.x}; }
template <bool INV>
__device__ __forceinline__ void fft_passes(LAS f32x2* X, int tid) {
#pragma unroll 1
    for (int st = 0; st < 7; ++st) {
        const int lq = INV ? 2 * st : 12 - 2 * st;
        const int q = 1 << lq; const float inv4q = __uint_as_float((unsigned)(127 - (lq + 2)) << 23);
        __syncthreads();
#pragma unroll 2
        for (int mm = 0; mm < 8; ++mm) { const int uu = tid + 512 * mm; const int k = uu & (q - 1), blk = uu >> lq; const int i0 = (blk << (lq + 2)) + k;
            const int p0 = fswz(i0), p1 = fswz(i0 + q), p2 = fswz(i0 + 2 * q), p3 = fswz(i0 + 3 * q);
            f32x2 a0 = X[p0], a1 = X[p1], a2 = X[p2], a3 = X[p3];
            const float fr = (float)k * inv4q;
            const float cs = __builtin_amdgcn_cosf(fr), sn = __builtin_amdgcn_sinf(fr);
            const f32x2 w1 = INV ? (f32x2){cs, sn} : (f32x2){cs, -sn}; const f32x2 w2 = cmul(w1, w1), w3 = cmul(w2, w1);
            if (!INV) {
                const f32x2 t0 = a0 + a2, t1 = a0 - a2, t2 = a1 + a3, t3 = a1 - a3;
                const f32x2 b0 = t0 + t2, b2 = t0 - t2, b1 = (f32x2){t1.x + t3.y, t1.y - t3.x}, b3 = (f32x2){t1.x - t3.y, t1.y + t3.x};
                X[p0] = b0; X[p1] = cmul(b1, w1); X[p2] = cmul(b2, w2); X[p3] = cmul(b3, w3);
            } else {
                a1 = cmul(a1, w1); a2 = cmul(a2, w2); a3 = cmul(a3, w3);
                const f32x2 u0 = a0 + a2, u1 = a0 - a2, u2 = a1 + a3, u3 = a1 - a3;
                X[p0] = u0 + u2; X[p2] = u0 - u2; X[p1] = (f32x2){u1.x - u3.y, u1.y + u3.x}; X[p3] = (f32x2){u1.x + u3.y, u1.y - u3.x};
            } }
    }
    __syncthreads();
}
__device__ __forceinline__ void phase_hyena_fft(Frame& F, const Args& a, int layer, bool dry = false) {
    const bf16_t* FILT = WSP(bf16_t, WS_FILT); float* VT = WSP(float, WS_VT); const float* hyd = arg_in(a, I_HD) + layer * 1024;
    LAS f32x2* X = (LAS f32x2*)F.lds;
    for (int c = F.bid; c < 1024; c += F.G) {
        __syncthreads();
        const int tid = F.wave * 64 + (lane_asm() & 63), i0 = tid * 16;
        { const bf16_t* hf = FILT + (size_t)c * 2 * SEQ; const bf16_t* hb = hf + SEQ;
          float f[16], g[16]; ld8bf(hf + i0, *(float(*)[8])&f[0]); ld8bf(hf + i0 + 8, *(float(*)[8])&f[8]);
          ld8bf(hb + (SEQ - 16 - i0), *(float(*)[8])&g[0]); ld8bf(hb + (SEQ - 8 - i0), *(float(*)[8])&g[8]);
#pragma unroll
          for (int j = 0; j < 16; ++j) X[fswz(i0 + j)] = (f32x2){f[j], 0.f};
#pragma unroll
          for (int j = 0; j < 16; ++j) { const int pos = SEQ + i0 + 1 + j; if (pos < FFT_N) X[fswz(pos)] = (f32x2){g[15 - j], 0.f}; }
          if (tid == 0) { float zz = 0.f; asm volatile("" : "+v"(zz)); X[fswz(SEQ)] = (f32x2){zz, zz}; } }
        fft_passes<false>(X, F.tid);
        f32x2 Kh[32];
#pragma unroll
        for (int j = 0; j < 32; ++j) Kh[j] = X[fswz(F.tid + 512 * j)];
        __syncthreads();
        float* v0 = VT + (size_t)c * 2 * SEQ; float* v1 = v0 + SEQ;
        { f32x4 a0[4], a1[4];
#pragma unroll
          for (int q = 0; q < 4; ++q) { a0[q] = *(const f32x4*)(v0 + i0 + 4 * q); a1[q] = *(const f32x4*)(v1 + i0 + 4 * q); }
#pragma unroll
          for (int q = 0; q < 4; ++q) { X[fswz(i0 + 4 * q)] = (f32x2){a0[q].x, a1[q].x}; X[fswz(i0 + 4 * q + 1)] = (f32x2){a0[q].y, a1[q].y}; X[fswz(i0 + 4 * q + 2)] = (f32x2){a0[q].z, a1[q].z}; X[fswz(i0 + 4 * q + 3)] = (f32x2){a0[q].w, a1[q].w}; }
          { float zz = 0.f; asm volatile("" : "+v"(zz));
#pragma unroll
          for (int j = 0; j < 16; ++j) X[fswz(SEQ + i0 + j)] = (f32x2){zz, zz}; } }
        fft_passes<false>(X, F.tid);
#pragma unroll
        for (int j = 0; j < 32; ++j) { const int p = fswz(F.tid + 512 * j); X[p] = cmul(X[p], Kh[j]); }
        fft_passes<true>(X, F.tid);
        const float dc = hyd[c];
        { f32x4 a0[4], a1[4];
#pragma unroll
          for (int q = 0; q < 4; ++q) { a0[q] = *(const f32x4*)(v0 + i0 + 4 * q); a1[q] = *(const f32x4*)(v1 + i0 + 4 * q); }
#pragma unroll
          for (int q = 0; q < 4; ++q) { const f32x2 r0 = X[fswz(i0 + 4 * q)], r1 = X[fswz(i0 + 4 * q + 1)], r2 = X[fswz(i0 + 4 * q + 2)], r3 = X[fswz(i0 + 4 * q + 3)];
              const f32x4 o0 = (f32x4){r0.x, r1.x, r2.x, r3.x} * (1.f / FFT_N) + a0[q] * dc, o1 = (f32x4){r0.y, r1.y, r2.y, r3.y} * (1.f / FFT_N) + a1[q] * dc;
              if (!dry) { *(f32x4*)(v0 + i0 + 4 * q) = o0; *(f32x4*)(v1 + i0 + 4 * q) = o1; } } }
    }
}
__device__ __forceinline__ void phase_hyena_out(Frame& F, const Args& a, int layer) {
    const float* VT = WSP(float, WS_VT); const bf16_t* P2 = WSP(bf16_t, WS_P2); bf16_t* YC = WSP(bf16_t, WS_Y) + (size_t)2 * T * 1024;
    LAS float* tl = (LAS float*)F.lds;
    for (int u = F.bid; u < (TL / 64) * 4; u += F.G) {
        const int tb = u >> 2, cb = u & 3; const int row0 = TC + tb * 64; const int b = (row0 - TC) >> 13, t0 = (row0 - TC) & (SEQ - 1);
        __syncthreads();
        for (int p = 0; p < 8; ++p) { const int cl = p * 32 + (F.tid >> 4), q = F.tid & 15;
            const f32x4 v = *(const f32x4*)(VT + ((size_t)(cb * 256 + cl) * 2 + b) * SEQ + t0 + 4 * q);
            tl[cl * 65 + 4 * q] = v.x; tl[cl * 65 + 4 * q + 1] = v.y; tl[cl * 65 + 4 * q + 2] = v.z; tl[cl * 65 + 4 * q + 3] = v.w; }
        __syncthreads();
        const int cl = F.tid & 255, th = F.tid >> 8;
        for (int i = 0; i < 32; ++i) { const int tl_ = th * 32 + i; const size_t row = (size_t)(row0 + tl_);
            const float x0 = bf2f(P2[row * P2W + P2_X0 + cb * 256 + cl]);
            YC[row * 1024 + cb * 256 + cl] = (bf16_t)f2bf(tl[cl * 65 + tl_] * x0); }
    }
    const float* VC = WSP(float, WS_VC); const float* FC = WSP(float, WS_FILTC); const float* hyd = arg_in(a, I_HD) + layer * 1024;
    for (int it = F.gw; it < 2 * 16 * 16; it += F.NGW) {
        const int b = it >> 8, cbk = (it >> 4) & 15, tb = it & 15; const int c = cbk * 64 + F.lane, t0 = tb * 16;
        const float* vb = VC + (size_t)b * CTX * 1024 + c; const float* fc = FC + c;
        float acc[16];
#pragma unroll
        for (int i = 0; i < 16; ++i) acc[i] = 0.f;
#pragma unroll 1
        for (int sb = 0; sb < 16; ++sb) { const int s0 = sb * 16, dl = t0 - s0;
            float f[31], v[16];
#pragma unroll
            for (int j = 0; j < 31; ++j) { const int lag = dl + j - 15; f[j] = lag >= 0 ? fc[(size_t)lag * 2048] : fc[(size_t)(-lag) * 2048 + 1024]; }
#pragma unroll
            for (int j = 0; j < 16; ++j) v[j] = vb[(size_t)(s0 + j) * 1024];
#pragma unroll
            for (int i = 0; i < 16; ++i)
#pragma unroll
                for (int j = 0; j < 16; ++j) acc[i] += f[i - j + 15] * v[j]; }
#pragma unroll
        for (int i = 0; i < 16; ++i) { const int t = t0 + i; const size_t row = (size_t)(b * CTX + t);
            const float x0 = bf2f(P2[row * P2W + P2_X0 + c]);
            YC[row * 1024 + c] = (bf16_t)f2bf((acc[i] + vb[(size_t)t * 1024] * hyd[c]) * x0); }
    }
}

__device__ __forceinline__ void phase_ln1(Frame& F, const Args& a, int layer) {
    const float* mod = (const float*)(F.ws + WS_CTL) + CW_MOD + (size_t)layer * 3 * 6 * DM;
    const float* YM = WSP(float, WS_YMIX); float* XS = WSP(float, WS_XS); unsigned* H2 = WSP(unsigned, WS_H2); float* AFF = WSP(float, WS_AFF); int* INV = WSP(int, WS_INV);
    const float* g1w = arg_in(a, I_LN1G) + layer * DM; const float* b1w = arg_in(a, I_LN1B) + layer * DM; const float* wr = arg_in(a, I_WROUTER) + (size_t)layer * DM * NEXP;
    LAS float* wrT = (LAS float*)F.lds;
    __syncthreads();
    for (int i = F.tid; i < DM * NEXP; i += NTHREADS) { const int c = i >> 4, e = i & 15; wrT[e * DM + c] = wr[i]; }
    __syncthreads();
    int* PTOK = WSP(int, WS_PTOK); float* PG = WSP(float, WS_PGATE);
    for (int i = F.bid * NTHREADS + F.tid; i < NPAIR; i += F.G * NTHREADS) { PTOK[i] = -1; PG[i] = 0.f; }
    for (int row = F.gw; row < T; row += F.NGW) {
        const f32x4* xr = (const f32x4*)x_src_row(a, F, layer, row) + F.lane; const f32x4* yr = (const f32x4*)(YM + (size_t)row * DM) + F.lane;
        const float* m = mod + (size_t)row_modidx(row) * 6 * DM;
        f32x4 v[8];
#pragma unroll
        for (int j = 0; j < 8; ++j) { const int c = 4 * (64 * j + F.lane); v[j] = xr[64 * j] * ALPHA + *(const f32x4*)(m + 2 * DM + c) * yr[64 * j]; }
        float mean, rstd; row_stats(v, mean, rstd, 1e-6f);
        f32x4* xo = (f32x4*)(XS + (size_t)row * DM) + F.lane;
#pragma unroll
        for (int j = 0; j < 8; ++j) { const int c = 4 * (64 * j + F.lane); v[j] = (v[j] - mean) * rstd * *(const f32x4*)(g1w + c) + *(const f32x4*)(b1w + c); xo[64 * j] = v[j]; }
        row_stats(v, mean, rstd, 1e-6f);
        unsigned* ho = H2 + (size_t)row * (DM / 4) + F.lane;
        float lg[16];
#pragma unroll
        for (int e = 0; e < 16; ++e) lg[e] = 0.f;
#pragma unroll
        for (int j = 0; j < 8; ++j) { const int c = 4 * (64 * j + F.lane);
            const f32x4 y = (v[j] - mean) * rstd * (*(const f32x4*)(m + 4 * DM + c) + 1.f) + *(const f32x4*)(m + 3 * DM + c);
            ho[64 * j] = pk4fp8(y.x, y.y, y.z, y.w);
#pragma unroll
            for (int e = 0; e < 16; ++e) { const f32x4 ww = *(const LAS f32x4*)(wrT + e * DM + c); lg[e] += (y.x * ww.x + y.y * ww.y) + (y.z * ww.z + y.w * ww.w); } }
        float mx = -1e30f;
#pragma unroll
        for (int e = 0; e < 16; ++e) { lg[e] = wave_sum(lg[e]); mx = fmaxf(mx, lg[e]); }
        float den = 0.f;
#pragma unroll
        for (int e = 0; e < 16; ++e) { lg[e] = __expf(lg[e] - mx); den += lg[e]; }
        float mine = 0.f;
#pragma unroll
        for (int e = 0; e < 16; ++e) mine = (F.lane == e) ? lg[e] : mine;
        if (F.lane < 16) { AFF[(size_t)row * 16 + F.lane] = mine / den; INV[(size_t)row * 16 + F.lane] = -1; }
    }
}
__device__ __forceinline__ void phase_topk(Frame& F, bool lat_only) {
    const float* AFF = WSP(float, WS_AFF); int* INV = WSP(int, WS_INV); int* PTOK = WSP(int, WS_PTOK); float* PG = WSP(float, WS_PGATE);
    LAS unsigned* vals = (LAS unsigned*)F.lds; LAS unsigned* hist = vals + 8192; LAS unsigned* ctl = hist + 256;
    for (int u = F.bid + (lat_only ? 32 : 0); u < 64; u += F.G) {
        const int s = u >> 4, e = u & 15, rs = seg_start(s), n = seg_len(s), cap = s < 2 ? CAP_C : CAP_L;
        __syncthreads();
        for (int i = F.tid; i < n; i += NTHREADS) vals[i] = __builtin_bit_cast(unsigned, AFF[(size_t)(rs + i) * 16 + e]);
        if (F.tid == 0) { ctl[0] = 0u; ctl[1] = (unsigned)cap; ctl[2] = 0u; ctl[3] = 0u; }
        unsigned mask = 0u;
        for (int shift = 24; shift >= 0; shift -= 8) {
            if (F.tid < 256) hist[F.tid] = 0u;
            __syncthreads();
            const unsigned prefix = ctl[0];
            for (int i = F.tid; i < n; i += NTHREADS) { const unsigned b = vals[i]; if ((b & mask) == prefix) __hip_atomic_fetch_add(&hist[(b >> shift) & 255u], 1u, __ATOMIC_RELAXED, __HIP_MEMORY_SCOPE_WORKGROUP); }
            __syncthreads();
            if (F.wave == 0) {
                const unsigned rem = ctl[1]; unsigned cnt[4]; float tot = 0.f;
#pragma unroll
                for (int j = 0; j < 4; ++j) { cnt[j] = hist[255 - (4 * F.lane + j)]; tot += (float)cnt[j]; }
                const unsigned incl = (unsigned)(wave_incl_scan(tot, F.lane) + 0.5f), excl = incl - (unsigned)(tot + 0.5f);
                if (excl < rem && rem <= incl) { unsigned cum = excl; int j = 0;
#pragma unroll
                    for (int q = 0; q < 3; ++q) { if (j == q && cum + cnt[q] < rem) { cum += cnt[q]; j = q + 1; } }
                    ctl[1] = rem - cum; ctl[0] = prefix | ((unsigned)(255 - (4 * F.lane + j)) << shift); } }
            mask |= 255u << shift;
            __syncthreads();
        }
        const unsigned thr = ctl[0], rem = ctl[1]; const unsigned ngt = (unsigned)cap - rem;
        const int pbase = s < 2 ? NBATCH * NEXP * CAP_L + e * 256 + s * CAP_C : ((s - 2) * NEXP + e) * CAP_L;
        for (int i = F.tid; i < n; i += NTHREADS) { const unsigned b = vals[i]; int slot = -1;
            if (b > thr) slot = (int)__hip_atomic_fetch_add(&ctl[2], 1u, __ATOMIC_RELAXED, __HIP_MEMORY_SCOPE_WORKGROUP);
            else if (b == thr) { const unsigned q = __hip_atomic_fetch_add(&ctl[3], 1u, __ATOMIC_RELAXED, __HIP_MEMORY_SCOPE_WORKGROUP); if (q < rem) slot = (int)(ngt + q); }
            if (slot >= 0) { const int pair = pbase + slot, row = rs + i; PTOK[pair] = row; PG[pair] = __builtin_bit_cast(float, b); INV[(size_t)row * 16 + e] = pair; } }
    }
}
__device__ __forceinline__ void phase_gather(Frame& F) {
    const unsigned char* H2 = WSP(unsigned char, WS_H2); unsigned char* XG = WSP(unsigned char, WS_XG); unsigned char* HID = WSP(unsigned char, WS_HID); const int* PTOK = WSP(int, WS_PTOK);
    for (int p0 = F.gw * 64; p0 < NPAIR; p0 += F.NGW * 64) {
        const int mytok = PTOK[p0 + F.lane];
        unsigned zz = 0u; asm volatile("" : "+v"(zz));
#pragma unroll 1
        for (int q = 0; q < 64; q += 4) {
            u32x4 v[4][2]; int tk[4];
#pragma unroll
            for (int j = 0; j < 4; ++j) { tk[j] = __builtin_amdgcn_readlane(mytok, q + j); const u32x4* src = (const u32x4*)(H2 + (size_t)(tk[j] >= 0 ? tk[j] : 0) * DM) + F.lane; v[j][0] = src[0]; v[j][1] = src[64]; }
#pragma unroll
            for (int j = 0; j < 4; ++j) { const int p = p0 + q + j; u32x4* dst = (u32x4*)(XG + (size_t)p * DM) + F.lane; const bool ok = tk[j] >= 0;
                dst[0] = ok ? v[j][0] : (u32x4){zz, zz, zz, zz}; dst[64] = ok ? v[j][1] : (u32x4){zz, zz, zz, zz};
                if (F.lane < 8) *((u32x4*)(HID + (size_t)p * EFFP + EFF) + F.lane) = (u32x4){zz, zz, zz, zz}; } }
    }
}
__device__ __forceinline__ void phase_ln2(Frame& F, const Args& a, int layer) {
    const float* mod = (const float*)(F.ws + WS_CTL) + CW_MOD + (size_t)layer * 3 * 6 * DM;
    float* XS = WSP(float, WS_XS); const bf16_t* YE = WSP(bf16_t, WS_YE); const int* INV = WSP(int, WS_INV); const float* PG = WSP(float, WS_PGATE);
    const float* g2w = arg_in(a, I_LN2G) + layer * DM; const float* b2w = arg_in(a, I_LN2B) + layer * DM;
    for (int row = F.gw; row < T; row += F.NGW) {
        f32x4* xr = (f32x4*)(XS + (size_t)row * DM) + F.lane; const float* m = mod + (size_t)row_modidx(row) * 6 * DM;
        f32x4 mo[8];
#pragma unroll
        for (int j = 0; j < 8; ++j) mo[j] = (f32x4){0.f, 0.f, 0.f, 0.f};
        const int myinv = F.lane < 16 ? INV[(size_t)row * 16 + F.lane] : -1;
        unsigned long long sel = __ballot(myinv >= 0);
        while (sel) {
            const int e0 = __builtin_ctzll(sel); sel &= sel - 1; const bool two = sel != 0; const int e1 = two ? __builtin_ctzll(sel) : e0; if (two) sel &= sel - 1;
            const int p0 = __builtin_amdgcn_readlane(myinv, e0), p1 = __builtin_amdgcn_readlane(myinv, e1);
            const u32x2* y0 = (const u32x2*)(YE + (size_t)p0 * DM) + F.lane; const u32x2* y1 = (const u32x2*)(YE + (size_t)p1 * DM) + F.lane;
            const float g0 = PG[p0], g1 = two ? PG[p1] : 0.f;
            u32x2 w0[8], w1[8];
#pragma unroll
            for (int j = 0; j < 8; ++j) { w0[j] = y0[64 * j]; w1[j] = y1[64 * j]; }
#pragma unroll
            for (int j = 0; j < 8; ++j) mo[j] += (f32x4){bflo(w0[j].x), bfhi(w0[j].x), bflo(w0[j].y), bfhi(w0[j].y)} * g0 + (f32x4){bflo(w1[j].x), bfhi(w1[j].x), bflo(w1[j].y), bfhi(w1[j].y)} * g1;
        }
        f32x4 v[8];
#pragma unroll
        for (int j = 0; j < 8; ++j) { const int c = 4 * (64 * j + F.lane); v[j] = xr[64 * j] * ALPHA + *(const f32x4*)(m + 5 * DM + c) * mo[j]; }
        float mean, rstd; row_stats(v, mean, rstd, 1e-6f);
#pragma unroll
        for (int j = 0; j < 8; ++j) { const int c = 4 * (64 * j + F.lane); v[j] = (v[j] - mean) * rstd * *(const f32x4*)(g2w + c) + *(const f32x4*)(b2w + c); xr[64 * j] = v[j]; }
        if (layer == DEPTH - 1) { if (row >= TC) { f32x4* o = (f32x4*)(a.out + (size_t)(row - TC) * DM) + F.lane;
#pragma unroll
            for (int j = 0; j < 8; ++j) o[64 * j] = v[j]; } }
        else {
            row_stats(v, mean, rstd, 1e-6f);
            const float* m1 = m + (size_t)3 * 6 * DM;
            bf16_t* H = WSP(bf16_t, WS_H); unsigned* H8 = WSP(unsigned, WS_H8);
            u32x2* o = (u32x2*)(H + (size_t)row * DM) + F.lane; unsigned* o8 = H8 + (size_t)row * (DM / 4) + F.lane;
#pragma unroll
            for (int j = 0; j < 8; ++j) { const int c = 4 * (64 * j + F.lane); const f32x4 sh = *(const f32x4*)(m1 + c), sc = *(const f32x4*)(m1 + DM + c);
                const f32x4 y = (v[j] - mean) * rstd * (sc + 1.f) + sh; u32x2 w; w.x = pk2(y.x, y.y); w.y = pk2(y.z, y.w); o[64 * j] = w; o8[64 * j] = pk4fp8(y.x, y.y, y.z, y.w); } }
    }
}

constexpr int LDS_BYTES = 156672, MISC_OFF = LDS_BYTES - 64;
constexpr int NPL = 16, NPHASE = 1 + DEPTH * NPL;

__global__ void __launch_bounds__(NTHREADS, 2) fwd_kernel(Args args) {
    extern __shared__ __attribute__((aligned(16))) unsigned char lds_raw[];
    Frame F;
    F.lds = (LAS unsigned char*)lds_raw;
    F.tid = threadIdx.x; F.lane = F.tid & 63; F.wave = __builtin_amdgcn_readfirstlane(F.tid >> 6); const int wave0 = F.wave;
    F.G = gridDim.x; F.bid = blockIdx.x; F.gw = F.bid * NWAVES + F.wave; F.NGW = F.G * NWAVES; F.ws = args.ws;
    volatile LAS unsigned* misc = (volatile LAS unsigned*)(F.lds + MISC_OFF);
    if (F.tid < 16) misc[F.tid] = 0u;
    __syncthreads();
    const int lo = args.ph_lo, hi = args.ph_hi;
    XcdBarrier bar; bar.bar = (unsigned*)(F.ws + WS_CTL) + CW_BAR; bar.x = 0; bar.st = nullptr;
    const bool multi = (hi - lo) > 1;
    if (multi) bar = xcd_barrier_post((unsigned*)(F.ws + WS_CTL) + CW_BAR, misc);
#ifndef ONLY_PHASE
#define ONLY_PHASE -1
#endif
#define PON(r) (ONLY_PHASE < 0 || ONLY_PHASE == (r))
#ifndef REP_MASK
#define REP_MASK 0
#endif
#define REP(b) ((REP_MASK >> (b)) & 1)
#define REOPQ() do { F.ws = opq(args.ws); F.lane = lane_asm() & 63; F.wave = opqs(wave0) & 7; F.tid = F.wave * 64 + F.lane; F.G = opqs(gridDim.x); F.bid = opqs(blockIdx.x); F.gw = F.bid * NWAVES + F.wave; F.NGW = F.G * NWAVES; } while (0)
#define IN(k) (lo <= (k) && (k) < hi)
#define SEAM(k) do { if (IN(k) && IN((k) + 1)) { XcdBarrier bb_ = bar; bb_.x = (unsigned)opqs((int)bar.x); xcd_barrier(bb_); } } while (0)
    if (PON(100) && IN(0)) { F.ws = opq(args.ws); F.lane = lane_asm() & 63; F.wave = opqs(wave0) & 7; F.tid = F.wave * 64 + F.lane; F.G = opqs(gridDim.x); F.bid = opqs(blockIdx.x); F.gw = F.bid * NWAVES + F.wave; F.NGW = F.G * NWAVES; { p0_weights(F, args); __syncthreads(); REOPQ(); p0_mod(F, args); __syncthreads(); REOPQ(); phase_hdn(F, args, 0); REOPQ(); phase_hdn(F, args, 1); __syncthreads(); } }
    SEAM(0);
#pragma unroll 1
    for (int layer = 0; layer < DEPTH; ++layer) {
        const int pb = 1 + layer * NPL; const bool lat_only = (layer == DEPTH - 1);
        if (PON(0) && IN(pb + 0)) { F.ws = opq(args.ws); F.lane = lane_asm() & 63; F.wave = opqs(wave0) & 7; F.tid = F.wave * 64 + F.lane; F.G = opqs(gridDim.x); F.bid = opqs(blockIdx.x); F.gw = F.bid * NWAVES + F.wave; F.NGW = F.G * NWAVES; if (layer == 0) phase_modln(F, args, layer); __syncthreads(); }
        SEAM(pb + 0);
        if (PON(1) && IN(pb + 1)) { F.ws = opq(args.ws); F.lane = lane_asm() & 63; F.wave = opqs(wave0) & 7; F.tid = F.wave * 64 + F.lane; F.G = opqs(gridDim.x); F.bid = opqs(blockIdx.x); F.gw = F.bid * NWAVES + F.wave; F.NGW = F.G * NWAVES;
            { pg8::Gemm g{WSP(bf16_t, WS_H), WSP(bf16_t, WS_WIN + layer * SZ_WIN), DM, DM, DM}; pg8::StaticOrder S; S.init(66, 13, F.G, F.bid, 0, 14);
              EpiBf16 E{WSP(bf16_t, WS_P), NNG, nullptr, 0, 0, 1.f, 1 << 30, 0};
              pg8::gemm_phase(F.lds, g, S, E, F.tid); }
            { pg8::Gemm g{WSP(bf16_t, WS_H8), WSP(bf16_t, WS_WIN + layer * SZ_WIN + WIN8P_OFF), DM / 2, DM / 2, DM / 2}; pg8::StaticOrder S; S.init(66, 27, F.G, (F.bid + 90) & 255);
              EpiBf16 E{WSP(bf16_t, WS_P), NNG, nullptr, 0, 0, 1.f / 64.f, 14, 13};
              pg8::gemm_phase<EpiBf16, pg8::StaticOrder, true>(F.lds, g, S, E, F.tid); }
        }
        SEAM(pb + 1);
        if (PON(2) && IN(pb + 2)) { F.ws = opq(args.ws); F.lane = lane_asm() & 63; F.wave = opqs(wave0) & 7; F.tid = F.wave * 64 + F.lane; F.G = opqs(gridDim.x); F.bid = opqs(blockIdx.x); F.gw = F.bid * NWAVES + F.wave; F.NGW = F.G * NWAVES; { phase_prep(F, args, layer); REOPQ(); phase_filt(F, args, layer); __syncthreads(); } }
        SEAM(pb + 2);
        if (PON(3) && IN(pb + 3)) { F.ws = opq(args.ws); F.lane = lane_asm() & 63; F.wave = opqs(wave0) & 7; F.tid = F.wave * 64 + F.lane; F.G = opqs(gridDim.x); F.bid = opqs(blockIdx.x); F.gw = F.bid * NWAVES + F.wave; F.NGW = F.G * NWAVES;
#if !defined(T3) || T3 == 0
            { pg8::Gemm g{WSP(bf16_t, WS_CQ8), WSP(bf16_t, WS_WQ + layer * SZ_WQ), 512, 256, 256}; pg8::StaticOrder S; S.init(lat_only ? 64 : 66, 6, F.G, F.bid, lat_only ? 2 : 0);
              EpiBf16 E{WSP(bf16_t, WS_Q), 1536, WSP(float, WS_RS), 2, 0, 1.f / 16.f, 1 << 30, 0}; pg8::gemm_phase<EpiBf16, pg8::StaticOrder, true>(F.lds, g, S, E, F.tid); }
#endif
#if !defined(T3) || T3 == 1
            { pg8::Gemm g{WSP(bf16_t, WS_CQ8) + 256, WSP(bf16_t, WS_WKV + layer * SZ_WKV), 512, 256, 256}; pg8::StaticOrder S; S.init(66, 8, F.G, (F.bid + 140) & 255);
              EpiBf16 E{WSP(bf16_t, WS_KV), 2048, WSP(float, WS_RS) + 1, 2, 0, 1.f / 16.f, 1 << 30, 0}; pg8::gemm_phase<EpiBf16, pg8::StaticOrder, true>(F.lds, g, S, E, F.tid); }
#endif
#if !defined(T3) || T3 == 2
            { pg8::Gemm g{WSP(bf16_t, WS_ALORA), WSP(bf16_t, WS_WLORA + layer * SZ_WLORA), 256, 256, 256}; pg8::StaticOrder S; S.init(66, 20, F.G, (F.bid + 156) & 255);
              EpiLora E{WSP(bf16_t, WS_EW), WSP(bf16_t, WS_ICLR), WSP(bf16_t, WS_GG), arg_in(args, I_RW0) + layer * 2048, arg_in(args, I_RA0) + layer * 2048, 1.f / 8.f}; pg8::gemm_phase<EpiLora, pg8::StaticOrder, true>(F.lds, g, S, E, F.tid); }
            REOPQ(); phase_mamba_states(F, args, layer); __syncthreads();
#endif
        }
        SEAM(pb + 3);
        if (PON(4) && IN(pb + 4)) { F.ws = opq(args.ws); F.lane = lane_asm() & 63; F.wave = opqs(wave0) & 7; F.tid = F.wave * 64 + F.lane; F.G = opqs(gridDim.x); F.bid = opqs(blockIdx.x); F.gw = F.bid * NWAVES + F.wave; F.NGW = F.G * NWAVES; phase_vt(F); __syncthreads(); }
        SEAM(pb + 4);
        if (PON(5) && IN(pb + 5)) { F.ws = opq(args.ws); F.lane = lane_asm() & 63; F.wave = opqs(wave0) & 7; F.tid = F.wave * 64 + F.lane; F.G = opqs(gridDim.x); F.bid = opqs(blockIdx.x); F.gw = F.bid * NWAVES + F.wave; F.NGW = F.G * NWAVES;
#if !defined(T5) || T5 == 0
            phase_rwkv_scan(F, args, layer); __syncthreads();
#endif
#if !defined(T5) || T5 == 1
            REOPQ(); phase_attn(F, lat_only);
#endif
#if !defined(T5) || T5 == 2
            REOPQ(); phase_hyena_fft(F, args, layer);
#endif
#if !defined(T5) || T5 == 3
            REOPQ(); phase_mamba_scan(F); __syncthreads();
#endif
        }
        SEAM(pb + 5);
        if (PON(6) && IN(pb + 6)) { F.ws = opq(args.ws); F.lane = lane_asm() & 63; F.wave = opqs(wave0) & 7; F.tid = F.wave * 64 + F.lane; F.G = opqs(gridDim.x); F.bid = opqs(blockIdx.x); F.gw = F.bid * NWAVES + F.wave; F.NGW = F.G * NWAVES;
#if !defined(T6) || T6 == 0
            phase_mamba_out(F, args, layer); __syncthreads();
#endif
#if !defined(T6) || T6 == 1
            REOPQ(); phase_hyena_out(F, args, layer);
#endif
#if !defined(T6) || T6 == 2
            REOPQ(); phase_rwkv_out(F, args, layer); __syncthreads();
#endif
        }
        SEAM(pb + 6);
        if (PON(7) && IN(pb + 7)) { F.ws = opq(args.ws); F.lane = lane_asm() & 63; F.wave = opqs(wave0) & 7; F.tid = F.wave * 64 + F.lane; F.G = opqs(gridDim.x); F.bid = opqs(blockIdx.x); F.gw = F.bid * NWAVES + F.wave; F.NGW = F.G * NWAVES;
            pg8::Gemm g{WSP(bf16_t, WS_H8), WSP(bf16_t, WS_WIN + layer * SZ_WIN) + (size_t)NNG * DM, DM / 2, DM / 2, DM / 2}; pg8::StaticOrder S; S.init(lat_only ? 64 : 66, NGATE / 256, F.G, F.bid, lat_only ? 2 : 0);
            EpiBf16 E{WSP(bf16_t, WS_GATES), NGATE, nullptr, 0, 0, 1.f / 64.f, 1 << 30, 0};
            pg8::gemm_phase<EpiBf16, pg8::StaticOrder, true>(F.lds, g, S, E, F.tid);
            REOPQ(); phase_mamba_norm(F, args, layer);
        }
        SEAM(pb + 7);
        if (PON(8) && IN(pb + 8)) { F.ws = opq(args.ws); F.lane = lane_asm() & 63; F.wave = opqs(wave0) & 7; F.tid = F.wave * 64 + F.lane; F.G = opqs(gridDim.x); F.bid = opqs(blockIdx.x); F.gw = F.bid * NWAVES + F.wave; F.NGW = F.G * NWAVES;
            { pg8::Gemm g{WSP(bf16_t, WS_Y), WSP(bf16_t, WS_WBR + layer * SZ_WBR), 1024, 1024, 1024}; OrderHy S; S.init(F.G, F.bid, lat_only ? 64 : 66, lat_only ? 2 : 0);
              EpiHy E{WSP(bf16_t, WS_GATES), WSP(bf16_t, WS_MRGB)};
              pg8::gemm_phase(F.lds, g, S, E, F.tid); }
            { pg8::Gemm g{WSP(bf16_t, WS_Y), WSP(bf16_t, WS_WBR + layer * SZ_WBR), 512, 512, 512}; OrderMerge3 S; S.init(F.G, F.bid, lat_only ? 64 : 66, lat_only ? 2 : 0);
              EpiMerge3 E{WSP(bf16_t, WS_GATES), WSP(bf16_t, WS_MRGB)};
              pg8::gemm_phase<EpiMerge3, OrderMerge3, true>(F.lds, g, S, E, F.tid); }
        }
        SEAM(pb + 8);
        if (PON(9) && IN(pb + 9)) { F.ws = opq(args.ws); F.lane = lane_asm() & 63; F.wave = opqs(wave0) & 7; F.tid = F.wave * 64 + F.lane; F.G = opqs(gridDim.x); F.bid = opqs(blockIdx.x); F.gw = F.bid * NWAVES + F.wave; F.NGW = F.G * NWAVES;
            pg8::Gemm g{WSP(bf16_t, WS_MRGB), WSP(bf16_t, WS_WOUT + layer * SZ_WOUT), DM, DM, DM}; pg8::StaticOrder S; S.init(lat_only ? 64 : 66, 8, F.G, F.bid, lat_only ? 2 : 0);
            EpiF32 E{WSP(float, WS_YMIX), DM};
            pg8::gemm_phase(F.lds, g, S, E, F.tid);

        }
        SEAM(pb + 9);
        if (PON(10) && IN(pb + 10)) { F.ws = opq(args.ws); F.lane = lane_asm() & 63; F.wave = opqs(wave0) & 7; F.tid = F.wave * 64 + F.lane; F.G = opqs(gridDim.x); F.bid = opqs(blockIdx.x); F.gw = F.bid * NWAVES + F.wave; F.NGW = F.G * NWAVES; phase_ln1(F, args, layer); __syncthreads(); { REOPQ(); conv_experts(F, args, layer); __syncthreads(); } }
        SEAM(pb + 10);
        if (PON(11) && IN(pb + 11)) { F.ws = opq(args.ws); F.lane = lane_asm() & 63; F.wave = opqs(wave0) & 7; F.tid = F.wave * 64 + F.lane; F.G = opqs(gridDim.x); F.bid = opqs(blockIdx.x); F.gw = F.bid * NWAVES + F.wave; F.NGW = F.G * NWAVES; phase_topk(F, lat_only); __syncthreads(); }
        SEAM(pb + 11);
        if (PON(12) && IN(pb + 12)) { F.ws = opq(args.ws); F.lane = lane_asm() & 63; F.wave = opqs(wave0) & 7; F.tid = F.wave * 64 + F.lane; F.G = opqs(gridDim.x); F.bid = opqs(blockIdx.x); F.gw = F.bid * NWAVES + F.wave; F.NGW = F.G * NWAVES; phase_gather(F); }
        SEAM(pb + 12);
        if (PON(13) && IN(pb + 13)) { F.ws = opq(args.ws); F.lane = lane_asm() & 63; F.wave = opqs(wave0) & 7; F.tid = F.wave * 64 + F.lane; F.G = opqs(gridDim.x); F.bid = opqs(blockIdx.x); F.gw = F.bid * NWAVES + F.wave; F.NGW = F.G * NWAVES;
            pg8::Gemm g{WSP(bf16_t, WS_XG), WSP(bf16_t, WS_WE), DM / 2, DM / 2, DM / 2}; OrderMoe S; S.init(11, F.G, F.bid, lat_only ? 8 : 9);
            EpiSwiglu E{WSP(unsigned char, WS_HID)};
            pg8::gemm_phase<EpiSwiglu, OrderMoe, true>(F.lds, g, S, E, F.tid);

        }
        SEAM(pb + 13);
        if (PON(14) && IN(pb + 14)) { F.ws = opq(args.ws); F.lane = lane_asm() & 63; F.wave = opqs(wave0) & 7; F.tid = F.wave * 64 + F.lane; F.G = opqs(gridDim.x); F.bid = opqs(blockIdx.x); F.gw = F.bid * NWAVES + F.wave; F.NGW = F.G * NWAVES;
            pg8::Gemm g{WSP(bf16_t, WS_HID), WSP(bf16_t, WS_WE + SZ_WGU8), EFFP / 2, EFFP / 2, EFFP / 2}; OrderMoe S; S.init(8, F.G, F.bid, lat_only ? 8 : 9);
            EpiDown E{WSP(bf16_t, WS_YE)};
            pg8::gemm_phase<EpiDown, OrderMoe, true>(F.lds, g, S, E, F.tid);

        }
        SEAM(pb + 14);
        if (PON(15) && IN(pb + 15)) { F.ws = opq(args.ws); F.lane = lane_asm() & 63; F.wave = opqs(wave0) & 7; F.tid = F.wave * 64 + F.lane; F.G = opqs(gridDim.x); F.bid = opqs(blockIdx.x); F.gw = F.bid * NWAVES + F.wave; F.NGW = F.G * NWAVES; phase_ln2(F, args, layer); }
        SEAM(pb + 15);
    }
#undef IN
#undef SEAM
}


#ifdef DBG_CUT
__global__ void dbg_dump(const unsigned char* ws, float* out, size_t off, int is_bf16, size_t n_src) {
    const size_t N = (size_t)TL * DM;
    for (size_t i = (size_t)blockIdx.x * blockDim.x + threadIdx.x; i < N; i += (size_t)gridDim.x * blockDim.x) {
        const size_t j = i % n_src;
        out[i] = is_bf16 ? bf2f(((const bf16_t*)(ws + off))[j]) : ((const float*)(ws + off))[j];
    }
}
#endif

#ifdef DBG_PASSES
__global__ void dbg_chk(const unsigned char* base, size_t off, size_t nbytes, unsigned long long* slot) {
    const unsigned* p = (const unsigned*)(base + off); const size_t n = nbytes / 4; unsigned long long s = 0;
    for (size_t i = (size_t)blockIdx.x * blockDim.x + threadIdx.x; i < n; i += (size_t)gridDim.x * blockDim.x) s += p[i];
    for (int o = 32; o > 0; o >>= 1) s += __shfl_xor(s, o);
    if ((threadIdx.x & 63) == 0) atomicAdd(slot, s);
}
__global__ void dbg_report(const unsigned long long* tab, float* out, int npass) {
    int k = 0;
    for (int ph = NPHASE - 1; ph >= 0; --ph) if (tab[ph] != tab[64 + ph]) k = ph + 1;
    if (k == 0 && npass > 2) { for (int ph = NPHASE - 1; ph >= 0; --ph) if (tab[64 + ph] != tab[128 + ph]) k = 50 + ph + 1; }
    if (k == 0) return;
    const float c = sqrtf(10.f * (float)k);
    for (size_t i = (size_t)blockIdx.x * blockDim.x + threadIdx.x; i < (size_t)TL * DM; i += (size_t)gridDim.x * blockDim.x) out[i] = c;
}
struct DbgReg { size_t off, n; };
#endif
extern "C" void kernel_launch(void* const* d_in, const int* in_sizes, int n_in, void* d_out, int out_size, void* d_ws, size_t ws_size, hipStream_t stream) {
    static int grid = 0;
    if (grid == 0) {
        if (n_in != N_INPUTS || in_sizes[0] != TL * DM || out_size != TL * DM || ws_size < WS_END) {
            fprintf(stderr, "kernel_launch: shape/workspace mismatch: n_in %d in0 %d out %d ws %zu (need %zu)\n", n_in, n_in > 0 ? in_sizes[0] : -1, out_size, ws_size, (size_t)WS_END); grid = -1; return; }
        int dev = 0, cus = 0, per_cu = 0;
        if (hipGetDevice(&dev) != hipSuccess || hipDeviceGetAttribute(&cus, hipDeviceAttributeMultiprocessorCount, dev) != hipSuccess) { grid = -1; return; }
        if (hipFuncSetAttribute((const void*)fwd_kernel, hipFuncAttributeMaxDynamicSharedMemorySize, LDS_BYTES) != hipSuccess) { fprintf(stderr, "kernel_launch: hipFuncSetAttribute failed\n"); grid = -1; return; }
        if (hipOccupancyMaxActiveBlocksPerMultiprocessor(&per_cu, (const void*)fwd_kernel, NTHREADS, LDS_BYTES) != hipSuccess || per_cu < 1) { fprintf(stderr, "kernel_launch: occupancy query says %d\n", per_cu); grid = -1; (void)hipGetLastError(); return; }
        grid = cus;
    }
    if (grid < 0) return;
    (void)hipMemsetAsync((char*)d_ws + WS_CTL, 0, CTL_BYTES, stream);
    Args a{};
    for (int i = 0; i < N_INPUTS; ++i) a.in[i] = (const float*)d_in[i];
    a.out = (float*)d_out; a.ws = (unsigned char*)d_ws;
#if MK_ONE_LAUNCH
    a.ph_lo = 0; a.ph_hi = NPHASE;
    hipLaunchKernelGGL(fwd_kernel, dim3(grid), dim3(NTHREADS), LDS_BYTES, stream, a);
#else
#ifdef DBG_PASSES
    {
        unsigned long long* tab = (unsigned long long*)((char*)d_ws + 1600000);
        auto chk = [&](int pass, int ph, size_t off, size_t n) { hipLaunchKernelGGL(dbg_chk, dim3(1024), dim3(256), 0, stream, (const unsigned char*)d_ws, off, n, tab + pass * 64 + ph); };
        for (int pass = 0; pass < DBG_PASSES; ++pass) {
            if (pass > 0) (void)hipMemsetAsync((char*)d_ws + (size_t)CW_MOD * 4, 0, (size_t)DEPTH * 3 * 6 * DM * 4, stream);
            for (int ph = 0; ph < NPHASE; ++ph) {
                a.ph_lo = ph; a.ph_hi = ph + 1; hipLaunchKernelGGL(fwd_kernel, dim3(grid), dim3(NTHREADS), LDS_BYTES, stream, a);
                if (ph == 0) { chk(pass, ph, WS_WIN, WS_XS - WS_WIN); chk(pass, ph, (size_t)CW_MOD * 4, (size_t)DEPTH * 3 * 6 * DM * 4); continue; }
                const int r = (ph - 1) % NPL;
                switch (r) {
                case 0: chk(pass, ph, WS_H, SZ_H); chk(pass, ph, WS_HDN, SZ_HDN); break;
                case 1: chk(pass, ph, WS_P, SZ_P); break;
                case 2: chk(pass, ph, WS_P2, SZ_P2); chk(pass, ph, WS_KK, SZ_TK2); chk(pass, ph, WS_ALORA, WS_VT - WS_ALORA); chk(pass, ph, WS_VT, WS_HDN - WS_VT); break;
                case 3: chk(pass, ph, WS_Q, SZ_Q + SZ_KV); chk(pass, ph, WS_EW, 4 * SZ_TK2); chk(pass, ph, WS_GG, SZ_TK2); break;
                case 4: chk(pass, ph, WS_Q, SZ_Q); chk(pass, ph, WS_MST, SZ_MST + SZ_MCS); break;
                case 5: chk(pass, ph, WS_YRW, 2 * SZ_TK2); chk(pass, ph, WS_Y, SZ_Y / 4); chk(pass, ph, WS_VT, SZ_VT); chk(pass, ph, WS_MST, SZ_MST); break;
                case 6: chk(pass, ph, WS_Y + SZ_Y / 4, 3 * (SZ_Y / 4)); break;
                case 7: chk(pass, ph, WS_GATES, SZ_GATES); chk(pass, ph, WS_Y + SZ_Y / 4, SZ_Y / 4); break;
                case 8: chk(pass, ph, WS_MRGF, SZ_MRGF); chk(pass, ph, WS_MRGB, SZ_MRGB); break;
                case 9: chk(pass, ph, WS_YMIX, SZ_YMIX); break;
                case 10: chk(pass, ph, WS_XS, SZ_XS); chk(pass, ph, WS_H2, SZ_H); chk(pass, ph, WS_AFF, SZ_AFF); chk(pass, ph, WS_WE, SZ_WGU + SZ_WD); break;
                case 11: chk(pass, ph, WS_INV, SZ_INV + SZ_PTOK + SZ_PGATE); break;
                case 12: chk(pass, ph, WS_XG, SZ_XG); break;
                case 13: chk(pass, ph, WS_HID, SZ_HID); break;
                case 14: chk(pass, ph, WS_YE, SZ_YE); break;
                case 15: chk(pass, ph, WS_XS, SZ_XS); break;
                }
            }
        }
        hipLaunchKernelGGL(dbg_report, dim3(2048), dim3(256), 0, stream, (const unsigned long long*)tab, (float*)d_out, (int)DBG_PASSES);
    }
#elif defined(DBG_CUT)
    for (int ph = 0; ph < DBG_CUT; ++ph) { a.ph_lo = ph; a.ph_hi = ph + 1; hipLaunchKernelGGL(fwd_kernel, dim3(grid), dim3(NTHREADS), LDS_BYTES, stream, a); }
    hipLaunchKernelGGL(dbg_dump, dim3(2048), dim3(256), 0, stream, (const unsigned char*)d_ws, (float*)d_out, (size_t)DBG_OFF, DBG_BF16, (size_t)DBG_N);
#else
    for (int ph = 0; ph < NPHASE; ++ph) { a.ph_lo = ph; a.ph_hi = ph + 1; hipLaunchKernelGGL(fwd_kernel, dim3(grid), dim3(NTHREADS), LDS_BYTES, stream, a); }
#endif
#endif
}
```

```cpp
#include <hip/hip_runtime.h>
#include <cstdio>
#include <cstdint>

#define REP_MASK 0x80000
#ifndef MK_ONE_LAUNCH
#define MK_ONE_LAUNCH 1
#endif

#define LAS __attribute__((address_space(3)))
typedef unsigned short bf16_t;
typedef short bf16x8 __attribute__((ext_vector_type(8)));
typedef float f32x4 __attribute__((ext_vector_type(4)));
typedef float f32x2 __attribute__((ext_vector_type(2)));
typedef unsigned u32x4 __attribute__((ext_vector_type(4)));
typedef unsigned u32x2 __attribute__((ext_vector_type(2)));

constexpr int DM = 2048, NBATCH = 2, SEQ = 8192, CTX = 256, DEPTH = 2;
constexpr int TC = NBATCH * CTX, TL = NBATCH * SEQ, T = TC + TL;
constexpr int NIN = 18432, NNG = 10240, NGATE = 8192;
constexpr int P_CQ = 0, P_CKV = 512, P_KPE = 1024;
constexpr int P_Z = 1088, P_XBC = 2112, P_DT = 3648;
constexpr int P_HY = 3680;
constexpr int P_RW = 6752, P_WD = 9824, P_AD = 9952, P_GD = 10080;
constexpr int NH_MLA = 8, NH_SSM = 16, NH_RW = 16;
constexpr int NEXP = 16, EFF = 1408, CAP_L = 1024, CAP_C = 32;
constexpr int NPAIR = NBATCH * NEXP * CAP_L + NEXP * 256;
constexpr float ALPHA = 1.4142135623730951f;
constexpr int NWAVES = 8, NTHREADS = 512;

__device__ __forceinline__ int seg_of(int row) { return row < 256 ? 0 : row < 512 ? 1 : row < 512 + SEQ ? 2 : 3; }
__device__ __forceinline__ int seg_start(int s) { return s == 0 ? 0 : s == 1 ? 256 : s == 2 ? 512 : 512 + SEQ; }
__device__ __forceinline__ int seg_len(int s) { return s < 2 ? CTX : SEQ; }
__device__ __forceinline__ bool row_first(int row) { return row == 0 || row == 256 || row == 512 || row == 512 + SEQ; }
__device__ __forceinline__ bool row_last(int row) { return row == 255 || row == 511 || row == 511 + SEQ || row == T - 1; }
__device__ __forceinline__ int row_modidx(int row) { return row < 512 ? 2 : (row < 512 + SEQ ? 0 : 1); }

constexpr size_t AL(size_t x) { return (x + 255) / 256 * 256; }
constexpr size_t WS_CTL = 0, CTL_BYTES = 2u << 20;
constexpr int CW_BAR = 1024;
constexpr int CW_MOD = 16384;
constexpr size_t SZ_WIN = (size_t)NIN * DM * 2, SZ_WBR = (size_t)4 * DM * 1024 * 2, SZ_WOUT = (size_t)DM * DM * 2, SZ_WQ = (size_t)1536 * 512 * 2,
                 SZ_WKV = (size_t)2048 * 512 * 2, SZ_WLORA = (size_t)5120 * 512 * 2;
constexpr size_t WS_WIN = CTL_BYTES, WS_WBR = WS_WIN + DEPTH * SZ_WIN, WS_WOUT = WS_WBR + DEPTH * SZ_WBR, WS_WQ = WS_WOUT + DEPTH * SZ_WOUT,
                 WS_WKV = WS_WQ + DEPTH * SZ_WQ, WS_WLORA = WS_WKV + DEPTH * SZ_WKV, WS_XS = WS_WLORA + DEPTH * SZ_WLORA;
constexpr size_t SZ_XS = (size_t)T * DM * 4;
constexpr size_t WIN8P_OFF = (size_t)NNG * DM * 2 + (size_t)NGATE * DM;
static_assert(WIN8P_OFF + (size_t)27 * 256 * DM <= SZ_WIN, "w_in area");
constexpr size_t WS_H = WS_XS + SZ_XS, SZ_H = (size_t)T * DM * 2;
constexpr size_t WS_P = WS_H + SZ_H, SZ_P = (size_t)T * NNG * 2;
constexpr int P2W = 5632, P2_XBC = 0, P2_X0 = 1536, P2_RKV = 2560;
constexpr size_t WS_P2 = WS_P + SZ_P, SZ_P2 = (size_t)T * P2W * 2;
constexpr size_t WS_Q = WS_P2 + SZ_P2, SZ_Q = (size_t)T * 1536 * 2;
constexpr size_t WS_KV = WS_Q + SZ_Q, SZ_KV = (size_t)T * 2048 * 2;
constexpr size_t WS_EW = WS_KV + SZ_KV, SZ_TK2 = (size_t)T * 1024 * 2;
constexpr size_t WS_ICLR = WS_EW + 2 * SZ_TK2;
constexpr size_t WS_KK = WS_ICLR + 2 * SZ_TK2;
constexpr size_t WS_GG = WS_KK + SZ_TK2;
constexpr size_t WS_YRW = WS_GG + SZ_TK2;
constexpr size_t WS_ALORA = WS_YRW + 2 * SZ_TK2, SZ_ALORA = (size_t)T * 512 * 2;
constexpr size_t WS_KPE = WS_ALORA + SZ_ALORA, SZ_KPE = (size_t)T * 64 * 2;
constexpr size_t WS_RS = WS_KPE + SZ_KPE, SZ_RS = AL((size_t)T * 2 * 4);
constexpr size_t WS_DT = WS_RS + SZ_RS, SZ_DT = (size_t)T * 32 * 4;
constexpr size_t WS_VT = WS_DT + SZ_DT, SZ_VT = (size_t)1024 * 2 * SEQ * 4;
constexpr size_t WS_VC = WS_VT + SZ_VT, SZ_VC = (size_t)TC * 1024 * 4;
constexpr size_t WS_FILT = WS_VC + SZ_VC, SZ_FILT = (size_t)1024 * 2 * SEQ * 2;
constexpr size_t WS_FILTC = WS_FILT + SZ_FILT, SZ_FILTC = (size_t)CTX * 2048 * 4;
constexpr size_t WS_HDN = WS_FILTC + SZ_FILTC, SZ_HDN1 = (size_t)(SEQ + CTX) * 64 * 4, SZ_HDN = DEPTH * SZ_HDN1;
constexpr int NCHUNK = T / 128;
constexpr size_t WS_MST = WS_HDN + SZ_HDN, SZ_MST = (size_t)2 * NCHUNK * 16 * 8192 * 2;
constexpr size_t WS_MCS = WS_MST + SZ_MST, SZ_MCS = (size_t)2 * NCHUNK * 16 * 4 * 2;
constexpr size_t WS_Y = WS_MCS + AL(SZ_MCS), SZ_Y = (size_t)4 * T * 1024 * 2;
constexpr float Y8A_SCALE = 64.f;
constexpr size_t SZ_Y8 = (size_t)T * 1024, WS_Y8A = WS_Y, WS_Y8B = WS_Y + SZ_Y8, WS_Y8D = WS_Y + 3 * (SZ_Y / 4);
constexpr size_t WS_VT8 = WS_Y + 2 * (SZ_Y / 4), WS_K8 = WS_VT8 + (size_t)8 * 128 * T, WS_KPE8 = WS_Y + 3 * (SZ_Y / 4) + (size_t)T * 1024;
constexpr size_t WS_AFF = WS_Y + SZ_Y, SZ_AFF = (size_t)T * 16 * 4;
constexpr size_t WS_INV = WS_AFF + SZ_AFF, SZ_INV = (size_t)T * 16 * 4;
constexpr size_t WS_PTOK = WS_INV + SZ_INV, SZ_PTOK = (size_t)NPAIR * 4;
constexpr size_t WS_PGATE = WS_PTOK + SZ_PTOK, SZ_PGATE = (size_t)NPAIR * 4;
constexpr size_t WS_H8 = WS_PGATE + SZ_PGATE, SZ_H8 = (size_t)T * DM;
constexpr size_t WS_CQ8 = WS_H8 + SZ_H8, SZ_CQ8 = (size_t)T * 1024;
constexpr size_t WS_END = WS_CQ8 + SZ_CQ8;
constexpr size_t WS_GATES = WS_P, SZ_GATES = (size_t)T * NGATE * 2;
constexpr size_t WS_MRGF = WS_P2, SZ_MRGF = (size_t)T * DM * 4;
constexpr size_t WS_MRGB = WS_Q, SZ_MRGB = (size_t)T * DM * 2;
constexpr size_t WS_YMIX = WS_P, SZ_YMIX = (size_t)T * DM * 4;
constexpr size_t WS_H2 = WS_H;
constexpr size_t WS_WE = WS_P2, SZ_WGU = (size_t)NEXP * 2816 * DM * 2, SZ_WD = (size_t)NEXP * DM * EFF * 2;
constexpr size_t WS_XG = WS_P, SZ_XG = (size_t)NPAIR * DM * 2;
constexpr size_t WS_HID = WS_XG + SZ_XG, SZ_HID = (size_t)NPAIR * EFF * 2;
constexpr size_t WS_YE = WS_WE + SZ_WGU + SZ_WD, SZ_YE = (size_t)NPAIR * DM * 2;
static_assert(SZ_GATES <= SZ_P && SZ_MRGF <= SZ_P2 && SZ_MRGB <= SZ_Q + SZ_KV && SZ_YMIX <= SZ_P, "alias map 1");
static_assert(SZ_XG + SZ_HID <= SZ_P, "alias map 2");
static_assert(WS_YE + SZ_YE <= WS_VT, "alias map 3");
static_assert(WS_END < 1800000000ull, "workspace budget");

__device__ __forceinline__ unsigned f2bf(float f) { unsigned u = __builtin_bit_cast(unsigned, f); return (u + 0x7fffu + ((u >> 16) & 1u)) >> 16; }
__device__ __forceinline__ unsigned pk2(float lo, float hi) { return f2bf(lo) | (f2bf(hi) << 16); }
__device__ __forceinline__ float bf2f(unsigned short b) { return __builtin_bit_cast(float, (unsigned)b << 16); }
__device__ __forceinline__ float bflo(unsigned w) { return __builtin_bit_cast(float, w << 16); }
__device__ __forceinline__ float bfhi(unsigned w) { return __builtin_bit_cast(float, w & 0xffff0000u); }
__device__ __forceinline__ unsigned cvt_pk_bf16(float lo, float hi) { unsigned r; asm volatile("v_cvt_pk_bf16_f32 %0, %1, %2" : "=v"(r) : "v"(lo), "v"(hi)); return r; }
__device__ __forceinline__ float dppx(float x, const int sel) {
    const int xi = __builtin_bit_cast(int, x); int r;
    if (sel == 0) r = __builtin_amdgcn_update_dpp(0, xi, 0xB1, 0xF, 0xF, false);
    else if (sel == 1) r = __builtin_amdgcn_update_dpp(0, xi, 0x4E, 0xF, 0xF, false);
    else if (sel == 2) r = __builtin_amdgcn_update_dpp(0, xi, 0x141, 0xF, 0xF, false);
    else r = __builtin_amdgcn_update_dpp(0, xi, 0x140, 0xF, 0xF, false);
    return __builtin_bit_cast(float, r);
}
__device__ __forceinline__ float swz16(float x) { return __builtin_bit_cast(float, __builtin_amdgcn_ds_swizzle(__builtin_bit_cast(int, x), 0x401F)); }
__device__ __forceinline__ float sum4(float v) { v += dppx(v, 0); v += dppx(v, 1); return v; }
__device__ __forceinline__ float sum8(float v) { v = sum4(v); v += dppx(v, 2); return v; }
__device__ __forceinline__ float sum16(float v) { v = sum8(v); v += dppx(v, 3); return v; }
__device__ __forceinline__ float sum32(float v) { v = sum16(v); v += swz16(v); return v; }
__device__ __forceinline__ unsigned pk4fp8(float a, float b, float c, float d) { int w = 0; w = __builtin_amdgcn_cvt_pk_fp8_f32(a, b, w, false); w = __builtin_amdgcn_cvt_pk_fp8_f32(c, d, w, true); return (unsigned)w; }
__device__ __forceinline__ float wave_sum(float v) {
    v = sum32(v);
    auto rr = __builtin_amdgcn_permlane32_swap(__float_as_uint(v), __float_as_uint(v), false, false);
    return __uint_as_float(rr[0]) + __uint_as_float(rr[1]);
}
__device__ __forceinline__ float sigmoidf_(float x) { return 1.f / (1.f + __expf(-x)); }
__device__ __forceinline__ float siluf_(float x) { return x / (1.f + __expf(-x)); }
__device__ __forceinline__ float softplusf_(float x) { return x > 20.f ? x : __logf(1.f + __expf(x)); }
__device__ __forceinline__ float tanhf_(float x) { const float e = __expf(2.f * fminf(x, 15.f)); return 1.f - 2.f / (e + 1.f); }
#define LDS_WAIT() asm volatile("s_waitcnt lgkmcnt(0)" ::: "memory")
#define VM_WAIT() asm volatile("s_waitcnt vmcnt(0)" ::: "memory")

#define XB_TMO      128
#define XB_XCNT(j)  (256  + 64 * (j))
#define XB_XSUB(j)  (1280 + 64 * (j))
#define XB_XGEN(j)  (2304 + 64 * (j))
#define XB_TOP      3328
#define XB_TOPGEN   3392
#define XCD_BAR_WORDS 3456
#define XB_SPIN_CAP (1u << 18)
__device__ __forceinline__ unsigned xb_ld(unsigned* p)              { return __hip_atomic_load(p, __ATOMIC_RELAXED, __HIP_MEMORY_SCOPE_AGENT); }
__device__ __forceinline__ unsigned xb_add(unsigned* p, unsigned v) { return __hip_atomic_fetch_add(p, v, __ATOMIC_RELAXED, __HIP_MEMORY_SCOPE_AGENT); }
__device__ __forceinline__ unsigned xb_xcc_id() { return (unsigned)__builtin_amdgcn_s_getreg((3 << 11) | 20) & 0xFu; }
#define XB_SPIN(cond, bar) do { unsigned _sp = 0; while (cond) { __builtin_amdgcn_s_sleep(1); \
    if ((++_sp & 255u) == 0u) { if (xb_ld(&(bar)[XB_TMO])) break; if (_sp > XB_SPIN_CAP) { atomicAdd(&(bar)[XB_TMO], 1u); break; } } } } while (0)
struct XcdBarrier { unsigned* bar; unsigned x; volatile LAS unsigned* st; };
__device__ __forceinline__ XcdBarrier xcd_barrier_post(unsigned* bar, volatile LAS unsigned* st) {
    XcdBarrier b; b.bar = bar; b.x = xb_xcc_id(); b.st = st;
    if (threadIdx.x == 0) (void)xb_add(&bar[XB_XCNT(b.x)], 1u);
    return b;
}
__device__ __forceinline__ void xcd_barrier_complete(unsigned* bar, unsigned x, unsigned& nloc, unsigned& nx) {
    const unsigned G = gridDim.x * gridDim.y * gridDim.z;
    unsigned sum, cnt, mine, sp = 0u;
    for (;;) {
        sum = 0u; cnt = 0u; mine = 0u;
#pragma unroll
        for (unsigned j = 0; j < 16; ++j) { const unsigned c = xb_ld(&bar[XB_XCNT(j)]); sum += c; cnt += (c > 0u) ? 1u : 0u; mine = (j == x) ? c : mine; }
        if (sum == G) break;
        __builtin_amdgcn_s_sleep(1);
        if ((++sp & 255u) == 0u) { if (xb_ld(&bar[XB_TMO])) break; if (sp > XB_SPIN_CAP) { atomicAdd(&bar[XB_TMO], 1u); break; } }
    }
    nloc = mine > 0u ? mine : 1u; nx = cnt > 0u ? cnt : 1u;
}
__device__ __forceinline__ void xcd_barrier(const XcdBarrier& b) {
    asm volatile("s_waitcnt vmcnt(0)" ::: "memory");
    __syncthreads();
    if (threadIdx.x == 0) {
        unsigned* bar = b.bar;
        __builtin_amdgcn_s_waitcnt(0);
        unsigned nloc = b.st[0], nx = b.st[1];
        if (nloc == 0u) { xcd_barrier_complete(bar, b.x, nloc, nx); b.st[0] = nloc; b.st[1] = nx; }
        const unsigned old = xb_add(&bar[XB_XSUB(b.x)], 1u);
        const unsigned gen = old / nloc;
        if (old + 1u == (gen + 1u) * nloc) {
            __builtin_amdgcn_fence(__ATOMIC_RELEASE, "agent");
            asm volatile("s_waitcnt vmcnt(0)" ::: "memory");
            const unsigned og = xb_add(&bar[XB_TOP], 1u);
            const unsigned tg = og / nx;
            if (og + 1u == (tg + 1u) * nx) xb_add(&bar[XB_TOPGEN], 1u);
            else XB_SPIN(xb_ld(&bar[XB_TOPGEN]) == tg, bar);
            __builtin_amdgcn_fence(__ATOMIC_ACQUIRE, "agent");
            xb_add(&bar[XB_XGEN(b.x)], 1u);
            asm volatile("s_waitcnt vmcnt(0)" ::: "memory");
        } else {
            XB_SPIN(xb_ld(&bar[XB_XGEN(b.x)]) == gen, bar);
            __builtin_amdgcn_fence(__ATOMIC_ACQUIRE, "agent");
            asm volatile("s_waitcnt vmcnt(0)" ::: "memory");
        }
    }
    __syncthreads();
}

__device__ __forceinline__ int lane_asm() { int l; asm volatile("v_mbcnt_lo_u32_b32 %0, -1, 0\n\tv_mbcnt_hi_u32_b32 %0, -1, %0" : "=v"(l)); return l; }
namespace pg8 {
constexpr int BM = 256, BK = 64, HALF = 128, HTB = HALF * BK * 2, STAGE_BYTES = 8 * HTB, NXCD = 8, WGM = 8;
__host__ __device__ __forceinline__ int lds_byte(int r, int c) { const int st = (r >> 4) * 2 + (c >> 5), rr = r & 15, cc = c & 31, ob = rr * 64 + cc * 2; return st * 1024 + (ob ^ (((ob >> 9) & 1) << 5)); }
__host__ __device__ __forceinline__ void stage_rc(int b, int& R, int& C) { const int st = b / 1024, sb = b % 1024, swz = sb ^ (((sb >> 9) & 1) << 5); R = (st >> 1) * 16 + swz / 64; C = (st & 1) * 32 + (swz % 64) / 2; }
__host__ __device__ __forceinline__ int perm32(int rho) { const int n = rho >> 4, i = rho & 15; return 8 * (i >> 2) + 4 * n + (i & 3); }
struct Unit { int pm, pn; };
struct Gemm { const bf16_t* A; const bf16_t* Bt; int lda, ldb, K; };
struct StaticOrder {
    int nM, nN, nwg, G, c, pm0, pn0;
    __device__ void init(int nM_, int nN_, int G_, int c_, int pm0_ = 0, int pn0_ = 0) { nM = nM_; nN = nN_; nwg = nM * nN; G = G_; c = c_; pm0 = pm0_; pn0 = pn0_; }
    __device__ bool next(int i, Unit& u) const {
        const long L = (long)i * G + c; if (L >= nwg) return false;
        int wgid = (int)L; { const int q = nwg / NXCD, r = nwg % NXCD, xcd = wgid % NXCD, off = wgid / NXCD; wgid = (xcd < r ? xcd * (q + 1) : r * (q + 1) + (xcd - r) * q) + off; }
        const int nig = WGM * nN, gid = wgid / nig, fm = gid * WGM, gsz = (nM - fm) < WGM ? (nM - fm) : WGM;
        u.pm = pm0 + fm + ((wgid % nig) % gsz); u.pn = pn0 + (wgid % nig) / gsz; return true;
    }
};
typedef int i32x4v __attribute__((ext_vector_type(4)));
typedef int i32x8v __attribute__((ext_vector_type(8)));
__device__ __forceinline__ i32x8v cat8(bf16x8 a, bf16x8 b) { return __builtin_shufflevector(__builtin_bit_cast(i32x4v, a), __builtin_bit_cast(i32x4v, b), 0, 1, 2, 3, 4, 5, 6, 7); }
template <class Epi, class Sched, bool FP8 = false>
__device__ __forceinline__ void gemm_phase(LAS unsigned char* lds, const Gemm g, const Sched& S, const Epi& E, int tid_in) {
    constexpr bool ALIGN_EPI = true;
    const unsigned tid_u = (unsigned)tid_in; __builtin_assume(tid_u < 512u);
    const int tid = (int)tid_u, wid = __builtin_amdgcn_readfirstlane(tid >> 6), lane = tid & 63, wr = wid >> 2, wc = wid & 3, fr = lane & 15, fq = lane >> 4;
    const int K = g.K, nt = K / BK;
    unsigned voffA[2], voffB[2];
#pragma unroll
    for (int i = 0; i < 2; ++i) { int R, C; stage_rc(tid * 16 + i * 8192, R, C); const int Rb = Epi::PERM ? ((R & ~31) + perm32(R & 31)) : R;
        voffA[i] = (unsigned)(R * g.lda + C) * 2u; voffB[i] = (unsigned)(Rb * g.ldb + C) * 2u; }
    const unsigned kstep = (unsigned)(BK * 2);
    const unsigned hstepA = (unsigned)HALF * g.lda * 2u, hstepB = (unsigned)HALF * g.ldb * 2u;
    const unsigned tstepA = 2u * hstepA, tstepB = 2u * hstepB;
    const unsigned ldsw = (unsigned)wid * 1024u;
    const int aoff = lds_byte(wr * 64 + fr, fq * 8), boff = lds_byte(wc * 32 + fr, fq * 8);
    const __amdgpu_buffer_rsrc_t rsA = __builtin_amdgcn_make_buffer_rsrc((void*)g.A, 0, 0xFFFFFFFFu, 0x00020000);
    const __amdgpu_buffer_rsrc_t rsB = __builtin_amdgcn_make_buffer_rsrc((void*)g.Bt, 0, 0xFFFFFFFFu, 0x00020000);
#define PG8_SA(b, h) (((b) * 2 + (h)) * HTB)
#define PG8_SB(b, h) ((4 + (b) * 2 + (h)) * HTB)
#define PG8_STAGE(bufoff, rs, soff, voff) do { _Pragma("unroll") for (int _i = 0; _i < 2; ++_i) \
        __builtin_amdgcn_raw_ptr_buffer_load_lds(rs, (LAS unsigned*)(lds + (bufoff) + ldsw + _i * 8192), 16, (int)(voff)[_i], (int)(soff), 0, 0); } while (0)
#define PG8_LDA(dst, b, h) do { if constexpr (FP8) { _Pragma("unroll") for (int m = 0; m < 4; ++m) dst##8[m] = __builtin_shufflevector(*(const LAS i32x4v*)(lds + PG8_SA(b, h) + aoff + m * 2048), *(const LAS i32x4v*)(lds + PG8_SA(b, h) + aoff + m * 2048 + 1024), 0, 1, 2, 3, 4, 5, 6, 7); } \
    else { _Pragma("unroll") for (int m = 0; m < 4; ++m) _Pragma("unroll") for (int k = 0; k < 2; ++k) dst[m][k] = *(const LAS bf16x8*)(lds + PG8_SA(b, h) + aoff + m * 2048 + k * 1024); } } while (0)
#define PG8_LDB(dst, b, h) do { if constexpr (FP8) { _Pragma("unroll") for (int n = 0; n < 2; ++n) dst##8[n] = __builtin_shufflevector(*(const LAS i32x4v*)(lds + PG8_SB(b, h) + boff + n * 2048), *(const LAS i32x4v*)(lds + PG8_SB(b, h) + boff + n * 2048 + 1024), 0, 1, 2, 3, 4, 5, 6, 7); } \
    else { _Pragma("unroll") for (int n = 0; n < 2; ++n) _Pragma("unroll") for (int k = 0; k < 2; ++k) dst[n][k] = *(const LAS bf16x8*)(lds + PG8_SB(b, h) + boff + n * 2048 + k * 1024); } } while (0)
#define PG8_MMA(ai, bj, At, Bt) do { __builtin_amdgcn_s_setprio(1); if constexpr (FP8) { _Pragma("unroll") for (int m = 0; m < 4; ++m) _Pragma("unroll") for (int n = 0; n < 2; ++n) \
        asm volatile("v_mfma_scale_f32_16x16x128_f8f6f4 %0, %1, %2, %0, %3, %3 op_sel_hi:[0,0,0]" : "+v"(acc[ai][bj][m][n]) : "v"(Bt##8[n]), "v"(At##8[m]), "v"(sc1)); } else { \
        _Pragma("unroll") for (int m = 0; m < 4; ++m) _Pragma("unroll") for (int n = 0; n < 2; ++n) _Pragma("unroll") for (int k = 0; k < 2; ++k) \
        acc[ai][bj][m][n] = __builtin_amdgcn_mfma_f32_16x16x32_bf16(Bt[n][k], At[m][k], acc[ai][bj][m][n], 0, 0, 0); } __builtin_amdgcn_s_setprio(0); } while (0)
#define PG8_WAIT_V(n) asm volatile("s_waitcnt vmcnt(" #n ")" ::: "memory")
#define PG8_WAIT_L(n) asm volatile("s_waitcnt lgkmcnt(" #n ")" ::: "memory")
#define PG8_BAR __builtin_amdgcn_s_barrier()
#define PG8_SCHED __builtin_amdgcn_sched_barrier(0)
    Unit cur, nxt; int ui = 0;
    if (!S.next(0, cur)) return;
    f32x4 acc[2][2][4][2];
#pragma unroll
    for (int a = 0; a < 2; ++a)
#pragma unroll
        for (int b = 0; b < 2; ++b)
#pragma unroll
            for (int m = 0; m < 4; ++m)
#pragma unroll
                for (int n = 0; n < 2; ++n) acc[a][b][m][n] = (f32x4){0.f, 0.f, 0.f, 0.f};
    i32x8v At8[4], B08[2], B18[2]; bf16x8 At[4][2], B0[2][2], B1[2][2];
    const int sc1 = 0x7F7F7F7F;
    unsigned cA = (unsigned)cur.pm * tstepA, cB = (unsigned)cur.pn * tstepB;
    PG8_STAGE(PG8_SB(0, 0), rsB, cB, voffB); PG8_STAGE(PG8_SB(0, 1), rsB, cB + hstepB, voffB); PG8_STAGE(PG8_SA(0, 0), rsA, cA, voffA); PG8_STAGE(PG8_SA(0, 1), rsA, cA + hstepA, voffA);
    if (wr == 1) PG8_BAR;
    PG8_WAIT_V(2); PG8_BAR;
    PG8_STAGE(PG8_SB(1, 0), rsB, cB + kstep, voffB); PG8_STAGE(PG8_SA(1, 0), rsA, cA + kstep, voffA); PG8_STAGE(PG8_SB(1, 1), rsB, cB + hstepB + kstep, voffB);
    PG8_WAIT_V(6); PG8_BAR;
    for (;;) {
        const bool has_next = S.next(ui + 1, nxt);
        const unsigned nA = has_next ? (unsigned)nxt.pm * tstepA : cA; const unsigned nB = has_next ? (unsigned)nxt.pn * tstepB : cB;
        for (int t = 0; t < nt; t += 2) {
            const bool last = (t == nt - 2);
            const unsigned a1 = cA + (unsigned)(t + 1) * kstep;
            const unsigned a2 = last ? nA : cA + (unsigned)(t + 2) * kstep; const unsigned b2 = last ? nB : cB + (unsigned)(t + 2) * kstep;
            const unsigned a3 = a2 + kstep; const unsigned b3 = b2 + kstep;
            PG8_LDB(B0, 0, 0); PG8_LDB(B1, 0, 1); PG8_SCHED; PG8_LDA(At, 0, 0); PG8_STAGE(PG8_SA(1, 1), rsA, a1 + hstepA, voffA);
            PG8_WAIT_V(8); PG8_WAIT_L(0); PG8_BAR; PG8_MMA(0, 0, At, B0); PG8_MMA(0, 1, At, B1); PG8_BAR; PG8_SCHED;
            PG8_LDA(At, 0, 1); PG8_STAGE(PG8_SB(0, 0), rsB, b2, voffB); PG8_STAGE(PG8_SB(0, 1), rsB, b2 + hstepB, voffB); PG8_STAGE(PG8_SA(0, 0), rsA, a2, voffA);
            PG8_WAIT_V(8); PG8_WAIT_L(0); PG8_BAR; PG8_MMA(1, 0, At, B0); PG8_MMA(1, 1, At, B1); PG8_BAR; PG8_SCHED;
            PG8_LDB(B0, 1, 0); PG8_LDB(B1, 1, 1); PG8_SCHED; PG8_LDA(At, 1, 0); PG8_STAGE(PG8_SA(0, 1), rsA, a2 + hstepA, voffA);
            PG8_WAIT_V(8); PG8_WAIT_L(0); PG8_BAR; PG8_MMA(0, 0, At, B0); PG8_MMA(0, 1, At, B1); PG8_BAR; PG8_SCHED;
            PG8_LDA(At, 1, 1); PG8_STAGE(PG8_SB(1, 0), rsB, b3, voffB); PG8_STAGE(PG8_SB(1, 1), rsB, b3 + hstepB, voffB); PG8_STAGE(PG8_SA(1, 0), rsA, a3, voffA);
            PG8_WAIT_V(8); PG8_WAIT_L(0); PG8_BAR; PG8_MMA(1, 0, At, B0); PG8_MMA(1, 1, At, B1); PG8_BAR; PG8_SCHED;
        }
        if constexpr (FP8) asm volatile("s_nop 15\n\ts_nop 7" ::: "memory");
        if constexpr (ALIGN_EPI) { if (wr == 0) PG8_BAR; }
        bool keep_acc = false;
        { const int l2 = lane_asm() & 63; if constexpr (Epi::KEEPS) keep_acc = E(acc, cur, wr, wc, l2 & 15, l2 >> 4); else E(acc, cur, wr, wc, l2 & 15, l2 >> 4); }
        if (!has_next) break;
        if (!keep_acc) {
#pragma unroll
        for (int a = 0; a < 2; ++a)
#pragma unroll
            for (int b = 0; b < 2; ++b)
#pragma unroll
                for (int m = 0; m < 4; ++m)
#pragma unroll
                    for (int n = 0; n < 2; ++n) acc[a][b][m][n] = (f32x4){0.f, 0.f, 0.f, 0.f};
        }
        cur = nxt; cA = nA; cB = nB; ++ui;
        if constexpr (ALIGN_EPI) { if (wr == 1) PG8_BAR; }
    }
    PG8_WAIT_V(0);
    if constexpr (!ALIGN_EPI) { if (wr == 0) PG8_BAR; }
    PG8_BAR;
#undef PG8_SA
#undef PG8_SB
#undef PG8_STAGE
#undef PG8_LDA
#undef PG8_LDB
#undef PG8_MMA
#undef PG8_WAIT_V
#undef PG8_WAIT_L
#undef PG8_BAR
#undef PG8_SCHED
}
}

enum { I_X = 0, I_C, I_CTX, I_CCTX, I_WADA, I_BADA, I_WIN, I_QNORM, I_WQUP, I_KVNORM, I_WKVUP, I_SCONVW, I_SCONVB, I_SDTB, I_SALOG, I_SD, I_SNORM,
       I_HCONVW, I_HCONVB, I_HW1, I_HB1, I_HW2, I_HB2, I_HW3, I_HFREQ, I_HD, I_RMU, I_RW0, I_RWUP, I_RA0, I_RAUP, I_RGUP, I_RKK, I_RKA, I_RRK, I_RLNG, I_RLNB,
       I_WBR, I_WOUT, I_LN1G, I_LN1B, I_WROUTER, I_WGATE, I_WUP, I_WDOWN, I_LN2G, I_LN2B, N_INPUTS };
struct Args { const float* in[N_INPUTS]; float* out; unsigned char* ws; int ph_lo, ph_hi; };
static_assert(sizeof(Args) == (N_INPUTS + 2) * 8 + 8, "Args has no padding");

__device__ __forceinline__ const float* arg_in(const Args& a, int i) { asm volatile("" : "+s"(i)); return a.in[i]; }
__device__ __forceinline__ int opqs(int v) { asm volatile("" : "+s"(v)); return v; }
__device__ __forceinline__ int opqv(int v) { asm volatile("" : "+v"(v)); return v; }
__device__ __forceinline__ unsigned char* opq(unsigned char* p) { asm volatile("" : "+s"(p)); return p; }
struct Frame {
    LAS unsigned char* lds;
    int tid, lane, wave, G, bid, gw, NGW;
    unsigned char* ws;
};
#define WSP(T_, off) ((T_*)(F.ws + (off)))

struct RmId { __device__ int operator()(int n) const { return n; } };
struct RmShift { int sh; __device__ int operator()(int n) const { return n + sh; } };
struct RmGateUp { int up; __device__ int operator()(int n) const { return 256 * (n >> 7) + (n & 127) + (up ? 128 : 0); } };
constexpr int TR_SCR = 64 * 65 * 4;
__device__ __forceinline__ void tr_load(const float* W, int ldw, int k0, int n0, const float* kscale, float sc, LAS float* scr, int lane) {
    float v[64];
    const float* wp = W + (size_t)k0 * ldw + n0 + lane;
#pragma unroll
    for (int i = 0; i < 64; ++i) v[i] = wp[(size_t)i * ldw];
#pragma unroll
    for (int i = 0; i < 64; ++i) { float x = v[i] * sc; if (kscale) x *= kscale[k0 + i]; scr[i * 65 + lane] = x; }
    LDS_WAIT(); asm volatile("" ::: "memory");
}
template <class RowMap>
__device__ __forceinline__ void transpose_item(const float* W, int ldw, bf16_t* WT, int ldt, int k0, int n0, const float* kscale, RowMap rm, LAS float* scr, int lane) {
    tr_load(W, ldw, k0, n0, kscale, 1.f, scr, lane);
    const int c = lane & 7;
#pragma unroll
    for (int j = 0; j < 8; ++j) { const int n = (lane >> 3) + 8 * j; const LAS float* s = scr + (8 * c) * 65 + n;
        u32x4 o; o.x = pk2(s[0 * 65], s[1 * 65]); o.y = pk2(s[2 * 65], s[3 * 65]); o.z = pk2(s[4 * 65], s[5 * 65]); o.w = pk2(s[6 * 65], s[7 * 65]);
        *(u32x4*)(WT + (size_t)rm(n0 + n) * ldt + k0 + 8 * c) = o; }
    LDS_WAIT(); asm volatile("" ::: "memory");
}
template <class RowMap>
__device__ __forceinline__ void transpose_item_fp8(const float* W, int ldw, unsigned char* WT, int ldt, int k0, int n0, float sc, RowMap rm, LAS float* scr, int lane, const float* kscale = nullptr) {
    tr_load(W, ldw, k0, n0, kscale, sc, scr, lane);
    const int c = lane & 3;
#pragma unroll
    for (int j = 0; j < 4; ++j) { const int n = (lane >> 2) + 16 * j; const LAS float* s = scr + (16 * c) * 65 + n;
        u32x4 o; o.x = pk4fp8(s[0 * 65], s[1 * 65], s[2 * 65], s[3 * 65]); o.y = pk4fp8(s[4 * 65], s[5 * 65], s[6 * 65], s[7 * 65]);
        o.z = pk4fp8(s[8 * 65], s[9 * 65], s[10 * 65], s[11 * 65]); o.w = pk4fp8(s[12 * 65], s[13 * 65], s[14 * 65], s[15 * 65]);
        *(u32x4*)(WT + (size_t)rm(n0 + n) * ldt + k0 + 16 * c) = o; }
    LDS_WAIT(); asm volatile("" ::: "memory");
}

__device__ __forceinline__ void p0_weights(Frame& F, const Args& a) {
    LAS float* scr = (LAS float*)(F.lds + F.wave * TR_SCR);
    constexpr int IT_IN = 32 * 288, IT_BR = 16 * 32, IT_OUT = 32 * 32, IT_Q = 8 * 24, IT_KV = 8 * 32;
    constexpr int PER_L = IT_IN + 4 * IT_BR + IT_OUT + IT_Q + IT_KV;
    for (int it = F.gw; it < DEPTH * PER_L; it += F.NGW) {
        const int l = it / PER_L; int r = it % PER_L;
        if (r < IT_IN) { const int kb = r / 288, nb = r % 288;
            if (nb * 64 < NNG) { const int tile = nb >> 2;
                if (tile >= 14 && tile < 27) transpose_item(arg_in(a, I_WIN) + (size_t)l * DM * NIN, NIN, WSP(bf16_t, WS_WIN + l * SZ_WIN), DM, kb * 64, nb * 64, nullptr, RmId(), scr, F.lane);
                else { RmShift rs; rs.sh = tile < 14 ? 0 : -13 * 256; transpose_item_fp8(arg_in(a, I_WIN) + (size_t)l * DM * NIN, NIN, WSP(unsigned char, WS_WIN + l * SZ_WIN + WIN8P_OFF), DM, kb * 64, nb * 64, 64.f, rs, scr, F.lane); } }
            else transpose_item_fp8(arg_in(a, I_WIN) + (size_t)l * DM * NIN + NNG, NIN, WSP(unsigned char, WS_WIN + l * SZ_WIN) + (size_t)NNG * DM * 2, DM, kb * 64, nb * 64 - NNG, 64.f, RmId(), scr, F.lane);
            continue; } r -= IT_IN;
        if (r < 4 * IT_BR) { const int br = r / IT_BR, q = r % IT_BR, kb = q / 32, nb = q % 32;
            if (br == 2) transpose_item(arg_in(a, I_WBR) + ((size_t)l * 4 + br) * 1024 * DM, DM, WSP(bf16_t, WS_WBR + l * SZ_WBR) + (size_t)br * DM * 1024, 1024, kb * 64, nb * 64, nullptr, RmId(), scr, F.lane);
            else { const int sub = br == 3 ? 2 : br; transpose_item_fp8(arg_in(a, I_WBR) + ((size_t)l * 4 + br) * 1024 * DM, DM, WSP(unsigned char, WS_WBR + l * SZ_WBR) + (size_t)sub * DM * 1024, 1024, kb * 64, nb * 64, 32.f, RmId(), scr, F.lane); }
            continue; } r -= 4 * IT_BR;
        if (r < IT_OUT) { const int kb = r / 32, nb = r % 32;
            transpose_item(arg_in(a, I_WOUT) + (size_t)l * DM * DM, DM, WSP(bf16_t, WS_WOUT + l * SZ_WOUT), DM, kb * 64, nb * 64, nullptr, RmId(), scr, F.lane); continue; } r -= IT_OUT;
        if (r < IT_Q) { const int kb = r / 24, nb = r % 24;
            transpose_item_fp8(arg_in(a, I_WQUP) + (size_t)l * 512 * 1536, 1536, WSP(unsigned char, WS_WQ + l * SZ_WQ), 512, kb * 64, nb * 64, 16.f, RmId(), scr, F.lane, arg_in(a, I_QNORM) + l * 512); continue; } r -= IT_Q;
        { const int kb = r / 32, nb = r % 32;
            transpose_item_fp8(arg_in(a, I_WKVUP) + (size_t)l * 512 * 2048, 2048, WSP(unsigned char, WS_WKV + l * SZ_WKV), 512, kb * 64, nb * 64, 16.f, RmId(), scr, F.lane, arg_in(a, I_KVNORM) + l * 512); }
    }
    for (size_t e4 = (size_t)F.bid * NTHREADS + F.tid; e4 < (size_t)DEPTH * 5120 * 128; e4 += (size_t)F.G * NTHREADS) {
        const int l = (int)(e4 / (5120 * 128)); const int rem = (int)(e4 % (5120 * 128)); const int n = rem / 128, kc0 = (rem % 128) * 4; const int blk = n >> 10, c = n & 1023;
        float v[4];
#pragma unroll
        for (int q = 0; q < 4; ++q) { const int kc = kc0 + q; float x = 0.f;
            if (blk < 2) { if (kc >= 64 * blk && kc < 64 * blk + 64) x = arg_in(a, I_RWUP)[(((size_t)l * 2 + blk) * 64 + (kc - 64 * blk)) * 1024 + c]; }
            else if (blk < 4) { const int d = blk - 2; if (kc >= 128 + 64 * d && kc < 192 + 64 * d) x = arg_in(a, I_RAUP)[(((size_t)l * 2 + d) * 64 + (kc - 128 - 64 * d)) * 1024 + c]; }
            else { if (kc >= 256 && kc < 416) x = arg_in(a, I_RGUP)[((size_t)l * 160 + (kc - 256)) * 1024 + c]; }
            v[q] = x * 8.f; }
        WSP(unsigned, WS_WLORA + l * SZ_WLORA)[(size_t)n * 128 + kc0 / 4] = pk4fp8(v[0], v[1], v[2], v[3]);
    }
}
constexpr int EFFP = 1536;
constexpr size_t SZ_WGU8 = (size_t)NEXP * 2816 * DM, SZ_WD8 = (size_t)NEXP * DM * EFFP;
__device__ __forceinline__ void conv_experts(Frame& F, const Args& a, int l) {
    LAS float* scr = (LAS float*)(F.lds + F.wave * TR_SCR);
    constexpr int IT_G = 32 * 22, IT_D = 22 * 32, PER_E = 2 * IT_G + IT_D;
    unsigned char* wgu = WSP(unsigned char, WS_WE); unsigned char* wd = WSP(unsigned char, WS_WE + SZ_WGU8);
    for (int it = F.gw; it < NEXP * PER_E; it += F.NGW) {
        const int e = it / PER_E; int r = it % PER_E;
        if (r < 2 * IT_G) { const int up = r / IT_G, q = r % IT_G, kb = q / 22, nb = q % 22;
            const float* src = arg_in(a, up ? I_WUP : I_WGATE) + ((size_t)l * NEXP + e) * DM * EFF;
            RmGateUp rm; rm.up = up;
            transpose_item_fp8(src, EFF, wgu + (size_t)e * 2816 * DM, DM, kb * 64, nb * 64, 64.f, rm, scr, F.lane); continue; } r -= 2 * IT_G;
        { const int kb = r / 32, nb = r % 32;
            transpose_item_fp8(arg_in(a, I_WDOWN) + ((size_t)l * NEXP + e) * EFF * DM, DM, wd + (size_t)e * DM * EFFP, EFFP, kb * 64, nb * 64, 64.f, RmId(), scr, F.lane); }
    }
    for (int i = F.bid * NTHREADS + F.tid; i < NEXP * DM * 8; i += F.G * NTHREADS) { const int rowi = i >> 3, q = i & 7; unsigned zz = 0u; asm volatile("" : "+v"(zz));
        *(u32x4*)(wd + (size_t)rowi * EFFP + EFF + q * 16) = (u32x4){zz, zz, zz, zz}; }
}
__device__ __forceinline__ void p0_mod(Frame& F, const Args& a) {
    LAS float* sv = (LAS float*)(F.lds + 69632);
    for (int i = F.tid; i < 3 * DM; i += NTHREADS) { const int v = i / DM, k = i % DM; const float x = v < 2 ? arg_in(a, I_C)[v * DM + k] : arg_in(a, I_CCTX)[k]; sv[i] = siluf_(x); }
    __syncthreads();
    float* mod = (float*)(F.ws + WS_CTL) + CW_MOD;
    LAS float* red = (LAS float*)(F.lds + 69632 + 3 * DM * 4);
    for (int u = F.bid; u < DEPTH * (6 * DM / 128); u += F.G) {
        const int l = u / (6 * DM / 128), nb = u % (6 * DM / 128); const int kg = F.tid >> 7, cl = F.tid & 127, n = nb * 128 + cl;
        const float* w = arg_in(a, I_WADA) + ((size_t)l * DM + kg * 512) * (6 * DM) + n;
        float a0 = 0.f, a1 = 0.f, a2 = 0.f;
#pragma unroll 32
        for (int k = 0; k < 512; ++k) { const float wv = w[(size_t)k * (6 * DM)]; const int kk = kg * 512 + k; a0 += sv[kk] * wv; a1 += sv[DM + kk] * wv; a2 += sv[2 * DM + kk] * wv; }
        __syncthreads();
        red[(kg * 3 + 0) * 128 + cl] = a0; red[(kg * 3 + 1) * 128 + cl] = a1; red[(kg * 3 + 2) * 128 + cl] = a2;
        __syncthreads();
        if (F.tid < 384) { const int v = F.tid >> 7; const float b = arg_in(a, I_BADA)[l * 6 * DM + n];
            mod[(l * 3 + v) * 6 * DM + n] = b + ((red[(0 * 3 + v) * 128 + cl] + red[(1 * 3 + v) * 128 + cl]) + (red[(2 * 3 + v) * 128 + cl] + red[(3 * 3 + v) * 128 + cl])); }
    }
}

__device__ __forceinline__ void row_stats(const f32x4 (&v)[8], float& mean, float& rstd, float eps) {
    float s = 0.f;
#pragma unroll
    for (int j = 0; j < 8; ++j) s += (v[j].x + v[j].y) + (v[j].z + v[j].w);
    mean = wave_sum(s) * (1.f / DM);
    float s2 = 0.f;
#pragma unroll
    for (int j = 0; j < 8; ++j) { const f32x4 d = v[j] - mean; s2 += (d.x * d.x + d.y * d.y) + (d.z * d.z + d.w * d.w); }
    rstd = 1.f / sqrtf(wave_sum(s2) * (1.f / DM) + eps);
}
__device__ __forceinline__ const float* x_src_row(const Args& a, const Frame& F, int layer, int row) {
    if (layer == 0) return row < TC ? arg_in(a, I_CTX) + (size_t)row * DM : arg_in(a, I_X) + (size_t)(row - TC) * DM;
    return (const float*)(F.ws + WS_XS) + (size_t)row * DM;
}
__device__ __forceinline__ void phase_modln(Frame& F, const Args& a, int layer) {
    const float* mod = (const float*)(F.ws + WS_CTL) + CW_MOD + (size_t)layer * 3 * 6 * DM;
    bf16_t* H = WSP(bf16_t, WS_H); unsigned* H8 = WSP(unsigned, WS_H8);
    for (int row = F.gw; row < T; row += F.NGW) {
        const f32x4* xr = (const f32x4*)x_src_row(a, F, layer, row) + F.lane;
        f32x4 v[8];
#pragma unroll
        for (int j = 0; j < 8; ++j) v[j] = xr[64 * j];
        float mean, rstd; row_stats(v, mean, rstd, 1e-6f);
        const float* m = mod + (size_t)row_modidx(row) * 6 * DM;
        u32x2* o = (u32x2*)(H + (size_t)row * DM) + F.lane; unsigned* o8 = H8 + (size_t)row * (DM / 4) + F.lane;
#pragma unroll
        for (int j = 0; j < 8; ++j) { const int c = 4 * (64 * j + F.lane); const f32x4 sh = *(const f32x4*)(m + c), sc = *(const f32x4*)(m + DM + c);
            const f32x4 y = (v[j] - mean) * rstd * (sc + 1.f) + sh; u32x2 w; w.x = pk2(y.x, y.y); w.y = pk2(y.z, y.w); o[64 * j] = w; o8[64 * j] = pk4fp8(y.x, y.y, y.z, y.w); }
    }
}

__device__ __forceinline__ void phase_hdn(Frame& F, const Args& a, int layer) {
    LAS float* zs = (LAS float*)(F.lds + F.wave * 512);
    const float* w1 = arg_in(a, I_HW1) + (size_t)layer * 33 * 64; const float* b1 = arg_in(a, I_HB1) + layer * 64;
    const float* w2 = arg_in(a, I_HW2) + (size_t)layer * 64 * 64; const float* b2 = arg_in(a, I_HB2) + layer * 64;
    const float fr = arg_in(a, I_HFREQ)[layer * 64 + F.lane];
    float* HDN = WSP(float, WS_HDN + layer * SZ_HDN1);
    for (int r = F.gw; r < SEQ + CTX; r += F.NGW) {
        const int n = r < SEQ ? SEQ : CTX, t = r < SEQ ? r : r - SEQ;
        const float wpos = (6.283185307179586f * (float)t) / (float)n;
        if (F.lane < 33) { float z;
            if (F.lane == 0) z = (float)t / (float)(n - 1);
            else { const int b = (F.lane - 1) & 15; const float f = 1e-4f + (float)b * ((15.f - 1e-4f) / 15.f); const float ang = f * wpos; z = F.lane <= 16 ? __cosf(ang) : -__sinf(ang); }
            zs[F.lane] = z; }
        LDS_WAIT(); asm volatile("" ::: "memory");
        float p = b1[F.lane];
#pragma unroll
        for (int i = 0; i < 33; ++i) p += zs[i] * w1[i * 64 + F.lane];
        const float h1 = __sinf(fr * p);
        zs[64 + F.lane] = h1;
        LDS_WAIT(); asm volatile("" ::: "memory");
        float q = b2[F.lane];
#pragma unroll 16
        for (int i = 0; i < 64; ++i) q += zs[64 + i] * w2[i * 64 + F.lane];
        HDN[(size_t)r * 64 + F.lane] = __sinf(fr * q);
        LDS_WAIT(); asm volatile("" ::: "memory");
    }
}
__device__ __forceinline__ float hy_delta(int c) { const float mn = -3.0701134573253943f, mx = -15.350567286626972f; return fabsf(mn + (float)c * ((mx - mn) / 1023.f)); }
__device__ __forceinline__ void phase_filt(Frame& F, const Args& a, int layer) {
    const float* w3 = arg_in(a, I_HW3) + (size_t)layer * 64 * 2048; const float* HDN = WSP(float, WS_HDN + layer * SZ_HDN1);
    LAS float* ws3 = (LAS float*)F.lds;
    bf16_t* FILT = WSP(bf16_t, WS_FILT);
    for (int u = F.bid; u < 32 * 16; u += F.G) {
        const int cb = u / 16, tb = u % 16, col0 = cb * 64, t = tb * 512 + F.tid;
        __syncthreads();
        for (int i = F.tid; i < 4096; i += NTHREADS) { const int j = i >> 6, cc = i & 63; ws3[cc * 64 + j] = w3[(size_t)j * 2048 + col0 + cc]; }
        __syncthreads();
        f32x4 h[16];
#pragma unroll
        for (int i = 0; i < 16; ++i) h[i] = *(const f32x4*)(HDN + (size_t)t * 64 + 4 * i);
        const float tn = (float)t / (float)(SEQ - 1);
        for (int cc = 0; cc < 64; ++cc) {
            float acc = 0.f;
#pragma unroll
            for (int i = 0; i < 16; ++i) { const f32x4 w = *(const LAS f32x4*)(ws3 + cc * 64 + 4 * i); acc += h[i].x * w.x + h[i].y * w.y + h[i].z * w.z + h[i].w * w.w; }
            const int col = col0 + cc, side = col >> 10, c = col & 1023;
            FILT[((size_t)c * 2 + side) * SEQ + t] = (bf16_t)f2bf(acc * __expf(-tn * hy_delta(c)));
        }
    }
    float* FILTC = WSP(float, WS_FILTC);
    for (int e = F.bid * NTHREADS + F.tid; e < CTX * 2048; e += F.G * NTHREADS) {
        const int lag = e >> 11, col = e & 2047, c = col & 1023; const float* hr = HDN + (size_t)(SEQ + lag) * 64; float acc = 0.f;
#pragma unroll 16
        for (int j = 0; j < 64; ++j) acc += hr[j] * w3[(size_t)j * 2048 + col];
        FILTC[e] = acc * __expf(-((float)lag / (float)(CTX - 1)) * hy_delta(c));
    }
}

__device__ __forceinline__ void ld8bf(const bf16_t* p, float (&o)[8]) { const u32x4 w = *(const u32x4*)p; o[0] = bflo(w.x); o[1] = bfhi(w.x); o[2] = bflo(w.y); o[3] = bfhi(w.y); o[4] = bflo(w.z); o[5] = bfhi(w.z); o[6] = bflo(w.w); o[7] = bfhi(w.w); }
__device__ __forceinline__ void up8(const u32x4 w, float (&o)[8]) { o[0] = bflo(w.x); o[1] = bfhi(w.x); o[2] = bflo(w.y); o[3] = bfhi(w.y); o[4] = bflo(w.z); o[5] = bfhi(w.z); o[6] = bflo(w.w); o[7] = bfhi(w.w); }
__device__ __forceinline__ void st8bf(bf16_t* p, const float (&v)[8]) { u32x4 w; w.x = pk2(v[0], v[1]); w.y = pk2(v[2], v[3]); w.z = pk2(v[4], v[5]); w.w = pk2(v[6], v[7]); *(u32x4*)p = w; }
__device__ __forceinline__ void ld8f(const float* p, float (&o)[8]) { const f32x4 a = *(const f32x4*)p, b = *(const f32x4*)(p + 4); o[0] = a.x; o[1] = a.y; o[2] = a.z; o[3] = a.w; o[4] = b.x; o[5] = b.y; o[6] = b.z; o[7] = b.w; }

constexpr int PREP_RUN = 16;
__device__ __forceinline__ void phase_prep(Frame& F, const Args& a, int layer) {
    const bf16_t* P = WSP(bf16_t, WS_P); bf16_t* P2 = WSP(bf16_t, WS_P2);
    float* RS = WSP(float, WS_RS); bf16_t* KPE = WSP(bf16_t, WS_KPE); float* DT = WSP(float, WS_DT);
    bf16_t* KK = WSP(bf16_t, WS_KK); unsigned char* AL_ = WSP(unsigned char, WS_ALORA); float* VC = WSP(float, WS_VC); unsigned char* CQ8 = WSP(unsigned char, WS_CQ8);
    const float* scw = arg_in(a, I_SCONVW) + (size_t)layer * 3 * 1536; const float* scb = arg_in(a, I_SCONVB) + layer * 1536; const float* dtb = arg_in(a, I_SDTB) + layer * 32;
    const float* hcw = arg_in(a, I_HCONVW) + (size_t)layer * 3 * 3072; const float* hcb = arg_in(a, I_HCONVB) + layer * 3072;
    const float* mu = arg_in(a, I_RMU) + (size_t)layer * 2 * 3488; const float* rkk = arg_in(a, I_RKK) + layer * 1024;
    const int lane = F.lane;
    for (int item = F.gw; item < (T / PREP_RUN) * 13; item += F.NGW) {
        const int run = item / 13, ct = item % 13; const int r0 = run * PREP_RUN;
        if (ct == 0) {
#pragma unroll 1
        for (int rr = 0; rr < PREP_RUN; ++rr) { const int row = r0 + rr; const bf16_t* pr = P + (size_t)row * NNG;
            float x[8]; ld8bf(pr + P_CQ + lane * 8, x); float s = 0.f;
            *(u32x2*)(CQ8 + (size_t)row * 1024 + lane * 8) = (u32x2){pk4fp8(x[0], x[1], x[2], x[3]), pk4fp8(x[4], x[5], x[6], x[7])};
#pragma unroll
            for (int i = 0; i < 8; ++i) s += x[i] * x[i];
            s = wave_sum(s); const float rq = 1.f / sqrtf(s * (1.f / 512.f) + 1e-6f);
            ld8bf(pr + P_CKV + lane * 8, x); s = 0.f;
            *(u32x2*)(CQ8 + (size_t)row * 1024 + 512 + lane * 8) = (u32x2){pk4fp8(x[0], x[1], x[2], x[3]), pk4fp8(x[4], x[5], x[6], x[7])};
#pragma unroll
            for (int i = 0; i < 8; ++i) s += x[i] * x[i];
            s = wave_sum(s); const float rk = 1.f / sqrtf(s * (1.f / 512.f) + 1e-6f);
            if (lane == 0) { RS[row * 2] = rq; RS[row * 2 + 1] = rk; }
            float kv = bf2f(pr[P_KPE + lane]);
            const float other = swz16(kv);
            if (row >= TC) { const int t = (row - TC) & (SEQ - 1); const int axis = lane >> 5, half = (lane >> 4) & 1, j = lane & 15;
                const float pos = (float)(axis == 0 ? (t >> 6) : (t & 63)); const float inv = __builtin_amdgcn_exp2f(-(float)j * 0.8304820237218406f);
                const float sn = __sinf(pos * inv), cs = __cosf(pos * inv);
                kv = half == 0 ? kv * cs - other * sn : kv * cs + other * sn; }
            KPE[(size_t)row * 64 + lane] = (bf16_t)f2bf(kv);
            if (lane < 32) DT[(size_t)row * 32 + lane] = softplusf_(bf2f(pr[P_DT + lane]) + dtb[lane]); }
        continue; }
        const bool first = row_first(r0), last = row_last(r0 + PREP_RUN - 1);
        if (ct >= 1 && ct <= 3) { const int ch = ct - 1; const int c = ch * 512 + lane * 8; float xm[8], x0[8], xp[8], w0[8], w1[8], w2[8], bb[8];
            ld8f(scw + c, w0); ld8f(scw + 1536 + c, w1); ld8f(scw + 3072 + c, w2); ld8f(scb + c, bb);
            const bf16_t* pc = P + (size_t)r0 * NNG + P_XBC + c;
            u32x4 raw[PREP_RUN + 2];
#pragma unroll
            for (int rr = 0; rr < PREP_RUN + 2; ++rr) { const bool ok = (rr > 0 || !first) && (rr < PREP_RUN + 1 || !last); raw[rr] = ok ? *(const u32x4*)(pc + (ptrdiff_t)(rr - 1) * NNG) : (u32x4){0u, 0u, 0u, 0u}; }
            up8(raw[0], xm); up8(raw[1], x0);
#pragma unroll
            for (int rr = 0; rr < PREP_RUN; ++rr) {
                up8(raw[rr + 2], xp);
                float o[8];
#pragma unroll
                for (int i = 0; i < 8; ++i) { o[i] = siluf_(xm[i] * w0[i] + x0[i] * w1[i] + xp[i] * w2[i] + bb[i]); xm[i] = x0[i]; x0[i] = xp[i]; }
                st8bf(P2 + (size_t)(r0 + rr) * P2W + P2_XBC + c, o); } continue; }
        if (ct >= 4 && ct <= 5) { const int ch = ct - 4; { const int c = ch * 512 + lane * 8; float xm[8], x0[8], xp[8], w0[8], w1[8], w2[8], bb[8];
            ld8f(hcw + c, w0); ld8f(hcw + 3072 + c, w1); ld8f(hcw + 6144 + c, w2); ld8f(hcb + c, bb);
            const bf16_t* pc = P + (size_t)r0 * NNG + P_HY + c;
            u32x4 raw[PREP_RUN + 2];
#pragma unroll
            for (int rr = 0; rr < PREP_RUN + 2; ++rr) { const bool ok = (rr > 0 || !first) && (rr < PREP_RUN + 1 || !last); raw[rr] = ok ? *(const u32x4*)(pc + (ptrdiff_t)(rr - 1) * NNG) : (u32x4){0u, 0u, 0u, 0u}; }
            up8(raw[0], xm); up8(raw[1], x0);
#pragma unroll
            for (int rr = 0; rr < PREP_RUN; ++rr) {
                up8(raw[rr + 2], xp);
                float o[8];
#pragma unroll
                for (int i = 0; i < 8; ++i) { o[i] = xm[i] * w0[i] + x0[i] * w1[i] + xp[i] * w2[i] + bb[i]; xm[i] = x0[i]; x0[i] = xp[i]; }
                st8bf(P2 + (size_t)(r0 + rr) * P2W + P2_X0 + c, o); } }
        if (r0 < TC) {
#pragma unroll 1
                for (int rr = 0; rr < PREP_RUN; ++rr) { const int row = r0 + rr; const bool f1 = row_first(row), l1 = row_last(row); const int c = ch * 512 + lane * 8;
                    const bf16_t* pr = P + (size_t)row * NNG; float o1[8], o2[8];
#pragma unroll
                    for (int part = 1; part < 3; ++part) { float x0[8], xm[8], xp[8], w0[8], w1[8], w2[8], bb[8]; const int cc = part * 1024 + c;
                        ld8bf(pr + P_HY + cc, x0);
                        if (!f1) ld8bf(pr - NNG + P_HY + cc, xm); else { for (int i = 0; i < 8; ++i) xm[i] = 0.f; }
                        if (!l1) ld8bf(pr + NNG + P_HY + cc, xp); else { for (int i = 0; i < 8; ++i) xp[i] = 0.f; }
                        ld8f(hcw + cc, w0); ld8f(hcw + 3072 + cc, w1); ld8f(hcw + 6144 + cc, w2); ld8f(hcb + cc, bb);
#pragma unroll
                        for (int i = 0; i < 8; ++i) { const float r = xm[i] * w0[i] + x0[i] * w1[i] + xp[i] * w2[i] + bb[i]; if (part == 1) o1[i] = r; else o2[i] = r; } }
                    float* vc = VC + (size_t)row * 1024 + c;
                    *(f32x4*)vc = (f32x4){o1[0] * o2[0], o1[1] * o2[1], o1[2] * o2[2], o1[3] * o2[3]};
                    *(f32x4*)(vc + 4) = (f32x4){o1[4] * o2[4], o1[5] * o2[5], o1[6] * o2[6], o1[7] * o2[7]}; } }
        continue; }
        { const int ch = ct - 6; const int c = ch * 512 + lane * 8;
            if (c < 3488) { float um[8], u0[8], up[8], m0[8], m1[8], g8[8];
                ld8f(mu + c, m0); ld8f(mu + 3488 + c, m1);
                if (ch == 2 || ch == 3) ld8f(rkk + (c - 1024), g8);
                const bf16_t* pc = P + (size_t)r0 * NNG + P_RW + c;
                u32x4 raw[PREP_RUN + 2];
#pragma unroll
                for (int rr = 0; rr < PREP_RUN + 2; ++rr) { const bool ok = (rr > 0 || !first) && (rr < PREP_RUN + 1 || !last); raw[rr] = ok ? *(const u32x4*)(pc + (ptrdiff_t)(rr - 1) * NNG) : (u32x4){0u, 0u, 0u, 0u}; }
                up8(raw[0], um); up8(raw[1], u0);
#pragma unroll
                for (int rr = 0; rr < PREP_RUN; ++rr) { const int row = r0 + rr;
                    up8(raw[rr + 2], up);
                    float us[8];
#pragma unroll
                    for (int i = 0; i < 8; ++i) { us[i] = u0[i] + m0[i] * (um[i] - u0[i]) + m1[i] * (up[i] - u0[i]); um[i] = u0[i]; u0[i] = up[i]; }
                    if (ch < 6) st8bf(P2 + (size_t)row * P2W + P2_RKV + c, us);
                    if (ch == 2 || ch == 3) { float kx[8]; float s = 0.f;
#pragma unroll
                        for (int i = 0; i < 8; ++i) { kx[i] = us[i] * g8[i]; s += kx[i] * kx[i]; }
                        s = sum8(s);
                        const float inv = 1.f / fmaxf(sqrtf(s), 1e-12f);
#pragma unroll
                        for (int i = 0; i < 8; ++i) kx[i] *= inv;
                        st8bf(KK + (size_t)row * 1024 + (c - 1024), kx); }
                    if (ch == 6) { const int cl = c - 3072; float o[8];
#pragma unroll
                        for (int i = 0; i < 8; ++i) o[i] = cl < 128 ? tanhf_(us[i]) : cl < 256 ? us[i] : sigmoidf_(us[i]);
                        *(u32x2*)(AL_ + (size_t)row * 512 + cl) = (u32x2){pk4fp8(o[0], o[1], o[2], o[3]), pk4fp8(o[4], o[5], o[6], o[7])}; } } }
            else if (ch == 6) { const int cl = c - 3072;
                for (int rr = 0; rr < PREP_RUN; ++rr) { float zz = 0.f; asm volatile("" : "+v"(zz)); *(u32x2*)(AL_ + (size_t)(r0 + rr) * 512 + cl) = (u32x2){__builtin_bit_cast(unsigned, zz), __builtin_bit_cast(unsigned, zz)}; } } }
    }
    float* VT = WSP(float, WS_VT);
    LAS float* tl = (LAS float*)F.lds;
    for (int u = F.bid; u < (TL / 64) * 4; u += F.G) {
        const int tb = u >> 2, cb = u & 3; const int row0 = TC + tb * 64; const int c8 = (F.tid & 31) * 8, c = cb * 256 + c8, tq = F.tid >> 5;
        float w1[3][8], w2[3][8], b1[8], b2[8];
#pragma unroll
        for (int k = 0; k < 3; ++k) { ld8f(hcw + k * 3072 + 1024 + c, w1[k]); ld8f(hcw + k * 3072 + 2048 + c, w2[k]); }
        ld8f(hcb + 1024 + c, b1); ld8f(hcb + 2048 + c, b2);
        __syncthreads();
#pragma unroll 1
        for (int i = 0; i < 4; ++i) { const int tl_ = tq * 4 + i, row = row0 + tl_; const bf16_t* pr = P + (size_t)row * NNG + P_HY;
            const bool first = row_first(row), last = row_last(row);
            float a1[8], a2[8], x[8];
            ld8bf(pr + 1024 + c, x);
#pragma unroll
            for (int j = 0; j < 8; ++j) a1[j] = x[j] * w1[1][j] + b1[j];
            ld8bf(pr + 2048 + c, x);
#pragma unroll
            for (int j = 0; j < 8; ++j) a2[j] = x[j] * w2[1][j] + b2[j];
            if (!first) { ld8bf(pr - NNG + 1024 + c, x);
#pragma unroll
                for (int j = 0; j < 8; ++j) a1[j] += x[j] * w1[0][j];
                ld8bf(pr - NNG + 2048 + c, x);
#pragma unroll
                for (int j = 0; j < 8; ++j) a2[j] += x[j] * w2[0][j]; }
            if (!last) { ld8bf(pr + NNG + 1024 + c, x);
#pragma unroll
                for (int j = 0; j < 8; ++j) a1[j] += x[j] * w1[2][j];
                ld8bf(pr + NNG + 2048 + c, x);
#pragma unroll
                for (int j = 0; j < 8; ++j) a2[j] += x[j] * w2[2][j]; }
#pragma unroll
            for (int j = 0; j < 8; ++j) tl[(c8 + j) * 65 + tl_] = a1[j] * a2[j]; }
        __syncthreads();
        const int b = (row0 - TC) >> 13, t0 = (row0 - TC) & (SEQ - 1);
        for (int p_ = 0; p_ < 8; ++p_) { const int cl = p_ * 32 + (F.tid >> 4), q = F.tid & 15;
            const f32x4 o = {tl[cl * 65 + 4 * q], tl[cl * 65 + 4 * q + 1], tl[cl * 65 + 4 * q + 2], tl[cl * 65 + 4 * q + 3]};
            *(f32x4*)(VT + ((size_t)(cb * 256 + cl) * 2 + b) * SEQ + t0 + 4 * q) = o; }
    }
}

using pg8::Unit;
#define EPI_LOOP_BEGIN const int row0 = u.pm * 256 + wr * 64 + fr; \
    _Pragma("unroll") for (int ai = 0; ai < 2; ++ai) _Pragma("unroll") for (int m = 0; m < 4; ++m) { const int row = row0 + ai * 128 + m * 16; \
    _Pragma("unroll") for (int bj = 0; bj < 2; ++bj) { const int cl = bj * 128 + wc * 32 + 8 * fq; const f32x4 v0 = acc[ai][bj][m][0], v1 = acc[ai][bj][m][1];
#define EPI_LOOP_END } __builtin_amdgcn_sched_barrier(0); }
struct EpiBf16 {
    static constexpr bool PERM = true, KEEPS = false;
    bf16_t* O; int ldc; const float* rscale; int rs_stride; int act; float cscale; int pn_from, pn_add;
    __device__ __forceinline__ void operator()(const f32x4 (&acc)[2][2][4][2], const Unit& u, int wr, int wc, int fr, int fq) const {
        EPI_LOOP_BEGIN
            const float s = (rscale ? rscale[(size_t)row * rs_stride] : 1.f) * cscale;
            float x[8] = {v0.x * s, v0.y * s, v0.z * s, v0.w * s, v1.x * s, v1.y * s, v1.z * s, v1.w * s};
            if (act == 1) {
#pragma unroll
                for (int i = 0; i < 8; ++i) x[i] = sigmoidf_(x[i]); }
            u32x4 w; w.x = cvt_pk_bf16(x[0], x[1]); w.y = cvt_pk_bf16(x[2], x[3]); w.z = cvt_pk_bf16(x[4], x[5]); w.w = cvt_pk_bf16(x[6], x[7]);
            *(u32x4*)(O + (size_t)row * ldc + (u.pn + (u.pn >= pn_from ? pn_add : 0)) * 256 + cl) = w;
        EPI_LOOP_END
    }
};
struct EpiLora {
    static constexpr bool PERM = true, KEEPS = false;
    bf16_t* EW; bf16_t* ICLR; bf16_t* GG; const float* w0; const float* a0; float cscale;
    __device__ __forceinline__ void operator()(const f32x4 (&acc)[2][2][4][2], const Unit& u, int wr, int wc, int fr, int fq) const {
        const int blk = u.pn >> 2, cb = (u.pn & 3) * 256;
        const float* bias = blk < 2 ? w0 + blk * 1024 : a0 + (blk & 1) * 1024;
        bf16_t* dbase = blk < 2 ? EW + (size_t)blk * T * 1024 : blk < 4 ? ICLR + (size_t)(blk - 2) * T * 1024 : GG;
        const float scale = blk < 2 ? 0.6065306597126334f : 1.f; const bool sig = blk < 4;
        f32x4 bia[2][2];
#pragma unroll
        for (int bj = 0; bj < 2; ++bj) { const int c = cb + bj * 128 + wc * 32 + 8 * fq; bia[bj][0] = *(const f32x4*)(bias + c); bia[bj][1] = *(const f32x4*)(bias + c + 4); }
        EPI_LOOP_BEGIN
            const int c = cb + cl; float x[8] = {v0.x * cscale, v0.y * cscale, v0.z * cscale, v0.w * cscale, v1.x * cscale, v1.y * cscale, v1.z * cscale, v1.w * cscale};
            if (sig) { const f32x4 b0 = bia[bj][0], b1 = bia[bj][1]; const float bb[8] = {b0.x, b0.y, b0.z, b0.w, b1.x, b1.y, b1.z, b1.w};
#pragma unroll
                for (int i = 0; i < 8; ++i) x[i] = scale * sigmoidf_(bb[i] + x[i]); }
            u32x4 w; w.x = cvt_pk_bf16(x[0], x[1]); w.y = cvt_pk_bf16(x[2], x[3]); w.z = cvt_pk_bf16(x[4], x[5]); w.w = cvt_pk_bf16(x[6], x[7]);
            *(u32x4*)(dbase + (size_t)row * 1024 + c) = w;
        EPI_LOOP_END
    }
};
struct EpiHy {
    static constexpr bool PERM = true, KEEPS = false;
    const bf16_t* gates; bf16_t* MB;
    __device__ __forceinline__ void operator()(const f32x4 (&acc)[2][2][4][2], const Unit& uu, int wr, int wc, int fr, int fq) const {
        Unit u; u.pm = uu.pm - 2 * 66; u.pn = uu.pn & 7;
        const int row0 = u.pm * 256 + wr * 64 + fr, col0 = u.pn * 256 + wc * 32 + 8 * fq;
        const bf16_t* gcur = gates + 2 * DM + col0;
        u32x4 gq[2], gn[2];
#define EM_ROW(it_) ((size_t)(row0 + ((it_) >> 2) * 128 + ((it_) & 3) * 16))
#pragma unroll
        for (int bj = 0; bj < 2; ++bj) gq[bj] = *(const u32x4*)(gcur + EM_ROW(0) * NGATE + bj * 128);
#pragma unroll
        for (int it = 0; it < 8; ++it) { const int ai = it >> 2, m = it & 3;
            if (it < 7) {
#pragma unroll
                for (int bj = 0; bj < 2; ++bj) gn[bj] = *(const u32x4*)(gcur + EM_ROW(it + 1) * NGATE + bj * 128); }
#pragma unroll
            for (int bj = 0; bj < 2; ++bj) { float g[8]; up8(gq[bj], g); const f32x4 v0 = acc[ai][bj][m][0], v1 = acc[ai][bj][m][1];
#pragma unroll
                for (int i = 0; i < 8; ++i) g[i] = sigmoidf_(g[i]);
                u32x4 w; w.x = cvt_pk_bf16(v0.x * g[0], v0.y * g[1]); w.y = cvt_pk_bf16(v0.z * g[2], v0.w * g[3]); w.z = cvt_pk_bf16(v1.x * g[4], v1.y * g[5]); w.w = cvt_pk_bf16(v1.z * g[6], v1.w * g[7]);
                *(u32x4*)(MB + EM_ROW(it) * DM + col0 + bj * 128) = w; }
            gq[0] = gn[0]; gq[1] = gn[1];
            __builtin_amdgcn_sched_barrier(0); }
    }
};
struct OrderHy {
    pg8::StaticOrder so;
    __device__ void init(int G, int c, int nM, int pm0) { so.init(nM, 8, G, c, pm0); }
    __device__ bool next(int i, Unit& u) const { Unit t; if (!so.next(i, t)) return false; u.pm = 2 * 66 + t.pm; u.pn = 2 * 8 + t.pn; return true; }
};
struct EpiMerge3 {
    static constexpr bool PERM = true, KEEPS = true;
    const bf16_t* gates; bf16_t* MB;
    __device__ __forceinline__ bool operator()(f32x4 (&acc)[2][2][4][2], const Unit& uu, int wr, int wc, int fr, int fq) const {
        const int sub = uu.pn >> 3; Unit u; u.pm = uu.pm - (sub == 0 ? 0 : sub == 1 ? 66 : 396); u.pn = uu.pn & 7;
        const int br = sub == 2 ? 3 : sub, brn = sub == 0 ? 1 : 3; const bool last = sub == 2; const float fs = sub == 0 ? 1.f / Y8A_SCALE : 1.f;
        const int row0 = u.pm * 256 + wr * 64 + fr, col0 = u.pn * 256 + wc * 32 + 8 * fq;
        const bf16_t* gcur = gates + br * DM + col0; const bf16_t* gnxt = gates + brn * DM + col0;
        u32x4 gq[2], hq[2], gn[2], hn[2];
#pragma unroll
        for (int bj = 0; bj < 2; ++bj) { gq[bj] = *(const u32x4*)(gcur + EM_ROW(0) * NGATE + bj * 128); hq[bj] = last ? *(const u32x4*)(MB + EM_ROW(0) * DM + col0 + bj * 128) : *(const u32x4*)(gnxt + EM_ROW(0) * NGATE + bj * 128); }
#pragma unroll
        for (int it = 0; it < 8; ++it) { const int ai = it >> 2, m = it & 3;
            if (it < 7) {
#pragma unroll
                for (int bj = 0; bj < 2; ++bj) { gn[bj] = *(const u32x4*)(gcur + EM_ROW(it + 1) * NGATE + bj * 128); hn[bj] = last ? *(const u32x4*)(MB + EM_ROW(it + 1) * DM + col0 + bj * 128) : *(const u32x4*)(gnxt + EM_ROW(it + 1) * NGATE + bj * 128); } }
#pragma unroll
            for (int bj = 0; bj < 2; ++bj) { float g[8], hh[8]; up8(gq[bj], g); up8(hq[bj], hh); float f[8];
#pragma unroll
                for (int i = 0; i < 8; ++i) { const float ea = __expf(-g[i]), eb = __expf(-hh[i]); f[i] = last ? (1.f / 32.f) / (1.f + ea) : fs * (1.f + eb) / (1.f + ea); }
                f32x4& v0 = acc[ai][bj][m][0]; f32x4& v1 = acc[ai][bj][m][1];
                v0 = v0 * (f32x4){f[0], f[1], f[2], f[3]}; v1 = v1 * (f32x4){f[4], f[5], f[6], f[7]};
                if (last) { u32x4 w; w.x = cvt_pk_bf16(v0.x + hh[0], v0.y + hh[1]); w.y = cvt_pk_bf16(v0.z + hh[2], v0.w + hh[3]); w.z = cvt_pk_bf16(v1.x + hh[4], v1.y + hh[5]); w.w = cvt_pk_bf16(v1.z + hh[6], v1.w + hh[7]);
                    *(u32x4*)(MB + EM_ROW(it) * DM + col0 + bj * 128) = w; } }
            gq[0] = gn[0]; gq[1] = gn[1]; hq[0] = hn[0]; hq[1] = hn[1];
            __builtin_amdgcn_sched_barrier(0); }
#undef EM_ROW
        return !last;
    }
};
struct OrderMerge3 {
    pg8::StaticOrder so;
    __device__ void init(int G, int c, int nM, int pm0) { so.init(nM, 8, G, c, pm0); }
    __device__ bool next(int i, Unit& u) const { Unit t; if (!so.next(i / 3, t)) return false; const int sub = i % 3; u.pm = (sub == 0 ? 0 : sub == 1 ? 66 : 396) + t.pm; u.pn = sub * 8 + t.pn; return true; }
};
struct EpiF32 {
    static constexpr bool PERM = true, KEEPS = false;
    float* O; int ldc;
    __device__ __forceinline__ void operator()(const f32x4 (&acc)[2][2][4][2], const Unit& u, int wr, int wc, int fr, int fq) const {
        EPI_LOOP_BEGIN
            float* o = O + (size_t)row * ldc + u.pn * 256 + cl; *(f32x4*)o = v0; *(f32x4*)(o + 4) = v1;
        EPI_LOOP_END
    }
};
__device__ __forceinline__ int moe_panel(int e, int pi) { return pi < 8 ? (((pi >> 2) * NEXP + e) * 4 + (pi & 3)) : 128 + e; }
struct OrderMoe {
    int npn, G, c, npan;
    __device__ void init(int npn_, int G_, int c_, int npan_) { npn = npn_; G = G_; c = c_; npan = npan_; }
    __device__ bool next(int i, Unit& u) const { const int per = npan * npn;
        if ((G & 7) == 0 && G >= 8) { const int xcd = c & 7, wx = G >> 3, r = c >> 3; const int Lx = i * wx + r; if (Lx >= 2 * per) return false;
            const int e = xcd + 8 * (Lx / per), rem = Lx % per, j = rem / npan, pi = rem % npan; u.pm = moe_panel(e, pi); u.pn = e * npn + j; return true; }
        const int L = i * G + c; if (L >= NEXP * per) return false;
        const int e = L / per, r = L % per, j = r / npan, pi = r % npan; u.pm = moe_panel(e, pi); u.pn = e * npn + j; return true; }
};
struct EpiSwiglu {
    static constexpr bool PERM = true, KEEPS = false;
    unsigned char* HID;
    __device__ __forceinline__ void operator()(const f32x4 (&acc)[2][2][4][2], const Unit& u, int wr, int wc, int fr, int fq) const {
        const int j = u.pn % 11; const int row0 = u.pm * 256 + wr * 64 + fr; const float sc = 1.f / 64.f;
#pragma unroll
        for (int ai = 0; ai < 2; ++ai)
#pragma unroll
            for (int m = 0; m < 4; ++m) { const int row = row0 + ai * 128 + m * 16;
                const f32x4 g0 = acc[ai][0][m][0] * sc, g1 = acc[ai][0][m][1] * sc, u0 = acc[ai][1][m][0] * sc, u1 = acc[ai][1][m][1] * sc;
                u32x2 w; w.x = pk4fp8(siluf_(g0.x) * u0.x, siluf_(g0.y) * u0.y, siluf_(g0.z) * u0.z, siluf_(g0.w) * u0.w);
                w.y = pk4fp8(siluf_(g1.x) * u1.x, siluf_(g1.y) * u1.y, siluf_(g1.z) * u1.z, siluf_(g1.w) * u1.w);
                *(u32x2*)(HID + (size_t)row * EFFP + j * 128 + wc * 32 + 8 * fq) = w; __builtin_amdgcn_sched_barrier(0); }
    }
};
struct EpiDown {
    static constexpr bool PERM = true, KEEPS = false;
    bf16_t* YE;
    __device__ __forceinline__ void operator()(const f32x4 (&acc)[2][2][4][2], const Unit& uu, int wr, int wc, int fr, int fq) const {
        Unit u; u.pm = uu.pm; u.pn = uu.pn & 7; const float s = 1.f / 64.f;
        EPI_LOOP_BEGIN
            u32x4 w; w.x = cvt_pk_bf16(v0.x * s, v0.y * s); w.y = cvt_pk_bf16(v0.z * s, v0.w * s); w.z = cvt_pk_bf16(v1.x * s, v1.y * s); w.w = cvt_pk_bf16(v1.z * s, v1.w * s);
            *(u32x4*)(YE + (size_t)row * DM + u.pn * 256 + cl) = w;
        EPI_LOOP_END
    }
};

namespace att {
using s16x4 = __attribute__((ext_vector_type(4))) short;
using f32x16 = __attribute__((ext_vector_type(16))) float;
constexpr int NW = 8, QBLK = 32, KVBLK = 64, LDQ = 1536, LDKV = 2048, LDO = 1024;
constexpr float SCALE = 0.07216878364870322f;
constexpr float THR = 3.f;
constexpr float P_LOG2_SCALE = 4.f;
#ifndef ATT_SDEPTH
#define ATT_SDEPTH 1
#endif
constexpr int SDEPTH = ATT_SDEPTH;
constexpr int SHM_V = KVBLK * 128 * 2, SHM_K = KVBLK * 128 * 2, SHM_KP = KVBLK * 64 * 2;
constexpr int OFF_V = 0, OFF_K = 2 * SHM_V, OFF_KP = OFF_K + 2 * SHM_K, OFF_WS = OFF_KP + 2 * SHM_KP, OFF_QP = OFF_WS + NW * 64 * 4, SHM_ATTN = OFF_QP + 256 * 256;
static_assert(SHM_ATTN <= 150 * 1024, "attention LDS");
#define KSWZ(row, colB) ((row) * 256 + ((colB) ^ (((row) & 7) << 4)))
#define KPSWZ(row, colB) ((row) * 128 + ((colB) ^ (((row) & 7) << 4)))
#define SBAR() __builtin_amdgcn_sched_barrier(0)
__device__ __forceinline__ int crow(int r, int hi) { return (r & 3) + 8 * (r >> 2) + 4 * hi; }
__device__ __forceinline__ void partialSM(f32x16& p0, f32x16& p1, float& m_reg, float& mn, float& alpha) {
  constexpr float C = SCALE * 1.4426950408889634f;
  float pmax = p0[0]; for (int r = 1; r < 16; ++r) pmax = fmaxf(pmax, p0[r]); for (int r = 0; r < 16; ++r) pmax = fmaxf(pmax, p1[r]);
  { auto rr = __builtin_amdgcn_permlane32_swap(__float_as_uint(pmax), __float_as_uint(pmax), false, false);
    pmax = fmaxf(__uint_as_float(rr[0]), __uint_as_float(rr[1])); }
  if (__builtin_expect(__all(pmax - m_reg <= THR / SCALE), 1)) { mn = m_reg; alpha = 1.f; }
  else { mn = fmaxf(m_reg, pmax); alpha = __builtin_amdgcn_exp2f((m_reg - mn) * C); m_reg = mn; }
  float mnC = -mn * C + P_LOG2_SCALE;
  for (int r = 0; r < 16; ++r) p0[r] = fmaf(p0[r], C, mnC); for (int r = 0; r < 16; ++r) p1[r] = fmaf(p1[r], C, mnC);
  for (int r = 0; r < 16; ++r) p0[r] = __builtin_amdgcn_exp2f(p0[r]);
}
typedef int i32x8a __attribute__((ext_vector_type(8)));
typedef int i32x4a __attribute__((ext_vector_type(4)));
__device__ __forceinline__ void finishSM(f32x16& p0, f32x16& p1, float alpha, float& l_reg, i32x8a& pf) {
  for (int r = 0; r < 16; ++r) p1[r] = __builtin_amdgcn_exp2f(p1[r]);
  float ps = 0; for (int r = 0; r < 16; ++r) ps += p0[r]; for (int r = 0; r < 16; ++r) ps += p1[r];
  { auto rr = __builtin_amdgcn_permlane32_swap(__float_as_uint(ps), __float_as_uint(ps), false, false);
    ps = __uint_as_float(rr[0]) + __uint_as_float(rr[1]); }
  l_reg = l_reg * alpha + ps;
#pragma unroll
  for (int i = 0; i < 4; ++i) { pf[i] = (int)pk4fp8(p0[4 * i], p0[4 * i + 1], p0[4 * i + 2], p0[4 * i + 3]); pf[4 + i] = (int)pk4fp8(p1[4 * i], p1[4 * i + 1], p1[4 * i + 2], p1[4 * i + 3]); }
}
__host__ __device__ __forceinline__ int vt_pos(int key) { const int kk = key & 31; return ((kk >> 2) & 1) * 32 + (key >= 32 ? 16 : 0) + (kk & 3) + 4 * (kk >> 3); }
#define K8SWZ(row, bo) ((row) * 128 + (((((bo) >> 4) ^ (((row) >> 1) & 7))) << 4) + ((bo) & 15))
#define P8SWZ(row, bo) ((row) * 64 + (((((bo) >> 4) ^ (((row) >> 2) & 3))) << 4) + ((bo) & 15))
__device__ __forceinline__ i32x8a ld32(const char* p0, const char* p1) { return __builtin_shufflevector(*reinterpret_cast<const i32x4a*>(p0), *reinterpret_cast<const i32x4a*>(p1), 0, 1, 2, 3, 4, 5, 6, 7); }
#define MFMA8(acc, a, b) acc = __builtin_amdgcn_mfma_scale_f32_32x32x64_f8f6f4(a, b, acc, 0, 0, 0, sc1, 0, sc1)
__device__ __forceinline__ void qkt(f32x16& p0, f32x16& p1, const char* Ks, const char* Kp, const i32x8a (&q8)[3], int r32, int hi) {
  p0 = f32x16{}; p1 = f32x16{}; const int sc1 = 0x7F7F7F7F;
#pragma unroll
  for (int blk = 0; blk < 2; ++blk) { const int bo = blk * 64 + hi * 32;
    const i32x8a a0 = ld32(Ks + K8SWZ(r32, bo), Ks + K8SWZ(r32, bo + 16)), a1 = ld32(Ks + K8SWZ(32 + r32, bo), Ks + K8SWZ(32 + r32, bo + 16));
    MFMA8(p0, a0, q8[blk]); MFMA8(p1, a1, q8[blk]); }
  { const int bo = hi * 32;
    const i32x8a a0 = ld32(Kp + P8SWZ(r32, bo), Kp + P8SWZ(r32, bo + 16)), a1 = ld32(Kp + P8SWZ(32 + r32, bo), Kp + P8SWZ(32 + r32, bo + 16));
    MFMA8(p0, a0, q8[2]); MFMA8(p1, a1, q8[2]); }
}
__device__ __forceinline__ u32x2 cvt8(bf16x8 v) { const u32x4 w = __builtin_bit_cast(u32x4, v); return (u32x2){pk4fp8(bflo(w.x), bfhi(w.x), bflo(w.y), bfhi(w.y)), pk4fp8(bflo(w.z), bfhi(w.z), bflo(w.w), bfhi(w.w))}; }
__device__ __forceinline__ void pv_d0(f32x16* o, const char* Vt, const i32x8a pf, int r32, int hi) {
  const int sc1 = 0x7F7F7F7F;
#pragma unroll
  for (int d0 = 0; d0 < 4; ++d0) { const int dim = d0 * 32 + r32; const i32x8a bfr = ld32(Vt + P8SWZ(dim, hi * 32), Vt + P8SWZ(dim, hi * 32 + 16)); MFMA8(o[d0], pf, bfr); }
}
__device__ __forceinline__ void attn_unit(const bf16_t* __restrict__ Qb, const unsigned char* __restrict__ KVh, const unsigned char* __restrict__ VTh, const unsigned char* __restrict__ KPE, unsigned char* __restrict__ Ob,
                                          int ka0, int kb0, int NT, char* lds, int tid_in, int tpos0) {
  const unsigned tid_u = (unsigned)tid_in; __builtin_assume(tid_u < 512u);
  const int tid = (int)tid_u, wid = tid >> 6, lane = tid & 63, r32 = lane & 31, hi = lane >> 5;
  char* V_lds = lds + OFF_V; char* K_lds = lds + OFF_K; char* P_lds = lds + OFF_KP;
  float* ws = (float*)(lds + OFF_WS) + wid * 64; float* li_l = ws; float* al_l = ws + 32;
  float m_reg = -1e30f, l_reg = 0; f32x16 o[4] = {}; i32x8a q8[3];
  const int qrow = wid * QBLK + r32;
  const bf16_t* Qrow = Qb + (long)qrow * LDQ;
#pragma unroll
  for (int blk = 0; blk < 2; ++blk) { const bf16_t* src = Qrow + blk * 64 + hi * 32;
#pragma unroll
    for (int i = 0; i < 4; ++i) { const u32x2 c = cvt8(*reinterpret_cast<const bf16x8*>(src + 8 * i)); q8[blk][2 * i] = (int)c.x; q8[blk][2 * i + 1] = (int)c.y; } }
  { const bf16_t* src = Qrow + 128 + hi * 32; float x1[16], x2[16];
    { float t0[8], t1[8]; ld8bf(src, t0); ld8bf(src + 8, t1);
#pragma unroll
      for (int i = 0; i < 8; ++i) { x1[i] = t0[i]; x1[8 + i] = t1[i]; }
      ld8bf(src + 16, t0); ld8bf(src + 24, t1);
#pragma unroll
      for (int i = 0; i < 8; ++i) { x2[i] = t0[i]; x2[8 + i] = t1[i]; } }
    if (tpos0 >= 0) { const int t = tpos0 + qrow; const float pos = (float)(hi == 0 ? (t >> 6) : (t & 63));
#pragma unroll
      for (int i = 0; i < 16; ++i) { const float ang = pos * __builtin_amdgcn_exp2f(-(float)i * 0.8304820237218406f); const float c = __cosf(ang), sn = __sinf(ang);
        const float a0 = x1[i], b0 = x2[i]; x1[i] = a0 * c - b0 * sn; x2[i] = b0 * c + a0 * sn; } }
#pragma unroll
    for (int i = 0; i < 4; ++i) { q8[2][i] = (int)pk4fp8(x1[4 * i], x1[4 * i + 1], x1[4 * i + 2], x1[4 * i + 3]); q8[2][4 + i] = (int)pk4fp8(x2[4 * i], x2[4 * i + 1], x2[4 * i + 2], x2[4 * i + 3]); } }
  const int vdim = tid >> 2, vch = (tid & 3) * 16;
  struct { i32x4a vt, k8, p8; } sr_[SDEPTH];
#define KROW(j) ((j) < 4 ? ka0 + 64 * (j) : kb0 + 64 * ((j) - 4))
  const __amdgpu_buffer_rsrc_t rsKV = __builtin_amdgcn_make_buffer_rsrc((void*)KVh, 0, 0xFFFFFFFFu, 0x00020000);
  const __amdgpu_buffer_rsrc_t rsKP = __builtin_amdgcn_make_buffer_rsrc((void*)KPE, 0, 0xFFFFFFFFu, 0x00020000);
  const __amdgpu_buffer_rsrc_t rsVT = __builtin_amdgcn_make_buffer_rsrc((void*)VTh, 0, 0xFFFFFFFFu, 0x00020000);
  const int vo_v = vdim * T + vch;
  const int krow = tid >> 3, kch = (tid & 7) * 16, vo_k = krow * 128 + kch, vo_p = ((tid & 255) >> 2) * 64 + vch;
#define SLOAD(i, jt) do { const int k0_ = KROW(jt); \
    sr_[i].vt = __builtin_bit_cast(i32x4a, __builtin_amdgcn_raw_buffer_load_b128(rsVT, vo_v, k0_, 0)); \
    sr_[i].k8 = __builtin_bit_cast(i32x4a, __builtin_amdgcn_raw_buffer_load_b128(rsKV, vo_k, k0_ * 128, 0)); \
    sr_[i].p8 = __builtin_bit_cast(i32x4a, __builtin_amdgcn_raw_buffer_load_b128(rsKP, vo_p, k0_ * 64, 0)); } while (0)
#define SWRITE(b, i) do { *(i32x4a*)(V_lds + (b) * SHM_V + P8SWZ(vdim, vch)) = sr_[i].vt;               \
    *(i32x4a*)(K_lds + (b) * SHM_K + K8SWZ(krow, kch)) = sr_[i].k8;                       \
    if (tid < 256) *(i32x4a*)(P_lds + (b) * SHM_KP + P8SWZ(vdim, vch)) = sr_[i].p8; } while (0)
#define SWAIT() do { if constexpr (SDEPTH == 2) asm volatile("s_waitcnt vmcnt(5)" ::: "memory"); else asm volatile("s_waitcnt vmcnt(0)" ::: "memory"); } while (0)
#define RESC(a) do { if (__any((a) < 1.f)) { if (hi == 0) al_l[r32] = (a); asm volatile("s_waitcnt lgkmcnt(0)" ::: "memory"); \
    for (int d = 0; d < 4; ++d) for (int r = 0; r < 16; ++r) o[d][r] *= al_l[crow(r, hi)]; } } while (0)
  f32x16 pA0, pA1, pB0, pB1; float mnA, mnB, alA, alB; i32x8a pf;
  constexpr int SE = 0, SO = SDEPTH - 1;
  SLOAD(SE, 0); asm volatile("s_waitcnt vmcnt(0)" ::: "memory"); SWRITE(0, SE); __syncthreads();
  qkt(pA0, pA1, K_lds, P_lds, q8, r32, hi); partialSM(pA0, pA1, m_reg, mnA, alA);
  SLOAD(SO, 1); if constexpr (SDEPTH == 2) { if (2 < NT) SLOAD(SE, 2); }
  SWAIT(); SWRITE(1, SO); __syncthreads();
  for (int j = 1; j + 1 < NT; j += 2) {
    SBAR(); qkt(pB0, pB1, K_lds + SHM_K, P_lds + SHM_KP, q8, r32, hi);
    finishSM(pA0, pA1, alA, l_reg, pf); SBAR();
    SLOAD(SO, j + SDEPTH); SBAR();
    pv_d0(o, V_lds, pf, r32, hi); partialSM(pB0, pB1, m_reg, mnB, alB);
    __syncthreads(); SWAIT(); SWRITE(0, SE);
    RESC(alB); __syncthreads();
    SBAR(); qkt(pA0, pA1, K_lds, P_lds, q8, r32, hi);
    finishSM(pB0, pB1, alB, l_reg, pf); SBAR();
    if (SDEPTH == 1 || j + 3 < NT) SLOAD(SE, j + 1 + SDEPTH); SBAR();
    pv_d0(o, V_lds + SHM_V, pf, r32, hi); partialSM(pA0, pA1, m_reg, mnA, alA);
    __syncthreads(); SWAIT(); SWRITE(1, SO);
    RESC(alA); __syncthreads();
  }
  SBAR(); qkt(pB0, pB1, K_lds + SHM_K, P_lds + SHM_KP, q8, r32, hi);
  finishSM(pA0, pA1, alA, l_reg, pf); SBAR();
  pv_d0(o, V_lds, pf, r32, hi); partialSM(pB0, pB1, m_reg, mnB, alB);
  __syncthreads(); RESC(alB);
  finishSM(pB0, pB1, alB, l_reg, pf); SBAR();
  pv_d0(o, V_lds + SHM_V, pf, r32, hi);
  if (hi == 0) li_l[r32] = l_reg; asm volatile("s_waitcnt lgkmcnt(0)" ::: "memory");
  float rli[16];
#pragma unroll
  for (int r = 0; r < 16; ++r) rli[r] = __builtin_amdgcn_rcpf(li_l[crow(r, hi)]);
  unsigned char* Ow = Ob + (long)(wid * QBLK) * LDO;
#pragma unroll
  for (int r = 0; r < 16; ++r) { int orow = crow(r, hi);
    for (int d0 = 0; d0 < 4; ++d0) Ow[(long)orow * LDO + d0 * 32 + r32] = (unsigned char)(pk4fp8(o[d0][r] * rli[r] * Y8A_SCALE, 0.f, 0.f, 0.f) & 0xffu); }
  __syncthreads();
#undef KROW
#undef SLOAD
#undef SWRITE
#undef SWAIT
#undef RESC
}
}

__device__ __forceinline__ void phase_vt(Frame& F) {
    const bf16_t* KV = WSP(bf16_t, WS_KV); unsigned char* VT = WSP(unsigned char, WS_VT8);
    LAS unsigned char* scr = (LAS unsigned char*)(F.lds + F.wave * 8192);
    const int lane = F.lane;
    for (int it = F.gw; it < (T / 64) * 8; it += F.NGW) { const int tb = it >> 3, h = it & 7, row0 = tb * 64;
        bf16x8 v[16];
#pragma unroll
        for (int i = 0; i < 16; ++i) v[i] = *(const bf16x8*)(KV + (size_t)(row0 + 4 * i + (lane >> 4)) * 2048 + h * 256 + 128 + (lane & 15) * 8);
#pragma unroll
        for (int i = 0; i < 16; ++i) { const u32x2 c = att::cvt8(v[i]); const int pos = att::vt_pos(4 * i + (lane >> 4)); LAS unsigned char* d = scr + ((lane & 15) * 8) * 64 + pos;
            d[0] = (unsigned char)(c.x & 0xff); d[64] = (unsigned char)((c.x >> 8) & 0xff); d[128] = (unsigned char)((c.x >> 16) & 0xff); d[192] = (unsigned char)(c.x >> 24);
            d[256] = (unsigned char)(c.y & 0xff); d[320] = (unsigned char)((c.y >> 8) & 0xff); d[384] = (unsigned char)((c.y >> 16) & 0xff); d[448] = (unsigned char)(c.y >> 24); }
        LDS_WAIT(); asm volatile("" ::: "memory");
#pragma unroll
        for (int r = 0; r < 2; ++r) { const int d = lane * 2 + r; const LAS u32x4* sp = (const LAS u32x4*)(scr + d * 64); u32x4* gp = (u32x4*)(VT + ((size_t)(h * 128 + d)) * T + row0);
            const u32x4 a0 = sp[0], a1 = sp[1], a2 = sp[2], a3 = sp[3]; gp[0] = a0; gp[1] = a1; gp[2] = a2; gp[3] = a3; }
        LDS_WAIT(); asm volatile("" ::: "memory");
        { unsigned char* K8 = WSP(unsigned char, WS_K8) + ((size_t)h * T + row0) * 128;
#pragma unroll
          for (int i = 0; i < 16; ++i) v[i] = *(const bf16x8*)(KV + (size_t)(row0 + 4 * i + (lane >> 4)) * 2048 + h * 256 + (lane & 15) * 8);
#pragma unroll
          for (int i = 0; i < 16; ++i) *(u32x2*)(K8 + (size_t)(4 * i + (lane >> 4)) * 128 + (lane & 15) * 8) = att::cvt8(v[i]); }
        if (h == 0) { const bf16_t* KPE = WSP(bf16_t, WS_KPE) + (size_t)row0 * 64; unsigned char* P8 = WSP(unsigned char, WS_KPE8) + (size_t)row0 * 64;
#pragma unroll
          for (int i = 0; i < 8; ++i) v[i] = *(const bf16x8*)(KPE + (size_t)(8 * i + (lane >> 3)) * 64 + (lane & 7) * 8);
#pragma unroll
          for (int i = 0; i < 8; ++i) *(u32x2*)(P8 + (size_t)(8 * i + (lane >> 3)) * 64 + (lane & 7) * 8) = att::cvt8(v[i]); }
    }
}
__device__ __forceinline__ void phase_attn(Frame& F, bool lat_only) {
    const bf16_t* Q = WSP(bf16_t, WS_Q); const bf16_t* KV = WSP(bf16_t, WS_KV); const bf16_t* KPE = WSP(bf16_t, WS_KPE); unsigned char* YA = WSP(unsigned char, WS_Y8A);
    const int NU = NBATCH * NH_MLA * 32 + (lat_only ? 0 : NBATCH * NH_MLA);
    const bool xa = (F.G == 256);
    for (int u0 = F.bid; u0 < NU; u0 += F.G) {
        int u = u0;
        if (xa && u0 < NBATCH * NH_MLA * 32) { const int xcd = u0 & 7, r = (u0 >> 3) & 31, rnd = u0 >> 8; u = ((xcd + 8 * rnd) << 5) + r; }
        int b, h, row0, NT, tpos0;
        if (u < NBATCH * NH_MLA * 32) { const int bh = u >> 5, qb = u & 31; b = bh >> 3; h = bh & 7; row0 = TC + b * SEQ + qb * 256; NT = 4 + SEQ / 64; tpos0 = qb * 256; }
        else { const int bh = u - NBATCH * NH_MLA * 32; b = bh >> 3; h = bh & 7; row0 = b * CTX; NT = 4; tpos0 = -1; }
        att::attn_unit(Q + (size_t)row0 * 1536 + h * 192, WSP(unsigned char, WS_K8) + (size_t)h * T * 128, WSP(unsigned char, WS_VT8) + (size_t)h * 128 * T, WSP(unsigned char, WS_KPE8), YA + (size_t)row0 * 1024 + h * 128, b * CTX, TC + b * SEQ, NT, (char*)F.lds, F.tid, tpos0);
    }
}
__device__ __forceinline__ void phase_qrope(Frame& F) {
    bf16_t* Q = WSP(bf16_t, WS_Q);
    for (int row = TC + F.gw; row < T; row += F.NGW) {
        const int t = (row - TC) & (SEQ - 1); const int p = F.lane & 31, axis = p >> 4, j = p & 15, hs = F.lane >> 5;
        const float pos = (float)(axis == 0 ? (t >> 6) : (t & 63)); const float inv = __builtin_amdgcn_exp2f(-(float)j * 0.8304820237218406f);
        const float sn = __sinf(pos * inv), cs = __cosf(pos * inv);
#pragma unroll
        for (int hh = 0; hh < 4; ++hh) { const int h = hh * 2 + hs; bf16_t* q = Q + (size_t)row * 1536 + h * 192 + 128 + axis * 32 + j;
            const float x1 = bf2f(q[0]), x2 = bf2f(q[16]);
            q[0] = (bf16_t)f2bf(x1 * cs - x2 * sn); q[16] = (bf16_t)f2bf(x2 * cs + x1 * sn); }
    }
}

#define MFMA16(a, b, c) __builtin_amdgcn_mfma_f32_16x16x32_bf16((a), (b), (c), 0, 0, 0)
constexpr int XS_LD = 264, BC_LD = 136;
__device__ __forceinline__ float bperm(float v, int srclane) { return __builtin_bit_cast(float, __builtin_amdgcn_ds_bpermute(srclane << 2, __builtin_bit_cast(int, v))); }
__device__ __forceinline__ float wave_incl_scan(float v, int lane) {
#pragma unroll
    for (int o = 1; o < 64; o <<= 1) { const float t = bperm(v, lane - o); if (lane >= o) v += t; }
    return v;
}
template <int NCOLS>
__device__ __forceinline__ void stage_tile(LAS bf16_t* dst, int ld, const bf16_t* src, int tid) {
    constexpr int cpr = NCOLS >> 3, NIT = 128 * cpr / NTHREADS;
    u32x4 v[NIT];
#pragma unroll
    for (int k = 0; k < NIT; ++k) { const int i = tid + k * NTHREADS; const int r = i / cpr, c8 = (i % cpr) * 8; v[k] = *(const u32x4*)(src + (size_t)r * P2W + c8); }
#pragma unroll
    for (int k = 0; k < NIT; ++k) { const int i = tid + k * NTHREADS; const int r = i / cpr, c8 = (i % cpr) * 8; *(LAS u32x4*)(dst + r * ld + c8) = v[k]; }
}
__device__ __forceinline__ void phase_mamba_states(Frame& F, const Args& a, int layer) {
    const bf16_t* P2 = WSP(bf16_t, WS_P2); const float* DT = WSP(float, WS_DT); bf16_t* MST = WSP(bf16_t, WS_MST); float* MCS = WSP(float, WS_MCS);
    LAS bf16_t* XSl = (LAS bf16_t*)F.lds; LAS bf16_t* Bl = (LAS bf16_t*)(F.lds + 67584); LAS float* wt = (LAS float*)(F.lds + 102400) + F.wave * 128;
    const int lane = F.lane, row = lane & 15, quad = lane >> 4;
    for (int u = F.bid; u < NCHUNK * 4; u += F.G) {
        const int chunk = u >> 2, g = (u >> 1) & 1, half = u & 1, row0 = chunk * 128;
        __syncthreads();
        stage_tile<256>(XSl, XS_LD, P2 + (size_t)row0 * P2W + P2_XBC + (g * 8 + half * 4) * 64, F.tid);
        stage_tile<128>(Bl, BC_LD, P2 + (size_t)row0 * P2W + P2_XBC + 1024 + g * 128, F.tid);
        const int hl = F.wave >> 1, d = F.wave & 1, h = g * 8 + half * 4 + hl;
        const float aa = -__expf(arg_in(a, I_SALOG)[(layer * 2 + d) * 16 + h]);
        { const float dt0 = DT[(size_t)(row0 + lane) * 32 + d * 16 + h], dt1 = DT[(size_t)(row0 + 64 + lane) * 32 + d * 16 + h];
          const float da0 = dt0 * aa, da1 = dt1 * aa;
          float c0 = wave_incl_scan(da0, lane); const float tot0 = bperm(c0, 63); float c1 = wave_incl_scan(da1, lane) + tot0; const float tot = bperm(c1, 63);
          if (d == 0) { wt[lane] = dt0 * __expf(tot - c0); wt[64 + lane] = dt1 * __expf(tot - c1); }
          else { wt[lane] = dt0 * __expf(c0 - da0); wt[64 + lane] = dt1 * __expf(c1 - da1); }
          if (lane == 0) MCS[(d * NCHUNK + chunk) * 16 + h] = tot; }
        __syncthreads();
        bf16_t* out = MST + ((size_t)(d * NCHUNK + chunk) * 16 + h) * 8192;
#pragma unroll 1
        for (int nh = 0; nh < 2; ++nh) {
            f32x4 acc[4][4];
#pragma unroll
            for (int i = 0; i < 4; ++i)
#pragma unroll
                for (int j = 0; j < 4; ++j) acc[i][j] = (f32x4){0.f, 0.f, 0.f, 0.f};
#pragma unroll 1
            for (int k0 = 0; k0 < 128; k0 += 32) {
                const int sb = k0 + quad * 8;
                float w8[8];
#pragma unroll
                for (int j = 0; j < 8; ++j) w8[j] = wt[sb + j];
                bf16x8 bf[4];
#pragma unroll
                for (int nt = 0; nt < 4; ++nt) {
#pragma unroll
                    for (int j = 0; j < 8; ++j) bf[nt][j] = (short)Bl[(sb + j) * BC_LD + (nh * 4 + nt) * 16 + row]; }
#pragma unroll
                for (int pt = 0; pt < 4; ++pt) { bf16x8 af;
#pragma unroll
                    for (int j = 0; j < 8; ++j) af[j] = (short)f2bf(w8[j] * bf2f(XSl[(sb + j) * XS_LD + hl * 64 + pt * 16 + row]));
#pragma unroll
                    for (int nt = 0; nt < 4; ++nt) acc[pt][nt] = MFMA16(af, bf[nt], acc[pt][nt]); }
            }
#pragma unroll
            for (int pt = 0; pt < 4; ++pt)
#pragma unroll
                for (int nt = 0; nt < 4; ++nt)
#pragma unroll
                    for (int jj = 0; jj < 4; ++jj) out[(pt * 16 + quad * 4 + jj) * 128 + (nh * 4 + nt) * 16 + row] = (bf16_t)f2bf(acc[pt][nt][jj]);
        }
    }
}
__device__ __forceinline__ void phase_mamba_scan(Frame& F) {
    bf16_t* MST = WSP(bf16_t, WS_MST); const float* MCS = WSP(float, WS_MCS);
    for (int idx = F.bid * NTHREADS + F.tid; idx < 2 * 2 * 16 * 8192; idx += F.G * NTHREADS) {
        const int e = idx & 8191, h = (idx >> 13) & 15, b = (idx >> 17) & 1, d = idx >> 18;
        float state = 0.f;
#pragma unroll 6
        for (int i = 0; i < 66; ++i) {
            int chunk; if (i < 2) chunk = 2 * b + (d == 0 ? i : 1 - i); else chunk = 4 + 64 * b + (d == 0 ? i - 2 : 65 - i);
            bf16_t* p = MST + ((size_t)(d * NCHUNK + chunk) * 16 + h) * 8192 + e;
            const float cs = bf2f(*p); const float dec = __expf(MCS[(d * NCHUNK + chunk) * 16 + h]);
            *p = (bf16_t)f2bf(state);
            state = state * dec + cs;
        }
    }
}
__device__ __forceinline__ void phase_mamba_out(Frame& F, const Args& a, int layer) {
    const bf16_t* P = WSP(bf16_t, WS_P); const bf16_t* P2 = WSP(bf16_t, WS_P2); const float* DT = WSP(float, WS_DT); const bf16_t* MST = WSP(bf16_t, WS_MST);
    bf16_t* YB = WSP(bf16_t, WS_Y) + (size_t)1 * T * 1024;
    LAS bf16_t* Cl = (LAS bf16_t*)F.lds; LAS bf16_t* Bl = (LAS bf16_t*)(F.lds + 34816); LAS bf16_t* XSl = (LAS bf16_t*)(F.lds + 69632);
    LAS float* tab = (LAS float*)(F.lds + 137216);
    for (int u = F.bid; u < NCHUNK * 4; u += F.G) {
        const int chunk = u >> 2, g = (u >> 1) & 1, half = u & 1, row0 = chunk * 128;
        __syncthreads();
        { const int tid_ = F.wave * 64 + (lane_asm() & 63);
          stage_tile<256>(XSl, XS_LD, P2 + (size_t)row0 * P2W + P2_XBC + (g * 8 + half * 4) * 64, tid_);
          stage_tile<128>(Bl, BC_LD, P2 + (size_t)row0 * P2W + P2_XBC + 1024 + g * 128, tid_);
          stage_tile<128>(Cl, BC_LD, P2 + (size_t)row0 * P2W + P2_XBC + 1280 + g * 128, tid_); }
        const int lane = lane_asm() & 63, row = lane & 15, quad = lane >> 4;
        float tot1 = 0.f;
        { const int hl = F.wave >> 1, d = F.wave & 1, h = g * 8 + half * 4 + hl;
          const float aa = -__expf(arg_in(a, I_SALOG)[(layer * 2 + d) * 16 + h]);
          const float dt0 = DT[(size_t)(row0 + lane) * 32 + d * 16 + h], dt1 = DT[(size_t)(row0 + 64 + lane) * 32 + d * 16 + h];
          const float da0 = dt0 * aa, da1 = dt1 * aa;
          float c0 = wave_incl_scan(da0, lane); const float t0 = bperm(c0, 63); float c1 = wave_incl_scan(da1, lane) + t0;
          LAS float* tb = tab + hl * 512;
          if (d == 0) { tb[lane] = c0; tb[64 + lane] = c1; tb[256 + lane] = __logf(dt0) - c0; tb[320 + lane] = __logf(dt1) - c1; }
          else { tb[128 + lane] = c0 - da0; tb[192 + lane] = c1 - da1; tb[384 + lane] = (c0 - da0) + __logf(dt0); tb[448 + lane] = (c1 - da1) + __logf(dt1); if (lane == 63) tab[2048 + hl] = c1; } }
        __syncthreads();
        { f32x4 cb[8];
#pragma unroll
          for (int st = 0; st < 8; ++st) cb[st] = (f32x4){0.f, 0.f, 0.f, 0.f};
#pragma unroll
          for (int k0 = 0; k0 < 128; k0 += 32) { const bf16x8 af = *(const LAS bf16x8*)(Cl + (F.wave * 16 + row) * BC_LD + k0 + quad * 8);
#pragma unroll
              for (int st = 0; st < 8; ++st) { const bf16x8 bfr = *(const LAS bf16x8*)(Bl + (st * 16 + row) * BC_LD + k0 + quad * 8); cb[st] = MFMA16(af, bfr, cb[st]); } }
          __syncthreads();
#pragma unroll
          for (int st = 0; st < 8; ++st)
#pragma unroll
              for (int jj = 0; jj < 4; ++jj) Bl[(F.wave * 16 + quad * 4 + jj) * BC_LD + st * 16 + row] = (bf16_t)f2bf(cb[st][jj]); }
        __syncthreads();
        const int hl = F.wave >> 1, th = F.wave & 1, h = g * 8 + half * 4 + hl;
        const LAS float* tb = tab + hl * 512; tot1 = tab[2048 + hl];
        f32x4 acc[4][4];
#pragma unroll
        for (int i = 0; i < 4; ++i)
#pragma unroll
            for (int j = 0; j < 4; ++j) acc[i][j] = (f32x4){0.f, 0.f, 0.f, 0.f};
#pragma unroll 1
        for (int k0 = 0; k0 < 128; k0 += 32) {
            const int sb = k0 + quad * 8;
            float u0s[8], u1s[8];
#pragma unroll
            for (int j = 0; j < 8; ++j) { u0s[j] = tb[256 + sb + j]; u1s[j] = tb[384 + sb + j]; }
            bf16x8 bx[4];
#pragma unroll
            for (int pt = 0; pt < 4; ++pt) {
#pragma unroll
                for (int j = 0; j < 8; ++j) bx[pt][j] = (short)XSl[(sb + j) * XS_LD + hl * 64 + pt * 16 + row]; }
#pragma unroll
            for (int tt = 0; tt < 4; ++tt) { const int t = th * 64 + tt * 16 + row; const float c0t = tb[t], e1t = tb[128 + t];
                float cbv[8]; { const u32x4 w = *(const LAS u32x4*)(Bl + t * BC_LD + sb); cbv[0] = bflo(w.x); cbv[1] = bfhi(w.x); cbv[2] = bflo(w.y); cbv[3] = bfhi(w.y); cbv[4] = bflo(w.z); cbv[5] = bfhi(w.z); cbv[6] = bflo(w.w); cbv[7] = bfhi(w.w); }
                bf16x8 af;
#pragma unroll
                for (int j = 0; j < 8; ++j) { const int s = sb + j;
                    const float f0 = s <= t ? __expf(c0t + u0s[j]) : 0.f;
                    const float f1 = s >= t ? __expf(u1s[j] - e1t) : 0.f;
                    af[j] = (short)f2bf(cbv[j] * (f0 + f1)); }
#pragma unroll
                for (int pt = 0; pt < 4; ++pt) acc[tt][pt] = MFMA16(af, bx[pt], acc[tt][pt]); }
        }
#pragma unroll 1
        for (int d = 0; d < 2; ++d) {
            const bf16_t* S = MST + ((size_t)(d * NCHUNK + chunk) * 16 + h) * 8192;
#pragma unroll 1
            for (int k0 = 0; k0 < 128; k0 += 32) {
                bf16x8 bs[4];
#pragma unroll
                for (int pt = 0; pt < 4; ++pt) bs[pt] = *(const bf16x8*)(S + (pt * 16 + row) * 128 + k0 + quad * 8);
#pragma unroll
                for (int tt = 0; tt < 4; ++tt) { const int t = th * 64 + tt * 16 + row;
                    const float sc = d == 0 ? __expf(tb[t]) : __expf(tot1 - tb[128 + t]);
                    const u32x4 cw = *(const LAS u32x4*)(Cl + t * BC_LD + k0 + quad * 8);
                    u32x4 aw; aw.x = cvt_pk_bf16(bflo(cw.x) * sc, bfhi(cw.x) * sc); aw.y = cvt_pk_bf16(bflo(cw.y) * sc, bfhi(cw.y) * sc);
                    aw.z = cvt_pk_bf16(bflo(cw.z) * sc, bfhi(cw.z) * sc); aw.w = cvt_pk_bf16(bflo(cw.w) * sc, bfhi(cw.w) * sc);
                    const bf16x8 af = __builtin_bit_cast(bf16x8, aw);
#pragma unroll
                    for (int pt = 0; pt < 4; ++pt) acc[tt][pt] = MFMA16(af, bs[pt], acc[tt][pt]); } }
        }
        const float Dh = arg_in(a, I_SD)[layer * 16 + h];
#pragma unroll
        for (int tt = 0; tt < 4; ++tt)
#pragma unroll
            for (int jj = 0; jj < 4; ++jj) { const int t = th * 64 + tt * 16 + quad * 4 + jj; const size_t r = (size_t)(row0 + t);
#pragma unroll
                for (int pt = 0; pt < 4; ++pt) { const int p = pt * 16 + row;
                    const float xs = bf2f(XSl[t * XS_LD + hl * 64 + p]); const float z = bf2f(P[r * NNG + P_Z + h * 64 + p]);
                    YB[r * 1024 + h * 64 + p] = (bf16_t)f2bf((acc[tt][pt][jj] + xs * Dh) * siluf_(z)); } }
    }
}
__device__ __forceinline__ void phase_mamba_norm(Frame& F, const Args& a, int layer) {
    bf16_t* YB = WSP(bf16_t, WS_Y) + (size_t)1 * T * 1024; const float* nw = arg_in(a, I_SNORM) + layer * 1024;
    for (int row = F.gw; row < T; row += F.NGW) {
        bf16_t* p = YB + (size_t)row * 1024 + F.lane * 16; float x[16]; { float t0[8], t1[8]; ld8bf(p, t0); ld8bf(p + 8, t1);
#pragma unroll
            for (int i = 0; i < 8; ++i) { x[i] = t0[i]; x[8 + i] = t1[i]; } }
        float s = 0.f;
#pragma unroll
        for (int i = 0; i < 16; ++i) s += x[i] * x[i];
        s = sum32(s);
        const float r = 1.f / sqrtf(s * (1.f / 512.f) + 1e-5f);
        float o0[8], o1[8];
#pragma unroll
        for (int i = 0; i < 8; ++i) { o0[i] = x[i] * r * nw[F.lane * 16 + i]; o1[i] = x[8 + i] * r * nw[F.lane * 16 + 8 + i]; }
        *(u32x4*)(WSP(unsigned char, WS_Y8B) + (size_t)row * 1024 + F.lane * 16) = (u32x4){pk4fp8(o0[0], o0[1], o0[2], o0[3]), pk4fp8(o0[4], o0[5], o0[6], o0[7]), pk4fp8(o1[0], o1[1], o1[2], o1[3]), pk4fp8(o1[4], o1[5], o1[6], o1[7])};
    }
}

__device__ __forceinline__ float dpp_f(float x, const int ctrl_sel) {
    const int xi = __builtin_bit_cast(int, x); int r;
    if (ctrl_sel == 0) r = __builtin_amdgcn_update_dpp(0, xi, 0xB1, 0xF, 0xF, false);
    else if (ctrl_sel == 1) r = __builtin_amdgcn_update_dpp(0, xi, 0x4E, 0xF, 0xF, false);
    else r = __builtin_amdgcn_update_dpp(0, xi, 0x141, 0xF, 0xF, false);
    return __builtin_bit_cast(float, r);
}
__device__ __forceinline__ float red8(float x) { x += dpp_f(x, 0); x += dpp_f(x, 1); x += dpp_f(x, 2); return x; }
__device__ __forceinline__ int rw_row(int pos, int b, int d) { return pos < CTX ? b * CTX + (d == 0 ? pos : CTX - 1 - pos) : TC + b * SEQ + (d == 0 ? pos - CTX : SEQ - 1 - (pos - CTX)); }
constexpr int RW_STEP_F = 352, RW_CH = 32, RW_CHF = RW_STEP_F * RW_CH;
#define RW_CHUNK_ASM \
    "ds_read_b128 v[152:155], %[a16] offset:0\n\t" \
    "ds_read_b128 v[156:159], %[a16] offset:512\n\t" \
    "ds_read_b64 v[160:161], %[a8] offset:0\n\t" \
    "ds_read_b64 v[162:163], %[av] offset:0\n\t" \
    "ds_read_b128 v[164:167], %[a16] offset:1408\n\t" \
    "ds_read_b128 v[168:171], %[a16] offset:1920\n\t" \
    "ds_read_b64 v[172:173], %[a8] offset:1408\n\t" \
    "ds_read_b64 v[174:175], %[av] offset:1408\n\t" \
    "ds_read_b128 v[176:179], %[a16] offset:2816\n\t" \
    "ds_read_b128 v[180:183], %[a16] offset:3328\n\t" \
    "ds_read_b64 v[184:185], %[a8] offset:2816\n\t" \
    "ds_read_b64 v[186:187], %[av] offset:2816\n\t" \
    "s_waitcnt lgkmcnt(8)\n\t" \
    "v_pk_mul_f32 v[218:219], v[154:155], v[162:163] op_sel_hi:[1,0]\n\t" \
    "v_pk_mul_f32 v[200:201], %[sm], v[158:159]\n\t" \
    "v_pk_mul_f32 v[202:203], %[so], v[158:159]\n\t" \
    "v_pk_mul_f32 v[220:221], v[154:155], v[162:163] op_sel:[0,1] op_sel_hi:[1,1]\n\t" \
    "v_add_f32 v208, v200, v201\n\t" \
    "v_add_f32 v209, v202, v203\n\t" \
    "v_pk_fma_f32 v[218:219], %[sm], v[152:153], v[218:219]\n\t" \
    "v_pk_fma_f32 v[220:221], %[so], v[152:153], v[220:221]\n\t" \
    "v_add_f32_dpp v226, v209, v208 quad_perm:[1,0,3,2] row_mask:0xf bank_mask:0xf bound_ctrl:1\n\t" \
    "ds_read_b128 v[188:191], %[a16] offset:4224\n\t" \
    "ds_read_b128 v[192:195], %[a16] offset:4736\n\t" \
    "v_add_f32_dpp v226, v226, v226 quad_perm:[2,3,0,1] row_mask:0xf bank_mask:0xf bound_ctrl:1\n\t" \
    "ds_read_b64 v[196:197], %[a8] offset:4224\n\t" \
    "ds_read_b64 v[198:199], %[av] offset:4224\n\t" \
    "v_add_f32_dpp v226, v226, v226 row_ror:4 row_mask:0xf bank_mask:0xf bound_ctrl:1\n\t" \
    "s_nop 1\n\t" \
    "v_add_f32_dpp v226, v226, v226 row_ror:8 row_mask:0xf bank_mask:0xf bound_ctrl:1\n\t" \
    "v_mov_b32 v227, v226\n\t" \
    "s_nop 1\n\t" \
    "v_permlane16_swap_b32 v226, v227\n\t" \
    "s_waitcnt lgkmcnt(8)\n\t" \
    "v_add_f32 v216, v226, v227\n\t" \
    "v_pk_mul_f32 v[222:223], v[166:167], v[174:175] op_sel_hi:[1,0]\n\t" \
    "v_pk_fma_f32 %[sm], v[156:157], v[216:217], v[218:219] op_sel_hi:[1,0,1]\n\t" \
    "v_mov_b32_dpp v214, v216 quad_perm:[1,0,3,2] row_mask:0xf bank_mask:0xf\n\t" \
    "v_pk_mul_f32 v[200:201], %[sm], v[170:171]\n\t" \
    "v_pk_fma_f32 %[so], v[156:157], v[214:215], v[220:221] op_sel_hi:[1,0,1]\n\t" \
    "v_add_f32 v208, v200, v201\n\t" \
    "v_pk_mul_f32 v[202:203], %[so], v[170:171]\n\t" \
    "v_pk_mul_f32 v[204:205], %[sm], v[160:161]\n\t" \
    "v_add_f32 v209, v202, v203\n\t" \
    "v_pk_mul_f32 v[206:207], %[so], v[160:161]\n\t" \
    "v_add_f32 v210, v204, v205\n\t" \
    "v_add_f32_dpp v226, v209, v208 quad_perm:[1,0,3,2] row_mask:0xf bank_mask:0xf bound_ctrl:1\n\t" \
    "ds_read_b128 v[152:155], %[a16] offset:5632\n\t" \
    "v_add_f32 v211, v206, v207\n\t" \
    "v_pk_fma_f32 v[222:223], %[sm], v[164:165], v[222:223]\n\t" \
    "v_add_f32_dpp v226, v226, v226 quad_perm:[2,3,0,1] row_mask:0xf bank_mask:0xf bound_ctrl:1\n\t" \
    "ds_read_b128 v[156:159], %[a16] offset:6144\n\t" \
    "v_pk_mul_f32 v[224:225], v[166:167], v[174:175] op_sel:[0,1] op_sel_hi:[1,1]\n\t" \
    "v_add_f32_dpp v212, v211, v210 quad_perm:[1,0,3,2] row_mask:0xf bank_mask:0xf bound_ctrl:1\n\t" \
    "v_add_f32_dpp v226, v226, v226 row_ror:4 row_mask:0xf bank_mask:0xf bound_ctrl:1\n\t" \
    "v_pk_fma_f32 v[224:225], %[so], v[164:165], v[224:225]\n\t" \
    "ds_read_b64 v[160:161], %[a8] offset:5632\n\t" \
    "v_add_f32_dpp v226, v226, v226 row_ror:8 row_mask:0xf bank_mask:0xf bound_ctrl:1\n\t" \
    "v_mov_b32 v227, v226\n\t" \
    "ds_write_b32 %[ya], v212 offset:0\n\t" \
    "ds_read_b64 v[162:163], %[av] offset:5632\n\t" \
    "v_permlane16_swap_b32 v226, v227\n\t" \
    "s_waitcnt lgkmcnt(9)\n\t" \
    "v_add_f32 v216, v226, v227\n\t" \
    "v_pk_mul_f32 v[218:219], v[178:179], v[186:187] op_sel_hi:[1,0]\n\t" \
    "v_pk_fma_f32 %[sm], v[168:169], v[216:217], v[222:223] op_sel_hi:[1,0,1]\n\t" \
    "v_mov_b32_dpp v214, v216 quad_perm:[1,0,3,2] row_mask:0xf bank_mask:0xf\n\t" \
    "v_pk_mul_f32 v[200:201], %[sm], v[182:183]\n\t" \
    "v_pk_fma_f32 %[so], v[168:169], v[214:215], v[224:225] op_sel_hi:[1,0,1]\n\t" \
    "v_add_f32 v208, v200, v201\n\t" \
    "v_pk_mul_f32 v[202:203], %[so], v[182:183]\n\t" \
    "v_pk_mul_f32 v[204:205], %[sm], v[172:173]\n\t" \
    "v_add_f32 v209, v202, v203\n\t" \
    "v_pk_mul_f32 v[206:207], %[so], v[172:173]\n\t" \
    "v_add_f32 v210, v204, v205\n\t" \
    "v_add_f32_dpp v226, v209, v208 quad_perm:[1,0,3,2] row_mask:0xf bank_mask:0xf bound_ctrl:1\n\t" \
    "ds_read_b128 v[164:167], %[a16] offset:7040\n\t" \
    "v_add_f32 v211, v206, v207\n\t" \
    "v_pk_fma_f32 v[218:219], %[sm], v[176:177], v[218:219]\n\t" \
    "v_add_f32_dpp v226, v226, v226 quad_perm:[2,3,0,1] row_mask:0xf bank_mask:0xf bound_ctrl:1\n\t" \
    "ds_read_b128 v[168:171], %[a16] offset:7552\n\t" \
    "v_pk_mul_f32 v[220:221], v[178:179], v[186:187] op_sel:[0,1] op_sel_hi:[1,1]\n\t" \
    "v_add_f32_dpp v212, v211, v210 quad_perm:[1,0,3,2] row_mask:0xf bank_mask:0xf bound_ctrl:1\n\t" \
    "v_add_f32_dpp v226, v226, v226 row_ror:4 row_mask:0xf bank_mask:0xf bound_ctrl:1\n\t" \
    "v_pk_fma_f32 v[220:221], %[so], v[176:177], v[220:221]\n\t" \
    "ds_read_b64 v[172:173], %[a8] offset:7040\n\t" \
    "v_add_f32_dpp v226, v226, v226 row_ror:8 row_mask:0xf bank_mask:0xf bound_ctrl:1\n\t" \
    "v_mov_b32 v227, v226\n\t" \
    "ds_write_b32 %[ya], v212 offset:1024\n\t" \
    "ds_read_b64 v[174:175], %[av] offset:7040\n\t" \
    "v_permlane16_swap_b32 v226, v227\n\t" \
    "s_waitcnt lgkmcnt(10)\n\t" \
    "v_add_f32 v216, v226, v227\n\t" \
    "v_pk_mul_f32 v[222:223], v[190:191], v[198:199] op_sel_hi:[1,0]\n\t" \
    "v_pk_fma_f32 %[sm], v[180:181], v[216:217], v[218:219] op_sel_hi:[1,0,1]\n\t" \
    "v_mov_b32_dpp v214, v216 quad_perm:[1,0,3,2] row_mask:0xf bank_mask:0xf\n\t" \
    "v_pk_mul_f32 v[200:201], %[sm], v[194:195]\n\t" \
    "v_pk_fma_f32 %[so], v[180:181], v[214:215], v[220:221] op_sel_hi:[1,0,1]\n\t" \
    "v_add_f32 v208, v200, v201\n\t" \
    "v_pk_mul_f32 v[202:203], %[so], v[194:195]\n\t" \
    "v_pk_mul_f32 v[204:205], %[sm], v[184:185]\n\t" \
    "v_add_f32 v209, v202, v203\n\t" \
    "v_pk_mul_f32 v[206:207], %[so], v[184:185]\n\t" \
    "v_add_f32 v210, v204, v205\n\t" \
    "v_add_f32_dpp v226, v209, v208 quad_perm:[1,0,3,2] row_mask:0xf bank_mask:0xf bound_ctrl:1\n\t" \
    "ds_read_b128 v[176:179], %[a16] offset:8448\n\t" \
    "v_add_f32 v211, v206, v207\n\t" \
    "v_pk_fma_f32 v[222:223], %[sm], v[188:189], v[222:223]\n\t" \
    "v_add_f32_dpp v226, v226, v226 quad_perm:[2,3,0,1] row_mask:0xf bank_mask:0xf bound_ctrl:1\n\t" \
    "ds_read_b128 v[180:183], %[a16] offset:8960\n\t" \
    "v_pk_mul_f32 v[224:225], v[190:191], v[198:199] op_sel:[0,1] op_sel_hi:[1,1]\n\t" \
    "v_add_f32_dpp v212, v211, v210 quad_perm:[1,0,3,2] row_mask:0xf bank_mask:0xf bound_ctrl:1\n\t" \
    "v_add_f32_dpp v226, v226, v226 row_ror:4 row_mask:0xf bank_mask:0xf bound_ctrl:1\n\t" \
    "v_pk_fma_f32 v[224:225], %[so], v[188:189], v[224:225]\n\t" \
    "ds_read_b64 v[184:185], %[a8] offset:8448\n\t" \
    "v_add_f32_dpp v226, v226, v226 row_ror:8 row_mask:0xf bank_mask:0xf bound_ctrl:1\n\t" \
    "v_mov_b32 v227, v226\n\t" \
    "ds_write_b32 %[ya], v212 offset:2048\n\t" \
    "ds_read_b64 v[186:187], %[av] offset:8448\n\t" \
    "v_permlane16_swap_b32 v226, v227\n\t" \
    "s_waitcnt lgkmcnt(10)\n\t" \
    "v_add_f32 v216, v226, v227\n\t" \
    "v_pk_mul_f32 v[218:219], v[154:155], v[162:163] op_sel_hi:[1,0]\n\t" \
    "v_pk_fma_f32 %[sm], v[192:193], v[216:217], v[222:223] op_sel_hi:[1,0,1]\n\t" \
    "v_mov_b32_dpp v214, v216 quad_perm:[1,0,3,2] row_mask:0xf bank_mask:0xf\n\t" \
    "v_pk_mul_f32 v[200:201], %[sm], v[158:159]\n\t" \
    "v_pk_fma_f32 %[so], v[192:193], v[214:215], v[224:225] op_sel_hi:[1,0,1]\n\t" \
    "v_add_f32 v208, v200, v201\n\t" \
    "v_pk_mul_f32 v[202:203], %[so], v[158:159]\n\t" \
    "v_pk_mul_f32 v[204:205], %[sm], v[196:197]\n\t" \
    "v_add_f32 v209, v202, v203\n\t" \
    "v_pk_mul_f32 v[206:207], %[so], v[196:197]\n\t" \
    "v_add_f32 v210, v204, v205\n\t" \
    "v_add_f32_dpp v226, v209, v208 quad_perm:[1,0,3,2] row_mask:0xf bank_mask:0xf bound_ctrl:1\n\t" \
    "ds_read_b128 v[188:191], %[a16] offset:9856\n\t" \
    "v_add_f32 v211, v206, v207\n\t" \
    "v_pk_fma_f32 v[218:219], %[sm], v[152:153], v[218:219]\n\t" \
    "v_add_f32_dpp v226, v226, v226 quad_perm:[2,3,0,1] row_mask:0xf bank_mask:0xf bound_ctrl:1\n\t" \
    "ds_read_b128 v[192:195], %[a16] offset:10368\n\t" \
    "v_pk_mul_f32 v[220:221], v[154:155], v[162:163] op_sel:[0,1] op_sel_hi:[1,1]\n\t" \
    "v_add_f32_dpp v212, v211, v210 quad_perm:[1,0,3,2] row_mask:0xf bank_mask:0xf bound_ctrl:1\n\t" \
    "v_add_f32_dpp v226, v226, v226 row_ror:4 row_mask:0xf bank_mask:0xf bound_ctrl:1\n\t" \
    "v_pk_fma_f32 v[220:221], %[so], v[152:153], v[220:221]\n\t" \
    "ds_read_b64 v[196:197], %[a8] offset:9856\n\t" \
    "v_add_f32_dpp v226, v226, v226 row_ror:8 row_mask:0xf bank_mask:0xf bound_ctrl:1\n\t" \
    "v_mov_b32 v227, v226\n\t" \
    "ds_write_b32 %[ya], v212 offset:3072\n\t" \
    "ds_read_b64 v[198:199], %[av] offset:9856\n\t" \
    "v_permlane16_swap_b32 v226, v227\n\t" \
    "s_waitcnt lgkmcnt(10)\n\t" \
    "v_add_f32 v216, v226, v227\n\t" \
    "v_pk_mul_f32 v[222:223], v[166:167], v[174:175] op_sel_hi:[1,0]\n\t" \
    "v_pk_fma_f32 %[sm], v[156:157], v[216:217], v[218:219] op_sel_hi:[1,0,1]\n\t" \
    "v_mov_b32_dpp v214, v216 quad_perm:[1,0,3,2] row_mask:0xf bank_mask:0xf\n\t" \
    "v_pk_mul_f32 v[200:201], %[sm], v[170:171]\n\t" \
    "v_pk_fma_f32 %[so], v[156:157], v[214:215], v[220:221] op_sel_hi:[1,0,1]\n\t" \
    "v_add_f32 v208, v200, v201\n\t" \
    "v_pk_mul_f32 v[202:203], %[so], v[170:171]\n\t" \
    "v_pk_mul_f32 v[204:205], %[sm], v[160:161]\n\t" \
    "v_add_f32 v209, v202, v203\n\t" \
    "v_pk_mul_f32 v[206:207], %[so], v[160:161]\n\t" \
    "v_add_f32 v210, v204, v205\n\t" \
    "v_add_f32_dpp v226, v209, v208 quad_perm:[1,0,3,2] row_mask:0xf bank_mask:0xf bound_ctrl:1\n\t" \
    "ds_read_b128 v[152:155], %[a16] offset:11264\n\t" \
    "v_add_f32 v211, v206, v207\n\t" \
    "v_pk_fma_f32 v[222:223], %[sm], v[164:165], v[222:223]\n\t" \
    "v_add_f32_dpp v226, v226, v226 quad_perm:[2,3,0,1] row_mask:0xf bank_mask:0xf bound_ctrl:1\n\t" \
    "ds_read_b128 v[156:159], %[a16] offset:11776\n\t" \
    "v_pk_mul_f32 v[224:225], v[166:167], v[174:175] op_sel:[0,1] op_sel_hi:[1,1]\n\t" \
    "v_add_f32_dpp v212, v211, v210 quad_perm:[1,0,3,2] row_mask:0xf bank_mask:0xf bound_ctrl:1\n\t" \
    "v_add_f32_dpp v226, v226, v226 row_ror:4 row_mask:0xf bank_mask:0xf bound_ctrl:1\n\t" \
    "v_pk_fma_f32 v[224:225], %[so], v[164:165], v[224:225]\n\t" \
    "ds_read_b64 v[160:161], %[a8] offset:11264\n\t" \
    "v_add_f32_dpp v226, v226, v226 row_ror:8 row_mask:0xf bank_mask:0xf bound_ctrl:1\n\t" \
    "v_mov_b32 v227, v226\n\t" \
    "ds_write_b32 %[ya], v212 offset:4096\n\t" \
    "ds_read_b64 v[162:163], %[av] offset:11264\n\t" \
    "v_permlane16_swap_b32 v226, v227\n\t" \
    "s_waitcnt lgkmcnt(10)\n\t" \
    "v_add_f32 v216, v226, v227\n\t" \
    "v_pk_mul_f32 v[218:219], v[178:179], v[186:187] op_sel_hi:[1,0]\n\t" \
    "v_pk_fma_f32 %[sm], v[168:169], v[216:217], v[222:223] op_sel_hi:[1,0,1]\n\t" \
    "v_mov_b32_dpp v214, v216 quad_perm:[1,0,3,2] row_mask:0xf bank_mask:0xf\n\t" \
    "v_pk_mul_f32 v[200:201], %[sm], v[182:183]\n\t" \
    "v_pk_fma_f32 %[so], v[168:169], v[214:215], v[224:225] op_sel_hi:[1,0,1]\n\t" \
    "v_add_f32 v208, v200, v201\n\t" \
    "v_pk_mul_f32 v[202:203], %[so], v[182:183]\n\t" \
    "v_pk_mul_f32 v[204:205], %[sm], v[172:173]\n\t" \
    "v_add_f32 v209, v202, v203\n\t" \
    "v_pk_mul_f32 v[206:207], %[so], v[172:173]\n\t" \
    "v_add_f32 v210, v204, v205\n\t" \
    "v_add_f32_dpp v226, v209, v208 quad_perm:[1,0,3,2] row_mask:0xf bank_mask:0xf bound_ctrl:1\n\t" \
    "ds_read_b128 v[164:167], %[a16] offset:12672\n\t" \
    "v_add_f32 v211, v206, v207\n\t" \
    "v_pk_fma_f32 v[218:219], %[sm], v[176:177], v[218:219]\n\t" \
    "v_add_f32_dpp v226, v226, v226 quad_perm:[2,3,0,1] row_mask:0xf bank_mask:0xf bound_ctrl:1\n\t" \
    "ds_read_b128 v[168:171], %[a16] offset:13184\n\t" \
    "v_pk_mul_f32 v[220:221], v[178:179], v[186:187] op_sel:[0,1] op_sel_hi:[1,1]\n\t" \
    "v_add_f32_dpp v212, v211, v210 quad_perm:[1,0,3,2] row_mask:0xf bank_mask:0xf bound_ctrl:1\n\t" \
    "v_add_f32_dpp v226, v226, v226 row_ror:4 row_mask:0xf bank_mask:0xf bound_ctrl:1\n\t" \
    "v_pk_fma_f32 v[220:221], %[so], v[176:177], v[220:221]\n\t" \
    "ds_read_b64 v[172:173], %[a8] offset:12672\n\t" \
    "v_add_f32_dpp v226, v226, v226 row_ror:8 row_mask:0xf bank_mask:0xf bound_ctrl:1\n\t" \
    "v_mov_b32 v227, v226\n\t" \
    "ds_write_b32 %[ya], v212 offset:5120\n\t" \
    "ds_read_b64 v[174:175], %[av] offset:12672\n\t" \
    "v_permlane16_swap_b32 v226, v227\n\t" \
    "s_waitcnt lgkmcnt(10)\n\t" \
    "v_add_f32 v216, v226, v227\n\t" \
    "v_pk_mul_f32 v[222:223], v[190:191], v[198:199] op_sel_hi:[1,0]\n\t" \
    "v_pk_fma_f32 %[sm], v[180:181], v[216:217], v[218:219] op_sel_hi:[1,0,1]\n\t" \
    "v_mov_b32_dpp v214, v216 quad_perm:[1,0,3,2] row_mask:0xf bank_mask:0xf\n\t" \
    "v_pk_mul_f32 v[200:201], %[sm], v[194:195]\n\t" \
    "v_pk_fma_f32 %[so], v[180:181], v[214:215], v[220:221] op_sel_hi:[1,0,1]\n\t" \
    "v_add_f32 v208, v200, v201\n\t" \
    "v_pk_mul_f32 v[202:203], %[so], v[194:195]\n\t" \
    "v_pk_mul_f32 v[204:205], %[sm], v[184:185]\n\t" \
    "v_add_f32 v209, v202, v203\n\t" \
    "v_pk_mul_f32 v[206:207], %[so], v[184:185]\n\t" \
    "v_add_f32 v210, v204, v205\n\t" \
    "v_add_f32_dpp v226, v209, v208 quad_perm:[1,0,3,2] row_mask:0xf bank_mask:0xf bound_ctrl:1\n\t" \
    "ds_read_b128 v[176:179], %[a16] offset:14080\n\t" \
    "v_add_f32 v211, v206, v207\n\t" \
    "v_pk_fma_f32 v[222:223], %[sm], v[188:189], v[222:223]\n\t" \
    "v_add_f32_dpp v226, v226, v226 quad_perm:[2,3,0,1] row_mask:0xf bank_mask:0xf bound_ctrl:1\n\t" \
    "ds_read_b128 v[180:183], %[a16] offset:14592\n\t" \
    "v_pk_mul_f32 v[224:225], v[190:191], v[198:199] op_sel:[0,1] op_sel_hi:[1,1]\n\t" \
    "v_add_f32_dpp v212, v211, v210 quad_perm:[1,0,3,2] row_mask:0xf bank_mask:0xf bound_ctrl:1\n\t" \
    "v_add_f32_dpp v226, v226, v226 row_ror:4 row_mask:0xf bank_mask:0xf bound_ctrl:1\n\t" \
    "v_pk_fma_f32 v[224:225], %[so], v[188:189], v[224:225]\n\t" \
    "ds_read_b64 v[184:185], %[a8] offset:14080\n\t" \
    "v_add_f32_dpp v226, v226, v226 row_ror:8 row_mask:0xf bank_mask:0xf bound_ctrl:1\n\t" \
    "v_mov_b32 v227, v226\n\t" \
    "ds_write_b32 %[ya], v212 offset:6144\n\t" \
    "ds_read_b64 v[186:187], %[av] offset:14080\n\t" \
    "v_permlane16_swap_b32 v226, v227\n\t" \
    "s_waitcnt lgkmcnt(10)\n\t" \
    "v_add_f32 v216, v226, v227\n\t" \
    "v_pk_mul_f32 v[218:219], v[154:155], v[162:163] op_sel_hi:[1,0]\n\t" \
    "v_pk_fma_f32 %[sm], v[192:193], v[216:217], v[222:223] op_sel_hi:[1,0,1]\n\t" \
    "v_mov_b32_dpp v214, v216 quad_perm:[1,0,3,2] row_mask:0xf bank_mask:0xf\n\t" \
    "v_pk_mul_f32 v[200:201], %[sm], v[158:159]\n\t" \
    "v_pk_fma_f32 %[so], v[192:193], v[214:215], v[224:225] op_sel_hi:[1,0,1]\n\t" \
    "v_add_f32 v208, v200, v201\n\t" \
    "v_pk_mul_f32 v[202:203], %[so], v[158:159]\n\t" \
    "v_pk_mul_f32 v[204:205], %[sm], v[196:197]\n\t" \
    "v_add_f32 v209, v202, v203\n\t" \
    "v_pk_mul_f32 v[206:207], %[so], v[196:197]\n\t" \
    "v_add_f32 v210, v204, v205\n\t" \
    "v_add_f32_dpp v226, v209, v208 quad_perm:[1,0,3,2] row_mask:0xf bank_mask:0xf bound_ctrl:1\n\t" \
    "ds_read_b128 v[188:191], %[a16] offset:15488\n\t" \
    "v_add_f32 v211, v206, v207\n\t" \
    "v_pk_fma_f32 v[218:219], %[sm], v[152:153], v[218:219]\n\t" \
    "v_add_f32_dpp v226, v226, v226 quad_perm:[2,3,0,1] row_mask:0xf bank_mask:0xf bound_ctrl:1\n\t" \
    "ds_read_b128 v[192:195], %[a16] offset:16000\n\t" \
    "v_pk_mul_f32 v[220:221], v[154:155], v[162:163] op_sel:[0,1] op_sel_hi:[1,1]\n\t" \
    "v_add_f32_dpp v212, v211, v210 quad_perm:[1,0,3,2] row_mask:0xf bank_mask:0xf bound_ctrl:1\n\t" \
    "v_add_f32_dpp v226, v226, v226 row_ror:4 row_mask:0xf bank_mask:0xf bound_ctrl:1\n\t" \
    "v_pk_fma_f32 v[220:221], %[so], v[152:153], v[220:221]\n\t" \
    "ds_read_b64 v[196:197], %[a8] offset:15488\n\t" \
    "v_add_f32_dpp v226, v226, v226 row_ror:8 row_mask:0xf bank_mask:0xf bound_ctrl:1\n\t" \
    "v_mov_b32 v227, v226\n\t" \
    "ds_write_b32 %[ya], v212 offset:7168\n\t" \
    "ds_read_b64 v[198:199], %[av] offset:15488\n\t" \
    "v_permlane16_swap_b32 v226, v227\n\t" \
    "s_waitcnt lgkmcnt(10)\n\t" \
    "v_add_f32 v216, v226, v227\n\t" \
    "v_pk_mul_f32 v[222:223], v[166:167], v[174:175] op_sel_hi:[1,0]\n\t" \
    "v_pk_fma_f32 %[sm], v[156:157], v[216:217], v[218:219] op_sel_hi:[1,0,1]\n\t" \
    "v_mov_b32_dpp v214, v216 quad_perm:[1,0,3,2] row_mask:0xf bank_mask:0xf\n\t" \
    "v_pk_mul_f32 v[200:201], %[sm], v[170:171]\n\t" \
    "v_pk_fma_f32 %[so], v[156:157], v[214:215], v[220:221] op_sel_hi:[1,0,1]\n\t" \
    "v_add_f32 v208, v200, v201\n\t" \
    "v_pk_mul_f32 v[202:203], %[so], v[170:171]\n\t" \
    "v_pk_mul_f32 v[204:205], %[sm], v[160:161]\n\t" \
    "v_add_f32 v209, v202, v203\n\t" \
    "v_pk_mul_f32 v[206:207], %[so], v[160:161]\n\t" \
    "v_add_f32 v210, v204, v205\n\t" \
    "v_add_f32_dpp v226, v209, v208 quad_perm:[1,0,3,2] row_mask:0xf bank_mask:0xf bound_ctrl:1\n\t" \
    "ds_read_b128 v[152:155], %[a16] offset:16896\n\t" \
    "v_add_f32 v211, v206, v207\n\t" \
    "v_pk_fma_f32 v[222:223], %[sm], v[164:165], v[222:223]\n\t" \
    "v_add_f32_dpp v226, v226, v226 quad_perm:[2,3,0,1] row_mask:0xf bank_mask:0xf bound_ctrl:1\n\t" \
    "ds_read_b128 v[156:159], %[a16] offset:17408\n\t" \
    "v_pk_mul_f32 v[224:225], v[166:167], v[174:175] op_sel:[0,1] op_sel_hi:[1,1]\n\t" \
    "v_add_f32_dpp v212, v211, v210 quad_perm:[1,0,3,2] row_mask:0xf bank_mask:0xf bound_ctrl:1\n\t" \
    "v_add_f32_dpp v226, v226, v226 row_ror:4 row_mask:0xf bank_mask:0xf bound_ctrl:1\n\t" \
    "v_pk_fma_f32 v[224:225], %[so], v[164:165], v[224:225]\n\t" \
    "ds_read_b64 v[160:161], %[a8] offset:16896\n\t" \
    "v_add_f32_dpp v226, v226, v226 row_ror:8 row_mask:0xf bank_mask:0xf bound_ctrl:1\n\t" \
    "v_mov_b32 v227, v226\n\t" \
    "ds_write_b32 %[ya], v212 offset:8192\n\t" \
    "ds_read_b64 v[162:163], %[av] offset:16896\n\t" \
    "v_permlane16_swap_b32 v226, v227\n\t" \
    "s_waitcnt lgkmcnt(10)\n\t" \
    "v_add_f32 v216, v226, v227\n\t" \
    "v_pk_mul_f32 v[218:219], v[178:179], v[186:187] op_sel_hi:[1,0]\n\t" \
    "v_pk_fma_f32 %[sm], v[168:169], v[216:217], v[222:223] op_sel_hi:[1,0,1]\n\t" \
    "v_mov_b32_dpp v214, v216 quad_perm:[1,0,3,2] row_mask:0xf bank_mask:0xf\n\t" \
    "v_pk_mul_f32 v[200:201], %[sm], v[182:183]\n\t" \
    "v_pk_fma_f32 %[so], v[168:169], v[214:215], v[224:225] op_sel_hi:[1,0,1]\n\t" \
    "v_add_f32 v208, v200, v201\n\t" \
    "v_pk_mul_f32 v[202:203], %[so], v[182:183]\n\t" \
    "v_pk_mul_f32 v[204:205], %[sm], v[172:173]\n\t" \
    "v_add_f32 v209, v202, v203\n\t" \
    "v_pk_mul_f32 v[206:207], %[so], v[172:173]\n\t" \
    "v_add_f32 v210, v204, v205\n\t" \
    "v_add_f32_dpp v226, v209, v208 quad_perm:[1,0,3,2] row_mask:0xf bank_mask:0xf bound_ctrl:1\n\t" \
    "ds_read_b128 v[164:167], %[a16] offset:18304\n\t" \
    "v_add_f32 v211, v206, v207\n\t" \
    "v_pk_fma_f32 v[218:219], %[sm], v[176:177], v[218:219]\n\t" \
    "v_add_f32_dpp v226, v226, v226 quad_perm:[2,3,0,1] row_mask:0xf bank_mask:0xf bound_ctrl:1\n\t" \
    "ds_read_b128 v[168:171], %[a16] offset:18816\n\t" \
    "v_pk_mul_f32 v[220:221], v[178:179], v[186:187] op_sel:[0,1] op_sel_hi:[1,1]\n\t" \
    "v_add_f32_dpp v212, v211, v210 quad_perm:[1,0,3,2] row_mask:0xf bank_mask:0xf bound_ctrl:1\n\t" \
    "v_add_f32_dpp v226, v226, v226 row_ror:4 row_mask:0xf bank_mask:0xf bound_ctrl:1\n\t" \
    "v_pk_fma_f32 v[220:221], %[so], v[176:177], v[220:221]\n\t" \
    "ds_read_b64 v[172:173], %[a8] offset:18304\n\t" \
    "v_add_f32_dpp v226, v226, v226 row_ror:8 row_mask:0xf bank_mask:0xf bound_ctrl:1\n\t" \
    "v_mov_b32 v227, v226\n\t" \
    "ds_write_b32 %[ya], v212 offset:9216\n\t" \
    "ds_read_b64 v[174:175], %[av] offset:18304\n\t" \
    "v_permlane16_swap_b32 v226, v227\n\t" \
    "s_waitcnt lgkmcnt(10)\n\t" \
    "v_add_f32 v216, v226, v227\n\t" \
    "v_pk_mul_f32 v[222:223], v[190:191], v[198:199] op_sel_hi:[1,0]\n\t" \
    "v_pk_fma_f32 %[sm], v[180:181], v[216:217], v[218:219] op_sel_hi:[1,0,1]\n\t" \
    "v_mov_b32_dpp v214, v216 quad_perm:[1,0,3,2] row_mask:0xf bank_mask:0xf\n\t" \
    "v_pk_mul_f32 v[200:201], %[sm], v[194:195]\n\t" \
    "v_pk_fma_f32 %[so], v[180:181], v[214:215], v[220:221] op_sel_hi:[1,0,1]\n\t" \
    "v_add_f32 v208, v200, v201\n\t" \
    "v_pk_mul_f32 v[202:203], %[so], v[194:195]\n\t" \
    "v_pk_mul_f32 v[204:205], %[sm], v[184:185]\n\t" \
    "v_add_f32 v209, v202, v203\n\t" \
    "v_pk_mul_f32 v[206:207], %[so], v[184:185]\n\t" \
    "v_add_f32 v210, v204, v205\n\t" \
    "v_add_f32_dpp v226, v209, v208 quad_perm:[1,0,3,2] row_mask:0xf bank_mask:0xf bound_ctrl:1\n\t" \
    "ds_read_b128 v[176:179], %[a16] offset:19712\n\t" \
    "v_add_f32 v211, v206, v207\n\t" \
    "v_pk_fma_f32 v[222:223], %[sm], v[188:189], v[222:223]\n\t" \
    "v_add_f32_dpp v226, v226, v226 quad_perm:[2,3,0,1] row_mask:0xf bank_mask:0xf bound_ctrl:1\n\t" \
    "ds_read_b128 v[180:183], %[a16] offset:20224\n\t" \
    "v_pk_mul_f32 v[224:225], v[190:191], v[198:199] op_sel:[0,1] op_sel_hi:[1,1]\n\t" \
    "v_add_f32_dpp v212, v211, v210 quad_perm:[1,0,3,2] row_mask:0xf bank_mask:0xf bound_ctrl:1\n\t" \
    "v_add_f32_dpp v226, v226, v226 row_ror:4 row_mask:0xf bank_mask:0xf bound_ctrl:1\n\t" \
    "v_pk_fma_f32 v[224:225], %[so], v[188:189], v[224:225]\n\t" \
    "ds_read_b64 v[184:185], %[a8] offset:19712\n\t" \
    "v_add_f32_dpp v226, v226, v226 row_ror:8 row_mask:0xf bank_mask:0xf bound_ctrl:1\n\t" \
    "v_mov_b32 v227, v226\n\t" \
    "ds_write_b32 %[ya], v212 offset:10240\n\t" \
    "ds_read_b64 v[186:187], %[av] offset:19712\n\t" \
    "v_permlane16_swap_b32 v226, v227\n\t" \
    "s_waitcnt lgkmcnt(10)\n\t" \
    "v_add_f32 v216, v226, v227\n\t" \
    "v_pk_mul_f32 v[218:219], v[154:155], v[162:163] op_sel_hi:[1,0]\n\t" \
    "v_pk_fma_f32 %[sm], v[192:193], v[216:217], v[222:223] op_sel_hi:[1,0,1]\n\t" \
    "v_mov_b32_dpp v214, v216 quad_perm:[1,0,3,2] row_mask:0xf bank_mask:0xf\n\t" \
    "v_pk_mul_f32 v[200:201], %[sm], v[158:159]\n\t" \
    "v_pk_fma_f32 %[so], v[192:193], v[214:215], v[224:225] op_sel_hi:[1,0,1]\n\t" \
    "v_add_f32 v208, v200, v201\n\t" \
    "v_pk_mul_f32 v[202:203], %[so], v[158:159]\n\t" \
    "v_pk_mul_f32 v[204:205], %[sm], v[196:197]\n\t" \
    "v_add_f32 v209, v202, v203\n\t" \
    "v_pk_mul_f32 v[206:207], %[so], v[196:197]\n\t" \
    "v_add_f32 v210, v204, v205\n\t" \
    "v_add_f32_dpp v226, v209, v208 quad_perm:[1,0,3,2] row_mask:0xf bank_mask:0xf bound_ctrl:1\n\t" \
    "ds_read_b128 v[188:191], %[a16] offset:21120\n\t" \
    "v_add_f32 v211, v206, v207\n\t" \
    "v_pk_fma_f32 v[218:219], %[sm], v[152:153], v[218:219]\n\t" \
    "v_add_f32_dpp v226, v226, v226 quad_perm:[2,3,0,1] row_mask:0xf bank_mask:0xf bound_ctrl:1\n\t" \
    "ds_read_b128 v[192:195], %[a16] offset:21632\n\t" \
    "v_pk_mul_f32 v[220:221], v[154:155], v[162:163] op_sel:[0,1] op_sel_hi:[1,1]\n\t" \
    "v_add_f32_dpp v212, v211, v210 quad_perm:[1,0,3,2] row_mask:0xf bank_mask:0xf bound_ctrl:1\n\t" \
    "v_add_f32_dpp v226, v226, v226 row_ror:4 row_mask:0xf bank_mask:0xf bound_ctrl:1\n\t" \
    "v_pk_fma_f32 v[220:221], %[so], v[152:153], v[220:221]\n\t" \
    "ds_read_b64 v[196:197], %[a8] offset:21120\n\t" \
    "v_add_f32_dpp v226, v226, v226 row_ror:8 row_mask:0xf bank_mask:0xf bound_ctrl:1\n\t" \
    "v_mov_b32 v227, v226\n\t" \
    "ds_write_b32 %[ya], v212 offset:11264\n\t" \
    "ds_read_b64 v[198:199], %[av] offset:21120\n\t" \
    "v_permlane16_swap_b32 v226, v227\n\t" \
    "s_waitcnt lgkmcnt(10)\n\t" \
    "v_add_f32 v216, v226, v227\n\t" \
    "v_pk_mul_f32 v[222:223], v[166:167], v[174:175] op_sel_hi:[1,0]\n\t" \
    "v_pk_fma_f32 %[sm], v[156:157], v[216:217], v[218:219] op_sel_hi:[1,0,1]\n\t" \
    "v_mov_b32_dpp v214, v216 quad_perm:[1,0,3,2] row_mask:0xf bank_mask:0xf\n\t" \
    "v_pk_mul_f32 v[200:201], %[sm], v[170:171]\n\t" \
    "v_pk_fma_f32 %[so], v[156:157], v[214:215], v[220:221] op_sel_hi:[1,0,1]\n\t" \
    "v_add_f32 v208, v200, v201\n\t" \
    "v_pk_mul_f32 v[202:203], %[so], v[170:171]\n\t" \
    "v_pk_mul_f32 v[204:205], %[sm], v[160:161]\n\t" \
    "v_add_f32 v209, v202, v203\n\t" \
    "v_pk_mul_f32 v[206:207], %[so], v[160:161]\n\t" \
    "v_add_f32 v210, v204, v205\n\t" \
    "v_add_f32_dpp v226, v209, v208 quad_perm:[1,0,3,2] row_mask:0xf bank_mask:0xf bound_ctrl:1\n\t" \
    "ds_read_b128 v[152:155], %[a16] offset:22528\n\t" \
    "v_add_f32 v211, v206, v207\n\t" \
    "v_pk_fma_f32 v[222:223], %[sm], v[164:165], v[222:223]\n\t" \
    "v_add_f32_dpp v226, v226, v226 quad_perm:[2,3,0,1] row_mask:0xf bank_mask:0xf bound_ctrl:1\n\t" \
    "ds_read_b128 v[156:159], %[a16] offset:23040\n\t" \
    "v_pk_mul_f32 v[224:225], v[166:167], v[174:175] op_sel:[0,1] op_sel_hi:[1,1]\n\t" \
    "v_add_f32_dpp v212, v211, v210 quad_perm:[1,0,3,2] row_mask:0xf bank_mask:0xf bound_ctrl:1\n\t" \
    "v_add_f32_dpp v226, v226, v226 row_ror:4 row_mask:0xf bank_mask:0xf bound_ctrl:1\n\t" \
    "v_pk_fma_f32 v[224:225], %[so], v[164:165], v[224:225]\n\t" \
    "ds_read_b64 v[160:161], %[a8] offset:22528\n\t" \
    "v_add_f32_dpp v226, v226, v226 row_ror:8 row_mask:0xf bank_mask:0xf bound_ctrl:1\n\t" \
    "v_mov_b32 v227, v226\n\t" \
    "ds_write_b32 %[ya], v212 offset:12288\n\t" \
    "ds_read_b64 v[162:163], %[av] offset:22528\n\t" \
    "v_permlane16_swap_b32 v226, v227\n\t" \
    "s_waitcnt lgkmcnt(10)\n\t" \
    "v_add_f32 v216, v226, v227\n\t" \
    "v_pk_mul_f32 v[218:219], v[178:179], v[186:187] op_sel_hi:[1,0]\n\t" \
    "v_pk_fma_f32 %[sm], v[168:169], v[216:217], v[222:223] op_sel_hi:[1,0,1]\n\t" \
    "v_mov_b32_dpp v214, v216 quad_perm:[1,0,3,2] row_mask:0xf bank_mask:0xf\n\t" \
    "v_pk_mul_f32 v[200:201], %[sm], v[182:183]\n\t" \
    "v_pk_fma_f32 %[so], v[168:169], v[214:215], v[224:225] op_sel_hi:[1,0,1]\n\t" \
    "v_add_f32 v208, v200, v201\n\t" \
    "v_pk_mul_f32 v[202:203], %[so], v[182:183]\n\t" \
    "v_pk_mul_f32 v[204:205], %[sm], v[172:173]\n\t" \
    "v_add_f32 v209, v202, v203\n\t" \
    "v_pk_mul_f32 v[206:207], %[so], v[172:173]\n\t" \
    "v_add_f32 v210, v204, v205\n\t" \
    "v_add_f32_dpp v226, v209, v208 quad_perm:[1,0,3,2] row_mask:0xf bank_mask:0xf bound_ctrl:1\n\t" \
    "ds_read_b128 v[164:167], %[a16] offset:23936\n\t" \
    "v_add_f32 v211, v206, v207\n\t" \
    "v_pk_fma_f32 v[218:219], %[sm], v[176:177], v[218:219]\n\t" \
    "v_add_f32_dpp v226, v226, v226 quad_perm:[2,3,0,1] row_mask:0xf bank_mask:0xf bound_ctrl:1\n\t" \
    "ds_read_b128 v[168:171], %[a16] offset:24448\n\t" \
    "v_pk_mul_f32 v[220:221], v[178:179], v[186:187] op_sel:[0,1] op_sel_hi:[1,1]\n\t" \
    "v_add_f32_dpp v212, v211, v210 quad_perm:[1,0,3,2] row_mask:0xf bank_mask:0xf bound_ctrl:1\n\t" \
    "v_add_f32_dpp v226, v226, v226 row_ror:4 row_mask:0xf bank_mask:0xf bound_ctrl:1\n\t" \
    "v_pk_fma_f32 v[220:221], %[so], v[176:177], v[220:221]\n\t" \
    "ds_read_b64 v[172:173], %[a8] offset:23936\n\t" \
    "v_add_f32_dpp v226, v226, v226 row_ror:8 row_mask:0xf bank_mask:0xf bound_ctrl:1\n\t" \
    "v_mov_b32 v227, v226\n\t" \
    "ds_write_b32 %[ya], v212 offset:13312\n\t" \
    "ds_read_b64 v[174:175], %[av] offset:23936\n\t" \
    "v_permlane16_swap_b32 v226, v227\n\t" \
    "s_waitcnt lgkmcnt(10)\n\t" \
    "v_add_f32 v216, v226, v227\n\t" \
    "v_pk_mul_f32 v[222:223], v[190:191], v[198:199] op_sel_hi:[1,0]\n\t" \
    "v_pk_fma_f32 %[sm], v[180:181], v[216:217], v[218:219] op_sel_hi:[1,0,1]\n\t" \
    "v_mov_b32_dpp v214, v216 quad_perm:[1,0,3,2] row_mask:0xf bank_mask:0xf\n\t" \
    "v_pk_mul_f32 v[200:201], %[sm], v[194:195]\n\t" \
    "v_pk_fma_f32 %[so], v[180:181], v[214:215], v[220:221] op_sel_hi:[1,0,1]\n\t" \
    "v_add_f32 v208, v200, v201\n\t" \
    "v_pk_mul_f32 v[202:203], %[so], v[194:195]\n\t" \
    "v_pk_mul_f32 v[204:205], %[sm], v[184:185]\n\t" \
    "v_add_f32 v209, v202, v203\n\t" \
    "v_pk_mul_f32 v[206:207], %[so], v[184:185]\n\t" \
    "v_add_f32 v210, v204, v205\n\t" \
    "v_add_f32_dpp v226, v209, v208 quad_perm:[1,0,3,2] row_mask:0xf bank_mask:0xf bound_ctrl:1\n\t" \
    "ds_read_b128 v[176:179], %[a16] offset:25344\n\t" \
    "v_add_f32 v211, v206, v207\n\t" \
    "v_pk_fma_f32 v[222:223], %[sm], v[188:189], v[222:223]\n\t" \
    "v_add_f32_dpp v226, v226, v226 quad_perm:[2,3,0,1] row_mask:0xf bank_mask:0xf bound_ctrl:1\n\t" \
    "ds_read_b128 v[180:183], %[a16] offset:25856\n\t" \
    "v_pk_mul_f32 v[224:225], v[190:191], v[198:199] op_sel:[0,1] op_sel_hi:[1,1]\n\t" \
    "v_add_f32_dpp v212, v211, v210 quad_perm:[1,0,3,2] row_mask:0xf bank_mask:0xf bound_ctrl:1\n\t" \
    "v_add_f32_dpp v226, v226, v226 row_ror:4 row_mask:0xf bank_mask:0xf bound_ctrl:1\n\t" \
    "v_pk_fma_f32 v[224:225], %[so], v[188:189], v[224:225]\n\t" \
    "ds_read_b64 v[184:185], %[a8] offset:25344\n\t" \
    "v_add_f32_dpp v226, v226, v226 row_ror:8 row_mask:0xf bank_mask:0xf bound_ctrl:1\n\t" \
    "v_mov_b32 v227, v226\n\t" \
    "ds_write_b32 %[ya], v212 offset:14336\n\t" \
    "ds_read_b64 v[186:187], %[av] offset:25344\n\t" \
    "v_permlane16_swap_b32 v226, v227\n\t" \
    "s_waitcnt lgkmcnt(10)\n\t" \
    "v_add_f32 v216, v226, v227\n\t" \
    "v_pk_mul_f32 v[218:219], v[154:155], v[162:163] op_sel_hi:[1,0]\n\t" \
    "v_pk_fma_f32 %[sm], v[192:193], v[216:217], v[222:223] op_sel_hi:[1,0,1]\n\t" \
    "v_mov_b32_dpp v214, v216 quad_perm:[1,0,3,2] row_mask:0xf bank_mask:0xf\n\t" \
    "v_pk_mul_f32 v[200:201], %[sm], v[158:159]\n\t" \
    "v_pk_fma_f32 %[so], v[192:193], v[214:215], v[224:225] op_sel_hi:[1,0,1]\n\t" \
    "v_add_f32 v208, v200, v201\n\t" \
    "v_pk_mul_f32 v[202:203], %[so], v[158:159]\n\t" \
    "v_pk_mul_f32 v[204:205], %[sm], v[196:197]\n\t" \
    "v_add_f32 v209, v202, v203\n\t" \
    "v_pk_mul_f32 v[206:207], %[so], v[196:197]\n\t" \
    "v_add_f32 v210, v204, v205\n\t" \
    "v_add_f32_dpp v226, v209, v208 quad_perm:[1,0,3,2] row_mask:0xf bank_mask:0xf bound_ctrl:1\n\t" \
    "ds_read_b128 v[188:191], %[a16] offset:26752\n\t" \
    "v_add_f32 v211, v206, v207\n\t" \
    "v_pk_fma_f32 v[218:219], %[sm], v[152:153], v[218:219]\n\t" \
    "v_add_f32_dpp v226, v226, v226 quad_perm:[2,3,0,1] row_mask:0xf bank_mask:0xf bound_ctrl:1\n\t" \
    "ds_read_b128 v[192:195], %[a16] offset:27264\n\t" \
    "v_pk_mul_f32 v[220:221], v[154:155], v[162:163] op_sel:[0,1] op_sel_hi:[1,1]\n\t" \
    "v_add_f32_dpp v212, v211, v210 quad_perm:[1,0,3,2] row_mask:0xf bank_mask:0xf bound_ctrl:1\n\t" \
    "v_add_f32_dpp v226, v226, v226 row_ror:4 row_mask:0xf bank_mask:0xf bound_ctrl:1\n\t" \
    "v_pk_fma_f32 v[220:221], %[so], v[152:153], v[220:221]\n\t" \
    "ds_read_b64 v[196:197], %[a8] offset:26752\n\t" \
    "v_add_f32_dpp v226, v226, v226 row_ror:8 row_mask:0xf bank_mask:0xf bound_ctrl:1\n\t" \
    "v_mov_b32 v227, v226\n\t" \
    "ds_write_b32 %[ya], v212 offset:15360\n\t" \
    "ds_read_b64 v[198:199], %[av] offset:26752\n\t" \
    "v_permlane16_swap_b32 v226, v227\n\t" \
    "s_waitcnt lgkmcnt(10)\n\t" \
    "v_add_f32 v216, v226, v227\n\t" \
    "v_pk_mul_f32 v[222:223], v[166:167], v[174:175] op_sel_hi:[1,0]\n\t" \
    "v_pk_fma_f32 %[sm], v[156:157], v[216:217], v[218:219] op_sel_hi:[1,0,1]\n\t" \
    "v_mov_b32_dpp v214, v216 quad_perm:[1,0,3,2] row_mask:0xf bank_mask:0xf\n\t" \
    "v_pk_mul_f32 v[200:201], %[sm], v[170:171]\n\t" \
    "v_pk_fma_f32 %[so], v[156:157], v[214:215], v[220:221] op_sel_hi:[1,0,1]\n\t" \
    "v_add_f32 v208, v200, v201\n\t" \
    "v_pk_mul_f32 v[202:203], %[so], v[170:171]\n\t" \
    "v_pk_mul_f32 v[204:205], %[sm], v[160:161]\n\t" \
    "v_add_f32 v209, v202, v203\n\t" \
    "v_pk_mul_f32 v[206:207], %[so], v[160:161]\n\t" \
    "v_add_f32 v210, v204, v205\n\t" \
    "v_add_f32_dpp v226, v209, v208 quad_perm:[1,0,3,2] row_mask:0xf bank_mask:0xf bound_ctrl:1\n\t" \
    "ds_read_b128 v[152:155], %[a16] offset:28160\n\t" \
    "v_add_f32 v211, v206, v207\n\t" \
    "v_pk_fma_f32 v[222:223], %[sm], v[164:165], v[222:223]\n\t" \
    "v_add_f32_dpp v226, v226, v226 quad_perm:[2,3,0,1] row_mask:0xf bank_mask:0xf bound_ctrl:1\n\t" \
    "ds_read_b128 v[156:159], %[a16] offset:28672\n\t" \
    "v_pk_mul_f32 v[224:225], v[166:167], v[174:175] op_sel:[0,1] op_sel_hi:[1,1]\n\t" \
    "v_add_f32_dpp v212, v211, v210 quad_perm:[1,0,3,2] row_mask:0xf bank_mask:0xf bound_ctrl:1\n\t" \
    "v_add_f32_dpp v226, v226, v226 row_ror:4 row_mask:0xf bank_mask:0xf bound_ctrl:1\n\t" \
    "v_pk_fma_f32 v[224:225], %[so], v[164:165], v[224:225]\n\t" \
    "ds_read_b64 v[160:161], %[a8] offset:28160\n\t" \
    "v_add_f32_dpp v226, v226, v226 row_ror:8 row_mask:0xf bank_mask:0xf bound_ctrl:1\n\t" \
    "v_mov_b32 v227, v226\n\t" \
    "ds_write_b32 %[ya], v212 offset:16384\n\t" \
    "ds_read_b64 v[162:163], %[av] offset:28160\n\t" \
    "v_permlane16_swap_b32 v226, v227\n\t" \
    "s_waitcnt lgkmcnt(10)\n\t" \
    "v_add_f32 v216, v226, v227\n\t" \
    "v_pk_mul_f32 v[218:219], v[178:179], v[186:187] op_sel_hi:[1,0]\n\t" \
    "v_pk_fma_f32 %[sm], v[168:169], v[216:217], v[222:223] op_sel_hi:[1,0,1]\n\t" \
    "v_mov_b32_dpp v214, v216 quad_perm:[1,0,3,2] row_mask:0xf bank_mask:0xf\n\t" \
    "v_pk_mul_f32 v[200:201], %[sm], v[182:183]\n\t" \
    "v_pk_fma_f32 %[so], v[168:169], v[214:215], v[224:225] op_sel_hi:[1,0,1]\n\t" \
    "v_add_f32 v208, v200, v201\n\t" \
    "v_pk_mul_f32 v[202:203], %[so], v[182:183]\n\t" \
    "v_pk_mul_f32 v[204:205], %[sm], v[172:173]\n\t" \
    "v_add_f32 v209, v202, v203\n\t" \
    "v_pk_mul_f32 v[206:207], %[so], v[172:173]\n\t" \
    "v_add_f32 v210, v204, v205\n\t" \
    "v_add_f32_dpp v226, v209, v208 quad_perm:[1,0,3,2] row_mask:0xf bank_mask:0xf bound_ctrl:1\n\t" \
    "ds_read_b128 v[164:167], %[a16] offset:29568\n\t" \
    "v_add_f32 v211, v206, v207\n\t" \
    "v_pk_fma_f32 v[218:219], %[sm], v[176:177], v[218:219]\n\t" \
    "v_add_f32_dpp v226, v226, v226 quad_perm:[2,3,0,1] row_mask:0xf bank_mask:0xf bound_ctrl:1\n\t" \
    "ds_read_b128 v[168:171], %[a16] offset:30080\n\t" \
    "v_pk_mul_f32 v[220:221], v[178:179], v[186:187] op_sel:[0,1] op_sel_hi:[1,1]\n\t" \
    "v_add_f32_dpp v212, v211, v210 quad_perm:[1,0,3,2] row_mask:0xf bank_mask:0xf bound_ctrl:1\n\t" \
    "v_add_f32_dpp v226, v226, v226 row_ror:4 row_mask:0xf bank_mask:0xf bound_ctrl:1\n\t" \
    "v_pk_fma_f32 v[220:221], %[so], v[176:177], v[220:221]\n\t" \
    "ds_read_b64 v[172:173], %[a8] offset:29568\n\t" \
    "v_add_f32_dpp v226, v226, v226 row_ror:8 row_mask:0xf bank_mask:0xf bound_ctrl:1\n\t" \
    "v_mov_b32 v227, v226\n\t" \
    "ds_write_b32 %[ya], v212 offset:17408\n\t" \
    "ds_read_b64 v[174:175], %[av] offset:29568\n\t" \
    "v_permlane16_swap_b32 v226, v227\n\t" \
    "s_waitcnt lgkmcnt(10)\n\t" \
    "v_add_f32 v216, v226, v227\n\t" \
    "v_pk_mul_f32 v[222:223], v[190:191], v[198:199] op_sel_hi:[1,0]\n\t" \
    "v_pk_fma_f32 %[sm], v[180:181], v[216:217], v[218:219] op_sel_hi:[1,0,1]\n\t" \
    "v_mov_b32_dpp v214, v216 quad_perm:[1,0,3,2] row_mask:0xf bank_mask:0xf\n\t" \
    "v_pk_mul_f32 v[200:201], %[sm], v[194:195]\n\t" \
    "v_pk_fma_f32 %[so], v[180:181], v[214:215], v[220:221] op_sel_hi:[1,0,1]\n\t" \
    "v_add_f32 v208, v200, v201\n\t" \
    "v_pk_mul_f32 v[202:203], %[so], v[194:195]\n\t" \
    "v_pk_mul_f32 v[204:205], %[sm], v[184:185]\n\t" \
    "v_add_f32 v209, v202, v203\n\t" \
    "v_pk_mul_f32 v[206:207], %[so], v[184:185]\n\t" \
    "v_add_f32 v210, v204, v205\n\t" \
    "v_add_f32_dpp v226, v209, v208 quad_perm:[1,0,3,2] row_mask:0xf bank_mask:0xf bound_ctrl:1\n\t" \
    "ds_read_b128 v[176:179], %[a16] offset:30976\n\t" \
    "v_add_f32 v211, v206, v207\n\t" \
    "v_pk_fma_f32 v[222:223], %[sm], v[188:189], v[222:223]\n\t" \
    "v_add_f32_dpp v226, v226, v226 quad_perm:[2,3,0,1] row_mask:0xf bank_mask:0xf bound_ctrl:1\n\t" \
    "ds_read_b128 v[180:183], %[a16] offset:31488\n\t" \
    "v_pk_mul_f32 v[224:225], v[190:191], v[198:199] op_sel:[0,1] op_sel_hi:[1,1]\n\t" \
    "v_add_f32_dpp v212, v211, v210 quad_perm:[1,0,3,2] row_mask:0xf bank_mask:0xf bound_ctrl:1\n\t" \
    "v_add_f32_dpp v226, v226, v226 row_ror:4 row_mask:0xf bank_mask:0xf bound_ctrl:1\n\t" \
    "v_pk_fma_f32 v[224:225], %[so], v[188:189], v[224:225]\n\t" \
    "ds_read_b64 v[184:185], %[a8] offset:30976\n\t" \
    "v_add_f32_dpp v226, v226, v226 row_ror:8 row_mask:0xf bank_mask:0xf bound_ctrl:1\n\t" \
    "v_mov_b32 v227, v226\n\t" \
    "ds_write_b32 %[ya], v212 offset:18432\n\t" \
    "ds_read_b64 v[186:187], %[av] offset:30976\n\t" \
    "v_permlane16_swap_b32 v226, v227\n\t" \
    "s_waitcnt lgkmcnt(10)\n\t" \
    "v_add_f32 v216, v226, v227\n\t" \
    "v_pk_mul_f32 v[218:219], v[154:155], v[162:163] op_sel_hi:[1,0]\n\t" \
    "v_pk_fma_f32 %[sm], v[192:193], v[216:217], v[222:223] op_sel_hi:[1,0,1]\n\t" \
    "v_mov_b32_dpp v214, v216 quad_perm:[1,0,3,2] row_mask:0xf bank_mask:0xf\n\t" \
    "v_pk_mul_f32 v[200:201], %[sm], v[158:159]\n\t" \
    "v_pk_fma_f32 %[so], v[192:193], v[214:215], v[224:225] op_sel_hi:[1,0,1]\n\t" \
    "v_add_f32 v208, v200, v201\n\t" \
    "v_pk_mul_f32 v[202:203], %[so], v[158:159]\n\t" \
    "v_pk_mul_f32 v[204:205], %[sm], v[196:197]\n\t" \
    "v_add_f32 v209, v202, v203\n\t" \
    "v_pk_mul_f32 v[206:207], %[so], v[196:197]\n\t" \
    "v_add_f32 v210, v204, v205\n\t" \
    "v_add_f32_dpp v226, v209, v208 quad_perm:[1,0,3,2] row_mask:0xf bank_mask:0xf bound_ctrl:1\n\t" \
    "ds_read_b128 v[188:191], %[a16] offset:32384\n\t" \
    "v_add_f32 v211, v206, v207\n\t" \
    "v_pk_fma_f32 v[218:219], %[sm], v[152:153], v[218:219]\n\t" \
    "v_add_f32_dpp v226, v226, v226 quad_perm:[2,3,0,1] row_mask:0xf bank_mask:0xf bound_ctrl:1\n\t" \
    "ds_read_b128 v[192:195], %[a16] offset:32896\n\t" \
    "v_pk_mul_f32 v[220:221], v[154:155], v[162:163] op_sel:[0,1] op_sel_hi:[1,1]\n\t" \
    "v_add_f32_dpp v212, v211, v210 quad_perm:[1,0,3,2] row_mask:0xf bank_mask:0xf bound_ctrl:1\n\t" \
    "v_add_f32_dpp v226, v226, v226 row_ror:4 row_mask:0xf bank_mask:0xf bound_ctrl:1\n\t" \
    "v_pk_fma_f32 v[220:221], %[so], v[152:153], v[220:221]\n\t" \
    "ds_read_b64 v[196:197], %[a8] offset:32384\n\t" \
    "v_add_f32_dpp v226, v226, v226 row_ror:8 row_mask:0xf bank_mask:0xf bound_ctrl:1\n\t" \
    "v_mov_b32 v227, v226\n\t" \
    "ds_write_b32 %[ya], v212 offset:19456\n\t" \
    "ds_read_b64 v[198:199], %[av] offset:32384\n\t" \
    "v_permlane16_swap_b32 v226, v227\n\t" \
    "s_waitcnt lgkmcnt(10)\n\t" \
    "v_add_f32 v216, v226, v227\n\t" \
    "v_pk_mul_f32 v[222:223], v[166:167], v[174:175] op_sel_hi:[1,0]\n\t" \
    "v_pk_fma_f32 %[sm], v[156:157], v[216:217], v[218:219] op_sel_hi:[1,0,1]\n\t" \
    "v_mov_b32_dpp v214, v216 quad_perm:[1,0,3,2] row_mask:0xf bank_mask:0xf\n\t" \
    "v_pk_mul_f32 v[200:201], %[sm], v[170:171]\n\t" \
    "v_pk_fma_f32 %[so], v[156:157], v[214:215], v[220:221] op_sel_hi:[1,0,1]\n\t" \
    "v_add_f32 v208, v200, v201\n\t" \
    "v_pk_mul_f32 v[202:203], %[so], v[170:171]\n\t" \
    "v_pk_mul_f32 v[204:205], %[sm], v[160:161]\n\t" \
    "v_add_f32 v209, v202, v203\n\t" \
    "v_pk_mul_f32 v[206:207], %[so], v[160:161]\n\t" \
    "v_add_f32 v210, v204, v205\n\t" \
    "v_add_f32_dpp v226, v209, v208 quad_perm:[1,0,3,2] row_mask:0xf bank_mask:0xf bound_ctrl:1\n\t" \
    "ds_read_b128 v[152:155], %[a16] offset:33792\n\t" \
    "v_add_f32 v211, v206, v207\n\t" \
    "v_pk_fma_f32 v[222:223], %[sm], v[164:165], v[222:223]\n\t" \
    "v_add_f32_dpp v226, v226, v226 quad_perm:[2,3,0,1] row_mask:0xf bank_mask:0xf bound_ctrl:1\n\t" \
    "ds_read_b128 v[156:159], %[a16] offset:34304\n\t" \
    "v_pk_mul_f32 v[224:225], v[166:167], v[174:175] op_sel:[0,1] op_sel_hi:[1,1]\n\t" \
    "v_add_f32_dpp v212, v211, v210 quad_perm:[1,0,3,2] row_mask:0xf bank_mask:0xf bound_ctrl:1\n\t" \
    "v_add_f32_dpp v226, v226, v226 row_ror:4 row_mask:0xf bank_mask:0xf bound_ctrl:1\n\t" \
    "v_pk_fma_f32 v[224:225], %[so], v[164:165], v[224:225]\n\t" \
    "ds_read_b64 v[160:161], %[a8] offset:33792\n\t" \
    "v_add_f32_dpp v226, v226, v226 row_ror:8 row_mask:0xf bank_mask:0xf bound_ctrl:1\n\t" \
    "v_mov_b32 v227, v226\n\t" \
    "ds_write_b32 %[ya], v212 offset:20480\n\t" \
    "ds_read_b64 v[162:163], %[av] offset:33792\n\t" \
    "v_permlane16_swap_b32 v226, v227\n\t" \
    "s_waitcnt lgkmcnt(10)\n\t" \
    "v_add_f32 v216, v226, v227\n\t" \
    "v_pk_mul_f32 v[218:219], v[178:179], v[186:187] op_sel_hi:[1,0]\n\t" \
    "v_pk_fma_f32 %[sm], v[168:169], v[216:217], v[222:223] op_sel_hi:[1,0,1]\n\t" \
    "v_mov_b32_dpp v214, v216 quad_perm:[1,0,3,2] row_mask:0xf bank_mask:0xf\n\t" \
    "v_pk_mul_f32 v[200:201], %[sm], v[182:183]\n\t" \
    "v_pk_fma_f32 %[so], v[168:169], v[214:215], v[224:225] op_sel_hi:[1,0,1]\n\t" \
    "v_add_f32 v208, v200, v201\n\t" \
    "v_pk_mul_f32 v[202:203], %[so], v[182:183]\n\t" \
    "v_pk_mul_f32 v[204:205], %[sm], v[172:173]\n\t" \
    "v_add_f32 v209, v202, v203\n\t" \
    "v_pk_mul_f32 v[206:207], %[so], v[172:173]\n\t" \
    "v_add_f32 v210, v204, v205\n\t" \
    "v_add_f32_dpp v226, v209, v208 quad_perm:[1,0,3,2] row_mask:0xf bank_mask:0xf bound_ctrl:1\n\t" \
    "ds_read_b128 v[164:167], %[a16] offset:35200\n\t" \
    "v_add_f32 v211, v206, v207\n\t" \
    "v_pk_fma_f32 v[218:219], %[sm], v[176:177], v[218:219]\n\t" \
    "v_add_f32_dpp v226, v226, v226 quad_perm:[2,3,0,1] row_mask:0xf bank_mask:0xf bound_ctrl:1\n\t" \
    "ds_read_b128 v[168:171], %[a16] offset:35712\n\t" \
    "v_pk_mul_f32 v[220:221], v[178:179], v[186:187] op_sel:[0,1] op_sel_hi:[1,1]\n\t" \
    "v_add_f32_dpp v212, v211, v210 quad_perm:[1,0,3,2] row_mask:0xf bank_mask:0xf bound_ctrl:1\n\t" \
    "v_add_f32_dpp v226, v226, v226 row_ror:4 row_mask:0xf bank_mask:0xf bound_ctrl:1\n\t" \
    "v_pk_fma_f32 v[220:221], %[so], v[176:177], v[220:221]\n\t" \
    "ds_read_b64 v[172:173], %[a8] offset:35200\n\t" \
    "v_add_f32_dpp v226, v226, v226 row_ror:8 row_mask:0xf bank_mask:0xf bound_ctrl:1\n\t" \
    "v_mov_b32 v227, v226\n\t" \
    "ds_write_b32 %[ya], v212 offset:21504\n\t" \
    "ds_read_b64 v[174:175], %[av] offset:35200\n\t" \
    "v_permlane16_swap_b32 v226, v227\n\t" \
    "s_waitcnt lgkmcnt(10)\n\t" \
    "v_add_f32 v216, v226, v227\n\t" \
    "v_pk_mul_f32 v[222:223], v[190:191], v[198:199] op_sel_hi:[1,0]\n\t" \
    "v_pk_fma_f32 %[sm], v[180:181], v[216:217], v[218:219] op_sel_hi:[1,0,1]\n\t" \
    "v_mov_b32_dpp v214, v216 quad_perm:[1,0,3,2] row_mask:0xf bank_mask:0xf\n\t" \
    "v_pk_mul_f32 v[200:201], %[sm], v[194:195]\n\t" \
    "v_pk_fma_f32 %[so], v[180:181], v[214:215], v[220:221] op_sel_hi:[1,0,1]\n\t" \
    "v_add_f32 v208, v200, v201\n\t" \
    "v_pk_mul_f32 v[202:203], %[so], v[194:195]\n\t" \
    "v_pk_mul_f32 v[204:205], %[sm], v[184:185]\n\t" \
    "v_add_f32 v209, v202, v203\n\t" \
    "v_pk_mul_f32 v[206:207], %[so], v[184:185]\n\t" \
    "v_add_f32 v210, v204, v205\n\t" \
    "v_add_f32_dpp v226, v209, v208 quad_perm:[1,0,3,2] row_mask:0xf bank_mask:0xf bound_ctrl:1\n\t" \
    "ds_read_b128 v[176:179], %[a16] offset:36608\n\t" \
    "v_add_f32 v211, v206, v207\n\t" \
    "v_pk_fma_f32 v[222:223], %[sm], v[188:189], v[222:223]\n\t" \
    "v_add_f32_dpp v226, v226, v226 quad_perm:[2,3,0,1] row_mask:0xf bank_mask:0xf bound_ctrl:1\n\t" \
    "ds_read_b128 v[180:183], %[a16] offset:37120\n\t" \
    "v_pk_mul_f32 v[224:225], v[190:191], v[198:199] op_sel:[0,1] op_sel_hi:[1,1]\n\t" \
    "v_add_f32_dpp v212, v211, v210 quad_perm:[1,0,3,2] row_mask:0xf bank_mask:0xf bound_ctrl:1\n\t" \
    "v_add_f32_dpp v226, v226, v226 row_ror:4 row_mask:0xf bank_mask:0xf bound_ctrl:1\n\t" \
    "v_pk_fma_f32 v[224:225], %[so], v[188:189], v[224:225]\n\t" \
    "ds_read_b64 v[184:185], %[a8] offset:36608\n\t" \
    "v_add_f32_dpp v226, v226, v226 row_ror:8 row_mask:0xf bank_mask:0xf bound_ctrl:1\n\t" \
    "v_mov_b32 v227, v226\n\t" \
    "ds_write_b32 %[ya], v212 offset:22528\n\t" \
    "ds_read_b64 v[186:187], %[av] offset:36608\n\t" \
    "v_permlane16_swap_b32 v226, v227\n\t" \
    "s_waitcnt lgkmcnt(10)\n\t" \
    "v_add_f32 v216, v226, v227\n\t" \
    "v_pk_mul_f32 v[218:219], v[154:155], v[162:163] op_sel_hi:[1,0]\n\t" \
    "v_pk_fma_f32 %[sm], v[192:193], v[216:217], v[222:223] op_sel_hi:[1,0,1]\n\t" \
    "v_mov_b32_dpp v214, v216 quad_perm:[1,0,3,2] row_mask:0xf bank_mask:0xf\n\t" \
    "v_pk_mul_f32 v[200:201], %[sm], v[158:159]\n\t" \
    "v_pk_fma_f32 %[so], v[192:193], v[214:215], v[224:225] op_sel_hi:[1,0,1]\n\t" \
    "v_add_f32 v208, v200, v201\n\t" \
    "v_pk_mul_f32 v[202:203], %[so], v[158:159]\n\t" \
    "v_pk_mul_f32 v[204:205], %[sm], v[196:197]\n\t" \
    "v_add_f32 v209, v202, v203\n\t" \
    "v_pk_mul_f32 v[206:207], %[so], v[196:197]\n\t" \
    "v_add_f32 v210, v204, v205\n\t" \
    "v_add_f32_dpp v226, v209, v208 quad_perm:[1,0,3,2] row_mask:0xf bank_mask:0xf bound_ctrl:1\n\t" \
    "ds_read_b128 v[188:191], %[a16] offset:38016\n\t" \
    "v_add_f32 v211, v206, v207\n\t" \
    "v_pk_fma_f32 v[218:219], %[sm], v[152:153], v[218:219]\n\t" \
    "v_add_f32_dpp v226, v226, v226 quad_perm:[2,3,0,1] row_mask:0xf bank_mask:0xf bound_ctrl:1\n\t" \
    "ds_read_b128 v[192:195], %[a16] offset:38528\n\t" \
    "v_pk_mul_f32 v[220:221], v[154:155], v[162:163] op_sel:[0,1] op_sel_hi:[1,1]\n\t" \
    "v_add_f32_dpp v212, v211, v210 quad_perm:[1,0,3,2] row_mask:0xf bank_mask:0xf bound_ctrl:1\n\t" \
    "v_add_f32_dpp v226, v226, v226 row_ror:4 row_mask:0xf bank_mask:0xf bound_ctrl:1\n\t" \
    "v_pk_fma_f32 v[220:221], %[so], v[152:153], v[220:221]\n\t" \
    "ds_read_b64 v[196:197], %[a8] offset:38016\n\t" \
    "v_add_f32_dpp v226, v226, v226 row_ror:8 row_mask:0xf bank_mask:0xf bound_ctrl:1\n\t" \
    "v_mov_b32 v227, v226\n\t" \
    "ds_write_b32 %[ya], v212 offset:23552\n\t" \
    "ds_read_b64 v[198:199], %[av] offset:38016\n\t" \
    "v_permlane16_swap_b32 v226, v227\n\t" \
    "s_waitcnt lgkmcnt(10)\n\t" \
    "v_add_f32 v216, v226, v227\n\t" \
    "v_pk_mul_f32 v[222:223], v[166:167], v[174:175] op_sel_hi:[1,0]\n\t" \
    "v_pk_fma_f32 %[sm], v[156:157], v[216:217], v[218:219] op_sel_hi:[1,0,1]\n\t" \
    "v_mov_b32_dpp v214, v216 quad_perm:[1,0,3,2] row_mask:0xf bank_mask:0xf\n\t" \
    "v_pk_mul_f32 v[200:201], %[sm], v[170:171]\n\t" \
    "v_pk_fma_f32 %[so], v[156:157], v[214:215], v[220:221] op_sel_hi:[1,0,1]\n\t" \
    "v_add_f32 v208, v200, v201\n\t" \
    "v_pk_mul_f32 v[202:203], %[so], v[170:171]\n\t" \
    "v_pk_mul_f32 v[204:205], %[sm], v[160:161]\n\t" \
    "v_add_f32 v209, v202, v203\n\t" \
    "v_pk_mul_f32 v[206:207], %[so], v[160:161]\n\t" \
    "v_add_f32 v210, v204, v205\n\t" \
    "v_add_f32_dpp v226, v209, v208 quad_perm:[1,0,3,2] row_mask:0xf bank_mask:0xf bound_ctrl:1\n\t" \
    "ds_read_b128 v[152:155], %[a16] offset:39424\n\t" \
    "v_add_f32 v211, v206, v207\n\t" \
    "v_pk_fma_f32 v[222:223], %[sm], v[164:165], v[222:223]\n\t" \
    "v_add_f32_dpp v226, v226, v226 quad_perm:[2,3,0,1] row_mask:0xf bank_mask:0xf bound_ctrl:1\n\t" \
    "ds_read_b128 v[156:159], %[a16] offset:39936\n\t" \
    "v_pk_mul_f32 v[224:225], v[166:167], v[174:175] op_sel:[0,1] op_sel_hi:[1,1]\n\t" \
    "v_add_f32_dpp v212, v211, v210 quad_perm:[1,0,3,2] row_mask:0xf bank_mask:0xf bound_ctrl:1\n\t" \
    "v_add_f32_dpp v226, v226, v226 row_ror:4 row_mask:0xf bank_mask:0xf bound_ctrl:1\n\t" \
    "v_pk_fma_f32 v[224:225], %[so], v[164:165], v[224:225]\n\t" \
    "ds_read_b64 v[160:161], %[a8] offset:39424\n\t" \
    "v_add_f32_dpp v226, v226, v226 row_ror:8 row_mask:0xf bank_mask:0xf bound_ctrl:1\n\t" \
    "v_mov_b32 v227, v226\n\t" \
    "ds_write_b32 %[ya], v212 offset:24576\n\t" \
    "ds_read_b64 v[162:163], %[av] offset:39424\n\t" \
    "v_permlane16_swap_b32 v226, v227\n\t" \
    "s_waitcnt lgkmcnt(10)\n\t" \
    "v_add_f32 v216, v226, v227\n\t" \
    "v_pk_mul_f32 v[218:219], v[178:179], v[186:187] op_sel_hi:[1,0]\n\t" \
    "v_pk_fma_f32 %[sm], v[168:169], v[216:217], v[222:223] op_sel_hi:[1,0,1]\n\t" \
    "v_mov_b32_dpp v214, v216 quad_perm:[1,0,3,2] row_mask:0xf bank_mask:0xf\n\t" \
    "v_pk_mul_f32 v[200:201], %[sm], v[182:183]\n\t" \
    "v_pk_fma_f32 %[so], v[168:169], v[214:215], v[224:225] op_sel_hi:[1,0,1]\n\t" \
    "v_add_f32 v208, v200, v201\n\t" \
    "v_pk_mul_f32 v[202:203], %[so], v[182:183]\n\t" \
    "v_pk_mul_f32 v[204:205], %[sm], v[172:173]\n\t" \
    "v_add_f32 v209, v202, v203\n\t" \
    "v_pk_mul_f32 v[206:207], %[so], v[172:173]\n\t" \
    "v_add_f32 v210, v204, v205\n\t" \
    "v_add_f32_dpp v226, v209, v208 quad_perm:[1,0,3,2] row_mask:0xf bank_mask:0xf bound_ctrl:1\n\t" \
    "ds_read_b128 v[164:167], %[a16] offset:40832\n\t" \
    "v_add_f32 v211, v206, v207\n\t" \
    "v_pk_fma_f32 v[218:219], %[sm], v[176:177], v[218:219]\n\t" \
    "v_add_f32_dpp v226, v226, v226 quad_perm:[2,3,0,1] row_mask:0xf bank_mask:0xf bound_ctrl:1\n\t" \
    "ds_read_b128 v[168:171], %[a16] offset:41344\n\t" \
    "v_pk_mul_f32 v[220:221], v[178:179], v[186:187] op_sel:[0,1] op_sel_hi:[1,1]\n\t" \
    "v_add_f32_dpp v212, v211, v210 quad_perm:[1,0,3,2] row_mask:0xf bank_mask:0xf bound_ctrl:1\n\t" \
    "v_add_f32_dpp v226, v226, v226 row_ror:4 row_mask:0xf bank_mask:0xf bound_ctrl:1\n\t" \
    "v_pk_fma_f32 v[220:221], %[so], v[176:177], v[220:221]\n\t" \
    "ds_read_b64 v[172:173], %[a8] offset:40832\n\t" \
    "v_add_f32_dpp v226, v226, v226 row_ror:8 row_mask:0xf bank_mask:0xf bound_ctrl:1\n\t" \
    "v_mov_b32 v227, v226\n\t" \
    "ds_write_b32 %[ya], v212 offset:25600\n\t" \
    "ds_read_b64 v[174:175], %[av] offset:40832\n\t" \
    "v_permlane16_swap_b32 v226, v227\n\t" \
    "s_waitcnt lgkmcnt(10)\n\t" \
    "v_add_f32 v216, v226, v227\n\t" \
    "v_pk_mul_f32 v[222:223], v[190:191], v[198:199] op_sel_hi:[1,0]\n\t" \
    "v_pk_fma_f32 %[sm], v[180:181], v[216:217], v[218:219] op_sel_hi:[1,0,1]\n\t" \
    "v_mov_b32_dpp v214, v216 quad_perm:[1,0,3,2] row_mask:0xf bank_mask:0xf\n\t" \
    "v_pk_mul_f32 v[200:201], %[sm], v[194:195]\n\t" \
    "v_pk_fma_f32 %[so], v[180:181], v[214:215], v[220:221] op_sel_hi:[1,0,1]\n\t" \
    "v_add_f32 v208, v200, v201\n\t" \
    "v_pk_mul_f32 v[202:203], %[so], v[194:195]\n\t" \
    "v_pk_mul_f32 v[204:205], %[sm], v[184:185]\n\t" \
    "v_add_f32 v209, v202, v203\n\t" \
    "v_pk_mul_f32 v[206:207], %[so], v[184:185]\n\t" \
    "v_add_f32 v210, v204, v205\n\t" \
    "v_add_f32_dpp v226, v209, v208 quad_perm:[1,0,3,2] row_mask:0xf bank_mask:0xf bound_ctrl:1\n\t" \
    "ds_read_b128 v[176:179], %[a16] offset:42240\n\t" \
    "v_add_f32 v211, v206, v207\n\t" \
    "v_pk_fma_f32 v[222:223], %[sm], v[188:189], v[222:223]\n\t" \
    "v_add_f32_dpp v226, v226, v226 quad_perm:[2,3,0,1] row_mask:0xf bank_mask:0xf bound_ctrl:1\n\t" \
    "ds_read_b128 v[180:183], %[a16] offset:42752\n\t" \
    "v_pk_mul_f32 v[224:225], v[190:191], v[198:199] op_sel:[0,1] op_sel_hi:[1,1]\n\t" \
    "v_add_f32_dpp v212, v211, v210 quad_perm:[1,0,3,2] row_mask:0xf bank_mask:0xf bound_ctrl:1\n\t" \
    "v_add_f32_dpp v226, v226, v226 row_ror:4 row_mask:0xf bank_mask:0xf bound_ctrl:1\n\t" \
    "v_pk_fma_f32 v[224:225], %[so], v[188:189], v[224:225]\n\t" \
    "ds_read_b64 v[184:185], %[a8] offset:42240\n\t" \
    "v_add_f32_dpp v226, v226, v226 row_ror:8 row_mask:0xf bank_mask:0xf bound_ctrl:1\n\t" \
    "v_mov_b32 v227, v226\n\t" \
    "ds_write_b32 %[ya], v212 offset:26624\n\t" \
    "ds_read_b64 v[186:187], %[av] offset:42240\n\t" \
    "v_permlane16_swap_b32 v226, v227\n\t" \
    "s_waitcnt lgkmcnt(10)\n\t" \
    "v_add_f32 v216, v226, v227\n\t" \
    "v_pk_mul_f32 v[218:219], v[154:155], v[162:163] op_sel_hi:[1,0]\n\t" \
    "v_pk_fma_f32 %[sm], v[192:193], v[216:217], v[222:223] op_sel_hi:[1,0,1]\n\t" \
    "v_mov_b32_dpp v214, v216 quad_perm:[1,0,3,2] row_mask:0xf bank_mask:0xf\n\t" \
    "v_pk_mul_f32 v[200:201], %[sm], v[158:159]\n\t" \
    "v_pk_fma_f32 %[so], v[192:193], v[214:215], v[224:225] op_sel_hi:[1,0,1]\n\t" \
    "v_add_f32 v208, v200, v201\n\t" \
    "v_pk_mul_f32 v[202:203], %[so], v[158:159]\n\t" \
    "v_pk_mul_f32 v[204:205], %[sm], v[196:197]\n\t" \
    "v_add_f32 v209, v202, v203\n\t" \
    "v_pk_mul_f32 v[206:207], %[so], v[196:197]\n\t" \
    "v_add_f32 v210, v204, v205\n\t" \
    "v_add_f32_dpp v226, v209, v208 quad_perm:[1,0,3,2] row_mask:0xf bank_mask:0xf bound_ctrl:1\n\t" \
    "ds_read_b128 v[188:191], %[a16] offset:43648\n\t" \
    "v_add_f32 v211, v206, v207\n\t" \
    "v_pk_fma_f32 v[218:219], %[sm], v[152:153], v[218:219]\n\t" \
    "v_add_f32_dpp v226, v226, v226 quad_perm:[2,3,0,1] row_mask:0xf bank_mask:0xf bound_ctrl:1\n\t" \
    "ds_read_b128 v[192:195], %[a16] offset:44160\n\t" \
    "v_pk_mul_f32 v[220:221], v[154:155], v[162:163] op_sel:[0,1] op_sel_hi:[1,1]\n\t" \
    "v_add_f32_dpp v212, v211, v210 quad_perm:[1,0,3,2] row_mask:0xf bank_mask:0xf bound_ctrl:1\n\t" \
    "v_add_f32_dpp v226, v226, v226 row_ror:4 row_mask:0xf bank_mask:0xf bound_ctrl:1\n\t" \
    "v_pk_fma_f32 v[220:221], %[so], v[152:153], v[220:221]\n\t" \
    "ds_read_b64 v[196:197], %[a8] offset:43648\n\t" \
    "v_add_f32_dpp v226, v226, v226 row_ror:8 row_mask:0xf bank_mask:0xf bound_ctrl:1\n\t" \
    "v_mov_b32 v227, v226\n\t" \
    "ds_write_b32 %[ya], v212 offset:27648\n\t" \
    "ds_read_b64 v[198:199], %[av] offset:43648\n\t" \
    "v_permlane16_swap_b32 v226, v227\n\t" \
    "s_waitcnt lgkmcnt(10)\n\t" \
    "v_add_f32 v216, v226, v227\n\t" \
    "v_pk_mul_f32 v[222:223], v[166:167], v[174:175] op_sel_hi:[1,0]\n\t" \
    "v_pk_fma_f32 %[sm], v[156:157], v[216:217], v[218:219] op_sel_hi:[1,0,1]\n\t" \
    "v_mov_b32_dpp v214, v216 quad_perm:[1,0,3,2] row_mask:0xf bank_mask:0xf\n\t" \
    "v_pk_mul_f32 v[200:201], %[sm], v[170:171]\n\t" \
    "v_pk_fma_f32 %[so], v[156:157], v[214:215], v[220:221] op_sel_hi:[1,0,1]\n\t" \
    "v_add_f32 v208, v200, v201\n\t" \
    "v_pk_mul_f32 v[202:203], %[so], v[170:171]\n\t" \
    "v_pk_mul_f32 v[204:205], %[sm], v[160:161]\n\t" \
    "v_add_f32 v209, v202, v203\n\t" \
    "v_pk_mul_f32 v[206:207], %[so], v[160:161]\n\t" \
    "v_add_f32 v210, v204, v205\n\t" \
    "v_add_f32_dpp v226, v209, v208 quad_perm:[1,0,3,2] row_mask:0xf bank_mask:0xf bound_ctrl:1\n\t" \
    "v_add_f32 v211, v206, v207\n\t" \
    "v_pk_fma_f32 v[222:223], %[sm], v[164:165], v[222:223]\n\t" \
    "v_add_f32_dpp v226, v226, v226 quad_perm:[2,3,0,1] row_mask:0xf bank_mask:0xf bound_ctrl:1\n\t" \
    "v_pk_mul_f32 v[224:225], v[166:167], v[174:175] op_sel:[0,1] op_sel_hi:[1,1]\n\t" \
    "v_add_f32_dpp v212, v211, v210 quad_perm:[1,0,3,2] row_mask:0xf bank_mask:0xf bound_ctrl:1\n\t" \
    "v_add_f32_dpp v226, v226, v226 row_ror:4 row_mask:0xf bank_mask:0xf bound_ctrl:1\n\t" \
    "v_pk_fma_f32 v[224:225], %[so], v[164:165], v[224:225]\n\t" \
    "s_nop 0\n\t" \
    "v_add_f32_dpp v226, v226, v226 row_ror:8 row_mask:0xf bank_mask:0xf bound_ctrl:1\n\t" \
    "v_mov_b32 v227, v226\n\t" \
    "ds_write_b32 %[ya], v212 offset:28672\n\t" \
    "s_nop 0\n\t" \
    "v_permlane16_swap_b32 v226, v227\n\t" \
    "s_waitcnt lgkmcnt(6)\n\t" \
    "v_add_f32 v216, v226, v227\n\t" \
    "v_pk_mul_f32 v[218:219], v[178:179], v[186:187] op_sel_hi:[1,0]\n\t" \
    "v_pk_fma_f32 %[sm], v[168:169], v[216:217], v[222:223] op_sel_hi:[1,0,1]\n\t" \
    "v_mov_b32_dpp v214, v216 quad_perm:[1,0,3,2] row_mask:0xf bank_mask:0xf\n\t" \
    "v_pk_mul_f32 v[200:201], %[sm], v[182:183]\n\t" \
    "v_pk_fma_f32 %[so], v[168:169], v[214:215], v[224:225] op_sel_hi:[1,0,1]\n\t" \
    "v_add_f32 v208, v200, v201\n\t" \
    "v_pk_mul_f32 v[202:203], %[so], v[182:183]\n\t" \
    "v_pk_mul_f32 v[204:205], %[sm], v[172:173]\n\t" \
    "v_add_f32 v209, v202, v203\n\t" \
    "v_pk_mul_f32 v[206:207], %[so], v[172:173]\n\t" \
    "v_add_f32 v210, v204, v205\n\t" \
    "v_add_f32_dpp v226, v209, v208 quad_perm:[1,0,3,2] row_mask:0xf bank_mask:0xf bound_ctrl:1\n\t" \
    "v_add_f32 v211, v206, v207\n\t" \
    "v_pk_fma_f32 v[218:219], %[sm], v[176:177], v[218:219]\n\t" \
    "v_add_f32_dpp v226, v226, v226 quad_perm:[2,3,0,1] row_mask:0xf bank_mask:0xf bound_ctrl:1\n\t" \
    "v_pk_mul_f32 v[220:221], v[178:179], v[186:187] op_sel:[0,1] op_sel_hi:[1,1]\n\t" \
    "v_add_f32_dpp v212, v211, v210 quad_perm:[1,0,3,2] row_mask:0xf bank_mask:0xf bound_ctrl:1\n\t" \
    "v_add_f32_dpp v226, v226, v226 row_ror:4 row_mask:0xf bank_mask:0xf bound_ctrl:1\n\t" \
    "v_pk_fma_f32 v[220:221], %[so], v[176:177], v[220:221]\n\t" \
    "s_nop 0\n\t" \
    "v_add_f32_dpp v226, v226, v226 row_ror:8 row_mask:0xf bank_mask:0xf bound_ctrl:1\n\t" \
    "v_mov_b32 v227, v226\n\t" \
    "ds_write_b32 %[ya], v212 offset:29696\n\t" \
    "s_nop 0\n\t" \
    "v_permlane16_swap_b32 v226, v227\n\t" \
    "s_waitcnt lgkmcnt(2)\n\t" \
    "v_add_f32 v216, v226, v227\n\t" \
    "v_pk_mul_f32 v[222:223], v[190:191], v[198:199] op_sel_hi:[1,0]\n\t" \
    "v_pk_fma_f32 %[sm], v[180:181], v[216:217], v[218:219] op_sel_hi:[1,0,1]\n\t" \
    "v_mov_b32_dpp v214, v216 quad_perm:[1,0,3,2] row_mask:0xf bank_mask:0xf\n\t" \
    "v_pk_mul_f32 v[200:201], %[sm], v[194:195]\n\t" \
    "v_pk_fma_f32 %[so], v[180:181], v[214:215], v[220:221] op_sel_hi:[1,0,1]\n\t" \
    "v_add_f32 v208, v200, v201\n\t" \
    "v_pk_mul_f32 v[202:203], %[so], v[194:195]\n\t" \
    "v_pk_mul_f32 v[204:205], %[sm], v[184:185]\n\t" \
    "v_add_f32 v209, v202, v203\n\t" \
    "v_pk_mul_f32 v[206:207], %[so], v[184:185]\n\t" \
    "v_add_f32 v210, v204, v205\n\t" \
    "v_add_f32_dpp v226, v209, v208 quad_perm:[1,0,3,2] row_mask:0xf bank_mask:0xf bound_ctrl:1\n\t" \
    "v_add_f32 v211, v206, v207\n\t" \
    "v_pk_fma_f32 v[222:223], %[sm], v[188:189], v[222:223]\n\t" \
    "v_add_f32_dpp v226, v226, v226 quad_perm:[2,3,0,1] row_mask:0xf bank_mask:0xf bound_ctrl:1\n\t" \
    "v_pk_mul_f32 v[224:225], v[190:191], v[198:199] op_sel:[0,1] op_sel_hi:[1,1]\n\t" \
    "v_add_f32_dpp v212, v211, v210 quad_perm:[1,0,3,2] row_mask:0xf bank_mask:0xf bound_ctrl:1\n\t" \
    "v_add_f32_dpp v226, v226, v226 row_ror:4 row_mask:0xf bank_mask:0xf bound_ctrl:1\n\t" \
    "v_pk_fma_f32 v[224:225], %[so], v[188:189], v[224:225]\n\t" \
    "s_nop 0\n\t" \
    "v_add_f32_dpp v226, v226, v226 row_ror:8 row_mask:0xf bank_mask:0xf bound_ctrl:1\n\t" \
    "v_mov_b32 v227, v226\n\t" \
    "ds_write_b32 %[ya], v212 offset:30720\n\t" \
    "s_nop 0\n\t" \
    "v_permlane16_swap_b32 v226, v227\n\t" \
    "v_add_f32 v216, v226, v227\n\t" \
    "v_pk_fma_f32 %[sm], v[192:193], v[216:217], v[222:223] op_sel_hi:[1,0,1]\n\t" \
    "s_nop 0\n\t" \
    "v_mov_b32_dpp v214, v216 quad_perm:[1,0,3,2] row_mask:0xf bank_mask:0xf\n\t" \
    "s_nop 0\n\t" \
    "v_pk_fma_f32 %[so], v[192:193], v[214:215], v[224:225] op_sel_hi:[1,0,1]\n\t" \
    "v_pk_mul_f32 v[204:205], %[sm], v[196:197]\n\t" \
    "v_pk_mul_f32 v[206:207], %[so], v[196:197]\n\t" \
    "v_add_f32 v210, v204, v205\n\t" \
    "v_add_f32 v211, v206, v207\n\t" \
    "s_nop 1\n\t" \
    "v_add_f32_dpp v212, v211, v210 quad_perm:[1,0,3,2] row_mask:0xf bank_mask:0xf bound_ctrl:1\n\t" \
    "ds_write_b32 %[ya], v212 offset:31744\n\t" \
    "s_waitcnt lgkmcnt(0)\n\t"
#define RW_CHUNK_CLOB "memory", "v152", "v153", "v154", "v155", "v156", "v157", "v158", "v159", "v160", "v161", "v162", "v163", "v164", "v165", "v166", "v167", "v168", "v169", "v170", "v171", "v172", "v173", "v174", "v175", "v176", "v177", "v178", "v179", "v180", "v181", "v182", "v183", "v184", "v185", "v186", "v187", "v188", "v189", "v190", "v191", "v192", "v193", "v194", "v195", "v196", "v197", "v198", "v199", "v200", "v201", "v202", "v203", "v204", "v205", "v206", "v207", "v208", "v209", "v210", "v211", "v212", "v213", "v214", "v215", "v216", "v217", "v218", "v219", "v220", "v221", "v222", "v223", "v224", "v225", "v226", "v227"
struct RwRaw { unsigned ew[4], ic[4], kk[4], rr[4], kr[4], vv[4]; };
__device__ __forceinline__ void phase_rwkv_scan(Frame& F, const Args& a, int layer) {
    const bf16_t* P2 = WSP(bf16_t, WS_P2); const bf16_t* EW = WSP(bf16_t, WS_EW); const bf16_t* ICLR = WSP(bf16_t, WS_ICLR); const bf16_t* KK = WSP(bf16_t, WS_KK);
    bf16_t* YRW = WSP(bf16_t, WS_YRW);
    LAS float* ring = (LAS float*)F.lds; LAS float* ybuf = (LAS float*)(F.lds + 2 * RW_CHF * 4);
    const int lane = F.lane;
    for (int u0 = F.bid; u0 < 256; u0 += F.G) {
        const int u = (F.G == 256) ? (((u0 & 7) * 8 + (u0 >> 5)) << 2) + ((u0 >> 3) & 3) : u0;
        const int chain = u >> 2, rq = u & 3, d = chain >> 5, b = (chain >> 4) & 1, h = chain & 15;
        constexpr int NCH = (CTX + SEQ) / RW_CH; static_assert(NCH % 6 == 0, "loader loop is unrolled by 3, compute loop by 2");
        const int lw = F.wave - 4;
        const int tsel = lane >> 5, kp = lane & 31;
        const f32x2 ka2 = *(const f32x2*)(arg_in(a, I_RKA) + layer * 1024 + h * 64 + 2 * kp);
        auto issue = [&](RwRaw& x, int cidx) {
            const int row0 = rw_row(cidx * RW_CH, b, d), st = d == 0 ? 1 : -1;
            const int tk0 = 2 * lw + tsel;
            const unsigned* ewp = (const unsigned*)(EW + (size_t)d * T * 1024); const unsigned* icp = (const unsigned*)(ICLR + (size_t)d * T * 1024);
            const unsigned* kkp = (const unsigned*)KK; const unsigned* p2p = (const unsigned*)P2;
#pragma unroll
            for (int j = 0; j < 4; ++j) { const int row = row0 + st * (8 * j + tk0); const int o = (row * 1024 + h * 64) / 2 + kp, q = (row * P2W + P2_RKV + h * 64) / 2 + kp;
                x.ew[j] = ewp[o]; x.ic[j] = icp[o]; x.kk[j] = kkp[o]; x.rr[j] = p2p[q]; x.kr[j] = p2p[q + 512]; x.vv[j] = p2p[q + 1024 + rq * 8 - kp + (kp & 7)]; } };
        auto commit = [&](const RwRaw& x, int cidx) {
            LAS float* dst = ring + (cidx & 1) * RW_CHF;
#pragma unroll
            for (int j = 0; j < 4; ++j) { LAS float* sbase = dst + (8 * j + 2 * lw + tsel) * RW_STEP_F; LAS f32x2* s2 = (LAS f32x2*)sbase + kp;
                const f32x2 ew = {bflo(x.ew[j]), bfhi(x.ew[j])}, ic = {bflo(x.ic[j]), bfhi(x.ic[j])}, kkv = {bflo(x.kk[j]), bfhi(x.kk[j])}, rr = {bflo(x.rr[j]), bfhi(x.rr[j])}, kr = {bflo(x.kr[j]), bfhi(x.kr[j])};
                const f32x2 kq = kr * ((ic - 1.f) * ka2 + 1.f), bq = kkv * ic; LAS f32x4* s4 = (LAS f32x4*)sbase + kp;
                s4[0] = (f32x4){__expf(-ew.x), __expf(-ew.y), kq.x, kq.y}; s4[32] = (f32x4){bq.x, bq.y, -kkv.x, -kkv.y}; s2[128] = rr;
                if (kp < 8) { const float v0 = bflo(x.vv[j]), v1 = bfhi(x.vv[j]); s4[80] = (f32x4){v0, v1, v1, v0}; } } };
        auto flush_chunk = [&](int cidx) {
            const LAS float* yb = ybuf + (cidx & 1) * (RW_CH * 256);
            const int row0 = rw_row(cidx * RW_CH, b, d), st = d == 0 ? 1 : -1;
#pragma unroll
            for (int q = 0; q < 2; ++q) { const int i = (F.tid - 256) + 256 * q, tok = i >> 4, rr = i & 15; const LAS f32x4* pp = (const LAS f32x4*)(yb + i * 16);
                const f32x4 p0 = pp[0], p1 = pp[1], p2 = pp[2], p3 = pp[3];
                const float y = ((p0.x + p0.y) + (p0.z + p0.w)) + ((p1.x + p1.y) + (p1.z + p1.w)) + (((p2.x + p2.y) + (p2.z + p2.w)) + ((p3.x + p3.y) + (p3.z + p3.w)));
                YRW[((size_t)d * T + row0 + st * tok) * 1024 + h * 64 + rq * 16 + rr] = (bf16_t)f2bf(y); } };
        auto compute = [&](f32x2& sm, f32x2& so, int c) {
            const int kp = lane & 31, par = lane & 1, r16 = F.wave * 4 + (lane >> 5) * 2;
            const unsigned rc = (unsigned)(__UINTPTR_TYPE__)(ring + (c & 1) * RW_CHF);
            const unsigned a16 = rc + kp * 16, a8 = rc + 1024 + kp * 8, av = rc + 1280 + (r16 >> 1) * 16 + par * 8;
            const unsigned ya = (unsigned)(__UINTPTR_TYPE__)(ybuf + (c & 1) * (RW_CH * 256) + (r16 + par) * 16 + (kp >> 1));
            asm volatile(RW_CHUNK_ASM : [sm] "+v"(sm), [so] "+v"(so) : [a16] "v"(a16), [a8] "v"(a8), [av] "v"(av), [ya] "v"(ya) : RW_CHUNK_CLOB);
        };
        __syncthreads();
        f32x2 sm = {0.f, 0.f}, so = {0.f, 0.f};
        if (F.wave >= 4) {
            RwRaw r0, r1, r2;
            issue(r0, 0); commit(r0, 0); issue(r1, 1); issue(r2, 2);
            __syncthreads();
            for (int c = 0; c < NCH; c += 3) {
                if (c + 3 < NCH) issue(r0, c + 3);
                if (c > 0) flush_chunk(c - 1);
                commit(r1, c + 1);
                __syncthreads();
                if (c + 4 < NCH) issue(r1, c + 4);
                flush_chunk(c);
                commit(r2, c + 2);
                __syncthreads();
                if (c + 5 < NCH) issue(r2, c + 5);
                flush_chunk(c + 1);
                if (c + 3 < NCH) commit(r0, c + 3);
                __syncthreads();
            }
            flush_chunk(NCH - 1);
        } else {
            __syncthreads();
            for (int c = 0; c < NCH; c += 2) { compute(sm, so, c); __syncthreads(); compute(sm, so, c + 1); __syncthreads(); }
        }
    }
}
__device__ __forceinline__ void phase_rwkv_out(Frame& F, const Args& a, int layer) {
    const bf16_t* P2 = WSP(bf16_t, WS_P2); const bf16_t* ICLR = WSP(bf16_t, WS_ICLR); const bf16_t* YRW = WSP(bf16_t, WS_YRW); const bf16_t* GG = WSP(bf16_t, WS_GG);
    unsigned char* YD = WSP(unsigned char, WS_Y8D);
    const float* lng = arg_in(a, I_RLNG) + layer * 1024; const float* lnb = arg_in(a, I_RLNB) + layer * 1024; const float* rk = arg_in(a, I_RRK) + layer * 1024; const float* kav = arg_in(a, I_RKA) + layer * 1024;
    for (int row = F.gw; row < T; row += F.NGW) {
        const int c = F.lane * 16; const size_t o = (size_t)row * 1024 + c;
        float y[16], r[16], k[16], v[16], i0[16], i1[16], g[16];
#define LD16(dst, ptr) do { float t0_[8], t1_[8]; ld8bf((ptr), t0_); ld8bf((ptr) + 8, t1_); _Pragma("unroll") for (int i_ = 0; i_ < 8; ++i_) { dst[i_] = t0_[i_]; dst[8 + i_] = t1_[i_]; } } while (0)
        LD16(y, YRW + o); LD16(r, YRW + (size_t)T * 1024 + o);
#pragma unroll
        for (int i = 0; i < 16; ++i) y[i] += r[i];
        const bf16_t* p2 = P2 + (size_t)row * P2W + P2_RKV + c;
        LD16(r, p2); LD16(k, p2 + 1024); LD16(v, p2 + 2048); LD16(i0, ICLR + o); LD16(i1, ICLR + (size_t)T * 1024 + o); LD16(g, GG + o);
#undef LD16
        float s = 0.f, bsum = 0.f;
#pragma unroll
        for (int i = 0; i < 16; ++i) { s += y[i]; const float ka = kav[c + i]; bsum += r[i] * k[i] * rk[c + i] * ((1.f + (i0[i] - 1.f) * ka) + (1.f + (i1[i] - 1.f) * ka)); }
        s = sum4(s); bsum = sum4(bsum);
        const float mu = s * (1.f / 64.f); float q = 0.f;
#pragma unroll
        for (int i = 0; i < 16; ++i) { const float dd = y[i] - mu; q += dd * dd; }
        q = sum4(q);
        const float rstd = 1.f / sqrtf(q * (1.f / 64.f) + 64e-5f);
        float o0[8], o1[8];
#pragma unroll
        for (int i = 0; i < 8; ++i) { o0[i] = ((y[i] - mu) * rstd * lng[c + i] + lnb[c + i] + bsum * v[i]) * g[i];
            o1[i] = ((y[8 + i] - mu) * rstd * lng[c + 8 + i] + lnb[c + 8 + i] + bsum * v[8 + i]) * g[8 + i]; }
        *(u32x4*)(YD + o) = (u32x4){pk4fp8(o0[0], o0[1], o0[2], o0[3]), pk4fp8(o0[4], o0[5], o0[6], o0[7]), pk4fp8(o1[0], o1[1], o1[2], o1[3]), pk4fp8(o1[4], o1[5], o1[6], o1[7])};
    }
}

constexpr int FFT_N = 16384;
__device__ __forceinline__ int fswz(int i) { return i ^ (((i >> 5) & 3) << 2) ^ (((i >> 6) & 1) << 4); }
__device__ __forceinline__ f32x2 cmul(f32x2 a, f32x2 b) { return (f32x2){a.x * b.x - a.y * b.y, a.x * b.y + a.y * b.x}; }
template <bool INV>
__device__ __forceinline__ void fft_passes(LAS f32x2* X, int tid) {
#pragma unroll 1
    for (int st = 0; st < 7; ++st) {
        const int lq = INV ? 2 * st : 12 - 2 * st;
        const int q = 1 << lq; const float inv4q = __uint_as_float((unsigned)(127 - (lq + 2)) << 23);
        __syncthreads();
#pragma unroll 2
        for (int mm = 0; mm < 8; ++mm) { const int uu = tid + 512 * mm; const int k = uu & (q - 1), blk = uu >> lq; const int i0 = (blk << (lq + 2)) + k;
            const int p0 = fswz(i0), p1 = fswz(i0 + q), p2 = fswz(i0 + 2 * q), p3 = fswz(i0 + 3 * q);
            f32x2 a0 = X[p0], a1 = X[p1], a2 = X[p2], a3 = X[p3];
            const float fr = (float)k * inv4q;
            const float cs = __builtin_amdgcn_cosf(fr), sn = __builtin_amdgcn_sinf(fr);
            const f32x2 w1 = INV ? (f32x2){cs, sn} : (f32x2){cs, -sn}; const f32x2 w2 = cmul(w1, w1), w3 = cmul(w2, w1);
            if (!INV) {
                const f32x2 t0 = a0 + a2, t1 = a0 - a2, t2 = a1 + a3, t3 = a1 - a3;
                const f32x2 b0 = t0 + t2, b2 = t0 - t2, b1 = (f32x2){t1.x + t3.y, t1.y - t3.x}, b3 = (f32x2){t1.x - t3.y, t1.y + t3.x};
                X[p0] = b0; X[p1] = cmul(b1, w1); X[p2] = cmul(b2, w2); X[p3] = cmul(b3, w3);
            } else {
                a1 = cmul(a1, w1); a2 = cmul(a2, w2); a3 = cmul(a3, w3);
                const f32x2 u0 = a0 + a2, u1 = a0 - a2, u2 = a1 + a3, u3 = a1 - a3;
                X[p0] = u0 + u2; X[p2] = u0 - u2; X[p1] = (f32x2){u1.x - u3.y, u1.y + u3.x}; X[p3] = (f32x2){u1.x + u3.y, u1.y - u3.x};
            } }
    }
    __syncthreads();
}
__device__ __forceinline__ void phase_hyena_fft(Frame& F, const Args& a, int layer, bool dry = false) {
    const bf16_t* FILT = WSP(bf16_t, WS_FILT); float* VT = WSP(float, WS_VT); const float* hyd = arg_in(a, I_HD) + layer * 1024;
    LAS f32x2* X = (LAS f32x2*)F.lds;
    for (int c = F.bid; c < 1024; c += F.G) {
        __syncthreads();
        const int tid = F.wave * 64 + (lane_asm() & 63), i0 = tid * 16;
        { const bf16_t* hf = FILT + (size_t)c * 2 * SEQ; const bf16_t* hb = hf + SEQ;
          float f[16], g[16]; ld8bf(hf + i0, *(float(*)[8])&f[0]); ld8bf(hf + i0 + 8, *(float(*)[8])&f[8]);
          ld8bf(hb + (SEQ - 16 - i0), *(float(*)[8])&g[0]); ld8bf(hb + (SEQ - 8 - i0), *(float(*)[8])&g[8]);
#pragma unroll
          for (int j = 0; j < 16; ++j) X[fswz(i0 + j)] = (f32x2){f[j], 0.f};
#pragma unroll
          for (int j = 0; j < 16; ++j) { const int pos = SEQ + i0 + 1 + j; if (pos < FFT_N) X[fswz(pos)] = (f32x2){g[15 - j], 0.f}; }
          if (tid == 0) { float zz = 0.f; asm volatile("" : "+v"(zz)); X[fswz(SEQ)] = (f32x2){zz, zz}; } }
        fft_passes<false>(X, F.tid);
        f32x2 Kh[32];
#pragma unroll
        for (int j = 0; j < 32; ++j) Kh[j] = X[fswz(F.tid + 512 * j)];
        __syncthreads();
        float* v0 = VT + (size_t)c * 2 * SEQ; float* v1 = v0 + SEQ;
        { f32x4 a0[4], a1[4];
#pragma unroll
          for (int q = 0; q < 4; ++q) { a0[q] = *(const f32x4*)(v0 + i0 + 4 * q); a1[q] = *(const f32x4*)(v1 + i0 + 4 * q); }
#pragma unroll
          for (int q = 0; q < 4; ++q) { X[fswz(i0 + 4 * q)] = (f32x2){a0[q].x, a1[q].x}; X[fswz(i0 + 4 * q + 1)] = (f32x2){a0[q].y, a1[q].y}; X[fswz(i0 + 4 * q + 2)] = (f32x2){a0[q].z, a1[q].z}; X[fswz(i0 + 4 * q + 3)] = (f32x2){a0[q].w, a1[q].w}; }
          { float zz = 0.f; asm volatile("" : "+v"(zz));
#pragma unroll
          for (int j = 0; j < 16; ++j) X[fswz(SEQ + i0 + j)] = (f32x2){zz, zz}; } }
        fft_passes<false>(X, F.tid);
#pragma unroll
        for (int j = 0; j < 32; ++j) { const int p = fswz(F.tid + 512 * j); X[p] = cmul(X[p], Kh[j]); }
        fft_passes<true>(X, F.tid);
        const float dc = hyd[c];
        { f32x4 a0[4], a1[4];
#pragma unroll
          for (int q = 0; q < 4; ++q) { a0[q] = *(const f32x4*)(v0 + i0 + 4 * q); a1[q] = *(const f32x4*)(v1 + i0 + 4 * q); }
#pragma unroll
          for (int q = 0; q < 4; ++q) { const f32x2 r0 = X[fswz(i0 + 4 * q)], r1 = X[fswz(i0 + 4 * q + 1)], r2 = X[fswz(i0 + 4 * q + 2)], r3 = X[fswz(i0 + 4 * q + 3)];
              const f32x4 o0 = (f32x4){r0.x, r1.x, r2.x, r3.x} * (1.f / FFT_N) + a0[q] * dc, o1 = (f32x4){r0.y, r1.y, r2.y, r3.y} * (1.f / FFT_N) + a1[q] * dc;
              if (!dry) { *(f32x4*)(v0 + i0 + 4 * q) = o0; *(f32x4*)(v1 + i0 + 4 * q) = o1; } } }
    }
}
__device__ __forceinline__ void phase_hyena_out(Frame& F, const Args& a, int layer) {
    const float* VT = WSP(float, WS_VT); const bf16_t* P2 = WSP(bf16_t, WS_P2); bf16_t* YC = WSP(bf16_t, WS_Y) + (size_t)2 * T * 1024;
    LAS float* tl = (LAS float*)F.lds;
    for (int u = F.bid; u < (TL / 64) * 4; u += F.G) {
        const int tb = u >> 2, cb = u & 3; const int row0 = TC + tb * 64; const int b = (row0 - TC) >> 13, t0 = (row0 - TC) & (SEQ - 1);
        __syncthreads();
        for (int p = 0; p < 8; ++p) { const int cl = p * 32 + (F.tid >> 4), q = F.tid & 15;
            const f32x4 v = *(const f32x4*)(VT + ((size_t)(cb * 256 + cl) * 2 + b) * SEQ + t0 + 4 * q);
            tl[cl * 65 + 4 * q] = v.x; tl[cl * 65 + 4 * q + 1] = v.y; tl[cl * 65 + 4 * q + 2] = v.z; tl[cl * 65 + 4 * q + 3] = v.w; }
        __syncthreads();
        const int cl = F.tid & 255, th = F.tid >> 8;
        for (int i = 0; i < 32; ++i) { const int tl_ = th * 32 + i; const size_t row = (size_t)(row0 + tl_);
            const float x0 = bf2f(P2[row * P2W + P2_X0 + cb * 256 + cl]);
            YC[row * 1024 + cb * 256 + cl] = (bf16_t)f2bf(tl[cl * 65 + tl_] * x0); }
    }
    const float* VC = WSP(float, WS_VC); const float* FC = WSP(float, WS_FILTC); const float* hyd = arg_in(a, I_HD) + layer * 1024;
    for (int it = F.gw; it < 2 * 16 * 16; it += F.NGW) {
        const int b = it >> 8, cbk = (it >> 4) & 15, tb = it & 15; const int c = cbk * 64 + F.lane, t0 = tb * 16;
        const float* vb = VC + (size_t)b * CTX * 1024 + c; const float* fc = FC + c;
        float acc[16];
#pragma unroll
        for (int i = 0; i < 16; ++i) acc[i] = 0.f;
#pragma unroll 1
        for (int sb = 0; sb < 16; ++sb) { const int s0 = sb * 16, dl = t0 - s0;
            float f[31], v[16];
#pragma unroll
            for (int j = 0; j < 31; ++j) { const int lag = dl + j - 15; f[j] = lag >= 0 ? fc[(size_t)lag * 2048] : fc[(size_t)(-lag) * 2048 + 1024]; }
#pragma unroll
            for (int j = 0; j < 16; ++j) v[j] = vb[(size_t)(s0 + j) * 1024];
#pragma unroll
            for (int i = 0; i < 16; ++i)
#pragma unroll
                for (int j = 0; j < 16; ++j) acc[i] += f[i - j + 15] * v[j]; }
#pragma unroll
        for (int i = 0; i < 16; ++i) { const int t = t0 + i; const size_t row = (size_t)(b * CTX + t);
            const float x0 = bf2f(P2[row * P2W + P2_X0 + c]);
            YC[row * 1024 + c] = (bf16_t)f2bf((acc[i] + vb[(size_t)t * 1024] * hyd[c]) * x0); }
    }
}

__device__ __forceinline__ void phase_ln1(Frame& F, const Args& a, int layer) {
    const float* mod = (const float*)(F.ws + WS_CTL) + CW_MOD + (size_t)layer * 3 * 6 * DM;
    const float* YM = WSP(float, WS_YMIX); float* XS = WSP(float, WS_XS); unsigned* H2 = WSP(unsigned, WS_H2); float* AFF = WSP(float, WS_AFF); int* INV = WSP(int, WS_INV);
    const float* g1w = arg_in(a, I_LN1G) + layer * DM; const float* b1w = arg_in(a, I_LN1B) + layer * DM; const float* wr = arg_in(a, I_WROUTER) + (size_t)layer * DM * NEXP;
    LAS float* wrT = (LAS float*)F.lds;
    __syncthreads();
    for (int i = F.tid; i < DM * NEXP; i += NTHREADS) { const int c = i >> 4, e = i & 15; wrT[e * DM + c] = wr[i]; }
    __syncthreads();
    int* PTOK = WSP(int, WS_PTOK); float* PG = WSP(float, WS_PGATE);
    for (int i = F.bid * NTHREADS + F.tid; i < NPAIR; i += F.G * NTHREADS) { PTOK[i] = -1; PG[i] = 0.f; }
    for (int row = F.gw; row < T; row += F.NGW) {
        const f32x4* xr = (const f32x4*)x_src_row(a, F, layer, row) + F.lane; const f32x4* yr = (const f32x4*)(YM + (size_t)row * DM) + F.lane;
        const float* m = mod + (size_t)row_modidx(row) * 6 * DM;
        f32x4 v[8];
#pragma unroll
        for (int j = 0; j < 8; ++j) { const int c = 4 * (64 * j + F.lane); v[j] = xr[64 * j] * ALPHA + *(const f32x4*)(m + 2 * DM + c) * yr[64 * j]; }
        float mean, rstd; row_stats(v, mean, rstd, 1e-6f);
        f32x4* xo = (f32x4*)(XS + (size_t)row * DM) + F.lane;
#pragma unroll
        for (int j = 0; j < 8; ++j) { const int c = 4 * (64 * j + F.lane); v[j] = (v[j] - mean) * rstd * *(const f32x4*)(g1w + c) + *(const f32x4*)(b1w + c); xo[64 * j] = v[j]; }
        row_stats(v, mean, rstd, 1e-6f);
        unsigned* ho = H2 + (size_t)row * (DM / 4) + F.lane;
        float lg[16];
#pragma unroll
        for (int e = 0; e < 16; ++e) lg[e] = 0.f;
#pragma unroll
        for (int j = 0; j < 8; ++j) { const int c = 4 * (64 * j + F.lane);
            const f32x4 y = (v[j] - mean) * rstd * (*(const f32x4*)(m + 4 * DM + c) + 1.f) + *(const f32x4*)(m + 3 * DM + c);
            ho[64 * j] = pk4fp8(y.x, y.y, y.z, y.w);
#pragma unroll
            for (int e = 0; e < 16; ++e) { const f32x4 ww = *(const LAS f32x4*)(wrT + e * DM + c); lg[e] += (y.x * ww.x + y.y * ww.y) + (y.z * ww.z + y.w * ww.w); } }
        float mx = -1e30f;
#pragma unroll
        for (int e = 0; e < 16; ++e) { lg[e] = wave_sum(lg[e]); mx = fmaxf(mx, lg[e]); }
        float den = 0.f;
#pragma unroll
        for (int e = 0; e < 16; ++e) { lg[e] = __expf(lg[e] - mx); den += lg[e]; }
        float mine = 0.f;
#pragma unroll
        for (int e = 0; e < 16; ++e) mine = (F.lane == e) ? lg[e] : mine;
        if (F.lane < 16) { AFF[(size_t)row * 16 + F.lane] = mine / den; INV[(size_t)row * 16 + F.lane] = -1; }
    }
}
__device__ __forceinline__ void phase_topk(Frame& F, bool lat_only) {
    const float* AFF = WSP(float, WS_AFF); int* INV = WSP(int, WS_INV); int* PTOK = WSP(int, WS_PTOK); float* PG = WSP(float, WS_PGATE);
    LAS unsigned* vals = (LAS unsigned*)F.lds; LAS unsigned* hist = vals + 8192; LAS unsigned* ctl = hist + 256;
    for (int u = F.bid + (lat_only ? 32 : 0); u < 64; u += F.G) {
        const int s = u >> 4, e = u & 15, rs = seg_start(s), n = seg_len(s), cap = s < 2 ? CAP_C : CAP_L;
        __syncthreads();
        for (int i = F.tid; i < n; i += NTHREADS) vals[i] = __builtin_bit_cast(unsigned, AFF[(size_t)(rs + i) * 16 + e]);
        if (F.tid == 0) { ctl[0] = 0u; ctl[1] = (unsigned)cap; ctl[2] = 0u; ctl[3] = 0u; }
        unsigned mask = 0u;
        for (int shift = 24; shift >= 0; shift -= 8) {
            if (F.tid < 256) hist[F.tid] = 0u;
            __syncthreads();
            const unsigned prefix = ctl[0];
            for (int i = F.tid; i < n; i += NTHREADS) { const unsigned b = vals[i]; if ((b & mask) == prefix) __hip_atomic_fetch_add(&hist[(b >> shift) & 255u], 1u, __ATOMIC_RELAXED, __HIP_MEMORY_SCOPE_WORKGROUP); }
            __syncthreads();
            if (F.wave == 0) {
                const unsigned rem = ctl[1]; unsigned cnt[4]; float tot = 0.f;
#pragma unroll
                for (int j = 0; j < 4; ++j) { cnt[j] = hist[255 - (4 * F.lane + j)]; tot += (float)cnt[j]; }
                const unsigned incl = (unsigned)(wave_incl_scan(tot, F.lane) + 0.5f), excl = incl - (unsigned)(tot + 0.5f);
                if (excl < rem && rem <= incl) { unsigned cum = excl; int j = 0;
#pragma unroll
                    for (int q = 0; q < 3; ++q) { if (j == q && cum + cnt[q] < rem) { cum += cnt[q]; j = q + 1; } }
                    ctl[1] = rem - cum; ctl[0] = prefix | ((unsigned)(255 - (4 * F.lane + j)) << shift); } }
            mask |= 255u << shift;
            __syncthreads();
        }
        const unsigned thr = ctl[0], rem = ctl[1]; const unsigned ngt = (unsigned)cap - rem;
        const int pbase = s < 2 ? NBATCH * NEXP * CAP_L + e * 256 + s * CAP_C : ((s - 2) * NEXP + e) * CAP_L;
        for (int i = F.tid; i < n; i += NTHREADS) { const unsigned b = vals[i]; int slot = -1;
            if (b > thr) slot = (int)__hip_atomic_fetch_add(&ctl[2], 1u, __ATOMIC_RELAXED, __HIP_MEMORY_SCOPE_WORKGROUP);
            else if (b == thr) { const unsigned q = __hip_atomic_fetch_add(&ctl[3], 1u, __ATOMIC_RELAXED, __HIP_MEMORY_SCOPE_WORKGROUP); if (q < rem) slot = (int)(ngt + q); }
            if (slot >= 0) { const int pair = pbase + slot, row = rs + i; PTOK[pair] = row; PG[pair] = __builtin_bit_cast(float, b); INV[(size_t)row * 16 + e] = pair; } }
    }
}
__device__ __forceinline__ void phase_gather(Frame& F) {
    const unsigned char* H2 = WSP(unsigned char, WS_H2); unsigned char* XG = WSP(unsigned char, WS_XG); unsigned char* HID = WSP(unsigned char, WS_HID); const int* PTOK = WSP(int, WS_PTOK);
    for (int p0 = F.gw * 64; p0 < NPAIR; p0 += F.NGW * 64) {
        const int mytok = PTOK[p0 + F.lane];
        unsigned zz = 0u; asm volatile("" : "+v"(zz));
#pragma unroll 1
        for (int q = 0; q < 64; q += 4) {
            u32x4 v[4][2]; int tk[4];
#pragma unroll
            for (int j = 0; j < 4; ++j) { tk[j] = __builtin_amdgcn_readlane(mytok, q + j); const u32x4* src = (const u32x4*)(H2 + (size_t)(tk[j] >= 0 ? tk[j] : 0) * DM) + F.lane; v[j][0] = src[0]; v[j][1] = src[64]; }
#pragma unroll
            for (int j = 0; j < 4; ++j) { const int p = p0 + q + j; u32x4* dst = (u32x4*)(XG + (size_t)p * DM) + F.lane; const bool ok = tk[j] >= 0;
                dst[0] = ok ? v[j][0] : (u32x4){zz, zz, zz, zz}; dst[64] = ok ? v[j][1] : (u32x4){zz, zz, zz, zz};
                if (F.lane < 8) *((u32x4*)(HID + (size_t)p * EFFP + EFF) + F.lane) = (u32x4){zz, zz, zz, zz}; } }
    }
}
__device__ __forceinline__ void phase_ln2(Frame& F, const Args& a, int layer) {
    const float* mod = (const float*)(F.ws + WS_CTL) + CW_MOD + (size_t)layer * 3 * 6 * DM;
    float* XS = WSP(float, WS_XS); const bf16_t* YE = WSP(bf16_t, WS_YE); const int* INV = WSP(int, WS_INV); const float* PG = WSP(float, WS_PGATE);
    const float* g2w = arg_in(a, I_LN2G) + layer * DM; const float* b2w = arg_in(a, I_LN2B) + layer * DM;
    for (int row = F.gw; row < T; row += F.NGW) {
        f32x4* xr = (f32x4*)(XS + (size_t)row * DM) + F.lane; const float* m = mod + (size_t)row_modidx(row) * 6 * DM;
        f32x4 mo[8];
#pragma unroll
        for (int j = 0; j < 8; ++j) mo[j] = (f32x4){0.f, 0.f, 0.f, 0.f};
        const int myinv = F.lane < 16 ? INV[(size_t)row * 16 + F.lane] : -1;
        unsigned long long sel = __ballot(myinv >= 0);
        while (sel) {
            const int e0 = __builtin_ctzll(sel); sel &= sel - 1; const bool two = sel != 0; const int e1 = two ? __builtin_ctzll(sel) : e0; if (two) sel &= sel - 1;
            const int p0 = __builtin_amdgcn_readlane(myinv, e0), p1 = __builtin_amdgcn_readlane(myinv, e1);
            const u32x2* y0 = (const u32x2*)(YE + (size_t)p0 * DM) + F.lane; const u32x2* y1 = (const u32x2*)(YE + (size_t)p1 * DM) + F.lane;
            const float g0 = PG[p0], g1 = two ? PG[p1] : 0.f;
            u32x2 w0[8], w1[8];
#pragma unroll
            for (int j = 0; j < 8; ++j) { w0[j] = y0[64 * j]; w1[j] = y1[64 * j]; }
#pragma unroll
            for (int j = 0; j < 8; ++j) mo[j] += (f32x4){bflo(w0[j].x), bfhi(w0[j].x), bflo(w0[j].y), bfhi(w0[j].y)} * g0 + (f32x4){bflo(w1[j].x), bfhi(w1[j].x), bflo(w1[j].y), bfhi(w1[j].y)} * g1;
        }
        f32x4 v[8];
#pragma unroll
        for (int j = 0; j < 8; ++j) { const int c = 4 * (64 * j + F.lane); v[j] = xr[64 * j] * ALPHA + *(const f32x4*)(m + 5 * DM + c) * mo[j]; }
        float mean, rstd; row_stats(v, mean, rstd, 1e-6f);
#pragma unroll
        for (int j = 0; j < 8; ++j) { const int c = 4 * (64 * j + F.lane); v[j] = (v[j] - mean) * rstd * *(const f32x4*)(g2w + c) + *(const f32x4*)(b2w + c); xr[64 * j] = v[j]; }
        if (layer == DEPTH - 1) { if (row >= TC) { f32x4* o = (f32x4*)(a.out + (size_t)(row - TC) * DM) + F.lane;
#pragma unroll
            for (int j = 0; j < 8; ++j) o[64 * j] = v[j]; } }
        else {
            row_stats(v, mean, rstd, 1e-6f);
            const float* m1 = m + (size_t)3 * 6 * DM;
            bf16_t* H = WSP(bf16_t, WS_H); unsigned* H8 = WSP(unsigned, WS_H8);
            u32x2* o = (u32x2*)(H + (size_t)row * DM) + F.lane; unsigned* o8 = H8 + (size_t)row * (DM / 4) + F.lane;
#pragma unroll
            for (int j = 0; j < 8; ++j) { const int c = 4 * (64 * j + F.lane); const f32x4 sh = *(const f32x4*)(m1 + c), sc = *(const f32x4*)(m1 + DM + c);
                const f32x4 y = (v[j] - mean) * rstd * (sc + 1.f) + sh; u32x2 w; w.x = pk2(y.x, y.y); w.y = pk2(y.z, y.w); o[64 * j] = w; o8[64 * j] = pk4fp8(y.x, y.y, y.z, y.w); } }
    }
}

constexpr int LDS_BYTES = 156672, MISC_OFF = LDS_BYTES - 64;
constexpr int NPL = 16, NPHASE = 1 + DEPTH * NPL;

__global__ void __launch_bounds__(NTHREADS, 2) fwd_kernel(Args args) {
    extern __shared__ __attribute__((aligned(16))) unsigned char lds_raw[];
    Frame F;
    F.lds = (LAS unsigned char*)lds_raw;
    F.tid = threadIdx.x; F.lane = F.tid & 63; F.wave = __builtin_amdgcn_readfirstlane(F.tid >> 6); const int wave0 = F.wave;
    F.G = gridDim.x; F.bid = blockIdx.x; F.gw = F.bid * NWAVES + F.wave; F.NGW = F.G * NWAVES; F.ws = args.ws;
    volatile LAS unsigned* misc = (volatile LAS unsigned*)(F.lds + MISC_OFF);
    if (F.tid < 16) misc[F.tid] = 0u;
    __syncthreads();
    const int lo = args.ph_lo, hi = args.ph_hi;
    XcdBarrier bar; bar.bar = (unsigned*)(F.ws + WS_CTL) + CW_BAR; bar.x = 0; bar.st = nullptr;
    const bool multi = (hi - lo) > 1;
    if (multi) bar = xcd_barrier_post((unsigned*)(F.ws + WS_CTL) + CW_BAR, misc);
#ifndef ONLY_PHASE
#define ONLY_PHASE -1
#endif
#define PON(r) (ONLY_PHASE < 0 || ONLY_PHASE == (r))
#ifndef REP_MASK
#define REP_MASK 0
#endif
#define REP(b) ((REP_MASK >> (b)) & 1)
#define REOPQ() do { F.ws = opq(args.ws); F.lane = lane_asm() & 63; F.wave = opqs(wave0) & 7; F.tid = F.wave * 64 + F.lane; F.G = opqs(gridDim.x); F.bid = opqs(blockIdx.x); F.gw = F.bid * NWAVES + F.wave; F.NGW = F.G * NWAVES; } while (0)
#define IN(k) (lo <= (k) && (k) < hi)
#define SEAM(k) do { if (IN(k) && IN((k) + 1)) { XcdBarrier bb_ = bar; bb_.x = (unsigned)opqs((int)bar.x); xcd_barrier(bb_); } } while (0)
    if (PON(100) && IN(0)) { F.ws = opq(args.ws); F.lane = lane_asm() & 63; F.wave = opqs(wave0) & 7; F.tid = F.wave * 64 + F.lane; F.G = opqs(gridDim.x); F.bid = opqs(blockIdx.x); F.gw = F.bid * NWAVES + F.wave; F.NGW = F.G * NWAVES; { p0_weights(F, args); __syncthreads(); REOPQ(); p0_mod(F, args); __syncthreads(); REOPQ(); phase_hdn(F, args, 0); REOPQ(); phase_hdn(F, args, 1); __syncthreads(); } }
    SEAM(0);
#pragma unroll 1
    for (int layer = 0; layer < DEPTH; ++layer) {
        const int pb = 1 + layer * NPL; const bool lat_only = (layer == DEPTH - 1);
        if (PON(0) && IN(pb + 0)) { F.ws = opq(args.ws); F.lane = lane_asm() & 63; F.wave = opqs(wave0) & 7; F.tid = F.wave * 64 + F.lane; F.G = opqs(gridDim.x); F.bid = opqs(blockIdx.x); F.gw = F.bid * NWAVES + F.wave; F.NGW = F.G * NWAVES; if (layer == 0) phase_modln(F, args, layer); __syncthreads(); }
        SEAM(pb + 0);
        if (PON(1) && IN(pb + 1)) { F.ws = opq(args.ws); F.lane = lane_asm() & 63; F.wave = opqs(wave0) & 7; F.tid = F.wave * 64 + F.lane; F.G = opqs(gridDim.x); F.bid = opqs(blockIdx.x); F.gw = F.bid * NWAVES + F.wave; F.NGW = F.G * NWAVES;
            { pg8::Gemm g{WSP(bf16_t, WS_H), WSP(bf16_t, WS_WIN + layer * SZ_WIN), DM, DM, DM}; pg8::StaticOrder S; S.init(66, 13, F.G, F.bid, 0, 14);
              EpiBf16 E{WSP(bf16_t, WS_P), NNG, nullptr, 0, 0, 1.f, 1 << 30, 0};
              pg8::gemm_phase(F.lds, g, S, E, F.tid); }
            { pg8::Gemm g{WSP(bf16_t, WS_H8), WSP(bf16_t, WS_WIN + layer * SZ_WIN + WIN8P_OFF), DM / 2, DM / 2, DM / 2}; pg8::StaticOrder S; S.init(66, 27, F.G, (F.bid + 90) & 255);
              EpiBf16 E{WSP(bf16_t, WS_P), NNG, nullptr, 0, 0, 1.f / 64.f, 14, 13};
              pg8::gemm_phase<EpiBf16, pg8::StaticOrder, true>(F.lds, g, S, E, F.tid); }
        }
        SEAM(pb + 1);
        if (PON(2) && IN(pb + 2)) { F.ws = opq(args.ws); F.lane = lane_asm() & 63; F.wave = opqs(wave0) & 7; F.tid = F.wave * 64 + F.lane; F.G = opqs(gridDim.x); F.bid = opqs(blockIdx.x); F.gw = F.bid * NWAVES + F.wave; F.NGW = F.G * NWAVES; { phase_prep(F, args, layer); REOPQ(); phase_filt(F, args, layer); __syncthreads(); } }
        SEAM(pb + 2);
        if (PON(3) && IN(pb + 3)) { F.ws = opq(args.ws); F.lane = lane_asm() & 63; F.wave = opqs(wave0) & 7; F.tid = F.wave * 64 + F.lane; F.G = opqs(gridDim.x); F.bid = opqs(blockIdx.x); F.gw = F.bid * NWAVES + F.wave; F.NGW = F.G * NWAVES;
#if !defined(T3) || T3 == 0
            { pg8::Gemm g{WSP(bf16_t, WS_CQ8), WSP(bf16_t, WS_WQ + layer * SZ_WQ), 512, 256, 256}; pg8::StaticOrder S; S.init(lat_only ? 64 : 66, 6, F.G, F.bid, lat_only ? 2 : 0);
              EpiBf16 E{WSP(bf16_t, WS_Q), 1536, WSP(float, WS_RS), 2, 0, 1.f / 16.f, 1 << 30, 0}; pg8::gemm_phase<EpiBf16, pg8::StaticOrder, true>(F.lds, g, S, E, F.tid); }
#endif
#if !defined(T3) || T3 == 1
            { pg8::Gemm g{WSP(bf16_t, WS_CQ8) + 256, WSP(bf16_t, WS_WKV + layer * SZ_WKV), 512, 256, 256}; pg8::StaticOrder S; S.init(66, 8, F.G, (F.bid + 140) & 255);
              EpiBf16 E{WSP(bf16_t, WS_KV), 2048, WSP(float, WS_RS) + 1, 2, 0, 1.f / 16.f, 1 << 30, 0}; pg8::gemm_phase<EpiBf16, pg8::StaticOrder, true>(F.lds, g, S, E, F.tid); }
#endif
#if !defined(T3) || T3 == 2
            { pg8::Gemm g{WSP(bf16_t, WS_ALORA), WSP(bf16_t, WS_WLORA + layer * SZ_WLORA), 256, 256, 256}; pg8::StaticOrder S; S.init(66, 20, F.G, (F.bid + 156) & 255);
              EpiLora E{WSP(bf16_t, WS_EW), WSP(bf16_t, WS_ICLR), WSP(bf16_t, WS_GG), arg_in(args, I_RW0) + layer * 2048, arg_in(args, I_RA0) + layer * 2048, 1.f / 8.f}; pg8::gemm_phase<EpiLora, pg8::StaticOrder, true>(F.lds, g, S, E, F.tid); }
            REOPQ(); phase_mamba_states(F, args, layer); __syncthreads();
#endif
        }
        SEAM(pb + 3);
        if (PON(4) && IN(pb + 4)) { F.ws = opq(args.ws); F.lane = lane_asm() & 63; F.wave = opqs(wave0) & 7; F.tid = F.wave * 64 + F.lane; F.G = opqs(gridDim.x); F.bid = opqs(blockIdx.x); F.gw = F.bid * NWAVES + F.wave; F.NGW = F.G * NWAVES; phase_vt(F); __syncthreads(); }
        SEAM(pb + 4);
        if (PON(5) && IN(pb + 5)) { F.ws = opq(args.ws); F.lane = lane_asm() & 63; F.wave = opqs(wave0) & 7; F.tid = F.wave * 64 + F.lane; F.G = opqs(gridDim.x); F.bid = opqs(blockIdx.x); F.gw = F.bid * NWAVES + F.wave; F.NGW = F.G * NWAVES;
#if !defined(T5) || T5 == 0
            phase_rwkv_scan(F, args, layer); __syncthreads();
#endif
#if !defined(T5) || T5 == 1
            REOPQ(); phase_attn(F, lat_only);
#endif
#if !defined(T5) || T5 == 2
            REOPQ(); phase_hyena_fft(F, args, layer);
#endif
#if !defined(T5) || T5 == 3
            REOPQ(); phase_mamba_scan(F); __syncthreads();
#endif
        }
        SEAM(pb + 5);
        if (PON(6) && IN(pb + 6)) { F.ws = opq(args.ws); F.lane = lane_asm() & 63; F.wave = opqs(wave0) & 7; F.tid = F.wave * 64 + F.lane; F.G = opqs(gridDim.x); F.bid = opqs(blockIdx.x); F.gw = F.bid * NWAVES + F.wave; F.NGW = F.G * NWAVES;
#if !defined(T6) || T6 == 0
            phase_mamba_out(F, args, layer); __syncthreads();
#endif
#if !defined(T6) || T6 == 1
            REOPQ(); phase_hyena_out(F, args, layer);
#endif
#if !defined(T6) || T6 == 2
            REOPQ(); phase_rwkv_out(F, args, layer); __syncthreads();
#endif
        }
        SEAM(pb + 6);
        if (PON(7) && IN(pb + 7)) { F.ws = opq(args.ws); F.lane = lane_asm() & 63; F.wave = opqs(wave0) & 7; F.tid = F.wave * 64 + F.lane; F.G = opqs(gridDim.x); F.bid = opqs(blockIdx.x); F.gw = F.bid * NWAVES + F.wave; F.NGW = F.G * NWAVES;
            pg8::Gemm g{WSP(bf16_t, WS_H8), WSP(bf16_t, WS_WIN + layer * SZ_WIN) + (size_t)NNG * DM, DM / 2, DM / 2, DM / 2}; pg8::StaticOrder S; S.init(lat_only ? 64 : 66, NGATE / 256, F.G, F.bid, lat_only ? 2 : 0);
            EpiBf16 E{WSP(bf16_t, WS_GATES), NGATE, nullptr, 0, 0, 1.f / 64.f, 1 << 30, 0};
            pg8::gemm_phase<EpiBf16, pg8::StaticOrder, true>(F.lds, g, S, E, F.tid);
            REOPQ(); phase_mamba_norm(F, args, layer);
        }
        SEAM(pb + 7);
        if (PON(8) && IN(pb + 8)) { F.ws = opq(args.ws); F.lane = lane_asm() & 63; F.wave = opqs(wave0) & 7; F.tid = F.wave * 64 + F.lane; F.G = opqs(gridDim.x); F.bid = opqs(blockIdx.x); F.gw = F.bid * NWAVES + F.wave; F.NGW = F.G * NWAVES;
            { pg8::Gemm g{WSP(bf16_t, WS_Y), WSP(bf16_t, WS_WBR + layer * SZ_WBR), 1024, 1024, 1024}; OrderHy S; S.init(F.G, F.bid, lat_only ? 64 : 66, lat_only ? 2 : 0);
              EpiHy E{WSP(bf16_t, WS_GATES), WSP(bf16_t, WS_MRGB)};
              pg8::gemm_phase(F.lds, g, S, E, F.tid); }
            { pg8::Gemm g{WSP(bf16_t, WS_Y), WSP(bf16_t, WS_WBR + layer * SZ_WBR), 512, 512, 512}; OrderMerge3 S; S.init(F.G, F.bid, lat_only ? 64 : 66, lat_only ? 2 : 0);
              EpiMerge3 E{WSP(bf16_t, WS_GATES), WSP(bf16_t, WS_MRGB)};
              pg8::gemm_phase<EpiMerge3, OrderMerge3, true>(F.lds, g, S, E, F.tid); }
        }
        SEAM(pb + 8);
        if (PON(9) && IN(pb + 9)) { F.ws = opq(args.ws); F.lane = lane_asm() & 63; F.wave = opqs(wave0) & 7; F.tid = F.wave * 64 + F.lane; F.G = opqs(gridDim.x); F.bid = opqs(blockIdx.x); F.gw = F.bid * NWAVES + F.wave; F.NGW = F.G * NWAVES;
            pg8::Gemm g{WSP(bf16_t, WS_MRGB), WSP(bf16_t, WS_WOUT + layer * SZ_WOUT), DM, DM, DM}; pg8::StaticOrder S; S.init(lat_only ? 64 : 66, 8, F.G, F.bid, lat_only ? 2 : 0);
            EpiF32 E{WSP(float, WS_YMIX), DM};
            pg8::gemm_phase(F.lds, g, S, E, F.tid);

        }
        SEAM(pb + 9);
        if (PON(10) && IN(pb + 10)) { F.ws = opq(args.ws); F.lane = lane_asm() & 63; F.wave = opqs(wave0) & 7; F.tid = F.wave * 64 + F.lane; F.G = opqs(gridDim.x); F.bid = opqs(blockIdx.x); F.gw = F.bid * NWAVES + F.wave; F.NGW = F.G * NWAVES; phase_ln1(F, args, layer); __syncthreads(); { REOPQ(); conv_experts(F, args, layer); __syncthreads(); } }
        SEAM(pb + 10);
        if (PON(11) && IN(pb + 11)) { F.ws = opq(args.ws); F.lane = lane_asm() & 63; F.wave = opqs(wave0) & 7; F.tid = F.wave * 64 + F.lane; F.G = opqs(gridDim.x); F.bid = opqs(blockIdx.x); F.gw = F.bid * NWAVES + F.wave; F.NGW = F.G * NWAVES; phase_topk(F, lat_only); __syncthreads(); }
        SEAM(pb + 11);
        if (PON(12) && IN(pb + 12)) { F.ws = opq(args.ws); F.lane = lane_asm() & 63; F.wave = opqs(wave0) & 7; F.tid = F.wave * 64 + F.lane; F.G = opqs(gridDim.x); F.bid = opqs(blockIdx.x); F.gw = F.bid * NWAVES + F.wave; F.NGW = F.G * NWAVES; phase_gather(F); }
        SEAM(pb + 12);
        if (PON(13) && IN(pb + 13)) { F.ws = opq(args.ws); F.lane = lane_asm() & 63; F.wave = opqs(wave0) & 7; F.tid = F.wave * 64 + F.lane; F.G = opqs(gridDim.x); F.bid = opqs(blockIdx.x); F.gw = F.bid * NWAVES + F.wave; F.NGW = F.G * NWAVES;
            pg8::Gemm g{WSP(bf16_t, WS_XG), WSP(bf16_t, WS_WE), DM / 2, DM / 2, DM / 2}; OrderMoe S; S.init(11, F.G, F.bid, lat_only ? 8 : 9);
            EpiSwiglu E{WSP(unsigned char, WS_HID)};
            pg8::gemm_phase<EpiSwiglu, OrderMoe, true>(F.lds, g, S, E, F.tid);

        }
        SEAM(pb + 13);
        if (PON(14) && IN(pb + 14)) { F.ws = opq(args.ws); F.lane = lane_asm() & 63; F.wave = opqs(wave0) & 7; F.tid = F.wave * 64 + F.lane; F.G = opqs(gridDim.x); F.bid = opqs(blockIdx.x); F.gw = F.bid * NWAVES + F.wave; F.NGW = F.G * NWAVES;
            pg8::Gemm g{WSP(bf16_t, WS_HID), WSP(bf16_t, WS_WE + SZ_WGU8), EFFP / 2, EFFP / 2, EFFP / 2}; OrderMoe S; S.init(8, F.G, F.bid, lat_only ? 8 : 9);
            EpiDown E{WSP(bf16_t, WS_YE)};
            pg8::gemm_phase<EpiDown, OrderMoe, true>(F.lds, g, S, E, F.tid);

        }
        SEAM(pb + 14);
        if (PON(15) && IN(pb + 15)) { F.ws = opq(args.ws); F.lane = lane_asm() & 63; F.wave = opqs(wave0) & 7; F.tid = F.wave * 64 + F.lane; F.G = opqs(gridDim.x); F.bid = opqs(blockIdx.x); F.gw = F.bid * NWAVES + F.wave; F.NGW = F.G * NWAVES; phase_ln2(F, args, layer); }
        SEAM(pb + 15);
    }
#undef IN
#undef SEAM
}


#ifdef DBG_CUT
__global__ void dbg_dump(const unsigned char* ws, float* out, size_t off, int is_bf16, size_t n_src) {
    const size_t N = (size_t)TL * DM;
    for (size_t i = (size_t)blockIdx.x * blockDim.x + threadIdx.x; i < N; i += (size_t)gridDim.x * blockDim.x) {
        const size_t j = i % n_src;
        out[i] = is_bf16 ? bf2f(((const bf16_t*)(ws + off))[j]) : ((const float*)(ws + off))[j];
    }
}
#endif

#ifdef DBG_PASSES
__global__ void dbg_chk(const unsigned char* base, size_t off, size_t nbytes, unsigned long long* slot) {
    const unsigned* p = (const unsigned*)(base + off); const size_t n = nbytes / 4; unsigned long long s = 0;
    for (size_t i = (size_t)blockIdx.x * blockDim.x + threadIdx.x; i < n; i += (size_t)gridDim.x * blockDim.x) s += p[i];
    for (int o = 32; o > 0; o >>= 1) s += __shfl_xor(s, o);
    if ((threadIdx.x & 63) == 0) atomicAdd(slot, s);
}
__global__ void dbg_report(const unsigned long long* tab, float* out, int npass) {
    int k = 0;
    for (int ph = NPHASE - 1; ph >= 0; --ph) if (tab[ph] != tab[64 + ph]) k = ph + 1;
    if (k == 0 && npass > 2) { for (int ph = NPHASE - 1; ph >= 0; --ph) if (tab[64 + ph] != tab[128 + ph]) k = 50 + ph + 1; }
    if (k == 0) return;
    const float c = sqrtf(10.f * (float)k);
    for (size_t i = (size_t)blockIdx.x * blockDim.x + threadIdx.x; i < (size_t)TL * DM; i += (size_t)gridDim.x * blockDim.x) out[i] = c;
}
struct DbgReg { size_t off, n; };
#endif
extern "C" void kernel_launch(void* const* d_in, const int* in_sizes, int n_in, void* d_out, int out_size, void* d_ws, size_t ws_size, hipStream_t stream) {
    static int grid = 0;
    if (grid == 0) {
        if (n_in != N_INPUTS || in_sizes[0] != TL * DM || out_size != TL * DM || ws_size < WS_END) {
            fprintf(stderr, "kernel_launch: shape/workspace mismatch: n_in %d in0 %d out %d ws %zu (need %zu)\n", n_in, n_in > 0 ? in_sizes[0] : -1, out_size, ws_size, (size_t)WS_END); grid = -1; return; }
        int dev = 0, cus = 0, per_cu = 0;
        if (hipGetDevice(&dev) != hipSuccess || hipDeviceGetAttribute(&cus, hipDeviceAttributeMultiprocessorCount, dev) != hipSuccess) { grid = -1; return; }
        if (hipFuncSetAttribute((const void*)fwd_kernel, hipFuncAttributeMaxDynamicSharedMemorySize, LDS_BYTES) != hipSuccess) { fprintf(stderr, "kernel_launch: hipFuncSetAttribute failed\n"); grid = -1; return; }
        if (hipOccupancyMaxActiveBlocksPerMultiprocessor(&per_cu, (const void*)fwd_kernel, NTHREADS, LDS_BYTES) != hipSuccess || per_cu < 1) { fprintf(stderr, "kernel_launch: occupancy query says %d\n", per_cu); grid = -1; (void)hipGetLastError(); return; }
        grid = cus;
    }
    if (grid < 0) return;
    (void)hipMemsetAsync((char*)d_ws + WS_CTL, 0, CTL_BYTES, stream);
    Args a{};
    for (int i = 0; i < N_INPUTS; ++i) a.in[i] = (const float*)d_in[i];
    a.out = (float*)d_out; a.ws = (unsigned char*)d_ws;
#if MK_ONE_LAUNCH
    a.ph_lo = 0; a.ph_hi = NPHASE;
    hipLaunchKernelGGL(fwd_kernel, dim3(grid), dim3(NTHREADS), LDS_BYTES, stream, a);
#else
#ifdef DBG_PASSES
    {
        unsigned long long* tab = (unsigned long long*)((char*)d_ws + 1600000);
        auto chk = [&](int pass, int ph, size_t off, size_t n) { hipLaunchKernelGGL(dbg_chk, dim3(1024), dim3(256), 0, stream, (const unsigned char*)d_ws, off, n, tab + pass * 64 + ph); };
        for (int pass = 0; pass < DBG_PASSES; ++pass) {
            if (pass > 0) (void)hipMemsetAsync((char*)d_ws + (size_t)CW_MOD * 4, 0, (size_t)DEPTH * 3 * 6 * DM * 4, stream);
            for (int ph = 0; ph < NPHASE; ++ph) {
                a.ph_lo = ph; a.ph_hi = ph + 1; hipLaunchKernelGGL(fwd_kernel, dim3(grid), dim3(NTHREADS), LDS_BYTES, stream, a);
                if (ph == 0) { chk(pass, ph, WS_WIN, WS_XS - WS_WIN); chk(pass, ph, (size_t)CW_MOD * 4, (size_t)DEPTH * 3 * 6 * DM * 4); continue; }
                const int r = (ph - 1) % NPL;
                switch (r) {
                case 0: chk(pass, ph, WS_H, SZ_H); chk(pass, ph, WS_HDN, SZ_HDN); break;
                case 1: chk(pass, ph, WS_P, SZ_P); break;
                case 2: chk(pass, ph, WS_P2, SZ_P2); chk(pass, ph, WS_KK, SZ_TK2); chk(pass, ph, WS_ALORA, WS_VT - WS_ALORA); chk(pass, ph, WS_VT, WS_HDN - WS_VT); break;
                case 3: chk(pass, ph, WS_Q, SZ_Q + SZ_KV); chk(pass, ph, WS_EW, 4 * SZ_TK2); chk(pass, ph, WS_GG, SZ_TK2); break;
                case 4: chk(pass, ph, WS_Q, SZ_Q); chk(pass, ph, WS_MST, SZ_MST + SZ_MCS); break;
                case 5: chk(pass, ph, WS_YRW, 2 * SZ_TK2); chk(pass, ph, WS_Y, SZ_Y / 4); chk(pass, ph, WS_VT, SZ_VT); chk(pass, ph, WS_MST, SZ_MST); break;
                case 6: chk(pass, ph, WS_Y + SZ_Y / 4, 3 * (SZ_Y / 4)); break;
                case 7: chk(pass, ph, WS_GATES, SZ_GATES); chk(pass, ph, WS_Y + SZ_Y / 4, SZ_Y / 4); break;
                case 8: chk(pass, ph, WS_MRGF, SZ_MRGF); chk(pass, ph, WS_MRGB, SZ_MRGB); break;
                case 9: chk(pass, ph, WS_YMIX, SZ_YMIX); break;
                case 10: chk(pass, ph, WS_XS, SZ_XS); chk(pass, ph, WS_H2, SZ_H); chk(pass, ph, WS_AFF, SZ_AFF); chk(pass, ph, WS_WE, SZ_WGU + SZ_WD); break;
                case 11: chk(pass, ph, WS_INV, SZ_INV + SZ_PTOK + SZ_PGATE); break;
                case 12: chk(pass, ph, WS_XG, SZ_XG); break;
                case 13: chk(pass, ph, WS_HID, SZ_HID); break;
                case 14: chk(pass, ph, WS_YE, SZ_YE); break;
                case 15: chk(pass, ph, WS_XS, SZ_XS); break;
                }
            }
        }
        hipLaunchKernelGGL(dbg_report, dim3(2048), dim3(256), 0, stream, (const unsigned long long*)tab, (float*)d_out, (int)DBG_PASSES);
    }
#elif defined(DBG_CUT)
    for (int ph = 0; ph < DBG_CUT; ++ph) { a.ph_lo = ph; a.ph_hi = ph + 1; hipLaunchKernelGGL(fwd_kernel, dim3(grid), dim3(NTHREADS), LDS_BYTES, stream, a); }
    hipLaunchKernelGGL(dbg_dump, dim3(2048), dim3(256), 0, stream, (const unsigned char*)d_ws, (float*)d_out, (size_t)DBG_OFF, DBG_BF16, (size_t)DBG_N);
#else
    for (int ph = 0; ph < NPHASE; ++ph) { a.ph_lo = ph; a.ph_hi = ph + 1; hipLaunchKernelGGL(fwd_kernel, dim3(grid), dim3(NTHREADS), LDS_BYTES, stream, a); }
#endif
#endif
}
```
